# Optimizing an MI355X kernel written in HIP

```python
import math
import jax
import jax.numpy as jnp
from jax import lax
import numpy as np

D_MODEL = 2048
BATCH = 4
SEQ = 4096
DEPTH = 2

MIX_WIDTH = D_MODEL
N_GROUPS = 4
GROUP_WIDTH = MIX_WIDTH // N_GROUPS
NORM_EPS = 1e-6
CONV_WIDTH = 4

RW_HEAD = 64
RW_HEADS = GROUP_WIDTH // RW_HEAD
RW_W_RANK = 64
RW_A_RANK = 64
RW_G_RANK = 128
RW_V_RANK = 32
RW_GN_EPS = 64e-5
RW_WIDTHS = (GROUP_WIDTH, GROUP_WIDTH, GROUP_WIDTH, RW_W_RANK, RW_A_RANK, RW_G_RANK)
RW_COLS = sum(RW_WIDTHS)

GLA_HEADS = 4
GLA_DV = GROUP_WIDTH // GLA_HEADS
GLA_DK = GLA_DV // 2
GLA_GATE_RANK = 16
GLA_GATE_NORMALIZER = 16.0
GLA_CHUNK = 64
GLA_WIDTHS = (GLA_HEADS * GLA_DK, GLA_HEADS * GLA_DK, GROUP_WIDTH, GROUP_WIDTH, GLA_GATE_RANK)
GLA_COLS = sum(GLA_WIDTHS)

LRU_WIDTH = GROUP_WIDTH
LRU_BLOCKS = 8
LRU_BLOCK = LRU_WIDTH // LRU_BLOCKS
LRU_C = 8.0
LRU_WIDTHS = (LRU_WIDTH, LRU_WIDTH)
LRU_COLS = sum(LRU_WIDTHS)

GDN_HEADS = 4
GDN_DK = 128
GDN_DV = GROUP_WIDTH // GDN_HEADS
GDN_CHUNK = 64
GDN_WIDTHS = (GDN_HEADS * GDN_DK, GDN_HEADS * GDN_DK, GDN_HEADS * GDN_DV, GDN_HEADS * GDN_DV, GDN_HEADS, GDN_HEADS)
GDN_COLS = sum(GDN_WIDTHS)
GDN_CONV_CH = 2 * GDN_HEADS * GDN_DK + GDN_HEADS * GDN_DV

IN_COLS = RW_COLS + GLA_COLS + LRU_COLS + GDN_COLS

PEER_HEADS = 8
PEER_KEYS = 128
PEER_EXPERTS = PEER_KEYS * PEER_KEYS
PEER_QDIM = 256
PEER_TOPK = 16
PEER_TOKEN_BLOCK = 128

kernel_name = "hybrid_rwkv7_gla_rglru_gdn_peer"


def rms_norm(x, gain, eps=NORM_EPS):
    xf = x.astype(jnp.float32)
    y = xf * lax.rsqrt(jnp.mean(xf * xf, axis=-1, keepdims=True) + eps)
    return (y * gain).astype(x.dtype)


def _split(z, widths):
    return jnp.split(z, np.cumsum(widths)[:-1].tolist(), axis=-1)


def _token_shift(x):
    return jnp.pad(x[:, :-1], ((0, 0), (1, 0), (0, 0)))


def _causal_conv(x, w):
    width, ch = w.shape
    return lax.conv_general_dilated(
        x, w[:, None, :].astype(x.dtype), window_strides=(1,), padding=[(width - 1, 0)],
        dimension_numbers=("NWC", "WIO", "NWC"), feature_group_count=ch)


def _l2norm(t, eps=1e-6):
    return t * lax.rsqrt(jnp.sum(t * t, axis=-1, keepdims=True) + eps)


def _to_chunks(t, chunk):
    b, s = t.shape[:2]
    t = t.reshape((b, s // chunk, chunk) + t.shape[2:])
    return jnp.moveaxis(t, (1, 3), (0, 2))


def _from_chunks(t):
    t = jnp.moveaxis(t, (0, 2), (1, 3))
    return t.reshape((t.shape[0], t.shape[1] * t.shape[2]) + t.shape[3:])


def _rwkv7_scan(r, w, k, v, a, b):
    bsz, _, nh, n = r.shape

    def step(s, inp):
        r_t, w_t, k_t, v_t, a_t, b_t = inp
        sa = jnp.einsum("bhvk,bhk->bhv", s, a_t)
        s = s * w_t[:, :, None, :] + sa[..., None] * b_t[:, :, None, :] + v_t[..., None] * k_t[:, :, None, :]
        return s, jnp.einsum("bhvk,bhk->bhv", s, r_t)

    xs = tuple(jnp.swapaxes(t, 0, 1) for t in (r, w, k, v, a, b))
    _, y = lax.scan(step, jnp.zeros((bsz, nh, n, n), jnp.float32), xs)
    return jnp.swapaxes(y, 0, 1)


def rwkv7_mixer(p, v_first, mu, w0, w_up, a0, a_up, g_up, k_k, k_a, r_k, ln_w, ln_b, v_res):
    bsz, s, _ = p.shape
    z = p + (_token_shift(p) - p) * mu
    r, k, v, wd, ad, gd = _split(z, RW_WIDTHS)
    w_raw = -jax.nn.softplus(-(w0 + jnp.tanh(wd) @ w_up)) - 0.5
    a = jax.nn.sigmoid(a0 + ad @ a_up)
    g = jax.nn.sigmoid(gd) @ g_up
    if v_res is None:
        v_first = v
    else:
        v0, v_down, v_up = v_res
        v = v + (v_first - v) * jax.nn.sigmoid(v0 + (v @ v_down) @ v_up)

    def heads(t):
        return t.reshape(bsz, s, RW_HEADS, RW_HEAD).astype(jnp.float32)

    kk = heads(k * k_k)
    kk = kk * lax.rsqrt(jnp.maximum(jnp.sum(kk * kk, axis=-1, keepdims=True), 1e-24))
    k = k * (1.0 + (a - 1.0) * k_a)
    rh, kh, vh, ah = heads(r), heads(k), heads(v), heads(a)
    decay = jnp.exp(-jnp.exp(heads(w_raw)))
    y = _rwkv7_scan(rh, decay, kh, vh, -kk, kk * ah)
    mean = jnp.mean(y, axis=-1, keepdims=True)
    var = jnp.mean(jnp.square(y - mean), axis=-1, keepdims=True)
    y = ((y - mean) * lax.rsqrt(var + RW_GN_EPS)).reshape(bsz, s, GROUP_WIDTH) * ln_w + ln_b
    bonus = (jnp.sum(rh * kh * r_k, axis=-1, keepdims=True) * vh).reshape(bsz, s, GROUP_WIDTH)
    return ((y + bonus) * g).astype(p.dtype), v_first


def _gla_chunked(q, k, v, log_a):
    bsz, s, nh, dk = q.shape
    dv = v.shape[-1]
    c = GLA_CHUNK
    q, k, v, log_a = (_to_chunks(t, c) for t in (q * dk ** -0.5, k, v, log_a))
    b = jnp.cumsum(log_a, axis=3)
    b_ref = b[:, :, :, c // 2 - 1:c // 2, :]
    b_last = b[:, :, :, -1:, :]
    causal = jnp.tril(jnp.ones((c, c), dtype=bool))
    scores = jnp.einsum("nbhik,nbhjk->nbhij", q * jnp.exp(b - b_ref), k * jnp.exp(b_ref - b))
    o_intra = jnp.einsum("nbhij,nbhjv->nbhiv", jnp.where(causal, scores, 0.0), v)
    q_in = q * jnp.exp(b)
    k_st = k * jnp.exp(b_last - b)
    dec = jnp.exp(b_last[:, :, :, 0, :])

    def step(st, inp):
        q_n, k_n, v_n, d_n = inp
        o = jnp.einsum("bhck,bhkv->bhcv", q_n, st)
        st = st * d_n[..., None] + jnp.einsum("bhck,bhcv->bhkv", k_n, v_n)
        return st, o

    _, o_inter = lax.scan(step, jnp.zeros((bsz, nh, dk, dv), jnp.float32), (q_in, k_st, v, dec))
    return _from_chunks(o_intra + o_inter)


def gla_mixer(p, a_up, a_bias, norm_gain):
    bsz, s, _ = p.shape
    q, k, v, g, ad = _split(p, GLA_WIDTHS)
    log_a = jax.nn.log_sigmoid((ad @ a_up + a_bias).astype(jnp.float32)) / GLA_GATE_NORMALIZER

    def hk(t):
        return t.reshape(bsz, s, GLA_HEADS, GLA_DK).astype(jnp.float32)

    o = _gla_chunked(hk(q), hk(k), v.reshape(bsz, s, GLA_HEADS, GLA_DV).astype(jnp.float32), hk(log_a))
    o = rms_norm(o, norm_gain).reshape(bsz, s, GROUP_WIDTH)
    return (o * jax.nn.silu(g.astype(jnp.float32))).astype(p.dtype)


def _linear_scan(a, u):
    def combine(c1, c2):
        a1, b1 = c1
        a2, b2 = c2
        return a1 * a2, a2 * b1 + b2

    _, h = lax.associative_scan(combine, (a, u), axis=1)
    return h


def rglru_mixer(p, conv_w, conv_b, w_r, b_r, w_i, b_i, lam):
    bsz, s, _ = p.shape
    xb, yb = _split(p, LRU_WIDTHS)
    xc = _causal_conv(xb, conv_w) + conv_b
    blocks = xc.reshape(bsz, s, LRU_BLOCKS, LRU_BLOCK)
    r = jax.nn.sigmoid(jnp.einsum("btni,nij->btnj", blocks, w_r).reshape(bsz, s, LRU_WIDTH) + b_r)
    i = jax.nn.sigmoid(jnp.einsum("btni,nij->btnj", blocks, w_i).reshape(bsz, s, LRU_WIDTH) + b_i)
    log_a = (-LRU_C * r * jax.nn.softplus(-lam)).astype(jnp.float32)
    u = (xc * i).astype(jnp.float32) * jnp.sqrt(-jnp.expm1(2.0 * log_a))
    h = _linear_scan(jnp.exp(log_a), u)
    return (h * jax.nn.gelu(yb.astype(jnp.float32))).astype(p.dtype)


def _gated_delta_chunked(q, k, v, g, beta):
    bsz, s, nh, dk = q.shape
    dv = v.shape[-1]
    c = GDN_CHUNK
    q, k, v, g, beta = (_to_chunks(t, c) for t in (q * dk ** -0.5, k, v, g, beta))
    gc = jnp.cumsum(g, axis=-1)
    incl = jnp.tril(jnp.ones((c, c), dtype=bool))
    strict = jnp.tril(jnp.ones((c, c), dtype=bool), k=-1)
    decay = jnp.exp(jnp.where(incl, gc[..., :, None] - gc[..., None, :], -jnp.inf))
    k_beta = k * beta[..., None]
    lmat = jnp.where(strict, jnp.einsum("nbhik,nbhjk->nbhij", k_beta, k) * decay, 0.0)
    tmat = lmat + jnp.eye(c, dtype=jnp.float32)
    rhs = jnp.concatenate([v * beta[..., None], k_beta * jnp.exp(gc)[..., None]], axis=-1)
    sol = lax.linalg.triangular_solve(tmat, rhs, left_side=True, lower=True, unit_diagonal=True)
    u, w = sol[..., :dv], sol[..., dv:]
    attn = jnp.einsum("nbhik,nbhjk->nbhij", q, k) * decay
    q_g = q * jnp.exp(gc)[..., None]
    k_g = k * jnp.exp(gc[..., -1:] - gc)[..., None]
    g_last = jnp.exp(gc[..., -1])

    def step(st, inp):
        u_n, w_n, q_n, k_n, a_n, d_n = inp
        v_new = u_n - jnp.einsum("bhck,bhkv->bhcv", w_n, st)
        o = jnp.einsum("bhck,bhkv->bhcv", q_n, st) + jnp.einsum("bhij,bhjv->bhiv", a_n, v_new)
        st = st * d_n[..., None, None] + jnp.einsum("bhck,bhcv->bhkv", k_n, v_new)
        return st, o

    _, o = lax.scan(step, jnp.zeros((bsz, nh, dk, dv), jnp.float32), (u, w, q_g, k_g, attn, g_last))
    return _from_chunks(o)


def gdn_mixer(p, conv_w, a_log, dt_bias, norm_gain):
    bsz, s, _ = p.shape
    q, k, v, zg, b_logit, a_logit = _split(p, GDN_WIDTHS)
    qkv = jax.nn.silu(_causal_conv(jnp.concatenate([q, k, v], axis=-1), conv_w))
    q, k, v = _split(qkv, (GDN_HEADS * GDN_DK, GDN_HEADS * GDN_DK, GDN_HEADS * GDN_DV))
    q = _l2norm(q.reshape(bsz, s, GDN_HEADS, GDN_DK).astype(jnp.float32))
    k = _l2norm(k.reshape(bsz, s, GDN_HEADS, GDN_DK).astype(jnp.float32))
    v = v.reshape(bsz, s, GDN_HEADS, GDN_DV).astype(jnp.float32)
    beta = jax.nn.sigmoid(b_logit.astype(jnp.float32))
    g = -jnp.exp(a_log) * jax.nn.softplus(a_logit.astype(jnp.float32) + dt_bias)
    o = _gated_delta_chunked(q, k, v, g, beta)
    o = rms_norm(o, norm_gain) * jax.nn.silu(zg.reshape(bsz, s, GDN_HEADS, GDN_DV).astype(jnp.float32))
    return o.reshape(bsz, s, GROUP_WIDTH).astype(p.dtype)


def peer_ffn(h, w_query, sub_keys, expert_u, expert_v):
    bsz, s, d = h.shape
    tok = h.reshape(bsz * s, d)
    n = tok.shape[0]
    q = (tok @ w_query).reshape(n, PEER_HEADS, 2, PEER_QDIM // 2)
    sc = jnp.einsum("nhpd,hpkd->nhpk", q, sub_keys).astype(jnp.float32)
    s_top, i_top = lax.top_k(sc, PEER_TOPK)
    cand_s = (s_top[:, :, 0, :, None] + s_top[:, :, 1, None, :]).reshape(n, PEER_HEADS, PEER_TOPK * PEER_TOPK)
    cand_i = (i_top[:, :, 0, :, None] * PEER_KEYS + i_top[:, :, 1, None, :]).reshape(n, PEER_HEADS, PEER_TOPK * PEER_TOPK)
    best_s, pos = lax.top_k(cand_s, PEER_TOPK)
    idx = jnp.take_along_axis(cand_i, pos, axis=-1)
    gate = jax.nn.softmax(best_s, axis=-1)
    nb = n // PEER_TOKEN_BLOCK

    def block(args):
        xb, ib, gb = args
        u = jnp.take(expert_u, ib, axis=0)
        act = jax.nn.gelu(jnp.einsum("td,thkd->thk", xb, u))
        v = jnp.take(expert_v, ib, axis=0)
        return jnp.einsum("thk,thkd->td", (act * gb).astype(v.dtype), v)

    out = lax.map(block, (tok.reshape(nb, PEER_TOKEN_BLOCK, d),
                          idx.reshape(nb, PEER_TOKEN_BLOCK, PEER_HEADS, PEER_TOPK),
                          gate.reshape(nb, PEER_TOKEN_BLOCK, PEER_HEADS, PEER_TOPK)))
    return out.reshape(bsz, s, d).astype(h.dtype)


def setup_inputs(seed: int = 0) -> dict:
    key = jax.random.key(seed)
    keys = jax.random.split(key, 64)
    counter = [0]
    f32 = jnp.float32
    L = DEPTH
    G = GROUP_WIDTH

    def nk():
        counter[0] += 1
        return keys[counter[0] - 1]

    def normal(shape, scale):
        return scale * jax.random.normal(nk(), shape, f32)

    def unif(shape, lo, hi):
        return jax.random.uniform(nk(), shape, f32, lo, hi)

    def gain(shape):
        return 1.0 + normal(shape, 0.02)

    x = normal((BATCH, SEQ, D_MODEL), 1.0)
    norm_mix = gain((L, D_MODEL))
    w_in = normal((L, D_MODEL, IN_COLS), D_MODEL ** -0.5)
    w_out = normal((L, MIX_WIDTH, D_MODEL), MIX_WIDTH ** -0.5)
    rw_mu = unif((L, RW_COLS), 0.0, 1.0)
    rw_w0 = unif((L, G), -6.5, -1.5)
    rw_w_up = normal((L, RW_W_RANK, G), 0.1)
    rw_a0 = normal((L, G), 0.1)
    rw_a_up = normal((L, RW_A_RANK, G), 0.5 * RW_A_RANK ** -0.5)
    rw_g_up = normal((L, RW_G_RANK, G), RW_G_RANK ** -0.5)
    rw_k_k = 0.85 + normal((L, G), 0.02)
    rw_k_a = 1.0 + normal((L, G), 0.02)
    rw_r_k = normal((L, RW_HEADS, RW_HEAD), 0.1)
    rw_ln_w = gain((L, G))
    rw_ln_b = normal((L, G), 0.02)
    rw_v0 = 1.0 + normal((L - 1, G), 0.02)
    rw_v_down = normal((L - 1, G, RW_V_RANK), G ** -0.5)
    rw_v_up = normal((L - 1, RW_V_RANK, G), 0.5 * RW_V_RANK ** -0.5)
    gla_a_up = normal((L, GLA_GATE_RANK, GLA_HEADS * GLA_DK), 0.5 * GLA_GATE_RANK ** -0.5)
    gla_a_bias = unif((L, GLA_HEADS * GLA_DK), -1.0, 4.0)
    gla_norm = gain((L, GLA_DV))
    lru_conv_w = normal((L, CONV_WIDTH, LRU_WIDTH), 0.5)
    lru_conv_b = normal((L, LRU_WIDTH), 0.02)
    lru_w_r = normal((L, LRU_BLOCKS, LRU_BLOCK, LRU_BLOCK), LRU_BLOCK ** -0.5)
    lru_b_r = normal((L, LRU_WIDTH), 0.02)
    lru_w_i = normal((L, LRU_BLOCKS, LRU_BLOCK, LRU_BLOCK), LRU_BLOCK ** -0.5)
    lru_b_i = normal((L, LRU_WIDTH), 0.02)
    a_c = unif((L, LRU_WIDTH), 0.9, 0.999)
    sig = a_c ** (1.0 / LRU_C)
    lru_lam = jnp.log(sig) - jnp.log1p(-sig)
    gdn_conv_w = normal((L, CONV_WIDTH, GDN_CONV_CH), 0.5)
    gdn_a_log = jnp.log(unif((L, GDN_HEADS), 1.0, 16.0))
    dt = jnp.exp(unif((L, GDN_HEADS), math.log(1e-3), math.log(1e-1)))
    gdn_dt_bias = dt + jnp.log(-jnp.expm1(-dt))
    gdn_norm = gain((L, GDN_DV))
    norm_ffn = gain((L, D_MODEL))
    peer_wq = normal((L, D_MODEL, PEER_HEADS * PEER_QDIM), D_MODEL ** -0.5)
    peer_sub_keys = normal((L, PEER_HEADS, 2, PEER_KEYS, PEER_QDIM // 2), (PEER_QDIM // 2) ** -0.5)
    peer_u = normal((L, PEER_EXPERTS, D_MODEL), D_MODEL ** -0.5)
    peer_v = normal((L, PEER_EXPERTS, D_MODEL), PEER_HEADS ** -0.5)
    norm_final = gain((D_MODEL,))
    return {
        "x": x, "norm_mix": norm_mix, "w_in": w_in, "w_out": w_out,
        "rw_mu": rw_mu, "rw_w0": rw_w0, "rw_w_up": rw_w_up, "rw_a0": rw_a0, "rw_a_up": rw_a_up,
        "rw_g_up": rw_g_up, "rw_k_k": rw_k_k, "rw_k_a": rw_k_a, "rw_r_k": rw_r_k,
        "rw_ln_w": rw_ln_w, "rw_ln_b": rw_ln_b, "rw_v0": rw_v0, "rw_v_down": rw_v_down, "rw_v_up": rw_v_up,
        "gla_a_up": gla_a_up, "gla_a_bias": gla_a_bias, "gla_norm": gla_norm,
        "lru_conv_w": lru_conv_w, "lru_conv_b": lru_conv_b, "lru_w_r": lru_w_r, "lru_b_r": lru_b_r,
        "lru_w_i": lru_w_i, "lru_b_i": lru_b_i, "lru_lam": lru_lam,
        "gdn_conv_w": gdn_conv_w, "gdn_a_log": gdn_a_log, "gdn_dt_bias": gdn_dt_bias, "gdn_norm": gdn_norm,
        "norm_ffn": norm_ffn, "peer_wq": peer_wq, "peer_sub_keys": peer_sub_keys,
        "peer_u": peer_u, "peer_v": peer_v, "norm_final": norm_final,
    }


def reference(x, norm_mix, w_in, w_out,
              rw_mu, rw_w0, rw_w_up, rw_a0, rw_a_up, rw_g_up, rw_k_k, rw_k_a, rw_r_k,
              rw_ln_w, rw_ln_b, rw_v0, rw_v_down, rw_v_up,
              gla_a_up, gla_a_bias, gla_norm,
              lru_conv_w, lru_conv_b, lru_w_r, lru_b_r, lru_w_i, lru_b_i, lru_lam,
              gdn_conv_w, gdn_a_log, gdn_dt_bias, gdn_norm,
              norm_ffn, peer_wq, peer_sub_keys, peer_u, peer_v, norm_final):
    v_first = None
    for l in range(DEPTH):
        h = rms_norm(x, norm_mix[l])
        p = h @ w_in[l]
        pa, pb, pc, pd = _split(p, (RW_COLS, GLA_COLS, LRU_COLS, GDN_COLS))
        v_res = None if l == 0 else (rw_v0[l - 1], rw_v_down[l - 1], rw_v_up[l - 1])
        oa, v_first = rwkv7_mixer(pa, v_first, rw_mu[l], rw_w0[l], rw_w_up[l], rw_a0[l], rw_a_up[l],
                                  rw_g_up[l], rw_k_k[l], rw_k_a[l], rw_r_k[l], rw_ln_w[l], rw_ln_b[l], v_res)
        ob = gla_mixer(pb, gla_a_up[l], gla_a_bias[l], gla_norm[l])
        oc = rglru_mixer(pc, lru_conv_w[l], lru_conv_b[l], lru_w_r[l], lru_b_r[l],
                         lru_w_i[l], lru_b_i[l], lru_lam[l])
        od = gdn_mixer(pd, gdn_conv_w[l], gdn_a_log[l], gdn_dt_bias[l], gdn_norm[l])
        x = x + jnp.concatenate([oa, ob, oc, od], axis=-1) @ w_out[l]
        x = x + peer_ffn(rms_norm(x, norm_ffn[l]), peer_wq[l], peer_sub_keys[l], peer_u[l], peer_v[l])
    return rms_norm(x, norm_final)
```

```cpp
#ifndef HOST_EMU
#include <hip/hip_runtime.h>
#include <cstring>
#define HD __host__ __device__ __forceinline__
#else
#include <cmath>
#include <cstdio>
#include <cstdlib>
#include <cstring>
#define HD inline
#endif

constexpr int DM = 2048;
constexpr int NL = 2;
constexpr int INC = 6424;
constexpr int C_RW = 0;
constexpr int C_GLA = 1792;
constexpr int C_LRU = 3344;
constexpr int C_GDN = 4368;
constexpr int NEXP = 16384;

struct Params {
    const float *x, *norm_mix, *w_in, *w_out, *rw_mu, *rw_w0, *rw_w_up, *rw_a0, *rw_a_up, *rw_g_up, *rw_k_k, *rw_k_a,
        *rw_r_k, *rw_ln_w, *rw_ln_b, *rw_v0, *rw_v_down, *rw_v_up, *gla_a_up, *gla_a_bias, *gla_norm, *lru_conv_w,
        *lru_conv_b, *lru_w_r, *lru_b_r, *lru_w_i, *lru_b_i, *lru_lam, *gdn_conv_w, *gdn_a_log, *gdn_dt_bias, *gdn_norm,
        *norm_ffn, *peer_wq, *peer_sub_keys, *peer_u, *peer_v, *norm_final;
    float* xcur;
    float* hbuf;
    float* pbuf;
    float* rstd;
    float* vfirst;
    float* scr;
    float* act;
    float* gate;
    int* idx;
    int B, T, N, pad;
};

HD float sigmoidf_(float x) { return 1.0f / (1.0f + expf(-x)); }
HD float softplusf_(float x) { return log1pf(expf(-fabsf(x))) + fmaxf(x, 0.0f); }
HD float siluf_(float x) { return x * sigmoidf_(x); }
HD float geluf_(float x) { return 0.5f * x * (1.0f + tanhf(0.7978845608028654f * (x + 0.044715f * x * x * x))); }

enum Stage {
    ST_COPYX = 0,
    ST_RSTD, ST_NORM1, ST_GEMM1,
    ST_RW_A0, ST_RW_A1, ST_RW_A2, ST_RW_A3, ST_RW_KKN, ST_RW_SCAN, ST_RW_POST,
    ST_GLA_B0, ST_GLA_SCAN, ST_GLA_POST,
    ST_LRU_C0, ST_LRU_C1, ST_LRU_SCAN,
    ST_GDN_D0, ST_GDN_D1, ST_GDN_SCAN, ST_GDN_POST,
    ST_GEMM2, ST_RSTD2, ST_NORM2, ST_GEMM3, ST_SCORES, ST_TOPK1, ST_TOPK2, ST_PEER_U, ST_PEER_V,
    ST_FRSTD, ST_FNORM,
    ST_COUNT
};

constexpr long SO_ZS = 0, SO_R = 256, SO_DEC = 768, SO_KM = 1280, SO_KK = 1792, SO_A = 2304, SO_G = 2816, SO_V = 3328,
               SO_Y = 3840, SO_VD = 4352, SO_KKINV = 4384;
constexpr long SO_ALPHA = 0, SO_GO = 256;
constexpr long SO_XC = 0, SO_LA = 512, SO_LU = 1024;
constexpr long SO_QKV = 0, SO_GS = 1536, SO_DO = 1552;
constexpr long SCR_PER_TOK = 4400;
constexpr long SO_TS = 0, SO_TI = 256;

HD long stage_items(const Params& P, int st, int l) {
    const long N = P.N;
    switch (st) {
        case ST_COPYX: return N * DM;
        case ST_RSTD: case ST_RSTD2: case ST_FRSTD: return N;
        case ST_NORM1: case ST_NORM2: case ST_FNORM: return N * DM;
        case ST_GEMM1: return (N / 4) * (INC / 4);
        case ST_RW_A0: return N * 256;
        case ST_RW_A1: return N * 512;
        case ST_RW_A2: return l > 0 ? N * 32 : 0;
        case ST_RW_A3: return l > 0 ? N * 512 : 0;
        case ST_RW_KKN: return N * 8;
        case ST_RW_SCAN: return (long)P.B * 512;
        case ST_RW_POST: return N * 8;
        case ST_GLA_B0: return N * 256;
        case ST_GLA_SCAN: return (long)P.B * 512;
        case ST_GLA_POST: return N * 4;
        case ST_LRU_C0: return N * 512;
        case ST_LRU_C1: return N * 512;
        case ST_LRU_SCAN: return (long)P.B * 512;
        case ST_GDN_D0: return N * 1536;
        case ST_GDN_D1: return N * 4;
        case ST_GDN_SCAN: return (long)P.B * 512;
        case ST_GDN_POST: return N * 4;
        case ST_GEMM2: case ST_GEMM3: return (N / 4) * (DM / 4);
        case ST_SCORES: return N * 2048;
        case ST_TOPK1: return N * 16;
        case ST_TOPK2: return N * 8;
        case ST_PEER_U: return N * 128;
        case ST_PEER_V: return N * DM;
    }
    return 0;
}

HD void gemm_item(const float* A, int lda, const float* W, int ldw, float* C, int ldc, int K, int n4, long item, bool accum) {
    const long r4 = item / n4;
    const int c4 = (int)(item % n4);
    const float* a0 = A + (r4 * 4) * (long)lda;
    const float* w = W + c4 * 4;
    float acc[4][4];
    for (int i = 0; i < 4; ++i)
        for (int j = 0; j < 4; ++j) acc[i][j] = 0.f;
    for (int k = 0; k < K; ++k) {
        const float w0 = w[(long)k * ldw + 0], w1 = w[(long)k * ldw + 1], w2 = w[(long)k * ldw + 2], w3 = w[(long)k * ldw + 3];
#pragma unroll
        for (int i = 0; i < 4; ++i) {
            const float a = a0[(long)i * lda + k];
            acc[i][0] += a * w0; acc[i][1] += a * w1; acc[i][2] += a * w2; acc[i][3] += a * w3;
        }
    }
#pragma unroll
    for (int i = 0; i < 4; ++i) {
        float* c = C + (r4 * 4 + i) * (long)ldc + c4 * 4;
#pragma unroll
        for (int j = 0; j < 4; ++j) c[j] = accum ? c[j] + acc[i][j] : acc[i][j];
    }
}

HD float rw_shift(const Params& P, int l, long n, int col) {
    const int t = (int)(n % P.T);
    const float cur = P.pbuf[n * INC + C_RW + col];
    const float prev = t > 0 ? P.pbuf[(n - 1) * INC + C_RW + col] : 0.f;
    return cur + (prev - cur) * P.rw_mu[l * 1792 + col];
}

HD void run_item(const Params& P, int st, int l, long it) {
    const long N = P.N;
    float* scr = P.scr;
    switch (st) {
        case ST_COPYX: P.xcur[it] = P.x[it]; break;
        case ST_RSTD: case ST_RSTD2: case ST_FRSTD: {
            const float* xr = P.xcur + it * DM;
            float s = 0.f;
            for (int d = 0; d < DM; ++d) s += xr[d] * xr[d];
            P.rstd[it] = 1.0f / sqrtf(s * (1.0f / DM) + 1e-6f);
        } break;
        case ST_NORM1: case ST_NORM2: case ST_FNORM: {
            const long n = it / DM; const int d = (int)(it % DM);
            const float* g = st == ST_NORM1 ? P.norm_mix + l * DM : (st == ST_NORM2 ? P.norm_ffn + l * DM : P.norm_final);
            float* dst = st == ST_FNORM ? P.xcur : P.hbuf;
            dst[it] = P.xcur[it] * P.rstd[n] * g[d];
        } break;
        case ST_GEMM1: gemm_item(P.hbuf, DM, P.w_in + (long)l * DM * INC, INC, P.pbuf, INC, DM, INC / 4, it, false); break;
        case ST_GEMM2: gemm_item(P.hbuf, DM, P.w_out + (long)l * DM * DM, DM, P.xcur, DM, DM, DM / 4, it, true); break;
        case ST_GEMM3: gemm_item(P.hbuf, DM, P.peer_wq + (long)l * DM * DM, DM, P.pbuf, DM, DM, DM / 4, it, false); break;
        case ST_RW_A0: {
            const long n = it / 256; const int c = (int)(it % 256);
            const float z = rw_shift(P, l, n, 1536 + c);
            scr[N * SO_ZS + it] = c < 64 ? tanhf(z) : (c < 128 ? z : sigmoidf_(z));
        } break;
        case ST_RW_A1: {
            const long n = it / 512; const int j = (int)(it % 512);
            const float zr = rw_shift(P, l, n, j), zk = rw_shift(P, l, n, 512 + j), zv = rw_shift(P, l, n, 1024 + j);
            const float* zs = scr + N * SO_ZS + n * 256;
            float aw = P.rw_w0[l * 512 + j], aa = P.rw_a0[l * 512 + j], ag = 0.f;
            const float* wu = P.rw_w_up + (long)l * 64 * 512 + j;
            const float* au = P.rw_a_up + (long)l * 64 * 512 + j;
            const float* gu = P.rw_g_up + (long)l * 128 * 512 + j;
            for (int i = 0; i < 64; ++i) { aw += zs[i] * wu[i * 512]; aa += zs[64 + i] * au[i * 512]; }
            for (int i = 0; i < 128; ++i) ag += zs[128 + i] * gu[i * 512];
            const float w_raw = -softplusf_(-aw) - 0.5f;
            const float a = sigmoidf_(aa);
            scr[N * SO_R + it] = zr;
            scr[N * SO_DEC + it] = expf(-expf(w_raw));
            scr[N * SO_KM + it] = zk * (1.0f + (a - 1.0f) * P.rw_k_a[l * 512 + j]);
            scr[N * SO_KK + it] = zk * P.rw_k_k[l * 512 + j];
            scr[N * SO_A + it] = a;
            scr[N * SO_G + it] = ag;
            scr[N * SO_V + it] = zv;
            if (l == 0) P.vfirst[it] = zv;
        } break;
        case ST_RW_A2: {
            const long n = it / 32; const int i = (int)(it % 32);
            const float* v = scr + N * SO_V + n * 512;
            const float* vdn = P.rw_v_down + (long)(l - 1) * 512 * 32 + i;
            float s = 0.f;
            for (int j = 0; j < 512; ++j) s += v[j] * vdn[j * 32];
            scr[N * SO_VD + it] = s;
        } break;
        case ST_RW_A3: {
            const long n = it / 512; const int j = (int)(it % 512);
            const float* vd = scr + N * SO_VD + n * 32;
            const float* vup = P.rw_v_up + (long)(l - 1) * 32 * 512 + j;
            float s = P.rw_v0[(l - 1) * 512 + j];
            for (int i = 0; i < 32; ++i) s += vd[i] * vup[i * 512];
            const float v = scr[N * SO_V + it];
            scr[N * SO_V + it] = v + (P.vfirst[it] - v) * sigmoidf_(s);
        } break;
        case ST_RW_KKN: {
            const float* kk = scr + N * SO_KK + it * 64;
            float s = 0.f;
            for (int i = 0; i < 64; ++i) s += kk[i] * kk[i];
            scr[N * SO_KKINV + it] = 1.0f / sqrtf(fmaxf(s, 1e-24f));
        } break;
        case ST_RW_SCAN: {
            const int b = (int)(it / 512); const int h = (int)((it % 512) / 64); const int v = (int)(it % 64);
            float S[64];
#pragma unroll
            for (int i = 0; i < 64; ++i) S[i] = 0.f;
            for (int t = 0; t < P.T; ++t) {
                const long n = (long)b * P.T + t;
                const long base = n * 512 + h * 64;
                const float inv = scr[N * SO_KKINV + n * 8 + h];
                const float vv = scr[N * SO_V + base + v];
                const float* KK = scr + N * SO_KK + base;
                const float* DEC = scr + N * SO_DEC + base;
                const float* KM = scr + N * SO_KM + base;
                const float* AA = scr + N * SO_A + base;
                const float* RR = scr + N * SO_R + base;
                float sa = 0.f;
#pragma unroll
                for (int i = 0; i < 64; ++i) sa += S[i] * (-KK[i] * inv);
                float y = 0.f;
#pragma unroll
                for (int i = 0; i < 64; ++i) {
                    const float kk = KK[i] * inv;
                    S[i] = S[i] * DEC[i] + sa * (kk * AA[i]) + vv * KM[i];
                    y += S[i] * RR[i];
                }
                scr[N * SO_Y + base + v] = y;
            }
        } break;
        case ST_RW_POST: {
            const long n = it / 8; const int h = (int)(it % 8);
            const long base = n * 512 + h * 64;
            const float* Y = scr + N * SO_Y + base;
            const float* RR = scr + N * SO_R + base;
            const float* KM = scr + N * SO_KM + base;
            const float* V = scr + N * SO_V + base;
            const float* G = scr + N * SO_G + base;
            float mean = 0.f, bon = 0.f;
            for (int i = 0; i < 64; ++i) { mean += Y[i]; bon += RR[i] * KM[i] * P.rw_r_k[l * 512 + h * 64 + i]; }
            mean *= (1.0f / 64);
            float var = 0.f;
            for (int i = 0; i < 64; ++i) { const float d = Y[i] - mean; var += d * d; }
            const float rs = 1.0f / sqrtf(var * (1.0f / 64) + 64e-5f);
            for (int i = 0; i < 64; ++i) {
                const int c = h * 64 + i;
                const float yn = (Y[i] - mean) * rs * P.rw_ln_w[l * 512 + c] + P.rw_ln_b[l * 512 + c];
                P.hbuf[n * DM + c] = (yn + bon * V[i]) * G[i];
            }
        } break;
        case ST_GLA_B0: {
            const long n = it / 256; const int c = (int)(it % 256);
            const float* ad = P.pbuf + n * INC + C_GLA + 1536;
            float s = P.gla_a_bias[l * 256 + c];
            for (int i = 0; i < 16; ++i) s += ad[i] * P.gla_a_up[(long)l * 16 * 256 + i * 256 + c];
            scr[N * SO_ALPHA + it] = expf(-softplusf_(-s) * (1.0f / 16.0f));
        } break;
        case ST_GLA_SCAN: {
            const int b = (int)(it / 512); const int h = (int)((it % 512) / 128); const int v = (int)(it % 128);
            float S[64];
#pragma unroll
            for (int i = 0; i < 64; ++i) S[i] = 0.f;
            for (int t = 0; t < P.T; ++t) {
                const long n = (long)b * P.T + t;
                const float* q = P.pbuf + n * INC + C_GLA + h * 64;
                const float* k = q + 256;
                const float vv = P.pbuf[n * INC + C_GLA + 512 + h * 128 + v];
                const float* al = scr + N * SO_ALPHA + n * 256 + h * 64;
                float o = 0.f;
#pragma unroll
                for (int i = 0; i < 64; ++i) {
                    S[i] = S[i] * al[i] + k[i] * vv;
                    o += q[i] * S[i];
                }
                scr[N * SO_GO + n * 512 + h * 128 + v] = o * 0.125f;
            }
        } break;
        case ST_GLA_POST: {
            const long n = it / 4; const int h = (int)(it % 4);
            const float* o = scr + N * SO_GO + n * 512 + h * 128;
            float ms = 0.f;
            for (int i = 0; i < 128; ++i) ms += o[i] * o[i];
            const float rs = 1.0f / sqrtf(ms * (1.0f / 128) + 1e-6f);
            for (int i = 0; i < 128; ++i) {
                const float g = P.pbuf[n * INC + C_GLA + 1024 + h * 128 + i];
                P.hbuf[n * DM + 512 + h * 128 + i] = o[i] * rs * P.gla_norm[l * 128 + i] * siluf_(g);
            }
        } break;
        case ST_LRU_C0: {
            const long n = it / 512; const int c = (int)(it % 512);
            const int t = (int)(n % P.T);
            float s = P.lru_conv_b[l * 512 + c];
            for (int j = 0; j < 4; ++j) {
                const int tt = t - 3 + j;
                if (tt >= 0) s += P.lru_conv_w[(long)l * 4 * 512 + j * 512 + c] * P.pbuf[(n - 3 + j) * INC + C_LRU + c];
            }
            scr[N * SO_XC + it] = s;
        } break;
        case ST_LRU_C1: {
            const long n = it / 512; const int c = (int)(it % 512);
            const int blk = c / 64, j = c % 64;
            const float* xc = scr + N * SO_XC + n * 512 + blk * 64;
            const float* wr = P.lru_w_r + (long)l * 8 * 64 * 64 + (long)blk * 64 * 64 + j;
            const float* wi = P.lru_w_i + (long)l * 8 * 64 * 64 + (long)blk * 64 * 64 + j;
            float sr = P.lru_b_r[l * 512 + c], si = P.lru_b_i[l * 512 + c];
            for (int i = 0; i < 64; ++i) { sr += xc[i] * wr[i * 64]; si += xc[i] * wi[i * 64]; }
            const float r = sigmoidf_(sr), ig = sigmoidf_(si);
            const float log_a = -8.0f * r * softplusf_(-P.lru_lam[l * 512 + c]);
            scr[N * SO_LA + it] = expf(log_a);
            scr[N * SO_LU + it] = scr[N * SO_XC + it] * ig * sqrtf(-expm1f(2.0f * log_a));
        } break;
        case ST_LRU_SCAN: {
            const int b = (int)(it / 512); const int c = (int)(it % 512);
            float hst = 0.f;
            for (int t = 0; t < P.T; ++t) {
                const long n = (long)b * P.T + t;
                hst = scr[N * SO_LA + n * 512 + c] * hst + scr[N * SO_LU + n * 512 + c];
                P.hbuf[n * DM + 1024 + c] = hst * geluf_(P.pbuf[n * INC + C_LRU + 512 + c]);
            }
        } break;
        case ST_GDN_D0: {
            const long n = it / 1536; const int c = (int)(it % 1536);
            const int t = (int)(n % P.T);
            float s = 0.f;
            for (int j = 0; j < 4; ++j) {
                const int tt = t - 3 + j;
                if (tt >= 0) s += P.gdn_conv_w[(long)l * 4 * 1536 + j * 1536 + c] * P.pbuf[(n - 3 + j) * INC + C_GDN + c];
            }
            scr[N * SO_QKV + it] = siluf_(s);
        } break;
        case ST_GDN_D1: {
            const long n = it / 4; const int h = (int)(it % 4);
            const float* q = scr + N * SO_QKV + n * 1536 + h * 128;
            const float* k = q + 512;
            float qs = 0.f, ks = 0.f;
            for (int i = 0; i < 128; ++i) { qs += q[i] * q[i]; ks += k[i] * k[i]; }
            float* gs = scr + N * SO_GS + n * 16 + h * 4;
            gs[0] = (1.0f / sqrtf(qs + 1e-6f)) * 0.08838834764831845f;
            gs[1] = 1.0f / sqrtf(ks + 1e-6f);
            gs[2] = sigmoidf_(P.pbuf[n * INC + C_GDN + 2048 + h]);
            gs[3] = expf(-expf(P.gdn_a_log[l * 4 + h]) * softplusf_(P.pbuf[n * INC + C_GDN + 2052 + h] + P.gdn_dt_bias[l * 4 + h]));
        } break;
        case ST_GDN_SCAN: {
            const int b = (int)(it / 512); const int h = (int)((it % 512) / 128); const int v = (int)(it % 128);
            float S[128];
#pragma unroll
            for (int i = 0; i < 128; ++i) S[i] = 0.f;
            for (int t = 0; t < P.T; ++t) {
                const long n = (long)b * P.T + t;
                const float* q = scr + N * SO_QKV + n * 1536 + h * 128;
                const float* k = q + 512;
                const float vv = scr[N * SO_QKV + n * 1536 + 1024 + h * 128 + v];
                const float* gs = scr + N * SO_GS + n * 16 + h * 4;
                const float qinv = gs[0], kinv = gs[1], beta = gs[2], eg = gs[3];
                float dk = 0.f;
#pragma unroll
                for (int i = 0; i < 128; ++i) dk += S[i] * k[i];
                const float u = beta * (vv - eg * kinv * dk) * kinv;
                float o = 0.f;
#pragma unroll
                for (int i = 0; i < 128; ++i) {
                    S[i] = S[i] * eg + u * k[i];
                    o += S[i] * q[i];
                }
                scr[N * SO_DO + n * 512 + h * 128 + v] = o * qinv;
            }
        } break;
        case ST_GDN_POST: {
            const long n = it / 4; const int h = (int)(it % 4);
            const float* o = scr + N * SO_DO + n * 512 + h * 128;
            float ms = 0.f;
            for (int i = 0; i < 128; ++i) ms += o[i] * o[i];
            const float rs = 1.0f / sqrtf(ms * (1.0f / 128) + 1e-6f);
            for (int i = 0; i < 128; ++i) {
                const float z = P.pbuf[n * INC + C_GDN + 1536 + h * 128 + i];
                P.hbuf[n * DM + 1536 + h * 128 + i] = o[i] * rs * P.gdn_norm[l * 128 + i] * siluf_(z);
            }
        } break;
        case ST_SCORES: {
            const long n = it / 2048; const int c = (int)(it % 2048);
            const int hp = c / 128, key = c % 128;
            const float* q = P.pbuf + n * DM + hp * 128;
            const float* sk = P.peer_sub_keys + (long)l * 16 * 128 * 128 + ((long)hp * 128 + key) * 128;
            float s = 0.f;
            for (int d = 0; d < 128; ++d) s += q[d] * sk[d];
            P.pbuf[N * DM + it] = s;
        } break;
        case ST_TOPK1: {
            const float* sc = P.pbuf + N * DM + it * 128;
            float ts[16]; int ti[16];
#pragma unroll
            for (int j = 0; j < 16; ++j) { ts[j] = -3.0e38f; ti[j] = 0; }
            for (int i = 0; i < 128; ++i) {
                float xv = sc[i]; int xi = i;
                if (xv > ts[15]) {
#pragma unroll
                    for (int j = 0; j < 16; ++j) {
                        if (xv > ts[j]) { const float tv = ts[j]; const int tj = ti[j]; ts[j] = xv; ti[j] = xi; xv = tv; xi = tj; }
                    }
                }
            }
            float* TS = scr + N * SO_TS + it * 16;
            int* TI = (int*)(scr + N * SO_TI) + it * 16;
#pragma unroll
            for (int j = 0; j < 16; ++j) { TS[j] = ts[j]; TI[j] = ti[j]; }
        } break;
        case ST_TOPK2: {
            const float* s0 = scr + N * SO_TS + it * 32;
            const float* s1 = s0 + 16;
            const int* i0 = (const int*)(scr + N * SO_TI) + it * 32;
            const int* i1 = i0 + 16;
            float ts[16]; int ti[16];
#pragma unroll
            for (int j = 0; j < 16; ++j) { ts[j] = -3.0e38f; ti[j] = 0; }
            for (int a = 0; a < 16; ++a) {
                const int jmax = 16 / (a + 1);
                for (int b = 0; b < jmax; ++b) {
                    float xv = s0[a] + s1[b]; int xi = i0[a] * 128 + i1[b];
                    if (xv > ts[15]) {
#pragma unroll
                        for (int j = 0; j < 16; ++j) {
                            if (xv > ts[j]) { const float tv = ts[j]; const int tj = ti[j]; ts[j] = xv; ti[j] = xi; xv = tv; xi = tj; }
                        }
                    }
                }
            }
            const float mx = ts[0];
            float den = 0.f;
#pragma unroll
            for (int j = 0; j < 16; ++j) { ts[j] = expf(ts[j] - mx); den += ts[j]; }
            const float inv = 1.0f / den;
#pragma unroll
            for (int j = 0; j < 16; ++j) { P.gate[it * 16 + j] = ts[j] * inv; P.idx[it * 16 + j] = ti[j]; }
        } break;
        case ST_PEER_U: {
            const long n = it / 128;
            const int e = P.idx[it];
            const float* u = P.peer_u + ((long)l * NEXP + e) * DM;
            const float* hx = P.hbuf + n * DM;
            float s = 0.f;
            for (int d = 0; d < DM; ++d) s += hx[d] * u[d];
            P.act[it] = geluf_(s) * P.gate[it];
        } break;
        case ST_PEER_V: {
            const long n = it / DM; const int d = (int)(it % DM);
            const float* a = P.act + n * 128;
            const int* ix = P.idx + n * 128;
            float s = 0.f;
            for (int j = 0; j < 128; ++j) s += a[j] * P.peer_v[((long)l * NEXP + ix[j]) * DM + d];
            P.xcur[it] += s;
        } break;
    }
}

struct Step { int st, l; };
static inline int build_schedule(Step* s) {
    int n = 0;
    s[n++] = {ST_COPYX, 0};
    for (int l = 0; l < NL; ++l) {
        static const int per_layer[] = {ST_RSTD, ST_NORM1, ST_GEMM1,
            ST_RW_A0, ST_RW_A1, ST_RW_A2, ST_RW_A3, ST_RW_KKN, ST_RW_SCAN, ST_RW_POST,
            ST_GLA_B0, ST_GLA_SCAN, ST_GLA_POST, ST_LRU_C0, ST_LRU_C1, ST_LRU_SCAN,
            ST_GDN_D0, ST_GDN_D1, ST_GDN_SCAN, ST_GDN_POST,
            ST_GEMM2, ST_RSTD2, ST_NORM2, ST_GEMM3, ST_SCORES, ST_TOPK1, ST_TOPK2, ST_PEER_U, ST_PEER_V};
        for (int i = 0; i < (int)(sizeof(per_layer) / sizeof(int)); ++i) s[n++] = {per_layer[i], l};
    }
    s[n++] = {ST_FRSTD, 0};
    s[n++] = {ST_FNORM, 0};
    return n;
}

static inline size_t carve(Params& P, char* ws) {
    size_t off = 0;
    auto take = [&](size_t bytes) { char* p = ws ? ws + off : nullptr; off += (bytes + 255) & ~(size_t)255; return p; };
    const size_t N = (size_t)P.N;
    P.hbuf = (float*)take(N * DM * 4);
    P.pbuf = (float*)take(N * INC * 4);
    P.rstd = (float*)take(N * 4);
    P.vfirst = (float*)take(N * 512 * 4);
    P.scr = (float*)take(N * SCR_PER_TOK * 4);
    P.act = (float*)take(N * 128 * 4);
    P.gate = (float*)take(N * 128 * 4);
    P.idx = (int*)take(N * 128 * 4);
    return off;
}

static inline void fill_inputs(Params& P, void* const* d_in) {
    const float** dst = (const float**)&P;
    for (int i = 0; i < 38; ++i) dst[i] = (const float*)d_in[i];
}

#ifndef HOST_EMU
template <int ST>
__global__ void __launch_bounds__(256) stage_kernel(Params P, int l) {
    const long n = stage_items(P, ST, l);
    for (long it = blockIdx.x * 256L + threadIdx.x; it < n; it += gridDim.x * 256L) run_item(P, ST, l, it);
}

template <int ST>
static void launch_stage(const Params& P, int l, hipStream_t stream) {
    const long n = stage_items(P, ST, l);
    if (n <= 0) return;
    long blocks = (n + 255) / 256;
    if (blocks > 8192) blocks = 8192;
    stage_kernel<ST><<<dim3((unsigned)blocks), dim3(256), 0, stream>>>(P, l);
}

#define LS(X) case X: launch_stage<X>(P, l, stream); break;
static void launch_any(int st, const Params& P, int l, hipStream_t stream) {
    switch (st) {
        LS(ST_COPYX) LS(ST_RSTD) LS(ST_NORM1) LS(ST_GEMM1) LS(ST_RW_A0) LS(ST_RW_A1) LS(ST_RW_A2) LS(ST_RW_A3) LS(ST_RW_KKN)
        LS(ST_RW_SCAN) LS(ST_RW_POST) LS(ST_GLA_B0) LS(ST_GLA_SCAN) LS(ST_GLA_POST) LS(ST_LRU_C0) LS(ST_LRU_C1) LS(ST_LRU_SCAN)
        LS(ST_GDN_D0) LS(ST_GDN_D1) LS(ST_GDN_SCAN) LS(ST_GDN_POST) LS(ST_GEMM2) LS(ST_RSTD2) LS(ST_NORM2) LS(ST_GEMM3)
        LS(ST_SCORES) LS(ST_TOPK1) LS(ST_TOPK2) LS(ST_PEER_U) LS(ST_PEER_V) LS(ST_FRSTD) LS(ST_FNORM)
    }
}

extern "C" void kernel_launch(void* const* d_in, const int* in_sizes, int n_in, void* d_out, int out_size, void* d_ws,
                              size_t ws_size, hipStream_t stream) {
    Params P;
    memset(&P, 0, sizeof(P));
    fill_inputs(P, d_in);
    P.B = 4; P.T = 4096; P.N = 16384; P.pad = 0;
    P.xcur = (float*)d_out;
    carve(P, (char*)d_ws);
    Step sched[80];
    const int ns = build_schedule(sched);
    for (int i = 0; i < ns; ++i) launch_any(sched[i].st, P, sched[i].l, stream);
}
#endif
```

```cpp
#ifndef HOST_EMU
#include <hip/hip_runtime.h>
#include <cstring>
#define HD __host__ __device__ __forceinline__
#else
#include <cmath>
#include <cstdio>
#include <cstdlib>
#include <cstring>
#define HD inline
#endif

constexpr int DM = 2048;
constexpr int NL = 2;
constexpr int INC = 6424;
constexpr int C_RW = 0;
constexpr int C_GLA = 1792;
constexpr int C_LRU = 3344;
constexpr int C_GDN = 4368;
constexpr int NEXP = 16384;

typedef unsigned short bf16_t;
constexpr int PLD = 6656;
HD float bf2f(bf16_t h) { unsigned u = (unsigned)h << 16; float f; memcpy(&f, &u, 4); return f; }
HD bf16_t f2bf(float f) { unsigned u; memcpy(&u, &f, 4); return (bf16_t)((u + 0x7fffu + ((u >> 16) & 1u)) >> 16); }

struct Params {
    const float *x, *norm_mix, *w_in, *w_out, *rw_mu, *rw_w0, *rw_w_up, *rw_a0, *rw_a_up, *rw_g_up, *rw_k_k, *rw_k_a,
        *rw_r_k, *rw_ln_w, *rw_ln_b, *rw_v0, *rw_v_down, *rw_v_up, *gla_a_up, *gla_a_bias, *gla_norm, *lru_conv_w,
        *lru_conv_b, *lru_w_r, *lru_b_r, *lru_w_i, *lru_b_i, *lru_lam, *gdn_conv_w, *gdn_a_log, *gdn_dt_bias, *gdn_norm,
        *norm_ffn, *peer_wq, *peer_sub_keys, *peer_u, *peer_v, *norm_final;
    float* xcur;
    bf16_t* xn;
    bf16_t* hb;
    bf16_t* mix16;
    bf16_t* p16;
    float* sc;
    float* qf;
    float* rstd;
    float* vfirst;
    float* scr;
    float* act;
    float* gate;
    int* idx;
    int B, T, N, pad;
};

HD float sigmoidf_(float x) { return 1.0f / (1.0f + expf(-x)); }
HD float softplusf_(float x) { return log1pf(expf(-fabsf(x))) + fmaxf(x, 0.0f); }
HD float siluf_(float x) { return x * sigmoidf_(x); }
HD float geluf_(float x) { return 0.5f * x * (1.0f + tanhf(0.7978845608028654f * (x + 0.044715f * x * x * x))); }

enum Stage {
    ST_COPYX = 0,
    ST_RSTD, ST_NORM1, ST_GEMM1,
    ST_RW_A0, ST_RW_A1, ST_RW_A2, ST_RW_A3, ST_RW_KKN, ST_RW_SCAN, ST_RW_POST,
    ST_GLA_B0, ST_GLA_SCAN, ST_GLA_POST,
    ST_LRU_C0, ST_LRU_C1, ST_LRU_SCAN,
    ST_GDN_D0, ST_GDN_D1, ST_GDN_SCAN, ST_GDN_POST,
    ST_GEMM2, ST_RSTD2, ST_NORM2, ST_GEMM3, ST_SCORES, ST_TOPK1, ST_TOPK2, ST_PEER_U, ST_PEER_V,
    ST_FRSTD, ST_FNORM,
    ST_COUNT
};

constexpr long SO_ZS = 0, SO_R = 256, SO_DEC = 768, SO_KM = 1280, SO_KK = 1792, SO_A = 2304, SO_G = 2816, SO_V = 3328,
               SO_Y = 3840, SO_VD = 4352, SO_KKINV = 4384;
constexpr long SO_ALPHA = 0, SO_GO = 256;
constexpr long SO_XC = 0, SO_LA = 512, SO_LU = 1024;
constexpr long SO_QKV = 0, SO_GS = 1536, SO_DO = 1552;
constexpr long SCR_PER_TOK = 4400;
constexpr long SO_TS = 0, SO_TI = 256;

HD long stage_items(const Params& P, int st, int l) {
    const long N = P.N;
    switch (st) {
        case ST_COPYX: return N * DM;
        case ST_RSTD: case ST_RSTD2: case ST_FRSTD: return N;
        case ST_NORM1: case ST_NORM2: case ST_FNORM: return N * DM;
        case ST_GEMM1: return (N / 4) * (INC / 4);
        case ST_RW_A0: return N * 256;
        case ST_RW_A1: return N * 512;
        case ST_RW_A2: return l > 0 ? N * 32 : 0;
        case ST_RW_A3: return l > 0 ? N * 512 : 0;
        case ST_RW_KKN: return N * 8;
        case ST_RW_SCAN: return (long)P.B * 512;
        case ST_RW_POST: return N * 8;
        case ST_GLA_B0: return N * 256;
        case ST_GLA_SCAN: return (long)P.B * 512;
        case ST_GLA_POST: return N * 4;
        case ST_LRU_C0: return N * 512;
        case ST_LRU_C1: return N * 512;
        case ST_LRU_SCAN: return (long)P.B * 512;
        case ST_GDN_D0: return N * 1536;
        case ST_GDN_D1: return N * 4;
        case ST_GDN_SCAN: return (long)P.B * 512;
        case ST_GDN_POST: return N * 4;
        case ST_GEMM2: case ST_GEMM3: return (N / 4) * (DM / 4);
        case ST_SCORES: return N * 2048;
        case ST_TOPK1: return N * 16;
        case ST_TOPK2: return N * 8;
        case ST_PEER_U: return N * 128;
        case ST_PEER_V: return N * DM;
    }
    return 0;
}

HD void gemm_item(const bf16_t* A, const float* W, int ldw, const float* kscale, float* Cf, bf16_t* Ch, int ldc, int n4, long item, int mode) {
    const long r4 = item / n4;
    const int c4 = (int)(item % n4);
    const bf16_t* a0 = A + (r4 * 4) * (long)DM;
    const float* w = W + c4 * 4;
    float acc[4][4];
    for (int i = 0; i < 4; ++i)
        for (int j = 0; j < 4; ++j) acc[i][j] = 0.f;
    for (int k = 0; k < DM; ++k) {
        const float ks = kscale ? kscale[k] : 1.0f;
        const float w0 = w[(long)k * ldw + 0] * ks, w1 = w[(long)k * ldw + 1] * ks, w2 = w[(long)k * ldw + 2] * ks, w3 = w[(long)k * ldw + 3] * ks;
#pragma unroll
        for (int i = 0; i < 4; ++i) {
            const float a = bf2f(a0[(long)i * DM + k]);
            acc[i][0] += a * w0; acc[i][1] += a * w1; acc[i][2] += a * w2; acc[i][3] += a * w3;
        }
    }
#pragma unroll
    for (int i = 0; i < 4; ++i) {
        const long o = (r4 * 4 + i) * (long)ldc + c4 * 4;
#pragma unroll
        for (int j = 0; j < 4; ++j) {
            if (mode == 0) Ch[o + j] = f2bf(acc[i][j]);
            else if (mode == 1) Cf[o + j] += acc[i][j];
            else Cf[o + j] = acc[i][j];
        }
    }
}

#define PF(n, col) bf2f(P.p16[(long)(n) * PLD + (col)])
HD float rw_shift(const Params& P, int l, long n, int col) {
    const int t = (int)(n % P.T);
    const float cur = PF(n, C_RW + col);
    const float prev = t > 0 ? PF(n - 1, C_RW + col) : 0.f;
    return cur + (prev - cur) * P.rw_mu[l * 1792 + col];
}

HD void run_item(const Params& P, int st, int l, long it) {
    const long N = P.N;
    float* scr = P.scr;
    switch (st) {
        case ST_COPYX: P.xcur[it] = P.x[it]; break;
        case ST_RSTD: case ST_RSTD2: case ST_FRSTD: {
            const float* xr = P.xcur + it * DM;
            float s = 0.f;
            for (int d = 0; d < DM; ++d) s += xr[d] * xr[d];
            P.rstd[it] = 1.0f / sqrtf(s * (1.0f / DM) + 1e-6f);
        } break;
        case ST_NORM1: case ST_NORM2: case ST_FNORM: {
            const long n = it / DM; const int d = (int)(it % DM);
            if (st == ST_NORM1) P.xn[it] = f2bf(P.xcur[it] * P.rstd[n]);
            else if (st == ST_NORM2) P.hb[it] = f2bf(P.xcur[it] * P.rstd[n] * P.norm_ffn[l * DM + d]);
            else P.xcur[it] = P.xcur[it] * P.rstd[n] * P.norm_final[d];
        } break;
        case ST_GEMM1: gemm_item(P.xn, P.w_in + (long)l * DM * INC, INC, P.norm_mix + l * DM, nullptr, P.p16, PLD, INC / 4, it, 0); break;
        case ST_GEMM2: gemm_item(P.mix16, P.w_out + (long)l * DM * DM, DM, nullptr, P.xcur, nullptr, DM, DM / 4, it, 1); break;
        case ST_GEMM3: gemm_item(P.hb, P.peer_wq + (long)l * DM * DM, DM, nullptr, P.qf, nullptr, DM, DM / 4, it, 2); break;
        case ST_RW_A0: {
            const long n = it / 256; const int c = (int)(it % 256);
            const float z = rw_shift(P, l, n, 1536 + c);
            scr[N * SO_ZS + it] = c < 64 ? tanhf(z) : (c < 128 ? z : sigmoidf_(z));
        } break;
        case ST_RW_A1: {
            const long n = it / 512; const int j = (int)(it % 512);
            const float zr = rw_shift(P, l, n, j), zk = rw_shift(P, l, n, 512 + j), zv = rw_shift(P, l, n, 1024 + j);
            const float* zs = scr + N * SO_ZS + n * 256;
            float aw = P.rw_w0[l * 512 + j], aa = P.rw_a0[l * 512 + j], ag = 0.f;
            const float* wu = P.rw_w_up + (long)l * 64 * 512 + j;
            const float* au = P.rw_a_up + (long)l * 64 * 512 + j;
            const float* gu = P.rw_g_up + (long)l * 128 * 512 + j;
            for (int i = 0; i < 64; ++i) { aw += zs[i] * wu[i * 512]; aa += zs[64 + i] * au[i * 512]; }
            for (int i = 0; i < 128; ++i) ag += zs[128 + i] * gu[i * 512];
            const float w_raw = -softplusf_(-aw) - 0.5f;
            const float a = sigmoidf_(aa);
            scr[N * SO_R + it] = zr;
            scr[N * SO_DEC + it] = expf(-expf(w_raw));
            scr[N * SO_KM + it] = zk * (1.0f + (a - 1.0f) * P.rw_k_a[l * 512 + j]);
            scr[N * SO_KK + it] = zk * P.rw_k_k[l * 512 + j];
            scr[N * SO_A + it] = a;
            scr[N * SO_G + it] = ag;
            scr[N * SO_V + it] = zv;
            if (l == 0) P.vfirst[it] = zv;
        } break;
        case ST_RW_A2: {
            const long n = it / 32; const int i = (int)(it % 32);
            const float* v = scr + N * SO_V + n * 512;
            const float* vdn = P.rw_v_down + (long)(l - 1) * 512 * 32 + i;
            float s = 0.f;
            for (int j = 0; j < 512; ++j) s += v[j] * vdn[j * 32];
            scr[N * SO_VD + it] = s;
        } break;
        case ST_RW_A3: {
            const long n = it / 512; const int j = (int)(it % 512);
            const float* vd = scr + N * SO_VD + n * 32;
            const float* vup = P.rw_v_up + (long)(l - 1) * 32 * 512 + j;
            float s = P.rw_v0[(l - 1) * 512 + j];
            for (int i = 0; i < 32; ++i) s += vd[i] * vup[i * 512];
            const float v = scr[N * SO_V + it];
            scr[N * SO_V + it] = v + (P.vfirst[it] - v) * sigmoidf_(s);
        } break;
        case ST_RW_KKN: {
            const float* kk = scr + N * SO_KK + it * 64;
            float s = 0.f;
            for (int i = 0; i < 64; ++i) s += kk[i] * kk[i];
            scr[N * SO_KKINV + it] = 1.0f / sqrtf(fmaxf(s, 1e-24f));
        } break;
        case ST_RW_SCAN: {
            const int b = (int)(it / 512); const int h = (int)((it % 512) / 64); const int v = (int)(it % 64);
            float S[64];
#pragma unroll
            for (int i = 0; i < 64; ++i) S[i] = 0.f;
            for (int t = 0; t < P.T; ++t) {
                const long n = (long)b * P.T + t;
                const long base = n * 512 + h * 64;
                const float inv = scr[N * SO_KKINV + n * 8 + h];
                const float vv = scr[N * SO_V + base + v];
                const float* KK = scr + N * SO_KK + base;
                const float* DEC = scr + N * SO_DEC + base;
                const float* KM = scr + N * SO_KM + base;
                const float* AA = scr + N * SO_A + base;
                const float* RR = scr + N * SO_R + base;
                float sa = 0.f;
#pragma unroll
                for (int i = 0; i < 64; ++i) sa += S[i] * (-KK[i] * inv);
                float y = 0.f;
#pragma unroll
                for (int i = 0; i < 64; ++i) {
                    const float kk = KK[i] * inv;
                    S[i] = S[i] * DEC[i] + sa * (kk * AA[i]) + vv * KM[i];
                    y += S[i] * RR[i];
                }
                scr[N * SO_Y + base + v] = y;
            }
        } break;
        case ST_RW_POST: {
            const long n = it / 8; const int h = (int)(it % 8);
            const long base = n * 512 + h * 64;
            const float* Y = scr + N * SO_Y + base;
            const float* RR = scr + N * SO_R + base;
            const float* KM = scr + N * SO_KM + base;
            const float* V = scr + N * SO_V + base;
            const float* G = scr + N * SO_G + base;
            float mean = 0.f, bon = 0.f;
            for (int i = 0; i < 64; ++i) { mean += Y[i]; bon += RR[i] * KM[i] * P.rw_r_k[l * 512 + h * 64 + i]; }
            mean *= (1.0f / 64);
            float var = 0.f;
            for (int i = 0; i < 64; ++i) { const float d = Y[i] - mean; var += d * d; }
            const float rs = 1.0f / sqrtf(var * (1.0f / 64) + 64e-5f);
            for (int i = 0; i < 64; ++i) {
                const int c = h * 64 + i;
                const float yn = (Y[i] - mean) * rs * P.rw_ln_w[l * 512 + c] + P.rw_ln_b[l * 512 + c];
                P.mix16[n * DM + c] = f2bf((yn + bon * V[i]) * G[i]);
            }
        } break;
        case ST_GLA_B0: {
            const long n = it / 256; const int c = (int)(it % 256);
            float s = P.gla_a_bias[l * 256 + c];
            for (int i = 0; i < 16; ++i) s += PF(n, C_GLA + 1536 + i) * P.gla_a_up[(long)l * 16 * 256 + i * 256 + c];
            scr[N * SO_ALPHA + it] = expf(-softplusf_(-s) * (1.0f / 16.0f));
        } break;
        case ST_GLA_SCAN: {
            const int b = (int)(it / 512); const int h = (int)((it % 512) / 128); const int v = (int)(it % 128);
            float S[64];
#pragma unroll
            for (int i = 0; i < 64; ++i) S[i] = 0.f;
            for (int t = 0; t < P.T; ++t) {
                const long n = (long)b * P.T + t;
                const bf16_t* q = P.p16 + n * PLD + C_GLA + h * 64;
                const bf16_t* k = q + 256;
                const float vv = PF(n, C_GLA + 512 + h * 128 + v);
                const float* al = scr + N * SO_ALPHA + n * 256 + h * 64;
                float o = 0.f;
#pragma unroll
                for (int i = 0; i < 64; ++i) {
                    S[i] = S[i] * al[i] + bf2f(k[i]) * vv;
                    o += bf2f(q[i]) * S[i];
                }
                scr[N * SO_GO + n * 512 + h * 128 + v] = o * 0.125f;
            }
        } break;
        case ST_GLA_POST: {
            const long n = it / 4; const int h = (int)(it % 4);
            const float* o = scr + N * SO_GO + n * 512 + h * 128;
            float ms = 0.f;
            for (int i = 0; i < 128; ++i) ms += o[i] * o[i];
            const float rs = 1.0f / sqrtf(ms * (1.0f / 128) + 1e-6f);
            for (int i = 0; i < 128; ++i) {
                const float g = PF(n, C_GLA + 1024 + h * 128 + i);
                P.mix16[n * DM + 512 + h * 128 + i] = f2bf(o[i] * rs * P.gla_norm[l * 128 + i] * siluf_(g));
            }
        } break;
        case ST_LRU_C0: {
            const long n = it / 512; const int c = (int)(it % 512);
            const int t = (int)(n % P.T);
            float s = P.lru_conv_b[l * 512 + c];
            for (int j = 0; j < 4; ++j) {
                const int tt = t - 3 + j;
                if (tt >= 0) s += P.lru_conv_w[(long)l * 4 * 512 + j * 512 + c] * PF(n - 3 + j, C_LRU + c);
            }
            scr[N * SO_XC + it] = s;
        } break;
        case ST_LRU_C1: {
            const long n = it / 512; const int c = (int)(it % 512);
            const int blk = c / 64, j = c % 64;
            const float* xc = scr + N * SO_XC + n * 512 + blk * 64;
            const float* wr = P.lru_w_r + (long)l * 8 * 64 * 64 + (long)blk * 64 * 64 + j;
            const float* wi = P.lru_w_i + (long)l * 8 * 64 * 64 + (long)blk * 64 * 64 + j;
            float sr = P.lru_b_r[l * 512 + c], si = P.lru_b_i[l * 512 + c];
            for (int i = 0; i < 64; ++i) { sr += xc[i] * wr[i * 64]; si += xc[i] * wi[i * 64]; }
            const float r = sigmoidf_(sr), ig = sigmoidf_(si);
            const float log_a = -8.0f * r * softplusf_(-P.lru_lam[l * 512 + c]);
            scr[N * SO_LA + it] = expf(log_a);
            scr[N * SO_LU + it] = scr[N * SO_XC + it] * ig * sqrtf(-expm1f(2.0f * log_a));
        } break;
        case ST_LRU_SCAN: {
            const int b = (int)(it / 512); const int c = (int)(it % 512);
            float hst = 0.f;
            for (int t = 0; t < P.T; ++t) {
                const long n = (long)b * P.T + t;
                hst = scr[N * SO_LA + n * 512 + c] * hst + scr[N * SO_LU + n * 512 + c];
                P.mix16[n * DM + 1024 + c] = f2bf(hst * geluf_(PF(n, C_LRU + 512 + c)));
            }
        } break;
        case ST_GDN_D0: {
            const long n = it / 1536; const int c = (int)(it % 1536);
            const int t = (int)(n % P.T);
            float s = 0.f;
            for (int j = 0; j < 4; ++j) {
                const int tt = t - 3 + j;
                if (tt >= 0) s += P.gdn_conv_w[(long)l * 4 * 1536 + j * 1536 + c] * PF(n - 3 + j, C_GDN + c);
            }
            scr[N * SO_QKV + it] = siluf_(s);
        } break;
        case ST_GDN_D1: {
            const long n = it / 4; const int h = (int)(it % 4);
            const float* q = scr + N * SO_QKV + n * 1536 + h * 128;
            const float* k = q + 512;
            float qs = 0.f, ks = 0.f;
            for (int i = 0; i < 128; ++i) { qs += q[i] * q[i]; ks += k[i] * k[i]; }
            float* gs = scr + N * SO_GS + n * 16 + h * 4;
            gs[0] = (1.0f / sqrtf(qs + 1e-6f)) * 0.08838834764831845f;
            gs[1] = 1.0f / sqrtf(ks + 1e-6f);
            gs[2] = sigmoidf_(PF(n, C_GDN + 2048 + h));
            gs[3] = expf(-expf(P.gdn_a_log[l * 4 + h]) * softplusf_(PF(n, C_GDN + 2052 + h) + P.gdn_dt_bias[l * 4 + h]));
        } break;
        case ST_GDN_SCAN: {
            const int b = (int)(it / 512); const int h = (int)((it % 512) / 128); const int v = (int)(it % 128);
            float S[128];
#pragma unroll
            for (int i = 0; i < 128; ++i) S[i] = 0.f;
            for (int t = 0; t < P.T; ++t) {
                const long n = (long)b * P.T + t;
                const float* q = scr + N * SO_QKV + n * 1536 + h * 128;
                const float* k = q + 512;
                const float vv = scr[N * SO_QKV + n * 1536 + 1024 + h * 128 + v];
                const float* gs = scr + N * SO_GS + n * 16 + h * 4;
                const float qinv = gs[0], kinv = gs[1], beta = gs[2], eg = gs[3];
                float dk = 0.f;
#pragma unroll
                for (int i = 0; i < 128; ++i) dk += S[i] * k[i];
                const float u = beta * (vv - eg * kinv * dk) * kinv;
                float o = 0.f;
#pragma unroll
                for (int i = 0; i < 128; ++i) {
                    S[i] = S[i] * eg + u * k[i];
                    o += S[i] * q[i];
                }
                scr[N * SO_DO + n * 512 + h * 128 + v] = o * qinv;
            }
        } break;
        case ST_GDN_POST: {
            const long n = it / 4; const int h = (int)(it % 4);
            const float* o = scr + N * SO_DO + n * 512 + h * 128;
            float ms = 0.f;
            for (int i = 0; i < 128; ++i) ms += o[i] * o[i];
            const float rs = 1.0f / sqrtf(ms * (1.0f / 128) + 1e-6f);
            for (int i = 0; i < 128; ++i) {
                const float z = PF(n, C_GDN + 1536 + h * 128 + i);
                P.mix16[n * DM + 1536 + h * 128 + i] = f2bf(o[i] * rs * P.gdn_norm[l * 128 + i] * siluf_(z));
            }
        } break;
        case ST_SCORES: {
            const long n = it / 2048; const int c = (int)(it % 2048);
            const int hp = c / 128, key = c % 128;
            const float* q = P.qf + n * DM + hp * 128;
            const float* sk = P.peer_sub_keys + (long)l * 16 * 128 * 128 + ((long)hp * 128 + key) * 128;
            float s = 0.f;
            for (int d = 0; d < 128; ++d) s += q[d] * sk[d];
            P.sc[it] = s;
        } break;
        case ST_TOPK1: {
            const float* sc = P.sc + it * 128;
            float ts[16]; int ti[16];
#pragma unroll
            for (int j = 0; j < 16; ++j) { ts[j] = -3.0e38f; ti[j] = 0; }
            for (int i = 0; i < 128; ++i) {
                float xv = sc[i]; int xi = i;
                if (xv > ts[15]) {
#pragma unroll
                    for (int j = 0; j < 16; ++j) {
                        if (xv > ts[j]) { const float tv = ts[j]; const int tj = ti[j]; ts[j] = xv; ti[j] = xi; xv = tv; xi = tj; }
                    }
                }
            }
            float* TS = scr + N * SO_TS + it * 16;
            int* TI = (int*)(scr + N * SO_TI) + it * 16;
#pragma unroll
            for (int j = 0; j < 16; ++j) { TS[j] = ts[j]; TI[j] = ti[j]; }
        } break;
        case ST_TOPK2: {
            const float* s0 = scr + N * SO_TS + it * 32;
            const float* s1 = s0 + 16;
            const int* i0 = (const int*)(scr + N * SO_TI) + it * 32;
            const int* i1 = i0 + 16;
            float ts[16]; int ti[16];
#pragma unroll
            for (int j = 0; j < 16; ++j) { ts[j] = -3.0e38f; ti[j] = 0; }
            for (int a = 0; a < 16; ++a) {
                const int jmax = 16 / (a + 1);
                for (int b = 0; b < jmax; ++b) {
                    float xv = s0[a] + s1[b]; int xi = i0[a] * 128 + i1[b];
                    if (xv > ts[15]) {
#pragma unroll
                        for (int j = 0; j < 16; ++j) {
                            if (xv > ts[j]) { const float tv = ts[j]; const int tj = ti[j]; ts[j] = xv; ti[j] = xi; xv = tv; xi = tj; }
                        }
                    }
                }
            }
            const float mx = ts[0];
            float den = 0.f;
#pragma unroll
            for (int j = 0; j < 16; ++j) { ts[j] = expf(ts[j] - mx); den += ts[j]; }
            const float inv = 1.0f / den;
#pragma unroll
            for (int j = 0; j < 16; ++j) { P.gate[it * 16 + j] = ts[j] * inv; P.idx[it * 16 + j] = ti[j]; }
        } break;
        case ST_PEER_U: {
            const long n = it / 128;
            const int e = P.idx[it];
            const float* u = P.peer_u + ((long)l * NEXP + e) * DM;
            const bf16_t* hx = P.hb + n * DM;
            float s = 0.f;
            for (int d = 0; d < DM; ++d) s += bf2f(hx[d]) * u[d];
            P.act[it] = geluf_(s) * P.gate[it];
        } break;
        case ST_PEER_V: {
            const long n = it / DM; const int d = (int)(it % DM);
            const float* a = P.act + n * 128;
            const int* ix = P.idx + n * 128;
            float s = 0.f;
            for (int j = 0; j < 128; ++j) s += a[j] * P.peer_v[((long)l * NEXP + ix[j]) * DM + d];
            P.xcur[it] += s;
        } break;
    }
}


struct WsMap {
    size_t ctl, w1t, w2t, wsct, auxwt, lruwt, vreswt, pp, tabu, tabv, xn, hb, mix16, p16, sc, aux, vfirst, idx, gate, rstd, act, end;
    size_t auxA, zrkv, xc, auxo, gates, vres, glao, gdno;
    size_t scr, qf;
};
HD WsMap ws_map(size_t N) {
    WsMap m{};
    size_t o = 0;
    auto take = [&](size_t bytes) { size_t r = o; o += (bytes + 4095) & ~(size_t)4095; return r; };
    m.ctl = take(1u << 20);
    m.w1t = take((size_t)NL * PLD * DM * 2);
    m.w2t = take((size_t)NL * DM * DM * 2);
    m.wsct = take((size_t)NL * DM * DM * 2);
    m.auxwt = take((size_t)NL * 1792 * 384 * 2);
    m.lruwt = take((size_t)NL * 1024 * 512 * 2);
    m.vreswt = take((size_t)512 * 512 * 2);
    m.pp = take(1u << 20);
    m.xn = take(N * DM * 2);
    m.hb = take(N * DM * 2);
    m.mix16 = take(N * DM * 2);
    m.p16 = take(N * PLD * 2);
    m.sc = m.p16;
    m.vfirst = take(N * 512 * 4);
    m.idx = take(N * 128 * 4);
    m.gate = take(N * 128 * 4);
    m.act = take(N * 128 * 4);
    m.rstd = take(N * 4);
    m.tabu = take((size_t)NL * 2 * NEXP * DM * 2);
    m.tabv = m.tabu + (size_t)NEXP * DM * 2;
    m.aux = take(N * 3392 * 4);
    m.end = o;
    size_t a = m.aux;
    auto sub = [&](size_t bytes) { size_t r = a; a += (bytes + 4095) & ~(size_t)4095; return r; };
    m.auxA = sub(N * 384 * 2); m.zrkv = sub(N * 1536 * 2); m.xc = sub(N * 512 * 2); m.auxo = sub(N * 1792 * 2);
    m.gates = sub(N * 1024 * 2); m.vres = sub(N * 512 * 2); m.glao = sub(N * 512 * 2); m.gdno = sub(N * 512 * 2);
    m.scr = m.tabu;
    m.qf = m.aux + N * 1024 * 4;
    return m;
}
static inline void bind_ws(Params& P, char* ws) {
    const WsMap m = ws_map((size_t)P.N);
    P.xn = (bf16_t*)(ws + m.xn); P.hb = (bf16_t*)(ws + m.hb); P.mix16 = (bf16_t*)(ws + m.mix16); P.p16 = (bf16_t*)(ws + m.p16);
    P.sc = (float*)(ws + m.sc); P.qf = (float*)(ws + m.qf); P.rstd = (float*)(ws + m.rstd); P.vfirst = (float*)(ws + m.vfirst);
    P.scr = (float*)(ws + m.scr); P.act = (float*)(ws + m.act); P.gate = (float*)(ws + m.gate); P.idx = (int*)(ws + m.idx);
}

struct Step { int st, l; };
static inline int build_schedule(Step* s) {
    int n = 0;
    s[n++] = {ST_COPYX, 0};
    for (int l = 0; l < NL; ++l) {
        static const int per_layer[] = {ST_RSTD, ST_NORM1, ST_GEMM1,
            ST_RW_A0, ST_RW_A1, ST_RW_A2, ST_RW_A3, ST_RW_KKN, ST_RW_SCAN, ST_RW_POST,
            ST_GLA_B0, ST_GLA_SCAN, ST_GLA_POST, ST_LRU_C0, ST_LRU_C1, ST_LRU_SCAN,
            ST_GDN_D0, ST_GDN_D1, ST_GDN_SCAN, ST_GDN_POST,
            ST_GEMM2, ST_RSTD2, ST_NORM2, ST_GEMM3, ST_SCORES, ST_TOPK1, ST_TOPK2, ST_PEER_U, ST_PEER_V};
        for (int i = 0; i < (int)(sizeof(per_layer) / sizeof(int)); ++i) s[n++] = {per_layer[i], l};
    }
    s[n++] = {ST_FRSTD, 0};
    s[n++] = {ST_FNORM, 0};
    return n;
}

static inline void fill_inputs(Params& P, void* const* d_in) {
    const float** dst = (const float**)&P;
    for (int i = 0; i < 38; ++i) dst[i] = (const float*)d_in[i];
}

#ifndef HOST_EMU
#define GAS __attribute__((address_space(1)))
#define LAS __attribute__((address_space(3)))
typedef unsigned v4u __attribute__((ext_vector_type(4)));
typedef unsigned v2u __attribute__((ext_vector_type(2)));
typedef float f32x4 __attribute__((ext_vector_type(4)));
typedef float f32x2 __attribute__((ext_vector_type(2)));
typedef short bf16x8 __attribute__((ext_vector_type(8)));
constexpr int NWAVES = 8, NTHR = 512;
constexpr int RING_BYTES = 131072, MISC_OFF = RING_BYTES + 320, LDS_BYTES = 147456;
constexpr int NTOK = 16384, TSEQ = 4096, NBATCH = 4;

__device__ __forceinline__ unsigned pk2(float lo, float hi) { return (unsigned)f2bf(lo) | ((unsigned)f2bf(hi) << 16); }
__device__ __forceinline__ float bflo(unsigned u) { return __builtin_bit_cast(float, u << 16); }
__device__ __forceinline__ float bfhi(unsigned u) { return __builtin_bit_cast(float, u & 0xffff0000u); }
__device__ __forceinline__ float wave_sum(float v) {
#pragma unroll
    for (int o = 1; o < 64; o <<= 1) v += __shfl_xor(v, o);
    return v;
}
#define LDS_WAIT() asm volatile("s_waitcnt lgkmcnt(0)" ::: "memory")
#define VM_WAIT() asm volatile("s_waitcnt vmcnt(0)" ::: "memory")

namespace pg8 {
#define PG8_LAS __attribute__((address_space(3)))
constexpr int BM = 256, BK = 64, HALF = 128, HTB = HALF * BK * 2, STAGE_BYTES = 8 * HTB, NXCD = 8, WGM = 8;
__host__ __device__ __forceinline__ int lds_byte(int r, int c) { const int st = (r >> 4) * 2 + (c >> 5), rr = r & 15, cc = c & 31, ob = rr * 64 + cc * 2; return st * 1024 + (ob ^ (((ob >> 9) & 1) << 5)); }
__host__ __device__ __forceinline__ void stage_rc(int b, int& R, int& C) { const int st = b / 1024, sb = b % 1024, swz = sb ^ (((sb >> 9) & 1) << 5); R = (st >> 1) * 16 + swz / 64; C = (st & 1) * 32 + (swz % 64) / 2; }
__host__ __device__ __forceinline__ int perm32(int rho) { const int n = rho >> 4, i = rho & 15; return 8 * (i >> 2) + 4 * n + (i & 3); }
struct Unit { int pm, pn; };
struct GemmX { const bf16_t* A; const bf16_t* Bt; int M, N, K, lda; };
struct StaticOrder {
    int nM, nN, nwg, G, c;
    __host__ __device__ void init(int M, int N, int G_, int c_) { nM = M / BM; nN = N / BM; nwg = nM * nN; G = G_; c = c_; }
    __host__ __device__ bool next(int i, Unit& u) const {
        const long L = (long)i * G + c; if (L >= nwg) return false;
        int wgid = (int)L; { const int q = nwg / NXCD, r = nwg % NXCD, xcd = wgid % NXCD, off = wgid / NXCD; wgid = (xcd < r ? xcd * (q + 1) : r * (q + 1) + (xcd - r) * q) + off; }
        const int nig = WGM * nN, gid = wgid / nig, fm = gid * WGM, gsz = (nM - fm) < WGM ? (nM - fm) : WGM;
        u.pm = fm + ((wgid % nig) % gsz); u.pn = (wgid % nig) / gsz; return true;
    }
    __device__ __forceinline__ void a_ready(const Unit&) const {}
    __device__ __forceinline__ void done(const Unit&) const {}
};
__device__ __forceinline__ unsigned cvt_pk_bf16(float lo, float hi) { unsigned r; asm volatile("v_cvt_pk_bf16_f32 %0, %1, %2" : "=v"(r) : "v"(lo), "v"(hi)); return r; }
template <bool ACCUM> struct EpiF32 {
    static constexpr bool PERM = false, AFTER_DRAIN = false;
    float* C; int ldc;
    __device__ __forceinline__ void operator()(const f32x4 (&acc)[2][2][4][2], const Unit& u, int wr, int wc, int fr, int fq) const {
        const int row0 = u.pm * BM + wr * 64 + fr, col0 = u.pn * BM + wc * 32 + 4 * fq;
#pragma unroll
        for (int ai = 0; ai < 2; ++ai)
#pragma unroll
            for (int m = 0; m < 4; ++m) { float* rowp = C + (size_t)(row0 + ai * HALF + m * 16) * ldc + col0;
#pragma unroll
                for (int bj = 0; bj < 2; ++bj)
#pragma unroll
                    for (int n = 0; n < 2; ++n) { f32x4* p = (f32x4*)(rowp + bj * HALF + n * 16);
                        if (ACCUM) *p = *p + acc[ai][bj][m][n]; else *p = acc[ai][bj][m][n]; } }
    }
};
struct EpiBf16 {
    static constexpr bool PERM = true, AFTER_DRAIN = false;
    bf16_t* O; int ldc; const float* bias;
    __device__ __forceinline__ void operator()(const f32x4 (&acc)[2][2][4][2], const Unit& u, int wr, int wc, int fr, int fq) const {
        const int row0 = u.pm * BM + wr * 64 + fr; const int col0 = u.pn * BM + wc * 32 + 8 * fq;
        f32x4 bv[2][2];
#pragma unroll
        for (int bj = 0; bj < 2; ++bj)
#pragma unroll
            for (int n = 0; n < 2; ++n) bv[bj][n] = bias ? *(const f32x4*)(bias + col0 + bj * HALF + 4 * n) : (f32x4){0.f, 0.f, 0.f, 0.f};
#pragma unroll
        for (int ai = 0; ai < 2; ++ai)
#pragma unroll
            for (int m = 0; m < 4; ++m) { bf16_t* rowp = O + (size_t)(row0 + ai * HALF + m * 16) * ldc + col0;
#pragma unroll
                for (int bj = 0; bj < 2; ++bj) { const f32x4 v0 = acc[ai][bj][m][0] + bv[bj][0], v1 = acc[ai][bj][m][1] + bv[bj][1];
                    v4u w; w.x = cvt_pk_bf16(v0[0], v0[1]); w.y = cvt_pk_bf16(v0[2], v0[3]); w.z = cvt_pk_bf16(v1[0], v1[1]); w.w = cvt_pk_bf16(v1[2], v1[3]);
                    *(v4u*)(rowp + bj * HALF) = w; } }
    }
};
template <class Epi, class Sched, bool ALIGN_EPI = false, bool SP2 = false>
__device__ __forceinline__ void gemm_phase(PG8_LAS unsigned char* lds, const GemmX g, const Sched& S, const Epi& E) {
    const int tid = threadIdx.x, wid = __builtin_amdgcn_readfirstlane(tid >> 6), lane = tid & 63, wr = wid >> 2, wc = wid & 3, fr = lane & 15, fq = lane >> 4;
    const int K = g.K, nt = K / BK;
    unsigned voffA[2], voffB[2];
#pragma unroll
    for (int i = 0; i < 2; ++i) { int R, C; stage_rc(tid * 16 + i * 8192, R, C); const int Rb = Epi::PERM ? ((R & ~31) + perm32(R & 31)) : R;
        voffA[i] = (unsigned)(R * g.lda + C) * 2u; voffB[i] = (unsigned)(Rb * K + C) * 2u; }
    const size_t kstep = (size_t)(BK * 2);
    const size_t hstep = (size_t)HALF * K * 2;
    const size_t tstep = 2 * hstep;
    const size_t hstepA = (size_t)HALF * g.lda * 2, tstepA = 2 * hstepA;
    const unsigned ldsw = (unsigned)wid * 1024u;
    const int aoff = lds_byte(wr * 64 + fr, fq * 8), boff = lds_byte(wc * 32 + fr, fq * 8);
#define PG8_SA(b, h) (((b) * 2 + (h)) * HTB)
#define PG8_SB(b, h) ((4 + (b) * 2 + (h)) * HTB)
#define PG8_STAGE(bufoff, gbase, voff) do { _Pragma("unroll") for (int _i = 0; _i < 2; ++_i) \
        __builtin_amdgcn_global_load_lds((const unsigned*)((const char*)(gbase) + (voff)[_i]), (PG8_LAS unsigned*)(lds + (bufoff) + ldsw + _i * 8192), 16, 0, 0); } while (0)
#define PG8_LDA(dst, b, h) do { _Pragma("unroll") for (int m = 0; m < 4; ++m) _Pragma("unroll") for (int k = 0; k < 2; ++k) dst[m][k] = *(const PG8_LAS bf16x8*)(lds + PG8_SA(b, h) + aoff + m * 2048 + k * 1024); } while (0)
#define PG8_LDB(dst, b, h) do { _Pragma("unroll") for (int n = 0; n < 2; ++n) _Pragma("unroll") for (int k = 0; k < 2; ++k) dst[n][k] = *(const PG8_LAS bf16x8*)(lds + PG8_SB(b, h) + boff + n * 2048 + k * 1024); } while (0)
#define PG8_MMA(ai, bj, At, Bt) do { __builtin_amdgcn_s_setprio(1); _Pragma("unroll") for (int m = 0; m < 4; ++m) _Pragma("unroll") for (int n = 0; n < 2; ++n) _Pragma("unroll") for (int k = 0; k < 2; ++k) \
        acc[ai][bj][m][n] = __builtin_amdgcn_mfma_f32_16x16x32_bf16(Bt[n][k], At[m][k], acc[ai][bj][m][n], 0, 0, 0); __builtin_amdgcn_s_setprio(0); } while (0)
#define PG8_WAIT_V(n) asm volatile("s_waitcnt vmcnt(" #n ")" ::: "memory")
#define PG8_WAIT_L(n) asm volatile("s_waitcnt lgkmcnt(" #n ")" ::: "memory")
#define PG8_BAR __builtin_amdgcn_s_barrier()
#define PG8_SCHED __builtin_amdgcn_sched_barrier(0)
    Unit cur, nxt; int ui = 0;
    if (!S.next(0, cur)) return;
    f32x4 acc[2][2][4][2];
#pragma unroll
    for (int a = 0; a < 2; ++a)
#pragma unroll
        for (int b = 0; b < 2; ++b)
#pragma unroll
            for (int m = 0; m < 4; ++m)
#pragma unroll
                for (int n = 0; n < 2; ++n) acc[a][b][m][n] = (f32x4){0.f, 0.f, 0.f, 0.f};
    bf16x8 At[4][2], B0[2][2], B1[2][2];
    const char* cA = (const char*)g.A + (size_t)cur.pm * tstepA; const char* cB = (const char*)g.Bt + (size_t)cur.pn * tstep;
    S.a_ready(cur);
    if constexpr (SP2) {
        PG8_STAGE(PG8_SB(0, 0), cB, voffB); PG8_STAGE(PG8_SB(0, 1), cB + hstep, voffB); PG8_STAGE(PG8_SA(0, 0), cA, voffA); PG8_STAGE(PG8_SA(0, 1), cA + hstepA, voffA);
        if (wr == 1) PG8_BAR;
        PG8_WAIT_V(2); PG8_BAR;
        PG8_STAGE(PG8_SB(1, 0), cB + kstep, voffB); PG8_STAGE(PG8_SA(1, 0), cA + kstep, voffA); PG8_STAGE(PG8_SB(1, 1), cB + hstep + kstep, voffB);
        PG8_WAIT_V(6); PG8_BAR;
    } else {
        PG8_STAGE(PG8_SB(0, 0), cB, voffB); PG8_STAGE(PG8_SA(0, 0), cA, voffA); PG8_STAGE(PG8_SB(0, 1), cB + hstep, voffB); PG8_STAGE(PG8_SA(0, 1), cA + hstepA, voffA);
        if (wr == 1) PG8_BAR;
        PG8_WAIT_V(4); PG8_BAR;
        PG8_STAGE(PG8_SB(1, 0), cB + kstep, voffB); PG8_STAGE(PG8_SA(1, 0), cA + kstep, voffA); PG8_STAGE(PG8_SB(1, 1), cB + hstep + kstep, voffB);
        PG8_WAIT_V(6); PG8_BAR;
    }
    for (;;) {
        const bool has_next = S.next(ui + 1, nxt);
        const char* nA = has_next ? (const char*)g.A + (size_t)nxt.pm * tstepA : cA; const char* nB = has_next ? (const char*)g.Bt + (size_t)nxt.pn * tstep : cB;
        for (int t = 0; t < nt; t += 2) {
            const bool last = (t == nt - 2);
            const char* a1 = cA + (size_t)(t + 1) * kstep;
            const char* a2 = last ? nA : cA + (size_t)(t + 2) * kstep; const char* b2 = last ? nB : cB + (size_t)(t + 2) * kstep;
            const char* a3 = a2 + kstep; const char* b3 = b2 + kstep;
            if (last && has_next) S.a_ready(nxt);
            if constexpr (SP2) {
            PG8_LDB(B0, 0, 0); PG8_LDB(B1, 0, 1); PG8_SCHED; PG8_LDA(At, 0, 0); PG8_STAGE(PG8_SA(1, 1), a1 + hstepA, voffA);
            PG8_WAIT_V(8); PG8_WAIT_L(0); PG8_BAR; PG8_MMA(0, 0, At, B0); PG8_MMA(0, 1, At, B1); PG8_BAR; PG8_SCHED;
            PG8_LDA(At, 0, 1); PG8_STAGE(PG8_SB(0, 0), b2, voffB); PG8_STAGE(PG8_SB(0, 1), b2 + hstep, voffB); PG8_STAGE(PG8_SA(0, 0), a2, voffA);
            PG8_WAIT_V(8); PG8_WAIT_L(0); PG8_BAR; PG8_MMA(1, 0, At, B0); PG8_MMA(1, 1, At, B1); PG8_BAR; PG8_SCHED;
            PG8_LDB(B0, 1, 0); PG8_LDB(B1, 1, 1); PG8_SCHED; PG8_LDA(At, 1, 0); PG8_STAGE(PG8_SA(0, 1), a2 + hstepA, voffA);
            PG8_WAIT_V(8); PG8_WAIT_L(0); PG8_BAR; PG8_MMA(0, 0, At, B0); PG8_MMA(0, 1, At, B1); PG8_BAR; PG8_SCHED;
            PG8_LDA(At, 1, 1); PG8_STAGE(PG8_SB(1, 0), b3, voffB); PG8_STAGE(PG8_SB(1, 1), b3 + hstep, voffB); PG8_STAGE(PG8_SA(1, 0), a3, voffA);
            PG8_WAIT_V(8); PG8_WAIT_L(0); PG8_BAR; PG8_MMA(1, 0, At, B0); PG8_MMA(1, 1, At, B1); PG8_BAR; PG8_SCHED;
            } else {
            PG8_LDB(B0, 0, 0); PG8_SCHED; PG8_LDA(At, 0, 0); PG8_STAGE(PG8_SA(1, 1), a1 + hstepA, voffA);
            PG8_WAIT_L(8); PG8_BAR; PG8_WAIT_L(0); PG8_MMA(0, 0, At, B0); PG8_BAR; PG8_SCHED;
            PG8_LDB(B1, 0, 1); PG8_STAGE(PG8_SB(0, 0), b2, voffB);
            PG8_BAR; PG8_WAIT_L(0); PG8_MMA(0, 1, At, B1); PG8_BAR;
            PG8_LDA(At, 0, 1); PG8_STAGE(PG8_SA(0, 0), a2, voffA);
            PG8_BAR; PG8_WAIT_L(0); PG8_MMA(1, 0, At, B0); PG8_BAR; PG8_SCHED;
            PG8_STAGE(PG8_SB(0, 1), b2 + hstep, voffB);
            PG8_WAIT_V(6); PG8_BAR; PG8_MMA(1, 1, At, B1); PG8_BAR;
            PG8_LDB(B0, 1, 0); PG8_SCHED; PG8_LDA(At, 1, 0); PG8_STAGE(PG8_SA(0, 1), a2 + hstepA, voffA);
            PG8_WAIT_L(8); PG8_BAR; PG8_WAIT_L(0); PG8_MMA(0, 0, At, B0); PG8_BAR; PG8_SCHED;
            PG8_LDB(B1, 1, 1); PG8_STAGE(PG8_SB(1, 0), b3, voffB);
            PG8_BAR; PG8_WAIT_L(0); PG8_MMA(0, 1, At, B1); PG8_BAR;
            PG8_LDA(At, 1, 1); PG8_STAGE(PG8_SA(1, 0), a3, voffA);
            PG8_BAR; PG8_WAIT_L(0); PG8_MMA(1, 0, At, B0); PG8_BAR; PG8_SCHED;
            PG8_STAGE(PG8_SB(1, 1), b3 + hstep, voffB);
            PG8_WAIT_V(6); PG8_BAR; PG8_MMA(1, 1, At, B1); PG8_BAR;
            }
        }
        if constexpr (ALIGN_EPI) { if (wr == 0) PG8_BAR; }
        if constexpr (!Epi::AFTER_DRAIN) { E(acc, cur, wr, wc, fr, fq); S.done(cur); }
        if (!has_next) break;
#pragma unroll
        for (int a = 0; a < 2; ++a)
#pragma unroll
            for (int b = 0; b < 2; ++b)
#pragma unroll
                for (int m = 0; m < 4; ++m)
#pragma unroll
                    for (int n = 0; n < 2; ++n) acc[a][b][m][n] = (f32x4){0.f, 0.f, 0.f, 0.f};
        cur = nxt; cA = nA; cB = nB; ++ui;
        if constexpr (ALIGN_EPI) { if (wr == 1) PG8_BAR; }
    }
    PG8_WAIT_V(0);
    if constexpr (!ALIGN_EPI) { if (wr == 0) PG8_BAR; }
    PG8_BAR;
    if constexpr (Epi::AFTER_DRAIN) { E.fused(acc, cur, wr, wc, fr, fq, lds, wid, lane); S.done(cur); }
#undef PG8_SA
#undef PG8_SB
#undef PG8_STAGE
#undef PG8_LDA
#undef PG8_LDB
#undef PG8_MMA
#undef PG8_WAIT_V
#undef PG8_WAIT_L
#undef PG8_BAR
#undef PG8_SCHED
}
}

#define XB_TMO      128
#define XB_XCNT(j)  (256  + 64 * (j))
#define XB_XSUB(j)  (1280 + 64 * (j))
#define XB_XGEN(j)  (2304 + 64 * (j))
#define XB_TOP      3328
#define XB_TOPGEN   3392
#define XCD_BAR_WORDS 3456
#define XB_SPIN_CAP (1u << 20)
__device__ __forceinline__ unsigned xb_ld(unsigned* p) { return __hip_atomic_load(p, __ATOMIC_RELAXED, __HIP_MEMORY_SCOPE_AGENT); }
__device__ __forceinline__ unsigned xb_add(unsigned* p, unsigned v) { return __hip_atomic_fetch_add(p, v, __ATOMIC_RELAXED, __HIP_MEMORY_SCOPE_AGENT); }
__device__ __forceinline__ unsigned xb_xcc_id() { return (unsigned)__builtin_amdgcn_s_getreg((3 << 11) | 20) & 0xFu; }
#define XB_SPIN(cond, bar) do { unsigned _sp = 0; while (cond) { __builtin_amdgcn_s_sleep(1); \
    if ((++_sp & 255u) == 0u) { if (xb_ld(&(bar)[XB_TMO])) break; if (_sp > XB_SPIN_CAP) { atomicAdd(&(bar)[XB_TMO], 1u); break; } } } } while (0)
struct XcdBarrier { unsigned* bar; unsigned x; volatile LAS unsigned* st; };
__device__ __forceinline__ XcdBarrier xcd_barrier_post(unsigned* bar, volatile LAS unsigned* st) {
    XcdBarrier b; b.bar = bar; b.x = xb_xcc_id(); b.st = st;
    if (threadIdx.x == 0) (void)xb_add(&bar[XB_XCNT(b.x)], 1u);
    return b;
}
__device__ __forceinline__ void xcd_barrier_complete(unsigned* bar, unsigned x, unsigned& nloc, unsigned& nx) {
    const unsigned G = gridDim.x * gridDim.y * gridDim.z;
    unsigned sum, cnt, mine, sp = 0u;
    for (;;) {
        sum = 0u; cnt = 0u; mine = 0u;
#pragma unroll
        for (unsigned j = 0; j < 16; ++j) { const unsigned c = xb_ld(&bar[XB_XCNT(j)]); sum += c; cnt += (c > 0u) ? 1u : 0u; mine = (j == x) ? c : mine; }
        if (sum == G) break;
        __builtin_amdgcn_s_sleep(1);
        if ((++sp & 255u) == 0u) { if (xb_ld(&bar[XB_TMO])) break; if (sp > XB_SPIN_CAP) { atomicAdd(&bar[XB_TMO], 1u); break; } }
    }
    nloc = mine > 0u ? mine : 1u; nx = cnt > 0u ? cnt : 1u;
}
__device__ __forceinline__ void xcd_barrier(const XcdBarrier& b) {
    asm volatile("s_waitcnt vmcnt(0)" ::: "memory");
    __syncthreads();
    if (threadIdx.x == 0) {
        unsigned* bar = b.bar;
        __builtin_amdgcn_s_waitcnt(0);
        unsigned nloc = b.st[0], nx = b.st[1];
        if (nloc == 0u) { xcd_barrier_complete(bar, b.x, nloc, nx); b.st[0] = nloc; b.st[1] = nx; }
        const unsigned old = xb_add(&bar[XB_XSUB(b.x)], 1u);
        const unsigned gen = old / nloc;
        if (old + 1u == (gen + 1u) * nloc) {
            __builtin_amdgcn_fence(__ATOMIC_RELEASE, "agent");
            asm volatile("s_waitcnt vmcnt(0)" ::: "memory");
            const unsigned og = xb_add(&bar[XB_TOP], 1u);
            const unsigned tg = og / nx;
            if (og + 1u == (tg + 1u) * nx) xb_add(&bar[XB_TOPGEN], 1u);
            else XB_SPIN(xb_ld(&bar[XB_TOPGEN]) == tg, bar);
            __builtin_amdgcn_fence(__ATOMIC_ACQUIRE, "agent");
            xb_add(&bar[XB_XGEN(b.x)], 1u);
            asm volatile("s_waitcnt vmcnt(0)" ::: "memory");
        } else {
            XB_SPIN(xb_ld(&bar[XB_XGEN(b.x)]) == gen, bar);
            __builtin_amdgcn_fence(__ATOMIC_ACQUIRE, "agent");
            asm volatile("s_waitcnt vmcnt(0)" ::: "memory");
        }
    }
    __syncthreads();
}

struct Args { const float* in[38]; float* out; unsigned char* ws; int ph_lo, ph_hi, li, pad; };
enum InputId { I_X = 0, I_NORM_MIX, I_W_IN, I_W_OUT, I_RW_MU, I_RW_W0, I_RW_W_UP, I_RW_A0, I_RW_A_UP, I_RW_G_UP, I_RW_K_K, I_RW_K_A, I_RW_R_K,
    I_RW_LN_W, I_RW_LN_B, I_RW_V0, I_RW_V_DOWN, I_RW_V_UP, I_GLA_A_UP, I_GLA_A_BIAS, I_GLA_NORM, I_LRU_CONV_W, I_LRU_CONV_B, I_LRU_W_R,
    I_LRU_B_R, I_LRU_W_I, I_LRU_B_I, I_LRU_LAM, I_GDN_CONV_W, I_GDN_A_LOG, I_GDN_DT_BIAS, I_GDN_NORM, I_NORM_FFN, I_PEER_WQ, I_PEER_SK,
    I_PEER_U, I_PEER_V, I_NORM_FINAL };
enum { PH_P0 = 0, PH_GEMM1 = 1, PH_PREP = 2, PH_AUX = 3, PH_SCAN = 4, PH_POST = 5, PH_GEMM2 = 6, PH_NORM2 = 7, PH_GEMM3 = 8, PH_TOPK = 9, PH_PEER = 10, PH_PER_LAYER = 10, PH_TOTAL = 21 };

struct Frame {
    LAS unsigned char* lds;
    int tid, lane, wave, vcu, G;
    int gw, ngw;
};

__device__ __forceinline__ void p0_transpose_item(const float* W, int K, int N, const float* kscale, bf16_t* WT, LAS float* scr, int item, int nblk, int lane) {
    const int kb = item / nblk, nb = item % nblk, k0 = 64 * kb, n0 = 32 * nb;
    const int nn = n0 + (lane & 31);
#pragma unroll 8
    for (int i = 0; i < 32; ++i) { const int kk = 2 * i + (lane >> 5);
        float v = nn < N ? W[(size_t)(k0 + kk) * N + nn] : 0.f;
        if (kscale) v *= kscale[k0 + kk];
        scr[kk * 33 + (lane & 31)] = v; }
    LDS_WAIT(); asm volatile("" ::: "memory");
    const int c = lane & 7;
#pragma unroll
    for (int j = 0; j < 4; ++j) { const int n = (lane >> 3) + 8 * j; const LAS float* s = scr + (8 * c) * 33 + n;
        v4u o; o.x = pk2(s[0 * 33], s[1 * 33]); o.y = pk2(s[2 * 33], s[3 * 33]); o.z = pk2(s[4 * 33], s[5 * 33]); o.w = pk2(s[6 * 33], s[7 * 33]);
        *(v4u*)(WT + (size_t)(n0 + n) * K + k0 + 8 * c) = o; }
    LDS_WAIT(); asm volatile("" ::: "memory");
}

__device__ __forceinline__ void p0_prologue(const Args& a, Frame& F) {
    const WsMap m = ws_map(NTOK);
    unsigned char* ws = a.ws;
    LAS float* scr = (LAS float*)(F.lds + F.wave * 16384);
    const int gw = F.gw, NGW = F.ngw, lane = F.lane;
    for (int n = gw; n < NTOK; n += NGW) {
        const f32x4* xr = (const f32x4*)(a.in[I_X] + (size_t)n * DM) + lane;
        f32x4 v[8]; float s = 0.f;
#pragma unroll
        for (int j = 0; j < 8; ++j) { v[j] = xr[64 * j]; s += (v[j].x * v[j].x + v[j].y * v[j].y) + (v[j].z * v[j].z + v[j].w * v[j].w); }
        const float rstd = 1.0f / sqrtf(wave_sum(s) * (1.0f / DM) + 1e-6f);
        f32x4* xo = (f32x4*)(a.out + (size_t)n * DM) + lane;
        v2u* o8 = (v2u*)((bf16_t*)(ws + m.xn) + (size_t)n * DM) + lane;
#pragma unroll
        for (int j = 0; j < 8; ++j) { xo[64 * j] = v[j]; v2u w; w.x = pk2(v[j].x * rstd, v[j].y * rstd); w.y = pk2(v[j].z * rstd, v[j].w * rstd); o8[64 * j] = w; }
    }
    {
        constexpr int I1 = (DM / 64) * (PLD / 32), I2 = (DM / 64) * (DM / 32);
        for (int it = gw; it < NL * (I1 + I2); it += NGW) {
            const int l = it / (I1 + I2); int r = it % (I1 + I2);
            if (r < I1) p0_transpose_item(a.in[I_W_IN] + (size_t)l * DM * INC, DM, INC, a.in[I_NORM_MIX] + l * DM, (bf16_t*)(ws + m.w1t) + (size_t)l * PLD * DM, scr, r, PLD / 32, lane);
            else p0_transpose_item(a.in[I_W_OUT] + (size_t)l * DM * DM, DM, DM, nullptr, (bf16_t*)(ws + m.w2t) + (size_t)l * DM * DM, scr, r - I1, DM / 32, lane);
        }
    }
    for (int it = gw; it < NL * 16 * 64; it += NGW) {
        const int l = it / 1024, hp = (it % 1024) / 64, kb = it % 64;
        const int dh = lane & 1, kk = kb * 32 + (lane >> 1);
        const float* wq = a.in[I_PEER_WQ] + (size_t)l * DM * DM + (size_t)kk * DM + hp * 128 + dh * 64;
        const float* sk = a.in[I_PEER_SK] + ((size_t)l * 16 + hp) * 128 * 128 + dh * 64;
        f32x4 q[16];
#pragma unroll
        for (int d = 0; d < 16; ++d) q[d] = *(const f32x4*)(wq + 4 * d);
        bf16_t* o = (bf16_t*)(ws + m.wsct) + (size_t)l * DM * DM + (size_t)(hp * 128) * DM + kk;
        for (int key = 0; key < 128; ++key) {
            const f32x4* s4 = (const f32x4*)(sk + key * 128);
            float acc = 0.f;
#pragma unroll
            for (int d = 0; d < 16; ++d) { const f32x4 sv = s4[d]; acc += (q[d].x * sv.x + q[d].y * sv.y) + (q[d].z * sv.z + q[d].w * sv.w); }
            acc += __shfl_xor(acc, 1);
            if (dh == 0) o[(size_t)key * DM] = f2bf(acc);
        }
    }
    {
        const int gt = F.vcu * NTHR + F.tid, GT = F.G * NTHR;
        bf16_t* AW = (bf16_t*)(ws + m.auxwt); bf16_t* LW = (bf16_t*)(ws + m.lruwt); bf16_t* VW = (bf16_t*)(ws + m.vreswt); float* PP = (float*)(ws + m.pp);
        for (int it = gt; it < NL * 1792 * 384; it += GT) {
            const int l = it / (1792 * 384), r = it % (1792 * 384), n = r / 384, k = r % 384;
            float v = 0.f;
            if (n < 512) { if (k < 64) v = a.in[I_RW_W_UP][(size_t)l * 64 * 512 + k * 512 + n]; }
            else if (n < 1024) { if (k >= 64 && k < 128) v = a.in[I_RW_A_UP][(size_t)l * 64 * 512 + (k - 64) * 512 + (n - 512)]; }
            else if (n < 1536) { if (k >= 128 && k < 256) v = a.in[I_RW_G_UP][(size_t)l * 128 * 512 + (k - 128) * 512 + (n - 1024)]; }
            else { if (k >= 256 && k < 272) v = a.in[I_GLA_A_UP][(size_t)l * 16 * 256 + (k - 256) * 256 + (n - 1536)]; }
            AW[it] = f2bf(v);
        }
        for (int it = gt; it < NL * 1024 * 512; it += GT) {
            const int l = it / (1024 * 512), r = it % (1024 * 512), n = r / 512, k = r % 512;
            const int nn = n & 511, blk = nn >> 6, j = nn & 63;
            float v = 0.f;
            if ((k >> 6) == blk) v = (n < 512 ? a.in[I_LRU_W_R] : a.in[I_LRU_W_I])[(size_t)l * 8 * 64 * 64 + (size_t)blk * 4096 + (k & 63) * 64 + j];
            LW[it] = f2bf(v);
        }
        for (int it = gt; it < 512 * 512; it += GT) {
            const int n = it / 512, k = it % 512;
            float s = 0.f;
            for (int i = 0; i < 32; ++i) s += a.in[I_RW_V_DOWN][k * 32 + i] * a.in[I_RW_V_UP][i * 512 + n];
            VW[it] = f2bf(s);
        }
        for (int it = gt; it < 6144; it += GT) {
            float v = 0.f;
            if (it < 3584) { const int l = it / 1792, c = it % 1792;
                v = c < 512 ? a.in[I_RW_W0][l * 512 + c] : (c < 1024 ? a.in[I_RW_A0][l * 512 + c - 512] : (c < 1536 ? 0.f : a.in[I_GLA_A_BIAS][l * 256 + c - 1536])); }
            else if (it < 5632) { const int l = (it - 3584) / 1024, c = (it - 3584) % 1024; v = c < 512 ? a.in[I_LRU_B_R][l * 512 + c] : a.in[I_LRU_B_I][l * 512 + c - 512]; }
            else v = a.in[I_RW_V0][it - 5632];
            PP[it] = v;
        }
    }
}

__device__ __forceinline__ void tables_phase(const Args& a, Frame& F, int l0, int l1) {
    const WsMap m = ws_map(NTOK);
    const size_t per = (size_t)NEXP * DM / 8;
    for (size_t it = (size_t)l0 * 2 * per + (size_t)F.vcu * NTHR + F.tid; it < (size_t)l1 * 2 * per; it += (size_t)F.G * NTHR) {
        const int tb = (int)(it / per); const size_t r = it % per;
        const float* srcp = ((tb & 1) ? a.in[I_PEER_V] : a.in[I_PEER_U]) + (size_t)(tb >> 1) * NEXP * DM + r * 8;
        const f32x4 v0 = __builtin_nontemporal_load((const f32x4*)srcp), v1 = __builtin_nontemporal_load((const f32x4*)srcp + 1);
        v4u w; w.x = pk2(v0.x, v0.y); w.y = pk2(v0.z, v0.w); w.z = pk2(v1.x, v1.y); w.w = pk2(v1.z, v1.w);
        *(v4u*)((bf16_t*)(a.ws + m.tabu) + (size_t)tb * NEXP * DM + r * 8) = w;
    }
}

template <int CTRL> __device__ __forceinline__ float dpp_f(float v) { return __builtin_bit_cast(float, __builtin_amdgcn_update_dpp(0, __builtin_bit_cast(int, v), CTRL, 0xF, 0xF, true)); }
__device__ __forceinline__ float rdlane_f(float v, int l) { return __builtin_bit_cast(float, __builtin_amdgcn_readlane(__builtin_bit_cast(int, v), l)); }
__device__ __forceinline__ float row16_sum(float v) {
    v += dpp_f<0xB1>(v); v += dpp_f<0x4E>(v); v += dpp_f<0x141>(v); v += dpp_f<0x140>(v); return v;
}
__device__ __forceinline__ float wave_sum_u(float v) {
    v = row16_sum(v);
    return (rdlane_f(v, 0) + rdlane_f(v, 16)) + (rdlane_f(v, 32) + rdlane_f(v, 48));
}
typedef __bf16 bf16x2_t __attribute__((ext_vector_type(2)));
__device__ __forceinline__ float dot2bf(unsigned w, unsigned x, float acc) { return __builtin_amdgcn_fdot2_f32_bf16(__builtin_bit_cast(bf16x2_t, w), __builtin_bit_cast(bf16x2_t, x), acc, false); }
__device__ __forceinline__ float gelu_fast(float x) {
    const float u = 1.5957691216057308f * (x + 0.044715f * x * x * x);
    return x / (1.0f + __expf(-u));
}


__device__ __forceinline__ float sigm(float x) { return 1.0f / (1.0f + __expf(-x)); }
__device__ __forceinline__ float softplus_f(float x) { return log1pf(__expf(-fabsf(x))) + fmaxf(x, 0.0f); }
__device__ __forceinline__ float tanh_f(float x) { return 1.0f - 2.0f / (1.0f + __expf(2.0f * x)); }
__device__ __forceinline__ float red8(float v) { v += dpp_f<0xB1>(v); v += dpp_f<0x4E>(v); v += dpp_f<0x141>(v); return v; }
__device__ __forceinline__ v4u ld8(const bf16_t* p) { return *(const v4u*)p; }
__device__ __forceinline__ void unpack8(const v4u w, float (&f)[8]) { f[0] = bflo(w.x); f[1] = bfhi(w.x); f[2] = bflo(w.y); f[3] = bfhi(w.y); f[4] = bflo(w.z); f[5] = bfhi(w.z); f[6] = bflo(w.w); f[7] = bfhi(w.w); }
__device__ __forceinline__ v4u pack8(const float (&f)[8]) { v4u w; w.x = pk2(f[0], f[1]); w.y = pk2(f[2], f[3]); w.z = pk2(f[4], f[5]); w.w = pk2(f[6], f[7]); return w; }

__device__ __forceinline__ void prep_phase(const Args& a, Frame& F, int l) {
    const WsMap m = ws_map(NTOK);
    const bf16_t* p16 = (const bf16_t*)(a.ws + m.p16);
    bf16_t* zrkv = (bf16_t*)(a.ws + m.zrkv); bf16_t* auxA = (bf16_t*)(a.ws + m.auxA); bf16_t* xc = (bf16_t*)(a.ws + m.xc);
    const float* mu = a.in[I_RW_MU] + l * 1792;
    for (size_t it = (size_t)F.vcu * NTHR + F.tid; it < (size_t)NTOK * 304; it += (size_t)F.G * NTHR) {
        const int n = (int)(it / 304), j = (int)(it % 304), t = n % TSEQ;
        if (j < 224) {
            const int col = j * 8;
            float cur[8], prv[8], z[8];
            unpack8(ld8(p16 + (size_t)n * PLD + col), cur);
            if (t > 0) unpack8(ld8(p16 + (size_t)(n - 1) * PLD + col), prv);
            else {
#pragma unroll
                for (int k = 0; k < 8; ++k) prv[k] = 0.f; }
            const f32x4 m0 = *(const f32x4*)(mu + col), m1 = *(const f32x4*)(mu + col + 4);
            const float mm[8] = {m0.x, m0.y, m0.z, m0.w, m1.x, m1.y, m1.z, m1.w};
#pragma unroll
            for (int k = 0; k < 8; ++k) z[k] = cur[k] + (prv[k] - cur[k]) * mm[k];
            if (col < 1536) *(v4u*)(zrkv + (size_t)n * 1536 + col) = pack8(z);
            else {
                const int c = col - 1536;
#pragma unroll
                for (int k = 0; k < 8; ++k) z[k] = c < 64 ? tanh_f(z[k]) : (c < 128 ? z[k] : sigm(z[k]));
                *(v4u*)(auxA + (size_t)n * 384 + c) = pack8(z);
            }
        } else if (j < 240) {
            const int c = 256 + (j - 224) * 8;
            v4u w = (v4u){0u, 0u, 0u, 0u};
            if (c < 272) w = ld8(p16 + (size_t)n * PLD + C_GLA + 1536 + (c - 256));
            *(v4u*)(auxA + (size_t)n * 384 + c) = w;
        } else {
            const int c = (j - 240) * 8;
            float acc[8];
            { const f32x4 b0 = *(const f32x4*)(a.in[I_LRU_CONV_B] + l * 512 + c), b1 = *(const f32x4*)(a.in[I_LRU_CONV_B] + l * 512 + c + 4);
              acc[0] = b0.x; acc[1] = b0.y; acc[2] = b0.z; acc[3] = b0.w; acc[4] = b1.x; acc[5] = b1.y; acc[6] = b1.z; acc[7] = b1.w; }
#pragma unroll
            for (int jj = 0; jj < 4; ++jj) {
                if (t - 3 + jj >= 0) {
                    float xv[8]; unpack8(ld8(p16 + (size_t)(n - 3 + jj) * PLD + C_LRU + c), xv);
                    const float* cw = a.in[I_LRU_CONV_W] + (size_t)l * 4 * 512 + jj * 512 + c;
                    const f32x4 w0 = *(const f32x4*)cw, w1 = *(const f32x4*)(cw + 4);
                    acc[0] += w0.x * xv[0]; acc[1] += w0.y * xv[1]; acc[2] += w0.z * xv[2]; acc[3] += w0.w * xv[3];
                    acc[4] += w1.x * xv[4]; acc[5] += w1.y * xv[5]; acc[6] += w1.z * xv[6]; acc[7] += w1.w * xv[7];
                }
            }
            *(v4u*)(xc + (size_t)n * 512 + c) = pack8(acc);
        }
    }
}

__device__ __forceinline__ void rwkv_task(const Args& a, Frame& F, int l, int task) {
    const WsMap m = ws_map(NTOK);
    const int b = task >> 3, h = task & 7;
    LAS float* LR = (LAS float*)F.lds; LAS float* LW = LR + 2048; LAS float* LK = LW + 2048; LAS float* LV = LK + 2048;
    LAS float* LA = LV + 2048; LAS float* LB = LA + 2048; LAS float* LY = LB + 2048;
    const int lane = F.lane, w = F.wave, tid = F.tid;
    const int ch = h * 64 + lane;
    const float kk_ = a.in[I_RW_K_K][l * 512 + ch], ka_ = a.in[I_RW_K_A][l * 512 + ch], rk_ = a.in[I_RW_R_K][l * 512 + ch];
    const float lnw = a.in[I_RW_LN_W][l * 512 + ch], lnb = a.in[I_RW_LN_B][l * 512 + ch];
    const bf16_t* zr = (const bf16_t*)(a.ws + m.zrkv); const bf16_t* ao = (const bf16_t*)(a.ws + m.auxo); const bf16_t* vr = (const bf16_t*)(a.ws + m.vres);
    float* vf = (float*)(a.ws + m.vfirst); bf16_t* mix = (bf16_t*)(a.ws + m.mix16);
    float S[8];
#pragma unroll
    for (int j = 0; j < 8; ++j) S[j] = 0.f;
    const int row = tid >> 3, ks = tid & 7;
    float in_[4][8];
    auto load_chunk = [&](int c) {
#pragma unroll
        for (int q = 0; q < 4; ++q) { const size_t n = (size_t)b * TSEQ + c * 32 + w + 8 * q;
            in_[q][0] = bf2f(zr[n * 1536 + ch]); in_[q][1] = bf2f(zr[n * 1536 + 512 + ch]); in_[q][2] = bf2f(zr[n * 1536 + 1024 + ch]);
            in_[q][3] = bf2f(ao[n * 1792 + ch]); in_[q][4] = bf2f(ao[n * 1792 + 512 + ch]); in_[q][5] = bf2f(ao[n * 1792 + 1024 + ch]);
            if (l > 0) { in_[q][6] = bf2f(vr[n * 512 + ch]); in_[q][7] = vf[n * 512 + ch]; } else { in_[q][6] = 0.f; in_[q][7] = 0.f; } }
    };
    load_chunk(0);
    for (int c = 0; c < TSEQ / 32; ++c) {
        float gq[4], vq[4], bonq[4];
#pragma unroll
        for (int q = 0; q < 4; ++q) {
            const int tl = w + 8 * q; const size_t n = (size_t)b * TSEQ + c * 32 + tl;
            const float zr_ = in_[q][0], zk_ = in_[q][1], zv_ = in_[q][2], wp = in_[q][3], ap = in_[q][4];
            float v = zv_;
            if (l == 0) vf[n * 512 + ch] = zv_; else v = zv_ + (in_[q][7] - zv_) * sigm(in_[q][6]);
            const float w_raw = -softplus_f(-wp) - 0.5f, dec = __expf(-__expf(w_raw));
            const float aa = sigm(ap);
            const float kkraw = zk_ * kk_;
            const float ss = wave_sum_u(kkraw * kkraw);
            const float kk = kkraw * (1.0f / sqrtf(fmaxf(ss, 1e-24f)));
            const float km = zk_ * (1.0f + (aa - 1.0f) * ka_);
            bonq[q] = wave_sum_u(zr_ * km * rk_);
            LR[tl * 64 + lane] = zr_; LW[tl * 64 + lane] = dec; LK[tl * 64 + lane] = km; LV[tl * 64 + lane] = v; LA[tl * 64 + lane] = -kk; LB[tl * 64 + lane] = kk * aa;
            gq[q] = in_[q][5]; vq[q] = v;
        }
        __syncthreads();
        if (c + 1 < TSEQ / 32) load_chunk(c + 1);
#pragma unroll 2
        for (int tl = 0; tl < 32; ++tl) {
            const int o = tl * 64 + ks * 8;
            const f32x4 a0 = *(const LAS f32x4*)(LA + o), a1 = *(const LAS f32x4*)(LA + o + 4);
            const f32x4 w0 = *(const LAS f32x4*)(LW + o), w1 = *(const LAS f32x4*)(LW + o + 4);
            const f32x4 b0 = *(const LAS f32x4*)(LB + o), b1 = *(const LAS f32x4*)(LB + o + 4);
            const f32x4 k0 = *(const LAS f32x4*)(LK + o), k1 = *(const LAS f32x4*)(LK + o + 4);
            const f32x4 r0 = *(const LAS f32x4*)(LR + o), r1 = *(const LAS f32x4*)(LR + o + 4);
            const float vv = LV[tl * 64 + row];
            float sa = ((S[0] * a0.x + S[1] * a0.y) + (S[2] * a0.z + S[3] * a0.w)) + ((S[4] * a1.x + S[5] * a1.y) + (S[6] * a1.z + S[7] * a1.w));
            sa = red8(sa);
            S[0] = S[0] * w0.x + (sa * b0.x + vv * k0.x); S[1] = S[1] * w0.y + (sa * b0.y + vv * k0.y); S[2] = S[2] * w0.z + (sa * b0.z + vv * k0.z); S[3] = S[3] * w0.w + (sa * b0.w + vv * k0.w);
            S[4] = S[4] * w1.x + (sa * b1.x + vv * k1.x); S[5] = S[5] * w1.y + (sa * b1.y + vv * k1.y); S[6] = S[6] * w1.z + (sa * b1.z + vv * k1.z); S[7] = S[7] * w1.w + (sa * b1.w + vv * k1.w);
            float y = ((S[0] * r0.x + S[1] * r0.y) + (S[2] * r0.z + S[3] * r0.w)) + ((S[4] * r1.x + S[5] * r1.y) + (S[6] * r1.z + S[7] * r1.w));
            y = red8(y);
            if (ks == 0) LY[tl * 64 + row] = y;
        }
        __syncthreads();
#pragma unroll
        for (int q = 0; q < 4; ++q) {
            const int tl = w + 8 * q; const size_t n = (size_t)b * TSEQ + c * 32 + tl;
            const float y = LY[tl * 64 + lane];
            const float mean = wave_sum_u(y) * (1.0f / 64.0f);
            const float d = y - mean;
            const float var = wave_sum_u(d * d) * (1.0f / 64.0f);
            const float rs = 1.0f / sqrtf(var + 64e-5f);
            const float outv = (d * rs * lnw + lnb + bonq[q] * vq[q]) * gq[q];
            mix[n * DM + ch] = f2bf(outv);
        }
    }
}

__device__ __forceinline__ void gdn_task(const Args& a, Frame& F, int l, int task) {
    const WsMap m = ws_map(NTOK);
    const int b = task >> 4, h = (task >> 2) & 3, rq = task & 3;
    LAS float* LQ = (LAS float*)F.lds; LAS float* LK = LQ + 4096; LAS float* LV = LK + 4096; LAS float* LBE = LV + 1024; LAS float* LEG = LBE + 32; LAS float* LO = LEG + 32;
    const int lane = F.lane, w = F.wave, tid = F.tid;
    const bf16_t* p16 = (const bf16_t*)(a.ws + m.p16);
    bf16_t* go = (bf16_t*)(a.ws + m.gdno);
    const float* cw = a.in[I_GDN_CONV_W] + (size_t)l * 4 * 1536;
    const int cq = h * 128 + 2 * lane, ck = 512 + h * 128 + 2 * lane, vi = lane & 31, cv = 1024 + h * 128 + rq * 32 + vi, vt = lane >> 5;
    float wq[4][2], wk[4][2], wv[4];
#pragma unroll
    for (int j = 0; j < 4; ++j) { wq[j][0] = cw[j * 1536 + cq]; wq[j][1] = cw[j * 1536 + cq + 1]; wk[j][0] = cw[j * 1536 + ck]; wk[j][1] = cw[j * 1536 + ck + 1]; wv[j] = cw[j * 1536 + cv]; }
    const float nAexp = -__expf(a.in[I_GDN_A_LOG][l * 4 + h]), dtb = a.in[I_GDN_DT_BIAS][l * 4 + h];
    float S[8];
#pragma unroll
    for (int j = 0; j < 8; ++j) S[j] = 0.f;
    const int row = tid >> 4, ks = tid & 15;
    unsigned rq_[7], rk_[7]; unsigned short rv_[5]; float rb_ = 0.f, ra_ = 0.f;
    auto load_chunk = [&](int c) {
        const int t0 = c * 32 + 4 * w;
        const size_t n0 = (size_t)b * TSEQ + t0;
#pragma unroll
        for (int r = 0; r < 7; ++r) { const bool ok = t0 - 3 + r >= 0; const bf16_t* pr = p16 + (n0 - 3 + r) * PLD + C_GDN;
            rq_[r] = ok ? *(const unsigned*)(pr + cq) : 0u; rk_[r] = ok ? *(const unsigned*)(pr + ck) : 0u; }
#pragma unroll
        for (int r = 0; r < 5; ++r) { const bool ok = t0 + 2 * vt - 3 + r >= 0; rv_[r] = ok ? p16[(n0 + 2 * vt - 3 + r) * PLD + C_GDN + cv] : (unsigned short)0; }
        if (lane < 4) { rb_ = bf2f(p16[(n0 + lane) * PLD + C_GDN + 2048 + h]); ra_ = bf2f(p16[(n0 + lane) * PLD + C_GDN + 2052 + h]); }
    };
    load_chunk(0);
    for (int c = 0; c < TSEQ / 32; ++c) {
#pragma unroll
        for (int i = 0; i < 4; ++i) {
            const int tl = 4 * w + i;
            float q0 = 0.f, q1 = 0.f, k0 = 0.f, k1 = 0.f;
#pragma unroll
            for (int j = 0; j < 4; ++j) { q0 += wq[j][0] * bflo(rq_[i + j]); q1 += wq[j][1] * bfhi(rq_[i + j]); k0 += wk[j][0] * bflo(rk_[i + j]); k1 += wk[j][1] * bfhi(rk_[i + j]); }
            q0 = q0 * sigm(q0); q1 = q1 * sigm(q1); k0 = k0 * sigm(k0); k1 = k1 * sigm(k1);
            const float qs = wave_sum_u(q0 * q0 + q1 * q1), ksum = wave_sum_u(k0 * k0 + k1 * k1);
            const float qi = (1.0f / sqrtf(qs + 1e-6f)) * 0.08838834764831845f, ki = 1.0f / sqrtf(ksum + 1e-6f);
            *(LAS f32x2*)(LQ + tl * 128 + 2 * lane) = (f32x2){q0 * qi, q1 * qi};
            *(LAS f32x2*)(LK + tl * 128 + 2 * lane) = (f32x2){k0 * ki, k1 * ki};
        }
#pragma unroll
        for (int i = 0; i < 2; ++i) {
            float v = 0.f;
#pragma unroll
            for (int j = 0; j < 4; ++j) v += wv[j] * bf2f(rv_[i + j]);
            LV[(4 * w + 2 * vt + i) * 32 + vi] = v * sigm(v);
        }
        if (lane < 4) { LBE[4 * w + lane] = sigm(rb_); LEG[4 * w + lane] = __expf(nAexp * softplus_f(ra_ + dtb)); }
        __syncthreads();
        if (c + 1 < TSEQ / 32) load_chunk(c + 1);
#pragma unroll 2
        for (int tl = 0; tl < 32; ++tl) {
            const int o = tl * 128 + ks * 8;
            const f32x4 k0 = *(const LAS f32x4*)(LK + o), k1 = *(const LAS f32x4*)(LK + o + 4);
            const f32x4 q0 = *(const LAS f32x4*)(LQ + o), q1 = *(const LAS f32x4*)(LQ + o + 4);
            const float vv = LV[tl * 32 + row], be = LBE[tl], eg = LEG[tl];
            float dk = ((S[0] * k0.x + S[1] * k0.y) + (S[2] * k0.z + S[3] * k0.w)) + ((S[4] * k1.x + S[5] * k1.y) + (S[6] * k1.z + S[7] * k1.w));
            dk = row16_sum(dk);
            const float u = be * (vv - eg * dk);
            S[0] = S[0] * eg + u * k0.x; S[1] = S[1] * eg + u * k0.y; S[2] = S[2] * eg + u * k0.z; S[3] = S[3] * eg + u * k0.w;
            S[4] = S[4] * eg + u * k1.x; S[5] = S[5] * eg + u * k1.y; S[6] = S[6] * eg + u * k1.z; S[7] = S[7] * eg + u * k1.w;
            float oo = ((S[0] * q0.x + S[1] * q0.y) + (S[2] * q0.z + S[3] * q0.w)) + ((S[4] * q1.x + S[5] * q1.y) + (S[6] * q1.z + S[7] * q1.w));
            oo = row16_sum(oo);
            if (ks == 0) LO[tl * 32 + row] = oo;
        }
        __syncthreads();
        { const int tl = tid >> 4, r2 = (tid & 15) * 2; const size_t n = (size_t)b * TSEQ + c * 32 + tl;
          *(unsigned*)(go + n * 512 + h * 128 + rq * 32 + r2) = pk2(LO[tl * 32 + r2], LO[tl * 32 + r2 + 1]); }
    }
}

__device__ __forceinline__ void gla_task(const Args& a, Frame& F, int l, int task) {
    const WsMap m = ws_map(NTOK);
    const int b = task >> 3, h = (task >> 1) & 3, chh = task & 1;
    LAS float* LQ = (LAS float*)F.lds; LAS float* LK = LQ + 2048; LAS float* LAL = LK + 2048; LAS float* LV = LAL + 2048; LAS float* LO = LV + 2048;
    const int lane = F.lane, w = F.wave, tid = F.tid;
    const bf16_t* p16 = (const bf16_t*)(a.ws + m.p16); const bf16_t* ao = (const bf16_t*)(a.ws + m.auxo);
    bf16_t* go = (bf16_t*)(a.ws + m.glao);
    float S[8];
#pragma unroll
    for (int j = 0; j < 8; ++j) S[j] = 0.f;
    const int col = tid >> 3, ks = tid & 7;
    float in_[4][4];
    auto load_chunk = [&](int c) {
#pragma unroll
        for (int q = 0; q < 4; ++q) { const size_t n = (size_t)b * TSEQ + c * 32 + w + 8 * q;
            in_[q][0] = bf2f(p16[n * PLD + C_GLA + h * 64 + lane]); in_[q][1] = bf2f(p16[n * PLD + C_GLA + 256 + h * 64 + lane]);
            in_[q][2] = bf2f(ao[n * 1792 + 1536 + h * 64 + lane]); in_[q][3] = bf2f(p16[n * PLD + C_GLA + 512 + h * 128 + chh * 64 + lane]); }
    };
    load_chunk(0);
    for (int c = 0; c < TSEQ / 32; ++c) {
#pragma unroll
        for (int q = 0; q < 4; ++q) { const int tl = w + 8 * q;
            LQ[tl * 64 + lane] = in_[q][0] * 0.125f; LK[tl * 64 + lane] = in_[q][1];
            LAL[tl * 64 + lane] = __expf(-softplus_f(-in_[q][2]) * (1.0f / 16.0f)); LV[tl * 64 + lane] = in_[q][3]; }
        __syncthreads();
        if (c + 1 < TSEQ / 32) load_chunk(c + 1);
#pragma unroll 2
        for (int tl = 0; tl < 32; ++tl) {
            const int o = tl * 64 + ks * 8;
            const f32x4 a0 = *(const LAS f32x4*)(LAL + o), a1 = *(const LAS f32x4*)(LAL + o + 4);
            const f32x4 k0 = *(const LAS f32x4*)(LK + o), k1 = *(const LAS f32x4*)(LK + o + 4);
            const f32x4 q0 = *(const LAS f32x4*)(LQ + o), q1 = *(const LAS f32x4*)(LQ + o + 4);
            const float vv = LV[tl * 64 + col];
            S[0] = S[0] * a0.x + k0.x * vv; S[1] = S[1] * a0.y + k0.y * vv; S[2] = S[2] * a0.z + k0.z * vv; S[3] = S[3] * a0.w + k0.w * vv;
            S[4] = S[4] * a1.x + k1.x * vv; S[5] = S[5] * a1.y + k1.y * vv; S[6] = S[6] * a1.z + k1.z * vv; S[7] = S[7] * a1.w + k1.w * vv;
            float oo = ((S[0] * q0.x + S[1] * q0.y) + (S[2] * q0.z + S[3] * q0.w)) + ((S[4] * q1.x + S[5] * q1.y) + (S[6] * q1.z + S[7] * q1.w));
            oo = red8(oo);
            if (ks == 0) LO[tl * 64 + col] = oo;
        }
        __syncthreads();
#pragma unroll
        for (int q = 0; q < 4; ++q) { const int tl = w + 8 * q; const size_t n = (size_t)b * TSEQ + c * 32 + tl;
            go[n * 512 + h * 128 + chh * 64 + lane] = f2bf(LO[tl * 64 + lane]); }
    }
}

__device__ __forceinline__ void lru_task(const Args& a, Frame& F, int l, int task) {
    const WsMap m = ws_map(NTOK);
    const int b = task >> 3, cg = task & 7;
    LAS float* AP = (LAS float*)F.lds; LAS float* HL = AP + 512;
    const int lane = F.lane, w = F.wave;
    const int ch = cg * 64 + lane;
    const bf16_t* gt = (const bf16_t*)(a.ws + m.gates); const bf16_t* xc = (const bf16_t*)(a.ws + m.xc); const bf16_t* p16 = (const bf16_t*)(a.ws + m.p16);
    bf16_t* mix = (bf16_t*)(a.ws + m.mix16);
    const float sp8 = 8.0f * softplus_f(-a.in[I_LRU_LAM][l * 512 + ch]);
    const size_t nb = (size_t)b * TSEQ + (size_t)w * 512;
    float hh = 0.f, ap = 1.f;
#pragma unroll 8
    for (int t = 0; t < 512; ++t) { const size_t n = nb + t;
        const float la = -sp8 * sigm(bf2f(gt[n * 1024 + ch]));
        const float u = bf2f(xc[n * 512 + ch]) * sigm(bf2f(gt[n * 1024 + 512 + ch])) * sqrtf(-expm1f(2.0f * la));
        const float av = __expf(la);
        hh = av * hh + u; ap *= av; }
    AP[w * 64 + lane] = ap; HL[w * 64 + lane] = hh;
    __syncthreads();
    hh = 0.f;
    for (int s = 0; s < w; ++s) hh = AP[s * 64 + lane] * hh + HL[s * 64 + lane];
#pragma unroll 8
    for (int t = 0; t < 512; ++t) { const size_t n = nb + t;
        const float la = -sp8 * sigm(bf2f(gt[n * 1024 + ch]));
        const float u = bf2f(xc[n * 512 + ch]) * sigm(bf2f(gt[n * 1024 + 512 + ch])) * sqrtf(-expm1f(2.0f * la));
        hh = __expf(la) * hh + u;
        mix[n * DM + 1024 + ch] = f2bf(hh * gelu_fast(bf2f(p16[n * PLD + C_LRU + 512 + ch]))); }
}

__device__ __forceinline__ void scan_phase(const Args& a, Frame& F, int l) {
    const int task = blockIdx.x;
    if (task < 32) rwkv_task(a, F, l, task);
    else if (task < 96) gdn_task(a, F, l, task - 32);
    else if (task < 128) gla_task(a, F, l, task - 96);
    else if (task < 160) lru_task(a, F, l, task - 128);
}

__device__ __forceinline__ void post_phase(const Args& a, Frame& F, int l) {
    const WsMap m = ws_map(NTOK);
    const bf16_t* p16 = (const bf16_t*)(a.ws + m.p16); const bf16_t* glao = (const bf16_t*)(a.ws + m.glao); const bf16_t* gdno = (const bf16_t*)(a.ws + m.gdno);
    bf16_t* mix = (bf16_t*)(a.ws + m.mix16);
    const int lane = F.lane, col = lane * 8, hc = col & 127;
    float gg[8], gd[8];
    { const f32x4 x0 = *(const f32x4*)(a.in[I_GLA_NORM] + l * 128 + hc), x1 = *(const f32x4*)(a.in[I_GLA_NORM] + l * 128 + hc + 4);
      gg[0] = x0.x; gg[1] = x0.y; gg[2] = x0.z; gg[3] = x0.w; gg[4] = x1.x; gg[5] = x1.y; gg[6] = x1.z; gg[7] = x1.w;
      const f32x4 y0 = *(const f32x4*)(a.in[I_GDN_NORM] + l * 128 + hc), y1 = *(const f32x4*)(a.in[I_GDN_NORM] + l * 128 + hc + 4);
      gd[0] = y0.x; gd[1] = y0.y; gd[2] = y0.z; gd[3] = y0.w; gd[4] = y1.x; gd[5] = y1.y; gd[6] = y1.z; gd[7] = y1.w; }
    for (int n = F.gw; n < NTOK; n += F.ngw) {
#pragma unroll
        for (int which = 0; which < 2; ++which) {
            float o[8], g[8];
            unpack8(ld8((which ? gdno : glao) + (size_t)n * 512 + col), o);
            unpack8(ld8(p16 + (size_t)n * PLD + (which ? C_GDN + 1536 : C_GLA + 1024) + col), g);
            float ss = 0.f;
#pragma unroll
            for (int k = 0; k < 8; ++k) ss += o[k] * o[k];
            ss = row16_sum(ss);
            const float rs = 1.0f / sqrtf(ss * (1.0f / 128.0f) + 1e-6f);
#pragma unroll
            for (int k = 0; k < 8; ++k) o[k] = o[k] * rs * (which ? gd[k] : gg[k]) * (g[k] * sigm(g[k]));
            *(v4u*)(mix + (size_t)n * DM + (which ? 1536 : 512) + col) = pack8(o);
        }
    }
}

__device__ __forceinline__ void norm2_phase(const Args& a, Frame& F, int l) {
    const WsMap m = ws_map(NTOK);
    const float* gain = a.in[I_NORM_FFN] + l * DM;
    f32x4 gv[8];
#pragma unroll
    for (int j = 0; j < 8; ++j) gv[j] = ((const f32x4*)gain)[64 * j + F.lane];
    for (int n = F.gw; n < NTOK; n += F.ngw) {
        const f32x4* xr = (const f32x4*)(a.out + (size_t)n * DM) + F.lane;
        f32x4 v[8]; float s = 0.f;
#pragma unroll
        for (int j = 0; j < 8; ++j) { v[j] = xr[64 * j]; s += (v[j].x * v[j].x + v[j].y * v[j].y) + (v[j].z * v[j].z + v[j].w * v[j].w); }
        const float rstd = 1.0f / sqrtf(wave_sum_u(s) * (1.0f / DM) + 1e-6f);
        v2u* o8 = (v2u*)((bf16_t*)(a.ws + m.hb) + (size_t)n * DM) + F.lane;
#pragma unroll
        for (int j = 0; j < 8; ++j) { v2u w; w.x = pk2(v[j].x * rstd * gv[j].x, v[j].y * rstd * gv[j].y); w.y = pk2(v[j].z * rstd * gv[j].z, v[j].w * rstd * gv[j].w); o8[64 * j] = w; }
    }
}

#define TK_INSERT(XV, XI, TS, TI) do { float xv_ = (XV); int xi_ = (XI); if (xv_ > TS[15]) { _Pragma("unroll") for (int j_ = 0; j_ < 16; ++j_) { \
    if (xv_ > TS[j_]) { const float tv_ = TS[j_]; const int tj_ = TI[j_]; TS[j_] = xv_; TI[j_] = xi_; xv_ = tv_; xi_ = tj_; } } } } while (0)
__device__ __forceinline__ void topk_phase(const Args& a, Frame& F) {
    const WsMap m = ws_map(NTOK);
    const float* sc = (const float*)(a.ws + m.sc);
    int* idx = (int*)(a.ws + m.idx); float* gate = (float*)(a.ws + m.gate);
    LAS float* LS = (LAS float*)F.lds;
    LAS int* LI = (LAS int*)F.lds;
    const int t = F.tid;
    for (int it = F.vcu * NTHR + F.tid; it < NTOK * 8; it += F.G * NTHR) {
        const f32x4* s4 = (const f32x4*)(sc + (size_t)it * 256);
#pragma unroll 1
        for (int half = 0; half < 2; ++half) {
            float ts[16]; int ti[16];
#pragma unroll
            for (int j = 0; j < 16; ++j) { ts[j] = -3.0e38f; ti[j] = 0; }
#pragma unroll 1
            for (int i = 0; i < 32; ++i) { const f32x4 v = s4[half * 32 + i];
                TK_INSERT(v.x, 4 * i, ts, ti); TK_INSERT(v.y, 4 * i + 1, ts, ti); TK_INSERT(v.z, 4 * i + 2, ts, ti); TK_INSERT(v.w, 4 * i + 3, ts, ti); }
#pragma unroll
            for (int j = 0; j < 16; ++j) { LS[((half * 2 + 0) * 16 + j) * 512 + t] = ts[j]; LI[((half * 2 + 1) * 16 + j) * 512 + t] = ti[j]; }
        }
        float ts[16]; int ti[16];
#pragma unroll
        for (int j = 0; j < 16; ++j) { ts[j] = -3.0e38f; ti[j] = 0; }
#pragma unroll 1
        for (int p = 0; p < 16; ++p) {
            const float sp = LS[(0 * 16 + p) * 512 + t]; const int ip = LI[(1 * 16 + p) * 512 + t] * 128;
            const int qn = 16 / (p + 1);
#pragma unroll 1
            for (int q = 0; q < qn; ++q) { const float sq = LS[(2 * 16 + q) * 512 + t]; const int iq = LI[(3 * 16 + q) * 512 + t];
                TK_INSERT(sp + sq, ip + iq, ts, ti); }
        }
        const float mx = ts[0]; float den = 0.f;
#pragma unroll
        for (int j = 0; j < 16; ++j) { ts[j] = __expf(ts[j] - mx); den += ts[j]; }
        const float inv = 1.0f / den;
        f32x4* go = (f32x4*)(gate + (size_t)it * 16); v4u* io = (v4u*)(idx + (size_t)it * 16);
#pragma unroll
        for (int j = 0; j < 4; ++j) { go[j] = (f32x4){ts[4 * j] * inv, ts[4 * j + 1] * inv, ts[4 * j + 2] * inv, ts[4 * j + 3] * inv};
            io[j] = (v4u){(unsigned)ti[4 * j], (unsigned)ti[4 * j + 1], (unsigned)ti[4 * j + 2], (unsigned)ti[4 * j + 3]}; }
    }
}

__device__ __forceinline__ void peer_phase(const Args& a, Frame& F, int l) {
    const WsMap m = ws_map(NTOK);
    const bf16_t* TU = (const bf16_t*)(a.ws + m.tabu) + (size_t)l * 2 * NEXP * DM;
    const bf16_t* TV = TU + (size_t)NEXP * DM;
    const int* idx = (const int*)(a.ws + m.idx); const float* gate = (const float*)(a.ws + m.gate);
    const int lane = F.lane;
    for (int n = F.gw; n < NTOK; n += F.ngw) {
        v4u hx[4];
        { const v4u* hr = (const v4u*)((const bf16_t*)(a.ws + m.hb) + (size_t)n * DM) + lane;
#pragma unroll
          for (int c = 0; c < 4; ++c) hx[c] = hr[64 * c]; }
        const int e0 = idx[(size_t)n * 128 + lane], e1 = idx[(size_t)n * 128 + 64 + lane];
        const float g0 = gate[(size_t)n * 128 + lane], g1 = gate[(size_t)n * 128 + 64 + lane];
        float d0 = 0.f, d1 = 0.f;
#pragma unroll
        for (int half = 0; half < 2; ++half) {
            const int ev = half ? e1 : e0; float dd = 0.f;
            for (int j = 0; j < 64; j += 4) {
                v4u u[4][4];
#pragma unroll
                for (int r = 0; r < 4; ++r) { const int e = __builtin_amdgcn_readlane(ev, j + r);
                    const v4u* row = (const v4u*)(TU + (size_t)e * DM) + lane;
#pragma unroll
                    for (int c = 0; c < 4; ++c) u[r][c] = row[64 * c]; }
#pragma unroll
                for (int r = 0; r < 4; ++r) { float a0 = 0.f, a1 = 0.f;
#pragma unroll
                    for (int c = 0; c < 4; ++c) { a0 = dot2bf(u[r][c].x, hx[c].x, a0); a1 = dot2bf(u[r][c].y, hx[c].y, a1); a0 = dot2bf(u[r][c].z, hx[c].z, a0); a1 = dot2bf(u[r][c].w, hx[c].w, a1); }
                    const float t = wave_sum_u(a0 + a1);
                    dd = (lane == j + r) ? t : dd; }
            }
            if (half) d1 = dd; else d0 = dd;
        }
        const float c0 = gelu_fast(d0) * g0, c1 = gelu_fast(d1) * g1;
        float o[32];
#pragma unroll
        for (int i = 0; i < 32; ++i) o[i] = 0.f;
#pragma unroll
        for (int half = 0; half < 2; ++half) {
            const int ev = half ? e1 : e0; const float cv = half ? c1 : c0;
            for (int j = 0; j < 64; j += 4) {
                v4u v[4][4]; float cj[4];
#pragma unroll
                for (int r = 0; r < 4; ++r) { const int e = __builtin_amdgcn_readlane(ev, j + r); cj[r] = __builtin_bit_cast(float, __builtin_amdgcn_readlane(__builtin_bit_cast(int, cv), j + r));
                    const v4u* row = (const v4u*)(TV + (size_t)e * DM) + lane;
#pragma unroll
                    for (int c = 0; c < 4; ++c) v[r][c] = row[64 * c]; }
#pragma unroll
                for (int r = 0; r < 4; ++r)
#pragma unroll
                    for (int c = 0; c < 4; ++c) {
                        o[c * 8 + 0] += cj[r] * bflo(v[r][c].x); o[c * 8 + 1] += cj[r] * bfhi(v[r][c].x);
                        o[c * 8 + 2] += cj[r] * bflo(v[r][c].y); o[c * 8 + 3] += cj[r] * bfhi(v[r][c].y);
                        o[c * 8 + 4] += cj[r] * bflo(v[r][c].z); o[c * 8 + 5] += cj[r] * bfhi(v[r][c].z);
                        o[c * 8 + 6] += cj[r] * bflo(v[r][c].w); o[c * 8 + 7] += cj[r] * bfhi(v[r][c].w); }
            }
        }
        float* xrow = a.out + (size_t)n * DM;
        float s = 0.f;
#pragma unroll
        for (int c = 0; c < 4; ++c) { const f32x4 x0 = *(const f32x4*)(xrow + c * 512 + lane * 8), x1 = *(const f32x4*)(xrow + c * 512 + lane * 8 + 4);
            o[c * 8 + 0] += x0.x; o[c * 8 + 1] += x0.y; o[c * 8 + 2] += x0.z; o[c * 8 + 3] += x0.w; o[c * 8 + 4] += x1.x; o[c * 8 + 5] += x1.y; o[c * 8 + 6] += x1.z; o[c * 8 + 7] += x1.w;
#pragma unroll
            for (int k = 0; k < 8; ++k) s += o[c * 8 + k] * o[c * 8 + k]; }
        const float rstd = 1.0f / sqrtf(wave_sum_u(s) * (1.0f / DM) + 1e-6f);
        if (l + 1 < NL) {
            bf16_t* xo = (bf16_t*)(a.ws + m.xn) + (size_t)n * DM;
#pragma unroll
            for (int c = 0; c < 4; ++c) { *(f32x4*)(xrow + c * 512 + lane * 8) = (f32x4){o[c * 8], o[c * 8 + 1], o[c * 8 + 2], o[c * 8 + 3]};
                *(f32x4*)(xrow + c * 512 + lane * 8 + 4) = (f32x4){o[c * 8 + 4], o[c * 8 + 5], o[c * 8 + 6], o[c * 8 + 7]};
                v4u w; w.x = pk2(o[c * 8] * rstd, o[c * 8 + 1] * rstd); w.y = pk2(o[c * 8 + 2] * rstd, o[c * 8 + 3] * rstd); w.z = pk2(o[c * 8 + 4] * rstd, o[c * 8 + 5] * rstd); w.w = pk2(o[c * 8 + 6] * rstd, o[c * 8 + 7] * rstd);
                *(v4u*)(xo + c * 512 + lane * 8) = w; }
        } else {
            const float* gf = a.in[I_NORM_FINAL];
#pragma unroll
            for (int c = 0; c < 4; ++c) { const f32x4 g0v = *(const f32x4*)(gf + c * 512 + lane * 8), g1v = *(const f32x4*)(gf + c * 512 + lane * 8 + 4);
                *(f32x4*)(xrow + c * 512 + lane * 8) = (f32x4){o[c * 8] * rstd * g0v.x, o[c * 8 + 1] * rstd * g0v.y, o[c * 8 + 2] * rstd * g0v.z, o[c * 8 + 3] * rstd * g0v.w};
                *(f32x4*)(xrow + c * 512 + lane * 8 + 4) = (f32x4){o[c * 8 + 4] * rstd * g1v.x, o[c * 8 + 5] * rstd * g1v.y, o[c * 8 + 6] * rstd * g1v.z, o[c * 8 + 7] * rstd * g1v.w}; }
        }
    }
}

#define IN(k) (lo <= (k) && (k) < hi)
#define SEAM(k) do { if (IN(k) && IN((k) + 1)) xcd_barrier(bar); } while (0)
template <int l>
__device__ __forceinline__ void layer_phases(const Args& a, Frame& F, const XcdBarrier& bar, const WsMap& m, int lo, int hi) {
    constexpr int pb = l * PH_PER_LAYER;
        if (IN(pb + PH_GEMM1)) {
            pg8::GemmX g{(const bf16_t*)(a.ws + m.xn), (const bf16_t*)(a.ws + m.w1t) + (size_t)l * PLD * DM, NTOK, PLD, DM, DM};
            pg8::StaticOrder S; S.init(NTOK, PLD, F.G, (int)blockIdx.x);
            pg8::EpiBf16 E{(bf16_t*)(a.ws + m.p16), PLD, nullptr};
            pg8::gemm_phase<pg8::EpiBf16, pg8::StaticOrder, true, true>(F.lds, g, S, E);
            SEAM(pb + PH_GEMM1);
        }
        if (IN(pb + PH_PREP)) { prep_phase(a, F, l); SEAM(pb + PH_PREP); }
        if (IN(pb + PH_AUX)) {
            const float* PP = (const float*)(a.ws + m.pp);
            { pg8::GemmX g{(const bf16_t*)(a.ws + m.auxA), (const bf16_t*)(a.ws + m.auxwt) + (size_t)l * 1792 * 384, NTOK, 1792, 384, 384};
              pg8::StaticOrder S; S.init(NTOK, 1792, F.G, (int)blockIdx.x);
              pg8::EpiBf16 E{(bf16_t*)(a.ws + m.auxo), 1792, PP + l * 1792};
              pg8::gemm_phase<pg8::EpiBf16, pg8::StaticOrder, true, true>(F.lds, g, S, E); }
            { pg8::GemmX g{(const bf16_t*)(a.ws + m.xc), (const bf16_t*)(a.ws + m.lruwt) + (size_t)l * 1024 * 512, NTOK, 1024, 512, 512};
              pg8::StaticOrder S; S.init(NTOK, 1024, F.G, (int)blockIdx.x);
              pg8::EpiBf16 E{(bf16_t*)(a.ws + m.gates), 1024, PP + 3584 + l * 1024};
              pg8::gemm_phase<pg8::EpiBf16, pg8::StaticOrder, true, true>(F.lds, g, S, E); }
            if (l > 0) {
              pg8::GemmX g{(const bf16_t*)(a.ws + m.zrkv) + 1024, (const bf16_t*)(a.ws + m.vreswt), NTOK, 512, 512, 1536};
              pg8::StaticOrder S; S.init(NTOK, 512, F.G, (int)blockIdx.x);
              pg8::EpiBf16 E{(bf16_t*)(a.ws + m.vres), 512, PP + 5632};
              pg8::gemm_phase<pg8::EpiBf16, pg8::StaticOrder, true, true>(F.lds, g, S, E); }
            SEAM(pb + PH_AUX);
        }
        if (IN(pb + PH_SCAN)) { scan_phase(a, F, l); SEAM(pb + PH_SCAN); }
        if (IN(pb + PH_POST)) { post_phase(a, F, l); SEAM(pb + PH_POST); }
        if (IN(pb + PH_GEMM2)) {
            pg8::GemmX g{(const bf16_t*)(a.ws + m.mix16), (const bf16_t*)(a.ws + m.w2t) + (size_t)l * DM * DM, NTOK, DM, DM, DM};
            pg8::StaticOrder S; S.init(NTOK, DM, F.G, (int)blockIdx.x);
            pg8::EpiF32<true> E{a.out, DM};
            pg8::gemm_phase<pg8::EpiF32<true>, pg8::StaticOrder, true, true>(F.lds, g, S, E);
            SEAM(pb + PH_GEMM2);
        }
        if (IN(pb + PH_NORM2)) { norm2_phase(a, F, l); SEAM(pb + PH_NORM2); }
        if (IN(pb + PH_GEMM3)) {
            pg8::GemmX g{(const bf16_t*)(a.ws + m.hb), (const bf16_t*)(a.ws + m.wsct) + (size_t)l * DM * DM, NTOK, DM, DM, DM};
            pg8::StaticOrder S; S.init(NTOK, DM, F.G, (int)blockIdx.x);
            pg8::EpiF32<false> E{(float*)(a.ws + m.sc), DM};
            pg8::gemm_phase<pg8::EpiF32<false>, pg8::StaticOrder, true, true>(F.lds, g, S, E);
            SEAM(pb + PH_GEMM3);
        }
        if (IN(pb + PH_TOPK)) { topk_phase(a, F); SEAM(pb + PH_TOPK); }
        if (IN(pb + PH_PEER)) { peer_phase(a, F, l); SEAM(pb + PH_PEER); }
}

#undef IN
#undef SEAM
__global__ void __launch_bounds__(NTHR, 2) mega(Args a) {
    extern __shared__ __attribute__((aligned(16))) unsigned char lds_raw[];
    Frame F;
    F.lds = (LAS unsigned char*)lds_raw;
    F.tid = threadIdx.x; F.lane = F.tid & 63; F.wave = __builtin_amdgcn_readfirstlane(F.tid >> 6);
    F.G = gridDim.x; { const int bx = blockIdx.x; F.vcu = (F.G % 8 == 0) ? (bx % 8) * (F.G / 8) + bx / 8 : bx; }
    F.gw = F.vcu * NWAVES + F.wave; F.ngw = F.G * NWAVES;
    volatile LAS unsigned* MISC = (volatile LAS unsigned*)(F.lds + MISC_OFF);
    if (F.tid < 32) MISC[F.tid] = 0u;
    __syncthreads();
    const WsMap m = ws_map(NTOK);
    unsigned* ctl = (unsigned*)(a.ws + m.ctl);
    XcdBarrier bar; bar.bar = ctl + 4096 + a.li * XCD_BAR_WORDS; bar.x = 0; bar.st = nullptr;
    const int lo = a.ph_lo, hi = a.ph_hi;
    if (hi - lo > 1) bar = xcd_barrier_post(ctl + 4096 + a.li * XCD_BAR_WORDS, MISC + 8);
#define IN(k) (lo <= (k) && (k) < hi)
#define SEAM(k) do { if (IN(k) && IN((k) + 1)) xcd_barrier(bar); } while (0)
    if (IN(PH_P0)) { p0_prologue(a, F); tables_phase(a, F, 0, NL); SEAM(PH_P0); }
    if (lo >= 100) { tables_phase(a, F, lo - 100, hi - 100); }
    layer_phases<0>(a, F, bar, m, lo, hi);
    layer_phases<1>(a, F, bar, m, lo, hi);
#undef IN
#undef SEAM
}

template <int ST>
__global__ void __launch_bounds__(256) stage_kernel(Params P, int l) {
    const long n = stage_items(P, ST, l);
    for (long it = blockIdx.x * 256L + threadIdx.x; it < n; it += gridDim.x * 256L) run_item(P, ST, l, it);
}
template <int ST>
static void launch_stage(const Params& P, int l, hipStream_t stream) {
    const long n = stage_items(P, ST, l);
    if (n <= 0) return;
    long blocks = (n + 255) / 256;
    if (blocks > 8192) blocks = 8192;
    stage_kernel<ST><<<dim3((unsigned)blocks), dim3(256), 0, stream>>>(P, l);
}
#define LS(X) case X: launch_stage<X>(P, l, stream); break;
static void launch_any(int st, const Params& P, int l, hipStream_t stream) {
    switch (st) {
        LS(ST_COPYX) LS(ST_RSTD) LS(ST_NORM1) LS(ST_GEMM1) LS(ST_RW_A0) LS(ST_RW_A1) LS(ST_RW_A2) LS(ST_RW_A3) LS(ST_RW_KKN)
        LS(ST_RW_SCAN) LS(ST_RW_POST) LS(ST_GLA_B0) LS(ST_GLA_SCAN) LS(ST_GLA_POST) LS(ST_LRU_C0) LS(ST_LRU_C1) LS(ST_LRU_SCAN)
        LS(ST_GDN_D0) LS(ST_GDN_D1) LS(ST_GDN_SCAN) LS(ST_GDN_POST) LS(ST_GEMM2) LS(ST_RSTD2) LS(ST_NORM2) LS(ST_GEMM3)
        LS(ST_SCORES) LS(ST_TOPK1) LS(ST_TOPK2) LS(ST_PEER_U) LS(ST_PEER_V) LS(ST_FRSTD) LS(ST_FNORM)
    }
}

extern "C" void kernel_launch(void* const* d_in, const int* in_sizes, int n_in, void* d_out, int out_size, void* d_ws,
                              size_t ws_size, hipStream_t stream) {
    static int grid = 0;
    if (grid == 0) {
        int dev = 0, cus = 0;
        (void)hipGetDevice(&dev);
        (void)hipDeviceGetAttribute(&cus, hipDeviceAttributeMultiprocessorCount, dev);
        (void)hipFuncSetAttribute((const void*)mega, hipFuncAttributeMaxDynamicSharedMemorySize, LDS_BYTES);
        grid = cus > 0 ? cus : 256;
    }
    Params P;
    memset(&P, 0, sizeof(P));
    fill_inputs(P, d_in);
    P.B = 4; P.T = 4096; P.N = 16384; P.pad = 0;
    P.xcur = (float*)d_out;
    bind_ws(P, (char*)d_ws);
    Args a;
    memset(&a, 0, sizeof(a));
    for (int i = 0; i < 38; ++i) a.in[i] = (const float*)d_in[i];
    a.out = (float*)d_out; a.ws = (unsigned char*)d_ws;
    (void)hipMemsetAsync(d_ws, 0, 1u << 20, stream);
    int li = 0;
    auto run_mega = [&](int lo, int hi) { a.ph_lo = lo; a.ph_hi = hi; a.li = li++; hipLaunchKernelGGL(mega, dim3(grid), dim3(NTHR), LDS_BYTES, stream, a); };
    run_mega(PH_P0, PH_TOTAL);
}
#endif
```

```cpp
#ifndef HOST_EMU
#include <hip/hip_runtime.h>
#include <cstring>
#define HD __host__ __device__ __forceinline__
#else
#include <cmath>
#include <cstdio>
#include <cstdlib>
#include <cstring>
#define HD inline
#endif

constexpr int DM = 2048;
constexpr int NL = 2;
constexpr int INC = 6424;
constexpr int C_RW = 0;
constexpr int C_GLA = 1792;
constexpr int C_LRU = 3344;
constexpr int C_GDN = 4368;
constexpr int NEXP = 16384;

typedef unsigned short bf16_t;
constexpr int PLD = 6656;
HD float bf2f(bf16_t h) { unsigned u = (unsigned)h << 16; float f; memcpy(&f, &u, 4); return f; }
HD bf16_t f2bf(float f) { unsigned u; memcpy(&u, &f, 4); return (bf16_t)((u + 0x7fffu + ((u >> 16) & 1u)) >> 16); }

struct Params {
    const float *x, *norm_mix, *w_in, *w_out, *rw_mu, *rw_w0, *rw_w_up, *rw_a0, *rw_a_up, *rw_g_up, *rw_k_k, *rw_k_a,
        *rw_r_k, *rw_ln_w, *rw_ln_b, *rw_v0, *rw_v_down, *rw_v_up, *gla_a_up, *gla_a_bias, *gla_norm, *lru_conv_w,
        *lru_conv_b, *lru_w_r, *lru_b_r, *lru_w_i, *lru_b_i, *lru_lam, *gdn_conv_w, *gdn_a_log, *gdn_dt_bias, *gdn_norm,
        *norm_ffn, *peer_wq, *peer_sub_keys, *peer_u, *peer_v, *norm_final;
    float* xcur;
    bf16_t* xn;
    bf16_t* hb;
    bf16_t* mix16;
    bf16_t* p16;
    float* sc;
    float* qf;
    float* rstd;
    float* vfirst;
    float* scr;
    float* act;
    float* gate;
    int* idx;
    int B, T, N, pad;
};

HD float sigmoidf_(float x) { return 1.0f / (1.0f + expf(-x)); }
HD float softplusf_(float x) { return log1pf(expf(-fabsf(x))) + fmaxf(x, 0.0f); }
HD float siluf_(float x) { return x * sigmoidf_(x); }
HD float geluf_(float x) { return 0.5f * x * (1.0f + tanhf(0.7978845608028654f * (x + 0.044715f * x * x * x))); }

enum Stage {
    ST_COPYX = 0,
    ST_RSTD, ST_NORM1, ST_GEMM1,
    ST_RW_A0, ST_RW_A1, ST_RW_A2, ST_RW_A3, ST_RW_KKN, ST_RW_SCAN, ST_RW_POST,
    ST_GLA_B0, ST_GLA_SCAN, ST_GLA_POST,
    ST_LRU_C0, ST_LRU_C1, ST_LRU_SCAN,
    ST_GDN_D0, ST_GDN_D1, ST_GDN_SCAN, ST_GDN_POST,
    ST_GEMM2, ST_RSTD2, ST_NORM2, ST_GEMM3, ST_SCORES, ST_TOPK1, ST_TOPK2, ST_PEER_U, ST_PEER_V,
    ST_FRSTD, ST_FNORM,
    ST_COUNT
};

constexpr long SO_ZS = 0, SO_R = 256, SO_DEC = 768, SO_KM = 1280, SO_KK = 1792, SO_A = 2304, SO_G = 2816, SO_V = 3328,
               SO_Y = 3840, SO_VD = 4352, SO_KKINV = 4384;
constexpr long SO_ALPHA = 0, SO_GO = 256;
constexpr long SO_XC = 0, SO_LA = 512, SO_LU = 1024;
constexpr long SO_QKV = 0, SO_GS = 1536, SO_DO = 1552;
constexpr long SCR_PER_TOK = 4400;
constexpr long SO_TS = 0, SO_TI = 256;

HD long stage_items(const Params& P, int st, int l) {
    const long N = P.N;
    switch (st) {
        case ST_COPYX: return N * DM;
        case ST_RSTD: case ST_RSTD2: case ST_FRSTD: return N;
        case ST_NORM1: case ST_NORM2: case ST_FNORM: return N * DM;
        case ST_GEMM1: return (N / 4) * (INC / 4);
        case ST_RW_A0: return N * 256;
        case ST_RW_A1: return N * 512;
        case ST_RW_A2: return l > 0 ? N * 32 : 0;
        case ST_RW_A3: return l > 0 ? N * 512 : 0;
        case ST_RW_KKN: return N * 8;
        case ST_RW_SCAN: return (long)P.B * 512;
        case ST_RW_POST: return N * 8;
        case ST_GLA_B0: return N * 256;
        case ST_GLA_SCAN: return (long)P.B * 512;
        case ST_GLA_POST: return N * 4;
        case ST_LRU_C0: return N * 512;
        case ST_LRU_C1: return N * 512;
        case ST_LRU_SCAN: return (long)P.B * 512;
        case ST_GDN_D0: return N * 1536;
        case ST_GDN_D1: return N * 4;
        case ST_GDN_SCAN: return (long)P.B * 512;
        case ST_GDN_POST: return N * 4;
        case ST_GEMM2: case ST_GEMM3: return (N / 4) * (DM / 4);
        case ST_SCORES: return N * 2048;
        case ST_TOPK1: return N * 16;
        case ST_TOPK2: return N * 8;
        case ST_PEER_U: return N * 128;
        case ST_PEER_V: return N * DM;
    }
    return 0;
}

HD void gemm_item(const bf16_t* A, const float* W, int ldw, const float* kscale, float* Cf, bf16_t* Ch, int ldc, int n4, long item, int mode) {
    const long r4 = item / n4;
    const int c4 = (int)(item % n4);
    const bf16_t* a0 = A + (r4 * 4) * (long)DM;
    const float* w = W + c4 * 4;
    float acc[4][4];
    for (int i = 0; i < 4; ++i)
        for (int j = 0; j < 4; ++j) acc[i][j] = 0.f;
    for (int k = 0; k < DM; ++k) {
        const float ks = kscale ? kscale[k] : 1.0f;
        const float w0 = w[(long)k * ldw + 0] * ks, w1 = w[(long)k * ldw + 1] * ks, w2 = w[(long)k * ldw + 2] * ks, w3 = w[(long)k * ldw + 3] * ks;
#pragma unroll
        for (int i = 0; i < 4; ++i) {
            const float a = bf2f(a0[(long)i * DM + k]);
            acc[i][0] += a * w0; acc[i][1] += a * w1; acc[i][2] += a * w2; acc[i][3] += a * w3;
        }
    }
#pragma unroll
    for (int i = 0; i < 4; ++i) {
        const long o = (r4 * 4 + i) * (long)ldc + c4 * 4;
#pragma unroll
        for (int j = 0; j < 4; ++j) {
            if (mode == 0) Ch[o + j] = f2bf(acc[i][j]);
            else if (mode == 1) Cf[o + j] += acc[i][j];
            else Cf[o + j] = acc[i][j];
        }
    }
}

#define PF(n, col) bf2f(P.p16[(long)(n) * PLD + (col)])
HD float rw_shift(const Params& P, int l, long n, int col) {
    const int t = (int)(n % P.T);
    const float cur = PF(n, C_RW + col);
    const float prev = t > 0 ? PF(n - 1, C_RW + col) : 0.f;
    return cur + (prev - cur) * P.rw_mu[l * 1792 + col];
}

HD void run_item(const Params& P, int st, int l, long it) {
    const long N = P.N;
    float* scr = P.scr;
    switch (st) {
        case ST_COPYX: P.xcur[it] = P.x[it]; break;
        case ST_RSTD: case ST_RSTD2: case ST_FRSTD: {
            const float* xr = P.xcur + it * DM;
            float s = 0.f;
            for (int d = 0; d < DM; ++d) s += xr[d] * xr[d];
            P.rstd[it] = 1.0f / sqrtf(s * (1.0f / DM) + 1e-6f);
        } break;
        case ST_NORM1: case ST_NORM2: case ST_FNORM: {
            const long n = it / DM; const int d = (int)(it % DM);
            if (st == ST_NORM1) P.xn[it] = f2bf(P.xcur[it] * P.rstd[n]);
            else if (st == ST_NORM2) P.hb[it] = f2bf(P.xcur[it] * P.rstd[n] * P.norm_ffn[l * DM + d]);
            else P.xcur[it] = P.xcur[it] * P.rstd[n] * P.norm_final[d];
        } break;
        case ST_GEMM1: gemm_item(P.xn, P.w_in + (long)l * DM * INC, INC, P.norm_mix + l * DM, nullptr, P.p16, PLD, INC / 4, it, 0); break;
        case ST_GEMM2: gemm_item(P.mix16, P.w_out + (long)l * DM * DM, DM, nullptr, P.xcur, nullptr, DM, DM / 4, it, 1); break;
        case ST_GEMM3: gemm_item(P.hb, P.peer_wq + (long)l * DM * DM, DM, nullptr, P.qf, nullptr, DM, DM / 4, it, 2); break;
        case ST_RW_A0: {
            const long n = it / 256; const int c = (int)(it % 256);
            const float z = rw_shift(P, l, n, 1536 + c);
            scr[N * SO_ZS + it] = c < 64 ? tanhf(z) : (c < 128 ? z : sigmoidf_(z));
        } break;
        case ST_RW_A1: {
            const long n = it / 512; const int j = (int)(it % 512);
            const float zr = rw_shift(P, l, n, j), zk = rw_shift(P, l, n, 512 + j), zv = rw_shift(P, l, n, 1024 + j);
            const float* zs = scr + N * SO_ZS + n * 256;
            float aw = P.rw_w0[l * 512 + j], aa = P.rw_a0[l * 512 + j], ag = 0.f;
            const float* wu = P.rw_w_up + (long)l * 64 * 512 + j;
            const float* au = P.rw_a_up + (long)l * 64 * 512 + j;
            const float* gu = P.rw_g_up + (long)l * 128 * 512 + j;
            for (int i = 0; i < 64; ++i) { aw += zs[i] * wu[i * 512]; aa += zs[64 + i] * au[i * 512]; }
            for (int i = 0; i < 128; ++i) ag += zs[128 + i] * gu[i * 512];
            const float w_raw = -softplusf_(-aw) - 0.5f;
            const float a = sigmoidf_(aa);
            scr[N * SO_R + it] = zr;
            scr[N * SO_DEC + it] = expf(-expf(w_raw));
            scr[N * SO_KM + it] = zk * (1.0f + (a - 1.0f) * P.rw_k_a[l * 512 + j]);
            scr[N * SO_KK + it] = zk * P.rw_k_k[l * 512 + j];
            scr[N * SO_A + it] = a;
            scr[N * SO_G + it] = ag;
            scr[N * SO_V + it] = zv;
            if (l == 0) P.vfirst[it] = zv;
        } break;
        case ST_RW_A2: {
            const long n = it / 32; const int i = (int)(it % 32);
            const float* v = scr + N * SO_V + n * 512;
            const float* vdn = P.rw_v_down + (long)(l - 1) * 512 * 32 + i;
            float s = 0.f;
            for (int j = 0; j < 512; ++j) s += v[j] * vdn[j * 32];
            scr[N * SO_VD + it] = s;
        } break;
        case ST_RW_A3: {
            const long n = it / 512; const int j = (int)(it % 512);
            const float* vd = scr + N * SO_VD + n * 32;
            const float* vup = P.rw_v_up + (long)(l - 1) * 32 * 512 + j;
            float s = P.rw_v0[(l - 1) * 512 + j];
            for (int i = 0; i < 32; ++i) s += vd[i] * vup[i * 512];
            const float v = scr[N * SO_V + it];
            scr[N * SO_V + it] = v + (P.vfirst[it] - v) * sigmoidf_(s);
        } break;
        case ST_RW_KKN: {
            const float* kk = scr + N * SO_KK + it * 64;
            float s = 0.f;
            for (int i = 0; i < 64; ++i) s += kk[i] * kk[i];
            scr[N * SO_KKINV + it] = 1.0f / sqrtf(fmaxf(s, 1e-24f));
        } break;
        case ST_RW_SCAN: {
            const int b = (int)(it / 512); const int h = (int)((it % 512) / 64); const int v = (int)(it % 64);
            float S[64];
#pragma unroll
            for (int i = 0; i < 64; ++i) S[i] = 0.f;
            for (int t = 0; t < P.T; ++t) {
                const long n = (long)b * P.T + t;
                const long base = n * 512 + h * 64;
                const float inv = scr[N * SO_KKINV + n * 8 + h];
                const float vv = scr[N * SO_V + base + v];
                const float* KK = scr + N * SO_KK + base;
                const float* DEC = scr + N * SO_DEC + base;
                const float* KM = scr + N * SO_KM + base;
                const float* AA = scr + N * SO_A + base;
                const float* RR = scr + N * SO_R + base;
                float sa = 0.f;
#pragma unroll
                for (int i = 0; i < 64; ++i) sa += S[i] * (-KK[i] * inv);
                float y = 0.f;
#pragma unroll
                for (int i = 0; i < 64; ++i) {
                    const float kk = KK[i] * inv;
                    S[i] = S[i] * DEC[i] + sa * (kk * AA[i]) + vv * KM[i];
                    y += S[i] * RR[i];
                }
                scr[N * SO_Y + base + v] = y;
            }
        } break;
        case ST_RW_POST: {
            const long n = it / 8; const int h = (int)(it % 8);
            const long base = n * 512 + h * 64;
            const float* Y = scr + N * SO_Y + base;
            const float* RR = scr + N * SO_R + base;
            const float* KM = scr + N * SO_KM + base;
            const float* V = scr + N * SO_V + base;
            const float* G = scr + N * SO_G + base;
            float mean = 0.f, bon = 0.f;
            for (int i = 0; i < 64; ++i) { mean += Y[i]; bon += RR[i] * KM[i] * P.rw_r_k[l * 512 + h * 64 + i]; }
            mean *= (1.0f / 64);
            float var = 0.f;
            for (int i = 0; i < 64; ++i) { const float d = Y[i] - mean; var += d * d; }
            const float rs = 1.0f / sqrtf(var * (1.0f / 64) + 64e-5f);
            for (int i = 0; i < 64; ++i) {
                const int c = h * 64 + i;
                const float yn = (Y[i] - mean) * rs * P.rw_ln_w[l * 512 + c] + P.rw_ln_b[l * 512 + c];
                P.mix16[n * DM + c] = f2bf((yn + bon * V[i]) * G[i]);
            }
        } break;
        case ST_GLA_B0: {
            const long n = it / 256; const int c = (int)(it % 256);
            float s = P.gla_a_bias[l * 256 + c];
            for (int i = 0; i < 16; ++i) s += PF(n, C_GLA + 1536 + i) * P.gla_a_up[(long)l * 16 * 256 + i * 256 + c];
            scr[N * SO_ALPHA + it] = expf(-softplusf_(-s) * (1.0f / 16.0f));
        } break;
        case ST_GLA_SCAN: {
            const int b = (int)(it / 512); const int h = (int)((it % 512) / 128); const int v = (int)(it % 128);
            float S[64];
#pragma unroll
            for (int i = 0; i < 64; ++i) S[i] = 0.f;
            for (int t = 0; t < P.T; ++t) {
                const long n = (long)b * P.T + t;
                const bf16_t* q = P.p16 + n * PLD + C_GLA + h * 64;
                const bf16_t* k = q + 256;
                const float vv = PF(n, C_GLA + 512 + h * 128 + v);
                const float* al = scr + N * SO_ALPHA + n * 256 + h * 64;
                float o = 0.f;
#pragma unroll
                for (int i = 0; i < 64; ++i) {
                    S[i] = S[i] * al[i] + bf2f(k[i]) * vv;
                    o += bf2f(q[i]) * S[i];
                }
                scr[N * SO_GO + n * 512 + h * 128 + v] = o * 0.125f;
            }
        } break;
        case ST_GLA_POST: {
            const long n = it / 4; const int h = (int)(it % 4);
            const float* o = scr + N * SO_GO + n * 512 + h * 128;
            float ms = 0.f;
            for (int i = 0; i < 128; ++i) ms += o[i] * o[i];
            const float rs = 1.0f / sqrtf(ms * (1.0f / 128) + 1e-6f);
            for (int i = 0; i < 128; ++i) {
                const float g = PF(n, C_GLA + 1024 + h * 128 + i);
                P.mix16[n * DM + 512 + h * 128 + i] = f2bf(o[i] * rs * P.gla_norm[l * 128 + i] * siluf_(g));
            }
        } break;
        case ST_LRU_C0: {
            const long n = it / 512; const int c = (int)(it % 512);
            const int t = (int)(n % P.T);
            float s = P.lru_conv_b[l * 512 + c];
            for (int j = 0; j < 4; ++j) {
                const int tt = t - 3 + j;
                if (tt >= 0) s += P.lru_conv_w[(long)l * 4 * 512 + j * 512 + c] * PF(n - 3 + j, C_LRU + c);
            }
            scr[N * SO_XC + it] = s;
        } break;
        case ST_LRU_C1: {
            const long n = it / 512; const int c = (int)(it % 512);
            const int blk = c / 64, j = c % 64;
            const float* xc = scr + N * SO_XC + n * 512 + blk * 64;
            const float* wr = P.lru_w_r + (long)l * 8 * 64 * 64 + (long)blk * 64 * 64 + j;
            const float* wi = P.lru_w_i + (long)l * 8 * 64 * 64 + (long)blk * 64 * 64 + j;
            float sr = P.lru_b_r[l * 512 + c], si = P.lru_b_i[l * 512 + c];
            for (int i = 0; i < 64; ++i) { sr += xc[i] * wr[i * 64]; si += xc[i] * wi[i * 64]; }
            const float r = sigmoidf_(sr), ig = sigmoidf_(si);
            const float log_a = -8.0f * r * softplusf_(-P.lru_lam[l * 512 + c]);
            scr[N * SO_LA + it] = expf(log_a);
            scr[N * SO_LU + it] = scr[N * SO_XC + it] * ig * sqrtf(-expm1f(2.0f * log_a));
        } break;
        case ST_LRU_SCAN: {
            const int b = (int)(it / 512); const int c = (int)(it % 512);
            float hst = 0.f;
            for (int t = 0; t < P.T; ++t) {
                const long n = (long)b * P.T + t;
                hst = scr[N * SO_LA + n * 512 + c] * hst + scr[N * SO_LU + n * 512 + c];
                P.mix16[n * DM + 1024 + c] = f2bf(hst * geluf_(PF(n, C_LRU + 512 + c)));
            }
        } break;
        case ST_GDN_D0: {
            const long n = it / 1536; const int c = (int)(it % 1536);
            const int t = (int)(n % P.T);
            float s = 0.f;
            for (int j = 0; j < 4; ++j) {
                const int tt = t - 3 + j;
                if (tt >= 0) s += P.gdn_conv_w[(long)l * 4 * 1536 + j * 1536 + c] * PF(n - 3 + j, C_GDN + c);
            }
            scr[N * SO_QKV + it] = siluf_(s);
        } break;
        case ST_GDN_D1: {
            const long n = it / 4; const int h = (int)(it % 4);
            const float* q = scr + N * SO_QKV + n * 1536 + h * 128;
            const float* k = q + 512;
            float qs = 0.f, ks = 0.f;
            for (int i = 0; i < 128; ++i) { qs += q[i] * q[i]; ks += k[i] * k[i]; }
            float* gs = scr + N * SO_GS + n * 16 + h * 4;
            gs[0] = (1.0f / sqrtf(qs + 1e-6f)) * 0.08838834764831845f;
            gs[1] = 1.0f / sqrtf(ks + 1e-6f);
            gs[2] = sigmoidf_(PF(n, C_GDN + 2048 + h));
            gs[3] = expf(-expf(P.gdn_a_log[l * 4 + h]) * softplusf_(PF(n, C_GDN + 2052 + h) + P.gdn_dt_bias[l * 4 + h]));
        } break;
        case ST_GDN_SCAN: {
            const int b = (int)(it / 512); const int h = (int)((it % 512) / 128); const int v = (int)(it % 128);
            float S[128];
#pragma unroll
            for (int i = 0; i < 128; ++i) S[i] = 0.f;
            for (int t = 0; t < P.T; ++t) {
                const long n = (long)b * P.T + t;
                const float* q = scr + N * SO_QKV + n * 1536 + h * 128;
                const float* k = q + 512;
                const float vv = scr[N * SO_QKV + n * 1536 + 1024 + h * 128 + v];
                const float* gs = scr + N * SO_GS + n * 16 + h * 4;
                const float qinv = gs[0], kinv = gs[1], beta = gs[2], eg = gs[3];
                float dk = 0.f;
#pragma unroll
                for (int i = 0; i < 128; ++i) dk += S[i] * k[i];
                const float u = beta * (vv - eg * kinv * dk) * kinv;
                float o = 0.f;
#pragma unroll
                for (int i = 0; i < 128; ++i) {
                    S[i] = S[i] * eg + u * k[i];
                    o += S[i] * q[i];
                }
                scr[N * SO_DO + n * 512 + h * 128 + v] = o * qinv;
            }
        } break;
        case ST_GDN_POST: {
            const long n = it / 4; const int h = (int)(it % 4);
            const float* o = scr + N * SO_DO + n * 512 + h * 128;
            float ms = 0.f;
            for (int i = 0; i < 128; ++i) ms += o[i] * o[i];
            const float rs = 1.0f / sqrtf(ms * (1.0f / 128) + 1e-6f);
            for (int i = 0; i < 128; ++i) {
                const float z = PF(n, C_GDN + 1536 + h * 128 + i);
                P.mix16[n * DM + 1536 + h * 128 + i] = f2bf(o[i] * rs * P.gdn_norm[l * 128 + i] * siluf_(z));
            }
        } break;
        case ST_SCORES: {
            const long n = it / 2048; const int c = (int)(it % 2048);
            const int hp = c / 128, key = c % 128;
            const float* q = P.qf + n * DM + hp * 128;
            const float* sk = P.peer_sub_keys + (long)l * 16 * 128 * 128 + ((long)hp * 128 + key) * 128;
            float s = 0.f;
            for (int d = 0; d < 128; ++d) s += q[d] * sk[d];
            P.sc[it] = s;
        } break;
        case ST_TOPK1: {
            const float* sc = P.sc + it * 128;
            float ts[16]; int ti[16];
#pragma unroll
            for (int j = 0; j < 16; ++j) { ts[j] = -3.0e38f; ti[j] = 0; }
            for (int i = 0; i < 128; ++i) {
                float xv = sc[i]; int xi = i;
                if (xv > ts[15]) {
#pragma unroll
                    for (int j = 0; j < 16; ++j) {
                        if (xv > ts[j]) { const float tv = ts[j]; const int tj = ti[j]; ts[j] = xv; ti[j] = xi; xv = tv; xi = tj; }
                    }
                }
            }
            float* TS = scr + N * SO_TS + it * 16;
            int* TI = (int*)(scr + N * SO_TI) + it * 16;
#pragma unroll
            for (int j = 0; j < 16; ++j) { TS[j] = ts[j]; TI[j] = ti[j]; }
        } break;
        case ST_TOPK2: {
            const float* s0 = scr + N * SO_TS + it * 32;
            const float* s1 = s0 + 16;
            const int* i0 = (const int*)(scr + N * SO_TI) + it * 32;
            const int* i1 = i0 + 16;
            float ts[16]; int ti[16];
#pragma unroll
            for (int j = 0; j < 16; ++j) { ts[j] = -3.0e38f; ti[j] = 0; }
            for (int a = 0; a < 16; ++a) {
                const int jmax = 16 / (a + 1);
                for (int b = 0; b < jmax; ++b) {
                    float xv = s0[a] + s1[b]; int xi = i0[a] * 128 + i1[b];
                    if (xv > ts[15]) {
#pragma unroll
                        for (int j = 0; j < 16; ++j) {
                            if (xv > ts[j]) { const float tv = ts[j]; const int tj = ti[j]; ts[j] = xv; ti[j] = xi; xv = tv; xi = tj; }
                        }
                    }
                }
            }
            const float mx = ts[0];
            float den = 0.f;
#pragma unroll
            for (int j = 0; j < 16; ++j) { ts[j] = expf(ts[j] - mx); den += ts[j]; }
            const float inv = 1.0f / den;
#pragma unroll
            for (int j = 0; j < 16; ++j) { P.gate[it * 16 + j] = ts[j] * inv; P.idx[it * 16 + j] = ti[j]; }
        } break;
        case ST_PEER_U: {
            const long n = it / 128;
            const int e = P.idx[it];
            const float* u = P.peer_u + ((long)l * NEXP + e) * DM;
            const bf16_t* hx = P.hb + n * DM;
            float s = 0.f;
            for (int d = 0; d < DM; ++d) s += bf2f(hx[d]) * u[d];
            P.act[it] = geluf_(s) * P.gate[it];
        } break;
        case ST_PEER_V: {
            const long n = it / DM; const int d = (int)(it % DM);
            const float* a = P.act + n * 128;
            const int* ix = P.idx + n * 128;
            float s = 0.f;
            for (int j = 0; j < 128; ++j) s += a[j] * P.peer_v[((long)l * NEXP + ix[j]) * DM + d];
            P.xcur[it] += s;
        } break;
    }
}


struct WsMap {
    size_t ctl, w1t, w2t, wsct, auxwt, lruwt, vreswt, pp, tabu, tabv, xn, hb, mix16, p16, sc, aux, vfirst, idx, gate, rstd, act, end;
    size_t auxA, zrkv, xc, auxo, gates, vres, glao, gdno;
    size_t scr, qf;
};
HD WsMap ws_map(size_t N) {
    WsMap m{};
    size_t o = 0;
    auto take = [&](size_t bytes) { size_t r = o; o += (bytes + 4095) & ~(size_t)4095; return r; };
    m.ctl = take(1u << 20);
    m.w1t = take((size_t)NL * PLD * DM * 2);
    m.w2t = take((size_t)NL * DM * DM * 2);
    m.wsct = take((size_t)NL * DM * DM * 2);
    m.auxwt = take((size_t)NL * 1792 * 384 * 2);
    m.lruwt = take((size_t)NL * 1024 * 512 * 2);
    m.vreswt = take((size_t)512 * 512 * 2);
    m.pp = take(1u << 20);
    m.xn = take(N * DM * 2);
    m.hb = take(N * DM * 2);
    m.mix16 = take(N * DM * 2);
    m.p16 = take(N * PLD * 2);
    m.sc = m.p16;
    m.vfirst = take(N * 512 * 4);
    m.idx = take(N * 128 * 4);
    m.gate = take(N * 128 * 4);
    m.act = take(N * 128 * 4);
    m.rstd = take(N * 4);
    m.tabu = take((size_t)NL * 2 * NEXP * DM);
    m.tabv = m.tabu + (size_t)NEXP * DM;
    m.aux = take(N * 3392 * 4);
    m.end = o;
    size_t a = m.aux;
    auto sub = [&](size_t bytes) { size_t r = a; a += (bytes + 4095) & ~(size_t)4095; return r; };
    m.auxA = sub(N * 384 * 2); m.zrkv = sub(N * 1536 * 2); m.xc = sub(N * 512 * 2); m.auxo = sub(N * 1792 * 2);
    m.gates = sub(N * 1024 * 2); m.vres = sub(N * 512 * 2); m.glao = sub(N * 512 * 2); m.gdno = sub(N * 512 * 2);
    m.scr = m.tabu;
    m.qf = m.aux + N * 1024 * 4;
    return m;
}
static inline void bind_ws(Params& P, char* ws) {
    const WsMap m = ws_map((size_t)P.N);
    P.xn = (bf16_t*)(ws + m.xn); P.hb = (bf16_t*)(ws + m.hb); P.mix16 = (bf16_t*)(ws + m.mix16); P.p16 = (bf16_t*)(ws + m.p16);
    P.sc = (float*)(ws + m.sc); P.qf = (float*)(ws + m.qf); P.rstd = (float*)(ws + m.rstd); P.vfirst = (float*)(ws + m.vfirst);
    P.scr = (float*)(ws + m.scr); P.act = (float*)(ws + m.act); P.gate = (float*)(ws + m.gate); P.idx = (int*)(ws + m.idx);
}

struct Step { int st, l; };
static inline int build_schedule(Step* s) {
    int n = 0;
    s[n++] = {ST_COPYX, 0};
    for (int l = 0; l < NL; ++l) {
        static const int per_layer[] = {ST_RSTD, ST_NORM1, ST_GEMM1,
            ST_RW_A0, ST_RW_A1, ST_RW_A2, ST_RW_A3, ST_RW_KKN, ST_RW_SCAN, ST_RW_POST,
            ST_GLA_B0, ST_GLA_SCAN, ST_GLA_POST, ST_LRU_C0, ST_LRU_C1, ST_LRU_SCAN,
            ST_GDN_D0, ST_GDN_D1, ST_GDN_SCAN, ST_GDN_POST,
            ST_GEMM2, ST_RSTD2, ST_NORM2, ST_GEMM3, ST_SCORES, ST_TOPK1, ST_TOPK2, ST_PEER_U, ST_PEER_V};
        for (int i = 0; i < (int)(sizeof(per_layer) / sizeof(int)); ++i) s[n++] = {per_layer[i], l};
    }
    s[n++] = {ST_FRSTD, 0};
    s[n++] = {ST_FNORM, 0};
    return n;
}

static inline void fill_inputs(Params& P, void* const* d_in) {
    const float** dst = (const float**)&P;
    for (int i = 0; i < 38; ++i) dst[i] = (const float*)d_in[i];
}

#ifndef HOST_EMU
#define GAS __attribute__((address_space(1)))
#define LAS __attribute__((address_space(3)))
typedef unsigned v4u __attribute__((ext_vector_type(4)));
typedef unsigned v2u __attribute__((ext_vector_type(2)));
typedef float f32x4 __attribute__((ext_vector_type(4)));
typedef float f32x2 __attribute__((ext_vector_type(2)));
typedef short bf16x8 __attribute__((ext_vector_type(8)));
constexpr int NWAVES = 8, NTHR = 512;
constexpr int RING_BYTES = 131072, MISC_OFF = RING_BYTES + 320, LDS_BYTES = 147456;
constexpr int NTOK = 16384, TSEQ = 4096, NBATCH = 4;

__device__ __forceinline__ unsigned pk2(float lo, float hi) { return (unsigned)f2bf(lo) | ((unsigned)f2bf(hi) << 16); }
__device__ __forceinline__ float bflo(unsigned u) { return __builtin_bit_cast(float, u << 16); }
__device__ __forceinline__ float bfhi(unsigned u) { return __builtin_bit_cast(float, u & 0xffff0000u); }
__device__ __forceinline__ float wave_sum(float v) {
#pragma unroll
    for (int o = 1; o < 64; o <<= 1) v += __shfl_xor(v, o);
    return v;
}
#define LDS_WAIT() asm volatile("s_waitcnt lgkmcnt(0)" ::: "memory")
#define VM_WAIT() asm volatile("s_waitcnt vmcnt(0)" ::: "memory")

namespace pg8 {
#define PG8_LAS __attribute__((address_space(3)))
constexpr int BM = 256, BK = 64, HALF = 128, HTB = HALF * BK * 2, STAGE_BYTES = 8 * HTB, NXCD = 8, WGM = 8;
__host__ __device__ __forceinline__ int lds_byte(int r, int c) { const int st = (r >> 4) * 2 + (c >> 5), rr = r & 15, cc = c & 31, ob = rr * 64 + cc * 2; return st * 1024 + (ob ^ (((ob >> 9) & 1) << 5)); }
__host__ __device__ __forceinline__ void stage_rc(int b, int& R, int& C) { const int st = b / 1024, sb = b % 1024, swz = sb ^ (((sb >> 9) & 1) << 5); R = (st >> 1) * 16 + swz / 64; C = (st & 1) * 32 + (swz % 64) / 2; }
__host__ __device__ __forceinline__ int perm32(int rho) { const int n = rho >> 4, i = rho & 15; return 8 * (i >> 2) + 4 * n + (i & 3); }
struct Unit { int pm, pn; };
struct GemmX { const bf16_t* A; const bf16_t* Bt; int M, N, K, lda; };
struct StaticOrder {
    int nM, nN, nwg, G, c;
    __host__ __device__ void init(int M, int N, int G_, int c_) { nM = M / BM; nN = N / BM; nwg = nM * nN; G = G_; c = c_; }
    __host__ __device__ bool next(int i, Unit& u) const {
        const long L = (long)i * G + c; if (L >= nwg) return false;
        int wgid = (int)L; { const int q = nwg / NXCD, r = nwg % NXCD, xcd = wgid % NXCD, off = wgid / NXCD; wgid = (xcd < r ? xcd * (q + 1) : r * (q + 1) + (xcd - r) * q) + off; }
        const int nig = WGM * nN, gid = wgid / nig, fm = gid * WGM, gsz = (nM - fm) < WGM ? (nM - fm) : WGM;
        u.pm = fm + ((wgid % nig) % gsz); u.pn = (wgid % nig) / gsz; return true;
    }
    __device__ __forceinline__ void a_ready(const Unit&) const {}
    __device__ __forceinline__ void done(const Unit&) const {}
};
__device__ __forceinline__ unsigned cvt_pk_bf16(float lo, float hi) { unsigned r; asm volatile("v_cvt_pk_bf16_f32 %0, %1, %2" : "=v"(r) : "v"(lo), "v"(hi)); return r; }
template <bool ACCUM> struct EpiF32 {
    static constexpr bool PERM = false, AFTER_DRAIN = false;
    float* C; int ldc;
    __device__ __forceinline__ void operator()(const f32x4 (&acc)[2][2][4][2], const Unit& u, int wr, int wc, int fr, int fq) const {
        const int row0 = u.pm * BM + wr * 64 + fr, col0 = u.pn * BM + wc * 32 + 4 * fq;
#pragma unroll
        for (int ai = 0; ai < 2; ++ai)
#pragma unroll
            for (int m = 0; m < 4; ++m) { float* rowp = C + (size_t)(row0 + ai * HALF + m * 16) * ldc + col0;
#pragma unroll
                for (int bj = 0; bj < 2; ++bj)
#pragma unroll
                    for (int n = 0; n < 2; ++n) { f32x4* p = (f32x4*)(rowp + bj * HALF + n * 16);
                        if (ACCUM) *p = *p + acc[ai][bj][m][n]; else *p = acc[ai][bj][m][n]; } }
    }
};
struct EpiBf16 {
    static constexpr bool PERM = true, AFTER_DRAIN = false;
    bf16_t* O; int ldc; const float* bias;
    __device__ __forceinline__ void operator()(const f32x4 (&acc)[2][2][4][2], const Unit& u, int wr, int wc, int fr, int fq) const {
        const int row0 = u.pm * BM + wr * 64 + fr; const int col0 = u.pn * BM + wc * 32 + 8 * fq;
        f32x4 bv[2][2];
#pragma unroll
        for (int bj = 0; bj < 2; ++bj)
#pragma unroll
            for (int n = 0; n < 2; ++n) bv[bj][n] = bias ? *(const f32x4*)(bias + col0 + bj * HALF + 4 * n) : (f32x4){0.f, 0.f, 0.f, 0.f};
#pragma unroll
        for (int ai = 0; ai < 2; ++ai)
#pragma unroll
            for (int m = 0; m < 4; ++m) { bf16_t* rowp = O + (size_t)(row0 + ai * HALF + m * 16) * ldc + col0;
#pragma unroll
                for (int bj = 0; bj < 2; ++bj) { const f32x4 v0 = acc[ai][bj][m][0] + bv[bj][0], v1 = acc[ai][bj][m][1] + bv[bj][1];
                    v4u w; w.x = cvt_pk_bf16(v0[0], v0[1]); w.y = cvt_pk_bf16(v0[2], v0[3]); w.z = cvt_pk_bf16(v1[0], v1[1]); w.w = cvt_pk_bf16(v1[2], v1[3]);
                    *(v4u*)(rowp + bj * HALF) = w; } }
    }
};
template <class Epi, class Sched, bool ALIGN_EPI = false, bool SP2 = false>
__device__ __forceinline__ void gemm_phase(PG8_LAS unsigned char* lds, const GemmX g, const Sched& S, const Epi& E) {
    const int tid = threadIdx.x, wid = __builtin_amdgcn_readfirstlane(tid >> 6), lane = tid & 63, wr = wid >> 2, wc = wid & 3, fr = lane & 15, fq = lane >> 4;
    const int K = g.K, nt = K / BK;
    unsigned voffA[2], voffB[2];
#pragma unroll
    for (int i = 0; i < 2; ++i) { int R, C; stage_rc(tid * 16 + i * 8192, R, C); const int Rb = Epi::PERM ? ((R & ~31) + perm32(R & 31)) : R;
        voffA[i] = (unsigned)(R * g.lda + C) * 2u; voffB[i] = (unsigned)(Rb * K + C) * 2u; }
    const size_t kstep = (size_t)(BK * 2);
    const size_t hstep = (size_t)HALF * K * 2;
    const size_t tstep = 2 * hstep;
    const size_t hstepA = (size_t)HALF * g.lda * 2, tstepA = 2 * hstepA;
    const unsigned ldsw = (unsigned)wid * 1024u;
    const int aoff = lds_byte(wr * 64 + fr, fq * 8), boff = lds_byte(wc * 32 + fr, fq * 8);
#define PG8_SA(b, h) (((b) * 2 + (h)) * HTB)
#define PG8_SB(b, h) ((4 + (b) * 2 + (h)) * HTB)
#define PG8_STAGE(bufoff, gbase, voff) do { _Pragma("unroll") for (int _i = 0; _i < 2; ++_i) \
        __builtin_amdgcn_global_load_lds((const unsigned*)((const char*)(gbase) + (voff)[_i]), (PG8_LAS unsigned*)(lds + (bufoff) + ldsw + _i * 8192), 16, 0, 0); } while (0)
#define PG8_LDA(dst, b, h) do { _Pragma("unroll") for (int m = 0; m < 4; ++m) _Pragma("unroll") for (int k = 0; k < 2; ++k) dst[m][k] = *(const PG8_LAS bf16x8*)(lds + PG8_SA(b, h) + aoff + m * 2048 + k * 1024); } while (0)
#define PG8_LDB(dst, b, h) do { _Pragma("unroll") for (int n = 0; n < 2; ++n) _Pragma("unroll") for (int k = 0; k < 2; ++k) dst[n][k] = *(const PG8_LAS bf16x8*)(lds + PG8_SB(b, h) + boff + n * 2048 + k * 1024); } while (0)
#define PG8_MMA(ai, bj, At, Bt) do { __builtin_amdgcn_s_setprio(1); _Pragma("unroll") for (int m = 0; m < 4; ++m) _Pragma("unroll") for (int n = 0; n < 2; ++n) _Pragma("unroll") for (int k = 0; k < 2; ++k) \
        acc[ai][bj][m][n] = __builtin_amdgcn_mfma_f32_16x16x32_bf16(Bt[n][k], At[m][k], acc[ai][bj][m][n], 0, 0, 0); __builtin_amdgcn_s_setprio(0); } while (0)
#define PG8_WAIT_V(n) asm volatile("s_waitcnt vmcnt(" #n ")" ::: "memory")
#define PG8_WAIT_L(n) asm volatile("s_waitcnt lgkmcnt(" #n ")" ::: "memory")
#define PG8_BAR __builtin_amdgcn_s_barrier()
#define PG8_SCHED __builtin_amdgcn_sched_barrier(0)
    Unit cur, nxt; int ui = 0;
    if (!S.next(0, cur)) return;
    f32x4 acc[2][2][4][2];
#pragma unroll
    for (int a = 0; a < 2; ++a)
#pragma unroll
        for (int b = 0; b < 2; ++b)
#pragma unroll
            for (int m = 0; m < 4; ++m)
#pragma unroll
                for (int n = 0; n < 2; ++n) acc[a][b][m][n] = (f32x4){0.f, 0.f, 0.f, 0.f};
    bf16x8 At[4][2], B0[2][2], B1[2][2];
    const char* cA = (const char*)g.A + (size_t)cur.pm * tstepA; const char* cB = (const char*)g.Bt + (size_t)cur.pn * tstep;
    S.a_ready(cur);
    if constexpr (SP2) {
        PG8_STAGE(PG8_SB(0, 0), cB, voffB); PG8_STAGE(PG8_SB(0, 1), cB + hstep, voffB); PG8_STAGE(PG8_SA(0, 0), cA, voffA); PG8_STAGE(PG8_SA(0, 1), cA + hstepA, voffA);
        if (wr == 1) PG8_BAR;
        PG8_WAIT_V(2); PG8_BAR;
        PG8_STAGE(PG8_SB(1, 0), cB + kstep, voffB); PG8_STAGE(PG8_SA(1, 0), cA + kstep, voffA); PG8_STAGE(PG8_SB(1, 1), cB + hstep + kstep, voffB);
        PG8_WAIT_V(6); PG8_BAR;
    } else {
        PG8_STAGE(PG8_SB(0, 0), cB, voffB); PG8_STAGE(PG8_SA(0, 0), cA, voffA); PG8_STAGE(PG8_SB(0, 1), cB + hstep, voffB); PG8_STAGE(PG8_SA(0, 1), cA + hstepA, voffA);
        if (wr == 1) PG8_BAR;
        PG8_WAIT_V(4); PG8_BAR;
        PG8_STAGE(PG8_SB(1, 0), cB + kstep, voffB); PG8_STAGE(PG8_SA(1, 0), cA + kstep, voffA); PG8_STAGE(PG8_SB(1, 1), cB + hstep + kstep, voffB);
        PG8_WAIT_V(6); PG8_BAR;
    }
    for (;;) {
        const bool has_next = S.next(ui + 1, nxt);
        const char* nA = has_next ? (const char*)g.A + (size_t)nxt.pm * tstepA : cA; const char* nB = has_next ? (const char*)g.Bt + (size_t)nxt.pn * tstep : cB;
        for (int t = 0; t < nt; t += 2) {
            const bool last = (t == nt - 2);
            const char* a1 = cA + (size_t)(t + 1) * kstep;
            const char* a2 = last ? nA : cA + (size_t)(t + 2) * kstep; const char* b2 = last ? nB : cB + (size_t)(t + 2) * kstep;
            const char* a3 = a2 + kstep; const char* b3 = b2 + kstep;
            if (last && has_next) S.a_ready(nxt);
            if constexpr (SP2) {
            PG8_LDB(B0, 0, 0); PG8_LDB(B1, 0, 1); PG8_SCHED; PG8_LDA(At, 0, 0); PG8_STAGE(PG8_SA(1, 1), a1 + hstepA, voffA);
            PG8_WAIT_V(8); PG8_WAIT_L(0); PG8_BAR; PG8_MMA(0, 0, At, B0); PG8_MMA(0, 1, At, B1); PG8_BAR; PG8_SCHED;
            PG8_LDA(At, 0, 1); PG8_STAGE(PG8_SB(0, 0), b2, voffB); PG8_STAGE(PG8_SB(0, 1), b2 + hstep, voffB); PG8_STAGE(PG8_SA(0, 0), a2, voffA);
            PG8_WAIT_V(8); PG8_WAIT_L(0); PG8_BAR; PG8_MMA(1, 0, At, B0); PG8_MMA(1, 1, At, B1); PG8_BAR; PG8_SCHED;
            PG8_LDB(B0, 1, 0); PG8_LDB(B1, 1, 1); PG8_SCHED; PG8_LDA(At, 1, 0); PG8_STAGE(PG8_SA(0, 1), a2 + hstepA, voffA);
            PG8_WAIT_V(8); PG8_WAIT_L(0); PG8_BAR; PG8_MMA(0, 0, At, B0); PG8_MMA(0, 1, At, B1); PG8_BAR; PG8_SCHED;
            PG8_LDA(At, 1, 1); PG8_STAGE(PG8_SB(1, 0), b3, voffB); PG8_STAGE(PG8_SB(1, 1), b3 + hstep, voffB); PG8_STAGE(PG8_SA(1, 0), a3, voffA);
            PG8_WAIT_V(8); PG8_WAIT_L(0); PG8_BAR; PG8_MMA(1, 0, At, B0); PG8_MMA(1, 1, At, B1); PG8_BAR; PG8_SCHED;
            } else {
            PG8_LDB(B0, 0, 0); PG8_SCHED; PG8_LDA(At, 0, 0); PG8_STAGE(PG8_SA(1, 1), a1 + hstepA, voffA);
            PG8_WAIT_L(8); PG8_BAR; PG8_WAIT_L(0); PG8_MMA(0, 0, At, B0); PG8_BAR; PG8_SCHED;
            PG8_LDB(B1, 0, 1); PG8_STAGE(PG8_SB(0, 0), b2, voffB);
            PG8_BAR; PG8_WAIT_L(0); PG8_MMA(0, 1, At, B1); PG8_BAR;
            PG8_LDA(At, 0, 1); PG8_STAGE(PG8_SA(0, 0), a2, voffA);
            PG8_BAR; PG8_WAIT_L(0); PG8_MMA(1, 0, At, B0); PG8_BAR; PG8_SCHED;
            PG8_STAGE(PG8_SB(0, 1), b2 + hstep, voffB);
            PG8_WAIT_V(6); PG8_BAR; PG8_MMA(1, 1, At, B1); PG8_BAR;
            PG8_LDB(B0, 1, 0); PG8_SCHED; PG8_LDA(At, 1, 0); PG8_STAGE(PG8_SA(0, 1), a2 + hstepA, voffA);
            PG8_WAIT_L(8); PG8_BAR; PG8_WAIT_L(0); PG8_MMA(0, 0, At, B0); PG8_BAR; PG8_SCHED;
            PG8_LDB(B1, 1, 1); PG8_STAGE(PG8_SB(1, 0), b3, voffB);
            PG8_BAR; PG8_WAIT_L(0); PG8_MMA(0, 1, At, B1); PG8_BAR;
            PG8_LDA(At, 1, 1); PG8_STAGE(PG8_SA(1, 0), a3, voffA);
            PG8_BAR; PG8_WAIT_L(0); PG8_MMA(1, 0, At, B0); PG8_BAR; PG8_SCHED;
            PG8_STAGE(PG8_SB(1, 1), b3 + hstep, voffB);
            PG8_WAIT_V(6); PG8_BAR; PG8_MMA(1, 1, At, B1); PG8_BAR;
            }
        }
        if constexpr (ALIGN_EPI) { if (wr == 0) PG8_BAR; }
        if constexpr (!Epi::AFTER_DRAIN) { E(acc, cur, wr, wc, fr, fq); S.done(cur); }
        if (!has_next) break;
#pragma unroll
        for (int a = 0; a < 2; ++a)
#pragma unroll
            for (int b = 0; b < 2; ++b)
#pragma unroll
                for (int m = 0; m < 4; ++m)
#pragma unroll
                    for (int n = 0; n < 2; ++n) acc[a][b][m][n] = (f32x4){0.f, 0.f, 0.f, 0.f};
        cur = nxt; cA = nA; cB = nB; ++ui;
        if constexpr (ALIGN_EPI) { if (wr == 1) PG8_BAR; }
    }
    PG8_WAIT_V(0);
    if constexpr (!ALIGN_EPI) { if (wr == 0) PG8_BAR; }
    PG8_BAR;
    if constexpr (Epi::AFTER_DRAIN) { E.fused(acc, cur, wr, wc, fr, fq, lds, wid, lane); S.done(cur); }
#undef PG8_SA
#undef PG8_SB
#undef PG8_STAGE
#undef PG8_LDA
#undef PG8_LDB
#undef PG8_MMA
#undef PG8_WAIT_V
#undef PG8_WAIT_L
#undef PG8_BAR
#undef PG8_SCHED
}
}

#define XB_TMO      128
#define XB_XCNT(j)  (256  + 64 * (j))
#define XB_XSUB(j)  (1280 + 64 * (j))
#define XB_XGEN(j)  (2304 + 64 * (j))
#define XB_TOP      3328
#define XB_TOPGEN   3392
#define XCD_BAR_WORDS 3456
#define XB_SPIN_CAP (1u << 20)
__device__ __forceinline__ unsigned xb_ld(unsigned* p) { return __hip_atomic_load(p, __ATOMIC_RELAXED, __HIP_MEMORY_SCOPE_AGENT); }
__device__ __forceinline__ unsigned xb_add(unsigned* p, unsigned v) { return __hip_atomic_fetch_add(p, v, __ATOMIC_RELAXED, __HIP_MEMORY_SCOPE_AGENT); }
__device__ __forceinline__ unsigned xb_xcc_id() { return (unsigned)__builtin_amdgcn_s_getreg((3 << 11) | 20) & 0xFu; }
#define XB_SPIN(cond, bar) do { unsigned _sp = 0; while (cond) { __builtin_amdgcn_s_sleep(1); \
    if ((++_sp & 255u) == 0u) { if (xb_ld(&(bar)[XB_TMO])) break; if (_sp > XB_SPIN_CAP) { atomicAdd(&(bar)[XB_TMO], 1u); break; } } } } while (0)
struct XcdBarrier { unsigned* bar; unsigned x; volatile LAS unsigned* st; };
__device__ __forceinline__ XcdBarrier xcd_barrier_post(unsigned* bar, volatile LAS unsigned* st) {
    XcdBarrier b; b.bar = bar; b.x = xb_xcc_id(); b.st = st;
    if (threadIdx.x == 0) (void)xb_add(&bar[XB_XCNT(b.x)], 1u);
    return b;
}
__device__ __forceinline__ void xcd_barrier_complete(unsigned* bar, unsigned x, unsigned& nloc, unsigned& nx) {
    const unsigned G = gridDim.x * gridDim.y * gridDim.z;
    unsigned sum, cnt, mine, sp = 0u;
    for (;;) {
        sum = 0u; cnt = 0u; mine = 0u;
#pragma unroll
        for (unsigned j = 0; j < 16; ++j) { const unsigned c = xb_ld(&bar[XB_XCNT(j)]); sum += c; cnt += (c > 0u) ? 1u : 0u; mine = (j == x) ? c : mine; }
        if (sum == G) break;
        __builtin_amdgcn_s_sleep(1);
        if ((++sp & 255u) == 0u) { if (xb_ld(&bar[XB_TMO])) break; if (sp > XB_SPIN_CAP) { atomicAdd(&bar[XB_TMO], 1u); break; } }
    }
    nloc = mine > 0u ? mine : 1u; nx = cnt > 0u ? cnt : 1u;
}
__device__ __forceinline__ void xcd_barrier(const XcdBarrier& b) {
    asm volatile("s_waitcnt vmcnt(0)" ::: "memory");
    __syncthreads();
    if (threadIdx.x == 0) {
        unsigned* bar = b.bar;
        __builtin_amdgcn_s_waitcnt(0);
        unsigned nloc = b.st[0], nx = b.st[1];
        if (nloc == 0u) { xcd_barrier_complete(bar, b.x, nloc, nx); b.st[0] = nloc; b.st[1] = nx; }
        const unsigned old = xb_add(&bar[XB_XSUB(b.x)], 1u);
        const unsigned gen = old / nloc;
        if (old + 1u == (gen + 1u) * nloc) {
            __builtin_amdgcn_fence(__ATOMIC_RELEASE, "agent");
            asm volatile("s_waitcnt vmcnt(0)" ::: "memory");
            const unsigned og = xb_add(&bar[XB_TOP], 1u);
            const unsigned tg = og / nx;
            if (og + 1u == (tg + 1u) * nx) xb_add(&bar[XB_TOPGEN], 1u);
            else XB_SPIN(xb_ld(&bar[XB_TOPGEN]) == tg, bar);
            __builtin_amdgcn_fence(__ATOMIC_ACQUIRE, "agent");
            xb_add(&bar[XB_XGEN(b.x)], 1u);
            asm volatile("s_waitcnt vmcnt(0)" ::: "memory");
        } else {
            XB_SPIN(xb_ld(&bar[XB_XGEN(b.x)]) == gen, bar);
            __builtin_amdgcn_fence(__ATOMIC_ACQUIRE, "agent");
            asm volatile("s_waitcnt vmcnt(0)" ::: "memory");
        }
    }
    __syncthreads();
}

struct Args { const float* in[38]; float* out; unsigned char* ws; int ph_lo, ph_hi, li, pad; };
enum InputId { I_X = 0, I_NORM_MIX, I_W_IN, I_W_OUT, I_RW_MU, I_RW_W0, I_RW_W_UP, I_RW_A0, I_RW_A_UP, I_RW_G_UP, I_RW_K_K, I_RW_K_A, I_RW_R_K,
    I_RW_LN_W, I_RW_LN_B, I_RW_V0, I_RW_V_DOWN, I_RW_V_UP, I_GLA_A_UP, I_GLA_A_BIAS, I_GLA_NORM, I_LRU_CONV_W, I_LRU_CONV_B, I_LRU_W_R,
    I_LRU_B_R, I_LRU_W_I, I_LRU_B_I, I_LRU_LAM, I_GDN_CONV_W, I_GDN_A_LOG, I_GDN_DT_BIAS, I_GDN_NORM, I_NORM_FFN, I_PEER_WQ, I_PEER_SK,
    I_PEER_U, I_PEER_V, I_NORM_FINAL };
enum { PH_P0 = 0, PH_GEMM1 = 1, PH_PREP = 2, PH_AUX = 3, PH_SCAN = 4, PH_POST = 5, PH_GEMM2 = 6, PH_NORM2 = 7, PH_GEMM3 = 8, PH_TOPK = 9, PH_PEER = 10, PH_PER_LAYER = 10, PH_TOTAL = 21 };

struct Frame {
    LAS unsigned char* lds;
    int tid, lane, wave, vcu, G;
    int gw, ngw;
};

__device__ __forceinline__ void p0_transpose_item(const float* W, int K, int N, const float* kscale, bf16_t* WT, LAS float* scr, int item, int nblk, int lane) {
    const int kb = item / nblk, nb = item % nblk, k0 = 64 * kb, n0 = 32 * nb;
    const int nn = n0 + (lane & 31);
#pragma unroll 8
    for (int i = 0; i < 32; ++i) { const int kk = 2 * i + (lane >> 5);
        float v = nn < N ? W[(size_t)(k0 + kk) * N + nn] : 0.f;
        if (kscale) v *= kscale[k0 + kk];
        scr[kk * 33 + (lane & 31)] = v; }
    LDS_WAIT(); asm volatile("" ::: "memory");
    const int c = lane & 7;
#pragma unroll
    for (int j = 0; j < 4; ++j) { const int n = (lane >> 3) + 8 * j; const LAS float* s = scr + (8 * c) * 33 + n;
        v4u o; o.x = pk2(s[0 * 33], s[1 * 33]); o.y = pk2(s[2 * 33], s[3 * 33]); o.z = pk2(s[4 * 33], s[5 * 33]); o.w = pk2(s[6 * 33], s[7 * 33]);
        *(v4u*)(WT + (size_t)(n0 + n) * K + k0 + 8 * c) = o; }
    LDS_WAIT(); asm volatile("" ::: "memory");
}

__device__ __forceinline__ void p0_prologue(const Args& a, Frame& F) {
    const WsMap m = ws_map(NTOK);
    unsigned char* ws = a.ws;
    LAS float* scr = (LAS float*)(F.lds + F.wave * 16384);
    const int gw = F.gw, NGW = F.ngw, lane = F.lane;
    for (int n = gw; n < NTOK; n += NGW) {
        const f32x4* xr = (const f32x4*)(a.in[I_X] + (size_t)n * DM) + lane;
        f32x4 v[8]; float s = 0.f;
#pragma unroll
        for (int j = 0; j < 8; ++j) { v[j] = xr[64 * j]; s += (v[j].x * v[j].x + v[j].y * v[j].y) + (v[j].z * v[j].z + v[j].w * v[j].w); }
        const float rstd = 1.0f / sqrtf(wave_sum(s) * (1.0f / DM) + 1e-6f);
        f32x4* xo = (f32x4*)(a.out + (size_t)n * DM) + lane;
        v2u* o8 = (v2u*)((bf16_t*)(ws + m.xn) + (size_t)n * DM) + lane;
#pragma unroll
        for (int j = 0; j < 8; ++j) { xo[64 * j] = v[j]; v2u w; w.x = pk2(v[j].x * rstd, v[j].y * rstd); w.y = pk2(v[j].z * rstd, v[j].w * rstd); o8[64 * j] = w; }
    }
    {
        constexpr int I1 = (DM / 64) * (PLD / 32), I2 = (DM / 64) * (DM / 32);
        for (int it = gw; it < NL * (I1 + I2); it += NGW) {
            const int l = it / (I1 + I2); int r = it % (I1 + I2);
            if (r < I1) p0_transpose_item(a.in[I_W_IN] + (size_t)l * DM * INC, DM, INC, a.in[I_NORM_MIX] + l * DM, (bf16_t*)(ws + m.w1t) + (size_t)l * PLD * DM, scr, r, PLD / 32, lane);
            else p0_transpose_item(a.in[I_W_OUT] + (size_t)l * DM * DM, DM, DM, nullptr, (bf16_t*)(ws + m.w2t) + (size_t)l * DM * DM, scr, r - I1, DM / 32, lane);
        }
    }
    for (int it = gw; it < NL * 16 * 64; it += NGW) {
        const int l = it / 1024, hp = (it % 1024) / 64, kb = it % 64;
        const int dh = lane & 1, kk = kb * 32 + (lane >> 1);
        const float* wq = a.in[I_PEER_WQ] + (size_t)l * DM * DM + (size_t)kk * DM + hp * 128 + dh * 64;
        const float* sk = a.in[I_PEER_SK] + ((size_t)l * 16 + hp) * 128 * 128 + dh * 64;
        f32x4 q[16];
#pragma unroll
        for (int d = 0; d < 16; ++d) q[d] = *(const f32x4*)(wq + 4 * d);
        bf16_t* o = (bf16_t*)(ws + m.wsct) + (size_t)l * DM * DM + (size_t)(hp * 128) * DM + kk;
        for (int key = 0; key < 128; ++key) {
            const f32x4* s4 = (const f32x4*)(sk + key * 128);
            float acc = 0.f;
#pragma unroll
            for (int d = 0; d < 16; ++d) { const f32x4 sv = s4[d]; acc += (q[d].x * sv.x + q[d].y * sv.y) + (q[d].z * sv.z + q[d].w * sv.w); }
            acc += __shfl_xor(acc, 1);
            if (dh == 0) o[(size_t)key * DM] = f2bf(acc);
        }
    }
    {
        const int gt = F.vcu * NTHR + F.tid, GT = F.G * NTHR;
        bf16_t* AW = (bf16_t*)(ws + m.auxwt); bf16_t* LW = (bf16_t*)(ws + m.lruwt); bf16_t* VW = (bf16_t*)(ws + m.vreswt); float* PP = (float*)(ws + m.pp);
        for (int it = gt; it < NL * 1792 * 384; it += GT) {
            const int l = it / (1792 * 384), r = it % (1792 * 384), n = r / 384, k = r % 384;
            float v = 0.f;
            if (n < 512) { if (k < 64) v = a.in[I_RW_W_UP][(size_t)l * 64 * 512 + k * 512 + n]; }
            else if (n < 1024) { if (k >= 64 && k < 128) v = a.in[I_RW_A_UP][(size_t)l * 64 * 512 + (k - 64) * 512 + (n - 512)]; }
            else if (n < 1536) { if (k >= 128 && k < 256) v = a.in[I_RW_G_UP][(size_t)l * 128 * 512 + (k - 128) * 512 + (n - 1024)]; }
            else { if (k >= 256 && k < 272) v = a.in[I_GLA_A_UP][(size_t)l * 16 * 256 + (k - 256) * 256 + (n - 1536)]; }
            AW[it] = f2bf(v);
        }
        for (int it = gt; it < NL * 1024 * 512; it += GT) {
            const int l = it / (1024 * 512), r = it % (1024 * 512), n = r / 512, k = r % 512;
            const int nn = n & 511, blk = nn >> 6, j = nn & 63;
            float v = 0.f;
            if ((k >> 6) == blk) v = (n < 512 ? a.in[I_LRU_W_R] : a.in[I_LRU_W_I])[(size_t)l * 8 * 64 * 64 + (size_t)blk * 4096 + (k & 63) * 64 + j];
            LW[it] = f2bf(v);
        }
        for (int it = gt; it < 512 * 512; it += GT) {
            const int n = it / 512, k = it % 512;
            float s = 0.f;
            for (int i = 0; i < 32; ++i) s += a.in[I_RW_V_DOWN][k * 32 + i] * a.in[I_RW_V_UP][i * 512 + n];
            VW[it] = f2bf(s);
        }
        for (int it = gt; it < 6144; it += GT) {
            float v = 0.f;
            if (it < 3584) { const int l = it / 1792, c = it % 1792;
                v = c < 512 ? a.in[I_RW_W0][l * 512 + c] : (c < 1024 ? a.in[I_RW_A0][l * 512 + c - 512] : (c < 1536 ? 0.f : a.in[I_GLA_A_BIAS][l * 256 + c - 1536])); }
            else if (it < 5632) { const int l = (it - 3584) / 1024, c = (it - 3584) % 1024; v = c < 512 ? a.in[I_LRU_B_R][l * 512 + c] : a.in[I_LRU_B_I][l * 512 + c - 512]; }
            else v = a.in[I_RW_V0][it - 5632];
            PP[it] = v;
        }
    }
}

__device__ __forceinline__ unsigned pk4_fp8(float a, float b, float c, float d) {
    int w = 0;
    w = __builtin_amdgcn_cvt_pk_fp8_f32(__builtin_fmaxf(__builtin_fminf(a, 448.f), -448.f), __builtin_fmaxf(__builtin_fminf(b, 448.f), -448.f), w, false);
    w = __builtin_amdgcn_cvt_pk_fp8_f32(__builtin_fmaxf(__builtin_fminf(c, 448.f), -448.f), __builtin_fmaxf(__builtin_fminf(d, 448.f), -448.f), w, true);
    return (unsigned)w;
}
__device__ __forceinline__ void tables_phase(const Args& a, Frame& F, int l0, int l1) {
    const WsMap m = ws_map(NTOK);
    const size_t per = (size_t)NEXP * DM / 16;
    for (size_t it = (size_t)l0 * 2 * per + (size_t)F.vcu * NTHR + F.tid; it < (size_t)l1 * 2 * per; it += (size_t)F.G * NTHR) {
        const int tb = (int)(it / per); const size_t r = it % per;
        const float* srcp = ((tb & 1) ? a.in[I_PEER_V] : a.in[I_PEER_U]) + (size_t)(tb >> 1) * NEXP * DM + r * 16;
        const float sc = (tb & 1) ? 64.0f : 1024.0f;
        const f32x4 v0 = __builtin_nontemporal_load((const f32x4*)srcp) * sc, v1 = __builtin_nontemporal_load((const f32x4*)srcp + 1) * sc;
        const f32x4 v2 = __builtin_nontemporal_load((const f32x4*)srcp + 2) * sc, v3 = __builtin_nontemporal_load((const f32x4*)srcp + 3) * sc;
        v4u w; w.x = pk4_fp8(v0.x, v0.y, v0.z, v0.w); w.y = pk4_fp8(v1.x, v1.y, v1.z, v1.w); w.z = pk4_fp8(v2.x, v2.y, v2.z, v2.w); w.w = pk4_fp8(v3.x, v3.y, v3.z, v3.w);
        *(v4u*)((unsigned char*)(a.ws + m.tabu) + (size_t)tb * NEXP * DM + r * 16) = w;
    }
}

template <int CTRL> __device__ __forceinline__ float dpp_f(float v) { return __builtin_bit_cast(float, __builtin_amdgcn_update_dpp(0, __builtin_bit_cast(int, v), CTRL, 0xF, 0xF, true)); }
__device__ __forceinline__ float rdlane_f(float v, int l) { return __builtin_bit_cast(float, __builtin_amdgcn_readlane(__builtin_bit_cast(int, v), l)); }
__device__ __forceinline__ float row16_sum(float v) {
    v += dpp_f<0xB1>(v); v += dpp_f<0x4E>(v); v += dpp_f<0x141>(v); v += dpp_f<0x140>(v); return v;
}
__device__ __forceinline__ float wave_sum_u(float v) {
    v = row16_sum(v);
    return (rdlane_f(v, 0) + rdlane_f(v, 16)) + (rdlane_f(v, 32) + rdlane_f(v, 48));
}
typedef __bf16 bf16x2_t __attribute__((ext_vector_type(2)));
__device__ __forceinline__ float dot2bf(unsigned w, unsigned x, float acc) { return __builtin_amdgcn_fdot2_f32_bf16(__builtin_bit_cast(bf16x2_t, w), __builtin_bit_cast(bf16x2_t, x), acc, false); }
__device__ __forceinline__ float gelu_fast(float x) {
    const float u = 1.5957691216057308f * (x + 0.044715f * x * x * x);
    return x / (1.0f + __expf(-u));
}


__device__ __forceinline__ float sigm(float x) { return 1.0f / (1.0f + __expf(-x)); }
__device__ __forceinline__ float softplus_f(float x) { return log1pf(__expf(-fabsf(x))) + fmaxf(x, 0.0f); }
__device__ __forceinline__ float tanh_f(float x) { return 1.0f - 2.0f / (1.0f + __expf(2.0f * x)); }
__device__ __forceinline__ float red8(float v) { v += dpp_f<0xB1>(v); v += dpp_f<0x4E>(v); v += dpp_f<0x141>(v); return v; }
__device__ __forceinline__ v4u ld8(const bf16_t* p) { return *(const v4u*)p; }
__device__ __forceinline__ void unpack8(const v4u w, float (&f)[8]) { f[0] = bflo(w.x); f[1] = bfhi(w.x); f[2] = bflo(w.y); f[3] = bfhi(w.y); f[4] = bflo(w.z); f[5] = bfhi(w.z); f[6] = bflo(w.w); f[7] = bfhi(w.w); }
__device__ __forceinline__ v4u pack8(const float (&f)[8]) { v4u w; w.x = pk2(f[0], f[1]); w.y = pk2(f[2], f[3]); w.z = pk2(f[4], f[5]); w.w = pk2(f[6], f[7]); return w; }

__device__ __forceinline__ void prep_phase(const Args& a, Frame& F, int l) {
    const WsMap m = ws_map(NTOK);
    const bf16_t* p16 = (const bf16_t*)(a.ws + m.p16);
    bf16_t* zrkv = (bf16_t*)(a.ws + m.zrkv); bf16_t* auxA = (bf16_t*)(a.ws + m.auxA); bf16_t* xc = (bf16_t*)(a.ws + m.xc);
    const float* mu = a.in[I_RW_MU] + l * 1792;
    for (size_t it = (size_t)F.vcu * NTHR + F.tid; it < (size_t)NTOK * 304; it += (size_t)F.G * NTHR) {
        const int n = (int)(it / 304), j = (int)(it % 304), t = n % TSEQ;
        if (j < 224) {
            const int col = j * 8;
            float cur[8], prv[8], z[8];
            unpack8(ld8(p16 + (size_t)n * PLD + col), cur);
            if (t > 0) unpack8(ld8(p16 + (size_t)(n - 1) * PLD + col), prv);
            else {
#pragma unroll
                for (int k = 0; k < 8; ++k) prv[k] = 0.f; }
            const f32x4 m0 = *(const f32x4*)(mu + col), m1 = *(const f32x4*)(mu + col + 4);
            const float mm[8] = {m0.x, m0.y, m0.z, m0.w, m1.x, m1.y, m1.z, m1.w};
#pragma unroll
            for (int k = 0; k < 8; ++k) z[k] = cur[k] + (prv[k] - cur[k]) * mm[k];
            if (col < 1536) *(v4u*)(zrkv + (size_t)n * 1536 + col) = pack8(z);
            else {
                const int c = col - 1536;
#pragma unroll
                for (int k = 0; k < 8; ++k) z[k] = c < 64 ? tanh_f(z[k]) : (c < 128 ? z[k] : sigm(z[k]));
                *(v4u*)(auxA + (size_t)n * 384 + c) = pack8(z);
            }
        } else if (j < 240) {
            const int c = 256 + (j - 224) * 8;
            v4u w = (v4u){0u, 0u, 0u, 0u};
            if (c < 272) w = ld8(p16 + (size_t)n * PLD + C_GLA + 1536 + (c - 256));
            *(v4u*)(auxA + (size_t)n * 384 + c) = w;
        } else {
            const int c = (j - 240) * 8;
            float acc[8];
            { const f32x4 b0 = *(const f32x4*)(a.in[I_LRU_CONV_B] + l * 512 + c), b1 = *(const f32x4*)(a.in[I_LRU_CONV_B] + l * 512 + c + 4);
              acc[0] = b0.x; acc[1] = b0.y; acc[2] = b0.z; acc[3] = b0.w; acc[4] = b1.x; acc[5] = b1.y; acc[6] = b1.z; acc[7] = b1.w; }
#pragma unroll
            for (int jj = 0; jj < 4; ++jj) {
                if (t - 3 + jj >= 0) {
                    float xv[8]; unpack8(ld8(p16 + (size_t)(n - 3 + jj) * PLD + C_LRU + c), xv);
                    const float* cw = a.in[I_LRU_CONV_W] + (size_t)l * 4 * 512 + jj * 512 + c;
                    const f32x4 w0 = *(const f32x4*)cw, w1 = *(const f32x4*)(cw + 4);
                    acc[0] += w0.x * xv[0]; acc[1] += w0.y * xv[1]; acc[2] += w0.z * xv[2]; acc[3] += w0.w * xv[3];
                    acc[4] += w1.x * xv[4]; acc[5] += w1.y * xv[5]; acc[6] += w1.z * xv[6]; acc[7] += w1.w * xv[7];
                }
            }
            *(v4u*)(xc + (size_t)n * 512 + c) = pack8(acc);
        }
    }
}

__device__ __forceinline__ void rwkv_task(const Args& a, Frame& F, int l, int task) {
    const WsMap m = ws_map(NTOK);
    const int b = task >> 3, h = task & 7;
    LAS float* LR = (LAS float*)F.lds; LAS float* LW = LR + 2048; LAS float* LK = LW + 2048; LAS float* LV = LK + 2048;
    LAS float* LA = LV + 2048; LAS float* LB = LA + 2048; LAS float* LY = LB + 2048;
    const int lane = F.lane, w = F.wave, tid = F.tid;
    const int ch = h * 64 + lane;
    const float kk_ = a.in[I_RW_K_K][l * 512 + ch], ka_ = a.in[I_RW_K_A][l * 512 + ch], rk_ = a.in[I_RW_R_K][l * 512 + ch];
    const float lnw = a.in[I_RW_LN_W][l * 512 + ch], lnb = a.in[I_RW_LN_B][l * 512 + ch];
    const bf16_t* zr = (const bf16_t*)(a.ws + m.zrkv); const bf16_t* ao = (const bf16_t*)(a.ws + m.auxo); const bf16_t* vr = (const bf16_t*)(a.ws + m.vres);
    float* vf = (float*)(a.ws + m.vfirst); bf16_t* mix = (bf16_t*)(a.ws + m.mix16);
    float S[8];
#pragma unroll
    for (int j = 0; j < 8; ++j) S[j] = 0.f;
    const int row = tid >> 3, ks = tid & 7;
    float in_[4][8];
    auto load_chunk = [&](int c) {
#pragma unroll
        for (int q = 0; q < 4; ++q) { const size_t n = (size_t)b * TSEQ + c * 32 + w + 8 * q;
            in_[q][0] = bf2f(zr[n * 1536 + ch]); in_[q][1] = bf2f(zr[n * 1536 + 512 + ch]); in_[q][2] = bf2f(zr[n * 1536 + 1024 + ch]);
            in_[q][3] = bf2f(ao[n * 1792 + ch]); in_[q][4] = bf2f(ao[n * 1792 + 512 + ch]); in_[q][5] = bf2f(ao[n * 1792 + 1024 + ch]);
            if (l > 0) { in_[q][6] = bf2f(vr[n * 512 + ch]); in_[q][7] = vf[n * 512 + ch]; } else { in_[q][6] = 0.f; in_[q][7] = 0.f; } }
    };
    load_chunk(0);
    for (int c = 0; c < TSEQ / 32; ++c) {
        float gq[4], vq[4], bonq[4];
#pragma unroll
        for (int q = 0; q < 4; ++q) {
            const int tl = w + 8 * q; const size_t n = (size_t)b * TSEQ + c * 32 + tl;
            const float zr_ = in_[q][0], zk_ = in_[q][1], zv_ = in_[q][2], wp = in_[q][3], ap = in_[q][4];
            float v = zv_;
            if (l == 0) vf[n * 512 + ch] = zv_; else v = zv_ + (in_[q][7] - zv_) * sigm(in_[q][6]);
            const float w_raw = -softplus_f(-wp) - 0.5f, dec = __expf(-__expf(w_raw));
            const float aa = sigm(ap);
            const float kkraw = zk_ * kk_;
            const float ss = wave_sum_u(kkraw * kkraw);
            const float kk = kkraw * (1.0f / sqrtf(fmaxf(ss, 1e-24f)));
            const float km = zk_ * (1.0f + (aa - 1.0f) * ka_);
            bonq[q] = wave_sum_u(zr_ * km * rk_);
            LR[tl * 64 + lane] = zr_; LW[tl * 64 + lane] = dec; LK[tl * 64 + lane] = km; LV[tl * 64 + lane] = v; LA[tl * 64 + lane] = -kk; LB[tl * 64 + lane] = kk * aa;
            gq[q] = in_[q][5]; vq[q] = v;
        }
        __syncthreads();
        if (c + 1 < TSEQ / 32) load_chunk(c + 1);
#pragma unroll 2
        for (int tl = 0; tl < 32; ++tl) {
            const int o = tl * 64 + ks * 8;
            const f32x4 a0 = *(const LAS f32x4*)(LA + o), a1 = *(const LAS f32x4*)(LA + o + 4);
            const f32x4 w0 = *(const LAS f32x4*)(LW + o), w1 = *(const LAS f32x4*)(LW + o + 4);
            const f32x4 b0 = *(const LAS f32x4*)(LB + o), b1 = *(const LAS f32x4*)(LB + o + 4);
            const f32x4 k0 = *(const LAS f32x4*)(LK + o), k1 = *(const LAS f32x4*)(LK + o + 4);
            const f32x4 r0 = *(const LAS f32x4*)(LR + o), r1 = *(const LAS f32x4*)(LR + o + 4);
            const float vv = LV[tl * 64 + row];
            float sa = ((S[0] * a0.x + S[1] * a0.y) + (S[2] * a0.z + S[3] * a0.w)) + ((S[4] * a1.x + S[5] * a1.y) + (S[6] * a1.z + S[7] * a1.w));
            sa = red8(sa);
            S[0] = S[0] * w0.x + (sa * b0.x + vv * k0.x); S[1] = S[1] * w0.y + (sa * b0.y + vv * k0.y); S[2] = S[2] * w0.z + (sa * b0.z + vv * k0.z); S[3] = S[3] * w0.w + (sa * b0.w + vv * k0.w);
            S[4] = S[4] * w1.x + (sa * b1.x + vv * k1.x); S[5] = S[5] * w1.y + (sa * b1.y + vv * k1.y); S[6] = S[6] * w1.z + (sa * b1.z + vv * k1.z); S[7] = S[7] * w1.w + (sa * b1.w + vv * k1.w);
            float y = ((S[0] * r0.x + S[1] * r0.y) + (S[2] * r0.z + S[3] * r0.w)) + ((S[4] * r1.x + S[5] * r1.y) + (S[6] * r1.z + S[7] * r1.w));
            y = red8(y);
            if (ks == 0) LY[tl * 64 + row] = y;
        }
        __syncthreads();
#pragma unroll
        for (int q = 0; q < 4; ++q) {
            const int tl = w + 8 * q; const size_t n = (size_t)b * TSEQ + c * 32 + tl;
            const float y = LY[tl * 64 + lane];
            const float mean = wave_sum_u(y) * (1.0f / 64.0f);
            const float d = y - mean;
            const float var = wave_sum_u(d * d) * (1.0f / 64.0f);
            const float rs = 1.0f / sqrtf(var + 64e-5f);
            const float outv = (d * rs * lnw + lnb + bonq[q] * vq[q]) * gq[q];
            mix[n * DM + ch] = f2bf(outv);
        }
    }
}

__device__ __forceinline__ void gdn_task(const Args& a, Frame& F, int l, int task) {
    const WsMap m = ws_map(NTOK);
    const int b = task >> 4, h = (task >> 2) & 3, rq = task & 3;
    LAS float* LQ = (LAS float*)F.lds; LAS float* LK = LQ + 4096; LAS float* LV = LK + 4096; LAS float* LBE = LV + 1024; LAS float* LEG = LBE + 32; LAS float* LO = LEG + 32;
    const int lane = F.lane, w = F.wave, tid = F.tid;
    const bf16_t* p16 = (const bf16_t*)(a.ws + m.p16);
    bf16_t* go = (bf16_t*)(a.ws + m.gdno);
    const float* cw = a.in[I_GDN_CONV_W] + (size_t)l * 4 * 1536;
    const int cq = h * 128 + 2 * lane, ck = 512 + h * 128 + 2 * lane, vi = lane & 31, cv = 1024 + h * 128 + rq * 32 + vi, vt = lane >> 5;
    float wq[4][2], wk[4][2], wv[4];
#pragma unroll
    for (int j = 0; j < 4; ++j) { wq[j][0] = cw[j * 1536 + cq]; wq[j][1] = cw[j * 1536 + cq + 1]; wk[j][0] = cw[j * 1536 + ck]; wk[j][1] = cw[j * 1536 + ck + 1]; wv[j] = cw[j * 1536 + cv]; }
    const float nAexp = -__expf(a.in[I_GDN_A_LOG][l * 4 + h]), dtb = a.in[I_GDN_DT_BIAS][l * 4 + h];
    float S[8];
#pragma unroll
    for (int j = 0; j < 8; ++j) S[j] = 0.f;
    const int row = tid >> 4, ks = tid & 15;
    unsigned rq_[7], rk_[7]; unsigned short rv_[5]; float rb_ = 0.f, ra_ = 0.f;
    auto load_chunk = [&](int c) {
        const int t0 = c * 32 + 4 * w;
        const size_t n0 = (size_t)b * TSEQ + t0;
#pragma unroll
        for (int r = 0; r < 7; ++r) { const bool ok = t0 - 3 + r >= 0; const bf16_t* pr = p16 + (n0 - 3 + r) * PLD + C_GDN;
            rq_[r] = ok ? *(const unsigned*)(pr + cq) : 0u; rk_[r] = ok ? *(const unsigned*)(pr + ck) : 0u; }
#pragma unroll
        for (int r = 0; r < 5; ++r) { const bool ok = t0 + 2 * vt - 3 + r >= 0; rv_[r] = ok ? p16[(n0 + 2 * vt - 3 + r) * PLD + C_GDN + cv] : (unsigned short)0; }
        if (lane < 4) { rb_ = bf2f(p16[(n0 + lane) * PLD + C_GDN + 2048 + h]); ra_ = bf2f(p16[(n0 + lane) * PLD + C_GDN + 2052 + h]); }
    };
    load_chunk(0);
    for (int c = 0; c < TSEQ / 32; ++c) {
#pragma unroll
        for (int i = 0; i < 4; ++i) {
            const int tl = 4 * w + i;
            float q0 = 0.f, q1 = 0.f, k0 = 0.f, k1 = 0.f;
#pragma unroll
            for (int j = 0; j < 4; ++j) { q0 += wq[j][0] * bflo(rq_[i + j]); q1 += wq[j][1] * bfhi(rq_[i + j]); k0 += wk[j][0] * bflo(rk_[i + j]); k1 += wk[j][1] * bfhi(rk_[i + j]); }
            q0 = q0 * sigm(q0); q1 = q1 * sigm(q1); k0 = k0 * sigm(k0); k1 = k1 * sigm(k1);
            const float qs = wave_sum_u(q0 * q0 + q1 * q1), ksum = wave_sum_u(k0 * k0 + k1 * k1);
            const float qi = (1.0f / sqrtf(qs + 1e-6f)) * 0.08838834764831845f, ki = 1.0f / sqrtf(ksum + 1e-6f);
            *(LAS f32x2*)(LQ + tl * 128 + 2 * lane) = (f32x2){q0 * qi, q1 * qi};
            *(LAS f32x2*)(LK + tl * 128 + 2 * lane) = (f32x2){k0 * ki, k1 * ki};
        }
#pragma unroll
        for (int i = 0; i < 2; ++i) {
            float v = 0.f;
#pragma unroll
            for (int j = 0; j < 4; ++j) v += wv[j] * bf2f(rv_[i + j]);
            LV[(4 * w + 2 * vt + i) * 32 + vi] = v * sigm(v);
        }
        if (lane < 4) { LBE[4 * w + lane] = sigm(rb_); LEG[4 * w + lane] = __expf(nAexp * softplus_f(ra_ + dtb)); }
        __syncthreads();
        if (c + 1 < TSEQ / 32) load_chunk(c + 1);
#pragma unroll 2
        for (int tl = 0; tl < 32; ++tl) {
            const int o = tl * 128 + ks * 8;
            const f32x4 k0 = *(const LAS f32x4*)(LK + o), k1 = *(const LAS f32x4*)(LK + o + 4);
            const f32x4 q0 = *(const LAS f32x4*)(LQ + o), q1 = *(const LAS f32x4*)(LQ + o + 4);
            const float vv = LV[tl * 32 + row], be = LBE[tl], eg = LEG[tl];
            float dk = ((S[0] * k0.x + S[1] * k0.y) + (S[2] * k0.z + S[3] * k0.w)) + ((S[4] * k1.x + S[5] * k1.y) + (S[6] * k1.z + S[7] * k1.w));
            dk = row16_sum(dk);
            const float u = be * (vv - eg * dk);
            S[0] = S[0] * eg + u * k0.x; S[1] = S[1] * eg + u * k0.y; S[2] = S[2] * eg + u * k0.z; S[3] = S[3] * eg + u * k0.w;
            S[4] = S[4] * eg + u * k1.x; S[5] = S[5] * eg + u * k1.y; S[6] = S[6] * eg + u * k1.z; S[7] = S[7] * eg + u * k1.w;
            float oo = ((S[0] * q0.x + S[1] * q0.y) + (S[2] * q0.z + S[3] * q0.w)) + ((S[4] * q1.x + S[5] * q1.y) + (S[6] * q1.z + S[7] * q1.w));
            oo = row16_sum(oo);
            if (ks == 0) LO[tl * 32 + row] = oo;
        }
        __syncthreads();
        { const int tl = tid >> 4, r2 = (tid & 15) * 2; const size_t n = (size_t)b * TSEQ + c * 32 + tl;
          *(unsigned*)(go + n * 512 + h * 128 + rq * 32 + r2) = pk2(LO[tl * 32 + r2], LO[tl * 32 + r2 + 1]); }
    }
}

__device__ __forceinline__ void gla_task(const Args& a, Frame& F, int l, int task) {
    const WsMap m = ws_map(NTOK);
    const int b = task >> 3, h = (task >> 1) & 3, chh = task & 1;
    LAS float* LQ = (LAS float*)F.lds; LAS float* LK = LQ + 2048; LAS float* LAL = LK + 2048; LAS float* LV = LAL + 2048; LAS float* LO = LV + 2048;
    const int lane = F.lane, w = F.wave, tid = F.tid;
    const bf16_t* p16 = (const bf16_t*)(a.ws + m.p16); const bf16_t* ao = (const bf16_t*)(a.ws + m.auxo);
    bf16_t* go = (bf16_t*)(a.ws + m.glao);
    float S[8];
#pragma unroll
    for (int j = 0; j < 8; ++j) S[j] = 0.f;
    const int col = tid >> 3, ks = tid & 7;
    float in_[4][4];
    auto load_chunk = [&](int c) {
#pragma unroll
        for (int q = 0; q < 4; ++q) { const size_t n = (size_t)b * TSEQ + c * 32 + w + 8 * q;
            in_[q][0] = bf2f(p16[n * PLD + C_GLA + h * 64 + lane]); in_[q][1] = bf2f(p16[n * PLD + C_GLA + 256 + h * 64 + lane]);
            in_[q][2] = bf2f(ao[n * 1792 + 1536 + h * 64 + lane]); in_[q][3] = bf2f(p16[n * PLD + C_GLA + 512 + h * 128 + chh * 64 + lane]); }
    };
    load_chunk(0);
    for (int c = 0; c < TSEQ / 32; ++c) {
#pragma unroll
        for (int q = 0; q < 4; ++q) { const int tl = w + 8 * q;
            LQ[tl * 64 + lane] = in_[q][0] * 0.125f; LK[tl * 64 + lane] = in_[q][1];
            LAL[tl * 64 + lane] = __expf(-softplus_f(-in_[q][2]) * (1.0f / 16.0f)); LV[tl * 64 + lane] = in_[q][3]; }
        __syncthreads();
        if (c + 1 < TSEQ / 32) load_chunk(c + 1);
#pragma unroll 2
        for (int tl = 0; tl < 32; ++tl) {
            const int o = tl * 64 + ks * 8;
            const f32x4 a0 = *(const LAS f32x4*)(LAL + o), a1 = *(const LAS f32x4*)(LAL + o + 4);
            const f32x4 k0 = *(const LAS f32x4*)(LK + o), k1 = *(const LAS f32x4*)(LK + o + 4);
            const f32x4 q0 = *(const LAS f32x4*)(LQ + o), q1 = *(const LAS f32x4*)(LQ + o + 4);
            const float vv = LV[tl * 64 + col];
            S[0] = S[0] * a0.x + k0.x * vv; S[1] = S[1] * a0.y + k0.y * vv; S[2] = S[2] * a0.z + k0.z * vv; S[3] = S[3] * a0.w + k0.w * vv;
            S[4] = S[4] * a1.x + k1.x * vv; S[5] = S[5] * a1.y + k1.y * vv; S[6] = S[6] * a1.z + k1.z * vv; S[7] = S[7] * a1.w + k1.w * vv;
            float oo = ((S[0] * q0.x + S[1] * q0.y) + (S[2] * q0.z + S[3] * q0.w)) + ((S[4] * q1.x + S[5] * q1.y) + (S[6] * q1.z + S[7] * q1.w));
            oo = red8(oo);
            if (ks == 0) LO[tl * 64 + col] = oo;
        }
        __syncthreads();
#pragma unroll
        for (int q = 0; q < 4; ++q) { const int tl = w + 8 * q; const size_t n = (size_t)b * TSEQ + c * 32 + tl;
            go[n * 512 + h * 128 + chh * 64 + lane] = f2bf(LO[tl * 64 + lane]); }
    }
}

__device__ __forceinline__ void lru_task(const Args& a, Frame& F, int l, int task) {
    const WsMap m = ws_map(NTOK);
    const int b = task >> 3, cg = task & 7;
    LAS float* AP = (LAS float*)F.lds; LAS float* HL = AP + 512;
    const int lane = F.lane, w = F.wave;
    const int ch = cg * 64 + lane;
    const bf16_t* gt = (const bf16_t*)(a.ws + m.gates); const bf16_t* xc = (const bf16_t*)(a.ws + m.xc); const bf16_t* p16 = (const bf16_t*)(a.ws + m.p16);
    bf16_t* mix = (bf16_t*)(a.ws + m.mix16);
    const float sp8 = 8.0f * softplus_f(-a.in[I_LRU_LAM][l * 512 + ch]);
    const size_t nb = (size_t)b * TSEQ + (size_t)w * 512;
    float hh = 0.f, ap = 1.f;
#pragma unroll 8
    for (int t = 0; t < 512; ++t) { const size_t n = nb + t;
        const float la = -sp8 * sigm(bf2f(gt[n * 1024 + ch]));
        const float u = bf2f(xc[n * 512 + ch]) * sigm(bf2f(gt[n * 1024 + 512 + ch])) * sqrtf(-expm1f(2.0f * la));
        const float av = __expf(la);
        hh = av * hh + u; ap *= av; }
    AP[w * 64 + lane] = ap; HL[w * 64 + lane] = hh;
    __syncthreads();
    hh = 0.f;
    for (int s = 0; s < w; ++s) hh = AP[s * 64 + lane] * hh + HL[s * 64 + lane];
#pragma unroll 8
    for (int t = 0; t < 512; ++t) { const size_t n = nb + t;
        const float la = -sp8 * sigm(bf2f(gt[n * 1024 + ch]));
        const float u = bf2f(xc[n * 512 + ch]) * sigm(bf2f(gt[n * 1024 + 512 + ch])) * sqrtf(-expm1f(2.0f * la));
        hh = __expf(la) * hh + u;
        mix[n * DM + 1024 + ch] = f2bf(hh * gelu_fast(bf2f(p16[n * PLD + C_LRU + 512 + ch]))); }
}

__device__ __forceinline__ void scan_phase(const Args& a, Frame& F, int l) {
    const int task = blockIdx.x;
    if (task < 32) rwkv_task(a, F, l, task);
    else if (task < 96) gdn_task(a, F, l, task - 32);
    else if (task < 128) gla_task(a, F, l, task - 96);
    else if (task < 160) lru_task(a, F, l, task - 128);
}

__device__ __forceinline__ void post_phase(const Args& a, Frame& F, int l) {
    const WsMap m = ws_map(NTOK);
    const bf16_t* p16 = (const bf16_t*)(a.ws + m.p16); const bf16_t* glao = (const bf16_t*)(a.ws + m.glao); const bf16_t* gdno = (const bf16_t*)(a.ws + m.gdno);
    bf16_t* mix = (bf16_t*)(a.ws + m.mix16);
    const int lane = F.lane, col = lane * 8, hc = col & 127;
    float gg[8], gd[8];
    { const f32x4 x0 = *(const f32x4*)(a.in[I_GLA_NORM] + l * 128 + hc), x1 = *(const f32x4*)(a.in[I_GLA_NORM] + l * 128 + hc + 4);
      gg[0] = x0.x; gg[1] = x0.y; gg[2] = x0.z; gg[3] = x0.w; gg[4] = x1.x; gg[5] = x1.y; gg[6] = x1.z; gg[7] = x1.w;
      const f32x4 y0 = *(const f32x4*)(a.in[I_GDN_NORM] + l * 128 + hc), y1 = *(const f32x4*)(a.in[I_GDN_NORM] + l * 128 + hc + 4);
      gd[0] = y0.x; gd[1] = y0.y; gd[2] = y0.z; gd[3] = y0.w; gd[4] = y1.x; gd[5] = y1.y; gd[6] = y1.z; gd[7] = y1.w; }
    for (int n = F.gw; n < NTOK; n += F.ngw) {
#pragma unroll
        for (int which = 0; which < 2; ++which) {
            float o[8], g[8];
            unpack8(ld8((which ? gdno : glao) + (size_t)n * 512 + col), o);
            unpack8(ld8(p16 + (size_t)n * PLD + (which ? C_GDN + 1536 : C_GLA + 1024) + col), g);
            float ss = 0.f;
#pragma unroll
            for (int k = 0; k < 8; ++k) ss += o[k] * o[k];
            ss = row16_sum(ss);
            const float rs = 1.0f / sqrtf(ss * (1.0f / 128.0f) + 1e-6f);
#pragma unroll
            for (int k = 0; k < 8; ++k) o[k] = o[k] * rs * (which ? gd[k] : gg[k]) * (g[k] * sigm(g[k]));
            *(v4u*)(mix + (size_t)n * DM + (which ? 1536 : 512) + col) = pack8(o);
        }
    }
}

__device__ __forceinline__ void norm2_phase(const Args& a, Frame& F, int l) {
    const WsMap m = ws_map(NTOK);
    const float* gain = a.in[I_NORM_FFN] + l * DM;
    f32x4 gv[8];
#pragma unroll
    for (int j = 0; j < 8; ++j) gv[j] = ((const f32x4*)gain)[64 * j + F.lane];
    for (int n = F.gw; n < NTOK; n += F.ngw) {
        const f32x4* xr = (const f32x4*)(a.out + (size_t)n * DM) + F.lane;
        f32x4 v[8]; float s = 0.f;
#pragma unroll
        for (int j = 0; j < 8; ++j) { v[j] = xr[64 * j]; s += (v[j].x * v[j].x + v[j].y * v[j].y) + (v[j].z * v[j].z + v[j].w * v[j].w); }
        const float rstd = 1.0f / sqrtf(wave_sum_u(s) * (1.0f / DM) + 1e-6f);
        v2u* o8 = (v2u*)((bf16_t*)(a.ws + m.hb) + (size_t)n * DM) + F.lane;
#pragma unroll
        for (int j = 0; j < 8; ++j) { v2u w; w.x = pk2(v[j].x * rstd * gv[j].x, v[j].y * rstd * gv[j].y); w.y = pk2(v[j].z * rstd * gv[j].z, v[j].w * rstd * gv[j].w); o8[64 * j] = w; }
    }
}

#define TK_INSERT(XV, XI, TS, TI) do { float xv_ = (XV); int xi_ = (XI); if (xv_ > TS[15]) { _Pragma("unroll") for (int j_ = 0; j_ < 16; ++j_) { \
    if (xv_ > TS[j_]) { const float tv_ = TS[j_]; const int tj_ = TI[j_]; TS[j_] = xv_; TI[j_] = xi_; xv_ = tv_; xi_ = tj_; } } } } while (0)
__device__ __forceinline__ void topk_phase(const Args& a, Frame& F) {
    const WsMap m = ws_map(NTOK);
    const float* sc = (const float*)(a.ws + m.sc);
    int* idx = (int*)(a.ws + m.idx); float* gate = (float*)(a.ws + m.gate);
    LAS float* LS = (LAS float*)F.lds;
    LAS int* LI = (LAS int*)F.lds;
    const int t = F.tid;
    for (int it = F.vcu * NTHR + F.tid; it < NTOK * 8; it += F.G * NTHR) {
        const f32x4* s4 = (const f32x4*)(sc + (size_t)it * 256);
#pragma unroll 1
        for (int half = 0; half < 2; ++half) {
            float ts[16]; int ti[16];
#pragma unroll
            for (int j = 0; j < 16; ++j) { ts[j] = -3.0e38f; ti[j] = 0; }
#pragma unroll 1
            for (int i = 0; i < 32; ++i) { const f32x4 v = s4[half * 32 + i];
                TK_INSERT(v.x, 4 * i, ts, ti); TK_INSERT(v.y, 4 * i + 1, ts, ti); TK_INSERT(v.z, 4 * i + 2, ts, ti); TK_INSERT(v.w, 4 * i + 3, ts, ti); }
#pragma unroll
            for (int j = 0; j < 16; ++j) { LS[((half * 2 + 0) * 16 + j) * 512 + t] = ts[j]; LI[((half * 2 + 1) * 16 + j) * 512 + t] = ti[j]; }
        }
        float ts[16]; int ti[16];
#pragma unroll
        for (int j = 0; j < 16; ++j) { ts[j] = -3.0e38f; ti[j] = 0; }
#pragma unroll 1
        for (int p = 0; p < 16; ++p) {
            const float sp = LS[(0 * 16 + p) * 512 + t]; const int ip = LI[(1 * 16 + p) * 512 + t] * 128;
            const int qn = 16 / (p + 1);
#pragma unroll 1
            for (int q = 0; q < qn; ++q) { const float sq = LS[(2 * 16 + q) * 512 + t]; const int iq = LI[(3 * 16 + q) * 512 + t];
                TK_INSERT(sp + sq, ip + iq, ts, ti); }
        }
        const float mx = ts[0]; float den = 0.f;
#pragma unroll
        for (int j = 0; j < 16; ++j) { ts[j] = __expf(ts[j] - mx); den += ts[j]; }
        const float inv = 1.0f / den;
        f32x4* go = (f32x4*)(gate + (size_t)it * 16); v4u* io = (v4u*)(idx + (size_t)it * 16);
#pragma unroll
        for (int j = 0; j < 4; ++j) { go[j] = (f32x4){ts[4 * j] * inv, ts[4 * j + 1] * inv, ts[4 * j + 2] * inv, ts[4 * j + 3] * inv};
            io[j] = (v4u){(unsigned)ti[4 * j], (unsigned)ti[4 * j + 1], (unsigned)ti[4 * j + 2], (unsigned)ti[4 * j + 3]}; }
    }
}

__device__ __forceinline__ void peer_phase(const Args& a, Frame& F, int l) {
    const WsMap m = ws_map(NTOK);
    const unsigned char* TU = (const unsigned char*)(a.ws + m.tabu) + (size_t)l * 2 * NEXP * DM;
    const unsigned char* TV = TU + (size_t)NEXP * DM;
    const int* idx = (const int*)(a.ws + m.idx); const float* gate = (const float*)(a.ws + m.gate);
    const int lane = F.lane;
    for (int n = F.gw; n < NTOK; n += F.ngw) {
        f32x2 xf[16];
        { const v4u* hr = (const v4u*)((const bf16_t*)(a.ws + m.hb) + (size_t)n * DM);
#pragma unroll
          for (int c = 0; c < 2; ++c)
#pragma unroll
              for (int hh = 0; hh < 2; ++hh) { const v4u w = hr[c * 128 + lane * 2 + hh]; const int o = c * 8 + hh * 4;
                  xf[o + 0] = (f32x2){bflo(w.x), bfhi(w.x)}; xf[o + 1] = (f32x2){bflo(w.y), bfhi(w.y)}; xf[o + 2] = (f32x2){bflo(w.z), bfhi(w.z)}; xf[o + 3] = (f32x2){bflo(w.w), bfhi(w.w)}; } }
        const int e0 = idx[(size_t)n * 128 + lane], e1 = idx[(size_t)n * 128 + 64 + lane];
        const float g0 = gate[(size_t)n * 128 + lane], g1 = gate[(size_t)n * 128 + 64 + lane];
        float d0 = 0.f, d1 = 0.f;
#pragma unroll
        for (int half = 0; half < 2; ++half) {
            const int ev = half ? e1 : e0; float dd = 0.f;
            for (int j = 0; j < 64; j += 8) {
                v4u u[8][2];
#pragma unroll
                for (int r = 0; r < 8; ++r) { const int e = __builtin_amdgcn_readlane(ev, j + r);
                    const v4u* row = (const v4u*)(TU + (size_t)e * DM) + lane;
                    u[r][0] = row[0]; u[r][1] = row[64]; }
#pragma unroll
                for (int r = 0; r < 8; ++r) { f32x2 a0 = {0.f, 0.f}, a1 = {0.f, 0.f};
#pragma unroll
                    for (int c = 0; c < 2; ++c) { const unsigned wv[4] = {u[r][c].x, u[r][c].y, u[r][c].z, u[r][c].w};
#pragma unroll
                        for (int k = 0; k < 4; ++k) { a0 += __builtin_amdgcn_cvt_pk_f32_fp8((int)wv[k], false) * xf[c * 8 + k * 2]; a1 += __builtin_amdgcn_cvt_pk_f32_fp8((int)wv[k], true) * xf[c * 8 + k * 2 + 1]; } }
                    const float t = wave_sum_u((a0.x + a0.y) + (a1.x + a1.y));
                    dd = (lane == j + r) ? t : dd; }
            }
            if (half) d1 = dd; else d0 = dd;
        }
        const float c0 = gelu_fast(d0 * (1.0f / 1024.0f)) * g0 * (1.0f / 64.0f), c1 = gelu_fast(d1 * (1.0f / 1024.0f)) * g1 * (1.0f / 64.0f);
        f32x2 o[16];
#pragma unroll
        for (int i = 0; i < 16; ++i) o[i] = (f32x2){0.f, 0.f};
#pragma unroll
        for (int half = 0; half < 2; ++half) {
            const int ev = half ? e1 : e0; const float cv = half ? c1 : c0;
            for (int j = 0; j < 64; j += 8) {
                v4u v[8][2]; float cj[8];
#pragma unroll
                for (int r = 0; r < 8; ++r) { const int e = __builtin_amdgcn_readlane(ev, j + r); cj[r] = rdlane_f(cv, j + r);
                    const v4u* row = (const v4u*)(TV + (size_t)e * DM) + lane;
                    v[r][0] = row[0]; v[r][1] = row[64]; }
#pragma unroll
                for (int r = 0; r < 8; ++r)
#pragma unroll
                    for (int c = 0; c < 2; ++c) { const unsigned wv[4] = {v[r][c].x, v[r][c].y, v[r][c].z, v[r][c].w};
#pragma unroll
                        for (int k = 0; k < 4; ++k) { o[c * 8 + k * 2] += __builtin_amdgcn_cvt_pk_f32_fp8((int)wv[k], false) * cj[r]; o[c * 8 + k * 2 + 1] += __builtin_amdgcn_cvt_pk_f32_fp8((int)wv[k], true) * cj[r]; } }
            }
        }
        float* xrow = a.out + (size_t)n * DM;
        float s = 0.f;
#pragma unroll
        for (int c = 0; c < 2; ++c)
#pragma unroll
            for (int q = 0; q < 4; ++q) { const f32x4 x4 = *(const f32x4*)(xrow + c * 1024 + lane * 16 + q * 4);
                o[c * 8 + q * 2].x += x4.x; o[c * 8 + q * 2].y += x4.y; o[c * 8 + q * 2 + 1].x += x4.z; o[c * 8 + q * 2 + 1].y += x4.w;
                s += (o[c * 8 + q * 2].x * o[c * 8 + q * 2].x + o[c * 8 + q * 2].y * o[c * 8 + q * 2].y) + (o[c * 8 + q * 2 + 1].x * o[c * 8 + q * 2 + 1].x + o[c * 8 + q * 2 + 1].y * o[c * 8 + q * 2 + 1].y); }
        const float rstd = 1.0f / sqrtf(wave_sum_u(s) * (1.0f / DM) + 1e-6f);
        if (l + 1 < NL) {
            bf16_t* xo = (bf16_t*)(a.ws + m.xn) + (size_t)n * DM;
#pragma unroll
            for (int c = 0; c < 2; ++c) {
#pragma unroll
                for (int q = 0; q < 4; ++q) *(f32x4*)(xrow + c * 1024 + lane * 16 + q * 4) = (f32x4){o[c * 8 + q * 2].x, o[c * 8 + q * 2].y, o[c * 8 + q * 2 + 1].x, o[c * 8 + q * 2 + 1].y};
#pragma unroll
                for (int hh = 0; hh < 2; ++hh) { const int b0 = c * 8 + hh * 4; v4u w;
                    w.x = pk2(o[b0].x * rstd, o[b0].y * rstd); w.y = pk2(o[b0 + 1].x * rstd, o[b0 + 1].y * rstd); w.z = pk2(o[b0 + 2].x * rstd, o[b0 + 2].y * rstd); w.w = pk2(o[b0 + 3].x * rstd, o[b0 + 3].y * rstd);
                    *(v4u*)(xo + c * 1024 + lane * 16 + hh * 8) = w; } }
        } else {
            const float* gf = a.in[I_NORM_FINAL];
#pragma unroll
            for (int c = 0; c < 2; ++c)
#pragma unroll
                for (int q = 0; q < 4; ++q) { const f32x4 g4 = *(const f32x4*)(gf + c * 1024 + lane * 16 + q * 4);
                    *(f32x4*)(xrow + c * 1024 + lane * 16 + q * 4) = (f32x4){o[c * 8 + q * 2].x * rstd * g4.x, o[c * 8 + q * 2].y * rstd * g4.y, o[c * 8 + q * 2 + 1].x * rstd * g4.z, o[c * 8 + q * 2 + 1].y * rstd * g4.w}; }
        }
    }
}

#define IN(k) (lo <= (k) && (k) < hi)
#define SEAM(k) do { if (IN(k) && IN((k) + 1)) xcd_barrier(bar); } while (0)
template <int l>
__device__ __forceinline__ void layer_phases(const Args& a, Frame& F, const XcdBarrier& bar, const WsMap& m, int lo, int hi) {
    constexpr int pb = l * PH_PER_LAYER;
        if (IN(pb + PH_GEMM1)) {
            pg8::GemmX g{(const bf16_t*)(a.ws + m.xn), (const bf16_t*)(a.ws + m.w1t) + (size_t)l * PLD * DM, NTOK, PLD, DM, DM};
            pg8::StaticOrder S; S.init(NTOK, PLD, F.G, (int)blockIdx.x);
            pg8::EpiBf16 E{(bf16_t*)(a.ws + m.p16), PLD, nullptr};
            pg8::gemm_phase<pg8::EpiBf16, pg8::StaticOrder, true, true>(F.lds, g, S, E);
            SEAM(pb + PH_GEMM1);
        }
        if (IN(pb + PH_PREP)) { prep_phase(a, F, l); SEAM(pb + PH_PREP); }
        if (IN(pb + PH_AUX)) {
            const float* PP = (const float*)(a.ws + m.pp);
            { pg8::GemmX g{(const bf16_t*)(a.ws + m.auxA), (const bf16_t*)(a.ws + m.auxwt) + (size_t)l * 1792 * 384, NTOK, 1792, 384, 384};
              pg8::StaticOrder S; S.init(NTOK, 1792, F.G, (int)blockIdx.x);
              pg8::EpiBf16 E{(bf16_t*)(a.ws + m.auxo), 1792, PP + l * 1792};
              pg8::gemm_phase<pg8::EpiBf16, pg8::StaticOrder, true, true>(F.lds, g, S, E); }
            { pg8::GemmX g{(const bf16_t*)(a.ws + m.xc), (const bf16_t*)(a.ws + m.lruwt) + (size_t)l * 1024 * 512, NTOK, 1024, 512, 512};
              pg8::StaticOrder S; S.init(NTOK, 1024, F.G, (int)blockIdx.x);
              pg8::EpiBf16 E{(bf16_t*)(a.ws + m.gates), 1024, PP + 3584 + l * 1024};
              pg8::gemm_phase<pg8::EpiBf16, pg8::StaticOrder, true, true>(F.lds, g, S, E); }
            if (l > 0) {
              pg8::GemmX g{(const bf16_t*)(a.ws + m.zrkv) + 1024, (const bf16_t*)(a.ws + m.vreswt), NTOK, 512, 512, 1536};
              pg8::StaticOrder S; S.init(NTOK, 512, F.G, (int)blockIdx.x);
              pg8::EpiBf16 E{(bf16_t*)(a.ws + m.vres), 512, PP + 5632};
              pg8::gemm_phase<pg8::EpiBf16, pg8::StaticOrder, true, true>(F.lds, g, S, E); }
            SEAM(pb + PH_AUX);
        }
        if (IN(pb + PH_SCAN)) { scan_phase(a, F, l); SEAM(pb + PH_SCAN); }
        if (IN(pb + PH_POST)) { post_phase(a, F, l); SEAM(pb + PH_POST); }
        if (IN(pb + PH_GEMM2)) {
            pg8::GemmX g{(const bf16_t*)(a.ws + m.mix16), (const bf16_t*)(a.ws + m.w2t) + (size_t)l * DM * DM, NTOK, DM, DM, DM};
            pg8::StaticOrder S; S.init(NTOK, DM, F.G, (int)blockIdx.x);
            pg8::EpiF32<true> E{a.out, DM};
            pg8::gemm_phase<pg8::EpiF32<true>, pg8::StaticOrder, true, true>(F.lds, g, S, E);
            SEAM(pb + PH_GEMM2);
        }
        if (IN(pb + PH_NORM2)) { norm2_phase(a, F, l); SEAM(pb + PH_NORM2); }
        if (IN(pb + PH_GEMM3)) {
            pg8::GemmX g{(const bf16_t*)(a.ws + m.hb), (const bf16_t*)(a.ws + m.wsct) + (size_t)l * DM * DM, NTOK, DM, DM, DM};
            pg8::StaticOrder S; S.init(NTOK, DM, F.G, (int)blockIdx.x);
            pg8::EpiF32<false> E{(float*)(a.ws + m.sc), DM};
            pg8::gemm_phase<pg8::EpiF32<false>, pg8::StaticOrder, true, true>(F.lds, g, S, E);
            SEAM(pb + PH_GEMM3);
        }
        if (IN(pb + PH_TOPK)) { topk_phase(a, F); SEAM(pb + PH_TOPK); }
        if (IN(pb + PH_PEER)) { peer_phase(a, F, l); SEAM(pb + PH_PEER); }
}

#undef IN
#undef SEAM
__global__ void __launch_bounds__(NTHR, 2) mega(Args a) {
    extern __shared__ __attribute__((aligned(16))) unsigned char lds_raw[];
    Frame F;
    F.lds = (LAS unsigned char*)lds_raw;
    F.tid = threadIdx.x; F.lane = F.tid & 63; F.wave = __builtin_amdgcn_readfirstlane(F.tid >> 6);
    F.G = gridDim.x; { const int bx = blockIdx.x; F.vcu = (F.G % 8 == 0) ? (bx % 8) * (F.G / 8) + bx / 8 : bx; }
    F.gw = F.vcu * NWAVES + F.wave; F.ngw = F.G * NWAVES;
    volatile LAS unsigned* MISC = (volatile LAS unsigned*)(F.lds + MISC_OFF);
    if (F.tid < 32) MISC[F.tid] = 0u;
    __syncthreads();
    const WsMap m = ws_map(NTOK);
    unsigned* ctl = (unsigned*)(a.ws + m.ctl);
    XcdBarrier bar; bar.bar = ctl + 4096 + a.li * XCD_BAR_WORDS; bar.x = 0; bar.st = nullptr;
    const int lo = a.ph_lo, hi = a.ph_hi;
    if (hi - lo > 1) bar = xcd_barrier_post(ctl + 4096 + a.li * XCD_BAR_WORDS, MISC + 8);
#define IN(k) (lo <= (k) && (k) < hi)
#define SEAM(k) do { if (IN(k) && IN((k) + 1)) xcd_barrier(bar); } while (0)
    if (IN(PH_P0)) { p0_prologue(a, F); tables_phase(a, F, 0, NL); SEAM(PH_P0); }
    if (lo >= 100) { tables_phase(a, F, lo - 100, hi - 100); }
    layer_phases<0>(a, F, bar, m, lo, hi);
    layer_phases<1>(a, F, bar, m, lo, hi);
#undef IN
#undef SEAM
}

template <int ST>
__global__ void __launch_bounds__(256) stage_kernel(Params P, int l) {
    const long n = stage_items(P, ST, l);
    for (long it = blockIdx.x * 256L + threadIdx.x; it < n; it += gridDim.x * 256L) run_item(P, ST, l, it);
}
template <int ST>
static void launch_stage(const Params& P, int l, hipStream_t stream) {
    const long n = stage_items(P, ST, l);
    if (n <= 0) return;
    long blocks = (n + 255) / 256;
    if (blocks > 8192) blocks = 8192;
    stage_kernel<ST><<<dim3((unsigned)blocks), dim3(256), 0, stream>>>(P, l);
}
#define LS(X) case X: launch_stage<X>(P, l, stream); break;
static void launch_any(int st, const Params& P, int l, hipStream_t stream) {
    switch (st) {
        LS(ST_COPYX) LS(ST_RSTD) LS(ST_NORM1) LS(ST_GEMM1) LS(ST_RW_A0) LS(ST_RW_A1) LS(ST_RW_A2) LS(ST_RW_A3) LS(ST_RW_KKN)
        LS(ST_RW_SCAN) LS(ST_RW_POST) LS(ST_GLA_B0) LS(ST_GLA_SCAN) LS(ST_GLA_POST) LS(ST_LRU_C0) LS(ST_LRU_C1) LS(ST_LRU_SCAN)
        LS(ST_GDN_D0) LS(ST_GDN_D1) LS(ST_GDN_SCAN) LS(ST_GDN_POST) LS(ST_GEMM2) LS(ST_RSTD2) LS(ST_NORM2) LS(ST_GEMM3)
        LS(ST_SCORES) LS(ST_TOPK1) LS(ST_TOPK2) LS(ST_PEER_U) LS(ST_PEER_V) LS(ST_FRSTD) LS(ST_FNORM)
    }
}

extern "C" void kernel_launch(void* const* d_in, const int* in_sizes, int n_in, void* d_out, int out_size, void* d_ws,
                              size_t ws_size, hipStream_t stream) {
    static int grid = 0;
    if (grid == 0) {
        int dev = 0, cus = 0;
        (void)hipGetDevice(&dev);
        (void)hipDeviceGetAttribute(&cus, hipDeviceAttributeMultiprocessorCount, dev);
        (void)hipFuncSetAttribute((const void*)mega, hipFuncAttributeMaxDynamicSharedMemorySize, LDS_BYTES);
        grid = cus > 0 ? cus : 256;
    }
    Params P;
    memset(&P, 0, sizeof(P));
    fill_inputs(P, d_in);
    P.B = 4; P.T = 4096; P.N = 16384; P.pad = 0;
    P.xcur = (float*)d_out;
    bind_ws(P, (char*)d_ws);
    Args a;
    memset(&a, 0, sizeof(a));
    for (int i = 0; i < 38; ++i) a.in[i] = (const float*)d_in[i];
    a.out = (float*)d_out; a.ws = (unsigned char*)d_ws;
    (void)hipMemsetAsync(d_ws, 0, 1u << 20, stream);
    int li = 0;
    auto run_mega = [&](int lo, int hi) { a.ph_lo = lo; a.ph_hi = hi; a.li = li++; hipLaunchKernelGGL(mega, dim3(grid), dim3(NTHR), LDS_BYTES, stream, a); };
    run_mega(PH_P0, PH_TOTAL);
}
#endif
```

```cpp
#ifndef HOST_EMU
#include <hip/hip_runtime.h>
#include <cstring>
#define HD __host__ __device__ __forceinline__
#else
#include <cmath>
#include <cstdio>
#include <cstdlib>
#include <cstring>
#define HD inline
#endif

constexpr int DM = 2048;
constexpr int NL = 2;
constexpr int INC = 6424;
constexpr int C_RW = 0;
constexpr int C_GLA = 1792;
constexpr int C_LRU = 3344;
constexpr int C_GDN = 4368;
constexpr int NEXP = 16384;

typedef unsigned short bf16_t;
constexpr int PLD = 6656;
HD float bf2f(bf16_t h) { unsigned u = (unsigned)h << 16; float f; memcpy(&f, &u, 4); return f; }
HD bf16_t f2bf(float f) { unsigned u; memcpy(&u, &f, 4); return (bf16_t)((u + 0x7fffu + ((u >> 16) & 1u)) >> 16); }

struct Params {
    const float *x, *norm_mix, *w_in, *w_out, *rw_mu, *rw_w0, *rw_w_up, *rw_a0, *rw_a_up, *rw_g_up, *rw_k_k, *rw_k_a,
        *rw_r_k, *rw_ln_w, *rw_ln_b, *rw_v0, *rw_v_down, *rw_v_up, *gla_a_up, *gla_a_bias, *gla_norm, *lru_conv_w,
        *lru_conv_b, *lru_w_r, *lru_b_r, *lru_w_i, *lru_b_i, *lru_lam, *gdn_conv_w, *gdn_a_log, *gdn_dt_bias, *gdn_norm,
        *norm_ffn, *peer_wq, *peer_sub_keys, *peer_u, *peer_v, *norm_final;
    float* xcur;
    bf16_t* xn;
    bf16_t* hb;
    bf16_t* mix16;
    bf16_t* p16;
    float* sc;
    float* qf;
    float* rstd;
    float* vfirst;
    float* scr;
    float* act;
    float* gate;
    int* idx;
    int B, T, N, pad;
};

HD float sigmoidf_(float x) { return 1.0f / (1.0f + expf(-x)); }
HD float softplusf_(float x) { return log1pf(expf(-fabsf(x))) + fmaxf(x, 0.0f); }
HD float siluf_(float x) { return x * sigmoidf_(x); }
HD float geluf_(float x) { return 0.5f * x * (1.0f + tanhf(0.7978845608028654f * (x + 0.044715f * x * x * x))); }

enum Stage {
    ST_COPYX = 0,
    ST_RSTD, ST_NORM1, ST_GEMM1,
    ST_RW_A0, ST_RW_A1, ST_RW_A2, ST_RW_A3, ST_RW_KKN, ST_RW_SCAN, ST_RW_POST,
    ST_GLA_B0, ST_GLA_SCAN, ST_GLA_POST,
    ST_LRU_C0, ST_LRU_C1, ST_LRU_SCAN,
    ST_GDN_D0, ST_GDN_D1, ST_GDN_SCAN, ST_GDN_POST,
    ST_GEMM2, ST_RSTD2, ST_NORM2, ST_GEMM3, ST_SCORES, ST_TOPK1, ST_TOPK2, ST_PEER_U, ST_PEER_V,
    ST_FRSTD, ST_FNORM,
    ST_COUNT
};

constexpr long SO_ZS = 0, SO_R = 256, SO_DEC = 768, SO_KM = 1280, SO_KK = 1792, SO_A = 2304, SO_G = 2816, SO_V = 3328,
               SO_Y = 3840, SO_VD = 4352, SO_KKINV = 4384;
constexpr long SO_ALPHA = 0, SO_GO = 256;
constexpr long SO_XC = 0, SO_LA = 512, SO_LU = 1024;
constexpr long SO_QKV = 0, SO_GS = 1536, SO_DO = 1552;
constexpr long SCR_PER_TOK = 4400;
constexpr long SO_TS = 0, SO_TI = 256;

HD long stage_items(const Params& P, int st, int l) {
    const long N = P.N;
    switch (st) {
        case ST_COPYX: return N * DM;
        case ST_RSTD: case ST_RSTD2: case ST_FRSTD: return N;
        case ST_NORM1: case ST_NORM2: case ST_FNORM: return N * DM;
        case ST_GEMM1: return (N / 4) * (INC / 4);
        case ST_RW_A0: return N * 256;
        case ST_RW_A1: return N * 512;
        case ST_RW_A2: return l > 0 ? N * 32 : 0;
        case ST_RW_A3: return l > 0 ? N * 512 : 0;
        case ST_RW_KKN: return N * 8;
        case ST_RW_SCAN: return (long)P.B * 512;
        case ST_RW_POST: return N * 8;
        case ST_GLA_B0: return N * 256;
        case ST_GLA_SCAN: return (long)P.B * 512;
        case ST_GLA_POST: return N * 4;
        case ST_LRU_C0: return N * 512;
        case ST_LRU_C1: return N * 512;
        case ST_LRU_SCAN: return (long)P.B * 512;
        case ST_GDN_D0: return N * 1536;
        case ST_GDN_D1: return N * 4;
        case ST_GDN_SCAN: return (long)P.B * 512;
        case ST_GDN_POST: return N * 4;
        case ST_GEMM2: case ST_GEMM3: return (N / 4) * (DM / 4);
        case ST_SCORES: return N * 2048;
        case ST_TOPK1: return N * 16;
        case ST_TOPK2: return N * 8;
        case ST_PEER_U: return N * 128;
        case ST_PEER_V: return N * DM;
    }
    return 0;
}

HD void gemm_item(const bf16_t* A, const float* W, int ldw, const float* kscale, float* Cf, bf16_t* Ch, int ldc, int n4, long item, int mode) {
    const long r4 = item / n4;
    const int c4 = (int)(item % n4);
    const bf16_t* a0 = A + (r4 * 4) * (long)DM;
    const float* w = W + c4 * 4;
    float acc[4][4];
    for (int i = 0; i < 4; ++i)
        for (int j = 0; j < 4; ++j) acc[i][j] = 0.f;
    for (int k = 0; k < DM; ++k) {
        const float ks = kscale ? kscale[k] : 1.0f;
        const float w0 = w[(long)k * ldw + 0] * ks, w1 = w[(long)k * ldw + 1] * ks, w2 = w[(long)k * ldw + 2] * ks, w3 = w[(long)k * ldw + 3] * ks;
#pragma unroll
        for (int i = 0; i < 4; ++i) {
            const float a = bf2f(a0[(long)i * DM + k]);
            acc[i][0] += a * w0; acc[i][1] += a * w1; acc[i][2] += a * w2; acc[i][3] += a * w3;
        }
    }
#pragma unroll
    for (int i = 0; i < 4; ++i) {
        const long o = (r4 * 4 + i) * (long)ldc + c4 * 4;
#pragma unroll
        for (int j = 0; j < 4; ++j) {
            if (mode == 0) Ch[o + j] = f2bf(acc[i][j]);
            else if (mode == 1) Cf[o + j] += acc[i][j];
            else Cf[o + j] = acc[i][j];
        }
    }
}

#define PF(n, col) bf2f(P.p16[(long)(n) * PLD + (col)])
HD float rw_shift(const Params& P, int l, long n, int col) {
    const int t = (int)(n % P.T);
    const float cur = PF(n, C_RW + col);
    const float prev = t > 0 ? PF(n - 1, C_RW + col) : 0.f;
    return cur + (prev - cur) * P.rw_mu[l * 1792 + col];
}

HD void run_item(const Params& P, int st, int l, long it) {
    const long N = P.N;
    float* scr = P.scr;
    switch (st) {
        case ST_COPYX: P.xcur[it] = P.x[it]; break;
        case ST_RSTD: case ST_RSTD2: case ST_FRSTD: {
            const float* xr = P.xcur + it * DM;
            float s = 0.f;
            for (int d = 0; d < DM; ++d) s += xr[d] * xr[d];
            P.rstd[it] = 1.0f / sqrtf(s * (1.0f / DM) + 1e-6f);
        } break;
        case ST_NORM1: case ST_NORM2: case ST_FNORM: {
            const long n = it / DM; const int d = (int)(it % DM);
            if (st == ST_NORM1) P.xn[it] = f2bf(P.xcur[it] * P.rstd[n]);
            else if (st == ST_NORM2) P.hb[it] = f2bf(P.xcur[it] * P.rstd[n] * P.norm_ffn[l * DM + d]);
            else P.xcur[it] = P.xcur[it] * P.rstd[n] * P.norm_final[d];
        } break;
        case ST_GEMM1: gemm_item(P.xn, P.w_in + (long)l * DM * INC, INC, P.norm_mix + l * DM, nullptr, P.p16, PLD, INC / 4, it, 0); break;
        case ST_GEMM2: gemm_item(P.mix16, P.w_out + (long)l * DM * DM, DM, nullptr, P.xcur, nullptr, DM, DM / 4, it, 1); break;
        case ST_GEMM3: gemm_item(P.hb, P.peer_wq + (long)l * DM * DM, DM, nullptr, P.qf, nullptr, DM, DM / 4, it, 2); break;
        case ST_RW_A0: {
            const long n = it / 256; const int c = (int)(it % 256);
            const float z = rw_shift(P, l, n, 1536 + c);
            scr[N * SO_ZS + it] = c < 64 ? tanhf(z) : (c < 128 ? z : sigmoidf_(z));
        } break;
        case ST_RW_A1: {
            const long n = it / 512; const int j = (int)(it % 512);
            const float zr = rw_shift(P, l, n, j), zk = rw_shift(P, l, n, 512 + j), zv = rw_shift(P, l, n, 1024 + j);
            const float* zs = scr + N * SO_ZS + n * 256;
            float aw = P.rw_w0[l * 512 + j], aa = P.rw_a0[l * 512 + j], ag = 0.f;
            const float* wu = P.rw_w_up + (long)l * 64 * 512 + j;
            const float* au = P.rw_a_up + (long)l * 64 * 512 + j;
            const float* gu = P.rw_g_up + (long)l * 128 * 512 + j;
            for (int i = 0; i < 64; ++i) { aw += zs[i] * wu[i * 512]; aa += zs[64 + i] * au[i * 512]; }
            for (int i = 0; i < 128; ++i) ag += zs[128 + i] * gu[i * 512];
            const float w_raw = -softplusf_(-aw) - 0.5f;
            const float a = sigmoidf_(aa);
            scr[N * SO_R + it] = zr;
            scr[N * SO_DEC + it] = expf(-expf(w_raw));
            scr[N * SO_KM + it] = zk * (1.0f + (a - 1.0f) * P.rw_k_a[l * 512 + j]);
            scr[N * SO_KK + it] = zk * P.rw_k_k[l * 512 + j];
            scr[N * SO_A + it] = a;
            scr[N * SO_G + it] = ag;
            scr[N * SO_V + it] = zv;
            if (l == 0) P.vfirst[it] = zv;
        } break;
        case ST_RW_A2: {
            const long n = it / 32; const int i = (int)(it % 32);
            const float* v = scr + N * SO_V + n * 512;
            const float* vdn = P.rw_v_down + (long)(l - 1) * 512 * 32 + i;
            float s = 0.f;
            for (int j = 0; j < 512; ++j) s += v[j] * vdn[j * 32];
            scr[N * SO_VD + it] = s;
        } break;
        case ST_RW_A3: {
            const long n = it / 512; const int j = (int)(it % 512);
            const float* vd = scr + N * SO_VD + n * 32;
            const float* vup = P.rw_v_up + (long)(l - 1) * 32 * 512 + j;
            float s = P.rw_v0[(l - 1) * 512 + j];
            for (int i = 0; i < 32; ++i) s += vd[i] * vup[i * 512];
            const float v = scr[N * SO_V + it];
            scr[N * SO_V + it] = v + (P.vfirst[it] - v) * sigmoidf_(s);
        } break;
        case ST_RW_KKN: {
            const float* kk = scr + N * SO_KK + it * 64;
            float s = 0.f;
            for (int i = 0; i < 64; ++i) s += kk[i] * kk[i];
            scr[N * SO_KKINV + it] = 1.0f / sqrtf(fmaxf(s, 1e-24f));
        } break;
        case ST_RW_SCAN: {
            const int b = (int)(it / 512); const int h = (int)((it % 512) / 64); const int v = (int)(it % 64);
            float S[64];
#pragma unroll
            for (int i = 0; i < 64; ++i) S[i] = 0.f;
            for (int t = 0; t < P.T; ++t) {
                const long n = (long)b * P.T + t;
                const long base = n * 512 + h * 64;
                const float inv = scr[N * SO_KKINV + n * 8 + h];
                const float vv = scr[N * SO_V + base + v];
                const float* KK = scr + N * SO_KK + base;
                const float* DEC = scr + N * SO_DEC + base;
                const float* KM = scr + N * SO_KM + base;
                const float* AA = scr + N * SO_A + base;
                const float* RR = scr + N * SO_R + base;
                float sa = 0.f;
#pragma unroll
                for (int i = 0; i < 64; ++i) sa += S[i] * (-KK[i] * inv);
                float y = 0.f;
#pragma unroll
                for (int i = 0; i < 64; ++i) {
                    const float kk = KK[i] * inv;
                    S[i] = S[i] * DEC[i] + sa * (kk * AA[i]) + vv * KM[i];
                    y += S[i] * RR[i];
                }
                scr[N * SO_Y + base + v] = y;
            }
        } break;
        case ST_RW_POST: {
            const long n = it / 8; const int h = (int)(it % 8);
            const long base = n * 512 + h * 64;
            const float* Y = scr + N * SO_Y + base;
            const float* RR = scr + N * SO_R + base;
            const float* KM = scr + N * SO_KM + base;
            const float* V = scr + N * SO_V + base;
            const float* G = scr + N * SO_G + base;
            float mean = 0.f, bon = 0.f;
            for (int i = 0; i < 64; ++i) { mean += Y[i]; bon += RR[i] * KM[i] * P.rw_r_k[l * 512 + h * 64 + i]; }
            mean *= (1.0f / 64);
            float var = 0.f;
            for (int i = 0; i < 64; ++i) { const float d = Y[i] - mean; var += d * d; }
            const float rs = 1.0f / sqrtf(var * (1.0f / 64) + 64e-5f);
            for (int i = 0; i < 64; ++i) {
                const int c = h * 64 + i;
                const float yn = (Y[i] - mean) * rs * P.rw_ln_w[l * 512 + c] + P.rw_ln_b[l * 512 + c];
                P.mix16[n * DM + c] = f2bf((yn + bon * V[i]) * G[i]);
            }
        } break;
        case ST_GLA_B0: {
            const long n = it / 256; const int c = (int)(it % 256);
            float s = P.gla_a_bias[l * 256 + c];
            for (int i = 0; i < 16; ++i) s += PF(n, C_GLA + 1536 + i) * P.gla_a_up[(long)l * 16 * 256 + i * 256 + c];
            scr[N * SO_ALPHA + it] = expf(-softplusf_(-s) * (1.0f / 16.0f));
        } break;
        case ST_GLA_SCAN: {
            const int b = (int)(it / 512); const int h = (int)((it % 512) / 128); const int v = (int)(it % 128);
            float S[64];
#pragma unroll
            for (int i = 0; i < 64; ++i) S[i] = 0.f;
            for (int t = 0; t < P.T; ++t) {
                const long n = (long)b * P.T + t;
                const bf16_t* q = P.p16 + n * PLD + C_GLA + h * 64;
                const bf16_t* k = q + 256;
                const float vv = PF(n, C_GLA + 512 + h * 128 + v);
                const float* al = scr + N * SO_ALPHA + n * 256 + h * 64;
                float o = 0.f;
#pragma unroll
                for (int i = 0; i < 64; ++i) {
                    S[i] = S[i] * al[i] + bf2f(k[i]) * vv;
                    o += bf2f(q[i]) * S[i];
                }
                scr[N * SO_GO + n * 512 + h * 128 + v] = o * 0.125f;
            }
        } break;
        case ST_GLA_POST: {
            const long n = it / 4; const int h = (int)(it % 4);
            const float* o = scr + N * SO_GO + n * 512 + h * 128;
            float ms = 0.f;
            for (int i = 0; i < 128; ++i) ms += o[i] * o[i];
            const float rs = 1.0f / sqrtf(ms * (1.0f / 128) + 1e-6f);
            for (int i = 0; i < 128; ++i) {
                const float g = PF(n, C_GLA + 1024 + h * 128 + i);
                P.mix16[n * DM + 512 + h * 128 + i] = f2bf(o[i] * rs * P.gla_norm[l * 128 + i] * siluf_(g));
            }
        } break;
        case ST_LRU_C0: {
            const long n = it / 512; const int c = (int)(it % 512);
            const int t = (int)(n % P.T);
            float s = P.lru_conv_b[l * 512 + c];
            for (int j = 0; j < 4; ++j) {
                const int tt = t - 3 + j;
                if (tt >= 0) s += P.lru_conv_w[(long)l * 4 * 512 + j * 512 + c] * PF(n - 3 + j, C_LRU + c);
            }
            scr[N * SO_XC + it] = s;
        } break;
        case ST_LRU_C1: {
            const long n = it / 512; const int c = (int)(it % 512);
            const int blk = c / 64, j = c % 64;
            const float* xc = scr + N * SO_XC + n * 512 + blk * 64;
            const float* wr = P.lru_w_r + (long)l * 8 * 64 * 64 + (long)blk * 64 * 64 + j;
            const float* wi = P.lru_w_i + (long)l * 8 * 64 * 64 + (long)blk * 64 * 64 + j;
            float sr = P.lru_b_r[l * 512 + c], si = P.lru_b_i[l * 512 + c];
            for (int i = 0; i < 64; ++i) { sr += xc[i] * wr[i * 64]; si += xc[i] * wi[i * 64]; }
            const float r = sigmoidf_(sr), ig = sigmoidf_(si);
            const float log_a = -8.0f * r * softplusf_(-P.lru_lam[l * 512 + c]);
            scr[N * SO_LA + it] = expf(log_a);
            scr[N * SO_LU + it] = scr[N * SO_XC + it] * ig * sqrtf(-expm1f(2.0f * log_a));
        } break;
        case ST_LRU_SCAN: {
            const int b = (int)(it / 512); const int c = (int)(it % 512);
            float hst = 0.f;
            for (int t = 0; t < P.T; ++t) {
                const long n = (long)b * P.T + t;
                hst = scr[N * SO_LA + n * 512 + c] * hst + scr[N * SO_LU + n * 512 + c];
                P.mix16[n * DM + 1024 + c] = f2bf(hst * geluf_(PF(n, C_LRU + 512 + c)));
            }
        } break;
        case ST_GDN_D0: {
            const long n = it / 1536; const int c = (int)(it % 1536);
            const int t = (int)(n % P.T);
            float s = 0.f;
            for (int j = 0; j < 4; ++j) {
                const int tt = t - 3 + j;
                if (tt >= 0) s += P.gdn_conv_w[(long)l * 4 * 1536 + j * 1536 + c] * PF(n - 3 + j, C_GDN + c);
            }
            scr[N * SO_QKV + it] = siluf_(s);
        } break;
        case ST_GDN_D1: {
            const long n = it / 4; const int h = (int)(it % 4);
            const float* q = scr + N * SO_QKV + n * 1536 + h * 128;
            const float* k = q + 512;
            float qs = 0.f, ks = 0.f;
            for (int i = 0; i < 128; ++i) { qs += q[i] * q[i]; ks += k[i] * k[i]; }
            float* gs = scr + N * SO_GS + n * 16 + h * 4;
            gs[0] = (1.0f / sqrtf(qs + 1e-6f)) * 0.08838834764831845f;
            gs[1] = 1.0f / sqrtf(ks + 1e-6f);
            gs[2] = sigmoidf_(PF(n, C_GDN + 2048 + h));
            gs[3] = expf(-expf(P.gdn_a_log[l * 4 + h]) * softplusf_(PF(n, C_GDN + 2052 + h) + P.gdn_dt_bias[l * 4 + h]));
        } break;
        case ST_GDN_SCAN: {
            const int b = (int)(it / 512); const int h = (int)((it % 512) / 128); const int v = (int)(it % 128);
            float S[128];
#pragma unroll
            for (int i = 0; i < 128; ++i) S[i] = 0.f;
            for (int t = 0; t < P.T; ++t) {
                const long n = (long)b * P.T + t;
                const float* q = scr + N * SO_QKV + n * 1536 + h * 128;
                const float* k = q + 512;
                const float vv = scr[N * SO_QKV + n * 1536 + 1024 + h * 128 + v];
                const float* gs = scr + N * SO_GS + n * 16 + h * 4;
                const float qinv = gs[0], kinv = gs[1], beta = gs[2], eg = gs[3];
                float dk = 0.f;
#pragma unroll
                for (int i = 0; i < 128; ++i) dk += S[i] * k[i];
                const float u = beta * (vv - eg * kinv * dk) * kinv;
                float o = 0.f;
#pragma unroll
                for (int i = 0; i < 128; ++i) {
                    S[i] = S[i] * eg + u * k[i];
                    o += S[i] * q[i];
                }
                scr[N * SO_DO + n * 512 + h * 128 + v] = o * qinv;
            }
        } break;
        case ST_GDN_POST: {
            const long n = it / 4; const int h = (int)(it % 4);
            const float* o = scr + N * SO_DO + n * 512 + h * 128;
            float ms = 0.f;
            for (int i = 0; i < 128; ++i) ms += o[i] * o[i];
            const float rs = 1.0f / sqrtf(ms * (1.0f / 128) + 1e-6f);
            for (int i = 0; i < 128; ++i) {
                const float z = PF(n, C_GDN + 1536 + h * 128 + i);
                P.mix16[n * DM + 1536 + h * 128 + i] = f2bf(o[i] * rs * P.gdn_norm[l * 128 + i] * siluf_(z));
            }
        } break;
        case ST_SCORES: {
            const long n = it / 2048; const int c = (int)(it % 2048);
            const int hp = c / 128, key = c % 128;
            const float* q = P.qf + n * DM + hp * 128;
            const float* sk = P.peer_sub_keys + (long)l * 16 * 128 * 128 + ((long)hp * 128 + key) * 128;
            float s = 0.f;
            for (int d = 0; d < 128; ++d) s += q[d] * sk[d];
            P.sc[it] = s;
        } break;
        case ST_TOPK1: {
            const float* sc = P.sc + it * 128;
            float ts[16]; int ti[16];
#pragma unroll
            for (int j = 0; j < 16; ++j) { ts[j] = -3.0e38f; ti[j] = 0; }
            for (int i = 0; i < 128; ++i) {
                float xv = sc[i]; int xi = i;
                if (xv > ts[15]) {
#pragma unroll
                    for (int j = 0; j < 16; ++j) {
                        if (xv > ts[j]) { const float tv = ts[j]; const int tj = ti[j]; ts[j] = xv; ti[j] = xi; xv = tv; xi = tj; }
                    }
                }
            }
            float* TS = scr + N * SO_TS + it * 16;
            int* TI = (int*)(scr + N * SO_TI) + it * 16;
#pragma unroll
            for (int j = 0; j < 16; ++j) { TS[j] = ts[j]; TI[j] = ti[j]; }
        } break;
        case ST_TOPK2: {
            const float* s0 = scr + N * SO_TS + it * 32;
            const float* s1 = s0 + 16;
            const int* i0 = (const int*)(scr + N * SO_TI) + it * 32;
            const int* i1 = i0 + 16;
            float ts[16]; int ti[16];
#pragma unroll
            for (int j = 0; j < 16; ++j) { ts[j] = -3.0e38f; ti[j] = 0; }
            for (int a = 0; a < 16; ++a) {
                const int jmax = 16 / (a + 1);
                for (int b = 0; b < jmax; ++b) {
                    float xv = s0[a] + s1[b]; int xi = i0[a] * 128 + i1[b];
                    if (xv > ts[15]) {
#pragma unroll
                        for (int j = 0; j < 16; ++j) {
                            if (xv > ts[j]) { const float tv = ts[j]; const int tj = ti[j]; ts[j] = xv; ti[j] = xi; xv = tv; xi = tj; }
                        }
                    }
                }
            }
            const float mx = ts[0];
            float den = 0.f;
#pragma unroll
            for (int j = 0; j < 16; ++j) { ts[j] = expf(ts[j] - mx); den += ts[j]; }
            const float inv = 1.0f / den;
#pragma unroll
            for (int j = 0; j < 16; ++j) { P.gate[it * 16 + j] = ts[j] * inv; P.idx[it * 16 + j] = ti[j]; }
        } break;
        case ST_PEER_U: {
            const long n = it / 128;
            const int e = P.idx[it];
            const float* u = P.peer_u + ((long)l * NEXP + e) * DM;
            const bf16_t* hx = P.hb + n * DM;
            float s = 0.f;
            for (int d = 0; d < DM; ++d) s += bf2f(hx[d]) * u[d];
            P.act[it] = geluf_(s) * P.gate[it];
        } break;
        case ST_PEER_V: {
            const long n = it / DM; const int d = (int)(it % DM);
            const float* a = P.act + n * 128;
            const int* ix = P.idx + n * 128;
            float s = 0.f;
            for (int j = 0; j < 128; ++j) s += a[j] * P.peer_v[((long)l * NEXP + ix[j]) * DM + d];
            P.xcur[it] += s;
        } break;
    }
}


struct WsMap {
    size_t ctl, w1t, w2t, wsct, auxwt, lruwt, vreswt, pp, tabu, tabv, xn, hb, mix16, p16, sc, aux, vfirst, idx, gate, rstd, act, end;
    size_t auxA, zrkv, xc, auxo, gates, vres, glao, gdno, gq, gk, gv, gsc, rwy, rwbv, lrs;
    size_t scr, qf;
};
HD WsMap ws_map(size_t N) {
    WsMap m{};
    size_t o = 0;
    auto take = [&](size_t bytes) { size_t r = o; o += (bytes + 4095) & ~(size_t)4095; return r; };
    m.ctl = take(1u << 20);
    m.w1t = take((size_t)NL * PLD * DM * 2);
    m.w2t = take((size_t)NL * DM * DM * 2);
    m.wsct = take((size_t)NL * DM * DM * 2);
    m.auxwt = take((size_t)NL * 1792 * 384 * 2);
    m.lruwt = take((size_t)NL * 1024 * 512 * 2);
    m.vreswt = take((size_t)512 * 512 * 2);
    m.pp = take(1u << 20);
    m.xn = take(N * DM * 2);
    m.hb = take(N * DM * 2);
    m.mix16 = take(N * DM * 2);
    m.p16 = take(N * PLD * 2);
    m.sc = m.p16;
    m.vfirst = take(N * 512 * 4);
    m.idx = take(N * 128 * 4);
    m.gate = take(N * 128 * 4);
    m.act = take(N * 128 * 4);
    m.rstd = take(N * 4);
    m.tabu = take((size_t)NL * 2 * NEXP * DM);
    m.tabv = m.tabu + (size_t)NEXP * DM;
    m.aux = take(N * 5184 * 4);
    m.end = o;
    size_t a = m.aux;
    auto sub = [&](size_t bytes) { size_t r = a; a += (bytes + 4095) & ~(size_t)4095; return r; };
    m.auxA = sub(N * 384 * 2); m.zrkv = sub(N * 1536 * 2); m.xc = sub(N * 512 * 2); m.auxo = sub(N * 1792 * 2);
    m.gates = sub(N * 1024 * 2); m.vres = sub(N * 512 * 2); m.glao = sub(N * 512 * 2); m.gdno = sub(N * 512 * 2);
    m.gq = sub(N * 512 * 2); m.gk = sub(N * 512 * 2); m.gv = sub(N * 512 * 2); m.gsc = sub(N * 8 * 4); m.rwy = sub(N * 512 * 2); m.rwbv = sub(N * 512 * 2); m.lrs = sub(N / 64 * 512 * 2 * 4);
    m.scr = m.tabu;
    m.qf = m.aux + N * 1024 * 4;
    return m;
}
static inline void bind_ws(Params& P, char* ws) {
    const WsMap m = ws_map((size_t)P.N);
    P.xn = (bf16_t*)(ws + m.xn); P.hb = (bf16_t*)(ws + m.hb); P.mix16 = (bf16_t*)(ws + m.mix16); P.p16 = (bf16_t*)(ws + m.p16);
    P.sc = (float*)(ws + m.sc); P.qf = (float*)(ws + m.qf); P.rstd = (float*)(ws + m.rstd); P.vfirst = (float*)(ws + m.vfirst);
    P.scr = (float*)(ws + m.scr); P.act = (float*)(ws + m.act); P.gate = (float*)(ws + m.gate); P.idx = (int*)(ws + m.idx);
}

struct Step { int st, l; };
static inline int build_schedule(Step* s) {
    int n = 0;
    s[n++] = {ST_COPYX, 0};
    for (int l = 0; l < NL; ++l) {
        static const int per_layer[] = {ST_RSTD, ST_NORM1, ST_GEMM1,
            ST_RW_A0, ST_RW_A1, ST_RW_A2, ST_RW_A3, ST_RW_KKN, ST_RW_SCAN, ST_RW_POST,
            ST_GLA_B0, ST_GLA_SCAN, ST_GLA_POST, ST_LRU_C0, ST_LRU_C1, ST_LRU_SCAN,
            ST_GDN_D0, ST_GDN_D1, ST_GDN_SCAN, ST_GDN_POST,
            ST_GEMM2, ST_RSTD2, ST_NORM2, ST_GEMM3, ST_SCORES, ST_TOPK1, ST_TOPK2, ST_PEER_U, ST_PEER_V};
        for (int i = 0; i < (int)(sizeof(per_layer) / sizeof(int)); ++i) s[n++] = {per_layer[i], l};
    }
    s[n++] = {ST_FRSTD, 0};
    s[n++] = {ST_FNORM, 0};
    return n;
}

static inline void fill_inputs(Params& P, void* const* d_in) {
    const float** dst = (const float**)&P;
    for (int i = 0; i < 38; ++i) dst[i] = (const float*)d_in[i];
}

#ifndef HOST_EMU
#define GAS __attribute__((address_space(1)))
#define LAS __attribute__((address_space(3)))
typedef unsigned v4u __attribute__((ext_vector_type(4)));
typedef unsigned v2u __attribute__((ext_vector_type(2)));
typedef float f32x4 __attribute__((ext_vector_type(4)));
typedef float f32x2 __attribute__((ext_vector_type(2)));
typedef short bf16x8 __attribute__((ext_vector_type(8)));
constexpr int NWAVES = 8, NTHR = 512;
constexpr int RING_BYTES = 131072, MISC_OFF = RING_BYTES + 320, LDS_BYTES = 147456;
constexpr int NTOK = 16384, TSEQ = 4096, NBATCH = 4;

__device__ __forceinline__ unsigned pk2(float lo, float hi) { return (unsigned)f2bf(lo) | ((unsigned)f2bf(hi) << 16); }
__device__ __forceinline__ float bflo(unsigned u) { return __builtin_bit_cast(float, u << 16); }
__device__ __forceinline__ float bfhi(unsigned u) { return __builtin_bit_cast(float, u & 0xffff0000u); }
__device__ __forceinline__ float wave_sum(float v) {
#pragma unroll
    for (int o = 1; o < 64; o <<= 1) v += __shfl_xor(v, o);
    return v;
}
#define LDS_WAIT() asm volatile("s_waitcnt lgkmcnt(0)" ::: "memory")
#define VM_WAIT() asm volatile("s_waitcnt vmcnt(0)" ::: "memory")

namespace pg8 {
#define PG8_LAS __attribute__((address_space(3)))
constexpr int BM = 256, BK = 64, HALF = 128, HTB = HALF * BK * 2, STAGE_BYTES = 8 * HTB, NXCD = 8, WGM = 8;
__host__ __device__ __forceinline__ int lds_byte(int r, int c) { const int st = (r >> 4) * 2 + (c >> 5), rr = r & 15, cc = c & 31, ob = rr * 64 + cc * 2; return st * 1024 + (ob ^ (((ob >> 9) & 1) << 5)); }
__host__ __device__ __forceinline__ void stage_rc(int b, int& R, int& C) { const int st = b / 1024, sb = b % 1024, swz = sb ^ (((sb >> 9) & 1) << 5); R = (st >> 1) * 16 + swz / 64; C = (st & 1) * 32 + (swz % 64) / 2; }
__host__ __device__ __forceinline__ int perm32(int rho) { const int n = rho >> 4, i = rho & 15; return 8 * (i >> 2) + 4 * n + (i & 3); }
struct Unit { int pm, pn; };
struct GemmX { const bf16_t* A; const bf16_t* Bt; int M, N, K, lda; };
struct StaticOrder {
    int nM, nN, nwg, G, c;
    __host__ __device__ void init(int M, int N, int G_, int c_) { nM = M / BM; nN = N / BM; nwg = nM * nN; G = G_; c = c_; }
    __host__ __device__ bool next(int i, Unit& u) const {
        const long L = (long)i * G + c; if (L >= nwg) return false;
        int wgid = (int)L; { const int q = nwg / NXCD, r = nwg % NXCD, xcd = wgid % NXCD, off = wgid / NXCD; wgid = (xcd < r ? xcd * (q + 1) : r * (q + 1) + (xcd - r) * q) + off; }
        const int nig = WGM * nN, gid = wgid / nig, fm = gid * WGM, gsz = (nM - fm) < WGM ? (nM - fm) : WGM;
        u.pm = fm + ((wgid % nig) % gsz); u.pn = (wgid % nig) / gsz; return true;
    }
    __device__ __forceinline__ void a_ready(const Unit&) const {}
    __device__ __forceinline__ void done(const Unit&) const {}
};
__device__ __forceinline__ unsigned cvt_pk_bf16(float lo, float hi) { unsigned r; asm volatile("v_cvt_pk_bf16_f32 %0, %1, %2" : "=v"(r) : "v"(lo), "v"(hi)); return r; }
template <bool ACCUM> struct EpiF32 {
    static constexpr bool PERM = false, AFTER_DRAIN = false;
    float* C; int ldc;
    __device__ __forceinline__ void operator()(const f32x4 (&acc)[2][2][4][2], const Unit& u, int wr, int wc, int fr, int fq) const {
        const int row0 = u.pm * BM + wr * 64 + fr, col0 = u.pn * BM + wc * 32 + 4 * fq;
#pragma unroll
        for (int ai = 0; ai < 2; ++ai)
#pragma unroll
            for (int m = 0; m < 4; ++m) { float* rowp = C + (size_t)(row0 + ai * HALF + m * 16) * ldc + col0;
#pragma unroll
                for (int bj = 0; bj < 2; ++bj)
#pragma unroll
                    for (int n = 0; n < 2; ++n) { f32x4* p = (f32x4*)(rowp + bj * HALF + n * 16);
                        if (ACCUM) *p = *p + acc[ai][bj][m][n]; else *p = acc[ai][bj][m][n]; } }
    }
};
struct EpiBf16 {
    static constexpr bool PERM = true, AFTER_DRAIN = false;
    bf16_t* O; int ldc; const float* bias;
    __device__ __forceinline__ void operator()(const f32x4 (&acc)[2][2][4][2], const Unit& u, int wr, int wc, int fr, int fq) const {
        const int row0 = u.pm * BM + wr * 64 + fr; const int col0 = u.pn * BM + wc * 32 + 8 * fq;
        f32x4 bv[2][2];
#pragma unroll
        for (int bj = 0; bj < 2; ++bj)
#pragma unroll
            for (int n = 0; n < 2; ++n) bv[bj][n] = bias ? *(const f32x4*)(bias + col0 + bj * HALF + 4 * n) : (f32x4){0.f, 0.f, 0.f, 0.f};
#pragma unroll
        for (int ai = 0; ai < 2; ++ai)
#pragma unroll
            for (int m = 0; m < 4; ++m) { bf16_t* rowp = O + (size_t)(row0 + ai * HALF + m * 16) * ldc + col0;
#pragma unroll
                for (int bj = 0; bj < 2; ++bj) { const f32x4 v0 = acc[ai][bj][m][0] + bv[bj][0], v1 = acc[ai][bj][m][1] + bv[bj][1];
                    v4u w; w.x = cvt_pk_bf16(v0[0], v0[1]); w.y = cvt_pk_bf16(v0[2], v0[3]); w.z = cvt_pk_bf16(v1[0], v1[1]); w.w = cvt_pk_bf16(v1[2], v1[3]);
                    *(v4u*)(rowp + bj * HALF) = w; } }
    }
};
template <class Epi, class Sched, bool ALIGN_EPI = false, bool SP2 = false>
__device__ __forceinline__ void gemm_phase(PG8_LAS unsigned char* lds, const GemmX g, const Sched& S, const Epi& E) {
    const int tid = threadIdx.x, wid = __builtin_amdgcn_readfirstlane(tid >> 6), lane = tid & 63, wr = wid >> 2, wc = wid & 3, fr = lane & 15, fq = lane >> 4;
    const int K = g.K, nt = K / BK;
    unsigned voffA[2], voffB[2];
#pragma unroll
    for (int i = 0; i < 2; ++i) { int R, C; stage_rc(tid * 16 + i * 8192, R, C); const int Rb = Epi::PERM ? ((R & ~31) + perm32(R & 31)) : R;
        voffA[i] = (unsigned)(R * g.lda + C) * 2u; voffB[i] = (unsigned)(Rb * K + C) * 2u; }
    const size_t kstep = (size_t)(BK * 2);
    const size_t hstep = (size_t)HALF * K * 2;
    const size_t tstep = 2 * hstep;
    const size_t hstepA = (size_t)HALF * g.lda * 2, tstepA = 2 * hstepA;
    const unsigned ldsw = (unsigned)wid * 1024u;
    const int aoff = lds_byte(wr * 64 + fr, fq * 8), boff = lds_byte(wc * 32 + fr, fq * 8);
#define PG8_SA(b, h) (((b) * 2 + (h)) * HTB)
#define PG8_SB(b, h) ((4 + (b) * 2 + (h)) * HTB)
#define PG8_STAGE(bufoff, gbase, voff) do { _Pragma("unroll") for (int _i = 0; _i < 2; ++_i) \
        __builtin_amdgcn_global_load_lds((const unsigned*)((const char*)(gbase) + (voff)[_i]), (PG8_LAS unsigned*)(lds + (bufoff) + ldsw + _i * 8192), 16, 0, 0); } while (0)
#define PG8_LDA(dst, b, h) do { _Pragma("unroll") for (int m = 0; m < 4; ++m) _Pragma("unroll") for (int k = 0; k < 2; ++k) dst[m][k] = *(const PG8_LAS bf16x8*)(lds + PG8_SA(b, h) + aoff + m * 2048 + k * 1024); } while (0)
#define PG8_LDB(dst, b, h) do { _Pragma("unroll") for (int n = 0; n < 2; ++n) _Pragma("unroll") for (int k = 0; k < 2; ++k) dst[n][k] = *(const PG8_LAS bf16x8*)(lds + PG8_SB(b, h) + boff + n * 2048 + k * 1024); } while (0)
#define PG8_MMA(ai, bj, At, Bt) do { __builtin_amdgcn_s_setprio(1); _Pragma("unroll") for (int m = 0; m < 4; ++m) _Pragma("unroll") for (int n = 0; n < 2; ++n) _Pragma("unroll") for (int k = 0; k < 2; ++k) \
        acc[ai][bj][m][n] = __builtin_amdgcn_mfma_f32_16x16x32_bf16(Bt[n][k], At[m][k], acc[ai][bj][m][n], 0, 0, 0); __builtin_amdgcn_s_setprio(0); } while (0)
#define PG8_WAIT_V(n) asm volatile("s_waitcnt vmcnt(" #n ")" ::: "memory")
#define PG8_WAIT_L(n) asm volatile("s_waitcnt lgkmcnt(" #n ")" ::: "memory")
#define PG8_BAR __builtin_amdgcn_s_barrier()
#define PG8_SCHED __builtin_amdgcn_sched_barrier(0)
    Unit cur, nxt; int ui = 0;
    if (!S.next(0, cur)) return;
    f32x4 acc[2][2][4][2];
#pragma unroll
    for (int a = 0; a < 2; ++a)
#pragma unroll
        for (int b = 0; b < 2; ++b)
#pragma unroll
            for (int m = 0; m < 4; ++m)
#pragma unroll
                for (int n = 0; n < 2; ++n) acc[a][b][m][n] = (f32x4){0.f, 0.f, 0.f, 0.f};
    bf16x8 At[4][2], B0[2][2], B1[2][2];
    const char* cA = (const char*)g.A + (size_t)cur.pm * tstepA; const char* cB = (const char*)g.Bt + (size_t)cur.pn * tstep;
    S.a_ready(cur);
    if constexpr (SP2) {
        PG8_STAGE(PG8_SB(0, 0), cB, voffB); PG8_STAGE(PG8_SB(0, 1), cB + hstep, voffB); PG8_STAGE(PG8_SA(0, 0), cA, voffA); PG8_STAGE(PG8_SA(0, 1), cA + hstepA, voffA);
        if (wr == 1) PG8_BAR;
        PG8_WAIT_V(2); PG8_BAR;
        PG8_STAGE(PG8_SB(1, 0), cB + kstep, voffB); PG8_STAGE(PG8_SA(1, 0), cA + kstep, voffA); PG8_STAGE(PG8_SB(1, 1), cB + hstep + kstep, voffB);
        PG8_WAIT_V(6); PG8_BAR;
    } else {
        PG8_STAGE(PG8_SB(0, 0), cB, voffB); PG8_STAGE(PG8_SA(0, 0), cA, voffA); PG8_STAGE(PG8_SB(0, 1), cB + hstep, voffB); PG8_STAGE(PG8_SA(0, 1), cA + hstepA, voffA);
        if (wr == 1) PG8_BAR;
        PG8_WAIT_V(4); PG8_BAR;
        PG8_STAGE(PG8_SB(1, 0), cB + kstep, voffB); PG8_STAGE(PG8_SA(1, 0), cA + kstep, voffA); PG8_STAGE(PG8_SB(1, 1), cB + hstep + kstep, voffB);
        PG8_WAIT_V(6); PG8_BAR;
    }
    for (;;) {
        const bool has_next = S.next(ui + 1, nxt);
        const char* nA = has_next ? (const char*)g.A + (size_t)nxt.pm * tstepA : cA; const char* nB = has_next ? (const char*)g.Bt + (size_t)nxt.pn * tstep : cB;
        for (int t = 0; t < nt; t += 2) {
            const bool last = (t == nt - 2);
            const char* a1 = cA + (size_t)(t + 1) * kstep;
            const char* a2 = last ? nA : cA + (size_t)(t + 2) * kstep; const char* b2 = last ? nB : cB + (size_t)(t + 2) * kstep;
            const char* a3 = a2 + kstep; const char* b3 = b2 + kstep;
            if (last && has_next) S.a_ready(nxt);
            if constexpr (SP2) {
            PG8_LDB(B0, 0, 0); PG8_LDB(B1, 0, 1); PG8_SCHED; PG8_LDA(At, 0, 0); PG8_STAGE(PG8_SA(1, 1), a1 + hstepA, voffA);
            PG8_WAIT_V(8); PG8_WAIT_L(0); PG8_BAR; PG8_MMA(0, 0, At, B0); PG8_MMA(0, 1, At, B1); PG8_BAR; PG8_SCHED;
            PG8_LDA(At, 0, 1); PG8_STAGE(PG8_SB(0, 0), b2, voffB); PG8_STAGE(PG8_SB(0, 1), b2 + hstep, voffB); PG8_STAGE(PG8_SA(0, 0), a2, voffA);
            PG8_WAIT_V(8); PG8_WAIT_L(0); PG8_BAR; PG8_MMA(1, 0, At, B0); PG8_MMA(1, 1, At, B1); PG8_BAR; PG8_SCHED;
            PG8_LDB(B0, 1, 0); PG8_LDB(B1, 1, 1); PG8_SCHED; PG8_LDA(At, 1, 0); PG8_STAGE(PG8_SA(0, 1), a2 + hstepA, voffA);
            PG8_WAIT_V(8); PG8_WAIT_L(0); PG8_BAR; PG8_MMA(0, 0, At, B0); PG8_MMA(0, 1, At, B1); PG8_BAR; PG8_SCHED;
            PG8_LDA(At, 1, 1); PG8_STAGE(PG8_SB(1, 0), b3, voffB); PG8_STAGE(PG8_SB(1, 1), b3 + hstep, voffB); PG8_STAGE(PG8_SA(1, 0), a3, voffA);
            PG8_WAIT_V(8); PG8_WAIT_L(0); PG8_BAR; PG8_MMA(1, 0, At, B0); PG8_MMA(1, 1, At, B1); PG8_BAR; PG8_SCHED;
            } else {
            PG8_LDB(B0, 0, 0); PG8_SCHED; PG8_LDA(At, 0, 0); PG8_STAGE(PG8_SA(1, 1), a1 + hstepA, voffA);
            PG8_WAIT_L(8); PG8_BAR; PG8_WAIT_L(0); PG8_MMA(0, 0, At, B0); PG8_BAR; PG8_SCHED;
            PG8_LDB(B1, 0, 1); PG8_STAGE(PG8_SB(0, 0), b2, voffB);
            PG8_BAR; PG8_WAIT_L(0); PG8_MMA(0, 1, At, B1); PG8_BAR;
            PG8_LDA(At, 0, 1); PG8_STAGE(PG8_SA(0, 0), a2, voffA);
            PG8_BAR; PG8_WAIT_L(0); PG8_MMA(1, 0, At, B0); PG8_BAR; PG8_SCHED;
            PG8_STAGE(PG8_SB(0, 1), b2 + hstep, voffB);
            PG8_WAIT_V(6); PG8_BAR; PG8_MMA(1, 1, At, B1); PG8_BAR;
            PG8_LDB(B0, 1, 0); PG8_SCHED; PG8_LDA(At, 1, 0); PG8_STAGE(PG8_SA(0, 1), a2 + hstepA, voffA);
            PG8_WAIT_L(8); PG8_BAR; PG8_WAIT_L(0); PG8_MMA(0, 0, At, B0); PG8_BAR; PG8_SCHED;
            PG8_LDB(B1, 1, 1); PG8_STAGE(PG8_SB(1, 0), b3, voffB);
            PG8_BAR; PG8_WAIT_L(0); PG8_MMA(0, 1, At, B1); PG8_BAR;
            PG8_LDA(At, 1, 1); PG8_STAGE(PG8_SA(1, 0), a3, voffA);
            PG8_BAR; PG8_WAIT_L(0); PG8_MMA(1, 0, At, B0); PG8_BAR; PG8_SCHED;
            PG8_STAGE(PG8_SB(1, 1), b3 + hstep, voffB);
            PG8_WAIT_V(6); PG8_BAR; PG8_MMA(1, 1, At, B1); PG8_BAR;
            }
        }
        if constexpr (ALIGN_EPI) { if (wr == 0) PG8_BAR; }
        if constexpr (!Epi::AFTER_DRAIN) { E(acc, cur, wr, wc, fr, fq); S.done(cur); }
        if (!has_next) break;
#pragma unroll
        for (int a = 0; a < 2; ++a)
#pragma unroll
            for (int b = 0; b < 2; ++b)
#pragma unroll
                for (int m = 0; m < 4; ++m)
#pragma unroll
                    for (int n = 0; n < 2; ++n) acc[a][b][m][n] = (f32x4){0.f, 0.f, 0.f, 0.f};
        cur = nxt; cA = nA; cB = nB; ++ui;
        if constexpr (ALIGN_EPI) { if (wr == 1) PG8_BAR; }
    }
    PG8_WAIT_V(0);
    if constexpr (!ALIGN_EPI) { if (wr == 0) PG8_BAR; }
    PG8_BAR;
    if constexpr (Epi::AFTER_DRAIN) { E.fused(acc, cur, wr, wc, fr, fq, lds, wid, lane); S.done(cur); }
#undef PG8_SA
#undef PG8_SB
#undef PG8_STAGE
#undef PG8_LDA
#undef PG8_LDB
#undef PG8_MMA
#undef PG8_WAIT_V
#undef PG8_WAIT_L
#undef PG8_BAR
#undef PG8_SCHED
}
}

#define XB_TMO      128
#define XB_XCNT(j)  (256  + 64 * (j))
#define XB_XSUB(j)  (1280 + 64 * (j))
#define XB_XGEN(j)  (2304 + 64 * (j))
#define XB_TOP      3328
#define XB_TOPGEN   3392
#define XCD_BAR_WORDS 3456
#define XB_SPIN_CAP (1u << 20)
__device__ __forceinline__ unsigned xb_ld(unsigned* p) { return __hip_atomic_load(p, __ATOMIC_RELAXED, __HIP_MEMORY_SCOPE_AGENT); }
__device__ __forceinline__ unsigned xb_add(unsigned* p, unsigned v) { return __hip_atomic_fetch_add(p, v, __ATOMIC_RELAXED, __HIP_MEMORY_SCOPE_AGENT); }
__device__ __forceinline__ unsigned xb_xcc_id() { return (unsigned)__builtin_amdgcn_s_getreg((3 << 11) | 20) & 0xFu; }
#define XB_SPIN(cond, bar) do { unsigned _sp = 0; while (cond) { __builtin_amdgcn_s_sleep(1); \
    if ((++_sp & 255u) == 0u) { if (xb_ld(&(bar)[XB_TMO])) break; if (_sp > XB_SPIN_CAP) { atomicAdd(&(bar)[XB_TMO], 1u); break; } } } } while (0)
struct XcdBarrier { unsigned* bar; unsigned x; volatile LAS unsigned* st; };
__device__ __forceinline__ XcdBarrier xcd_barrier_post(unsigned* bar, volatile LAS unsigned* st) {
    XcdBarrier b; b.bar = bar; b.x = xb_xcc_id(); b.st = st;
    if (threadIdx.x == 0) (void)xb_add(&bar[XB_XCNT(b.x)], 1u);
    return b;
}
__device__ __forceinline__ void xcd_barrier_complete(unsigned* bar, unsigned x, unsigned& nloc, unsigned& nx) {
    const unsigned G = gridDim.x * gridDim.y * gridDim.z;
    unsigned sum, cnt, mine, sp = 0u;
    for (;;) {
        sum = 0u; cnt = 0u; mine = 0u;
#pragma unroll
        for (unsigned j = 0; j < 16; ++j) { const unsigned c = xb_ld(&bar[XB_XCNT(j)]); sum += c; cnt += (c > 0u) ? 1u : 0u; mine = (j == x) ? c : mine; }
        if (sum == G) break;
        __builtin_amdgcn_s_sleep(1);
        if ((++sp & 255u) == 0u) { if (xb_ld(&bar[XB_TMO])) break; if (sp > XB_SPIN_CAP) { atomicAdd(&bar[XB_TMO], 1u); break; } }
    }
    nloc = mine > 0u ? mine : 1u; nx = cnt > 0u ? cnt : 1u;
}
__device__ __forceinline__ void xcd_barrier(const XcdBarrier& b) {
    asm volatile("s_waitcnt vmcnt(0)" ::: "memory");
    __syncthreads();
    if (threadIdx.x == 0) {
        unsigned* bar = b.bar;
        __builtin_amdgcn_s_waitcnt(0);
        unsigned nloc = b.st[0], nx = b.st[1];
        if (nloc == 0u) { xcd_barrier_complete(bar, b.x, nloc, nx); b.st[0] = nloc; b.st[1] = nx; }
        const unsigned old = xb_add(&bar[XB_XSUB(b.x)], 1u);
        const unsigned gen = old / nloc;
        if (old + 1u == (gen + 1u) * nloc) {
            __builtin_amdgcn_fence(__ATOMIC_RELEASE, "agent");
            asm volatile("s_waitcnt vmcnt(0)" ::: "memory");
            const unsigned og = xb_add(&bar[XB_TOP], 1u);
            const unsigned tg = og / nx;
            if (og + 1u == (tg + 1u) * nx) xb_add(&bar[XB_TOPGEN], 1u);
            else XB_SPIN(xb_ld(&bar[XB_TOPGEN]) == tg, bar);
            __builtin_amdgcn_fence(__ATOMIC_ACQUIRE, "agent");
            xb_add(&bar[XB_XGEN(b.x)], 1u);
            asm volatile("s_waitcnt vmcnt(0)" ::: "memory");
        } else {
            XB_SPIN(xb_ld(&bar[XB_XGEN(b.x)]) == gen, bar);
            __builtin_amdgcn_fence(__ATOMIC_ACQUIRE, "agent");
            asm volatile("s_waitcnt vmcnt(0)" ::: "memory");
        }
    }
    __syncthreads();
}

struct Args { const float* in[38]; float* out; unsigned char* ws; int ph_lo, ph_hi, li, pad; };
enum InputId { I_X = 0, I_NORM_MIX, I_W_IN, I_W_OUT, I_RW_MU, I_RW_W0, I_RW_W_UP, I_RW_A0, I_RW_A_UP, I_RW_G_UP, I_RW_K_K, I_RW_K_A, I_RW_R_K,
    I_RW_LN_W, I_RW_LN_B, I_RW_V0, I_RW_V_DOWN, I_RW_V_UP, I_GLA_A_UP, I_GLA_A_BIAS, I_GLA_NORM, I_LRU_CONV_W, I_LRU_CONV_B, I_LRU_W_R,
    I_LRU_B_R, I_LRU_W_I, I_LRU_B_I, I_LRU_LAM, I_GDN_CONV_W, I_GDN_A_LOG, I_GDN_DT_BIAS, I_GDN_NORM, I_NORM_FFN, I_PEER_WQ, I_PEER_SK,
    I_PEER_U, I_PEER_V, I_NORM_FINAL };
enum { PH_P0 = 0, PH_GEMM1 = 1, PH_PREP = 2, PH_AUX = 3, PH_SCAN = 4, PH_POST = 5, PH_GEMM2 = 6, PH_NORM2 = 7, PH_GEMM3 = 8, PH_TOPK = 9, PH_PEER = 10, PH_PER_LAYER = 10, PH_TOTAL = 21 };

struct Frame {
    LAS unsigned char* lds;
    int tid, lane, wave, vcu, G;
    int gw, ngw;
};

__device__ __forceinline__ void p0_transpose_item(const float* W, int K, int N, const float* kscale, bf16_t* WT, LAS float* scr, int item, int nblk, int lane) {
    const int kb = item / nblk, nb = item % nblk, k0 = 64 * kb, n0 = 32 * nb;
    const int nn = n0 + (lane & 31);
#pragma unroll 8
    for (int i = 0; i < 32; ++i) { const int kk = 2 * i + (lane >> 5);
        float v = nn < N ? W[(size_t)(k0 + kk) * N + nn] : 0.f;
        if (kscale) v *= kscale[k0 + kk];
        scr[kk * 33 + (lane & 31)] = v; }
    LDS_WAIT(); asm volatile("" ::: "memory");
    const int c = lane & 7;
#pragma unroll
    for (int j = 0; j < 4; ++j) { const int n = (lane >> 3) + 8 * j; const LAS float* s = scr + (8 * c) * 33 + n;
        v4u o; o.x = pk2(s[0 * 33], s[1 * 33]); o.y = pk2(s[2 * 33], s[3 * 33]); o.z = pk2(s[4 * 33], s[5 * 33]); o.w = pk2(s[6 * 33], s[7 * 33]);
        *(v4u*)(WT + (size_t)(n0 + n) * K + k0 + 8 * c) = o; }
    LDS_WAIT(); asm volatile("" ::: "memory");
}

__device__ __forceinline__ void p0_prologue(const Args& a, Frame& F) {
    const WsMap m = ws_map(NTOK);
    unsigned char* ws = a.ws;
    LAS float* scr = (LAS float*)(F.lds + F.wave * 16384);
    const int gw = F.gw, NGW = F.ngw, lane = F.lane;
    for (int n = gw; n < NTOK; n += NGW) {
        const f32x4* xr = (const f32x4*)(a.in[I_X] + (size_t)n * DM) + lane;
        f32x4 v[8]; float s = 0.f;
#pragma unroll
        for (int j = 0; j < 8; ++j) { v[j] = xr[64 * j]; s += (v[j].x * v[j].x + v[j].y * v[j].y) + (v[j].z * v[j].z + v[j].w * v[j].w); }
        const float rstd = 1.0f / sqrtf(wave_sum(s) * (1.0f / DM) + 1e-6f);
        f32x4* xo = (f32x4*)(a.out + (size_t)n * DM) + lane;
        v2u* o8 = (v2u*)((bf16_t*)(ws + m.xn) + (size_t)n * DM) + lane;
#pragma unroll
        for (int j = 0; j < 8; ++j) { xo[64 * j] = v[j]; v2u w; w.x = pk2(v[j].x * rstd, v[j].y * rstd); w.y = pk2(v[j].z * rstd, v[j].w * rstd); o8[64 * j] = w; }
    }
    {
        constexpr int I1 = (DM / 64) * (PLD / 32), I2 = (DM / 64) * (DM / 32);
        for (int it = gw; it < NL * (I1 + I2); it += NGW) {
            const int l = it / (I1 + I2); int r = it % (I1 + I2);
            if (r < I1) p0_transpose_item(a.in[I_W_IN] + (size_t)l * DM * INC, DM, INC, a.in[I_NORM_MIX] + l * DM, (bf16_t*)(ws + m.w1t) + (size_t)l * PLD * DM, scr, r, PLD / 32, lane);
            else p0_transpose_item(a.in[I_W_OUT] + (size_t)l * DM * DM, DM, DM, nullptr, (bf16_t*)(ws + m.w2t) + (size_t)l * DM * DM, scr, r - I1, DM / 32, lane);
        }
    }
    for (int it = gw; it < NL * 16 * 64; it += NGW) {
        const int l = it / 1024, hp = (it % 1024) / 64, kb = it % 64;
        const int dh = lane & 1, kk = kb * 32 + (lane >> 1);
        const float* wq = a.in[I_PEER_WQ] + (size_t)l * DM * DM + (size_t)kk * DM + hp * 128 + dh * 64;
        const float* sk = a.in[I_PEER_SK] + ((size_t)l * 16 + hp) * 128 * 128 + dh * 64;
        f32x4 q[16];
#pragma unroll
        for (int d = 0; d < 16; ++d) q[d] = *(const f32x4*)(wq + 4 * d);
        bf16_t* o = (bf16_t*)(ws + m.wsct) + (size_t)l * DM * DM + (size_t)(hp * 128) * DM + kk;
        for (int key = 0; key < 128; ++key) {
            const f32x4* s4 = (const f32x4*)(sk + key * 128);
            float acc = 0.f;
#pragma unroll
            for (int d = 0; d < 16; ++d) { const f32x4 sv = s4[d]; acc += (q[d].x * sv.x + q[d].y * sv.y) + (q[d].z * sv.z + q[d].w * sv.w); }
            acc += __shfl_xor(acc, 1);
            if (dh == 0) o[(size_t)key * DM] = f2bf(acc);
        }
    }
    {
        const int gt = F.vcu * NTHR + F.tid, GT = F.G * NTHR;
        bf16_t* AW = (bf16_t*)(ws + m.auxwt); bf16_t* LW = (bf16_t*)(ws + m.lruwt); bf16_t* VW = (bf16_t*)(ws + m.vreswt); float* PP = (float*)(ws + m.pp);
        for (int it = gt; it < NL * 1792 * 384; it += GT) {
            const int l = it / (1792 * 384), r = it % (1792 * 384), n = r / 384, k = r % 384;
            float v = 0.f;
            if (n < 512) { if (k < 64) v = a.in[I_RW_W_UP][(size_t)l * 64 * 512 + k * 512 + n]; }
            else if (n < 1024) { if (k >= 64 && k < 128) v = a.in[I_RW_A_UP][(size_t)l * 64 * 512 + (k - 64) * 512 + (n - 512)]; }
            else if (n < 1536) { if (k >= 128 && k < 256) v = a.in[I_RW_G_UP][(size_t)l * 128 * 512 + (k - 128) * 512 + (n - 1024)]; }
            else { if (k >= 256 && k < 272) v = a.in[I_GLA_A_UP][(size_t)l * 16 * 256 + (k - 256) * 256 + (n - 1536)]; }
            AW[it] = f2bf(v);
        }
        for (int it = gt; it < NL * 1024 * 512; it += GT) {
            const int l = it / (1024 * 512), r = it % (1024 * 512), n = r / 512, k = r % 512;
            const int nn = n & 511, blk = nn >> 6, j = nn & 63;
            float v = 0.f;
            if ((k >> 6) == blk) v = (n < 512 ? a.in[I_LRU_W_R] : a.in[I_LRU_W_I])[(size_t)l * 8 * 64 * 64 + (size_t)blk * 4096 + (k & 63) * 64 + j];
            LW[it] = f2bf(v);
        }
        for (int it = gt; it < 512 * 512; it += GT) {
            const int n = it / 512, k = it % 512;
            float s = 0.f;
            for (int i = 0; i < 32; ++i) s += a.in[I_RW_V_DOWN][k * 32 + i] * a.in[I_RW_V_UP][i * 512 + n];
            VW[it] = f2bf(s);
        }
        for (int it = gt; it < 6144; it += GT) {
            float v = 0.f;
            if (it < 3584) { const int l = it / 1792, c = it % 1792;
                v = c < 512 ? a.in[I_RW_W0][l * 512 + c] : (c < 1024 ? a.in[I_RW_A0][l * 512 + c - 512] : (c < 1536 ? 0.f : a.in[I_GLA_A_BIAS][l * 256 + c - 1536])); }
            else if (it < 5632) { const int l = (it - 3584) / 1024, c = (it - 3584) % 1024; v = c < 512 ? a.in[I_LRU_B_R][l * 512 + c] : a.in[I_LRU_B_I][l * 512 + c - 512]; }
            else v = a.in[I_RW_V0][it - 5632];
            PP[it] = v;
        }
    }
}

__device__ __forceinline__ unsigned pk4_fp8(float a, float b, float c, float d) {
    int w = 0;
    w = __builtin_amdgcn_cvt_pk_fp8_f32(__builtin_fmaxf(__builtin_fminf(a, 448.f), -448.f), __builtin_fmaxf(__builtin_fminf(b, 448.f), -448.f), w, false);
    w = __builtin_amdgcn_cvt_pk_fp8_f32(__builtin_fmaxf(__builtin_fminf(c, 448.f), -448.f), __builtin_fmaxf(__builtin_fminf(d, 448.f), -448.f), w, true);
    return (unsigned)w;
}
__device__ __forceinline__ void tables_phase(const Args& a, Frame& F, int l0, int l1) {
    const WsMap m = ws_map(NTOK);
    const size_t per = (size_t)NEXP * DM / 16;
    for (size_t it = (size_t)l0 * 2 * per + (size_t)F.vcu * NTHR + F.tid; it < (size_t)l1 * 2 * per; it += (size_t)F.G * NTHR) {
        const int tb = (int)(it / per); const size_t r = it % per;
        const float* srcp = ((tb & 1) ? a.in[I_PEER_V] : a.in[I_PEER_U]) + (size_t)(tb >> 1) * NEXP * DM + r * 16;
        const float sc = (tb & 1) ? 64.0f : 1024.0f;
        const f32x4 v0 = __builtin_nontemporal_load((const f32x4*)srcp) * sc, v1 = __builtin_nontemporal_load((const f32x4*)srcp + 1) * sc;
        const f32x4 v2 = __builtin_nontemporal_load((const f32x4*)srcp + 2) * sc, v3 = __builtin_nontemporal_load((const f32x4*)srcp + 3) * sc;
        v4u w; w.x = pk4_fp8(v0.x, v0.y, v0.z, v0.w); w.y = pk4_fp8(v1.x, v1.y, v1.z, v1.w); w.z = pk4_fp8(v2.x, v2.y, v2.z, v2.w); w.w = pk4_fp8(v3.x, v3.y, v3.z, v3.w);
        *(v4u*)((unsigned char*)(a.ws + m.tabu) + (size_t)tb * NEXP * DM + r * 16) = w;
    }
}

template <int CTRL> __device__ __forceinline__ float dpp_f(float v) { return __builtin_bit_cast(float, __builtin_amdgcn_update_dpp(0, __builtin_bit_cast(int, v), CTRL, 0xF, 0xF, true)); }
__device__ __forceinline__ float rdlane_f(float v, int l) { return __builtin_bit_cast(float, __builtin_amdgcn_readlane(__builtin_bit_cast(int, v), l)); }
__device__ __forceinline__ float row16_sum(float v) {
    v += dpp_f<0xB1>(v); v += dpp_f<0x4E>(v); v += dpp_f<0x141>(v); v += dpp_f<0x140>(v); return v;
}
__device__ __forceinline__ float wave_sum_u(float v) {
    v = row16_sum(v);
    return (rdlane_f(v, 0) + rdlane_f(v, 16)) + (rdlane_f(v, 32) + rdlane_f(v, 48));
}
typedef __bf16 bf16x2_t __attribute__((ext_vector_type(2)));
__device__ __forceinline__ float dot2bf(unsigned w, unsigned x, float acc) { return __builtin_amdgcn_fdot2_f32_bf16(__builtin_bit_cast(bf16x2_t, w), __builtin_bit_cast(bf16x2_t, x), acc, false); }
__device__ __forceinline__ float gelu_fast(float x) {
    const float u = 1.5957691216057308f * (x + 0.044715f * x * x * x);
    return x / (1.0f + __expf(-u));
}


__device__ __forceinline__ float sigm(float x) { return 1.0f / (1.0f + __expf(-x)); }
__device__ __forceinline__ float softplus_f(float x) { return log1pf(__expf(-fabsf(x))) + fmaxf(x, 0.0f); }
__device__ __forceinline__ float tanh_f(float x) { return 1.0f - 2.0f / (1.0f + __expf(2.0f * x)); }
__device__ __forceinline__ float red8(float v) { v += dpp_f<0xB1>(v); v += dpp_f<0x4E>(v); v += dpp_f<0x141>(v); return v; }
__device__ __forceinline__ v4u ld8(const bf16_t* p) { return *(const v4u*)p; }
__device__ __forceinline__ void unpack8(const v4u w, float (&f)[8]) { f[0] = bflo(w.x); f[1] = bfhi(w.x); f[2] = bflo(w.y); f[3] = bfhi(w.y); f[4] = bflo(w.z); f[5] = bfhi(w.z); f[6] = bflo(w.w); f[7] = bfhi(w.w); }
__device__ __forceinline__ v4u pack8(const float (&f)[8]) { v4u w; w.x = pk2(f[0], f[1]); w.y = pk2(f[2], f[3]); w.z = pk2(f[4], f[5]); w.w = pk2(f[6], f[7]); return w; }

__device__ __forceinline__ void prep_phase(const Args& a, Frame& F, int l) {
    const WsMap m = ws_map(NTOK);
    const bf16_t* p16 = (const bf16_t*)(a.ws + m.p16);
    bf16_t* zrkv = (bf16_t*)(a.ws + m.zrkv); bf16_t* auxA = (bf16_t*)(a.ws + m.auxA); bf16_t* xc = (bf16_t*)(a.ws + m.xc);
    const float* mu = a.in[I_RW_MU] + l * 1792;
    for (size_t it = (size_t)F.vcu * NTHR + F.tid; it < (size_t)NTOK * 304; it += (size_t)F.G * NTHR) {
        const int n = (int)(it / 304), j = (int)(it % 304), t = n % TSEQ;
        if (j < 224) {
            const int col = j * 8;
            float cur[8], prv[8], z[8];
            unpack8(ld8(p16 + (size_t)n * PLD + col), cur);
            if (t > 0) unpack8(ld8(p16 + (size_t)(n - 1) * PLD + col), prv);
            else {
#pragma unroll
                for (int k = 0; k < 8; ++k) prv[k] = 0.f; }
            const f32x4 m0 = *(const f32x4*)(mu + col), m1 = *(const f32x4*)(mu + col + 4);
            const float mm[8] = {m0.x, m0.y, m0.z, m0.w, m1.x, m1.y, m1.z, m1.w};
#pragma unroll
            for (int k = 0; k < 8; ++k) z[k] = cur[k] + (prv[k] - cur[k]) * mm[k];
            if (col < 1536) *(v4u*)(zrkv + (size_t)n * 1536 + col) = pack8(z);
            else {
                const int c = col - 1536;
#pragma unroll
                for (int k = 0; k < 8; ++k) z[k] = c < 64 ? tanh_f(z[k]) : (c < 128 ? z[k] : sigm(z[k]));
                *(v4u*)(auxA + (size_t)n * 384 + c) = pack8(z);
            }
        } else if (j < 240) {
            const int c = 256 + (j - 224) * 8;
            v4u w = (v4u){0u, 0u, 0u, 0u};
            if (c < 272) w = ld8(p16 + (size_t)n * PLD + C_GLA + 1536 + (c - 256));
            *(v4u*)(auxA + (size_t)n * 384 + c) = w;
        } else {
            const int c = (j - 240) * 8;
            float acc[8];
            { const f32x4 b0 = *(const f32x4*)(a.in[I_LRU_CONV_B] + l * 512 + c), b1 = *(const f32x4*)(a.in[I_LRU_CONV_B] + l * 512 + c + 4);
              acc[0] = b0.x; acc[1] = b0.y; acc[2] = b0.z; acc[3] = b0.w; acc[4] = b1.x; acc[5] = b1.y; acc[6] = b1.z; acc[7] = b1.w; }
#pragma unroll
            for (int jj = 0; jj < 4; ++jj) {
                if (t - 3 + jj >= 0) {
                    float xv[8]; unpack8(ld8(p16 + (size_t)(n - 3 + jj) * PLD + C_LRU + c), xv);
                    const float* cw = a.in[I_LRU_CONV_W] + (size_t)l * 4 * 512 + jj * 512 + c;
                    const f32x4 w0 = *(const f32x4*)cw, w1 = *(const f32x4*)(cw + 4);
                    acc[0] += w0.x * xv[0]; acc[1] += w0.y * xv[1]; acc[2] += w0.z * xv[2]; acc[3] += w0.w * xv[3];
                    acc[4] += w1.x * xv[4]; acc[5] += w1.y * xv[5]; acc[6] += w1.z * xv[6]; acc[7] += w1.w * xv[7];
                }
            }
            *(v4u*)(xc + (size_t)n * 512 + c) = pack8(acc);
        }
    }
    {
        bf16_t* gq = (bf16_t*)(a.ws + m.gq); bf16_t* gk = (bf16_t*)(a.ws + m.gk); bf16_t* gv = (bf16_t*)(a.ws + m.gv); float* gsc = (float*)(a.ws + m.gsc);
        const float* cw = a.in[I_GDN_CONV_W] + (size_t)l * 4 * 1536;
        const int lane = F.lane;
        for (int n = F.gw; n < NTOK; n += F.ngw) {
            const int t = n % TSEQ;
#pragma unroll
            for (int part = 0; part < 3; ++part) {
                const int cb = part * 512 + lane * 8;
                float acc[8];
#pragma unroll
                for (int k = 0; k < 8; ++k) acc[k] = 0.f;
#pragma unroll
                for (int jj = 0; jj < 4; ++jj) {
                    if (t - 3 + jj >= 0) {
                        float xv[8]; unpack8(ld8(p16 + (size_t)(n - 3 + jj) * PLD + C_GDN + cb), xv);
                        const f32x4 w0 = *(const f32x4*)(cw + jj * 1536 + cb), w1 = *(const f32x4*)(cw + jj * 1536 + cb + 4);
                        acc[0] += w0.x * xv[0]; acc[1] += w0.y * xv[1]; acc[2] += w0.z * xv[2]; acc[3] += w0.w * xv[3];
                        acc[4] += w1.x * xv[4]; acc[5] += w1.y * xv[5]; acc[6] += w1.z * xv[6]; acc[7] += w1.w * xv[7];
                    }
                }
                float ss = 0.f;
#pragma unroll
                for (int k = 0; k < 8; ++k) { acc[k] = acc[k] * sigm(acc[k]); ss += acc[k] * acc[k]; }
                if (part < 2) {
                    ss = row16_sum(ss);
                    const float inv = (1.0f / sqrtf(ss + 1e-6f)) * (part == 0 ? 0.08838834764831845f : 1.0f);
#pragma unroll
                    for (int k = 0; k < 8; ++k) acc[k] *= inv;
                }
                *(v4u*)((part == 0 ? gq : (part == 1 ? gk : gv)) + (size_t)n * 512 + lane * 8) = pack8(acc);
            }
            if (lane < 4) {
                gsc[(size_t)n * 8 + lane] = sigm(bf2f(p16[(size_t)n * PLD + C_GDN + 2048 + lane]));
                gsc[(size_t)n * 8 + 4 + lane] = __expf(-__expf(a.in[I_GDN_A_LOG][l * 4 + lane]) * softplus_f(bf2f(p16[(size_t)n * PLD + C_GDN + 2052 + lane]) + a.in[I_GDN_DT_BIAS][l * 4 + lane]));
            }
        }
    }
}

__device__ __forceinline__ float swz16(float v) { return __builtin_bit_cast(float, __builtin_amdgcn_ds_swizzle(__builtin_bit_cast(int, v), 0x401F)); }
__device__ __forceinline__ float red32(float v) { v = row16_sum(v); return v + swz16(v); }

__device__ __forceinline__ void rwkv_task(const Args& a, Frame& F, int l, int task) {
    const WsMap m = ws_map(NTOK);
    const int b = task >> 4, h = (task >> 1) & 7, hf = task & 1;
    LAS float* LR = (LAS float*)F.lds; LAS float* LW = LR + 2048; LAS float* LK = LW + 2048; LAS float* LA = LK + 2048; LAS float* LB = LA + 2048;
    LAS float* LV = LB + 2048; LAS float* LY = LV + 1024;
    const int lane = F.lane, w = F.wave, tid = F.tid;
    const int ch = h * 64 + lane;
    const bool mine = (lane >> 5) == hf;
    const float kk_ = a.in[I_RW_K_K][l * 512 + ch], ka_ = a.in[I_RW_K_A][l * 512 + ch], rk_ = a.in[I_RW_R_K][l * 512 + ch];
    const bf16_t* zr = (const bf16_t*)(a.ws + m.zrkv); const bf16_t* ao = (const bf16_t*)(a.ws + m.auxo); const bf16_t* vr = (const bf16_t*)(a.ws + m.vres);
    float* vf = (float*)(a.ws + m.vfirst); bf16_t* yo = (bf16_t*)(a.ws + m.rwy); bf16_t* bvo = (bf16_t*)(a.ws + m.rwbv);
    float S0 = 0.f, S1 = 0.f, S2 = 0.f, S3 = 0.f;
    const int row = tid >> 4, ks = tid & 15;
    float in_[4][7];
    auto load_chunk = [&](int c) {
#pragma unroll
        for (int q = 0; q < 4; ++q) { const size_t n = (size_t)b * TSEQ + c * 32 + w + 8 * q;
            in_[q][0] = bf2f(zr[n * 1536 + ch]); in_[q][1] = bf2f(zr[n * 1536 + 512 + ch]); in_[q][2] = bf2f(zr[n * 1536 + 1024 + ch]);
            in_[q][3] = bf2f(ao[n * 1792 + ch]); in_[q][4] = bf2f(ao[n * 1792 + 512 + ch]);
            if (l > 0) { in_[q][5] = bf2f(vr[n * 512 + ch]); in_[q][6] = vf[n * 512 + ch]; } else { in_[q][5] = 0.f; in_[q][6] = 0.f; } }
    };
    load_chunk(0);
    for (int c = 0; c < TSEQ / 32; ++c) {
#pragma unroll
        for (int q = 0; q < 4; ++q) {
            const int tl = w + 8 * q; const size_t n = (size_t)b * TSEQ + c * 32 + tl;
            const float zr_ = in_[q][0], zk_ = in_[q][1], zv_ = in_[q][2], wp = in_[q][3], ap = in_[q][4];
            float v = zv_;
            if (l == 0) { if (mine) vf[n * 512 + ch] = zv_; } else v = zv_ + (in_[q][6] - zv_) * sigm(in_[q][5]);
            const float w_raw = -softplus_f(-wp) - 0.5f, dec = __expf(-__expf(w_raw));
            const float aa = sigm(ap);
            const float kkraw = zk_ * kk_;
            const float ss = wave_sum_u(kkraw * kkraw);
            const float kk = kkraw * (1.0f / sqrtf(fmaxf(ss, 1e-24f)));
            const float km = zk_ * (1.0f + (aa - 1.0f) * ka_);
            const float bon = wave_sum_u(zr_ * km * rk_);
            LR[tl * 64 + lane] = zr_; LW[tl * 64 + lane] = dec; LK[tl * 64 + lane] = km; LA[tl * 64 + lane] = -kk; LB[tl * 64 + lane] = kk * aa;
            if (mine) { LV[tl * 32 + (lane & 31)] = v; bvo[n * 512 + ch] = f2bf(bon * v); }
        }
        __syncthreads();
        if (c + 1 < TSEQ / 32) load_chunk(c + 1);
        float keep0 = 0.f, keep1 = 0.f;
#pragma unroll 4
        for (int tl = 0; tl < 32; ++tl) {
            const int o = tl * 64 + ks * 4;
            const f32x4 a4 = *(const LAS f32x4*)(LA + o), w4 = *(const LAS f32x4*)(LW + o), b4 = *(const LAS f32x4*)(LB + o), k4 = *(const LAS f32x4*)(LK + o), r4 = *(const LAS f32x4*)(LR + o);
            const float vv = LV[tl * 32 + row];
            const float sa = row16_sum((S0 * a4.x + S1 * a4.y) + (S2 * a4.z + S3 * a4.w));
            S0 = S0 * w4.x + (sa * b4.x + vv * k4.x); S1 = S1 * w4.y + (sa * b4.y + vv * k4.y); S2 = S2 * w4.z + (sa * b4.z + vv * k4.z); S3 = S3 * w4.w + (sa * b4.w + vv * k4.w);
            const float y = row16_sum((S0 * r4.x + S1 * r4.y) + (S2 * r4.z + S3 * r4.w));
            keep0 = (ks == tl) ? y : keep0; keep1 = (ks + 16 == tl) ? y : keep1;
        }
        LY[ks * 32 + row] = keep0; LY[(16 + ks) * 32 + row] = keep1;
        __syncthreads();
        { const int tl = tid >> 4, r2 = (tid & 15) * 2; const size_t n = (size_t)b * TSEQ + c * 32 + tl;
          *(unsigned*)(yo + n * 512 + h * 64 + hf * 32 + r2) = pk2(LY[tl * 32 + r2], LY[tl * 32 + r2 + 1]); }
    }
}


constexpr int RWP = 72;
constexpr int RWT = 64 * RWP;
constexpr size_t RWB_TILES = 4 * RWT * 2;
constexpr size_t RWB_DVEC = RWB_TILES;
constexpr size_t RWB_VS = RWB_DVEC + 256;
constexpr size_t RWB_BYTES = RWB_VS + 4 * 3 * 64 * 16 * 2;

__device__ __forceinline__ f32x4 mm64(const LAS bf16_t* A, const LAS bf16_t* Bt, int mt, int nt, int lane, f32x4 acc) {
    const LAS bf16_t* ap = A + (mt * 16 + (lane & 15)) * RWP + (lane >> 4) * 8;
    const LAS bf16_t* bp = Bt + (nt * 16 + (lane & 15)) * RWP + (lane >> 4) * 8;
#pragma unroll
    for (int k0 = 0; k0 < 64; k0 += 32)
        acc = __builtin_amdgcn_mfma_f32_16x16x32_bf16(*(const LAS bf16x8*)(ap + k0), *(const LAS bf16x8*)(bp + k0), acc, 0, 0, 0);
    return acc;
}
__device__ __forceinline__ void st_rowmajor(LAS bf16_t* T, int mt, int nt, int lane, const f32x4 v) {
    const int n = nt * 16 + (lane & 15), i0 = mt * 16 + (lane >> 4) * 4;
    T[(i0 + 0) * RWP + n] = f2bf(v.x); T[(i0 + 1) * RWP + n] = f2bf(v.y); T[(i0 + 2) * RWP + n] = f2bf(v.z); T[(i0 + 3) * RWP + n] = f2bf(v.w);
}
__device__ __forceinline__ void st_transposed(LAS bf16_t* T, int mt, int nt, int lane, const f32x4 v) {
    const int n = nt * 16 + (lane & 15), i0 = mt * 16 + (lane >> 4) * 4;
    *(LAS v2u*)(T + n * RWP + i0) = (v2u){pk2(v.x, v.y), pk2(v.z, v.w)};
}

__device__ __forceinline__ void rwkv_pa_chunk(const Args& a, Frame& F, int l, int ci) {
    const WsMap m = ws_map(NTOK);
    const int bh = ci >> 6, c = ci & 63, b = bh >> 3, h = bh & 7;
    const int lane = F.lane, w = F.wave, tid = F.tid;
    const int ch = h * 64 + lane;
    LAS bf16_t* At = (LAS bf16_t*)F.lds; LAS bf16_t* AtT = At + RWT; LAS bf16_t* Bt = AtT + RWT; LAS bf16_t* Kt = Bt + RWT; LAS bf16_t* KtGT = Kt + RWT;
    LAS bf16_t* Rt = KtGT + RWT; LAS bf16_t* VmT = Rt + RWT; LAS bf16_t* LAK = VmT + RWT;
    LAS bf16_t* X0 = LAK + RWT; LAS bf16_t* XT0 = X0 + RWT; LAS bf16_t* T0 = XT0 + RWT; LAS bf16_t* X1 = T0 + RWT; LAS bf16_t* XT1 = X1 + RWT; LAS bf16_t* T1 = XT1 + RWT;
    LAS float* LWL = (LAS float*)X0;
    LAS bf16_t* A2 = X1;
    LAS bf16_t* LVT = XT1;
    const float kk_ = a.in[I_RW_K_K][l * 512 + ch], ka_ = a.in[I_RW_K_A][l * 512 + ch], rk_ = a.in[I_RW_R_K][l * 512 + ch];
    const bf16_t* zr = (const bf16_t*)(a.ws + m.zrkv); const bf16_t* ao = (const bf16_t*)(a.ws + m.auxo); const bf16_t* vr = (const bf16_t*)(a.ws + m.vres);
    float* vf = (float*)(a.ws + m.vfirst); bf16_t* bvo = (bf16_t*)(a.ws + m.rwbv);
    unsigned char* blob = a.ws + m.xn + (size_t)ci * RWB_BYTES;
    bf16_t* gW = (bf16_t*)blob; bf16_t* gQG = gW + RWT; bf16_t* gKGT = gQG + RWT; bf16_t* gA1 = gKGT + RWT;
    float* gDV = (float*)(blob + RWB_DVEC); bf16_t* gVS = (bf16_t*)(blob + RWB_VS);
#pragma unroll 1
    for (int q = 0; q < 8; ++q) {
        const int j = w + 8 * q; const size_t n = (size_t)b * TSEQ + c * 64 + j;
        const float wp = bf2f(ao[n * 1792 + ch]);
        LWL[j * 64 + lane] = -__expf(-softplus_f(-wp) - 0.5f);
    }
    __syncthreads();
    if (tid < 64) { float s = 0.f;
#pragma unroll 8
        for (int j = 0; j < 64; ++j) { s += LWL[j * 64 + tid]; LWL[j * 64 + tid] = s; } }
    __syncthreads();
    {
        const float gc = LWL[63 * 64 + lane];
#pragma unroll 1
        for (int q = 0; q < 8; ++q) {
            const int j = w + 8 * q; const size_t n = (size_t)b * TSEQ + c * 64 + j;
            const float zr_ = bf2f(zr[n * 1536 + ch]), zk_ = bf2f(zr[n * 1536 + 512 + ch]), zv_ = bf2f(zr[n * 1536 + 1024 + ch]);
            const float ap = bf2f(ao[n * 1792 + 512 + ch]);
            float v = zv_;
            if (l == 0) vf[n * 512 + ch] = zv_; else v = zv_ + (vf[n * 512 + ch] - zv_) * sigm(bf2f(vr[n * 512 + ch]));
            const float aa = sigm(ap);
            const float kkraw = zk_ * kk_;
            const float ss = wave_sum_u(kkraw * kkraw);
            const float kk = kkraw * (1.0f / sqrtf(fmaxf(ss, 1e-24f)));
            const float km = zk_ * (1.0f + (aa - 1.0f) * ka_);
            const float bon = wave_sum_u(zr_ * km * rk_);
            bvo[n * 512 + ch] = f2bf(bon * v);
            const float cs = LWL[j * 64 + lane];
            const float csm1 = j > 0 ? LWL[(j - 1) * 64 + lane] : 0.f;
            const float G = __expf(cs), Gm1 = __expf(csm1), iG = __expf(-cs), GcG = __expf(gc - cs);
            const float av = -kk, bv = kk * aa;
            const bf16_t at = f2bf(av * Gm1);
            At[j * RWP + lane] = at; AtT[lane * RWP + j] = at;
            Bt[j * RWP + lane] = f2bf(bv * iG);
            Kt[j * RWP + lane] = f2bf(km * iG);
            KtGT[lane * RWP + j] = f2bf(km * GcG);
            const bf16_t rt = f2bf(zr_ * G);
            Rt[j * RWP + lane] = rt; gQG[j * RWP + lane] = rt;
            VmT[lane * RWP + j] = f2bf(v);
            gKGT[lane * RWP + j] = f2bf(bv * GcG);
        }
        if (w == 0) gDV[lane] = __expf(gc);
    }
    __syncthreads();
    {
        f32x4 z4 = {0.f, 0.f, 0.f, 0.f};
#pragma unroll 1
        for (int tt = 0; tt < 2; ++tt) {
            const int t = w + 8 * tt, mt = t >> 2, nt = t & 3;
            const int n = nt * 16 + (lane & 15), i0 = mt * 16 + (lane >> 4) * 4;
            f32x4 lab = mm64(At, Bt, mt, nt, lane, z4), lak = mm64(At, Kt, mt, nt, lane, z4), a1 = mm64(Rt, Bt, mt, nt, lane, z4), a2 = mm64(Rt, Kt, mt, nt, lane, z4);
            f32x4 tt0;
#pragma unroll
            for (int e = 0; e < 4; ++e) { const int i = i0 + e;
                if (n >= i) { lab[e] = 0.f; lak[e] = 0.f; }
                if (n > i) { a1[e] = 0.f; a2[e] = 0.f; }
                tt0[e] = lab[e] + (n == i ? 1.0f : 0.f); }
            st_rowmajor(X0, mt, nt, lane, lab); st_transposed(XT0, mt, nt, lane, lab);
            st_rowmajor(T0, mt, nt, lane, tt0);
            st_rowmajor(LAK, mt, nt, lane, lak);
            st_rowmajor(A2, mt, nt, lane, a2);
            gA1[(i0 + 0) * RWP + n] = f2bf(a1.x); gA1[(i0 + 1) * RWP + n] = f2bf(a1.y); gA1[(i0 + 2) * RWP + n] = f2bf(a1.z); gA1[(i0 + 3) * RWP + n] = f2bf(a1.w);
        }
    }
    __syncthreads();
    {
        f32x4 z4 = {0.f, 0.f, 0.f, 0.f};
#pragma unroll 1
        for (int tt = 0; tt < 2; ++tt) {
            const int t = w + 8 * tt, mt = t >> 2, nt = t & 3;
            const int n = nt * 16 + (lane & 15), i0 = mt * 16 + (lane >> 4) * 4;
            const f32x4 lv = mm64(LAK, VmT, mt, nt, lane, z4), o0 = mm64(A2, VmT, mt, nt, lane, z4), kv0 = mm64(KtGT, VmT, mt, nt, lane, z4);
            st_transposed((LAS bf16_t*)(F.lds + 131584), mt, nt, lane, lv);
            bf16_t* go = gVS + (size_t)nt * 3 * 1024 + 1024;
            const int r = lane & 15;
            go[(i0 + 0) * 16 + r] = f2bf(o0.x); go[(i0 + 1) * 16 + r] = f2bf(o0.y); go[(i0 + 2) * 16 + r] = f2bf(o0.z); go[(i0 + 3) * 16 + r] = f2bf(o0.w);
            go[1024 + (i0 + 0) * 16 + r] = f2bf(kv0.x); go[1024 + (i0 + 1) * 16 + r] = f2bf(kv0.y); go[1024 + (i0 + 2) * 16 + r] = f2bf(kv0.z); go[1024 + (i0 + 3) * 16 + r] = f2bf(kv0.w);
            (void)n;
        }
    }
    __syncthreads();
    {
        LAS bf16_t* Xc = X0; LAS bf16_t* XTc = XT0; LAS bf16_t* Tc = T0; LAS bf16_t* Xn = X1; LAS bf16_t* XTn = XT1; LAS bf16_t* Tn = T1;
        f32x4 z4 = {0.f, 0.f, 0.f, 0.f};
#pragma unroll 1
        for (int it = 0; it < 5; ++it) {
#pragma unroll 1
            for (int tt = 0; tt < 2; ++tt) { const int t = w + 8 * tt, mt = t >> 2, nt = t & 3;
                const f32x4 x2 = mm64(Xc, XTc, mt, nt, lane, z4);
                st_rowmajor(Xn, mt, nt, lane, x2); st_transposed(XTn, mt, nt, lane, x2); }
            __syncthreads();
#pragma unroll 1
            for (int tt = 0; tt < 2; ++tt) { const int t = w + 8 * tt, mt = t >> 2, nt = t & 3;
                const int n = nt * 16 + (lane & 15), i0 = mt * 16 + (lane >> 4) * 4;
                f32x4 tc; tc.x = bf2f(Tc[(i0 + 0) * RWP + n]); tc.y = bf2f(Tc[(i0 + 1) * RWP + n]); tc.z = bf2f(Tc[(i0 + 2) * RWP + n]); tc.w = bf2f(Tc[(i0 + 3) * RWP + n]);
                const f32x4 tn = mm64(Tc, XTn, mt, nt, lane, tc);
                st_rowmajor(Tn, mt, nt, lane, tn); }
            __syncthreads();
            LAS bf16_t* s0 = Xc; Xc = Xn; Xn = s0; s0 = XTc; XTc = XTn; XTn = s0; s0 = Tc; Tc = Tn; Tn = s0;
        }
        LAS bf16_t* LVTp = (LAS bf16_t*)(F.lds + 131584);
#pragma unroll 1
        for (int tt = 0; tt < 2; ++tt) { const int t = w + 8 * tt, mt = t >> 2, nt = t & 3;
            const int n = nt * 16 + (lane & 15), i0 = mt * 16 + (lane >> 4) * 4, r = lane & 15;
            const f32x4 wt = mm64(Tc, AtT, mt, nt, lane, z4), u0 = mm64(Tc, LVTp, mt, nt, lane, z4);
            gW[(i0 + 0) * RWP + n] = f2bf(wt.x); gW[(i0 + 1) * RWP + n] = f2bf(wt.y); gW[(i0 + 2) * RWP + n] = f2bf(wt.z); gW[(i0 + 3) * RWP + n] = f2bf(wt.w);
            bf16_t* gu = gVS + (size_t)nt * 3 * 1024;
            gu[(i0 + 0) * 16 + r] = f2bf(u0.x); gu[(i0 + 1) * 16 + r] = f2bf(u0.y); gu[(i0 + 2) * 16 + r] = f2bf(u0.z); gu[(i0 + 3) * 16 + r] = f2bf(u0.w); }
    }
    __syncthreads();
    (void)LVT;
}

__device__ __forceinline__ void rwkv_ps_task(const Args& a, Frame& F, int task) {
    const WsMap m = ws_map(NTOK);
    const int bh = task >> 2, vs = task & 3, b = bh >> 3, h = bh & 7;
    const int lane = F.lane, w = F.wave, tid = F.tid;
    LAS bf16_t* LB = (LAS bf16_t*)F.lds;
    LAS bf16_t* ST = LB + 4 * RWT; LAS bf16_t* VNT = ST + 16 * RWP;
    bf16_t* yo = (bf16_t*)(a.ws + m.rwy);
    const unsigned char* blob0 = a.ws + m.xn + (size_t)(bh * 64) * RWB_BYTES;
    const int r = lane & 15, i0w = (w & 3) * 16 + (lane >> 4) * 4;
    f32x4 Sacc = {0.f, 0.f, 0.f, 0.f};
    for (int i = tid; i < 16 * RWP / 2; i += NTHR) ((LAS unsigned*)ST)[i] = 0u;
    v4u pre[5];
    auto prefetch = [&](int c) {
        const v4u* g = (const v4u*)(blob0 + (size_t)c * RWB_BYTES);
#pragma unroll
        for (int k = 0; k < 5; ++k) { const int o = k * 512 + tid; pre[k] = (o < (int)(RWB_TILES / 16)) ? g[o] : (v4u){0u, 0u, 0u, 0u}; }
    };
    auto commit = [&]() {
#pragma unroll
        for (int k = 0; k < 5; ++k) { const int o = k * 512 + tid; if (o < (int)(RWB_TILES / 16)) ((LAS v4u*)LB)[o] = pre[k]; }
    };
    prefetch(0); commit(); prefetch(1);
    for (int c = 0; c < 64; ++c) {
        const unsigned char* blob = blob0 + (size_t)c * RWB_BYTES;
        const bf16_t* gvs = (const bf16_t*)(blob + RWB_VS) + (size_t)vs * 3 * 1024;
        float fr[4]; float dv[4] = {1.f, 1.f, 1.f, 1.f}, kv0[4] = {0.f, 0.f, 0.f, 0.f};
        { const bf16_t* src = gvs + (w < 4 ? 0 : 1024);
#pragma unroll
          for (int e = 0; e < 4; ++e) fr[e] = bf2f(src[(i0w + e) * 16 + r]); }
        if (w < 4) { const float* gd = (const float*)(blob + RWB_DVEC);
#pragma unroll
          for (int e = 0; e < 4; ++e) { dv[e] = gd[i0w + e]; kv0[e] = bf2f(gvs[2048 + (i0w + e) * 16 + r]); } }
        __syncthreads();
        if (w < 4) {
            f32x4 vn = mm64(LB, ST, w, 0, lane, (f32x4){fr[0], fr[1], fr[2], fr[3]});
            st_transposed(VNT, w, 0, lane, vn);
        }
        __syncthreads();
        if (w < 4) {
            const f32x4 base = {dv[0] * Sacc.x + kv0[0], dv[1] * Sacc.y + kv0[1], dv[2] * Sacc.z + kv0[2], dv[3] * Sacc.w + kv0[3]};
            Sacc = mm64(LB + 2 * RWT, VNT, w, 0, lane, base);
        } else {
            f32x4 o = mm64(LB + RWT, ST, w - 4, 0, lane, (f32x4){fr[0], fr[1], fr[2], fr[3]});
            o = mm64(LB + 3 * RWT, VNT, w - 4, 0, lane, o);
            const size_t n = (size_t)b * TSEQ + c * 64 + i0w;
            bf16_t* yp = yo + n * 512 + h * 64 + vs * 16 + r;
            yp[0] = f2bf(o.x); yp[512] = f2bf(o.y); yp[1024] = f2bf(o.z); yp[1536] = f2bf(o.w);
        }
        __syncthreads();
        if (w < 4) st_transposed(ST, w, 0, lane, Sacc);
        if (c + 1 < 64) commit();
        if (c + 2 < 64) prefetch(c + 2);
    }
    __syncthreads();
}

__device__ __forceinline__ void gdn_task(const Args& a, Frame& F, int l, int task) {
    const WsMap m = ws_map(NTOK);
    const int b = task >> 5, h = (task >> 3) & 3, oc = task & 7;
    LAS float* LQ = (LAS float*)F.lds; LAS float* LK = LQ + 4096; LAS float* LV = LK + 4096; LAS float* LBE = LV + 512; LAS float* LEG = LBE + 32; LAS float* LO = LEG + 32;
    const int tid = F.tid;
    const bf16_t* gq = (const bf16_t*)(a.ws + m.gq); const bf16_t* gk = (const bf16_t*)(a.ws + m.gk); const bf16_t* gv = (const bf16_t*)(a.ws + m.gv);
    const float* gsc = (const float*)(a.ws + m.gsc); bf16_t* go = (bf16_t*)(a.ws + m.gdno);
    float S0 = 0.f, S1 = 0.f, S2 = 0.f, S3 = 0.f;
    const int row = tid >> 5, ks = tid & 31;
    const int ptl = tid >> 4, pc8 = (tid & 15) * 8, pr = tid & 15;
    v4u nq, nk; unsigned short nv; float nbe = 0.f, neg = 0.f;
    auto load_chunk = [&](int c) {
        const size_t n = (size_t)b * TSEQ + c * 32 + ptl;
        nq = ld8(gq + n * 512 + h * 128 + pc8); nk = ld8(gk + n * 512 + h * 128 + pc8); nv = gv[n * 512 + h * 128 + oc * 16 + pr];
        if (tid < 32) { const size_t n2 = (size_t)b * TSEQ + c * 32 + tid; nbe = gsc[n2 * 8 + h]; neg = gsc[n2 * 8 + 4 + h]; }
    };
    load_chunk(0);
    for (int c = 0; c < TSEQ / 32; ++c) {
        { float f[8]; unpack8(nq, f);
          *(LAS f32x4*)(LQ + ptl * 128 + pc8) = (f32x4){f[0], f[1], f[2], f[3]}; *(LAS f32x4*)(LQ + ptl * 128 + pc8 + 4) = (f32x4){f[4], f[5], f[6], f[7]};
          unpack8(nk, f);
          *(LAS f32x4*)(LK + ptl * 128 + pc8) = (f32x4){f[0], f[1], f[2], f[3]}; *(LAS f32x4*)(LK + ptl * 128 + pc8 + 4) = (f32x4){f[4], f[5], f[6], f[7]};
          LV[ptl * 16 + pr] = bf2f(nv);
          if (tid < 32) { LBE[tid] = nbe; LEG[tid] = neg; } }
        __syncthreads();
        if (c + 1 < TSEQ / 32) load_chunk(c + 1);
        float keep = 0.f;
#pragma unroll 4
        for (int tl = 0; tl < 32; ++tl) {
            const int o = tl * 128 + ks * 4;
            const f32x4 k4 = *(const LAS f32x4*)(LK + o), q4 = *(const LAS f32x4*)(LQ + o);
            const float vv = LV[tl * 16 + row], be = LBE[tl], eg = LEG[tl];
            const float dk = red32((S0 * k4.x + S1 * k4.y) + (S2 * k4.z + S3 * k4.w));
            const float u = be * (vv - eg * dk);
            S0 = S0 * eg + u * k4.x; S1 = S1 * eg + u * k4.y; S2 = S2 * eg + u * k4.z; S3 = S3 * eg + u * k4.w;
            const float oo = red32((S0 * q4.x + S1 * q4.y) + (S2 * q4.z + S3 * q4.w));
            keep = (ks == tl) ? oo : keep;
        }
        LO[ks * 16 + row] = keep;
        __syncthreads();
        { const size_t n = (size_t)b * TSEQ + c * 32 + ptl; go[n * 512 + h * 128 + oc * 16 + pr] = f2bf(LO[ptl * 16 + pr]); }
    }
}

__device__ __forceinline__ void gla_task(const Args& a, Frame& F, int l, int task) {
    const WsMap m = ws_map(NTOK);
    const int b = task >> 4, h = (task >> 2) & 3, qt = task & 3;
    LAS float* LQ = (LAS float*)F.lds; LAS float* LK = LQ + 2048; LAS float* LAL = LK + 2048; LAS float* LV = LAL + 2048; LAS float* LO = LV + 1024;
    const int lane = F.lane, w = F.wave, tid = F.tid;
    const bf16_t* p16 = (const bf16_t*)(a.ws + m.p16); const bf16_t* ao = (const bf16_t*)(a.ws + m.auxo);
    bf16_t* go = (bf16_t*)(a.ws + m.glao);
    float S0 = 0.f, S1 = 0.f, S2 = 0.f, S3 = 0.f;
    const int col = tid >> 4, ks = tid & 15;
    float in_[4][4];
    auto load_chunk = [&](int c) {
#pragma unroll
        for (int q = 0; q < 4; ++q) { const size_t n = (size_t)b * TSEQ + c * 32 + w + 8 * q;
            in_[q][0] = bf2f(p16[n * PLD + C_GLA + h * 64 + lane]); in_[q][1] = bf2f(p16[n * PLD + C_GLA + 256 + h * 64 + lane]);
            in_[q][2] = bf2f(ao[n * 1792 + 1536 + h * 64 + lane]); in_[q][3] = bf2f(p16[n * PLD + C_GLA + 512 + h * 128 + qt * 32 + (lane & 31)]); }
    };
    load_chunk(0);
    for (int c = 0; c < TSEQ / 32; ++c) {
#pragma unroll
        for (int q = 0; q < 4; ++q) { const int tl = w + 8 * q;
            LQ[tl * 64 + lane] = in_[q][0] * 0.125f; LK[tl * 64 + lane] = in_[q][1];
            LAL[tl * 64 + lane] = __expf(-softplus_f(-in_[q][2]) * (1.0f / 16.0f)); if (lane < 32) LV[tl * 32 + lane] = in_[q][3]; }
        __syncthreads();
        if (c + 1 < TSEQ / 32) load_chunk(c + 1);
        float keep0 = 0.f, keep1 = 0.f;
#pragma unroll 4
        for (int tl = 0; tl < 32; ++tl) {
            const int o = tl * 64 + ks * 4;
            const f32x4 a4 = *(const LAS f32x4*)(LAL + o), k4 = *(const LAS f32x4*)(LK + o), q4 = *(const LAS f32x4*)(LQ + o);
            const float vv = LV[tl * 32 + col];
            S0 = S0 * a4.x + k4.x * vv; S1 = S1 * a4.y + k4.y * vv; S2 = S2 * a4.z + k4.z * vv; S3 = S3 * a4.w + k4.w * vv;
            const float oo = row16_sum((S0 * q4.x + S1 * q4.y) + (S2 * q4.z + S3 * q4.w));
            keep0 = (ks == tl) ? oo : keep0; keep1 = (ks + 16 == tl) ? oo : keep1;
        }
        LO[ks * 32 + col] = keep0; LO[(16 + ks) * 32 + col] = keep1;
        __syncthreads();
        { const int tl = tid >> 4, r2 = (tid & 15) * 2; const size_t n = (size_t)b * TSEQ + c * 32 + tl;
          *(unsigned*)(go + n * 512 + h * 128 + qt * 32 + r2) = pk2(LO[tl * 32 + r2], LO[tl * 32 + r2 + 1]); }
    }
}

__device__ __forceinline__ void lru_pass(const Args& a, Frame& F, int l, bool passB) {
    const WsMap m = ws_map(NTOK);
    const bf16_t* gt = (const bf16_t*)(a.ws + m.gates); const bf16_t* xc = (const bf16_t*)(a.ws + m.xc); const bf16_t* p16 = (const bf16_t*)(a.ws + m.p16);
    bf16_t* mix = (bf16_t*)(a.ws + m.mix16); float* lrs = (float*)(a.ws + m.lrs);
    for (int it = F.vcu * NTHR + F.tid; it < NBATCH * 64 * 512; it += F.G * NTHR) {
        const int ch = it & 511, bc = it >> 9, c = bc & 63;
        const float sp8 = 8.0f * softplus_f(-a.in[I_LRU_LAM][l * 512 + ch]);
        const size_t nb = (size_t)bc * 64;
        float hh = 0.f, ap = 1.f;
        if (passB) { for (int s = 0; s < c; ++s) { const f32x2 su = *(const f32x2*)(lrs + ((size_t)(bc - c + s) * 512 + ch) * 2); hh = su.x * hh + su.y; } }
#pragma unroll 8
        for (int t = 0; t < 64; ++t) { const size_t n = nb + t;
            const float la = -sp8 * sigm(bf2f(gt[n * 1024 + ch]));
            const float u = bf2f(xc[n * 512 + ch]) * sigm(bf2f(gt[n * 1024 + 512 + ch])) * sqrtf(-expm1f(2.0f * la));
            const float av = __expf(la);
            hh = av * hh + u; ap *= av;
            if (passB) mix[n * DM + 1024 + ch] = f2bf(hh * gelu_fast(bf2f(p16[n * PLD + C_LRU + 512 + ch]))); }
        if (!passB) *(f32x2*)(lrs + ((size_t)bc * 512 + ch) * 2) = (f32x2){ap, hh};
    }
}

__device__ __forceinline__ void scan_phase(const Args& a, Frame& F, int l) {
    lru_pass(a, F, l, false);
    const int task = blockIdx.x;
    if (task < 128) gdn_task(a, F, l, task);
    else if (task < 192) { for (int q = 0; q < 32; ++q) rwkv_pa_chunk(a, F, l, (task - 128) * 32 + q); }
    else gla_task(a, F, l, task - 192);
}

__device__ __forceinline__ void post_phase(const Args& a, Frame& F, int l, const XcdBarrier& bar) {
    const WsMap m = ws_map(NTOK);
    if (blockIdx.x < 128) rwkv_ps_task(a, F, blockIdx.x);
    lru_pass(a, F, l, true);
    const bf16_t* p16 = (const bf16_t*)(a.ws + m.p16); const bf16_t* glao = (const bf16_t*)(a.ws + m.glao); const bf16_t* gdno = (const bf16_t*)(a.ws + m.gdno);
    const bf16_t* rwy = (const bf16_t*)(a.ws + m.rwy); const bf16_t* rwbv = (const bf16_t*)(a.ws + m.rwbv); const bf16_t* ao = (const bf16_t*)(a.ws + m.auxo);
    bf16_t* mix = (bf16_t*)(a.ws + m.mix16);
    const int lane = F.lane, col = lane * 8, hc = col & 127;
    float gg[8], gd[8], lw[8], lb[8];
    { const f32x4 x0 = *(const f32x4*)(a.in[I_GLA_NORM] + l * 128 + hc), x1 = *(const f32x4*)(a.in[I_GLA_NORM] + l * 128 + hc + 4);
      gg[0] = x0.x; gg[1] = x0.y; gg[2] = x0.z; gg[3] = x0.w; gg[4] = x1.x; gg[5] = x1.y; gg[6] = x1.z; gg[7] = x1.w;
      const f32x4 y0 = *(const f32x4*)(a.in[I_GDN_NORM] + l * 128 + hc), y1 = *(const f32x4*)(a.in[I_GDN_NORM] + l * 128 + hc + 4);
      gd[0] = y0.x; gd[1] = y0.y; gd[2] = y0.z; gd[3] = y0.w; gd[4] = y1.x; gd[5] = y1.y; gd[6] = y1.z; gd[7] = y1.w;
      const f32x4 w0 = *(const f32x4*)(a.in[I_RW_LN_W] + l * 512 + col), w1 = *(const f32x4*)(a.in[I_RW_LN_W] + l * 512 + col + 4);
      lw[0] = w0.x; lw[1] = w0.y; lw[2] = w0.z; lw[3] = w0.w; lw[4] = w1.x; lw[5] = w1.y; lw[6] = w1.z; lw[7] = w1.w;
      const f32x4 b0 = *(const f32x4*)(a.in[I_RW_LN_B] + l * 512 + col), b1 = *(const f32x4*)(a.in[I_RW_LN_B] + l * 512 + col + 4);
      lb[0] = b0.x; lb[1] = b0.y; lb[2] = b0.z; lb[3] = b0.w; lb[4] = b1.x; lb[5] = b1.y; lb[6] = b1.z; lb[7] = b1.w; }
    for (int pass = 0; pass < 2; ++pass) {
    if (pass == 1) xcd_barrier(bar);
    for (int n = F.gw; n < NTOK; n += F.ngw) {
        if (pass == 1) {
            float y[8], bv[8], g[8];
            unpack8(ld8(rwy + (size_t)n * 512 + col), y); unpack8(ld8(rwbv + (size_t)n * 512 + col), bv); unpack8(ld8(ao + (size_t)n * 1792 + 1024 + col), g);
            float s = 0.f;
#pragma unroll
            for (int k = 0; k < 8; ++k) s += y[k];
            const float mean = red8(s) * (1.0f / 64.0f);
            float s2 = 0.f;
#pragma unroll
            for (int k = 0; k < 8; ++k) { y[k] -= mean; s2 += y[k] * y[k]; }
            const float rs = 1.0f / sqrtf(red8(s2) * (1.0f / 64.0f) + 64e-5f);
#pragma unroll
            for (int k = 0; k < 8; ++k) y[k] = (y[k] * rs * lw[k] + lb[k] + bv[k]) * g[k];
            *(v4u*)(mix + (size_t)n * DM + col) = pack8(y);
        }
        if (pass == 0)
#pragma unroll
        for (int which = 0; which < 2; ++which) {
            float o[8], g[8];
            unpack8(ld8((which ? gdno : glao) + (size_t)n * 512 + col), o);
            unpack8(ld8(p16 + (size_t)n * PLD + (which ? C_GDN + 1536 : C_GLA + 1024) + col), g);
            float ss = 0.f;
#pragma unroll
            for (int k = 0; k < 8; ++k) ss += o[k] * o[k];
            ss = row16_sum(ss);
            const float rs = 1.0f / sqrtf(ss * (1.0f / 128.0f) + 1e-6f);
#pragma unroll
            for (int k = 0; k < 8; ++k) o[k] = o[k] * rs * (which ? gd[k] : gg[k]) * (g[k] * sigm(g[k]));
            *(v4u*)(mix + (size_t)n * DM + (which ? 1536 : 512) + col) = pack8(o);
        }
    }
    }
}

__device__ __forceinline__ void norm2_phase(const Args& a, Frame& F, int l) {
    const WsMap m = ws_map(NTOK);
    const float* gain = a.in[I_NORM_FFN] + l * DM;
    f32x4 gv[8];
#pragma unroll
    for (int j = 0; j < 8; ++j) gv[j] = ((const f32x4*)gain)[64 * j + F.lane];
    for (int n = F.gw; n < NTOK; n += F.ngw) {
        const f32x4* xr = (const f32x4*)(a.out + (size_t)n * DM) + F.lane;
        f32x4 v[8]; float s = 0.f;
#pragma unroll
        for (int j = 0; j < 8; ++j) { v[j] = xr[64 * j]; s += (v[j].x * v[j].x + v[j].y * v[j].y) + (v[j].z * v[j].z + v[j].w * v[j].w); }
        const float rstd = 1.0f / sqrtf(wave_sum_u(s) * (1.0f / DM) + 1e-6f);
        v2u* o8 = (v2u*)((bf16_t*)(a.ws + m.hb) + (size_t)n * DM) + F.lane;
#pragma unroll
        for (int j = 0; j < 8; ++j) { v2u w; w.x = pk2(v[j].x * rstd * gv[j].x, v[j].y * rstd * gv[j].y); w.y = pk2(v[j].z * rstd * gv[j].z, v[j].w * rstd * gv[j].w); o8[64 * j] = w; }
    }
}

#define TK_CE(A, B) do { const float mx_ = fmaxf(A, B), mn_ = fminf(A, B); A = mx_; B = mn_; } while (0)
__device__ __forceinline__ void tk_sort16_desc(float (&x)[16]) {
#pragma unroll
    for (int k = 2; k <= 16; k <<= 1)
#pragma unroll
        for (int j = k >> 1; j > 0; j >>= 1)
#pragma unroll
            for (int i = 0; i < 16; ++i) { const int p = i ^ j;
                if (p > i) { if ((i & k) == 0) TK_CE(x[i], x[p]); else TK_CE(x[p], x[i]); } }
}
__device__ __forceinline__ void tk_merge16(float (&run)[16], const float (&g)[16]) {
#pragma unroll
    for (int i = 0; i < 16; ++i) run[i] = fmaxf(run[i], g[15 - i]);
#pragma unroll
    for (int j = 8; j > 0; j >>= 1)
#pragma unroll
        for (int i = 0; i < 16; ++i) { const int p = i ^ j; if (p > i) TK_CE(run[i], run[p]); }
}
__device__ __forceinline__ float tk_tag(float v, unsigned tag, unsigned mask) { return __builtin_bit_cast(float, (__builtin_bit_cast(unsigned, v) & ~mask) | tag); }
__device__ __forceinline__ void topk_phase(const Args& a, Frame& F) {
    const WsMap m = ws_map(NTOK);
    const float* sc = (const float*)(a.ws + m.sc);
    int* idx = (int*)(a.ws + m.idx); float* gate = (float*)(a.ws + m.gate);
    LAS float* LS = (LAS float*)F.lds;
    const int t = F.tid;
    for (int wv = F.gw; wv < (NTOK / 64) * 8; wv += F.ngw) {
        const int h = wv & 7, n = (wv >> 3) * 64 + F.lane;
        const float* sp = sc + (size_t)(h * 256) * NTOK + n;
        float s0[16], s1[16];
#pragma unroll
        for (int half = 0; half < 2; ++half) {
            float run[16];
#pragma unroll
            for (int j = 0; j < 16; ++j) run[j] = -3.0e38f;
#pragma unroll 1
            for (int g = 0; g < 8; ++g) {
                float x[16];
#pragma unroll
                for (int k = 0; k < 16; ++k) x[k] = tk_tag(sp[(size_t)(half * 128 + g * 16 + k) * NTOK], (unsigned)(g * 16 + k), 127u);
                tk_sort16_desc(x);
                tk_merge16(run, x);
            }
#pragma unroll
            for (int j = 0; j < 16; ++j) { if (half) s1[j] = run[j]; else s0[j] = run[j]; LS[(half * 16 + j) * 512 + t] = run[j]; }
        }
        float run[16];
#pragma unroll
        for (int j = 0; j < 16; ++j) run[j] = -3.0e38f;
        {
            float x[16]; int cnt = 0;
#pragma unroll
            for (int p = 0; p < 16; ++p)
#pragma unroll
                for (int q = 0; q < 16; ++q) if ((p + 1) * (q + 1) <= 16) {
                    x[cnt & 15] = tk_tag(s0[p] + s1[q], (unsigned)(p * 16 + q), 255u); ++cnt;
                    if ((cnt & 15) == 0) { tk_sort16_desc(x); tk_merge16(run, x); }
                }
#pragma unroll
            for (int k = 0; k < 16; ++k) if (k >= (cnt & 15)) x[k] = -3.0e38f;
            tk_sort16_desc(x); tk_merge16(run, x);
        }
        const float mx = run[0]; float den = 0.f; float e[16]; int ti[16];
#pragma unroll
        for (int j = 0; j < 16; ++j) {
            const unsigned tg = __builtin_bit_cast(unsigned, run[j]) & 255u; const int p = (int)(tg >> 4), q = (int)(tg & 15u);
            const unsigned k0 = __builtin_bit_cast(unsigned, LS[(0 * 16 + p) * 512 + t]) & 127u, k1 = __builtin_bit_cast(unsigned, LS[(1 * 16 + q) * 512 + t]) & 127u;
            ti[j] = (int)(k0 * 128u + k1);
            e[j] = __expf(run[j] - mx); den += e[j];
        }
        const float inv = 1.0f / den;
        const size_t it = (size_t)n * 8 + h;
        f32x4* go = (f32x4*)(gate + it * 16); v4u* io = (v4u*)(idx + it * 16);
#pragma unroll
        for (int j = 0; j < 4; ++j) { go[j] = (f32x4){e[4 * j] * inv, e[4 * j + 1] * inv, e[4 * j + 2] * inv, e[4 * j + 3] * inv};
            io[j] = (v4u){(unsigned)ti[4 * j], (unsigned)ti[4 * j + 1], (unsigned)ti[4 * j + 2], (unsigned)ti[4 * j + 3]}; }
    }
}

__device__ __forceinline__ void peer_phase(const Args& a, Frame& F, int l) {
    const WsMap m = ws_map(NTOK);
    const unsigned char* TU = (const unsigned char*)(a.ws + m.tabu) + (size_t)l * 2 * NEXP * DM;
    const unsigned char* TV = TU + (size_t)NEXP * DM;
    const int* idx = (const int*)(a.ws + m.idx); const float* gate = (const float*)(a.ws + m.gate);
    const int lane = F.lane;
    for (int n = F.gw; n < NTOK; n += F.ngw) {
        f32x2 xf[16];
        { const v4u* hr = (const v4u*)((const bf16_t*)(a.ws + m.hb) + (size_t)n * DM);
#pragma unroll
          for (int c = 0; c < 2; ++c)
#pragma unroll
              for (int hh = 0; hh < 2; ++hh) { const v4u w = hr[c * 128 + lane * 2 + hh]; const int o = c * 8 + hh * 4;
                  xf[o + 0] = (f32x2){bflo(w.x), bfhi(w.x)}; xf[o + 1] = (f32x2){bflo(w.y), bfhi(w.y)}; xf[o + 2] = (f32x2){bflo(w.z), bfhi(w.z)}; xf[o + 3] = (f32x2){bflo(w.w), bfhi(w.w)}; } }
        const int e0 = idx[(size_t)n * 128 + lane], e1 = idx[(size_t)n * 128 + 64 + lane];
        const float g0 = gate[(size_t)n * 128 + lane], g1 = gate[(size_t)n * 128 + 64 + lane];
        float d0 = 0.f, d1 = 0.f;
#pragma unroll
        for (int half = 0; half < 2; ++half) {
            const int ev = half ? e1 : e0; float dd = 0.f;
            for (int j = 0; j < 64; j += 8) {
                v4u u[8][2];
#pragma unroll
                for (int r = 0; r < 8; ++r) { const int e = __builtin_amdgcn_readlane(ev, j + r);
                    const v4u* row = (const v4u*)(TU + (size_t)e * DM) + lane;
                    u[r][0] = row[0]; u[r][1] = row[64]; }
#pragma unroll
                for (int r = 0; r < 8; ++r) { f32x2 a0 = {0.f, 0.f}, a1 = {0.f, 0.f};
#pragma unroll
                    for (int c = 0; c < 2; ++c) { const unsigned wv[4] = {u[r][c].x, u[r][c].y, u[r][c].z, u[r][c].w};
#pragma unroll
                        for (int k = 0; k < 4; ++k) { a0 += __builtin_amdgcn_cvt_pk_f32_fp8((int)wv[k], false) * xf[c * 8 + k * 2]; a1 += __builtin_amdgcn_cvt_pk_f32_fp8((int)wv[k], true) * xf[c * 8 + k * 2 + 1]; } }
                    const float t = wave_sum_u((a0.x + a0.y) + (a1.x + a1.y));
                    dd = (lane == j + r) ? t : dd; }
            }
            if (half) d1 = dd; else d0 = dd;
        }
        const float c0 = gelu_fast(d0 * (1.0f / 1024.0f)) * g0 * (1.0f / 64.0f), c1 = gelu_fast(d1 * (1.0f / 1024.0f)) * g1 * (1.0f / 64.0f);
        f32x2 o[16];
#pragma unroll
        for (int i = 0; i < 16; ++i) o[i] = (f32x2){0.f, 0.f};
#pragma unroll
        for (int half = 0; half < 2; ++half) {
            const int ev = half ? e1 : e0; const float cv = half ? c1 : c0;
            for (int j = 0; j < 64; j += 8) {
                v4u v[8][2]; float cj[8];
#pragma unroll
                for (int r = 0; r < 8; ++r) { const int e = __builtin_amdgcn_readlane(ev, j + r); cj[r] = rdlane_f(cv, j + r);
                    const v4u* row = (const v4u*)(TV + (size_t)e * DM) + lane;
                    v[r][0] = row[0]; v[r][1] = row[64]; }
#pragma unroll
                for (int r = 0; r < 8; ++r)
#pragma unroll
                    for (int c = 0; c < 2; ++c) { const unsigned wv[4] = {v[r][c].x, v[r][c].y, v[r][c].z, v[r][c].w};
#pragma unroll
                        for (int k = 0; k < 4; ++k) { o[c * 8 + k * 2] += __builtin_amdgcn_cvt_pk_f32_fp8((int)wv[k], false) * cj[r]; o[c * 8 + k * 2 + 1] += __builtin_amdgcn_cvt_pk_f32_fp8((int)wv[k], true) * cj[r]; } }
            }
        }
        float* xrow = a.out + (size_t)n * DM;
        float s = 0.f;
#pragma unroll
        for (int c = 0; c < 2; ++c)
#pragma unroll
            for (int q = 0; q < 4; ++q) { const f32x4 x4 = *(const f32x4*)(xrow + c * 1024 + lane * 16 + q * 4);
                o[c * 8 + q * 2].x += x4.x; o[c * 8 + q * 2].y += x4.y; o[c * 8 + q * 2 + 1].x += x4.z; o[c * 8 + q * 2 + 1].y += x4.w;
                s += (o[c * 8 + q * 2].x * o[c * 8 + q * 2].x + o[c * 8 + q * 2].y * o[c * 8 + q * 2].y) + (o[c * 8 + q * 2 + 1].x * o[c * 8 + q * 2 + 1].x + o[c * 8 + q * 2 + 1].y * o[c * 8 + q * 2 + 1].y); }
        const float rstd = 1.0f / sqrtf(wave_sum_u(s) * (1.0f / DM) + 1e-6f);
        if (l + 1 < NL) {
            bf16_t* xo = (bf16_t*)(a.ws + m.xn) + (size_t)n * DM;
#pragma unroll
            for (int c = 0; c < 2; ++c) {
#pragma unroll
                for (int q = 0; q < 4; ++q) *(f32x4*)(xrow + c * 1024 + lane * 16 + q * 4) = (f32x4){o[c * 8 + q * 2].x, o[c * 8 + q * 2].y, o[c * 8 + q * 2 + 1].x, o[c * 8 + q * 2 + 1].y};
#pragma unroll
                for (int hh = 0; hh < 2; ++hh) { const int b0 = c * 8 + hh * 4; v4u w;
                    w.x = pk2(o[b0].x * rstd, o[b0].y * rstd); w.y = pk2(o[b0 + 1].x * rstd, o[b0 + 1].y * rstd); w.z = pk2(o[b0 + 2].x * rstd, o[b0 + 2].y * rstd); w.w = pk2(o[b0 + 3].x * rstd, o[b0 + 3].y * rstd);
                    *(v4u*)(xo + c * 1024 + lane * 16 + hh * 8) = w; } }
        } else {
            const float* gf = a.in[I_NORM_FINAL];
#pragma unroll
            for (int c = 0; c < 2; ++c)
#pragma unroll
                for (int q = 0; q < 4; ++q) { const f32x4 g4 = *(const f32x4*)(gf + c * 1024 + lane * 16 + q * 4);
                    *(f32x4*)(xrow + c * 1024 + lane * 16 + q * 4) = (f32x4){o[c * 8 + q * 2].x * rstd * g4.x, o[c * 8 + q * 2].y * rstd * g4.y, o[c * 8 + q * 2 + 1].x * rstd * g4.z, o[c * 8 + q * 2 + 1].y * rstd * g4.w}; }
        }
    }
}

#define IN(k) (lo <= (k) && (k) < hi)
#define SEAM(k) do { if (IN(k) && IN((k) + 1)) xcd_barrier(bar); } while (0)
template <int l>
__device__ __forceinline__ void layer_phases(const Args& a, Frame& F, const XcdBarrier& bar, const WsMap& m, int lo, int hi) {
    constexpr int pb = l * PH_PER_LAYER;
        if (IN(pb + PH_GEMM1)) {
            pg8::GemmX g{(const bf16_t*)(a.ws + m.xn), (const bf16_t*)(a.ws + m.w1t) + (size_t)l * PLD * DM, NTOK, PLD, DM, DM};
            pg8::StaticOrder S; S.init(NTOK, PLD, F.G, (int)blockIdx.x);
            pg8::EpiBf16 E{(bf16_t*)(a.ws + m.p16), PLD, nullptr};
            pg8::gemm_phase<pg8::EpiBf16, pg8::StaticOrder, true, true>(F.lds, g, S, E);
            SEAM(pb + PH_GEMM1);
        }
        if (IN(pb + PH_PREP)) { prep_phase(a, F, l); SEAM(pb + PH_PREP); }
        if (IN(pb + PH_AUX)) {
            const float* PP = (const float*)(a.ws + m.pp);
            { pg8::GemmX g{(const bf16_t*)(a.ws + m.auxA), (const bf16_t*)(a.ws + m.auxwt) + (size_t)l * 1792 * 384, NTOK, 1792, 384, 384};
              pg8::StaticOrder S; S.init(NTOK, 1792, F.G, (int)blockIdx.x);
              pg8::EpiBf16 E{(bf16_t*)(a.ws + m.auxo), 1792, PP + l * 1792};
              pg8::gemm_phase<pg8::EpiBf16, pg8::StaticOrder, true, true>(F.lds, g, S, E); }
            { pg8::GemmX g{(const bf16_t*)(a.ws + m.xc), (const bf16_t*)(a.ws + m.lruwt) + (size_t)l * 1024 * 512, NTOK, 1024, 512, 512};
              pg8::StaticOrder S; S.init(NTOK, 1024, F.G, (int)blockIdx.x);
              pg8::EpiBf16 E{(bf16_t*)(a.ws + m.gates), 1024, PP + 3584 + l * 1024};
              pg8::gemm_phase<pg8::EpiBf16, pg8::StaticOrder, true, true>(F.lds, g, S, E); }
            if (l > 0) {
              pg8::GemmX g{(const bf16_t*)(a.ws + m.zrkv) + 1024, (const bf16_t*)(a.ws + m.vreswt), NTOK, 512, 512, 1536};
              pg8::StaticOrder S; S.init(NTOK, 512, F.G, (int)blockIdx.x);
              pg8::EpiBf16 E{(bf16_t*)(a.ws + m.vres), 512, PP + 5632};
              pg8::gemm_phase<pg8::EpiBf16, pg8::StaticOrder, true, true>(F.lds, g, S, E); }
            SEAM(pb + PH_AUX);
        }
        if (IN(pb + PH_SCAN)) { scan_phase(a, F, l); SEAM(pb + PH_SCAN); }
        if (IN(pb + PH_POST)) { post_phase(a, F, l, bar); SEAM(pb + PH_POST); }
        if (IN(pb + PH_GEMM2)) {
            pg8::GemmX g{(const bf16_t*)(a.ws + m.mix16), (const bf16_t*)(a.ws + m.w2t) + (size_t)l * DM * DM, NTOK, DM, DM, DM};
            pg8::StaticOrder S; S.init(NTOK, DM, F.G, (int)blockIdx.x);
            pg8::EpiF32<true> E{a.out, DM};
            pg8::gemm_phase<pg8::EpiF32<true>, pg8::StaticOrder, true, true>(F.lds, g, S, E);
            SEAM(pb + PH_GEMM2);
        }
        if (IN(pb + PH_NORM2)) { norm2_phase(a, F, l); SEAM(pb + PH_NORM2); }
        if (IN(pb + PH_GEMM3)) {
            pg8::GemmX g{(const bf16_t*)(a.ws + m.wsct) + (size_t)l * DM * DM, (const bf16_t*)(a.ws + m.hb), DM, NTOK, DM, DM};
            pg8::StaticOrder S; S.init(DM, NTOK, F.G, (int)blockIdx.x);
            pg8::EpiF32<false> E{(float*)(a.ws + m.sc), NTOK};
            pg8::gemm_phase<pg8::EpiF32<false>, pg8::StaticOrder, true, true>(F.lds, g, S, E);
            SEAM(pb + PH_GEMM3);
        }
        if (IN(pb + PH_TOPK)) { topk_phase(a, F); SEAM(pb + PH_TOPK); }
        if (IN(pb + PH_PEER)) { peer_phase(a, F, l); SEAM(pb + PH_PEER); }
}

#undef IN
#undef SEAM
__global__ void __launch_bounds__(NTHR, 2) mega(Args a) {
    extern __shared__ __attribute__((aligned(16))) unsigned char lds_raw[];
    Frame F;
    F.lds = (LAS unsigned char*)lds_raw;
    F.tid = threadIdx.x; F.lane = F.tid & 63; F.wave = __builtin_amdgcn_readfirstlane(F.tid >> 6);
    F.G = gridDim.x; { const int bx = blockIdx.x; F.vcu = (F.G % 8 == 0) ? (bx % 8) * (F.G / 8) + bx / 8 : bx; }
    F.gw = F.vcu * NWAVES + F.wave; F.ngw = F.G * NWAVES;
    volatile LAS unsigned* MISC = (volatile LAS unsigned*)(F.lds + MISC_OFF);
    if (F.tid < 32) MISC[F.tid] = 0u;
    __syncthreads();
    const WsMap m = ws_map(NTOK);
    unsigned* ctl = (unsigned*)(a.ws + m.ctl);
    XcdBarrier bar; bar.bar = ctl + 4096 + a.li * XCD_BAR_WORDS; bar.x = 0; bar.st = nullptr;
    const int lo = a.ph_lo, hi = a.ph_hi;
    if (hi - lo > 1) bar = xcd_barrier_post(ctl + 4096 + a.li * XCD_BAR_WORDS, MISC + 8);
#define IN(k) (lo <= (k) && (k) < hi)
#define SEAM(k) do { if (IN(k) && IN((k) + 1)) xcd_barrier(bar); } while (0)
    if (IN(PH_P0)) { p0_prologue(a, F); tables_phase(a, F, 0, NL); SEAM(PH_P0); }
    if (lo >= 100) { tables_phase(a, F, lo - 100, hi - 100); }
    layer_phases<0>(a, F, bar, m, lo, hi);
    layer_phases<1>(a, F, bar, m, lo, hi);
#undef IN
#undef SEAM
}

template <int ST>
__global__ void __launch_bounds__(256) stage_kernel(Params P, int l) {
    const long n = stage_items(P, ST, l);
    for (long it = blockIdx.x * 256L + threadIdx.x; it < n; it += gridDim.x * 256L) run_item(P, ST, l, it);
}
template <int ST>
static void launch_stage(const Params& P, int l, hipStream_t stream) {
    const long n = stage_items(P, ST, l);
    if (n <= 0) return;
    long blocks = (n + 255) / 256;
    if (blocks > 8192) blocks = 8192;
    stage_kernel<ST><<<dim3((unsigned)blocks), dim3(256), 0, stream>>>(P, l);
}
#define LS(X) case X: launch_stage<X>(P, l, stream); break;
static void launch_any(int st, const Params& P, int l, hipStream_t stream) {
    switch (st) {
        LS(ST_COPYX) LS(ST_RSTD) LS(ST_NORM1) LS(ST_GEMM1) LS(ST_RW_A0) LS(ST_RW_A1) LS(ST_RW_A2) LS(ST_RW_A3) LS(ST_RW_KKN)
        LS(ST_RW_SCAN) LS(ST_RW_POST) LS(ST_GLA_B0) LS(ST_GLA_SCAN) LS(ST_GLA_POST) LS(ST_LRU_C0) LS(ST_LRU_C1) LS(ST_LRU_SCAN)
        LS(ST_GDN_D0) LS(ST_GDN_D1) LS(ST_GDN_SCAN) LS(ST_GDN_POST) LS(ST_GEMM2) LS(ST_RSTD2) LS(ST_NORM2) LS(ST_GEMM3)
        LS(ST_SCORES) LS(ST_TOPK1) LS(ST_TOPK2) LS(ST_PEER_U) LS(ST_PEER_V) LS(ST_FRSTD) LS(ST_FNORM)
    }
}

extern "C" void kernel_launch(void* const* d_in, const int* in_sizes, int n_in, void* d_out, int out_size, void* d_ws,
                              size_t ws_size, hipStream_t stream) {
    static int grid = 0;
    if (grid == 0) {
        int dev = 0, cus = 0;
        (void)hipGetDevice(&dev);
        (void)hipDeviceGetAttribute(&cus, hipDeviceAttributeMultiprocessorCount, dev);
        (void)hipFuncSetAttribute((const void*)mega, hipFuncAttributeMaxDynamicSharedMemorySize, LDS_BYTES);
        grid = cus > 0 ? cus : 256;
    }
    Params P;
    memset(&P, 0, sizeof(P));
    fill_inputs(P, d_in);
    P.B = 4; P.T = 4096; P.N = 16384; P.pad = 0;
    P.xcur = (float*)d_out;
    bind_ws(P, (char*)d_ws);
    Args a;
    memset(&a, 0, sizeof(a));
    for (int i = 0; i < 38; ++i) a.in[i] = (const float*)d_in[i];
    a.out = (float*)d_out; a.ws = (unsigned char*)d_ws;
    (void)hipMemsetAsync(d_ws, 0, 1u << 20, stream);
    int li = 0;
    auto run_mega = [&](int lo, int hi) { a.ph_lo = lo; a.ph_hi = hi; a.li = li++; hipLaunchKernelGGL(mega, dim3(grid), dim3(NTHR), LDS_BYTES, stream, a); };
    run_mega(PH_P0, PH_TOTAL);
}
#endif
```

```cpp
#ifndef HOST_EMU
#include <hip/hip_runtime.h>
#include <cstring>
#define HD __host__ __device__ __forceinline__
#else
#include <cmath>
#include <cstdio>
#include <cstdlib>
#include <cstring>
#define HD inline
#endif

constexpr int DM = 2048;
constexpr int NL = 2;
constexpr int INC = 6424;
constexpr int C_RW = 0;
constexpr int C_GLA = 1792;
constexpr int C_LRU = 3344;
constexpr int C_GDN = 4368;
constexpr int NEXP = 16384;

typedef unsigned short bf16_t;
constexpr int PLD = 6656;
HD float bf2f(bf16_t h) { unsigned u = (unsigned)h << 16; float f; memcpy(&f, &u, 4); return f; }
HD bf16_t f2bf(float f) { unsigned u; memcpy(&u, &f, 4); return (bf16_t)((u + 0x7fffu + ((u >> 16) & 1u)) >> 16); }

struct Params {
    const float *x, *norm_mix, *w_in, *w_out, *rw_mu, *rw_w0, *rw_w_up, *rw_a0, *rw_a_up, *rw_g_up, *rw_k_k, *rw_k_a,
        *rw_r_k, *rw_ln_w, *rw_ln_b, *rw_v0, *rw_v_down, *rw_v_up, *gla_a_up, *gla_a_bias, *gla_norm, *lru_conv_w,
        *lru_conv_b, *lru_w_r, *lru_b_r, *lru_w_i, *lru_b_i, *lru_lam, *gdn_conv_w, *gdn_a_log, *gdn_dt_bias, *gdn_norm,
        *norm_ffn, *peer_wq, *peer_sub_keys, *peer_u, *peer_v, *norm_final;
    float* xcur;
    bf16_t* xn;
    bf16_t* hb;
    bf16_t* mix16;
    bf16_t* p16;
    float* sc;
    float* qf;
    float* rstd;
    float* vfirst;
    float* scr;
    float* act;
    float* gate;
    int* idx;
    int B, T, N, pad;
};

HD float sigmoidf_(float x) { return 1.0f / (1.0f + expf(-x)); }
HD float softplusf_(float x) { return log1pf(expf(-fabsf(x))) + fmaxf(x, 0.0f); }
HD float siluf_(float x) { return x * sigmoidf_(x); }
HD float geluf_(float x) { return 0.5f * x * (1.0f + tanhf(0.7978845608028654f * (x + 0.044715f * x * x * x))); }

enum Stage {
    ST_COPYX = 0,
    ST_RSTD, ST_NORM1, ST_GEMM1,
    ST_RW_A0, ST_RW_A1, ST_RW_A2, ST_RW_A3, ST_RW_KKN, ST_RW_SCAN, ST_RW_POST,
    ST_GLA_B0, ST_GLA_SCAN, ST_GLA_POST,
    ST_LRU_C0, ST_LRU_C1, ST_LRU_SCAN,
    ST_GDN_D0, ST_GDN_D1, ST_GDN_SCAN, ST_GDN_POST,
    ST_GEMM2, ST_RSTD2, ST_NORM2, ST_GEMM3, ST_SCORES, ST_TOPK1, ST_TOPK2, ST_PEER_U, ST_PEER_V,
    ST_FRSTD, ST_FNORM,
    ST_COUNT
};

constexpr long SO_ZS = 0, SO_R = 256, SO_DEC = 768, SO_KM = 1280, SO_KK = 1792, SO_A = 2304, SO_G = 2816, SO_V = 3328,
               SO_Y = 3840, SO_VD = 4352, SO_KKINV = 4384;
constexpr long SO_ALPHA = 0, SO_GO = 256;
constexpr long SO_XC = 0, SO_LA = 512, SO_LU = 1024;
constexpr long SO_QKV = 0, SO_GS = 1536, SO_DO = 1552;
constexpr long SCR_PER_TOK = 4400;
constexpr long SO_TS = 0, SO_TI = 256;

HD long stage_items(const Params& P, int st, int l) {
    const long N = P.N;
    switch (st) {
        case ST_COPYX: return N * DM;
        case ST_RSTD: case ST_RSTD2: case ST_FRSTD: return N;
        case ST_NORM1: case ST_NORM2: case ST_FNORM: return N * DM;
        case ST_GEMM1: return (N / 4) * (INC / 4);
        case ST_RW_A0: return N * 256;
        case ST_RW_A1: return N * 512;
        case ST_RW_A2: return l > 0 ? N * 32 : 0;
        case ST_RW_A3: return l > 0 ? N * 512 : 0;
        case ST_RW_KKN: return N * 8;
        case ST_RW_SCAN: return (long)P.B * 512;
        case ST_RW_POST: return N * 8;
        case ST_GLA_B0: return N * 256;
        case ST_GLA_SCAN: return (long)P.B * 512;
        case ST_GLA_POST: return N * 4;
        case ST_LRU_C0: return N * 512;
        case ST_LRU_C1: return N * 512;
        case ST_LRU_SCAN: return (long)P.B * 512;
        case ST_GDN_D0: return N * 1536;
        case ST_GDN_D1: return N * 4;
        case ST_GDN_SCAN: return (long)P.B * 512;
        case ST_GDN_POST: return N * 4;
        case ST_GEMM2: case ST_GEMM3: return (N / 4) * (DM / 4);
        case ST_SCORES: return N * 2048;
        case ST_TOPK1: return N * 16;
        case ST_TOPK2: return N * 8;
        case ST_PEER_U: return N * 128;
        case ST_PEER_V: return N * DM;
    }
    return 0;
}

HD void gemm_item(const bf16_t* A, const float* W, int ldw, const float* kscale, float* Cf, bf16_t* Ch, int ldc, int n4, long item, int mode) {
    const long r4 = item / n4;
    const int c4 = (int)(item % n4);
    const bf16_t* a0 = A + (r4 * 4) * (long)DM;
    const float* w = W + c4 * 4;
    float acc[4][4];
    for (int i = 0; i < 4; ++i)
        for (int j = 0; j < 4; ++j) acc[i][j] = 0.f;
    for (int k = 0; k < DM; ++k) {
        const float ks = kscale ? kscale[k] : 1.0f;
        const float w0 = w[(long)k * ldw + 0] * ks, w1 = w[(long)k * ldw + 1] * ks, w2 = w[(long)k * ldw + 2] * ks, w3 = w[(long)k * ldw + 3] * ks;
#pragma unroll
        for (int i = 0; i < 4; ++i) {
            const float a = bf2f(a0[(long)i * DM + k]);
            acc[i][0] += a * w0; acc[i][1] += a * w1; acc[i][2] += a * w2; acc[i][3] += a * w3;
        }
    }
#pragma unroll
    for (int i = 0; i < 4; ++i) {
        const long o = (r4 * 4 + i) * (long)ldc + c4 * 4;
#pragma unroll
        for (int j = 0; j < 4; ++j) {
            if (mode == 0) Ch[o + j] = f2bf(acc[i][j]);
            else if (mode == 1) Cf[o + j] += acc[i][j];
            else Cf[o + j] = acc[i][j];
        }
    }
}

#define PF(n, col) bf2f(P.p16[(long)(n) * PLD + (col)])
HD float rw_shift(const Params& P, int l, long n, int col) {
    const int t = (int)(n % P.T);
    const float cur = PF(n, C_RW + col);
    const float prev = t > 0 ? PF(n - 1, C_RW + col) : 0.f;
    return cur + (prev - cur) * P.rw_mu[l * 1792 + col];
}

HD void run_item(const Params& P, int st, int l, long it) {
    const long N = P.N;
    float* scr = P.scr;
    switch (st) {
        case ST_COPYX: P.xcur[it] = P.x[it]; break;
        case ST_RSTD: case ST_RSTD2: case ST_FRSTD: {
            const float* xr = P.xcur + it * DM;
            float s = 0.f;
            for (int d = 0; d < DM; ++d) s += xr[d] * xr[d];
            P.rstd[it] = 1.0f / sqrtf(s * (1.0f / DM) + 1e-6f);
        } break;
        case ST_NORM1: case ST_NORM2: case ST_FNORM: {
            const long n = it / DM; const int d = (int)(it % DM);
            if (st == ST_NORM1) P.xn[it] = f2bf(P.xcur[it] * P.rstd[n]);
            else if (st == ST_NORM2) P.hb[it] = f2bf(P.xcur[it] * P.rstd[n] * P.norm_ffn[l * DM + d]);
            else P.xcur[it] = P.xcur[it] * P.rstd[n] * P.norm_final[d];
        } break;
        case ST_GEMM1: gemm_item(P.xn, P.w_in + (long)l * DM * INC, INC, P.norm_mix + l * DM, nullptr, P.p16, PLD, INC / 4, it, 0); break;
        case ST_GEMM2: gemm_item(P.mix16, P.w_out + (long)l * DM * DM, DM, nullptr, P.xcur, nullptr, DM, DM / 4, it, 1); break;
        case ST_GEMM3: gemm_item(P.hb, P.peer_wq + (long)l * DM * DM, DM, nullptr, P.qf, nullptr, DM, DM / 4, it, 2); break;
        case ST_RW_A0: {
            const long n = it / 256; const int c = (int)(it % 256);
            const float z = rw_shift(P, l, n, 1536 + c);
            scr[N * SO_ZS + it] = c < 64 ? tanhf(z) : (c < 128 ? z : sigmoidf_(z));
        } break;
        case ST_RW_A1: {
            const long n = it / 512; const int j = (int)(it % 512);
            const float zr = rw_shift(P, l, n, j), zk = rw_shift(P, l, n, 512 + j), zv = rw_shift(P, l, n, 1024 + j);
            const float* zs = scr + N * SO_ZS + n * 256;
            float aw = P.rw_w0[l * 512 + j], aa = P.rw_a0[l * 512 + j], ag = 0.f;
            const float* wu = P.rw_w_up + (long)l * 64 * 512 + j;
            const float* au = P.rw_a_up + (long)l * 64 * 512 + j;
            const float* gu = P.rw_g_up + (long)l * 128 * 512 + j;
            for (int i = 0; i < 64; ++i) { aw += zs[i] * wu[i * 512]; aa += zs[64 + i] * au[i * 512]; }
            for (int i = 0; i < 128; ++i) ag += zs[128 + i] * gu[i * 512];
            const float w_raw = -softplusf_(-aw) - 0.5f;
            const float a = sigmoidf_(aa);
            scr[N * SO_R + it] = zr;
            scr[N * SO_DEC + it] = expf(-expf(w_raw));
            scr[N * SO_KM + it] = zk * (1.0f + (a - 1.0f) * P.rw_k_a[l * 512 + j]);
            scr[N * SO_KK + it] = zk * P.rw_k_k[l * 512 + j];
            scr[N * SO_A + it] = a;
            scr[N * SO_G + it] = ag;
            scr[N * SO_V + it] = zv;
            if (l == 0) P.vfirst[it] = zv;
        } break;
        case ST_RW_A2: {
            const long n = it / 32; const int i = (int)(it % 32);
            const float* v = scr + N * SO_V + n * 512;
            const float* vdn = P.rw_v_down + (long)(l - 1) * 512 * 32 + i;
            float s = 0.f;
            for (int j = 0; j < 512; ++j) s += v[j] * vdn[j * 32];
            scr[N * SO_VD + it] = s;
        } break;
        case ST_RW_A3: {
            const long n = it / 512; const int j = (int)(it % 512);
            const float* vd = scr + N * SO_VD + n * 32;
            const float* vup = P.rw_v_up + (long)(l - 1) * 32 * 512 + j;
            float s = P.rw_v0[(l - 1) * 512 + j];
            for (int i = 0; i < 32; ++i) s += vd[i] * vup[i * 512];
            const float v = scr[N * SO_V + it];
            scr[N * SO_V + it] = v + (P.vfirst[it] - v) * sigmoidf_(s);
        } break;
        case ST_RW_KKN: {
            const float* kk = scr + N * SO_KK + it * 64;
            float s = 0.f;
            for (int i = 0; i < 64; ++i) s += kk[i] * kk[i];
            scr[N * SO_KKINV + it] = 1.0f / sqrtf(fmaxf(s, 1e-24f));
        } break;
        case ST_RW_SCAN: {
            const int b = (int)(it / 512); const int h = (int)((it % 512) / 64); const int v = (int)(it % 64);
            float S[64];
#pragma unroll
            for (int i = 0; i < 64; ++i) S[i] = 0.f;
            for (int t = 0; t < P.T; ++t) {
                const long n = (long)b * P.T + t;
                const long base = n * 512 + h * 64;
                const float inv = scr[N * SO_KKINV + n * 8 + h];
                const float vv = scr[N * SO_V + base + v];
                const float* KK = scr + N * SO_KK + base;
                const float* DEC = scr + N * SO_DEC + base;
                const float* KM = scr + N * SO_KM + base;
                const float* AA = scr + N * SO_A + base;
                const float* RR = scr + N * SO_R + base;
                float sa = 0.f;
#pragma unroll
                for (int i = 0; i < 64; ++i) sa += S[i] * (-KK[i] * inv);
                float y = 0.f;
#pragma unroll
                for (int i = 0; i < 64; ++i) {
                    const float kk = KK[i] * inv;
                    S[i] = S[i] * DEC[i] + sa * (kk * AA[i]) + vv * KM[i];
                    y += S[i] * RR[i];
                }
                scr[N * SO_Y + base + v] = y;
            }
        } break;
        case ST_RW_POST: {
            const long n = it / 8; const int h = (int)(it % 8);
            const long base = n * 512 + h * 64;
            const float* Y = scr + N * SO_Y + base;
            const float* RR = scr + N * SO_R + base;
            const float* KM = scr + N * SO_KM + base;
            const float* V = scr + N * SO_V + base;
            const float* G = scr + N * SO_G + base;
            float mean = 0.f, bon = 0.f;
            for (int i = 0; i < 64; ++i) { mean += Y[i]; bon += RR[i] * KM[i] * P.rw_r_k[l * 512 + h * 64 + i]; }
            mean *= (1.0f / 64);
            float var = 0.f;
            for (int i = 0; i < 64; ++i) { const float d = Y[i] - mean; var += d * d; }
            const float rs = 1.0f / sqrtf(var * (1.0f / 64) + 64e-5f);
            for (int i = 0; i < 64; ++i) {
                const int c = h * 64 + i;
                const float yn = (Y[i] - mean) * rs * P.rw_ln_w[l * 512 + c] + P.rw_ln_b[l * 512 + c];
                P.mix16[n * DM + c] = f2bf((yn + bon * V[i]) * G[i]);
            }
        } break;
        case ST_GLA_B0: {
            const long n = it / 256; const int c = (int)(it % 256);
            float s = P.gla_a_bias[l * 256 + c];
            for (int i = 0; i < 16; ++i) s += PF(n, C_GLA + 1536 + i) * P.gla_a_up[(long)l * 16 * 256 + i * 256 + c];
            scr[N * SO_ALPHA + it] = expf(-softplusf_(-s) * (1.0f / 16.0f));
        } break;
        case ST_GLA_SCAN: {
            const int b = (int)(it / 512); const int h = (int)((it % 512) / 128); const int v = (int)(it % 128);
            float S[64];
#pragma unroll
            for (int i = 0; i < 64; ++i) S[i] = 0.f;
            for (int t = 0; t < P.T; ++t) {
                const long n = (long)b * P.T + t;
                const bf16_t* q = P.p16 + n * PLD + C_GLA + h * 64;
                const bf16_t* k = q + 256;
                const float vv = PF(n, C_GLA + 512 + h * 128 + v);
                const float* al = scr + N * SO_ALPHA + n * 256 + h * 64;
                float o = 0.f;
#pragma unroll
                for (int i = 0; i < 64; ++i) {
                    S[i] = S[i] * al[i] + bf2f(k[i]) * vv;
                    o += bf2f(q[i]) * S[i];
                }
                scr[N * SO_GO + n * 512 + h * 128 + v] = o * 0.125f;
            }
        } break;
        case ST_GLA_POST: {
            const long n = it / 4; const int h = (int)(it % 4);
            const float* o = scr + N * SO_GO + n * 512 + h * 128;
            float ms = 0.f;
            for (int i = 0; i < 128; ++i) ms += o[i] * o[i];
            const float rs = 1.0f / sqrtf(ms * (1.0f / 128) + 1e-6f);
            for (int i = 0; i < 128; ++i) {
                const float g = PF(n, C_GLA + 1024 + h * 128 + i);
                P.mix16[n * DM + 512 + h * 128 + i] = f2bf(o[i] * rs * P.gla_norm[l * 128 + i] * siluf_(g));
            }
        } break;
        case ST_LRU_C0: {
            const long n = it / 512; const int c = (int)(it % 512);
            const int t = (int)(n % P.T);
            float s = P.lru_conv_b[l * 512 + c];
            for (int j = 0; j < 4; ++j) {
                const int tt = t - 3 + j;
                if (tt >= 0) s += P.lru_conv_w[(long)l * 4 * 512 + j * 512 + c] * PF(n - 3 + j, C_LRU + c);
            }
            scr[N * SO_XC + it] = s;
        } break;
        case ST_LRU_C1: {
            const long n = it / 512; const int c = (int)(it % 512);
            const int blk = c / 64, j = c % 64;
            const float* xc = scr + N * SO_XC + n * 512 + blk * 64;
            const float* wr = P.lru_w_r + (long)l * 8 * 64 * 64 + (long)blk * 64 * 64 + j;
            const float* wi = P.lru_w_i + (long)l * 8 * 64 * 64 + (long)blk * 64 * 64 + j;
            float sr = P.lru_b_r[l * 512 + c], si = P.lru_b_i[l * 512 + c];
            for (int i = 0; i < 64; ++i) { sr += xc[i] * wr[i * 64]; si += xc[i] * wi[i * 64]; }
            const float r = sigmoidf_(sr), ig = sigmoidf_(si);
            const float log_a = -8.0f * r * softplusf_(-P.lru_lam[l * 512 + c]);
            scr[N * SO_LA + it] = expf(log_a);
            scr[N * SO_LU + it] = scr[N * SO_XC + it] * ig * sqrtf(-expm1f(2.0f * log_a));
        } break;
        case ST_LRU_SCAN: {
            const int b = (int)(it / 512); const int c = (int)(it % 512);
            float hst = 0.f;
            for (int t = 0; t < P.T; ++t) {
                const long n = (long)b * P.T + t;
                hst = scr[N * SO_LA + n * 512 + c] * hst + scr[N * SO_LU + n * 512 + c];
                P.mix16[n * DM + 1024 + c] = f2bf(hst * geluf_(PF(n, C_LRU + 512 + c)));
            }
        } break;
        case ST_GDN_D0: {
            const long n = it / 1536; const int c = (int)(it % 1536);
            const int t = (int)(n % P.T);
            float s = 0.f;
            for (int j = 0; j < 4; ++j) {
                const int tt = t - 3 + j;
                if (tt >= 0) s += P.gdn_conv_w[(long)l * 4 * 1536 + j * 1536 + c] * PF(n - 3 + j, C_GDN + c);
            }
            scr[N * SO_QKV + it] = siluf_(s);
        } break;
        case ST_GDN_D1: {
            const long n = it / 4; const int h = (int)(it % 4);
            const float* q = scr + N * SO_QKV + n * 1536 + h * 128;
            const float* k = q + 512;
            float qs = 0.f, ks = 0.f;
            for (int i = 0; i < 128; ++i) { qs += q[i] * q[i]; ks += k[i] * k[i]; }
            float* gs = scr + N * SO_GS + n * 16 + h * 4;
            gs[0] = (1.0f / sqrtf(qs + 1e-6f)) * 0.08838834764831845f;
            gs[1] = 1.0f / sqrtf(ks + 1e-6f);
            gs[2] = sigmoidf_(PF(n, C_GDN + 2048 + h));
            gs[3] = expf(-expf(P.gdn_a_log[l * 4 + h]) * softplusf_(PF(n, C_GDN + 2052 + h) + P.gdn_dt_bias[l * 4 + h]));
        } break;
        case ST_GDN_SCAN: {
            const int b = (int)(it / 512); const int h = (int)((it % 512) / 128); const int v = (int)(it % 128);
            float S[128];
#pragma unroll
            for (int i = 0; i < 128; ++i) S[i] = 0.f;
            for (int t = 0; t < P.T; ++t) {
                const long n = (long)b * P.T + t;
                const float* q = scr + N * SO_QKV + n * 1536 + h * 128;
                const float* k = q + 512;
                const float vv = scr[N * SO_QKV + n * 1536 + 1024 + h * 128 + v];
                const float* gs = scr + N * SO_GS + n * 16 + h * 4;
                const float qinv = gs[0], kinv = gs[1], beta = gs[2], eg = gs[3];
                float dk = 0.f;
#pragma unroll
                for (int i = 0; i < 128; ++i) dk += S[i] * k[i];
                const float u = beta * (vv - eg * kinv * dk) * kinv;
                float o = 0.f;
#pragma unroll
                for (int i = 0; i < 128; ++i) {
                    S[i] = S[i] * eg + u * k[i];
                    o += S[i] * q[i];
                }
                scr[N * SO_DO + n * 512 + h * 128 + v] = o * qinv;
            }
        } break;
        case ST_GDN_POST: {
            const long n = it / 4; const int h = (int)(it % 4);
            const float* o = scr + N * SO_DO + n * 512 + h * 128;
            float ms = 0.f;
            for (int i = 0; i < 128; ++i) ms += o[i] * o[i];
            const float rs = 1.0f / sqrtf(ms * (1.0f / 128) + 1e-6f);
            for (int i = 0; i < 128; ++i) {
                const float z = PF(n, C_GDN + 1536 + h * 128 + i);
                P.mix16[n * DM + 1536 + h * 128 + i] = f2bf(o[i] * rs * P.gdn_norm[l * 128 + i] * siluf_(z));
            }
        } break;
        case ST_SCORES: {
            const long n = it / 2048; const int c = (int)(it % 2048);
            const int hp = c / 128, key = c % 128;
            const float* q = P.qf + n * DM + hp * 128;
            const float* sk = P.peer_sub_keys + (long)l * 16 * 128 * 128 + ((long)hp * 128 + key) * 128;
            float s = 0.f;
            for (int d = 0; d < 128; ++d) s += q[d] * sk[d];
            P.sc[it] = s;
        } break;
        case ST_TOPK1: {
            const float* sc = P.sc + it * 128;
            float ts[16]; int ti[16];
#pragma unroll
            for (int j = 0; j < 16; ++j) { ts[j] = -3.0e38f; ti[j] = 0; }
            for (int i = 0; i < 128; ++i) {
                float xv = sc[i]; int xi = i;
                if (xv > ts[15]) {
#pragma unroll
                    for (int j = 0; j < 16; ++j) {
                        if (xv > ts[j]) { const float tv = ts[j]; const int tj = ti[j]; ts[j] = xv; ti[j] = xi; xv = tv; xi = tj; }
                    }
                }
            }
            float* TS = scr + N * SO_TS + it * 16;
            int* TI = (int*)(scr + N * SO_TI) + it * 16;
#pragma unroll
            for (int j = 0; j < 16; ++j) { TS[j] = ts[j]; TI[j] = ti[j]; }
        } break;
        case ST_TOPK2: {
            const float* s0 = scr + N * SO_TS + it * 32;
            const float* s1 = s0 + 16;
            const int* i0 = (const int*)(scr + N * SO_TI) + it * 32;
            const int* i1 = i0 + 16;
            float ts[16]; int ti[16];
#pragma unroll
            for (int j = 0; j < 16; ++j) { ts[j] = -3.0e38f; ti[j] = 0; }
            for (int a = 0; a < 16; ++a) {
                const int jmax = 16 / (a + 1);
                for (int b = 0; b < jmax; ++b) {
                    float xv = s0[a] + s1[b]; int xi = i0[a] * 128 + i1[b];
                    if (xv > ts[15]) {
#pragma unroll
                        for (int j = 0; j < 16; ++j) {
                            if (xv > ts[j]) { const float tv = ts[j]; const int tj = ti[j]; ts[j] = xv; ti[j] = xi; xv = tv; xi = tj; }
                        }
                    }
                }
            }
            const float mx = ts[0];
            float den = 0.f;
#pragma unroll
            for (int j = 0; j < 16; ++j) { ts[j] = expf(ts[j] - mx); den += ts[j]; }
            const float inv = 1.0f / den;
#pragma unroll
            for (int j = 0; j < 16; ++j) { P.gate[it * 16 + j] = ts[j] * inv; P.idx[it * 16 + j] = ti[j]; }
        } break;
        case ST_PEER_U: {
            const long n = it / 128;
            const int e = P.idx[it];
            const float* u = P.peer_u + ((long)l * NEXP + e) * DM;
            const bf16_t* hx = P.hb + n * DM;
            float s = 0.f;
            for (int d = 0; d < DM; ++d) s += bf2f(hx[d]) * u[d];
            P.act[it] = geluf_(s) * P.gate[it];
        } break;
        case ST_PEER_V: {
            const long n = it / DM; const int d = (int)(it % DM);
            const float* a = P.act + n * 128;
            const int* ix = P.idx + n * 128;
            float s = 0.f;
            for (int j = 0; j < 128; ++j) s += a[j] * P.peer_v[((long)l * NEXP + ix[j]) * DM + d];
            P.xcur[it] += s;
        } break;
    }
}


struct WsMap {
    size_t ctl, w1t, w2t, wsct, auxwt, lruwt, vreswt, pp, tabu, tabv, xn, hb, mix16, p16, sc, aux, vfirst, idx, gate, rstd, act, end;
    size_t auxA, zrkv, xc, auxo, gates, vres, glao, gdno, gq, gk, gv, gsc, rwy, rwbv, lrs, gblob;
    size_t scr, qf;
};
HD WsMap ws_map(size_t N) {
    WsMap m{};
    size_t o = 0;
    auto take = [&](size_t bytes) { size_t r = o; o += (bytes + 4095) & ~(size_t)4095; return r; };
    m.ctl = take(1u << 20);
    m.w1t = take((size_t)NL * PLD * DM * 2);
    m.w2t = take((size_t)NL * DM * DM * 2);
    m.wsct = take((size_t)NL * DM * DM * 2);
    m.auxwt = take((size_t)NL * 1792 * 384 * 2);
    m.lruwt = take((size_t)NL * 1024 * 512 * 2);
    m.vreswt = take((size_t)512 * 512 * 2);
    m.pp = take(1u << 20);
    m.xn = take(N * DM * 2);
    m.hb = take(N * DM * 2);
    m.mix16 = take(N * DM * 2);
    m.p16 = take(N * PLD * 2);
    m.sc = m.p16;
    m.vfirst = take(N * 512 * 4);
    m.idx = take(N * 128 * 4);
    m.gate = take(N * 128 * 4);
    m.act = take(N * 128 * 4);
    m.rstd = take(N * 4);
    m.tabu = take((size_t)NL * 2 * NEXP * DM);
    m.tabv = m.tabu + (size_t)NEXP * DM;
    m.aux = take(N * 5488 * 4);
    m.end = o;
    size_t a = m.aux;
    auto sub = [&](size_t bytes) { size_t r = a; a += (bytes + 4095) & ~(size_t)4095; return r; };
    m.auxA = sub(N * 384 * 2); m.zrkv = sub(N * 1536 * 2); m.xc = sub(N * 512 * 2); m.auxo = sub(N * 1792 * 2);
    m.gates = sub(N * 1024 * 2); m.vres = sub(N * 512 * 2); m.glao = sub(N * 512 * 2); m.gdno = sub(N * 512 * 2);
    m.gq = sub(N * 512 * 2); m.gk = sub(N * 512 * 2); m.gv = sub(N * 512 * 2); m.gsc = sub(N * 8 * 4); m.rwy = sub(N * 512 * 2); m.rwbv = sub(N * 512 * 2); m.lrs = sub(N / 64 * 512 * 2 * 4);
    m.gblob = sub(N / 64 * 4 * 18688);
    m.scr = m.tabu;
    m.qf = m.aux + N * 1024 * 4;
    return m;
}
static inline void bind_ws(Params& P, char* ws) {
    const WsMap m = ws_map((size_t)P.N);
    P.xn = (bf16_t*)(ws + m.xn); P.hb = (bf16_t*)(ws + m.hb); P.mix16 = (bf16_t*)(ws + m.mix16); P.p16 = (bf16_t*)(ws + m.p16);
    P.sc = (float*)(ws + m.sc); P.qf = (float*)(ws + m.qf); P.rstd = (float*)(ws + m.rstd); P.vfirst = (float*)(ws + m.vfirst);
    P.scr = (float*)(ws + m.scr); P.act = (float*)(ws + m.act); P.gate = (float*)(ws + m.gate); P.idx = (int*)(ws + m.idx);
}

struct Step { int st, l; };
static inline int build_schedule(Step* s) {
    int n = 0;
    s[n++] = {ST_COPYX, 0};
    for (int l = 0; l < NL; ++l) {
        static const int per_layer[] = {ST_RSTD, ST_NORM1, ST_GEMM1,
            ST_RW_A0, ST_RW_A1, ST_RW_A2, ST_RW_A3, ST_RW_KKN, ST_RW_SCAN, ST_RW_POST,
            ST_GLA_B0, ST_GLA_SCAN, ST_GLA_POST, ST_LRU_C0, ST_LRU_C1, ST_LRU_SCAN,
            ST_GDN_D0, ST_GDN_D1, ST_GDN_SCAN, ST_GDN_POST,
            ST_GEMM2, ST_RSTD2, ST_NORM2, ST_GEMM3, ST_SCORES, ST_TOPK1, ST_TOPK2, ST_PEER_U, ST_PEER_V};
        for (int i = 0; i < (int)(sizeof(per_layer) / sizeof(int)); ++i) s[n++] = {per_layer[i], l};
    }
    s[n++] = {ST_FRSTD, 0};
    s[n++] = {ST_FNORM, 0};
    return n;
}

static inline void fill_inputs(Params& P, void* const* d_in) {
    const float** dst = (const float**)&P;
    for (int i = 0; i < 38; ++i) dst[i] = (const float*)d_in[i];
}

#ifndef HOST_EMU
#define GAS __attribute__((address_space(1)))
#define LAS __attribute__((address_space(3)))
typedef unsigned v4u __attribute__((ext_vector_type(4)));
typedef unsigned v2u __attribute__((ext_vector_type(2)));
typedef float f32x4 __attribute__((ext_vector_type(4)));
typedef float f32x2 __attribute__((ext_vector_type(2)));
typedef short bf16x8 __attribute__((ext_vector_type(8)));
constexpr int NWAVES = 8, NTHR = 512;
constexpr int RING_BYTES = 131072, MISC_OFF = RING_BYTES + 320, LDS_BYTES = 147456;
constexpr int NTOK = 16384, TSEQ = 4096, NBATCH = 4;

__device__ __forceinline__ unsigned pk2(float lo, float hi) { return (unsigned)f2bf(lo) | ((unsigned)f2bf(hi) << 16); }
__device__ __forceinline__ float bflo(unsigned u) { return __builtin_bit_cast(float, u << 16); }
__device__ __forceinline__ float bfhi(unsigned u) { return __builtin_bit_cast(float, u & 0xffff0000u); }
__device__ __forceinline__ float wave_sum(float v) {
#pragma unroll
    for (int o = 1; o < 64; o <<= 1) v += __shfl_xor(v, o);
    return v;
}
#define LDS_WAIT() asm volatile("s_waitcnt lgkmcnt(0)" ::: "memory")
#define VM_WAIT() asm volatile("s_waitcnt vmcnt(0)" ::: "memory")

namespace pg8 {
#define PG8_LAS __attribute__((address_space(3)))
constexpr int BM = 256, BK = 64, HALF = 128, HTB = HALF * BK * 2, STAGE_BYTES = 8 * HTB, NXCD = 8, WGM = 8;
__host__ __device__ __forceinline__ int lds_byte(int r, int c) { const int st = (r >> 4) * 2 + (c >> 5), rr = r & 15, cc = c & 31, ob = rr * 64 + cc * 2; return st * 1024 + (ob ^ (((ob >> 9) & 1) << 5)); }
__host__ __device__ __forceinline__ void stage_rc(int b, int& R, int& C) { const int st = b / 1024, sb = b % 1024, swz = sb ^ (((sb >> 9) & 1) << 5); R = (st >> 1) * 16 + swz / 64; C = (st & 1) * 32 + (swz % 64) / 2; }
__host__ __device__ __forceinline__ int perm32(int rho) { const int n = rho >> 4, i = rho & 15; return 8 * (i >> 2) + 4 * n + (i & 3); }
struct Unit { int pm, pn; };
struct GemmX { const bf16_t* A; const bf16_t* Bt; int M, N, K, lda; };
struct StaticOrder {
    int nM, nN, nwg, G, c;
    __host__ __device__ void init(int M, int N, int G_, int c_) { nM = M / BM; nN = N / BM; nwg = nM * nN; G = G_; c = c_; }
    __host__ __device__ bool next(int i, Unit& u) const {
        const long L = (long)i * G + c; if (L >= nwg) return false;
        int wgid = (int)L; { const int q = nwg / NXCD, r = nwg % NXCD, xcd = wgid % NXCD, off = wgid / NXCD; wgid = (xcd < r ? xcd * (q + 1) : r * (q + 1) + (xcd - r) * q) + off; }
        const int nig = WGM * nN, gid = wgid / nig, fm = gid * WGM, gsz = (nM - fm) < WGM ? (nM - fm) : WGM;
        u.pm = fm + ((wgid % nig) % gsz); u.pn = (wgid % nig) / gsz; return true;
    }
    __device__ __forceinline__ void a_ready(const Unit&) const {}
    __device__ __forceinline__ void done(const Unit&) const {}
};
__device__ __forceinline__ unsigned cvt_pk_bf16(float lo, float hi) { unsigned r; asm volatile("v_cvt_pk_bf16_f32 %0, %1, %2" : "=v"(r) : "v"(lo), "v"(hi)); return r; }
template <bool ACCUM> struct EpiF32 {
    static constexpr bool PERM = false, AFTER_DRAIN = false;
    float* C; int ldc;
    __device__ __forceinline__ void operator()(const f32x4 (&acc)[2][2][4][2], const Unit& u, int wr, int wc, int fr, int fq) const {
        const int row0 = u.pm * BM + wr * 64 + fr, col0 = u.pn * BM + wc * 32 + 4 * fq;
#pragma unroll
        for (int ai = 0; ai < 2; ++ai)
#pragma unroll
            for (int m = 0; m < 4; ++m) { float* rowp = C + (size_t)(row0 + ai * HALF + m * 16) * ldc + col0;
#pragma unroll
                for (int bj = 0; bj < 2; ++bj)
#pragma unroll
                    for (int n = 0; n < 2; ++n) { f32x4* p = (f32x4*)(rowp + bj * HALF + n * 16);
                        if (ACCUM) *p = *p + acc[ai][bj][m][n]; else *p = acc[ai][bj][m][n]; } }
    }
};
struct EpiBf16 {
    static constexpr bool PERM = true, AFTER_DRAIN = false;
    bf16_t* O; int ldc; const float* bias;
    __device__ __forceinline__ void operator()(const f32x4 (&acc)[2][2][4][2], const Unit& u, int wr, int wc, int fr, int fq) const {
        const int row0 = u.pm * BM + wr * 64 + fr; const int col0 = u.pn * BM + wc * 32 + 8 * fq;
        f32x4 bv[2][2];
#pragma unroll
        for (int bj = 0; bj < 2; ++bj)
#pragma unroll
            for (int n = 0; n < 2; ++n) bv[bj][n] = bias ? *(const f32x4*)(bias + col0 + bj * HALF + 4 * n) : (f32x4){0.f, 0.f, 0.f, 0.f};
#pragma unroll
        for (int ai = 0; ai < 2; ++ai)
#pragma unroll
            for (int m = 0; m < 4; ++m) { bf16_t* rowp = O + (size_t)(row0 + ai * HALF + m * 16) * ldc + col0;
#pragma unroll
                for (int bj = 0; bj < 2; ++bj) { const f32x4 v0 = acc[ai][bj][m][0] + bv[bj][0], v1 = acc[ai][bj][m][1] + bv[bj][1];
                    v4u w; w.x = cvt_pk_bf16(v0[0], v0[1]); w.y = cvt_pk_bf16(v0[2], v0[3]); w.z = cvt_pk_bf16(v1[0], v1[1]); w.w = cvt_pk_bf16(v1[2], v1[3]);
                    *(v4u*)(rowp + bj * HALF) = w; } }
    }
};
template <class Epi, class Sched, bool ALIGN_EPI = false, bool SP2 = false>
__device__ __forceinline__ void gemm_phase(PG8_LAS unsigned char* lds, const GemmX g, const Sched& S, const Epi& E) {
    const int tid = threadIdx.x, wid = __builtin_amdgcn_readfirstlane(tid >> 6), lane = tid & 63, wr = wid >> 2, wc = wid & 3, fr = lane & 15, fq = lane >> 4;
    const int K = g.K, nt = K / BK;
    unsigned voffA[2], voffB[2];
#pragma unroll
    for (int i = 0; i < 2; ++i) { int R, C; stage_rc(tid * 16 + i * 8192, R, C); const int Rb = Epi::PERM ? ((R & ~31) + perm32(R & 31)) : R;
        voffA[i] = (unsigned)(R * g.lda + C) * 2u; voffB[i] = (unsigned)(Rb * K + C) * 2u; }
    const size_t kstep = (size_t)(BK * 2);
    const size_t hstep = (size_t)HALF * K * 2;
    const size_t tstep = 2 * hstep;
    const size_t hstepA = (size_t)HALF * g.lda * 2, tstepA = 2 * hstepA;
    const unsigned ldsw = (unsigned)wid * 1024u;
    const int aoff = lds_byte(wr * 64 + fr, fq * 8), boff = lds_byte(wc * 32 + fr, fq * 8);
#define PG8_SA(b, h) (((b) * 2 + (h)) * HTB)
#define PG8_SB(b, h) ((4 + (b) * 2 + (h)) * HTB)
#define PG8_STAGE(bufoff, gbase, voff) do { _Pragma("unroll") for (int _i = 0; _i < 2; ++_i) \
        __builtin_amdgcn_global_load_lds((const unsigned*)((const char*)(gbase) + (voff)[_i]), (PG8_LAS unsigned*)(lds + (bufoff) + ldsw + _i * 8192), 16, 0, 0); } while (0)
#define PG8_LDA(dst, b, h) do { _Pragma("unroll") for (int m = 0; m < 4; ++m) _Pragma("unroll") for (int k = 0; k < 2; ++k) dst[m][k] = *(const PG8_LAS bf16x8*)(lds + PG8_SA(b, h) + aoff + m * 2048 + k * 1024); } while (0)
#define PG8_LDB(dst, b, h) do { _Pragma("unroll") for (int n = 0; n < 2; ++n) _Pragma("unroll") for (int k = 0; k < 2; ++k) dst[n][k] = *(const PG8_LAS bf16x8*)(lds + PG8_SB(b, h) + boff + n * 2048 + k * 1024); } while (0)
#define PG8_MMA(ai, bj, At, Bt) do { __builtin_amdgcn_s_setprio(1); _Pragma("unroll") for (int m = 0; m < 4; ++m) _Pragma("unroll") for (int n = 0; n < 2; ++n) _Pragma("unroll") for (int k = 0; k < 2; ++k) \
        acc[ai][bj][m][n] = __builtin_amdgcn_mfma_f32_16x16x32_bf16(Bt[n][k], At[m][k], acc[ai][bj][m][n], 0, 0, 0); __builtin_amdgcn_s_setprio(0); } while (0)
#define PG8_WAIT_V(n) asm volatile("s_waitcnt vmcnt(" #n ")" ::: "memory")
#define PG8_WAIT_L(n) asm volatile("s_waitcnt lgkmcnt(" #n ")" ::: "memory")
#define PG8_BAR __builtin_amdgcn_s_barrier()
#define PG8_SCHED __builtin_amdgcn_sched_barrier(0)
    Unit cur, nxt; int ui = 0;
    if (!S.next(0, cur)) return;
    f32x4 acc[2][2][4][2];
#pragma unroll
    for (int a = 0; a < 2; ++a)
#pragma unroll
        for (int b = 0; b < 2; ++b)
#pragma unroll
            for (int m = 0; m < 4; ++m)
#pragma unroll
                for (int n = 0; n < 2; ++n) acc[a][b][m][n] = (f32x4){0.f, 0.f, 0.f, 0.f};
    bf16x8 At[4][2], B0[2][2], B1[2][2];
    const char* cA = (const char*)g.A + (size_t)cur.pm * tstepA; const char* cB = (const char*)g.Bt + (size_t)cur.pn * tstep;
    S.a_ready(cur);
    if constexpr (SP2) {
        PG8_STAGE(PG8_SB(0, 0), cB, voffB); PG8_STAGE(PG8_SB(0, 1), cB + hstep, voffB); PG8_STAGE(PG8_SA(0, 0), cA, voffA); PG8_STAGE(PG8_SA(0, 1), cA + hstepA, voffA);
        if (wr == 1) PG8_BAR;
        PG8_WAIT_V(2); PG8_BAR;
        PG8_STAGE(PG8_SB(1, 0), cB + kstep, voffB); PG8_STAGE(PG8_SA(1, 0), cA + kstep, voffA); PG8_STAGE(PG8_SB(1, 1), cB + hstep + kstep, voffB);
        PG8_WAIT_V(6); PG8_BAR;
    } else {
        PG8_STAGE(PG8_SB(0, 0), cB, voffB); PG8_STAGE(PG8_SA(0, 0), cA, voffA); PG8_STAGE(PG8_SB(0, 1), cB + hstep, voffB); PG8_STAGE(PG8_SA(0, 1), cA + hstepA, voffA);
        if (wr == 1) PG8_BAR;
        PG8_WAIT_V(4); PG8_BAR;
        PG8_STAGE(PG8_SB(1, 0), cB + kstep, voffB); PG8_STAGE(PG8_SA(1, 0), cA + kstep, voffA); PG8_STAGE(PG8_SB(1, 1), cB + hstep + kstep, voffB);
        PG8_WAIT_V(6); PG8_BAR;
    }
    for (;;) {
        const bool has_next = S.next(ui + 1, nxt);
        const char* nA = has_next ? (const char*)g.A + (size_t)nxt.pm * tstepA : cA; const char* nB = has_next ? (const char*)g.Bt + (size_t)nxt.pn * tstep : cB;
        for (int t = 0; t < nt; t += 2) {
            const bool last = (t == nt - 2);
            const char* a1 = cA + (size_t)(t + 1) * kstep;
            const char* a2 = last ? nA : cA + (size_t)(t + 2) * kstep; const char* b2 = last ? nB : cB + (size_t)(t + 2) * kstep;
            const char* a3 = a2 + kstep; const char* b3 = b2 + kstep;
            if (last && has_next) S.a_ready(nxt);
            if constexpr (SP2) {
            PG8_LDB(B0, 0, 0); PG8_LDB(B1, 0, 1); PG8_SCHED; PG8_LDA(At, 0, 0); PG8_STAGE(PG8_SA(1, 1), a1 + hstepA, voffA);
            PG8_WAIT_V(8); PG8_WAIT_L(0); PG8_BAR; PG8_MMA(0, 0, At, B0); PG8_MMA(0, 1, At, B1); PG8_BAR; PG8_SCHED;
            PG8_LDA(At, 0, 1); PG8_STAGE(PG8_SB(0, 0), b2, voffB); PG8_STAGE(PG8_SB(0, 1), b2 + hstep, voffB); PG8_STAGE(PG8_SA(0, 0), a2, voffA);
            PG8_WAIT_V(8); PG8_WAIT_L(0); PG8_BAR; PG8_MMA(1, 0, At, B0); PG8_MMA(1, 1, At, B1); PG8_BAR; PG8_SCHED;
            PG8_LDB(B0, 1, 0); PG8_LDB(B1, 1, 1); PG8_SCHED; PG8_LDA(At, 1, 0); PG8_STAGE(PG8_SA(0, 1), a2 + hstepA, voffA);
            PG8_WAIT_V(8); PG8_WAIT_L(0); PG8_BAR; PG8_MMA(0, 0, At, B0); PG8_MMA(0, 1, At, B1); PG8_BAR; PG8_SCHED;
            PG8_LDA(At, 1, 1); PG8_STAGE(PG8_SB(1, 0), b3, voffB); PG8_STAGE(PG8_SB(1, 1), b3 + hstep, voffB); PG8_STAGE(PG8_SA(1, 0), a3, voffA);
            PG8_WAIT_V(8); PG8_WAIT_L(0); PG8_BAR; PG8_MMA(1, 0, At, B0); PG8_MMA(1, 1, At, B1); PG8_BAR; PG8_SCHED;
            } else {
            PG8_LDB(B0, 0, 0); PG8_SCHED; PG8_LDA(At, 0, 0); PG8_STAGE(PG8_SA(1, 1), a1 + hstepA, voffA);
            PG8_WAIT_L(8); PG8_BAR; PG8_WAIT_L(0); PG8_MMA(0, 0, At, B0); PG8_BAR; PG8_SCHED;
            PG8_LDB(B1, 0, 1); PG8_STAGE(PG8_SB(0, 0), b2, voffB);
            PG8_BAR; PG8_WAIT_L(0); PG8_MMA(0, 1, At, B1); PG8_BAR;
            PG8_LDA(At, 0, 1); PG8_STAGE(PG8_SA(0, 0), a2, voffA);
            PG8_BAR; PG8_WAIT_L(0); PG8_MMA(1, 0, At, B0); PG8_BAR; PG8_SCHED;
            PG8_STAGE(PG8_SB(0, 1), b2 + hstep, voffB);
            PG8_WAIT_V(6); PG8_BAR; PG8_MMA(1, 1, At, B1); PG8_BAR;
            PG8_LDB(B0, 1, 0); PG8_SCHED; PG8_LDA(At, 1, 0); PG8_STAGE(PG8_SA(0, 1), a2 + hstepA, voffA);
            PG8_WAIT_L(8); PG8_BAR; PG8_WAIT_L(0); PG8_MMA(0, 0, At, B0); PG8_BAR; PG8_SCHED;
            PG8_LDB(B1, 1, 1); PG8_STAGE(PG8_SB(1, 0), b3, voffB);
            PG8_BAR; PG8_WAIT_L(0); PG8_MMA(0, 1, At, B1); PG8_BAR;
            PG8_LDA(At, 1, 1); PG8_STAGE(PG8_SA(1, 0), a3, voffA);
            PG8_BAR; PG8_WAIT_L(0); PG8_MMA(1, 0, At, B0); PG8_BAR; PG8_SCHED;
            PG8_STAGE(PG8_SB(1, 1), b3 + hstep, voffB);
            PG8_WAIT_V(6); PG8_BAR; PG8_MMA(1, 1, At, B1); PG8_BAR;
            }
        }
        if constexpr (ALIGN_EPI) { if (wr == 0) PG8_BAR; }
        if constexpr (!Epi::AFTER_DRAIN) { E(acc, cur, wr, wc, fr, fq); S.done(cur); }
        if (!has_next) break;
#pragma unroll
        for (int a = 0; a < 2; ++a)
#pragma unroll
            for (int b = 0; b < 2; ++b)
#pragma unroll
                for (int m = 0; m < 4; ++m)
#pragma unroll
                    for (int n = 0; n < 2; ++n) acc[a][b][m][n] = (f32x4){0.f, 0.f, 0.f, 0.f};
        cur = nxt; cA = nA; cB = nB; ++ui;
        if constexpr (ALIGN_EPI) { if (wr == 1) PG8_BAR; }
    }
    PG8_WAIT_V(0);
    if constexpr (!ALIGN_EPI) { if (wr == 0) PG8_BAR; }
    PG8_BAR;
    if constexpr (Epi::AFTER_DRAIN) { E.fused(acc, cur, wr, wc, fr, fq, lds, wid, lane); S.done(cur); }
#undef PG8_SA
#undef PG8_SB
#undef PG8_STAGE
#undef PG8_LDA
#undef PG8_LDB
#undef PG8_MMA
#undef PG8_WAIT_V
#undef PG8_WAIT_L
#undef PG8_BAR
#undef PG8_SCHED
}
}

#define XB_TMO      128
#define XB_XCNT(j)  (256  + 64 * (j))
#define XB_XSUB(j)  (1280 + 64 * (j))
#define XB_XGEN(j)  (2304 + 64 * (j))
#define XB_TOP      3328
#define XB_TOPGEN   3392
#define XCD_BAR_WORDS 3456
#define XB_SPIN_CAP (1u << 20)
__device__ __forceinline__ unsigned xb_ld(unsigned* p) { return __hip_atomic_load(p, __ATOMIC_RELAXED, __HIP_MEMORY_SCOPE_AGENT); }
__device__ __forceinline__ unsigned xb_add(unsigned* p, unsigned v) { return __hip_atomic_fetch_add(p, v, __ATOMIC_RELAXED, __HIP_MEMORY_SCOPE_AGENT); }
__device__ __forceinline__ unsigned xb_xcc_id() { return (unsigned)__builtin_amdgcn_s_getreg((3 << 11) | 20) & 0xFu; }
#define XB_SPIN(cond, bar) do { unsigned _sp = 0; while (cond) { __builtin_amdgcn_s_sleep(1); \
    if ((++_sp & 255u) == 0u) { if (xb_ld(&(bar)[XB_TMO])) break; if (_sp > XB_SPIN_CAP) { atomicAdd(&(bar)[XB_TMO], 1u); break; } } } } while (0)
struct XcdBarrier { unsigned* bar; unsigned x; volatile LAS unsigned* st; };
__device__ __forceinline__ XcdBarrier xcd_barrier_post(unsigned* bar, volatile LAS unsigned* st) {
    XcdBarrier b; b.bar = bar; b.x = xb_xcc_id(); b.st = st;
    if (threadIdx.x == 0) (void)xb_add(&bar[XB_XCNT(b.x)], 1u);
    return b;
}
__device__ __forceinline__ void xcd_barrier_complete(unsigned* bar, unsigned x, unsigned& nloc, unsigned& nx) {
    const unsigned G = gridDim.x * gridDim.y * gridDim.z;
    unsigned sum, cnt, mine, sp = 0u;
    for (;;) {
        sum = 0u; cnt = 0u; mine = 0u;
#pragma unroll
        for (unsigned j = 0; j < 16; ++j) { const unsigned c = xb_ld(&bar[XB_XCNT(j)]); sum += c; cnt += (c > 0u) ? 1u : 0u; mine = (j == x) ? c : mine; }
        if (sum == G) break;
        __builtin_amdgcn_s_sleep(1);
        if ((++sp & 255u) == 0u) { if (xb_ld(&bar[XB_TMO])) break; if (sp > XB_SPIN_CAP) { atomicAdd(&bar[XB_TMO], 1u); break; } }
    }
    nloc = mine > 0u ? mine : 1u; nx = cnt > 0u ? cnt : 1u;
}
__device__ __forceinline__ void xcd_barrier(const XcdBarrier& b) {
    asm volatile("s_waitcnt vmcnt(0)" ::: "memory");
    __syncthreads();
    if (threadIdx.x == 0) {
        unsigned* bar = b.bar;
        __builtin_amdgcn_s_waitcnt(0);
        unsigned nloc = b.st[0], nx = b.st[1];
        if (nloc == 0u) { xcd_barrier_complete(bar, b.x, nloc, nx); b.st[0] = nloc; b.st[1] = nx; }
        const unsigned old = xb_add(&bar[XB_XSUB(b.x)], 1u);
        const unsigned gen = old / nloc;
        if (old + 1u == (gen + 1u) * nloc) {
            __builtin_amdgcn_fence(__ATOMIC_RELEASE, "agent");
            asm volatile("s_waitcnt vmcnt(0)" ::: "memory");
            const unsigned og = xb_add(&bar[XB_TOP], 1u);
            const unsigned tg = og / nx;
            if (og + 1u == (tg + 1u) * nx) xb_add(&bar[XB_TOPGEN], 1u);
            else XB_SPIN(xb_ld(&bar[XB_TOPGEN]) == tg, bar);
            __builtin_amdgcn_fence(__ATOMIC_ACQUIRE, "agent");
            xb_add(&bar[XB_XGEN(b.x)], 1u);
            asm volatile("s_waitcnt vmcnt(0)" ::: "memory");
        } else {
            XB_SPIN(xb_ld(&bar[XB_XGEN(b.x)]) == gen, bar);
            __builtin_amdgcn_fence(__ATOMIC_ACQUIRE, "agent");
            asm volatile("s_waitcnt vmcnt(0)" ::: "memory");
        }
    }
    __syncthreads();
}

struct Args { const float* in[38]; float* out; unsigned char* ws; int ph_lo, ph_hi, li, pad; };
enum InputId { I_X = 0, I_NORM_MIX, I_W_IN, I_W_OUT, I_RW_MU, I_RW_W0, I_RW_W_UP, I_RW_A0, I_RW_A_UP, I_RW_G_UP, I_RW_K_K, I_RW_K_A, I_RW_R_K,
    I_RW_LN_W, I_RW_LN_B, I_RW_V0, I_RW_V_DOWN, I_RW_V_UP, I_GLA_A_UP, I_GLA_A_BIAS, I_GLA_NORM, I_LRU_CONV_W, I_LRU_CONV_B, I_LRU_W_R,
    I_LRU_B_R, I_LRU_W_I, I_LRU_B_I, I_LRU_LAM, I_GDN_CONV_W, I_GDN_A_LOG, I_GDN_DT_BIAS, I_GDN_NORM, I_NORM_FFN, I_PEER_WQ, I_PEER_SK,
    I_PEER_U, I_PEER_V, I_NORM_FINAL };
enum { PH_P0 = 0, PH_GEMM1 = 1, PH_PREP = 2, PH_AUX = 3, PH_SCAN = 4, PH_POST = 5, PH_GEMM2 = 6, PH_NORM2 = 7, PH_GEMM3 = 8, PH_TOPK = 9, PH_PEER = 10, PH_PER_LAYER = 10, PH_TOTAL = 21 };

struct Frame {
    LAS unsigned char* lds;
    int tid, lane, wave, vcu, G;
    int gw, ngw;
};

__device__ __forceinline__ void p0_transpose_item(const float* W, int K, int N, const float* kscale, bf16_t* WT, LAS float* scr, int item, int nblk, int lane) {
    const int kb = item / nblk, nb = item % nblk, k0 = 64 * kb, n0 = 32 * nb;
    const int nn = n0 + (lane & 31);
#pragma unroll 8
    for (int i = 0; i < 32; ++i) { const int kk = 2 * i + (lane >> 5);
        float v = nn < N ? W[(size_t)(k0 + kk) * N + nn] : 0.f;
        if (kscale) v *= kscale[k0 + kk];
        scr[kk * 33 + (lane & 31)] = v; }
    LDS_WAIT(); asm volatile("" ::: "memory");
    const int c = lane & 7;
#pragma unroll
    for (int j = 0; j < 4; ++j) { const int n = (lane >> 3) + 8 * j; const LAS float* s = scr + (8 * c) * 33 + n;
        v4u o; o.x = pk2(s[0 * 33], s[1 * 33]); o.y = pk2(s[2 * 33], s[3 * 33]); o.z = pk2(s[4 * 33], s[5 * 33]); o.w = pk2(s[6 * 33], s[7 * 33]);
        *(v4u*)(WT + (size_t)(n0 + n) * K + k0 + 8 * c) = o; }
    LDS_WAIT(); asm volatile("" ::: "memory");
}

__device__ __forceinline__ void p0_prologue(const Args& a, Frame& F) {
    const WsMap m = ws_map(NTOK);
    unsigned char* ws = a.ws;
    LAS float* scr = (LAS float*)(F.lds + F.wave * 16384);
    const int gw = F.gw, NGW = F.ngw, lane = F.lane;
    for (int n = gw; n < NTOK; n += NGW) {
        const f32x4* xr = (const f32x4*)(a.in[I_X] + (size_t)n * DM) + lane;
        f32x4 v[8]; float s = 0.f;
#pragma unroll
        for (int j = 0; j < 8; ++j) { v[j] = xr[64 * j]; s += (v[j].x * v[j].x + v[j].y * v[j].y) + (v[j].z * v[j].z + v[j].w * v[j].w); }
        const float rstd = 1.0f / sqrtf(wave_sum(s) * (1.0f / DM) + 1e-6f);
        f32x4* xo = (f32x4*)(a.out + (size_t)n * DM) + lane;
        v2u* o8 = (v2u*)((bf16_t*)(ws + m.xn) + (size_t)n * DM) + lane;
#pragma unroll
        for (int j = 0; j < 8; ++j) { xo[64 * j] = v[j]; v2u w; w.x = pk2(v[j].x * rstd, v[j].y * rstd); w.y = pk2(v[j].z * rstd, v[j].w * rstd); o8[64 * j] = w; }
    }
    {
        constexpr int I1 = (DM / 64) * (PLD / 32), I2 = (DM / 64) * (DM / 32);
        for (int it = gw; it < NL * (I1 + I2); it += NGW) {
            const int l = it / (I1 + I2); int r = it % (I1 + I2);
            if (r < I1) p0_transpose_item(a.in[I_W_IN] + (size_t)l * DM * INC, DM, INC, a.in[I_NORM_MIX] + l * DM, (bf16_t*)(ws + m.w1t) + (size_t)l * PLD * DM, scr, r, PLD / 32, lane);
            else p0_transpose_item(a.in[I_W_OUT] + (size_t)l * DM * DM, DM, DM, nullptr, (bf16_t*)(ws + m.w2t) + (size_t)l * DM * DM, scr, r - I1, DM / 32, lane);
        }
    }
    for (int it = gw; it < NL * 16 * 64; it += NGW) {
        const int l = it / 1024, hp = (it % 1024) / 64, kb = it % 64;
        const int dh = lane & 1, kk = kb * 32 + (lane >> 1);
        const float* wq = a.in[I_PEER_WQ] + (size_t)l * DM * DM + (size_t)kk * DM + hp * 128 + dh * 64;
        const float* sk = a.in[I_PEER_SK] + ((size_t)l * 16 + hp) * 128 * 128 + dh * 64;
        f32x4 q[16];
#pragma unroll
        for (int d = 0; d < 16; ++d) q[d] = *(const f32x4*)(wq + 4 * d);
        bf16_t* o = (bf16_t*)(ws + m.wsct) + (size_t)l * DM * DM + (size_t)(hp * 128) * DM + kk;
        for (int key = 0; key < 128; ++key) {
            const f32x4* s4 = (const f32x4*)(sk + key * 128);
            float acc = 0.f;
#pragma unroll
            for (int d = 0; d < 16; ++d) { const f32x4 sv = s4[d]; acc += (q[d].x * sv.x + q[d].y * sv.y) + (q[d].z * sv.z + q[d].w * sv.w); }
            acc += __shfl_xor(acc, 1);
            if (dh == 0) o[(size_t)key * DM] = f2bf(acc);
        }
    }
    {
        const int gt = F.vcu * NTHR + F.tid, GT = F.G * NTHR;
        bf16_t* AW = (bf16_t*)(ws + m.auxwt); bf16_t* LW = (bf16_t*)(ws + m.lruwt); bf16_t* VW = (bf16_t*)(ws + m.vreswt); float* PP = (float*)(ws + m.pp);
        for (int it = gt; it < NL * 1792 * 384; it += GT) {
            const int l = it / (1792 * 384), r = it % (1792 * 384), n = r / 384, k = r % 384;
            float v = 0.f;
            if (n < 512) { if (k < 64) v = a.in[I_RW_W_UP][(size_t)l * 64 * 512 + k * 512 + n]; }
            else if (n < 1024) { if (k >= 64 && k < 128) v = a.in[I_RW_A_UP][(size_t)l * 64 * 512 + (k - 64) * 512 + (n - 512)]; }
            else if (n < 1536) { if (k >= 128 && k < 256) v = a.in[I_RW_G_UP][(size_t)l * 128 * 512 + (k - 128) * 512 + (n - 1024)]; }
            else { if (k >= 256 && k < 272) v = a.in[I_GLA_A_UP][(size_t)l * 16 * 256 + (k - 256) * 256 + (n - 1536)]; }
            AW[it] = f2bf(v);
        }
        for (int it = gt; it < NL * 1024 * 512; it += GT) {
            const int l = it / (1024 * 512), r = it % (1024 * 512), n = r / 512, k = r % 512;
            const int nn = n & 511, blk = nn >> 6, j = nn & 63;
            float v = 0.f;
            if ((k >> 6) == blk) v = (n < 512 ? a.in[I_LRU_W_R] : a.in[I_LRU_W_I])[(size_t)l * 8 * 64 * 64 + (size_t)blk * 4096 + (k & 63) * 64 + j];
            LW[it] = f2bf(v);
        }
        for (int it = gt; it < 512 * 512; it += GT) {
            const int n = it / 512, k = it % 512;
            float s = 0.f;
            for (int i = 0; i < 32; ++i) s += a.in[I_RW_V_DOWN][k * 32 + i] * a.in[I_RW_V_UP][i * 512 + n];
            VW[it] = f2bf(s);
        }
        for (int it = gt; it < 6144; it += GT) {
            float v = 0.f;
            if (it < 3584) { const int l = it / 1792, c = it % 1792;
                v = c < 512 ? a.in[I_RW_W0][l * 512 + c] : (c < 1024 ? a.in[I_RW_A0][l * 512 + c - 512] : (c < 1536 ? 0.f : a.in[I_GLA_A_BIAS][l * 256 + c - 1536])); }
            else if (it < 5632) { const int l = (it - 3584) / 1024, c = (it - 3584) % 1024; v = c < 512 ? a.in[I_LRU_B_R][l * 512 + c] : a.in[I_LRU_B_I][l * 512 + c - 512]; }
            else v = a.in[I_RW_V0][it - 5632];
            PP[it] = v;
        }
    }
}

__device__ __forceinline__ unsigned pk4_fp8(float a, float b, float c, float d) {
    int w = 0;
    w = __builtin_amdgcn_cvt_pk_fp8_f32(__builtin_fmaxf(__builtin_fminf(a, 448.f), -448.f), __builtin_fmaxf(__builtin_fminf(b, 448.f), -448.f), w, false);
    w = __builtin_amdgcn_cvt_pk_fp8_f32(__builtin_fmaxf(__builtin_fminf(c, 448.f), -448.f), __builtin_fmaxf(__builtin_fminf(d, 448.f), -448.f), w, true);
    return (unsigned)w;
}
__device__ __forceinline__ void tables_phase(const Args& a, Frame& F, int l0, int l1) {
    const WsMap m = ws_map(NTOK);
    const size_t per = (size_t)NEXP * DM / 16;
    for (size_t it = (size_t)l0 * 2 * per + (size_t)F.vcu * NTHR + F.tid; it < (size_t)l1 * 2 * per; it += (size_t)F.G * NTHR) {
        const int tb = (int)(it / per); const size_t r = it % per;
        const float* srcp = ((tb & 1) ? a.in[I_PEER_V] : a.in[I_PEER_U]) + (size_t)(tb >> 1) * NEXP * DM + r * 16;
        const float sc = (tb & 1) ? 64.0f : 1024.0f;
        const f32x4 v0 = __builtin_nontemporal_load((const f32x4*)srcp) * sc, v1 = __builtin_nontemporal_load((const f32x4*)srcp + 1) * sc;
        const f32x4 v2 = __builtin_nontemporal_load((const f32x4*)srcp + 2) * sc, v3 = __builtin_nontemporal_load((const f32x4*)srcp + 3) * sc;
        v4u w; w.x = pk4_fp8(v0.x, v0.y, v0.z, v0.w); w.y = pk4_fp8(v1.x, v1.y, v1.z, v1.w); w.z = pk4_fp8(v2.x, v2.y, v2.z, v2.w); w.w = pk4_fp8(v3.x, v3.y, v3.z, v3.w);
        *(v4u*)((unsigned char*)(a.ws + m.tabu) + (size_t)tb * NEXP * DM + r * 16) = w;
    }
}

template <int CTRL> __device__ __forceinline__ float dpp_f(float v) { return __builtin_bit_cast(float, __builtin_amdgcn_update_dpp(0, __builtin_bit_cast(int, v), CTRL, 0xF, 0xF, true)); }
__device__ __forceinline__ float rdlane_f(float v, int l) { return __builtin_bit_cast(float, __builtin_amdgcn_readlane(__builtin_bit_cast(int, v), l)); }
__device__ __forceinline__ float row16_sum(float v) {
    v += dpp_f<0xB1>(v); v += dpp_f<0x4E>(v); v += dpp_f<0x141>(v); v += dpp_f<0x140>(v); return v;
}
__device__ __forceinline__ float wave_sum_u(float v) {
    v = row16_sum(v);
    return (rdlane_f(v, 0) + rdlane_f(v, 16)) + (rdlane_f(v, 32) + rdlane_f(v, 48));
}
typedef __bf16 bf16x2_t __attribute__((ext_vector_type(2)));
__device__ __forceinline__ float dot2bf(unsigned w, unsigned x, float acc) { return __builtin_amdgcn_fdot2_f32_bf16(__builtin_bit_cast(bf16x2_t, w), __builtin_bit_cast(bf16x2_t, x), acc, false); }
__device__ __forceinline__ float gelu_fast(float x) {
    const float u = 1.5957691216057308f * (x + 0.044715f * x * x * x);
    return x / (1.0f + __expf(-u));
}


__device__ __forceinline__ float sigm(float x) { return 1.0f / (1.0f + __expf(-x)); }
__device__ __forceinline__ float softplus_f(float x) { return log1pf(__expf(-fabsf(x))) + fmaxf(x, 0.0f); }
__device__ __forceinline__ float tanh_f(float x) { return 1.0f - 2.0f / (1.0f + __expf(2.0f * x)); }
__device__ __forceinline__ float red8(float v) { v += dpp_f<0xB1>(v); v += dpp_f<0x4E>(v); v += dpp_f<0x141>(v); return v; }
__device__ __forceinline__ v4u ld8(const bf16_t* p) { return *(const v4u*)p; }
__device__ __forceinline__ void unpack8(const v4u w, float (&f)[8]) { f[0] = bflo(w.x); f[1] = bfhi(w.x); f[2] = bflo(w.y); f[3] = bfhi(w.y); f[4] = bflo(w.z); f[5] = bfhi(w.z); f[6] = bflo(w.w); f[7] = bfhi(w.w); }
__device__ __forceinline__ v4u pack8(const float (&f)[8]) { v4u w; w.x = pk2(f[0], f[1]); w.y = pk2(f[2], f[3]); w.z = pk2(f[4], f[5]); w.w = pk2(f[6], f[7]); return w; }

__device__ __forceinline__ void prep_phase(const Args& a, Frame& F, int l) {
    const WsMap m = ws_map(NTOK);
    const bf16_t* p16 = (const bf16_t*)(a.ws + m.p16);
    bf16_t* zrkv = (bf16_t*)(a.ws + m.zrkv); bf16_t* auxA = (bf16_t*)(a.ws + m.auxA); bf16_t* xc = (bf16_t*)(a.ws + m.xc);
    const float* mu = a.in[I_RW_MU] + l * 1792;
    for (size_t it = (size_t)F.vcu * NTHR + F.tid; it < (size_t)NTOK * 304; it += (size_t)F.G * NTHR) {
        const int n = (int)(it / 304), j = (int)(it % 304), t = n % TSEQ;
        if (j < 224) {
            const int col = j * 8;
            float cur[8], prv[8], z[8];
            unpack8(ld8(p16 + (size_t)n * PLD + col), cur);
            if (t > 0) unpack8(ld8(p16 + (size_t)(n - 1) * PLD + col), prv);
            else {
#pragma unroll
                for (int k = 0; k < 8; ++k) prv[k] = 0.f; }
            const f32x4 m0 = *(const f32x4*)(mu + col), m1 = *(const f32x4*)(mu + col + 4);
            const float mm[8] = {m0.x, m0.y, m0.z, m0.w, m1.x, m1.y, m1.z, m1.w};
#pragma unroll
            for (int k = 0; k < 8; ++k) z[k] = cur[k] + (prv[k] - cur[k]) * mm[k];
            if (col < 1536) *(v4u*)(zrkv + (size_t)n * 1536 + col) = pack8(z);
            else {
                const int c = col - 1536;
#pragma unroll
                for (int k = 0; k < 8; ++k) z[k] = c < 64 ? tanh_f(z[k]) : (c < 128 ? z[k] : sigm(z[k]));
                *(v4u*)(auxA + (size_t)n * 384 + c) = pack8(z);
            }
        } else if (j < 240) {
            const int c = 256 + (j - 224) * 8;
            v4u w = (v4u){0u, 0u, 0u, 0u};
            if (c < 272) w = ld8(p16 + (size_t)n * PLD + C_GLA + 1536 + (c - 256));
            *(v4u*)(auxA + (size_t)n * 384 + c) = w;
        } else {
            const int c = (j - 240) * 8;
            float acc[8];
            { const f32x4 b0 = *(const f32x4*)(a.in[I_LRU_CONV_B] + l * 512 + c), b1 = *(const f32x4*)(a.in[I_LRU_CONV_B] + l * 512 + c + 4);
              acc[0] = b0.x; acc[1] = b0.y; acc[2] = b0.z; acc[3] = b0.w; acc[4] = b1.x; acc[5] = b1.y; acc[6] = b1.z; acc[7] = b1.w; }
#pragma unroll
            for (int jj = 0; jj < 4; ++jj) {
                if (t - 3 + jj >= 0) {
                    float xv[8]; unpack8(ld8(p16 + (size_t)(n - 3 + jj) * PLD + C_LRU + c), xv);
                    const float* cw = a.in[I_LRU_CONV_W] + (size_t)l * 4 * 512 + jj * 512 + c;
                    const f32x4 w0 = *(const f32x4*)cw, w1 = *(const f32x4*)(cw + 4);
                    acc[0] += w0.x * xv[0]; acc[1] += w0.y * xv[1]; acc[2] += w0.z * xv[2]; acc[3] += w0.w * xv[3];
                    acc[4] += w1.x * xv[4]; acc[5] += w1.y * xv[5]; acc[6] += w1.z * xv[6]; acc[7] += w1.w * xv[7];
                }
            }
            *(v4u*)(xc + (size_t)n * 512 + c) = pack8(acc);
        }
    }
    {
        bf16_t* gq = (bf16_t*)(a.ws + m.gq); bf16_t* gk = (bf16_t*)(a.ws + m.gk); bf16_t* gv = (bf16_t*)(a.ws + m.gv); float* gsc = (float*)(a.ws + m.gsc);
        const float* cw = a.in[I_GDN_CONV_W] + (size_t)l * 4 * 1536;
        const int lane = F.lane;
        for (int n = F.gw; n < NTOK; n += F.ngw) {
            const int t = n % TSEQ;
#pragma unroll
            for (int part = 0; part < 3; ++part) {
                const int cb = part * 512 + lane * 8;
                float acc[8];
#pragma unroll
                for (int k = 0; k < 8; ++k) acc[k] = 0.f;
#pragma unroll
                for (int jj = 0; jj < 4; ++jj) {
                    if (t - 3 + jj >= 0) {
                        float xv[8]; unpack8(ld8(p16 + (size_t)(n - 3 + jj) * PLD + C_GDN + cb), xv);
                        const f32x4 w0 = *(const f32x4*)(cw + jj * 1536 + cb), w1 = *(const f32x4*)(cw + jj * 1536 + cb + 4);
                        acc[0] += w0.x * xv[0]; acc[1] += w0.y * xv[1]; acc[2] += w0.z * xv[2]; acc[3] += w0.w * xv[3];
                        acc[4] += w1.x * xv[4]; acc[5] += w1.y * xv[5]; acc[6] += w1.z * xv[6]; acc[7] += w1.w * xv[7];
                    }
                }
                float ss = 0.f;
#pragma unroll
                for (int k = 0; k < 8; ++k) { acc[k] = acc[k] * sigm(acc[k]); ss += acc[k] * acc[k]; }
                if (part < 2) {
                    ss = row16_sum(ss);
                    const float inv = (1.0f / sqrtf(ss + 1e-6f)) * (part == 0 ? 0.08838834764831845f : 1.0f);
#pragma unroll
                    for (int k = 0; k < 8; ++k) acc[k] *= inv;
                }
                *(v4u*)((part == 0 ? gq : (part == 1 ? gk : gv)) + (size_t)n * 512 + lane * 8) = pack8(acc);
            }
            if (lane < 4) {
                gsc[(size_t)n * 8 + lane] = sigm(bf2f(p16[(size_t)n * PLD + C_GDN + 2048 + lane]));
                gsc[(size_t)n * 8 + 4 + lane] = -__expf(a.in[I_GDN_A_LOG][l * 4 + lane]) * softplus_f(bf2f(p16[(size_t)n * PLD + C_GDN + 2052 + lane]) + a.in[I_GDN_DT_BIAS][l * 4 + lane]);
            }
        }
    }
}

__device__ __forceinline__ float swz16(float v) { return __builtin_bit_cast(float, __builtin_amdgcn_ds_swizzle(__builtin_bit_cast(int, v), 0x401F)); }
__device__ __forceinline__ float red32(float v) { v = row16_sum(v); return v + swz16(v); }

__device__ __forceinline__ void rwkv_task(const Args& a, Frame& F, int l, int task) {
    const WsMap m = ws_map(NTOK);
    const int b = task >> 4, h = (task >> 1) & 7, hf = task & 1;
    LAS float* LR = (LAS float*)F.lds; LAS float* LW = LR + 2048; LAS float* LK = LW + 2048; LAS float* LA = LK + 2048; LAS float* LB = LA + 2048;
    LAS float* LV = LB + 2048; LAS float* LY = LV + 1024;
    const int lane = F.lane, w = F.wave, tid = F.tid;
    const int ch = h * 64 + lane;
    const bool mine = (lane >> 5) == hf;
    const float kk_ = a.in[I_RW_K_K][l * 512 + ch], ka_ = a.in[I_RW_K_A][l * 512 + ch], rk_ = a.in[I_RW_R_K][l * 512 + ch];
    const bf16_t* zr = (const bf16_t*)(a.ws + m.zrkv); const bf16_t* ao = (const bf16_t*)(a.ws + m.auxo); const bf16_t* vr = (const bf16_t*)(a.ws + m.vres);
    float* vf = (float*)(a.ws + m.vfirst); bf16_t* yo = (bf16_t*)(a.ws + m.rwy); bf16_t* bvo = (bf16_t*)(a.ws + m.rwbv);
    float S0 = 0.f, S1 = 0.f, S2 = 0.f, S3 = 0.f;
    const int row = tid >> 4, ks = tid & 15;
    float in_[4][7];
    auto load_chunk = [&](int c) {
#pragma unroll
        for (int q = 0; q < 4; ++q) { const size_t n = (size_t)b * TSEQ + c * 32 + w + 8 * q;
            in_[q][0] = bf2f(zr[n * 1536 + ch]); in_[q][1] = bf2f(zr[n * 1536 + 512 + ch]); in_[q][2] = bf2f(zr[n * 1536 + 1024 + ch]);
            in_[q][3] = bf2f(ao[n * 1792 + ch]); in_[q][4] = bf2f(ao[n * 1792 + 512 + ch]);
            if (l > 0) { in_[q][5] = bf2f(vr[n * 512 + ch]); in_[q][6] = vf[n * 512 + ch]; } else { in_[q][5] = 0.f; in_[q][6] = 0.f; } }
    };
    load_chunk(0);
    for (int c = 0; c < TSEQ / 32; ++c) {
#pragma unroll
        for (int q = 0; q < 4; ++q) {
            const int tl = w + 8 * q; const size_t n = (size_t)b * TSEQ + c * 32 + tl;
            const float zr_ = in_[q][0], zk_ = in_[q][1], zv_ = in_[q][2], wp = in_[q][3], ap = in_[q][4];
            float v = zv_;
            if (l == 0) { if (mine) vf[n * 512 + ch] = zv_; } else v = zv_ + (in_[q][6] - zv_) * sigm(in_[q][5]);
            const float w_raw = -softplus_f(-wp) - 0.5f, dec = __expf(-__expf(w_raw));
            const float aa = sigm(ap);
            const float kkraw = zk_ * kk_;
            const float ss = wave_sum_u(kkraw * kkraw);
            const float kk = kkraw * (1.0f / sqrtf(fmaxf(ss, 1e-24f)));
            const float km = zk_ * (1.0f + (aa - 1.0f) * ka_);
            const float bon = wave_sum_u(zr_ * km * rk_);
            LR[tl * 64 + lane] = zr_; LW[tl * 64 + lane] = dec; LK[tl * 64 + lane] = km; LA[tl * 64 + lane] = -kk; LB[tl * 64 + lane] = kk * aa;
            if (mine) { LV[tl * 32 + (lane & 31)] = v; bvo[n * 512 + ch] = f2bf(bon * v); }
        }
        __syncthreads();
        if (c + 1 < TSEQ / 32) load_chunk(c + 1);
        float keep0 = 0.f, keep1 = 0.f;
#pragma unroll 4
        for (int tl = 0; tl < 32; ++tl) {
            const int o = tl * 64 + ks * 4;
            const f32x4 a4 = *(const LAS f32x4*)(LA + o), w4 = *(const LAS f32x4*)(LW + o), b4 = *(const LAS f32x4*)(LB + o), k4 = *(const LAS f32x4*)(LK + o), r4 = *(const LAS f32x4*)(LR + o);
            const float vv = LV[tl * 32 + row];
            const float sa = row16_sum((S0 * a4.x + S1 * a4.y) + (S2 * a4.z + S3 * a4.w));
            S0 = S0 * w4.x + (sa * b4.x + vv * k4.x); S1 = S1 * w4.y + (sa * b4.y + vv * k4.y); S2 = S2 * w4.z + (sa * b4.z + vv * k4.z); S3 = S3 * w4.w + (sa * b4.w + vv * k4.w);
            const float y = row16_sum((S0 * r4.x + S1 * r4.y) + (S2 * r4.z + S3 * r4.w));
            keep0 = (ks == tl) ? y : keep0; keep1 = (ks + 16 == tl) ? y : keep1;
        }
        LY[ks * 32 + row] = keep0; LY[(16 + ks) * 32 + row] = keep1;
        __syncthreads();
        { const int tl = tid >> 4, r2 = (tid & 15) * 2; const size_t n = (size_t)b * TSEQ + c * 32 + tl;
          *(unsigned*)(yo + n * 512 + h * 64 + hf * 32 + r2) = pk2(LY[tl * 32 + r2], LY[tl * 32 + r2 + 1]); }
    }
}


constexpr int RWP = 72;
constexpr int RWT = 64 * RWP;
constexpr size_t RWB_TILES = 4 * RWT * 2;
constexpr size_t RWB_DVEC = RWB_TILES;
constexpr size_t RWB_VS = RWB_DVEC + 256;
constexpr size_t RWB_BYTES = RWB_VS + 4 * 3 * 64 * 16 * 2;

__device__ __forceinline__ f32x4 mm64(const LAS bf16_t* A, const LAS bf16_t* Bt, int mt, int nt, int lane, f32x4 acc) {
    const LAS bf16_t* ap = A + (mt * 16 + (lane & 15)) * RWP + (lane >> 4) * 8;
    const LAS bf16_t* bp = Bt + (nt * 16 + (lane & 15)) * RWP + (lane >> 4) * 8;
#pragma unroll
    for (int k0 = 0; k0 < 64; k0 += 32)
        acc = __builtin_amdgcn_mfma_f32_16x16x32_bf16(*(const LAS bf16x8*)(ap + k0), *(const LAS bf16x8*)(bp + k0), acc, 0, 0, 0);
    return acc;
}
__device__ __forceinline__ void st_rowmajor(LAS bf16_t* T, int mt, int nt, int lane, const f32x4 v) {
    const int n = nt * 16 + (lane & 15), i0 = mt * 16 + (lane >> 4) * 4;
    T[(i0 + 0) * RWP + n] = f2bf(v.x); T[(i0 + 1) * RWP + n] = f2bf(v.y); T[(i0 + 2) * RWP + n] = f2bf(v.z); T[(i0 + 3) * RWP + n] = f2bf(v.w);
}
__device__ __forceinline__ void st_transposed(LAS bf16_t* T, int mt, int nt, int lane, const f32x4 v) {
    const int n = nt * 16 + (lane & 15), i0 = mt * 16 + (lane >> 4) * 4;
    *(LAS v2u*)(T + n * RWP + i0) = (v2u){pk2(v.x, v.y), pk2(v.z, v.w)};
}

__device__ __forceinline__ void rwkv_pa_chunk(const Args& a, Frame& F, int l, int ci) {
    const WsMap m = ws_map(NTOK);
    const int bh = ci >> 6, c = ci & 63, b = bh >> 3, h = bh & 7;
    const int lane = F.lane, w = F.wave, tid = F.tid;
    const int ch = h * 64 + lane;
    LAS bf16_t* At = (LAS bf16_t*)F.lds; LAS bf16_t* AtT = At + RWT; LAS bf16_t* Bt = AtT + RWT; LAS bf16_t* Kt = Bt + RWT; LAS bf16_t* KtGT = Kt + RWT;
    LAS bf16_t* Rt = KtGT + RWT; LAS bf16_t* VmT = Rt + RWT; LAS bf16_t* LAK = VmT + RWT;
    LAS bf16_t* X0 = LAK + RWT; LAS bf16_t* XT0 = X0 + RWT; LAS bf16_t* T0 = XT0 + RWT; LAS bf16_t* X1 = T0 + RWT; LAS bf16_t* XT1 = X1 + RWT; LAS bf16_t* T1 = XT1 + RWT;
    LAS float* LWL = (LAS float*)X0;
    LAS bf16_t* A2 = X1;
    LAS bf16_t* LVT = XT1;
    const bf16_t* zr = (const bf16_t*)(a.ws + m.zrkv); const bf16_t* ao = (const bf16_t*)(a.ws + m.auxo); const bf16_t* vr = (const bf16_t*)(a.ws + m.vres);
    float* vf = (float*)(a.ws + m.vfirst); bf16_t* bvo = (bf16_t*)(a.ws + m.rwbv);
    unsigned char* blob = a.ws + m.xn + (size_t)ci * RWB_BYTES;
    bf16_t* gW = (bf16_t*)blob; bf16_t* gQG = gW + RWT; bf16_t* gKGT = gQG + RWT; bf16_t* gA1 = gKGT + RWT;
    float* gDV = (float*)(blob + RWB_DVEC); bf16_t* gVS = (bf16_t*)(blob + RWB_VS);
    const int j = tid >> 3, c8 = (tid & 7) * 8, chb = h * 64 + c8;
    const size_t n = (size_t)b * TSEQ + c * 64 + j;
    float zr_[8], zk_[8], zv_[8], wp[8], ap[8];
    unpack8(ld8(zr + n * 1536 + chb), zr_); unpack8(ld8(zr + n * 1536 + 512 + chb), zk_); unpack8(ld8(zr + n * 1536 + 1024 + chb), zv_);
    unpack8(ld8(ao + n * 1792 + chb), wp); unpack8(ld8(ao + n * 1792 + 512 + chb), ap);
    float vres8[8], vf8[8];
    if (l > 0) { unpack8(ld8(vr + n * 512 + chb), vres8); const f32x4 f0 = *(const f32x4*)(vf + n * 512 + chb), f1 = *(const f32x4*)(vf + n * 512 + chb + 4);
        vf8[0] = f0.x; vf8[1] = f0.y; vf8[2] = f0.z; vf8[3] = f0.w; vf8[4] = f1.x; vf8[5] = f1.y; vf8[6] = f1.z; vf8[7] = f1.w; }
    float lw[8];
#pragma unroll
    for (int k = 0; k < 8; ++k) lw[k] = -__expf(-softplus_f(-wp[k]) - 0.5f);
    *(LAS f32x4*)(LWL + j * 64 + c8) = (f32x4){lw[0], lw[1], lw[2], lw[3]}; *(LAS f32x4*)(LWL + j * 64 + c8 + 4) = (f32x4){lw[4], lw[5], lw[6], lw[7]};
    __syncthreads();
    if (tid < 64) { float s = 0.f;
#pragma unroll 8
        for (int jj = 0; jj < 64; ++jj) { s += LWL[jj * 64 + tid]; LWL[jj * 64 + tid] = s; } }
    __syncthreads();
    {
        float pk_[8], pa_[8], pr_[8];
        { const float* p0 = a.in[I_RW_K_K] + l * 512 + chb; const float* p1 = a.in[I_RW_K_A] + l * 512 + chb; const float* p2 = a.in[I_RW_R_K] + l * 512 + chb;
          const f32x4 a0 = *(const f32x4*)p0, a1 = *(const f32x4*)(p0 + 4), b0 = *(const f32x4*)p1, b1 = *(const f32x4*)(p1 + 4), c0 = *(const f32x4*)p2, c1 = *(const f32x4*)(p2 + 4);
          pk_[0] = a0.x; pk_[1] = a0.y; pk_[2] = a0.z; pk_[3] = a0.w; pk_[4] = a1.x; pk_[5] = a1.y; pk_[6] = a1.z; pk_[7] = a1.w;
          pa_[0] = b0.x; pa_[1] = b0.y; pa_[2] = b0.z; pa_[3] = b0.w; pa_[4] = b1.x; pa_[5] = b1.y; pa_[6] = b1.z; pa_[7] = b1.w;
          pr_[0] = c0.x; pr_[1] = c0.y; pr_[2] = c0.z; pr_[3] = c0.w; pr_[4] = c1.x; pr_[5] = c1.y; pr_[6] = c1.z; pr_[7] = c1.w; }
        float v[8], aa[8], kk[8], km[8];
        float ss = 0.f, bs = 0.f;
#pragma unroll
        for (int k = 0; k < 8; ++k) {
            v[k] = (l == 0) ? zv_[k] : zv_[k] + (vf8[k] - zv_[k]) * sigm(vres8[k]);
            aa[k] = sigm(ap[k]);
            kk[k] = zk_[k] * pk_[k]; ss += kk[k] * kk[k];
            km[k] = zk_[k] * (1.0f + (aa[k] - 1.0f) * pa_[k]); bs += zr_[k] * km[k] * pr_[k];
        }
        if (l == 0) { *(f32x4*)(vf + n * 512 + chb) = (f32x4){zv_[0], zv_[1], zv_[2], zv_[3]}; *(f32x4*)(vf + n * 512 + chb + 4) = (f32x4){zv_[4], zv_[5], zv_[6], zv_[7]}; }
        ss = red8(ss); bs = red8(bs);
        const float kinv = 1.0f / sqrtf(fmaxf(ss, 1e-24f));
        float cs[8], cm[8], gcv[8];
        { const f32x4 x0 = *(const LAS f32x4*)(LWL + j * 64 + c8), x1 = *(const LAS f32x4*)(LWL + j * 64 + c8 + 4);
          cs[0] = x0.x; cs[1] = x0.y; cs[2] = x0.z; cs[3] = x0.w; cs[4] = x1.x; cs[5] = x1.y; cs[6] = x1.z; cs[7] = x1.w;
          const f32x4 g0 = *(const LAS f32x4*)(LWL + 63 * 64 + c8), g1 = *(const LAS f32x4*)(LWL + 63 * 64 + c8 + 4);
          gcv[0] = g0.x; gcv[1] = g0.y; gcv[2] = g0.z; gcv[3] = g0.w; gcv[4] = g1.x; gcv[5] = g1.y; gcv[6] = g1.z; gcv[7] = g1.w; }
#pragma unroll
        for (int k = 0; k < 8; ++k) cm[k] = cs[k] - lw[k];
        float t_at[8], t_bt[8], t_kt[8], t_rt[8], t_bv[8];
        LAS bf16_t* KGTl = T1;
#pragma unroll
        for (int k = 0; k < 8; ++k) {
            const float G = __expf(cs[k]), Gm1 = __expf(cm[k]), iG = __expf(-cs[k]), GcG = __expf(gcv[k] - cs[k]);
            const float kkn = kk[k] * kinv;
            const float av = -kkn, bv = kkn * aa[k];
            t_at[k] = av * Gm1; t_bt[k] = bv * iG; t_kt[k] = km[k] * iG; t_rt[k] = zr_[k] * G; t_bv[k] = bs * v[k];
            AtT[(c8 + k) * RWP + j] = f2bf(t_at[k]);
            KtGT[(c8 + k) * RWP + j] = f2bf(km[k] * GcG);
            VmT[(c8 + k) * RWP + j] = f2bf(v[k]);
            KGTl[(c8 + k) * RWP + j] = f2bf(bv * GcG);
        }
        *(LAS v4u*)(At + j * RWP + c8) = pack8(t_at); *(LAS v4u*)(Bt + j * RWP + c8) = pack8(t_bt); *(LAS v4u*)(Kt + j * RWP + c8) = pack8(t_kt);
        const v4u rt8 = pack8(t_rt);
        *(LAS v4u*)(Rt + j * RWP + c8) = rt8; *(v4u*)(gQG + j * RWP + c8) = rt8;
        *(v4u*)(bvo + n * 512 + chb) = pack8(t_bv);
        if (j == 63) { *(f32x4*)(gDV + c8) = (f32x4){__expf(gcv[0]), __expf(gcv[1]), __expf(gcv[2]), __expf(gcv[3])}; *(f32x4*)(gDV + c8 + 4) = (f32x4){__expf(gcv[4]), __expf(gcv[5]), __expf(gcv[6]), __expf(gcv[7])}; }
    }
    __syncthreads();
    {
        for (int o = tid; o < RWT / 8; o += NTHR) ((v4u*)gKGT)[o] = ((const LAS v4u*)T1)[o];
        f32x4 z4 = {0.f, 0.f, 0.f, 0.f};
#pragma unroll 1
        for (int tt = 0; tt < 2; ++tt) {
            const int t = w + 8 * tt, mt = t >> 2, nt = t & 3;
            const int n = nt * 16 + (lane & 15), i0 = mt * 16 + (lane >> 4) * 4;
            f32x4 lab = mm64(At, Bt, mt, nt, lane, z4), lak = mm64(At, Kt, mt, nt, lane, z4), a1 = mm64(Rt, Bt, mt, nt, lane, z4), a2 = mm64(Rt, Kt, mt, nt, lane, z4);
            f32x4 tt0;
#pragma unroll
            for (int e = 0; e < 4; ++e) { const int i = i0 + e;
                if (n >= i) { lab[e] = 0.f; lak[e] = 0.f; }
                if (n > i) { a1[e] = 0.f; a2[e] = 0.f; }
                tt0[e] = lab[e] + (n == i ? 1.0f : 0.f); }
            st_rowmajor(X0, mt, nt, lane, lab); st_transposed(XT0, mt, nt, lane, lab);
            st_rowmajor(T0, mt, nt, lane, tt0);
            st_rowmajor(LAK, mt, nt, lane, lak);
            st_rowmajor(A2, mt, nt, lane, a2);
            gA1[(i0 + 0) * RWP + n] = f2bf(a1.x); gA1[(i0 + 1) * RWP + n] = f2bf(a1.y); gA1[(i0 + 2) * RWP + n] = f2bf(a1.z); gA1[(i0 + 3) * RWP + n] = f2bf(a1.w);
        }
    }
    __syncthreads();
    {
        f32x4 z4 = {0.f, 0.f, 0.f, 0.f};
#pragma unroll 1
        for (int tt = 0; tt < 2; ++tt) {
            const int t = w + 8 * tt, mt = t >> 2, nt = t & 3;
            const int n = nt * 16 + (lane & 15), i0 = mt * 16 + (lane >> 4) * 4;
            const f32x4 lv = mm64(LAK, VmT, mt, nt, lane, z4), o0 = mm64(A2, VmT, mt, nt, lane, z4), kv0 = mm64(KtGT, VmT, mt, nt, lane, z4);
            st_transposed((LAS bf16_t*)(F.lds + 131584), mt, nt, lane, lv);
            bf16_t* go = gVS + (size_t)nt * 3 * 1024 + 1024;
            const int r = lane & 15;
            go[(i0 + 0) * 16 + r] = f2bf(o0.x); go[(i0 + 1) * 16 + r] = f2bf(o0.y); go[(i0 + 2) * 16 + r] = f2bf(o0.z); go[(i0 + 3) * 16 + r] = f2bf(o0.w);
            go[1024 + (i0 + 0) * 16 + r] = f2bf(kv0.x); go[1024 + (i0 + 1) * 16 + r] = f2bf(kv0.y); go[1024 + (i0 + 2) * 16 + r] = f2bf(kv0.z); go[1024 + (i0 + 3) * 16 + r] = f2bf(kv0.w);
            (void)n;
        }
    }
    __syncthreads();
    {
        LAS bf16_t* Xc = X0; LAS bf16_t* XTc = XT0; LAS bf16_t* Tc = T0; LAS bf16_t* Xn = X1; LAS bf16_t* XTn = XT1; LAS bf16_t* Tn = T1;
        f32x4 z4 = {0.f, 0.f, 0.f, 0.f};
#pragma unroll 1
        for (int it = 0; it < 5; ++it) {
#pragma unroll 1
            for (int tt = 0; tt < 2; ++tt) { const int t = w + 8 * tt, mt = t >> 2, nt = t & 3;
                const f32x4 x2 = mm64(Xc, XTc, mt, nt, lane, z4);
                st_rowmajor(Xn, mt, nt, lane, x2); st_transposed(XTn, mt, nt, lane, x2); }
            __syncthreads();
#pragma unroll 1
            for (int tt = 0; tt < 2; ++tt) { const int t = w + 8 * tt, mt = t >> 2, nt = t & 3;
                const int n = nt * 16 + (lane & 15), i0 = mt * 16 + (lane >> 4) * 4;
                f32x4 tc; tc.x = bf2f(Tc[(i0 + 0) * RWP + n]); tc.y = bf2f(Tc[(i0 + 1) * RWP + n]); tc.z = bf2f(Tc[(i0 + 2) * RWP + n]); tc.w = bf2f(Tc[(i0 + 3) * RWP + n]);
                const f32x4 tn = mm64(Tc, XTn, mt, nt, lane, tc);
                st_rowmajor(Tn, mt, nt, lane, tn); }
            __syncthreads();
            LAS bf16_t* s0 = Xc; Xc = Xn; Xn = s0; s0 = XTc; XTc = XTn; XTn = s0; s0 = Tc; Tc = Tn; Tn = s0;
        }
        LAS bf16_t* LVTp = (LAS bf16_t*)(F.lds + 131584);
#pragma unroll 1
        for (int tt = 0; tt < 2; ++tt) { const int t = w + 8 * tt, mt = t >> 2, nt = t & 3;
            const int n = nt * 16 + (lane & 15), i0 = mt * 16 + (lane >> 4) * 4, r = lane & 15;
            const f32x4 wt = mm64(Tc, AtT, mt, nt, lane, z4), u0 = mm64(Tc, LVTp, mt, nt, lane, z4);
            gW[(i0 + 0) * RWP + n] = f2bf(wt.x); gW[(i0 + 1) * RWP + n] = f2bf(wt.y); gW[(i0 + 2) * RWP + n] = f2bf(wt.z); gW[(i0 + 3) * RWP + n] = f2bf(wt.w);
            bf16_t* gu = gVS + (size_t)nt * 3 * 1024;
            gu[(i0 + 0) * 16 + r] = f2bf(u0.x); gu[(i0 + 1) * 16 + r] = f2bf(u0.y); gu[(i0 + 2) * 16 + r] = f2bf(u0.z); gu[(i0 + 3) * 16 + r] = f2bf(u0.w); }
    }
    __syncthreads();
    (void)LVT;
}

__device__ __forceinline__ void rwkv_ps_task(const Args& a, Frame& F, int task) {
    const WsMap m = ws_map(NTOK);
    const int bh = task >> 2, vs = task & 3, b = bh >> 3, h = bh & 7;
    const int lane = F.lane, w = F.wave, tid = F.tid;
    LAS bf16_t* LB = (LAS bf16_t*)F.lds;
    LAS bf16_t* ST = LB + 4 * RWT; LAS bf16_t* VNT = ST + 16 * RWP;
    bf16_t* yo = (bf16_t*)(a.ws + m.rwy);
    const unsigned char* blob0 = a.ws + m.xn + (size_t)(bh * 64) * RWB_BYTES;
    const int r = lane & 15, i0w = (w & 3) * 16 + (lane >> 4) * 4;
    f32x4 Sacc = {0.f, 0.f, 0.f, 0.f};
    for (int i = tid; i < 16 * RWP / 2; i += NTHR) ((LAS unsigned*)ST)[i] = 0u;
    v4u pre[5];
    auto prefetch = [&](int c) {
        const v4u* g = (const v4u*)(blob0 + (size_t)c * RWB_BYTES);
#pragma unroll
        for (int k = 0; k < 5; ++k) { const int o = k * 512 + tid; pre[k] = (o < (int)(RWB_TILES / 16)) ? g[o] : (v4u){0u, 0u, 0u, 0u}; }
    };
    auto commit = [&]() {
#pragma unroll
        for (int k = 0; k < 5; ++k) { const int o = k * 512 + tid; if (o < (int)(RWB_TILES / 16)) ((LAS v4u*)LB)[o] = pre[k]; }
    };
    prefetch(0); commit(); prefetch(1);
    for (int c = 0; c < 64; ++c) {
        const unsigned char* blob = blob0 + (size_t)c * RWB_BYTES;
        const bf16_t* gvs = (const bf16_t*)(blob + RWB_VS) + (size_t)vs * 3 * 1024;
        float fr[4]; float dv[4] = {1.f, 1.f, 1.f, 1.f}, kv0[4] = {0.f, 0.f, 0.f, 0.f};
        { const bf16_t* src = gvs + (w < 4 ? 0 : 1024);
#pragma unroll
          for (int e = 0; e < 4; ++e) fr[e] = bf2f(src[(i0w + e) * 16 + r]); }
        if (w < 4) { const float* gd = (const float*)(blob + RWB_DVEC);
#pragma unroll
          for (int e = 0; e < 4; ++e) { dv[e] = gd[i0w + e]; kv0[e] = bf2f(gvs[2048 + (i0w + e) * 16 + r]); } }
        __syncthreads();
        if (w < 4) {
            f32x4 vn = mm64(LB, ST, w, 0, lane, (f32x4){fr[0], fr[1], fr[2], fr[3]});
            st_transposed(VNT, w, 0, lane, vn);
        }
        __syncthreads();
        if (w < 4) {
            const f32x4 base = {dv[0] * Sacc.x + kv0[0], dv[1] * Sacc.y + kv0[1], dv[2] * Sacc.z + kv0[2], dv[3] * Sacc.w + kv0[3]};
            Sacc = mm64(LB + 2 * RWT, VNT, w, 0, lane, base);
        } else {
            f32x4 o = mm64(LB + RWT, ST, w - 4, 0, lane, (f32x4){fr[0], fr[1], fr[2], fr[3]});
            o = mm64(LB + 3 * RWT, VNT, w - 4, 0, lane, o);
            const size_t n = (size_t)b * TSEQ + c * 64 + i0w;
            bf16_t* yp = yo + n * 512 + h * 64 + vs * 16 + r;
            yp[0] = f2bf(o.x); yp[512] = f2bf(o.y); yp[1024] = f2bf(o.z); yp[1536] = f2bf(o.w);
        }
        __syncthreads();
        if (w < 4) st_transposed(ST, w, 0, lane, Sacc);
        if (c + 1 < 64) commit();
        if (c + 2 < 64) prefetch(c + 2);
    }
    __syncthreads();
}

constexpr int GP = 136;
constexpr size_t GB_BYTES = 18688;
template <int KD, int PA_, int PB_>
__device__ __forceinline__ f32x4 mmx(const LAS bf16_t* A, const LAS bf16_t* Bt, int mt, int nt, int lane, f32x4 acc) {
    const LAS bf16_t* ap = A + (mt * 16 + (lane & 15)) * PA_ + (lane >> 4) * 8;
    const LAS bf16_t* bp = Bt + (nt * 16 + (lane & 15)) * PB_ + (lane >> 4) * 8;
#pragma unroll
    for (int k0 = 0; k0 < KD; k0 += 32)
        acc = __builtin_amdgcn_mfma_f32_16x16x32_bf16(*(const LAS bf16x8*)(ap + k0), *(const LAS bf16x8*)(bp + k0), acc, 0, 0, 0);
    return acc;
}
__device__ __forceinline__ void gdn_pa_chunk(const Args& a, Frame& F, int ci) {
    const WsMap m = ws_map(NTOK);
    const int bh = ci >> 6, c = ci & 63, b = bh >> 2, h = bh & 3;
    const int lane = F.lane, w = F.wave, tid = F.tid;
    LAS bf16_t* KB = (LAS bf16_t*)F.lds; LAS bf16_t* KH = KB + 64 * GP; LAS bf16_t* QH = KH + 64 * GP;
    LAS bf16_t* X0 = QH + 64 * GP; LAS bf16_t* XT0 = X0 + RWT; LAS bf16_t* T0 = XT0 + RWT; LAS bf16_t* X1 = T0 + RWT; LAS bf16_t* XT1 = X1 + RWT; LAS bf16_t* T1 = XT1 + RWT;
    LAS float* GC = (LAS float*)(T1 + RWT);
    const bf16_t* gq = (const bf16_t*)(a.ws + m.gq); const bf16_t* gk = (const bf16_t*)(a.ws + m.gk); const float* gsc = (const float*)(a.ws + m.gsc);
    unsigned char* blob = a.ws + m.gblob + (size_t)ci * GB_BYTES;
    bf16_t* gT = (bf16_t*)blob; bf16_t* gA1 = gT + RWT; float* gGC = (float*)(blob + 2 * RWT * 2);
    const int j = tid >> 3, c16 = (tid & 7) * 16;
    const size_t n = (size_t)b * TSEQ + c * 64 + j;
    {
        const float be = gsc[n * 8 + h];
        float kf[8];
#pragma unroll
        for (int hh = 0; hh < 2; ++hh) {
            const v4u kw = ld8(gk + n * 512 + h * 128 + c16 + hh * 8), qw = ld8(gq + n * 512 + h * 128 + c16 + hh * 8);
            *(LAS v4u*)(KH + j * GP + c16 + hh * 8) = kw; *(LAS v4u*)(QH + j * GP + c16 + hh * 8) = qw;
            unpack8(kw, kf);
#pragma unroll
            for (int k = 0; k < 8; ++k) kf[k] *= be;
            *(LAS v4u*)(KB + j * GP + c16 + hh * 8) = pack8(kf);
        }
        if (w == 0) {
            float g = gsc[((size_t)b * TSEQ + c * 64 + lane) * 8 + 4 + h];
#pragma unroll
            for (int o = 1; o < 64; o <<= 1) { const float t = __shfl_up(g, o); if (lane >= o) g += t; }
            GC[lane] = g; gGC[lane] = g;
        }
    }
    __syncthreads();
    {
        const f32x4 z4 = {0.f, 0.f, 0.f, 0.f};
#pragma unroll 1
        for (int tt = 0; tt < 2; ++tt) {
            const int t = w + 8 * tt, mt = t >> 2, nt = t & 3;
            const int nn = nt * 16 + (lane & 15), i0 = mt * 16 + (lane >> 4) * 4;
            f32x4 kk = mmx<128, GP, GP>(KB, KH, mt, nt, lane, z4), qk = mmx<128, GP, GP>(QH, KH, mt, nt, lane, z4);
            const float gj = GC[nn];
            f32x4 x, t0;
#pragma unroll
            for (int e = 0; e < 4; ++e) { const int i = i0 + e; const float d = __expf(fminf(GC[i] - gj, 0.f));
                x[e] = (nn < i) ? -kk[e] * d : 0.f; qk[e] = (nn <= i) ? qk[e] * d : 0.f; t0[e] = x[e] + (nn == i ? 1.0f : 0.f); }
            st_rowmajor(X0, mt, nt, lane, x); st_transposed(XT0, mt, nt, lane, x); st_rowmajor(T0, mt, nt, lane, t0);
            gA1[(i0 + 0) * RWP + nn] = f2bf(qk.x); gA1[(i0 + 1) * RWP + nn] = f2bf(qk.y); gA1[(i0 + 2) * RWP + nn] = f2bf(qk.z); gA1[(i0 + 3) * RWP + nn] = f2bf(qk.w);
        }
    }
    __syncthreads();
    {
        LAS bf16_t* Xc = X0; LAS bf16_t* XTc = XT0; LAS bf16_t* Tc = T0; LAS bf16_t* Xn = X1; LAS bf16_t* XTn = XT1; LAS bf16_t* Tn = T1;
        const f32x4 z4 = {0.f, 0.f, 0.f, 0.f};
#pragma unroll 1
        for (int it = 0; it < 5; ++it) {
#pragma unroll 1
            for (int tt = 0; tt < 2; ++tt) { const int t = w + 8 * tt, mt = t >> 2, nt = t & 3;
                const f32x4 x2 = mm64(Xc, XTc, mt, nt, lane, z4);
                st_rowmajor(Xn, mt, nt, lane, x2); st_transposed(XTn, mt, nt, lane, x2); }
            __syncthreads();
#pragma unroll 1
            for (int tt = 0; tt < 2; ++tt) { const int t = w + 8 * tt, mt = t >> 2, nt = t & 3;
                const int nn = nt * 16 + (lane & 15), i0 = mt * 16 + (lane >> 4) * 4;
                f32x4 tc; tc.x = bf2f(Tc[(i0 + 0) * RWP + nn]); tc.y = bf2f(Tc[(i0 + 1) * RWP + nn]); tc.z = bf2f(Tc[(i0 + 2) * RWP + nn]); tc.w = bf2f(Tc[(i0 + 3) * RWP + nn]);
                const f32x4 tn = mm64(Tc, XTn, mt, nt, lane, tc);
                st_rowmajor(Tn, mt, nt, lane, tn); }
            __syncthreads();
            LAS bf16_t* s0 = Xc; Xc = Xn; Xn = s0; s0 = XTc; XTc = XTn; XTn = s0; s0 = Tc; Tc = Tn; Tn = s0;
        }
        for (int o = tid; o < RWT / 8; o += NTHR) ((v4u*)gT)[o] = ((const LAS v4u*)Tc)[o];
    }
    __syncthreads();
}

__device__ __forceinline__ void gdn_ps_task(const Args& a, Frame& F, int task) {
    const WsMap m = ws_map(NTOK);
    const int bh = task >> 3, vs = task & 7, b = bh >> 2, h = bh & 3;
    const int lane = F.lane, w = F.wave, tid = F.tid;
    LAS bf16_t* KBE = (LAS bf16_t*)F.lds; LAS bf16_t* QG = KBE + 64 * GP; LAS bf16_t* KGT = QG + 64 * GP;
    LAS bf16_t* TT = KGT + 128 * RWP; LAS bf16_t* A1 = TT + RWT; LAS bf16_t* ST = A1 + RWT;
    LAS bf16_t* R2T = ST + 16 * GP; LAS bf16_t* VNT = R2T + 16 * RWP; LAS float* VB = (LAS float*)(VNT + 16 * RWP); LAS float* GC = VB + 64 * 16;
    const bf16_t* gq = (const bf16_t*)(a.ws + m.gq); const bf16_t* gk = (const bf16_t*)(a.ws + m.gk); const bf16_t* gv = (const bf16_t*)(a.ws + m.gv);
    const float* gsc = (const float*)(a.ws + m.gsc); bf16_t* go = (bf16_t*)(a.ws + m.gdno);
    const unsigned char* blob0 = a.ws + m.gblob + (size_t)(bh * 64) * GB_BYTES;
    const int j = tid >> 3, c16 = (tid & 7) * 16, r = lane & 15, kq4 = (lane >> 4) * 4;
    f32x4 Sacc = {0.f, 0.f, 0.f, 0.f};
    for (int i = tid; i < 16 * GP / 2; i += NTHR) ((LAS unsigned*)ST)[i] = 0u;
    v4u pk_[2], pq_[2], pt_[3]; v4u pv_; float pbe = 0.f;
    auto prefetch = [&](int c) {
        const size_t n = (size_t)b * TSEQ + c * 64 + j;
#pragma unroll
        for (int hh = 0; hh < 2; ++hh) { pk_[hh] = ld8(gk + n * 512 + h * 128 + c16 + hh * 8); pq_[hh] = ld8(gq + n * 512 + h * 128 + c16 + hh * 8); }
        pbe = gsc[n * 8 + h];
        const v4u* g = (const v4u*)(blob0 + (size_t)c * GB_BYTES);
#pragma unroll
        for (int k = 0; k < 3; ++k) { const int o = k * 512 + tid; pt_[k] = (o < (int)(GB_BYTES / 16)) ? g[o] : (v4u){0u, 0u, 0u, 0u}; }
        if (tid < 128) pv_ = ld8(gv + ((size_t)b * TSEQ + c * 64 + (tid >> 1)) * 512 + h * 128 + vs * 16 + (tid & 1) * 8);
    };
    prefetch(0);
    for (int c = 0; c < 64; ++c) {
#pragma unroll
        for (int k = 0; k < 3; ++k) { const int o = k * 512 + tid;
            if (o < 2 * RWT / 8) ((LAS v4u*)TT)[o] = pt_[k];
            else if (o < (int)(GB_BYTES / 16)) ((LAS v4u*)GC)[o - 2 * RWT / 8] = pt_[k]; }
        const v4u kw0 = pk_[0], kw1 = pk_[1], qw0 = pq_[0], qw1 = pq_[1]; const float be = pbe; const v4u vw = pv_;
        __syncthreads();
        if (c + 1 < 64) prefetch(c + 1);
        {
            const float gj = GC[j], g63 = GC[63];
            const float eg = __expf(gj), s_kbe = be * eg, s_kg = __expf(g63 - gj);
            float f[8], o8[8];
#pragma unroll
            for (int hh = 0; hh < 2; ++hh) {
                unpack8(hh ? kw1 : kw0, f);
#pragma unroll
                for (int k = 0; k < 8; ++k) { o8[k] = f[k] * s_kbe; KGT[(c16 + hh * 8 + k) * RWP + j] = f2bf(f[k] * s_kg); }
                *(LAS v4u*)(KBE + j * GP + c16 + hh * 8) = pack8(o8);
                unpack8(hh ? qw1 : qw0, f);
#pragma unroll
                for (int k = 0; k < 8; ++k) o8[k] = f[k] * eg;
                *(LAS v4u*)(QG + j * GP + c16 + hh * 8) = pack8(o8);
            }
            if (tid < 128) { const int jv = tid >> 1, cv = (tid & 1) * 8; const float bev = gsc[((size_t)b * TSEQ + c * 64 + jv) * 8 + h];
                unpack8(vw, f);
                *(LAS f32x4*)(VB + jv * 16 + cv) = (f32x4){f[0] * bev, f[1] * bev, f[2] * bev, f[3] * bev}; *(LAS f32x4*)(VB + jv * 16 + cv + 4) = (f32x4){f[4] * bev, f[5] * bev, f[6] * bev, f[7] * bev}; }
        }
        const float glast = __expf(GC[63]);
        __syncthreads();
        if (w < 4) {
            const int i0 = w * 16 + kq4;
            f32x4 r1 = mmx<128, GP, GP>(KBE, ST, w, 0, lane, (f32x4){0.f, 0.f, 0.f, 0.f});
            r1.x = VB[(i0 + 0) * 16 + r] - r1.x; r1.y = VB[(i0 + 1) * 16 + r] - r1.y; r1.z = VB[(i0 + 2) * 16 + r] - r1.z; r1.w = VB[(i0 + 3) * 16 + r] - r1.w;
            st_transposed(R2T, w, 0, lane, r1);
        }
        __syncthreads();
        if (w < 4) { const f32x4 vn = mm64(TT, R2T, w, 0, lane, (f32x4){0.f, 0.f, 0.f, 0.f}); st_transposed(VNT, w, 0, lane, vn); }
        __syncthreads();
        {
            const f32x4 base = {Sacc.x * glast, Sacc.y * glast, Sacc.z * glast, Sacc.w * glast};
            Sacc = mm64(KGT, VNT, w, 0, lane, base);
            if (w < 4) {
                f32x4 o = mmx<128, GP, GP>(QG, ST, w, 0, lane, (f32x4){0.f, 0.f, 0.f, 0.f});
                o = mm64(A1, VNT, w, 0, lane, o);
                const size_t n = (size_t)b * TSEQ + c * 64 + w * 16 + kq4;
                bf16_t* op = go + n * 512 + h * 128 + vs * 16 + r;
                op[0] = f2bf(o.x); op[512] = f2bf(o.y); op[1024] = f2bf(o.z); op[1536] = f2bf(o.w);
            }
        }
        __syncthreads();
        { const int k0 = w * 16 + kq4;
          *(LAS v2u*)(ST + r * GP + k0) = (v2u){pk2(Sacc.x, Sacc.y), pk2(Sacc.z, Sacc.w)}; }
    }
    __syncthreads();
}

__device__ __forceinline__ void gla_task(const Args& a, Frame& F, int l, int task) {
    const WsMap m = ws_map(NTOK);
    const int b = task >> 4, h = (task >> 2) & 3, qt = task & 3;
    const int lane = F.lane, w = F.wave, tid = F.tid;
    LAS bf16_t* QS = (LAS bf16_t*)F.lds; LAS bf16_t* KS = QS + RWT; LAS bf16_t* QG = KS + RWT; LAS bf16_t* KS2T = QG + RWT; LAS bf16_t* PM = KS2T + RWT;
    LAS bf16_t* VT = PM + RWT; LAS bf16_t* ST = VT + 32 * RWP; LAS float* LWL = (LAS float*)(ST + 32 * RWP);
    const bf16_t* p16 = (const bf16_t*)(a.ws + m.p16); const bf16_t* ao = (const bf16_t*)(a.ws + m.auxo);
    bf16_t* go = (bf16_t*)(a.ws + m.glao);
    const int j = tid >> 3, c8 = (tid & 7) * 8, v4 = (tid & 7) * 4;
    const int mtS = w >> 2, ntS = w & 3;
    const int mtO = w >> 1, ntO = w & 1;
    f32x4 Sacc = {0.f, 0.f, 0.f, 0.f};
    for (int i = tid; i < 32 * RWP / 2; i += NTHR) ((LAS unsigned*)ST)[i] = 0u;
    v4u nq, nk, npre; v2u nv;
    auto load_chunk = [&](int c) {
        const size_t n = (size_t)b * TSEQ + c * 64 + j;
        nq = ld8(p16 + n * PLD + C_GLA + h * 64 + c8); nk = ld8(p16 + n * PLD + C_GLA + 256 + h * 64 + c8); npre = ld8(ao + n * 1792 + 1536 + h * 64 + c8);
        nv = *(const v2u*)(p16 + n * PLD + C_GLA + 512 + h * 128 + qt * 32 + v4);
    };
    load_chunk(0);
    for (int c = 0; c < 64; ++c) {
        float q8[8], k8[8], la[8];
        unpack8(nq, q8); unpack8(nk, k8); unpack8(npre, la);
        const v2u vraw = nv;
#pragma unroll
        for (int k = 0; k < 8; ++k) la[k] = -softplus_f(-la[k]) * (1.0f / 16.0f);
        *(LAS f32x4*)(LWL + j * 64 + c8) = (f32x4){la[0], la[1], la[2], la[3]}; *(LAS f32x4*)(LWL + j * 64 + c8 + 4) = (f32x4){la[4], la[5], la[6], la[7]};
        __syncthreads();
        if (c + 1 < 64) load_chunk(c + 1);
        if (tid < 64) { float s = 0.f;
#pragma unroll 8
            for (int jj = 0; jj < 64; ++jj) { s += LWL[jj * 64 + tid]; LWL[jj * 64 + tid] = s; } }
        __syncthreads();
        {
            float bj[8], br[8], bl[8], t0[8], t1[8], t2[8];
            { const f32x4 x0 = *(const LAS f32x4*)(LWL + j * 64 + c8), x1 = *(const LAS f32x4*)(LWL + j * 64 + c8 + 4);
              bj[0] = x0.x; bj[1] = x0.y; bj[2] = x0.z; bj[3] = x0.w; bj[4] = x1.x; bj[5] = x1.y; bj[6] = x1.z; bj[7] = x1.w;
              const f32x4 y0 = *(const LAS f32x4*)(LWL + 31 * 64 + c8), y1 = *(const LAS f32x4*)(LWL + 31 * 64 + c8 + 4);
              br[0] = y0.x; br[1] = y0.y; br[2] = y0.z; br[3] = y0.w; br[4] = y1.x; br[5] = y1.y; br[6] = y1.z; br[7] = y1.w;
              const f32x4 z0 = *(const LAS f32x4*)(LWL + 63 * 64 + c8), z1 = *(const LAS f32x4*)(LWL + 63 * 64 + c8 + 4);
              bl[0] = z0.x; bl[1] = z0.y; bl[2] = z0.z; bl[3] = z0.w; bl[4] = z1.x; bl[5] = z1.y; bl[6] = z1.z; bl[7] = z1.w; }
#pragma unroll
            for (int k = 0; k < 8; ++k) {
                const float qq = q8[k] * 0.125f;
                t0[k] = qq * __expf(bj[k] - br[k]); t1[k] = k8[k] * __expf(br[k] - bj[k]); t2[k] = qq * __expf(bj[k]);
                KS2T[(c8 + k) * RWP + j] = f2bf(k8[k] * __expf(bl[k] - bj[k]));
            }
            *(LAS v4u*)(QS + j * RWP + c8) = pack8(t0); *(LAS v4u*)(KS + j * RWP + c8) = pack8(t1); *(LAS v4u*)(QG + j * RWP + c8) = pack8(t2);
            VT[(v4 + 0) * RWP + j] = (bf16_t)(vraw.x & 0xffffu); VT[(v4 + 1) * RWP + j] = (bf16_t)(vraw.x >> 16);
            VT[(v4 + 2) * RWP + j] = (bf16_t)(vraw.y & 0xffffu); VT[(v4 + 3) * RWP + j] = (bf16_t)(vraw.y >> 16);
        }
        const float dec = __expf(LWL[63 * 64 + ntS * 16 + (lane & 15)]);
        __syncthreads();
        f32x4 o4;
        {
            const f32x4 z4 = {0.f, 0.f, 0.f, 0.f};
#pragma unroll
            for (int tt = 0; tt < 2; ++tt) { const int t = w + 8 * tt, mt = t >> 2, nt = t & 3;
                f32x4 s4 = mm64(QS, KS, mt, nt, lane, z4);
                const int nn = nt * 16 + (lane & 15), i0 = mt * 16 + (lane >> 4) * 4;
#pragma unroll
                for (int e = 0; e < 4; ++e) if (nn > i0 + e) s4[e] = 0.f;
                st_rowmajor(PM, mt, nt, lane, s4); }
            o4 = mm64(QG, ST, mtO, ntO, lane, z4);
        }
        __syncthreads();
        {
            o4 = mm64(PM, VT, mtO, ntO, lane, o4);
            const size_t n = (size_t)b * TSEQ + c * 64 + mtO * 16 + (lane >> 4) * 4;
            bf16_t* op = go + n * 512 + h * 128 + qt * 32 + ntO * 16 + (lane & 15);
            op[0] = f2bf(o4.x); op[512] = f2bf(o4.y); op[1024] = f2bf(o4.z); op[1536] = f2bf(o4.w);
            const f32x4 base = {Sacc.x * dec, Sacc.y * dec, Sacc.z * dec, Sacc.w * dec};
            Sacc = mm64(VT, KS2T, mtS, ntS, lane, base);
            st_rowmajor(ST, mtS, ntS, lane, Sacc);
        }
        __syncthreads();
    }
}

__device__ __forceinline__ void lru_pass(const Args& a, Frame& F, int l, bool passB) {
    const WsMap m = ws_map(NTOK);
    const bf16_t* gt = (const bf16_t*)(a.ws + m.gates); const bf16_t* xc = (const bf16_t*)(a.ws + m.xc); const bf16_t* p16 = (const bf16_t*)(a.ws + m.p16);
    bf16_t* mix = (bf16_t*)(a.ws + m.mix16); float* lrs = (float*)(a.ws + m.lrs);
    for (int it = F.vcu * NTHR + F.tid; it < NBATCH * 64 * 512; it += F.G * NTHR) {
        const int ch = it & 511, bc = it >> 9, c = bc & 63;
        const float sp8 = 8.0f * softplus_f(-a.in[I_LRU_LAM][l * 512 + ch]);
        const size_t nb = (size_t)bc * 64;
        float hh = 0.f, ap = 1.f;
        if (passB) { for (int s = 0; s < c; ++s) { const f32x2 su = *(const f32x2*)(lrs + ((size_t)(bc - c + s) * 512 + ch) * 2); hh = su.x * hh + su.y; } }
#pragma unroll 8
        for (int t = 0; t < 64; ++t) { const size_t n = nb + t;
            const float la = -sp8 * sigm(bf2f(gt[n * 1024 + ch]));
            const float u = bf2f(xc[n * 512 + ch]) * sigm(bf2f(gt[n * 1024 + 512 + ch])) * sqrtf(-expm1f(2.0f * la));
            const float av = __expf(la);
            hh = av * hh + u; ap *= av;
            if (passB) mix[n * DM + 1024 + ch] = f2bf(hh * gelu_fast(bf2f(p16[n * PLD + C_LRU + 512 + ch]))); }
        if (!passB) *(f32x2*)(lrs + ((size_t)bc * 512 + ch) * 2) = (f32x2){ap, hh};
    }
}

__device__ __forceinline__ void scan_phase(const Args& a, Frame& F, int l) {
    lru_pass(a, F, l, false);
    const int task = blockIdx.x;
    if (task < 128) { for (int q = 0; q < 16; ++q) rwkv_pa_chunk(a, F, l, task * 16 + q); }
    else if (task < 192) { for (int q = 0; q < 16; ++q) gdn_pa_chunk(a, F, (task - 128) * 16 + q); }
    else gla_task(a, F, l, task - 192);
}

__device__ __forceinline__ void post_phase(const Args& a, Frame& F, int l, const XcdBarrier& bar) {
    const WsMap m = ws_map(NTOK);
    if (blockIdx.x < 128) rwkv_ps_task(a, F, blockIdx.x); else gdn_ps_task(a, F, blockIdx.x - 128);
    lru_pass(a, F, l, true);
    const bf16_t* p16 = (const bf16_t*)(a.ws + m.p16); const bf16_t* glao = (const bf16_t*)(a.ws + m.glao); const bf16_t* gdno = (const bf16_t*)(a.ws + m.gdno);
    const bf16_t* rwy = (const bf16_t*)(a.ws + m.rwy); const bf16_t* rwbv = (const bf16_t*)(a.ws + m.rwbv); const bf16_t* ao = (const bf16_t*)(a.ws + m.auxo);
    bf16_t* mix = (bf16_t*)(a.ws + m.mix16);
    const int lane = F.lane, col = lane * 8, hc = col & 127;
    float gg[8], gd[8], lw[8], lb[8];
    { const f32x4 x0 = *(const f32x4*)(a.in[I_GLA_NORM] + l * 128 + hc), x1 = *(const f32x4*)(a.in[I_GLA_NORM] + l * 128 + hc + 4);
      gg[0] = x0.x; gg[1] = x0.y; gg[2] = x0.z; gg[3] = x0.w; gg[4] = x1.x; gg[5] = x1.y; gg[6] = x1.z; gg[7] = x1.w;
      const f32x4 y0 = *(const f32x4*)(a.in[I_GDN_NORM] + l * 128 + hc), y1 = *(const f32x4*)(a.in[I_GDN_NORM] + l * 128 + hc + 4);
      gd[0] = y0.x; gd[1] = y0.y; gd[2] = y0.z; gd[3] = y0.w; gd[4] = y1.x; gd[5] = y1.y; gd[6] = y1.z; gd[7] = y1.w;
      const f32x4 w0 = *(const f32x4*)(a.in[I_RW_LN_W] + l * 512 + col), w1 = *(const f32x4*)(a.in[I_RW_LN_W] + l * 512 + col + 4);
      lw[0] = w0.x; lw[1] = w0.y; lw[2] = w0.z; lw[3] = w0.w; lw[4] = w1.x; lw[5] = w1.y; lw[6] = w1.z; lw[7] = w1.w;
      const f32x4 b0 = *(const f32x4*)(a.in[I_RW_LN_B] + l * 512 + col), b1 = *(const f32x4*)(a.in[I_RW_LN_B] + l * 512 + col + 4);
      lb[0] = b0.x; lb[1] = b0.y; lb[2] = b0.z; lb[3] = b0.w; lb[4] = b1.x; lb[5] = b1.y; lb[6] = b1.z; lb[7] = b1.w; }
    for (int pass = 1; pass < 2; ++pass) {
    if (pass == 1) xcd_barrier(bar);
    for (int n = F.gw; n < NTOK; n += F.ngw) {
        if (pass == 1) {
            float y[8], bv[8], g[8];
            unpack8(ld8(rwy + (size_t)n * 512 + col), y); unpack8(ld8(rwbv + (size_t)n * 512 + col), bv); unpack8(ld8(ao + (size_t)n * 1792 + 1024 + col), g);
            float s = 0.f;
#pragma unroll
            for (int k = 0; k < 8; ++k) s += y[k];
            const float mean = red8(s) * (1.0f / 64.0f);
            float s2 = 0.f;
#pragma unroll
            for (int k = 0; k < 8; ++k) { y[k] -= mean; s2 += y[k] * y[k]; }
            const float rs = 1.0f / sqrtf(red8(s2) * (1.0f / 64.0f) + 64e-5f);
#pragma unroll
            for (int k = 0; k < 8; ++k) y[k] = (y[k] * rs * lw[k] + lb[k] + bv[k]) * g[k];
            *(v4u*)(mix + (size_t)n * DM + col) = pack8(y);
        }
        if (pass == 1)
#pragma unroll
        for (int which = 0; which < 2; ++which) {
            float o[8], g[8];
            unpack8(ld8((which ? gdno : glao) + (size_t)n * 512 + col), o);
            unpack8(ld8(p16 + (size_t)n * PLD + (which ? C_GDN + 1536 : C_GLA + 1024) + col), g);
            float ss = 0.f;
#pragma unroll
            for (int k = 0; k < 8; ++k) ss += o[k] * o[k];
            ss = row16_sum(ss);
            const float rs = 1.0f / sqrtf(ss * (1.0f / 128.0f) + 1e-6f);
#pragma unroll
            for (int k = 0; k < 8; ++k) o[k] = o[k] * rs * (which ? gd[k] : gg[k]) * (g[k] * sigm(g[k]));
            *(v4u*)(mix + (size_t)n * DM + (which ? 1536 : 512) + col) = pack8(o);
        }
    }
    }
}

__device__ __forceinline__ void norm2_phase(const Args& a, Frame& F, int l) {
    const WsMap m = ws_map(NTOK);
    const float* gain = a.in[I_NORM_FFN] + l * DM;
    f32x4 gv[8];
#pragma unroll
    for (int j = 0; j < 8; ++j) gv[j] = ((const f32x4*)gain)[64 * j + F.lane];
    for (int n = F.gw; n < NTOK; n += F.ngw) {
        const f32x4* xr = (const f32x4*)(a.out + (size_t)n * DM) + F.lane;
        f32x4 v[8]; float s = 0.f;
#pragma unroll
        for (int j = 0; j < 8; ++j) { v[j] = xr[64 * j]; s += (v[j].x * v[j].x + v[j].y * v[j].y) + (v[j].z * v[j].z + v[j].w * v[j].w); }
        const float rstd = 1.0f / sqrtf(wave_sum_u(s) * (1.0f / DM) + 1e-6f);
        v2u* o8 = (v2u*)((bf16_t*)(a.ws + m.hb) + (size_t)n * DM) + F.lane;
#pragma unroll
        for (int j = 0; j < 8; ++j) { v2u w; w.x = pk2(v[j].x * rstd * gv[j].x, v[j].y * rstd * gv[j].y); w.y = pk2(v[j].z * rstd * gv[j].z, v[j].w * rstd * gv[j].w); o8[64 * j] = w; }
    }
}

#define TK_CE(A, B) do { const float mx_ = fmaxf(A, B), mn_ = fminf(A, B); A = mx_; B = mn_; } while (0)
__device__ __forceinline__ void tk_sort16_desc(float (&x)[16]) {
#pragma unroll
    for (int k = 2; k <= 16; k <<= 1)
#pragma unroll
        for (int j = k >> 1; j > 0; j >>= 1)
#pragma unroll
            for (int i = 0; i < 16; ++i) { const int p = i ^ j;
                if (p > i) { if ((i & k) == 0) TK_CE(x[i], x[p]); else TK_CE(x[p], x[i]); } }
}
__device__ __forceinline__ void tk_merge16(float (&run)[16], const float (&g)[16]) {
#pragma unroll
    for (int i = 0; i < 16; ++i) run[i] = fmaxf(run[i], g[15 - i]);
#pragma unroll
    for (int j = 8; j > 0; j >>= 1)
#pragma unroll
        for (int i = 0; i < 16; ++i) { const int p = i ^ j; if (p > i) TK_CE(run[i], run[p]); }
}
__device__ __forceinline__ float tk_tag(float v, unsigned tag, unsigned mask) { return __builtin_bit_cast(float, (__builtin_bit_cast(unsigned, v) & ~mask) | tag); }
__device__ __forceinline__ void topk_phase(const Args& a, Frame& F) {
    const WsMap m = ws_map(NTOK);
    const float* sc = (const float*)(a.ws + m.sc);
    int* idx = (int*)(a.ws + m.idx); float* gate = (float*)(a.ws + m.gate);
    LAS float* LS = (LAS float*)F.lds;
    const int t = F.tid;
    for (int wv = F.gw; wv < (NTOK / 64) * 8; wv += F.ngw) {
        const int h = wv & 7, n = (wv >> 3) * 64 + F.lane;
        const float* sp = sc + (size_t)(h * 256) * NTOK + n;
        float s0[16], s1[16];
#pragma unroll
        for (int half = 0; half < 2; ++half) {
            float run[16];
#pragma unroll
            for (int j = 0; j < 16; ++j) run[j] = -3.0e38f;
#pragma unroll 1
            for (int g = 0; g < 8; ++g) {
                float x[16];
#pragma unroll
                for (int k = 0; k < 16; ++k) x[k] = tk_tag(sp[(size_t)(half * 128 + g * 16 + k) * NTOK], (unsigned)(g * 16 + k), 127u);
                tk_sort16_desc(x);
                tk_merge16(run, x);
            }
#pragma unroll
            for (int j = 0; j < 16; ++j) { if (half) s1[j] = run[j]; else s0[j] = run[j]; LS[(half * 16 + j) * 512 + t] = run[j]; }
        }
        float run[16];
#pragma unroll
        for (int j = 0; j < 16; ++j) run[j] = -3.0e38f;
        {
            float x[16]; int cnt = 0;
#pragma unroll
            for (int p = 0; p < 16; ++p)
#pragma unroll
                for (int q = 0; q < 16; ++q) if ((p + 1) * (q + 1) <= 16) {
                    x[cnt & 15] = tk_tag(s0[p] + s1[q], (unsigned)(p * 16 + q), 255u); ++cnt;
                    if ((cnt & 15) == 0) { tk_sort16_desc(x); tk_merge16(run, x); }
                }
#pragma unroll
            for (int k = 0; k < 16; ++k) if (k >= (cnt & 15)) x[k] = -3.0e38f;
            tk_sort16_desc(x); tk_merge16(run, x);
        }
        const float mx = run[0]; float den = 0.f; float e[16]; int ti[16];
#pragma unroll
        for (int j = 0; j < 16; ++j) {
            const unsigned tg = __builtin_bit_cast(unsigned, run[j]) & 255u; const int p = (int)(tg >> 4), q = (int)(tg & 15u);
            const unsigned k0 = __builtin_bit_cast(unsigned, LS[(0 * 16 + p) * 512 + t]) & 127u, k1 = __builtin_bit_cast(unsigned, LS[(1 * 16 + q) * 512 + t]) & 127u;
            ti[j] = (int)(k0 * 128u + k1);
            e[j] = __expf(run[j] - mx); den += e[j];
        }
        const float inv = 1.0f / den;
        const size_t it = (size_t)n * 8 + h;
        f32x4* go = (f32x4*)(gate + it * 16); v4u* io = (v4u*)(idx + it * 16);
#pragma unroll
        for (int j = 0; j < 4; ++j) { go[j] = (f32x4){e[4 * j] * inv, e[4 * j + 1] * inv, e[4 * j + 2] * inv, e[4 * j + 3] * inv};
            io[j] = (v4u){(unsigned)ti[4 * j], (unsigned)ti[4 * j + 1], (unsigned)ti[4 * j + 2], (unsigned)ti[4 * j + 3]}; }
    }
}

__device__ __forceinline__ void peer_phase(const Args& a, Frame& F, int l) {
    const WsMap m = ws_map(NTOK);
    const unsigned char* TU = (const unsigned char*)(a.ws + m.tabu) + (size_t)l * 2 * NEXP * DM;
    const unsigned char* TV = TU + (size_t)NEXP * DM;
    const int* idx = (const int*)(a.ws + m.idx); const float* gate = (const float*)(a.ws + m.gate);
    const int lane = F.lane;
    for (int n = F.gw; n < NTOK; n += F.ngw) {
        f32x2 xf[16];
        { const v4u* hr = (const v4u*)((const bf16_t*)(a.ws + m.hb) + (size_t)n * DM);
#pragma unroll
          for (int c = 0; c < 2; ++c)
#pragma unroll
              for (int hh = 0; hh < 2; ++hh) { const v4u w = hr[c * 128 + lane * 2 + hh]; const int o = c * 8 + hh * 4;
                  xf[o + 0] = (f32x2){bflo(w.x), bfhi(w.x)}; xf[o + 1] = (f32x2){bflo(w.y), bfhi(w.y)}; xf[o + 2] = (f32x2){bflo(w.z), bfhi(w.z)}; xf[o + 3] = (f32x2){bflo(w.w), bfhi(w.w)}; } }
        const int e0 = idx[(size_t)n * 128 + lane], e1 = idx[(size_t)n * 128 + 64 + lane];
        const float g0 = gate[(size_t)n * 128 + lane], g1 = gate[(size_t)n * 128 + 64 + lane];
        float d0 = 0.f, d1 = 0.f;
#pragma unroll
        for (int half = 0; half < 2; ++half) {
            const int ev = half ? e1 : e0; float dd = 0.f;
            for (int j = 0; j < 64; j += 8) {
                v4u u[8][2];
#pragma unroll
                for (int r = 0; r < 8; ++r) { const int e = __builtin_amdgcn_readlane(ev, j + r);
                    const v4u* row = (const v4u*)(TU + (size_t)e * DM) + lane;
                    u[r][0] = row[0]; u[r][1] = row[64]; }
#pragma unroll
                for (int r = 0; r < 8; ++r) { f32x2 a0 = {0.f, 0.f}, a1 = {0.f, 0.f};
#pragma unroll
                    for (int c = 0; c < 2; ++c) { const unsigned wv[4] = {u[r][c].x, u[r][c].y, u[r][c].z, u[r][c].w};
#pragma unroll
                        for (int k = 0; k < 4; ++k) { a0 += __builtin_amdgcn_cvt_pk_f32_fp8((int)wv[k], false) * xf[c * 8 + k * 2]; a1 += __builtin_amdgcn_cvt_pk_f32_fp8((int)wv[k], true) * xf[c * 8 + k * 2 + 1]; } }
                    const float t = wave_sum_u((a0.x + a0.y) + (a1.x + a1.y));
                    dd = (lane == j + r) ? t : dd; }
            }
            if (half) d1 = dd; else d0 = dd;
        }
        const float c0 = gelu_fast(d0 * (1.0f / 1024.0f)) * g0 * (1.0f / 64.0f), c1 = gelu_fast(d1 * (1.0f / 1024.0f)) * g1 * (1.0f / 64.0f);
        f32x2 o[16];
#pragma unroll
        for (int i = 0; i < 16; ++i) o[i] = (f32x2){0.f, 0.f};
#pragma unroll
        for (int half = 0; half < 2; ++half) {
            const int ev = half ? e1 : e0; const float cv = half ? c1 : c0;
            for (int j = 0; j < 64; j += 8) {
                v4u v[8][2]; float cj[8];
#pragma unroll
                for (int r = 0; r < 8; ++r) { const int e = __builtin_amdgcn_readlane(ev, j + r); cj[r] = rdlane_f(cv, j + r);
                    const v4u* row = (const v4u*)(TV + (size_t)e * DM) + lane;
                    v[r][0] = row[0]; v[r][1] = row[64]; }
#pragma unroll
                for (int r = 0; r < 8; ++r)
#pragma unroll
                    for (int c = 0; c < 2; ++c) { const unsigned wv[4] = {v[r][c].x, v[r][c].y, v[r][c].z, v[r][c].w};
#pragma unroll
                        for (int k = 0; k < 4; ++k) { o[c * 8 + k * 2] += __builtin_amdgcn_cvt_pk_f32_fp8((int)wv[k], false) * cj[r]; o[c * 8 + k * 2 + 1] += __builtin_amdgcn_cvt_pk_f32_fp8((int)wv[k], true) * cj[r]; } }
            }
        }
        float* xrow = a.out + (size_t)n * DM;
        float s = 0.f;
#pragma unroll
        for (int c = 0; c < 2; ++c)
#pragma unroll
            for (int q = 0; q < 4; ++q) { const f32x4 x4 = *(const f32x4*)(xrow + c * 1024 + lane * 16 + q * 4);
                o[c * 8 + q * 2].x += x4.x; o[c * 8 + q * 2].y += x4.y; o[c * 8 + q * 2 + 1].x += x4.z; o[c * 8 + q * 2 + 1].y += x4.w;
                s += (o[c * 8 + q * 2].x * o[c * 8 + q * 2].x + o[c * 8 + q * 2].y * o[c * 8 + q * 2].y) + (o[c * 8 + q * 2 + 1].x * o[c * 8 + q * 2 + 1].x + o[c * 8 + q * 2 + 1].y * o[c * 8 + q * 2 + 1].y); }
        const float rstd = 1.0f / sqrtf(wave_sum_u(s) * (1.0f / DM) + 1e-6f);
        if (l + 1 < NL) {
            bf16_t* xo = (bf16_t*)(a.ws + m.xn) + (size_t)n * DM;
#pragma unroll
            for (int c = 0; c < 2; ++c) {
#pragma unroll
                for (int q = 0; q < 4; ++q) *(f32x4*)(xrow + c * 1024 + lane * 16 + q * 4) = (f32x4){o[c * 8 + q * 2].x, o[c * 8 + q * 2].y, o[c * 8 + q * 2 + 1].x, o[c * 8 + q * 2 + 1].y};
#pragma unroll
                for (int hh = 0; hh < 2; ++hh) { const int b0 = c * 8 + hh * 4; v4u w;
                    w.x = pk2(o[b0].x * rstd, o[b0].y * rstd); w.y = pk2(o[b0 + 1].x * rstd, o[b0 + 1].y * rstd); w.z = pk2(o[b0 + 2].x * rstd, o[b0 + 2].y * rstd); w.w = pk2(o[b0 + 3].x * rstd, o[b0 + 3].y * rstd);
                    *(v4u*)(xo + c * 1024 + lane * 16 + hh * 8) = w; } }
        } else {
            const float* gf = a.in[I_NORM_FINAL];
#pragma unroll
            for (int c = 0; c < 2; ++c)
#pragma unroll
                for (int q = 0; q < 4; ++q) { const f32x4 g4 = *(const f32x4*)(gf + c * 1024 + lane * 16 + q * 4);
                    *(f32x4*)(xrow + c * 1024 + lane * 16 + q * 4) = (f32x4){o[c * 8 + q * 2].x * rstd * g4.x, o[c * 8 + q * 2].y * rstd * g4.y, o[c * 8 + q * 2 + 1].x * rstd * g4.z, o[c * 8 + q * 2 + 1].y * rstd * g4.w}; }
        }
    }
}

#define IN(k) (lo <= (k) && (k) < hi)
#define SEAM(k) do { if (IN(k) && IN((k) + 1)) xcd_barrier(bar); } while (0)
template <int l>
__device__ __forceinline__ void layer_phases(const Args& a, Frame& F, const XcdBarrier& bar, const WsMap& m, int lo, int hi) {
    constexpr int pb = l * PH_PER_LAYER;
        if (IN(pb + PH_GEMM1)) {
            pg8::GemmX g{(const bf16_t*)(a.ws + m.xn), (const bf16_t*)(a.ws + m.w1t) + (size_t)l * PLD * DM, NTOK, PLD, DM, DM};
            pg8::StaticOrder S; S.init(NTOK, PLD, F.G, (int)blockIdx.x);
            pg8::EpiBf16 E{(bf16_t*)(a.ws + m.p16), PLD, nullptr};
            pg8::gemm_phase<pg8::EpiBf16, pg8::StaticOrder, true, true>(F.lds, g, S, E);
            SEAM(pb + PH_GEMM1);
        }
        if (IN(pb + PH_PREP)) { prep_phase(a, F, l); SEAM(pb + PH_PREP); }
        if (IN(pb + PH_AUX)) {
            const float* PP = (const float*)(a.ws + m.pp);
            { pg8::GemmX g{(const bf16_t*)(a.ws + m.auxA), (const bf16_t*)(a.ws + m.auxwt) + (size_t)l * 1792 * 384, NTOK, 1792, 384, 384};
              pg8::StaticOrder S; S.init(NTOK, 1792, F.G, (int)blockIdx.x);
              pg8::EpiBf16 E{(bf16_t*)(a.ws + m.auxo), 1792, PP + l * 1792};
              pg8::gemm_phase<pg8::EpiBf16, pg8::StaticOrder, true, true>(F.lds, g, S, E); }
            { pg8::GemmX g{(const bf16_t*)(a.ws + m.xc), (const bf16_t*)(a.ws + m.lruwt) + (size_t)l * 1024 * 512, NTOK, 1024, 512, 512};
              pg8::StaticOrder S; S.init(NTOK, 1024, F.G, (int)blockIdx.x);
              pg8::EpiBf16 E{(bf16_t*)(a.ws + m.gates), 1024, PP + 3584 + l * 1024};
              pg8::gemm_phase<pg8::EpiBf16, pg8::StaticOrder, true, true>(F.lds, g, S, E); }
            if (l > 0) {
              pg8::GemmX g{(const bf16_t*)(a.ws + m.zrkv) + 1024, (const bf16_t*)(a.ws + m.vreswt), NTOK, 512, 512, 1536};
              pg8::StaticOrder S; S.init(NTOK, 512, F.G, (int)blockIdx.x);
              pg8::EpiBf16 E{(bf16_t*)(a.ws + m.vres), 512, PP + 5632};
              pg8::gemm_phase<pg8::EpiBf16, pg8::StaticOrder, true, true>(F.lds, g, S, E); }
            SEAM(pb + PH_AUX);
        }
        if (IN(pb + PH_SCAN)) { scan_phase(a, F, l); SEAM(pb + PH_SCAN); }
        if (IN(pb + PH_POST)) { post_phase(a, F, l, bar); SEAM(pb + PH_POST); }
        if (IN(pb + PH_GEMM2)) {
            pg8::GemmX g{(const bf16_t*)(a.ws + m.mix16), (const bf16_t*)(a.ws + m.w2t) + (size_t)l * DM * DM, NTOK, DM, DM, DM};
            pg8::StaticOrder S; S.init(NTOK, DM, F.G, (int)blockIdx.x);
            pg8::EpiF32<true> E{a.out, DM};
            pg8::gemm_phase<pg8::EpiF32<true>, pg8::StaticOrder, true, true>(F.lds, g, S, E);
            SEAM(pb + PH_GEMM2);
        }
        if (IN(pb + PH_NORM2)) { norm2_phase(a, F, l); SEAM(pb + PH_NORM2); }
        if (IN(pb + PH_GEMM3)) {
            pg8::GemmX g{(const bf16_t*)(a.ws + m.wsct) + (size_t)l * DM * DM, (const bf16_t*)(a.ws + m.hb), DM, NTOK, DM, DM};
            pg8::StaticOrder S; S.init(DM, NTOK, F.G, (int)blockIdx.x);
            pg8::EpiF32<false> E{(float*)(a.ws + m.sc), NTOK};
            pg8::gemm_phase<pg8::EpiF32<false>, pg8::StaticOrder, true, true>(F.lds, g, S, E);
            SEAM(pb + PH_GEMM3);
        }
        if (IN(pb + PH_TOPK)) { topk_phase(a, F); SEAM(pb + PH_TOPK); }
        if (IN(pb + PH_PEER)) { peer_phase(a, F, l); SEAM(pb + PH_PEER); }
}

#undef IN
#undef SEAM
__global__ void __launch_bounds__(NTHR, 2) mega(Args a) {
    extern __shared__ __attribute__((aligned(16))) unsigned char lds_raw[];
    Frame F;
    F.lds = (LAS unsigned char*)lds_raw;
    F.tid = threadIdx.x; F.lane = F.tid & 63; F.wave = __builtin_amdgcn_readfirstlane(F.tid >> 6);
    F.G = gridDim.x; { const int bx = blockIdx.x; F.vcu = (F.G % 8 == 0) ? (bx % 8) * (F.G / 8) + bx / 8 : bx; }
    F.gw = F.vcu * NWAVES + F.wave; F.ngw = F.G * NWAVES;
    volatile LAS unsigned* MISC = (volatile LAS unsigned*)(F.lds + MISC_OFF);
    if (F.tid < 32) MISC[F.tid] = 0u;
    __syncthreads();
    const WsMap m = ws_map(NTOK);
    unsigned* ctl = (unsigned*)(a.ws + m.ctl);
    XcdBarrier bar; bar.bar = ctl + 4096 + a.li * XCD_BAR_WORDS; bar.x = 0; bar.st = nullptr;
    const int lo = a.ph_lo, hi = a.ph_hi;
    if (hi - lo > 1) bar = xcd_barrier_post(ctl + 4096 + a.li * XCD_BAR_WORDS, MISC + 8);
#define IN(k) (lo <= (k) && (k) < hi)
#define SEAM(k) do { if (IN(k) && IN((k) + 1)) xcd_barrier(bar); } while (0)
    if (IN(PH_P0)) { p0_prologue(a, F); tables_phase(a, F, 0, NL); SEAM(PH_P0); }
    if (lo >= 100) { tables_phase(a, F, lo - 100, hi - 100); }
    layer_phases<0>(a, F, bar, m, lo, hi);
    layer_phases<1>(a, F, bar, m, lo, hi);
#undef IN
#undef SEAM
}

template <int ST>
__global__ void __launch_bounds__(256) stage_kernel(Params P, int l) {
    const long n = stage_items(P, ST, l);
    for (long it = blockIdx.x * 256L + threadIdx.x; it < n; it += gridDim.x * 256L) run_item(P, ST, l, it);
}
template <int ST>
static void launch_stage(const Params& P, int l, hipStream_t stream) {
    const long n = stage_items(P, ST, l);
    if (n <= 0) return;
    long blocks = (n + 255) / 256;
    if (blocks > 8192) blocks = 8192;
    stage_kernel<ST><<<dim3((unsigned)blocks), dim3(256), 0, stream>>>(P, l);
}
#define LS(X) case X: launch_stage<X>(P, l, stream); break;
static void launch_any(int st, const Params& P, int l, hipStream_t stream) {
    switch (st) {
        LS(ST_COPYX) LS(ST_RSTD) LS(ST_NORM1) LS(ST_GEMM1) LS(ST_RW_A0) LS(ST_RW_A1) LS(ST_RW_A2) LS(ST_RW_A3) LS(ST_RW_KKN)
        LS(ST_RW_SCAN) LS(ST_RW_POST) LS(ST_GLA_B0) LS(ST_GLA_SCAN) LS(ST_GLA_POST) LS(ST_LRU_C0) LS(ST_LRU_C1) LS(ST_LRU_SCAN)
        LS(ST_GDN_D0) LS(ST_GDN_D1) LS(ST_GDN_SCAN) LS(ST_GDN_POST) LS(ST_GEMM2) LS(ST_RSTD2) LS(ST_NORM2) LS(ST_GEMM3)
        LS(ST_SCORES) LS(ST_TOPK1) LS(ST_TOPK2) LS(ST_PEER_U) LS(ST_PEER_V) LS(ST_FRSTD) LS(ST_FNORM)
    }
}

extern "C" void kernel_launch(void* const* d_in, const int* in_sizes, int n_in, void* d_out, int out_size, void* d_ws,
                              size_t ws_size, hipStream_t stream) {
    static int grid = 0;
    if (grid == 0) {
        int dev = 0, cus = 0;
        (void)hipGetDevice(&dev);
        (void)hipDeviceGetAttribute(&cus, hipDeviceAttributeMultiprocessorCount, dev);
        (void)hipFuncSetAttribute((const void*)mega, hipFuncAttributeMaxDynamicSharedMemorySize, LDS_BYTES);
        grid = cus > 0 ? cus : 256;
    }
    Params P;
    memset(&P, 0, sizeof(P));
    fill_inputs(P, d_in);
    P.B = 4; P.T = 4096; P.N = 16384; P.pad = 0;
    P.xcur = (float*)d_out;
    bind_ws(P, (char*)d_ws);
    Args a;
    memset(&a, 0, sizeof(a));
    for (int i = 0; i < 38; ++i) a.in[i] = (const float*)d_in[i];
    a.out = (float*)d_out; a.ws = (unsigned char*)d_ws;
    (void)hipMemsetAsync(d_ws, 0, 1u << 20, stream);
    int li = 0;
    auto run_mega = [&](int lo, int hi) { a.ph_lo = lo; a.ph_hi = hi; a.li = li++; hipLaunchKernelGGL(mega, dim3(grid), dim3(NTHR), LDS_BYTES, stream, a); };
    run_mega(PH_P0, PH_TOTAL);
}
#endif
```

```cpp
#ifndef HOST_EMU
#include <hip/hip_runtime.h>
#include <cstring>
#define HD __host__ __device__ __forceinline__
#else
#include <cmath>
#include <cstdio>
#include <cstdlib>
#include <cstring>
#define HD inline
#endif

constexpr int DM = 2048;
constexpr int NL = 2;
constexpr int INC = 6424;
constexpr int C_RW = 0;
constexpr int C_GLA = 1792;
constexpr int C_LRU = 3344;
constexpr int C_GDN = 4368;
constexpr int NEXP = 16384;

typedef unsigned short bf16_t;
constexpr int PLD = 6656;
HD float bf2f(bf16_t h) { unsigned u = (unsigned)h << 16; float f; memcpy(&f, &u, 4); return f; }
HD bf16_t f2bf(float f) { unsigned u; memcpy(&u, &f, 4); return (bf16_t)((u + 0x7fffu + ((u >> 16) & 1u)) >> 16); }

struct Params {
    const float *x, *norm_mix, *w_in, *w_out, *rw_mu, *rw_w0, *rw_w_up, *rw_a0, *rw_a_up, *rw_g_up, *rw_k_k, *rw_k_a,
        *rw_r_k, *rw_ln_w, *rw_ln_b, *rw_v0, *rw_v_down, *rw_v_up, *gla_a_up, *gla_a_bias, *gla_norm, *lru_conv_w,
        *lru_conv_b, *lru_w_r, *lru_b_r, *lru_w_i, *lru_b_i, *lru_lam, *gdn_conv_w, *gdn_a_log, *gdn_dt_bias, *gdn_norm,
        *norm_ffn, *peer_wq, *peer_sub_keys, *peer_u, *peer_v, *norm_final;
    float* xcur;
    bf16_t* xn;
    bf16_t* hb;
    bf16_t* mix16;
    bf16_t* p16;
    float* sc;
    float* qf;
    float* rstd;
    float* vfirst;
    float* scr;
    float* act;
    float* gate;
    int* idx;
    int B, T, N, pad;
};

HD float sigmoidf_(float x) { return 1.0f / (1.0f + expf(-x)); }
HD float softplusf_(float x) { return log1pf(expf(-fabsf(x))) + fmaxf(x, 0.0f); }
HD float siluf_(float x) { return x * sigmoidf_(x); }
HD float geluf_(float x) { return 0.5f * x * (1.0f + tanhf(0.7978845608028654f * (x + 0.044715f * x * x * x))); }

enum Stage {
    ST_COPYX = 0,
    ST_RSTD, ST_NORM1, ST_GEMM1,
    ST_RW_A0, ST_RW_A1, ST_RW_A2, ST_RW_A3, ST_RW_KKN, ST_RW_SCAN, ST_RW_POST,
    ST_GLA_B0, ST_GLA_SCAN, ST_GLA_POST,
    ST_LRU_C0, ST_LRU_C1, ST_LRU_SCAN,
    ST_GDN_D0, ST_GDN_D1, ST_GDN_SCAN, ST_GDN_POST,
    ST_GEMM2, ST_RSTD2, ST_NORM2, ST_GEMM3, ST_SCORES, ST_TOPK1, ST_TOPK2, ST_PEER_U, ST_PEER_V,
    ST_FRSTD, ST_FNORM,
    ST_COUNT
};

constexpr long SO_ZS = 0, SO_R = 256, SO_DEC = 768, SO_KM = 1280, SO_KK = 1792, SO_A = 2304, SO_G = 2816, SO_V = 3328,
               SO_Y = 3840, SO_VD = 4352, SO_KKINV = 4384;
constexpr long SO_ALPHA = 0, SO_GO = 256;
constexpr long SO_XC = 0, SO_LA = 512, SO_LU = 1024;
constexpr long SO_QKV = 0, SO_GS = 1536, SO_DO = 1552;
constexpr long SCR_PER_TOK = 4400;
constexpr long SO_TS = 0, SO_TI = 256;

HD long stage_items(const Params& P, int st, int l) {
    const long N = P.N;
    switch (st) {
        case ST_COPYX: return N * DM;
        case ST_RSTD: case ST_RSTD2: case ST_FRSTD: return N;
        case ST_NORM1: case ST_NORM2: case ST_FNORM: return N * DM;
        case ST_GEMM1: return (N / 4) * (INC / 4);
        case ST_RW_A0: return N * 256;
        case ST_RW_A1: return N * 512;
        case ST_RW_A2: return l > 0 ? N * 32 : 0;
        case ST_RW_A3: return l > 0 ? N * 512 : 0;
        case ST_RW_KKN: return N * 8;
        case ST_RW_SCAN: return (long)P.B * 512;
        case ST_RW_POST: return N * 8;
        case ST_GLA_B0: return N * 256;
        case ST_GLA_SCAN: return (long)P.B * 512;
        case ST_GLA_POST: return N * 4;
        case ST_LRU_C0: return N * 512;
        case ST_LRU_C1: return N * 512;
        case ST_LRU_SCAN: return (long)P.B * 512;
        case ST_GDN_D0: return N * 1536;
        case ST_GDN_D1: return N * 4;
        case ST_GDN_SCAN: return (long)P.B * 512;
        case ST_GDN_POST: return N * 4;
        case ST_GEMM2: case ST_GEMM3: return (N / 4) * (DM / 4);
        case ST_SCORES: return N * 2048;
        case ST_TOPK1: return N * 16;
        case ST_TOPK2: return N * 8;
        case ST_PEER_U: return N * 128;
        case ST_PEER_V: return N * DM;
    }
    return 0;
}

HD void gemm_item(const bf16_t* A, const float* W, int ldw, const float* kscale, float* Cf, bf16_t* Ch, int ldc, int n4, long item, int mode) {
    const long r4 = item / n4;
    const int c4 = (int)(item % n4);
    const bf16_t* a0 = A + (r4 * 4) * (long)DM;
    const float* w = W + c4 * 4;
    float acc[4][4];
    for (int i = 0; i < 4; ++i)
        for (int j = 0; j < 4; ++j) acc[i][j] = 0.f;
    for (int k = 0; k < DM; ++k) {
        const float ks = kscale ? kscale[k] : 1.0f;
        const float w0 = w[(long)k * ldw + 0] * ks, w1 = w[(long)k * ldw + 1] * ks, w2 = w[(long)k * ldw + 2] * ks, w3 = w[(long)k * ldw + 3] * ks;
#pragma unroll
        for (int i = 0; i < 4; ++i) {
            const float a = bf2f(a0[(long)i * DM + k]);
            acc[i][0] += a * w0; acc[i][1] += a * w1; acc[i][2] += a * w2; acc[i][3] += a * w3;
        }
    }
#pragma unroll
    for (int i = 0; i < 4; ++i) {
        const long o = (r4 * 4 + i) * (long)ldc + c4 * 4;
#pragma unroll
        for (int j = 0; j < 4; ++j) {
            if (mode == 0) Ch[o + j] = f2bf(acc[i][j]);
            else if (mode == 1) Cf[o + j] += acc[i][j];
            else Cf[o + j] = acc[i][j];
        }
    }
}

#define PF(n, col) bf2f(P.p16[(long)(n) * PLD + (col)])
HD float rw_shift(const Params& P, int l, long n, int col) {
    const int t = (int)(n % P.T);
    const float cur = PF(n, C_RW + col);
    const float prev = t > 0 ? PF(n - 1, C_RW + col) : 0.f;
    return cur + (prev - cur) * P.rw_mu[l * 1792 + col];
}

HD void run_item(const Params& P, int st, int l, long it) {
    const long N = P.N;
    float* scr = P.scr;
    switch (st) {
        case ST_COPYX: P.xcur[it] = P.x[it]; break;
        case ST_RSTD: case ST_RSTD2: case ST_FRSTD: {
            const float* xr = P.xcur + it * DM;
            float s = 0.f;
            for (int d = 0; d < DM; ++d) s += xr[d] * xr[d];
            P.rstd[it] = 1.0f / sqrtf(s * (1.0f / DM) + 1e-6f);
        } break;
        case ST_NORM1: case ST_NORM2: case ST_FNORM: {
            const long n = it / DM; const int d = (int)(it % DM);
            if (st == ST_NORM1) P.xn[it] = f2bf(P.xcur[it] * P.rstd[n]);
            else if (st == ST_NORM2) P.hb[it] = f2bf(P.xcur[it] * P.rstd[n] * P.norm_ffn[l * DM + d]);
            else P.xcur[it] = P.xcur[it] * P.rstd[n] * P.norm_final[d];
        } break;
        case ST_GEMM1: gemm_item(P.xn, P.w_in + (long)l * DM * INC, INC, P.norm_mix + l * DM, nullptr, P.p16, PLD, INC / 4, it, 0); break;
        case ST_GEMM2: gemm_item(P.mix16, P.w_out + (long)l * DM * DM, DM, nullptr, P.xcur, nullptr, DM, DM / 4, it, 1); break;
        case ST_GEMM3: gemm_item(P.hb, P.peer_wq + (long)l * DM * DM, DM, nullptr, P.qf, nullptr, DM, DM / 4, it, 2); break;
        case ST_RW_A0: {
            const long n = it / 256; const int c = (int)(it % 256);
            const float z = rw_shift(P, l, n, 1536 + c);
            scr[N * SO_ZS + it] = c < 64 ? tanhf(z) : (c < 128 ? z : sigmoidf_(z));
        } break;
        case ST_RW_A1: {
            const long n = it / 512; const int j = (int)(it % 512);
            const float zr = rw_shift(P, l, n, j), zk = rw_shift(P, l, n, 512 + j), zv = rw_shift(P, l, n, 1024 + j);
            const float* zs = scr + N * SO_ZS + n * 256;
            float aw = P.rw_w0[l * 512 + j], aa = P.rw_a0[l * 512 + j], ag = 0.f;
            const float* wu = P.rw_w_up + (long)l * 64 * 512 + j;
            const float* au = P.rw_a_up + (long)l * 64 * 512 + j;
            const float* gu = P.rw_g_up + (long)l * 128 * 512 + j;
            for (int i = 0; i < 64; ++i) { aw += zs[i] * wu[i * 512]; aa += zs[64 + i] * au[i * 512]; }
            for (int i = 0; i < 128; ++i) ag += zs[128 + i] * gu[i * 512];
            const float w_raw = -softplusf_(-aw) - 0.5f;
            const float a = sigmoidf_(aa);
            scr[N * SO_R + it] = zr;
            scr[N * SO_DEC + it] = expf(-expf(w_raw));
            scr[N * SO_KM + it] = zk * (1.0f + (a - 1.0f) * P.rw_k_a[l * 512 + j]);
            scr[N * SO_KK + it] = zk * P.rw_k_k[l * 512 + j];
            scr[N * SO_A + it] = a;
            scr[N * SO_G + it] = ag;
            scr[N * SO_V + it] = zv;
            if (l == 0) P.vfirst[it] = zv;
        } break;
        case ST_RW_A2: {
            const long n = it / 32; const int i = (int)(it % 32);
            const float* v = scr + N * SO_V + n * 512;
            const float* vdn = P.rw_v_down + (long)(l - 1) * 512 * 32 + i;
            float s = 0.f;
            for (int j = 0; j < 512; ++j) s += v[j] * vdn[j * 32];
            scr[N * SO_VD + it] = s;
        } break;
        case ST_RW_A3: {
            const long n = it / 512; const int j = (int)(it % 512);
            const float* vd = scr + N * SO_VD + n * 32;
            const float* vup = P.rw_v_up + (long)(l - 1) * 32 * 512 + j;
            float s = P.rw_v0[(l - 1) * 512 + j];
            for (int i = 0; i < 32; ++i) s += vd[i] * vup[i * 512];
            const float v = scr[N * SO_V + it];
            scr[N * SO_V + it] = v + (P.vfirst[it] - v) * sigmoidf_(s);
        } break;
        case ST_RW_KKN: {
            const float* kk = scr + N * SO_KK + it * 64;
            float s = 0.f;
            for (int i = 0; i < 64; ++i) s += kk[i] * kk[i];
            scr[N * SO_KKINV + it] = 1.0f / sqrtf(fmaxf(s, 1e-24f));
        } break;
        case ST_RW_SCAN: {
            const int b = (int)(it / 512); const int h = (int)((it % 512) / 64); const int v = (int)(it % 64);
            float S[64];
#pragma unroll
            for (int i = 0; i < 64; ++i) S[i] = 0.f;
            for (int t = 0; t < P.T; ++t) {
                const long n = (long)b * P.T + t;
                const long base = n * 512 + h * 64;
                const float inv = scr[N * SO_KKINV + n * 8 + h];
                const float vv = scr[N * SO_V + base + v];
                const float* KK = scr + N * SO_KK + base;
                const float* DEC = scr + N * SO_DEC + base;
                const float* KM = scr + N * SO_KM + base;
                const float* AA = scr + N * SO_A + base;
                const float* RR = scr + N * SO_R + base;
                float sa = 0.f;
#pragma unroll
                for (int i = 0; i < 64; ++i) sa += S[i] * (-KK[i] * inv);
                float y = 0.f;
#pragma unroll
                for (int i = 0; i < 64; ++i) {
                    const float kk = KK[i] * inv;
                    S[i] = S[i] * DEC[i] + sa * (kk * AA[i]) + vv * KM[i];
                    y += S[i] * RR[i];
                }
                scr[N * SO_Y + base + v] = y;
            }
        } break;
        case ST_RW_POST: {
            const long n = it / 8; const int h = (int)(it % 8);
            const long base = n * 512 + h * 64;
            const float* Y = scr + N * SO_Y + base;
            const float* RR = scr + N * SO_R + base;
            const float* KM = scr + N * SO_KM + base;
            const float* V = scr + N * SO_V + base;
            const float* G = scr + N * SO_G + base;
            float mean = 0.f, bon = 0.f;
            for (int i = 0; i < 64; ++i) { mean += Y[i]; bon += RR[i] * KM[i] * P.rw_r_k[l * 512 + h * 64 + i]; }
            mean *= (1.0f / 64);
            float var = 0.f;
            for (int i = 0; i < 64; ++i) { const float d = Y[i] - mean; var += d * d; }
            const float rs = 1.0f / sqrtf(var * (1.0f / 64) + 64e-5f);
            for (int i = 0; i < 64; ++i) {
                const int c = h * 64 + i;
                const float yn = (Y[i] - mean) * rs * P.rw_ln_w[l * 512 + c] + P.rw_ln_b[l * 512 + c];
                P.mix16[n * DM + c] = f2bf((yn + bon * V[i]) * G[i]);
            }
        } break;
        case ST_GLA_B0: {
            const long n = it / 256; const int c = (int)(it % 256);
            float s = P.gla_a_bias[l * 256 + c];
            for (int i = 0; i < 16; ++i) s += PF(n, C_GLA + 1536 + i) * P.gla_a_up[(long)l * 16 * 256 + i * 256 + c];
            scr[N * SO_ALPHA + it] = expf(-softplusf_(-s) * (1.0f / 16.0f));
        } break;
        case ST_GLA_SCAN: {
            const int b = (int)(it / 512); const int h = (int)((it % 512) / 128); const int v = (int)(it % 128);
            float S[64];
#pragma unroll
            for (int i = 0; i < 64; ++i) S[i] = 0.f;
            for (int t = 0; t < P.T; ++t) {
                const long n = (long)b * P.T + t;
                const bf16_t* q = P.p16 + n * PLD + C_GLA + h * 64;
                const bf16_t* k = q + 256;
                const float vv = PF(n, C_GLA + 512 + h * 128 + v);
                const float* al = scr + N * SO_ALPHA + n * 256 + h * 64;
                float o = 0.f;
#pragma unroll
                for (int i = 0; i < 64; ++i) {
                    S[i] = S[i] * al[i] + bf2f(k[i]) * vv;
                    o += bf2f(q[i]) * S[i];
                }
                scr[N * SO_GO + n * 512 + h * 128 + v] = o * 0.125f;
            }
        } break;
        case ST_GLA_POST: {
            const long n = it / 4; const int h = (int)(it % 4);
            const float* o = scr + N * SO_GO + n * 512 + h * 128;
            float ms = 0.f;
            for (int i = 0; i < 128; ++i) ms += o[i] * o[i];
            const float rs = 1.0f / sqrtf(ms * (1.0f / 128) + 1e-6f);
            for (int i = 0; i < 128; ++i) {
                const float g = PF(n, C_GLA + 1024 + h * 128 + i);
                P.mix16[n * DM + 512 + h * 128 + i] = f2bf(o[i] * rs * P.gla_norm[l * 128 + i] * siluf_(g));
            }
        } break;
        case ST_LRU_C0: {
            const long n = it / 512; const int c = (int)(it % 512);
            const int t = (int)(n % P.T);
            float s = P.lru_conv_b[l * 512 + c];
            for (int j = 0; j < 4; ++j) {
                const int tt = t - 3 + j;
                if (tt >= 0) s += P.lru_conv_w[(long)l * 4 * 512 + j * 512 + c] * PF(n - 3 + j, C_LRU + c);
            }
            scr[N * SO_XC + it] = s;
        } break;
        case ST_LRU_C1: {
            const long n = it / 512; const int c = (int)(it % 512);
            const int blk = c / 64, j = c % 64;
            const float* xc = scr + N * SO_XC + n * 512 + blk * 64;
            const float* wr = P.lru_w_r + (long)l * 8 * 64 * 64 + (long)blk * 64 * 64 + j;
            const float* wi = P.lru_w_i + (long)l * 8 * 64 * 64 + (long)blk * 64 * 64 + j;
            float sr = P.lru_b_r[l * 512 + c], si = P.lru_b_i[l * 512 + c];
            for (int i = 0; i < 64; ++i) { sr += xc[i] * wr[i * 64]; si += xc[i] * wi[i * 64]; }
            const float r = sigmoidf_(sr), ig = sigmoidf_(si);
            const float log_a = -8.0f * r * softplusf_(-P.lru_lam[l * 512 + c]);
            scr[N * SO_LA + it] = expf(log_a);
            scr[N * SO_LU + it] = scr[N * SO_XC + it] * ig * sqrtf(-expm1f(2.0f * log_a));
        } break;
        case ST_LRU_SCAN: {
            const int b = (int)(it / 512); const int c = (int)(it % 512);
            float hst = 0.f;
            for (int t = 0; t < P.T; ++t) {
                const long n = (long)b * P.T + t;
                hst = scr[N * SO_LA + n * 512 + c] * hst + scr[N * SO_LU + n * 512 + c];
                P.mix16[n * DM + 1024 + c] = f2bf(hst * geluf_(PF(n, C_LRU + 512 + c)));
            }
        } break;
        case ST_GDN_D0: {
            const long n = it / 1536; const int c = (int)(it % 1536);
            const int t = (int)(n % P.T);
            float s = 0.f;
            for (int j = 0; j < 4; ++j) {
                const int tt = t - 3 + j;
                if (tt >= 0) s += P.gdn_conv_w[(long)l * 4 * 1536 + j * 1536 + c] * PF(n - 3 + j, C_GDN + c);
            }
            scr[N * SO_QKV + it] = siluf_(s);
        } break;
        case ST_GDN_D1: {
            const long n = it / 4; const int h = (int)(it % 4);
            const float* q = scr + N * SO_QKV + n * 1536 + h * 128;
            const float* k = q + 512;
            float qs = 0.f, ks = 0.f;
            for (int i = 0; i < 128; ++i) { qs += q[i] * q[i]; ks += k[i] * k[i]; }
            float* gs = scr + N * SO_GS + n * 16 + h * 4;
            gs[0] = (1.0f / sqrtf(qs + 1e-6f)) * 0.08838834764831845f;
            gs[1] = 1.0f / sqrtf(ks + 1e-6f);
            gs[2] = sigmoidf_(PF(n, C_GDN + 2048 + h));
            gs[3] = expf(-expf(P.gdn_a_log[l * 4 + h]) * softplusf_(PF(n, C_GDN + 2052 + h) + P.gdn_dt_bias[l * 4 + h]));
        } break;
        case ST_GDN_SCAN: {
            const int b = (int)(it / 512); const int h = (int)((it % 512) / 128); const int v = (int)(it % 128);
            float S[128];
#pragma unroll
            for (int i = 0; i < 128; ++i) S[i] = 0.f;
            for (int t = 0; t < P.T; ++t) {
                const long n = (long)b * P.T + t;
                const float* q = scr + N * SO_QKV + n * 1536 + h * 128;
                const float* k = q + 512;
                const float vv = scr[N * SO_QKV + n * 1536 + 1024 + h * 128 + v];
                const float* gs = scr + N * SO_GS + n * 16 + h * 4;
                const float qinv = gs[0], kinv = gs[1], beta = gs[2], eg = gs[3];
                float dk = 0.f;
#pragma unroll
                for (int i = 0; i < 128; ++i) dk += S[i] * k[i];
                const float u = beta * (vv - eg * kinv * dk) * kinv;
                float o = 0.f;
#pragma unroll
                for (int i = 0; i < 128; ++i) {
                    S[i] = S[i] * eg + u * k[i];
                    o += S[i] * q[i];
                }
                scr[N * SO_DO + n * 512 + h * 128 + v] = o * qinv;
            }
        } break;
        case ST_GDN_POST: {
            const long n = it / 4; const int h = (int)(it % 4);
            const float* o = scr + N * SO_DO + n * 512 + h * 128;
            float ms = 0.f;
            for (int i = 0; i < 128; ++i) ms += o[i] * o[i];
            const float rs = 1.0f / sqrtf(ms * (1.0f / 128) + 1e-6f);
            for (int i = 0; i < 128; ++i) {
                const float z = PF(n, C_GDN + 1536 + h * 128 + i);
                P.mix16[n * DM + 1536 + h * 128 + i] = f2bf(o[i] * rs * P.gdn_norm[l * 128 + i] * siluf_(z));
            }
        } break;
        case ST_SCORES: {
            const long n = it / 2048; const int c = (int)(it % 2048);
            const int hp = c / 128, key = c % 128;
            const float* q = P.qf + n * DM + hp * 128;
            const float* sk = P.peer_sub_keys + (long)l * 16 * 128 * 128 + ((long)hp * 128 + key) * 128;
            float s = 0.f;
            for (int d = 0; d < 128; ++d) s += q[d] * sk[d];
            P.sc[it] = s;
        } break;
        case ST_TOPK1: {
            const float* sc = P.sc + it * 128;
            float ts[16]; int ti[16];
#pragma unroll
            for (int j = 0; j < 16; ++j) { ts[j] = -3.0e38f; ti[j] = 0; }
            for (int i = 0; i < 128; ++i) {
                float xv = sc[i]; int xi = i;
                if (xv > ts[15]) {
#pragma unroll
                    for (int j = 0; j < 16; ++j) {
                        if (xv > ts[j]) { const float tv = ts[j]; const int tj = ti[j]; ts[j] = xv; ti[j] = xi; xv = tv; xi = tj; }
                    }
                }
            }
            float* TS = scr + N * SO_TS + it * 16;
            int* TI = (int*)(scr + N * SO_TI) + it * 16;
#pragma unroll
            for (int j = 0; j < 16; ++j) { TS[j] = ts[j]; TI[j] = ti[j]; }
        } break;
        case ST_TOPK2: {
            const float* s0 = scr + N * SO_TS + it * 32;
            const float* s1 = s0 + 16;
            const int* i0 = (const int*)(scr + N * SO_TI) + it * 32;
            const int* i1 = i0 + 16;
            float ts[16]; int ti[16];
#pragma unroll
            for (int j = 0; j < 16; ++j) { ts[j] = -3.0e38f; ti[j] = 0; }
            for (int a = 0; a < 16; ++a) {
                const int jmax = 16 / (a + 1);
                for (int b = 0; b < jmax; ++b) {
                    float xv = s0[a] + s1[b]; int xi = i0[a] * 128 + i1[b];
                    if (xv > ts[15]) {
#pragma unroll
                        for (int j = 0; j < 16; ++j) {
                            if (xv > ts[j]) { const float tv = ts[j]; const int tj = ti[j]; ts[j] = xv; ti[j] = xi; xv = tv; xi = tj; }
                        }
                    }
                }
            }
            const float mx = ts[0];
            float den = 0.f;
#pragma unroll
            for (int j = 0; j < 16; ++j) { ts[j] = expf(ts[j] - mx); den += ts[j]; }
            const float inv = 1.0f / den;
#pragma unroll
            for (int j = 0; j < 16; ++j) { P.gate[it * 16 + j] = ts[j] * inv; P.idx[it * 16 + j] = ti[j]; }
        } break;
        case ST_PEER_U: {
            const long n = it / 128;
            const int e = P.idx[it];
            const float* u = P.peer_u + ((long)l * NEXP + e) * DM;
            const bf16_t* hx = P.hb + n * DM;
            float s = 0.f;
            for (int d = 0; d < DM; ++d) s += bf2f(hx[d]) * u[d];
            P.act[it] = geluf_(s) * P.gate[it];
        } break;
        case ST_PEER_V: {
            const long n = it / DM; const int d = (int)(it % DM);
            const float* a = P.act + n * 128;
            const int* ix = P.idx + n * 128;
            float s = 0.f;
            for (int j = 0; j < 128; ++j) s += a[j] * P.peer_v[((long)l * NEXP + ix[j]) * DM + d];
            P.xcur[it] += s;
        } break;
    }
}


struct WsMap {
    size_t ctl, w1t, w2t, wsct, auxwt, lruwt, vreswt, pp, tabu, tabv, xn, hb, mix16, p16, sc, aux, vfirst, idx, gate, rstd, act, end;
    size_t auxA, zrkv, xc, auxo, gates, vres, glao, gdno, gq, gk, gv, gsc, rwy, rwbv, lrs, gblob;
    size_t scr, qf;
};
HD WsMap ws_map(size_t N) {
    WsMap m{};
    size_t o = 0;
    auto take = [&](size_t bytes) { size_t r = o; o += (bytes + 4095) & ~(size_t)4095; return r; };
    m.ctl = take(1u << 20);
    m.w1t = take((size_t)NL * PLD * DM * 2);
    m.w2t = take((size_t)NL * DM * DM * 2);
    m.wsct = take((size_t)NL * DM * DM * 2);
    m.auxwt = take((size_t)NL * 1792 * 384 * 2);
    m.lruwt = take((size_t)NL * 1024 * 512 * 2);
    m.vreswt = take((size_t)512 * 512 * 2);
    m.pp = take(1u << 20);
    m.xn = take(N * DM * 2);
    m.hb = take(N * DM * 2);
    m.mix16 = take(N * DM * 2);
    m.p16 = take(N * PLD * 2);
    m.sc = m.p16;
    m.vfirst = take(N * 512 * 4);
    m.idx = take(N * 128 * 4);
    m.gate = take(N * 128 * 4);
    m.act = take(N * 128 * 4);
    m.rstd = take(N * 4);
    m.tabu = take((size_t)NL * 2 * NEXP * DM);
    m.tabv = m.tabu + (size_t)NEXP * DM;
    m.aux = take(N * 5488 * 4);
    m.end = o;
    size_t a = m.aux;
    auto sub = [&](size_t bytes) { size_t r = a; a += (bytes + 4095) & ~(size_t)4095; return r; };
    m.auxA = sub(N * 384 * 2); m.zrkv = sub(N * 1536 * 2); m.xc = sub(N * 512 * 2); m.auxo = sub(N * 1792 * 2);
    m.gates = sub(N * 1024 * 2); m.vres = sub(N * 512 * 2); m.glao = sub(N * 512 * 2); m.gdno = sub(N * 512 * 2);
    m.gq = sub(N * 512 * 2); m.gk = sub(N * 512 * 2); m.gv = sub(N * 512 * 2); m.gsc = sub(N * 8 * 4); m.rwy = sub(N * 512 * 2); m.rwbv = sub(N * 512 * 2); m.lrs = sub(N / 64 * 512 * 2 * 4);
    m.gblob = sub(N / 64 * 4 * 18688);
    m.scr = m.tabu;
    m.qf = m.aux + N * 1024 * 4;
    return m;
}
static inline void bind_ws(Params& P, char* ws) {
    const WsMap m = ws_map((size_t)P.N);
    P.xn = (bf16_t*)(ws + m.xn); P.hb = (bf16_t*)(ws + m.hb); P.mix16 = (bf16_t*)(ws + m.mix16); P.p16 = (bf16_t*)(ws + m.p16);
    P.sc = (float*)(ws + m.sc); P.qf = (float*)(ws + m.qf); P.rstd = (float*)(ws + m.rstd); P.vfirst = (float*)(ws + m.vfirst);
    P.scr = (float*)(ws + m.scr); P.act = (float*)(ws + m.act); P.gate = (float*)(ws + m.gate); P.idx = (int*)(ws + m.idx);
}

struct Step { int st, l; };
static inline int build_schedule(Step* s) {
    int n = 0;
    s[n++] = {ST_COPYX, 0};
    for (int l = 0; l < NL; ++l) {
        static const int per_layer[] = {ST_RSTD, ST_NORM1, ST_GEMM1,
            ST_RW_A0, ST_RW_A1, ST_RW_A2, ST_RW_A3, ST_RW_KKN, ST_RW_SCAN, ST_RW_POST,
            ST_GLA_B0, ST_GLA_SCAN, ST_GLA_POST, ST_LRU_C0, ST_LRU_C1, ST_LRU_SCAN,
            ST_GDN_D0, ST_GDN_D1, ST_GDN_SCAN, ST_GDN_POST,
            ST_GEMM2, ST_RSTD2, ST_NORM2, ST_GEMM3, ST_SCORES, ST_TOPK1, ST_TOPK2, ST_PEER_U, ST_PEER_V};
        for (int i = 0; i < (int)(sizeof(per_layer) / sizeof(int)); ++i) s[n++] = {per_layer[i], l};
    }
    s[n++] = {ST_FRSTD, 0};
    s[n++] = {ST_FNORM, 0};
    return n;
}

static inline void fill_inputs(Params& P, void* const* d_in) {
    const float** dst = (const float**)&P;
    for (int i = 0; i < 38; ++i) dst[i] = (const float*)d_in[i];
}

#ifndef HOST_EMU
#define GAS __attribute__((address_space(1)))
#define LAS __attribute__((address_space(3)))
typedef unsigned v4u __attribute__((ext_vector_type(4)));
typedef unsigned v2u __attribute__((ext_vector_type(2)));
typedef float f32x4 __attribute__((ext_vector_type(4)));
typedef float f32x2 __attribute__((ext_vector_type(2)));
typedef short bf16x8 __attribute__((ext_vector_type(8)));
constexpr int NWAVES = 8, NTHR = 512;
constexpr int RING_BYTES = 131072, MISC_OFF = RING_BYTES + 320, LDS_BYTES = 147456;
constexpr int NTOK = 16384, TSEQ = 4096, NBATCH = 4;

__device__ __forceinline__ unsigned pk2(float lo, float hi) { return (unsigned)f2bf(lo) | ((unsigned)f2bf(hi) << 16); }
__device__ __forceinline__ float bflo(unsigned u) { return __builtin_bit_cast(float, u << 16); }
__device__ __forceinline__ float bfhi(unsigned u) { return __builtin_bit_cast(float, u & 0xffff0000u); }
__device__ __forceinline__ float wave_sum(float v) {
#pragma unroll
    for (int o = 1; o < 64; o <<= 1) v += __shfl_xor(v, o);
    return v;
}
#define LDS_WAIT() asm volatile("s_waitcnt lgkmcnt(0)" ::: "memory")
#define VM_WAIT() asm volatile("s_waitcnt vmcnt(0)" ::: "memory")

namespace pg8 {
#define PG8_LAS __attribute__((address_space(3)))
constexpr int BM = 256, BK = 64, HALF = 128, HTB = HALF * BK * 2, STAGE_BYTES = 8 * HTB, NXCD = 8, WGM = 8;
__host__ __device__ __forceinline__ int lds_byte(int r, int c) { const int st = (r >> 4) * 2 + (c >> 5), rr = r & 15, cc = c & 31, ob = rr * 64 + cc * 2; return st * 1024 + (ob ^ (((ob >> 9) & 1) << 5)); }
__host__ __device__ __forceinline__ void stage_rc(int b, int& R, int& C) { const int st = b / 1024, sb = b % 1024, swz = sb ^ (((sb >> 9) & 1) << 5); R = (st >> 1) * 16 + swz / 64; C = (st & 1) * 32 + (swz % 64) / 2; }
__host__ __device__ __forceinline__ int perm32(int rho) { const int n = rho >> 4, i = rho & 15; return 8 * (i >> 2) + 4 * n + (i & 3); }
struct Unit { int pm, pn; };
struct GemmX { const bf16_t* A; const bf16_t* Bt; int M, N, K, lda; };
struct StaticOrder {
    int nM, nN, nwg, G, c;
    __host__ __device__ void init(int M, int N, int G_, int c_) { nM = M / BM; nN = N / BM; nwg = nM * nN; G = G_; c = c_; }
    __host__ __device__ bool next(int i, Unit& u) const {
        const long L = (long)i * G + c; if (L >= nwg) return false;
        int wgid = (int)L; { const int q = nwg / NXCD, r = nwg % NXCD, xcd = wgid % NXCD, off = wgid / NXCD; wgid = (xcd < r ? xcd * (q + 1) : r * (q + 1) + (xcd - r) * q) + off; }
        const int nig = WGM * nN, gid = wgid / nig, fm = gid * WGM, gsz = (nM - fm) < WGM ? (nM - fm) : WGM;
        u.pm = fm + ((wgid % nig) % gsz); u.pn = (wgid % nig) / gsz; return true;
    }
    __device__ __forceinline__ void a_ready(const Unit&) const {}
    __device__ __forceinline__ void done(const Unit&) const {}
};
__device__ __forceinline__ unsigned cvt_pk_bf16(float lo, float hi) { unsigned r; asm volatile("v_cvt_pk_bf16_f32 %0, %1, %2" : "=v"(r) : "v"(lo), "v"(hi)); return r; }
template <bool ACCUM> struct EpiF32 {
    static constexpr bool PERM = false, AFTER_DRAIN = false;
    float* C; int ldc;
    __device__ __forceinline__ void operator()(const f32x4 (&acc)[2][2][4][2], const Unit& u, int wr, int wc, int fr, int fq) const {
        const int row0 = u.pm * BM + wr * 64 + fr, col0 = u.pn * BM + wc * 32 + 4 * fq;
#pragma unroll
        for (int ai = 0; ai < 2; ++ai)
#pragma unroll
            for (int m = 0; m < 4; ++m) { float* rowp = C + (size_t)(row0 + ai * HALF + m * 16) * ldc + col0;
#pragma unroll
                for (int bj = 0; bj < 2; ++bj)
#pragma unroll
                    for (int n = 0; n < 2; ++n) { f32x4* p = (f32x4*)(rowp + bj * HALF + n * 16);
                        if (ACCUM) *p = *p + acc[ai][bj][m][n]; else *p = acc[ai][bj][m][n]; } }
    }
};
struct EpiBf16 {
    static constexpr bool PERM = true, AFTER_DRAIN = false;
    bf16_t* O; int ldc; const float* bias;
    __device__ __forceinline__ void operator()(const f32x4 (&acc)[2][2][4][2], const Unit& u, int wr, int wc, int fr, int fq) const {
        const int row0 = u.pm * BM + wr * 64 + fr; const int col0 = u.pn * BM + wc * 32 + 8 * fq;
        f32x4 bv[2][2];
#pragma unroll
        for (int bj = 0; bj < 2; ++bj)
#pragma unroll
            for (int n = 0; n < 2; ++n) bv[bj][n] = bias ? *(const f32x4*)(bias + col0 + bj * HALF + 4 * n) : (f32x4){0.f, 0.f, 0.f, 0.f};
#pragma unroll
        for (int ai = 0; ai < 2; ++ai)
#pragma unroll
            for (int m = 0; m < 4; ++m) { bf16_t* rowp = O + (size_t)(row0 + ai * HALF + m * 16) * ldc + col0;
#pragma unroll
                for (int bj = 0; bj < 2; ++bj) { const f32x4 v0 = acc[ai][bj][m][0] + bv[bj][0], v1 = acc[ai][bj][m][1] + bv[bj][1];
                    v4u w; w.x = cvt_pk_bf16(v0[0], v0[1]); w.y = cvt_pk_bf16(v0[2], v0[3]); w.z = cvt_pk_bf16(v1[0], v1[1]); w.w = cvt_pk_bf16(v1[2], v1[3]);
                    *(v4u*)(rowp + bj * HALF) = w; } }
    }
};
template <class Epi, class Sched, bool ALIGN_EPI = false, bool SP2 = false>
__device__ __forceinline__ void gemm_phase(PG8_LAS unsigned char* lds, const GemmX g, const Sched& S, const Epi& E) {
    const int tid = threadIdx.x, wid = __builtin_amdgcn_readfirstlane(tid >> 6), lane = tid & 63, wr = wid >> 2, wc = wid & 3, fr = lane & 15, fq = lane >> 4;
    const int K = g.K, nt = K / BK;
    unsigned voffA[2], voffB[2];
#pragma unroll
    for (int i = 0; i < 2; ++i) { int R, C; stage_rc(tid * 16 + i * 8192, R, C); const int Rb = Epi::PERM ? ((R & ~31) + perm32(R & 31)) : R;
        voffA[i] = (unsigned)(R * g.lda + C) * 2u; voffB[i] = (unsigned)(Rb * K + C) * 2u; }
    const size_t kstep = (size_t)(BK * 2);
    const size_t hstep = (size_t)HALF * K * 2;
    const size_t tstep = 2 * hstep;
    const size_t hstepA = (size_t)HALF * g.lda * 2, tstepA = 2 * hstepA;
    const unsigned ldsw = (unsigned)wid * 1024u;
    const int aoff = lds_byte(wr * 64 + fr, fq * 8), boff = lds_byte(wc * 32 + fr, fq * 8);
#define PG8_SA(b, h) (((b) * 2 + (h)) * HTB)
#define PG8_SB(b, h) ((4 + (b) * 2 + (h)) * HTB)
#define PG8_STAGE(bufoff, gbase, voff) do { _Pragma("unroll") for (int _i = 0; _i < 2; ++_i) \
        __builtin_amdgcn_global_load_lds((const unsigned*)((const char*)(gbase) + (voff)[_i]), (PG8_LAS unsigned*)(lds + (bufoff) + ldsw + _i * 8192), 16, 0, 0); } while (0)
#define PG8_LDA(dst, b, h) do { _Pragma("unroll") for (int m = 0; m < 4; ++m) _Pragma("unroll") for (int k = 0; k < 2; ++k) dst[m][k] = *(const PG8_LAS bf16x8*)(lds + PG8_SA(b, h) + aoff + m * 2048 + k * 1024); } while (0)
#define PG8_LDB(dst, b, h) do { _Pragma("unroll") for (int n = 0; n < 2; ++n) _Pragma("unroll") for (int k = 0; k < 2; ++k) dst[n][k] = *(const PG8_LAS bf16x8*)(lds + PG8_SB(b, h) + boff + n * 2048 + k * 1024); } while (0)
#define PG8_MMA(ai, bj, At, Bt) do { __builtin_amdgcn_s_setprio(1); _Pragma("unroll") for (int m = 0; m < 4; ++m) _Pragma("unroll") for (int n = 0; n < 2; ++n) _Pragma("unroll") for (int k = 0; k < 2; ++k) \
        acc[ai][bj][m][n] = __builtin_amdgcn_mfma_f32_16x16x32_bf16(Bt[n][k], At[m][k], acc[ai][bj][m][n], 0, 0, 0); __builtin_amdgcn_s_setprio(0); } while (0)
#define PG8_WAIT_V(n) asm volatile("s_waitcnt vmcnt(" #n ")" ::: "memory")
#define PG8_WAIT_L(n) asm volatile("s_waitcnt lgkmcnt(" #n ")" ::: "memory")
#define PG8_BAR __builtin_amdgcn_s_barrier()
#define PG8_SCHED __builtin_amdgcn_sched_barrier(0)
    Unit cur, nxt; int ui = 0;
    if (!S.next(0, cur)) return;
    f32x4 acc[2][2][4][2];
#pragma unroll
    for (int a = 0; a < 2; ++a)
#pragma unroll
        for (int b = 0; b < 2; ++b)
#pragma unroll
            for (int m = 0; m < 4; ++m)
#pragma unroll
                for (int n = 0; n < 2; ++n) acc[a][b][m][n] = (f32x4){0.f, 0.f, 0.f, 0.f};
    bf16x8 At[4][2], B0[2][2], B1[2][2];
    const char* cA = (const char*)g.A + (size_t)cur.pm * tstepA; const char* cB = (const char*)g.Bt + (size_t)cur.pn * tstep;
    S.a_ready(cur);
    if constexpr (SP2) {
        PG8_STAGE(PG8_SB(0, 0), cB, voffB); PG8_STAGE(PG8_SB(0, 1), cB + hstep, voffB); PG8_STAGE(PG8_SA(0, 0), cA, voffA); PG8_STAGE(PG8_SA(0, 1), cA + hstepA, voffA);
        if (wr == 1) PG8_BAR;
        PG8_WAIT_V(2); PG8_BAR;
        PG8_STAGE(PG8_SB(1, 0), cB + kstep, voffB); PG8_STAGE(PG8_SA(1, 0), cA + kstep, voffA); PG8_STAGE(PG8_SB(1, 1), cB + hstep + kstep, voffB);
        PG8_WAIT_V(6); PG8_BAR;
    } else {
        PG8_STAGE(PG8_SB(0, 0), cB, voffB); PG8_STAGE(PG8_SA(0, 0), cA, voffA); PG8_STAGE(PG8_SB(0, 1), cB + hstep, voffB); PG8_STAGE(PG8_SA(0, 1), cA + hstepA, voffA);
        if (wr == 1) PG8_BAR;
        PG8_WAIT_V(4); PG8_BAR;
        PG8_STAGE(PG8_SB(1, 0), cB + kstep, voffB); PG8_STAGE(PG8_SA(1, 0), cA + kstep, voffA); PG8_STAGE(PG8_SB(1, 1), cB + hstep + kstep, voffB);
        PG8_WAIT_V(6); PG8_BAR;
    }
    for (;;) {
        const bool has_next = S.next(ui + 1, nxt);
        const char* nA = has_next ? (const char*)g.A + (size_t)nxt.pm * tstepA : cA; const char* nB = has_next ? (const char*)g.Bt + (size_t)nxt.pn * tstep : cB;
        for (int t = 0; t < nt; t += 2) {
            const bool last = (t == nt - 2);
            const char* a1 = cA + (size_t)(t + 1) * kstep;
            const char* a2 = last ? nA : cA + (size_t)(t + 2) * kstep; const char* b2 = last ? nB : cB + (size_t)(t + 2) * kstep;
            const char* a3 = a2 + kstep; const char* b3 = b2 + kstep;
            if (last && has_next) S.a_ready(nxt);
            if constexpr (SP2) {
            PG8_LDB(B0, 0, 0); PG8_LDB(B1, 0, 1); PG8_SCHED; PG8_LDA(At, 0, 0); PG8_STAGE(PG8_SA(1, 1), a1 + hstepA, voffA);
            PG8_WAIT_V(8); PG8_WAIT_L(0); PG8_BAR; PG8_MMA(0, 0, At, B0); PG8_MMA(0, 1, At, B1); PG8_BAR; PG8_SCHED;
            PG8_LDA(At, 0, 1); PG8_STAGE(PG8_SB(0, 0), b2, voffB); PG8_STAGE(PG8_SB(0, 1), b2 + hstep, voffB); PG8_STAGE(PG8_SA(0, 0), a2, voffA);
            PG8_WAIT_V(8); PG8_WAIT_L(0); PG8_BAR; PG8_MMA(1, 0, At, B0); PG8_MMA(1, 1, At, B1); PG8_BAR; PG8_SCHED;
            PG8_LDB(B0, 1, 0); PG8_LDB(B1, 1, 1); PG8_SCHED; PG8_LDA(At, 1, 0); PG8_STAGE(PG8_SA(0, 1), a2 + hstepA, voffA);
            PG8_WAIT_V(8); PG8_WAIT_L(0); PG8_BAR; PG8_MMA(0, 0, At, B0); PG8_MMA(0, 1, At, B1); PG8_BAR; PG8_SCHED;
            PG8_LDA(At, 1, 1); PG8_STAGE(PG8_SB(1, 0), b3, voffB); PG8_STAGE(PG8_SB(1, 1), b3 + hstep, voffB); PG8_STAGE(PG8_SA(1, 0), a3, voffA);
            PG8_WAIT_V(8); PG8_WAIT_L(0); PG8_BAR; PG8_MMA(1, 0, At, B0); PG8_MMA(1, 1, At, B1); PG8_BAR; PG8_SCHED;
            } else {
            PG8_LDB(B0, 0, 0); PG8_SCHED; PG8_LDA(At, 0, 0); PG8_STAGE(PG8_SA(1, 1), a1 + hstepA, voffA);
            PG8_WAIT_L(8); PG8_BAR; PG8_WAIT_L(0); PG8_MMA(0, 0, At, B0); PG8_BAR; PG8_SCHED;
            PG8_LDB(B1, 0, 1); PG8_STAGE(PG8_SB(0, 0), b2, voffB);
            PG8_BAR; PG8_WAIT_L(0); PG8_MMA(0, 1, At, B1); PG8_BAR;
            PG8_LDA(At, 0, 1); PG8_STAGE(PG8_SA(0, 0), a2, voffA);
            PG8_BAR; PG8_WAIT_L(0); PG8_MMA(1, 0, At, B0); PG8_BAR; PG8_SCHED;
            PG8_STAGE(PG8_SB(0, 1), b2 + hstep, voffB);
            PG8_WAIT_V(6); PG8_BAR; PG8_MMA(1, 1, At, B1); PG8_BAR;
            PG8_LDB(B0, 1, 0); PG8_SCHED; PG8_LDA(At, 1, 0); PG8_STAGE(PG8_SA(0, 1), a2 + hstepA, voffA);
            PG8_WAIT_L(8); PG8_BAR; PG8_WAIT_L(0); PG8_MMA(0, 0, At, B0); PG8_BAR; PG8_SCHED;
            PG8_LDB(B1, 1, 1); PG8_STAGE(PG8_SB(1, 0), b3, voffB);
            PG8_BAR; PG8_WAIT_L(0); PG8_MMA(0, 1, At, B1); PG8_BAR;
            PG8_LDA(At, 1, 1); PG8_STAGE(PG8_SA(1, 0), a3, voffA);
            PG8_BAR; PG8_WAIT_L(0); PG8_MMA(1, 0, At, B0); PG8_BAR; PG8_SCHED;
            PG8_STAGE(PG8_SB(1, 1), b3 + hstep, voffB);
            PG8_WAIT_V(6); PG8_BAR; PG8_MMA(1, 1, At, B1); PG8_BAR;
            }
        }
        if constexpr (ALIGN_EPI) { if (wr == 0) PG8_BAR; }
        if constexpr (!Epi::AFTER_DRAIN) { E(acc, cur, wr, wc, fr, fq); S.done(cur); }
        if (!has_next) break;
#pragma unroll
        for (int a = 0; a < 2; ++a)
#pragma unroll
            for (int b = 0; b < 2; ++b)
#pragma unroll
                for (int m = 0; m < 4; ++m)
#pragma unroll
                    for (int n = 0; n < 2; ++n) acc[a][b][m][n] = (f32x4){0.f, 0.f, 0.f, 0.f};
        cur = nxt; cA = nA; cB = nB; ++ui;
        if constexpr (ALIGN_EPI) { if (wr == 1) PG8_BAR; }
    }
    PG8_WAIT_V(0);
    if constexpr (!ALIGN_EPI) { if (wr == 0) PG8_BAR; }
    PG8_BAR;
    if constexpr (Epi::AFTER_DRAIN) { E.fused(acc, cur, wr, wc, fr, fq, lds, wid, lane); S.done(cur); }
#undef PG8_SA
#undef PG8_SB
#undef PG8_STAGE
#undef PG8_LDA
#undef PG8_LDB
#undef PG8_MMA
#undef PG8_WAIT_V
#undef PG8_WAIT_L
#undef PG8_BAR
#undef PG8_SCHED
}
}

#define XB_TMO      128
#define XB_XCNT(j)  (256  + 64 * (j))
#define XB_XSUB(j)  (1280 + 64 * (j))
#define XB_XGEN(j)  (2304 + 64 * (j))
#define XB_TOP      3328
#define XB_TOPGEN   3392
#define XCD_BAR_WORDS 3456
#define XB_SPIN_CAP (1u << 20)
__device__ __forceinline__ unsigned xb_ld(unsigned* p) { return __hip_atomic_load(p, __ATOMIC_RELAXED, __HIP_MEMORY_SCOPE_AGENT); }
__device__ __forceinline__ unsigned xb_add(unsigned* p, unsigned v) { return __hip_atomic_fetch_add(p, v, __ATOMIC_RELAXED, __HIP_MEMORY_SCOPE_AGENT); }
__device__ __forceinline__ unsigned xb_xcc_id() { return (unsigned)__builtin_amdgcn_s_getreg((3 << 11) | 20) & 0xFu; }
#define XB_SPIN(cond, bar) do { unsigned _sp = 0; while (cond) { __builtin_amdgcn_s_sleep(1); \
    if ((++_sp & 255u) == 0u) { if (xb_ld(&(bar)[XB_TMO])) break; if (_sp > XB_SPIN_CAP) { atomicAdd(&(bar)[XB_TMO], 1u); break; } } } } while (0)
struct XcdBarrier { unsigned* bar; unsigned x; volatile LAS unsigned* st; };
__device__ __forceinline__ XcdBarrier xcd_barrier_post(unsigned* bar, volatile LAS unsigned* st) {
    XcdBarrier b; b.bar = bar; b.x = xb_xcc_id(); b.st = st;
    if (threadIdx.x == 0) (void)xb_add(&bar[XB_XCNT(b.x)], 1u);
    return b;
}
__device__ __forceinline__ void xcd_barrier_complete(unsigned* bar, unsigned x, unsigned& nloc, unsigned& nx) {
    const unsigned G = gridDim.x * gridDim.y * gridDim.z;
    unsigned sum, cnt, mine, sp = 0u;
    for (;;) {
        sum = 0u; cnt = 0u; mine = 0u;
#pragma unroll
        for (unsigned j = 0; j < 16; ++j) { const unsigned c = xb_ld(&bar[XB_XCNT(j)]); sum += c; cnt += (c > 0u) ? 1u : 0u; mine = (j == x) ? c : mine; }
        if (sum == G) break;
        __builtin_amdgcn_s_sleep(1);
        if ((++sp & 255u) == 0u) { if (xb_ld(&bar[XB_TMO])) break; if (sp > XB_SPIN_CAP) { atomicAdd(&bar[XB_TMO], 1u); break; } }
    }
    nloc = mine > 0u ? mine : 1u; nx = cnt > 0u ? cnt : 1u;
}
__device__ __forceinline__ void xcd_barrier(const XcdBarrier& b) {
    asm volatile("s_waitcnt vmcnt(0)" ::: "memory");
    __syncthreads();
    if (threadIdx.x == 0) {
        unsigned* bar = b.bar;
        __builtin_amdgcn_s_waitcnt(0);
        unsigned nloc = b.st[0], nx = b.st[1];
        if (nloc == 0u) { xcd_barrier_complete(bar, b.x, nloc, nx); b.st[0] = nloc; b.st[1] = nx; }
        const unsigned old = xb_add(&bar[XB_XSUB(b.x)], 1u);
        const unsigned gen = old / nloc;
        if (old + 1u == (gen + 1u) * nloc) {
            __builtin_amdgcn_fence(__ATOMIC_RELEASE, "agent");
            asm volatile("s_waitcnt vmcnt(0)" ::: "memory");
            const unsigned og = xb_add(&bar[XB_TOP], 1u);
            const unsigned tg = og / nx;
            if (og + 1u == (tg + 1u) * nx) xb_add(&bar[XB_TOPGEN], 1u);
            else XB_SPIN(xb_ld(&bar[XB_TOPGEN]) == tg, bar);
            __builtin_amdgcn_fence(__ATOMIC_ACQUIRE, "agent");
            xb_add(&bar[XB_XGEN(b.x)], 1u);
            asm volatile("s_waitcnt vmcnt(0)" ::: "memory");
        } else {
            XB_SPIN(xb_ld(&bar[XB_XGEN(b.x)]) == gen, bar);
            __builtin_amdgcn_fence(__ATOMIC_ACQUIRE, "agent");
            asm volatile("s_waitcnt vmcnt(0)" ::: "memory");
        }
    }
    __syncthreads();
}

struct Args { const float* in[38]; float* out; unsigned char* ws; int ph_lo, ph_hi, li, pad; };
enum InputId { I_X = 0, I_NORM_MIX, I_W_IN, I_W_OUT, I_RW_MU, I_RW_W0, I_RW_W_UP, I_RW_A0, I_RW_A_UP, I_RW_G_UP, I_RW_K_K, I_RW_K_A, I_RW_R_K,
    I_RW_LN_W, I_RW_LN_B, I_RW_V0, I_RW_V_DOWN, I_RW_V_UP, I_GLA_A_UP, I_GLA_A_BIAS, I_GLA_NORM, I_LRU_CONV_W, I_LRU_CONV_B, I_LRU_W_R,
    I_LRU_B_R, I_LRU_W_I, I_LRU_B_I, I_LRU_LAM, I_GDN_CONV_W, I_GDN_A_LOG, I_GDN_DT_BIAS, I_GDN_NORM, I_NORM_FFN, I_PEER_WQ, I_PEER_SK,
    I_PEER_U, I_PEER_V, I_NORM_FINAL };
enum { PH_P0 = 0, PH_GEMM1 = 1, PH_PREP = 2, PH_AUX = 3, PH_SCAN = 4, PH_POST = 5, PH_GEMM2 = 6, PH_NORM2 = 7, PH_GEMM3 = 8, PH_TOPK = 9, PH_PEER = 10, PH_PER_LAYER = 10, PH_TOTAL = 21 };

struct Frame {
    LAS unsigned char* lds;
    int tid, lane, wave, vcu, G;
    int gw, ngw;
};

__device__ __forceinline__ void p0_transpose_item(const float* W, int K, int N, const float* kscale, bf16_t* WT, LAS float* scr, int item, int nblk, int lane) {
    const int kb = item / nblk, nb = item % nblk, k0 = 64 * kb, n0 = 32 * nb;
    const int nn = n0 + (lane & 31);
#pragma unroll 8
    for (int i = 0; i < 32; ++i) { const int kk = 2 * i + (lane >> 5);
        float v = nn < N ? W[(size_t)(k0 + kk) * N + nn] : 0.f;
        if (kscale) v *= kscale[k0 + kk];
        scr[kk * 33 + (lane & 31)] = v; }
    LDS_WAIT(); asm volatile("" ::: "memory");
    const int c = lane & 7;
#pragma unroll
    for (int j = 0; j < 4; ++j) { const int n = (lane >> 3) + 8 * j; const LAS float* s = scr + (8 * c) * 33 + n;
        v4u o; o.x = pk2(s[0 * 33], s[1 * 33]); o.y = pk2(s[2 * 33], s[3 * 33]); o.z = pk2(s[4 * 33], s[5 * 33]); o.w = pk2(s[6 * 33], s[7 * 33]);
        *(v4u*)(WT + (size_t)(n0 + n) * K + k0 + 8 * c) = o; }
    LDS_WAIT(); asm volatile("" ::: "memory");
}

__device__ __forceinline__ void p0_prologue(const Args& a, Frame& F) {
    const WsMap m = ws_map(NTOK);
    unsigned char* ws = a.ws;
    LAS float* scr = (LAS float*)(F.lds + F.wave * 16384);
    const int gw = F.gw, NGW = F.ngw, lane = F.lane;
    for (int n = gw; n < NTOK; n += NGW) {
        const f32x4* xr = (const f32x4*)(a.in[I_X] + (size_t)n * DM) + lane;
        f32x4 v[8]; float s = 0.f;
#pragma unroll
        for (int j = 0; j < 8; ++j) { v[j] = xr[64 * j]; s += (v[j].x * v[j].x + v[j].y * v[j].y) + (v[j].z * v[j].z + v[j].w * v[j].w); }
        const float rstd = 1.0f / sqrtf(wave_sum(s) * (1.0f / DM) + 1e-6f);
        f32x4* xo = (f32x4*)(a.out + (size_t)n * DM) + lane;
        v2u* o8 = (v2u*)((bf16_t*)(ws + m.xn) + (size_t)n * DM) + lane;
#pragma unroll
        for (int j = 0; j < 8; ++j) { xo[64 * j] = v[j]; v2u w; w.x = pk2(v[j].x * rstd, v[j].y * rstd); w.y = pk2(v[j].z * rstd, v[j].w * rstd); o8[64 * j] = w; }
    }
    {
        constexpr int I1 = (DM / 64) * (PLD / 32), I2 = (DM / 64) * (DM / 32);
        for (int it = gw; it < NL * (I1 + I2); it += NGW) {
            const int l = it / (I1 + I2); int r = it % (I1 + I2);
            if (r < I1) p0_transpose_item(a.in[I_W_IN] + (size_t)l * DM * INC, DM, INC, a.in[I_NORM_MIX] + l * DM, (bf16_t*)(ws + m.w1t) + (size_t)l * PLD * DM, scr, r, PLD / 32, lane);
            else p0_transpose_item(a.in[I_W_OUT] + (size_t)l * DM * DM, DM, DM, nullptr, (bf16_t*)(ws + m.w2t) + (size_t)l * DM * DM, scr, r - I1, DM / 32, lane);
        }
    }
    for (int it = gw; it < NL * 16 * 64; it += NGW) {
        const int l = it / 1024, hp = (it % 1024) / 64, kb = it % 64;
        const int dh = lane & 1, kk = kb * 32 + (lane >> 1);
        const float* wq = a.in[I_PEER_WQ] + (size_t)l * DM * DM + (size_t)kk * DM + hp * 128 + dh * 64;
        const float* sk = a.in[I_PEER_SK] + ((size_t)l * 16 + hp) * 128 * 128 + dh * 64;
        f32x4 q[16];
#pragma unroll
        for (int d = 0; d < 16; ++d) q[d] = *(const f32x4*)(wq + 4 * d);
        bf16_t* o = (bf16_t*)(ws + m.wsct) + (size_t)l * DM * DM + (size_t)(hp * 128) * DM + kk;
        for (int key = 0; key < 128; ++key) {
            const f32x4* s4 = (const f32x4*)(sk + key * 128);
            float acc = 0.f;
#pragma unroll
            for (int d = 0; d < 16; ++d) { const f32x4 sv = s4[d]; acc += (q[d].x * sv.x + q[d].y * sv.y) + (q[d].z * sv.z + q[d].w * sv.w); }
            acc += __shfl_xor(acc, 1);
            if (dh == 0) o[(size_t)key * DM] = f2bf(acc);
        }
    }
    {
        const int gt = F.vcu * NTHR + F.tid, GT = F.G * NTHR;
        bf16_t* AW = (bf16_t*)(ws + m.auxwt); bf16_t* LW = (bf16_t*)(ws + m.lruwt); bf16_t* VW = (bf16_t*)(ws + m.vreswt); float* PP = (float*)(ws + m.pp);
        for (int it = gt; it < NL * 1792 * 384; it += GT) {
            const int l = it / (1792 * 384), r = it % (1792 * 384), n = r / 384, k = r % 384;
            float v = 0.f;
            if (n < 512) { if (k < 64) v = a.in[I_RW_W_UP][(size_t)l * 64 * 512 + k * 512 + n]; }
            else if (n < 1024) { if (k >= 64 && k < 128) v = a.in[I_RW_A_UP][(size_t)l * 64 * 512 + (k - 64) * 512 + (n - 512)]; }
            else if (n < 1536) { if (k >= 128 && k < 256) v = a.in[I_RW_G_UP][(size_t)l * 128 * 512 + (k - 128) * 512 + (n - 1024)]; }
            else { if (k >= 256 && k < 272) v = a.in[I_GLA_A_UP][(size_t)l * 16 * 256 + (k - 256) * 256 + (n - 1536)]; }
            AW[it] = f2bf(v);
        }
        for (int it = gt; it < NL * 1024 * 512; it += GT) {
            const int l = it / (1024 * 512), r = it % (1024 * 512), n = r / 512, k = r % 512;
            const int nn = n & 511, blk = nn >> 6, j = nn & 63;
            float v = 0.f;
            if ((k >> 6) == blk) v = (n < 512 ? a.in[I_LRU_W_R] : a.in[I_LRU_W_I])[(size_t)l * 8 * 64 * 64 + (size_t)blk * 4096 + (k & 63) * 64 + j];
            LW[it] = f2bf(v);
        }
        for (int it = gt; it < 512 * 512; it += GT) {
            const int n = it / 512, k = it % 512;
            float s = 0.f;
            for (int i = 0; i < 32; ++i) s += a.in[I_RW_V_DOWN][k * 32 + i] * a.in[I_RW_V_UP][i * 512 + n];
            VW[it] = f2bf(s);
        }
        for (int it = gt; it < 6144; it += GT) {
            float v = 0.f;
            if (it < 3584) { const int l = it / 1792, c = it % 1792;
                v = c < 512 ? a.in[I_RW_W0][l * 512 + c] : (c < 1024 ? a.in[I_RW_A0][l * 512 + c - 512] : (c < 1536 ? 0.f : a.in[I_GLA_A_BIAS][l * 256 + c - 1536])); }
            else if (it < 5632) { const int l = (it - 3584) / 1024, c = (it - 3584) % 1024; v = c < 512 ? a.in[I_LRU_B_R][l * 512 + c] : a.in[I_LRU_B_I][l * 512 + c - 512]; }
            else v = a.in[I_RW_V0][it - 5632];
            PP[it] = v;
        }
    }
}

__device__ __forceinline__ unsigned pk4_fp8(float a, float b, float c, float d) {
    int w = 0;
    w = __builtin_amdgcn_cvt_pk_fp8_f32(__builtin_fmaxf(__builtin_fminf(a, 448.f), -448.f), __builtin_fmaxf(__builtin_fminf(b, 448.f), -448.f), w, false);
    w = __builtin_amdgcn_cvt_pk_fp8_f32(__builtin_fmaxf(__builtin_fminf(c, 448.f), -448.f), __builtin_fmaxf(__builtin_fminf(d, 448.f), -448.f), w, true);
    return (unsigned)w;
}
typedef float v32f __attribute__((ext_vector_type(32)));
typedef __bf16 v32bf __attribute__((ext_vector_type(32)));
typedef unsigned v6u __attribute__((ext_vector_type(6)));
constexpr size_t TROW = 1536;
__device__ __forceinline__ void tables_range(const Args& a, Frame& F, size_t it0, size_t it1, int sub, int nsub) {
    const WsMap m = ws_map(NTOK);
    const size_t per = (size_t)NEXP * DM / 32;
    const size_t stride = (size_t)nsub * NTHR;
    for (size_t base = it0 + (size_t)sub * NTHR + F.tid; base < it1; base += 2 * stride) {
        f32x4 v[2][8];
#pragma unroll
        for (int u = 0; u < 2; ++u) { const size_t it = base + u * stride;
            if (it < it1) { const int tb = (int)(it / per); const size_t r = it % per;
                const f32x4* srcp = (const f32x4*)(((tb & 1) ? a.in[I_PEER_V] : a.in[I_PEER_U]) + (size_t)(tb >> 1) * NEXP * DM + r * 32);
#pragma unroll
                for (int q = 0; q < 8; ++q) v[u][q] = __builtin_nontemporal_load(srcp + q); } }
#pragma unroll
        for (int u = 0; u < 2; ++u) { const size_t it = base + u * stride;
            if (it < it1) { const int tb = (int)(it / per); const size_t r = it % per; const float sc = (tb & 1) ? 4.0f : 64.0f;
                v32bf h;
#pragma unroll
                for (int q = 0; q < 8; ++q) {
                    h[4 * q + 0] = (__bf16)__builtin_fmaxf(__builtin_fminf(v[u][q].x * sc, 7.5f), -7.5f); h[4 * q + 1] = (__bf16)__builtin_fmaxf(__builtin_fminf(v[u][q].y * sc, 7.5f), -7.5f);
                    h[4 * q + 2] = (__bf16)__builtin_fmaxf(__builtin_fminf(v[u][q].z * sc, 7.5f), -7.5f); h[4 * q + 3] = (__bf16)__builtin_fmaxf(__builtin_fminf(v[u][q].w * sc, 7.5f), -7.5f); }
                const v6u p = __builtin_amdgcn_cvt_scalef32_pk32_fp6_bf16(h, 1.0f);
                v2u* dst = (v2u*)((unsigned char*)(a.ws + m.tabu) + (size_t)tb * NEXP * TROW + r * 24);
                dst[0] = (v2u){p[0], p[1]}; dst[1] = (v2u){p[2], p[3]}; dst[2] = (v2u){p[4], p[5]}; } }
    }
}

template <int CTRL> __device__ __forceinline__ float dpp_f(float v) { return __builtin_bit_cast(float, __builtin_amdgcn_update_dpp(0, __builtin_bit_cast(int, v), CTRL, 0xF, 0xF, true)); }
__device__ __forceinline__ float rdlane_f(float v, int l) { return __builtin_bit_cast(float, __builtin_amdgcn_readlane(__builtin_bit_cast(int, v), l)); }
__device__ __forceinline__ float row16_sum(float v) {
    v += dpp_f<0xB1>(v); v += dpp_f<0x4E>(v); v += dpp_f<0x141>(v); v += dpp_f<0x140>(v); return v;
}
__device__ __forceinline__ float wave_sum_u(float v) {
    v = row16_sum(v);
    return (rdlane_f(v, 0) + rdlane_f(v, 16)) + (rdlane_f(v, 32) + rdlane_f(v, 48));
}
typedef __bf16 bf16x2_t __attribute__((ext_vector_type(2)));
__device__ __forceinline__ float dot2bf(unsigned w, unsigned x, float acc) { return __builtin_amdgcn_fdot2_f32_bf16(__builtin_bit_cast(bf16x2_t, w), __builtin_bit_cast(bf16x2_t, x), acc, false); }
__device__ __forceinline__ float gelu_fast(float x) {
    const float u = 1.5957691216057308f * (x + 0.044715f * x * x * x);
    return x / (1.0f + __expf(-u));
}


__device__ __forceinline__ float sigm(float x) { return 1.0f / (1.0f + __expf(-x)); }
__device__ __forceinline__ float softplus_f(float x) { return __logf(1.0f + __expf(-fabsf(x))) + fmaxf(x, 0.0f); }
__device__ __forceinline__ float tanh_f(float x) { return 1.0f - 2.0f / (1.0f + __expf(2.0f * x)); }
__device__ __forceinline__ float red8(float v) { v += dpp_f<0xB1>(v); v += dpp_f<0x4E>(v); v += dpp_f<0x141>(v); return v; }
__device__ __forceinline__ v4u ld8(const bf16_t* p) { return *(const v4u*)p; }
__device__ __forceinline__ void unpack8(const v4u w, float (&f)[8]) { f[0] = bflo(w.x); f[1] = bfhi(w.x); f[2] = bflo(w.y); f[3] = bfhi(w.y); f[4] = bflo(w.z); f[5] = bfhi(w.z); f[6] = bflo(w.w); f[7] = bfhi(w.w); }
__device__ __forceinline__ v4u pack8(const float (&f)[8]) { v4u w; w.x = pk2(f[0], f[1]); w.y = pk2(f[2], f[3]); w.z = pk2(f[4], f[5]); w.w = pk2(f[6], f[7]); return w; }

__device__ __forceinline__ void prep_phase(const Args& a, Frame& F, int l) {
    const WsMap m = ws_map(NTOK);
    const bf16_t* p16 = (const bf16_t*)(a.ws + m.p16);
    bf16_t* zrkv = (bf16_t*)(a.ws + m.zrkv); bf16_t* auxA = (bf16_t*)(a.ws + m.auxA); bf16_t* xc = (bf16_t*)(a.ws + m.xc);
    const float* mu = a.in[I_RW_MU] + l * 1792;
    for (size_t it = (size_t)F.vcu * NTHR + F.tid; it < (size_t)NTOK * 304; it += (size_t)F.G * NTHR) {
        const int n = (int)(it / 304), j = (int)(it % 304), t = n % TSEQ;
        if (j < 224) {
            const int col = j * 8;
            float cur[8], prv[8], z[8];
            unpack8(ld8(p16 + (size_t)n * PLD + col), cur);
            if (t > 0) unpack8(ld8(p16 + (size_t)(n - 1) * PLD + col), prv);
            else {
#pragma unroll
                for (int k = 0; k < 8; ++k) prv[k] = 0.f; }
            const f32x4 m0 = *(const f32x4*)(mu + col), m1 = *(const f32x4*)(mu + col + 4);
            const float mm[8] = {m0.x, m0.y, m0.z, m0.w, m1.x, m1.y, m1.z, m1.w};
#pragma unroll
            for (int k = 0; k < 8; ++k) z[k] = cur[k] + (prv[k] - cur[k]) * mm[k];
            if (col < 1536) *(v4u*)(zrkv + (size_t)n * 1536 + col) = pack8(z);
            else {
                const int c = col - 1536;
#pragma unroll
                for (int k = 0; k < 8; ++k) z[k] = c < 64 ? tanh_f(z[k]) : (c < 128 ? z[k] : sigm(z[k]));
                *(v4u*)(auxA + (size_t)n * 384 + c) = pack8(z);
            }
        } else if (j < 240) {
            const int c = 256 + (j - 224) * 8;
            v4u w = (v4u){0u, 0u, 0u, 0u};
            if (c < 272) w = ld8(p16 + (size_t)n * PLD + C_GLA + 1536 + (c - 256));
            *(v4u*)(auxA + (size_t)n * 384 + c) = w;
        } else {
            const int c = (j - 240) * 8;
            float acc[8];
            { const f32x4 b0 = *(const f32x4*)(a.in[I_LRU_CONV_B] + l * 512 + c), b1 = *(const f32x4*)(a.in[I_LRU_CONV_B] + l * 512 + c + 4);
              acc[0] = b0.x; acc[1] = b0.y; acc[2] = b0.z; acc[3] = b0.w; acc[4] = b1.x; acc[5] = b1.y; acc[6] = b1.z; acc[7] = b1.w; }
#pragma unroll
            for (int jj = 0; jj < 4; ++jj) {
                if (t - 3 + jj >= 0) {
                    float xv[8]; unpack8(ld8(p16 + (size_t)(n - 3 + jj) * PLD + C_LRU + c), xv);
                    const float* cw = a.in[I_LRU_CONV_W] + (size_t)l * 4 * 512 + jj * 512 + c;
                    const f32x4 w0 = *(const f32x4*)cw, w1 = *(const f32x4*)(cw + 4);
                    acc[0] += w0.x * xv[0]; acc[1] += w0.y * xv[1]; acc[2] += w0.z * xv[2]; acc[3] += w0.w * xv[3];
                    acc[4] += w1.x * xv[4]; acc[5] += w1.y * xv[5]; acc[6] += w1.z * xv[6]; acc[7] += w1.w * xv[7];
                }
            }
            *(v4u*)(xc + (size_t)n * 512 + c) = pack8(acc);
        }
    }
    {
        bf16_t* gq = (bf16_t*)(a.ws + m.gq); bf16_t* gk = (bf16_t*)(a.ws + m.gk); bf16_t* gv = (bf16_t*)(a.ws + m.gv); float* gsc = (float*)(a.ws + m.gsc);
        const float* cw = a.in[I_GDN_CONV_W] + (size_t)l * 4 * 1536;
        const int lane = F.lane;
        for (int n = F.gw; n < NTOK; n += F.ngw) {
            const int t = n % TSEQ;
#pragma unroll
            for (int part = 0; part < 3; ++part) {
                const int cb = part * 512 + lane * 8;
                float acc[8];
#pragma unroll
                for (int k = 0; k < 8; ++k) acc[k] = 0.f;
#pragma unroll
                for (int jj = 0; jj < 4; ++jj) {
                    if (t - 3 + jj >= 0) {
                        float xv[8]; unpack8(ld8(p16 + (size_t)(n - 3 + jj) * PLD + C_GDN + cb), xv);
                        const f32x4 w0 = *(const f32x4*)(cw + jj * 1536 + cb), w1 = *(const f32x4*)(cw + jj * 1536 + cb + 4);
                        acc[0] += w0.x * xv[0]; acc[1] += w0.y * xv[1]; acc[2] += w0.z * xv[2]; acc[3] += w0.w * xv[3];
                        acc[4] += w1.x * xv[4]; acc[5] += w1.y * xv[5]; acc[6] += w1.z * xv[6]; acc[7] += w1.w * xv[7];
                    }
                }
                float ss = 0.f;
#pragma unroll
                for (int k = 0; k < 8; ++k) { acc[k] = acc[k] * sigm(acc[k]); ss += acc[k] * acc[k]; }
                if (part < 2) {
                    ss = row16_sum(ss);
                    const float inv = (1.0f / sqrtf(ss + 1e-6f)) * (part == 0 ? 0.08838834764831845f : 1.0f);
#pragma unroll
                    for (int k = 0; k < 8; ++k) acc[k] *= inv;
                }
                *(v4u*)((part == 0 ? gq : (part == 1 ? gk : gv)) + (size_t)n * 512 + lane * 8) = pack8(acc);
            }
            if (lane < 4) {
                gsc[(size_t)n * 8 + lane] = sigm(bf2f(p16[(size_t)n * PLD + C_GDN + 2048 + lane]));
                gsc[(size_t)n * 8 + 4 + lane] = -__expf(a.in[I_GDN_A_LOG][l * 4 + lane]) * softplus_f(bf2f(p16[(size_t)n * PLD + C_GDN + 2052 + lane]) + a.in[I_GDN_DT_BIAS][l * 4 + lane]);
            }
        }
    }
}

__device__ __forceinline__ float swz16(float v) { return __builtin_bit_cast(float, __builtin_amdgcn_ds_swizzle(__builtin_bit_cast(int, v), 0x401F)); }
__device__ __forceinline__ float red32(float v) { v = row16_sum(v); return v + swz16(v); }

__device__ __forceinline__ void rwkv_task(const Args& a, Frame& F, int l, int task) {
    const WsMap m = ws_map(NTOK);
    const int b = task >> 4, h = (task >> 1) & 7, hf = task & 1;
    LAS float* LR = (LAS float*)F.lds; LAS float* LW = LR + 2048; LAS float* LK = LW + 2048; LAS float* LA = LK + 2048; LAS float* LB = LA + 2048;
    LAS float* LV = LB + 2048; LAS float* LY = LV + 1024;
    const int lane = F.lane, w = F.wave, tid = F.tid;
    const int ch = h * 64 + lane;
    const bool mine = (lane >> 5) == hf;
    const float kk_ = a.in[I_RW_K_K][l * 512 + ch], ka_ = a.in[I_RW_K_A][l * 512 + ch], rk_ = a.in[I_RW_R_K][l * 512 + ch];
    const bf16_t* zr = (const bf16_t*)(a.ws + m.zrkv); const bf16_t* ao = (const bf16_t*)(a.ws + m.auxo); const bf16_t* vr = (const bf16_t*)(a.ws + m.vres);
    float* vf = (float*)(a.ws + m.vfirst); bf16_t* yo = (bf16_t*)(a.ws + m.rwy); bf16_t* bvo = (bf16_t*)(a.ws + m.rwbv);
    float S0 = 0.f, S1 = 0.f, S2 = 0.f, S3 = 0.f;
    const int row = tid >> 4, ks = tid & 15;
    float in_[4][7];
    auto load_chunk = [&](int c) {
#pragma unroll
        for (int q = 0; q < 4; ++q) { const size_t n = (size_t)b * TSEQ + c * 32 + w + 8 * q;
            in_[q][0] = bf2f(zr[n * 1536 + ch]); in_[q][1] = bf2f(zr[n * 1536 + 512 + ch]); in_[q][2] = bf2f(zr[n * 1536 + 1024 + ch]);
            in_[q][3] = bf2f(ao[n * 1792 + ch]); in_[q][4] = bf2f(ao[n * 1792 + 512 + ch]);
            if (l > 0) { in_[q][5] = bf2f(vr[n * 512 + ch]); in_[q][6] = vf[n * 512 + ch]; } else { in_[q][5] = 0.f; in_[q][6] = 0.f; } }
    };
    load_chunk(0);
    for (int c = 0; c < TSEQ / 32; ++c) {
#pragma unroll
        for (int q = 0; q < 4; ++q) {
            const int tl = w + 8 * q; const size_t n = (size_t)b * TSEQ + c * 32 + tl;
            const float zr_ = in_[q][0], zk_ = in_[q][1], zv_ = in_[q][2], wp = in_[q][3], ap = in_[q][4];
            float v = zv_;
            if (l == 0) { if (mine) vf[n * 512 + ch] = zv_; } else v = zv_ + (in_[q][6] - zv_) * sigm(in_[q][5]);
            const float w_raw = -softplus_f(-wp) - 0.5f, dec = __expf(-__expf(w_raw));
            const float aa = sigm(ap);
            const float kkraw = zk_ * kk_;
            const float ss = wave_sum_u(kkraw * kkraw);
            const float kk = kkraw * (1.0f / sqrtf(fmaxf(ss, 1e-24f)));
            const float km = zk_ * (1.0f + (aa - 1.0f) * ka_);
            const float bon = wave_sum_u(zr_ * km * rk_);
            LR[tl * 64 + lane] = zr_; LW[tl * 64 + lane] = dec; LK[tl * 64 + lane] = km; LA[tl * 64 + lane] = -kk; LB[tl * 64 + lane] = kk * aa;
            if (mine) { LV[tl * 32 + (lane & 31)] = v; bvo[n * 512 + ch] = f2bf(bon * v); }
        }
        __syncthreads();
        if (c + 1 < TSEQ / 32) load_chunk(c + 1);
        float keep0 = 0.f, keep1 = 0.f;
#pragma unroll 4
        for (int tl = 0; tl < 32; ++tl) {
            const int o = tl * 64 + ks * 4;
            const f32x4 a4 = *(const LAS f32x4*)(LA + o), w4 = *(const LAS f32x4*)(LW + o), b4 = *(const LAS f32x4*)(LB + o), k4 = *(const LAS f32x4*)(LK + o), r4 = *(const LAS f32x4*)(LR + o);
            const float vv = LV[tl * 32 + row];
            const float sa = row16_sum((S0 * a4.x + S1 * a4.y) + (S2 * a4.z + S3 * a4.w));
            S0 = S0 * w4.x + (sa * b4.x + vv * k4.x); S1 = S1 * w4.y + (sa * b4.y + vv * k4.y); S2 = S2 * w4.z + (sa * b4.z + vv * k4.z); S3 = S3 * w4.w + (sa * b4.w + vv * k4.w);
            const float y = row16_sum((S0 * r4.x + S1 * r4.y) + (S2 * r4.z + S3 * r4.w));
            keep0 = (ks == tl) ? y : keep0; keep1 = (ks + 16 == tl) ? y : keep1;
        }
        LY[ks * 32 + row] = keep0; LY[(16 + ks) * 32 + row] = keep1;
        __syncthreads();
        { const int tl = tid >> 4, r2 = (tid & 15) * 2; const size_t n = (size_t)b * TSEQ + c * 32 + tl;
          *(unsigned*)(yo + n * 512 + h * 64 + hf * 32 + r2) = pk2(LY[tl * 32 + r2], LY[tl * 32 + r2 + 1]); }
    }
}


__device__ __forceinline__ void chunk_cumsum8(float (&x)[8], LAS float* tmp, int lane, int w, int c8) {
#pragma unroll
    for (int d = 8; d < 64; d <<= 1) {
#pragma unroll
        for (int k = 0; k < 8; ++k) { const float t = __shfl_up(x[k], d); if (lane >= d) x[k] += t; }
    }
    if (lane >= 56) { *(LAS f32x4*)(tmp + w * 64 + c8) = (f32x4){x[0], x[1], x[2], x[3]}; *(LAS f32x4*)(tmp + w * 64 + c8 + 4) = (f32x4){x[4], x[5], x[6], x[7]}; }
    __syncthreads();
    for (int ww = 0; ww < w; ++ww) { const f32x4 a0 = *(const LAS f32x4*)(tmp + ww * 64 + c8), a1 = *(const LAS f32x4*)(tmp + ww * 64 + c8 + 4);
        x[0] += a0.x; x[1] += a0.y; x[2] += a0.z; x[3] += a0.w; x[4] += a1.x; x[5] += a1.y; x[6] += a1.z; x[7] += a1.w; }
}

constexpr int RWP = 72;
constexpr int RWT = 64 * RWP;
constexpr size_t RWB_TILES = 4 * RWT * 2;
constexpr size_t RWB_DVEC = RWB_TILES;
constexpr size_t RWB_VS = RWB_DVEC + 256;
constexpr size_t RWB_BYTES = RWB_VS + 4 * 3 * 64 * 16 * 2;

__device__ __forceinline__ f32x4 mm64(const LAS bf16_t* A, const LAS bf16_t* Bt, int mt, int nt, int lane, f32x4 acc) {
    const LAS bf16_t* ap = A + (mt * 16 + (lane & 15)) * RWP + (lane >> 4) * 8;
    const LAS bf16_t* bp = Bt + (nt * 16 + (lane & 15)) * RWP + (lane >> 4) * 8;
#pragma unroll
    for (int k0 = 0; k0 < 64; k0 += 32)
        acc = __builtin_amdgcn_mfma_f32_16x16x32_bf16(*(const LAS bf16x8*)(ap + k0), *(const LAS bf16x8*)(bp + k0), acc, 0, 0, 0);
    return acc;
}
__device__ __forceinline__ void st_rowmajor(LAS bf16_t* T, int mt, int nt, int lane, const f32x4 v) {
    const int n = nt * 16 + (lane & 15), i0 = mt * 16 + (lane >> 4) * 4;
    T[(i0 + 0) * RWP + n] = f2bf(v.x); T[(i0 + 1) * RWP + n] = f2bf(v.y); T[(i0 + 2) * RWP + n] = f2bf(v.z); T[(i0 + 3) * RWP + n] = f2bf(v.w);
}
__device__ __forceinline__ void st_transposed(LAS bf16_t* T, int mt, int nt, int lane, const f32x4 v) {
    const int n = nt * 16 + (lane & 15), i0 = mt * 16 + (lane >> 4) * 4;
    *(LAS v2u*)(T + n * RWP + i0) = (v2u){pk2(v.x, v.y), pk2(v.z, v.w)};
}

__device__ __forceinline__ void rwkv_pa_chunk(const Args& a, Frame& F, int l, int ci) {
    const WsMap m = ws_map(NTOK);
    const int bh = ci >> 6, c = ci & 63, b = bh >> 3, h = bh & 7;
    const int lane = F.lane, w = F.wave, tid = F.tid;
    const int ch = h * 64 + lane;
    LAS bf16_t* At = (LAS bf16_t*)F.lds; LAS bf16_t* AtT = At + RWT; LAS bf16_t* Bt = AtT + RWT; LAS bf16_t* Kt = Bt + RWT; LAS bf16_t* KtGT = Kt + RWT;
    LAS bf16_t* Rt = KtGT + RWT; LAS bf16_t* VmT = Rt + RWT; LAS bf16_t* LAK = VmT + RWT;
    LAS bf16_t* X0 = LAK + RWT; LAS bf16_t* XT0 = X0 + RWT; LAS bf16_t* T0 = XT0 + RWT; LAS bf16_t* X1 = T0 + RWT; LAS bf16_t* XT1 = X1 + RWT; LAS bf16_t* T1 = XT1 + RWT;
    LAS float* LWL = (LAS float*)X0;
    LAS bf16_t* A2 = X1;
    LAS bf16_t* LVT = XT1;
    const bf16_t* zr = (const bf16_t*)(a.ws + m.zrkv); const bf16_t* ao = (const bf16_t*)(a.ws + m.auxo); const bf16_t* vr = (const bf16_t*)(a.ws + m.vres);
    float* vf = (float*)(a.ws + m.vfirst); bf16_t* bvo = (bf16_t*)(a.ws + m.rwbv);
    unsigned char* blob = a.ws + m.xn + (size_t)ci * RWB_BYTES;
    bf16_t* gW = (bf16_t*)blob; bf16_t* gQG = gW + RWT; bf16_t* gKGT = gQG + RWT; bf16_t* gA1 = gKGT + RWT;
    float* gDV = (float*)(blob + RWB_DVEC); bf16_t* gVS = (bf16_t*)(blob + RWB_VS);
    const int j = tid >> 3, c8 = (tid & 7) * 8, chb = h * 64 + c8;
    const size_t n = (size_t)b * TSEQ + c * 64 + j;
    float zr_[8], zk_[8], zv_[8], wp[8], ap[8];
    unpack8(ld8(zr + n * 1536 + chb), zr_); unpack8(ld8(zr + n * 1536 + 512 + chb), zk_); unpack8(ld8(zr + n * 1536 + 1024 + chb), zv_);
    unpack8(ld8(ao + n * 1792 + chb), wp); unpack8(ld8(ao + n * 1792 + 512 + chb), ap);
    float vres8[8], vf8[8];
    if (l > 0) { unpack8(ld8(vr + n * 512 + chb), vres8); const f32x4 f0 = *(const f32x4*)(vf + n * 512 + chb), f1 = *(const f32x4*)(vf + n * 512 + chb + 4);
        vf8[0] = f0.x; vf8[1] = f0.y; vf8[2] = f0.z; vf8[3] = f0.w; vf8[4] = f1.x; vf8[5] = f1.y; vf8[6] = f1.z; vf8[7] = f1.w; }
    float lw[8];
#pragma unroll
    for (int k = 0; k < 8; ++k) lw[k] = -__expf(-softplus_f(-wp[k]) - 0.5f);
    float cs[8];
#pragma unroll
    for (int k = 0; k < 8; ++k) cs[k] = lw[k];
    chunk_cumsum8(cs, LWL, lane, w, c8);
    if (j == 63) { *(LAS f32x4*)(LWL + 512 + c8) = (f32x4){cs[0], cs[1], cs[2], cs[3]}; *(LAS f32x4*)(LWL + 512 + c8 + 4) = (f32x4){cs[4], cs[5], cs[6], cs[7]}; }
    __syncthreads();
    {
        float pk_[8], pa_[8], pr_[8];
        { const float* p0 = a.in[I_RW_K_K] + l * 512 + chb; const float* p1 = a.in[I_RW_K_A] + l * 512 + chb; const float* p2 = a.in[I_RW_R_K] + l * 512 + chb;
          const f32x4 a0 = *(const f32x4*)p0, a1 = *(const f32x4*)(p0 + 4), b0 = *(const f32x4*)p1, b1 = *(const f32x4*)(p1 + 4), c0 = *(const f32x4*)p2, c1 = *(const f32x4*)(p2 + 4);
          pk_[0] = a0.x; pk_[1] = a0.y; pk_[2] = a0.z; pk_[3] = a0.w; pk_[4] = a1.x; pk_[5] = a1.y; pk_[6] = a1.z; pk_[7] = a1.w;
          pa_[0] = b0.x; pa_[1] = b0.y; pa_[2] = b0.z; pa_[3] = b0.w; pa_[4] = b1.x; pa_[5] = b1.y; pa_[6] = b1.z; pa_[7] = b1.w;
          pr_[0] = c0.x; pr_[1] = c0.y; pr_[2] = c0.z; pr_[3] = c0.w; pr_[4] = c1.x; pr_[5] = c1.y; pr_[6] = c1.z; pr_[7] = c1.w; }
        float v[8], aa[8], kk[8], km[8];
        float ss = 0.f, bs = 0.f;
#pragma unroll
        for (int k = 0; k < 8; ++k) {
            v[k] = (l == 0) ? zv_[k] : zv_[k] + (vf8[k] - zv_[k]) * sigm(vres8[k]);
            aa[k] = sigm(ap[k]);
            kk[k] = zk_[k] * pk_[k]; ss += kk[k] * kk[k];
            km[k] = zk_[k] * (1.0f + (aa[k] - 1.0f) * pa_[k]); bs += zr_[k] * km[k] * pr_[k];
        }
        if (l == 0) { *(f32x4*)(vf + n * 512 + chb) = (f32x4){zv_[0], zv_[1], zv_[2], zv_[3]}; *(f32x4*)(vf + n * 512 + chb + 4) = (f32x4){zv_[4], zv_[5], zv_[6], zv_[7]}; }
        ss = red8(ss); bs = red8(bs);
        const float kinv = 1.0f / sqrtf(fmaxf(ss, 1e-24f));
        float cm[8], gcv[8];
        { const f32x4 g0 = *(const LAS f32x4*)(LWL + 512 + c8), g1 = *(const LAS f32x4*)(LWL + 512 + c8 + 4);
          gcv[0] = g0.x; gcv[1] = g0.y; gcv[2] = g0.z; gcv[3] = g0.w; gcv[4] = g1.x; gcv[5] = g1.y; gcv[6] = g1.z; gcv[7] = g1.w; }
#pragma unroll
        for (int k = 0; k < 8; ++k) cm[k] = cs[k] - lw[k];
        float t_at[8], t_bt[8], t_kt[8], t_rt[8], t_bv[8];
        LAS bf16_t* KGTl = T1;
#pragma unroll
        for (int k = 0; k < 8; ++k) {
            const float G = __expf(cs[k]), Gm1 = __expf(cm[k]), iG = __expf(-cs[k]), GcG = __expf(gcv[k] - cs[k]);
            const float kkn = kk[k] * kinv;
            const float av = -kkn, bv = kkn * aa[k];
            t_at[k] = av * Gm1; t_bt[k] = bv * iG; t_kt[k] = km[k] * iG; t_rt[k] = zr_[k] * G; t_bv[k] = bs * v[k];
            AtT[(c8 + k) * RWP + j] = f2bf(t_at[k]);
            KtGT[(c8 + k) * RWP + j] = f2bf(km[k] * GcG);
            VmT[(c8 + k) * RWP + j] = f2bf(v[k]);
            KGTl[(c8 + k) * RWP + j] = f2bf(bv * GcG);
        }
        *(LAS v4u*)(At + j * RWP + c8) = pack8(t_at); *(LAS v4u*)(Bt + j * RWP + c8) = pack8(t_bt); *(LAS v4u*)(Kt + j * RWP + c8) = pack8(t_kt);
        const v4u rt8 = pack8(t_rt);
        *(LAS v4u*)(Rt + j * RWP + c8) = rt8; *(v4u*)(gQG + j * RWP + c8) = rt8;
        *(v4u*)(bvo + n * 512 + chb) = pack8(t_bv);
        if (j == 63) { *(f32x4*)(gDV + c8) = (f32x4){__expf(gcv[0]), __expf(gcv[1]), __expf(gcv[2]), __expf(gcv[3])}; *(f32x4*)(gDV + c8 + 4) = (f32x4){__expf(gcv[4]), __expf(gcv[5]), __expf(gcv[6]), __expf(gcv[7])}; }
    }
    __syncthreads();
    {
        for (int o = tid; o < RWT / 8; o += NTHR) ((v4u*)gKGT)[o] = ((const LAS v4u*)T1)[o];
        f32x4 z4 = {0.f, 0.f, 0.f, 0.f};
#pragma unroll 1
        for (int tt = 0; tt < 2; ++tt) {
            const int t = w + 8 * tt, mt = t >> 2, nt = t & 3;
            const int n = nt * 16 + (lane & 15), i0 = mt * 16 + (lane >> 4) * 4;
            f32x4 lab = mm64(At, Bt, mt, nt, lane, z4), lak = mm64(At, Kt, mt, nt, lane, z4), a1 = mm64(Rt, Bt, mt, nt, lane, z4), a2 = mm64(Rt, Kt, mt, nt, lane, z4);
            f32x4 tt0;
#pragma unroll
            for (int e = 0; e < 4; ++e) { const int i = i0 + e;
                if (n >= i) { lab[e] = 0.f; lak[e] = 0.f; }
                if (n > i) { a1[e] = 0.f; a2[e] = 0.f; }
                tt0[e] = lab[e] + (n == i ? 1.0f : 0.f); }
            st_rowmajor(X0, mt, nt, lane, lab); st_transposed(XT0, mt, nt, lane, lab);
            st_rowmajor(T0, mt, nt, lane, tt0);
            st_rowmajor(LAK, mt, nt, lane, lak);
            st_rowmajor(A2, mt, nt, lane, a2);
            gA1[(i0 + 0) * RWP + n] = f2bf(a1.x); gA1[(i0 + 1) * RWP + n] = f2bf(a1.y); gA1[(i0 + 2) * RWP + n] = f2bf(a1.z); gA1[(i0 + 3) * RWP + n] = f2bf(a1.w);
        }
    }
    __syncthreads();
    {
        f32x4 z4 = {0.f, 0.f, 0.f, 0.f};
#pragma unroll 1
        for (int tt = 0; tt < 2; ++tt) {
            const int t = w + 8 * tt, mt = t >> 2, nt = t & 3;
            const int n = nt * 16 + (lane & 15), i0 = mt * 16 + (lane >> 4) * 4;
            const f32x4 lv = mm64(LAK, VmT, mt, nt, lane, z4), o0 = mm64(A2, VmT, mt, nt, lane, z4), kv0 = mm64(KtGT, VmT, mt, nt, lane, z4);
            st_transposed((LAS bf16_t*)(F.lds + 131584), mt, nt, lane, lv);
            bf16_t* go = gVS + (size_t)nt * 3 * 1024 + 1024;
            const int r = lane & 15;
            go[(i0 + 0) * 16 + r] = f2bf(o0.x); go[(i0 + 1) * 16 + r] = f2bf(o0.y); go[(i0 + 2) * 16 + r] = f2bf(o0.z); go[(i0 + 3) * 16 + r] = f2bf(o0.w);
            go[1024 + (i0 + 0) * 16 + r] = f2bf(kv0.x); go[1024 + (i0 + 1) * 16 + r] = f2bf(kv0.y); go[1024 + (i0 + 2) * 16 + r] = f2bf(kv0.z); go[1024 + (i0 + 3) * 16 + r] = f2bf(kv0.w);
            (void)n;
        }
    }
    __syncthreads();
    {
        LAS bf16_t* Xc = X0; LAS bf16_t* XTc = XT0; LAS bf16_t* Tc = T0; LAS bf16_t* Xn = X1; LAS bf16_t* XTn = XT1; LAS bf16_t* Tn = T1;
        f32x4 z4 = {0.f, 0.f, 0.f, 0.f};
#pragma unroll 1
        for (int it = 0; it < 5; ++it) {
#pragma unroll 1
            for (int tt = 0; tt < 2; ++tt) { const int t = w + 8 * tt, mt = t >> 2, nt = t & 3;
                const f32x4 x2 = mm64(Xc, XTc, mt, nt, lane, z4);
                st_rowmajor(Xn, mt, nt, lane, x2); st_transposed(XTn, mt, nt, lane, x2); }
            __syncthreads();
#pragma unroll 1
            for (int tt = 0; tt < 2; ++tt) { const int t = w + 8 * tt, mt = t >> 2, nt = t & 3;
                const int n = nt * 16 + (lane & 15), i0 = mt * 16 + (lane >> 4) * 4;
                f32x4 tc; tc.x = bf2f(Tc[(i0 + 0) * RWP + n]); tc.y = bf2f(Tc[(i0 + 1) * RWP + n]); tc.z = bf2f(Tc[(i0 + 2) * RWP + n]); tc.w = bf2f(Tc[(i0 + 3) * RWP + n]);
                const f32x4 tn = mm64(Tc, XTn, mt, nt, lane, tc);
                st_rowmajor(Tn, mt, nt, lane, tn); }
            __syncthreads();
            LAS bf16_t* s0 = Xc; Xc = Xn; Xn = s0; s0 = XTc; XTc = XTn; XTn = s0; s0 = Tc; Tc = Tn; Tn = s0;
        }
        LAS bf16_t* LVTp = (LAS bf16_t*)(F.lds + 131584);
#pragma unroll 1
        for (int tt = 0; tt < 2; ++tt) { const int t = w + 8 * tt, mt = t >> 2, nt = t & 3;
            const int n = nt * 16 + (lane & 15), i0 = mt * 16 + (lane >> 4) * 4, r = lane & 15;
            const f32x4 wt = mm64(Tc, AtT, mt, nt, lane, z4), u0 = mm64(Tc, LVTp, mt, nt, lane, z4);
            gW[(i0 + 0) * RWP + n] = f2bf(wt.x); gW[(i0 + 1) * RWP + n] = f2bf(wt.y); gW[(i0 + 2) * RWP + n] = f2bf(wt.z); gW[(i0 + 3) * RWP + n] = f2bf(wt.w);
            bf16_t* gu = gVS + (size_t)nt * 3 * 1024;
            gu[(i0 + 0) * 16 + r] = f2bf(u0.x); gu[(i0 + 1) * 16 + r] = f2bf(u0.y); gu[(i0 + 2) * 16 + r] = f2bf(u0.z); gu[(i0 + 3) * 16 + r] = f2bf(u0.w); }
    }
    __syncthreads();
    (void)LVT;
}

__device__ __forceinline__ void rwkv_ps_task(const Args& a, Frame& F, int task) {
    const WsMap m = ws_map(NTOK);
    const int bh = task >> 2, vs = task & 3, b = bh >> 3, h = bh & 7;
    const int lane = F.lane, w = F.wave, tid = F.tid;
    LAS bf16_t* LB = (LAS bf16_t*)F.lds;
    LAS bf16_t* ST = LB + 4 * RWT; LAS bf16_t* VNT = ST + 16 * RWP;
    bf16_t* yo = (bf16_t*)(a.ws + m.rwy);
    const unsigned char* blob0 = a.ws + m.xn + (size_t)(bh * 64) * RWB_BYTES;
    const int r = lane & 15, i0w = (w & 3) * 16 + (lane >> 4) * 4;
    f32x4 Sacc = {0.f, 0.f, 0.f, 0.f};
    for (int i = tid; i < 16 * RWP / 2; i += NTHR) ((LAS unsigned*)ST)[i] = 0u;
    v4u pre[5];
    auto prefetch = [&](int c) {
        const v4u* g = (const v4u*)(blob0 + (size_t)c * RWB_BYTES);
#pragma unroll
        for (int k = 0; k < 5; ++k) { const int o = k * 512 + tid; pre[k] = (o < (int)(RWB_TILES / 16)) ? g[o] : (v4u){0u, 0u, 0u, 0u}; }
    };
    auto commit = [&]() {
#pragma unroll
        for (int k = 0; k < 5; ++k) { const int o = k * 512 + tid; if (o < (int)(RWB_TILES / 16)) ((LAS v4u*)LB)[o] = pre[k]; }
    };
    prefetch(0); commit(); prefetch(1);
    for (int c = 0; c < 64; ++c) {
        const unsigned char* blob = blob0 + (size_t)c * RWB_BYTES;
        const bf16_t* gvs = (const bf16_t*)(blob + RWB_VS) + (size_t)vs * 3 * 1024;
        float fr[4]; float dv[4] = {1.f, 1.f, 1.f, 1.f}, kv0[4] = {0.f, 0.f, 0.f, 0.f};
        { const bf16_t* src = gvs + (w < 4 ? 0 : 1024);
#pragma unroll
          for (int e = 0; e < 4; ++e) fr[e] = bf2f(src[(i0w + e) * 16 + r]); }
        if (w < 4) { const float* gd = (const float*)(blob + RWB_DVEC);
#pragma unroll
          for (int e = 0; e < 4; ++e) { dv[e] = gd[i0w + e]; kv0[e] = bf2f(gvs[2048 + (i0w + e) * 16 + r]); } }
        __syncthreads();
        if (w < 4) {
            f32x4 vn = mm64(LB, ST, w, 0, lane, (f32x4){fr[0], fr[1], fr[2], fr[3]});
            st_transposed(VNT, w, 0, lane, vn);
        }
        __syncthreads();
        if (w < 4) {
            const f32x4 base = {dv[0] * Sacc.x + kv0[0], dv[1] * Sacc.y + kv0[1], dv[2] * Sacc.z + kv0[2], dv[3] * Sacc.w + kv0[3]};
            Sacc = mm64(LB + 2 * RWT, VNT, w, 0, lane, base);
        } else {
            f32x4 o = mm64(LB + RWT, ST, w - 4, 0, lane, (f32x4){fr[0], fr[1], fr[2], fr[3]});
            o = mm64(LB + 3 * RWT, VNT, w - 4, 0, lane, o);
            const size_t n = (size_t)b * TSEQ + c * 64 + i0w;
            bf16_t* yp = yo + n * 512 + h * 64 + vs * 16 + r;
            yp[0] = f2bf(o.x); yp[512] = f2bf(o.y); yp[1024] = f2bf(o.z); yp[1536] = f2bf(o.w);
        }
        __syncthreads();
        if (w < 4) st_transposed(ST, w, 0, lane, Sacc);
        if (c + 1 < 64) commit();
        if (c + 2 < 64) prefetch(c + 2);
    }
    __syncthreads();
}

constexpr int GP = 136;
constexpr size_t GB_BYTES = 18688;
template <int KD, int PA_, int PB_>
__device__ __forceinline__ f32x4 mmx(const LAS bf16_t* A, const LAS bf16_t* Bt, int mt, int nt, int lane, f32x4 acc) {
    const LAS bf16_t* ap = A + (mt * 16 + (lane & 15)) * PA_ + (lane >> 4) * 8;
    const LAS bf16_t* bp = Bt + (nt * 16 + (lane & 15)) * PB_ + (lane >> 4) * 8;
#pragma unroll
    for (int k0 = 0; k0 < KD; k0 += 32)
        acc = __builtin_amdgcn_mfma_f32_16x16x32_bf16(*(const LAS bf16x8*)(ap + k0), *(const LAS bf16x8*)(bp + k0), acc, 0, 0, 0);
    return acc;
}
__device__ __forceinline__ void gdn_pa_chunk(const Args& a, Frame& F, int ci) {
    const WsMap m = ws_map(NTOK);
    const int bh = ci >> 6, c = ci & 63, b = bh >> 2, h = bh & 3;
    const int lane = F.lane, w = F.wave, tid = F.tid;
    LAS bf16_t* KB = (LAS bf16_t*)F.lds; LAS bf16_t* KH = KB + 64 * GP; LAS bf16_t* QH = KH + 64 * GP;
    LAS bf16_t* X0 = QH + 64 * GP; LAS bf16_t* XT0 = X0 + RWT; LAS bf16_t* T0 = XT0 + RWT; LAS bf16_t* X1 = T0 + RWT; LAS bf16_t* XT1 = X1 + RWT; LAS bf16_t* T1 = XT1 + RWT;
    LAS float* GC = (LAS float*)(T1 + RWT);
    const bf16_t* gq = (const bf16_t*)(a.ws + m.gq); const bf16_t* gk = (const bf16_t*)(a.ws + m.gk); const float* gsc = (const float*)(a.ws + m.gsc);
    unsigned char* blob = a.ws + m.gblob + (size_t)ci * GB_BYTES;
    bf16_t* gT = (bf16_t*)blob; bf16_t* gA1 = gT + RWT; float* gGC = (float*)(blob + 2 * RWT * 2);
    const int j = tid >> 3, c16 = (tid & 7) * 16;
    const size_t n = (size_t)b * TSEQ + c * 64 + j;
    {
        const float be = gsc[n * 8 + h];
        float kf[8];
#pragma unroll
        for (int hh = 0; hh < 2; ++hh) {
            const v4u kw = ld8(gk + n * 512 + h * 128 + c16 + hh * 8), qw = ld8(gq + n * 512 + h * 128 + c16 + hh * 8);
            *(LAS v4u*)(KH + j * GP + c16 + hh * 8) = kw; *(LAS v4u*)(QH + j * GP + c16 + hh * 8) = qw;
            unpack8(kw, kf);
#pragma unroll
            for (int k = 0; k < 8; ++k) kf[k] *= be;
            *(LAS v4u*)(KB + j * GP + c16 + hh * 8) = pack8(kf);
        }
        if (w == 0) {
            float g = gsc[((size_t)b * TSEQ + c * 64 + lane) * 8 + 4 + h];
#pragma unroll
            for (int o = 1; o < 64; o <<= 1) { const float t = __shfl_up(g, o); if (lane >= o) g += t; }
            GC[lane] = g; gGC[lane] = g;
        }
    }
    __syncthreads();
    {
        const f32x4 z4 = {0.f, 0.f, 0.f, 0.f};
#pragma unroll 1
        for (int tt = 0; tt < 2; ++tt) {
            const int t = w + 8 * tt, mt = t >> 2, nt = t & 3;
            const int nn = nt * 16 + (lane & 15), i0 = mt * 16 + (lane >> 4) * 4;
            f32x4 kk = mmx<128, GP, GP>(KB, KH, mt, nt, lane, z4), qk = mmx<128, GP, GP>(QH, KH, mt, nt, lane, z4);
            const float gj = GC[nn];
            f32x4 x, t0;
#pragma unroll
            for (int e = 0; e < 4; ++e) { const int i = i0 + e; const float d = __expf(fminf(GC[i] - gj, 0.f));
                x[e] = (nn < i) ? -kk[e] * d : 0.f; qk[e] = (nn <= i) ? qk[e] * d : 0.f; t0[e] = x[e] + (nn == i ? 1.0f : 0.f); }
            st_rowmajor(X0, mt, nt, lane, x); st_transposed(XT0, mt, nt, lane, x); st_rowmajor(T0, mt, nt, lane, t0);
            gA1[(i0 + 0) * RWP + nn] = f2bf(qk.x); gA1[(i0 + 1) * RWP + nn] = f2bf(qk.y); gA1[(i0 + 2) * RWP + nn] = f2bf(qk.z); gA1[(i0 + 3) * RWP + nn] = f2bf(qk.w);
        }
    }
    __syncthreads();
    {
        LAS bf16_t* Xc = X0; LAS bf16_t* XTc = XT0; LAS bf16_t* Tc = T0; LAS bf16_t* Xn = X1; LAS bf16_t* XTn = XT1; LAS bf16_t* Tn = T1;
        const f32x4 z4 = {0.f, 0.f, 0.f, 0.f};
#pragma unroll 1
        for (int it = 0; it < 5; ++it) {
#pragma unroll 1
            for (int tt = 0; tt < 2; ++tt) { const int t = w + 8 * tt, mt = t >> 2, nt = t & 3;
                const f32x4 x2 = mm64(Xc, XTc, mt, nt, lane, z4);
                st_rowmajor(Xn, mt, nt, lane, x2); st_transposed(XTn, mt, nt, lane, x2); }
            __syncthreads();
#pragma unroll 1
            for (int tt = 0; tt < 2; ++tt) { const int t = w + 8 * tt, mt = t >> 2, nt = t & 3;
                const int nn = nt * 16 + (lane & 15), i0 = mt * 16 + (lane >> 4) * 4;
                f32x4 tc; tc.x = bf2f(Tc[(i0 + 0) * RWP + nn]); tc.y = bf2f(Tc[(i0 + 1) * RWP + nn]); tc.z = bf2f(Tc[(i0 + 2) * RWP + nn]); tc.w = bf2f(Tc[(i0 + 3) * RWP + nn]);
                const f32x4 tn = mm64(Tc, XTn, mt, nt, lane, tc);
                st_rowmajor(Tn, mt, nt, lane, tn); }
            __syncthreads();
            LAS bf16_t* s0 = Xc; Xc = Xn; Xn = s0; s0 = XTc; XTc = XTn; XTn = s0; s0 = Tc; Tc = Tn; Tn = s0;
        }
        for (int o = tid; o < RWT / 8; o += NTHR) ((v4u*)gT)[o] = ((const LAS v4u*)Tc)[o];
    }
    __syncthreads();
}

__device__ __forceinline__ void gdn_ps_task(const Args& a, Frame& F, int task) {
    const WsMap m = ws_map(NTOK);
    const int bh = task >> 3, vs = task & 7, b = bh >> 2, h = bh & 3;
    const int lane = F.lane, w = F.wave, tid = F.tid;
    LAS bf16_t* KBE = (LAS bf16_t*)F.lds; LAS bf16_t* QG = KBE + 64 * GP; LAS bf16_t* KGT = QG + 64 * GP;
    LAS bf16_t* TT = KGT + 128 * RWP; LAS bf16_t* A1 = TT + RWT; LAS bf16_t* ST = A1 + RWT;
    LAS bf16_t* R2T = ST + 16 * GP; LAS bf16_t* VNT = R2T + 16 * RWP; LAS float* VB = (LAS float*)(VNT + 16 * RWP); LAS float* GC = VB + 64 * 16;
    const bf16_t* gq = (const bf16_t*)(a.ws + m.gq); const bf16_t* gk = (const bf16_t*)(a.ws + m.gk); const bf16_t* gv = (const bf16_t*)(a.ws + m.gv);
    const float* gsc = (const float*)(a.ws + m.gsc); bf16_t* go = (bf16_t*)(a.ws + m.gdno);
    const unsigned char* blob0 = a.ws + m.gblob + (size_t)(bh * 64) * GB_BYTES;
    const int j = tid >> 3, c16 = (tid & 7) * 16, r = lane & 15, kq4 = (lane >> 4) * 4;
    f32x4 Sacc = {0.f, 0.f, 0.f, 0.f};
    for (int i = tid; i < 16 * GP / 2; i += NTHR) ((LAS unsigned*)ST)[i] = 0u;
    v4u pk_[2], pq_[2], pt_[3]; v4u pv_; float pbe = 0.f;
    auto prefetch = [&](int c) {
        const size_t n = (size_t)b * TSEQ + c * 64 + j;
#pragma unroll
        for (int hh = 0; hh < 2; ++hh) { pk_[hh] = ld8(gk + n * 512 + h * 128 + c16 + hh * 8); pq_[hh] = ld8(gq + n * 512 + h * 128 + c16 + hh * 8); }
        pbe = gsc[n * 8 + h];
        const v4u* g = (const v4u*)(blob0 + (size_t)c * GB_BYTES);
#pragma unroll
        for (int k = 0; k < 3; ++k) { const int o = k * 512 + tid; pt_[k] = (o < (int)(GB_BYTES / 16)) ? g[o] : (v4u){0u, 0u, 0u, 0u}; }
        if (tid < 128) pv_ = ld8(gv + ((size_t)b * TSEQ + c * 64 + (tid >> 1)) * 512 + h * 128 + vs * 16 + (tid & 1) * 8);
    };
    prefetch(0);
    for (int c = 0; c < 64; ++c) {
#pragma unroll
        for (int k = 0; k < 3; ++k) { const int o = k * 512 + tid;
            if (o < 2 * RWT / 8) ((LAS v4u*)TT)[o] = pt_[k];
            else if (o < (int)(GB_BYTES / 16)) ((LAS v4u*)GC)[o - 2 * RWT / 8] = pt_[k]; }
        const v4u kw0 = pk_[0], kw1 = pk_[1], qw0 = pq_[0], qw1 = pq_[1]; const float be = pbe; const v4u vw = pv_;
        __syncthreads();
        if (c + 1 < 64) prefetch(c + 1);
        {
            const float gj = GC[j], g63 = GC[63];
            const float eg = __expf(gj), s_kbe = be * eg, s_kg = __expf(g63 - gj);
            float f[8], o8[8];
#pragma unroll
            for (int hh = 0; hh < 2; ++hh) {
                unpack8(hh ? kw1 : kw0, f);
#pragma unroll
                for (int k = 0; k < 8; ++k) { o8[k] = f[k] * s_kbe; KGT[(c16 + hh * 8 + k) * RWP + j] = f2bf(f[k] * s_kg); }
                *(LAS v4u*)(KBE + j * GP + c16 + hh * 8) = pack8(o8);
                unpack8(hh ? qw1 : qw0, f);
#pragma unroll
                for (int k = 0; k < 8; ++k) o8[k] = f[k] * eg;
                *(LAS v4u*)(QG + j * GP + c16 + hh * 8) = pack8(o8);
            }
            if (tid < 128) { const int jv = tid >> 1, cv = (tid & 1) * 8; const float bev = gsc[((size_t)b * TSEQ + c * 64 + jv) * 8 + h];
                unpack8(vw, f);
                *(LAS f32x4*)(VB + jv * 16 + cv) = (f32x4){f[0] * bev, f[1] * bev, f[2] * bev, f[3] * bev}; *(LAS f32x4*)(VB + jv * 16 + cv + 4) = (f32x4){f[4] * bev, f[5] * bev, f[6] * bev, f[7] * bev}; }
        }
        const float glast = __expf(GC[63]);
        __syncthreads();
        if (w < 4) {
            const int i0 = w * 16 + kq4;
            f32x4 r1 = mmx<128, GP, GP>(KBE, ST, w, 0, lane, (f32x4){0.f, 0.f, 0.f, 0.f});
            r1.x = VB[(i0 + 0) * 16 + r] - r1.x; r1.y = VB[(i0 + 1) * 16 + r] - r1.y; r1.z = VB[(i0 + 2) * 16 + r] - r1.z; r1.w = VB[(i0 + 3) * 16 + r] - r1.w;
            st_transposed(R2T, w, 0, lane, r1);
        }
        __syncthreads();
        if (w < 4) { const f32x4 vn = mm64(TT, R2T, w, 0, lane, (f32x4){0.f, 0.f, 0.f, 0.f}); st_transposed(VNT, w, 0, lane, vn); }
        __syncthreads();
        {
            const f32x4 base = {Sacc.x * glast, Sacc.y * glast, Sacc.z * glast, Sacc.w * glast};
            Sacc = mm64(KGT, VNT, w, 0, lane, base);
            if (w < 4) {
                f32x4 o = mmx<128, GP, GP>(QG, ST, w, 0, lane, (f32x4){0.f, 0.f, 0.f, 0.f});
                o = mm64(A1, VNT, w, 0, lane, o);
                const size_t n = (size_t)b * TSEQ + c * 64 + w * 16 + kq4;
                bf16_t* op = go + n * 512 + h * 128 + vs * 16 + r;
                op[0] = f2bf(o.x); op[512] = f2bf(o.y); op[1024] = f2bf(o.z); op[1536] = f2bf(o.w);
            }
        }
        __syncthreads();
        { const int k0 = w * 16 + kq4;
          *(LAS v2u*)(ST + r * GP + k0) = (v2u){pk2(Sacc.x, Sacc.y), pk2(Sacc.z, Sacc.w)}; }
    }
    __syncthreads();
}

__device__ __forceinline__ void gla_task(const Args& a, Frame& F, int l, int task) {
    const WsMap m = ws_map(NTOK);
    const int b = task >> 4, h = (task >> 2) & 3, qt = task & 3;
    const int lane = F.lane, w = F.wave, tid = F.tid;
    LAS bf16_t* QS = (LAS bf16_t*)F.lds; LAS bf16_t* KS = QS + RWT; LAS bf16_t* QG = KS + RWT; LAS bf16_t* KS2T = QG + RWT; LAS bf16_t* PM = KS2T + RWT;
    LAS bf16_t* VT = PM + RWT; LAS bf16_t* ST = VT + 32 * RWP; LAS float* LWL = (LAS float*)(ST + 32 * RWP);
    const bf16_t* p16 = (const bf16_t*)(a.ws + m.p16); const bf16_t* ao = (const bf16_t*)(a.ws + m.auxo);
    bf16_t* go = (bf16_t*)(a.ws + m.glao);
    const int j = tid >> 3, c8 = (tid & 7) * 8, v4 = (tid & 7) * 4;
    const int mtS = w >> 2, ntS = w & 3;
    const int mtO = w >> 1, ntO = w & 1;
    f32x4 Sacc = {0.f, 0.f, 0.f, 0.f};
    for (int i = tid; i < 32 * RWP / 2; i += NTHR) ((LAS unsigned*)ST)[i] = 0u;
    v4u nq, nk, npre; v2u nv;
    auto load_chunk = [&](int c) {
        const size_t n = (size_t)b * TSEQ + c * 64 + j;
        nq = ld8(p16 + n * PLD + C_GLA + h * 64 + c8); nk = ld8(p16 + n * PLD + C_GLA + 256 + h * 64 + c8); npre = ld8(ao + n * 1792 + 1536 + h * 64 + c8);
        nv = *(const v2u*)(p16 + n * PLD + C_GLA + 512 + h * 128 + qt * 32 + v4);
    };
    load_chunk(0);
    for (int c = 0; c < 64; ++c) {
        float q8[8], k8[8], la[8];
        unpack8(nq, q8); unpack8(nk, k8); unpack8(npre, la);
        const v2u vraw = nv;
#pragma unroll
        for (int k = 0; k < 8; ++k) la[k] = -softplus_f(-la[k]) * (1.0f / 16.0f);
        if (c + 1 < 64) load_chunk(c + 1);
        chunk_cumsum8(la, LWL, lane, w, c8);
        if (j == 31) { *(LAS f32x4*)(LWL + 512 + c8) = (f32x4){la[0], la[1], la[2], la[3]}; *(LAS f32x4*)(LWL + 512 + c8 + 4) = (f32x4){la[4], la[5], la[6], la[7]}; }
        if (j == 63) { *(LAS f32x4*)(LWL + 576 + c8) = (f32x4){la[0], la[1], la[2], la[3]}; *(LAS f32x4*)(LWL + 576 + c8 + 4) = (f32x4){la[4], la[5], la[6], la[7]}; }
        __syncthreads();
        {
            float bj[8], br[8], bl[8], t0[8], t1[8], t2[8];
            {
#pragma unroll
              for (int k = 0; k < 8; ++k) bj[k] = la[k];
              const f32x4 y0 = *(const LAS f32x4*)(LWL + 512 + c8), y1 = *(const LAS f32x4*)(LWL + 512 + c8 + 4);
              br[0] = y0.x; br[1] = y0.y; br[2] = y0.z; br[3] = y0.w; br[4] = y1.x; br[5] = y1.y; br[6] = y1.z; br[7] = y1.w;
              const f32x4 z0 = *(const LAS f32x4*)(LWL + 576 + c8), z1 = *(const LAS f32x4*)(LWL + 576 + c8 + 4);
              bl[0] = z0.x; bl[1] = z0.y; bl[2] = z0.z; bl[3] = z0.w; bl[4] = z1.x; bl[5] = z1.y; bl[6] = z1.z; bl[7] = z1.w; }
#pragma unroll
            for (int k = 0; k < 8; ++k) {
                const float qq = q8[k] * 0.125f;
                t0[k] = qq * __expf(bj[k] - br[k]); t1[k] = k8[k] * __expf(br[k] - bj[k]); t2[k] = qq * __expf(bj[k]);
                KS2T[(c8 + k) * RWP + j] = f2bf(k8[k] * __expf(bl[k] - bj[k]));
            }
            *(LAS v4u*)(QS + j * RWP + c8) = pack8(t0); *(LAS v4u*)(KS + j * RWP + c8) = pack8(t1); *(LAS v4u*)(QG + j * RWP + c8) = pack8(t2);
            VT[(v4 + 0) * RWP + j] = (bf16_t)(vraw.x & 0xffffu); VT[(v4 + 1) * RWP + j] = (bf16_t)(vraw.x >> 16);
            VT[(v4 + 2) * RWP + j] = (bf16_t)(vraw.y & 0xffffu); VT[(v4 + 3) * RWP + j] = (bf16_t)(vraw.y >> 16);
        }
        const float dec = __expf(LWL[576 + ntS * 16 + (lane & 15)]);
        __syncthreads();
        f32x4 o4;
        {
            const f32x4 z4 = {0.f, 0.f, 0.f, 0.f};
#pragma unroll
            for (int tt = 0; tt < 2; ++tt) { const int t = w + 8 * tt, mt = t >> 2, nt = t & 3;
                f32x4 s4 = mm64(QS, KS, mt, nt, lane, z4);
                const int nn = nt * 16 + (lane & 15), i0 = mt * 16 + (lane >> 4) * 4;
#pragma unroll
                for (int e = 0; e < 4; ++e) if (nn > i0 + e) s4[e] = 0.f;
                st_rowmajor(PM, mt, nt, lane, s4); }
            o4 = mm64(QG, ST, mtO, ntO, lane, z4);
        }
        __syncthreads();
        {
            o4 = mm64(PM, VT, mtO, ntO, lane, o4);
            const size_t n = (size_t)b * TSEQ + c * 64 + mtO * 16 + (lane >> 4) * 4;
            bf16_t* op = go + n * 512 + h * 128 + qt * 32 + ntO * 16 + (lane & 15);
            op[0] = f2bf(o4.x); op[512] = f2bf(o4.y); op[1024] = f2bf(o4.z); op[1536] = f2bf(o4.w);
            const f32x4 base = {Sacc.x * dec, Sacc.y * dec, Sacc.z * dec, Sacc.w * dec};
            Sacc = mm64(VT, KS2T, mtS, ntS, lane, base);
            st_rowmajor(ST, mtS, ntS, lane, Sacc);
        }
        __syncthreads();
    }
}

__device__ __forceinline__ void lru_pass(const Args& a, Frame& F, int l, bool passB) {
    const WsMap m = ws_map(NTOK);
    const bf16_t* gt = (const bf16_t*)(a.ws + m.gates); const bf16_t* xc = (const bf16_t*)(a.ws + m.xc); const bf16_t* p16 = (const bf16_t*)(a.ws + m.p16);
    bf16_t* mix = (bf16_t*)(a.ws + m.mix16); float* lrs = (float*)(a.ws + m.lrs);
    for (int it = F.vcu * NTHR + F.tid; it < NBATCH * 64 * 512; it += F.G * NTHR) {
        const int ch = it & 511, bc = it >> 9, c = bc & 63;
        const float sp8 = 8.0f * softplus_f(-a.in[I_LRU_LAM][l * 512 + ch]);
        const size_t nb = (size_t)bc * 64;
        float hh = 0.f, ap = 1.f;
        if (passB) { for (int s = 0; s < c; ++s) { const f32x2 su = *(const f32x2*)(lrs + ((size_t)(bc - c + s) * 512 + ch) * 2); hh = su.x * hh + su.y; } }
#pragma unroll 8
        for (int t = 0; t < 64; ++t) { const size_t n = nb + t;
            const float la = -sp8 * sigm(bf2f(gt[n * 1024 + ch]));
            const float u = bf2f(xc[n * 512 + ch]) * sigm(bf2f(gt[n * 1024 + 512 + ch])) * sqrtf(-expm1f(2.0f * la));
            const float av = __expf(la);
            hh = av * hh + u; ap *= av;
            if (passB) mix[n * DM + 1024 + ch] = f2bf(hh * gelu_fast(bf2f(p16[n * PLD + C_LRU + 512 + ch]))); }
        if (!passB) *(f32x2*)(lrs + ((size_t)bc * 512 + ch) * 2) = (f32x2){ap, hh};
    }
}

__device__ __forceinline__ void scan_phase(const Args& a, Frame& F, int l) {
    lru_pass(a, F, l, false);
    const int task = blockIdx.x;
    if (task < 128) { for (int q = 0; q < 16; ++q) rwkv_pa_chunk(a, F, l, task * 16 + q); }
    else if (task < 192) { for (int q = 0; q < 16; ++q) gdn_pa_chunk(a, F, (task - 128) * 16 + q);
        if (l == 0) tables_range(a, F, (size_t)2 * NEXP * DM / 32, (size_t)4 * NEXP * DM / 32, task - 128, 64); }
    else gla_task(a, F, l, task - 192);
}

__device__ __forceinline__ void post_phase(const Args& a, Frame& F, int l, const XcdBarrier& bar) {
    const WsMap m = ws_map(NTOK);
    if (blockIdx.x < 128) rwkv_ps_task(a, F, blockIdx.x); else gdn_ps_task(a, F, blockIdx.x - 128);
    lru_pass(a, F, l, true);
    const bf16_t* p16 = (const bf16_t*)(a.ws + m.p16); const bf16_t* glao = (const bf16_t*)(a.ws + m.glao); const bf16_t* gdno = (const bf16_t*)(a.ws + m.gdno);
    const bf16_t* rwy = (const bf16_t*)(a.ws + m.rwy); const bf16_t* rwbv = (const bf16_t*)(a.ws + m.rwbv); const bf16_t* ao = (const bf16_t*)(a.ws + m.auxo);
    bf16_t* mix = (bf16_t*)(a.ws + m.mix16);
    const int lane = F.lane, col = lane * 8, hc = col & 127;
    float gg[8], gd[8], lw[8], lb[8];
    { const f32x4 x0 = *(const f32x4*)(a.in[I_GLA_NORM] + l * 128 + hc), x1 = *(const f32x4*)(a.in[I_GLA_NORM] + l * 128 + hc + 4);
      gg[0] = x0.x; gg[1] = x0.y; gg[2] = x0.z; gg[3] = x0.w; gg[4] = x1.x; gg[5] = x1.y; gg[6] = x1.z; gg[7] = x1.w;
      const f32x4 y0 = *(const f32x4*)(a.in[I_GDN_NORM] + l * 128 + hc), y1 = *(const f32x4*)(a.in[I_GDN_NORM] + l * 128 + hc + 4);
      gd[0] = y0.x; gd[1] = y0.y; gd[2] = y0.z; gd[3] = y0.w; gd[4] = y1.x; gd[5] = y1.y; gd[6] = y1.z; gd[7] = y1.w;
      const f32x4 w0 = *(const f32x4*)(a.in[I_RW_LN_W] + l * 512 + col), w1 = *(const f32x4*)(a.in[I_RW_LN_W] + l * 512 + col + 4);
      lw[0] = w0.x; lw[1] = w0.y; lw[2] = w0.z; lw[3] = w0.w; lw[4] = w1.x; lw[5] = w1.y; lw[6] = w1.z; lw[7] = w1.w;
      const f32x4 b0 = *(const f32x4*)(a.in[I_RW_LN_B] + l * 512 + col), b1 = *(const f32x4*)(a.in[I_RW_LN_B] + l * 512 + col + 4);
      lb[0] = b0.x; lb[1] = b0.y; lb[2] = b0.z; lb[3] = b0.w; lb[4] = b1.x; lb[5] = b1.y; lb[6] = b1.z; lb[7] = b1.w; }
    for (int pass = 1; pass < 2; ++pass) {
    if (pass == 1) xcd_barrier(bar);
    for (int n = F.gw; n < NTOK; n += F.ngw) {
        if (pass == 1) {
            float y[8], bv[8], g[8];
            unpack8(ld8(rwy + (size_t)n * 512 + col), y); unpack8(ld8(rwbv + (size_t)n * 512 + col), bv); unpack8(ld8(ao + (size_t)n * 1792 + 1024 + col), g);
            float s = 0.f;
#pragma unroll
            for (int k = 0; k < 8; ++k) s += y[k];
            const float mean = red8(s) * (1.0f / 64.0f);
            float s2 = 0.f;
#pragma unroll
            for (int k = 0; k < 8; ++k) { y[k] -= mean; s2 += y[k] * y[k]; }
            const float rs = 1.0f / sqrtf(red8(s2) * (1.0f / 64.0f) + 64e-5f);
#pragma unroll
            for (int k = 0; k < 8; ++k) y[k] = (y[k] * rs * lw[k] + lb[k] + bv[k]) * g[k];
            *(v4u*)(mix + (size_t)n * DM + col) = pack8(y);
        }
        if (pass == 1)
#pragma unroll
        for (int which = 0; which < 2; ++which) {
            float o[8], g[8];
            unpack8(ld8((which ? gdno : glao) + (size_t)n * 512 + col), o);
            unpack8(ld8(p16 + (size_t)n * PLD + (which ? C_GDN + 1536 : C_GLA + 1024) + col), g);
            float ss = 0.f;
#pragma unroll
            for (int k = 0; k < 8; ++k) ss += o[k] * o[k];
            ss = row16_sum(ss);
            const float rs = 1.0f / sqrtf(ss * (1.0f / 128.0f) + 1e-6f);
#pragma unroll
            for (int k = 0; k < 8; ++k) o[k] = o[k] * rs * (which ? gd[k] : gg[k]) * (g[k] * sigm(g[k]));
            *(v4u*)(mix + (size_t)n * DM + (which ? 1536 : 512) + col) = pack8(o);
        }
    }
    }
}

__device__ __forceinline__ void norm2_phase(const Args& a, Frame& F, int l) {
    const WsMap m = ws_map(NTOK);
    const float* gain = a.in[I_NORM_FFN] + l * DM;
    f32x4 gv[8];
#pragma unroll
    for (int j = 0; j < 8; ++j) gv[j] = ((const f32x4*)gain)[64 * j + F.lane];
    for (int n = F.gw; n < NTOK; n += F.ngw) {
        const f32x4* xr = (const f32x4*)(a.out + (size_t)n * DM) + F.lane;
        f32x4 v[8]; float s = 0.f;
#pragma unroll
        for (int j = 0; j < 8; ++j) { v[j] = xr[64 * j]; s += (v[j].x * v[j].x + v[j].y * v[j].y) + (v[j].z * v[j].z + v[j].w * v[j].w); }
        const float rstd = 1.0f / sqrtf(wave_sum_u(s) * (1.0f / DM) + 1e-6f);
        v2u* o8 = (v2u*)((bf16_t*)(a.ws + m.hb) + (size_t)n * DM) + F.lane;
#pragma unroll
        for (int j = 0; j < 8; ++j) { v2u w; w.x = pk2(v[j].x * rstd * gv[j].x, v[j].y * rstd * gv[j].y); w.y = pk2(v[j].z * rstd * gv[j].z, v[j].w * rstd * gv[j].w); o8[64 * j] = w; }
    }
}

#define TK_CE(A, B) do { const float mx_ = fmaxf(A, B), mn_ = fminf(A, B); A = mx_; B = mn_; } while (0)
__device__ __forceinline__ void tk_sort16_desc(float (&x)[16]) {
#pragma unroll
    for (int k = 2; k <= 16; k <<= 1)
#pragma unroll
        for (int j = k >> 1; j > 0; j >>= 1)
#pragma unroll
            for (int i = 0; i < 16; ++i) { const int p = i ^ j;
                if (p > i) { if ((i & k) == 0) TK_CE(x[i], x[p]); else TK_CE(x[p], x[i]); } }
}
__device__ __forceinline__ void tk_merge16(float (&run)[16], const float (&g)[16]) {
#pragma unroll
    for (int i = 0; i < 16; ++i) run[i] = fmaxf(run[i], g[15 - i]);
#pragma unroll
    for (int j = 8; j > 0; j >>= 1)
#pragma unroll
        for (int i = 0; i < 16; ++i) { const int p = i ^ j; if (p > i) TK_CE(run[i], run[p]); }
}
__device__ __forceinline__ float tk_tag(float v, unsigned tag, unsigned mask) { return __builtin_bit_cast(float, (__builtin_bit_cast(unsigned, v) & ~mask) | tag); }
__device__ __forceinline__ void topk_phase(const Args& a, Frame& F) {
    const WsMap m = ws_map(NTOK);
    const float* sc = (const float*)(a.ws + m.sc);
    int* idx = (int*)(a.ws + m.idx); float* gate = (float*)(a.ws + m.gate);
    LAS float* LS = (LAS float*)F.lds;
    const int t = F.tid;
    for (int wv = F.gw; wv < (NTOK / 64) * 8; wv += F.ngw) {
        const int h = wv & 7, n = (wv >> 3) * 64 + F.lane;
        const float* sp = sc + (size_t)(h * 256) * NTOK + n;
        float s0[16], s1[16];
#pragma unroll
        for (int half = 0; half < 2; ++half) {
            float run[16];
#pragma unroll
            for (int j = 0; j < 16; ++j) run[j] = -3.0e38f;
#pragma unroll 1
            for (int g = 0; g < 8; ++g) {
                float x[16];
#pragma unroll
                for (int k = 0; k < 16; ++k) x[k] = tk_tag(sp[(size_t)(half * 128 + g * 16 + k) * NTOK], (unsigned)(g * 16 + k), 127u);
                tk_sort16_desc(x);
                tk_merge16(run, x);
            }
#pragma unroll
            for (int j = 0; j < 16; ++j) { if (half) s1[j] = run[j]; else s0[j] = run[j]; LS[(half * 16 + j) * 512 + t] = run[j]; }
        }
        float run[16];
#pragma unroll
        for (int j = 0; j < 16; ++j) run[j] = -3.0e38f;
        {
            float x[16]; int cnt = 0;
#pragma unroll
            for (int p = 0; p < 16; ++p)
#pragma unroll
                for (int q = 0; q < 16; ++q) if ((p + 1) * (q + 1) <= 16) {
                    x[cnt & 15] = tk_tag(s0[p] + s1[q], (unsigned)(p * 16 + q), 255u); ++cnt;
                    if ((cnt & 15) == 0) { tk_sort16_desc(x); tk_merge16(run, x); }
                }
#pragma unroll
            for (int k = 0; k < 16; ++k) if (k >= (cnt & 15)) x[k] = -3.0e38f;
            tk_sort16_desc(x); tk_merge16(run, x);
        }
        const float mx = run[0]; float den = 0.f; float e[16]; int ti[16];
#pragma unroll
        for (int j = 0; j < 16; ++j) {
            const unsigned tg = __builtin_bit_cast(unsigned, run[j]) & 255u; const int p = (int)(tg >> 4), q = (int)(tg & 15u);
            const unsigned k0 = __builtin_bit_cast(unsigned, LS[(0 * 16 + p) * 512 + t]) & 127u, k1 = __builtin_bit_cast(unsigned, LS[(1 * 16 + q) * 512 + t]) & 127u;
            ti[j] = (int)(k0 * 128u + k1);
            e[j] = __expf(run[j] - mx); den += e[j];
        }
        const float inv = 1.0f / den;
        const size_t it = (size_t)n * 8 + h;
        f32x4* go = (f32x4*)(gate + it * 16); v4u* io = (v4u*)(idx + it * 16);
#pragma unroll
        for (int j = 0; j < 4; ++j) { go[j] = (f32x4){e[4 * j] * inv, e[4 * j + 1] * inv, e[4 * j + 2] * inv, e[4 * j + 3] * inv};
            io[j] = (v4u){(unsigned)ti[4 * j], (unsigned)ti[4 * j + 1], (unsigned)ti[4 * j + 2], (unsigned)ti[4 * j + 3]}; }
    }
}

__device__ __forceinline__ v6u ld_row6(const unsigned char* p) { const v2u* q = (const v2u*)p; const v2u a0 = q[0], a1 = q[1], a2 = q[2]; return (v6u){a0.x, a0.y, a1.x, a1.y, a2.x, a2.y}; }
__device__ __forceinline__ void peer_phase(const Args& a, Frame& F, int l) {
    const WsMap m = ws_map(NTOK);
    const unsigned char* TU = (const unsigned char*)(a.ws + m.tabu) + (size_t)l * 2 * NEXP * TROW;
    const unsigned char* TV = TU + (size_t)NEXP * TROW;
    const int* idx = (const int*)(a.ws + m.idx); const float* gate = (const float*)(a.ws + m.gate);
    const int lane = F.lane;
    for (int n = F.gw; n < NTOK; n += F.ngw) {
        float xf[32];
        { const v4u* hr = (const v4u*)((const bf16_t*)(a.ws + m.hb) + (size_t)n * DM + lane * 32);
#pragma unroll
          for (int q = 0; q < 4; ++q) { const v4u w = hr[q];
              xf[8 * q + 0] = bflo(w.x); xf[8 * q + 1] = bfhi(w.x); xf[8 * q + 2] = bflo(w.y); xf[8 * q + 3] = bfhi(w.y); xf[8 * q + 4] = bflo(w.z); xf[8 * q + 5] = bfhi(w.z); xf[8 * q + 6] = bflo(w.w); xf[8 * q + 7] = bfhi(w.w); } }
        const int e0 = idx[(size_t)n * 128 + lane], e1 = idx[(size_t)n * 128 + 64 + lane];
        const float g0 = gate[(size_t)n * 128 + lane], g1 = gate[(size_t)n * 128 + 64 + lane];
        float d0 = 0.f, d1 = 0.f;
#pragma unroll
        for (int half = 0; half < 2; ++half) {
            const int ev = half ? e1 : e0; float dd = 0.f;
            for (int j = 0; j < 64; j += 4) {
                v6u u[4];
#pragma unroll
                for (int r = 0; r < 4; ++r) { const int e = __builtin_amdgcn_readlane(ev, j + r); u[r] = ld_row6(TU + (size_t)e * TROW + lane * 24); }
#pragma unroll
                for (int r = 0; r < 4; ++r) { const v32f f = __builtin_amdgcn_cvt_scalef32_pk32_f32_fp6(u[r], 1.0f);
                    float a0 = 0.f, a1 = 0.f, a2 = 0.f, a3 = 0.f;
#pragma unroll
                    for (int k = 0; k < 8; ++k) { a0 += f[4 * k] * xf[4 * k]; a1 += f[4 * k + 1] * xf[4 * k + 1]; a2 += f[4 * k + 2] * xf[4 * k + 2]; a3 += f[4 * k + 3] * xf[4 * k + 3]; }
                    const float t = wave_sum_u((a0 + a1) + (a2 + a3));
                    dd = (lane == j + r) ? t : dd;
}
            }
            if (half) d1 = dd; else d0 = dd;
        }
        const float c0 = gelu_fast(d0 * (1.0f / 64.0f)) * g0 * 0.25f, c1 = gelu_fast(d1 * (1.0f / 64.0f)) * g1 * 0.25f;
        float o[32];
#pragma unroll
        for (int i = 0; i < 32; ++i) o[i] = 0.f;
#pragma unroll
        for (int half = 0; half < 2; ++half) {
            const int ev = half ? e1 : e0; const float cv = half ? c1 : c0;
            for (int j = 0; j < 64; j += 4) {
                v6u v[4]; float cj[4];
#pragma unroll
                for (int r = 0; r < 4; ++r) { const int e = __builtin_amdgcn_readlane(ev, j + r); cj[r] = rdlane_f(cv, j + r); v[r] = ld_row6(TV + (size_t)e * TROW + lane * 24); }
#pragma unroll
                for (int r = 0; r < 4; ++r) { const v32f f = __builtin_amdgcn_cvt_scalef32_pk32_f32_fp6(v[r], 1.0f);
#pragma unroll
                    for (int i = 0; i < 32; ++i) o[i] += f[i] * cj[r];
}
            }
        }
        float* xrow = a.out + (size_t)n * DM + lane * 32;
        float s = 0.f;
#pragma unroll
        for (int q = 0; q < 8; ++q) { const f32x4 x4 = *(const f32x4*)(xrow + 4 * q);
            o[4 * q] += x4.x; o[4 * q + 1] += x4.y; o[4 * q + 2] += x4.z; o[4 * q + 3] += x4.w;
            s += (o[4 * q] * o[4 * q] + o[4 * q + 1] * o[4 * q + 1]) + (o[4 * q + 2] * o[4 * q + 2] + o[4 * q + 3] * o[4 * q + 3]); }
        const float rstd = 1.0f / sqrtf(wave_sum_u(s) * (1.0f / DM) + 1e-6f);
        if (l + 1 < NL) {
            bf16_t* xo = (bf16_t*)(a.ws + m.xn) + (size_t)n * DM + lane * 32;
#pragma unroll
            for (int q = 0; q < 8; ++q) *(f32x4*)(xrow + 4 * q) = (f32x4){o[4 * q], o[4 * q + 1], o[4 * q + 2], o[4 * q + 3]};
#pragma unroll
            for (int q = 0; q < 4; ++q) { v4u w; w.x = pk2(o[8 * q] * rstd, o[8 * q + 1] * rstd); w.y = pk2(o[8 * q + 2] * rstd, o[8 * q + 3] * rstd); w.z = pk2(o[8 * q + 4] * rstd, o[8 * q + 5] * rstd); w.w = pk2(o[8 * q + 6] * rstd, o[8 * q + 7] * rstd);
                *(v4u*)(xo + 8 * q) = w; }
        } else {
            const float* gf = a.in[I_NORM_FINAL] + lane * 32;
#pragma unroll
            for (int q = 0; q < 8; ++q) { const f32x4 g4 = *(const f32x4*)(gf + 4 * q);
                *(f32x4*)(xrow + 4 * q) = (f32x4){o[4 * q] * rstd * g4.x, o[4 * q + 1] * rstd * g4.y, o[4 * q + 2] * rstd * g4.z, o[4 * q + 3] * rstd * g4.w}; }
        }
    }
}

#define IN(k) (lo <= (k) && (k) < hi)
#define SEAM(k) do { if (IN(k) && IN((k) + 1)) xcd_barrier(bar); } while (0)
template <int l>
__device__ __forceinline__ void layer_phases(const Args& a, Frame& F, const XcdBarrier& bar, const WsMap& m, int lo, int hi) {
    constexpr int pb = l * PH_PER_LAYER;
        if (IN(pb + PH_GEMM1)) {
            pg8::GemmX g{(const bf16_t*)(a.ws + m.xn), (const bf16_t*)(a.ws + m.w1t) + (size_t)l * PLD * DM, NTOK, PLD, DM, DM};
            pg8::StaticOrder S; S.init(NTOK, PLD, F.G, (int)blockIdx.x);
            pg8::EpiBf16 E{(bf16_t*)(a.ws + m.p16), PLD, nullptr};
            pg8::gemm_phase<pg8::EpiBf16, pg8::StaticOrder, true, true>(F.lds, g, S, E);
            SEAM(pb + PH_GEMM1);
        }
        if (IN(pb + PH_PREP)) { prep_phase(a, F, l); SEAM(pb + PH_PREP); }
        if (IN(pb + PH_AUX)) {
            const float* PP = (const float*)(a.ws + m.pp);
            { pg8::GemmX g{(const bf16_t*)(a.ws + m.auxA), (const bf16_t*)(a.ws + m.auxwt) + (size_t)l * 1792 * 384, NTOK, 1792, 384, 384};
              pg8::StaticOrder S; S.init(NTOK, 1792, F.G, (int)blockIdx.x);
              pg8::EpiBf16 E{(bf16_t*)(a.ws + m.auxo), 1792, PP + l * 1792};
              pg8::gemm_phase<pg8::EpiBf16, pg8::StaticOrder, true, true>(F.lds, g, S, E); }
            { pg8::GemmX g{(const bf16_t*)(a.ws + m.xc), (const bf16_t*)(a.ws + m.lruwt) + (size_t)l * 1024 * 512, NTOK, 1024, 512, 512};
              pg8::StaticOrder S; S.init(NTOK, 1024, F.G, (int)blockIdx.x);
              pg8::EpiBf16 E{(bf16_t*)(a.ws + m.gates), 1024, PP + 3584 + l * 1024};
              pg8::gemm_phase<pg8::EpiBf16, pg8::StaticOrder, true, true>(F.lds, g, S, E); }
            if (l > 0) {
              pg8::GemmX g{(const bf16_t*)(a.ws + m.zrkv) + 1024, (const bf16_t*)(a.ws + m.vreswt), NTOK, 512, 512, 1536};
              pg8::StaticOrder S; S.init(NTOK, 512, F.G, (int)blockIdx.x);
              pg8::EpiBf16 E{(bf16_t*)(a.ws + m.vres), 512, PP + 5632};
              pg8::gemm_phase<pg8::EpiBf16, pg8::StaticOrder, true, true>(F.lds, g, S, E); }
            SEAM(pb + PH_AUX);
        }
        if (IN(pb + PH_SCAN)) { scan_phase(a, F, l); SEAM(pb + PH_SCAN); }
        if (IN(pb + PH_POST)) { post_phase(a, F, l, bar); SEAM(pb + PH_POST); }
        if (IN(pb + PH_GEMM2)) {
            pg8::GemmX g{(const bf16_t*)(a.ws + m.mix16), (const bf16_t*)(a.ws + m.w2t) + (size_t)l * DM * DM, NTOK, DM, DM, DM};
            pg8::StaticOrder S; S.init(NTOK, DM, F.G, (int)blockIdx.x);
            pg8::EpiF32<true> E{a.out, DM};
            pg8::gemm_phase<pg8::EpiF32<true>, pg8::StaticOrder, true, true>(F.lds, g, S, E);
            SEAM(pb + PH_GEMM2);
        }
        if (IN(pb + PH_NORM2)) { norm2_phase(a, F, l); SEAM(pb + PH_NORM2); }
        if (IN(pb + PH_GEMM3)) {
            pg8::GemmX g{(const bf16_t*)(a.ws + m.wsct) + (size_t)l * DM * DM, (const bf16_t*)(a.ws + m.hb), DM, NTOK, DM, DM};
            pg8::StaticOrder S; S.init(DM, NTOK, F.G, (int)blockIdx.x);
            pg8::EpiF32<false> E{(float*)(a.ws + m.sc), NTOK};
            pg8::gemm_phase<pg8::EpiF32<false>, pg8::StaticOrder, true, true>(F.lds, g, S, E);
            SEAM(pb + PH_GEMM3);
        }
        if (IN(pb + PH_TOPK)) { topk_phase(a, F); SEAM(pb + PH_TOPK); }
        if (IN(pb + PH_PEER)) { peer_phase(a, F, l); SEAM(pb + PH_PEER); }
}

#undef IN
#undef SEAM
__global__ void __launch_bounds__(NTHR, 2) mega(Args a) {
    extern __shared__ __attribute__((aligned(16))) unsigned char lds_raw[];
    Frame F;
    F.lds = (LAS unsigned char*)lds_raw;
    F.tid = threadIdx.x; F.lane = F.tid & 63; F.wave = __builtin_amdgcn_readfirstlane(F.tid >> 6);
    F.G = gridDim.x; { const int bx = blockIdx.x; F.vcu = (F.G % 8 == 0) ? (bx % 8) * (F.G / 8) + bx / 8 : bx; }
    F.gw = F.vcu * NWAVES + F.wave; F.ngw = F.G * NWAVES;
    volatile LAS unsigned* MISC = (volatile LAS unsigned*)(F.lds + MISC_OFF);
    if (F.tid < 32) MISC[F.tid] = 0u;
    __syncthreads();
    const WsMap m = ws_map(NTOK);
    unsigned* ctl = (unsigned*)(a.ws + m.ctl);
    XcdBarrier bar; bar.bar = ctl + 4096 + a.li * XCD_BAR_WORDS; bar.x = 0; bar.st = nullptr;
    const int lo = a.ph_lo, hi = a.ph_hi;
    if (hi - lo > 1) bar = xcd_barrier_post(ctl + 4096 + a.li * XCD_BAR_WORDS, MISC + 8);
#define IN(k) (lo <= (k) && (k) < hi)
#define SEAM(k) do { if (IN(k) && IN((k) + 1)) xcd_barrier(bar); } while (0)
    if (IN(PH_P0)) { p0_prologue(a, F); tables_range(a, F, 0, (size_t)2 * NEXP * DM / 32, F.vcu, F.G); SEAM(PH_P0); }
    layer_phases<0>(a, F, bar, m, lo, hi);
    layer_phases<1>(a, F, bar, m, lo, hi);
#undef IN
#undef SEAM
}

template <int ST>
__global__ void __launch_bounds__(256) stage_kernel(Params P, int l) {
    const long n = stage_items(P, ST, l);
    for (long it = blockIdx.x * 256L + threadIdx.x; it < n; it += gridDim.x * 256L) run_item(P, ST, l, it);
}
template <int ST>
static void launch_stage(const Params& P, int l, hipStream_t stream) {
    const long n = stage_items(P, ST, l);
    if (n <= 0) return;
    long blocks = (n + 255) / 256;
    if (blocks > 8192) blocks = 8192;
    stage_kernel<ST><<<dim3((unsigned)blocks), dim3(256), 0, stream>>>(P, l);
}
#define LS(X) case X: launch_stage<X>(P, l, stream); break;
static void launch_any(int st, const Params& P, int l, hipStream_t stream) {
    switch (st) {
        LS(ST_COPYX) LS(ST_RSTD) LS(ST_NORM1) LS(ST_GEMM1) LS(ST_RW_A0) LS(ST_RW_A1) LS(ST_RW_A2) LS(ST_RW_A3) LS(ST_RW_KKN)
        LS(ST_RW_SCAN) LS(ST_RW_POST) LS(ST_GLA_B0) LS(ST_GLA_SCAN) LS(ST_GLA_POST) LS(ST_LRU_C0) LS(ST_LRU_C1) LS(ST_LRU_SCAN)
        LS(ST_GDN_D0) LS(ST_GDN_D1) LS(ST_GDN_SCAN) LS(ST_GDN_POST) LS(ST_GEMM2) LS(ST_RSTD2) LS(ST_NORM2) LS(ST_GEMM3)
        LS(ST_SCORES) LS(ST_TOPK1) LS(ST_TOPK2) LS(ST_PEER_U) LS(ST_PEER_V) LS(ST_FRSTD) LS(ST_FNORM)
    }
}

extern "C" void kernel_launch(void* const* d_in, const int* in_sizes, int n_in, void* d_out, int out_size, void* d_ws,
                              size_t ws_size, hipStream_t stream) {
    static int grid = 0;
    if (grid == 0) {
        int dev = 0, cus = 0;
        (void)hipGetDevice(&dev);
        (void)hipDeviceGetAttribute(&cus, hipDeviceAttributeMultiprocessorCount, dev);
        (void)hipFuncSetAttribute((const void*)mega, hipFuncAttributeMaxDynamicSharedMemorySize, LDS_BYTES);
        grid = cus > 0 ? cus : 256;
    }
    Params P;
    memset(&P, 0, sizeof(P));
    fill_inputs(P, d_in);
    P.B = 4; P.T = 4096; P.N = 16384; P.pad = 0;
    P.xcur = (float*)d_out;
    bind_ws(P, (char*)d_ws);
    Args a;
    memset(&a, 0, sizeof(a));
    for (int i = 0; i < 38; ++i) a.in[i] = (const float*)d_in[i];
    a.out = (float*)d_out; a.ws = (unsigned char*)d_ws;
    (void)hipMemsetAsync(d_ws, 0, 1u << 20, stream);
    int li = 0;
    auto run_mega = [&](int lo, int hi) { a.ph_lo = lo; a.ph_hi = hi; a.li = li++; hipLaunchKernelGGL(mega, dim3(grid), dim3(NTHR), LDS_BYTES, stream, a); };
    run_mega(PH_P0, PH_TOTAL);
}
#endif
```

```cpp
#ifndef HOST_EMU
#include <hip/hip_runtime.h>
#include <cstring>
#define HD __host__ __device__ __forceinline__
#else
#include <cmath>
#include <cstdio>
#include <cstdlib>
#include <cstring>
#define HD inline
#endif

constexpr int DM = 2048;
constexpr int NL = 2;
constexpr int INC = 6424;
constexpr int C_RW = 0;
constexpr int C_GLA = 1792;
constexpr int C_LRU = 3344;
constexpr int C_GDN = 4368;
constexpr int NEXP = 16384;

typedef unsigned short bf16_t;
constexpr int PLD = 6656;
HD float bf2f(bf16_t h) { unsigned u = (unsigned)h << 16; float f; memcpy(&f, &u, 4); return f; }
HD bf16_t f2bf(float f) { unsigned u; memcpy(&u, &f, 4); return (bf16_t)((u + 0x7fffu + ((u >> 16) & 1u)) >> 16); }

struct Params {
    const float *x, *norm_mix, *w_in, *w_out, *rw_mu, *rw_w0, *rw_w_up, *rw_a0, *rw_a_up, *rw_g_up, *rw_k_k, *rw_k_a,
        *rw_r_k, *rw_ln_w, *rw_ln_b, *rw_v0, *rw_v_down, *rw_v_up, *gla_a_up, *gla_a_bias, *gla_norm, *lru_conv_w,
        *lru_conv_b, *lru_w_r, *lru_b_r, *lru_w_i, *lru_b_i, *lru_lam, *gdn_conv_w, *gdn_a_log, *gdn_dt_bias, *gdn_norm,
        *norm_ffn, *peer_wq, *peer_sub_keys, *peer_u, *peer_v, *norm_final;
    float* xcur;
    bf16_t* xn;
    bf16_t* hb;
    bf16_t* mix16;
    bf16_t* p16;
    float* sc;
    float* qf;
    float* rstd;
    float* vfirst;
    float* scr;
    float* act;
    float* gate;
    int* idx;
    int B, T, N, pad;
};

HD float sigmoidf_(float x) { return 1.0f / (1.0f + expf(-x)); }
HD float softplusf_(float x) { return log1pf(expf(-fabsf(x))) + fmaxf(x, 0.0f); }
HD float siluf_(float x) { return x * sigmoidf_(x); }
HD float geluf_(float x) { return 0.5f * x * (1.0f + tanhf(0.7978845608028654f * (x + 0.044715f * x * x * x))); }

enum Stage {
    ST_COPYX = 0,
    ST_RSTD, ST_NORM1, ST_GEMM1,
    ST_RW_A0, ST_RW_A1, ST_RW_A2, ST_RW_A3, ST_RW_KKN, ST_RW_SCAN, ST_RW_POST,
    ST_GLA_B0, ST_GLA_SCAN, ST_GLA_POST,
    ST_LRU_C0, ST_LRU_C1, ST_LRU_SCAN,
    ST_GDN_D0, ST_GDN_D1, ST_GDN_SCAN, ST_GDN_POST,
    ST_GEMM2, ST_RSTD2, ST_NORM2, ST_GEMM3, ST_SCORES, ST_TOPK1, ST_TOPK2, ST_PEER_U, ST_PEER_V,
    ST_FRSTD, ST_FNORM,
    ST_COUNT
};

constexpr long SO_ZS = 0, SO_R = 256, SO_DEC = 768, SO_KM = 1280, SO_KK = 1792, SO_A = 2304, SO_G = 2816, SO_V = 3328,
               SO_Y = 3840, SO_VD = 4352, SO_KKINV = 4384;
constexpr long SO_ALPHA = 0, SO_GO = 256;
constexpr long SO_XC = 0, SO_LA = 512, SO_LU = 1024;
constexpr long SO_QKV = 0, SO_GS = 1536, SO_DO = 1552;
constexpr long SCR_PER_TOK = 4400;
constexpr long SO_TS = 0, SO_TI = 256;

HD long stage_items(const Params& P, int st, int l) {
    const long N = P.N;
    switch (st) {
        case ST_COPYX: return N * DM;
        case ST_RSTD: case ST_RSTD2: case ST_FRSTD: return N;
        case ST_NORM1: case ST_NORM2: case ST_FNORM: return N * DM;
        case ST_GEMM1: return (N / 4) * (INC / 4);
        case ST_RW_A0: return N * 256;
        case ST_RW_A1: return N * 512;
        case ST_RW_A2: return l > 0 ? N * 32 : 0;
        case ST_RW_A3: return l > 0 ? N * 512 : 0;
        case ST_RW_KKN: return N * 8;
        case ST_RW_SCAN: return (long)P.B * 512;
        case ST_RW_POST: return N * 8;
        case ST_GLA_B0: return N * 256;
        case ST_GLA_SCAN: return (long)P.B * 512;
        case ST_GLA_POST: return N * 4;
        case ST_LRU_C0: return N * 512;
        case ST_LRU_C1: return N * 512;
        case ST_LRU_SCAN: return (long)P.B * 512;
        case ST_GDN_D0: return N * 1536;
        case ST_GDN_D1: return N * 4;
        case ST_GDN_SCAN: return (long)P.B * 512;
        case ST_GDN_POST: return N * 4;
        case ST_GEMM2: case ST_GEMM3: return (N / 4) * (DM / 4);
        case ST_SCORES: return N * 2048;
        case ST_TOPK1: return N * 16;
        case ST_TOPK2: return N * 8;
        case ST_PEER_U: return N * 128;
        case ST_PEER_V: return N * DM;
    }
    return 0;
}

HD void gemm_item(const bf16_t* A, const float* W, int ldw, const float* kscale, float* Cf, bf16_t* Ch, int ldc, int n4, long item, int mode) {
    const long r4 = item / n4;
    const int c4 = (int)(item % n4);
    const bf16_t* a0 = A + (r4 * 4) * (long)DM;
    const float* w = W + c4 * 4;
    float acc[4][4];
    for (int i = 0; i < 4; ++i)
        for (int j = 0; j < 4; ++j) acc[i][j] = 0.f;
    for (int k = 0; k < DM; ++k) {
        const float ks = kscale ? kscale[k] : 1.0f;
        const float w0 = w[(long)k * ldw + 0] * ks, w1 = w[(long)k * ldw + 1] * ks, w2 = w[(long)k * ldw + 2] * ks, w3 = w[(long)k * ldw + 3] * ks;
#pragma unroll
        for (int i = 0; i < 4; ++i) {
            const float a = bf2f(a0[(long)i * DM + k]);
            acc[i][0] += a * w0; acc[i][1] += a * w1; acc[i][2] += a * w2; acc[i][3] += a * w3;
        }
    }
#pragma unroll
    for (int i = 0; i < 4; ++i) {
        const long o = (r4 * 4 + i) * (long)ldc + c4 * 4;
#pragma unroll
        for (int j = 0; j < 4; ++j) {
            if (mode == 0) Ch[o + j] = f2bf(acc[i][j]);
            else if (mode == 1) Cf[o + j] += acc[i][j];
            else Cf[o + j] = acc[i][j];
        }
    }
}

#define PF(n, col) bf2f(P.p16[(long)(n) * PLD + (col)])
HD float rw_shift(const Params& P, int l, long n, int col) {
    const int t = (int)(n % P.T);
    const float cur = PF(n, C_RW + col);
    const float prev = t > 0 ? PF(n - 1, C_RW + col) : 0.f;
    return cur + (prev - cur) * P.rw_mu[l * 1792 + col];
}

HD void run_item(const Params& P, int st, int l, long it) {
    const long N = P.N;
    float* scr = P.scr;
    switch (st) {
        case ST_COPYX: P.xcur[it] = P.x[it]; break;
        case ST_RSTD: case ST_RSTD2: case ST_FRSTD: {
            const float* xr = P.xcur + it * DM;
            float s = 0.f;
            for (int d = 0; d < DM; ++d) s += xr[d] * xr[d];
            P.rstd[it] = 1.0f / sqrtf(s * (1.0f / DM) + 1e-6f);
        } break;
        case ST_NORM1: case ST_NORM2: case ST_FNORM: {
            const long n = it / DM; const int d = (int)(it % DM);
            if (st == ST_NORM1) P.xn[it] = f2bf(P.xcur[it] * P.rstd[n]);
            else if (st == ST_NORM2) P.hb[it] = f2bf(P.xcur[it] * P.rstd[n] * P.norm_ffn[l * DM + d]);
            else P.xcur[it] = P.xcur[it] * P.rstd[n] * P.norm_final[d];
        } break;
        case ST_GEMM1: gemm_item(P.xn, P.w_in + (long)l * DM * INC, INC, P.norm_mix + l * DM, nullptr, P.p16, PLD, INC / 4, it, 0); break;
        case ST_GEMM2: gemm_item(P.mix16, P.w_out + (long)l * DM * DM, DM, nullptr, P.xcur, nullptr, DM, DM / 4, it, 1); break;
        case ST_GEMM3: gemm_item(P.hb, P.peer_wq + (long)l * DM * DM, DM, nullptr, P.qf, nullptr, DM, DM / 4, it, 2); break;
        case ST_RW_A0: {
            const long n = it / 256; const int c = (int)(it % 256);
            const float z = rw_shift(P, l, n, 1536 + c);
            scr[N * SO_ZS + it] = c < 64 ? tanhf(z) : (c < 128 ? z : sigmoidf_(z));
        } break;
        case ST_RW_A1: {
            const long n = it / 512; const int j = (int)(it % 512);
            const float zr = rw_shift(P, l, n, j), zk = rw_shift(P, l, n, 512 + j), zv = rw_shift(P, l, n, 1024 + j);
            const float* zs = scr + N * SO_ZS + n * 256;
            float aw = P.rw_w0[l * 512 + j], aa = P.rw_a0[l * 512 + j], ag = 0.f;
            const float* wu = P.rw_w_up + (long)l * 64 * 512 + j;
            const float* au = P.rw_a_up + (long)l * 64 * 512 + j;
            const float* gu = P.rw_g_up + (long)l * 128 * 512 + j;
            for (int i = 0; i < 64; ++i) { aw += zs[i] * wu[i * 512]; aa += zs[64 + i] * au[i * 512]; }
            for (int i = 0; i < 128; ++i) ag += zs[128 + i] * gu[i * 512];
            const float w_raw = -softplusf_(-aw) - 0.5f;
            const float a = sigmoidf_(aa);
            scr[N * SO_R + it] = zr;
            scr[N * SO_DEC + it] = expf(-expf(w_raw));
            scr[N * SO_KM + it] = zk * (1.0f + (a - 1.0f) * P.rw_k_a[l * 512 + j]);
            scr[N * SO_KK + it] = zk * P.rw_k_k[l * 512 + j];
            scr[N * SO_A + it] = a;
            scr[N * SO_G + it] = ag;
            scr[N * SO_V + it] = zv;
            if (l == 0) P.vfirst[it] = zv;
        } break;
        case ST_RW_A2: {
            const long n = it / 32; const int i = (int)(it % 32);
            const float* v = scr + N * SO_V + n * 512;
            const float* vdn = P.rw_v_down + (long)(l - 1) * 512 * 32 + i;
            float s = 0.f;
            for (int j = 0; j < 512; ++j) s += v[j] * vdn[j * 32];
            scr[N * SO_VD + it] = s;
        } break;
        case ST_RW_A3: {
            const long n = it / 512; const int j = (int)(it % 512);
            const float* vd = scr + N * SO_VD + n * 32;
            const float* vup = P.rw_v_up + (long)(l - 1) * 32 * 512 + j;
            float s = P.rw_v0[(l - 1) * 512 + j];
            for (int i = 0; i < 32; ++i) s += vd[i] * vup[i * 512];
            const float v = scr[N * SO_V + it];
            scr[N * SO_V + it] = v + (P.vfirst[it] - v) * sigmoidf_(s);
        } break;
        case ST_RW_KKN: {
            const float* kk = scr + N * SO_KK + it * 64;
            float s = 0.f;
            for (int i = 0; i < 64; ++i) s += kk[i] * kk[i];
            scr[N * SO_KKINV + it] = 1.0f / sqrtf(fmaxf(s, 1e-24f));
        } break;
        case ST_RW_SCAN: {
            const int b = (int)(it / 512); const int h = (int)((it % 512) / 64); const int v = (int)(it % 64);
            float S[64];
#pragma unroll
            for (int i = 0; i < 64; ++i) S[i] = 0.f;
            for (int t = 0; t < P.T; ++t) {
                const long n = (long)b * P.T + t;
                const long base = n * 512 + h * 64;
                const float inv = scr[N * SO_KKINV + n * 8 + h];
                const float vv = scr[N * SO_V + base + v];
                const float* KK = scr + N * SO_KK + base;
                const float* DEC = scr + N * SO_DEC + base;
                const float* KM = scr + N * SO_KM + base;
                const float* AA = scr + N * SO_A + base;
                const float* RR = scr + N * SO_R + base;
                float sa = 0.f;
#pragma unroll
                for (int i = 0; i < 64; ++i) sa += S[i] * (-KK[i] * inv);
                float y = 0.f;
#pragma unroll
                for (int i = 0; i < 64; ++i) {
                    const float kk = KK[i] * inv;
                    S[i] = S[i] * DEC[i] + sa * (kk * AA[i]) + vv * KM[i];
                    y += S[i] * RR[i];
                }
                scr[N * SO_Y + base + v] = y;
            }
        } break;
        case ST_RW_POST: {
            const long n = it / 8; const int h = (int)(it % 8);
            const long base = n * 512 + h * 64;
            const float* Y = scr + N * SO_Y + base;
            const float* RR = scr + N * SO_R + base;
            const float* KM = scr + N * SO_KM + base;
            const float* V = scr + N * SO_V + base;
            const float* G = scr + N * SO_G + base;
            float mean = 0.f, bon = 0.f;
            for (int i = 0; i < 64; ++i) { mean += Y[i]; bon += RR[i] * KM[i] * P.rw_r_k[l * 512 + h * 64 + i]; }
            mean *= (1.0f / 64);
            float var = 0.f;
            for (int i = 0; i < 64; ++i) { const float d = Y[i] - mean; var += d * d; }
            const float rs = 1.0f / sqrtf(var * (1.0f / 64) + 64e-5f);
            for (int i = 0; i < 64; ++i) {
                const int c = h * 64 + i;
                const float yn = (Y[i] - mean) * rs * P.rw_ln_w[l * 512 + c] + P.rw_ln_b[l * 512 + c];
                P.mix16[n * DM + c] = f2bf((yn + bon * V[i]) * G[i]);
            }
        } break;
        case ST_GLA_B0: {
            const long n = it / 256; const int c = (int)(it % 256);
            float s = P.gla_a_bias[l * 256 + c];
            for (int i = 0; i < 16; ++i) s += PF(n, C_GLA + 1536 + i) * P.gla_a_up[(long)l * 16 * 256 + i * 256 + c];
            scr[N * SO_ALPHA + it] = expf(-softplusf_(-s) * (1.0f / 16.0f));
        } break;
        case ST_GLA_SCAN: {
            const int b = (int)(it / 512); const int h = (int)((it % 512) / 128); const int v = (int)(it % 128);
            float S[64];
#pragma unroll
            for (int i = 0; i < 64; ++i) S[i] = 0.f;
            for (int t = 0; t < P.T; ++t) {
                const long n = (long)b * P.T + t;
                const bf16_t* q = P.p16 + n * PLD + C_GLA + h * 64;
                const bf16_t* k = q + 256;
                const float vv = PF(n, C_GLA + 512 + h * 128 + v);
                const float* al = scr + N * SO_ALPHA + n * 256 + h * 64;
                float o = 0.f;
#pragma unroll
                for (int i = 0; i < 64; ++i) {
                    S[i] = S[i] * al[i] + bf2f(k[i]) * vv;
                    o += bf2f(q[i]) * S[i];
                }
                scr[N * SO_GO + n * 512 + h * 128 + v] = o * 0.125f;
            }
        } break;
        case ST_GLA_POST: {
            const long n = it / 4; const int h = (int)(it % 4);
            const float* o = scr + N * SO_GO + n * 512 + h * 128;
            float ms = 0.f;
            for (int i = 0; i < 128; ++i) ms += o[i] * o[i];
            const float rs = 1.0f / sqrtf(ms * (1.0f / 128) + 1e-6f);
            for (int i = 0; i < 128; ++i) {
                const float g = PF(n, C_GLA + 1024 + h * 128 + i);
                P.mix16[n * DM + 512 + h * 128 + i] = f2bf(o[i] * rs * P.gla_norm[l * 128 + i] * siluf_(g));
            }
        } break;
        case ST_LRU_C0: {
            const long n = it / 512; const int c = (int)(it % 512);
            const int t = (int)(n % P.T);
            float s = P.lru_conv_b[l * 512 + c];
            for (int j = 0; j < 4; ++j) {
                const int tt = t - 3 + j;
                if (tt >= 0) s += P.lru_conv_w[(long)l * 4 * 512 + j * 512 + c] * PF(n - 3 + j, C_LRU + c);
            }
            scr[N * SO_XC + it] = s;
        } break;
        case ST_LRU_C1: {
            const long n = it / 512; const int c = (int)(it % 512);
            const int blk = c / 64, j = c % 64;
            const float* xc = scr + N * SO_XC + n * 512 + blk * 64;
            const float* wr = P.lru_w_r + (long)l * 8 * 64 * 64 + (long)blk * 64 * 64 + j;
            const float* wi = P.lru_w_i + (long)l * 8 * 64 * 64 + (long)blk * 64 * 64 + j;
            float sr = P.lru_b_r[l * 512 + c], si = P.lru_b_i[l * 512 + c];
            for (int i = 0; i < 64; ++i) { sr += xc[i] * wr[i * 64]; si += xc[i] * wi[i * 64]; }
            const float r = sigmoidf_(sr), ig = sigmoidf_(si);
            const float log_a = -8.0f * r * softplusf_(-P.lru_lam[l * 512 + c]);
            scr[N * SO_LA + it] = expf(log_a);
            scr[N * SO_LU + it] = scr[N * SO_XC + it] * ig * sqrtf(-expm1f(2.0f * log_a));
        } break;
        case ST_LRU_SCAN: {
            const int b = (int)(it / 512); const int c = (int)(it % 512);
            float hst = 0.f;
            for (int t = 0; t < P.T; ++t) {
                const long n = (long)b * P.T + t;
                hst = scr[N * SO_LA + n * 512 + c] * hst + scr[N * SO_LU + n * 512 + c];
                P.mix16[n * DM + 1024 + c] = f2bf(hst * geluf_(PF(n, C_LRU + 512 + c)));
            }
        } break;
        case ST_GDN_D0: {
            const long n = it / 1536; const int c = (int)(it % 1536);
            const int t = (int)(n % P.T);
            float s = 0.f;
            for (int j = 0; j < 4; ++j) {
                const int tt = t - 3 + j;
                if (tt >= 0) s += P.gdn_conv_w[(long)l * 4 * 1536 + j * 1536 + c] * PF(n - 3 + j, C_GDN + c);
            }
            scr[N * SO_QKV + it] = siluf_(s);
        } break;
        case ST_GDN_D1: {
            const long n = it / 4; const int h = (int)(it % 4);
            const float* q = scr + N * SO_QKV + n * 1536 + h * 128;
            const float* k = q + 512;
            float qs = 0.f, ks = 0.f;
            for (int i = 0; i < 128; ++i) { qs += q[i] * q[i]; ks += k[i] * k[i]; }
            float* gs = scr + N * SO_GS + n * 16 + h * 4;
            gs[0] = (1.0f / sqrtf(qs + 1e-6f)) * 0.08838834764831845f;
            gs[1] = 1.0f / sqrtf(ks + 1e-6f);
            gs[2] = sigmoidf_(PF(n, C_GDN + 2048 + h));
            gs[3] = expf(-expf(P.gdn_a_log[l * 4 + h]) * softplusf_(PF(n, C_GDN + 2052 + h) + P.gdn_dt_bias[l * 4 + h]));
        } break;
        case ST_GDN_SCAN: {
            const int b = (int)(it / 512); const int h = (int)((it % 512) / 128); const int v = (int)(it % 128);
            float S[128];
#pragma unroll
            for (int i = 0; i < 128; ++i) S[i] = 0.f;
            for (int t = 0; t < P.T; ++t) {
                const long n = (long)b * P.T + t;
                const float* q = scr + N * SO_QKV + n * 1536 + h * 128;
                const float* k = q + 512;
                const float vv = scr[N * SO_QKV + n * 1536 + 1024 + h * 128 + v];
                const float* gs = scr + N * SO_GS + n * 16 + h * 4;
                const float qinv = gs[0], kinv = gs[1], beta = gs[2], eg = gs[3];
                float dk = 0.f;
#pragma unroll
                for (int i = 0; i < 128; ++i) dk += S[i] * k[i];
                const float u = beta * (vv - eg * kinv * dk) * kinv;
                float o = 0.f;
#pragma unroll
                for (int i = 0; i < 128; ++i) {
                    S[i] = S[i] * eg + u * k[i];
                    o += S[i] * q[i];
                }
                scr[N * SO_DO + n * 512 + h * 128 + v] = o * qinv;
            }
        } break;
        case ST_GDN_POST: {
            const long n = it / 4; const int h = (int)(it % 4);
            const float* o = scr + N * SO_DO + n * 512 + h * 128;
            float ms = 0.f;
            for (int i = 0; i < 128; ++i) ms += o[i] * o[i];
            const float rs = 1.0f / sqrtf(ms * (1.0f / 128) + 1e-6f);
            for (int i = 0; i < 128; ++i) {
                const float z = PF(n, C_GDN + 1536 + h * 128 + i);
                P.mix16[n * DM + 1536 + h * 128 + i] = f2bf(o[i] * rs * P.gdn_norm[l * 128 + i] * siluf_(z));
            }
        } break;
        case ST_SCORES: {
            const long n = it / 2048; const int c = (int)(it % 2048);
            const int hp = c / 128, key = c % 128;
            const float* q = P.qf + n * DM + hp * 128;
            const float* sk = P.peer_sub_keys + (long)l * 16 * 128 * 128 + ((long)hp * 128 + key) * 128;
            float s = 0.f;
            for (int d = 0; d < 128; ++d) s += q[d] * sk[d];
            P.sc[it] = s;
        } break;
        case ST_TOPK1: {
            const float* sc = P.sc + it * 128;
            float ts[16]; int ti[16];
#pragma unroll
            for (int j = 0; j < 16; ++j) { ts[j] = -3.0e38f; ti[j] = 0; }
            for (int i = 0; i < 128; ++i) {
                float xv = sc[i]; int xi = i;
                if (xv > ts[15]) {
#pragma unroll
                    for (int j = 0; j < 16; ++j) {
                        if (xv > ts[j]) { const float tv = ts[j]; const int tj = ti[j]; ts[j] = xv; ti[j] = xi; xv = tv; xi = tj; }
                    }
                }
            }
            float* TS = scr + N * SO_TS + it * 16;
            int* TI = (int*)(scr + N * SO_TI) + it * 16;
#pragma unroll
            for (int j = 0; j < 16; ++j) { TS[j] = ts[j]; TI[j] = ti[j]; }
        } break;
        case ST_TOPK2: {
            const float* s0 = scr + N * SO_TS + it * 32;
            const float* s1 = s0 + 16;
            const int* i0 = (const int*)(scr + N * SO_TI) + it * 32;
            const int* i1 = i0 + 16;
            float ts[16]; int ti[16];
#pragma unroll
            for (int j = 0; j < 16; ++j) { ts[j] = -3.0e38f; ti[j] = 0; }
            for (int a = 0; a < 16; ++a) {
                const int jmax = 16 / (a + 1);
                for (int b = 0; b < jmax; ++b) {
                    float xv = s0[a] + s1[b]; int xi = i0[a] * 128 + i1[b];
                    if (xv > ts[15]) {
#pragma unroll
                        for (int j = 0; j < 16; ++j) {
                            if (xv > ts[j]) { const float tv = ts[j]; const int tj = ti[j]; ts[j] = xv; ti[j] = xi; xv = tv; xi = tj; }
                        }
                    }
                }
            }
            const float mx = ts[0];
            float den = 0.f;
#pragma unroll
            for (int j = 0; j < 16; ++j) { ts[j] = expf(ts[j] - mx); den += ts[j]; }
            const float inv = 1.0f / den;
#pragma unroll
            for (int j = 0; j < 16; ++j) { P.gate[it * 16 + j] = ts[j] * inv; P.idx[it * 16 + j] = ti[j]; }
        } break;
        case ST_PEER_U: {
            const long n = it / 128;
            const int e = P.idx[it];
            const float* u = P.peer_u + ((long)l * NEXP + e) * DM;
            const bf16_t* hx = P.hb + n * DM;
            float s = 0.f;
            for (int d = 0; d < DM; ++d) s += bf2f(hx[d]) * u[d];
            P.act[it] = geluf_(s) * P.gate[it];
        } break;
        case ST_PEER_V: {
            const long n = it / DM; const int d = (int)(it % DM);
            const float* a = P.act + n * 128;
            const int* ix = P.idx + n * 128;
            float s = 0.f;
            for (int j = 0; j < 128; ++j) s += a[j] * P.peer_v[((long)l * NEXP + ix[j]) * DM + d];
            P.xcur[it] += s;
        } break;
    }
}


struct WsMap {
    size_t ctl, w1t, w2t, wsct, auxwt, lruwt, vreswt, pp, tabu, tabv, xn, hb, mix16, p16, sc, aux, vfirst, idx, gate, rstd, act, end;
    size_t auxA, zrkv, xc, auxo, gates, vres, glao, gdno, gq, gk, gv, gsc, rwy, rwbv, lrs, gblob;
    size_t scr, qf;
};
HD WsMap ws_map(size_t N) {
    WsMap m{};
    size_t o = 0;
    auto take = [&](size_t bytes) { size_t r = o; o += (bytes + 4095) & ~(size_t)4095; return r; };
    m.ctl = take(1u << 20);
    m.w1t = take((size_t)NL * PLD * DM * 2);
    m.w2t = take((size_t)NL * DM * DM * 2);
    m.wsct = take((size_t)NL * DM * DM * 2);
    m.auxwt = take((size_t)NL * 1792 * 384 * 2);
    m.lruwt = take((size_t)NL * 1024 * 512 * 2);
    m.vreswt = take((size_t)512 * 512 * 2);
    m.pp = take(1u << 20);
    m.xn = take(N * DM * 2);
    m.hb = take(N * DM * 2);
    m.mix16 = take(N * DM * 2);
    m.p16 = take(N * PLD * 2);
    m.sc = m.p16;
    m.vfirst = take(N * 512 * 4);
    m.idx = take(N * 128 * 4);
    m.gate = take(N * 128 * 4);
    m.act = take(N * 128 * 4);
    m.rstd = take(N * 4);
    m.tabu = take((size_t)NL * 2 * NEXP * DM);
    m.tabv = m.tabu + (size_t)NEXP * DM;
    m.aux = take(N * 5488 * 4);
    m.end = o;
    size_t a = m.aux;
    auto sub = [&](size_t bytes) { size_t r = a; a += (bytes + 4095) & ~(size_t)4095; return r; };
    m.auxA = sub(N * 384 * 2); m.zrkv = sub(N * 1536 * 2); m.xc = sub(N * 512 * 2); m.auxo = sub(N * 1792 * 2);
    m.gates = sub(N * 1024 * 2); m.vres = sub(N * 512 * 2); m.glao = sub(N * 512 * 2); m.gdno = sub(N * 512 * 2);
    m.gq = sub(N * 512 * 2); m.gk = sub(N * 512 * 2); m.gv = sub(N * 512 * 2); m.gsc = sub(N * 8 * 4); m.rwy = sub(N * 512 * 2); m.rwbv = sub(N * 512 * 2); m.lrs = sub(N / 64 * 512 * 2 * 4);
    m.gblob = sub(N / 64 * 4 * 18688);
    m.scr = m.tabu;
    m.qf = m.aux + N * 1024 * 4;
    return m;
}
static inline void bind_ws(Params& P, char* ws) {
    const WsMap m = ws_map((size_t)P.N);
    P.xn = (bf16_t*)(ws + m.xn); P.hb = (bf16_t*)(ws + m.hb); P.mix16 = (bf16_t*)(ws + m.mix16); P.p16 = (bf16_t*)(ws + m.p16);
    P.sc = (float*)(ws + m.sc); P.qf = (float*)(ws + m.qf); P.rstd = (float*)(ws + m.rstd); P.vfirst = (float*)(ws + m.vfirst);
    P.scr = (float*)(ws + m.scr); P.act = (float*)(ws + m.act); P.gate = (float*)(ws + m.gate); P.idx = (int*)(ws + m.idx);
}

struct Step { int st, l; };
static inline int build_schedule(Step* s) {
    int n = 0;
    s[n++] = {ST_COPYX, 0};
    for (int l = 0; l < NL; ++l) {
        static const int per_layer[] = {ST_RSTD, ST_NORM1, ST_GEMM1,
            ST_RW_A0, ST_RW_A1, ST_RW_A2, ST_RW_A3, ST_RW_KKN, ST_RW_SCAN, ST_RW_POST,
            ST_GLA_B0, ST_GLA_SCAN, ST_GLA_POST, ST_LRU_C0, ST_LRU_C1, ST_LRU_SCAN,
            ST_GDN_D0, ST_GDN_D1, ST_GDN_SCAN, ST_GDN_POST,
            ST_GEMM2, ST_RSTD2, ST_NORM2, ST_GEMM3, ST_SCORES, ST_TOPK1, ST_TOPK2, ST_PEER_U, ST_PEER_V};
        for (int i = 0; i < (int)(sizeof(per_layer) / sizeof(int)); ++i) s[n++] = {per_layer[i], l};
    }
    s[n++] = {ST_FRSTD, 0};
    s[n++] = {ST_FNORM, 0};
    return n;
}

static inline void fill_inputs(Params& P, void* const* d_in) {
    const float** dst = (const float**)&P;
    for (int i = 0; i < 38; ++i) dst[i] = (const float*)d_in[i];
}

#ifndef HOST_EMU
#define GAS __attribute__((address_space(1)))
#define LAS __attribute__((address_space(3)))
typedef unsigned v4u __attribute__((ext_vector_type(4)));
typedef unsigned v2u __attribute__((ext_vector_type(2)));
typedef float f32x4 __attribute__((ext_vector_type(4)));
typedef float f32x2 __attribute__((ext_vector_type(2)));
typedef short bf16x8 __attribute__((ext_vector_type(8)));
constexpr int NWAVES = 8, NTHR = 512;
constexpr int RING_BYTES = 131072, MISC_OFF = RING_BYTES + 320, LDS_BYTES = 147456;
constexpr int NTOK = 16384, TSEQ = 4096, NBATCH = 4;

__device__ __forceinline__ unsigned pk2(float lo, float hi) { return (unsigned)f2bf(lo) | ((unsigned)f2bf(hi) << 16); }
__device__ __forceinline__ float bflo(unsigned u) { return __builtin_bit_cast(float, u << 16); }
__device__ __forceinline__ float bfhi(unsigned u) { return __builtin_bit_cast(float, u & 0xffff0000u); }
__device__ __forceinline__ float wave_sum(float v) {
#pragma unroll
    for (int o = 1; o < 64; o <<= 1) v += __shfl_xor(v, o);
    return v;
}
#define LDS_WAIT() asm volatile("s_waitcnt lgkmcnt(0)" ::: "memory")
#define VM_WAIT() asm volatile("s_waitcnt vmcnt(0)" ::: "memory")

namespace pg8 {
#define PG8_LAS __attribute__((address_space(3)))
constexpr int BM = 256, BK = 64, HALF = 128, HTB = HALF * BK * 2, STAGE_BYTES = 8 * HTB, NXCD = 8, WGM = 8;
__host__ __device__ __forceinline__ int lds_byte(int r, int c) { const int st = (r >> 4) * 2 + (c >> 5), rr = r & 15, cc = c & 31, ob = rr * 64 + cc * 2; return st * 1024 + (ob ^ (((ob >> 9) & 1) << 5)); }
__host__ __device__ __forceinline__ void stage_rc(int b, int& R, int& C) { const int st = b / 1024, sb = b % 1024, swz = sb ^ (((sb >> 9) & 1) << 5); R = (st >> 1) * 16 + swz / 64; C = (st & 1) * 32 + (swz % 64) / 2; }
__host__ __device__ __forceinline__ int perm32(int rho) { const int n = rho >> 4, i = rho & 15; return 8 * (i >> 2) + 4 * n + (i & 3); }
struct Unit { int pm, pn; };
struct GemmX { const bf16_t* A; const bf16_t* Bt; int M, N, K, lda; };
struct StaticOrder {
    int nM, nN, nwg, G, c;
    __host__ __device__ void init(int M, int N, int G_, int c_) { nM = M / BM; nN = N / BM; nwg = nM * nN; G = G_; c = c_; }
    __host__ __device__ bool next(int i, Unit& u) const {
        const long L = (long)i * G + c; if (L >= nwg) return false;
        int wgid = (int)L; { const int q = nwg / NXCD, r = nwg % NXCD, xcd = wgid % NXCD, off = wgid / NXCD; wgid = (xcd < r ? xcd * (q + 1) : r * (q + 1) + (xcd - r) * q) + off; }
        const int nig = WGM * nN, gid = wgid / nig, fm = gid * WGM, gsz = (nM - fm) < WGM ? (nM - fm) : WGM;
        u.pm = fm + ((wgid % nig) % gsz); u.pn = (wgid % nig) / gsz; return true;
    }
    __device__ __forceinline__ void a_ready(const Unit&) const {}
    __device__ __forceinline__ void done(const Unit&) const {}
};
__device__ __forceinline__ unsigned cvt_pk_bf16(float lo, float hi) { unsigned r; asm volatile("v_cvt_pk_bf16_f32 %0, %1, %2" : "=v"(r) : "v"(lo), "v"(hi)); return r; }
template <bool ACCUM> struct EpiF32 {
    static constexpr bool PERM = false, AFTER_DRAIN = false;
    float* C; int ldc;
    __device__ __forceinline__ void operator()(const f32x4 (&acc)[2][2][4][2], const Unit& u, int wr, int wc, int fr, int fq) const {
        const int row0 = u.pm * BM + wr * 64 + fr, col0 = u.pn * BM + wc * 32 + 4 * fq;
#pragma unroll
        for (int ai = 0; ai < 2; ++ai)
#pragma unroll
            for (int m = 0; m < 4; ++m) { float* rowp = C + (size_t)(row0 + ai * HALF + m * 16) * ldc + col0;
#pragma unroll
                for (int bj = 0; bj < 2; ++bj)
#pragma unroll
                    for (int n = 0; n < 2; ++n) { f32x4* p = (f32x4*)(rowp + bj * HALF + n * 16);
                        if (ACCUM) *p = *p + acc[ai][bj][m][n]; else *p = acc[ai][bj][m][n]; } }
    }
};
struct EpiBf16 {
    static constexpr bool PERM = true, AFTER_DRAIN = false;
    bf16_t* O; int ldc; const float* bias;
    __device__ __forceinline__ void operator()(const f32x4 (&acc)[2][2][4][2], const Unit& u, int wr, int wc, int fr, int fq) const {
        const int row0 = u.pm * BM + wr * 64 + fr; const int col0 = u.pn * BM + wc * 32 + 8 * fq;
        f32x4 bv[2][2];
#pragma unroll
        for (int bj = 0; bj < 2; ++bj)
#pragma unroll
            for (int n = 0; n < 2; ++n) bv[bj][n] = bias ? *(const f32x4*)(bias + col0 + bj * HALF + 4 * n) : (f32x4){0.f, 0.f, 0.f, 0.f};
#pragma unroll
        for (int ai = 0; ai < 2; ++ai)
#pragma unroll
            for (int m = 0; m < 4; ++m) { bf16_t* rowp = O + (size_t)(row0 + ai * HALF + m * 16) * ldc + col0;
#pragma unroll
                for (int bj = 0; bj < 2; ++bj) { const f32x4 v0 = acc[ai][bj][m][0] + bv[bj][0], v1 = acc[ai][bj][m][1] + bv[bj][1];
                    v4u w; w.x = cvt_pk_bf16(v0[0], v0[1]); w.y = cvt_pk_bf16(v0[2], v0[3]); w.z = cvt_pk_bf16(v1[0], v1[1]); w.w = cvt_pk_bf16(v1[2], v1[3]);
                    *(v4u*)(rowp + bj * HALF) = w; } }
    }
};
template <class Epi, class Sched, bool ALIGN_EPI = false, bool SP2 = false>
__device__ __forceinline__ void gemm_phase(PG8_LAS unsigned char* lds, const GemmX g, const Sched& S, const Epi& E) {
    const int tid = threadIdx.x, wid = __builtin_amdgcn_readfirstlane(tid >> 6), lane = tid & 63, wr = wid >> 2, wc = wid & 3, fr = lane & 15, fq = lane >> 4;
    const int K = g.K, nt = K / BK;
    unsigned voffA[2], voffB[2];
#pragma unroll
    for (int i = 0; i < 2; ++i) { int R, C; stage_rc(tid * 16 + i * 8192, R, C); const int Rb = Epi::PERM ? ((R & ~31) + perm32(R & 31)) : R;
        voffA[i] = (unsigned)(R * g.lda + C) * 2u; voffB[i] = (unsigned)(Rb * K + C) * 2u; }
    const size_t kstep = (size_t)(BK * 2);
    const size_t hstep = (size_t)HALF * K * 2;
    const size_t tstep = 2 * hstep;
    const size_t hstepA = (size_t)HALF * g.lda * 2, tstepA = 2 * hstepA;
    const unsigned ldsw = (unsigned)wid * 1024u;
    const int aoff = lds_byte(wr * 64 + fr, fq * 8), boff = lds_byte(wc * 32 + fr, fq * 8);
#define PG8_SA(b, h) (((b) * 2 + (h)) * HTB)
#define PG8_SB(b, h) ((4 + (b) * 2 + (h)) * HTB)
#define PG8_STAGE(bufoff, gbase, voff) do { _Pragma("unroll") for (int _i = 0; _i < 2; ++_i) \
        __builtin_amdgcn_global_load_lds((const unsigned*)((const char*)(gbase) + (voff)[_i]), (PG8_LAS unsigned*)(lds + (bufoff) + ldsw + _i * 8192), 16, 0, 0); } while (0)
#define PG8_LDA(dst, b, h) do { _Pragma("unroll") for (int m = 0; m < 4; ++m) _Pragma("unroll") for (int k = 0; k < 2; ++k) dst[m][k] = *(const PG8_LAS bf16x8*)(lds + PG8_SA(b, h) + aoff + m * 2048 + k * 1024); } while (0)
#define PG8_LDB(dst, b, h) do { _Pragma("unroll") for (int n = 0; n < 2; ++n) _Pragma("unroll") for (int k = 0; k < 2; ++k) dst[n][k] = *(const PG8_LAS bf16x8*)(lds + PG8_SB(b, h) + boff + n * 2048 + k * 1024); } while (0)
#define PG8_MMA(ai, bj, At, Bt) do { __builtin_amdgcn_s_setprio(1); _Pragma("unroll") for (int m = 0; m < 4; ++m) _Pragma("unroll") for (int n = 0; n < 2; ++n) _Pragma("unroll") for (int k = 0; k < 2; ++k) \
        acc[ai][bj][m][n] = __builtin_amdgcn_mfma_f32_16x16x32_bf16(Bt[n][k], At[m][k], acc[ai][bj][m][n], 0, 0, 0); __builtin_amdgcn_s_setprio(0); } while (0)
#define PG8_WAIT_V(n) asm volatile("s_waitcnt vmcnt(" #n ")" ::: "memory")
#define PG8_WAIT_L(n) asm volatile("s_waitcnt lgkmcnt(" #n ")" ::: "memory")
#define PG8_BAR __builtin_amdgcn_s_barrier()
#define PG8_SCHED __builtin_amdgcn_sched_barrier(0)
    Unit cur, nxt; int ui = 0;
    if (!S.next(0, cur)) return;
    f32x4 acc[2][2][4][2];
#pragma unroll
    for (int a = 0; a < 2; ++a)
#pragma unroll
        for (int b = 0; b < 2; ++b)
#pragma unroll
            for (int m = 0; m < 4; ++m)
#pragma unroll
                for (int n = 0; n < 2; ++n) acc[a][b][m][n] = (f32x4){0.f, 0.f, 0.f, 0.f};
    bf16x8 At[4][2], B0[2][2], B1[2][2];
    const char* cA = (const char*)g.A + (size_t)cur.pm * tstepA; const char* cB = (const char*)g.Bt + (size_t)cur.pn * tstep;
    S.a_ready(cur);
    if constexpr (SP2) {
        PG8_STAGE(PG8_SB(0, 0), cB, voffB); PG8_STAGE(PG8_SB(0, 1), cB + hstep, voffB); PG8_STAGE(PG8_SA(0, 0), cA, voffA); PG8_STAGE(PG8_SA(0, 1), cA + hstepA, voffA);
        if (wr == 1) PG8_BAR;
        PG8_WAIT_V(2); PG8_BAR;
        PG8_STAGE(PG8_SB(1, 0), cB + kstep, voffB); PG8_STAGE(PG8_SA(1, 0), cA + kstep, voffA); PG8_STAGE(PG8_SB(1, 1), cB + hstep + kstep, voffB);
        PG8_WAIT_V(6); PG8_BAR;
    } else {
        PG8_STAGE(PG8_SB(0, 0), cB, voffB); PG8_STAGE(PG8_SA(0, 0), cA, voffA); PG8_STAGE(PG8_SB(0, 1), cB + hstep, voffB); PG8_STAGE(PG8_SA(0, 1), cA + hstepA, voffA);
        if (wr == 1) PG8_BAR;
        PG8_WAIT_V(4); PG8_BAR;
        PG8_STAGE(PG8_SB(1, 0), cB + kstep, voffB); PG8_STAGE(PG8_SA(1, 0), cA + kstep, voffA); PG8_STAGE(PG8_SB(1, 1), cB + hstep + kstep, voffB);
        PG8_WAIT_V(6); PG8_BAR;
    }
    for (;;) {
        const bool has_next = S.next(ui + 1, nxt);
        const char* nA = has_next ? (const char*)g.A + (size_t)nxt.pm * tstepA : cA; const char* nB = has_next ? (const char*)g.Bt + (size_t)nxt.pn * tstep : cB;
        for (int t = 0; t < nt; t += 2) {
            const bool last = (t == nt - 2);
            const char* a1 = cA + (size_t)(t + 1) * kstep;
            const char* a2 = last ? nA : cA + (size_t)(t + 2) * kstep; const char* b2 = last ? nB : cB + (size_t)(t + 2) * kstep;
            const char* a3 = a2 + kstep; const char* b3 = b2 + kstep;
            if (last && has_next) S.a_ready(nxt);
            if constexpr (SP2) {
            PG8_LDB(B0, 0, 0); PG8_LDB(B1, 0, 1); PG8_SCHED; PG8_LDA(At, 0, 0); PG8_STAGE(PG8_SA(1, 1), a1 + hstepA, voffA);
            PG8_WAIT_V(8); PG8_WAIT_L(0); PG8_BAR; PG8_MMA(0, 0, At, B0); PG8_MMA(0, 1, At, B1); PG8_BAR; PG8_SCHED;
            PG8_LDA(At, 0, 1); PG8_STAGE(PG8_SB(0, 0), b2, voffB); PG8_STAGE(PG8_SB(0, 1), b2 + hstep, voffB); PG8_STAGE(PG8_SA(0, 0), a2, voffA);
            PG8_WAIT_V(8); PG8_WAIT_L(0); PG8_BAR; PG8_MMA(1, 0, At, B0); PG8_MMA(1, 1, At, B1); PG8_BAR; PG8_SCHED;
            PG8_LDB(B0, 1, 0); PG8_LDB(B1, 1, 1); PG8_SCHED; PG8_LDA(At, 1, 0); PG8_STAGE(PG8_SA(0, 1), a2 + hstepA, voffA);
            PG8_WAIT_V(8); PG8_WAIT_L(0); PG8_BAR; PG8_MMA(0, 0, At, B0); PG8_MMA(0, 1, At, B1); PG8_BAR; PG8_SCHED;
            PG8_LDA(At, 1, 1); PG8_STAGE(PG8_SB(1, 0), b3, voffB); PG8_STAGE(PG8_SB(1, 1), b3 + hstep, voffB); PG8_STAGE(PG8_SA(1, 0), a3, voffA);
            PG8_WAIT_V(8); PG8_WAIT_L(0); PG8_BAR; PG8_MMA(1, 0, At, B0); PG8_MMA(1, 1, At, B1); PG8_BAR; PG8_SCHED;
            } else {
            PG8_LDB(B0, 0, 0); PG8_SCHED; PG8_LDA(At, 0, 0); PG8_STAGE(PG8_SA(1, 1), a1 + hstepA, voffA);
            PG8_WAIT_L(8); PG8_BAR; PG8_WAIT_L(0); PG8_MMA(0, 0, At, B0); PG8_BAR; PG8_SCHED;
            PG8_LDB(B1, 0, 1); PG8_STAGE(PG8_SB(0, 0), b2, voffB);
            PG8_BAR; PG8_WAIT_L(0); PG8_MMA(0, 1, At, B1); PG8_BAR;
            PG8_LDA(At, 0, 1); PG8_STAGE(PG8_SA(0, 0), a2, voffA);
            PG8_BAR; PG8_WAIT_L(0); PG8_MMA(1, 0, At, B0); PG8_BAR; PG8_SCHED;
            PG8_STAGE(PG8_SB(0, 1), b2 + hstep, voffB);
            PG8_WAIT_V(6); PG8_BAR; PG8_MMA(1, 1, At, B1); PG8_BAR;
            PG8_LDB(B0, 1, 0); PG8_SCHED; PG8_LDA(At, 1, 0); PG8_STAGE(PG8_SA(0, 1), a2 + hstepA, voffA);
            PG8_WAIT_L(8); PG8_BAR; PG8_WAIT_L(0); PG8_MMA(0, 0, At, B0); PG8_BAR; PG8_SCHED;
            PG8_LDB(B1, 1, 1); PG8_STAGE(PG8_SB(1, 0), b3, voffB);
            PG8_BAR; PG8_WAIT_L(0); PG8_MMA(0, 1, At, B1); PG8_BAR;
            PG8_LDA(At, 1, 1); PG8_STAGE(PG8_SA(1, 0), a3, voffA);
            PG8_BAR; PG8_WAIT_L(0); PG8_MMA(1, 0, At, B0); PG8_BAR; PG8_SCHED;
            PG8_STAGE(PG8_SB(1, 1), b3 + hstep, voffB);
            PG8_WAIT_V(6); PG8_BAR; PG8_MMA(1, 1, At, B1); PG8_BAR;
            }
        }
        if constexpr (ALIGN_EPI) { if (wr == 0) PG8_BAR; }
        if constexpr (!Epi::AFTER_DRAIN) { E(acc, cur, wr, wc, fr, fq); S.done(cur); }
        if (!has_next) break;
#pragma unroll
        for (int a = 0; a < 2; ++a)
#pragma unroll
            for (int b = 0; b < 2; ++b)
#pragma unroll
                for (int m = 0; m < 4; ++m)
#pragma unroll
                    for (int n = 0; n < 2; ++n) acc[a][b][m][n] = (f32x4){0.f, 0.f, 0.f, 0.f};
        cur = nxt; cA = nA; cB = nB; ++ui;
        if constexpr (ALIGN_EPI) { if (wr == 1) PG8_BAR; }
    }
    PG8_WAIT_V(0);
    if constexpr (!ALIGN_EPI) { if (wr == 0) PG8_BAR; }
    PG8_BAR;
    if constexpr (Epi::AFTER_DRAIN) { E.fused(acc, cur, wr, wc, fr, fq, lds, wid, lane); S.done(cur); }
#undef PG8_SA
#undef PG8_SB
#undef PG8_STAGE
#undef PG8_LDA
#undef PG8_LDB
#undef PG8_MMA
#undef PG8_WAIT_V
#undef PG8_WAIT_L
#undef PG8_BAR
#undef PG8_SCHED
}
}

#define XB_TMO      128
#define XB_XCNT(j)  (256  + 64 * (j))
#define XB_XSUB(j)  (1280 + 64 * (j))
#define XB_XGEN(j)  (2304 + 64 * (j))
#define XB_TOP      3328
#define XB_TOPGEN   3392
#define XCD_BAR_WORDS 3456
#define XB_SPIN_CAP (1u << 20)
__device__ __forceinline__ unsigned xb_ld(unsigned* p) { return __hip_atomic_load(p, __ATOMIC_RELAXED, __HIP_MEMORY_SCOPE_AGENT); }
__device__ __forceinline__ unsigned xb_add(unsigned* p, unsigned v) { return __hip_atomic_fetch_add(p, v, __ATOMIC_RELAXED, __HIP_MEMORY_SCOPE_AGENT); }
__device__ __forceinline__ unsigned xb_xcc_id() { return (unsigned)__builtin_amdgcn_s_getreg((3 << 11) | 20) & 0xFu; }
#define XB_SPIN(cond, bar) do { unsigned _sp = 0; while (cond) { __builtin_amdgcn_s_sleep(1); \
    if ((++_sp & 255u) == 0u) { if (xb_ld(&(bar)[XB_TMO])) break; if (_sp > XB_SPIN_CAP) { atomicAdd(&(bar)[XB_TMO], 1u); break; } } } } while (0)
struct XcdBarrier { unsigned* bar; unsigned x; volatile LAS unsigned* st; };
__device__ __forceinline__ XcdBarrier xcd_barrier_post(unsigned* bar, volatile LAS unsigned* st) {
    XcdBarrier b; b.bar = bar; b.x = xb_xcc_id(); b.st = st;
    if (threadIdx.x == 0) (void)xb_add(&bar[XB_XCNT(b.x)], 1u);
    return b;
}
__device__ __forceinline__ void xcd_barrier_complete(unsigned* bar, unsigned x, unsigned& nloc, unsigned& nx) {
    const unsigned G = gridDim.x * gridDim.y * gridDim.z;
    unsigned sum, cnt, mine, sp = 0u;
    for (;;) {
        sum = 0u; cnt = 0u; mine = 0u;
#pragma unroll
        for (unsigned j = 0; j < 16; ++j) { const unsigned c = xb_ld(&bar[XB_XCNT(j)]); sum += c; cnt += (c > 0u) ? 1u : 0u; mine = (j == x) ? c : mine; }
        if (sum == G) break;
        __builtin_amdgcn_s_sleep(1);
        if ((++sp & 255u) == 0u) { if (xb_ld(&bar[XB_TMO])) break; if (sp > XB_SPIN_CAP) { atomicAdd(&bar[XB_TMO], 1u); break; } }
    }
    nloc = mine > 0u ? mine : 1u; nx = cnt > 0u ? cnt : 1u;
}
__device__ __forceinline__ void xcd_barrier(const XcdBarrier& b) {
    asm volatile("s_waitcnt vmcnt(0)" ::: "memory");
    __syncthreads();
    if (threadIdx.x == 0) {
        unsigned* bar = b.bar;
        __builtin_amdgcn_s_waitcnt(0);
        unsigned nloc = b.st[0], nx = b.st[1];
        if (nloc == 0u) { xcd_barrier_complete(bar, b.x, nloc, nx); b.st[0] = nloc; b.st[1] = nx; }
        const unsigned old = xb_add(&bar[XB_XSUB(b.x)], 1u);
        const unsigned gen = old / nloc;
        if (old + 1u == (gen + 1u) * nloc) {
            __builtin_amdgcn_fence(__ATOMIC_RELEASE, "agent");
            asm volatile("s_waitcnt vmcnt(0)" ::: "memory");
            const unsigned og = xb_add(&bar[XB_TOP], 1u);
            const unsigned tg = og / nx;
            if (og + 1u == (tg + 1u) * nx) xb_add(&bar[XB_TOPGEN], 1u);
            else XB_SPIN(xb_ld(&bar[XB_TOPGEN]) == tg, bar);
            __builtin_amdgcn_fence(__ATOMIC_ACQUIRE, "agent");
            xb_add(&bar[XB_XGEN(b.x)], 1u);
            asm volatile("s_waitcnt vmcnt(0)" ::: "memory");
        } else {
            XB_SPIN(xb_ld(&bar[XB_XGEN(b.x)]) == gen, bar);
            __builtin_amdgcn_fence(__ATOMIC_ACQUIRE, "agent");
            asm volatile("s_waitcnt vmcnt(0)" ::: "memory");
        }
    }
    __syncthreads();
}

struct Args { const float* in[38]; float* out; unsigned char* ws; int ph_lo, ph_hi, li, pad; };
enum InputId { I_X = 0, I_NORM_MIX, I_W_IN, I_W_OUT, I_RW_MU, I_RW_W0, I_RW_W_UP, I_RW_A0, I_RW_A_UP, I_RW_G_UP, I_RW_K_K, I_RW_K_A, I_RW_R_K,
    I_RW_LN_W, I_RW_LN_B, I_RW_V0, I_RW_V_DOWN, I_RW_V_UP, I_GLA_A_UP, I_GLA_A_BIAS, I_GLA_NORM, I_LRU_CONV_W, I_LRU_CONV_B, I_LRU_W_R,
    I_LRU_B_R, I_LRU_W_I, I_LRU_B_I, I_LRU_LAM, I_GDN_CONV_W, I_GDN_A_LOG, I_GDN_DT_BIAS, I_GDN_NORM, I_NORM_FFN, I_PEER_WQ, I_PEER_SK,
    I_PEER_U, I_PEER_V, I_NORM_FINAL };
enum { PH_P0 = 0, PH_GEMM1 = 1, PH_PREP = 2, PH_AUX = 3, PH_SCAN = 4, PH_POST = 5, PH_GEMM2 = 6, PH_NORM2 = 7, PH_GEMM3 = 8, PH_TOPK = 9, PH_PEER = 10, PH_PER_LAYER = 10, PH_TOTAL = 21 };

struct Frame {
    LAS unsigned char* lds;
    int tid, lane, wave, vcu, G;
    int gw, ngw;
};

__device__ __forceinline__ void p0_transpose_item(const float* W, int K, int N, const float* kscale, bf16_t* WT, LAS float* scr, int item, int nblk, int lane) {
    const int kb = item / nblk, nb = item % nblk, k0 = 64 * kb, n0 = 32 * nb;
    const int kr = lane >> 3, n4 = (lane & 7) * 4;
    f32x4 v[8];
#pragma unroll
    for (int i = 0; i < 8; ++i) { const int kk = kr + 8 * i;
        v[i] = (n0 + n4 < N) ? *(const f32x4*)(W + (size_t)(k0 + kk) * N + n0 + n4) : (f32x4){0.f, 0.f, 0.f, 0.f}; }
#pragma unroll
    for (int i = 0; i < 8; ++i) { const int kk = kr + 8 * i; const float s = kscale ? kscale[k0 + kk] : 1.0f;
        scr[kk * 33 + n4 + 0] = v[i].x * s; scr[kk * 33 + n4 + 1] = v[i].y * s; scr[kk * 33 + n4 + 2] = v[i].z * s; scr[kk * 33 + n4 + 3] = v[i].w * s; }
    LDS_WAIT(); asm volatile("" ::: "memory");
    const int c = lane & 7;
#pragma unroll
    for (int j = 0; j < 4; ++j) { const int n = (lane >> 3) + 8 * j; const LAS float* s = scr + (8 * c) * 33 + n;
        v4u o; o.x = pk2(s[0 * 33], s[1 * 33]); o.y = pk2(s[2 * 33], s[3 * 33]); o.z = pk2(s[4 * 33], s[5 * 33]); o.w = pk2(s[6 * 33], s[7 * 33]);
        *(v4u*)(WT + (size_t)(n0 + n) * K + k0 + 8 * c) = o; }
    LDS_WAIT(); asm volatile("" ::: "memory");
}

__device__ __forceinline__ void p0_prologue(const Args& a, Frame& F) {
    const WsMap m = ws_map(NTOK);
    unsigned char* ws = a.ws;
    LAS float* scr = (LAS float*)(F.lds + F.wave * 16384);
    const int gw = F.gw, NGW = F.ngw, lane = F.lane;
    for (int n = gw; n < NTOK; n += NGW) {
        const f32x4* xr = (const f32x4*)(a.in[I_X] + (size_t)n * DM) + lane;
        f32x4 v[8]; float s = 0.f;
#pragma unroll
        for (int j = 0; j < 8; ++j) { v[j] = xr[64 * j]; s += (v[j].x * v[j].x + v[j].y * v[j].y) + (v[j].z * v[j].z + v[j].w * v[j].w); }
        const float rstd = 1.0f / sqrtf(wave_sum(s) * (1.0f / DM) + 1e-6f);
        f32x4* xo = (f32x4*)(a.out + (size_t)n * DM) + lane;
        v2u* o8 = (v2u*)((bf16_t*)(ws + m.xn) + (size_t)n * DM) + lane;
#pragma unroll
        for (int j = 0; j < 8; ++j) { xo[64 * j] = v[j]; v2u w; w.x = pk2(v[j].x * rstd, v[j].y * rstd); w.y = pk2(v[j].z * rstd, v[j].w * rstd); o8[64 * j] = w; }
    }
    {
        constexpr int I1 = (DM / 64) * (PLD / 32), I2 = (DM / 64) * (DM / 32);
        for (int it = gw; it < NL * (I1 + I2); it += NGW) {
            const int l = it / (I1 + I2); int r = it % (I1 + I2);
            if (r < I1) p0_transpose_item(a.in[I_W_IN] + (size_t)l * DM * INC, DM, INC, a.in[I_NORM_MIX] + l * DM, (bf16_t*)(ws + m.w1t) + (size_t)l * PLD * DM, scr, r, PLD / 32, lane);
            else p0_transpose_item(a.in[I_W_OUT] + (size_t)l * DM * DM, DM, DM, nullptr, (bf16_t*)(ws + m.w2t) + (size_t)l * DM * DM, scr, r - I1, DM / 32, lane);
        }
    }
    for (int it = gw; it < NL * 16 * 64; it += NGW) {
        const int l = it / 1024, hp = (it % 1024) / 64, kb = it % 64;
        const int dh = lane & 1, kk = kb * 32 + (lane >> 1);
        const float* wq = a.in[I_PEER_WQ] + (size_t)l * DM * DM + (size_t)kk * DM + hp * 128 + dh * 64;
        const float* sk = a.in[I_PEER_SK] + ((size_t)l * 16 + hp) * 128 * 128;
        f32x4 q[16];
#pragma unroll
        for (int d = 0; d < 16; ++d) q[d] = *(const f32x4*)(wq + 4 * d);
        bf16_t* o = (bf16_t*)(ws + m.wsct) + (size_t)l * DM * DM + (size_t)(hp * 128) * DM + kk;
        f32x4 stg[8];
#pragma unroll
        for (int i = 0; i < 8; ++i) stg[i] = ((const f32x4*)sk)[i * 64 + lane];
#pragma unroll 1
        for (int kc = 0; kc < 8; ++kc) {
#pragma unroll
            for (int i = 0; i < 8; ++i) ((LAS f32x4*)scr)[i * 64 + lane] = stg[i];
            if (kc + 1 < 8) {
#pragma unroll
                for (int i = 0; i < 8; ++i) stg[i] = ((const f32x4*)(sk + (kc + 1) * 2048))[i * 64 + lane]; }
            LDS_WAIT(); asm volatile("" ::: "memory");
#pragma unroll 2
            for (int key = 0; key < 16; ++key) {
                const LAS f32x4* s4 = (const LAS f32x4*)(scr + key * 128 + dh * 64);
                float acc = 0.f;
#pragma unroll
                for (int d = 0; d < 16; ++d) { const f32x4 sv = s4[d]; acc += (q[d].x * sv.x + q[d].y * sv.y) + (q[d].z * sv.z + q[d].w * sv.w); }
                acc += __shfl_xor(acc, 1);
                if (dh == 0) o[(size_t)(kc * 16 + key) * DM] = f2bf(acc);
            }
            LDS_WAIT(); asm volatile("" ::: "memory");
        }
    }
    {
        const int gt = F.vcu * NTHR + F.tid, GT = F.G * NTHR;
        bf16_t* AW = (bf16_t*)(ws + m.auxwt); bf16_t* LW = (bf16_t*)(ws + m.lruwt); bf16_t* VW = (bf16_t*)(ws + m.vreswt); float* PP = (float*)(ws + m.pp);
        for (int it = gt; it < NL * 1792 * 384; it += GT) {
            const int l = it / (1792 * 384), r = it % (1792 * 384), n = r / 384, k = r % 384;
            float v = 0.f;
            if (n < 512) { if (k < 64) v = a.in[I_RW_W_UP][(size_t)l * 64 * 512 + k * 512 + n]; }
            else if (n < 1024) { if (k >= 64 && k < 128) v = a.in[I_RW_A_UP][(size_t)l * 64 * 512 + (k - 64) * 512 + (n - 512)]; }
            else if (n < 1536) { if (k >= 128 && k < 256) v = a.in[I_RW_G_UP][(size_t)l * 128 * 512 + (k - 128) * 512 + (n - 1024)]; }
            else { if (k >= 256 && k < 272) v = a.in[I_GLA_A_UP][(size_t)l * 16 * 256 + (k - 256) * 256 + (n - 1536)]; }
            AW[it] = f2bf(v);
        }
        for (int it = gt; it < NL * 1024 * 512; it += GT) {
            const int l = it / (1024 * 512), r = it % (1024 * 512), n = r / 512, k = r % 512;
            const int nn = n & 511, blk = nn >> 6, j = nn & 63;
            float v = 0.f;
            if ((k >> 6) == blk) v = (n < 512 ? a.in[I_LRU_W_R] : a.in[I_LRU_W_I])[(size_t)l * 8 * 64 * 64 + (size_t)blk * 4096 + (k & 63) * 64 + j];
            LW[it] = f2bf(v);
        }
        for (int it = gt; it < 512 * 512; it += GT) {
            const int n = it / 512, k = it % 512;
            float s = 0.f;
            for (int i = 0; i < 32; ++i) s += a.in[I_RW_V_DOWN][k * 32 + i] * a.in[I_RW_V_UP][i * 512 + n];
            VW[it] = f2bf(s);
        }
        for (int it = gt; it < 6144; it += GT) {
            float v = 0.f;
            if (it < 3584) { const int l = it / 1792, c = it % 1792;
                v = c < 512 ? a.in[I_RW_W0][l * 512 + c] : (c < 1024 ? a.in[I_RW_A0][l * 512 + c - 512] : (c < 1536 ? 0.f : a.in[I_GLA_A_BIAS][l * 256 + c - 1536])); }
            else if (it < 5632) { const int l = (it - 3584) / 1024, c = (it - 3584) % 1024; v = c < 512 ? a.in[I_LRU_B_R][l * 512 + c] : a.in[I_LRU_B_I][l * 512 + c - 512]; }
            else v = a.in[I_RW_V0][it - 5632];
            PP[it] = v;
        }
    }
}

__device__ __forceinline__ unsigned pk4_fp8(float a, float b, float c, float d) {
    int w = 0;
    w = __builtin_amdgcn_cvt_pk_fp8_f32(__builtin_fmaxf(__builtin_fminf(a, 448.f), -448.f), __builtin_fmaxf(__builtin_fminf(b, 448.f), -448.f), w, false);
    w = __builtin_amdgcn_cvt_pk_fp8_f32(__builtin_fmaxf(__builtin_fminf(c, 448.f), -448.f), __builtin_fmaxf(__builtin_fminf(d, 448.f), -448.f), w, true);
    return (unsigned)w;
}
typedef float v32f __attribute__((ext_vector_type(32)));
typedef __bf16 v32bf __attribute__((ext_vector_type(32)));
typedef unsigned v6u __attribute__((ext_vector_type(6)));
constexpr size_t TROW = 1536;
__device__ __forceinline__ void tables_range(const Args& a, Frame& F, size_t it0, size_t it1, int sub, int nsub) {
    const WsMap m = ws_map(NTOK);
    const size_t per = (size_t)NEXP * DM / 32;
    const size_t stride = (size_t)nsub * NTHR;
    for (size_t base = it0 + (size_t)sub * NTHR + F.tid; base < it1; base += 2 * stride) {
        f32x4 v[2][8];
#pragma unroll
        for (int u = 0; u < 2; ++u) { const size_t it = base + u * stride;
            if (it < it1) { const int tb = (int)(it / per); const size_t r = it % per;
                const f32x4* srcp = (const f32x4*)(((tb & 1) ? a.in[I_PEER_V] : a.in[I_PEER_U]) + (size_t)(tb >> 1) * NEXP * DM + r * 32);
#pragma unroll
                for (int q = 0; q < 8; ++q) v[u][q] = __builtin_nontemporal_load(srcp + q); } }
#pragma unroll
        for (int u = 0; u < 2; ++u) { const size_t it = base + u * stride;
            if (it < it1) { const int tb = (int)(it / per); const size_t r = it % per; const float sc = (tb & 1) ? 4.0f : 64.0f;
                v32bf h;
#pragma unroll
                for (int q = 0; q < 8; ++q) {
                    h[4 * q + 0] = (__bf16)__builtin_fmaxf(__builtin_fminf(v[u][q].x * sc, 7.5f), -7.5f); h[4 * q + 1] = (__bf16)__builtin_fmaxf(__builtin_fminf(v[u][q].y * sc, 7.5f), -7.5f);
                    h[4 * q + 2] = (__bf16)__builtin_fmaxf(__builtin_fminf(v[u][q].z * sc, 7.5f), -7.5f); h[4 * q + 3] = (__bf16)__builtin_fmaxf(__builtin_fminf(v[u][q].w * sc, 7.5f), -7.5f); }
                const v6u p = __builtin_amdgcn_cvt_scalef32_pk32_fp6_bf16(h, 1.0f);
                v2u* dst = (v2u*)((unsigned char*)(a.ws + m.tabu) + (size_t)tb * NEXP * TROW + r * 24);
                dst[0] = (v2u){p[0], p[1]}; dst[1] = (v2u){p[2], p[3]}; dst[2] = (v2u){p[4], p[5]}; } }
    }
}

template <int CTRL> __device__ __forceinline__ float dpp_f(float v) { return __builtin_bit_cast(float, __builtin_amdgcn_update_dpp(0, __builtin_bit_cast(int, v), CTRL, 0xF, 0xF, true)); }
__device__ __forceinline__ float rdlane_f(float v, int l) { return __builtin_bit_cast(float, __builtin_amdgcn_readlane(__builtin_bit_cast(int, v), l)); }
__device__ __forceinline__ float row16_sum(float v) {
    v += dpp_f<0xB1>(v); v += dpp_f<0x4E>(v); v += dpp_f<0x141>(v); v += dpp_f<0x140>(v); return v;
}
__device__ __forceinline__ float wave_sum_u(float v) {
    v = row16_sum(v);
    return (rdlane_f(v, 0) + rdlane_f(v, 16)) + (rdlane_f(v, 32) + rdlane_f(v, 48));
}
typedef __bf16 bf16x2_t __attribute__((ext_vector_type(2)));
__device__ __forceinline__ float dot2bf(unsigned w, unsigned x, float acc) { return __builtin_amdgcn_fdot2_f32_bf16(__builtin_bit_cast(bf16x2_t, w), __builtin_bit_cast(bf16x2_t, x), acc, false); }
__device__ __forceinline__ float gelu_fast(float x) {
    const float u = 1.5957691216057308f * (x + 0.044715f * x * x * x);
    return x / (1.0f + __expf(-u));
}


__device__ __forceinline__ float sigm(float x) { return 1.0f / (1.0f + __expf(-x)); }
__device__ __forceinline__ float softplus_f(float x) { return __logf(1.0f + __expf(-fabsf(x))) + fmaxf(x, 0.0f); }
__device__ __forceinline__ float tanh_f(float x) { return 1.0f - 2.0f / (1.0f + __expf(2.0f * x)); }
__device__ __forceinline__ float red8(float v) { v += dpp_f<0xB1>(v); v += dpp_f<0x4E>(v); v += dpp_f<0x141>(v); return v; }
__device__ __forceinline__ v4u ld8(const bf16_t* p) { return *(const v4u*)p; }
__device__ __forceinline__ void unpack8(const v4u w, float (&f)[8]) { f[0] = bflo(w.x); f[1] = bfhi(w.x); f[2] = bflo(w.y); f[3] = bfhi(w.y); f[4] = bflo(w.z); f[5] = bfhi(w.z); f[6] = bflo(w.w); f[7] = bfhi(w.w); }
__device__ __forceinline__ v4u pack8(const float (&f)[8]) { v4u w; w.x = pk2(f[0], f[1]); w.y = pk2(f[2], f[3]); w.z = pk2(f[4], f[5]); w.w = pk2(f[6], f[7]); return w; }

__device__ __forceinline__ void prep_phase(const Args& a, Frame& F, int l) {
    const WsMap m = ws_map(NTOK);
    const bf16_t* p16 = (const bf16_t*)(a.ws + m.p16);
    bf16_t* zrkv = (bf16_t*)(a.ws + m.zrkv); bf16_t* auxA = (bf16_t*)(a.ws + m.auxA); bf16_t* xc = (bf16_t*)(a.ws + m.xc);
    const float* mu = a.in[I_RW_MU] + l * 1792;
#pragma unroll 4
    for (size_t it = (size_t)F.vcu * NTHR + F.tid; it < (size_t)NTOK * 224; it += (size_t)F.G * NTHR) {
        const int n = (int)(it / 224), j = (int)(it % 224), t = n % TSEQ;
        const int col = j * 8;
        float cur[8], prv[8], z[8];
        unpack8(ld8(p16 + (size_t)n * PLD + col), cur);
        unpack8(ld8(p16 + (size_t)(t > 0 ? n - 1 : n) * PLD + col), prv);
        const f32x4 m0 = *(const f32x4*)(mu + col), m1 = *(const f32x4*)(mu + col + 4);
        const float mm[8] = {m0.x, m0.y, m0.z, m0.w, m1.x, m1.y, m1.z, m1.w};
#pragma unroll
        for (int k = 0; k < 8; ++k) z[k] = cur[k] + ((t > 0 ? prv[k] : 0.f) - cur[k]) * mm[k];
        if (col < 1536) *(v4u*)(zrkv + (size_t)n * 1536 + col) = pack8(z);
        else {
            const int c = col - 1536;
#pragma unroll
            for (int k = 0; k < 8; ++k) z[k] = c < 64 ? tanh_f(z[k]) : (c < 128 ? z[k] : sigm(z[k]));
            *(v4u*)(auxA + (size_t)n * 384 + c) = pack8(z);
        }
    }
    for (size_t it = (size_t)F.vcu * NTHR + F.tid; it < (size_t)NTOK * 16; it += (size_t)F.G * NTHR) {
        const int n = (int)(it / 16), c = 256 + (int)(it % 16) * 8;
        v4u w = (v4u){0u, 0u, 0u, 0u};
        if (c < 272) w = ld8(p16 + (size_t)n * PLD + C_GLA + 1536 + (c - 256));
        *(v4u*)(auxA + (size_t)n * 384 + c) = w;
    }
#pragma unroll 2
    for (size_t it = (size_t)F.vcu * NTHR + F.tid; it < (size_t)NTOK * 64; it += (size_t)F.G * NTHR) {
        const int n = (int)(it / 64), c = (int)(it % 64) * 8, t = n % TSEQ;
        float acc[8];
        { const f32x4 b0 = *(const f32x4*)(a.in[I_LRU_CONV_B] + l * 512 + c), b1 = *(const f32x4*)(a.in[I_LRU_CONV_B] + l * 512 + c + 4);
          acc[0] = b0.x; acc[1] = b0.y; acc[2] = b0.z; acc[3] = b0.w; acc[4] = b1.x; acc[5] = b1.y; acc[6] = b1.z; acc[7] = b1.w; }
        v4u raw[4];
#pragma unroll
        for (int jj = 0; jj < 4; ++jj) raw[jj] = ld8(p16 + (size_t)(t - 3 + jj >= 0 ? n - 3 + jj : n) * PLD + C_LRU + c);
#pragma unroll
        for (int jj = 0; jj < 4; ++jj) {
            float xv[8]; unpack8(raw[jj], xv);
            const float ok = (t - 3 + jj >= 0) ? 1.0f : 0.0f;
            const float* cw = a.in[I_LRU_CONV_W] + (size_t)l * 4 * 512 + jj * 512 + c;
            const f32x4 w0 = *(const f32x4*)cw * ok, w1 = *(const f32x4*)(cw + 4) * ok;
            acc[0] += w0.x * xv[0]; acc[1] += w0.y * xv[1]; acc[2] += w0.z * xv[2]; acc[3] += w0.w * xv[3];
            acc[4] += w1.x * xv[4]; acc[5] += w1.y * xv[5]; acc[6] += w1.z * xv[6]; acc[7] += w1.w * xv[7];
        }
        *(v4u*)(xc + (size_t)n * 512 + c) = pack8(acc);
    }
    {
        bf16_t* gq = (bf16_t*)(a.ws + m.gq); bf16_t* gk = (bf16_t*)(a.ws + m.gk); bf16_t* gv = (bf16_t*)(a.ws + m.gv); float* gsc = (float*)(a.ws + m.gsc);
        const float* cw = a.in[I_GDN_CONV_W] + (size_t)l * 4 * 1536;
        const int lane = F.lane;
        for (int n = F.gw; n < NTOK; n += F.ngw) {
            const int t = n % TSEQ;
#pragma unroll
            for (int part = 0; part < 3; ++part) {
                const int cb = part * 512 + lane * 8;
                float acc[8];
#pragma unroll
                for (int k = 0; k < 8; ++k) acc[k] = 0.f;
#pragma unroll
                for (int jj = 0; jj < 4; ++jj) {
                    if (t - 3 + jj >= 0) {
                        float xv[8]; unpack8(ld8(p16 + (size_t)(n - 3 + jj) * PLD + C_GDN + cb), xv);
                        const f32x4 w0 = *(const f32x4*)(cw + jj * 1536 + cb), w1 = *(const f32x4*)(cw + jj * 1536 + cb + 4);
                        acc[0] += w0.x * xv[0]; acc[1] += w0.y * xv[1]; acc[2] += w0.z * xv[2]; acc[3] += w0.w * xv[3];
                        acc[4] += w1.x * xv[4]; acc[5] += w1.y * xv[5]; acc[6] += w1.z * xv[6]; acc[7] += w1.w * xv[7];
                    }
                }
                float ss = 0.f;
#pragma unroll
                for (int k = 0; k < 8; ++k) { acc[k] = acc[k] * sigm(acc[k]); ss += acc[k] * acc[k]; }
                if (part < 2) {
                    ss = row16_sum(ss);
                    const float inv = (1.0f / sqrtf(ss + 1e-6f)) * (part == 0 ? 0.08838834764831845f : 1.0f);
#pragma unroll
                    for (int k = 0; k < 8; ++k) acc[k] *= inv;
                }
                *(v4u*)((part == 0 ? gq : (part == 1 ? gk : gv)) + (size_t)n * 512 + lane * 8) = pack8(acc);
            }
            if (lane < 4) {
                gsc[(size_t)n * 8 + lane] = sigm(bf2f(p16[(size_t)n * PLD + C_GDN + 2048 + lane]));
                gsc[(size_t)n * 8 + 4 + lane] = -__expf(a.in[I_GDN_A_LOG][l * 4 + lane]) * softplus_f(bf2f(p16[(size_t)n * PLD + C_GDN + 2052 + lane]) + a.in[I_GDN_DT_BIAS][l * 4 + lane]);
            }
        }
    }
}

__device__ __forceinline__ float swz16(float v) { return __builtin_bit_cast(float, __builtin_amdgcn_ds_swizzle(__builtin_bit_cast(int, v), 0x401F)); }
__device__ __forceinline__ float red32(float v) { v = row16_sum(v); return v + swz16(v); }

__device__ __forceinline__ void rwkv_task(const Args& a, Frame& F, int l, int task) {
    const WsMap m = ws_map(NTOK);
    const int b = task >> 4, h = (task >> 1) & 7, hf = task & 1;
    LAS float* LR = (LAS float*)F.lds; LAS float* LW = LR + 2048; LAS float* LK = LW + 2048; LAS float* LA = LK + 2048; LAS float* LB = LA + 2048;
    LAS float* LV = LB + 2048; LAS float* LY = LV + 1024;
    const int lane = F.lane, w = F.wave, tid = F.tid;
    const int ch = h * 64 + lane;
    const bool mine = (lane >> 5) == hf;
    const float kk_ = a.in[I_RW_K_K][l * 512 + ch], ka_ = a.in[I_RW_K_A][l * 512 + ch], rk_ = a.in[I_RW_R_K][l * 512 + ch];
    const bf16_t* zr = (const bf16_t*)(a.ws + m.zrkv); const bf16_t* ao = (const bf16_t*)(a.ws + m.auxo); const bf16_t* vr = (const bf16_t*)(a.ws + m.vres);
    float* vf = (float*)(a.ws + m.vfirst); bf16_t* yo = (bf16_t*)(a.ws + m.rwy); bf16_t* bvo = (bf16_t*)(a.ws + m.rwbv);
    float S0 = 0.f, S1 = 0.f, S2 = 0.f, S3 = 0.f;
    const int row = tid >> 4, ks = tid & 15;
    float in_[4][7];
    auto load_chunk = [&](int c) {
#pragma unroll
        for (int q = 0; q < 4; ++q) { const size_t n = (size_t)b * TSEQ + c * 32 + w + 8 * q;
            in_[q][0] = bf2f(zr[n * 1536 + ch]); in_[q][1] = bf2f(zr[n * 1536 + 512 + ch]); in_[q][2] = bf2f(zr[n * 1536 + 1024 + ch]);
            in_[q][3] = bf2f(ao[n * 1792 + ch]); in_[q][4] = bf2f(ao[n * 1792 + 512 + ch]);
            if (l > 0) { in_[q][5] = bf2f(vr[n * 512 + ch]); in_[q][6] = vf[n * 512 + ch]; } else { in_[q][5] = 0.f; in_[q][6] = 0.f; } }
    };
    load_chunk(0);
    for (int c = 0; c < TSEQ / 32; ++c) {
#pragma unroll
        for (int q = 0; q < 4; ++q) {
            const int tl = w + 8 * q; const size_t n = (size_t)b * TSEQ + c * 32 + tl;
            const float zr_ = in_[q][0], zk_ = in_[q][1], zv_ = in_[q][2], wp = in_[q][3], ap = in_[q][4];
            float v = zv_;
            if (l == 0) { if (mine) vf[n * 512 + ch] = zv_; } else v = zv_ + (in_[q][6] - zv_) * sigm(in_[q][5]);
            const float w_raw = -softplus_f(-wp) - 0.5f, dec = __expf(-__expf(w_raw));
            const float aa = sigm(ap);
            const float kkraw = zk_ * kk_;
            const float ss = wave_sum_u(kkraw * kkraw);
            const float kk = kkraw * (1.0f / sqrtf(fmaxf(ss, 1e-24f)));
            const float km = zk_ * (1.0f + (aa - 1.0f) * ka_);
            const float bon = wave_sum_u(zr_ * km * rk_);
            LR[tl * 64 + lane] = zr_; LW[tl * 64 + lane] = dec; LK[tl * 64 + lane] = km; LA[tl * 64 + lane] = -kk; LB[tl * 64 + lane] = kk * aa;
            if (mine) { LV[tl * 32 + (lane & 31)] = v; bvo[n * 512 + ch] = f2bf(bon * v); }
        }
        __syncthreads();
        if (c + 1 < TSEQ / 32) load_chunk(c + 1);
        float keep0 = 0.f, keep1 = 0.f;
#pragma unroll 4
        for (int tl = 0; tl < 32; ++tl) {
            const int o = tl * 64 + ks * 4;
            const f32x4 a4 = *(const LAS f32x4*)(LA + o), w4 = *(const LAS f32x4*)(LW + o), b4 = *(const LAS f32x4*)(LB + o), k4 = *(const LAS f32x4*)(LK + o), r4 = *(const LAS f32x4*)(LR + o);
            const float vv = LV[tl * 32 + row];
            const float sa = row16_sum((S0 * a4.x + S1 * a4.y) + (S2 * a4.z + S3 * a4.w));
            S0 = S0 * w4.x + (sa * b4.x + vv * k4.x); S1 = S1 * w4.y + (sa * b4.y + vv * k4.y); S2 = S2 * w4.z + (sa * b4.z + vv * k4.z); S3 = S3 * w4.w + (sa * b4.w + vv * k4.w);
            const float y = row16_sum((S0 * r4.x + S1 * r4.y) + (S2 * r4.z + S3 * r4.w));
            keep0 = (ks == tl) ? y : keep0; keep1 = (ks + 16 == tl) ? y : keep1;
        }
        LY[ks * 32 + row] = keep0; LY[(16 + ks) * 32 + row] = keep1;
        __syncthreads();
        { const int tl = tid >> 4, r2 = (tid & 15) * 2; const size_t n = (size_t)b * TSEQ + c * 32 + tl;
          *(unsigned*)(yo + n * 512 + h * 64 + hf * 32 + r2) = pk2(LY[tl * 32 + r2], LY[tl * 32 + r2 + 1]); }
    }
}


__device__ __forceinline__ void chunk_cumsum8(float (&x)[8], LAS float* tmp, int lane, int w, int c8) {
#pragma unroll
    for (int d = 8; d < 64; d <<= 1) {
#pragma unroll
        for (int k = 0; k < 8; ++k) { const float t = __shfl_up(x[k], d); if (lane >= d) x[k] += t; }
    }
    if (lane >= 56) { *(LAS f32x4*)(tmp + w * 64 + c8) = (f32x4){x[0], x[1], x[2], x[3]}; *(LAS f32x4*)(tmp + w * 64 + c8 + 4) = (f32x4){x[4], x[5], x[6], x[7]}; }
    __syncthreads();
    for (int ww = 0; ww < w; ++ww) { const f32x4 a0 = *(const LAS f32x4*)(tmp + ww * 64 + c8), a1 = *(const LAS f32x4*)(tmp + ww * 64 + c8 + 4);
        x[0] += a0.x; x[1] += a0.y; x[2] += a0.z; x[3] += a0.w; x[4] += a1.x; x[5] += a1.y; x[6] += a1.z; x[7] += a1.w; }
}

constexpr int RWP = 72;
constexpr int RWT = 64 * RWP;
constexpr size_t RWB_TILES = 4 * RWT * 2;
constexpr size_t RWB_DVEC = RWB_TILES;
constexpr size_t RWB_VS = RWB_DVEC + 256;
constexpr size_t RWB_BYTES = RWB_VS + 4 * 3 * 64 * 16 * 2;

__device__ __forceinline__ f32x4 mm64(const LAS bf16_t* A, const LAS bf16_t* Bt, int mt, int nt, int lane, f32x4 acc) {
    const LAS bf16_t* ap = A + (mt * 16 + (lane & 15)) * RWP + (lane >> 4) * 8;
    const LAS bf16_t* bp = Bt + (nt * 16 + (lane & 15)) * RWP + (lane >> 4) * 8;
#pragma unroll
    for (int k0 = 0; k0 < 64; k0 += 32)
        acc = __builtin_amdgcn_mfma_f32_16x16x32_bf16(*(const LAS bf16x8*)(ap + k0), *(const LAS bf16x8*)(bp + k0), acc, 0, 0, 0);
    return acc;
}
__device__ __forceinline__ void st_rowmajor(LAS bf16_t* T, int mt, int nt, int lane, const f32x4 v) {
    const int n = nt * 16 + (lane & 15), i0 = mt * 16 + (lane >> 4) * 4;
    T[(i0 + 0) * RWP + n] = f2bf(v.x); T[(i0 + 1) * RWP + n] = f2bf(v.y); T[(i0 + 2) * RWP + n] = f2bf(v.z); T[(i0 + 3) * RWP + n] = f2bf(v.w);
}
__device__ __forceinline__ void st_transposed(LAS bf16_t* T, int mt, int nt, int lane, const f32x4 v) {
    const int n = nt * 16 + (lane & 15), i0 = mt * 16 + (lane >> 4) * 4;
    *(LAS v2u*)(T + n * RWP + i0) = (v2u){pk2(v.x, v.y), pk2(v.z, v.w)};
}

__device__ __forceinline__ void rwkv_pa_chunk(const Args& a, Frame& F, int l, int ci) {
    const WsMap m = ws_map(NTOK);
    const int bh = ci >> 6, c = ci & 63, b = bh >> 3, h = bh & 7;
    const int lane = F.lane, w = F.wave, tid = F.tid;
    const int ch = h * 64 + lane;
    LAS bf16_t* At = (LAS bf16_t*)F.lds; LAS bf16_t* AtT = At + RWT; LAS bf16_t* Bt = AtT + RWT; LAS bf16_t* Kt = Bt + RWT; LAS bf16_t* KtGT = Kt + RWT;
    LAS bf16_t* Rt = KtGT + RWT; LAS bf16_t* VmT = Rt + RWT; LAS bf16_t* LAK = VmT + RWT;
    LAS bf16_t* X0 = LAK + RWT; LAS bf16_t* XT0 = X0 + RWT; LAS bf16_t* T0 = XT0 + RWT; LAS bf16_t* X1 = T0 + RWT; LAS bf16_t* XT1 = X1 + RWT; LAS bf16_t* T1 = XT1 + RWT;
    LAS float* LWL = (LAS float*)X0;
    LAS bf16_t* A2 = X1;
    LAS bf16_t* LVT = XT1;
    const bf16_t* zr = (const bf16_t*)(a.ws + m.zrkv); const bf16_t* ao = (const bf16_t*)(a.ws + m.auxo); const bf16_t* vr = (const bf16_t*)(a.ws + m.vres);
    float* vf = (float*)(a.ws + m.vfirst); bf16_t* bvo = (bf16_t*)(a.ws + m.rwbv);
    unsigned char* blob = a.ws + m.xn + (size_t)ci * RWB_BYTES;
    bf16_t* gW = (bf16_t*)blob; bf16_t* gQG = gW + RWT; bf16_t* gKGT = gQG + RWT; bf16_t* gA1 = gKGT + RWT;
    float* gDV = (float*)(blob + RWB_DVEC); bf16_t* gVS = (bf16_t*)(blob + RWB_VS);
    const int j = tid >> 3, c8 = (tid & 7) * 8, chb = h * 64 + c8;
    const size_t n = (size_t)b * TSEQ + c * 64 + j;
    float zr_[8], zk_[8], zv_[8], wp[8], ap[8];
    unpack8(ld8(zr + n * 1536 + chb), zr_); unpack8(ld8(zr + n * 1536 + 512 + chb), zk_); unpack8(ld8(zr + n * 1536 + 1024 + chb), zv_);
    unpack8(ld8(ao + n * 1792 + chb), wp); unpack8(ld8(ao + n * 1792 + 512 + chb), ap);
    float vres8[8], vf8[8];
    if (l > 0) { unpack8(ld8(vr + n * 512 + chb), vres8); const f32x4 f0 = *(const f32x4*)(vf + n * 512 + chb), f1 = *(const f32x4*)(vf + n * 512 + chb + 4);
        vf8[0] = f0.x; vf8[1] = f0.y; vf8[2] = f0.z; vf8[3] = f0.w; vf8[4] = f1.x; vf8[5] = f1.y; vf8[6] = f1.z; vf8[7] = f1.w; }
    float lw[8];
#pragma unroll
    for (int k = 0; k < 8; ++k) lw[k] = -__expf(-softplus_f(-wp[k]) - 0.5f);
    float cs[8];
#pragma unroll
    for (int k = 0; k < 8; ++k) cs[k] = lw[k];
    chunk_cumsum8(cs, LWL, lane, w, c8);
    {
        float pk_[8], pa_[8], pr_[8];
        { const float* p0 = a.in[I_RW_K_K] + l * 512 + chb; const float* p1 = a.in[I_RW_K_A] + l * 512 + chb; const float* p2 = a.in[I_RW_R_K] + l * 512 + chb;
          const f32x4 a0 = *(const f32x4*)p0, a1 = *(const f32x4*)(p0 + 4), b0 = *(const f32x4*)p1, b1 = *(const f32x4*)(p1 + 4), c0 = *(const f32x4*)p2, c1 = *(const f32x4*)(p2 + 4);
          pk_[0] = a0.x; pk_[1] = a0.y; pk_[2] = a0.z; pk_[3] = a0.w; pk_[4] = a1.x; pk_[5] = a1.y; pk_[6] = a1.z; pk_[7] = a1.w;
          pa_[0] = b0.x; pa_[1] = b0.y; pa_[2] = b0.z; pa_[3] = b0.w; pa_[4] = b1.x; pa_[5] = b1.y; pa_[6] = b1.z; pa_[7] = b1.w;
          pr_[0] = c0.x; pr_[1] = c0.y; pr_[2] = c0.z; pr_[3] = c0.w; pr_[4] = c1.x; pr_[5] = c1.y; pr_[6] = c1.z; pr_[7] = c1.w; }
        float v[8], aa[8], kk[8], km[8];
        float ss = 0.f, bs = 0.f;
#pragma unroll
        for (int k = 0; k < 8; ++k) {
            v[k] = (l == 0) ? zv_[k] : zv_[k] + (vf8[k] - zv_[k]) * sigm(vres8[k]);
            aa[k] = sigm(ap[k]);
            kk[k] = zk_[k] * pk_[k]; ss += kk[k] * kk[k];
            km[k] = zk_[k] * (1.0f + (aa[k] - 1.0f) * pa_[k]); bs += zr_[k] * km[k] * pr_[k];
        }
        if (l == 0) { *(f32x4*)(vf + n * 512 + chb) = (f32x4){zv_[0], zv_[1], zv_[2], zv_[3]}; *(f32x4*)(vf + n * 512 + chb + 4) = (f32x4){zv_[4], zv_[5], zv_[6], zv_[7]}; }
        ss = red8(ss); bs = red8(bs);
        const float kinv = 1.0f / sqrtf(fmaxf(ss, 1e-24f));
        float cm[8], gcv[8];
        {
#pragma unroll
          for (int k = 0; k < 8; ++k) gcv[k] = 0.f;
#pragma unroll
          for (int ww = 0; ww < 8; ++ww) { const f32x4 g0 = *(const LAS f32x4*)(LWL + ww * 64 + c8), g1 = *(const LAS f32x4*)(LWL + ww * 64 + c8 + 4);
              gcv[0] += g0.x; gcv[1] += g0.y; gcv[2] += g0.z; gcv[3] += g0.w; gcv[4] += g1.x; gcv[5] += g1.y; gcv[6] += g1.z; gcv[7] += g1.w; } }
#pragma unroll
        for (int k = 0; k < 8; ++k) cm[k] = cs[k] - lw[k];
        float t_at[8], t_bt[8], t_kt[8], t_rt[8], t_bv[8];
        LAS bf16_t* KGTl = T1;
#pragma unroll
        for (int k = 0; k < 8; ++k) {
            const float G = __expf(cs[k]), Gm1 = __expf(cm[k]), iG = __expf(-cs[k]), GcG = __expf(gcv[k] - cs[k]);
            const float kkn = kk[k] * kinv;
            const float av = -kkn, bv = kkn * aa[k];
            t_at[k] = av * Gm1; t_bt[k] = bv * iG; t_kt[k] = km[k] * iG; t_rt[k] = zr_[k] * G; t_bv[k] = bs * v[k];
            AtT[(c8 + k) * RWP + j] = f2bf(t_at[k]);
            KtGT[(c8 + k) * RWP + j] = f2bf(km[k] * GcG);
            VmT[(c8 + k) * RWP + j] = f2bf(v[k]);
            KGTl[(c8 + k) * RWP + j] = f2bf(bv * GcG);
        }
        *(LAS v4u*)(At + j * RWP + c8) = pack8(t_at); *(LAS v4u*)(Bt + j * RWP + c8) = pack8(t_bt); *(LAS v4u*)(Kt + j * RWP + c8) = pack8(t_kt);
        const v4u rt8 = pack8(t_rt);
        *(LAS v4u*)(Rt + j * RWP + c8) = rt8; *(v4u*)(gQG + j * RWP + c8) = rt8;
        *(v4u*)(bvo + n * 512 + chb) = pack8(t_bv);
        if (j == 63) { *(f32x4*)(gDV + c8) = (f32x4){__expf(gcv[0]), __expf(gcv[1]), __expf(gcv[2]), __expf(gcv[3])}; *(f32x4*)(gDV + c8 + 4) = (f32x4){__expf(gcv[4]), __expf(gcv[5]), __expf(gcv[6]), __expf(gcv[7])}; }
    }
    __syncthreads();
    {
        for (int o = tid; o < RWT / 8; o += NTHR) ((v4u*)gKGT)[o] = ((const LAS v4u*)T1)[o];
        f32x4 z4 = {0.f, 0.f, 0.f, 0.f};
#pragma unroll 1
        for (int tt = 0; tt < 2; ++tt) {
            const int t = w + 8 * tt, mt = t >> 2, nt = t & 3;
            const int n = nt * 16 + (lane & 15), i0 = mt * 16 + (lane >> 4) * 4;
            f32x4 lab = mm64(At, Bt, mt, nt, lane, z4), lak = mm64(At, Kt, mt, nt, lane, z4), a1 = mm64(Rt, Bt, mt, nt, lane, z4), a2 = mm64(Rt, Kt, mt, nt, lane, z4);
            f32x4 tt0;
#pragma unroll
            for (int e = 0; e < 4; ++e) { const int i = i0 + e;
                if (n >= i) { lab[e] = 0.f; lak[e] = 0.f; }
                if (n > i) { a1[e] = 0.f; a2[e] = 0.f; }
                tt0[e] = lab[e] + (n == i ? 1.0f : 0.f); }
            st_rowmajor(X0, mt, nt, lane, lab); st_transposed(XT0, mt, nt, lane, lab);
            st_rowmajor(T0, mt, nt, lane, tt0);
            st_rowmajor(LAK, mt, nt, lane, lak);
            st_rowmajor(A2, mt, nt, lane, a2);
            gA1[(i0 + 0) * RWP + n] = f2bf(a1.x); gA1[(i0 + 1) * RWP + n] = f2bf(a1.y); gA1[(i0 + 2) * RWP + n] = f2bf(a1.z); gA1[(i0 + 3) * RWP + n] = f2bf(a1.w);
        }
    }
    __syncthreads();
    {
        f32x4 z4 = {0.f, 0.f, 0.f, 0.f};
#pragma unroll 1
        for (int tt = 0; tt < 2; ++tt) {
            const int t = w + 8 * tt, mt = t >> 2, nt = t & 3;
            const int n = nt * 16 + (lane & 15), i0 = mt * 16 + (lane >> 4) * 4;
            const f32x4 lv = mm64(LAK, VmT, mt, nt, lane, z4), o0 = mm64(A2, VmT, mt, nt, lane, z4), kv0 = mm64(KtGT, VmT, mt, nt, lane, z4);
            st_transposed((LAS bf16_t*)(F.lds + 131584), mt, nt, lane, lv);
            bf16_t* go = gVS + (size_t)nt * 3 * 1024 + 1024;
            const int r = lane & 15;
            go[(i0 + 0) * 16 + r] = f2bf(o0.x); go[(i0 + 1) * 16 + r] = f2bf(o0.y); go[(i0 + 2) * 16 + r] = f2bf(o0.z); go[(i0 + 3) * 16 + r] = f2bf(o0.w);
            go[1024 + (i0 + 0) * 16 + r] = f2bf(kv0.x); go[1024 + (i0 + 1) * 16 + r] = f2bf(kv0.y); go[1024 + (i0 + 2) * 16 + r] = f2bf(kv0.z); go[1024 + (i0 + 3) * 16 + r] = f2bf(kv0.w);
            (void)n;
        }
    }
    __syncthreads();
    {
        LAS bf16_t* Xc = X0; LAS bf16_t* XTc = XT0; LAS bf16_t* Tc = T0; LAS bf16_t* Xn = X1; LAS bf16_t* XTn = XT1; LAS bf16_t* Tn = T1;
        f32x4 z4 = {0.f, 0.f, 0.f, 0.f};
#pragma unroll 1
        for (int it = 0; it < 5; ++it) {
#pragma unroll 1
            for (int tt = 0; tt < 2; ++tt) { const int t = w + 8 * tt, mt = t >> 2, nt = t & 3;
                const f32x4 x2 = mm64(Xc, XTc, mt, nt, lane, z4);
                st_rowmajor(Xn, mt, nt, lane, x2); st_transposed(XTn, mt, nt, lane, x2); }
            __syncthreads();
#pragma unroll 1
            for (int tt = 0; tt < 2; ++tt) { const int t = w + 8 * tt, mt = t >> 2, nt = t & 3;
                const int n = nt * 16 + (lane & 15), i0 = mt * 16 + (lane >> 4) * 4;
                f32x4 tc; tc.x = bf2f(Tc[(i0 + 0) * RWP + n]); tc.y = bf2f(Tc[(i0 + 1) * RWP + n]); tc.z = bf2f(Tc[(i0 + 2) * RWP + n]); tc.w = bf2f(Tc[(i0 + 3) * RWP + n]);
                const f32x4 tn = mm64(Tc, XTn, mt, nt, lane, tc);
                st_rowmajor(Tn, mt, nt, lane, tn); }
            __syncthreads();
            LAS bf16_t* s0 = Xc; Xc = Xn; Xn = s0; s0 = XTc; XTc = XTn; XTn = s0; s0 = Tc; Tc = Tn; Tn = s0;
        }
        LAS bf16_t* LVTp = (LAS bf16_t*)(F.lds + 131584);
#pragma unroll 1
        for (int tt = 0; tt < 2; ++tt) { const int t = w + 8 * tt, mt = t >> 2, nt = t & 3;
            const int n = nt * 16 + (lane & 15), i0 = mt * 16 + (lane >> 4) * 4, r = lane & 15;
            const f32x4 wt = mm64(Tc, AtT, mt, nt, lane, z4), u0 = mm64(Tc, LVTp, mt, nt, lane, z4);
            gW[(i0 + 0) * RWP + n] = f2bf(wt.x); gW[(i0 + 1) * RWP + n] = f2bf(wt.y); gW[(i0 + 2) * RWP + n] = f2bf(wt.z); gW[(i0 + 3) * RWP + n] = f2bf(wt.w);
            bf16_t* gu = gVS + (size_t)nt * 3 * 1024;
            gu[(i0 + 0) * 16 + r] = f2bf(u0.x); gu[(i0 + 1) * 16 + r] = f2bf(u0.y); gu[(i0 + 2) * 16 + r] = f2bf(u0.z); gu[(i0 + 3) * 16 + r] = f2bf(u0.w); }
    }
    __syncthreads();
    (void)LVT;
}

__device__ __forceinline__ void rwkv_ps_task(const Args& a, Frame& F, int task) {
    const WsMap m = ws_map(NTOK);
    const int bh = task >> 2, vs = task & 3, b = bh >> 3, h = bh & 7;
    const int lane = F.lane, w = F.wave, tid = F.tid;
    LAS bf16_t* LB = (LAS bf16_t*)F.lds;
    LAS bf16_t* ST = LB + 4 * RWT; LAS bf16_t* VNT = ST + 16 * RWP;
    bf16_t* yo = (bf16_t*)(a.ws + m.rwy);
    const unsigned char* blob0 = a.ws + m.xn + (size_t)(bh * 64) * RWB_BYTES;
    const int r = lane & 15, i0w = (w & 3) * 16 + (lane >> 4) * 4;
    f32x4 Sacc = {0.f, 0.f, 0.f, 0.f};
    for (int i = tid; i < 16 * RWP / 2; i += NTHR) ((LAS unsigned*)ST)[i] = 0u;
    v4u pre[5];
    auto prefetch = [&](int c) {
        const v4u* g = (const v4u*)(blob0 + (size_t)c * RWB_BYTES);
#pragma unroll
        for (int k = 0; k < 5; ++k) { const int o = k * 512 + tid; pre[k] = (o < (int)(RWB_TILES / 16)) ? g[o] : (v4u){0u, 0u, 0u, 0u}; }
    };
    auto commit = [&]() {
#pragma unroll
        for (int k = 0; k < 5; ++k) { const int o = k * 512 + tid; if (o < (int)(RWB_TILES / 16)) ((LAS v4u*)LB)[o] = pre[k]; }
    };
    prefetch(0); commit(); prefetch(1);
    for (int c = 0; c < 64; ++c) {
        const unsigned char* blob = blob0 + (size_t)c * RWB_BYTES;
        const bf16_t* gvs = (const bf16_t*)(blob + RWB_VS) + (size_t)vs * 3 * 1024;
        float fr[4]; float dv[4] = {1.f, 1.f, 1.f, 1.f}, kv0[4] = {0.f, 0.f, 0.f, 0.f};
        { const bf16_t* src = gvs + (w < 4 ? 0 : 1024);
#pragma unroll
          for (int e = 0; e < 4; ++e) fr[e] = bf2f(src[(i0w + e) * 16 + r]); }
        if (w < 4) { const float* gd = (const float*)(blob + RWB_DVEC);
#pragma unroll
          for (int e = 0; e < 4; ++e) { dv[e] = gd[i0w + e]; kv0[e] = bf2f(gvs[2048 + (i0w + e) * 16 + r]); } }
        __syncthreads();
        if (w < 4) {
            f32x4 vn = mm64(LB, ST, w, 0, lane, (f32x4){fr[0], fr[1], fr[2], fr[3]});
            st_transposed(VNT, w, 0, lane, vn);
        }
        __syncthreads();
        if (w < 4) {
            const f32x4 base = {dv[0] * Sacc.x + kv0[0], dv[1] * Sacc.y + kv0[1], dv[2] * Sacc.z + kv0[2], dv[3] * Sacc.w + kv0[3]};
            Sacc = mm64(LB + 2 * RWT, VNT, w, 0, lane, base);
        } else {
            f32x4 o = mm64(LB + RWT, ST, w - 4, 0, lane, (f32x4){fr[0], fr[1], fr[2], fr[3]});
            o = mm64(LB + 3 * RWT, VNT, w - 4, 0, lane, o);
            const size_t n = (size_t)b * TSEQ + c * 64 + i0w;
            bf16_t* yp = yo + n * 512 + h * 64 + vs * 16 + r;
            yp[0] = f2bf(o.x); yp[512] = f2bf(o.y); yp[1024] = f2bf(o.z); yp[1536] = f2bf(o.w);
        }
        __syncthreads();
        if (w < 4) st_transposed(ST, w, 0, lane, Sacc);
        if (c + 1 < 64) commit();
        if (c + 2 < 64) prefetch(c + 2);
    }
    __syncthreads();
}

constexpr int GP = 136;
constexpr size_t GB_BYTES = 18688;
template <int KD, int PA_, int PB_>
__device__ __forceinline__ f32x4 mmx(const LAS bf16_t* A, const LAS bf16_t* Bt, int mt, int nt, int lane, f32x4 acc) {
    const LAS bf16_t* ap = A + (mt * 16 + (lane & 15)) * PA_ + (lane >> 4) * 8;
    const LAS bf16_t* bp = Bt + (nt * 16 + (lane & 15)) * PB_ + (lane >> 4) * 8;
#pragma unroll
    for (int k0 = 0; k0 < KD; k0 += 32)
        acc = __builtin_amdgcn_mfma_f32_16x16x32_bf16(*(const LAS bf16x8*)(ap + k0), *(const LAS bf16x8*)(bp + k0), acc, 0, 0, 0);
    return acc;
}
__device__ __forceinline__ void gdn_pa_chunk(const Args& a, Frame& F, int ci) {
    const WsMap m = ws_map(NTOK);
    const int bh = ci >> 6, c = ci & 63, b = bh >> 2, h = bh & 3;
    const int lane = F.lane, w = F.wave, tid = F.tid;
    LAS bf16_t* KB = (LAS bf16_t*)F.lds; LAS bf16_t* KH = KB + 64 * GP; LAS bf16_t* QH = KH + 64 * GP;
    LAS bf16_t* X0 = QH + 64 * GP; LAS bf16_t* XT0 = X0 + RWT; LAS bf16_t* T0 = XT0 + RWT; LAS bf16_t* X1 = T0 + RWT; LAS bf16_t* XT1 = X1 + RWT; LAS bf16_t* T1 = XT1 + RWT;
    LAS float* GC = (LAS float*)(T1 + RWT);
    const bf16_t* gq = (const bf16_t*)(a.ws + m.gq); const bf16_t* gk = (const bf16_t*)(a.ws + m.gk); const float* gsc = (const float*)(a.ws + m.gsc);
    unsigned char* blob = a.ws + m.gblob + (size_t)ci * GB_BYTES;
    bf16_t* gT = (bf16_t*)blob; bf16_t* gA1 = gT + RWT; float* gGC = (float*)(blob + 2 * RWT * 2);
    const int j = tid >> 3, c16 = (tid & 7) * 16;
    const size_t n = (size_t)b * TSEQ + c * 64 + j;
    {
        const float be = gsc[n * 8 + h];
        float kf[8];
#pragma unroll
        for (int hh = 0; hh < 2; ++hh) {
            const v4u kw = ld8(gk + n * 512 + h * 128 + c16 + hh * 8), qw = ld8(gq + n * 512 + h * 128 + c16 + hh * 8);
            *(LAS v4u*)(KH + j * GP + c16 + hh * 8) = kw; *(LAS v4u*)(QH + j * GP + c16 + hh * 8) = qw;
            unpack8(kw, kf);
#pragma unroll
            for (int k = 0; k < 8; ++k) kf[k] *= be;
            *(LAS v4u*)(KB + j * GP + c16 + hh * 8) = pack8(kf);
        }
        if (w == 0) {
            float g = gsc[((size_t)b * TSEQ + c * 64 + lane) * 8 + 4 + h];
#pragma unroll
            for (int o = 1; o < 64; o <<= 1) { const float t = __shfl_up(g, o); if (lane >= o) g += t; }
            GC[lane] = g; gGC[lane] = g;
        }
    }
    __syncthreads();
    {
        const f32x4 z4 = {0.f, 0.f, 0.f, 0.f};
#pragma unroll 1
        for (int tt = 0; tt < 2; ++tt) {
            const int t = w + 8 * tt, mt = t >> 2, nt = t & 3;
            const int nn = nt * 16 + (lane & 15), i0 = mt * 16 + (lane >> 4) * 4;
            f32x4 kk = mmx<128, GP, GP>(KB, KH, mt, nt, lane, z4), qk = mmx<128, GP, GP>(QH, KH, mt, nt, lane, z4);
            const float gj = GC[nn];
            f32x4 x, t0;
#pragma unroll
            for (int e = 0; e < 4; ++e) { const int i = i0 + e; const float d = __expf(fminf(GC[i] - gj, 0.f));
                x[e] = (nn < i) ? -kk[e] * d : 0.f; qk[e] = (nn <= i) ? qk[e] * d : 0.f; t0[e] = x[e] + (nn == i ? 1.0f : 0.f); }
            st_rowmajor(X0, mt, nt, lane, x); st_transposed(XT0, mt, nt, lane, x); st_rowmajor(T0, mt, nt, lane, t0);
            gA1[(i0 + 0) * RWP + nn] = f2bf(qk.x); gA1[(i0 + 1) * RWP + nn] = f2bf(qk.y); gA1[(i0 + 2) * RWP + nn] = f2bf(qk.z); gA1[(i0 + 3) * RWP + nn] = f2bf(qk.w);
        }
    }
    __syncthreads();
    {
        LAS bf16_t* Xc = X0; LAS bf16_t* XTc = XT0; LAS bf16_t* Tc = T0; LAS bf16_t* Xn = X1; LAS bf16_t* XTn = XT1; LAS bf16_t* Tn = T1;
        const f32x4 z4 = {0.f, 0.f, 0.f, 0.f};
#pragma unroll 1
        for (int it = 0; it < 5; ++it) {
#pragma unroll 1
            for (int tt = 0; tt < 2; ++tt) { const int t = w + 8 * tt, mt = t >> 2, nt = t & 3;
                const f32x4 x2 = mm64(Xc, XTc, mt, nt, lane, z4);
                st_rowmajor(Xn, mt, nt, lane, x2); st_transposed(XTn, mt, nt, lane, x2); }
            __syncthreads();
#pragma unroll 1
            for (int tt = 0; tt < 2; ++tt) { const int t = w + 8 * tt, mt = t >> 2, nt = t & 3;
                const int nn = nt * 16 + (lane & 15), i0 = mt * 16 + (lane >> 4) * 4;
                f32x4 tc; tc.x = bf2f(Tc[(i0 + 0) * RWP + nn]); tc.y = bf2f(Tc[(i0 + 1) * RWP + nn]); tc.z = bf2f(Tc[(i0 + 2) * RWP + nn]); tc.w = bf2f(Tc[(i0 + 3) * RWP + nn]);
                const f32x4 tn = mm64(Tc, XTn, mt, nt, lane, tc);
                st_rowmajor(Tn, mt, nt, lane, tn); }
            __syncthreads();
            LAS bf16_t* s0 = Xc; Xc = Xn; Xn = s0; s0 = XTc; XTc = XTn; XTn = s0; s0 = Tc; Tc = Tn; Tn = s0;
        }
        for (int o = tid; o < RWT / 8; o += NTHR) ((v4u*)gT)[o] = ((const LAS v4u*)Tc)[o];
    }
    __syncthreads();
}

__device__ __forceinline__ void gdn_ps_task(const Args& a, Frame& F, int task) {
    const WsMap m = ws_map(NTOK);
    const int bh = task >> 3, vs = task & 7, b = bh >> 2, h = bh & 3;
    const int lane = F.lane, w = F.wave, tid = F.tid;
    LAS bf16_t* KBE = (LAS bf16_t*)F.lds; LAS bf16_t* QG = KBE + 64 * GP; LAS bf16_t* KGT = QG + 64 * GP;
    LAS bf16_t* TT = KGT + 128 * RWP; LAS bf16_t* A1 = TT + RWT; LAS bf16_t* ST = A1 + RWT;
    LAS bf16_t* R2T = ST + 16 * GP; LAS bf16_t* VNT = R2T + 16 * RWP; LAS float* VB = (LAS float*)(VNT + 16 * RWP); LAS float* GC = VB + 64 * 16;
    const bf16_t* gq = (const bf16_t*)(a.ws + m.gq); const bf16_t* gk = (const bf16_t*)(a.ws + m.gk); const bf16_t* gv = (const bf16_t*)(a.ws + m.gv);
    const float* gsc = (const float*)(a.ws + m.gsc); bf16_t* go = (bf16_t*)(a.ws + m.gdno);
    const unsigned char* blob0 = a.ws + m.gblob + (size_t)(bh * 64) * GB_BYTES;
    const int j = tid >> 3, c16 = (tid & 7) * 16, r = lane & 15, kq4 = (lane >> 4) * 4;
    f32x4 Sacc = {0.f, 0.f, 0.f, 0.f};
    for (int i = tid; i < 16 * GP / 2; i += NTHR) ((LAS unsigned*)ST)[i] = 0u;
    v4u pk_[2], pq_[2], pt_[3]; v4u pv_; float pbe = 0.f;
    auto prefetch = [&](int c) {
        const size_t n = (size_t)b * TSEQ + c * 64 + j;
#pragma unroll
        for (int hh = 0; hh < 2; ++hh) { pk_[hh] = ld8(gk + n * 512 + h * 128 + c16 + hh * 8); pq_[hh] = ld8(gq + n * 512 + h * 128 + c16 + hh * 8); }
        pbe = gsc[n * 8 + h];
        const v4u* g = (const v4u*)(blob0 + (size_t)c * GB_BYTES);
#pragma unroll
        for (int k = 0; k < 3; ++k) { const int o = k * 512 + tid; pt_[k] = (o < (int)(GB_BYTES / 16)) ? g[o] : (v4u){0u, 0u, 0u, 0u}; }
        if (tid < 128) pv_ = ld8(gv + ((size_t)b * TSEQ + c * 64 + (tid >> 1)) * 512 + h * 128 + vs * 16 + (tid & 1) * 8);
    };
    prefetch(0);
    for (int c = 0; c < 64; ++c) {
#pragma unroll
        for (int k = 0; k < 3; ++k) { const int o = k * 512 + tid;
            if (o < 2 * RWT / 8) ((LAS v4u*)TT)[o] = pt_[k];
            else if (o < (int)(GB_BYTES / 16)) ((LAS v4u*)GC)[o - 2 * RWT / 8] = pt_[k]; }
        const v4u kw0 = pk_[0], kw1 = pk_[1], qw0 = pq_[0], qw1 = pq_[1]; const float be = pbe; const v4u vw = pv_;
        __syncthreads();
        if (c + 1 < 64) prefetch(c + 1);
        {
            const float gj = GC[j], g63 = GC[63];
            const float eg = __expf(gj), s_kbe = be * eg, s_kg = __expf(g63 - gj);
            float f[8], o8[8];
#pragma unroll
            for (int hh = 0; hh < 2; ++hh) {
                unpack8(hh ? kw1 : kw0, f);
#pragma unroll
                for (int k = 0; k < 8; ++k) { o8[k] = f[k] * s_kbe; KGT[(c16 + hh * 8 + k) * RWP + j] = f2bf(f[k] * s_kg); }
                *(LAS v4u*)(KBE + j * GP + c16 + hh * 8) = pack8(o8);
                unpack8(hh ? qw1 : qw0, f);
#pragma unroll
                for (int k = 0; k < 8; ++k) o8[k] = f[k] * eg;
                *(LAS v4u*)(QG + j * GP + c16 + hh * 8) = pack8(o8);
            }
            if (tid < 128) { const int jv = tid >> 1, cv = (tid & 1) * 8; const float bev = gsc[((size_t)b * TSEQ + c * 64 + jv) * 8 + h];
                unpack8(vw, f);
                *(LAS f32x4*)(VB + jv * 16 + cv) = (f32x4){f[0] * bev, f[1] * bev, f[2] * bev, f[3] * bev}; *(LAS f32x4*)(VB + jv * 16 + cv + 4) = (f32x4){f[4] * bev, f[5] * bev, f[6] * bev, f[7] * bev}; }
        }
        const float glast = __expf(GC[63]);
        __syncthreads();
        if (w < 4) {
            const int i0 = w * 16 + kq4;
            f32x4 r1 = mmx<128, GP, GP>(KBE, ST, w, 0, lane, (f32x4){0.f, 0.f, 0.f, 0.f});
            r1.x = VB[(i0 + 0) * 16 + r] - r1.x; r1.y = VB[(i0 + 1) * 16 + r] - r1.y; r1.z = VB[(i0 + 2) * 16 + r] - r1.z; r1.w = VB[(i0 + 3) * 16 + r] - r1.w;
            st_transposed(R2T, w, 0, lane, r1);
        }
        __syncthreads();
        if (w < 4) { const f32x4 vn = mm64(TT, R2T, w, 0, lane, (f32x4){0.f, 0.f, 0.f, 0.f}); st_transposed(VNT, w, 0, lane, vn); }
        __syncthreads();
        {
            const f32x4 base = {Sacc.x * glast, Sacc.y * glast, Sacc.z * glast, Sacc.w * glast};
            Sacc = mm64(KGT, VNT, w, 0, lane, base);
            if (w < 4) {
                f32x4 o = mmx<128, GP, GP>(QG, ST, w, 0, lane, (f32x4){0.f, 0.f, 0.f, 0.f});
                o = mm64(A1, VNT, w, 0, lane, o);
                const size_t n = (size_t)b * TSEQ + c * 64 + w * 16 + kq4;
                bf16_t* op = go + n * 512 + h * 128 + vs * 16 + r;
                op[0] = f2bf(o.x); op[512] = f2bf(o.y); op[1024] = f2bf(o.z); op[1536] = f2bf(o.w);
            }
        }
        __syncthreads();
        { const int k0 = w * 16 + kq4;
          *(LAS v2u*)(ST + r * GP + k0) = (v2u){pk2(Sacc.x, Sacc.y), pk2(Sacc.z, Sacc.w)}; }
    }
    __syncthreads();
}

__device__ __forceinline__ void gla_task(const Args& a, Frame& F, int l, int task) {
    const WsMap m = ws_map(NTOK);
    const int b = task >> 4, h = (task >> 2) & 3, qt = task & 3;
    const int lane = F.lane, w = F.wave, tid = F.tid;
    LAS bf16_t* QS = (LAS bf16_t*)F.lds; LAS bf16_t* KS = QS + RWT; LAS bf16_t* QG = KS + RWT; LAS bf16_t* KS2T = QG + RWT; LAS bf16_t* PM = KS2T + RWT;
    LAS bf16_t* VT = PM + RWT; LAS bf16_t* ST = VT + 32 * RWP; LAS float* LWL = (LAS float*)(ST + 32 * RWP);
    const bf16_t* p16 = (const bf16_t*)(a.ws + m.p16); const bf16_t* ao = (const bf16_t*)(a.ws + m.auxo);
    bf16_t* go = (bf16_t*)(a.ws + m.glao);
    const int j = tid >> 3, c8 = (tid & 7) * 8, v4 = (tid & 7) * 4;
    const int mtS = w >> 2, ntS = w & 3;
    const int mtO = w >> 1, ntO = w & 1;
    f32x4 Sacc = {0.f, 0.f, 0.f, 0.f};
    for (int i = tid; i < 32 * RWP / 2; i += NTHR) ((LAS unsigned*)ST)[i] = 0u;
    v4u nq, nk, npre; v2u nv;
    auto load_chunk = [&](int c) {
        const size_t n = (size_t)b * TSEQ + c * 64 + j;
        nq = ld8(p16 + n * PLD + C_GLA + h * 64 + c8); nk = ld8(p16 + n * PLD + C_GLA + 256 + h * 64 + c8); npre = ld8(ao + n * 1792 + 1536 + h * 64 + c8);
        nv = *(const v2u*)(p16 + n * PLD + C_GLA + 512 + h * 128 + qt * 32 + v4);
    };
    load_chunk(0);
    for (int c = 0; c < 64; ++c) {
        float q8[8], k8[8], la[8];
        unpack8(nq, q8); unpack8(nk, k8); unpack8(npre, la);
        const v2u vraw = nv;
#pragma unroll
        for (int k = 0; k < 8; ++k) la[k] = -softplus_f(-la[k]) * (1.0f / 16.0f);
        if (c + 1 < 64) load_chunk(c + 1);
        chunk_cumsum8(la, LWL, lane, w, c8);
        {
            float bj[8], br[8], bl[8], t0[8], t1[8], t2[8];
            {
#pragma unroll
              for (int k = 0; k < 8; ++k) bj[k] = la[k];
#pragma unroll
              for (int k = 0; k < 8; ++k) { br[k] = 0.f; bl[k] = 0.f; }
#pragma unroll
              for (int ww = 0; ww < 8; ++ww) { const f32x4 y0 = *(const LAS f32x4*)(LWL + ww * 64 + c8), y1 = *(const LAS f32x4*)(LWL + ww * 64 + c8 + 4);
                  const float yy[8] = {y0.x, y0.y, y0.z, y0.w, y1.x, y1.y, y1.z, y1.w};
#pragma unroll
                  for (int k = 0; k < 8; ++k) { bl[k] += yy[k]; if (ww < 4) br[k] += yy[k]; } } }
#pragma unroll
            for (int k = 0; k < 8; ++k) {
                const float qq = q8[k] * 0.125f;
                t0[k] = qq * __expf(bj[k] - br[k]); t1[k] = k8[k] * __expf(br[k] - bj[k]); t2[k] = qq * __expf(bj[k]);
                KS2T[(c8 + k) * RWP + j] = f2bf(k8[k] * __expf(bl[k] - bj[k]));
            }
            *(LAS v4u*)(QS + j * RWP + c8) = pack8(t0); *(LAS v4u*)(KS + j * RWP + c8) = pack8(t1); *(LAS v4u*)(QG + j * RWP + c8) = pack8(t2);
            VT[(v4 + 0) * RWP + j] = (bf16_t)(vraw.x & 0xffffu); VT[(v4 + 1) * RWP + j] = (bf16_t)(vraw.x >> 16);
            VT[(v4 + 2) * RWP + j] = (bf16_t)(vraw.y & 0xffffu); VT[(v4 + 3) * RWP + j] = (bf16_t)(vraw.y >> 16);
        }
        float dsum = 0.f;
#pragma unroll
        for (int ww = 0; ww < 8; ++ww) dsum += LWL[ww * 64 + ntS * 16 + (lane & 15)];
        const float dec = __expf(dsum);
        __syncthreads();
        f32x4 o4;
        {
            const f32x4 z4 = {0.f, 0.f, 0.f, 0.f};
#pragma unroll
            for (int tt = 0; tt < 2; ++tt) { const int t = w + 8 * tt, mt = t >> 2, nt = t & 3;
                f32x4 s4 = mm64(QS, KS, mt, nt, lane, z4);
                const int nn = nt * 16 + (lane & 15), i0 = mt * 16 + (lane >> 4) * 4;
#pragma unroll
                for (int e = 0; e < 4; ++e) if (nn > i0 + e) s4[e] = 0.f;
                st_rowmajor(PM, mt, nt, lane, s4); }
            o4 = mm64(QG, ST, mtO, ntO, lane, z4);
        }
        __syncthreads();
        {
            o4 = mm64(PM, VT, mtO, ntO, lane, o4);
            const size_t n = (size_t)b * TSEQ + c * 64 + mtO * 16 + (lane >> 4) * 4;
            bf16_t* op = go + n * 512 + h * 128 + qt * 32 + ntO * 16 + (lane & 15);
            op[0] = f2bf(o4.x); op[512] = f2bf(o4.y); op[1024] = f2bf(o4.z); op[1536] = f2bf(o4.w);
            const f32x4 base = {Sacc.x * dec, Sacc.y * dec, Sacc.z * dec, Sacc.w * dec};
            Sacc = mm64(VT, KS2T, mtS, ntS, lane, base);
            st_rowmajor(ST, mtS, ntS, lane, Sacc);
        }
        __syncthreads();
    }
}

__device__ __forceinline__ void lru_pass(const Args& a, Frame& F, int l, bool passB) {
    const WsMap m = ws_map(NTOK);
    const bf16_t* gt = (const bf16_t*)(a.ws + m.gates); const bf16_t* xc = (const bf16_t*)(a.ws + m.xc); const bf16_t* p16 = (const bf16_t*)(a.ws + m.p16);
    bf16_t* mix = (bf16_t*)(a.ws + m.mix16); float* lrs = (float*)(a.ws + m.lrs);
    for (int it = F.vcu * NTHR + F.tid; it < NBATCH * 64 * 512; it += F.G * NTHR) {
        const int ch = it & 511, bc = it >> 9, c = bc & 63;
        const float sp8 = 8.0f * softplus_f(-a.in[I_LRU_LAM][l * 512 + ch]);
        const size_t nb = (size_t)bc * 64;
        float hh = 0.f, ap = 1.f;
        if (passB) { for (int s = 0; s < c; ++s) { const f32x2 su = *(const f32x2*)(lrs + ((size_t)(bc - c + s) * 512 + ch) * 2); hh = su.x * hh + su.y; } }
#pragma unroll 8
        for (int t = 0; t < 64; ++t) { const size_t n = nb + t;
            const float la = -sp8 * sigm(bf2f(gt[n * 1024 + ch]));
            const float u = bf2f(xc[n * 512 + ch]) * sigm(bf2f(gt[n * 1024 + 512 + ch])) * sqrtf(-expm1f(2.0f * la));
            const float av = __expf(la);
            hh = av * hh + u; ap *= av;
            if (passB) mix[n * DM + 1024 + ch] = f2bf(hh * gelu_fast(bf2f(p16[n * PLD + C_LRU + 512 + ch]))); }
        if (!passB) *(f32x2*)(lrs + ((size_t)bc * 512 + ch) * 2) = (f32x2){ap, hh};
    }
}

__device__ __forceinline__ void scan_phase(const Args& a, Frame& F, int l) {
    lru_pass(a, F, l, false);
    const int task = blockIdx.x;
    if (task < 128) { for (int q = 0; q < 16; ++q) rwkv_pa_chunk(a, F, l, task * 16 + q); }
    else if (task < 192) { for (int q = 0; q < 16; ++q) gdn_pa_chunk(a, F, (task - 128) * 16 + q);
        if (l == 0) tables_range(a, F, (size_t)2 * NEXP * DM / 32, (size_t)4 * NEXP * DM / 32, task - 128, 64); }
    else gla_task(a, F, l, task - 192);
}

__device__ __forceinline__ void post_phase(const Args& a, Frame& F, int l, const XcdBarrier& bar) {
    const WsMap m = ws_map(NTOK);
    if (blockIdx.x < 128) rwkv_ps_task(a, F, blockIdx.x); else gdn_ps_task(a, F, blockIdx.x - 128);
    lru_pass(a, F, l, true);
    const bf16_t* p16 = (const bf16_t*)(a.ws + m.p16); const bf16_t* glao = (const bf16_t*)(a.ws + m.glao); const bf16_t* gdno = (const bf16_t*)(a.ws + m.gdno);
    const bf16_t* rwy = (const bf16_t*)(a.ws + m.rwy); const bf16_t* rwbv = (const bf16_t*)(a.ws + m.rwbv); const bf16_t* ao = (const bf16_t*)(a.ws + m.auxo);
    bf16_t* mix = (bf16_t*)(a.ws + m.mix16);
    const int lane = F.lane, col = lane * 8, hc = col & 127;
    float gg[8], gd[8], lw[8], lb[8];
    { const f32x4 x0 = *(const f32x4*)(a.in[I_GLA_NORM] + l * 128 + hc), x1 = *(const f32x4*)(a.in[I_GLA_NORM] + l * 128 + hc + 4);
      gg[0] = x0.x; gg[1] = x0.y; gg[2] = x0.z; gg[3] = x0.w; gg[4] = x1.x; gg[5] = x1.y; gg[6] = x1.z; gg[7] = x1.w;
      const f32x4 y0 = *(const f32x4*)(a.in[I_GDN_NORM] + l * 128 + hc), y1 = *(const f32x4*)(a.in[I_GDN_NORM] + l * 128 + hc + 4);
      gd[0] = y0.x; gd[1] = y0.y; gd[2] = y0.z; gd[3] = y0.w; gd[4] = y1.x; gd[5] = y1.y; gd[6] = y1.z; gd[7] = y1.w;
      const f32x4 w0 = *(const f32x4*)(a.in[I_RW_LN_W] + l * 512 + col), w1 = *(const f32x4*)(a.in[I_RW_LN_W] + l * 512 + col + 4);
      lw[0] = w0.x; lw[1] = w0.y; lw[2] = w0.z; lw[3] = w0.w; lw[4] = w1.x; lw[5] = w1.y; lw[6] = w1.z; lw[7] = w1.w;
      const f32x4 b0 = *(const f32x4*)(a.in[I_RW_LN_B] + l * 512 + col), b1 = *(const f32x4*)(a.in[I_RW_LN_B] + l * 512 + col + 4);
      lb[0] = b0.x; lb[1] = b0.y; lb[2] = b0.z; lb[3] = b0.w; lb[4] = b1.x; lb[5] = b1.y; lb[6] = b1.z; lb[7] = b1.w; }
    for (int pass = 1; pass < 2; ++pass) {
    if (pass == 1) xcd_barrier(bar);
    for (int n = F.gw; n < NTOK; n += F.ngw) {
        if (pass == 1) {
            float y[8], bv[8], g[8];
            unpack8(ld8(rwy + (size_t)n * 512 + col), y); unpack8(ld8(rwbv + (size_t)n * 512 + col), bv); unpack8(ld8(ao + (size_t)n * 1792 + 1024 + col), g);
            float s = 0.f;
#pragma unroll
            for (int k = 0; k < 8; ++k) s += y[k];
            const float mean = red8(s) * (1.0f / 64.0f);
            float s2 = 0.f;
#pragma unroll
            for (int k = 0; k < 8; ++k) { y[k] -= mean; s2 += y[k] * y[k]; }
            const float rs = 1.0f / sqrtf(red8(s2) * (1.0f / 64.0f) + 64e-5f);
#pragma unroll
            for (int k = 0; k < 8; ++k) y[k] = (y[k] * rs * lw[k] + lb[k] + bv[k]) * g[k];
            *(v4u*)(mix + (size_t)n * DM + col) = pack8(y);
        }
        if (pass == 1)
#pragma unroll
        for (int which = 0; which < 2; ++which) {
            float o[8], g[8];
            unpack8(ld8((which ? gdno : glao) + (size_t)n * 512 + col), o);
            unpack8(ld8(p16 + (size_t)n * PLD + (which ? C_GDN + 1536 : C_GLA + 1024) + col), g);
            float ss = 0.f;
#pragma unroll
            for (int k = 0; k < 8; ++k) ss += o[k] * o[k];
            ss = row16_sum(ss);
            const float rs = 1.0f / sqrtf(ss * (1.0f / 128.0f) + 1e-6f);
#pragma unroll
            for (int k = 0; k < 8; ++k) o[k] = o[k] * rs * (which ? gd[k] : gg[k]) * (g[k] * sigm(g[k]));
            *(v4u*)(mix + (size_t)n * DM + (which ? 1536 : 512) + col) = pack8(o);
        }
    }
    }
}

__device__ __forceinline__ void norm2_phase(const Args& a, Frame& F, int l) {
    const WsMap m = ws_map(NTOK);
    const float* gain = a.in[I_NORM_FFN] + l * DM;
    f32x4 gv[8];
#pragma unroll
    for (int j = 0; j < 8; ++j) gv[j] = ((const f32x4*)gain)[64 * j + F.lane];
    for (int n = F.gw; n < NTOK; n += F.ngw) {
        const f32x4* xr = (const f32x4*)(a.out + (size_t)n * DM) + F.lane;
        f32x4 v[8]; float s = 0.f;
#pragma unroll
        for (int j = 0; j < 8; ++j) { v[j] = xr[64 * j]; s += (v[j].x * v[j].x + v[j].y * v[j].y) + (v[j].z * v[j].z + v[j].w * v[j].w); }
        const float rstd = 1.0f / sqrtf(wave_sum_u(s) * (1.0f / DM) + 1e-6f);
        v2u* o8 = (v2u*)((bf16_t*)(a.ws + m.hb) + (size_t)n * DM) + F.lane;
#pragma unroll
        for (int j = 0; j < 8; ++j) { v2u w; w.x = pk2(v[j].x * rstd * gv[j].x, v[j].y * rstd * gv[j].y); w.y = pk2(v[j].z * rstd * gv[j].z, v[j].w * rstd * gv[j].w); o8[64 * j] = w; }
    }
}

#define TK_CE(A, B) do { const float mx_ = fmaxf(A, B), mn_ = fminf(A, B); A = mx_; B = mn_; } while (0)
__device__ __forceinline__ void tk_sort16_desc(float (&x)[16]) {
#pragma unroll
    for (int k = 2; k <= 16; k <<= 1)
#pragma unroll
        for (int j = k >> 1; j > 0; j >>= 1)
#pragma unroll
            for (int i = 0; i < 16; ++i) { const int p = i ^ j;
                if (p > i) { if ((i & k) == 0) TK_CE(x[i], x[p]); else TK_CE(x[p], x[i]); } }
}
__device__ __forceinline__ void tk_merge16(float (&run)[16], const float (&g)[16]) {
#pragma unroll
    for (int i = 0; i < 16; ++i) run[i] = fmaxf(run[i], g[15 - i]);
#pragma unroll
    for (int j = 8; j > 0; j >>= 1)
#pragma unroll
        for (int i = 0; i < 16; ++i) { const int p = i ^ j; if (p > i) TK_CE(run[i], run[p]); }
}
__device__ __forceinline__ float tk_tag(float v, unsigned tag, unsigned mask) { return __builtin_bit_cast(float, (__builtin_bit_cast(unsigned, v) & ~mask) | tag); }
__device__ __forceinline__ void topk_phase(const Args& a, Frame& F) {
    const WsMap m = ws_map(NTOK);
    const float* sc = (const float*)(a.ws + m.sc);
    int* idx = (int*)(a.ws + m.idx); float* gate = (float*)(a.ws + m.gate);
    LAS float* LS = (LAS float*)F.lds;
    const int t = F.tid;
    for (int wv = F.gw; wv < (NTOK / 64) * 8; wv += F.ngw) {
        const int h = wv & 7, n = (wv >> 3) * 64 + F.lane;
        const float* sp = sc + (size_t)(h * 256) * NTOK + n;
        float s0[16], s1[16];
#pragma unroll
        for (int half = 0; half < 2; ++half) {
            float run[16];
#pragma unroll
            for (int j = 0; j < 16; ++j) run[j] = -3.0e38f;
#pragma unroll 1
            for (int g = 0; g < 8; ++g) {
                float x[16];
#pragma unroll
                for (int k = 0; k < 16; ++k) x[k] = tk_tag(sp[(size_t)(half * 128 + g * 16 + k) * NTOK], (unsigned)(g * 16 + k), 127u);
                tk_sort16_desc(x);
                tk_merge16(run, x);
            }
#pragma unroll
            for (int j = 0; j < 16; ++j) { if (half) s1[j] = run[j]; else s0[j] = run[j]; LS[(half * 16 + j) * 512 + t] = run[j]; }
        }
        float run[16];
#pragma unroll
        for (int j = 0; j < 16; ++j) run[j] = -3.0e38f;
        {
            float x[16]; int cnt = 0;
#pragma unroll
            for (int p = 0; p < 16; ++p)
#pragma unroll
                for (int q = 0; q < 16; ++q) if ((p + 1) * (q + 1) <= 16) {
                    x[cnt & 15] = tk_tag(s0[p] + s1[q], (unsigned)(p * 16 + q), 255u); ++cnt;
                    if ((cnt & 15) == 0) { tk_sort16_desc(x); tk_merge16(run, x); }
                }
#pragma unroll
            for (int k = 0; k < 16; ++k) if (k >= (cnt & 15)) x[k] = -3.0e38f;
            tk_sort16_desc(x); tk_merge16(run, x);
        }
        const float mx = run[0]; float den = 0.f; float e[16]; int ti[16];
#pragma unroll
        for (int j = 0; j < 16; ++j) {
            const unsigned tg = __builtin_bit_cast(unsigned, run[j]) & 255u; const int p = (int)(tg >> 4), q = (int)(tg & 15u);
            const unsigned k0 = __builtin_bit_cast(unsigned, LS[(0 * 16 + p) * 512 + t]) & 127u, k1 = __builtin_bit_cast(unsigned, LS[(1 * 16 + q) * 512 + t]) & 127u;
            ti[j] = (int)(k0 * 128u + k1);
            e[j] = __expf(run[j] - mx); den += e[j];
        }
        const float inv = 1.0f / den;
        const size_t it = (size_t)n * 8 + h;
        f32x4* go = (f32x4*)(gate + it * 16); v4u* io = (v4u*)(idx + it * 16);
#pragma unroll
        for (int j = 0; j < 4; ++j) { go[j] = (f32x4){e[4 * j] * inv, e[4 * j + 1] * inv, e[4 * j + 2] * inv, e[4 * j + 3] * inv};
            io[j] = (v4u){(unsigned)ti[4 * j], (unsigned)ti[4 * j + 1], (unsigned)ti[4 * j + 2], (unsigned)ti[4 * j + 3]}; }
    }
}

__device__ __forceinline__ v6u ld_row6(const unsigned char* p) { const v2u* q = (const v2u*)p; const v2u a0 = q[0], a1 = q[1], a2 = q[2]; return (v6u){a0.x, a0.y, a1.x, a1.y, a2.x, a2.y}; }
__device__ __forceinline__ void peer_phase(const Args& a, Frame& F, int l) {
    const WsMap m = ws_map(NTOK);
    const unsigned char* TU = (const unsigned char*)(a.ws + m.tabu) + (size_t)l * 2 * NEXP * TROW;
    const unsigned char* TV = TU + (size_t)NEXP * TROW;
    const int* idx = (const int*)(a.ws + m.idx); const float* gate = (const float*)(a.ws + m.gate);
    const int lane = F.lane;
    for (int n = F.gw; n < NTOK; n += F.ngw) {
        float xf[32];
        { const v4u* hr = (const v4u*)((const bf16_t*)(a.ws + m.hb) + (size_t)n * DM + lane * 32);
#pragma unroll
          for (int q = 0; q < 4; ++q) { const v4u w = hr[q];
              xf[8 * q + 0] = bflo(w.x); xf[8 * q + 1] = bfhi(w.x); xf[8 * q + 2] = bflo(w.y); xf[8 * q + 3] = bfhi(w.y); xf[8 * q + 4] = bflo(w.z); xf[8 * q + 5] = bfhi(w.z); xf[8 * q + 6] = bflo(w.w); xf[8 * q + 7] = bfhi(w.w); } }
        const int e0 = idx[(size_t)n * 128 + lane], e1 = idx[(size_t)n * 128 + 64 + lane];
        const float g0 = gate[(size_t)n * 128 + lane], g1 = gate[(size_t)n * 128 + 64 + lane];
        float d0 = 0.f, d1 = 0.f;
#pragma unroll
        for (int half = 0; half < 2; ++half) {
            const int ev = half ? e1 : e0; float dd = 0.f;
            for (int j = 0; j < 64; j += 4) {
                v6u u[4];
#pragma unroll
                for (int r = 0; r < 4; ++r) { const int e = __builtin_amdgcn_readlane(ev, j + r); u[r] = ld_row6(TU + (size_t)e * TROW + lane * 24); }
#pragma unroll
                for (int r = 0; r < 4; ++r) { const v32f f = __builtin_amdgcn_cvt_scalef32_pk32_f32_fp6(u[r], 1.0f);
                    float a0 = 0.f, a1 = 0.f, a2 = 0.f, a3 = 0.f;
#pragma unroll
                    for (int k = 0; k < 8; ++k) { a0 += f[4 * k] * xf[4 * k]; a1 += f[4 * k + 1] * xf[4 * k + 1]; a2 += f[4 * k + 2] * xf[4 * k + 2]; a3 += f[4 * k + 3] * xf[4 * k + 3]; }
                    const float t = wave_sum_u((a0 + a1) + (a2 + a3));
                    dd = (lane == j + r) ? t : dd;
}
            }
            if (half) d1 = dd; else d0 = dd;
        }
        const float c0 = gelu_fast(d0 * (1.0f / 64.0f)) * g0 * 0.25f, c1 = gelu_fast(d1 * (1.0f / 64.0f)) * g1 * 0.25f;
        float o[32];
#pragma unroll
        for (int i = 0; i < 32; ++i) o[i] = 0.f;
#pragma unroll
        for (int half = 0; half < 2; ++half) {
            const int ev = half ? e1 : e0; const float cv = half ? c1 : c0;
            for (int j = 0; j < 64; j += 4) {
                v6u v[4]; float cj[4];
#pragma unroll
                for (int r = 0; r < 4; ++r) { const int e = __builtin_amdgcn_readlane(ev, j + r); cj[r] = rdlane_f(cv, j + r); v[r] = ld_row6(TV + (size_t)e * TROW + lane * 24); }
#pragma unroll
                for (int r = 0; r < 4; ++r) { const v32f f = __builtin_amdgcn_cvt_scalef32_pk32_f32_fp6(v[r], 1.0f);
#pragma unroll
                    for (int i = 0; i < 32; ++i) o[i] += f[i] * cj[r];
}
            }
        }
        float* xrow = a.out + (size_t)n * DM + lane * 32;
        float s = 0.f;
#pragma unroll
        for (int q = 0; q < 8; ++q) { const f32x4 x4 = *(const f32x4*)(xrow + 4 * q);
            o[4 * q] += x4.x; o[4 * q + 1] += x4.y; o[4 * q + 2] += x4.z; o[4 * q + 3] += x4.w;
            s += (o[4 * q] * o[4 * q] + o[4 * q + 1] * o[4 * q + 1]) + (o[4 * q + 2] * o[4 * q + 2] + o[4 * q + 3] * o[4 * q + 3]); }
        const float rstd = 1.0f / sqrtf(wave_sum_u(s) * (1.0f / DM) + 1e-6f);
        if (l + 1 < NL) {
            bf16_t* xo = (bf16_t*)(a.ws + m.xn) + (size_t)n * DM + lane * 32;
#pragma unroll
            for (int q = 0; q < 8; ++q) *(f32x4*)(xrow + 4 * q) = (f32x4){o[4 * q], o[4 * q + 1], o[4 * q + 2], o[4 * q + 3]};
#pragma unroll
            for (int q = 0; q < 4; ++q) { v4u w; w.x = pk2(o[8 * q] * rstd, o[8 * q + 1] * rstd); w.y = pk2(o[8 * q + 2] * rstd, o[8 * q + 3] * rstd); w.z = pk2(o[8 * q + 4] * rstd, o[8 * q + 5] * rstd); w.w = pk2(o[8 * q + 6] * rstd, o[8 * q + 7] * rstd);
                *(v4u*)(xo + 8 * q) = w; }
        } else {
            const float* gf = a.in[I_NORM_FINAL] + lane * 32;
#pragma unroll
            for (int q = 0; q < 8; ++q) { const f32x4 g4 = *(const f32x4*)(gf + 4 * q);
                *(f32x4*)(xrow + 4 * q) = (f32x4){o[4 * q] * rstd * g4.x, o[4 * q + 1] * rstd * g4.y, o[4 * q + 2] * rstd * g4.z, o[4 * q + 3] * rstd * g4.w}; }
        }
    }
}

#define IN(k) (lo <= (k) && (k) < hi)
#define SEAM(k) do { if (IN(k) && IN((k) + 1)) xcd_barrier(bar); } while (0)
template <int l>
__device__ __forceinline__ void layer_phases(const Args& a, Frame& F, const XcdBarrier& bar, const WsMap& m, int lo, int hi) {
    constexpr int pb = l * PH_PER_LAYER;
        if (IN(pb + PH_GEMM1)) {
            pg8::GemmX g{(const bf16_t*)(a.ws + m.xn), (const bf16_t*)(a.ws + m.w1t) + (size_t)l * PLD * DM, NTOK, PLD, DM, DM};
            pg8::StaticOrder S; S.init(NTOK, PLD, F.G, (int)blockIdx.x);
            pg8::EpiBf16 E{(bf16_t*)(a.ws + m.p16), PLD, nullptr};
            pg8::gemm_phase<pg8::EpiBf16, pg8::StaticOrder, true, true>(F.lds, g, S, E);
            SEAM(pb + PH_GEMM1);
        }
        if (IN(pb + PH_PREP)) { prep_phase(a, F, l); SEAM(pb + PH_PREP); }
        if (IN(pb + PH_AUX)) {
            const float* PP = (const float*)(a.ws + m.pp);
            { pg8::GemmX g{(const bf16_t*)(a.ws + m.auxA), (const bf16_t*)(a.ws + m.auxwt) + (size_t)l * 1792 * 384, NTOK, 1792, 384, 384};
              pg8::StaticOrder S; S.init(NTOK, 1792, F.G, (int)blockIdx.x);
              pg8::EpiBf16 E{(bf16_t*)(a.ws + m.auxo), 1792, PP + l * 1792};
              pg8::gemm_phase<pg8::EpiBf16, pg8::StaticOrder, true, true>(F.lds, g, S, E); }
            { pg8::GemmX g{(const bf16_t*)(a.ws + m.xc), (const bf16_t*)(a.ws + m.lruwt) + (size_t)l * 1024 * 512, NTOK, 1024, 512, 512};
              pg8::StaticOrder S; S.init(NTOK, 1024, F.G, (int)blockIdx.x);
              pg8::EpiBf16 E{(bf16_t*)(a.ws + m.gates), 1024, PP + 3584 + l * 1024};
              pg8::gemm_phase<pg8::EpiBf16, pg8::StaticOrder, true, true>(F.lds, g, S, E); }
            if (l > 0) {
              pg8::GemmX g{(const bf16_t*)(a.ws + m.zrkv) + 1024, (const bf16_t*)(a.ws + m.vreswt), NTOK, 512, 512, 1536};
              pg8::StaticOrder S; S.init(NTOK, 512, F.G, (int)blockIdx.x);
              pg8::EpiBf16 E{(bf16_t*)(a.ws + m.vres), 512, PP + 5632};
              pg8::gemm_phase<pg8::EpiBf16, pg8::StaticOrder, true, true>(F.lds, g, S, E); }
            SEAM(pb + PH_AUX);
        }
        if (IN(pb + PH_SCAN)) { scan_phase(a, F, l); SEAM(pb + PH_SCAN); }
        if (IN(pb + PH_POST)) { post_phase(a, F, l, bar); SEAM(pb + PH_POST); }
        if (IN(pb + PH_GEMM2)) {
            pg8::GemmX g{(const bf16_t*)(a.ws + m.mix16), (const bf16_t*)(a.ws + m.w2t) + (size_t)l * DM * DM, NTOK, DM, DM, DM};
            pg8::StaticOrder S; S.init(NTOK, DM, F.G, (int)blockIdx.x);
            pg8::EpiF32<true> E{a.out, DM};
            pg8::gemm_phase<pg8::EpiF32<true>, pg8::StaticOrder, true, true>(F.lds, g, S, E);
            SEAM(pb + PH_GEMM2);
        }
        if (IN(pb + PH_NORM2)) { norm2_phase(a, F, l); SEAM(pb + PH_NORM2); }
        if (IN(pb + PH_GEMM3)) {
            pg8::GemmX g{(const bf16_t*)(a.ws + m.wsct) + (size_t)l * DM * DM, (const bf16_t*)(a.ws + m.hb), DM, NTOK, DM, DM};
            pg8::StaticOrder S; S.init(DM, NTOK, F.G, (int)blockIdx.x);
            pg8::EpiF32<false> E{(float*)(a.ws + m.sc), NTOK};
            pg8::gemm_phase<pg8::EpiF32<false>, pg8::StaticOrder, true, true>(F.lds, g, S, E);
            SEAM(pb + PH_GEMM3);
        }
        if (IN(pb + PH_TOPK)) { topk_phase(a, F); SEAM(pb + PH_TOPK); }
        if (IN(pb + PH_PEER)) { peer_phase(a, F, l); SEAM(pb + PH_PEER); }
}

#undef IN
#undef SEAM
__global__ void __launch_bounds__(NTHR, 2) mega(Args a) {
    extern __shared__ __attribute__((aligned(16))) unsigned char lds_raw[];
    Frame F;
    F.lds = (LAS unsigned char*)lds_raw;
    F.tid = threadIdx.x; F.lane = F.tid & 63; F.wave = __builtin_amdgcn_readfirstlane(F.tid >> 6);
    F.G = gridDim.x; { const int bx = blockIdx.x; F.vcu = (F.G % 8 == 0) ? (bx % 8) * (F.G / 8) + bx / 8 : bx; }
    F.gw = F.vcu * NWAVES + F.wave; F.ngw = F.G * NWAVES;
    volatile LAS unsigned* MISC = (volatile LAS unsigned*)(F.lds + MISC_OFF);
    if (F.tid < 32) MISC[F.tid] = 0u;
    __syncthreads();
    const WsMap m = ws_map(NTOK);
    unsigned* ctl = (unsigned*)(a.ws + m.ctl);
    XcdBarrier bar; bar.bar = ctl + 4096 + a.li * XCD_BAR_WORDS; bar.x = 0; bar.st = nullptr;
    const int lo = a.ph_lo, hi = a.ph_hi;
    if (hi - lo > 1) bar = xcd_barrier_post(ctl + 4096 + a.li * XCD_BAR_WORDS, MISC + 8);
#define IN(k) (lo <= (k) && (k) < hi)
#define SEAM(k) do { if (IN(k) && IN((k) + 1)) xcd_barrier(bar); } while (0)
    if (IN(PH_P0)) { p0_prologue(a, F); tables_range(a, F, 0, (size_t)2 * NEXP * DM / 32, F.vcu, F.G); SEAM(PH_P0); }
    layer_phases<0>(a, F, bar, m, lo, hi);
    layer_phases<1>(a, F, bar, m, lo, hi);
#undef IN
#undef SEAM
}

template <int ST>
__global__ void __launch_bounds__(256) stage_kernel(Params P, int l) {
    const long n = stage_items(P, ST, l);
    for (long it = blockIdx.x * 256L + threadIdx.x; it < n; it += gridDim.x * 256L) run_item(P, ST, l, it);
}
template <int ST>
static void launch_stage(const Params& P, int l, hipStream_t stream) {
    const long n = stage_items(P, ST, l);
    if (n <= 0) return;
    long blocks = (n + 255) / 256;
    if (blocks > 8192) blocks = 8192;
    stage_kernel<ST><<<dim3((unsigned)blocks), dim3(256), 0, stream>>>(P, l);
}
#define LS(X) case X: launch_stage<X>(P, l, stream); break;
static void launch_any(int st, const Params& P, int l, hipStream_t stream) {
    switch (st) {
        LS(ST_COPYX) LS(ST_RSTD) LS(ST_NORM1) LS(ST_GEMM1) LS(ST_RW_A0) LS(ST_RW_A1) LS(ST_RW_A2) LS(ST_RW_A3) LS(ST_RW_KKN)
        LS(ST_RW_SCAN) LS(ST_RW_POST) LS(ST_GLA_B0) LS(ST_GLA_SCAN) LS(ST_GLA_POST) LS(ST_LRU_C0) LS(ST_LRU_C1) LS(ST_LRU_SCAN)
        LS(ST_GDN_D0) LS(ST_GDN_D1) LS(ST_GDN_SCAN) LS(ST_GDN_POST) LS(ST_GEMM2) LS(ST_RSTD2) LS(ST_NORM2) LS(ST_GEMM3)
        LS(ST_SCORES) LS(ST_TOPK1) LS(ST_TOPK2) LS(ST_PEER_U) LS(ST_PEER_V) LS(ST_FRSTD) LS(ST_FNORM)
    }
}

extern "C" void kernel_launch(void* const* d_in, const int* in_sizes, int n_in, void* d_out, int out_size, void* d_ws,
                              size_t ws_size, hipStream_t stream) {
    static int grid = 0;
    if (grid == 0) {
        int dev = 0, cus = 0;
        (void)hipGetDevice(&dev);
        (void)hipDeviceGetAttribute(&cus, hipDeviceAttributeMultiprocessorCount, dev);
        (void)hipFuncSetAttribute((const void*)mega, hipFuncAttributeMaxDynamicSharedMemorySize, LDS_BYTES);
        grid = cus > 0 ? cus : 256;
    }
    Params P;
    memset(&P, 0, sizeof(P));
    fill_inputs(P, d_in);
    P.B = 4; P.T = 4096; P.N = 16384; P.pad = 0;
    P.xcur = (float*)d_out;
    bind_ws(P, (char*)d_ws);
    Args a;
    memset(&a, 0, sizeof(a));
    for (int i = 0; i < 38; ++i) a.in[i] = (const float*)d_in[i];
    a.out = (float*)d_out; a.ws = (unsigned char*)d_ws;
    (void)hipMemsetAsync(d_ws, 0, 1u << 20, stream);
    int li = 0;
    auto run_mega = [&](int lo, int hi) { a.ph_lo = lo; a.ph_hi = hi; a.li = li++; hipLaunchKernelGGL(mega, dim3(grid), dim3(NTHR), LDS_BYTES, stream, a); };
    run_mega(PH_P0, PH_TOTAL);
}
#endif
```

```cpp
#ifndef HOST_EMU
#include <hip/hip_runtime.h>
#include <cstring>
#define HD __host__ __device__ __forceinline__
#else
#include <cmath>
#include <cstdio>
#include <cstdlib>
#include <cstring>
#define HD inline
#endif

constexpr int DM = 2048;
constexpr int NL = 2;
constexpr int INC = 6424;
constexpr int C_RW = 0;
constexpr int C_GLA = 1792;
constexpr int C_LRU = 3344;
constexpr int C_GDN = 4368;
constexpr int NEXP = 16384;

typedef unsigned short bf16_t;
constexpr int PLD = 6656;
HD float bf2f(bf16_t h) { unsigned u = (unsigned)h << 16; float f; memcpy(&f, &u, 4); return f; }
HD bf16_t f2bf(float f) { unsigned u; memcpy(&u, &f, 4); return (bf16_t)((u + 0x7fffu + ((u >> 16) & 1u)) >> 16); }

struct Params {
    const float *x, *norm_mix, *w_in, *w_out, *rw_mu, *rw_w0, *rw_w_up, *rw_a0, *rw_a_up, *rw_g_up, *rw_k_k, *rw_k_a,
        *rw_r_k, *rw_ln_w, *rw_ln_b, *rw_v0, *rw_v_down, *rw_v_up, *gla_a_up, *gla_a_bias, *gla_norm, *lru_conv_w,
        *lru_conv_b, *lru_w_r, *lru_b_r, *lru_w_i, *lru_b_i, *lru_lam, *gdn_conv_w, *gdn_a_log, *gdn_dt_bias, *gdn_norm,
        *norm_ffn, *peer_wq, *peer_sub_keys, *peer_u, *peer_v, *norm_final;
    float* xcur;
    bf16_t* xn;
    bf16_t* hb;
    bf16_t* mix16;
    bf16_t* p16;
    float* sc;
    float* qf;
    float* rstd;
    float* vfirst;
    float* scr;
    float* act;
    float* gate;
    int* idx;
    int B, T, N, pad;
};

HD float sigmoidf_(float x) { return 1.0f / (1.0f + expf(-x)); }
HD float softplusf_(float x) { return log1pf(expf(-fabsf(x))) + fmaxf(x, 0.0f); }
HD float siluf_(float x) { return x * sigmoidf_(x); }
HD float geluf_(float x) { return 0.5f * x * (1.0f + tanhf(0.7978845608028654f * (x + 0.044715f * x * x * x))); }

enum Stage {
    ST_COPYX = 0,
    ST_RSTD, ST_NORM1, ST_GEMM1,
    ST_RW_A0, ST_RW_A1, ST_RW_A2, ST_RW_A3, ST_RW_KKN, ST_RW_SCAN, ST_RW_POST,
    ST_GLA_B0, ST_GLA_SCAN, ST_GLA_POST,
    ST_LRU_C0, ST_LRU_C1, ST_LRU_SCAN,
    ST_GDN_D0, ST_GDN_D1, ST_GDN_SCAN, ST_GDN_POST,
    ST_GEMM2, ST_RSTD2, ST_NORM2, ST_GEMM3, ST_SCORES, ST_TOPK1, ST_TOPK2, ST_PEER_U, ST_PEER_V,
    ST_FRSTD, ST_FNORM,
    ST_COUNT
};

constexpr long SO_ZS = 0, SO_R = 256, SO_DEC = 768, SO_KM = 1280, SO_KK = 1792, SO_A = 2304, SO_G = 2816, SO_V = 3328,
               SO_Y = 3840, SO_VD = 4352, SO_KKINV = 4384;
constexpr long SO_ALPHA = 0, SO_GO = 256;
constexpr long SO_XC = 0, SO_LA = 512, SO_LU = 1024;
constexpr long SO_QKV = 0, SO_GS = 1536, SO_DO = 1552;
constexpr long SCR_PER_TOK = 4400;
constexpr long SO_TS = 0, SO_TI = 256;

HD long stage_items(const Params& P, int st, int l) {
    const long N = P.N;
    switch (st) {
        case ST_COPYX: return N * DM;
        case ST_RSTD: case ST_RSTD2: case ST_FRSTD: return N;
        case ST_NORM1: case ST_NORM2: case ST_FNORM: return N * DM;
        case ST_GEMM1: return (N / 4) * (INC / 4);
        case ST_RW_A0: return N * 256;
        case ST_RW_A1: return N * 512;
        case ST_RW_A2: return l > 0 ? N * 32 : 0;
        case ST_RW_A3: return l > 0 ? N * 512 : 0;
        case ST_RW_KKN: return N * 8;
        case ST_RW_SCAN: return (long)P.B * 512;
        case ST_RW_POST: return N * 8;
        case ST_GLA_B0: return N * 256;
        case ST_GLA_SCAN: return (long)P.B * 512;
        case ST_GLA_POST: return N * 4;
        case ST_LRU_C0: return N * 512;
        case ST_LRU_C1: return N * 512;
        case ST_LRU_SCAN: return (long)P.B * 512;
        case ST_GDN_D0: return N * 1536;
        case ST_GDN_D1: return N * 4;
        case ST_GDN_SCAN: return (long)P.B * 512;
        case ST_GDN_POST: return N * 4;
        case ST_GEMM2: case ST_GEMM3: return (N / 4) * (DM / 4);
        case ST_SCORES: return N * 2048;
        case ST_TOPK1: return N * 16;
        case ST_TOPK2: return N * 8;
        case ST_PEER_U: return N * 128;
        case ST_PEER_V: return N * DM;
    }
    return 0;
}

HD void gemm_item(const bf16_t* A, const float* W, int ldw, const float* kscale, float* Cf, bf16_t* Ch, int ldc, int n4, long item, int mode) {
    const long r4 = item / n4;
    const int c4 = (int)(item % n4);
    const bf16_t* a0 = A + (r4 * 4) * (long)DM;
    const float* w = W + c4 * 4;
    float acc[4][4];
    for (int i = 0; i < 4; ++i)
        for (int j = 0; j < 4; ++j) acc[i][j] = 0.f;
    for (int k = 0; k < DM; ++k) {
        const float ks = kscale ? kscale[k] : 1.0f;
        const float w0 = w[(long)k * ldw + 0] * ks, w1 = w[(long)k * ldw + 1] * ks, w2 = w[(long)k * ldw + 2] * ks, w3 = w[(long)k * ldw + 3] * ks;
#pragma unroll
        for (int i = 0; i < 4; ++i) {
            const float a = bf2f(a0[(long)i * DM + k]);
            acc[i][0] += a * w0; acc[i][1] += a * w1; acc[i][2] += a * w2; acc[i][3] += a * w3;
        }
    }
#pragma unroll
    for (int i = 0; i < 4; ++i) {
        const long o = (r4 * 4 + i) * (long)ldc + c4 * 4;
#pragma unroll
        for (int j = 0; j < 4; ++j) {
            if (mode == 0) Ch[o + j] = f2bf(acc[i][j]);
            else if (mode == 1) Cf[o + j] += acc[i][j];
            else Cf[o + j] = acc[i][j];
        }
    }
}

#define PF(n, col) bf2f(P.p16[(long)(n) * PLD + (col)])
HD float rw_shift(const Params& P, int l, long n, int col) {
    const int t = (int)(n % P.T);
    const float cur = PF(n, C_RW + col);
    const float prev = t > 0 ? PF(n - 1, C_RW + col) : 0.f;
    return cur + (prev - cur) * P.rw_mu[l * 1792 + col];
}

HD void run_item(const Params& P, int st, int l, long it) {
    const long N = P.N;
    float* scr = P.scr;
    switch (st) {
        case ST_COPYX: P.xcur[it] = P.x[it]; break;
        case ST_RSTD: case ST_RSTD2: case ST_FRSTD: {
            const float* xr = P.xcur + it * DM;
            float s = 0.f;
            for (int d = 0; d < DM; ++d) s += xr[d] * xr[d];
            P.rstd[it] = 1.0f / sqrtf(s * (1.0f / DM) + 1e-6f);
        } break;
        case ST_NORM1: case ST_NORM2: case ST_FNORM: {
            const long n = it / DM; const int d = (int)(it % DM);
            if (st == ST_NORM1) P.xn[it] = f2bf(P.xcur[it] * P.rstd[n]);
            else if (st == ST_NORM2) P.hb[it] = f2bf(P.xcur[it] * P.rstd[n] * P.norm_ffn[l * DM + d]);
            else P.xcur[it] = P.xcur[it] * P.rstd[n] * P.norm_final[d];
        } break;
        case ST_GEMM1: gemm_item(P.xn, P.w_in + (long)l * DM * INC, INC, P.norm_mix + l * DM, nullptr, P.p16, PLD, INC / 4, it, 0); break;
        case ST_GEMM2: gemm_item(P.mix16, P.w_out + (long)l * DM * DM, DM, nullptr, P.xcur, nullptr, DM, DM / 4, it, 1); break;
        case ST_GEMM3: gemm_item(P.hb, P.peer_wq + (long)l * DM * DM, DM, nullptr, P.qf, nullptr, DM, DM / 4, it, 2); break;
        case ST_RW_A0: {
            const long n = it / 256; const int c = (int)(it % 256);
            const float z = rw_shift(P, l, n, 1536 + c);
            scr[N * SO_ZS + it] = c < 64 ? tanhf(z) : (c < 128 ? z : sigmoidf_(z));
        } break;
        case ST_RW_A1: {
            const long n = it / 512; const int j = (int)(it % 512);
            const float zr = rw_shift(P, l, n, j), zk = rw_shift(P, l, n, 512 + j), zv = rw_shift(P, l, n, 1024 + j);
            const float* zs = scr + N * SO_ZS + n * 256;
            float aw = P.rw_w0[l * 512 + j], aa = P.rw_a0[l * 512 + j], ag = 0.f;
            const float* wu = P.rw_w_up + (long)l * 64 * 512 + j;
            const float* au = P.rw_a_up + (long)l * 64 * 512 + j;
            const float* gu = P.rw_g_up + (long)l * 128 * 512 + j;
            for (int i = 0; i < 64; ++i) { aw += zs[i] * wu[i * 512]; aa += zs[64 + i] * au[i * 512]; }
            for (int i = 0; i < 128; ++i) ag += zs[128 + i] * gu[i * 512];
            const float w_raw = -softplusf_(-aw) - 0.5f;
            const float a = sigmoidf_(aa);
            scr[N * SO_R + it] = zr;
            scr[N * SO_DEC + it] = expf(-expf(w_raw));
            scr[N * SO_KM + it] = zk * (1.0f + (a - 1.0f) * P.rw_k_a[l * 512 + j]);
            scr[N * SO_KK + it] = zk * P.rw_k_k[l * 512 + j];
            scr[N * SO_A + it] = a;
            scr[N * SO_G + it] = ag;
            scr[N * SO_V + it] = zv;
            if (l == 0) P.vfirst[it] = zv;
        } break;
        case ST_RW_A2: {
            const long n = it / 32; const int i = (int)(it % 32);
            const float* v = scr + N * SO_V + n * 512;
            const float* vdn = P.rw_v_down + (long)(l - 1) * 512 * 32 + i;
            float s = 0.f;
            for (int j = 0; j < 512; ++j) s += v[j] * vdn[j * 32];
            scr[N * SO_VD + it] = s;
        } break;
        case ST_RW_A3: {
            const long n = it / 512; const int j = (int)(it % 512);
            const float* vd = scr + N * SO_VD + n * 32;
            const float* vup = P.rw_v_up + (long)(l - 1) * 32 * 512 + j;
            float s = P.rw_v0[(l - 1) * 512 + j];
            for (int i = 0; i < 32; ++i) s += vd[i] * vup[i * 512];
            const float v = scr[N * SO_V + it];
            scr[N * SO_V + it] = v + (P.vfirst[it] - v) * sigmoidf_(s);
        } break;
        case ST_RW_KKN: {
            const float* kk = scr + N * SO_KK + it * 64;
            float s = 0.f;
            for (int i = 0; i < 64; ++i) s += kk[i] * kk[i];
            scr[N * SO_KKINV + it] = 1.0f / sqrtf(fmaxf(s, 1e-24f));
        } break;
        case ST_RW_SCAN: {
            const int b = (int)(it / 512); const int h = (int)((it % 512) / 64); const int v = (int)(it % 64);
            float S[64];
#pragma unroll
            for (int i = 0; i < 64; ++i) S[i] = 0.f;
            for (int t = 0; t < P.T; ++t) {
                const long n = (long)b * P.T + t;
                const long base = n * 512 + h * 64;
                const float inv = scr[N * SO_KKINV + n * 8 + h];
                const float vv = scr[N * SO_V + base + v];
                const float* KK = scr + N * SO_KK + base;
                const float* DEC = scr + N * SO_DEC + base;
                const float* KM = scr + N * SO_KM + base;
                const float* AA = scr + N * SO_A + base;
                const float* RR = scr + N * SO_R + base;
                float sa = 0.f;
#pragma unroll
                for (int i = 0; i < 64; ++i) sa += S[i] * (-KK[i] * inv);
                float y = 0.f;
#pragma unroll
                for (int i = 0; i < 64; ++i) {
                    const float kk = KK[i] * inv;
                    S[i] = S[i] * DEC[i] + sa * (kk * AA[i]) + vv * KM[i];
                    y += S[i] * RR[i];
                }
                scr[N * SO_Y + base + v] = y;
            }
        } break;
        case ST_RW_POST: {
            const long n = it / 8; const int h = (int)(it % 8);
            const long base = n * 512 + h * 64;
            const float* Y = scr + N * SO_Y + base;
            const float* RR = scr + N * SO_R + base;
            const float* KM = scr + N * SO_KM + base;
            const float* V = scr + N * SO_V + base;
            const float* G = scr + N * SO_G + base;
            float mean = 0.f, bon = 0.f;
            for (int i = 0; i < 64; ++i) { mean += Y[i]; bon += RR[i] * KM[i] * P.rw_r_k[l * 512 + h * 64 + i]; }
            mean *= (1.0f / 64);
            float var = 0.f;
            for (int i = 0; i < 64; ++i) { const float d = Y[i] - mean; var += d * d; }
            const float rs = 1.0f / sqrtf(var * (1.0f / 64) + 64e-5f);
            for (int i = 0; i < 64; ++i) {
                const int c = h * 64 + i;
                const float yn = (Y[i] - mean) * rs * P.rw_ln_w[l * 512 + c] + P.rw_ln_b[l * 512 + c];
                P.mix16[n * DM + c] = f2bf((yn + bon * V[i]) * G[i]);
            }
        } break;
        case ST_GLA_B0: {
            const long n = it / 256; const int c = (int)(it % 256);
            float s = P.gla_a_bias[l * 256 + c];
            for (int i = 0; i < 16; ++i) s += PF(n, C_GLA + 1536 + i) * P.gla_a_up[(long)l * 16 * 256 + i * 256 + c];
            scr[N * SO_ALPHA + it] = expf(-softplusf_(-s) * (1.0f / 16.0f));
        } break;
        case ST_GLA_SCAN: {
            const int b = (int)(it / 512); const int h = (int)((it % 512) / 128); const int v = (int)(it % 128);
            float S[64];
#pragma unroll
            for (int i = 0; i < 64; ++i) S[i] = 0.f;
            for (int t = 0; t < P.T; ++t) {
                const long n = (long)b * P.T + t;
                const bf16_t* q = P.p16 + n * PLD + C_GLA + h * 64;
                const bf16_t* k = q + 256;
                const float vv = PF(n, C_GLA + 512 + h * 128 + v);
                const float* al = scr + N * SO_ALPHA + n * 256 + h * 64;
                float o = 0.f;
#pragma unroll
                for (int i = 0; i < 64; ++i) {
                    S[i] = S[i] * al[i] + bf2f(k[i]) * vv;
                    o += bf2f(q[i]) * S[i];
                }
                scr[N * SO_GO + n * 512 + h * 128 + v] = o * 0.125f;
            }
        } break;
        case ST_GLA_POST: {
            const long n = it / 4; const int h = (int)(it % 4);
            const float* o = scr + N * SO_GO + n * 512 + h * 128;
            float ms = 0.f;
            for (int i = 0; i < 128; ++i) ms += o[i] * o[i];
            const float rs = 1.0f / sqrtf(ms * (1.0f / 128) + 1e-6f);
            for (int i = 0; i < 128; ++i) {
                const float g = PF(n, C_GLA + 1024 + h * 128 + i);
                P.mix16[n * DM + 512 + h * 128 + i] = f2bf(o[i] * rs * P.gla_norm[l * 128 + i] * siluf_(g));
            }
        } break;
        case ST_LRU_C0: {
            const long n = it / 512; const int c = (int)(it % 512);
            const int t = (int)(n % P.T);
            float s = P.lru_conv_b[l * 512 + c];
            for (int j = 0; j < 4; ++j) {
                const int tt = t - 3 + j;
                if (tt >= 0) s += P.lru_conv_w[(long)l * 4 * 512 + j * 512 + c] * PF(n - 3 + j, C_LRU + c);
            }
            scr[N * SO_XC + it] = s;
        } break;
        case ST_LRU_C1: {
            const long n = it / 512; const int c = (int)(it % 512);
            const int blk = c / 64, j = c % 64;
            const float* xc = scr + N * SO_XC + n * 512 + blk * 64;
            const float* wr = P.lru_w_r + (long)l * 8 * 64 * 64 + (long)blk * 64 * 64 + j;
            const float* wi = P.lru_w_i + (long)l * 8 * 64 * 64 + (long)blk * 64 * 64 + j;
            float sr = P.lru_b_r[l * 512 + c], si = P.lru_b_i[l * 512 + c];
            for (int i = 0; i < 64; ++i) { sr += xc[i] * wr[i * 64]; si += xc[i] * wi[i * 64]; }
            const float r = sigmoidf_(sr), ig = sigmoidf_(si);
            const float log_a = -8.0f * r * softplusf_(-P.lru_lam[l * 512 + c]);
            scr[N * SO_LA + it] = expf(log_a);
            scr[N * SO_LU + it] = scr[N * SO_XC + it] * ig * sqrtf(-expm1f(2.0f * log_a));
        } break;
        case ST_LRU_SCAN: {
            const int b = (int)(it / 512); const int c = (int)(it % 512);
            float hst = 0.f;
            for (int t = 0; t < P.T; ++t) {
                const long n = (long)b * P.T + t;
                hst = scr[N * SO_LA + n * 512 + c] * hst + scr[N * SO_LU + n * 512 + c];
                P.mix16[n * DM + 1024 + c] = f2bf(hst * geluf_(PF(n, C_LRU + 512 + c)));
            }
        } break;
        case ST_GDN_D0: {
            const long n = it / 1536; const int c = (int)(it % 1536);
            const int t = (int)(n % P.T);
            float s = 0.f;
            for (int j = 0; j < 4; ++j) {
                const int tt = t - 3 + j;
                if (tt >= 0) s += P.gdn_conv_w[(long)l * 4 * 1536 + j * 1536 + c] * PF(n - 3 + j, C_GDN + c);
            }
            scr[N * SO_QKV + it] = siluf_(s);
        } break;
        case ST_GDN_D1: {
            const long n = it / 4; const int h = (int)(it % 4);
            const float* q = scr + N * SO_QKV + n * 1536 + h * 128;
            const float* k = q + 512;
            float qs = 0.f, ks = 0.f;
            for (int i = 0; i < 128; ++i) { qs += q[i] * q[i]; ks += k[i] * k[i]; }
            float* gs = scr + N * SO_GS + n * 16 + h * 4;
            gs[0] = (1.0f / sqrtf(qs + 1e-6f)) * 0.08838834764831845f;
            gs[1] = 1.0f / sqrtf(ks + 1e-6f);
            gs[2] = sigmoidf_(PF(n, C_GDN + 2048 + h));
            gs[3] = expf(-expf(P.gdn_a_log[l * 4 + h]) * softplusf_(PF(n, C_GDN + 2052 + h) + P.gdn_dt_bias[l * 4 + h]));
        } break;
        case ST_GDN_SCAN: {
            const int b = (int)(it / 512); const int h = (int)((it % 512) / 128); const int v = (int)(it % 128);
            float S[128];
#pragma unroll
            for (int i = 0; i < 128; ++i) S[i] = 0.f;
            for (int t = 0; t < P.T; ++t) {
                const long n = (long)b * P.T + t;
                const float* q = scr + N * SO_QKV + n * 1536 + h * 128;
                const float* k = q + 512;
                const float vv = scr[N * SO_QKV + n * 1536 + 1024 + h * 128 + v];
                const float* gs = scr + N * SO_GS + n * 16 + h * 4;
                const float qinv = gs[0], kinv = gs[1], beta = gs[2], eg = gs[3];
                float dk = 0.f;
#pragma unroll
                for (int i = 0; i < 128; ++i) dk += S[i] * k[i];
                const float u = beta * (vv - eg * kinv * dk) * kinv;
                float o = 0.f;
#pragma unroll
                for (int i = 0; i < 128; ++i) {
                    S[i] = S[i] * eg + u * k[i];
                    o += S[i] * q[i];
                }
                scr[N * SO_DO + n * 512 + h * 128 + v] = o * qinv;
            }
        } break;
        case ST_GDN_POST: {
            const long n = it / 4; const int h = (int)(it % 4);
            const float* o = scr + N * SO_DO + n * 512 + h * 128;
            float ms = 0.f;
            for (int i = 0; i < 128; ++i) ms += o[i] * o[i];
            const float rs = 1.0f / sqrtf(ms * (1.0f / 128) + 1e-6f);
            for (int i = 0; i < 128; ++i) {
                const float z = PF(n, C_GDN + 1536 + h * 128 + i);
                P.mix16[n * DM + 1536 + h * 128 + i] = f2bf(o[i] * rs * P.gdn_norm[l * 128 + i] * siluf_(z));
            }
        } break;
        case ST_SCORES: {
            const long n = it / 2048; const int c = (int)(it % 2048);
            const int hp = c / 128, key = c % 128;
            const float* q = P.qf + n * DM + hp * 128;
            const float* sk = P.peer_sub_keys + (long)l * 16 * 128 * 128 + ((long)hp * 128 + key) * 128;
            float s = 0.f;
            for (int d = 0; d < 128; ++d) s += q[d] * sk[d];
            P.sc[it] = s;
        } break;
        case ST_TOPK1: {
            const float* sc = P.sc + it * 128;
            float ts[16]; int ti[16];
#pragma unroll
            for (int j = 0; j < 16; ++j) { ts[j] = -3.0e38f; ti[j] = 0; }
            for (int i = 0; i < 128; ++i) {
                float xv = sc[i]; int xi = i;
                if (xv > ts[15]) {
#pragma unroll
                    for (int j = 0; j < 16; ++j) {
                        if (xv > ts[j]) { const float tv = ts[j]; const int tj = ti[j]; ts[j] = xv; ti[j] = xi; xv = tv; xi = tj; }
                    }
                }
            }
            float* TS = scr + N * SO_TS + it * 16;
            int* TI = (int*)(scr + N * SO_TI) + it * 16;
#pragma unroll
            for (int j = 0; j < 16; ++j) { TS[j] = ts[j]; TI[j] = ti[j]; }
        } break;
        case ST_TOPK2: {
            const float* s0 = scr + N * SO_TS + it * 32;
            const float* s1 = s0 + 16;
            const int* i0 = (const int*)(scr + N * SO_TI) + it * 32;
            const int* i1 = i0 + 16;
            float ts[16]; int ti[16];
#pragma unroll
            for (int j = 0; j < 16; ++j) { ts[j] = -3.0e38f; ti[j] = 0; }
            for (int a = 0; a < 16; ++a) {
                const int jmax = 16 / (a + 1);
                for (int b = 0; b < jmax; ++b) {
                    float xv = s0[a] + s1[b]; int xi = i0[a] * 128 + i1[b];
                    if (xv > ts[15]) {
#pragma unroll
                        for (int j = 0; j < 16; ++j) {
                            if (xv > ts[j]) { const float tv = ts[j]; const int tj = ti[j]; ts[j] = xv; ti[j] = xi; xv = tv; xi = tj; }
                        }
                    }
                }
            }
            const float mx = ts[0];
            float den = 0.f;
#pragma unroll
            for (int j = 0; j < 16; ++j) { ts[j] = expf(ts[j] - mx); den += ts[j]; }
            const float inv = 1.0f / den;
#pragma unroll
            for (int j = 0; j < 16; ++j) { P.gate[it * 16 + j] = ts[j] * inv; P.idx[it * 16 + j] = ti[j]; }
        } break;
        case ST_PEER_U: {
            const long n = it / 128;
            const int e = P.idx[it];
            const float* u = P.peer_u + ((long)l * NEXP + e) * DM;
            const bf16_t* hx = P.hb + n * DM;
            float s = 0.f;
            for (int d = 0; d < DM; ++d) s += bf2f(hx[d]) * u[d];
            P.act[it] = geluf_(s) * P.gate[it];
        } break;
        case ST_PEER_V: {
            const long n = it / DM; const int d = (int)(it % DM);
            const float* a = P.act + n * 128;
            const int* ix = P.idx + n * 128;
            float s = 0.f;
            for (int j = 0; j < 128; ++j) s += a[j] * P.peer_v[((long)l * NEXP + ix[j]) * DM + d];
            P.xcur[it] += s;
        } break;
    }
}


struct WsMap {
    size_t ctl, w1t, w2t, wsct, auxwt, lruwt, vreswt, pp, tabu, tabv, xn, hb, mix16, p16, sc, aux, vfirst, idx, gate, rstd, act, end;
    size_t auxA, zrkv, xc, auxo, gates, vres, glao, gdno, gq, gk, gv, gsc, rwy, rwbv, lrs, gblob, glas, gladv;
    size_t scr, qf;
};
HD WsMap ws_map(size_t N) {
    WsMap m{};
    size_t o = 0;
    auto take = [&](size_t bytes) { size_t r = o; o += (bytes + 4095) & ~(size_t)4095; return r; };
    m.ctl = take(1u << 20);
    m.w1t = take((size_t)NL * PLD * DM * 2);
    m.w2t = take((size_t)NL * DM * DM * 2);
    m.wsct = take((size_t)NL * DM * DM * 2);
    m.auxwt = take((size_t)NL * 1792 * 384 * 2);
    m.lruwt = take((size_t)NL * 1024 * 512 * 2);
    m.vreswt = take((size_t)512 * 512 * 2);
    m.pp = take(1u << 20);
    m.xn = take(N * DM * 2);
    m.hb = take(N * DM * 2);
    m.mix16 = take(N * DM * 2);
    m.p16 = take(N * PLD * 2);
    m.sc = m.p16;
    m.vfirst = take(N * 512 * 4);
    m.idx = take(N * 128 * 4);
    m.gate = take(N * 128 * 4);
    m.act = take(N * 128 * 4);
    m.rstd = take(N * 4);
    m.tabu = take((size_t)NL * 2 * NEXP * 1536);
    m.tabv = m.tabu + (size_t)NEXP * 1536;
    m.aux = take(N * 5888 * 4);
    m.end = o;
    size_t a = m.aux;
    auto sub = [&](size_t bytes) { size_t r = a; a += (bytes + 4095) & ~(size_t)4095; return r; };
    m.auxA = sub(N * 384 * 2); m.zrkv = sub(N * 1536 * 2); m.xc = sub(N * 512 * 2); m.auxo = sub(N * 1792 * 2);
    m.gates = sub(N * 1024 * 2); m.vres = sub(N * 512 * 2); m.glao = sub(N * 512 * 2); m.gdno = sub(N * 512 * 2);
    m.gq = sub(N * 512 * 2); m.gk = sub(N * 512 * 2); m.gv = sub(N * 512 * 2); m.gsc = sub(N * 8 * 4); m.rwy = sub(N * 512 * 2); m.rwbv = sub(N * 512 * 2); m.lrs = sub(N / 64 * 512 * 2 * 4);
    m.gblob = sub(N / 64 * 4 * 26880);
    m.glas = sub(N / 64 * 4 * 8192 * 2); m.gladv = sub(N / 64 * 4 * 64 * 4);
    m.scr = m.tabu;
    m.qf = m.aux + N * 1024 * 4;
    return m;
}
static inline void bind_ws(Params& P, char* ws) {
    const WsMap m = ws_map((size_t)P.N);
    P.xn = (bf16_t*)(ws + m.xn); P.hb = (bf16_t*)(ws + m.hb); P.mix16 = (bf16_t*)(ws + m.mix16); P.p16 = (bf16_t*)(ws + m.p16);
    P.sc = (float*)(ws + m.sc); P.qf = (float*)(ws + m.qf); P.rstd = (float*)(ws + m.rstd); P.vfirst = (float*)(ws + m.vfirst);
    P.scr = (float*)(ws + m.scr); P.act = (float*)(ws + m.act); P.gate = (float*)(ws + m.gate); P.idx = (int*)(ws + m.idx);
}

struct Step { int st, l; };
static inline int build_schedule(Step* s) {
    int n = 0;
    s[n++] = {ST_COPYX, 0};
    for (int l = 0; l < NL; ++l) {
        static const int per_layer[] = {ST_RSTD, ST_NORM1, ST_GEMM1,
            ST_RW_A0, ST_RW_A1, ST_RW_A2, ST_RW_A3, ST_RW_KKN, ST_RW_SCAN, ST_RW_POST,
            ST_GLA_B0, ST_GLA_SCAN, ST_GLA_POST, ST_LRU_C0, ST_LRU_C1, ST_LRU_SCAN,
            ST_GDN_D0, ST_GDN_D1, ST_GDN_SCAN, ST_GDN_POST,
            ST_GEMM2, ST_RSTD2, ST_NORM2, ST_GEMM3, ST_SCORES, ST_TOPK1, ST_TOPK2, ST_PEER_U, ST_PEER_V};
        for (int i = 0; i < (int)(sizeof(per_layer) / sizeof(int)); ++i) s[n++] = {per_layer[i], l};
    }
    s[n++] = {ST_FRSTD, 0};
    s[n++] = {ST_FNORM, 0};
    return n;
}

static inline void fill_inputs(Params& P, void* const* d_in) {
    const float** dst = (const float**)&P;
    for (int i = 0; i < 38; ++i) dst[i] = (const float*)d_in[i];
}

#ifndef HOST_EMU
#define GAS __attribute__((address_space(1)))
#define LAS __attribute__((address_space(3)))
typedef unsigned v4u __attribute__((ext_vector_type(4)));
typedef unsigned v2u __attribute__((ext_vector_type(2)));
typedef float f32x4 __attribute__((ext_vector_type(4)));
typedef float f32x2 __attribute__((ext_vector_type(2)));
typedef short bf16x8 __attribute__((ext_vector_type(8)));
constexpr int NWAVES = 8, NTHR = 512;
constexpr int RING_BYTES = 131072, MISC_OFF = RING_BYTES + 320, LDS_BYTES = 147456;
constexpr int NTOK = 16384, TSEQ = 4096, NBATCH = 4;

__device__ __forceinline__ unsigned pk2(float lo, float hi) { return (unsigned)f2bf(lo) | ((unsigned)f2bf(hi) << 16); }
__device__ __forceinline__ float bflo(unsigned u) { return __builtin_bit_cast(float, u << 16); }
__device__ __forceinline__ float bfhi(unsigned u) { return __builtin_bit_cast(float, u & 0xffff0000u); }
__device__ __forceinline__ float wave_sum(float v) {
#pragma unroll
    for (int o = 1; o < 64; o <<= 1) v += __shfl_xor(v, o);
    return v;
}
#define LDS_WAIT() asm volatile("s_waitcnt lgkmcnt(0)" ::: "memory")
#define VM_WAIT() asm volatile("s_waitcnt vmcnt(0)" ::: "memory")

namespace pg8 {
#define PG8_LAS __attribute__((address_space(3)))
constexpr int BM = 256, BK = 64, HALF = 128, HTB = HALF * BK * 2, STAGE_BYTES = 8 * HTB, NXCD = 8, WGM = 8;
__host__ __device__ __forceinline__ int lds_byte(int r, int c) { const int st = (r >> 4) * 2 + (c >> 5), rr = r & 15, cc = c & 31, ob = rr * 64 + cc * 2; return st * 1024 + (ob ^ (((ob >> 9) & 1) << 5)); }
__host__ __device__ __forceinline__ void stage_rc(int b, int& R, int& C) { const int st = b / 1024, sb = b % 1024, swz = sb ^ (((sb >> 9) & 1) << 5); R = (st >> 1) * 16 + swz / 64; C = (st & 1) * 32 + (swz % 64) / 2; }
__host__ __device__ __forceinline__ int perm32(int rho) { const int n = rho >> 4, i = rho & 15; return 8 * (i >> 2) + 4 * n + (i & 3); }
struct Unit { int pm, pn; };
struct GemmX { const bf16_t* A; const bf16_t* Bt; int M, N, K, lda; };
struct StaticOrder {
    int nM, nN, nwg, G, c;
    __host__ __device__ void init(int M, int N, int G_, int c_) { nM = M / BM; nN = N / BM; nwg = nM * nN; G = G_; c = c_; }
    __host__ __device__ bool next(int i, Unit& u) const {
        const long L = (long)i * G + c; if (L >= nwg) return false;
        int wgid = (int)L; { const int q = nwg / NXCD, r = nwg % NXCD, xcd = wgid % NXCD, off = wgid / NXCD; wgid = (xcd < r ? xcd * (q + 1) : r * (q + 1) + (xcd - r) * q) + off; }
        const int nig = WGM * nN, gid = wgid / nig, fm = gid * WGM, gsz = (nM - fm) < WGM ? (nM - fm) : WGM;
        u.pm = fm + ((wgid % nig) % gsz); u.pn = (wgid % nig) / gsz; return true;
    }
    __device__ __forceinline__ void a_ready(const Unit&) const {}
    __device__ __forceinline__ void done(const Unit&) const {}
};
__device__ __forceinline__ unsigned cvt_pk_bf16(float lo, float hi) { unsigned r; asm volatile("v_cvt_pk_bf16_f32 %0, %1, %2" : "=v"(r) : "v"(lo), "v"(hi)); return r; }
template <bool ACCUM> struct EpiF32 {
    static constexpr bool PERM = false, AFTER_DRAIN = false;
    float* C; int ldc;
    __device__ __forceinline__ void operator()(const f32x4 (&acc)[2][2][4][2], const Unit& u, int wr, int wc, int fr, int fq) const {
        const int row0 = u.pm * BM + wr * 64 + fr, col0 = u.pn * BM + wc * 32 + 4 * fq;
#pragma unroll
        for (int ai = 0; ai < 2; ++ai)
#pragma unroll
            for (int m = 0; m < 4; ++m) { float* rowp = C + (size_t)(row0 + ai * HALF + m * 16) * ldc + col0;
#pragma unroll
                for (int bj = 0; bj < 2; ++bj)
#pragma unroll
                    for (int n = 0; n < 2; ++n) { f32x4* p = (f32x4*)(rowp + bj * HALF + n * 16);
                        if (ACCUM) *p = *p + acc[ai][bj][m][n]; else *p = acc[ai][bj][m][n]; } }
    }
};
struct EpiBf16 {
    static constexpr bool PERM = true, AFTER_DRAIN = false;
    bf16_t* O; int ldc; const float* bias;
    __device__ __forceinline__ void operator()(const f32x4 (&acc)[2][2][4][2], const Unit& u, int wr, int wc, int fr, int fq) const {
        const int row0 = u.pm * BM + wr * 64 + fr; const int col0 = u.pn * BM + wc * 32 + 8 * fq;
        f32x4 bv[2][2];
#pragma unroll
        for (int bj = 0; bj < 2; ++bj)
#pragma unroll
            for (int n = 0; n < 2; ++n) bv[bj][n] = bias ? *(const f32x4*)(bias + col0 + bj * HALF + 4 * n) : (f32x4){0.f, 0.f, 0.f, 0.f};
#pragma unroll
        for (int ai = 0; ai < 2; ++ai)
#pragma unroll
            for (int m = 0; m < 4; ++m) { bf16_t* rowp = O + (size_t)(row0 + ai * HALF + m * 16) * ldc + col0;
#pragma unroll
                for (int bj = 0; bj < 2; ++bj) { const f32x4 v0 = acc[ai][bj][m][0] + bv[bj][0], v1 = acc[ai][bj][m][1] + bv[bj][1];
                    v4u w; w.x = cvt_pk_bf16(v0[0], v0[1]); w.y = cvt_pk_bf16(v0[2], v0[3]); w.z = cvt_pk_bf16(v1[0], v1[1]); w.w = cvt_pk_bf16(v1[2], v1[3]);
                    *(v4u*)(rowp + bj * HALF) = w; } }
    }
};
template <class Epi, class Sched, bool ALIGN_EPI = false, bool SP2 = false>
__device__ __forceinline__ void gemm_phase(PG8_LAS unsigned char* lds, const GemmX g, const Sched& S, const Epi& E) {
    const int tid = threadIdx.x, wid = __builtin_amdgcn_readfirstlane(tid >> 6), lane = tid & 63, wr = wid >> 2, wc = wid & 3, fr = lane & 15, fq = lane >> 4;
    const int K = g.K, nt = K / BK;
    unsigned voffA[2], voffB[2];
#pragma unroll
    for (int i = 0; i < 2; ++i) { int R, C; stage_rc(tid * 16 + i * 8192, R, C); const int Rb = Epi::PERM ? ((R & ~31) + perm32(R & 31)) : R;
        voffA[i] = (unsigned)(R * g.lda + C) * 2u; voffB[i] = (unsigned)(Rb * K + C) * 2u; }
    const size_t kstep = (size_t)(BK * 2);
    const size_t hstep = (size_t)HALF * K * 2;
    const size_t tstep = 2 * hstep;
    const size_t hstepA = (size_t)HALF * g.lda * 2, tstepA = 2 * hstepA;
    const unsigned ldsw = (unsigned)wid * 1024u;
    const int aoff = lds_byte(wr * 64 + fr, fq * 8), boff = lds_byte(wc * 32 + fr, fq * 8);
#define PG8_SA(b, h) (((b) * 2 + (h)) * HTB)
#define PG8_SB(b, h) ((4 + (b) * 2 + (h)) * HTB)
#define PG8_STAGE(bufoff, gbase, voff) do { _Pragma("unroll") for (int _i = 0; _i < 2; ++_i) \
        __builtin_amdgcn_global_load_lds((const unsigned*)((const char*)(gbase) + (voff)[_i]), (PG8_LAS unsigned*)(lds + (bufoff) + ldsw + _i * 8192), 16, 0, 0); } while (0)
#define PG8_LDA(dst, b, h) do { _Pragma("unroll") for (int m = 0; m < 4; ++m) _Pragma("unroll") for (int k = 0; k < 2; ++k) dst[m][k] = *(const PG8_LAS bf16x8*)(lds + PG8_SA(b, h) + aoff + m * 2048 + k * 1024); } while (0)
#define PG8_LDB(dst, b, h) do { _Pragma("unroll") for (int n = 0; n < 2; ++n) _Pragma("unroll") for (int k = 0; k < 2; ++k) dst[n][k] = *(const PG8_LAS bf16x8*)(lds + PG8_SB(b, h) + boff + n * 2048 + k * 1024); } while (0)
#define PG8_MMA(ai, bj, At, Bt) do { __builtin_amdgcn_s_setprio(1); _Pragma("unroll") for (int m = 0; m < 4; ++m) _Pragma("unroll") for (int n = 0; n < 2; ++n) _Pragma("unroll") for (int k = 0; k < 2; ++k) \
        acc[ai][bj][m][n] = __builtin_amdgcn_mfma_f32_16x16x32_bf16(Bt[n][k], At[m][k], acc[ai][bj][m][n], 0, 0, 0); __builtin_amdgcn_s_setprio(0); } while (0)
#define PG8_WAIT_V(n) asm volatile("s_waitcnt vmcnt(" #n ")" ::: "memory")
#define PG8_WAIT_L(n) asm volatile("s_waitcnt lgkmcnt(" #n ")" ::: "memory")
#define PG8_BAR __builtin_amdgcn_s_barrier()
#define PG8_SCHED __builtin_amdgcn_sched_barrier(0)
    Unit cur, nxt; int ui = 0;
    if (!S.next(0, cur)) return;
    f32x4 acc[2][2][4][2];
#pragma unroll
    for (int a = 0; a < 2; ++a)
#pragma unroll
        for (int b = 0; b < 2; ++b)
#pragma unroll
            for (int m = 0; m < 4; ++m)
#pragma unroll
                for (int n = 0; n < 2; ++n) acc[a][b][m][n] = (f32x4){0.f, 0.f, 0.f, 0.f};
    bf16x8 At[4][2], B0[2][2], B1[2][2];
    const char* cA = (const char*)g.A + (size_t)cur.pm * tstepA; const char* cB = (const char*)g.Bt + (size_t)cur.pn * tstep;
    S.a_ready(cur);
    if constexpr (SP2) {
        PG8_STAGE(PG8_SB(0, 0), cB, voffB); PG8_STAGE(PG8_SB(0, 1), cB + hstep, voffB); PG8_STAGE(PG8_SA(0, 0), cA, voffA); PG8_STAGE(PG8_SA(0, 1), cA + hstepA, voffA);
        if (wr == 1) PG8_BAR;
        PG8_WAIT_V(2); PG8_BAR;
        PG8_STAGE(PG8_SB(1, 0), cB + kstep, voffB); PG8_STAGE(PG8_SA(1, 0), cA + kstep, voffA); PG8_STAGE(PG8_SB(1, 1), cB + hstep + kstep, voffB);
        PG8_WAIT_V(6); PG8_BAR;
    } else {
        PG8_STAGE(PG8_SB(0, 0), cB, voffB); PG8_STAGE(PG8_SA(0, 0), cA, voffA); PG8_STAGE(PG8_SB(0, 1), cB + hstep, voffB); PG8_STAGE(PG8_SA(0, 1), cA + hstepA, voffA);
        if (wr == 1) PG8_BAR;
        PG8_WAIT_V(4); PG8_BAR;
        PG8_STAGE(PG8_SB(1, 0), cB + kstep, voffB); PG8_STAGE(PG8_SA(1, 0), cA + kstep, voffA); PG8_STAGE(PG8_SB(1, 1), cB + hstep + kstep, voffB);
        PG8_WAIT_V(6); PG8_BAR;
    }
    for (;;) {
        const bool has_next = S.next(ui + 1, nxt);
        const char* nA = has_next ? (const char*)g.A + (size_t)nxt.pm * tstepA : cA; const char* nB = has_next ? (const char*)g.Bt + (size_t)nxt.pn * tstep : cB;
        for (int t = 0; t < nt; t += 2) {
            const bool last = (t == nt - 2);
            const char* a1 = cA + (size_t)(t + 1) * kstep;
            const char* a2 = last ? nA : cA + (size_t)(t + 2) * kstep; const char* b2 = last ? nB : cB + (size_t)(t + 2) * kstep;
            const char* a3 = a2 + kstep; const char* b3 = b2 + kstep;
            if (last && has_next) S.a_ready(nxt);
            if constexpr (SP2) {
            PG8_LDB(B0, 0, 0); PG8_LDB(B1, 0, 1); PG8_SCHED; PG8_LDA(At, 0, 0); PG8_STAGE(PG8_SA(1, 1), a1 + hstepA, voffA);
            PG8_WAIT_V(8); PG8_WAIT_L(0); PG8_BAR; PG8_MMA(0, 0, At, B0); PG8_MMA(0, 1, At, B1); PG8_BAR; PG8_SCHED;
            PG8_LDA(At, 0, 1); PG8_STAGE(PG8_SB(0, 0), b2, voffB); PG8_STAGE(PG8_SB(0, 1), b2 + hstep, voffB); PG8_STAGE(PG8_SA(0, 0), a2, voffA);
            PG8_WAIT_V(8); PG8_WAIT_L(0); PG8_BAR; PG8_MMA(1, 0, At, B0); PG8_MMA(1, 1, At, B1); PG8_BAR; PG8_SCHED;
            PG8_LDB(B0, 1, 0); PG8_LDB(B1, 1, 1); PG8_SCHED; PG8_LDA(At, 1, 0); PG8_STAGE(PG8_SA(0, 1), a2 + hstepA, voffA);
            PG8_WAIT_V(8); PG8_WAIT_L(0); PG8_BAR; PG8_MMA(0, 0, At, B0); PG8_MMA(0, 1, At, B1); PG8_BAR; PG8_SCHED;
            PG8_LDA(At, 1, 1); PG8_STAGE(PG8_SB(1, 0), b3, voffB); PG8_STAGE(PG8_SB(1, 1), b3 + hstep, voffB); PG8_STAGE(PG8_SA(1, 0), a3, voffA);
            PG8_WAIT_V(8); PG8_WAIT_L(0); PG8_BAR; PG8_MMA(1, 0, At, B0); PG8_MMA(1, 1, At, B1); PG8_BAR; PG8_SCHED;
            } else {
            PG8_LDB(B0, 0, 0); PG8_SCHED; PG8_LDA(At, 0, 0); PG8_STAGE(PG8_SA(1, 1), a1 + hstepA, voffA);
            PG8_WAIT_L(8); PG8_BAR; PG8_WAIT_L(0); PG8_MMA(0, 0, At, B0); PG8_BAR; PG8_SCHED;
            PG8_LDB(B1, 0, 1); PG8_STAGE(PG8_SB(0, 0), b2, voffB);
            PG8_BAR; PG8_WAIT_L(0); PG8_MMA(0, 1, At, B1); PG8_BAR;
            PG8_LDA(At, 0, 1); PG8_STAGE(PG8_SA(0, 0), a2, voffA);
            PG8_BAR; PG8_WAIT_L(0); PG8_MMA(1, 0, At, B0); PG8_BAR; PG8_SCHED;
            PG8_STAGE(PG8_SB(0, 1), b2 + hstep, voffB);
            PG8_WAIT_V(6); PG8_BAR; PG8_MMA(1, 1, At, B1); PG8_BAR;
            PG8_LDB(B0, 1, 0); PG8_SCHED; PG8_LDA(At, 1, 0); PG8_STAGE(PG8_SA(0, 1), a2 + hstepA, voffA);
            PG8_WAIT_L(8); PG8_BAR; PG8_WAIT_L(0); PG8_MMA(0, 0, At, B0); PG8_BAR; PG8_SCHED;
            PG8_LDB(B1, 1, 1); PG8_STAGE(PG8_SB(1, 0), b3, voffB);
            PG8_BAR; PG8_WAIT_L(0); PG8_MMA(0, 1, At, B1); PG8_BAR;
            PG8_LDA(At, 1, 1); PG8_STAGE(PG8_SA(1, 0), a3, voffA);
            PG8_BAR; PG8_WAIT_L(0); PG8_MMA(1, 0, At, B0); PG8_BAR; PG8_SCHED;
            PG8_STAGE(PG8_SB(1, 1), b3 + hstep, voffB);
            PG8_WAIT_V(6); PG8_BAR; PG8_MMA(1, 1, At, B1); PG8_BAR;
            }
        }
        if constexpr (ALIGN_EPI) { if (wr == 0) PG8_BAR; }
        if constexpr (!Epi::AFTER_DRAIN) { E(acc, cur, wr, wc, fr, fq); S.done(cur); }
        if (!has_next) break;
#pragma unroll
        for (int a = 0; a < 2; ++a)
#pragma unroll
            for (int b = 0; b < 2; ++b)
#pragma unroll
                for (int m = 0; m < 4; ++m)
#pragma unroll
                    for (int n = 0; n < 2; ++n) acc[a][b][m][n] = (f32x4){0.f, 0.f, 0.f, 0.f};
        cur = nxt; cA = nA; cB = nB; ++ui;
        if constexpr (ALIGN_EPI) { if (wr == 1) PG8_BAR; }
    }
    PG8_WAIT_V(0);
    if constexpr (!ALIGN_EPI) { if (wr == 0) PG8_BAR; }
    PG8_BAR;
    if constexpr (Epi::AFTER_DRAIN) { E.fused(acc, cur, wr, wc, fr, fq, lds, wid, lane); S.done(cur); }
#undef PG8_SA
#undef PG8_SB
#undef PG8_STAGE
#undef PG8_LDA
#undef PG8_LDB
#undef PG8_MMA
#undef PG8_WAIT_V
#undef PG8_WAIT_L
#undef PG8_BAR
#undef PG8_SCHED
}
}

#define XB_TMO      128
#define XB_XCNT(j)  (256  + 64 * (j))
#define XB_XSUB(j)  (1280 + 64 * (j))
#define XB_XGEN(j)  (2304 + 64 * (j))
#define XB_TOP      3328
#define XB_TOPGEN   3392
#define XCD_BAR_WORDS 3456
#define XB_SPIN_CAP (1u << 20)
__device__ __forceinline__ unsigned xb_ld(unsigned* p) { return __hip_atomic_load(p, __ATOMIC_RELAXED, __HIP_MEMORY_SCOPE_AGENT); }
__device__ __forceinline__ unsigned xb_add(unsigned* p, unsigned v) { return __hip_atomic_fetch_add(p, v, __ATOMIC_RELAXED, __HIP_MEMORY_SCOPE_AGENT); }
__device__ __forceinline__ unsigned xb_xcc_id() { return (unsigned)__builtin_amdgcn_s_getreg((3 << 11) | 20) & 0xFu; }
#define XB_SPIN(cond, bar) do { unsigned _sp = 0; while (cond) { __builtin_amdgcn_s_sleep(1); \
    if ((++_sp & 255u) == 0u) { if (xb_ld(&(bar)[XB_TMO])) break; if (_sp > XB_SPIN_CAP) { atomicAdd(&(bar)[XB_TMO], 1u); break; } } } } while (0)
struct XcdBarrier { unsigned* bar; unsigned x; volatile LAS unsigned* st; };
__device__ __forceinline__ XcdBarrier xcd_barrier_post(unsigned* bar, volatile LAS unsigned* st) {
    XcdBarrier b; b.bar = bar; b.x = xb_xcc_id(); b.st = st;
    if (threadIdx.x == 0) (void)xb_add(&bar[XB_XCNT(b.x)], 1u);
    return b;
}
__device__ __forceinline__ void xcd_barrier_complete(unsigned* bar, unsigned x, unsigned& nloc, unsigned& nx) {
    const unsigned G = gridDim.x * gridDim.y * gridDim.z;
    unsigned sum, cnt, mine, sp = 0u;
    for (;;) {
        sum = 0u; cnt = 0u; mine = 0u;
#pragma unroll
        for (unsigned j = 0; j < 16; ++j) { const unsigned c = xb_ld(&bar[XB_XCNT(j)]); sum += c; cnt += (c > 0u) ? 1u : 0u; mine = (j == x) ? c : mine; }
        if (sum == G) break;
        __builtin_amdgcn_s_sleep(1);
        if ((++sp & 255u) == 0u) { if (xb_ld(&bar[XB_TMO])) break; if (sp > XB_SPIN_CAP) { atomicAdd(&bar[XB_TMO], 1u); break; } }
    }
    nloc = mine > 0u ? mine : 1u; nx = cnt > 0u ? cnt : 1u;
}
__device__ __forceinline__ void xcd_barrier(const XcdBarrier& b) {
    asm volatile("s_waitcnt vmcnt(0)" ::: "memory");
    __syncthreads();
    if (threadIdx.x == 0) {
        unsigned* bar = b.bar;
        __builtin_amdgcn_s_waitcnt(0);
        unsigned nloc = b.st[0], nx = b.st[1];
        if (nloc == 0u) { xcd_barrier_complete(bar, b.x, nloc, nx); b.st[0] = nloc; b.st[1] = nx; }
        const unsigned old = xb_add(&bar[XB_XSUB(b.x)], 1u);
        const unsigned gen = old / nloc;
        if (old + 1u == (gen + 1u) * nloc) {
            __builtin_amdgcn_fence(__ATOMIC_RELEASE, "agent");
            asm volatile("s_waitcnt vmcnt(0)" ::: "memory");
            const unsigned og = xb_add(&bar[XB_TOP], 1u);
            const unsigned tg = og / nx;
            if (og + 1u == (tg + 1u) * nx) xb_add(&bar[XB_TOPGEN], 1u);
            else XB_SPIN(xb_ld(&bar[XB_TOPGEN]) == tg, bar);
            __builtin_amdgcn_fence(__ATOMIC_ACQUIRE, "agent");
            xb_add(&bar[XB_XGEN(b.x)], 1u);
            asm volatile("s_waitcnt vmcnt(0)" ::: "memory");
        } else {
            XB_SPIN(xb_ld(&bar[XB_XGEN(b.x)]) == gen, bar);
            __builtin_amdgcn_fence(__ATOMIC_ACQUIRE, "agent");
            asm volatile("s_waitcnt vmcnt(0)" ::: "memory");
        }
    }
    __syncthreads();
}

struct Args { const float* in[38]; float* out; unsigned char* ws; int ph_lo, ph_hi, li, pad; };
enum InputId { I_X = 0, I_NORM_MIX, I_W_IN, I_W_OUT, I_RW_MU, I_RW_W0, I_RW_W_UP, I_RW_A0, I_RW_A_UP, I_RW_G_UP, I_RW_K_K, I_RW_K_A, I_RW_R_K,
    I_RW_LN_W, I_RW_LN_B, I_RW_V0, I_RW_V_DOWN, I_RW_V_UP, I_GLA_A_UP, I_GLA_A_BIAS, I_GLA_NORM, I_LRU_CONV_W, I_LRU_CONV_B, I_LRU_W_R,
    I_LRU_B_R, I_LRU_W_I, I_LRU_B_I, I_LRU_LAM, I_GDN_CONV_W, I_GDN_A_LOG, I_GDN_DT_BIAS, I_GDN_NORM, I_NORM_FFN, I_PEER_WQ, I_PEER_SK,
    I_PEER_U, I_PEER_V, I_NORM_FINAL };
enum { PH_P0 = 0, PH_GEMM1 = 1, PH_PREP = 2, PH_AUX = 3, PH_SCAN = 4, PH_POST = 5, PH_GEMM2 = 6, PH_NORM2 = 7, PH_GEMM3 = 8, PH_TOPK = 9, PH_PEER = 10, PH_PER_LAYER = 10, PH_TOTAL = 21 };

struct Frame {
    LAS unsigned char* lds;
    int tid, lane, wave, vcu, G;
    int gw, ngw;
};

__device__ __forceinline__ void p0_transpose_item(const float* W, int K, int N, const float* kscale, bf16_t* WT, LAS float* scr, int item, int nblk, int lane) {
    const int kb = item / nblk, nb = item % nblk, k0 = 64 * kb, n0 = 32 * nb;
    const int kr = lane >> 3, n4 = (lane & 7) * 4;
    f32x4 v[8];
#pragma unroll
    for (int i = 0; i < 8; ++i) { const int kk = kr + 8 * i;
        v[i] = (n0 + n4 < N) ? *(const f32x4*)(W + (size_t)(k0 + kk) * N + n0 + n4) : (f32x4){0.f, 0.f, 0.f, 0.f}; }
#pragma unroll
    for (int i = 0; i < 8; ++i) { const int kk = kr + 8 * i; const float s = kscale ? kscale[k0 + kk] : 1.0f;
        scr[kk * 33 + n4 + 0] = v[i].x * s; scr[kk * 33 + n4 + 1] = v[i].y * s; scr[kk * 33 + n4 + 2] = v[i].z * s; scr[kk * 33 + n4 + 3] = v[i].w * s; }
    LDS_WAIT(); asm volatile("" ::: "memory");
    const int c = lane & 7;
#pragma unroll
    for (int j = 0; j < 4; ++j) { const int n = (lane >> 3) + 8 * j; const LAS float* s = scr + (8 * c) * 33 + n;
        v4u o; o.x = pk2(s[0 * 33], s[1 * 33]); o.y = pk2(s[2 * 33], s[3 * 33]); o.z = pk2(s[4 * 33], s[5 * 33]); o.w = pk2(s[6 * 33], s[7 * 33]);
        *(v4u*)(WT + (size_t)(n0 + n) * K + k0 + 8 * c) = o; }
    LDS_WAIT(); asm volatile("" ::: "memory");
}

__device__ __forceinline__ void p0_prologue(const Args& a, Frame& F) {
    const WsMap m = ws_map(NTOK);
    unsigned char* ws = a.ws;
    LAS float* scr = (LAS float*)(F.lds + F.wave * 16384);
    const int gw = F.gw, NGW = F.ngw, lane = F.lane;
    for (int n = gw; n < NTOK; n += NGW) {
        const f32x4* xr = (const f32x4*)(a.in[I_X] + (size_t)n * DM) + lane;
        f32x4 v[8]; float s = 0.f;
#pragma unroll
        for (int j = 0; j < 8; ++j) { v[j] = xr[64 * j]; s += (v[j].x * v[j].x + v[j].y * v[j].y) + (v[j].z * v[j].z + v[j].w * v[j].w); }
        const float rstd = 1.0f / sqrtf(wave_sum(s) * (1.0f / DM) + 1e-6f);
        f32x4* xo = (f32x4*)(a.out + (size_t)n * DM) + lane;
        v2u* o8 = (v2u*)((bf16_t*)(ws + m.xn) + (size_t)n * DM) + lane;
#pragma unroll
        for (int j = 0; j < 8; ++j) { xo[64 * j] = v[j]; v2u w; w.x = pk2(v[j].x * rstd, v[j].y * rstd); w.y = pk2(v[j].z * rstd, v[j].w * rstd); o8[64 * j] = w; }
    }
    {
        constexpr int I1 = (DM / 64) * (PLD / 32), I2 = (DM / 64) * (DM / 32);
        for (int it = gw; it < NL * (I1 + I2); it += NGW) {
            const int l = it / (I1 + I2); int r = it % (I1 + I2);
            if (r < I1) p0_transpose_item(a.in[I_W_IN] + (size_t)l * DM * INC, DM, INC, a.in[I_NORM_MIX] + l * DM, (bf16_t*)(ws + m.w1t) + (size_t)l * PLD * DM, scr, r, PLD / 32, lane);
            else p0_transpose_item(a.in[I_W_OUT] + (size_t)l * DM * DM, DM, DM, nullptr, (bf16_t*)(ws + m.w2t) + (size_t)l * DM * DM, scr, r - I1, DM / 32, lane);
        }
    }
    for (int it = gw; it < NL * 16 * 64; it += NGW) {
        const int l = it / 1024, hp = (it % 1024) / 64, kb = it % 64;
        const int dh = lane & 1, kk = kb * 32 + (lane >> 1);
        const float* wq = a.in[I_PEER_WQ] + (size_t)l * DM * DM + (size_t)kk * DM + hp * 128 + dh * 64;
        const float* sk = a.in[I_PEER_SK] + ((size_t)l * 16 + hp) * 128 * 128;
        f32x4 q[16];
#pragma unroll
        for (int d = 0; d < 16; ++d) q[d] = *(const f32x4*)(wq + 4 * d);
        bf16_t* o = (bf16_t*)(ws + m.wsct) + (size_t)l * DM * DM + (size_t)(hp * 128) * DM + kk;
        f32x4 stg[8];
#pragma unroll
        for (int i = 0; i < 8; ++i) stg[i] = ((const f32x4*)sk)[i * 64 + lane];
#pragma unroll 1
        for (int kc = 0; kc < 8; ++kc) {
#pragma unroll
            for (int i = 0; i < 8; ++i) ((LAS f32x4*)scr)[i * 64 + lane] = stg[i];
            if (kc + 1 < 8) {
#pragma unroll
                for (int i = 0; i < 8; ++i) stg[i] = ((const f32x4*)(sk + (kc + 1) * 2048))[i * 64 + lane]; }
            LDS_WAIT(); asm volatile("" ::: "memory");
#pragma unroll 2
            for (int key = 0; key < 16; ++key) {
                const LAS f32x4* s4 = (const LAS f32x4*)(scr + key * 128 + dh * 64);
                float acc = 0.f;
#pragma unroll
                for (int d = 0; d < 16; ++d) { const f32x4 sv = s4[d]; acc += (q[d].x * sv.x + q[d].y * sv.y) + (q[d].z * sv.z + q[d].w * sv.w); }
                acc += __shfl_xor(acc, 1);
                if (dh == 0) o[(size_t)(kc * 16 + key) * DM] = f2bf(acc);
            }
            LDS_WAIT(); asm volatile("" ::: "memory");
        }
    }
    {
        const int gt = F.vcu * NTHR + F.tid, GT = F.G * NTHR;
        bf16_t* AW = (bf16_t*)(ws + m.auxwt); bf16_t* LW = (bf16_t*)(ws + m.lruwt); bf16_t* VW = (bf16_t*)(ws + m.vreswt); float* PP = (float*)(ws + m.pp);
        for (int it = gt; it < NL * 1792 * 384; it += GT) {
            const int l = it / (1792 * 384), r = it % (1792 * 384), n = r / 384, k = r % 384;
            float v = 0.f;
            if (n < 512) { if (k < 64) v = a.in[I_RW_W_UP][(size_t)l * 64 * 512 + k * 512 + n]; }
            else if (n < 1024) { if (k >= 64 && k < 128) v = a.in[I_RW_A_UP][(size_t)l * 64 * 512 + (k - 64) * 512 + (n - 512)]; }
            else if (n < 1536) { if (k >= 128 && k < 256) v = a.in[I_RW_G_UP][(size_t)l * 128 * 512 + (k - 128) * 512 + (n - 1024)]; }
            else { if (k >= 256 && k < 272) v = a.in[I_GLA_A_UP][(size_t)l * 16 * 256 + (k - 256) * 256 + (n - 1536)]; }
            AW[it] = f2bf(v);
        }
        for (int it = gt; it < NL * 1024 * 512; it += GT) {
            const int l = it / (1024 * 512), r = it % (1024 * 512), n = r / 512, k = r % 512;
            const int nn = n & 511, blk = nn >> 6, j = nn & 63;
            float v = 0.f;
            if ((k >> 6) == blk) v = (n < 512 ? a.in[I_LRU_W_R] : a.in[I_LRU_W_I])[(size_t)l * 8 * 64 * 64 + (size_t)blk * 4096 + (k & 63) * 64 + j];
            LW[it] = f2bf(v);
        }
        for (int it = gt; it < 512 * 512; it += GT) {
            const int n = it / 512, k = it % 512;
            float s = 0.f;
            for (int i = 0; i < 32; ++i) s += a.in[I_RW_V_DOWN][k * 32 + i] * a.in[I_RW_V_UP][i * 512 + n];
            VW[it] = f2bf(s);
        }
        for (int it = gt; it < 6144; it += GT) {
            float v = 0.f;
            if (it < 3584) { const int l = it / 1792, c = it % 1792;
                v = c < 512 ? a.in[I_RW_W0][l * 512 + c] : (c < 1024 ? a.in[I_RW_A0][l * 512 + c - 512] : (c < 1536 ? 0.f : a.in[I_GLA_A_BIAS][l * 256 + c - 1536])); }
            else if (it < 5632) { const int l = (it - 3584) / 1024, c = (it - 3584) % 1024; v = c < 512 ? a.in[I_LRU_B_R][l * 512 + c] : a.in[I_LRU_B_I][l * 512 + c - 512]; }
            else v = a.in[I_RW_V0][it - 5632];
            PP[it] = v;
        }
    }
}

__device__ __forceinline__ unsigned pk4_fp8(float a, float b, float c, float d) {
    int w = 0;
    w = __builtin_amdgcn_cvt_pk_fp8_f32(__builtin_fmaxf(__builtin_fminf(a, 448.f), -448.f), __builtin_fmaxf(__builtin_fminf(b, 448.f), -448.f), w, false);
    w = __builtin_amdgcn_cvt_pk_fp8_f32(__builtin_fmaxf(__builtin_fminf(c, 448.f), -448.f), __builtin_fmaxf(__builtin_fminf(d, 448.f), -448.f), w, true);
    return (unsigned)w;
}
typedef float v32f __attribute__((ext_vector_type(32)));
typedef __bf16 v32bf __attribute__((ext_vector_type(32)));
typedef unsigned v6u __attribute__((ext_vector_type(6)));
constexpr size_t TROW = 1536;
__device__ __forceinline__ void tables_range(const Args& a, Frame& F, size_t it0, size_t it1, int sub, int nsub) {
    const WsMap m = ws_map(NTOK);
    const size_t per = (size_t)NEXP * DM / 32;
    const size_t stride = (size_t)nsub * NTHR;
    for (size_t base = it0 + (size_t)sub * NTHR + F.tid; base < it1; base += 2 * stride) {
        f32x4 v[2][8];
#pragma unroll
        for (int u = 0; u < 2; ++u) { const size_t it = base + u * stride;
            if (it < it1) { const int tb = (int)(it / per); const size_t r = it % per;
                const f32x4* srcp = (const f32x4*)(((tb & 1) ? a.in[I_PEER_V] : a.in[I_PEER_U]) + (size_t)(tb >> 1) * NEXP * DM + r * 32);
#pragma unroll
                for (int q = 0; q < 8; ++q) v[u][q] = __builtin_nontemporal_load(srcp + q); } }
#pragma unroll
        for (int u = 0; u < 2; ++u) { const size_t it = base + u * stride;
            if (it < it1) { const int tb = (int)(it / per); const size_t r = it % per; const float sc = (tb & 1) ? 4.0f : 64.0f;
                v32bf h;
#pragma unroll
                for (int q = 0; q < 8; ++q) {
                    h[4 * q + 0] = (__bf16)__builtin_fmaxf(__builtin_fminf(v[u][q].x * sc, 7.5f), -7.5f); h[4 * q + 1] = (__bf16)__builtin_fmaxf(__builtin_fminf(v[u][q].y * sc, 7.5f), -7.5f);
                    h[4 * q + 2] = (__bf16)__builtin_fmaxf(__builtin_fminf(v[u][q].z * sc, 7.5f), -7.5f); h[4 * q + 3] = (__bf16)__builtin_fmaxf(__builtin_fminf(v[u][q].w * sc, 7.5f), -7.5f); }
                const v6u p = __builtin_amdgcn_cvt_scalef32_pk32_fp6_bf16(h, 1.0f);
                v2u* dst = (v2u*)((unsigned char*)(a.ws + m.tabu) + (size_t)tb * NEXP * TROW + r * 24);
                dst[0] = (v2u){p[0], p[1]}; dst[1] = (v2u){p[2], p[3]}; dst[2] = (v2u){p[4], p[5]}; } }
    }
}

template <int CTRL> __device__ __forceinline__ float dpp_f(float v) { return __builtin_bit_cast(float, __builtin_amdgcn_update_dpp(0, __builtin_bit_cast(int, v), CTRL, 0xF, 0xF, true)); }
__device__ __forceinline__ float rdlane_f(float v, int l) { return __builtin_bit_cast(float, __builtin_amdgcn_readlane(__builtin_bit_cast(int, v), l)); }
__device__ __forceinline__ float row16_sum(float v) {
    v += dpp_f<0xB1>(v); v += dpp_f<0x4E>(v); v += dpp_f<0x141>(v); v += dpp_f<0x140>(v); return v;
}
__device__ __forceinline__ float wave_sum_u(float v) {
    v = row16_sum(v);
    return (rdlane_f(v, 0) + rdlane_f(v, 16)) + (rdlane_f(v, 32) + rdlane_f(v, 48));
}
typedef __bf16 bf16x2_t __attribute__((ext_vector_type(2)));
__device__ __forceinline__ float dot2bf(unsigned w, unsigned x, float acc) { return __builtin_amdgcn_fdot2_f32_bf16(__builtin_bit_cast(bf16x2_t, w), __builtin_bit_cast(bf16x2_t, x), acc, false); }
__device__ __forceinline__ float gelu_fast(float x) {
    const float u = 1.5957691216057308f * (x + 0.044715f * x * x * x);
    return x / (1.0f + __expf(-u));
}


__device__ __forceinline__ float sigm(float x) { return 1.0f / (1.0f + __expf(-x)); }
__device__ __forceinline__ float softplus_f(float x) { return __logf(1.0f + __expf(-fabsf(x))) + fmaxf(x, 0.0f); }
__device__ __forceinline__ float tanh_f(float x) { return 1.0f - 2.0f / (1.0f + __expf(2.0f * x)); }
__device__ __forceinline__ float red8(float v) { v += dpp_f<0xB1>(v); v += dpp_f<0x4E>(v); v += dpp_f<0x141>(v); return v; }
__device__ __forceinline__ v4u ld8(const bf16_t* p) { return *(const v4u*)p; }
__device__ __forceinline__ void unpack8(const v4u w, float (&f)[8]) { f[0] = bflo(w.x); f[1] = bfhi(w.x); f[2] = bflo(w.y); f[3] = bfhi(w.y); f[4] = bflo(w.z); f[5] = bfhi(w.z); f[6] = bflo(w.w); f[7] = bfhi(w.w); }
__device__ __forceinline__ v4u pack8(const float (&f)[8]) { v4u w; w.x = pk2(f[0], f[1]); w.y = pk2(f[2], f[3]); w.z = pk2(f[4], f[5]); w.w = pk2(f[6], f[7]); return w; }

__device__ __forceinline__ void prep_phase(const Args& a, Frame& F, int l) {
    const WsMap m = ws_map(NTOK);
    const bf16_t* p16 = (const bf16_t*)(a.ws + m.p16);
    bf16_t* zrkv = (bf16_t*)(a.ws + m.zrkv); bf16_t* auxA = (bf16_t*)(a.ws + m.auxA); bf16_t* xc = (bf16_t*)(a.ws + m.xc);
    const float* mu = a.in[I_RW_MU] + l * 1792;
#pragma unroll 4
    for (size_t it = (size_t)F.vcu * NTHR + F.tid; it < (size_t)NTOK * 224; it += (size_t)F.G * NTHR) {
        const int n = (int)(it / 224), j = (int)(it % 224), t = n % TSEQ;
        const int col = j * 8;
        float cur[8], prv[8], z[8];
        unpack8(ld8(p16 + (size_t)n * PLD + col), cur);
        unpack8(ld8(p16 + (size_t)(t > 0 ? n - 1 : n) * PLD + col), prv);
        const f32x4 m0 = *(const f32x4*)(mu + col), m1 = *(const f32x4*)(mu + col + 4);
        const float mm[8] = {m0.x, m0.y, m0.z, m0.w, m1.x, m1.y, m1.z, m1.w};
#pragma unroll
        for (int k = 0; k < 8; ++k) z[k] = cur[k] + ((t > 0 ? prv[k] : 0.f) - cur[k]) * mm[k];
        if (col < 1536) *(v4u*)(zrkv + (size_t)n * 1536 + col) = pack8(z);
        else {
            const int c = col - 1536;
#pragma unroll
            for (int k = 0; k < 8; ++k) z[k] = c < 64 ? tanh_f(z[k]) : (c < 128 ? z[k] : sigm(z[k]));
            *(v4u*)(auxA + (size_t)n * 384 + c) = pack8(z);
        }
    }
    for (size_t it = (size_t)F.vcu * NTHR + F.tid; it < (size_t)NTOK * 16; it += (size_t)F.G * NTHR) {
        const int n = (int)(it / 16), c = 256 + (int)(it % 16) * 8;
        v4u w = (v4u){0u, 0u, 0u, 0u};
        if (c < 272) w = ld8(p16 + (size_t)n * PLD + C_GLA + 1536 + (c - 256));
        *(v4u*)(auxA + (size_t)n * 384 + c) = w;
    }
#pragma unroll 2
    for (size_t it = (size_t)F.vcu * NTHR + F.tid; it < (size_t)NTOK * 64; it += (size_t)F.G * NTHR) {
        const int n = (int)(it / 64), c = (int)(it % 64) * 8, t = n % TSEQ;
        float acc[8];
        { const f32x4 b0 = *(const f32x4*)(a.in[I_LRU_CONV_B] + l * 512 + c), b1 = *(const f32x4*)(a.in[I_LRU_CONV_B] + l * 512 + c + 4);
          acc[0] = b0.x; acc[1] = b0.y; acc[2] = b0.z; acc[3] = b0.w; acc[4] = b1.x; acc[5] = b1.y; acc[6] = b1.z; acc[7] = b1.w; }
        v4u raw[4];
#pragma unroll
        for (int jj = 0; jj < 4; ++jj) raw[jj] = ld8(p16 + (size_t)(t - 3 + jj >= 0 ? n - 3 + jj : n) * PLD + C_LRU + c);
#pragma unroll
        for (int jj = 0; jj < 4; ++jj) {
            float xv[8]; unpack8(raw[jj], xv);
            const float ok = (t - 3 + jj >= 0) ? 1.0f : 0.0f;
            const float* cw = a.in[I_LRU_CONV_W] + (size_t)l * 4 * 512 + jj * 512 + c;
            const f32x4 w0 = *(const f32x4*)cw * ok, w1 = *(const f32x4*)(cw + 4) * ok;
            acc[0] += w0.x * xv[0]; acc[1] += w0.y * xv[1]; acc[2] += w0.z * xv[2]; acc[3] += w0.w * xv[3];
            acc[4] += w1.x * xv[4]; acc[5] += w1.y * xv[5]; acc[6] += w1.z * xv[6]; acc[7] += w1.w * xv[7];
        }
        *(v4u*)(xc + (size_t)n * 512 + c) = pack8(acc);
    }
    {
        bf16_t* gq = (bf16_t*)(a.ws + m.gq); bf16_t* gk = (bf16_t*)(a.ws + m.gk); bf16_t* gv = (bf16_t*)(a.ws + m.gv); float* gsc = (float*)(a.ws + m.gsc);
        const float* cw = a.in[I_GDN_CONV_W] + (size_t)l * 4 * 1536;
        const int lane = F.lane;
        for (int n = F.gw; n < NTOK; n += F.ngw) {
            const int t = n % TSEQ;
#pragma unroll
            for (int part = 0; part < 3; ++part) {
                const int cb = part * 512 + lane * 8;
                float acc[8];
#pragma unroll
                for (int k = 0; k < 8; ++k) acc[k] = 0.f;
#pragma unroll
                for (int jj = 0; jj < 4; ++jj) {
                    if (t - 3 + jj >= 0) {
                        float xv[8]; unpack8(ld8(p16 + (size_t)(n - 3 + jj) * PLD + C_GDN + cb), xv);
                        const f32x4 w0 = *(const f32x4*)(cw + jj * 1536 + cb), w1 = *(const f32x4*)(cw + jj * 1536 + cb + 4);
                        acc[0] += w0.x * xv[0]; acc[1] += w0.y * xv[1]; acc[2] += w0.z * xv[2]; acc[3] += w0.w * xv[3];
                        acc[4] += w1.x * xv[4]; acc[5] += w1.y * xv[5]; acc[6] += w1.z * xv[6]; acc[7] += w1.w * xv[7];
                    }
                }
                float ss = 0.f;
#pragma unroll
                for (int k = 0; k < 8; ++k) { acc[k] = acc[k] * sigm(acc[k]); ss += acc[k] * acc[k]; }
                if (part < 2) {
                    ss = row16_sum(ss);
                    const float inv = (1.0f / sqrtf(ss + 1e-6f)) * (part == 0 ? 0.08838834764831845f : 1.0f);
#pragma unroll
                    for (int k = 0; k < 8; ++k) acc[k] *= inv;
                }
                *(v4u*)((part == 0 ? gq : (part == 1 ? gk : gv)) + (size_t)n * 512 + lane * 8) = pack8(acc);
            }
            if (lane < 4) {
                gsc[(size_t)n * 8 + lane] = sigm(bf2f(p16[(size_t)n * PLD + C_GDN + 2048 + lane]));
                gsc[(size_t)n * 8 + 4 + lane] = -__expf(a.in[I_GDN_A_LOG][l * 4 + lane]) * softplus_f(bf2f(p16[(size_t)n * PLD + C_GDN + 2052 + lane]) + a.in[I_GDN_DT_BIAS][l * 4 + lane]);
            }
        }
    }
}

__device__ __forceinline__ float swz16(float v) { return __builtin_bit_cast(float, __builtin_amdgcn_ds_swizzle(__builtin_bit_cast(int, v), 0x401F)); }
__device__ __forceinline__ float red32(float v) { v = row16_sum(v); return v + swz16(v); }

__device__ __forceinline__ void rwkv_task(const Args& a, Frame& F, int l, int task) {
    const WsMap m = ws_map(NTOK);
    const int b = task >> 4, h = (task >> 1) & 7, hf = task & 1;
    LAS float* LR = (LAS float*)F.lds; LAS float* LW = LR + 2048; LAS float* LK = LW + 2048; LAS float* LA = LK + 2048; LAS float* LB = LA + 2048;
    LAS float* LV = LB + 2048; LAS float* LY = LV + 1024;
    const int lane = F.lane, w = F.wave, tid = F.tid;
    const int ch = h * 64 + lane;
    const bool mine = (lane >> 5) == hf;
    const float kk_ = a.in[I_RW_K_K][l * 512 + ch], ka_ = a.in[I_RW_K_A][l * 512 + ch], rk_ = a.in[I_RW_R_K][l * 512 + ch];
    const bf16_t* zr = (const bf16_t*)(a.ws + m.zrkv); const bf16_t* ao = (const bf16_t*)(a.ws + m.auxo); const bf16_t* vr = (const bf16_t*)(a.ws + m.vres);
    float* vf = (float*)(a.ws + m.vfirst); bf16_t* yo = (bf16_t*)(a.ws + m.rwy); bf16_t* bvo = (bf16_t*)(a.ws + m.rwbv);
    float S0 = 0.f, S1 = 0.f, S2 = 0.f, S3 = 0.f;
    const int row = tid >> 4, ks = tid & 15;
    float in_[4][7];
    auto load_chunk = [&](int c) {
#pragma unroll
        for (int q = 0; q < 4; ++q) { const size_t n = (size_t)b * TSEQ + c * 32 + w + 8 * q;
            in_[q][0] = bf2f(zr[n * 1536 + ch]); in_[q][1] = bf2f(zr[n * 1536 + 512 + ch]); in_[q][2] = bf2f(zr[n * 1536 + 1024 + ch]);
            in_[q][3] = bf2f(ao[n * 1792 + ch]); in_[q][4] = bf2f(ao[n * 1792 + 512 + ch]);
            if (l > 0) { in_[q][5] = bf2f(vr[n * 512 + ch]); in_[q][6] = vf[n * 512 + ch]; } else { in_[q][5] = 0.f; in_[q][6] = 0.f; } }
    };
    load_chunk(0);
    for (int c = 0; c < TSEQ / 32; ++c) {
#pragma unroll
        for (int q = 0; q < 4; ++q) {
            const int tl = w + 8 * q; const size_t n = (size_t)b * TSEQ + c * 32 + tl;
            const float zr_ = in_[q][0], zk_ = in_[q][1], zv_ = in_[q][2], wp = in_[q][3], ap = in_[q][4];
            float v = zv_;
            if (l == 0) { if (mine) vf[n * 512 + ch] = zv_; } else v = zv_ + (in_[q][6] - zv_) * sigm(in_[q][5]);
            const float w_raw = -softplus_f(-wp) - 0.5f, dec = __expf(-__expf(w_raw));
            const float aa = sigm(ap);
            const float kkraw = zk_ * kk_;
            const float ss = wave_sum_u(kkraw * kkraw);
            const float kk = kkraw * (1.0f / sqrtf(fmaxf(ss, 1e-24f)));
            const float km = zk_ * (1.0f + (aa - 1.0f) * ka_);
            const float bon = wave_sum_u(zr_ * km * rk_);
            LR[tl * 64 + lane] = zr_; LW[tl * 64 + lane] = dec; LK[tl * 64 + lane] = km; LA[tl * 64 + lane] = -kk; LB[tl * 64 + lane] = kk * aa;
            if (mine) { LV[tl * 32 + (lane & 31)] = v; bvo[n * 512 + ch] = f2bf(bon * v); }
        }
        __syncthreads();
        if (c + 1 < TSEQ / 32) load_chunk(c + 1);
        float keep0 = 0.f, keep1 = 0.f;
#pragma unroll 4
        for (int tl = 0; tl < 32; ++tl) {
            const int o = tl * 64 + ks * 4;
            const f32x4 a4 = *(const LAS f32x4*)(LA + o), w4 = *(const LAS f32x4*)(LW + o), b4 = *(const LAS f32x4*)(LB + o), k4 = *(const LAS f32x4*)(LK + o), r4 = *(const LAS f32x4*)(LR + o);
            const float vv = LV[tl * 32 + row];
            const float sa = row16_sum((S0 * a4.x + S1 * a4.y) + (S2 * a4.z + S3 * a4.w));
            S0 = S0 * w4.x + (sa * b4.x + vv * k4.x); S1 = S1 * w4.y + (sa * b4.y + vv * k4.y); S2 = S2 * w4.z + (sa * b4.z + vv * k4.z); S3 = S3 * w4.w + (sa * b4.w + vv * k4.w);
            const float y = row16_sum((S0 * r4.x + S1 * r4.y) + (S2 * r4.z + S3 * r4.w));
            keep0 = (ks == tl) ? y : keep0; keep1 = (ks + 16 == tl) ? y : keep1;
        }
        LY[ks * 32 + row] = keep0; LY[(16 + ks) * 32 + row] = keep1;
        __syncthreads();
        { const int tl = tid >> 4, r2 = (tid & 15) * 2; const size_t n = (size_t)b * TSEQ + c * 32 + tl;
          *(unsigned*)(yo + n * 512 + h * 64 + hf * 32 + r2) = pk2(LY[tl * 32 + r2], LY[tl * 32 + r2 + 1]); }
    }
}


__device__ __forceinline__ void chunk_cumsum8(float (&x)[8], LAS float* tmp, int lane, int w, int c8) {
#pragma unroll
    for (int d = 8; d < 64; d <<= 1) {
#pragma unroll
        for (int k = 0; k < 8; ++k) { const float t = __shfl_up(x[k], d); if (lane >= d) x[k] += t; }
    }
    if (lane >= 56) { *(LAS f32x4*)(tmp + w * 64 + c8) = (f32x4){x[0], x[1], x[2], x[3]}; *(LAS f32x4*)(tmp + w * 64 + c8 + 4) = (f32x4){x[4], x[5], x[6], x[7]}; }
    __syncthreads();
    for (int ww = 0; ww < w; ++ww) { const f32x4 a0 = *(const LAS f32x4*)(tmp + ww * 64 + c8), a1 = *(const LAS f32x4*)(tmp + ww * 64 + c8 + 4);
        x[0] += a0.x; x[1] += a0.y; x[2] += a0.z; x[3] += a0.w; x[4] += a1.x; x[5] += a1.y; x[6] += a1.z; x[7] += a1.w; }
}

constexpr int RWP = 72;
constexpr int RWT = 64 * RWP;
constexpr size_t RWB_TILES = 4 * RWT * 2;
constexpr size_t RWB_DVEC = RWB_TILES;
constexpr size_t RWB_VS = RWB_DVEC + 256;
constexpr size_t RWB_BYTES = RWB_VS + 4 * 3 * 64 * 16 * 2;

__device__ __forceinline__ f32x4 mm64(const LAS bf16_t* A, const LAS bf16_t* Bt, int mt, int nt, int lane, f32x4 acc) {
    const LAS bf16_t* ap = A + (mt * 16 + (lane & 15)) * RWP + (lane >> 4) * 8;
    const LAS bf16_t* bp = Bt + (nt * 16 + (lane & 15)) * RWP + (lane >> 4) * 8;
#pragma unroll
    for (int k0 = 0; k0 < 64; k0 += 32)
        acc = __builtin_amdgcn_mfma_f32_16x16x32_bf16(*(const LAS bf16x8*)(ap + k0), *(const LAS bf16x8*)(bp + k0), acc, 0, 0, 0);
    return acc;
}
__device__ __forceinline__ void st_rowmajor(LAS bf16_t* T, int mt, int nt, int lane, const f32x4 v) {
    const int n = nt * 16 + (lane & 15), i0 = mt * 16 + (lane >> 4) * 4;
    T[(i0 + 0) * RWP + n] = f2bf(v.x); T[(i0 + 1) * RWP + n] = f2bf(v.y); T[(i0 + 2) * RWP + n] = f2bf(v.z); T[(i0 + 3) * RWP + n] = f2bf(v.w);
}
__device__ __forceinline__ void st_transposed(LAS bf16_t* T, int mt, int nt, int lane, const f32x4 v) {
    const int n = nt * 16 + (lane & 15), i0 = mt * 16 + (lane >> 4) * 4;
    *(LAS v2u*)(T + n * RWP + i0) = (v2u){pk2(v.x, v.y), pk2(v.z, v.w)};
}

__device__ __forceinline__ void rwkv_pa_chunk(const Args& a, Frame& F, int l, int ci) {
    const WsMap m = ws_map(NTOK);
    const int bh = ci >> 6, c = ci & 63, b = bh >> 3, h = bh & 7;
    const int lane = F.lane, w = F.wave, tid = F.tid;
    const int ch = h * 64 + lane;
    LAS bf16_t* At = (LAS bf16_t*)F.lds; LAS bf16_t* AtT = At + RWT; LAS bf16_t* Bt = AtT + RWT; LAS bf16_t* Kt = Bt + RWT; LAS bf16_t* KtGT = Kt + RWT;
    LAS bf16_t* Rt = KtGT + RWT; LAS bf16_t* VmT = Rt + RWT; LAS bf16_t* LAK = VmT + RWT;
    LAS bf16_t* X0 = LAK + RWT; LAS bf16_t* XT0 = X0 + RWT; LAS bf16_t* T0 = XT0 + RWT; LAS bf16_t* X1 = T0 + RWT; LAS bf16_t* XT1 = X1 + RWT; LAS bf16_t* T1 = XT1 + RWT;
    LAS float* LWL = (LAS float*)X0;
    LAS bf16_t* A2 = X1;
    LAS bf16_t* LVT = XT1;
    const bf16_t* zr = (const bf16_t*)(a.ws + m.zrkv); const bf16_t* ao = (const bf16_t*)(a.ws + m.auxo); const bf16_t* vr = (const bf16_t*)(a.ws + m.vres);
    float* vf = (float*)(a.ws + m.vfirst); bf16_t* bvo = (bf16_t*)(a.ws + m.rwbv);
    unsigned char* blob = a.ws + m.xn + (size_t)ci * RWB_BYTES;
    bf16_t* gW = (bf16_t*)blob; bf16_t* gQG = gW + RWT; bf16_t* gKGT = gQG + RWT; bf16_t* gA1 = gKGT + RWT;
    float* gDV = (float*)(blob + RWB_DVEC); bf16_t* gVS = (bf16_t*)(blob + RWB_VS);
    const int j = tid >> 3, c8 = (tid & 7) * 8, chb = h * 64 + c8;
    const size_t n = (size_t)b * TSEQ + c * 64 + j;
    float zr_[8], zk_[8], zv_[8], wp[8], ap[8];
    unpack8(ld8(zr + n * 1536 + chb), zr_); unpack8(ld8(zr + n * 1536 + 512 + chb), zk_); unpack8(ld8(zr + n * 1536 + 1024 + chb), zv_);
    unpack8(ld8(ao + n * 1792 + chb), wp); unpack8(ld8(ao + n * 1792 + 512 + chb), ap);
    float vres8[8], vf8[8];
    if (l > 0) { unpack8(ld8(vr + n * 512 + chb), vres8); const f32x4 f0 = *(const f32x4*)(vf + n * 512 + chb), f1 = *(const f32x4*)(vf + n * 512 + chb + 4);
        vf8[0] = f0.x; vf8[1] = f0.y; vf8[2] = f0.z; vf8[3] = f0.w; vf8[4] = f1.x; vf8[5] = f1.y; vf8[6] = f1.z; vf8[7] = f1.w; }
    float lw[8];
#pragma unroll
    for (int k = 0; k < 8; ++k) lw[k] = -__expf(-softplus_f(-wp[k]) - 0.5f);
    float cs[8];
#pragma unroll
    for (int k = 0; k < 8; ++k) cs[k] = lw[k];
    chunk_cumsum8(cs, LWL, lane, w, c8);
    {
        float pk_[8], pa_[8], pr_[8];
        { const float* p0 = a.in[I_RW_K_K] + l * 512 + chb; const float* p1 = a.in[I_RW_K_A] + l * 512 + chb; const float* p2 = a.in[I_RW_R_K] + l * 512 + chb;
          const f32x4 a0 = *(const f32x4*)p0, a1 = *(const f32x4*)(p0 + 4), b0 = *(const f32x4*)p1, b1 = *(const f32x4*)(p1 + 4), c0 = *(const f32x4*)p2, c1 = *(const f32x4*)(p2 + 4);
          pk_[0] = a0.x; pk_[1] = a0.y; pk_[2] = a0.z; pk_[3] = a0.w; pk_[4] = a1.x; pk_[5] = a1.y; pk_[6] = a1.z; pk_[7] = a1.w;
          pa_[0] = b0.x; pa_[1] = b0.y; pa_[2] = b0.z; pa_[3] = b0.w; pa_[4] = b1.x; pa_[5] = b1.y; pa_[6] = b1.z; pa_[7] = b1.w;
          pr_[0] = c0.x; pr_[1] = c0.y; pr_[2] = c0.z; pr_[3] = c0.w; pr_[4] = c1.x; pr_[5] = c1.y; pr_[6] = c1.z; pr_[7] = c1.w; }
        float v[8], aa[8], kk[8], km[8];
        float ss = 0.f, bs = 0.f;
#pragma unroll
        for (int k = 0; k < 8; ++k) {
            v[k] = (l == 0) ? zv_[k] : zv_[k] + (vf8[k] - zv_[k]) * sigm(vres8[k]);
            aa[k] = sigm(ap[k]);
            kk[k] = zk_[k] * pk_[k]; ss += kk[k] * kk[k];
            km[k] = zk_[k] * (1.0f + (aa[k] - 1.0f) * pa_[k]); bs += zr_[k] * km[k] * pr_[k];
        }
        if (l == 0) { *(f32x4*)(vf + n * 512 + chb) = (f32x4){zv_[0], zv_[1], zv_[2], zv_[3]}; *(f32x4*)(vf + n * 512 + chb + 4) = (f32x4){zv_[4], zv_[5], zv_[6], zv_[7]}; }
        ss = red8(ss); bs = red8(bs);
        const float kinv = 1.0f / sqrtf(fmaxf(ss, 1e-24f));
        float cm[8], gcv[8];
        {
#pragma unroll
          for (int k = 0; k < 8; ++k) gcv[k] = 0.f;
#pragma unroll
          for (int ww = 0; ww < 8; ++ww) { const f32x4 g0 = *(const LAS f32x4*)(LWL + ww * 64 + c8), g1 = *(const LAS f32x4*)(LWL + ww * 64 + c8 + 4);
              gcv[0] += g0.x; gcv[1] += g0.y; gcv[2] += g0.z; gcv[3] += g0.w; gcv[4] += g1.x; gcv[5] += g1.y; gcv[6] += g1.z; gcv[7] += g1.w; } }
#pragma unroll
        for (int k = 0; k < 8; ++k) cm[k] = cs[k] - lw[k];
        float t_at[8], t_bt[8], t_kt[8], t_rt[8], t_bv[8];
        LAS bf16_t* KGTl = T1;
#pragma unroll
        for (int k = 0; k < 8; ++k) {
            const float G = __expf(cs[k]), Gm1 = __expf(cm[k]), iG = __expf(-cs[k]), GcG = __expf(gcv[k] - cs[k]);
            const float kkn = kk[k] * kinv;
            const float av = -kkn, bv = kkn * aa[k];
            t_at[k] = av * Gm1; t_bt[k] = bv * iG; t_kt[k] = km[k] * iG; t_rt[k] = zr_[k] * G; t_bv[k] = bs * v[k];
            AtT[(c8 + k) * RWP + j] = f2bf(t_at[k]);
            KtGT[(c8 + k) * RWP + j] = f2bf(km[k] * GcG);
            VmT[(c8 + k) * RWP + j] = f2bf(v[k]);
            KGTl[(c8 + k) * RWP + j] = f2bf(bv * GcG);
        }
        *(LAS v4u*)(At + j * RWP + c8) = pack8(t_at); *(LAS v4u*)(Bt + j * RWP + c8) = pack8(t_bt); *(LAS v4u*)(Kt + j * RWP + c8) = pack8(t_kt);
        const v4u rt8 = pack8(t_rt);
        *(LAS v4u*)(Rt + j * RWP + c8) = rt8; *(v4u*)(gQG + j * RWP + c8) = rt8;
        *(v4u*)(bvo + n * 512 + chb) = pack8(t_bv);
        if (j == 63) { *(f32x4*)(gDV + c8) = (f32x4){__expf(gcv[0]), __expf(gcv[1]), __expf(gcv[2]), __expf(gcv[3])}; *(f32x4*)(gDV + c8 + 4) = (f32x4){__expf(gcv[4]), __expf(gcv[5]), __expf(gcv[6]), __expf(gcv[7])}; }
    }
    __syncthreads();
    {
        for (int o = tid; o < RWT / 8; o += NTHR) ((v4u*)gKGT)[o] = ((const LAS v4u*)T1)[o];
        f32x4 z4 = {0.f, 0.f, 0.f, 0.f};
#pragma unroll 1
        for (int tt = 0; tt < 2; ++tt) {
            const int t = w + 8 * tt, mt = t >> 2, nt = t & 3;
            const int n = nt * 16 + (lane & 15), i0 = mt * 16 + (lane >> 4) * 4;
            f32x4 lab = mm64(At, Bt, mt, nt, lane, z4), lak = mm64(At, Kt, mt, nt, lane, z4), a1 = mm64(Rt, Bt, mt, nt, lane, z4), a2 = mm64(Rt, Kt, mt, nt, lane, z4);
            f32x4 tt0;
#pragma unroll
            for (int e = 0; e < 4; ++e) { const int i = i0 + e;
                if (n >= i) { lab[e] = 0.f; lak[e] = 0.f; }
                if (n > i) { a1[e] = 0.f; a2[e] = 0.f; }
                tt0[e] = lab[e] + (n == i ? 1.0f : 0.f); }
            st_rowmajor(X0, mt, nt, lane, lab); st_transposed(XT0, mt, nt, lane, lab);
            st_rowmajor(T0, mt, nt, lane, tt0);
            st_rowmajor(LAK, mt, nt, lane, lak);
            st_rowmajor(A2, mt, nt, lane, a2);
            gA1[(i0 + 0) * RWP + n] = f2bf(a1.x); gA1[(i0 + 1) * RWP + n] = f2bf(a1.y); gA1[(i0 + 2) * RWP + n] = f2bf(a1.z); gA1[(i0 + 3) * RWP + n] = f2bf(a1.w);
        }
    }
    __syncthreads();
    {
        f32x4 z4 = {0.f, 0.f, 0.f, 0.f};
#pragma unroll 1
        for (int tt = 0; tt < 2; ++tt) {
            const int t = w + 8 * tt, mt = t >> 2, nt = t & 3;
            const int n = nt * 16 + (lane & 15), i0 = mt * 16 + (lane >> 4) * 4;
            const f32x4 lv = mm64(LAK, VmT, mt, nt, lane, z4), o0 = mm64(A2, VmT, mt, nt, lane, z4), kv0 = mm64(KtGT, VmT, mt, nt, lane, z4);
            st_transposed((LAS bf16_t*)(F.lds + 131584), mt, nt, lane, lv);
            bf16_t* go = gVS + (size_t)nt * 3 * 1024 + 1024;
            const int r = lane & 15;
            go[(i0 + 0) * 16 + r] = f2bf(o0.x); go[(i0 + 1) * 16 + r] = f2bf(o0.y); go[(i0 + 2) * 16 + r] = f2bf(o0.z); go[(i0 + 3) * 16 + r] = f2bf(o0.w);
            go[1024 + (i0 + 0) * 16 + r] = f2bf(kv0.x); go[1024 + (i0 + 1) * 16 + r] = f2bf(kv0.y); go[1024 + (i0 + 2) * 16 + r] = f2bf(kv0.z); go[1024 + (i0 + 3) * 16 + r] = f2bf(kv0.w);
            (void)n;
        }
    }
    __syncthreads();
    {
        LAS bf16_t* Xc = X0; LAS bf16_t* XTc = XT0; LAS bf16_t* Tc = T0; LAS bf16_t* Xn = X1; LAS bf16_t* XTn = XT1; LAS bf16_t* Tn = T1;
        f32x4 z4 = {0.f, 0.f, 0.f, 0.f};
#pragma unroll 1
        for (int it = 0; it < 5; ++it) {
#pragma unroll 1
            for (int tt = 0; tt < 2; ++tt) { const int t = w + 8 * tt, mt = t >> 2, nt = t & 3;
                const f32x4 x2 = mm64(Xc, XTc, mt, nt, lane, z4);
                st_rowmajor(Xn, mt, nt, lane, x2); st_transposed(XTn, mt, nt, lane, x2); }
            __syncthreads();
#pragma unroll 1
            for (int tt = 0; tt < 2; ++tt) { const int t = w + 8 * tt, mt = t >> 2, nt = t & 3;
                const int n = nt * 16 + (lane & 15), i0 = mt * 16 + (lane >> 4) * 4;
                f32x4 tc; tc.x = bf2f(Tc[(i0 + 0) * RWP + n]); tc.y = bf2f(Tc[(i0 + 1) * RWP + n]); tc.z = bf2f(Tc[(i0 + 2) * RWP + n]); tc.w = bf2f(Tc[(i0 + 3) * RWP + n]);
                const f32x4 tn = mm64(Tc, XTn, mt, nt, lane, tc);
                st_rowmajor(Tn, mt, nt, lane, tn); }
            __syncthreads();
            LAS bf16_t* s0 = Xc; Xc = Xn; Xn = s0; s0 = XTc; XTc = XTn; XTn = s0; s0 = Tc; Tc = Tn; Tn = s0;
        }
        LAS bf16_t* LVTp = (LAS bf16_t*)(F.lds + 131584);
#pragma unroll 1
        for (int tt = 0; tt < 2; ++tt) { const int t = w + 8 * tt, mt = t >> 2, nt = t & 3;
            const int n = nt * 16 + (lane & 15), i0 = mt * 16 + (lane >> 4) * 4, r = lane & 15;
            const f32x4 wt = mm64(Tc, AtT, mt, nt, lane, z4), u0 = mm64(Tc, LVTp, mt, nt, lane, z4);
            gW[(i0 + 0) * RWP + n] = f2bf(wt.x); gW[(i0 + 1) * RWP + n] = f2bf(wt.y); gW[(i0 + 2) * RWP + n] = f2bf(wt.z); gW[(i0 + 3) * RWP + n] = f2bf(wt.w);
            bf16_t* gu = gVS + (size_t)nt * 3 * 1024;
            gu[(i0 + 0) * 16 + r] = f2bf(u0.x); gu[(i0 + 1) * 16 + r] = f2bf(u0.y); gu[(i0 + 2) * 16 + r] = f2bf(u0.z); gu[(i0 + 3) * 16 + r] = f2bf(u0.w); }
    }
    __syncthreads();
    (void)LVT;
}

__device__ __forceinline__ void rwkv_ps_task(const Args& a, Frame& F, int task) {
    const WsMap m = ws_map(NTOK);
    const int bh = task >> 2, vs = task & 3, b = bh >> 3, h = bh & 7;
    const int lane = F.lane, w = F.wave, tid = F.tid;
    LAS bf16_t* LB = (LAS bf16_t*)F.lds;
    LAS bf16_t* ST = LB + 4 * RWT; LAS bf16_t* VNT = ST + 16 * RWP;
    bf16_t* yo = (bf16_t*)(a.ws + m.rwy);
    const unsigned char* blob0 = a.ws + m.xn + (size_t)(bh * 64) * RWB_BYTES;
    const int r = lane & 15, i0w = (w & 3) * 16 + (lane >> 4) * 4;
    f32x4 Sacc = {0.f, 0.f, 0.f, 0.f};
    for (int i = tid; i < 16 * RWP / 2; i += NTHR) ((LAS unsigned*)ST)[i] = 0u;
    v4u pre[5];
    auto prefetch = [&](int c) {
        const v4u* g = (const v4u*)(blob0 + (size_t)c * RWB_BYTES);
#pragma unroll
        for (int k = 0; k < 5; ++k) { const int o = k * 512 + tid; pre[k] = (o < (int)(RWB_TILES / 16)) ? g[o] : (v4u){0u, 0u, 0u, 0u}; }
    };
    auto commit = [&]() {
#pragma unroll
        for (int k = 0; k < 5; ++k) { const int o = k * 512 + tid; if (o < (int)(RWB_TILES / 16)) ((LAS v4u*)LB)[o] = pre[k]; }
    };
    bf16_t nfr[4], nkv[4]; float ndv[4];
    auto prefrag = [&](int c) {
        const unsigned char* blob = blob0 + (size_t)c * RWB_BYTES;
        const bf16_t* gvs = (const bf16_t*)(blob + RWB_VS) + (size_t)vs * 3 * 1024;
        const bf16_t* src = gvs + (w < 4 ? 0 : 1024);
#pragma unroll
        for (int e = 0; e < 4; ++e) nfr[e] = src[(i0w + e) * 16 + r];
        if (w < 4) { const float* gd = (const float*)(blob + RWB_DVEC);
#pragma unroll
            for (int e = 0; e < 4; ++e) { ndv[e] = gd[i0w + e]; nkv[e] = gvs[2048 + (i0w + e) * 16 + r]; } }
        else {
#pragma unroll
            for (int e = 0; e < 4; ++e) { ndv[e] = 1.f; nkv[e] = 0; } }
    };
    prefetch(0); commit(); prefetch(1); prefrag(0);
    for (int c = 0; c < 64; ++c) {
        float fr[4], dv[4], kv0[4];
#pragma unroll
        for (int e = 0; e < 4; ++e) { fr[e] = bf2f(nfr[e]); dv[e] = ndv[e]; kv0[e] = bf2f(nkv[e]); }
        if (c + 1 < 64) prefrag(c + 1);
        __syncthreads();
        if (w < 4) {
            f32x4 vn = mm64(LB, ST, w, 0, lane, (f32x4){fr[0], fr[1], fr[2], fr[3]});
            st_transposed(VNT, w, 0, lane, vn);
        }
        __syncthreads();
        if (w < 4) {
            const f32x4 base = {dv[0] * Sacc.x + kv0[0], dv[1] * Sacc.y + kv0[1], dv[2] * Sacc.z + kv0[2], dv[3] * Sacc.w + kv0[3]};
            Sacc = mm64(LB + 2 * RWT, VNT, w, 0, lane, base);
        } else {
            f32x4 o = mm64(LB + RWT, ST, w - 4, 0, lane, (f32x4){fr[0], fr[1], fr[2], fr[3]});
            o = mm64(LB + 3 * RWT, VNT, w - 4, 0, lane, o);
            const size_t n = (size_t)b * TSEQ + c * 64 + i0w;
            bf16_t* yp = yo + n * 512 + h * 64 + vs * 16 + r;
            yp[0] = f2bf(o.x); yp[512] = f2bf(o.y); yp[1024] = f2bf(o.z); yp[1536] = f2bf(o.w);
        }
        __syncthreads();
        if (w < 4) st_transposed(ST, w, 0, lane, Sacc);
        if (c + 1 < 64) commit();
        if (c + 2 < 64) prefetch(c + 2);
    }
    __syncthreads();
}

constexpr int GP = 136;
constexpr size_t GB_BYTES = 26880;
template <int KD, int PA_, int PB_>
__device__ __forceinline__ f32x4 mmx(const LAS bf16_t* A, const LAS bf16_t* Bt, int mt, int nt, int lane, f32x4 acc) {
    const LAS bf16_t* ap = A + (mt * 16 + (lane & 15)) * PA_ + (lane >> 4) * 8;
    const LAS bf16_t* bp = Bt + (nt * 16 + (lane & 15)) * PB_ + (lane >> 4) * 8;
#pragma unroll
    for (int k0 = 0; k0 < KD; k0 += 32)
        acc = __builtin_amdgcn_mfma_f32_16x16x32_bf16(*(const LAS bf16x8*)(ap + k0), *(const LAS bf16x8*)(bp + k0), acc, 0, 0, 0);
    return acc;
}
__device__ __forceinline__ void gdn_pa_chunk(const Args& a, Frame& F, int ci) {
    const WsMap m = ws_map(NTOK);
    const int bh = ci >> 6, c = ci & 63, b = bh >> 2, h = bh & 3;
    const int lane = F.lane, w = F.wave, tid = F.tid;
    LAS bf16_t* KB = (LAS bf16_t*)F.lds; LAS bf16_t* KH = KB + 64 * GP; LAS bf16_t* QH = KH + 64 * GP;
    LAS bf16_t* KBEt = KB; LAS bf16_t* VbT = KB + 128 * RWP;
    LAS bf16_t* X0 = QH + 64 * GP; LAS bf16_t* XT0 = X0 + RWT; LAS bf16_t* T0 = XT0 + RWT; LAS bf16_t* X1 = T0 + RWT; LAS bf16_t* XT1 = X1 + RWT; LAS bf16_t* T1 = XT1 + RWT;
    LAS float* GC = (LAS float*)(T1 + RWT);
    LAS bf16_t* KGTl = (LAS bf16_t*)(GC + 64);
    bf16_t* gq = (bf16_t*)(a.ws + m.gq); bf16_t* gk = (bf16_t*)(a.ws + m.gk); bf16_t* gv = (bf16_t*)(a.ws + m.gv); const float* gsc = (const float*)(a.ws + m.gsc);
    unsigned char* blob = a.ws + m.gblob + (size_t)ci * GB_BYTES;
    bf16_t* gA1 = (bf16_t*)blob; bf16_t* gW = gA1 + RWT; float* gGC = (float*)(blob + RWT * 2 + 64 * GP * 2);
    const int j = tid >> 3, c16 = (tid & 7) * 16;
    const size_t n0 = (size_t)b * TSEQ + c * 64, n = n0 + j;
    const float be = gsc[n * 8 + h];
    v4u kw[2], qw[2], vw[2];
    {
        float kf[8];
#pragma unroll
        for (int hh = 0; hh < 2; ++hh) {
            kw[hh] = ld8(gk + n * 512 + h * 128 + c16 + hh * 8); qw[hh] = ld8(gq + n * 512 + h * 128 + c16 + hh * 8); vw[hh] = ld8(gv + n * 512 + h * 128 + c16 + hh * 8);
            *(LAS v4u*)(KH + j * GP + c16 + hh * 8) = kw[hh]; *(LAS v4u*)(QH + j * GP + c16 + hh * 8) = qw[hh];
            unpack8(kw[hh], kf);
#pragma unroll
            for (int k = 0; k < 8; ++k) kf[k] *= be;
            *(LAS v4u*)(KB + j * GP + c16 + hh * 8) = pack8(kf);
        }
        if (w == 0) {
            float g = gsc[(n0 + lane) * 8 + 4 + h];
#pragma unroll
            for (int o = 1; o < 64; o <<= 1) { const float t = __shfl_up(g, o); if (lane >= o) g += t; }
            GC[lane] = g; gGC[lane] = g;
        }
    }
    __syncthreads();
    {
        const f32x4 z4 = {0.f, 0.f, 0.f, 0.f};
#pragma unroll 1
        for (int tt = 0; tt < 2; ++tt) {
            const int t = w + 8 * tt, mt = t >> 2, nt = t & 3;
            const int nn = nt * 16 + (lane & 15), i0 = mt * 16 + (lane >> 4) * 4;
            f32x4 kk = mmx<128, GP, GP>(KB, KH, mt, nt, lane, z4), qk = mmx<128, GP, GP>(QH, KH, mt, nt, lane, z4);
            const float gj = GC[nn];
            f32x4 x, t0;
#pragma unroll
            for (int e = 0; e < 4; ++e) { const int i = i0 + e; const float d = __expf(fminf(GC[i] - gj, 0.f));
                x[e] = (nn < i) ? -kk[e] * d : 0.f; qk[e] = (nn <= i) ? qk[e] * d : 0.f; t0[e] = x[e] + (nn == i ? 1.0f : 0.f); }
            st_rowmajor(X0, mt, nt, lane, x); st_transposed(XT0, mt, nt, lane, x); st_rowmajor(T0, mt, nt, lane, t0);
            gA1[(i0 + 0) * RWP + nn] = f2bf(qk.x); gA1[(i0 + 1) * RWP + nn] = f2bf(qk.y); gA1[(i0 + 2) * RWP + nn] = f2bf(qk.z); gA1[(i0 + 3) * RWP + nn] = f2bf(qk.w);
        }
    }
    __syncthreads();
    {
        const float gj = GC[j], eg = __expf(gj), s_kbe = be * eg, s_kg = __expf(GC[63] - gj);
        float f[8], o8[8];
#pragma unroll
        for (int hh = 0; hh < 2; ++hh) {
            unpack8(kw[hh], f);
#pragma unroll
            for (int k = 0; k < 8; ++k) { KBEt[(c16 + hh * 8 + k) * RWP + j] = f2bf(f[k] * s_kbe); KGTl[(c16 + hh * 8 + k) * RWP + j] = f2bf(f[k] * s_kg); }
            unpack8(vw[hh], f);
#pragma unroll
            for (int k = 0; k < 8; ++k) VbT[(c16 + hh * 8 + k) * RWP + j] = f2bf(f[k] * be);
            unpack8(qw[hh], f);
#pragma unroll
            for (int k = 0; k < 8; ++k) o8[k] = f[k] * eg;
            *(v4u*)(gq + n * 512 + h * 128 + c16 + hh * 8) = pack8(o8);
        }
    }
    const f32x4 z4 = {0.f, 0.f, 0.f, 0.f};
    LAS bf16_t* Xc = X0; LAS bf16_t* XTc = XT0; LAS bf16_t* Tc = T0; LAS bf16_t* Xn = X1; LAS bf16_t* XTn = XT1; LAS bf16_t* Tn = T1;
#pragma unroll 1
    for (int it = 0; it < 5; ++it) {
#pragma unroll 1
        for (int tt = 0; tt < 2; ++tt) { const int t = w + 8 * tt, mt = t >> 2, nt = t & 3;
            const f32x4 x2 = mm64(Xc, XTc, mt, nt, lane, z4);
            st_rowmajor(Xn, mt, nt, lane, x2); st_transposed(XTn, mt, nt, lane, x2); }
        __syncthreads();
#pragma unroll 1
        for (int tt = 0; tt < 2; ++tt) { const int t = w + 8 * tt, mt = t >> 2, nt = t & 3;
            const int nn = nt * 16 + (lane & 15), i0 = mt * 16 + (lane >> 4) * 4;
            f32x4 tc; tc.x = bf2f(Tc[(i0 + 0) * RWP + nn]); tc.y = bf2f(Tc[(i0 + 1) * RWP + nn]); tc.z = bf2f(Tc[(i0 + 2) * RWP + nn]); tc.w = bf2f(Tc[(i0 + 3) * RWP + nn]);
            const f32x4 tn = mm64(Tc, XTn, mt, nt, lane, tc);
            st_rowmajor(Tn, mt, nt, lane, tn); }
        __syncthreads();
        LAS bf16_t* s0 = Xc; Xc = Xn; Xn = s0; s0 = XTc; XTc = XTn; XTn = s0; s0 = Tc; Tc = Tn; Tn = s0;
    }
    {
#pragma unroll 1
        for (int tt = 0; tt < 4; ++tt) { const int mt = w, nt = tt;
            const f32x4 dw = mm64(KBEt, Tc, mt, nt, lane, z4), du = mm64(VbT, Tc, mt, nt, lane, z4);
            const int i = nt * 16 + (lane & 15), c0 = mt * 16 + (lane >> 4) * 4;
            *(v2u*)(gW + i * GP + c0) = (v2u){pk2(dw.x, dw.y), pk2(dw.z, dw.w)};
            *(v2u*)(gv + (n0 + i) * 512 + h * 128 + c0) = (v2u){pk2(du.x, du.y), pk2(du.z, du.w)}; }
        for (int p = tid; p < 1024; p += NTHR) { const int k = p >> 3, j8 = (p & 7) * 8;
            *(v4u*)(gk + (n0 + (k >> 1)) * 512 + h * 128 + (k & 1) * 64 + j8) = *(const LAS v4u*)(KGTl + k * RWP + j8); }
    }
    __syncthreads();
}

__device__ __forceinline__ void gdn_ps_task(const Args& a, Frame& F, int task) {
    const WsMap m = ws_map(NTOK);
    const int bh = task >> 3, vs = task & 7, b = bh >> 2, h = bh & 3;
    const int lane = F.lane, w = F.wave, tid = F.tid;
    LAS bf16_t* A1 = (LAS bf16_t*)F.lds; LAS bf16_t* WT = A1 + RWT; LAS float* GC = (LAS float*)(WT + 64 * GP);
    LAS bf16_t* QG = (LAS bf16_t*)(GC + 64); LAS bf16_t* KGT = QG + 64 * GP; LAS bf16_t* ST = KGT + 128 * RWP;
    LAS bf16_t* VNT = ST + 16 * GP; LAS bf16_t* UU = VNT + 16 * RWP;
    const bf16_t* gq = (const bf16_t*)(a.ws + m.gq); const bf16_t* gk = (const bf16_t*)(a.ws + m.gk); const bf16_t* gv = (const bf16_t*)(a.ws + m.gv);
    bf16_t* go = (bf16_t*)(a.ws + m.gdno);
    const unsigned char* blob0 = a.ws + m.gblob + (size_t)(bh * 64) * GB_BYTES;
    const int r = lane & 15, kq4 = (lane >> 4) * 4;
    f32x4 Sacc = {0.f, 0.f, 0.f, 0.f};
    for (int i = tid; i < 16 * GP / 2; i += NTHR) ((LAS unsigned*)ST)[i] = 0u;
    v4u pb_[4], pq_[2], pk_[2], pu_;
    auto prefetch = [&](int c) {
        const size_t n0 = (size_t)b * TSEQ + c * 64;
        const v4u* g = (const v4u*)(blob0 + (size_t)c * GB_BYTES);
#pragma unroll
        for (int k = 0; k < 4; ++k) { const int o = k * 512 + tid; pb_[k] = (o < (int)(GB_BYTES / 16)) ? g[o] : (v4u){0u, 0u, 0u, 0u}; }
#pragma unroll
        for (int k = 0; k < 2; ++k) { const int p = k * 512 + tid;
            pq_[k] = ld8(gq + (n0 + (p >> 4)) * 512 + h * 128 + (p & 15) * 8);
            pk_[k] = ld8(gk + (n0 + (p >> 4)) * 512 + h * 128 + (p & 15) * 8); }
        if (tid < 128) pu_ = ld8(gv + (n0 + (tid >> 1)) * 512 + h * 128 + vs * 16 + (tid & 1) * 8);
    };
    prefetch(0);
    for (int c = 0; c < 64; ++c) {
#pragma unroll
        for (int k = 0; k < 4; ++k) { const int o = k * 512 + tid; if (o < (int)(GB_BYTES / 16)) ((LAS v4u*)A1)[o] = pb_[k]; }
#pragma unroll
        for (int k = 0; k < 2; ++k) { const int p = k * 512 + tid;
            *(LAS v4u*)(QG + (p >> 4) * GP + (p & 15) * 8) = pq_[k];
            const int kk = 2 * (p >> 4) + ((p & 15) >> 3), j8 = (p & 7) * 8;
            *(LAS v4u*)(KGT + kk * RWP + j8) = pk_[k]; }
        if (tid < 128) *(LAS v4u*)(UU + (tid >> 1) * 16 + (tid & 1) * 8) = pu_;
        __syncthreads();
        if (c + 1 < 64) prefetch(c + 1);
        const float glast = __expf(GC[63]);
        if (w < 4) {
            const int i0 = w * 16 + kq4;
            f32x4 vn = mmx<128, GP, GP>(WT, ST, w, 0, lane, (f32x4){0.f, 0.f, 0.f, 0.f});
            vn.x = bf2f(UU[(i0 + 0) * 16 + r]) - vn.x; vn.y = bf2f(UU[(i0 + 1) * 16 + r]) - vn.y; vn.z = bf2f(UU[(i0 + 2) * 16 + r]) - vn.z; vn.w = bf2f(UU[(i0 + 3) * 16 + r]) - vn.w;
            st_transposed(VNT, w, 0, lane, vn);
        }
        __syncthreads();
        {
            const f32x4 base = {Sacc.x * glast, Sacc.y * glast, Sacc.z * glast, Sacc.w * glast};
            Sacc = mm64(KGT, VNT, w, 0, lane, base);
            if (w < 4) {
                f32x4 o = mmx<128, GP, GP>(QG, ST, w, 0, lane, (f32x4){0.f, 0.f, 0.f, 0.f});
                o = mm64(A1, VNT, w, 0, lane, o);
                const size_t n = (size_t)b * TSEQ + c * 64 + w * 16 + kq4;
                bf16_t* op = go + n * 512 + h * 128 + vs * 16 + r;
                op[0] = f2bf(o.x); op[512] = f2bf(o.y); op[1024] = f2bf(o.z); op[1536] = f2bf(o.w);
            }
        }
        __syncthreads();
        { const int k0 = w * 16 + kq4;
          *(LAS v2u*)(ST + r * GP + k0) = (v2u){pk2(Sacc.x, Sacc.y), pk2(Sacc.z, Sacc.w)}; }
    }
    __syncthreads();
}

__device__ __forceinline__ void gla_pa_chunk(const Args& a, Frame& F, int ci) {
    const WsMap m = ws_map(NTOK);
    const int bh = ci >> 6, c = ci & 63, b = bh >> 2, h = bh & 3;
    const int lane = F.lane, w = F.wave, tid = F.tid;
    LAS bf16_t* KS2T = (LAS bf16_t*)F.lds; LAS bf16_t* VT = KS2T + RWT; LAS float* TMP = (LAS float*)(VT + 128 * RWP);
    const bf16_t* p16 = (const bf16_t*)(a.ws + m.p16); const bf16_t* ao = (const bf16_t*)(a.ws + m.auxo);
    bf16_t* gKV = (bf16_t*)(a.ws + m.glao) + (size_t)ci * 8192; float* gDV = (float*)(a.ws + m.gladv) + (size_t)ci * 64;
    const int j = tid >> 3, c8 = (tid & 7) * 8, v16 = (tid & 7) * 16;
    const size_t n = (size_t)b * TSEQ + c * 64 + j;
    float k8[8], la[8];
    unpack8(ld8(p16 + n * PLD + C_GLA + 256 + h * 64 + c8), k8); unpack8(ld8(ao + n * 1792 + 1536 + h * 64 + c8), la);
    const v4u v0 = ld8(p16 + n * PLD + C_GLA + 512 + h * 128 + v16), v1 = ld8(p16 + n * PLD + C_GLA + 512 + h * 128 + v16 + 8);
#pragma unroll
    for (int k = 0; k < 8; ++k) la[k] = -softplus_f(-la[k]) * (1.0f / 16.0f);
    chunk_cumsum8(la, TMP, lane, w, c8);
    float bl[8];
#pragma unroll
    for (int k = 0; k < 8; ++k) bl[k] = 0.f;
#pragma unroll
    for (int ww = 0; ww < 8; ++ww) { const f32x4 y0 = *(const LAS f32x4*)(TMP + ww * 64 + c8), y1 = *(const LAS f32x4*)(TMP + ww * 64 + c8 + 4);
        bl[0] += y0.x; bl[1] += y0.y; bl[2] += y0.z; bl[3] += y0.w; bl[4] += y1.x; bl[5] += y1.y; bl[6] += y1.z; bl[7] += y1.w; }
#pragma unroll
    for (int k = 0; k < 8; ++k) KS2T[(c8 + k) * RWP + j] = f2bf(k8[k] * __expf(bl[k] - la[k]));
    { const unsigned vw[8] = {v0.x, v0.y, v0.z, v0.w, v1.x, v1.y, v1.z, v1.w};
#pragma unroll
      for (int e = 0; e < 8; ++e) { VT[(v16 + 2 * e) * RWP + j] = (bf16_t)(vw[e] & 0xffffu); VT[(v16 + 2 * e + 1) * RWP + j] = (bf16_t)(vw[e] >> 16); } }
    if (j == 0) { *(f32x4*)(gDV + c8) = (f32x4){__expf(bl[0]), __expf(bl[1]), __expf(bl[2]), __expf(bl[3])}; *(f32x4*)(gDV + c8 + 4) = (f32x4){__expf(bl[4]), __expf(bl[5]), __expf(bl[6]), __expf(bl[7])}; }
    __syncthreads();
    {
        const f32x4 z4 = {0.f, 0.f, 0.f, 0.f};
#pragma unroll
        for (int tt = 0; tt < 4; ++tt) { const int mt = tt, nt = w;
            const f32x4 d = mm64(KS2T, VT, mt, nt, lane, z4);
            const int dv = nt * 16 + (lane & 15), k0 = mt * 16 + (lane >> 4) * 4;
            *(v2u*)(gKV + dv * 64 + k0) = (v2u){pk2(d.x, d.y), pk2(d.z, d.w)}; }
    }
    __syncthreads();
}
__device__ __forceinline__ void gla_sscan(const Args& a, Frame& F) {
    const WsMap m = ws_map(NTOK);
    const bf16_t* gKV = (const bf16_t*)(a.ws + m.glao); const float* gDV = (const float*)(a.ws + m.gladv); bf16_t* gS = (bf16_t*)(a.ws + m.glas);
    for (int it = F.vcu * NTHR + F.tid; it < 16 * 8192; it += F.G * NTHR) {
        const int bh = it >> 13, e = it & 8191, k = e & 63;
        float S = 0.f;
#pragma unroll 1
        for (int c0 = 0; c0 < 64; c0 += 16) {
            float kv[16], dv[16];
#pragma unroll
            for (int u = 0; u < 16; ++u) { const size_t ci = (size_t)bh * 64 + c0 + u; kv[u] = bf2f(gKV[ci * 8192 + e]); dv[u] = gDV[ci * 64 + k]; }
#pragma unroll
            for (int u = 0; u < 16; ++u) { const size_t ci = (size_t)bh * 64 + c0 + u; gS[ci * 8192 + e] = f2bf(S); S = S * dv[u] + kv[u]; }
        }
    }
}
__device__ __forceinline__ void gla_pb_chunk(const Args& a, Frame& F, int l, int ci) {
    const WsMap m = ws_map(NTOK);
    const int bh = ci >> 6, c = ci & 63, b = bh >> 2, h = bh & 3;
    const int lane = F.lane, w = F.wave, tid = F.tid;
    LAS bf16_t* QS = (LAS bf16_t*)F.lds; LAS bf16_t* KS = QS + RWT; LAS bf16_t* QG = KS + RWT; LAS bf16_t* PM = QG + RWT;
    LAS bf16_t* VT = PM + RWT; LAS bf16_t* ST = VT + 128 * RWP; LAS bf16_t* GG = ST + 128 * RWP;
    LAS float* TMP = (LAS float*)(GG + 64 * GP); LAS float* OSS = TMP + 512;
    const bf16_t* p16 = (const bf16_t*)(a.ws + m.p16); const bf16_t* ao = (const bf16_t*)(a.ws + m.auxo);
    const bf16_t* gS = (const bf16_t*)(a.ws + m.glas) + (size_t)ci * 8192; bf16_t* mix = (bf16_t*)(a.ws + m.mix16);
    const int j = tid >> 3, c8 = (tid & 7) * 8, v16 = (tid & 7) * 16;
    const size_t n = (size_t)b * TSEQ + c * 64 + j;
    float q8[8], k8[8], la[8];
    unpack8(ld8(p16 + n * PLD + C_GLA + h * 64 + c8), q8); unpack8(ld8(p16 + n * PLD + C_GLA + 256 + h * 64 + c8), k8); unpack8(ld8(ao + n * 1792 + 1536 + h * 64 + c8), la);
    const v4u v0 = ld8(p16 + n * PLD + C_GLA + 512 + h * 128 + v16), v1 = ld8(p16 + n * PLD + C_GLA + 512 + h * 128 + v16 + 8);
    const v4u g0 = ld8(p16 + n * PLD + C_GLA + 1024 + h * 128 + v16), g1 = ld8(p16 + n * PLD + C_GLA + 1024 + h * 128 + v16 + 8);
    const v4u s0 = ((const v4u*)gS)[tid], s1 = ((const v4u*)gS)[512 + tid];
#pragma unroll
    for (int k = 0; k < 8; ++k) la[k] = -softplus_f(-la[k]) * (1.0f / 16.0f);
    chunk_cumsum8(la, TMP, lane, w, c8);
    {
        float br[8], t0[8], t1[8], t2[8];
#pragma unroll
        for (int k = 0; k < 8; ++k) br[k] = 0.f;
#pragma unroll
        for (int ww = 0; ww < 4; ++ww) { const f32x4 y0 = *(const LAS f32x4*)(TMP + ww * 64 + c8), y1 = *(const LAS f32x4*)(TMP + ww * 64 + c8 + 4);
            br[0] += y0.x; br[1] += y0.y; br[2] += y0.z; br[3] += y0.w; br[4] += y1.x; br[5] += y1.y; br[6] += y1.z; br[7] += y1.w; }
#pragma unroll
        for (int k = 0; k < 8; ++k) { const float qq = q8[k] * 0.125f;
            t0[k] = qq * __expf(la[k] - br[k]); t1[k] = k8[k] * __expf(br[k] - la[k]); t2[k] = qq * __expf(la[k]); }
        *(LAS v4u*)(QS + j * RWP + c8) = pack8(t0); *(LAS v4u*)(KS + j * RWP + c8) = pack8(t1); *(LAS v4u*)(QG + j * RWP + c8) = pack8(t2);
        const unsigned vw[8] = {v0.x, v0.y, v0.z, v0.w, v1.x, v1.y, v1.z, v1.w};
#pragma unroll
        for (int e = 0; e < 8; ++e) { VT[(v16 + 2 * e) * RWP + j] = (bf16_t)(vw[e] & 0xffffu); VT[(v16 + 2 * e + 1) * RWP + j] = (bf16_t)(vw[e] >> 16); }
        *(LAS v4u*)(GG + j * GP + v16) = g0; *(LAS v4u*)(GG + j * GP + v16 + 8) = g1;
        { const int p0 = tid, p1 = 512 + tid;
          *(LAS v4u*)(ST + (p0 >> 3) * RWP + (p0 & 7) * 8) = s0; *(LAS v4u*)(ST + (p1 >> 3) * RWP + (p1 & 7) * 8) = s1; }
    }
    __syncthreads();
    {
        const f32x4 z4 = {0.f, 0.f, 0.f, 0.f};
#pragma unroll
        for (int tt = 0; tt < 2; ++tt) { const int t = w + 8 * tt, mtj = t >> 2, nti = t & 3;
            f32x4 s4 = mm64(KS, QS, mtj, nti, lane, z4);
            const int i = nti * 16 + (lane & 15), j0 = mtj * 16 + (lane >> 4) * 4;
#pragma unroll
            for (int e = 0; e < 4; ++e) if (j0 + e > i) s4[e] = 0.f;
            st_transposed(PM, mtj, nti, lane, s4); }
    }
    __syncthreads();
    {
        const int mt = w >> 1, ntb = (w & 1) * 4, r = lane & 15, i0 = mt * 16 + (lane >> 4) * 4;
        f32x4 o[4]; float ss[4] = {0.f, 0.f, 0.f, 0.f};
#pragma unroll
        for (int t = 0; t < 4; ++t) { o[t] = mm64(QG, ST, mt, ntb + t, lane, (f32x4){0.f, 0.f, 0.f, 0.f}); o[t] = mm64(PM, VT, mt, ntb + t, lane, o[t]);
            ss[0] += o[t].x * o[t].x; ss[1] += o[t].y * o[t].y; ss[2] += o[t].z * o[t].z; ss[3] += o[t].w * o[t].w; }
#pragma unroll
        for (int e = 0; e < 4; ++e) ss[e] = row16_sum(ss[e]);
        if (r == 0) {
#pragma unroll
            for (int e = 0; e < 4; ++e) OSS[(i0 + e) * 2 + (w & 1)] = ss[e]; }
        __syncthreads();
        float rs[4];
#pragma unroll
        for (int e = 0; e < 4; ++e) rs[e] = 1.0f / sqrtf((OSS[(i0 + e) * 2] + OSS[(i0 + e) * 2 + 1]) * (1.0f / 128.0f) + 1e-6f);
        const size_t nrow = (size_t)b * TSEQ + c * 64 + i0;
#pragma unroll
        for (int t = 0; t < 4; ++t) { const int dv = (ntb + t) * 16 + r; const float gn = a.in[I_GLA_NORM][l * 128 + dv];
            const float ov[4] = {o[t].x, o[t].y, o[t].z, o[t].w};
#pragma unroll
            for (int e = 0; e < 4; ++e) { const float g = bf2f(GG[(i0 + e) * GP + dv]);
                mix[(nrow + e) * DM + 512 + h * 128 + dv] = f2bf(ov[e] * rs[e] * gn * (g * sigm(g))); } }
    }
    __syncthreads();
}

__device__ __forceinline__ void lru_pass(const Args& a, Frame& F, int l, bool passB) {
    const WsMap m = ws_map(NTOK);
    const bf16_t* gt = (const bf16_t*)(a.ws + m.gates); const bf16_t* xc = (const bf16_t*)(a.ws + m.xc); const bf16_t* p16 = (const bf16_t*)(a.ws + m.p16);
    bf16_t* mix = (bf16_t*)(a.ws + m.mix16); float* lrs = (float*)(a.ws + m.lrs);
    for (int it = F.vcu * NTHR + F.tid; it < NBATCH * 64 * 512; it += F.G * NTHR) {
        const int ch = it & 511, bc = it >> 9, c = bc & 63;
        const float sp8 = 8.0f * softplus_f(-a.in[I_LRU_LAM][l * 512 + ch]);
        const size_t nb = (size_t)bc * 64;
        float hh = 0.f, ap = 1.f;
        if (passB) {
            for (int s0 = 0; s0 < c; s0 += 8) { f32x2 su[8];
#pragma unroll
                for (int u = 0; u < 8; ++u) su[u] = (s0 + u < c) ? *(const f32x2*)(lrs + ((size_t)(bc - c + s0 + u) * 512 + ch) * 2) : (f32x2){1.f, 0.f};
#pragma unroll
                for (int u = 0; u < 8; ++u) hh = su[u].x * hh + su[u].y; } }
#pragma unroll 1
        for (int t0 = 0; t0 < 64; t0 += 8) {
            bf16_t rr[8], ii[8], xx[8], yy[8];
#pragma unroll
            for (int u = 0; u < 8; ++u) { const size_t n = nb + t0 + u; rr[u] = gt[n * 1024 + ch]; ii[u] = gt[n * 1024 + 512 + ch]; xx[u] = xc[n * 512 + ch];
                yy[u] = passB ? p16[n * PLD + C_LRU + 512 + ch] : (bf16_t)0; }
#pragma unroll
            for (int u = 0; u < 8; ++u) { const size_t n = nb + t0 + u;
                const float la = -sp8 * sigm(bf2f(rr[u]));
                const float av = __expf(la);
                const float uu = bf2f(xx[u]) * sigm(bf2f(ii[u])) * sqrtf(fmaxf(1.0f - av * av, 0.0f));
                hh = av * hh + uu; ap *= av;
                if (passB) mix[n * DM + 1024 + ch] = f2bf(hh * gelu_fast(bf2f(yy[u]))); }
        }
        if (!passB) *(f32x2*)(lrs + ((size_t)bc * 512 + ch) * 2) = (f32x2){ap, hh};
    }
}

__device__ __forceinline__ void scan_phase(const Args& a, Frame& F, int l) {
    lru_pass(a, F, l, false);
    const int task = blockIdx.x;
    for (int q = 0; q < 8; ++q) rwkv_pa_chunk(a, F, l, task * 8 + q);
    for (int q = 0; q < 4; ++q) gdn_pa_chunk(a, F, task * 4 + q);
    for (int q = 0; q < 4; ++q) gla_pa_chunk(a, F, task * 4 + q);
    if (l == 0) tables_range(a, F, (size_t)2 * NEXP * DM / 32, (size_t)4 * NEXP * DM / 32, F.vcu, F.G);
}

__device__ __forceinline__ void post_phase(const Args& a, Frame& F, int l, const XcdBarrier& bar) {
    const WsMap m = ws_map(NTOK);
    if (blockIdx.x < 128) rwkv_ps_task(a, F, blockIdx.x); else gdn_ps_task(a, F, blockIdx.x - 128);
    gla_sscan(a, F);
    lru_pass(a, F, l, true);
    const bf16_t* p16 = (const bf16_t*)(a.ws + m.p16); const bf16_t* glao = (const bf16_t*)(a.ws + m.glao); const bf16_t* gdno = (const bf16_t*)(a.ws + m.gdno);
    const bf16_t* rwy = (const bf16_t*)(a.ws + m.rwy); const bf16_t* rwbv = (const bf16_t*)(a.ws + m.rwbv); const bf16_t* ao = (const bf16_t*)(a.ws + m.auxo);
    bf16_t* mix = (bf16_t*)(a.ws + m.mix16);
    const int lane = F.lane, col = lane * 8, hc = col & 127;
    float gg[8], gd[8], lw[8], lb[8];
    { const f32x4 x0 = *(const f32x4*)(a.in[I_GLA_NORM] + l * 128 + hc), x1 = *(const f32x4*)(a.in[I_GLA_NORM] + l * 128 + hc + 4);
      gg[0] = x0.x; gg[1] = x0.y; gg[2] = x0.z; gg[3] = x0.w; gg[4] = x1.x; gg[5] = x1.y; gg[6] = x1.z; gg[7] = x1.w;
      const f32x4 y0 = *(const f32x4*)(a.in[I_GDN_NORM] + l * 128 + hc), y1 = *(const f32x4*)(a.in[I_GDN_NORM] + l * 128 + hc + 4);
      gd[0] = y0.x; gd[1] = y0.y; gd[2] = y0.z; gd[3] = y0.w; gd[4] = y1.x; gd[5] = y1.y; gd[6] = y1.z; gd[7] = y1.w;
      const f32x4 w0 = *(const f32x4*)(a.in[I_RW_LN_W] + l * 512 + col), w1 = *(const f32x4*)(a.in[I_RW_LN_W] + l * 512 + col + 4);
      lw[0] = w0.x; lw[1] = w0.y; lw[2] = w0.z; lw[3] = w0.w; lw[4] = w1.x; lw[5] = w1.y; lw[6] = w1.z; lw[7] = w1.w;
      const f32x4 b0 = *(const f32x4*)(a.in[I_RW_LN_B] + l * 512 + col), b1 = *(const f32x4*)(a.in[I_RW_LN_B] + l * 512 + col + 4);
      lb[0] = b0.x; lb[1] = b0.y; lb[2] = b0.z; lb[3] = b0.w; lb[4] = b1.x; lb[5] = b1.y; lb[6] = b1.z; lb[7] = b1.w; }
    for (int pass = 1; pass < 2; ++pass) {
    if (pass == 1) xcd_barrier(bar);
    for (int q = 0; q < 4; ++q) gla_pb_chunk(a, F, l, blockIdx.x * 4 + q);
    for (int n = F.gw; n < NTOK; n += F.ngw) {
        if (pass == 1) {
            float y[8], bv[8], g[8];
            unpack8(ld8(rwy + (size_t)n * 512 + col), y); unpack8(ld8(rwbv + (size_t)n * 512 + col), bv); unpack8(ld8(ao + (size_t)n * 1792 + 1024 + col), g);
            float s = 0.f;
#pragma unroll
            for (int k = 0; k < 8; ++k) s += y[k];
            const float mean = red8(s) * (1.0f / 64.0f);
            float s2 = 0.f;
#pragma unroll
            for (int k = 0; k < 8; ++k) { y[k] -= mean; s2 += y[k] * y[k]; }
            const float rs = 1.0f / sqrtf(red8(s2) * (1.0f / 64.0f) + 64e-5f);
#pragma unroll
            for (int k = 0; k < 8; ++k) y[k] = (y[k] * rs * lw[k] + lb[k] + bv[k]) * g[k];
            *(v4u*)(mix + (size_t)n * DM + col) = pack8(y);
        }
        if (pass == 1)
#pragma unroll
        for (int which = 1; which < 2; ++which) {
            float o[8], g[8];
            unpack8(ld8((which ? gdno : glao) + (size_t)n * 512 + col), o);
            unpack8(ld8(p16 + (size_t)n * PLD + (which ? C_GDN + 1536 : C_GLA + 1024) + col), g);
            float ss = 0.f;
#pragma unroll
            for (int k = 0; k < 8; ++k) ss += o[k] * o[k];
            ss = row16_sum(ss);
            const float rs = 1.0f / sqrtf(ss * (1.0f / 128.0f) + 1e-6f);
#pragma unroll
            for (int k = 0; k < 8; ++k) o[k] = o[k] * rs * (which ? gd[k] : gg[k]) * (g[k] * sigm(g[k]));
            *(v4u*)(mix + (size_t)n * DM + (which ? 1536 : 512) + col) = pack8(o);
        }
    }
    }
}

__device__ __forceinline__ void norm2_phase(const Args& a, Frame& F, int l) {
    const WsMap m = ws_map(NTOK);
    const float* gain = a.in[I_NORM_FFN] + l * DM;
    f32x4 gv[8];
#pragma unroll
    for (int j = 0; j < 8; ++j) gv[j] = ((const f32x4*)gain)[64 * j + F.lane];
    for (int n = F.gw; n < NTOK; n += F.ngw) {
        const f32x4* xr = (const f32x4*)(a.out + (size_t)n * DM) + F.lane;
        f32x4 v[8]; float s = 0.f;
#pragma unroll
        for (int j = 0; j < 8; ++j) { v[j] = xr[64 * j]; s += (v[j].x * v[j].x + v[j].y * v[j].y) + (v[j].z * v[j].z + v[j].w * v[j].w); }
        const float rstd = 1.0f / sqrtf(wave_sum_u(s) * (1.0f / DM) + 1e-6f);
        v2u* o8 = (v2u*)((bf16_t*)(a.ws + m.hb) + (size_t)n * DM) + F.lane;
#pragma unroll
        for (int j = 0; j < 8; ++j) { v2u w; w.x = pk2(v[j].x * rstd * gv[j].x, v[j].y * rstd * gv[j].y); w.y = pk2(v[j].z * rstd * gv[j].z, v[j].w * rstd * gv[j].w); o8[64 * j] = w; }
    }
}

#define TK_CE(A, B) do { const float mx_ = fmaxf(A, B), mn_ = fminf(A, B); A = mx_; B = mn_; } while (0)
__device__ __forceinline__ void tk_sort16_desc(float (&x)[16]) {
#pragma unroll
    for (int k = 2; k <= 16; k <<= 1)
#pragma unroll
        for (int j = k >> 1; j > 0; j >>= 1)
#pragma unroll
            for (int i = 0; i < 16; ++i) { const int p = i ^ j;
                if (p > i) { if ((i & k) == 0) TK_CE(x[i], x[p]); else TK_CE(x[p], x[i]); } }
}
__device__ __forceinline__ void tk_merge16(float (&run)[16], const float (&g)[16]) {
#pragma unroll
    for (int i = 0; i < 16; ++i) run[i] = fmaxf(run[i], g[15 - i]);
#pragma unroll
    for (int j = 8; j > 0; j >>= 1)
#pragma unroll
        for (int i = 0; i < 16; ++i) { const int p = i ^ j; if (p > i) TK_CE(run[i], run[p]); }
}
__device__ __forceinline__ float tk_tag(float v, unsigned tag, unsigned mask) { return __builtin_bit_cast(float, (__builtin_bit_cast(unsigned, v) & ~mask) | tag); }
__device__ __forceinline__ void topk_phase(const Args& a, Frame& F) {
    const WsMap m = ws_map(NTOK);
    const float* sc = (const float*)(a.ws + m.sc);
    int* idx = (int*)(a.ws + m.idx); float* gate = (float*)(a.ws + m.gate);
    LAS float* LS = (LAS float*)F.lds;
    const int t = F.tid;
    for (int wv = F.gw; wv < (NTOK / 64) * 8; wv += F.ngw) {
        const int h = wv & 7, n = (wv >> 3) * 64 + F.lane;
        const float* sp = sc + (size_t)(h * 256) * NTOK + n;
        float s0[16], s1[16];
#pragma unroll
        for (int half = 0; half < 2; ++half) {
            float run[16];
#pragma unroll
            for (int j = 0; j < 16; ++j) run[j] = -3.0e38f;
#pragma unroll 1
            for (int g = 0; g < 8; ++g) {
                float x[16];
#pragma unroll
                for (int k = 0; k < 16; ++k) x[k] = tk_tag(sp[(size_t)(half * 128 + g * 16 + k) * NTOK], (unsigned)(g * 16 + k), 127u);
                tk_sort16_desc(x);
                tk_merge16(run, x);
            }
#pragma unroll
            for (int j = 0; j < 16; ++j) { if (half) s1[j] = run[j]; else s0[j] = run[j]; LS[(half * 16 + j) * 512 + t] = run[j]; }
        }
        float run[16];
#pragma unroll
        for (int j = 0; j < 16; ++j) run[j] = -3.0e38f;
        {
            float x[16]; int cnt = 0;
#pragma unroll
            for (int p = 0; p < 16; ++p)
#pragma unroll
                for (int q = 0; q < 16; ++q) if ((p + 1) * (q + 1) <= 16) {
                    x[cnt & 15] = tk_tag(s0[p] + s1[q], (unsigned)(p * 16 + q), 255u); ++cnt;
                    if ((cnt & 15) == 0) { tk_sort16_desc(x); tk_merge16(run, x); }
                }
#pragma unroll
            for (int k = 0; k < 16; ++k) if (k >= (cnt & 15)) x[k] = -3.0e38f;
            tk_sort16_desc(x); tk_merge16(run, x);
        }
        const float mx = run[0]; float den = 0.f; float e[16]; int ti[16];
#pragma unroll
        for (int j = 0; j < 16; ++j) {
            const unsigned tg = __builtin_bit_cast(unsigned, run[j]) & 255u; const int p = (int)(tg >> 4), q = (int)(tg & 15u);
            const unsigned k0 = __builtin_bit_cast(unsigned, LS[(0 * 16 + p) * 512 + t]) & 127u, k1 = __builtin_bit_cast(unsigned, LS[(1 * 16 + q) * 512 + t]) & 127u;
            ti[j] = (int)(k0 * 128u + k1);
            e[j] = __expf(run[j] - mx); den += e[j];
        }
        const float inv = 1.0f / den;
        const size_t it = (size_t)n * 8 + h;
        f32x4* go = (f32x4*)(gate + it * 16); v4u* io = (v4u*)(idx + it * 16);
#pragma unroll
        for (int j = 0; j < 4; ++j) { go[j] = (f32x4){e[4 * j] * inv, e[4 * j + 1] * inv, e[4 * j + 2] * inv, e[4 * j + 3] * inv};
            io[j] = (v4u){(unsigned)ti[4 * j], (unsigned)ti[4 * j + 1], (unsigned)ti[4 * j + 2], (unsigned)ti[4 * j + 3]}; }
    }
}

__device__ __forceinline__ v6u ld_row6(const unsigned char* p) { const v2u* q = (const v2u*)p; const v2u a0 = q[0], a1 = q[1], a2 = q[2]; return (v6u){a0.x, a0.y, a1.x, a1.y, a2.x, a2.y}; }
__device__ __forceinline__ void peer_phase(const Args& a, Frame& F, int l) {
    const WsMap m = ws_map(NTOK);
    const unsigned char* TU = (const unsigned char*)(a.ws + m.tabu) + (size_t)l * 2 * NEXP * TROW;
    const unsigned char* TV = TU + (size_t)NEXP * TROW;
    const int* idx = (const int*)(a.ws + m.idx); const float* gate = (const float*)(a.ws + m.gate);
    const int lane = F.lane;
    for (int n = F.gw; n < NTOK; n += F.ngw) {
        float xf[32];
        { const v4u* hr = (const v4u*)((const bf16_t*)(a.ws + m.hb) + (size_t)n * DM + lane * 32);
#pragma unroll
          for (int q = 0; q < 4; ++q) { const v4u w = hr[q];
              xf[8 * q + 0] = bflo(w.x); xf[8 * q + 1] = bfhi(w.x); xf[8 * q + 2] = bflo(w.y); xf[8 * q + 3] = bfhi(w.y); xf[8 * q + 4] = bflo(w.z); xf[8 * q + 5] = bfhi(w.z); xf[8 * q + 6] = bflo(w.w); xf[8 * q + 7] = bfhi(w.w); } }
        const int e0 = idx[(size_t)n * 128 + lane], e1 = idx[(size_t)n * 128 + 64 + lane];
        const float g0 = gate[(size_t)n * 128 + lane], g1 = gate[(size_t)n * 128 + 64 + lane];
        float d0 = 0.f, d1 = 0.f;
#pragma unroll
        for (int half = 0; half < 2; ++half) {
            const int ev = half ? e1 : e0; float dd = 0.f;
            for (int j = 0; j < 64; j += 4) {
                v6u u[4];
#pragma unroll
                for (int r = 0; r < 4; ++r) { const int e = __builtin_amdgcn_readlane(ev, j + r); u[r] = ld_row6(TU + (size_t)e * TROW + lane * 24); }
#pragma unroll
                for (int r = 0; r < 4; ++r) { const v32f f = __builtin_amdgcn_cvt_scalef32_pk32_f32_fp6(u[r], 1.0f);
                    float a0 = 0.f, a1 = 0.f, a2 = 0.f, a3 = 0.f;
#pragma unroll
                    for (int k = 0; k < 8; ++k) { a0 += f[4 * k] * xf[4 * k]; a1 += f[4 * k + 1] * xf[4 * k + 1]; a2 += f[4 * k + 2] * xf[4 * k + 2]; a3 += f[4 * k + 3] * xf[4 * k + 3]; }
                    const float t = wave_sum_u((a0 + a1) + (a2 + a3));
                    dd = (lane == j + r) ? t : dd;
}
            }
            if (half) d1 = dd; else d0 = dd;
        }
        const float c0 = gelu_fast(d0 * (1.0f / 64.0f)) * g0 * 0.25f, c1 = gelu_fast(d1 * (1.0f / 64.0f)) * g1 * 0.25f;
        float o[32];
#pragma unroll
        for (int i = 0; i < 32; ++i) o[i] = 0.f;
#pragma unroll
        for (int half = 0; half < 2; ++half) {
            const int ev = half ? e1 : e0; const float cv = half ? c1 : c0;
            for (int j = 0; j < 64; j += 4) {
                v6u v[4]; float cj[4];
#pragma unroll
                for (int r = 0; r < 4; ++r) { const int e = __builtin_amdgcn_readlane(ev, j + r); cj[r] = rdlane_f(cv, j + r); v[r] = ld_row6(TV + (size_t)e * TROW + lane * 24); }
#pragma unroll
                for (int r = 0; r < 4; ++r) { const v32f f = __builtin_amdgcn_cvt_scalef32_pk32_f32_fp6(v[r], 1.0f);
#pragma unroll
                    for (int i = 0; i < 32; ++i) o[i] += f[i] * cj[r];
}
            }
        }
        float* xrow = a.out + (size_t)n * DM + lane * 32;
        float s = 0.f;
#pragma unroll
        for (int q = 0; q < 8; ++q) { const f32x4 x4 = *(const f32x4*)(xrow + 4 * q);
            o[4 * q] += x4.x; o[4 * q + 1] += x4.y; o[4 * q + 2] += x4.z; o[4 * q + 3] += x4.w;
            s += (o[4 * q] * o[4 * q] + o[4 * q + 1] * o[4 * q + 1]) + (o[4 * q + 2] * o[4 * q + 2] + o[4 * q + 3] * o[4 * q + 3]); }
        const float rstd = 1.0f / sqrtf(wave_sum_u(s) * (1.0f / DM) + 1e-6f);
        if (l + 1 < NL) {
            bf16_t* xo = (bf16_t*)(a.ws + m.xn) + (size_t)n * DM + lane * 32;
#pragma unroll
            for (int q = 0; q < 8; ++q) *(f32x4*)(xrow + 4 * q) = (f32x4){o[4 * q], o[4 * q + 1], o[4 * q + 2], o[4 * q + 3]};
#pragma unroll
            for (int q = 0; q < 4; ++q) { v4u w; w.x = pk2(o[8 * q] * rstd, o[8 * q + 1] * rstd); w.y = pk2(o[8 * q + 2] * rstd, o[8 * q + 3] * rstd); w.z = pk2(o[8 * q + 4] * rstd, o[8 * q + 5] * rstd); w.w = pk2(o[8 * q + 6] * rstd, o[8 * q + 7] * rstd);
                *(v4u*)(xo + 8 * q) = w; }
        } else {
            const float* gf = a.in[I_NORM_FINAL] + lane * 32;
#pragma unroll
            for (int q = 0; q < 8; ++q) { const f32x4 g4 = *(const f32x4*)(gf + 4 * q);
                *(f32x4*)(xrow + 4 * q) = (f32x4){o[4 * q] * rstd * g4.x, o[4 * q + 1] * rstd * g4.y, o[4 * q + 2] * rstd * g4.z, o[4 * q + 3] * rstd * g4.w}; }
        }
    }
}

#define IN(k) (lo <= (k) && (k) < hi)
#define SEAM(k) do { if (IN(k) && IN((k) + 1)) xcd_barrier(bar); } while (0)
template <int l>
__device__ __forceinline__ void layer_phases(const Args& a, Frame& F, const XcdBarrier& bar, const WsMap& m, int lo, int hi) {
    constexpr int pb = l * PH_PER_LAYER;
        if (IN(pb + PH_GEMM1)) {
            pg8::GemmX g{(const bf16_t*)(a.ws + m.xn), (const bf16_t*)(a.ws + m.w1t) + (size_t)l * PLD * DM, NTOK, PLD, DM, DM};
            pg8::StaticOrder S; S.init(NTOK, PLD, F.G, (int)blockIdx.x);
            pg8::EpiBf16 E{(bf16_t*)(a.ws + m.p16), PLD, nullptr};
            pg8::gemm_phase<pg8::EpiBf16, pg8::StaticOrder, true, true>(F.lds, g, S, E);
            SEAM(pb + PH_GEMM1);
        }
        if (IN(pb + PH_PREP)) { prep_phase(a, F, l); SEAM(pb + PH_PREP); }
        if (IN(pb + PH_AUX)) {
            const float* PP = (const float*)(a.ws + m.pp);
            { pg8::GemmX g{(const bf16_t*)(a.ws + m.auxA), (const bf16_t*)(a.ws + m.auxwt) + (size_t)l * 1792 * 384, NTOK, 1792, 384, 384};
              pg8::StaticOrder S; S.init(NTOK, 1792, F.G, (int)blockIdx.x);
              pg8::EpiBf16 E{(bf16_t*)(a.ws + m.auxo), 1792, PP + l * 1792};
              pg8::gemm_phase<pg8::EpiBf16, pg8::StaticOrder, true, true>(F.lds, g, S, E); }
            { pg8::GemmX g{(const bf16_t*)(a.ws + m.xc), (const bf16_t*)(a.ws + m.lruwt) + (size_t)l * 1024 * 512, NTOK, 1024, 512, 512};
              pg8::StaticOrder S; S.init(NTOK, 1024, F.G, (int)blockIdx.x);
              pg8::EpiBf16 E{(bf16_t*)(a.ws + m.gates), 1024, PP + 3584 + l * 1024};
              pg8::gemm_phase<pg8::EpiBf16, pg8::StaticOrder, true, true>(F.lds, g, S, E); }
            if (l > 0) {
              pg8::GemmX g{(const bf16_t*)(a.ws + m.zrkv) + 1024, (const bf16_t*)(a.ws + m.vreswt), NTOK, 512, 512, 1536};
              pg8::StaticOrder S; S.init(NTOK, 512, F.G, (int)blockIdx.x);
              pg8::EpiBf16 E{(bf16_t*)(a.ws + m.vres), 512, PP + 5632};
              pg8::gemm_phase<pg8::EpiBf16, pg8::StaticOrder, true, true>(F.lds, g, S, E); }
            SEAM(pb + PH_AUX);
        }
        if (IN(pb + PH_SCAN)) { scan_phase(a, F, l); SEAM(pb + PH_SCAN); }
        if (IN(pb + PH_POST)) { post_phase(a, F, l, bar); SEAM(pb + PH_POST); }
        if (IN(pb + PH_GEMM2)) {
            pg8::GemmX g{(const bf16_t*)(a.ws + m.mix16), (const bf16_t*)(a.ws + m.w2t) + (size_t)l * DM * DM, NTOK, DM, DM, DM};
            pg8::StaticOrder S; S.init(NTOK, DM, F.G, (int)blockIdx.x);
            pg8::EpiF32<true> E{a.out, DM};
            pg8::gemm_phase<pg8::EpiF32<true>, pg8::StaticOrder, true, true>(F.lds, g, S, E);
            SEAM(pb + PH_GEMM2);
        }
        if (IN(pb + PH_NORM2)) { norm2_phase(a, F, l); SEAM(pb + PH_NORM2); }
        if (IN(pb + PH_GEMM3)) {
            pg8::GemmX g{(const bf16_t*)(a.ws + m.wsct) + (size_t)l * DM * DM, (const bf16_t*)(a.ws + m.hb), DM, NTOK, DM, DM};
            pg8::StaticOrder S; S.init(DM, NTOK, F.G, (int)blockIdx.x);
            pg8::EpiF32<false> E{(float*)(a.ws + m.sc), NTOK};
            pg8::gemm_phase<pg8::EpiF32<false>, pg8::StaticOrder, true, true>(F.lds, g, S, E);
            SEAM(pb + PH_GEMM3);
        }
        if (IN(pb + PH_TOPK)) { topk_phase(a, F); SEAM(pb + PH_TOPK); }
        if (IN(pb + PH_PEER)) { peer_phase(a, F, l); SEAM(pb + PH_PEER); }
}

#undef IN
#undef SEAM
__global__ void __launch_bounds__(NTHR, 2) mega(Args a) {
    extern __shared__ __attribute__((aligned(16))) unsigned char lds_raw[];
    Frame F;
    F.lds = (LAS unsigned char*)lds_raw;
    F.tid = threadIdx.x; F.lane = F.tid & 63; F.wave = __builtin_amdgcn_readfirstlane(F.tid >> 6);
    F.G = gridDim.x; { const int bx = blockIdx.x; F.vcu = (F.G % 8 == 0) ? (bx % 8) * (F.G / 8) + bx / 8 : bx; }
    F.gw = F.vcu * NWAVES + F.wave; F.ngw = F.G * NWAVES;
    volatile LAS unsigned* MISC = (volatile LAS unsigned*)(F.lds + MISC_OFF);
    if (F.tid < 32) MISC[F.tid] = 0u;
    __syncthreads();
    const WsMap m = ws_map(NTOK);
    unsigned* ctl = (unsigned*)(a.ws + m.ctl);
    XcdBarrier bar; bar.bar = ctl + 4096 + a.li * XCD_BAR_WORDS; bar.x = 0; bar.st = nullptr;
    const int lo = a.ph_lo, hi = a.ph_hi;
    if (hi - lo > 1) bar = xcd_barrier_post(ctl + 4096 + a.li * XCD_BAR_WORDS, MISC + 8);
#define IN(k) (lo <= (k) && (k) < hi)
#define SEAM(k) do { if (IN(k) && IN((k) + 1)) xcd_barrier(bar); } while (0)
    if (IN(PH_P0)) { p0_prologue(a, F); tables_range(a, F, 0, (size_t)2 * NEXP * DM / 32, F.vcu, F.G); SEAM(PH_P0); }
    layer_phases<0>(a, F, bar, m, lo, hi);
    layer_phases<1>(a, F, bar, m, lo, hi);
#undef IN
#undef SEAM
}

template <int ST>
__global__ void __launch_bounds__(256) stage_kernel(Params P, int l) {
    const long n = stage_items(P, ST, l);
    for (long it = blockIdx.x * 256L + threadIdx.x; it < n; it += gridDim.x * 256L) run_item(P, ST, l, it);
}
template <int ST>
static void launch_stage(const Params& P, int l, hipStream_t stream) {
    const long n = stage_items(P, ST, l);
    if (n <= 0) return;
    long blocks = (n + 255) / 256;
    if (blocks > 8192) blocks = 8192;
    stage_kernel<ST><<<dim3((unsigned)blocks), dim3(256), 0, stream>>>(P, l);
}
#define LS(X) case X: launch_stage<X>(P, l, stream); break;
static void launch_any(int st, const Params& P, int l, hipStream_t stream) {
    switch (st) {
        LS(ST_COPYX) LS(ST_RSTD) LS(ST_NORM1) LS(ST_GEMM1) LS(ST_RW_A0) LS(ST_RW_A1) LS(ST_RW_A2) LS(ST_RW_A3) LS(ST_RW_KKN)
        LS(ST_RW_SCAN) LS(ST_RW_POST) LS(ST_GLA_B0) LS(ST_GLA_SCAN) LS(ST_GLA_POST) LS(ST_LRU_C0) LS(ST_LRU_C1) LS(ST_LRU_SCAN)
        LS(ST_GDN_D0) LS(ST_GDN_D1) LS(ST_GDN_SCAN) LS(ST_GDN_POST) LS(ST_GEMM2) LS(ST_RSTD2) LS(ST_NORM2) LS(ST_GEMM3)
        LS(ST_SCORES) LS(ST_TOPK1) LS(ST_TOPK2) LS(ST_PEER_U) LS(ST_PEER_V) LS(ST_FRSTD) LS(ST_FNORM)
    }
}

extern "C" void kernel_launch(void* const* d_in, const int* in_sizes, int n_in, void* d_out, int out_size, void* d_ws,
                              size_t ws_size, hipStream_t stream) {
    static int grid = 0;
    if (grid == 0) {
        int dev = 0, cus = 0;
        (void)hipGetDevice(&dev);
        (void)hipDeviceGetAttribute(&cus, hipDeviceAttributeMultiprocessorCount, dev);
        (void)hipFuncSetAttribute((const void*)mega, hipFuncAttributeMaxDynamicSharedMemorySize, LDS_BYTES);
        grid = cus > 0 ? cus : 256;
    }
    Params P;
    memset(&P, 0, sizeof(P));
    fill_inputs(P, d_in);
    P.B = 4; P.T = 4096; P.N = 16384; P.pad = 0;
    P.xcur = (float*)d_out;
    bind_ws(P, (char*)d_ws);
    Args a;
    memset(&a, 0, sizeof(a));
    for (int i = 0; i < 38; ++i) a.in[i] = (const float*)d_in[i];
    a.out = (float*)d_out; a.ws = (unsigned char*)d_ws;
    (void)hipMemsetAsync(d_ws, 0, 1u << 20, stream);
    int li = 0;
    auto run_mega = [&](int lo, int hi) { a.ph_lo = lo; a.ph_hi = hi; a.li = li++; hipLaunchKernelGGL(mega, dim3(grid), dim3(NTHR), LDS_BYTES, stream, a); };
    run_mega(PH_P0, PH_TOTAL);
}
#endif
```

```cpp
#ifndef HOST_EMU
#include <hip/hip_runtime.h>
#include <cstring>
#define HD __host__ __device__ __forceinline__
#else
#include <cmath>
#include <cstdio>
#include <cstdlib>
#include <cstring>
#define HD inline
#endif

constexpr int DM = 2048;
constexpr int NL = 2;
constexpr int INC = 6424;
constexpr int C_RW = 0;
constexpr int C_GLA = 1792;
constexpr int C_LRU = 3344;
constexpr int C_GDN = 4368;
constexpr int NEXP = 16384;

typedef unsigned short bf16_t;
constexpr int PLD = 6656;
HD float bf2f(bf16_t h) { unsigned u = (unsigned)h << 16; float f; memcpy(&f, &u, 4); return f; }
HD bf16_t f2bf(float f) { unsigned u; memcpy(&u, &f, 4); return (bf16_t)((u + 0x7fffu + ((u >> 16) & 1u)) >> 16); }

struct Params {
    const float *x, *norm_mix, *w_in, *w_out, *rw_mu, *rw_w0, *rw_w_up, *rw_a0, *rw_a_up, *rw_g_up, *rw_k_k, *rw_k_a,
        *rw_r_k, *rw_ln_w, *rw_ln_b, *rw_v0, *rw_v_down, *rw_v_up, *gla_a_up, *gla_a_bias, *gla_norm, *lru_conv_w,
        *lru_conv_b, *lru_w_r, *lru_b_r, *lru_w_i, *lru_b_i, *lru_lam, *gdn_conv_w, *gdn_a_log, *gdn_dt_bias, *gdn_norm,
        *norm_ffn, *peer_wq, *peer_sub_keys, *peer_u, *peer_v, *norm_final;
    float* xcur;
    bf16_t* xn;
    bf16_t* hb;
    bf16_t* mix16;
    bf16_t* p16;
    float* sc;
    float* qf;
    float* rstd;
    float* vfirst;
    float* scr;
    float* act;
    float* gate;
    int* idx;
    int B, T, N, pad;
};

HD float sigmoidf_(float x) { return 1.0f / (1.0f + expf(-x)); }
HD float softplusf_(float x) { return log1pf(expf(-fabsf(x))) + fmaxf(x, 0.0f); }
HD float siluf_(float x) { return x * sigmoidf_(x); }
HD float geluf_(float x) { return 0.5f * x * (1.0f + tanhf(0.7978845608028654f * (x + 0.044715f * x * x * x))); }

enum Stage {
    ST_COPYX = 0,
    ST_RSTD, ST_NORM1, ST_GEMM1,
    ST_RW_A0, ST_RW_A1, ST_RW_A2, ST_RW_A3, ST_RW_KKN, ST_RW_SCAN, ST_RW_POST,
    ST_GLA_B0, ST_GLA_SCAN, ST_GLA_POST,
    ST_LRU_C0, ST_LRU_C1, ST_LRU_SCAN,
    ST_GDN_D0, ST_GDN_D1, ST_GDN_SCAN, ST_GDN_POST,
    ST_GEMM2, ST_RSTD2, ST_NORM2, ST_GEMM3, ST_SCORES, ST_TOPK1, ST_TOPK2, ST_PEER_U, ST_PEER_V,
    ST_FRSTD, ST_FNORM,
    ST_COUNT
};

constexpr long SO_ZS = 0, SO_R = 256, SO_DEC = 768, SO_KM = 1280, SO_KK = 1792, SO_A = 2304, SO_G = 2816, SO_V = 3328,
               SO_Y = 3840, SO_VD = 4352, SO_KKINV = 4384;
constexpr long SO_ALPHA = 0, SO_GO = 256;
constexpr long SO_XC = 0, SO_LA = 512, SO_LU = 1024;
constexpr long SO_QKV = 0, SO_GS = 1536, SO_DO = 1552;
constexpr long SCR_PER_TOK = 4400;
constexpr long SO_TS = 0, SO_TI = 256;

HD long stage_items(const Params& P, int st, int l) {
    const long N = P.N;
    switch (st) {
        case ST_COPYX: return N * DM;
        case ST_RSTD: case ST_RSTD2: case ST_FRSTD: return N;
        case ST_NORM1: case ST_NORM2: case ST_FNORM: return N * DM;
        case ST_GEMM1: return (N / 4) * (INC / 4);
        case ST_RW_A0: return N * 256;
        case ST_RW_A1: return N * 512;
        case ST_RW_A2: return l > 0 ? N * 32 : 0;
        case ST_RW_A3: return l > 0 ? N * 512 : 0;
        case ST_RW_KKN: return N * 8;
        case ST_RW_SCAN: return (long)P.B * 512;
        case ST_RW_POST: return N * 8;
        case ST_GLA_B0: return N * 256;
        case ST_GLA_SCAN: return (long)P.B * 512;
        case ST_GLA_POST: return N * 4;
        case ST_LRU_C0: return N * 512;
        case ST_LRU_C1: return N * 512;
        case ST_LRU_SCAN: return (long)P.B * 512;
        case ST_GDN_D0: return N * 1536;
        case ST_GDN_D1: return N * 4;
        case ST_GDN_SCAN: return (long)P.B * 512;
        case ST_GDN_POST: return N * 4;
        case ST_GEMM2: case ST_GEMM3: return (N / 4) * (DM / 4);
        case ST_SCORES: return N * 2048;
        case ST_TOPK1: return N * 16;
        case ST_TOPK2: return N * 8;
        case ST_PEER_U: return N * 128;
        case ST_PEER_V: return N * DM;
    }
    return 0;
}

HD void gemm_item(const bf16_t* A, const float* W, int ldw, const float* kscale, float* Cf, bf16_t* Ch, int ldc, int n4, long item, int mode) {
    const long r4 = item / n4;
    const int c4 = (int)(item % n4);
    const bf16_t* a0 = A + (r4 * 4) * (long)DM;
    const float* w = W + c4 * 4;
    float acc[4][4];
    for (int i = 0; i < 4; ++i)
        for (int j = 0; j < 4; ++j) acc[i][j] = 0.f;
    for (int k = 0; k < DM; ++k) {
        const float ks = kscale ? kscale[k] : 1.0f;
        const float w0 = w[(long)k * ldw + 0] * ks, w1 = w[(long)k * ldw + 1] * ks, w2 = w[(long)k * ldw + 2] * ks, w3 = w[(long)k * ldw + 3] * ks;
#pragma unroll
        for (int i = 0; i < 4; ++i) {
            const float a = bf2f(a0[(long)i * DM + k]);
            acc[i][0] += a * w0; acc[i][1] += a * w1; acc[i][2] += a * w2; acc[i][3] += a * w3;
        }
    }
#pragma unroll
    for (int i = 0; i < 4; ++i) {
        const long o = (r4 * 4 + i) * (long)ldc + c4 * 4;
#pragma unroll
        for (int j = 0; j < 4; ++j) {
            if (mode == 0) Ch[o + j] = f2bf(acc[i][j]);
            else if (mode == 1) Cf[o + j] += acc[i][j];
            else Cf[o + j] = acc[i][j];
        }
    }
}

#define PF(n, col) bf2f(P.p16[(long)(n) * PLD + (col)])
HD float rw_shift(const Params& P, int l, long n, int col) {
    const int t = (int)(n % P.T);
    const float cur = PF(n, C_RW + col);
    const float prev = t > 0 ? PF(n - 1, C_RW + col) : 0.f;
    return cur + (prev - cur) * P.rw_mu[l * 1792 + col];
}

HD void run_item(const Params& P, int st, int l, long it) {
    const long N = P.N;
    float* scr = P.scr;
    switch (st) {
        case ST_COPYX: P.xcur[it] = P.x[it]; break;
        case ST_RSTD: case ST_RSTD2: case ST_FRSTD: {
            const float* xr = P.xcur + it * DM;
            float s = 0.f;
            for (int d = 0; d < DM; ++d) s += xr[d] * xr[d];
            P.rstd[it] = 1.0f / sqrtf(s * (1.0f / DM) + 1e-6f);
        } break;
        case ST_NORM1: case ST_NORM2: case ST_FNORM: {
            const long n = it / DM; const int d = (int)(it % DM);
            if (st == ST_NORM1) P.xn[it] = f2bf(P.xcur[it] * P.rstd[n]);
            else if (st == ST_NORM2) P.hb[it] = f2bf(P.xcur[it] * P.rstd[n] * P.norm_ffn[l * DM + d]);
            else P.xcur[it] = P.xcur[it] * P.rstd[n] * P.norm_final[d];
        } break;
        case ST_GEMM1: gemm_item(P.xn, P.w_in + (long)l * DM * INC, INC, P.norm_mix + l * DM, nullptr, P.p16, PLD, INC / 4, it, 0); break;
        case ST_GEMM2: gemm_item(P.mix16, P.w_out + (long)l * DM * DM, DM, nullptr, P.xcur, nullptr, DM, DM / 4, it, 1); break;
        case ST_GEMM3: gemm_item(P.hb, P.peer_wq + (long)l * DM * DM, DM, nullptr, P.qf, nullptr, DM, DM / 4, it, 2); break;
        case ST_RW_A0: {
            const long n = it / 256; const int c = (int)(it % 256);
            const float z = rw_shift(P, l, n, 1536 + c);
            scr[N * SO_ZS + it] = c < 64 ? tanhf(z) : (c < 128 ? z : sigmoidf_(z));
        } break;
        case ST_RW_A1: {
            const long n = it / 512; const int j = (int)(it % 512);
            const float zr = rw_shift(P, l, n, j), zk = rw_shift(P, l, n, 512 + j), zv = rw_shift(P, l, n, 1024 + j);
            const float* zs = scr + N * SO_ZS + n * 256;
            float aw = P.rw_w0[l * 512 + j], aa = P.rw_a0[l * 512 + j], ag = 0.f;
            const float* wu = P.rw_w_up + (long)l * 64 * 512 + j;
            const float* au = P.rw_a_up + (long)l * 64 * 512 + j;
            const float* gu = P.rw_g_up + (long)l * 128 * 512 + j;
            for (int i = 0; i < 64; ++i) { aw += zs[i] * wu[i * 512]; aa += zs[64 + i] * au[i * 512]; }
            for (int i = 0; i < 128; ++i) ag += zs[128 + i] * gu[i * 512];
            const float w_raw = -softplusf_(-aw) - 0.5f;
            const float a = sigmoidf_(aa);
            scr[N * SO_R + it] = zr;
            scr[N * SO_DEC + it] = expf(-expf(w_raw));
            scr[N * SO_KM + it] = zk * (1.0f + (a - 1.0f) * P.rw_k_a[l * 512 + j]);
            scr[N * SO_KK + it] = zk * P.rw_k_k[l * 512 + j];
            scr[N * SO_A + it] = a;
            scr[N * SO_G + it] = ag;
            scr[N * SO_V + it] = zv;
            if (l == 0) P.vfirst[it] = zv;
        } break;
        case ST_RW_A2: {
            const long n = it / 32; const int i = (int)(it % 32);
            const float* v = scr + N * SO_V + n * 512;
            const float* vdn = P.rw_v_down + (long)(l - 1) * 512 * 32 + i;
            float s = 0.f;
            for (int j = 0; j < 512; ++j) s += v[j] * vdn[j * 32];
            scr[N * SO_VD + it] = s;
        } break;
        case ST_RW_A3: {
            const long n = it / 512; const int j = (int)(it % 512);
            const float* vd = scr + N * SO_VD + n * 32;
            const float* vup = P.rw_v_up + (long)(l - 1) * 32 * 512 + j;
            float s = P.rw_v0[(l - 1) * 512 + j];
            for (int i = 0; i < 32; ++i) s += vd[i] * vup[i * 512];
            const float v = scr[N * SO_V + it];
            scr[N * SO_V + it] = v + (P.vfirst[it] - v) * sigmoidf_(s);
        } break;
        case ST_RW_KKN: {
            const float* kk = scr + N * SO_KK + it * 64;
            float s = 0.f;
            for (int i = 0; i < 64; ++i) s += kk[i] * kk[i];
            scr[N * SO_KKINV + it] = 1.0f / sqrtf(fmaxf(s, 1e-24f));
        } break;
        case ST_RW_SCAN: {
            const int b = (int)(it / 512); const int h = (int)((it % 512) / 64); const int v = (int)(it % 64);
            float S[64];
#pragma unroll
            for (int i = 0; i < 64; ++i) S[i] = 0.f;
            for (int t = 0; t < P.T; ++t) {
                const long n = (long)b * P.T + t;
                const long base = n * 512 + h * 64;
                const float inv = scr[N * SO_KKINV + n * 8 + h];
                const float vv = scr[N * SO_V + base + v];
                const float* KK = scr + N * SO_KK + base;
                const float* DEC = scr + N * SO_DEC + base;
                const float* KM = scr + N * SO_KM + base;
                const float* AA = scr + N * SO_A + base;
                const float* RR = scr + N * SO_R + base;
                float sa = 0.f;
#pragma unroll
                for (int i = 0; i < 64; ++i) sa += S[i] * (-KK[i] * inv);
                float y = 0.f;
#pragma unroll
                for (int i = 0; i < 64; ++i) {
                    const float kk = KK[i] * inv;
                    S[i] = S[i] * DEC[i] + sa * (kk * AA[i]) + vv * KM[i];
                    y += S[i] * RR[i];
                }
                scr[N * SO_Y + base + v] = y;
            }
        } break;
        case ST_RW_POST: {
            const long n = it / 8; const int h = (int)(it % 8);
            const long base = n * 512 + h * 64;
            const float* Y = scr + N * SO_Y + base;
            const float* RR = scr + N * SO_R + base;
            const float* KM = scr + N * SO_KM + base;
            const float* V = scr + N * SO_V + base;
            const float* G = scr + N * SO_G + base;
            float mean = 0.f, bon = 0.f;
            for (int i = 0; i < 64; ++i) { mean += Y[i]; bon += RR[i] * KM[i] * P.rw_r_k[l * 512 + h * 64 + i]; }
            mean *= (1.0f / 64);
            float var = 0.f;
            for (int i = 0; i < 64; ++i) { const float d = Y[i] - mean; var += d * d; }
            const float rs = 1.0f / sqrtf(var * (1.0f / 64) + 64e-5f);
            for (int i = 0; i < 64; ++i) {
                const int c = h * 64 + i;
                const float yn = (Y[i] - mean) * rs * P.rw_ln_w[l * 512 + c] + P.rw_ln_b[l * 512 + c];
                P.mix16[n * DM + c] = f2bf((yn + bon * V[i]) * G[i]);
            }
        } break;
        case ST_GLA_B0: {
            const long n = it / 256; const int c = (int)(it % 256);
            float s = P.gla_a_bias[l * 256 + c];
            for (int i = 0; i < 16; ++i) s += PF(n, C_GLA + 1536 + i) * P.gla_a_up[(long)l * 16 * 256 + i * 256 + c];
            scr[N * SO_ALPHA + it] = expf(-softplusf_(-s) * (1.0f / 16.0f));
        } break;
        case ST_GLA_SCAN: {
            const int b = (int)(it / 512); const int h = (int)((it % 512) / 128); const int v = (int)(it % 128);
            float S[64];
#pragma unroll
            for (int i = 0; i < 64; ++i) S[i] = 0.f;
            for (int t = 0; t < P.T; ++t) {
                const long n = (long)b * P.T + t;
                const bf16_t* q = P.p16 + n * PLD + C_GLA + h * 64;
                const bf16_t* k = q + 256;
                const float vv = PF(n, C_GLA + 512 + h * 128 + v);
                const float* al = scr + N * SO_ALPHA + n * 256 + h * 64;
                float o = 0.f;
#pragma unroll
                for (int i = 0; i < 64; ++i) {
                    S[i] = S[i] * al[i] + bf2f(k[i]) * vv;
                    o += bf2f(q[i]) * S[i];
                }
                scr[N * SO_GO + n * 512 + h * 128 + v] = o * 0.125f;
            }
        } break;
        case ST_GLA_POST: {
            const long n = it / 4; const int h = (int)(it % 4);
            const float* o = scr + N * SO_GO + n * 512 + h * 128;
            float ms = 0.f;
            for (int i = 0; i < 128; ++i) ms += o[i] * o[i];
            const float rs = 1.0f / sqrtf(ms * (1.0f / 128) + 1e-6f);
            for (int i = 0; i < 128; ++i) {
                const float g = PF(n, C_GLA + 1024 + h * 128 + i);
                P.mix16[n * DM + 512 + h * 128 + i] = f2bf(o[i] * rs * P.gla_norm[l * 128 + i] * siluf_(g));
            }
        } break;
        case ST_LRU_C0: {
            const long n = it / 512; const int c = (int)(it % 512);
            const int t = (int)(n % P.T);
            float s = P.lru_conv_b[l * 512 + c];
            for (int j = 0; j < 4; ++j) {
                const int tt = t - 3 + j;
                if (tt >= 0) s += P.lru_conv_w[(long)l * 4 * 512 + j * 512 + c] * PF(n - 3 + j, C_LRU + c);
            }
            scr[N * SO_XC + it] = s;
        } break;
        case ST_LRU_C1: {
            const long n = it / 512; const int c = (int)(it % 512);
            const int blk = c / 64, j = c % 64;
            const float* xc = scr + N * SO_XC + n * 512 + blk * 64;
            const float* wr = P.lru_w_r + (long)l * 8 * 64 * 64 + (long)blk * 64 * 64 + j;
            const float* wi = P.lru_w_i + (long)l * 8 * 64 * 64 + (long)blk * 64 * 64 + j;
            float sr = P.lru_b_r[l * 512 + c], si = P.lru_b_i[l * 512 + c];
            for (int i = 0; i < 64; ++i) { sr += xc[i] * wr[i * 64]; si += xc[i] * wi[i * 64]; }
            const float r = sigmoidf_(sr), ig = sigmoidf_(si);
            const float log_a = -8.0f * r * softplusf_(-P.lru_lam[l * 512 + c]);
            scr[N * SO_LA + it] = expf(log_a);
            scr[N * SO_LU + it] = scr[N * SO_XC + it] * ig * sqrtf(-expm1f(2.0f * log_a));
        } break;
        case ST_LRU_SCAN: {
            const int b = (int)(it / 512); const int c = (int)(it % 512);
            float hst = 0.f;
            for (int t = 0; t < P.T; ++t) {
                const long n = (long)b * P.T + t;
                hst = scr[N * SO_LA + n * 512 + c] * hst + scr[N * SO_LU + n * 512 + c];
                P.mix16[n * DM + 1024 + c] = f2bf(hst * geluf_(PF(n, C_LRU + 512 + c)));
            }
        } break;
        case ST_GDN_D0: {
            const long n = it / 1536; const int c = (int)(it % 1536);
            const int t = (int)(n % P.T);
            float s = 0.f;
            for (int j = 0; j < 4; ++j) {
                const int tt = t - 3 + j;
                if (tt >= 0) s += P.gdn_conv_w[(long)l * 4 * 1536 + j * 1536 + c] * PF(n - 3 + j, C_GDN + c);
            }
            scr[N * SO_QKV + it] = siluf_(s);
        } break;
        case ST_GDN_D1: {
            const long n = it / 4; const int h = (int)(it % 4);
            const float* q = scr + N * SO_QKV + n * 1536 + h * 128;
            const float* k = q + 512;
            float qs = 0.f, ks = 0.f;
            for (int i = 0; i < 128; ++i) { qs += q[i] * q[i]; ks += k[i] * k[i]; }
            float* gs = scr + N * SO_GS + n * 16 + h * 4;
            gs[0] = (1.0f / sqrtf(qs + 1e-6f)) * 0.08838834764831845f;
            gs[1] = 1.0f / sqrtf(ks + 1e-6f);
            gs[2] = sigmoidf_(PF(n, C_GDN + 2048 + h));
            gs[3] = expf(-expf(P.gdn_a_log[l * 4 + h]) * softplusf_(PF(n, C_GDN + 2052 + h) + P.gdn_dt_bias[l * 4 + h]));
        } break;
        case ST_GDN_SCAN: {
            const int b = (int)(it / 512); const int h = (int)((it % 512) / 128); const int v = (int)(it % 128);
            float S[128];
#pragma unroll
            for (int i = 0; i < 128; ++i) S[i] = 0.f;
            for (int t = 0; t < P.T; ++t) {
                const long n = (long)b * P.T + t;
                const float* q = scr + N * SO_QKV + n * 1536 + h * 128;
                const float* k = q + 512;
                const float vv = scr[N * SO_QKV + n * 1536 + 1024 + h * 128 + v];
                const float* gs = scr + N * SO_GS + n * 16 + h * 4;
                const float qinv = gs[0], kinv = gs[1], beta = gs[2], eg = gs[3];
                float dk = 0.f;
#pragma unroll
                for (int i = 0; i < 128; ++i) dk += S[i] * k[i];
                const float u = beta * (vv - eg * kinv * dk) * kinv;
                float o = 0.f;
#pragma unroll
                for (int i = 0; i < 128; ++i) {
                    S[i] = S[i] * eg + u * k[i];
                    o += S[i] * q[i];
                }
                scr[N * SO_DO + n * 512 + h * 128 + v] = o * qinv;
            }
        } break;
        case ST_GDN_POST: {
            const long n = it / 4; const int h = (int)(it % 4);
            const float* o = scr + N * SO_DO + n * 512 + h * 128;
            float ms = 0.f;
            for (int i = 0; i < 128; ++i) ms += o[i] * o[i];
            const float rs = 1.0f / sqrtf(ms * (1.0f / 128) + 1e-6f);
            for (int i = 0; i < 128; ++i) {
                const float z = PF(n, C_GDN + 1536 + h * 128 + i);
                P.mix16[n * DM + 1536 + h * 128 + i] = f2bf(o[i] * rs * P.gdn_norm[l * 128 + i] * siluf_(z));
            }
        } break;
        case ST_SCORES: {
            const long n = it / 2048; const int c = (int)(it % 2048);
            const int hp = c / 128, key = c % 128;
            const float* q = P.qf + n * DM + hp * 128;
            const float* sk = P.peer_sub_keys + (long)l * 16 * 128 * 128 + ((long)hp * 128 + key) * 128;
            float s = 0.f;
            for (int d = 0; d < 128; ++d) s += q[d] * sk[d];
            P.sc[it] = s;
        } break;
        case ST_TOPK1: {
            const float* sc = P.sc + it * 128;
            float ts[16]; int ti[16];
#pragma unroll
            for (int j = 0; j < 16; ++j) { ts[j] = -3.0e38f; ti[j] = 0; }
            for (int i = 0; i < 128; ++i) {
                float xv = sc[i]; int xi = i;
                if (xv > ts[15]) {
#pragma unroll
                    for (int j = 0; j < 16; ++j) {
                        if (xv > ts[j]) { const float tv = ts[j]; const int tj = ti[j]; ts[j] = xv; ti[j] = xi; xv = tv; xi = tj; }
                    }
                }
            }
            float* TS = scr + N * SO_TS + it * 16;
            int* TI = (int*)(scr + N * SO_TI) + it * 16;
#pragma unroll
            for (int j = 0; j < 16; ++j) { TS[j] = ts[j]; TI[j] = ti[j]; }
        } break;
        case ST_TOPK2: {
            const float* s0 = scr + N * SO_TS + it * 32;
            const float* s1 = s0 + 16;
            const int* i0 = (const int*)(scr + N * SO_TI) + it * 32;
            const int* i1 = i0 + 16;
            float ts[16]; int ti[16];
#pragma unroll
            for (int j = 0; j < 16; ++j) { ts[j] = -3.0e38f; ti[j] = 0; }
            for (int a = 0; a < 16; ++a) {
                const int jmax = 16 / (a + 1);
                for (int b = 0; b < jmax; ++b) {
                    float xv = s0[a] + s1[b]; int xi = i0[a] * 128 + i1[b];
                    if (xv > ts[15]) {
#pragma unroll
                        for (int j = 0; j < 16; ++j) {
                            if (xv > ts[j]) { const float tv = ts[j]; const int tj = ti[j]; ts[j] = xv; ti[j] = xi; xv = tv; xi = tj; }
                        }
                    }
                }
            }
            const float mx = ts[0];
            float den = 0.f;
#pragma unroll
            for (int j = 0; j < 16; ++j) { ts[j] = expf(ts[j] - mx); den += ts[j]; }
            const float inv = 1.0f / den;
#pragma unroll
            for (int j = 0; j < 16; ++j) { P.gate[it * 16 + j] = ts[j] * inv; P.idx[it * 16 + j] = ti[j]; }
        } break;
        case ST_PEER_U: {
            const long n = it / 128;
            const int e = P.idx[it];
            const float* u = P.peer_u + ((long)l * NEXP + e) * DM;
            const bf16_t* hx = P.hb + n * DM;
            float s = 0.f;
            for (int d = 0; d < DM; ++d) s += bf2f(hx[d]) * u[d];
            P.act[it] = geluf_(s) * P.gate[it];
        } break;
        case ST_PEER_V: {
            const long n = it / DM; const int d = (int)(it % DM);
            const float* a = P.act + n * 128;
            const int* ix = P.idx + n * 128;
            float s = 0.f;
            for (int j = 0; j < 128; ++j) s += a[j] * P.peer_v[((long)l * NEXP + ix[j]) * DM + d];
            P.xcur[it] += s;
        } break;
    }
}


struct WsMap {
    size_t ctl, w1t, w2t, wsct, auxwt, lruwt, vreswt, pp, tabu, tabv, tsc, xn, hb, mix16, p16, sc, aux, vfirst, idx, gate, rstd, act, end;
    size_t auxA, zrkv, xc, auxo, gates, vres, glao, gdno, gq, gk, gv, gsc, rwy, rwbv, lrs, gblob, glas, gladv;
    size_t scr, qf;
};
HD WsMap ws_map(size_t N) {
    WsMap m{};
    size_t o = 0;
    auto take = [&](size_t bytes) { size_t r = o; o += (bytes + 4095) & ~(size_t)4095; return r; };
    m.ctl = take(1u << 20);
    m.w1t = take((size_t)NL * PLD * DM * 2);
    m.w2t = take((size_t)NL * DM * DM * 2);
    m.wsct = take((size_t)NL * DM * DM * 2);
    m.auxwt = take((size_t)NL * 1792 * 384 * 2);
    m.lruwt = take((size_t)NL * 1024 * 512 * 2);
    m.vreswt = take((size_t)512 * 512 * 2);
    m.pp = take(1u << 20);
    m.xn = take(N * DM * 2);
    m.hb = take(N * DM * 2);
    m.mix16 = take(N * DM * 2);
    m.p16 = take(N * PLD * 2);
    m.sc = m.p16;
    m.vfirst = take(N * 512 * 4);
    m.idx = take(N * 128 * 4);
    m.gate = take(N * 128 * 4);
    m.act = take(N * 128 * 4);
    m.rstd = take(N * 4);
    m.tabu = take((size_t)NL * 2 * NEXP * 1024);
    m.tabv = m.tabu + (size_t)NEXP * 1024;
    m.tsc = take((size_t)NL * 2 * NEXP * 4);
    m.aux = take(N * 5888 * 4);
    m.end = o;
    size_t a = m.aux;
    auto sub = [&](size_t bytes) { size_t r = a; a += (bytes + 4095) & ~(size_t)4095; return r; };
    m.auxA = sub(N * 384 * 2); m.zrkv = sub(N * 1536 * 2); m.xc = sub(N * 512 * 2); m.auxo = sub(N * 1792 * 2);
    m.gates = sub(N * 1024 * 2); m.vres = sub(N * 512 * 2); m.glao = sub(N * 512 * 2); m.gdno = sub(N * 512 * 2);
    m.gq = sub(N * 512 * 2); m.gk = sub(N * 512 * 2); m.gv = sub(N * 512 * 2); m.gsc = sub(N * 8 * 4); m.rwy = sub(N * 512 * 2); m.rwbv = sub(N * 512 * 2); m.lrs = sub(N / 64 * 512 * 2 * 4);
    m.gblob = sub(N / 64 * 4 * 26880);
    m.glas = sub(N / 64 * 4 * 8192 * 2); m.gladv = sub(N / 64 * 4 * 64 * 4);
    m.scr = m.tabu;
    m.qf = m.aux + N * 3584 * 4;
    return m;
}
static inline void bind_ws(Params& P, char* ws) {
    const WsMap m = ws_map((size_t)P.N);
    P.xn = (bf16_t*)(ws + m.xn); P.hb = (bf16_t*)(ws + m.hb); P.mix16 = (bf16_t*)(ws + m.mix16); P.p16 = (bf16_t*)(ws + m.p16);
    P.sc = (float*)(ws + m.sc); P.qf = (float*)(ws + m.qf); P.rstd = (float*)(ws + m.rstd); P.vfirst = (float*)(ws + m.vfirst);
    P.scr = (float*)(ws + m.scr); P.act = (float*)(ws + m.act); P.gate = (float*)(ws + m.gate); P.idx = (int*)(ws + m.idx);
}

struct Step { int st, l; };
static inline int build_schedule(Step* s) {
    int n = 0;
    s[n++] = {ST_COPYX, 0};
    for (int l = 0; l < NL; ++l) {
        static const int per_layer[] = {ST_RSTD, ST_NORM1, ST_GEMM1,
            ST_RW_A0, ST_RW_A1, ST_RW_A2, ST_RW_A3, ST_RW_KKN, ST_RW_SCAN, ST_RW_POST,
            ST_GLA_B0, ST_GLA_SCAN, ST_GLA_POST, ST_LRU_C0, ST_LRU_C1, ST_LRU_SCAN,
            ST_GDN_D0, ST_GDN_D1, ST_GDN_SCAN, ST_GDN_POST,
            ST_GEMM2, ST_RSTD2, ST_NORM2, ST_GEMM3, ST_SCORES, ST_TOPK1, ST_TOPK2, ST_PEER_U, ST_PEER_V};
        for (int i = 0; i < (int)(sizeof(per_layer) / sizeof(int)); ++i) s[n++] = {per_layer[i], l};
    }
    s[n++] = {ST_FRSTD, 0};
    s[n++] = {ST_FNORM, 0};
    return n;
}

static inline void fill_inputs(Params& P, void* const* d_in) {
    const float** dst = (const float**)&P;
    for (int i = 0; i < 38; ++i) dst[i] = (const float*)d_in[i];
}

#ifndef HOST_EMU
#define GAS __attribute__((address_space(1)))
#define LAS __attribute__((address_space(3)))
typedef unsigned v4u __attribute__((ext_vector_type(4)));
typedef unsigned v2u __attribute__((ext_vector_type(2)));
typedef float f32x4 __attribute__((ext_vector_type(4)));
typedef float f32x2 __attribute__((ext_vector_type(2)));
typedef short bf16x8 __attribute__((ext_vector_type(8)));
constexpr int NWAVES = 8, NTHR = 512;
constexpr int RING_BYTES = 131072, MISC_OFF = RING_BYTES + 320, LDS_BYTES = 147456;
constexpr int NTOK = 16384, TSEQ = 4096, NBATCH = 4;

__device__ __forceinline__ unsigned pk2(float lo, float hi) { return (unsigned)f2bf(lo) | ((unsigned)f2bf(hi) << 16); }
__device__ __forceinline__ float bflo(unsigned u) { return __builtin_bit_cast(float, u << 16); }
__device__ __forceinline__ float bfhi(unsigned u) { return __builtin_bit_cast(float, u & 0xffff0000u); }
__device__ __forceinline__ float wave_sum(float v) {
#pragma unroll
    for (int o = 1; o < 64; o <<= 1) v += __shfl_xor(v, o);
    return v;
}
#define LDS_WAIT() asm volatile("s_waitcnt lgkmcnt(0)" ::: "memory")
#define VM_WAIT() asm volatile("s_waitcnt vmcnt(0)" ::: "memory")

namespace pg8 {
#define PG8_LAS __attribute__((address_space(3)))
constexpr int BM = 256, BK = 64, HALF = 128, HTB = HALF * BK * 2, STAGE_BYTES = 8 * HTB, NXCD = 8, WGM = 8;
__host__ __device__ __forceinline__ int lds_byte(int r, int c) { const int st = (r >> 4) * 2 + (c >> 5), rr = r & 15, cc = c & 31, ob = rr * 64 + cc * 2; return st * 1024 + (ob ^ (((ob >> 9) & 1) << 5)); }
__host__ __device__ __forceinline__ void stage_rc(int b, int& R, int& C) { const int st = b / 1024, sb = b % 1024, swz = sb ^ (((sb >> 9) & 1) << 5); R = (st >> 1) * 16 + swz / 64; C = (st & 1) * 32 + (swz % 64) / 2; }
__host__ __device__ __forceinline__ int perm32(int rho) { const int n = rho >> 4, i = rho & 15; return 8 * (i >> 2) + 4 * n + (i & 3); }
struct Unit { int pm, pn; };
struct GemmX { const bf16_t* A; const bf16_t* Bt; int M, N, K, lda; };
struct StaticOrder {
    int nM, nN, nwg, G, c;
    __host__ __device__ void init(int M, int N, int G_, int c_) { nM = M / BM; nN = N / BM; nwg = nM * nN; G = G_; c = c_; }
    __host__ __device__ bool next(int i, Unit& u) const {
        const long L = (long)i * G + c; if (L >= nwg) return false;
        int wgid = (int)L; { const int q = nwg / NXCD, r = nwg % NXCD, xcd = wgid % NXCD, off = wgid / NXCD; wgid = (xcd < r ? xcd * (q + 1) : r * (q + 1) + (xcd - r) * q) + off; }
        const int nig = WGM * nN, gid = wgid / nig, fm = gid * WGM, gsz = (nM - fm) < WGM ? (nM - fm) : WGM;
        u.pm = fm + ((wgid % nig) % gsz); u.pn = (wgid % nig) / gsz; return true;
    }
    __device__ __forceinline__ void a_ready(const Unit&) const {}
    __device__ __forceinline__ void done(const Unit&) const {}
};
__device__ __forceinline__ unsigned cvt_pk_bf16(float lo, float hi) { unsigned r; asm volatile("v_cvt_pk_bf16_f32 %0, %1, %2" : "=v"(r) : "v"(lo), "v"(hi)); return r; }
template <bool ACCUM> struct EpiF32 {
    static constexpr bool PERM = false, AFTER_DRAIN = false;
    float* C; int ldc;
    __device__ __forceinline__ void operator()(const f32x4 (&acc)[2][2][4][2], const Unit& u, int wr, int wc, int fr, int fq) const {
        const int row0 = u.pm * BM + wr * 64 + fr, col0 = u.pn * BM + wc * 32 + 4 * fq;
#pragma unroll
        for (int ai = 0; ai < 2; ++ai)
#pragma unroll
            for (int m = 0; m < 4; ++m) { float* rowp = C + (size_t)(row0 + ai * HALF + m * 16) * ldc + col0;
#pragma unroll
                for (int bj = 0; bj < 2; ++bj)
#pragma unroll
                    for (int n = 0; n < 2; ++n) { f32x4* p = (f32x4*)(rowp + bj * HALF + n * 16);
                        if (ACCUM) *p = *p + acc[ai][bj][m][n]; else *p = acc[ai][bj][m][n]; } }
    }
};
struct EpiBf16 {
    static constexpr bool PERM = true, AFTER_DRAIN = false;
    bf16_t* O; int ldc; const float* bias;
    __device__ __forceinline__ void operator()(const f32x4 (&acc)[2][2][4][2], const Unit& u, int wr, int wc, int fr, int fq) const {
        const int row0 = u.pm * BM + wr * 64 + fr; const int col0 = u.pn * BM + wc * 32 + 8 * fq;
        f32x4 bv[2][2];
#pragma unroll
        for (int bj = 0; bj < 2; ++bj)
#pragma unroll
            for (int n = 0; n < 2; ++n) bv[bj][n] = bias ? *(const f32x4*)(bias + col0 + bj * HALF + 4 * n) : (f32x4){0.f, 0.f, 0.f, 0.f};
#pragma unroll
        for (int ai = 0; ai < 2; ++ai)
#pragma unroll
            for (int m = 0; m < 4; ++m) { bf16_t* rowp = O + (size_t)(row0 + ai * HALF + m * 16) * ldc + col0;
#pragma unroll
                for (int bj = 0; bj < 2; ++bj) { const f32x4 v0 = acc[ai][bj][m][0] + bv[bj][0], v1 = acc[ai][bj][m][1] + bv[bj][1];
                    v4u w; w.x = cvt_pk_bf16(v0[0], v0[1]); w.y = cvt_pk_bf16(v0[2], v0[3]); w.z = cvt_pk_bf16(v1[0], v1[1]); w.w = cvt_pk_bf16(v1[2], v1[3]);
                    *(v4u*)(rowp + bj * HALF) = w; } }
    }
};
template <class Epi, class Sched, bool ALIGN_EPI = false, bool SP2 = false>
__device__ __forceinline__ void gemm_phase(PG8_LAS unsigned char* lds, const GemmX g, const Sched& S, const Epi& E) {
    const int tid = threadIdx.x, wid = __builtin_amdgcn_readfirstlane(tid >> 6), lane = tid & 63, wr = wid >> 2, wc = wid & 3, fr = lane & 15, fq = lane >> 4;
    const int K = g.K, nt = K / BK;
    unsigned voffA[2], voffB[2];
#pragma unroll
    for (int i = 0; i < 2; ++i) { int R, C; stage_rc(tid * 16 + i * 8192, R, C); const int Rb = Epi::PERM ? ((R & ~31) + perm32(R & 31)) : R;
        voffA[i] = (unsigned)(R * g.lda + C) * 2u; voffB[i] = (unsigned)(Rb * K + C) * 2u; }
    const size_t kstep = (size_t)(BK * 2);
    const size_t hstep = (size_t)HALF * K * 2;
    const size_t tstep = 2 * hstep;
    const size_t hstepA = (size_t)HALF * g.lda * 2, tstepA = 2 * hstepA;
    const unsigned ldsw = (unsigned)wid * 1024u;
    const int aoff = lds_byte(wr * 64 + fr, fq * 8), boff = lds_byte(wc * 32 + fr, fq * 8);
#define PG8_SA(b, h) (((b) * 2 + (h)) * HTB)
#define PG8_SB(b, h) ((4 + (b) * 2 + (h)) * HTB)
#define PG8_STAGE(bufoff, gbase, voff) do { _Pragma("unroll") for (int _i = 0; _i < 2; ++_i) \
        __builtin_amdgcn_global_load_lds((const unsigned*)((const char*)(gbase) + (voff)[_i]), (PG8_LAS unsigned*)(lds + (bufoff) + ldsw + _i * 8192), 16, 0, 0); } while (0)
#define PG8_LDA(dst, b, h) do { _Pragma("unroll") for (int m = 0; m < 4; ++m) _Pragma("unroll") for (int k = 0; k < 2; ++k) dst[m][k] = *(const PG8_LAS bf16x8*)(lds + PG8_SA(b, h) + aoff + m * 2048 + k * 1024); } while (0)
#define PG8_LDB(dst, b, h) do { _Pragma("unroll") for (int n = 0; n < 2; ++n) _Pragma("unroll") for (int k = 0; k < 2; ++k) dst[n][k] = *(const PG8_LAS bf16x8*)(lds + PG8_SB(b, h) + boff + n * 2048 + k * 1024); } while (0)
#define PG8_MMA(ai, bj, At, Bt) do { __builtin_amdgcn_s_setprio(1); _Pragma("unroll") for (int m = 0; m < 4; ++m) _Pragma("unroll") for (int n = 0; n < 2; ++n) _Pragma("unroll") for (int k = 0; k < 2; ++k) \
        acc[ai][bj][m][n] = __builtin_amdgcn_mfma_f32_16x16x32_bf16(Bt[n][k], At[m][k], acc[ai][bj][m][n], 0, 0, 0); __builtin_amdgcn_s_setprio(0); } while (0)
#define PG8_WAIT_V(n) asm volatile("s_waitcnt vmcnt(" #n ")" ::: "memory")
#define PG8_WAIT_L(n) asm volatile("s_waitcnt lgkmcnt(" #n ")" ::: "memory")
#define PG8_BAR __builtin_amdgcn_s_barrier()
#define PG8_SCHED __builtin_amdgcn_sched_barrier(0)
    Unit cur, nxt; int ui = 0;
    if (!S.next(0, cur)) return;
    f32x4 acc[2][2][4][2];
#pragma unroll
    for (int a = 0; a < 2; ++a)
#pragma unroll
        for (int b = 0; b < 2; ++b)
#pragma unroll
            for (int m = 0; m < 4; ++m)
#pragma unroll
                for (int n = 0; n < 2; ++n) acc[a][b][m][n] = (f32x4){0.f, 0.f, 0.f, 0.f};
    bf16x8 At[4][2], B0[2][2], B1[2][2];
    const char* cA = (const char*)g.A + (size_t)cur.pm * tstepA; const char* cB = (const char*)g.Bt + (size_t)cur.pn * tstep;
    S.a_ready(cur);
    if constexpr (SP2) {
        PG8_STAGE(PG8_SB(0, 0), cB, voffB); PG8_STAGE(PG8_SB(0, 1), cB + hstep, voffB); PG8_STAGE(PG8_SA(0, 0), cA, voffA); PG8_STAGE(PG8_SA(0, 1), cA + hstepA, voffA);
        if (wr == 1) PG8_BAR;
        PG8_WAIT_V(2); PG8_BAR;
        PG8_STAGE(PG8_SB(1, 0), cB + kstep, voffB); PG8_STAGE(PG8_SA(1, 0), cA + kstep, voffA); PG8_STAGE(PG8_SB(1, 1), cB + hstep + kstep, voffB);
        PG8_WAIT_V(6); PG8_BAR;
    } else {
        PG8_STAGE(PG8_SB(0, 0), cB, voffB); PG8_STAGE(PG8_SA(0, 0), cA, voffA); PG8_STAGE(PG8_SB(0, 1), cB + hstep, voffB); PG8_STAGE(PG8_SA(0, 1), cA + hstepA, voffA);
        if (wr == 1) PG8_BAR;
        PG8_WAIT_V(4); PG8_BAR;
        PG8_STAGE(PG8_SB(1, 0), cB + kstep, voffB); PG8_STAGE(PG8_SA(1, 0), cA + kstep, voffA); PG8_STAGE(PG8_SB(1, 1), cB + hstep + kstep, voffB);
        PG8_WAIT_V(6); PG8_BAR;
    }
    for (;;) {
        const bool has_next = S.next(ui + 1, nxt);
        const char* nA = has_next ? (const char*)g.A + (size_t)nxt.pm * tstepA : cA; const char* nB = has_next ? (const char*)g.Bt + (size_t)nxt.pn * tstep : cB;
        for (int t = 0; t < nt; t += 2) {
            const bool last = (t == nt - 2);
            const char* a1 = cA + (size_t)(t + 1) * kstep;
            const char* a2 = last ? nA : cA + (size_t)(t + 2) * kstep; const char* b2 = last ? nB : cB + (size_t)(t + 2) * kstep;
            const char* a3 = a2 + kstep; const char* b3 = b2 + kstep;
            if (last && has_next) S.a_ready(nxt);
            if constexpr (SP2) {
            PG8_LDB(B0, 0, 0); PG8_LDB(B1, 0, 1); PG8_SCHED; PG8_LDA(At, 0, 0); PG8_STAGE(PG8_SA(1, 1), a1 + hstepA, voffA);
            PG8_WAIT_V(8); PG8_WAIT_L(0); PG8_BAR; PG8_MMA(0, 0, At, B0); PG8_MMA(0, 1, At, B1); PG8_BAR; PG8_SCHED;
            PG8_LDA(At, 0, 1); PG8_STAGE(PG8_SB(0, 0), b2, voffB); PG8_STAGE(PG8_SB(0, 1), b2 + hstep, voffB); PG8_STAGE(PG8_SA(0, 0), a2, voffA);
            PG8_WAIT_V(8); PG8_WAIT_L(0); PG8_BAR; PG8_MMA(1, 0, At, B0); PG8_MMA(1, 1, At, B1); PG8_BAR; PG8_SCHED;
            PG8_LDB(B0, 1, 0); PG8_LDB(B1, 1, 1); PG8_SCHED; PG8_LDA(At, 1, 0); PG8_STAGE(PG8_SA(0, 1), a2 + hstepA, voffA);
            PG8_WAIT_V(8); PG8_WAIT_L(0); PG8_BAR; PG8_MMA(0, 0, At, B0); PG8_MMA(0, 1, At, B1); PG8_BAR; PG8_SCHED;
            PG8_LDA(At, 1, 1); PG8_STAGE(PG8_SB(1, 0), b3, voffB); PG8_STAGE(PG8_SB(1, 1), b3 + hstep, voffB); PG8_STAGE(PG8_SA(1, 0), a3, voffA);
            PG8_WAIT_V(8); PG8_WAIT_L(0); PG8_BAR; PG8_MMA(1, 0, At, B0); PG8_MMA(1, 1, At, B1); PG8_BAR; PG8_SCHED;
            } else {
            PG8_LDB(B0, 0, 0); PG8_SCHED; PG8_LDA(At, 0, 0); PG8_STAGE(PG8_SA(1, 1), a1 + hstepA, voffA);
            PG8_WAIT_L(8); PG8_BAR; PG8_WAIT_L(0); PG8_MMA(0, 0, At, B0); PG8_BAR; PG8_SCHED;
            PG8_LDB(B1, 0, 1); PG8_STAGE(PG8_SB(0, 0), b2, voffB);
            PG8_BAR; PG8_WAIT_L(0); PG8_MMA(0, 1, At, B1); PG8_BAR;
            PG8_LDA(At, 0, 1); PG8_STAGE(PG8_SA(0, 0), a2, voffA);
            PG8_BAR; PG8_WAIT_L(0); PG8_MMA(1, 0, At, B0); PG8_BAR; PG8_SCHED;
            PG8_STAGE(PG8_SB(0, 1), b2 + hstep, voffB);
            PG8_WAIT_V(6); PG8_BAR; PG8_MMA(1, 1, At, B1); PG8_BAR;
            PG8_LDB(B0, 1, 0); PG8_SCHED; PG8_LDA(At, 1, 0); PG8_STAGE(PG8_SA(0, 1), a2 + hstepA, voffA);
            PG8_WAIT_L(8); PG8_BAR; PG8_WAIT_L(0); PG8_MMA(0, 0, At, B0); PG8_BAR; PG8_SCHED;
            PG8_LDB(B1, 1, 1); PG8_STAGE(PG8_SB(1, 0), b3, voffB);
            PG8_BAR; PG8_WAIT_L(0); PG8_MMA(0, 1, At, B1); PG8_BAR;
            PG8_LDA(At, 1, 1); PG8_STAGE(PG8_SA(1, 0), a3, voffA);
            PG8_BAR; PG8_WAIT_L(0); PG8_MMA(1, 0, At, B0); PG8_BAR; PG8_SCHED;
            PG8_STAGE(PG8_SB(1, 1), b3 + hstep, voffB);
            PG8_WAIT_V(6); PG8_BAR; PG8_MMA(1, 1, At, B1); PG8_BAR;
            }
        }
        if constexpr (ALIGN_EPI) { if (wr == 0) PG8_BAR; }
        if constexpr (!Epi::AFTER_DRAIN) { E(acc, cur, wr, wc, fr, fq); S.done(cur); }
        if (!has_next) break;
#pragma unroll
        for (int a = 0; a < 2; ++a)
#pragma unroll
            for (int b = 0; b < 2; ++b)
#pragma unroll
                for (int m = 0; m < 4; ++m)
#pragma unroll
                    for (int n = 0; n < 2; ++n) acc[a][b][m][n] = (f32x4){0.f, 0.f, 0.f, 0.f};
        cur = nxt; cA = nA; cB = nB; ++ui;
        if constexpr (ALIGN_EPI) { if (wr == 1) PG8_BAR; }
    }
    PG8_WAIT_V(0);
    if constexpr (!ALIGN_EPI) { if (wr == 0) PG8_BAR; }
    PG8_BAR;
    if constexpr (Epi::AFTER_DRAIN) { E.fused(acc, cur, wr, wc, fr, fq, lds, wid, lane); S.done(cur); }
#undef PG8_SA
#undef PG8_SB
#undef PG8_STAGE
#undef PG8_LDA
#undef PG8_LDB
#undef PG8_MMA
#undef PG8_WAIT_V
#undef PG8_WAIT_L
#undef PG8_BAR
#undef PG8_SCHED
}
}

#define XB_TMO      128
#define XB_XCNT(j)  (256  + 64 * (j))
#define XB_XSUB(j)  (1280 + 64 * (j))
#define XB_XGEN(j)  (2304 + 64 * (j))
#define XB_TOP      3328
#define XB_TOPGEN   3392
#define XCD_BAR_WORDS 3456
#define XB_SPIN_CAP (1u << 20)
__device__ __forceinline__ unsigned xb_ld(unsigned* p) { return __hip_atomic_load(p, __ATOMIC_RELAXED, __HIP_MEMORY_SCOPE_AGENT); }
__device__ __forceinline__ unsigned xb_add(unsigned* p, unsigned v) { return __hip_atomic_fetch_add(p, v, __ATOMIC_RELAXED, __HIP_MEMORY_SCOPE_AGENT); }
__device__ __forceinline__ unsigned xb_xcc_id() { return (unsigned)__builtin_amdgcn_s_getreg((3 << 11) | 20) & 0xFu; }
#define XB_SPIN(cond, bar) do { unsigned _sp = 0; while (cond) { __builtin_amdgcn_s_sleep(1); \
    if ((++_sp & 255u) == 0u) { if (xb_ld(&(bar)[XB_TMO])) break; if (_sp > XB_SPIN_CAP) { atomicAdd(&(bar)[XB_TMO], 1u); break; } } } } while (0)
struct XcdBarrier { unsigned* bar; unsigned x; volatile LAS unsigned* st; };
__device__ __forceinline__ XcdBarrier xcd_barrier_post(unsigned* bar, volatile LAS unsigned* st) {
    XcdBarrier b; b.bar = bar; b.x = xb_xcc_id(); b.st = st;
    if (threadIdx.x == 0) (void)xb_add(&bar[XB_XCNT(b.x)], 1u);
    return b;
}
__device__ __forceinline__ void xcd_barrier_complete(unsigned* bar, unsigned x, unsigned& nloc, unsigned& nx) {
    const unsigned G = gridDim.x * gridDim.y * gridDim.z;
    unsigned sum, cnt, mine, sp = 0u;
    for (;;) {
        sum = 0u; cnt = 0u; mine = 0u;
#pragma unroll
        for (unsigned j = 0; j < 16; ++j) { const unsigned c = xb_ld(&bar[XB_XCNT(j)]); sum += c; cnt += (c > 0u) ? 1u : 0u; mine = (j == x) ? c : mine; }
        if (sum == G) break;
        __builtin_amdgcn_s_sleep(1);
        if ((++sp & 255u) == 0u) { if (xb_ld(&bar[XB_TMO])) break; if (sp > XB_SPIN_CAP) { atomicAdd(&bar[XB_TMO], 1u); break; } }
    }
    nloc = mine > 0u ? mine : 1u; nx = cnt > 0u ? cnt : 1u;
}
__device__ __forceinline__ void xcd_barrier(const XcdBarrier& b) {
    asm volatile("s_waitcnt vmcnt(0)" ::: "memory");
    __syncthreads();
    if (threadIdx.x == 0) {
        unsigned* bar = b.bar;
        __builtin_amdgcn_s_waitcnt(0);
        unsigned nloc = b.st[0], nx = b.st[1];
        if (nloc == 0u) { xcd_barrier_complete(bar, b.x, nloc, nx); b.st[0] = nloc; b.st[1] = nx; }
        const unsigned old = xb_add(&bar[XB_XSUB(b.x)], 1u);
        const unsigned gen = old / nloc;
        if (old + 1u == (gen + 1u) * nloc) {
            __builtin_amdgcn_fence(__ATOMIC_RELEASE, "agent");
            asm volatile("s_waitcnt vmcnt(0)" ::: "memory");
            const unsigned og = xb_add(&bar[XB_TOP], 1u);
            const unsigned tg = og / nx;
            if (og + 1u == (tg + 1u) * nx) xb_add(&bar[XB_TOPGEN], 1u);
            else XB_SPIN(xb_ld(&bar[XB_TOPGEN]) == tg, bar);
            __builtin_amdgcn_fence(__ATOMIC_ACQUIRE, "agent");
            xb_add(&bar[XB_XGEN(b.x)], 1u);
            asm volatile("s_waitcnt vmcnt(0)" ::: "memory");
        } else {
            XB_SPIN(xb_ld(&bar[XB_XGEN(b.x)]) == gen, bar);
            __builtin_amdgcn_fence(__ATOMIC_ACQUIRE, "agent");
            asm volatile("s_waitcnt vmcnt(0)" ::: "memory");
        }
    }
    __syncthreads();
}

struct Args { const float* in[38]; float* out; unsigned char* ws; int ph_lo, ph_hi, li, pad; };
enum InputId { I_X = 0, I_NORM_MIX, I_W_IN, I_W_OUT, I_RW_MU, I_RW_W0, I_RW_W_UP, I_RW_A0, I_RW_A_UP, I_RW_G_UP, I_RW_K_K, I_RW_K_A, I_RW_R_K,
    I_RW_LN_W, I_RW_LN_B, I_RW_V0, I_RW_V_DOWN, I_RW_V_UP, I_GLA_A_UP, I_GLA_A_BIAS, I_GLA_NORM, I_LRU_CONV_W, I_LRU_CONV_B, I_LRU_W_R,
    I_LRU_B_R, I_LRU_W_I, I_LRU_B_I, I_LRU_LAM, I_GDN_CONV_W, I_GDN_A_LOG, I_GDN_DT_BIAS, I_GDN_NORM, I_NORM_FFN, I_PEER_WQ, I_PEER_SK,
    I_PEER_U, I_PEER_V, I_NORM_FINAL };
enum { PH_P0 = 0, PH_GEMM1 = 1, PH_PREP = 2, PH_AUX = 3, PH_SCAN = 4, PH_POST = 5, PH_GEMM2 = 6, PH_NORM2 = 7, PH_GEMM3 = 8, PH_TOPK = 9, PH_PEER = 10, PH_PER_LAYER = 10, PH_TOTAL = 21 };

struct Frame {
    LAS unsigned char* lds;
    int tid, lane, wave, vcu, G;
    int gw, ngw;
};

__device__ __forceinline__ void p0_transpose_item(const float* W, int K, int N, const float* kscale, bf16_t* WT, LAS float* scr, int item, int nblk, int lane) {
    const int kb = item / nblk, nb = item % nblk, k0 = 64 * kb, n0 = 32 * nb;
    const int kr = lane >> 3, n4 = (lane & 7) * 4;
    f32x4 v[8];
#pragma unroll
    for (int i = 0; i < 8; ++i) { const int kk = kr + 8 * i;
        v[i] = (n0 + n4 < N) ? *(const f32x4*)(W + (size_t)(k0 + kk) * N + n0 + n4) : (f32x4){0.f, 0.f, 0.f, 0.f}; }
#pragma unroll
    for (int i = 0; i < 8; ++i) { const int kk = kr + 8 * i; const float s = kscale ? kscale[k0 + kk] : 1.0f;
        scr[kk * 33 + n4 + 0] = v[i].x * s; scr[kk * 33 + n4 + 1] = v[i].y * s; scr[kk * 33 + n4 + 2] = v[i].z * s; scr[kk * 33 + n4 + 3] = v[i].w * s; }
    LDS_WAIT(); asm volatile("" ::: "memory");
    const int c = lane & 7;
#pragma unroll
    for (int j = 0; j < 4; ++j) { const int n = (lane >> 3) + 8 * j; const LAS float* s = scr + (8 * c) * 33 + n;
        v4u o; o.x = pk2(s[0 * 33], s[1 * 33]); o.y = pk2(s[2 * 33], s[3 * 33]); o.z = pk2(s[4 * 33], s[5 * 33]); o.w = pk2(s[6 * 33], s[7 * 33]);
        *(v4u*)(WT + (size_t)(n0 + n) * K + k0 + 8 * c) = o; }
    LDS_WAIT(); asm volatile("" ::: "memory");
}

__device__ __forceinline__ void p0_prologue(const Args& a, Frame& F) {
    const WsMap m = ws_map(NTOK);
    unsigned char* ws = a.ws;
    LAS float* scr = (LAS float*)(F.lds + F.wave * 16384);
    const int gw = F.gw, NGW = F.ngw, lane = F.lane;
    for (int n = gw; n < NTOK; n += NGW) {
        const f32x4* xr = (const f32x4*)(a.in[I_X] + (size_t)n * DM) + lane;
        f32x4 v[8]; float s = 0.f;
#pragma unroll
        for (int j = 0; j < 8; ++j) { v[j] = xr[64 * j]; s += (v[j].x * v[j].x + v[j].y * v[j].y) + (v[j].z * v[j].z + v[j].w * v[j].w); }
        const float rstd = 1.0f / sqrtf(wave_sum(s) * (1.0f / DM) + 1e-6f);
        f32x4* xo = (f32x4*)(a.out + (size_t)n * DM) + lane;
        v2u* o8 = (v2u*)((bf16_t*)(ws + m.xn) + (size_t)n * DM) + lane;
#pragma unroll
        for (int j = 0; j < 8; ++j) { xo[64 * j] = v[j]; v2u w; w.x = pk2(v[j].x * rstd, v[j].y * rstd); w.y = pk2(v[j].z * rstd, v[j].w * rstd); o8[64 * j] = w; }
    }
    {
        constexpr int I1 = (DM / 64) * (PLD / 32), I2 = (DM / 64) * (DM / 32);
        for (int it = gw; it < NL * (I1 + I2); it += NGW) {
            const int l = it / (I1 + I2); int r = it % (I1 + I2);
            if (r < I1) p0_transpose_item(a.in[I_W_IN] + (size_t)l * DM * INC, DM, INC, a.in[I_NORM_MIX] + l * DM, (bf16_t*)(ws + m.w1t) + (size_t)l * PLD * DM, scr, r, PLD / 32, lane);
            else p0_transpose_item(a.in[I_W_OUT] + (size_t)l * DM * DM, DM, DM, nullptr, (bf16_t*)(ws + m.w2t) + (size_t)l * DM * DM, scr, r - I1, DM / 32, lane);
        }
    }
    for (int it = gw; it < NL * 16 * 64; it += NGW) {
        const int l = it / 1024, hp = (it % 1024) / 64, kb = it % 64;
        const int dh = lane & 1, kk = kb * 32 + (lane >> 1);
        const float* wq = a.in[I_PEER_WQ] + (size_t)l * DM * DM + (size_t)kk * DM + hp * 128 + dh * 64;
        const float* sk = a.in[I_PEER_SK] + ((size_t)l * 16 + hp) * 128 * 128;
        f32x4 q[16];
#pragma unroll
        for (int d = 0; d < 16; ++d) q[d] = *(const f32x4*)(wq + 4 * d);
        bf16_t* o = (bf16_t*)(ws + m.wsct) + (size_t)l * DM * DM + (size_t)(hp * 128) * DM + kk;
        f32x4 stg[8];
#pragma unroll
        for (int i = 0; i < 8; ++i) stg[i] = ((const f32x4*)sk)[i * 64 + lane];
#pragma unroll 1
        for (int kc = 0; kc < 8; ++kc) {
#pragma unroll
            for (int i = 0; i < 8; ++i) ((LAS f32x4*)scr)[i * 64 + lane] = stg[i];
            if (kc + 1 < 8) {
#pragma unroll
                for (int i = 0; i < 8; ++i) stg[i] = ((const f32x4*)(sk + (kc + 1) * 2048))[i * 64 + lane]; }
            LDS_WAIT(); asm volatile("" ::: "memory");
#pragma unroll 2
            for (int key = 0; key < 16; ++key) {
                const LAS f32x4* s4 = (const LAS f32x4*)(scr + key * 128 + dh * 64);
                float acc = 0.f;
#pragma unroll
                for (int d = 0; d < 16; ++d) { const f32x4 sv = s4[d]; acc += (q[d].x * sv.x + q[d].y * sv.y) + (q[d].z * sv.z + q[d].w * sv.w); }
                acc += __shfl_xor(acc, 1);
                if (dh == 0) o[(size_t)(kc * 16 + key) * DM] = f2bf(acc);
            }
            LDS_WAIT(); asm volatile("" ::: "memory");
        }
    }
    {
        const int gt = F.vcu * NTHR + F.tid, GT = F.G * NTHR;
        bf16_t* AW = (bf16_t*)(ws + m.auxwt); bf16_t* LW = (bf16_t*)(ws + m.lruwt); bf16_t* VW = (bf16_t*)(ws + m.vreswt); float* PP = (float*)(ws + m.pp);
        for (int it = gt; it < NL * 1792 * 384; it += GT) {
            const int l = it / (1792 * 384), r = it % (1792 * 384), n = r / 384, k = r % 384;
            float v = 0.f;
            if (n < 512) { if (k < 64) v = a.in[I_RW_W_UP][(size_t)l * 64 * 512 + k * 512 + n]; }
            else if (n < 1024) { if (k >= 64 && k < 128) v = a.in[I_RW_A_UP][(size_t)l * 64 * 512 + (k - 64) * 512 + (n - 512)]; }
            else if (n < 1536) { if (k >= 128 && k < 256) v = a.in[I_RW_G_UP][(size_t)l * 128 * 512 + (k - 128) * 512 + (n - 1024)]; }
            else { if (k >= 256 && k < 272) v = a.in[I_GLA_A_UP][(size_t)l * 16 * 256 + (k - 256) * 256 + (n - 1536)]; }
            AW[it] = f2bf(v);
        }
        for (int it = gt; it < NL * 1024 * 512; it += GT) {
            const int l = it / (1024 * 512), r = it % (1024 * 512), n = r / 512, k = r % 512;
            const int nn = n & 511, blk = nn >> 6, j = nn & 63;
            float v = 0.f;
            if ((k >> 6) == blk) v = (n < 512 ? a.in[I_LRU_W_R] : a.in[I_LRU_W_I])[(size_t)l * 8 * 64 * 64 + (size_t)blk * 4096 + (k & 63) * 64 + j];
            LW[it] = f2bf(v);
        }
        for (int it = gt; it < 512 * 512; it += GT) {
            const int n = it / 512, k = it % 512;
            float s = 0.f;
            for (int i = 0; i < 32; ++i) s += a.in[I_RW_V_DOWN][k * 32 + i] * a.in[I_RW_V_UP][i * 512 + n];
            VW[it] = f2bf(s);
        }
        for (int it = gt; it < 6144; it += GT) {
            float v = 0.f;
            if (it < 3584) { const int l = it / 1792, c = it % 1792;
                v = c < 512 ? a.in[I_RW_W0][l * 512 + c] : (c < 1024 ? a.in[I_RW_A0][l * 512 + c - 512] : (c < 1536 ? 0.f : a.in[I_GLA_A_BIAS][l * 256 + c - 1536])); }
            else if (it < 5632) { const int l = (it - 3584) / 1024, c = (it - 3584) % 1024; v = c < 512 ? a.in[I_LRU_B_R][l * 512 + c] : a.in[I_LRU_B_I][l * 512 + c - 512]; }
            else v = a.in[I_RW_V0][it - 5632];
            PP[it] = v;
        }
    }
}

__device__ __forceinline__ unsigned pk4_fp8(float a, float b, float c, float d) {
    int w = 0;
    w = __builtin_amdgcn_cvt_pk_fp8_f32(__builtin_fmaxf(__builtin_fminf(a, 448.f), -448.f), __builtin_fmaxf(__builtin_fminf(b, 448.f), -448.f), w, false);
    w = __builtin_amdgcn_cvt_pk_fp8_f32(__builtin_fmaxf(__builtin_fminf(c, 448.f), -448.f), __builtin_fmaxf(__builtin_fminf(d, 448.f), -448.f), w, true);
    return (unsigned)w;
}
typedef float v32f __attribute__((ext_vector_type(32)));
constexpr size_t TROW = 1024;
__device__ __forceinline__ float clamp6(float x) { return __builtin_fmaxf(__builtin_fminf(x, 6.0f), -6.0f); }

template <int CTRL> __device__ __forceinline__ float dpp_f(float v) { return __builtin_bit_cast(float, __builtin_amdgcn_update_dpp(0, __builtin_bit_cast(int, v), CTRL, 0xF, 0xF, true)); }
__device__ __forceinline__ float rdlane_f(float v, int l) { return __builtin_bit_cast(float, __builtin_amdgcn_readlane(__builtin_bit_cast(int, v), l)); }
__device__ __forceinline__ float row16_sum(float v) {
    v += dpp_f<0xB1>(v); v += dpp_f<0x4E>(v); v += dpp_f<0x141>(v); v += dpp_f<0x140>(v); return v;
}
__device__ __forceinline__ float wave_sum_u(float v) {
    v = row16_sum(v);
    return (rdlane_f(v, 0) + rdlane_f(v, 16)) + (rdlane_f(v, 32) + rdlane_f(v, 48));
}
typedef __bf16 bf16x2_t __attribute__((ext_vector_type(2)));
__device__ __forceinline__ float dot2bf(unsigned w, unsigned x, float acc) { return __builtin_amdgcn_fdot2_f32_bf16(__builtin_bit_cast(bf16x2_t, w), __builtin_bit_cast(bf16x2_t, x), acc, false); }
__device__ __forceinline__ void tables_range(const Args& a, Frame& F, size_t it0, size_t it1, int sub, int nsub) {
    const WsMap m = ws_map(NTOK);
    const size_t per = (size_t)NEXP * DM / 32;
    const size_t stride = (size_t)nsub * NTHR;
    float* tsc = (float*)(a.ws + m.tsc);
    for (size_t base = it0 + (size_t)sub * NTHR + F.tid; base < it1; base += 2 * stride) {
        f32x4 v[2][8];
#pragma unroll
        for (int u = 0; u < 2; ++u) { const size_t it = base + u * stride;
            if (it < it1) { const int tb = (int)(it / per); const size_t r = it % per;
                const f32x4* srcp = (const f32x4*)(((tb & 1) ? a.in[I_PEER_V] : a.in[I_PEER_U]) + (size_t)(tb >> 1) * NEXP * DM + r * 32);
#pragma unroll
                for (int q = 0; q < 8; ++q) v[u][q] = __builtin_nontemporal_load(srcp + q); } }
#pragma unroll
        for (int u = 0; u < 2; ++u) { const size_t it = base + u * stride;
            if (it < it1) { const int tb = (int)(it / per); const size_t r = it % per;
                float ss = 0.f;
#pragma unroll
                for (int q = 0; q < 8; ++q) ss += (v[u][q].x * v[u][q].x + v[u][q].y * v[u][q].y) + (v[u][q].z * v[u][q].z + v[u][q].w * v[u][q].w);
                const float rms = sqrtf(wave_sum_u(ss) * (1.0f / DM));
                const float sc = rms > 0.f ? 2.05f / rms : 0.f;
                v4u w;
#pragma unroll
                for (int d = 0; d < 4; ++d) { unsigned p = 0;
                    p = __builtin_amdgcn_cvt_scalef32_pk_fp4_f32(p, clamp6(v[u][2 * d].x * sc), clamp6(v[u][2 * d].y * sc), 1.0f, 0);
                    p = __builtin_amdgcn_cvt_scalef32_pk_fp4_f32(p, clamp6(v[u][2 * d].z * sc), clamp6(v[u][2 * d].w * sc), 1.0f, 1);
                    p = __builtin_amdgcn_cvt_scalef32_pk_fp4_f32(p, clamp6(v[u][2 * d + 1].x * sc), clamp6(v[u][2 * d + 1].y * sc), 1.0f, 2);
                    p = __builtin_amdgcn_cvt_scalef32_pk_fp4_f32(p, clamp6(v[u][2 * d + 1].z * sc), clamp6(v[u][2 * d + 1].w * sc), 1.0f, 3);
                    w[d] = p; }
                *(v4u*)((unsigned char*)(a.ws + m.tabu) + (size_t)tb * NEXP * TROW + r * 16) = w;
                if (F.lane == 0) tsc[(size_t)tb * NEXP + (r >> 6)] = rms * (1.0f / 2.05f); } }
    }
}

__device__ __forceinline__ float gelu_fast(float x) {
    const float u = 1.5957691216057308f * (x + 0.044715f * x * x * x);
    return x / (1.0f + __expf(-u));
}


__device__ __forceinline__ float sigm(float x) { return 1.0f / (1.0f + __expf(-x)); }
__device__ __forceinline__ float softplus_f(float x) { return __logf(1.0f + __expf(-fabsf(x))) + fmaxf(x, 0.0f); }
__device__ __forceinline__ float tanh_f(float x) { return 1.0f - 2.0f / (1.0f + __expf(2.0f * x)); }
__device__ __forceinline__ float red8(float v) { v += dpp_f<0xB1>(v); v += dpp_f<0x4E>(v); v += dpp_f<0x141>(v); return v; }
__device__ __forceinline__ v4u ld8(const bf16_t* p) { return *(const v4u*)p; }
__device__ __forceinline__ void unpack8(const v4u w, float (&f)[8]) { f[0] = bflo(w.x); f[1] = bfhi(w.x); f[2] = bflo(w.y); f[3] = bfhi(w.y); f[4] = bflo(w.z); f[5] = bfhi(w.z); f[6] = bflo(w.w); f[7] = bfhi(w.w); }
__device__ __forceinline__ v4u pack8(const float (&f)[8]) { v4u w; w.x = pk2(f[0], f[1]); w.y = pk2(f[2], f[3]); w.z = pk2(f[4], f[5]); w.w = pk2(f[6], f[7]); return w; }

__device__ __forceinline__ void prep_phase(const Args& a, Frame& F, int l) {
    const WsMap m = ws_map(NTOK);
    const bf16_t* p16 = (const bf16_t*)(a.ws + m.p16);
    bf16_t* zrkv = (bf16_t*)(a.ws + m.zrkv); bf16_t* auxA = (bf16_t*)(a.ws + m.auxA); bf16_t* xc = (bf16_t*)(a.ws + m.xc);
    const float* mu = a.in[I_RW_MU] + l * 1792;
#pragma unroll 4
    for (size_t it = (size_t)F.vcu * NTHR + F.tid; it < (size_t)NTOK * 224; it += (size_t)F.G * NTHR) {
        const int n = (int)(it / 224), j = (int)(it % 224), t = n % TSEQ;
        const int col = j * 8;
        float cur[8], prv[8], z[8];
        unpack8(ld8(p16 + (size_t)n * PLD + col), cur);
        unpack8(ld8(p16 + (size_t)(t > 0 ? n - 1 : n) * PLD + col), prv);
        const f32x4 m0 = *(const f32x4*)(mu + col), m1 = *(const f32x4*)(mu + col + 4);
        const float mm[8] = {m0.x, m0.y, m0.z, m0.w, m1.x, m1.y, m1.z, m1.w};
#pragma unroll
        for (int k = 0; k < 8; ++k) z[k] = cur[k] + ((t > 0 ? prv[k] : 0.f) - cur[k]) * mm[k];
        if (col < 1536) *(v4u*)(zrkv + (size_t)n * 1536 + col) = pack8(z);
        else {
            const int c = col - 1536;
#pragma unroll
            for (int k = 0; k < 8; ++k) z[k] = c < 64 ? tanh_f(z[k]) : (c < 128 ? z[k] : sigm(z[k]));
            *(v4u*)(auxA + (size_t)n * 384 + c) = pack8(z);
        }
    }
    for (size_t it = (size_t)F.vcu * NTHR + F.tid; it < (size_t)NTOK * 16; it += (size_t)F.G * NTHR) {
        const int n = (int)(it / 16), c = 256 + (int)(it % 16) * 8;
        v4u w = (v4u){0u, 0u, 0u, 0u};
        if (c < 272) w = ld8(p16 + (size_t)n * PLD + C_GLA + 1536 + (c - 256));
        *(v4u*)(auxA + (size_t)n * 384 + c) = w;
    }
#pragma unroll 2
    for (size_t it = (size_t)F.vcu * NTHR + F.tid; it < (size_t)NTOK * 64; it += (size_t)F.G * NTHR) {
        const int n = (int)(it / 64), c = (int)(it % 64) * 8, t = n % TSEQ;
        float acc[8];
        { const f32x4 b0 = *(const f32x4*)(a.in[I_LRU_CONV_B] + l * 512 + c), b1 = *(const f32x4*)(a.in[I_LRU_CONV_B] + l * 512 + c + 4);
          acc[0] = b0.x; acc[1] = b0.y; acc[2] = b0.z; acc[3] = b0.w; acc[4] = b1.x; acc[5] = b1.y; acc[6] = b1.z; acc[7] = b1.w; }
        v4u raw[4];
#pragma unroll
        for (int jj = 0; jj < 4; ++jj) raw[jj] = ld8(p16 + (size_t)(t - 3 + jj >= 0 ? n - 3 + jj : n) * PLD + C_LRU + c);
#pragma unroll
        for (int jj = 0; jj < 4; ++jj) {
            float xv[8]; unpack8(raw[jj], xv);
            const float ok = (t - 3 + jj >= 0) ? 1.0f : 0.0f;
            const float* cw = a.in[I_LRU_CONV_W] + (size_t)l * 4 * 512 + jj * 512 + c;
            const f32x4 w0 = *(const f32x4*)cw * ok, w1 = *(const f32x4*)(cw + 4) * ok;
            acc[0] += w0.x * xv[0]; acc[1] += w0.y * xv[1]; acc[2] += w0.z * xv[2]; acc[3] += w0.w * xv[3];
            acc[4] += w1.x * xv[4]; acc[5] += w1.y * xv[5]; acc[6] += w1.z * xv[6]; acc[7] += w1.w * xv[7];
        }
        *(v4u*)(xc + (size_t)n * 512 + c) = pack8(acc);
    }
    {
        bf16_t* gq = (bf16_t*)(a.ws + m.gq); bf16_t* gk = (bf16_t*)(a.ws + m.gk); bf16_t* gv = (bf16_t*)(a.ws + m.gv); float* gsc = (float*)(a.ws + m.gsc);
        const float* cw = a.in[I_GDN_CONV_W] + (size_t)l * 4 * 1536;
        const int lane = F.lane;
        for (int n = F.gw; n < NTOK; n += F.ngw) {
            const int t = n % TSEQ;
#pragma unroll
            for (int part = 0; part < 3; ++part) {
                const int cb = part * 512 + lane * 8;
                float acc[8];
#pragma unroll
                for (int k = 0; k < 8; ++k) acc[k] = 0.f;
#pragma unroll
                for (int jj = 0; jj < 4; ++jj) {
                    if (t - 3 + jj >= 0) {
                        float xv[8]; unpack8(ld8(p16 + (size_t)(n - 3 + jj) * PLD + C_GDN + cb), xv);
                        const f32x4 w0 = *(const f32x4*)(cw + jj * 1536 + cb), w1 = *(const f32x4*)(cw + jj * 1536 + cb + 4);
                        acc[0] += w0.x * xv[0]; acc[1] += w0.y * xv[1]; acc[2] += w0.z * xv[2]; acc[3] += w0.w * xv[3];
                        acc[4] += w1.x * xv[4]; acc[5] += w1.y * xv[5]; acc[6] += w1.z * xv[6]; acc[7] += w1.w * xv[7];
                    }
                }
                float ss = 0.f;
#pragma unroll
                for (int k = 0; k < 8; ++k) { acc[k] = acc[k] * sigm(acc[k]); ss += acc[k] * acc[k]; }
                if (part < 2) {
                    ss = row16_sum(ss);
                    const float inv = (1.0f / sqrtf(ss + 1e-6f)) * (part == 0 ? 0.08838834764831845f : 1.0f);
#pragma unroll
                    for (int k = 0; k < 8; ++k) acc[k] *= inv;
                }
                *(v4u*)((part == 0 ? gq : (part == 1 ? gk : gv)) + (size_t)n * 512 + lane * 8) = pack8(acc);
            }
            if (lane < 4) {
                gsc[(size_t)n * 8 + lane] = sigm(bf2f(p16[(size_t)n * PLD + C_GDN + 2048 + lane]));
                gsc[(size_t)n * 8 + 4 + lane] = -__expf(a.in[I_GDN_A_LOG][l * 4 + lane]) * softplus_f(bf2f(p16[(size_t)n * PLD + C_GDN + 2052 + lane]) + a.in[I_GDN_DT_BIAS][l * 4 + lane]);
            }
        }
    }
}

__device__ __forceinline__ float swz16(float v) { return __builtin_bit_cast(float, __builtin_amdgcn_ds_swizzle(__builtin_bit_cast(int, v), 0x401F)); }
__device__ __forceinline__ float red32(float v) { v = row16_sum(v); return v + swz16(v); }

__device__ __forceinline__ void rwkv_task(const Args& a, Frame& F, int l, int task) {
    const WsMap m = ws_map(NTOK);
    const int b = task >> 4, h = (task >> 1) & 7, hf = task & 1;
    LAS float* LR = (LAS float*)F.lds; LAS float* LW = LR + 2048; LAS float* LK = LW + 2048; LAS float* LA = LK + 2048; LAS float* LB = LA + 2048;
    LAS float* LV = LB + 2048; LAS float* LY = LV + 1024;
    const int lane = F.lane, w = F.wave, tid = F.tid;
    const int ch = h * 64 + lane;
    const bool mine = (lane >> 5) == hf;
    const float kk_ = a.in[I_RW_K_K][l * 512 + ch], ka_ = a.in[I_RW_K_A][l * 512 + ch], rk_ = a.in[I_RW_R_K][l * 512 + ch];
    const bf16_t* zr = (const bf16_t*)(a.ws + m.zrkv); const bf16_t* ao = (const bf16_t*)(a.ws + m.auxo); const bf16_t* vr = (const bf16_t*)(a.ws + m.vres);
    float* vf = (float*)(a.ws + m.vfirst); bf16_t* yo = (bf16_t*)(a.ws + m.rwy); bf16_t* bvo = (bf16_t*)(a.ws + m.rwbv);
    float S0 = 0.f, S1 = 0.f, S2 = 0.f, S3 = 0.f;
    const int row = tid >> 4, ks = tid & 15;
    float in_[4][7];
    auto load_chunk = [&](int c) {
#pragma unroll
        for (int q = 0; q < 4; ++q) { const size_t n = (size_t)b * TSEQ + c * 32 + w + 8 * q;
            in_[q][0] = bf2f(zr[n * 1536 + ch]); in_[q][1] = bf2f(zr[n * 1536 + 512 + ch]); in_[q][2] = bf2f(zr[n * 1536 + 1024 + ch]);
            in_[q][3] = bf2f(ao[n * 1792 + ch]); in_[q][4] = bf2f(ao[n * 1792 + 512 + ch]);
            if (l > 0) { in_[q][5] = bf2f(vr[n * 512 + ch]); in_[q][6] = vf[n * 512 + ch]; } else { in_[q][5] = 0.f; in_[q][6] = 0.f; } }
    };
    load_chunk(0);
    for (int c = 0; c < TSEQ / 32; ++c) {
#pragma unroll
        for (int q = 0; q < 4; ++q) {
            const int tl = w + 8 * q; const size_t n = (size_t)b * TSEQ + c * 32 + tl;
            const float zr_ = in_[q][0], zk_ = in_[q][1], zv_ = in_[q][2], wp = in_[q][3], ap = in_[q][4];
            float v = zv_;
            if (l == 0) { if (mine) vf[n * 512 + ch] = zv_; } else v = zv_ + (in_[q][6] - zv_) * sigm(in_[q][5]);
            const float w_raw = -softplus_f(-wp) - 0.5f, dec = __expf(-__expf(w_raw));
            const float aa = sigm(ap);
            const float kkraw = zk_ * kk_;
            const float ss = wave_sum_u(kkraw * kkraw);
            const float kk = kkraw * (1.0f / sqrtf(fmaxf(ss, 1e-24f)));
            const float km = zk_ * (1.0f + (aa - 1.0f) * ka_);
            const float bon = wave_sum_u(zr_ * km * rk_);
            LR[tl * 64 + lane] = zr_; LW[tl * 64 + lane] = dec; LK[tl * 64 + lane] = km; LA[tl * 64 + lane] = -kk; LB[tl * 64 + lane] = kk * aa;
            if (mine) { LV[tl * 32 + (lane & 31)] = v; bvo[n * 512 + ch] = f2bf(bon * v); }
        }
        __syncthreads();
        if (c + 1 < TSEQ / 32) load_chunk(c + 1);
        float keep0 = 0.f, keep1 = 0.f;
#pragma unroll 4
        for (int tl = 0; tl < 32; ++tl) {
            const int o = tl * 64 + ks * 4;
            const f32x4 a4 = *(const LAS f32x4*)(LA + o), w4 = *(const LAS f32x4*)(LW + o), b4 = *(const LAS f32x4*)(LB + o), k4 = *(const LAS f32x4*)(LK + o), r4 = *(const LAS f32x4*)(LR + o);
            const float vv = LV[tl * 32 + row];
            const float sa = row16_sum((S0 * a4.x + S1 * a4.y) + (S2 * a4.z + S3 * a4.w));
            S0 = S0 * w4.x + (sa * b4.x + vv * k4.x); S1 = S1 * w4.y + (sa * b4.y + vv * k4.y); S2 = S2 * w4.z + (sa * b4.z + vv * k4.z); S3 = S3 * w4.w + (sa * b4.w + vv * k4.w);
            const float y = row16_sum((S0 * r4.x + S1 * r4.y) + (S2 * r4.z + S3 * r4.w));
            keep0 = (ks == tl) ? y : keep0; keep1 = (ks + 16 == tl) ? y : keep1;
        }
        LY[ks * 32 + row] = keep0; LY[(16 + ks) * 32 + row] = keep1;
        __syncthreads();
        { const int tl = tid >> 4, r2 = (tid & 15) * 2; const size_t n = (size_t)b * TSEQ + c * 32 + tl;
          *(unsigned*)(yo + n * 512 + h * 64 + hf * 32 + r2) = pk2(LY[tl * 32 + r2], LY[tl * 32 + r2 + 1]); }
    }
}


__device__ __forceinline__ void chunk_cumsum8(float (&x)[8], LAS float* tmp, int lane, int w, int c8) {
#pragma unroll
    for (int d = 8; d < 64; d <<= 1) {
#pragma unroll
        for (int k = 0; k < 8; ++k) { const float t = __shfl_up(x[k], d); if (lane >= d) x[k] += t; }
    }
    if (lane >= 56) { *(LAS f32x4*)(tmp + w * 64 + c8) = (f32x4){x[0], x[1], x[2], x[3]}; *(LAS f32x4*)(tmp + w * 64 + c8 + 4) = (f32x4){x[4], x[5], x[6], x[7]}; }
    __syncthreads();
    for (int ww = 0; ww < w; ++ww) { const f32x4 a0 = *(const LAS f32x4*)(tmp + ww * 64 + c8), a1 = *(const LAS f32x4*)(tmp + ww * 64 + c8 + 4);
        x[0] += a0.x; x[1] += a0.y; x[2] += a0.z; x[3] += a0.w; x[4] += a1.x; x[5] += a1.y; x[6] += a1.z; x[7] += a1.w; }
}

constexpr int RWP = 72;
constexpr int RWT = 64 * RWP;
constexpr size_t RWB_TILES = 4 * RWT * 2;
constexpr size_t RWB_DVEC = RWB_TILES;
constexpr size_t RWB_VS = RWB_DVEC + 256;
constexpr size_t RWB_BYTES = RWB_VS + 4 * 3 * 64 * 16 * 2;

__device__ __forceinline__ f32x4 mm64(const LAS bf16_t* A, const LAS bf16_t* Bt, int mt, int nt, int lane, f32x4 acc) {
    const LAS bf16_t* ap = A + (mt * 16 + (lane & 15)) * RWP + (lane >> 4) * 8;
    const LAS bf16_t* bp = Bt + (nt * 16 + (lane & 15)) * RWP + (lane >> 4) * 8;
#pragma unroll
    for (int k0 = 0; k0 < 64; k0 += 32)
        acc = __builtin_amdgcn_mfma_f32_16x16x32_bf16(*(const LAS bf16x8*)(ap + k0), *(const LAS bf16x8*)(bp + k0), acc, 0, 0, 0);
    return acc;
}
__device__ __forceinline__ void st_rowmajor(LAS bf16_t* T, int mt, int nt, int lane, const f32x4 v) {
    const int n = nt * 16 + (lane & 15), i0 = mt * 16 + (lane >> 4) * 4;
    T[(i0 + 0) * RWP + n] = f2bf(v.x); T[(i0 + 1) * RWP + n] = f2bf(v.y); T[(i0 + 2) * RWP + n] = f2bf(v.z); T[(i0 + 3) * RWP + n] = f2bf(v.w);
}
__device__ __forceinline__ void st_transposed(LAS bf16_t* T, int mt, int nt, int lane, const f32x4 v) {
    const int n = nt * 16 + (lane & 15), i0 = mt * 16 + (lane >> 4) * 4;
    *(LAS v2u*)(T + n * RWP + i0) = (v2u){pk2(v.x, v.y), pk2(v.z, v.w)};
}

__device__ __forceinline__ void rwkv_pa_chunk(const Args& a, Frame& F, int l, int ci) {
    const WsMap m = ws_map(NTOK);
    const int bh = ci >> 6, c = ci & 63, b = bh >> 3, h = bh & 7;
    const int lane = F.lane, w = F.wave, tid = F.tid;
    const int ch = h * 64 + lane;
    LAS bf16_t* At = (LAS bf16_t*)F.lds; LAS bf16_t* AtT = At + RWT; LAS bf16_t* Bt = AtT + RWT; LAS bf16_t* Kt = Bt + RWT; LAS bf16_t* KtGT = Kt + RWT;
    LAS bf16_t* Rt = KtGT + RWT; LAS bf16_t* VmT = Rt + RWT; LAS bf16_t* LAK = VmT + RWT;
    LAS bf16_t* X0 = LAK + RWT; LAS bf16_t* XT0 = X0 + RWT; LAS bf16_t* T0 = XT0 + RWT; LAS bf16_t* X1 = T0 + RWT; LAS bf16_t* XT1 = X1 + RWT; LAS bf16_t* T1 = XT1 + RWT;
    LAS float* LWL = (LAS float*)X0;
    LAS bf16_t* A2 = X1;
    LAS bf16_t* LVT = XT1;
    const bf16_t* zr = (const bf16_t*)(a.ws + m.zrkv); const bf16_t* ao = (const bf16_t*)(a.ws + m.auxo); const bf16_t* vr = (const bf16_t*)(a.ws + m.vres);
    float* vf = (float*)(a.ws + m.vfirst); bf16_t* bvo = (bf16_t*)(a.ws + m.rwbv);
    unsigned char* blob = a.ws + m.xn + (size_t)ci * RWB_BYTES;
    bf16_t* gW = (bf16_t*)blob; bf16_t* gQG = gW + RWT; bf16_t* gKGT = gQG + RWT; bf16_t* gA1 = gKGT + RWT;
    float* gDV = (float*)(blob + RWB_DVEC); bf16_t* gVS = (bf16_t*)(blob + RWB_VS);
    const int j = tid >> 3, c8 = (tid & 7) * 8, chb = h * 64 + c8;
    const size_t n = (size_t)b * TSEQ + c * 64 + j;
    float zr_[8], zk_[8], zv_[8], wp[8], ap[8];
    unpack8(ld8(zr + n * 1536 + chb), zr_); unpack8(ld8(zr + n * 1536 + 512 + chb), zk_); unpack8(ld8(zr + n * 1536 + 1024 + chb), zv_);
    unpack8(ld8(ao + n * 1792 + chb), wp); unpack8(ld8(ao + n * 1792 + 512 + chb), ap);
    float vres8[8], vf8[8];
    if (l > 0) { unpack8(ld8(vr + n * 512 + chb), vres8); const f32x4 f0 = *(const f32x4*)(vf + n * 512 + chb), f1 = *(const f32x4*)(vf + n * 512 + chb + 4);
        vf8[0] = f0.x; vf8[1] = f0.y; vf8[2] = f0.z; vf8[3] = f0.w; vf8[4] = f1.x; vf8[5] = f1.y; vf8[6] = f1.z; vf8[7] = f1.w; }
    float lw[8];
#pragma unroll
    for (int k = 0; k < 8; ++k) lw[k] = -__expf(-softplus_f(-wp[k]) - 0.5f);
    float cs[8];
#pragma unroll
    for (int k = 0; k < 8; ++k) cs[k] = lw[k];
    chunk_cumsum8(cs, LWL, lane, w, c8);
    {
        float pk_[8], pa_[8], pr_[8];
        { const float* p0 = a.in[I_RW_K_K] + l * 512 + chb; const float* p1 = a.in[I_RW_K_A] + l * 512 + chb; const float* p2 = a.in[I_RW_R_K] + l * 512 + chb;
          const f32x4 a0 = *(const f32x4*)p0, a1 = *(const f32x4*)(p0 + 4), b0 = *(const f32x4*)p1, b1 = *(const f32x4*)(p1 + 4), c0 = *(const f32x4*)p2, c1 = *(const f32x4*)(p2 + 4);
          pk_[0] = a0.x; pk_[1] = a0.y; pk_[2] = a0.z; pk_[3] = a0.w; pk_[4] = a1.x; pk_[5] = a1.y; pk_[6] = a1.z; pk_[7] = a1.w;
          pa_[0] = b0.x; pa_[1] = b0.y; pa_[2] = b0.z; pa_[3] = b0.w; pa_[4] = b1.x; pa_[5] = b1.y; pa_[6] = b1.z; pa_[7] = b1.w;
          pr_[0] = c0.x; pr_[1] = c0.y; pr_[2] = c0.z; pr_[3] = c0.w; pr_[4] = c1.x; pr_[5] = c1.y; pr_[6] = c1.z; pr_[7] = c1.w; }
        float v[8], aa[8], kk[8], km[8];
        float ss = 0.f, bs = 0.f;
#pragma unroll
        for (int k = 0; k < 8; ++k) {
            v[k] = (l == 0) ? zv_[k] : zv_[k] + (vf8[k] - zv_[k]) * sigm(vres8[k]);
            aa[k] = sigm(ap[k]);
            kk[k] = zk_[k] * pk_[k]; ss += kk[k] * kk[k];
            km[k] = zk_[k] * (1.0f + (aa[k] - 1.0f) * pa_[k]); bs += zr_[k] * km[k] * pr_[k];
        }
        if (l == 0) { *(f32x4*)(vf + n * 512 + chb) = (f32x4){zv_[0], zv_[1], zv_[2], zv_[3]}; *(f32x4*)(vf + n * 512 + chb + 4) = (f32x4){zv_[4], zv_[5], zv_[6], zv_[7]}; }
        ss = red8(ss); bs = red8(bs);
        const float kinv = 1.0f / sqrtf(fmaxf(ss, 1e-24f));
        float cm[8], gcv[8];
        {
#pragma unroll
          for (int k = 0; k < 8; ++k) gcv[k] = 0.f;
#pragma unroll
          for (int ww = 0; ww < 8; ++ww) { const f32x4 g0 = *(const LAS f32x4*)(LWL + ww * 64 + c8), g1 = *(const LAS f32x4*)(LWL + ww * 64 + c8 + 4);
              gcv[0] += g0.x; gcv[1] += g0.y; gcv[2] += g0.z; gcv[3] += g0.w; gcv[4] += g1.x; gcv[5] += g1.y; gcv[6] += g1.z; gcv[7] += g1.w; } }
#pragma unroll
        for (int k = 0; k < 8; ++k) cm[k] = cs[k] - lw[k];
        float t_at[8], t_bt[8], t_kt[8], t_rt[8], t_bv[8];
        LAS bf16_t* KGTl = T1;
#pragma unroll
        for (int k = 0; k < 8; ++k) {
            const float G = __expf(cs[k]), Gm1 = __expf(cm[k]), iG = __expf(-cs[k]), GcG = __expf(gcv[k] - cs[k]);
            const float kkn = kk[k] * kinv;
            const float av = -kkn, bv = kkn * aa[k];
            t_at[k] = av * Gm1; t_bt[k] = bv * iG; t_kt[k] = km[k] * iG; t_rt[k] = zr_[k] * G; t_bv[k] = bs * v[k];
            AtT[(c8 + k) * RWP + j] = f2bf(t_at[k]);
            KtGT[(c8 + k) * RWP + j] = f2bf(km[k] * GcG);
            VmT[(c8 + k) * RWP + j] = f2bf(v[k]);
            KGTl[(c8 + k) * RWP + j] = f2bf(bv * GcG);
        }
        *(LAS v4u*)(At + j * RWP + c8) = pack8(t_at); *(LAS v4u*)(Bt + j * RWP + c8) = pack8(t_bt); *(LAS v4u*)(Kt + j * RWP + c8) = pack8(t_kt);
        const v4u rt8 = pack8(t_rt);
        *(LAS v4u*)(Rt + j * RWP + c8) = rt8; *(v4u*)(gQG + j * RWP + c8) = rt8;
        *(v4u*)(bvo + n * 512 + chb) = pack8(t_bv);
        if (j == 63) { *(f32x4*)(gDV + c8) = (f32x4){__expf(gcv[0]), __expf(gcv[1]), __expf(gcv[2]), __expf(gcv[3])}; *(f32x4*)(gDV + c8 + 4) = (f32x4){__expf(gcv[4]), __expf(gcv[5]), __expf(gcv[6]), __expf(gcv[7])}; }
    }
    __syncthreads();
    {
        for (int o = tid; o < RWT / 8; o += NTHR) ((v4u*)gKGT)[o] = ((const LAS v4u*)T1)[o];
        f32x4 z4 = {0.f, 0.f, 0.f, 0.f};
#pragma unroll 1
        for (int tt = 0; tt < 2; ++tt) {
            const int t = w + 8 * tt, mt = t >> 2, nt = t & 3;
            const int n = nt * 16 + (lane & 15), i0 = mt * 16 + (lane >> 4) * 4;
            f32x4 lab = mm64(At, Bt, mt, nt, lane, z4), lak = mm64(At, Kt, mt, nt, lane, z4), a1 = mm64(Rt, Bt, mt, nt, lane, z4), a2 = mm64(Rt, Kt, mt, nt, lane, z4);
            f32x4 tt0;
#pragma unroll
            for (int e = 0; e < 4; ++e) { const int i = i0 + e;
                if (n >= i) { lab[e] = 0.f; lak[e] = 0.f; }
                if (n > i) { a1[e] = 0.f; a2[e] = 0.f; }
                tt0[e] = lab[e] + (n == i ? 1.0f : 0.f); }
            st_rowmajor(X0, mt, nt, lane, lab); st_transposed(XT0, mt, nt, lane, lab);
            st_rowmajor(T0, mt, nt, lane, tt0);
            st_rowmajor(LAK, mt, nt, lane, lak);
            st_rowmajor(A2, mt, nt, lane, a2);
            gA1[(i0 + 0) * RWP + n] = f2bf(a1.x); gA1[(i0 + 1) * RWP + n] = f2bf(a1.y); gA1[(i0 + 2) * RWP + n] = f2bf(a1.z); gA1[(i0 + 3) * RWP + n] = f2bf(a1.w);
        }
    }
    __syncthreads();
    {
        f32x4 z4 = {0.f, 0.f, 0.f, 0.f};
#pragma unroll 1
        for (int tt = 0; tt < 2; ++tt) {
            const int t = w + 8 * tt, mt = t >> 2, nt = t & 3;
            const int n = nt * 16 + (lane & 15), i0 = mt * 16 + (lane >> 4) * 4;
            const f32x4 lv = mm64(LAK, VmT, mt, nt, lane, z4), o0 = mm64(A2, VmT, mt, nt, lane, z4), kv0 = mm64(KtGT, VmT, mt, nt, lane, z4);
            st_transposed((LAS bf16_t*)(F.lds + 131584), mt, nt, lane, lv);
            bf16_t* go = gVS + (size_t)nt * 3 * 1024 + 1024;
            const int r = lane & 15;
            go[(i0 + 0) * 16 + r] = f2bf(o0.x); go[(i0 + 1) * 16 + r] = f2bf(o0.y); go[(i0 + 2) * 16 + r] = f2bf(o0.z); go[(i0 + 3) * 16 + r] = f2bf(o0.w);
            go[1024 + (i0 + 0) * 16 + r] = f2bf(kv0.x); go[1024 + (i0 + 1) * 16 + r] = f2bf(kv0.y); go[1024 + (i0 + 2) * 16 + r] = f2bf(kv0.z); go[1024 + (i0 + 3) * 16 + r] = f2bf(kv0.w);
            (void)n;
        }
    }
    __syncthreads();
    {
        LAS bf16_t* Xc = X0; LAS bf16_t* XTc = XT0; LAS bf16_t* Tc = T0; LAS bf16_t* Xn = X1; LAS bf16_t* XTn = XT1; LAS bf16_t* Tn = T1;
        f32x4 z4 = {0.f, 0.f, 0.f, 0.f};
#pragma unroll 1
        for (int it = 0; it < 5; ++it) {
#pragma unroll 1
            for (int tt = 0; tt < 2; ++tt) { const int t = w + 8 * tt, mt = t >> 2, nt = t & 3;
                const f32x4 x2 = mm64(Xc, XTc, mt, nt, lane, z4);
                st_rowmajor(Xn, mt, nt, lane, x2); st_transposed(XTn, mt, nt, lane, x2); }
            __syncthreads();
#pragma unroll 1
            for (int tt = 0; tt < 2; ++tt) { const int t = w + 8 * tt, mt = t >> 2, nt = t & 3;
                const int n = nt * 16 + (lane & 15), i0 = mt * 16 + (lane >> 4) * 4;
                f32x4 tc; tc.x = bf2f(Tc[(i0 + 0) * RWP + n]); tc.y = bf2f(Tc[(i0 + 1) * RWP + n]); tc.z = bf2f(Tc[(i0 + 2) * RWP + n]); tc.w = bf2f(Tc[(i0 + 3) * RWP + n]);
                const f32x4 tn = mm64(Tc, XTn, mt, nt, lane, tc);
                st_rowmajor(Tn, mt, nt, lane, tn); }
            __syncthreads();
            LAS bf16_t* s0 = Xc; Xc = Xn; Xn = s0; s0 = XTc; XTc = XTn; XTn = s0; s0 = Tc; Tc = Tn; Tn = s0;
        }
        LAS bf16_t* LVTp = (LAS bf16_t*)(F.lds + 131584);
#pragma unroll 1
        for (int tt = 0; tt < 2; ++tt) { const int t = w + 8 * tt, mt = t >> 2, nt = t & 3;
            const int n = nt * 16 + (lane & 15), i0 = mt * 16 + (lane >> 4) * 4, r = lane & 15;
            const f32x4 wt = mm64(Tc, AtT, mt, nt, lane, z4), u0 = mm64(Tc, LVTp, mt, nt, lane, z4);
            gW[(i0 + 0) * RWP + n] = f2bf(wt.x); gW[(i0 + 1) * RWP + n] = f2bf(wt.y); gW[(i0 + 2) * RWP + n] = f2bf(wt.z); gW[(i0 + 3) * RWP + n] = f2bf(wt.w);
            bf16_t* gu = gVS + (size_t)nt * 3 * 1024;
            gu[(i0 + 0) * 16 + r] = f2bf(u0.x); gu[(i0 + 1) * 16 + r] = f2bf(u0.y); gu[(i0 + 2) * 16 + r] = f2bf(u0.z); gu[(i0 + 3) * 16 + r] = f2bf(u0.w); }
    }
    __syncthreads();
    (void)LVT;
}

__device__ __forceinline__ void rwkv_ps_task(const Args& a, Frame& F, int task) {
    const WsMap m = ws_map(NTOK);
    const int bh = task >> 2, vs = task & 3, b = bh >> 3, h = bh & 7;
    const int lane = F.lane, w = F.wave, tid = F.tid;
    LAS bf16_t* LB = (LAS bf16_t*)F.lds;
    LAS bf16_t* ST = LB + 4 * RWT; LAS bf16_t* VNT = ST + 16 * RWP;
    bf16_t* yo = (bf16_t*)(a.ws + m.rwy);
    const unsigned char* blob0 = a.ws + m.xn + (size_t)(bh * 64) * RWB_BYTES;
    const int r = lane & 15, i0w = (w & 3) * 16 + (lane >> 4) * 4;
    f32x4 Sacc = {0.f, 0.f, 0.f, 0.f};
    for (int i = tid; i < 16 * RWP / 2; i += NTHR) ((LAS unsigned*)ST)[i] = 0u;
    v4u pre[5];
    auto prefetch = [&](int c) {
        const v4u* g = (const v4u*)(blob0 + (size_t)c * RWB_BYTES);
#pragma unroll
        for (int k = 0; k < 5; ++k) { const int o = k * 512 + tid; pre[k] = (o < (int)(RWB_TILES / 16)) ? g[o] : (v4u){0u, 0u, 0u, 0u}; }
    };
    auto commit = [&]() {
#pragma unroll
        for (int k = 0; k < 5; ++k) { const int o = k * 512 + tid; if (o < (int)(RWB_TILES / 16)) ((LAS v4u*)LB)[o] = pre[k]; }
    };
    bf16_t nfr[4], nkv[4]; float ndv[4];
    auto prefrag = [&](int c) {
        const unsigned char* blob = blob0 + (size_t)c * RWB_BYTES;
        const bf16_t* gvs = (const bf16_t*)(blob + RWB_VS) + (size_t)vs * 3 * 1024;
        const bf16_t* src = gvs + (w < 4 ? 0 : 1024);
#pragma unroll
        for (int e = 0; e < 4; ++e) nfr[e] = src[(i0w + e) * 16 + r];
        if (w < 4) { const float* gd = (const float*)(blob + RWB_DVEC);
#pragma unroll
            for (int e = 0; e < 4; ++e) { ndv[e] = gd[i0w + e]; nkv[e] = gvs[2048 + (i0w + e) * 16 + r]; } }
        else {
#pragma unroll
            for (int e = 0; e < 4; ++e) { ndv[e] = 1.f; nkv[e] = 0; } }
    };
    prefetch(0); commit(); prefetch(1); prefrag(0);
    for (int c = 0; c < 64; ++c) {
        float fr[4], dv[4], kv0[4];
#pragma unroll
        for (int e = 0; e < 4; ++e) { fr[e] = bf2f(nfr[e]); dv[e] = ndv[e]; kv0[e] = bf2f(nkv[e]); }
        if (c + 1 < 64) prefrag(c + 1);
        __syncthreads();
        if (w < 4) {
            f32x4 vn = mm64(LB, ST, w, 0, lane, (f32x4){fr[0], fr[1], fr[2], fr[3]});
            st_transposed(VNT, w, 0, lane, vn);
        }
        __syncthreads();
        if (w < 4) {
            const f32x4 base = {dv[0] * Sacc.x + kv0[0], dv[1] * Sacc.y + kv0[1], dv[2] * Sacc.z + kv0[2], dv[3] * Sacc.w + kv0[3]};
            Sacc = mm64(LB + 2 * RWT, VNT, w, 0, lane, base);
        } else {
            f32x4 o = mm64(LB + RWT, ST, w - 4, 0, lane, (f32x4){fr[0], fr[1], fr[2], fr[3]});
            o = mm64(LB + 3 * RWT, VNT, w - 4, 0, lane, o);
            const size_t n = (size_t)b * TSEQ + c * 64 + i0w;
            bf16_t* yp = yo + n * 512 + h * 64 + vs * 16 + r;
            yp[0] = f2bf(o.x); yp[512] = f2bf(o.y); yp[1024] = f2bf(o.z); yp[1536] = f2bf(o.w);
        }
        __syncthreads();
        if (w < 4) st_transposed(ST, w, 0, lane, Sacc);
        if (c + 1 < 64) commit();
        if (c + 2 < 64) prefetch(c + 2);
    }
    __syncthreads();
}

constexpr int GP = 136;
constexpr size_t GB_BYTES = 26880;
template <int KD, int PA_, int PB_>
__device__ __forceinline__ f32x4 mmx(const LAS bf16_t* A, const LAS bf16_t* Bt, int mt, int nt, int lane, f32x4 acc) {
    const LAS bf16_t* ap = A + (mt * 16 + (lane & 15)) * PA_ + (lane >> 4) * 8;
    const LAS bf16_t* bp = Bt + (nt * 16 + (lane & 15)) * PB_ + (lane >> 4) * 8;
#pragma unroll
    for (int k0 = 0; k0 < KD; k0 += 32)
        acc = __builtin_amdgcn_mfma_f32_16x16x32_bf16(*(const LAS bf16x8*)(ap + k0), *(const LAS bf16x8*)(bp + k0), acc, 0, 0, 0);
    return acc;
}
__device__ __forceinline__ void gdn_pa_chunk(const Args& a, Frame& F, int ci) {
    const WsMap m = ws_map(NTOK);
    const int bh = ci >> 6, c = ci & 63, b = bh >> 2, h = bh & 3;
    const int lane = F.lane, w = F.wave, tid = F.tid;
    LAS bf16_t* KB = (LAS bf16_t*)F.lds; LAS bf16_t* KH = KB + 64 * GP; LAS bf16_t* QH = KH + 64 * GP;
    LAS bf16_t* KBEt = KB; LAS bf16_t* VbT = KB + 128 * RWP;
    LAS bf16_t* X0 = QH + 64 * GP; LAS bf16_t* XT0 = X0 + RWT; LAS bf16_t* T0 = XT0 + RWT; LAS bf16_t* X1 = T0 + RWT; LAS bf16_t* XT1 = X1 + RWT; LAS bf16_t* T1 = XT1 + RWT;
    LAS float* GC = (LAS float*)(T1 + RWT);
    LAS bf16_t* KGTl = (LAS bf16_t*)(GC + 64);
    bf16_t* gq = (bf16_t*)(a.ws + m.gq); bf16_t* gk = (bf16_t*)(a.ws + m.gk); bf16_t* gv = (bf16_t*)(a.ws + m.gv); const float* gsc = (const float*)(a.ws + m.gsc);
    unsigned char* blob = a.ws + m.gblob + (size_t)ci * GB_BYTES;
    bf16_t* gA1 = (bf16_t*)blob; bf16_t* gW = gA1 + RWT; float* gGC = (float*)(blob + RWT * 2 + 64 * GP * 2);
    const int j = tid >> 3, c16 = (tid & 7) * 16;
    const size_t n0 = (size_t)b * TSEQ + c * 64, n = n0 + j;
    const float be = gsc[n * 8 + h];
    v4u kw[2], qw[2], vw[2];
    {
        float kf[8];
#pragma unroll
        for (int hh = 0; hh < 2; ++hh) {
            kw[hh] = ld8(gk + n * 512 + h * 128 + c16 + hh * 8); qw[hh] = ld8(gq + n * 512 + h * 128 + c16 + hh * 8); vw[hh] = ld8(gv + n * 512 + h * 128 + c16 + hh * 8);
            *(LAS v4u*)(KH + j * GP + c16 + hh * 8) = kw[hh]; *(LAS v4u*)(QH + j * GP + c16 + hh * 8) = qw[hh];
            unpack8(kw[hh], kf);
#pragma unroll
            for (int k = 0; k < 8; ++k) kf[k] *= be;
            *(LAS v4u*)(KB + j * GP + c16 + hh * 8) = pack8(kf);
        }
        if (w == 0) {
            float g = gsc[(n0 + lane) * 8 + 4 + h];
#pragma unroll
            for (int o = 1; o < 64; o <<= 1) { const float t = __shfl_up(g, o); if (lane >= o) g += t; }
            GC[lane] = g; gGC[lane] = g;
        }
    }
    __syncthreads();
    {
        const f32x4 z4 = {0.f, 0.f, 0.f, 0.f};
#pragma unroll 1
        for (int tt = 0; tt < 2; ++tt) {
            const int t = w + 8 * tt, mt = t >> 2, nt = t & 3;
            const int nn = nt * 16 + (lane & 15), i0 = mt * 16 + (lane >> 4) * 4;
            f32x4 kk = mmx<128, GP, GP>(KB, KH, mt, nt, lane, z4), qk = mmx<128, GP, GP>(QH, KH, mt, nt, lane, z4);
            const float gj = GC[nn];
            f32x4 x, t0;
#pragma unroll
            for (int e = 0; e < 4; ++e) { const int i = i0 + e; const float d = __expf(fminf(GC[i] - gj, 0.f));
                x[e] = (nn < i) ? -kk[e] * d : 0.f; qk[e] = (nn <= i) ? qk[e] * d : 0.f; t0[e] = x[e] + (nn == i ? 1.0f : 0.f); }
            st_rowmajor(X0, mt, nt, lane, x); st_transposed(XT0, mt, nt, lane, x); st_rowmajor(T0, mt, nt, lane, t0);
            gA1[(i0 + 0) * RWP + nn] = f2bf(qk.x); gA1[(i0 + 1) * RWP + nn] = f2bf(qk.y); gA1[(i0 + 2) * RWP + nn] = f2bf(qk.z); gA1[(i0 + 3) * RWP + nn] = f2bf(qk.w);
        }
    }
    __syncthreads();
    {
        const float gj = GC[j], eg = __expf(gj), s_kbe = be * eg, s_kg = __expf(GC[63] - gj);
        float f[8], o8[8];
#pragma unroll
        for (int hh = 0; hh < 2; ++hh) {
            unpack8(kw[hh], f);
#pragma unroll
            for (int k = 0; k < 8; ++k) { KBEt[(c16 + hh * 8 + k) * RWP + j] = f2bf(f[k] * s_kbe); KGTl[(c16 + hh * 8 + k) * RWP + j] = f2bf(f[k] * s_kg); }
            unpack8(vw[hh], f);
#pragma unroll
            for (int k = 0; k < 8; ++k) VbT[(c16 + hh * 8 + k) * RWP + j] = f2bf(f[k] * be);
            unpack8(qw[hh], f);
#pragma unroll
            for (int k = 0; k < 8; ++k) o8[k] = f[k] * eg;
            *(v4u*)(gq + n * 512 + h * 128 + c16 + hh * 8) = pack8(o8);
        }
    }
    const f32x4 z4 = {0.f, 0.f, 0.f, 0.f};
    LAS bf16_t* Xc = X0; LAS bf16_t* XTc = XT0; LAS bf16_t* Tc = T0; LAS bf16_t* Xn = X1; LAS bf16_t* XTn = XT1; LAS bf16_t* Tn = T1;
#pragma unroll 1
    for (int it = 0; it < 5; ++it) {
#pragma unroll 1
        for (int tt = 0; tt < 2; ++tt) { const int t = w + 8 * tt, mt = t >> 2, nt = t & 3;
            const f32x4 x2 = mm64(Xc, XTc, mt, nt, lane, z4);
            st_rowmajor(Xn, mt, nt, lane, x2); st_transposed(XTn, mt, nt, lane, x2); }
        __syncthreads();
#pragma unroll 1
        for (int tt = 0; tt < 2; ++tt) { const int t = w + 8 * tt, mt = t >> 2, nt = t & 3;
            const int nn = nt * 16 + (lane & 15), i0 = mt * 16 + (lane >> 4) * 4;
            f32x4 tc; tc.x = bf2f(Tc[(i0 + 0) * RWP + nn]); tc.y = bf2f(Tc[(i0 + 1) * RWP + nn]); tc.z = bf2f(Tc[(i0 + 2) * RWP + nn]); tc.w = bf2f(Tc[(i0 + 3) * RWP + nn]);
            const f32x4 tn = mm64(Tc, XTn, mt, nt, lane, tc);
            st_rowmajor(Tn, mt, nt, lane, tn); }
        __syncthreads();
        LAS bf16_t* s0 = Xc; Xc = Xn; Xn = s0; s0 = XTc; XTc = XTn; XTn = s0; s0 = Tc; Tc = Tn; Tn = s0;
    }
    {
#pragma unroll 1
        for (int tt = 0; tt < 4; ++tt) { const int mt = w, nt = tt;
            const f32x4 dw = mm64(KBEt, Tc, mt, nt, lane, z4), du = mm64(VbT, Tc, mt, nt, lane, z4);
            const int i = nt * 16 + (lane & 15), c0 = mt * 16 + (lane >> 4) * 4;
            *(v2u*)(gW + i * GP + c0) = (v2u){pk2(dw.x, dw.y), pk2(dw.z, dw.w)};
            *(v2u*)(gv + (n0 + i) * 512 + h * 128 + c0) = (v2u){pk2(du.x, du.y), pk2(du.z, du.w)}; }
        for (int p = tid; p < 1024; p += NTHR) { const int k = p >> 3, j8 = (p & 7) * 8;
            *(v4u*)(gk + (n0 + (k >> 1)) * 512 + h * 128 + (k & 1) * 64 + j8) = *(const LAS v4u*)(KGTl + k * RWP + j8); }
    }
    __syncthreads();
}

__device__ __forceinline__ void gdn_ps_task(const Args& a, Frame& F, int task) {
    const WsMap m = ws_map(NTOK);
    const int bh = task >> 3, vs = task & 7, b = bh >> 2, h = bh & 3;
    const int lane = F.lane, w = F.wave, tid = F.tid;
    LAS bf16_t* A1 = (LAS bf16_t*)F.lds; LAS bf16_t* WT = A1 + RWT; LAS float* GC = (LAS float*)(WT + 64 * GP);
    LAS bf16_t* QG = (LAS bf16_t*)(GC + 64); LAS bf16_t* KGT = QG + 64 * GP; LAS bf16_t* ST = KGT + 128 * RWP;
    LAS bf16_t* VNT = ST + 16 * GP; LAS bf16_t* UU = VNT + 16 * RWP;
    const bf16_t* gq = (const bf16_t*)(a.ws + m.gq); const bf16_t* gk = (const bf16_t*)(a.ws + m.gk); const bf16_t* gv = (const bf16_t*)(a.ws + m.gv);
    bf16_t* go = (bf16_t*)(a.ws + m.gdno);
    const unsigned char* blob0 = a.ws + m.gblob + (size_t)(bh * 64) * GB_BYTES;
    const int r = lane & 15, kq4 = (lane >> 4) * 4;
    f32x4 Sacc = {0.f, 0.f, 0.f, 0.f};
    for (int i = tid; i < 16 * GP / 2; i += NTHR) ((LAS unsigned*)ST)[i] = 0u;
    v4u pb_[4], pq_[2], pk_[2], pu_;
    auto prefetch = [&](int c) {
        const size_t n0 = (size_t)b * TSEQ + c * 64;
        const v4u* g = (const v4u*)(blob0 + (size_t)c * GB_BYTES);
#pragma unroll
        for (int k = 0; k < 4; ++k) { const int o = k * 512 + tid; pb_[k] = (o < (int)(GB_BYTES / 16)) ? g[o] : (v4u){0u, 0u, 0u, 0u}; }
#pragma unroll
        for (int k = 0; k < 2; ++k) { const int p = k * 512 + tid;
            pq_[k] = ld8(gq + (n0 + (p >> 4)) * 512 + h * 128 + (p & 15) * 8);
            pk_[k] = ld8(gk + (n0 + (p >> 4)) * 512 + h * 128 + (p & 15) * 8); }
        if (tid < 128) pu_ = ld8(gv + (n0 + (tid >> 1)) * 512 + h * 128 + vs * 16 + (tid & 1) * 8);
    };
    prefetch(0);
    for (int c = 0; c < 64; ++c) {
#pragma unroll
        for (int k = 0; k < 4; ++k) { const int o = k * 512 + tid; if (o < (int)(GB_BYTES / 16)) ((LAS v4u*)A1)[o] = pb_[k]; }
#pragma unroll
        for (int k = 0; k < 2; ++k) { const int p = k * 512 + tid;
            *(LAS v4u*)(QG + (p >> 4) * GP + (p & 15) * 8) = pq_[k];
            const int kk = 2 * (p >> 4) + ((p & 15) >> 3), j8 = (p & 7) * 8;
            *(LAS v4u*)(KGT + kk * RWP + j8) = pk_[k]; }
        if (tid < 128) *(LAS v4u*)(UU + (tid >> 1) * 16 + (tid & 1) * 8) = pu_;
        __syncthreads();
        if (c + 1 < 64) prefetch(c + 1);
        const float glast = __expf(GC[63]);
        if (w < 4) {
            const int i0 = w * 16 + kq4;
            f32x4 vn = mmx<128, GP, GP>(WT, ST, w, 0, lane, (f32x4){0.f, 0.f, 0.f, 0.f});
            vn.x = bf2f(UU[(i0 + 0) * 16 + r]) - vn.x; vn.y = bf2f(UU[(i0 + 1) * 16 + r]) - vn.y; vn.z = bf2f(UU[(i0 + 2) * 16 + r]) - vn.z; vn.w = bf2f(UU[(i0 + 3) * 16 + r]) - vn.w;
            st_transposed(VNT, w, 0, lane, vn);
        }
        __syncthreads();
        {
            const f32x4 base = {Sacc.x * glast, Sacc.y * glast, Sacc.z * glast, Sacc.w * glast};
            Sacc = mm64(KGT, VNT, w, 0, lane, base);
            if (w < 4) {
                f32x4 o = mmx<128, GP, GP>(QG, ST, w, 0, lane, (f32x4){0.f, 0.f, 0.f, 0.f});
                o = mm64(A1, VNT, w, 0, lane, o);
                const size_t n = (size_t)b * TSEQ + c * 64 + w * 16 + kq4;
                bf16_t* op = go + n * 512 + h * 128 + vs * 16 + r;
                op[0] = f2bf(o.x); op[512] = f2bf(o.y); op[1024] = f2bf(o.z); op[1536] = f2bf(o.w);
            }
        }
        __syncthreads();
        { const int k0 = w * 16 + kq4;
          *(LAS v2u*)(ST + r * GP + k0) = (v2u){pk2(Sacc.x, Sacc.y), pk2(Sacc.z, Sacc.w)}; }
    }
    __syncthreads();
}

__device__ __forceinline__ void gla_pa_chunk(const Args& a, Frame& F, int ci) {
    const WsMap m = ws_map(NTOK);
    const int bh = ci >> 6, c = ci & 63, b = bh >> 2, h = bh & 3;
    const int lane = F.lane, w = F.wave, tid = F.tid;
    LAS bf16_t* KS2T = (LAS bf16_t*)F.lds; LAS bf16_t* VT = KS2T + RWT; LAS float* TMP = (LAS float*)(VT + 128 * RWP);
    const bf16_t* p16 = (const bf16_t*)(a.ws + m.p16); const bf16_t* ao = (const bf16_t*)(a.ws + m.auxo);
    bf16_t* gKV = (bf16_t*)(a.ws + m.glao) + (size_t)ci * 8192; float* gDV = (float*)(a.ws + m.gladv) + (size_t)ci * 64;
    const int j = tid >> 3, c8 = (tid & 7) * 8, v16 = (tid & 7) * 16;
    const size_t n = (size_t)b * TSEQ + c * 64 + j;
    float k8[8], la[8];
    unpack8(ld8(p16 + n * PLD + C_GLA + 256 + h * 64 + c8), k8); unpack8(ld8(ao + n * 1792 + 1536 + h * 64 + c8), la);
    const v4u v0 = ld8(p16 + n * PLD + C_GLA + 512 + h * 128 + v16), v1 = ld8(p16 + n * PLD + C_GLA + 512 + h * 128 + v16 + 8);
#pragma unroll
    for (int k = 0; k < 8; ++k) la[k] = -softplus_f(-la[k]) * (1.0f / 16.0f);
    chunk_cumsum8(la, TMP, lane, w, c8);
    float bl[8];
#pragma unroll
    for (int k = 0; k < 8; ++k) bl[k] = 0.f;
#pragma unroll
    for (int ww = 0; ww < 8; ++ww) { const f32x4 y0 = *(const LAS f32x4*)(TMP + ww * 64 + c8), y1 = *(const LAS f32x4*)(TMP + ww * 64 + c8 + 4);
        bl[0] += y0.x; bl[1] += y0.y; bl[2] += y0.z; bl[3] += y0.w; bl[4] += y1.x; bl[5] += y1.y; bl[6] += y1.z; bl[7] += y1.w; }
#pragma unroll
    for (int k = 0; k < 8; ++k) KS2T[(c8 + k) * RWP + j] = f2bf(k8[k] * __expf(bl[k] - la[k]));
    { const unsigned vw[8] = {v0.x, v0.y, v0.z, v0.w, v1.x, v1.y, v1.z, v1.w};
#pragma unroll
      for (int e = 0; e < 8; ++e) { VT[(v16 + 2 * e) * RWP + j] = (bf16_t)(vw[e] & 0xffffu); VT[(v16 + 2 * e + 1) * RWP + j] = (bf16_t)(vw[e] >> 16); } }
    if (j == 0) { *(f32x4*)(gDV + c8) = (f32x4){__expf(bl[0]), __expf(bl[1]), __expf(bl[2]), __expf(bl[3])}; *(f32x4*)(gDV + c8 + 4) = (f32x4){__expf(bl[4]), __expf(bl[5]), __expf(bl[6]), __expf(bl[7])}; }
    __syncthreads();
    {
        const f32x4 z4 = {0.f, 0.f, 0.f, 0.f};
#pragma unroll
        for (int tt = 0; tt < 4; ++tt) { const int mt = tt, nt = w;
            const f32x4 d = mm64(KS2T, VT, mt, nt, lane, z4);
            const int dv = nt * 16 + (lane & 15), k0 = mt * 16 + (lane >> 4) * 4;
            *(v2u*)(gKV + dv * 64 + k0) = (v2u){pk2(d.x, d.y), pk2(d.z, d.w)}; }
    }
    __syncthreads();
}
__device__ __forceinline__ void gla_sscan(const Args& a, Frame& F) {
    const WsMap m = ws_map(NTOK);
    const bf16_t* gKV = (const bf16_t*)(a.ws + m.glao); const float* gDV = (const float*)(a.ws + m.gladv); bf16_t* gS = (bf16_t*)(a.ws + m.glas);
    for (int it = F.vcu * NTHR + F.tid; it < 16 * 8192; it += F.G * NTHR) {
        const int bh = it >> 13, e = it & 8191, k = e & 63;
        float S = 0.f;
#pragma unroll 1
        for (int c0 = 0; c0 < 64; c0 += 16) {
            float kv[16], dv[16];
#pragma unroll
            for (int u = 0; u < 16; ++u) { const size_t ci = (size_t)bh * 64 + c0 + u; kv[u] = bf2f(gKV[ci * 8192 + e]); dv[u] = gDV[ci * 64 + k]; }
#pragma unroll
            for (int u = 0; u < 16; ++u) { const size_t ci = (size_t)bh * 64 + c0 + u; gS[ci * 8192 + e] = f2bf(S); S = S * dv[u] + kv[u]; }
        }
    }
}
__device__ __forceinline__ void gla_pb_chunk(const Args& a, Frame& F, int l, int ci) {
    const WsMap m = ws_map(NTOK);
    const int bh = ci >> 6, c = ci & 63, b = bh >> 2, h = bh & 3;
    const int lane = F.lane, w = F.wave, tid = F.tid;
    LAS bf16_t* QS = (LAS bf16_t*)F.lds; LAS bf16_t* KS = QS + RWT; LAS bf16_t* QG = KS + RWT; LAS bf16_t* PM = QG + RWT;
    LAS bf16_t* VT = PM + RWT; LAS bf16_t* ST = VT + 128 * RWP; LAS bf16_t* GG = ST + 128 * RWP;
    LAS float* TMP = (LAS float*)(GG + 64 * GP); LAS float* OSS = TMP + 512;
    const bf16_t* p16 = (const bf16_t*)(a.ws + m.p16); const bf16_t* ao = (const bf16_t*)(a.ws + m.auxo);
    const bf16_t* gS = (const bf16_t*)(a.ws + m.glas) + (size_t)ci * 8192; bf16_t* mix = (bf16_t*)(a.ws + m.mix16);
    const int j = tid >> 3, c8 = (tid & 7) * 8, v16 = (tid & 7) * 16;
    const size_t n = (size_t)b * TSEQ + c * 64 + j;
    float q8[8], k8[8], la[8];
    unpack8(ld8(p16 + n * PLD + C_GLA + h * 64 + c8), q8); unpack8(ld8(p16 + n * PLD + C_GLA + 256 + h * 64 + c8), k8); unpack8(ld8(ao + n * 1792 + 1536 + h * 64 + c8), la);
    const v4u v0 = ld8(p16 + n * PLD + C_GLA + 512 + h * 128 + v16), v1 = ld8(p16 + n * PLD + C_GLA + 512 + h * 128 + v16 + 8);
    const v4u g0 = ld8(p16 + n * PLD + C_GLA + 1024 + h * 128 + v16), g1 = ld8(p16 + n * PLD + C_GLA + 1024 + h * 128 + v16 + 8);
    const v4u s0 = ((const v4u*)gS)[tid], s1 = ((const v4u*)gS)[512 + tid];
#pragma unroll
    for (int k = 0; k < 8; ++k) la[k] = -softplus_f(-la[k]) * (1.0f / 16.0f);
    chunk_cumsum8(la, TMP, lane, w, c8);
    {
        float br[8], t0[8], t1[8], t2[8];
#pragma unroll
        for (int k = 0; k < 8; ++k) br[k] = 0.f;
#pragma unroll
        for (int ww = 0; ww < 4; ++ww) { const f32x4 y0 = *(const LAS f32x4*)(TMP + ww * 64 + c8), y1 = *(const LAS f32x4*)(TMP + ww * 64 + c8 + 4);
            br[0] += y0.x; br[1] += y0.y; br[2] += y0.z; br[3] += y0.w; br[4] += y1.x; br[5] += y1.y; br[6] += y1.z; br[7] += y1.w; }
#pragma unroll
        for (int k = 0; k < 8; ++k) { const float qq = q8[k] * 0.125f;
            t0[k] = qq * __expf(la[k] - br[k]); t1[k] = k8[k] * __expf(br[k] - la[k]); t2[k] = qq * __expf(la[k]); }
        *(LAS v4u*)(QS + j * RWP + c8) = pack8(t0); *(LAS v4u*)(KS + j * RWP + c8) = pack8(t1); *(LAS v4u*)(QG + j * RWP + c8) = pack8(t2);
        const unsigned vw[8] = {v0.x, v0.y, v0.z, v0.w, v1.x, v1.y, v1.z, v1.w};
#pragma unroll
        for (int e = 0; e < 8; ++e) { VT[(v16 + 2 * e) * RWP + j] = (bf16_t)(vw[e] & 0xffffu); VT[(v16 + 2 * e + 1) * RWP + j] = (bf16_t)(vw[e] >> 16); }
        *(LAS v4u*)(GG + j * GP + v16) = g0; *(LAS v4u*)(GG + j * GP + v16 + 8) = g1;
        { const int p0 = tid, p1 = 512 + tid;
          *(LAS v4u*)(ST + (p0 >> 3) * RWP + (p0 & 7) * 8) = s0; *(LAS v4u*)(ST + (p1 >> 3) * RWP + (p1 & 7) * 8) = s1; }
    }
    __syncthreads();
    {
        const f32x4 z4 = {0.f, 0.f, 0.f, 0.f};
#pragma unroll
        for (int tt = 0; tt < 2; ++tt) { const int t = w + 8 * tt, mtj = t >> 2, nti = t & 3;
            f32x4 s4 = mm64(KS, QS, mtj, nti, lane, z4);
            const int i = nti * 16 + (lane & 15), j0 = mtj * 16 + (lane >> 4) * 4;
#pragma unroll
            for (int e = 0; e < 4; ++e) if (j0 + e > i) s4[e] = 0.f;
            st_transposed(PM, mtj, nti, lane, s4); }
    }
    __syncthreads();
    {
        const int mt = w >> 1, ntb = (w & 1) * 4, r = lane & 15, i0 = mt * 16 + (lane >> 4) * 4;
        f32x4 o[4]; float ss[4] = {0.f, 0.f, 0.f, 0.f};
#pragma unroll
        for (int t = 0; t < 4; ++t) { o[t] = mm64(QG, ST, mt, ntb + t, lane, (f32x4){0.f, 0.f, 0.f, 0.f}); o[t] = mm64(PM, VT, mt, ntb + t, lane, o[t]);
            ss[0] += o[t].x * o[t].x; ss[1] += o[t].y * o[t].y; ss[2] += o[t].z * o[t].z; ss[3] += o[t].w * o[t].w; }
#pragma unroll
        for (int e = 0; e < 4; ++e) ss[e] = row16_sum(ss[e]);
        if (r == 0) {
#pragma unroll
            for (int e = 0; e < 4; ++e) OSS[(i0 + e) * 2 + (w & 1)] = ss[e]; }
        __syncthreads();
        float rs[4];
#pragma unroll
        for (int e = 0; e < 4; ++e) rs[e] = 1.0f / sqrtf((OSS[(i0 + e) * 2] + OSS[(i0 + e) * 2 + 1]) * (1.0f / 128.0f) + 1e-6f);
        const size_t nrow = (size_t)b * TSEQ + c * 64 + i0;
#pragma unroll
        for (int t = 0; t < 4; ++t) { const int dv = (ntb + t) * 16 + r; const float gn = a.in[I_GLA_NORM][l * 128 + dv];
            const float ov[4] = {o[t].x, o[t].y, o[t].z, o[t].w};
#pragma unroll
            for (int e = 0; e < 4; ++e) { const float g = bf2f(GG[(i0 + e) * GP + dv]);
                mix[(nrow + e) * DM + 512 + h * 128 + dv] = f2bf(ov[e] * rs[e] * gn * (g * sigm(g))); } }
    }
    __syncthreads();
}

__device__ __forceinline__ void lru_pass(const Args& a, Frame& F, int l, bool passB) {
    const WsMap m = ws_map(NTOK);
    const bf16_t* gt = (const bf16_t*)(a.ws + m.gates); const bf16_t* xc = (const bf16_t*)(a.ws + m.xc); const bf16_t* p16 = (const bf16_t*)(a.ws + m.p16);
    bf16_t* mix = (bf16_t*)(a.ws + m.mix16); float* lrs = (float*)(a.ws + m.lrs);
    for (int it = F.vcu * NTHR + F.tid; it < NBATCH * 64 * 512; it += F.G * NTHR) {
        const int ch = it & 511, bc = it >> 9, c = bc & 63;
        const float sp8 = 8.0f * softplus_f(-a.in[I_LRU_LAM][l * 512 + ch]);
        const size_t nb = (size_t)bc * 64;
        float hh = 0.f, ap = 1.f;
        if (passB) {
            for (int s0 = 0; s0 < c; s0 += 8) { f32x2 su[8];
#pragma unroll
                for (int u = 0; u < 8; ++u) su[u] = (s0 + u < c) ? *(const f32x2*)(lrs + ((size_t)(bc - c + s0 + u) * 512 + ch) * 2) : (f32x2){1.f, 0.f};
#pragma unroll
                for (int u = 0; u < 8; ++u) hh = su[u].x * hh + su[u].y; } }
#pragma unroll 1
        for (int t0 = 0; t0 < 64; t0 += 8) {
            bf16_t rr[8], ii[8], xx[8], yy[8];
#pragma unroll
            for (int u = 0; u < 8; ++u) { const size_t n = nb + t0 + u; rr[u] = gt[n * 1024 + ch]; ii[u] = gt[n * 1024 + 512 + ch]; xx[u] = xc[n * 512 + ch];
                yy[u] = passB ? p16[n * PLD + C_LRU + 512 + ch] : (bf16_t)0; }
#pragma unroll
            for (int u = 0; u < 8; ++u) { const size_t n = nb + t0 + u;
                const float la = -sp8 * sigm(bf2f(rr[u]));
                const float av = __expf(la);
                const float uu = bf2f(xx[u]) * sigm(bf2f(ii[u])) * sqrtf(fmaxf(1.0f - av * av, 0.0f));
                hh = av * hh + uu; ap *= av;
                if (passB) mix[n * DM + 1024 + ch] = f2bf(hh * gelu_fast(bf2f(yy[u]))); }
        }
        if (!passB) *(f32x2*)(lrs + ((size_t)bc * 512 + ch) * 2) = (f32x2){ap, hh};
    }
}

__device__ __forceinline__ void scan_phase(const Args& a, Frame& F, int l) {
    lru_pass(a, F, l, false);
    const int task = blockIdx.x;
    for (int q = 0; q < 8; ++q) rwkv_pa_chunk(a, F, l, task * 8 + q);
    for (int q = 0; q < 4; ++q) gdn_pa_chunk(a, F, task * 4 + q);
    for (int q = 0; q < 4; ++q) gla_pa_chunk(a, F, task * 4 + q);
    if (l == 0) tables_range(a, F, (size_t)2 * NEXP * DM / 32, (size_t)4 * NEXP * DM / 32, F.vcu, F.G);
}

__device__ __forceinline__ void post_phase(const Args& a, Frame& F, int l, const XcdBarrier& bar) {
    const WsMap m = ws_map(NTOK);
    if (blockIdx.x < 128) rwkv_ps_task(a, F, blockIdx.x); else gdn_ps_task(a, F, blockIdx.x - 128);
    gla_sscan(a, F);
    lru_pass(a, F, l, true);
    const bf16_t* p16 = (const bf16_t*)(a.ws + m.p16); const bf16_t* glao = (const bf16_t*)(a.ws + m.glao); const bf16_t* gdno = (const bf16_t*)(a.ws + m.gdno);
    const bf16_t* rwy = (const bf16_t*)(a.ws + m.rwy); const bf16_t* rwbv = (const bf16_t*)(a.ws + m.rwbv); const bf16_t* ao = (const bf16_t*)(a.ws + m.auxo);
    bf16_t* mix = (bf16_t*)(a.ws + m.mix16);
    const int lane = F.lane, col = lane * 8, hc = col & 127;
    float gg[8], gd[8], lw[8], lb[8];
    { const f32x4 x0 = *(const f32x4*)(a.in[I_GLA_NORM] + l * 128 + hc), x1 = *(const f32x4*)(a.in[I_GLA_NORM] + l * 128 + hc + 4);
      gg[0] = x0.x; gg[1] = x0.y; gg[2] = x0.z; gg[3] = x0.w; gg[4] = x1.x; gg[5] = x1.y; gg[6] = x1.z; gg[7] = x1.w;
      const f32x4 y0 = *(const f32x4*)(a.in[I_GDN_NORM] + l * 128 + hc), y1 = *(const f32x4*)(a.in[I_GDN_NORM] + l * 128 + hc + 4);
      gd[0] = y0.x; gd[1] = y0.y; gd[2] = y0.z; gd[3] = y0.w; gd[4] = y1.x; gd[5] = y1.y; gd[6] = y1.z; gd[7] = y1.w;
      const f32x4 w0 = *(const f32x4*)(a.in[I_RW_LN_W] + l * 512 + col), w1 = *(const f32x4*)(a.in[I_RW_LN_W] + l * 512 + col + 4);
      lw[0] = w0.x; lw[1] = w0.y; lw[2] = w0.z; lw[3] = w0.w; lw[4] = w1.x; lw[5] = w1.y; lw[6] = w1.z; lw[7] = w1.w;
      const f32x4 b0 = *(const f32x4*)(a.in[I_RW_LN_B] + l * 512 + col), b1 = *(const f32x4*)(a.in[I_RW_LN_B] + l * 512 + col + 4);
      lb[0] = b0.x; lb[1] = b0.y; lb[2] = b0.z; lb[3] = b0.w; lb[4] = b1.x; lb[5] = b1.y; lb[6] = b1.z; lb[7] = b1.w; }
    for (int pass = 1; pass < 2; ++pass) {
    if (pass == 1) xcd_barrier(bar);
    for (int q = 0; q < 4; ++q) gla_pb_chunk(a, F, l, blockIdx.x * 4 + q);
    for (int n = F.gw; n < NTOK; n += F.ngw) {
        if (pass == 1) {
            float y[8], bv[8], g[8];
            unpack8(ld8(rwy + (size_t)n * 512 + col), y); unpack8(ld8(rwbv + (size_t)n * 512 + col), bv); unpack8(ld8(ao + (size_t)n * 1792 + 1024 + col), g);
            float s = 0.f;
#pragma unroll
            for (int k = 0; k < 8; ++k) s += y[k];
            const float mean = red8(s) * (1.0f / 64.0f);
            float s2 = 0.f;
#pragma unroll
            for (int k = 0; k < 8; ++k) { y[k] -= mean; s2 += y[k] * y[k]; }
            const float rs = 1.0f / sqrtf(red8(s2) * (1.0f / 64.0f) + 64e-5f);
#pragma unroll
            for (int k = 0; k < 8; ++k) y[k] = (y[k] * rs * lw[k] + lb[k] + bv[k]) * g[k];
            *(v4u*)(mix + (size_t)n * DM + col) = pack8(y);
        }
        if (pass == 1)
#pragma unroll
        for (int which = 1; which < 2; ++which) {
            float o[8], g[8];
            unpack8(ld8((which ? gdno : glao) + (size_t)n * 512 + col), o);
            unpack8(ld8(p16 + (size_t)n * PLD + (which ? C_GDN + 1536 : C_GLA + 1024) + col), g);
            float ss = 0.f;
#pragma unroll
            for (int k = 0; k < 8; ++k) ss += o[k] * o[k];
            ss = row16_sum(ss);
            const float rs = 1.0f / sqrtf(ss * (1.0f / 128.0f) + 1e-6f);
#pragma unroll
            for (int k = 0; k < 8; ++k) o[k] = o[k] * rs * (which ? gd[k] : gg[k]) * (g[k] * sigm(g[k]));
            *(v4u*)(mix + (size_t)n * DM + (which ? 1536 : 512) + col) = pack8(o);
        }
    }
    }
}

__device__ __forceinline__ void norm2_phase(const Args& a, Frame& F, int l) {
    const WsMap m = ws_map(NTOK);
    const float* gain = a.in[I_NORM_FFN] + l * DM;
    f32x4 gv[8];
#pragma unroll
    for (int j = 0; j < 8; ++j) gv[j] = ((const f32x4*)gain)[64 * j + F.lane];
    for (int n = F.gw; n < NTOK; n += F.ngw) {
        const f32x4* xr = (const f32x4*)(a.out + (size_t)n * DM) + F.lane;
        f32x4 v[8]; float s = 0.f;
#pragma unroll
        for (int j = 0; j < 8; ++j) { v[j] = xr[64 * j]; s += (v[j].x * v[j].x + v[j].y * v[j].y) + (v[j].z * v[j].z + v[j].w * v[j].w); }
        const float rstd = 1.0f / sqrtf(wave_sum_u(s) * (1.0f / DM) + 1e-6f);
        v2u* o8 = (v2u*)((bf16_t*)(a.ws + m.hb) + (size_t)n * DM) + F.lane;
#pragma unroll
        for (int j = 0; j < 8; ++j) { v2u w; w.x = pk2(v[j].x * rstd * gv[j].x, v[j].y * rstd * gv[j].y); w.y = pk2(v[j].z * rstd * gv[j].z, v[j].w * rstd * gv[j].w); o8[64 * j] = w; }
    }
}

#define TK_CE(A, B) do { const float mx_ = fmaxf(A, B), mn_ = fminf(A, B); A = mx_; B = mn_; } while (0)
__device__ __forceinline__ void tk_sort16_desc(float (&x)[16]) {
#pragma unroll
    for (int k = 2; k <= 16; k <<= 1)
#pragma unroll
        for (int j = k >> 1; j > 0; j >>= 1)
#pragma unroll
            for (int i = 0; i < 16; ++i) { const int p = i ^ j;
                if (p > i) { if ((i & k) == 0) TK_CE(x[i], x[p]); else TK_CE(x[p], x[i]); } }
}
__device__ __forceinline__ void tk_merge16(float (&run)[16], const float (&g)[16]) {
#pragma unroll
    for (int i = 0; i < 16; ++i) run[i] = fmaxf(run[i], g[15 - i]);
#pragma unroll
    for (int j = 8; j > 0; j >>= 1)
#pragma unroll
        for (int i = 0; i < 16; ++i) { const int p = i ^ j; if (p > i) TK_CE(run[i], run[p]); }
}
__device__ __forceinline__ float tk_tag(float v, unsigned tag, unsigned mask) { return __builtin_bit_cast(float, (__builtin_bit_cast(unsigned, v) & ~mask) | tag); }
__device__ __forceinline__ void topk_phase(const Args& a, Frame& F) {
    const WsMap m = ws_map(NTOK);
    const float* sc = (const float*)(a.ws + m.sc);
    int* idx = (int*)(a.ws + m.idx); float* gate = (float*)(a.ws + m.gate);
    LAS float* LS = (LAS float*)F.lds;
    const int t = F.tid;
    for (int wv = F.gw; wv < (NTOK / 64) * 8; wv += F.ngw) {
        const int h = wv & 7, n = (wv >> 3) * 64 + F.lane;
        const float* sp = sc + (size_t)(h * 256) * NTOK + n;
        float s0[16], s1[16];
#pragma unroll
        for (int half = 0; half < 2; ++half) {
            float run[16];
#pragma unroll
            for (int j = 0; j < 16; ++j) run[j] = -3.0e38f;
#pragma unroll 1
            for (int g = 0; g < 8; ++g) {
                float x[16];
#pragma unroll
                for (int k = 0; k < 16; ++k) x[k] = tk_tag(sp[(size_t)(half * 128 + g * 16 + k) * NTOK], (unsigned)(g * 16 + k), 127u);
                tk_sort16_desc(x);
                tk_merge16(run, x);
            }
#pragma unroll
            for (int j = 0; j < 16; ++j) { if (half) s1[j] = run[j]; else s0[j] = run[j]; LS[(half * 16 + j) * 512 + t] = run[j]; }
        }
        float run[16];
#pragma unroll
        for (int j = 0; j < 16; ++j) run[j] = -3.0e38f;
        {
            float x[16]; int cnt = 0;
#pragma unroll
            for (int p = 0; p < 16; ++p)
#pragma unroll
                for (int q = 0; q < 16; ++q) if ((p + 1) * (q + 1) <= 16) {
                    x[cnt & 15] = tk_tag(s0[p] + s1[q], (unsigned)(p * 16 + q), 255u); ++cnt;
                    if ((cnt & 15) == 0) { tk_sort16_desc(x); tk_merge16(run, x); }
                }
#pragma unroll
            for (int k = 0; k < 16; ++k) if (k >= (cnt & 15)) x[k] = -3.0e38f;
            tk_sort16_desc(x); tk_merge16(run, x);
        }
        const float mx = run[0]; float den = 0.f; float e[16]; int ti[16];
#pragma unroll
        for (int j = 0; j < 16; ++j) {
            const unsigned tg = __builtin_bit_cast(unsigned, run[j]) & 255u; const int p = (int)(tg >> 4), q = (int)(tg & 15u);
            const unsigned k0 = __builtin_bit_cast(unsigned, LS[(0 * 16 + p) * 512 + t]) & 127u, k1 = __builtin_bit_cast(unsigned, LS[(1 * 16 + q) * 512 + t]) & 127u;
            ti[j] = (int)(k0 * 128u + k1);
            e[j] = __expf(run[j] - mx); den += e[j];
        }
        const float inv = 1.0f / den;
        const size_t it = (size_t)n * 8 + h;
        f32x4* go = (f32x4*)(gate + it * 16); v4u* io = (v4u*)(idx + it * 16);
#pragma unroll
        for (int j = 0; j < 4; ++j) { go[j] = (f32x4){e[4 * j] * inv, e[4 * j + 1] * inv, e[4 * j + 2] * inv, e[4 * j + 3] * inv};
            io[j] = (v4u){(unsigned)ti[4 * j], (unsigned)ti[4 * j + 1], (unsigned)ti[4 * j + 2], (unsigned)ti[4 * j + 3]}; }
    }
}

typedef float f32x2_t __attribute__((ext_vector_type(2)));
constexpr int PEER_R = 4;
__device__ __forceinline__ void peer_phase(const Args& a, Frame& F, int l) {
    const WsMap m = ws_map(NTOK);
    const unsigned char* TU = (const unsigned char*)(a.ws + m.tabu) + (size_t)l * 2 * NEXP * TROW;
    const unsigned char* TV = TU + (size_t)NEXP * TROW;
    const float* tsu = (const float*)(a.ws + m.tsc) + (size_t)l * 2 * NEXP; const float* tsv = tsu + NEXP;
    const int* idx = (const int*)(a.ws + m.idx); const float* gate = (const float*)(a.ws + m.gate);
    const int lane = F.lane;
    for (int n = F.gw; n < NTOK; n += F.ngw) {
        float xf[32];
        { const v4u* hr = (const v4u*)((const bf16_t*)(a.ws + m.hb) + (size_t)n * DM + lane * 32);
#pragma unroll
          for (int q = 0; q < 4; ++q) { const v4u w = hr[q];
              xf[8 * q + 0] = bflo(w.x); xf[8 * q + 1] = bfhi(w.x); xf[8 * q + 2] = bflo(w.y); xf[8 * q + 3] = bfhi(w.y); xf[8 * q + 4] = bflo(w.z); xf[8 * q + 5] = bfhi(w.z); xf[8 * q + 6] = bflo(w.w); xf[8 * q + 7] = bfhi(w.w); } }
        const int e0 = idx[(size_t)n * 128 + lane], e1 = idx[(size_t)n * 128 + 64 + lane];
        const float g0 = gate[(size_t)n * 128 + lane] * tsv[e0], g1 = gate[(size_t)n * 128 + 64 + lane] * tsv[e1];
        const float su0 = tsu[e0], su1 = tsu[e1];
        float d0 = 0.f, d1 = 0.f;
#pragma unroll
        for (int half = 0; half < 2; ++half) {
            const int ev = half ? e1 : e0; float dd = 0.f;
            for (int j = 0; j < 64; j += PEER_R) {
                v4u u[PEER_R];
#pragma unroll
                for (int r = 0; r < PEER_R; ++r) { const int e = __builtin_amdgcn_readlane(ev, j + r); u[r] = *(const v4u*)(TU + (size_t)e * TROW + lane * 16); }
#pragma unroll
                for (int r = 0; r < PEER_R; ++r) {
                    float a0 = 0.f, a1 = 0.f, a2 = 0.f, a3 = 0.f;
#pragma unroll
                    for (int d = 0; d < 4; ++d) {
                        const f32x2_t f0 = __builtin_amdgcn_cvt_scalef32_pk_f32_fp4(u[r][d], 1.0f, 0), f1 = __builtin_amdgcn_cvt_scalef32_pk_f32_fp4(u[r][d], 1.0f, 1);
                        const f32x2_t f2 = __builtin_amdgcn_cvt_scalef32_pk_f32_fp4(u[r][d], 1.0f, 2), f3 = __builtin_amdgcn_cvt_scalef32_pk_f32_fp4(u[r][d], 1.0f, 3);
                        a0 += f0.x * xf[8 * d]; a1 += f0.y * xf[8 * d + 1]; a2 += f1.x * xf[8 * d + 2]; a3 += f1.y * xf[8 * d + 3];
                        a0 += f2.x * xf[8 * d + 4]; a1 += f2.y * xf[8 * d + 5]; a2 += f3.x * xf[8 * d + 6]; a3 += f3.y * xf[8 * d + 7]; }
                    const float t = wave_sum_u((a0 + a1) + (a2 + a3));
                    dd = (lane == j + r) ? t : dd;
                }
            }
            if (half) d1 = dd; else d0 = dd;
        }
        const float c0 = gelu_fast(d0 * su0) * g0, c1 = gelu_fast(d1 * su1) * g1;
        float o[32];
#pragma unroll
        for (int i = 0; i < 32; ++i) o[i] = 0.f;
#pragma unroll
        for (int half = 0; half < 2; ++half) {
            const int ev = half ? e1 : e0; const float cv = half ? c1 : c0;
            for (int j = 0; j < 64; j += PEER_R) {
                v4u v[PEER_R]; float cj[PEER_R];
#pragma unroll
                for (int r = 0; r < PEER_R; ++r) { const int e = __builtin_amdgcn_readlane(ev, j + r); cj[r] = rdlane_f(cv, j + r); v[r] = *(const v4u*)(TV + (size_t)e * TROW + lane * 16); }
#pragma unroll
                for (int r = 0; r < PEER_R; ++r) {
#pragma unroll
                    for (int d = 0; d < 4; ++d) {
                        const f32x2_t f0 = __builtin_amdgcn_cvt_scalef32_pk_f32_fp4(v[r][d], 1.0f, 0), f1 = __builtin_amdgcn_cvt_scalef32_pk_f32_fp4(v[r][d], 1.0f, 1);
                        const f32x2_t f2 = __builtin_amdgcn_cvt_scalef32_pk_f32_fp4(v[r][d], 1.0f, 2), f3 = __builtin_amdgcn_cvt_scalef32_pk_f32_fp4(v[r][d], 1.0f, 3);
                        o[8 * d] += f0.x * cj[r]; o[8 * d + 1] += f0.y * cj[r]; o[8 * d + 2] += f1.x * cj[r]; o[8 * d + 3] += f1.y * cj[r];
                        o[8 * d + 4] += f2.x * cj[r]; o[8 * d + 5] += f2.y * cj[r]; o[8 * d + 6] += f3.x * cj[r]; o[8 * d + 7] += f3.y * cj[r]; }
                }
            }
        }
        float* xrow = a.out + (size_t)n * DM + lane * 32;
        float s = 0.f;
#pragma unroll
        for (int q = 0; q < 8; ++q) { const f32x4 x4 = *(const f32x4*)(xrow + 4 * q);
            o[4 * q] += x4.x; o[4 * q + 1] += x4.y; o[4 * q + 2] += x4.z; o[4 * q + 3] += x4.w;
            s += (o[4 * q] * o[4 * q] + o[4 * q + 1] * o[4 * q + 1]) + (o[4 * q + 2] * o[4 * q + 2] + o[4 * q + 3] * o[4 * q + 3]); }
        const float rstd = 1.0f / sqrtf(wave_sum_u(s) * (1.0f / DM) + 1e-6f);
        if (l + 1 < NL) {
            bf16_t* xo = (bf16_t*)(a.ws + m.xn) + (size_t)n * DM + lane * 32;
#pragma unroll
            for (int q = 0; q < 8; ++q) *(f32x4*)(xrow + 4 * q) = (f32x4){o[4 * q], o[4 * q + 1], o[4 * q + 2], o[4 * q + 3]};
#pragma unroll
            for (int q = 0; q < 4; ++q) { v4u w; w.x = pk2(o[8 * q] * rstd, o[8 * q + 1] * rstd); w.y = pk2(o[8 * q + 2] * rstd, o[8 * q + 3] * rstd); w.z = pk2(o[8 * q + 4] * rstd, o[8 * q + 5] * rstd); w.w = pk2(o[8 * q + 6] * rstd, o[8 * q + 7] * rstd);
                *(v4u*)(xo + 8 * q) = w; }
        } else {
            const float* gf = a.in[I_NORM_FINAL] + lane * 32;
#pragma unroll
            for (int q = 0; q < 8; ++q) { const f32x4 g4 = *(const f32x4*)(gf + 4 * q);
                *(f32x4*)(xrow + 4 * q) = (f32x4){o[4 * q] * rstd * g4.x, o[4 * q + 1] * rstd * g4.y, o[4 * q + 2] * rstd * g4.z, o[4 * q + 3] * rstd * g4.w}; }
        }
    }
}

#define IN(k) (lo <= (k) && (k) < hi)
#define SEAM(k) do { if (IN(k) && IN((k) + 1)) xcd_barrier(bar); } while (0)
template <int l>
__device__ __forceinline__ void layer_phases(const Args& a, Frame& F, const XcdBarrier& bar, const WsMap& m, int lo, int hi) {
    constexpr int pb = l * PH_PER_LAYER;
        if (IN(pb + PH_GEMM1)) {
            pg8::GemmX g{(const bf16_t*)(a.ws + m.xn), (const bf16_t*)(a.ws + m.w1t) + (size_t)l * PLD * DM, NTOK, PLD, DM, DM};
            pg8::StaticOrder S; S.init(NTOK, PLD, F.G, (int)blockIdx.x);
            pg8::EpiBf16 E{(bf16_t*)(a.ws + m.p16), PLD, nullptr};
            pg8::gemm_phase<pg8::EpiBf16, pg8::StaticOrder, true, true>(F.lds, g, S, E);
            SEAM(pb + PH_GEMM1);
        }
        if (IN(pb + PH_PREP)) { prep_phase(a, F, l); SEAM(pb + PH_PREP); }
        if (IN(pb + PH_AUX)) {
            const float* PP = (const float*)(a.ws + m.pp);
            { pg8::GemmX g{(const bf16_t*)(a.ws + m.auxA), (const bf16_t*)(a.ws + m.auxwt) + (size_t)l * 1792 * 384, NTOK, 1792, 384, 384};
              pg8::StaticOrder S; S.init(NTOK, 1792, F.G, (int)blockIdx.x);
              pg8::EpiBf16 E{(bf16_t*)(a.ws + m.auxo), 1792, PP + l * 1792};
              pg8::gemm_phase<pg8::EpiBf16, pg8::StaticOrder, true, true>(F.lds, g, S, E); }
            { pg8::GemmX g{(const bf16_t*)(a.ws + m.xc), (const bf16_t*)(a.ws + m.lruwt) + (size_t)l * 1024 * 512, NTOK, 1024, 512, 512};
              pg8::StaticOrder S; S.init(NTOK, 1024, F.G, (int)blockIdx.x);
              pg8::EpiBf16 E{(bf16_t*)(a.ws + m.gates), 1024, PP + 3584 + l * 1024};
              pg8::gemm_phase<pg8::EpiBf16, pg8::StaticOrder, true, true>(F.lds, g, S, E); }
            if (l > 0) {
              pg8::GemmX g{(const bf16_t*)(a.ws + m.zrkv) + 1024, (const bf16_t*)(a.ws + m.vreswt), NTOK, 512, 512, 1536};
              pg8::StaticOrder S; S.init(NTOK, 512, F.G, (int)blockIdx.x);
              pg8::EpiBf16 E{(bf16_t*)(a.ws + m.vres), 512, PP + 5632};
              pg8::gemm_phase<pg8::EpiBf16, pg8::StaticOrder, true, true>(F.lds, g, S, E); }
            SEAM(pb + PH_AUX);
        }
        if (IN(pb + PH_SCAN)) { scan_phase(a, F, l); SEAM(pb + PH_SCAN); }
        if (IN(pb + PH_POST)) { post_phase(a, F, l, bar); SEAM(pb + PH_POST); }
        if (IN(pb + PH_GEMM2)) {
            pg8::GemmX g{(const bf16_t*)(a.ws + m.mix16), (const bf16_t*)(a.ws + m.w2t) + (size_t)l * DM * DM, NTOK, DM, DM, DM};
            pg8::StaticOrder S; S.init(NTOK, DM, F.G, (int)blockIdx.x);
            pg8::EpiF32<true> E{a.out, DM};
            pg8::gemm_phase<pg8::EpiF32<true>, pg8::StaticOrder, true, true>(F.lds, g, S, E);
            SEAM(pb + PH_GEMM2);
        }
        if (IN(pb + PH_NORM2)) { norm2_phase(a, F, l); SEAM(pb + PH_NORM2); }
        if (IN(pb + PH_GEMM3)) {
            pg8::GemmX g{(const bf16_t*)(a.ws + m.wsct) + (size_t)l * DM * DM, (const bf16_t*)(a.ws + m.hb), DM, NTOK, DM, DM};
            pg8::StaticOrder S; S.init(DM, NTOK, F.G, (int)blockIdx.x);
            pg8::EpiF32<false> E{(float*)(a.ws + m.sc), NTOK};
            pg8::gemm_phase<pg8::EpiF32<false>, pg8::StaticOrder, true, true>(F.lds, g, S, E);
            SEAM(pb + PH_GEMM3);
        }
        if (IN(pb + PH_TOPK)) { topk_phase(a, F); SEAM(pb + PH_TOPK); }
        if (IN(pb + PH_PEER)) { peer_phase(a, F, l); SEAM(pb + PH_PEER); }
}

#undef IN
#undef SEAM
__global__ void __launch_bounds__(NTHR, 2) mega(Args a) {
    extern __shared__ __attribute__((aligned(16))) unsigned char lds_raw[];
    Frame F;
    F.lds = (LAS unsigned char*)lds_raw;
    F.tid = threadIdx.x; F.lane = F.tid & 63; F.wave = __builtin_amdgcn_readfirstlane(F.tid >> 6);
    F.G = gridDim.x; { const int bx = blockIdx.x; F.vcu = (F.G % 8 == 0) ? (bx % 8) * (F.G / 8) + bx / 8 : bx; }
    F.gw = F.vcu * NWAVES + F.wave; F.ngw = F.G * NWAVES;
    volatile LAS unsigned* MISC = (volatile LAS unsigned*)(F.lds + MISC_OFF);
    if (F.tid < 32) MISC[F.tid] = 0u;
    __syncthreads();
    const WsMap m = ws_map(NTOK);
    unsigned* ctl = (unsigned*)(a.ws + m.ctl);
    XcdBarrier bar; bar.bar = ctl + 4096 + a.li * XCD_BAR_WORDS; bar.x = 0; bar.st = nullptr;
    const int lo = a.ph_lo, hi = a.ph_hi;
    if (hi - lo > 1) bar = xcd_barrier_post(ctl + 4096 + a.li * XCD_BAR_WORDS, MISC + 8);
#define IN(k) (lo <= (k) && (k) < hi)
#define SEAM(k) do { if (IN(k) && IN((k) + 1)) xcd_barrier(bar); } while (0)
    if (IN(PH_P0)) { p0_prologue(a, F); tables_range(a, F, 0, (size_t)2 * NEXP * DM / 32, F.vcu, F.G); SEAM(PH_P0); }
    layer_phases<0>(a, F, bar, m, lo, hi);
    layer_phases<1>(a, F, bar, m, lo, hi);
#undef IN
#undef SEAM
}

template <int ST>
__global__ void __launch_bounds__(256) stage_kernel(Params P, int l) {
    const long n = stage_items(P, ST, l);
    for (long it = blockIdx.x * 256L + threadIdx.x; it < n; it += gridDim.x * 256L) run_item(P, ST, l, it);
}
template <int ST>
static void launch_stage(const Params& P, int l, hipStream_t stream) {
    const long n = stage_items(P, ST, l);
    if (n <= 0) return;
    long blocks = (n + 255) / 256;
    if (blocks > 8192) blocks = 8192;
    stage_kernel<ST><<<dim3((unsigned)blocks), dim3(256), 0, stream>>>(P, l);
}
#define LS(X) case X: launch_stage<X>(P, l, stream); break;
static void launch_any(int st, const Params& P, int l, hipStream_t stream) {
    switch (st) {
        LS(ST_COPYX) LS(ST_RSTD) LS(ST_NORM1) LS(ST_GEMM1) LS(ST_RW_A0) LS(ST_RW_A1) LS(ST_RW_A2) LS(ST_RW_A3) LS(ST_RW_KKN)
        LS(ST_RW_SCAN) LS(ST_RW_POST) LS(ST_GLA_B0) LS(ST_GLA_SCAN) LS(ST_GLA_POST) LS(ST_LRU_C0) LS(ST_LRU_C1) LS(ST_LRU_SCAN)
        LS(ST_GDN_D0) LS(ST_GDN_D1) LS(ST_GDN_SCAN) LS(ST_GDN_POST) LS(ST_GEMM2) LS(ST_RSTD2) LS(ST_NORM2) LS(ST_GEMM3)
        LS(ST_SCORES) LS(ST_TOPK1) LS(ST_TOPK2) LS(ST_PEER_U) LS(ST_PEER_V) LS(ST_FRSTD) LS(ST_FNORM)
    }
}

extern "C" void kernel_launch(void* const* d_in, const int* in_sizes, int n_in, void* d_out, int out_size, void* d_ws,
                              size_t ws_size, hipStream_t stream) {
    static int grid = 0;
    if (grid == 0) {
        int dev = 0, cus = 0;
        (void)hipGetDevice(&dev);
        (void)hipDeviceGetAttribute(&cus, hipDeviceAttributeMultiprocessorCount, dev);
        (void)hipFuncSetAttribute((const void*)mega, hipFuncAttributeMaxDynamicSharedMemorySize, LDS_BYTES);
        grid = cus > 0 ? cus : 256;
    }
    Params P;
    memset(&P, 0, sizeof(P));
    fill_inputs(P, d_in);
    P.B = 4; P.T = 4096; P.N = 16384; P.pad = 0;
    P.xcur = (float*)d_out;
    bind_ws(P, (char*)d_ws);
    Args a;
    memset(&a, 0, sizeof(a));
    for (int i = 0; i < 38; ++i) a.in[i] = (const float*)d_in[i];
    a.out = (float*)d_out; a.ws = (unsigned char*)d_ws;
    (void)hipMemsetAsync(d_ws, 0, 1u << 20, stream);
    int li = 0;
    auto run_mega = [&](int lo, int hi) { a.ph_lo = lo; a.ph_hi = hi; a.li = li++; hipLaunchKernelGGL(mega, dim3(grid), dim3(NTHR), LDS_BYTES, stream, a); };
    run_mega(PH_P0, PH_TOTAL);
}
#endif
```

```cpp
#ifndef HOST_EMU
#include <hip/hip_runtime.h>
#include <cstring>
#define HD __host__ __device__ __forceinline__
#else
#include <cmath>
#include <cstdio>
#include <cstdlib>
#include <cstring>
#define HD inline
#endif

constexpr int DM = 2048;
constexpr int NL = 2;
constexpr int INC = 6424;
constexpr int C_RW = 0;
constexpr int C_GLA = 1792;
constexpr int C_LRU = 3344;
constexpr int C_GDN = 4368;
constexpr int NEXP = 16384;

typedef unsigned short bf16_t;
constexpr int PLD = 6656;
HD float bf2f(bf16_t h) { unsigned u = (unsigned)h << 16; float f; memcpy(&f, &u, 4); return f; }
HD bf16_t f2bf(float f) { unsigned u; memcpy(&u, &f, 4); return (bf16_t)((u + 0x7fffu + ((u >> 16) & 1u)) >> 16); }

struct Params {
    const float *x, *norm_mix, *w_in, *w_out, *rw_mu, *rw_w0, *rw_w_up, *rw_a0, *rw_a_up, *rw_g_up, *rw_k_k, *rw_k_a,
        *rw_r_k, *rw_ln_w, *rw_ln_b, *rw_v0, *rw_v_down, *rw_v_up, *gla_a_up, *gla_a_bias, *gla_norm, *lru_conv_w,
        *lru_conv_b, *lru_w_r, *lru_b_r, *lru_w_i, *lru_b_i, *lru_lam, *gdn_conv_w, *gdn_a_log, *gdn_dt_bias, *gdn_norm,
        *norm_ffn, *peer_wq, *peer_sub_keys, *peer_u, *peer_v, *norm_final;
    float* xcur;
    bf16_t* xn;
    bf16_t* hb;
    bf16_t* mix16;
    bf16_t* p16;
    float* sc;
    float* qf;
    float* rstd;
    float* vfirst;
    float* scr;
    float* act;
    float* gate;
    int* idx;
    int B, T, N, pad;
};

HD float sigmoidf_(float x) { return 1.0f / (1.0f + expf(-x)); }
HD float softplusf_(float x) { return log1pf(expf(-fabsf(x))) + fmaxf(x, 0.0f); }
HD float siluf_(float x) { return x * sigmoidf_(x); }
HD float geluf_(float x) { return 0.5f * x * (1.0f + tanhf(0.7978845608028654f * (x + 0.044715f * x * x * x))); }

enum Stage {
    ST_COPYX = 0,
    ST_RSTD, ST_NORM1, ST_GEMM1,
    ST_RW_A0, ST_RW_A1, ST_RW_A2, ST_RW_A3, ST_RW_KKN, ST_RW_SCAN, ST_RW_POST,
    ST_GLA_B0, ST_GLA_SCAN, ST_GLA_POST,
    ST_LRU_C0, ST_LRU_C1, ST_LRU_SCAN,
    ST_GDN_D0, ST_GDN_D1, ST_GDN_SCAN, ST_GDN_POST,
    ST_GEMM2, ST_RSTD2, ST_NORM2, ST_GEMM3, ST_SCORES, ST_TOPK1, ST_TOPK2, ST_PEER_U, ST_PEER_V,
    ST_FRSTD, ST_FNORM,
    ST_COUNT
};

constexpr long SO_ZS = 0, SO_R = 256, SO_DEC = 768, SO_KM = 1280, SO_KK = 1792, SO_A = 2304, SO_G = 2816, SO_V = 3328,
               SO_Y = 3840, SO_VD = 4352, SO_KKINV = 4384;
constexpr long SO_ALPHA = 0, SO_GO = 256;
constexpr long SO_XC = 0, SO_LA = 512, SO_LU = 1024;
constexpr long SO_QKV = 0, SO_GS = 1536, SO_DO = 1552;
constexpr long SCR_PER_TOK = 4400;
constexpr long SO_TS = 0, SO_TI = 256;

HD long stage_items(const Params& P, int st, int l) {
    const long N = P.N;
    switch (st) {
        case ST_COPYX: return N * DM;
        case ST_RSTD: case ST_RSTD2: case ST_FRSTD: return N;
        case ST_NORM1: case ST_NORM2: case ST_FNORM: return N * DM;
        case ST_GEMM1: return (N / 4) * (INC / 4);
        case ST_RW_A0: return N * 256;
        case ST_RW_A1: return N * 512;
        case ST_RW_A2: return l > 0 ? N * 32 : 0;
        case ST_RW_A3: return l > 0 ? N * 512 : 0;
        case ST_RW_KKN: return N * 8;
        case ST_RW_SCAN: return (long)P.B * 512;
        case ST_RW_POST: return N * 8;
        case ST_GLA_B0: return N * 256;
        case ST_GLA_SCAN: return (long)P.B * 512;
        case ST_GLA_POST: return N * 4;
        case ST_LRU_C0: return N * 512;
        case ST_LRU_C1: return N * 512;
        case ST_LRU_SCAN: return (long)P.B * 512;
        case ST_GDN_D0: return N * 1536;
        case ST_GDN_D1: return N * 4;
        case ST_GDN_SCAN: return (long)P.B * 512;
        case ST_GDN_POST: return N * 4;
        case ST_GEMM2: case ST_GEMM3: return (N / 4) * (DM / 4);
        case ST_SCORES: return N * 2048;
        case ST_TOPK1: return N * 16;
        case ST_TOPK2: return N * 8;
        case ST_PEER_U: return N * 128;
        case ST_PEER_V: return N * DM;
    }
    return 0;
}

HD void gemm_item(const bf16_t* A, const float* W, int ldw, const float* kscale, float* Cf, bf16_t* Ch, int ldc, int n4, long item, int mode) {
    const long r4 = item / n4;
    const int c4 = (int)(item % n4);
    const bf16_t* a0 = A + (r4 * 4) * (long)DM;
    const float* w = W + c4 * 4;
    float acc[4][4];
    for (int i = 0; i < 4; ++i)
        for (int j = 0; j < 4; ++j) acc[i][j] = 0.f;
    for (int k = 0; k < DM; ++k) {
        const float ks = kscale ? kscale[k] : 1.0f;
        const float w0 = w[(long)k * ldw + 0] * ks, w1 = w[(long)k * ldw + 1] * ks, w2 = w[(long)k * ldw + 2] * ks, w3 = w[(long)k * ldw + 3] * ks;
#pragma unroll
        for (int i = 0; i < 4; ++i) {
            const float a = bf2f(a0[(long)i * DM + k]);
            acc[i][0] += a * w0; acc[i][1] += a * w1; acc[i][2] += a * w2; acc[i][3] += a * w3;
        }
    }
#pragma unroll
    for (int i = 0; i < 4; ++i) {
        const long o = (r4 * 4 + i) * (long)ldc + c4 * 4;
#pragma unroll
        for (int j = 0; j < 4; ++j) {
            if (mode == 0) Ch[o + j] = f2bf(acc[i][j]);
            else if (mode == 1) Cf[o + j] += acc[i][j];
            else Cf[o + j] = acc[i][j];
        }
    }
}

#define PF(n, col) bf2f(P.p16[(long)(n) * PLD + (col)])
HD float rw_shift(const Params& P, int l, long n, int col) {
    const int t = (int)(n % P.T);
    const float cur = PF(n, C_RW + col);
    const float prev = t > 0 ? PF(n - 1, C_RW + col) : 0.f;
    return cur + (prev - cur) * P.rw_mu[l * 1792 + col];
}

HD void run_item(const Params& P, int st, int l, long it) {
    const long N = P.N;
    float* scr = P.scr;
    switch (st) {
        case ST_COPYX: P.xcur[it] = P.x[it]; break;
        case ST_RSTD: case ST_RSTD2: case ST_FRSTD: {
            const float* xr = P.xcur + it * DM;
            float s = 0.f;
            for (int d = 0; d < DM; ++d) s += xr[d] * xr[d];
            P.rstd[it] = 1.0f / sqrtf(s * (1.0f / DM) + 1e-6f);
        } break;
        case ST_NORM1: case ST_NORM2: case ST_FNORM: {
            const long n = it / DM; const int d = (int)(it % DM);
            if (st == ST_NORM1) P.xn[it] = f2bf(P.xcur[it] * P.rstd[n]);
            else if (st == ST_NORM2) P.hb[it] = f2bf(P.xcur[it] * P.rstd[n] * P.norm_ffn[l * DM + d]);
            else P.xcur[it] = P.xcur[it] * P.rstd[n] * P.norm_final[d];
        } break;
        case ST_GEMM1: gemm_item(P.xn, P.w_in + (long)l * DM * INC, INC, P.norm_mix + l * DM, nullptr, P.p16, PLD, INC / 4, it, 0); break;
        case ST_GEMM2: gemm_item(P.mix16, P.w_out + (long)l * DM * DM, DM, nullptr, P.xcur, nullptr, DM, DM / 4, it, 1); break;
        case ST_GEMM3: gemm_item(P.hb, P.peer_wq + (long)l * DM * DM, DM, nullptr, P.qf, nullptr, DM, DM / 4, it, 2); break;
        case ST_RW_A0: {
            const long n = it / 256; const int c = (int)(it % 256);
            const float z = rw_shift(P, l, n, 1536 + c);
            scr[N * SO_ZS + it] = c < 64 ? tanhf(z) : (c < 128 ? z : sigmoidf_(z));
        } break;
        case ST_RW_A1: {
            const long n = it / 512; const int j = (int)(it % 512);
            const float zr = rw_shift(P, l, n, j), zk = rw_shift(P, l, n, 512 + j), zv = rw_shift(P, l, n, 1024 + j);
            const float* zs = scr + N * SO_ZS + n * 256;
            float aw = P.rw_w0[l * 512 + j], aa = P.rw_a0[l * 512 + j], ag = 0.f;
            const float* wu = P.rw_w_up + (long)l * 64 * 512 + j;
            const float* au = P.rw_a_up + (long)l * 64 * 512 + j;
            const float* gu = P.rw_g_up + (long)l * 128 * 512 + j;
            for (int i = 0; i < 64; ++i) { aw += zs[i] * wu[i * 512]; aa += zs[64 + i] * au[i * 512]; }
            for (int i = 0; i < 128; ++i) ag += zs[128 + i] * gu[i * 512];
            const float w_raw = -softplusf_(-aw) - 0.5f;
            const float a = sigmoidf_(aa);
            scr[N * SO_R + it] = zr;
            scr[N * SO_DEC + it] = expf(-expf(w_raw));
            scr[N * SO_KM + it] = zk * (1.0f + (a - 1.0f) * P.rw_k_a[l * 512 + j]);
            scr[N * SO_KK + it] = zk * P.rw_k_k[l * 512 + j];
            scr[N * SO_A + it] = a;
            scr[N * SO_G + it] = ag;
            scr[N * SO_V + it] = zv;
            if (l == 0) P.vfirst[it] = zv;
        } break;
        case ST_RW_A2: {
            const long n = it / 32; const int i = (int)(it % 32);
            const float* v = scr + N * SO_V + n * 512;
            const float* vdn = P.rw_v_down + (long)(l - 1) * 512 * 32 + i;
            float s = 0.f;
            for (int j = 0; j < 512; ++j) s += v[j] * vdn[j * 32];
            scr[N * SO_VD + it] = s;
        } break;
        case ST_RW_A3: {
            const long n = it / 512; const int j = (int)(it % 512);
            const float* vd = scr + N * SO_VD + n * 32;
            const float* vup = P.rw_v_up + (long)(l - 1) * 32 * 512 + j;
            float s = P.rw_v0[(l - 1) * 512 + j];
            for (int i = 0; i < 32; ++i) s += vd[i] * vup[i * 512];
            const float v = scr[N * SO_V + it];
            scr[N * SO_V + it] = v + (P.vfirst[it] - v) * sigmoidf_(s);
        } break;
        case ST_RW_KKN: {
            const float* kk = scr + N * SO_KK + it * 64;
            float s = 0.f;
            for (int i = 0; i < 64; ++i) s += kk[i] * kk[i];
            scr[N * SO_KKINV + it] = 1.0f / sqrtf(fmaxf(s, 1e-24f));
        } break;
        case ST_RW_SCAN: {
            const int b = (int)(it / 512); const int h = (int)((it % 512) / 64); const int v = (int)(it % 64);
            float S[64];
#pragma unroll
            for (int i = 0; i < 64; ++i) S[i] = 0.f;
            for (int t = 0; t < P.T; ++t) {
                const long n = (long)b * P.T + t;
                const long base = n * 512 + h * 64;
                const float inv = scr[N * SO_KKINV + n * 8 + h];
                const float vv = scr[N * SO_V + base + v];
                const float* KK = scr + N * SO_KK + base;
                const float* DEC = scr + N * SO_DEC + base;
                const float* KM = scr + N * SO_KM + base;
                const float* AA = scr + N * SO_A + base;
                const float* RR = scr + N * SO_R + base;
                float sa = 0.f;
#pragma unroll
                for (int i = 0; i < 64; ++i) sa += S[i] * (-KK[i] * inv);
                float y = 0.f;
#pragma unroll
                for (int i = 0; i < 64; ++i) {
                    const float kk = KK[i] * inv;
                    S[i] = S[i] * DEC[i] + sa * (kk * AA[i]) + vv * KM[i];
                    y += S[i] * RR[i];
                }
                scr[N * SO_Y + base + v] = y;
            }
        } break;
        case ST_RW_POST: {
            const long n = it / 8; const int h = (int)(it % 8);
            const long base = n * 512 + h * 64;
            const float* Y = scr + N * SO_Y + base;
            const float* RR = scr + N * SO_R + base;
            const float* KM = scr + N * SO_KM + base;
            const float* V = scr + N * SO_V + base;
            const float* G = scr + N * SO_G + base;
            float mean = 0.f, bon = 0.f;
            for (int i = 0; i < 64; ++i) { mean += Y[i]; bon += RR[i] * KM[i] * P.rw_r_k[l * 512 + h * 64 + i]; }
            mean *= (1.0f / 64);
            float var = 0.f;
            for (int i = 0; i < 64; ++i) { const float d = Y[i] - mean; var += d * d; }
            const float rs = 1.0f / sqrtf(var * (1.0f / 64) + 64e-5f);
            for (int i = 0; i < 64; ++i) {
                const int c = h * 64 + i;
                const float yn = (Y[i] - mean) * rs * P.rw_ln_w[l * 512 + c] + P.rw_ln_b[l * 512 + c];
                P.mix16[n * DM + c] = f2bf((yn + bon * V[i]) * G[i]);
            }
        } break;
        case ST_GLA_B0: {
            const long n = it / 256; const int c = (int)(it % 256);
            float s = P.gla_a_bias[l * 256 + c];
            for (int i = 0; i < 16; ++i) s += PF(n, C_GLA + 1536 + i) * P.gla_a_up[(long)l * 16 * 256 + i * 256 + c];
            scr[N * SO_ALPHA + it] = expf(-softplusf_(-s) * (1.0f / 16.0f));
        } break;
        case ST_GLA_SCAN: {
            const int b = (int)(it / 512); const int h = (int)((it % 512) / 128); const int v = (int)(it % 128);
            float S[64];
#pragma unroll
            for (int i = 0; i < 64; ++i) S[i] = 0.f;
            for (int t = 0; t < P.T; ++t) {
                const long n = (long)b * P.T + t;
                const bf16_t* q = P.p16 + n * PLD + C_GLA + h * 64;
                const bf16_t* k = q + 256;
                const float vv = PF(n, C_GLA + 512 + h * 128 + v);
                const float* al = scr + N * SO_ALPHA + n * 256 + h * 64;
                float o = 0.f;
#pragma unroll
                for (int i = 0; i < 64; ++i) {
                    S[i] = S[i] * al[i] + bf2f(k[i]) * vv;
                    o += bf2f(q[i]) * S[i];
                }
                scr[N * SO_GO + n * 512 + h * 128 + v] = o * 0.125f;
            }
        } break;
        case ST_GLA_POST: {
            const long n = it / 4; const int h = (int)(it % 4);
            const float* o = scr + N * SO_GO + n * 512 + h * 128;
            float ms = 0.f;
            for (int i = 0; i < 128; ++i) ms += o[i] * o[i];
            const float rs = 1.0f / sqrtf(ms * (1.0f / 128) + 1e-6f);
            for (int i = 0; i < 128; ++i) {
                const float g = PF(n, C_GLA + 1024 + h * 128 + i);
                P.mix16[n * DM + 512 + h * 128 + i] = f2bf(o[i] * rs * P.gla_norm[l * 128 + i] * siluf_(g));
            }
        } break;
        case ST_LRU_C0: {
            const long n = it / 512; const int c = (int)(it % 512);
            const int t = (int)(n % P.T);
            float s = P.lru_conv_b[l * 512 + c];
            for (int j = 0; j < 4; ++j) {
                const int tt = t - 3 + j;
                if (tt >= 0) s += P.lru_conv_w[(long)l * 4 * 512 + j * 512 + c] * PF(n - 3 + j, C_LRU + c);
            }
            scr[N * SO_XC + it] = s;
        } break;
        case ST_LRU_C1: {
            const long n = it / 512; const int c = (int)(it % 512);
            const int blk = c / 64, j = c % 64;
            const float* xc = scr + N * SO_XC + n * 512 + blk * 64;
            const float* wr = P.lru_w_r + (long)l * 8 * 64 * 64 + (long)blk * 64 * 64 + j;
            const float* wi = P.lru_w_i + (long)l * 8 * 64 * 64 + (long)blk * 64 * 64 + j;
            float sr = P.lru_b_r[l * 512 + c], si = P.lru_b_i[l * 512 + c];
            for (int i = 0; i < 64; ++i) { sr += xc[i] * wr[i * 64]; si += xc[i] * wi[i * 64]; }
            const float r = sigmoidf_(sr), ig = sigmoidf_(si);
            const float log_a = -8.0f * r * softplusf_(-P.lru_lam[l * 512 + c]);
            scr[N * SO_LA + it] = expf(log_a);
            scr[N * SO_LU + it] = scr[N * SO_XC + it] * ig * sqrtf(-expm1f(2.0f * log_a));
        } break;
        case ST_LRU_SCAN: {
            const int b = (int)(it / 512); const int c = (int)(it % 512);
            float hst = 0.f;
            for (int t = 0; t < P.T; ++t) {
                const long n = (long)b * P.T + t;
                hst = scr[N * SO_LA + n * 512 + c] * hst + scr[N * SO_LU + n * 512 + c];
                P.mix16[n * DM + 1024 + c] = f2bf(hst * geluf_(PF(n, C_LRU + 512 + c)));
            }
        } break;
        case ST_GDN_D0: {
            const long n = it / 1536; const int c = (int)(it % 1536);
            const int t = (int)(n % P.T);
            float s = 0.f;
            for (int j = 0; j < 4; ++j) {
                const int tt = t - 3 + j;
                if (tt >= 0) s += P.gdn_conv_w[(long)l * 4 * 1536 + j * 1536 + c] * PF(n - 3 + j, C_GDN + c);
            }
            scr[N * SO_QKV + it] = siluf_(s);
        } break;
        case ST_GDN_D1: {
            const long n = it / 4; const int h = (int)(it % 4);
            const float* q = scr + N * SO_QKV + n * 1536 + h * 128;
            const float* k = q + 512;
            float qs = 0.f, ks = 0.f;
            for (int i = 0; i < 128; ++i) { qs += q[i] * q[i]; ks += k[i] * k[i]; }
            float* gs = scr + N * SO_GS + n * 16 + h * 4;
            gs[0] = (1.0f / sqrtf(qs + 1e-6f)) * 0.08838834764831845f;
            gs[1] = 1.0f / sqrtf(ks + 1e-6f);
            gs[2] = sigmoidf_(PF(n, C_GDN + 2048 + h));
            gs[3] = expf(-expf(P.gdn_a_log[l * 4 + h]) * softplusf_(PF(n, C_GDN + 2052 + h) + P.gdn_dt_bias[l * 4 + h]));
        } break;
        case ST_GDN_SCAN: {
            const int b = (int)(it / 512); const int h = (int)((it % 512) / 128); const int v = (int)(it % 128);
            float S[128];
#pragma unroll
            for (int i = 0; i < 128; ++i) S[i] = 0.f;
            for (int t = 0; t < P.T; ++t) {
                const long n = (long)b * P.T + t;
                const float* q = scr + N * SO_QKV + n * 1536 + h * 128;
                const float* k = q + 512;
                const float vv = scr[N * SO_QKV + n * 1536 + 1024 + h * 128 + v];
                const float* gs = scr + N * SO_GS + n * 16 + h * 4;
                const float qinv = gs[0], kinv = gs[1], beta = gs[2], eg = gs[3];
                float dk = 0.f;
#pragma unroll
                for (int i = 0; i < 128; ++i) dk += S[i] * k[i];
                const float u = beta * (vv - eg * kinv * dk) * kinv;
                float o = 0.f;
#pragma unroll
                for (int i = 0; i < 128; ++i) {
                    S[i] = S[i] * eg + u * k[i];
                    o += S[i] * q[i];
                }
                scr[N * SO_DO + n * 512 + h * 128 + v] = o * qinv;
            }
        } break;
        case ST_GDN_POST: {
            const long n = it / 4; const int h = (int)(it % 4);
            const float* o = scr + N * SO_DO + n * 512 + h * 128;
            float ms = 0.f;
            for (int i = 0; i < 128; ++i) ms += o[i] * o[i];
            const float rs = 1.0f / sqrtf(ms * (1.0f / 128) + 1e-6f);
            for (int i = 0; i < 128; ++i) {
                const float z = PF(n, C_GDN + 1536 + h * 128 + i);
                P.mix16[n * DM + 1536 + h * 128 + i] = f2bf(o[i] * rs * P.gdn_norm[l * 128 + i] * siluf_(z));
            }
        } break;
        case ST_SCORES: {
            const long n = it / 2048; const int c = (int)(it % 2048);
            const int hp = c / 128, key = c % 128;
            const float* q = P.qf + n * DM + hp * 128;
            const float* sk = P.peer_sub_keys + (long)l * 16 * 128 * 128 + ((long)hp * 128 + key) * 128;
            float s = 0.f;
            for (int d = 0; d < 128; ++d) s += q[d] * sk[d];
            P.sc[it] = s;
        } break;
        case ST_TOPK1: {
            const float* sc = P.sc + it * 128;
            float ts[16]; int ti[16];
#pragma unroll
            for (int j = 0; j < 16; ++j) { ts[j] = -3.0e38f; ti[j] = 0; }
            for (int i = 0; i < 128; ++i) {
                float xv = sc[i]; int xi = i;
                if (xv > ts[15]) {
#pragma unroll
                    for (int j = 0; j < 16; ++j) {
                        if (xv > ts[j]) { const float tv = ts[j]; const int tj = ti[j]; ts[j] = xv; ti[j] = xi; xv = tv; xi = tj; }
                    }
                }
            }
            float* TS = scr + N * SO_TS + it * 16;
            int* TI = (int*)(scr + N * SO_TI) + it * 16;
#pragma unroll
            for (int j = 0; j < 16; ++j) { TS[j] = ts[j]; TI[j] = ti[j]; }
        } break;
        case ST_TOPK2: {
            const float* s0 = scr + N * SO_TS + it * 32;
            const float* s1 = s0 + 16;
            const int* i0 = (const int*)(scr + N * SO_TI) + it * 32;
            const int* i1 = i0 + 16;
            float ts[16]; int ti[16];
#pragma unroll
            for (int j = 0; j < 16; ++j) { ts[j] = -3.0e38f; ti[j] = 0; }
            for (int a = 0; a < 16; ++a) {
                const int jmax = 16 / (a + 1);
                for (int b = 0; b < jmax; ++b) {
                    float xv = s0[a] + s1[b]; int xi = i0[a] * 128 + i1[b];
                    if (xv > ts[15]) {
#pragma unroll
                        for (int j = 0; j < 16; ++j) {
                            if (xv > ts[j]) { const float tv = ts[j]; const int tj = ti[j]; ts[j] = xv; ti[j] = xi; xv = tv; xi = tj; }
                        }
                    }
                }
            }
            const float mx = ts[0];
            float den = 0.f;
#pragma unroll
            for (int j = 0; j < 16; ++j) { ts[j] = expf(ts[j] - mx); den += ts[j]; }
            const float inv = 1.0f / den;
#pragma unroll
            for (int j = 0; j < 16; ++j) { P.gate[it * 16 + j] = ts[j] * inv; P.idx[it * 16 + j] = ti[j]; }
        } break;
        case ST_PEER_U: {
            const long n = it / 128;
            const int e = P.idx[it];
            const float* u = P.peer_u + ((long)l * NEXP + e) * DM;
            const bf16_t* hx = P.hb + n * DM;
            float s = 0.f;
            for (int d = 0; d < DM; ++d) s += bf2f(hx[d]) * u[d];
            P.act[it] = geluf_(s) * P.gate[it];
        } break;
        case ST_PEER_V: {
            const long n = it / DM; const int d = (int)(it % DM);
            const float* a = P.act + n * 128;
            const int* ix = P.idx + n * 128;
            float s = 0.f;
            for (int j = 0; j < 128; ++j) s += a[j] * P.peer_v[((long)l * NEXP + ix[j]) * DM + d];
            P.xcur[it] += s;
        } break;
    }
}


struct WsMap {
    size_t ctl, w1t, w2t, wsct, auxwt, lruwt, vreswt, pp, tabu, tabv, tsc, xn, hb, mix16, p16, sc, aux, vfirst, idx, gate, rstd, act, end;
    size_t auxA, zrkv, xc, auxo, gates, vres, glao, gdno, gq, gk, gv, gsc, rwy, rwbv, lrs, gblob, glas, gladv;
    size_t scr, qf;
};
HD WsMap ws_map(size_t N) {
    WsMap m{};
    size_t o = 0;
    auto take = [&](size_t bytes) { size_t r = o; o += (bytes + 4095) & ~(size_t)4095; return r; };
    m.ctl = take(1u << 20);
    m.w1t = take((size_t)NL * PLD * DM * 2);
    m.w2t = take((size_t)NL * DM * DM * 2);
    m.wsct = take((size_t)NL * DM * DM * 2);
    m.auxwt = take((size_t)NL * 1792 * 384 * 2);
    m.lruwt = take((size_t)NL * 1024 * 512 * 2);
    m.vreswt = take((size_t)512 * 512 * 2);
    m.pp = take(1u << 20);
    m.xn = take(N * DM * 2);
    m.hb = take(N * DM * 2);
    m.mix16 = take(N * DM * 2);
    m.p16 = take(N * PLD * 2);
    m.sc = m.p16;
    m.vfirst = take(N * 512 * 4);
    m.idx = take(N * 128 * 4);
    m.gate = take(N * 128 * 4);
    m.act = take(N * 128 * 4);
    m.rstd = take(N * 4);
    m.tabu = take((size_t)NL * 2 * NEXP * 1024);
    m.tabv = m.tabu + (size_t)NEXP * 1024;
    m.tsc = take((size_t)NL * 2 * NEXP * 4);
    m.aux = take(N * 5888 * 4);
    m.end = o;
    size_t a = m.aux;
    auto sub = [&](size_t bytes) { size_t r = a; a += (bytes + 4095) & ~(size_t)4095; return r; };
    m.auxA = sub(N * 384 * 2); m.zrkv = sub(N * 1536 * 2); m.xc = sub(N * 512 * 2); m.auxo = sub(N * 1792 * 2);
    m.gates = sub(N * 1024 * 2); m.vres = sub(N * 512 * 2); m.glao = sub(N * 512 * 2); m.gdno = sub(N * 512 * 2);
    m.gq = sub(N * 512 * 2); m.gk = sub(N * 512 * 2); m.gv = sub(N * 512 * 2); m.gsc = sub(N * 8 * 4); m.rwy = sub(N * 512 * 2); m.rwbv = sub(N * 512 * 2); m.lrs = sub(N / 64 * 512 * 2 * 4);
    m.gblob = sub(N / 64 * 4 * 26880);
    m.glas = sub(N / 64 * 4 * 8192 * 2); m.gladv = sub(N / 64 * 4 * 64 * 4);
    m.scr = m.tabu;
    m.qf = m.aux + N * 3584 * 4;
    return m;
}
static inline void bind_ws(Params& P, char* ws) {
    const WsMap m = ws_map((size_t)P.N);
    P.xn = (bf16_t*)(ws + m.xn); P.hb = (bf16_t*)(ws + m.hb); P.mix16 = (bf16_t*)(ws + m.mix16); P.p16 = (bf16_t*)(ws + m.p16);
    P.sc = (float*)(ws + m.sc); P.qf = (float*)(ws + m.qf); P.rstd = (float*)(ws + m.rstd); P.vfirst = (float*)(ws + m.vfirst);
    P.scr = (float*)(ws + m.scr); P.act = (float*)(ws + m.act); P.gate = (float*)(ws + m.gate); P.idx = (int*)(ws + m.idx);
}

struct Step { int st, l; };
static inline int build_schedule(Step* s) {
    int n = 0;
    s[n++] = {ST_COPYX, 0};
    for (int l = 0; l < NL; ++l) {
        static const int per_layer[] = {ST_RSTD, ST_NORM1, ST_GEMM1,
            ST_RW_A0, ST_RW_A1, ST_RW_A2, ST_RW_A3, ST_RW_KKN, ST_RW_SCAN, ST_RW_POST,
            ST_GLA_B0, ST_GLA_SCAN, ST_GLA_POST, ST_LRU_C0, ST_LRU_C1, ST_LRU_SCAN,
            ST_GDN_D0, ST_GDN_D1, ST_GDN_SCAN, ST_GDN_POST,
            ST_GEMM2, ST_RSTD2, ST_NORM2, ST_GEMM3, ST_SCORES, ST_TOPK1, ST_TOPK2, ST_PEER_U, ST_PEER_V};
        for (int i = 0; i < (int)(sizeof(per_layer) / sizeof(int)); ++i) s[n++] = {per_layer[i], l};
    }
    s[n++] = {ST_FRSTD, 0};
    s[n++] = {ST_FNORM, 0};
    return n;
}

static inline void fill_inputs(Params& P, void* const* d_in) {
    const float** dst = (const float**)&P;
    for (int i = 0; i < 38; ++i) dst[i] = (const float*)d_in[i];
}

#ifndef HOST_EMU
#define GAS __attribute__((address_space(1)))
#define LAS __attribute__((address_space(3)))
typedef unsigned v4u __attribute__((ext_vector_type(4)));
typedef unsigned v2u __attribute__((ext_vector_type(2)));
typedef float f32x4 __attribute__((ext_vector_type(4)));
typedef float f32x2 __attribute__((ext_vector_type(2)));
typedef short bf16x8 __attribute__((ext_vector_type(8)));
constexpr int NWAVES = 8, NTHR = 512;
constexpr int RING_BYTES = 131072, MISC_OFF = RING_BYTES + 320, LDS_BYTES = 147456;
constexpr int NTOK = 16384, TSEQ = 4096, NBATCH = 4;

__device__ __forceinline__ unsigned pk2(float lo, float hi) { return (unsigned)f2bf(lo) | ((unsigned)f2bf(hi) << 16); }
__device__ __forceinline__ float bflo(unsigned u) { return __builtin_bit_cast(float, u << 16); }
__device__ __forceinline__ float bfhi(unsigned u) { return __builtin_bit_cast(float, u & 0xffff0000u); }
__device__ __forceinline__ float wave_sum(float v) {
#pragma unroll
    for (int o = 1; o < 64; o <<= 1) v += __shfl_xor(v, o);
    return v;
}
#define LDS_WAIT() asm volatile("s_waitcnt lgkmcnt(0)" ::: "memory")
#define VM_WAIT() asm volatile("s_waitcnt vmcnt(0)" ::: "memory")

namespace pg8 {
#define PG8_LAS __attribute__((address_space(3)))
constexpr int BM = 256, BK = 64, HALF = 128, HTB = HALF * BK * 2, STAGE_BYTES = 8 * HTB, NXCD = 8, WGM = 8;
__host__ __device__ __forceinline__ int lds_byte(int r, int c) { const int st = (r >> 4) * 2 + (c >> 5), rr = r & 15, cc = c & 31, ob = rr * 64 + cc * 2; return st * 1024 + (ob ^ (((ob >> 9) & 1) << 5)); }
__host__ __device__ __forceinline__ void stage_rc(int b, int& R, int& C) { const int st = b / 1024, sb = b % 1024, swz = sb ^ (((sb >> 9) & 1) << 5); R = (st >> 1) * 16 + swz / 64; C = (st & 1) * 32 + (swz % 64) / 2; }
__host__ __device__ __forceinline__ int perm32(int rho) { const int n = rho >> 4, i = rho & 15; return 8 * (i >> 2) + 4 * n + (i & 3); }
struct Unit { int pm, pn; };
struct GemmX { const bf16_t* A; const bf16_t* Bt; int M, N, K, lda; };
struct StaticOrder {
    int nM, nN, nwg, G, c;
    __host__ __device__ void init(int M, int N, int G_, int c_) { nM = M / BM; nN = N / BM; nwg = nM * nN; G = G_; c = c_; }
    __host__ __device__ bool next(int i, Unit& u) const {
        const long L = (long)i * G + c; if (L >= nwg) return false;
        int wgid = (int)L; { const int q = nwg / NXCD, r = nwg % NXCD, xcd = wgid % NXCD, off = wgid / NXCD; wgid = (xcd < r ? xcd * (q + 1) : r * (q + 1) + (xcd - r) * q) + off; }
        const int nig = WGM * nN, gid = wgid / nig, fm = gid * WGM, gsz = (nM - fm) < WGM ? (nM - fm) : WGM;
        u.pm = fm + ((wgid % nig) % gsz); u.pn = (wgid % nig) / gsz; return true;
    }
    __device__ __forceinline__ void a_ready(const Unit&) const {}
    __device__ __forceinline__ void done(const Unit&) const {}
};
__device__ __forceinline__ unsigned cvt_pk_bf16(float lo, float hi) { unsigned r; asm volatile("v_cvt_pk_bf16_f32 %0, %1, %2" : "=v"(r) : "v"(lo), "v"(hi)); return r; }
template <bool ACCUM> struct EpiF32 {
    static constexpr bool PERM = false, AFTER_DRAIN = false;
    float* C; int ldc;
    __device__ __forceinline__ void operator()(const f32x4 (&acc)[2][2][4][2], const Unit& u, int wr, int wc, int fr, int fq) const {
        const int row0 = u.pm * BM + wr * 64 + fr, col0 = u.pn * BM + wc * 32 + 4 * fq;
#pragma unroll
        for (int ai = 0; ai < 2; ++ai)
#pragma unroll
            for (int m = 0; m < 4; ++m) { float* rowp = C + (size_t)(row0 + ai * HALF + m * 16) * ldc + col0;
#pragma unroll
                for (int bj = 0; bj < 2; ++bj)
#pragma unroll
                    for (int n = 0; n < 2; ++n) { f32x4* p = (f32x4*)(rowp + bj * HALF + n * 16);
                        if (ACCUM) *p = *p + acc[ai][bj][m][n]; else *p = acc[ai][bj][m][n]; } }
    }
};
struct EpiBf16 {
    static constexpr bool PERM = true, AFTER_DRAIN = false;
    bf16_t* O; int ldc; const float* bias;
    __device__ __forceinline__ void operator()(const f32x4 (&acc)[2][2][4][2], const Unit& u, int wr, int wc, int fr, int fq) const {
        const int row0 = u.pm * BM + wr * 64 + fr; const int col0 = u.pn * BM + wc * 32 + 8 * fq;
        f32x4 bv[2][2];
#pragma unroll
        for (int bj = 0; bj < 2; ++bj)
#pragma unroll
            for (int n = 0; n < 2; ++n) bv[bj][n] = bias ? *(const f32x4*)(bias + col0 + bj * HALF + 4 * n) : (f32x4){0.f, 0.f, 0.f, 0.f};
#pragma unroll
        for (int ai = 0; ai < 2; ++ai)
#pragma unroll
            for (int m = 0; m < 4; ++m) { bf16_t* rowp = O + (size_t)(row0 + ai * HALF + m * 16) * ldc + col0;
#pragma unroll
                for (int bj = 0; bj < 2; ++bj) { const f32x4 v0 = acc[ai][bj][m][0] + bv[bj][0], v1 = acc[ai][bj][m][1] + bv[bj][1];
                    v4u w; w.x = cvt_pk_bf16(v0[0], v0[1]); w.y = cvt_pk_bf16(v0[2], v0[3]); w.z = cvt_pk_bf16(v1[0], v1[1]); w.w = cvt_pk_bf16(v1[2], v1[3]);
                    *(v4u*)(rowp + bj * HALF) = w; } }
    }
};
template <class Epi, class Sched, bool ALIGN_EPI = false, bool SP2 = false>
__device__ __forceinline__ void gemm_phase(PG8_LAS unsigned char* lds, const GemmX g, const Sched& S, const Epi& E) {
    const int tid = threadIdx.x, wid = __builtin_amdgcn_readfirstlane(tid >> 6), lane = tid & 63, wr = wid >> 2, wc = wid & 3, fr = lane & 15, fq = lane >> 4;
    const int K = g.K, nt = K / BK;
    unsigned voffA[2], voffB[2];
#pragma unroll
    for (int i = 0; i < 2; ++i) { int R, C; stage_rc(tid * 16 + i * 8192, R, C); const int Rb = Epi::PERM ? ((R & ~31) + perm32(R & 31)) : R;
        voffA[i] = (unsigned)(R * g.lda + C) * 2u; voffB[i] = (unsigned)(Rb * K + C) * 2u; }
    const size_t kstep = (size_t)(BK * 2);
    const size_t hstep = (size_t)HALF * K * 2;
    const size_t tstep = 2 * hstep;
    const size_t hstepA = (size_t)HALF * g.lda * 2, tstepA = 2 * hstepA;
    const unsigned ldsw = (unsigned)wid * 1024u;
    const int aoff = lds_byte(wr * 64 + fr, fq * 8), boff = lds_byte(wc * 32 + fr, fq * 8);
#define PG8_SA(b, h) (((b) * 2 + (h)) * HTB)
#define PG8_SB(b, h) ((4 + (b) * 2 + (h)) * HTB)
#define PG8_STAGE(bufoff, gbase, voff) do { _Pragma("unroll") for (int _i = 0; _i < 2; ++_i) \
        __builtin_amdgcn_global_load_lds((const unsigned*)((const char*)(gbase) + (voff)[_i]), (PG8_LAS unsigned*)(lds + (bufoff) + ldsw + _i * 8192), 16, 0, 0); } while (0)
#define PG8_LDA(dst, b, h) do { _Pragma("unroll") for (int m = 0; m < 4; ++m) _Pragma("unroll") for (int k = 0; k < 2; ++k) dst[m][k] = *(const PG8_LAS bf16x8*)(lds + PG8_SA(b, h) + aoff + m * 2048 + k * 1024); } while (0)
#define PG8_LDB(dst, b, h) do { _Pragma("unroll") for (int n = 0; n < 2; ++n) _Pragma("unroll") for (int k = 0; k < 2; ++k) dst[n][k] = *(const PG8_LAS bf16x8*)(lds + PG8_SB(b, h) + boff + n * 2048 + k * 1024); } while (0)
#define PG8_MMA(ai, bj, At, Bt) do { __builtin_amdgcn_s_setprio(1); _Pragma("unroll") for (int m = 0; m < 4; ++m) _Pragma("unroll") for (int n = 0; n < 2; ++n) _Pragma("unroll") for (int k = 0; k < 2; ++k) \
        acc[ai][bj][m][n] = __builtin_amdgcn_mfma_f32_16x16x32_bf16(Bt[n][k], At[m][k], acc[ai][bj][m][n], 0, 0, 0); __builtin_amdgcn_s_setprio(0); } while (0)
#define PG8_WAIT_V(n) asm volatile("s_waitcnt vmcnt(" #n ")" ::: "memory")
#define PG8_WAIT_L(n) asm volatile("s_waitcnt lgkmcnt(" #n ")" ::: "memory")
#define PG8_BAR __builtin_amdgcn_s_barrier()
#define PG8_SCHED __builtin_amdgcn_sched_barrier(0)
    Unit cur, nxt; int ui = 0;
    if (!S.next(0, cur)) return;
    f32x4 acc[2][2][4][2];
#pragma unroll
    for (int a = 0; a < 2; ++a)
#pragma unroll
        for (int b = 0; b < 2; ++b)
#pragma unroll
            for (int m = 0; m < 4; ++m)
#pragma unroll
                for (int n = 0; n < 2; ++n) acc[a][b][m][n] = (f32x4){0.f, 0.f, 0.f, 0.f};
    bf16x8 At[4][2], B0[2][2], B1[2][2];
    const char* cA = (const char*)g.A + (size_t)cur.pm * tstepA; const char* cB = (const char*)g.Bt + (size_t)cur.pn * tstep;
    S.a_ready(cur);
    if constexpr (SP2) {
        PG8_STAGE(PG8_SB(0, 0), cB, voffB); PG8_STAGE(PG8_SB(0, 1), cB + hstep, voffB); PG8_STAGE(PG8_SA(0, 0), cA, voffA); PG8_STAGE(PG8_SA(0, 1), cA + hstepA, voffA);
        if (wr == 1) PG8_BAR;
        PG8_WAIT_V(2); PG8_BAR;
        PG8_STAGE(PG8_SB(1, 0), cB + kstep, voffB); PG8_STAGE(PG8_SA(1, 0), cA + kstep, voffA); PG8_STAGE(PG8_SB(1, 1), cB + hstep + kstep, voffB);
        PG8_WAIT_V(6); PG8_BAR;
    } else {
        PG8_STAGE(PG8_SB(0, 0), cB, voffB); PG8_STAGE(PG8_SA(0, 0), cA, voffA); PG8_STAGE(PG8_SB(0, 1), cB + hstep, voffB); PG8_STAGE(PG8_SA(0, 1), cA + hstepA, voffA);
        if (wr == 1) PG8_BAR;
        PG8_WAIT_V(4); PG8_BAR;
        PG8_STAGE(PG8_SB(1, 0), cB + kstep, voffB); PG8_STAGE(PG8_SA(1, 0), cA + kstep, voffA); PG8_STAGE(PG8_SB(1, 1), cB + hstep + kstep, voffB);
        PG8_WAIT_V(6); PG8_BAR;
    }
    for (;;) {
        const bool has_next = S.next(ui + 1, nxt);
        const char* nA = has_next ? (const char*)g.A + (size_t)nxt.pm * tstepA : cA; const char* nB = has_next ? (const char*)g.Bt + (size_t)nxt.pn * tstep : cB;
        for (int t = 0; t < nt; t += 2) {
            const bool last = (t == nt - 2);
            const char* a1 = cA + (size_t)(t + 1) * kstep;
            const char* a2 = last ? nA : cA + (size_t)(t + 2) * kstep; const char* b2 = last ? nB : cB + (size_t)(t + 2) * kstep;
            const char* a3 = a2 + kstep; const char* b3 = b2 + kstep;
            if (last && has_next) S.a_ready(nxt);
            if constexpr (SP2) {
            PG8_LDB(B0, 0, 0); PG8_LDB(B1, 0, 1); PG8_SCHED; PG8_LDA(At, 0, 0); PG8_STAGE(PG8_SA(1, 1), a1 + hstepA, voffA);
            PG8_WAIT_V(8); PG8_WAIT_L(0); PG8_BAR; PG8_MMA(0, 0, At, B0); PG8_MMA(0, 1, At, B1); PG8_BAR; PG8_SCHED;
            PG8_LDA(At, 0, 1); PG8_STAGE(PG8_SB(0, 0), b2, voffB); PG8_STAGE(PG8_SB(0, 1), b2 + hstep, voffB); PG8_STAGE(PG8_SA(0, 0), a2, voffA);
            PG8_WAIT_V(8); PG8_WAIT_L(0); PG8_BAR; PG8_MMA(1, 0, At, B0); PG8_MMA(1, 1, At, B1); PG8_BAR; PG8_SCHED;
            PG8_LDB(B0, 1, 0); PG8_LDB(B1, 1, 1); PG8_SCHED; PG8_LDA(At, 1, 0); PG8_STAGE(PG8_SA(0, 1), a2 + hstepA, voffA);
            PG8_WAIT_V(8); PG8_WAIT_L(0); PG8_BAR; PG8_MMA(0, 0, At, B0); PG8_MMA(0, 1, At, B1); PG8_BAR; PG8_SCHED;
            PG8_LDA(At, 1, 1); PG8_STAGE(PG8_SB(1, 0), b3, voffB); PG8_STAGE(PG8_SB(1, 1), b3 + hstep, voffB); PG8_STAGE(PG8_SA(1, 0), a3, voffA);
            PG8_WAIT_V(8); PG8_WAIT_L(0); PG8_BAR; PG8_MMA(1, 0, At, B0); PG8_MMA(1, 1, At, B1); PG8_BAR; PG8_SCHED;
            } else {
            PG8_LDB(B0, 0, 0); PG8_SCHED; PG8_LDA(At, 0, 0); PG8_STAGE(PG8_SA(1, 1), a1 + hstepA, voffA);
            PG8_WAIT_L(8); PG8_BAR; PG8_WAIT_L(0); PG8_MMA(0, 0, At, B0); PG8_BAR; PG8_SCHED;
            PG8_LDB(B1, 0, 1); PG8_STAGE(PG8_SB(0, 0), b2, voffB);
            PG8_BAR; PG8_WAIT_L(0); PG8_MMA(0, 1, At, B1); PG8_BAR;
            PG8_LDA(At, 0, 1); PG8_STAGE(PG8_SA(0, 0), a2, voffA);
            PG8_BAR; PG8_WAIT_L(0); PG8_MMA(1, 0, At, B0); PG8_BAR; PG8_SCHED;
            PG8_STAGE(PG8_SB(0, 1), b2 + hstep, voffB);
            PG8_WAIT_V(6); PG8_BAR; PG8_MMA(1, 1, At, B1); PG8_BAR;
            PG8_LDB(B0, 1, 0); PG8_SCHED; PG8_LDA(At, 1, 0); PG8_STAGE(PG8_SA(0, 1), a2 + hstepA, voffA);
            PG8_WAIT_L(8); PG8_BAR; PG8_WAIT_L(0); PG8_MMA(0, 0, At, B0); PG8_BAR; PG8_SCHED;
            PG8_LDB(B1, 1, 1); PG8_STAGE(PG8_SB(1, 0), b3, voffB);
            PG8_BAR; PG8_WAIT_L(0); PG8_MMA(0, 1, At, B1); PG8_BAR;
            PG8_LDA(At, 1, 1); PG8_STAGE(PG8_SA(1, 0), a3, voffA);
            PG8_BAR; PG8_WAIT_L(0); PG8_MMA(1, 0, At, B0); PG8_BAR; PG8_SCHED;
            PG8_STAGE(PG8_SB(1, 1), b3 + hstep, voffB);
            PG8_WAIT_V(6); PG8_BAR; PG8_MMA(1, 1, At, B1); PG8_BAR;
            }
        }
        if constexpr (ALIGN_EPI) { if (wr == 0) PG8_BAR; }
        if constexpr (!Epi::AFTER_DRAIN) { E(acc, cur, wr, wc, fr, fq); S.done(cur); }
        if (!has_next) break;
#pragma unroll
        for (int a = 0; a < 2; ++a)
#pragma unroll
            for (int b = 0; b < 2; ++b)
#pragma unroll
                for (int m = 0; m < 4; ++m)
#pragma unroll
                    for (int n = 0; n < 2; ++n) acc[a][b][m][n] = (f32x4){0.f, 0.f, 0.f, 0.f};
        cur = nxt; cA = nA; cB = nB; ++ui;
        if constexpr (ALIGN_EPI) { if (wr == 1) PG8_BAR; }
    }
    PG8_WAIT_V(0);
    if constexpr (!ALIGN_EPI) { if (wr == 0) PG8_BAR; }
    PG8_BAR;
    if constexpr (Epi::AFTER_DRAIN) { E.fused(acc, cur, wr, wc, fr, fq, lds, wid, lane); S.done(cur); }
#undef PG8_SA
#undef PG8_SB
#undef PG8_STAGE
#undef PG8_LDA
#undef PG8_LDB
#undef PG8_MMA
#undef PG8_WAIT_V
#undef PG8_WAIT_L
#undef PG8_BAR
#undef PG8_SCHED
}
}

#define XB_TMO      128
#define XB_XCNT(j)  (256  + 64 * (j))
#define XB_XSUB(j)  (1280 + 64 * (j))
#define XB_XGEN(j)  (2304 + 64 * (j))
#define XB_TOP      3328
#define XB_TOPGEN   3392
#define XCD_BAR_WORDS 3456
#define XB_SPIN_CAP (1u << 20)
__device__ __forceinline__ unsigned xb_ld(unsigned* p) { return __hip_atomic_load(p, __ATOMIC_RELAXED, __HIP_MEMORY_SCOPE_AGENT); }
__device__ __forceinline__ unsigned xb_add(unsigned* p, unsigned v) { return __hip_atomic_fetch_add(p, v, __ATOMIC_RELAXED, __HIP_MEMORY_SCOPE_AGENT); }
__device__ __forceinline__ unsigned xb_xcc_id() { return (unsigned)__builtin_amdgcn_s_getreg((3 << 11) | 20) & 0xFu; }
#define XB_SPIN(cond, bar) do { unsigned _sp = 0; while (cond) { __builtin_amdgcn_s_sleep(1); \
    if ((++_sp & 255u) == 0u) { if (xb_ld(&(bar)[XB_TMO])) break; if (_sp > XB_SPIN_CAP) { atomicAdd(&(bar)[XB_TMO], 1u); break; } } } } while (0)
struct XcdBarrier { unsigned* bar; unsigned x; volatile LAS unsigned* st; };
__device__ __forceinline__ XcdBarrier xcd_barrier_post(unsigned* bar, volatile LAS unsigned* st) {
    XcdBarrier b; b.bar = bar; b.x = xb_xcc_id(); b.st = st;
    if (threadIdx.x == 0) (void)xb_add(&bar[XB_XCNT(b.x)], 1u);
    return b;
}
__device__ __forceinline__ void xcd_barrier_complete(unsigned* bar, unsigned x, unsigned& nloc, unsigned& nx) {
    const unsigned G = gridDim.x * gridDim.y * gridDim.z;
    unsigned sum, cnt, mine, sp = 0u;
    for (;;) {
        sum = 0u; cnt = 0u; mine = 0u;
#pragma unroll
        for (unsigned j = 0; j < 16; ++j) { const unsigned c = xb_ld(&bar[XB_XCNT(j)]); sum += c; cnt += (c > 0u) ? 1u : 0u; mine = (j == x) ? c : mine; }
        if (sum == G) break;
        __builtin_amdgcn_s_sleep(1);
        if ((++sp & 255u) == 0u) { if (xb_ld(&bar[XB_TMO])) break; if (sp > XB_SPIN_CAP) { atomicAdd(&bar[XB_TMO], 1u); break; } }
    }
    nloc = mine > 0u ? mine : 1u; nx = cnt > 0u ? cnt : 1u;
}
__device__ __forceinline__ void xcd_barrier(const XcdBarrier& b) {
    asm volatile("s_waitcnt vmcnt(0)" ::: "memory");
    __syncthreads();
    if (threadIdx.x == 0) {
        unsigned* bar = b.bar;
        __builtin_amdgcn_s_waitcnt(0);
        unsigned nloc = b.st[0], nx = b.st[1];
        if (nloc == 0u) { xcd_barrier_complete(bar, b.x, nloc, nx); b.st[0] = nloc; b.st[1] = nx; }
        const unsigned old = xb_add(&bar[XB_XSUB(b.x)], 1u);
        const unsigned gen = old / nloc;
        if (old + 1u == (gen + 1u) * nloc) {
            __builtin_amdgcn_fence(__ATOMIC_RELEASE, "agent");
            asm volatile("s_waitcnt vmcnt(0)" ::: "memory");
            const unsigned og = xb_add(&bar[XB_TOP], 1u);
            const unsigned tg = og / nx;
            if (og + 1u == (tg + 1u) * nx) xb_add(&bar[XB_TOPGEN], 1u);
            else XB_SPIN(xb_ld(&bar[XB_TOPGEN]) == tg, bar);
            __builtin_amdgcn_fence(__ATOMIC_ACQUIRE, "agent");
            xb_add(&bar[XB_XGEN(b.x)], 1u);
            asm volatile("s_waitcnt vmcnt(0)" ::: "memory");
        } else {
            XB_SPIN(xb_ld(&bar[XB_XGEN(b.x)]) == gen, bar);
            __builtin_amdgcn_fence(__ATOMIC_ACQUIRE, "agent");
            asm volatile("s_waitcnt vmcnt(0)" ::: "memory");
        }
    }
    __syncthreads();
}

struct Args { const float* in[38]; float* out; unsigned char* ws; int ph_lo, ph_hi, li, pad; };
enum InputId { I_X = 0, I_NORM_MIX, I_W_IN, I_W_OUT, I_RW_MU, I_RW_W0, I_RW_W_UP, I_RW_A0, I_RW_A_UP, I_RW_G_UP, I_RW_K_K, I_RW_K_A, I_RW_R_K,
    I_RW_LN_W, I_RW_LN_B, I_RW_V0, I_RW_V_DOWN, I_RW_V_UP, I_GLA_A_UP, I_GLA_A_BIAS, I_GLA_NORM, I_LRU_CONV_W, I_LRU_CONV_B, I_LRU_W_R,
    I_LRU_B_R, I_LRU_W_I, I_LRU_B_I, I_LRU_LAM, I_GDN_CONV_W, I_GDN_A_LOG, I_GDN_DT_BIAS, I_GDN_NORM, I_NORM_FFN, I_PEER_WQ, I_PEER_SK,
    I_PEER_U, I_PEER_V, I_NORM_FINAL };
enum { PH_P0 = 0, PH_GEMM1 = 1, PH_PREP = 2, PH_AUX = 3, PH_SCAN = 4, PH_POST = 5, PH_GEMM2 = 6, PH_NORM2 = 7, PH_GEMM3 = 8, PH_TOPK = 9, PH_PEER = 10, PH_PER_LAYER = 10, PH_TOTAL = 21 };

struct Frame {
    LAS unsigned char* lds;
    int tid, lane, wave, vcu, G;
    int gw, ngw;
};

__device__ __forceinline__ void p0_transpose_item(const float* W, int K, int N, const float* kscale, bf16_t* WT, LAS float* scr, int item, int nblk, int lane) {
    const int kb = item / nblk, nb = item % nblk, k0 = 64 * kb, n0 = 32 * nb;
    const int kr = lane >> 3, n4 = (lane & 7) * 4;
    f32x4 v[8];
#pragma unroll
    for (int i = 0; i < 8; ++i) { const int kk = kr + 8 * i;
        v[i] = (n0 + n4 < N) ? *(const f32x4*)(W + (size_t)(k0 + kk) * N + n0 + n4) : (f32x4){0.f, 0.f, 0.f, 0.f}; }
#pragma unroll
    for (int i = 0; i < 8; ++i) { const int kk = kr + 8 * i; const float s = kscale ? kscale[k0 + kk] : 1.0f;
        scr[kk * 33 + n4 + 0] = v[i].x * s; scr[kk * 33 + n4 + 1] = v[i].y * s; scr[kk * 33 + n4 + 2] = v[i].z * s; scr[kk * 33 + n4 + 3] = v[i].w * s; }
    LDS_WAIT(); asm volatile("" ::: "memory");
    const int c = lane & 7;
#pragma unroll
    for (int j = 0; j < 4; ++j) { const int n = (lane >> 3) + 8 * j; const LAS float* s = scr + (8 * c) * 33 + n;
        v4u o; o.x = pk2(s[0 * 33], s[1 * 33]); o.y = pk2(s[2 * 33], s[3 * 33]); o.z = pk2(s[4 * 33], s[5 * 33]); o.w = pk2(s[6 * 33], s[7 * 33]);
        *(v4u*)(WT + (size_t)(n0 + n) * K + k0 + 8 * c) = o; }
    LDS_WAIT(); asm volatile("" ::: "memory");
}

__device__ __forceinline__ void p0_prologue(const Args& a, Frame& F) {
    const WsMap m = ws_map(NTOK);
    unsigned char* ws = a.ws;
    LAS float* scr = (LAS float*)(F.lds + F.wave * 16384);
    const int gw = F.gw, NGW = F.ngw, lane = F.lane;
    for (int n = gw; n < NTOK; n += NGW) {
        const f32x4* xr = (const f32x4*)(a.in[I_X] + (size_t)n * DM) + lane;
        f32x4 v[8]; float s = 0.f;
#pragma unroll
        for (int j = 0; j < 8; ++j) { v[j] = xr[64 * j]; s += (v[j].x * v[j].x + v[j].y * v[j].y) + (v[j].z * v[j].z + v[j].w * v[j].w); }
        const float rstd = 1.0f / sqrtf(wave_sum(s) * (1.0f / DM) + 1e-6f);
        f32x4* xo = (f32x4*)(a.out + (size_t)n * DM) + lane;
        v2u* o8 = (v2u*)((bf16_t*)(ws + m.xn) + (size_t)n * DM) + lane;
#pragma unroll
        for (int j = 0; j < 8; ++j) { xo[64 * j] = v[j]; v2u w; w.x = pk2(v[j].x * rstd, v[j].y * rstd); w.y = pk2(v[j].z * rstd, v[j].w * rstd); o8[64 * j] = w; }
    }
    {
        constexpr int I1 = (DM / 64) * (PLD / 32), I2 = (DM / 64) * (DM / 32);
        for (int it = gw; it < NL * (I1 + I2); it += NGW) {
            const int l = it / (I1 + I2); int r = it % (I1 + I2);
            if (r < I1) p0_transpose_item(a.in[I_W_IN] + (size_t)l * DM * INC, DM, INC, a.in[I_NORM_MIX] + l * DM, (bf16_t*)(ws + m.w1t) + (size_t)l * PLD * DM, scr, r, PLD / 32, lane);
            else p0_transpose_item(a.in[I_W_OUT] + (size_t)l * DM * DM, DM, DM, nullptr, (bf16_t*)(ws + m.w2t) + (size_t)l * DM * DM, scr, r - I1, DM / 32, lane);
        }
    }
    for (int it = gw; it < NL * 16 * 64; it += NGW) {
        const int l = it / 1024, hp = (it % 1024) / 64, kb = it % 64;
        const int dh = lane & 1, kk = kb * 32 + (lane >> 1);
        const float* wq = a.in[I_PEER_WQ] + (size_t)l * DM * DM + (size_t)kk * DM + hp * 128 + dh * 64;
        const float* sk = a.in[I_PEER_SK] + ((size_t)l * 16 + hp) * 128 * 128;
        f32x4 q[16];
#pragma unroll
        for (int d = 0; d < 16; ++d) q[d] = *(const f32x4*)(wq + 4 * d);
        bf16_t* o = (bf16_t*)(ws + m.wsct) + (size_t)l * DM * DM + (size_t)(hp * 128) * DM + kk;
        f32x4 stg[8];
#pragma unroll
        for (int i = 0; i < 8; ++i) stg[i] = ((const f32x4*)sk)[i * 64 + lane];
#pragma unroll 1
        for (int kc = 0; kc < 8; ++kc) {
#pragma unroll
            for (int i = 0; i < 8; ++i) ((LAS f32x4*)scr)[i * 64 + lane] = stg[i];
            if (kc + 1 < 8) {
#pragma unroll
                for (int i = 0; i < 8; ++i) stg[i] = ((const f32x4*)(sk + (kc + 1) * 2048))[i * 64 + lane]; }
            LDS_WAIT(); asm volatile("" ::: "memory");
#pragma unroll 2
            for (int key = 0; key < 16; ++key) {
                const LAS f32x4* s4 = (const LAS f32x4*)(scr + key * 128 + dh * 64);
                float acc = 0.f;
#pragma unroll
                for (int d = 0; d < 16; ++d) { const f32x4 sv = s4[d]; acc += (q[d].x * sv.x + q[d].y * sv.y) + (q[d].z * sv.z + q[d].w * sv.w); }
                acc += __shfl_xor(acc, 1);
                if (dh == 0) o[(size_t)(kc * 16 + key) * DM] = f2bf(acc);
            }
            LDS_WAIT(); asm volatile("" ::: "memory");
        }
    }
    {
        const int gt = F.vcu * NTHR + F.tid, GT = F.G * NTHR;
        bf16_t* AW = (bf16_t*)(ws + m.auxwt); bf16_t* LW = (bf16_t*)(ws + m.lruwt); bf16_t* VW = (bf16_t*)(ws + m.vreswt); float* PP = (float*)(ws + m.pp);
        for (int it = gt; it < NL * 1792 * 384; it += GT) {
            const int l = it / (1792 * 384), r = it % (1792 * 384), n = r / 384, k = r % 384;
            float v = 0.f;
            if (n < 512) { if (k < 64) v = a.in[I_RW_W_UP][(size_t)l * 64 * 512 + k * 512 + n]; }
            else if (n < 1024) { if (k >= 64 && k < 128) v = a.in[I_RW_A_UP][(size_t)l * 64 * 512 + (k - 64) * 512 + (n - 512)]; }
            else if (n < 1536) { if (k >= 128 && k < 256) v = a.in[I_RW_G_UP][(size_t)l * 128 * 512 + (k - 128) * 512 + (n - 1024)]; }
            else { if (k >= 256 && k < 272) v = a.in[I_GLA_A_UP][(size_t)l * 16 * 256 + (k - 256) * 256 + (n - 1536)]; }
            AW[it] = f2bf(v);
        }
        for (int it = gt; it < NL * 1024 * 512; it += GT) {
            const int l = it / (1024 * 512), r = it % (1024 * 512), n = r / 512, k = r % 512;
            const int nn = n & 511, blk = nn >> 6, j = nn & 63;
            float v = 0.f;
            if ((k >> 6) == blk) v = (n < 512 ? a.in[I_LRU_W_R] : a.in[I_LRU_W_I])[(size_t)l * 8 * 64 * 64 + (size_t)blk * 4096 + (k & 63) * 64 + j];
            LW[it] = f2bf(v);
        }
        for (int it = gt; it < 512 * 512; it += GT) {
            const int n = it / 512, k = it % 512;
            float s = 0.f;
            for (int i = 0; i < 32; ++i) s += a.in[I_RW_V_DOWN][k * 32 + i] * a.in[I_RW_V_UP][i * 512 + n];
            VW[it] = f2bf(s);
        }
        for (int it = gt; it < 6144; it += GT) {
            float v = 0.f;
            if (it < 3584) { const int l = it / 1792, c = it % 1792;
                v = c < 512 ? a.in[I_RW_W0][l * 512 + c] : (c < 1024 ? a.in[I_RW_A0][l * 512 + c - 512] : (c < 1536 ? 0.f : a.in[I_GLA_A_BIAS][l * 256 + c - 1536])); }
            else if (it < 5632) { const int l = (it - 3584) / 1024, c = (it - 3584) % 1024; v = c < 512 ? a.in[I_LRU_B_R][l * 512 + c] : a.in[I_LRU_B_I][l * 512 + c - 512]; }
            else v = a.in[I_RW_V0][it - 5632];
            PP[it] = v;
        }
    }
}

__device__ __forceinline__ unsigned pk4_fp8(float a, float b, float c, float d) {
    int w = 0;
    w = __builtin_amdgcn_cvt_pk_fp8_f32(__builtin_fmaxf(__builtin_fminf(a, 448.f), -448.f), __builtin_fmaxf(__builtin_fminf(b, 448.f), -448.f), w, false);
    w = __builtin_amdgcn_cvt_pk_fp8_f32(__builtin_fmaxf(__builtin_fminf(c, 448.f), -448.f), __builtin_fmaxf(__builtin_fminf(d, 448.f), -448.f), w, true);
    return (unsigned)w;
}
typedef float v32f __attribute__((ext_vector_type(32)));
constexpr size_t TROW = 1024;
__device__ __forceinline__ float clamp6(float x) { return __builtin_fmaxf(__builtin_fminf(x, 6.0f), -6.0f); }

template <int CTRL> __device__ __forceinline__ float dpp_f(float v) { return __builtin_bit_cast(float, __builtin_amdgcn_update_dpp(0, __builtin_bit_cast(int, v), CTRL, 0xF, 0xF, true)); }
__device__ __forceinline__ float rdlane_f(float v, int l) { return __builtin_bit_cast(float, __builtin_amdgcn_readlane(__builtin_bit_cast(int, v), l)); }
__device__ __forceinline__ float row16_sum(float v) {
    v += dpp_f<0xB1>(v); v += dpp_f<0x4E>(v); v += dpp_f<0x141>(v); v += dpp_f<0x140>(v); return v;
}
__device__ __forceinline__ float wave_sum_u(float v) {
    v = row16_sum(v);
    return (rdlane_f(v, 0) + rdlane_f(v, 16)) + (rdlane_f(v, 32) + rdlane_f(v, 48));
}
typedef __bf16 bf16x2_t __attribute__((ext_vector_type(2)));
__device__ __forceinline__ float dot2bf(unsigned w, unsigned x, float acc) { return __builtin_amdgcn_fdot2_f32_bf16(__builtin_bit_cast(bf16x2_t, w), __builtin_bit_cast(bf16x2_t, x), acc, false); }
__device__ __forceinline__ void tables_range(const Args& a, Frame& F, size_t it0, size_t it1, int sub, int nsub) {
    const WsMap m = ws_map(NTOK);
    const size_t per = (size_t)NEXP * DM / 32;
    const size_t stride = (size_t)nsub * NTHR;
    float* tsc = (float*)(a.ws + m.tsc);
    for (size_t base = it0 + (size_t)sub * NTHR + F.tid; base < it1; base += 2 * stride) {
        f32x4 v[2][8];
#pragma unroll
        for (int u = 0; u < 2; ++u) { const size_t it = base + u * stride;
            if (it < it1) { const int tb = (int)(it / per); const size_t r = it % per;
                const f32x4* srcp = (const f32x4*)(((tb & 1) ? a.in[I_PEER_V] : a.in[I_PEER_U]) + (size_t)(tb >> 1) * NEXP * DM + r * 32);
#pragma unroll
                for (int q = 0; q < 8; ++q) v[u][q] = __builtin_nontemporal_load(srcp + q); } }
#pragma unroll
        for (int u = 0; u < 2; ++u) { const size_t it = base + u * stride;
            if (it < it1) { const int tb = (int)(it / per); const size_t r = it % per;
                float ss = 0.f;
#pragma unroll
                for (int q = 0; q < 8; ++q) ss += (v[u][q].x * v[u][q].x + v[u][q].y * v[u][q].y) + (v[u][q].z * v[u][q].z + v[u][q].w * v[u][q].w);
                const float rms = sqrtf(wave_sum_u(ss) * (1.0f / DM));
                const float sc = rms > 0.f ? 2.05f / rms : 0.f;
                v4u w;
#pragma unroll
                for (int d = 0; d < 4; ++d) { unsigned p = 0;
                    p = __builtin_amdgcn_cvt_scalef32_pk_fp4_f32(p, clamp6(v[u][2 * d].x * sc), clamp6(v[u][2 * d].y * sc), 1.0f, 0);
                    p = __builtin_amdgcn_cvt_scalef32_pk_fp4_f32(p, clamp6(v[u][2 * d].z * sc), clamp6(v[u][2 * d].w * sc), 1.0f, 1);
                    p = __builtin_amdgcn_cvt_scalef32_pk_fp4_f32(p, clamp6(v[u][2 * d + 1].x * sc), clamp6(v[u][2 * d + 1].y * sc), 1.0f, 2);
                    p = __builtin_amdgcn_cvt_scalef32_pk_fp4_f32(p, clamp6(v[u][2 * d + 1].z * sc), clamp6(v[u][2 * d + 1].w * sc), 1.0f, 3);
                    w[d] = p; }
                *(v4u*)((unsigned char*)(a.ws + m.tabu) + (size_t)tb * NEXP * TROW + r * 16) = w;
                if (F.lane == 0) tsc[(size_t)tb * NEXP + (r >> 6)] = rms * (1.0f / 2.05f); } }
    }
}

__device__ __forceinline__ float gelu_fast(float x) {
    const float u = 1.5957691216057308f * (x + 0.044715f * x * x * x);
    return x / (1.0f + __expf(-u));
}


__device__ __forceinline__ float sigm(float x) { return 1.0f / (1.0f + __expf(-x)); }
__device__ __forceinline__ float softplus_f(float x) { return __logf(1.0f + __expf(-fabsf(x))) + fmaxf(x, 0.0f); }
__device__ __forceinline__ float tanh_f(float x) { return 1.0f - 2.0f / (1.0f + __expf(2.0f * x)); }
__device__ __forceinline__ float red8(float v) { v += dpp_f<0xB1>(v); v += dpp_f<0x4E>(v); v += dpp_f<0x141>(v); return v; }
__device__ __forceinline__ v4u ld8(const bf16_t* p) { return *(const v4u*)p; }
__device__ __forceinline__ void unpack8(const v4u w, float (&f)[8]) { f[0] = bflo(w.x); f[1] = bfhi(w.x); f[2] = bflo(w.y); f[3] = bfhi(w.y); f[4] = bflo(w.z); f[5] = bfhi(w.z); f[6] = bflo(w.w); f[7] = bfhi(w.w); }
__device__ __forceinline__ v4u pack8(const float (&f)[8]) { v4u w; w.x = pk2(f[0], f[1]); w.y = pk2(f[2], f[3]); w.z = pk2(f[4], f[5]); w.w = pk2(f[6], f[7]); return w; }

__device__ __forceinline__ void prep_phase(const Args& a, Frame& F, int l) {
    const WsMap m = ws_map(NTOK);
    const bf16_t* p16 = (const bf16_t*)(a.ws + m.p16);
    bf16_t* zrkv = (bf16_t*)(a.ws + m.zrkv); bf16_t* auxA = (bf16_t*)(a.ws + m.auxA); bf16_t* xc = (bf16_t*)(a.ws + m.xc);
    const float* mu = a.in[I_RW_MU] + l * 1792;
#pragma unroll 4
    for (size_t it = (size_t)F.vcu * NTHR + F.tid; it < (size_t)NTOK * 224; it += (size_t)F.G * NTHR) {
        const int n = (int)(it / 224), j = (int)(it % 224), t = n % TSEQ;
        const int col = j * 8;
        float cur[8], prv[8], z[8];
        unpack8(ld8(p16 + (size_t)n * PLD + col), cur);
        unpack8(ld8(p16 + (size_t)(t > 0 ? n - 1 : n) * PLD + col), prv);
        const f32x4 m0 = *(const f32x4*)(mu + col), m1 = *(const f32x4*)(mu + col + 4);
        const float mm[8] = {m0.x, m0.y, m0.z, m0.w, m1.x, m1.y, m1.z, m1.w};
#pragma unroll
        for (int k = 0; k < 8; ++k) z[k] = cur[k] + ((t > 0 ? prv[k] : 0.f) - cur[k]) * mm[k];
        if (col < 1536) *(v4u*)(zrkv + (size_t)n * 1536 + col) = pack8(z);
        else {
            const int c = col - 1536;
#pragma unroll
            for (int k = 0; k < 8; ++k) z[k] = c < 64 ? tanh_f(z[k]) : (c < 128 ? z[k] : sigm(z[k]));
            *(v4u*)(auxA + (size_t)n * 384 + c) = pack8(z);
        }
    }
    for (size_t it = (size_t)F.vcu * NTHR + F.tid; it < (size_t)NTOK * 16; it += (size_t)F.G * NTHR) {
        const int n = (int)(it / 16), c = 256 + (int)(it % 16) * 8;
        v4u w = (v4u){0u, 0u, 0u, 0u};
        if (c < 272) w = ld8(p16 + (size_t)n * PLD + C_GLA + 1536 + (c - 256));
        *(v4u*)(auxA + (size_t)n * 384 + c) = w;
    }
#pragma unroll 2
    for (size_t it = (size_t)F.vcu * NTHR + F.tid; it < (size_t)NTOK * 64; it += (size_t)F.G * NTHR) {
        const int n = (int)(it / 64), c = (int)(it % 64) * 8, t = n % TSEQ;
        float acc[8];
        { const f32x4 b0 = *(const f32x4*)(a.in[I_LRU_CONV_B] + l * 512 + c), b1 = *(const f32x4*)(a.in[I_LRU_CONV_B] + l * 512 + c + 4);
          acc[0] = b0.x; acc[1] = b0.y; acc[2] = b0.z; acc[3] = b0.w; acc[4] = b1.x; acc[5] = b1.y; acc[6] = b1.z; acc[7] = b1.w; }
        v4u raw[4];
#pragma unroll
        for (int jj = 0; jj < 4; ++jj) raw[jj] = ld8(p16 + (size_t)(t - 3 + jj >= 0 ? n - 3 + jj : n) * PLD + C_LRU + c);
#pragma unroll
        for (int jj = 0; jj < 4; ++jj) {
            float xv[8]; unpack8(raw[jj], xv);
            const float ok = (t - 3 + jj >= 0) ? 1.0f : 0.0f;
            const float* cw = a.in[I_LRU_CONV_W] + (size_t)l * 4 * 512 + jj * 512 + c;
            const f32x4 w0 = *(const f32x4*)cw * ok, w1 = *(const f32x4*)(cw + 4) * ok;
            acc[0] += w0.x * xv[0]; acc[1] += w0.y * xv[1]; acc[2] += w0.z * xv[2]; acc[3] += w0.w * xv[3];
            acc[4] += w1.x * xv[4]; acc[5] += w1.y * xv[5]; acc[6] += w1.z * xv[6]; acc[7] += w1.w * xv[7];
        }
        *(v4u*)(xc + (size_t)n * 512 + c) = pack8(acc);
    }
    {
        bf16_t* gq = (bf16_t*)(a.ws + m.gq); bf16_t* gk = (bf16_t*)(a.ws + m.gk); bf16_t* gv = (bf16_t*)(a.ws + m.gv); float* gsc = (float*)(a.ws + m.gsc);
        const float* cw = a.in[I_GDN_CONV_W] + (size_t)l * 4 * 1536;
        const int lane = F.lane;
        for (int n = F.gw; n < NTOK; n += F.ngw) {
            const int t = n % TSEQ;
#pragma unroll
            for (int part = 0; part < 3; ++part) {
                const int cb = part * 512 + lane * 8;
                float acc[8];
#pragma unroll
                for (int k = 0; k < 8; ++k) acc[k] = 0.f;
#pragma unroll
                for (int jj = 0; jj < 4; ++jj) {
                    if (t - 3 + jj >= 0) {
                        float xv[8]; unpack8(ld8(p16 + (size_t)(n - 3 + jj) * PLD + C_GDN + cb), xv);
                        const f32x4 w0 = *(const f32x4*)(cw + jj * 1536 + cb), w1 = *(const f32x4*)(cw + jj * 1536 + cb + 4);
                        acc[0] += w0.x * xv[0]; acc[1] += w0.y * xv[1]; acc[2] += w0.z * xv[2]; acc[3] += w0.w * xv[3];
                        acc[4] += w1.x * xv[4]; acc[5] += w1.y * xv[5]; acc[6] += w1.z * xv[6]; acc[7] += w1.w * xv[7];
                    }
                }
                float ss = 0.f;
#pragma unroll
                for (int k = 0; k < 8; ++k) { acc[k] = acc[k] * sigm(acc[k]); ss += acc[k] * acc[k]; }
                if (part < 2) {
                    ss = row16_sum(ss);
                    const float inv = (1.0f / sqrtf(ss + 1e-6f)) * (part == 0 ? 0.08838834764831845f : 1.0f);
#pragma unroll
                    for (int k = 0; k < 8; ++k) acc[k] *= inv;
                }
                *(v4u*)((part == 0 ? gq : (part == 1 ? gk : gv)) + (size_t)n * 512 + lane * 8) = pack8(acc);
            }
            if (lane < 4) {
                gsc[(size_t)n * 8 + lane] = sigm(bf2f(p16[(size_t)n * PLD + C_GDN + 2048 + lane]));
                gsc[(size_t)n * 8 + 4 + lane] = -__expf(a.in[I_GDN_A_LOG][l * 4 + lane]) * softplus_f(bf2f(p16[(size_t)n * PLD + C_GDN + 2052 + lane]) + a.in[I_GDN_DT_BIAS][l * 4 + lane]);
            }
        }
    }
}

__device__ __forceinline__ float swz16(float v) { return __builtin_bit_cast(float, __builtin_amdgcn_ds_swizzle(__builtin_bit_cast(int, v), 0x401F)); }
__device__ __forceinline__ float red32(float v) { v = row16_sum(v); return v + swz16(v); }

__device__ __forceinline__ void rwkv_task(const Args& a, Frame& F, int l, int task) {
    const WsMap m = ws_map(NTOK);
    const int b = task >> 4, h = (task >> 1) & 7, hf = task & 1;
    LAS float* LR = (LAS float*)F.lds; LAS float* LW = LR + 2048; LAS float* LK = LW + 2048; LAS float* LA = LK + 2048; LAS float* LB = LA + 2048;
    LAS float* LV = LB + 2048; LAS float* LY = LV + 1024;
    const int lane = F.lane, w = F.wave, tid = F.tid;
    const int ch = h * 64 + lane;
    const bool mine = (lane >> 5) == hf;
    const float kk_ = a.in[I_RW_K_K][l * 512 + ch], ka_ = a.in[I_RW_K_A][l * 512 + ch], rk_ = a.in[I_RW_R_K][l * 512 + ch];
    const bf16_t* zr = (const bf16_t*)(a.ws + m.zrkv); const bf16_t* ao = (const bf16_t*)(a.ws + m.auxo); const bf16_t* vr = (const bf16_t*)(a.ws + m.vres);
    float* vf = (float*)(a.ws + m.vfirst); bf16_t* yo = (bf16_t*)(a.ws + m.rwy); bf16_t* bvo = (bf16_t*)(a.ws + m.rwbv);
    float S0 = 0.f, S1 = 0.f, S2 = 0.f, S3 = 0.f;
    const int row = tid >> 4, ks = tid & 15;
    float in_[4][7];
    auto load_chunk = [&](int c) {
#pragma unroll
        for (int q = 0; q < 4; ++q) { const size_t n = (size_t)b * TSEQ + c * 32 + w + 8 * q;
            in_[q][0] = bf2f(zr[n * 1536 + ch]); in_[q][1] = bf2f(zr[n * 1536 + 512 + ch]); in_[q][2] = bf2f(zr[n * 1536 + 1024 + ch]);
            in_[q][3] = bf2f(ao[n * 1792 + ch]); in_[q][4] = bf2f(ao[n * 1792 + 512 + ch]);
            if (l > 0) { in_[q][5] = bf2f(vr[n * 512 + ch]); in_[q][6] = vf[n * 512 + ch]; } else { in_[q][5] = 0.f; in_[q][6] = 0.f; } }
    };
    load_chunk(0);
    for (int c = 0; c < TSEQ / 32; ++c) {
#pragma unroll
        for (int q = 0; q < 4; ++q) {
            const int tl = w + 8 * q; const size_t n = (size_t)b * TSEQ + c * 32 + tl;
            const float zr_ = in_[q][0], zk_ = in_[q][1], zv_ = in_[q][2], wp = in_[q][3], ap = in_[q][4];
            float v = zv_;
            if (l == 0) { if (mine) vf[n * 512 + ch] = zv_; } else v = zv_ + (in_[q][6] - zv_) * sigm(in_[q][5]);
            const float w_raw = -softplus_f(-wp) - 0.5f, dec = __expf(-__expf(w_raw));
            const float aa = sigm(ap);
            const float kkraw = zk_ * kk_;
            const float ss = wave_sum_u(kkraw * kkraw);
            const float kk = kkraw * (1.0f / sqrtf(fmaxf(ss, 1e-24f)));
            const float km = zk_ * (1.0f + (aa - 1.0f) * ka_);
            const float bon = wave_sum_u(zr_ * km * rk_);
            LR[tl * 64 + lane] = zr_; LW[tl * 64 + lane] = dec; LK[tl * 64 + lane] = km; LA[tl * 64 + lane] = -kk; LB[tl * 64 + lane] = kk * aa;
            if (mine) { LV[tl * 32 + (lane & 31)] = v; bvo[n * 512 + ch] = f2bf(bon * v); }
        }
        __syncthreads();
        if (c + 1 < TSEQ / 32) load_chunk(c + 1);
        float keep0 = 0.f, keep1 = 0.f;
#pragma unroll 4
        for (int tl = 0; tl < 32; ++tl) {
            const int o = tl * 64 + ks * 4;
            const f32x4 a4 = *(const LAS f32x4*)(LA + o), w4 = *(const LAS f32x4*)(LW + o), b4 = *(const LAS f32x4*)(LB + o), k4 = *(const LAS f32x4*)(LK + o), r4 = *(const LAS f32x4*)(LR + o);
            const float vv = LV[tl * 32 + row];
            const float sa = row16_sum((S0 * a4.x + S1 * a4.y) + (S2 * a4.z + S3 * a4.w));
            S0 = S0 * w4.x + (sa * b4.x + vv * k4.x); S1 = S1 * w4.y + (sa * b4.y + vv * k4.y); S2 = S2 * w4.z + (sa * b4.z + vv * k4.z); S3 = S3 * w4.w + (sa * b4.w + vv * k4.w);
            const float y = row16_sum((S0 * r4.x + S1 * r4.y) + (S2 * r4.z + S3 * r4.w));
            keep0 = (ks == tl) ? y : keep0; keep1 = (ks + 16 == tl) ? y : keep1;
        }
        LY[ks * 32 + row] = keep0; LY[(16 + ks) * 32 + row] = keep1;
        __syncthreads();
        { const int tl = tid >> 4, r2 = (tid & 15) * 2; const size_t n = (size_t)b * TSEQ + c * 32 + tl;
          *(unsigned*)(yo + n * 512 + h * 64 + hf * 32 + r2) = pk2(LY[tl * 32 + r2], LY[tl * 32 + r2 + 1]); }
    }
}


__device__ __forceinline__ void chunk_cumsum8(float (&x)[8], LAS float* tmp, int lane, int w, int c8) {
#pragma unroll
    for (int d = 8; d < 64; d <<= 1) {
#pragma unroll
        for (int k = 0; k < 8; ++k) { const float t = __shfl_up(x[k], d); if (lane >= d) x[k] += t; }
    }
    if (lane >= 56) { *(LAS f32x4*)(tmp + w * 64 + c8) = (f32x4){x[0], x[1], x[2], x[3]}; *(LAS f32x4*)(tmp + w * 64 + c8 + 4) = (f32x4){x[4], x[5], x[6], x[7]}; }
    __syncthreads();
    for (int ww = 0; ww < w; ++ww) { const f32x4 a0 = *(const LAS f32x4*)(tmp + ww * 64 + c8), a1 = *(const LAS f32x4*)(tmp + ww * 64 + c8 + 4);
        x[0] += a0.x; x[1] += a0.y; x[2] += a0.z; x[3] += a0.w; x[4] += a1.x; x[5] += a1.y; x[6] += a1.z; x[7] += a1.w; }
}

constexpr int RWP = 72;
constexpr int RWT = 64 * RWP;
constexpr size_t RWB_TILES = 4 * RWT * 2;
constexpr size_t RWB_DVEC = RWB_TILES;
constexpr size_t RWB_VS = RWB_DVEC + 256;
constexpr size_t RWB_BYTES = RWB_VS + 4 * 3 * 64 * 16 * 2;

__device__ __forceinline__ f32x4 mm64(const LAS bf16_t* A, const LAS bf16_t* Bt, int mt, int nt, int lane, f32x4 acc) {
    const LAS bf16_t* ap = A + (mt * 16 + (lane & 15)) * RWP + (lane >> 4) * 8;
    const LAS bf16_t* bp = Bt + (nt * 16 + (lane & 15)) * RWP + (lane >> 4) * 8;
#pragma unroll
    for (int k0 = 0; k0 < 64; k0 += 32)
        acc = __builtin_amdgcn_mfma_f32_16x16x32_bf16(*(const LAS bf16x8*)(ap + k0), *(const LAS bf16x8*)(bp + k0), acc, 0, 0, 0);
    return acc;
}
__device__ __forceinline__ void st_rowmajor(LAS bf16_t* T, int mt, int nt, int lane, const f32x4 v) {
    const int n = nt * 16 + (lane & 15), i0 = mt * 16 + (lane >> 4) * 4;
    T[(i0 + 0) * RWP + n] = f2bf(v.x); T[(i0 + 1) * RWP + n] = f2bf(v.y); T[(i0 + 2) * RWP + n] = f2bf(v.z); T[(i0 + 3) * RWP + n] = f2bf(v.w);
}
__device__ __forceinline__ void st_transposed(LAS bf16_t* T, int mt, int nt, int lane, const f32x4 v) {
    const int n = nt * 16 + (lane & 15), i0 = mt * 16 + (lane >> 4) * 4;
    *(LAS v2u*)(T + n * RWP + i0) = (v2u){pk2(v.x, v.y), pk2(v.z, v.w)};
}

__device__ __forceinline__ void rwkv_pa_chunk(const Args& a, Frame& F, int l, int ci) {
    const WsMap m = ws_map(NTOK);
    const int bh = ci >> 6, c = ci & 63, b = bh >> 3, h = bh & 7;
    const int lane = F.lane, w = F.wave, tid = F.tid;
    const int ch = h * 64 + lane;
    LAS bf16_t* At = (LAS bf16_t*)F.lds; LAS bf16_t* AtT = At + RWT; LAS bf16_t* Bt = AtT + RWT; LAS bf16_t* Kt = Bt + RWT; LAS bf16_t* KtGT = Kt + RWT;
    LAS bf16_t* Rt = KtGT + RWT; LAS bf16_t* VmT = Rt + RWT; LAS bf16_t* LAK = VmT + RWT;
    LAS bf16_t* X0 = LAK + RWT; LAS bf16_t* XT0 = X0 + RWT; LAS bf16_t* T0 = XT0 + RWT; LAS bf16_t* X1 = T0 + RWT; LAS bf16_t* XT1 = X1 + RWT; LAS bf16_t* T1 = XT1 + RWT;
    LAS float* LWL = (LAS float*)X0;
    LAS bf16_t* A2 = X1;
    LAS bf16_t* LVT = XT1;
    const bf16_t* zr = (const bf16_t*)(a.ws + m.zrkv); const bf16_t* ao = (const bf16_t*)(a.ws + m.auxo); const bf16_t* vr = (const bf16_t*)(a.ws + m.vres);
    float* vf = (float*)(a.ws + m.vfirst); bf16_t* bvo = (bf16_t*)(a.ws + m.rwbv);
    unsigned char* blob = a.ws + m.xn + (size_t)ci * RWB_BYTES;
    bf16_t* gW = (bf16_t*)blob; bf16_t* gQG = gW + RWT; bf16_t* gKGT = gQG + RWT; bf16_t* gA1 = gKGT + RWT;
    float* gDV = (float*)(blob + RWB_DVEC); bf16_t* gVS = (bf16_t*)(blob + RWB_VS);
    const int j = tid >> 3, c8 = (tid & 7) * 8, chb = h * 64 + c8;
    const size_t n = (size_t)b * TSEQ + c * 64 + j;
    float zr_[8], zk_[8], zv_[8], wp[8], ap[8];
    unpack8(ld8(zr + n * 1536 + chb), zr_); unpack8(ld8(zr + n * 1536 + 512 + chb), zk_); unpack8(ld8(zr + n * 1536 + 1024 + chb), zv_);
    unpack8(ld8(ao + n * 1792 + chb), wp); unpack8(ld8(ao + n * 1792 + 512 + chb), ap);
    float vres8[8], vf8[8];
    if (l > 0) { unpack8(ld8(vr + n * 512 + chb), vres8); const f32x4 f0 = *(const f32x4*)(vf + n * 512 + chb), f1 = *(const f32x4*)(vf + n * 512 + chb + 4);
        vf8[0] = f0.x; vf8[1] = f0.y; vf8[2] = f0.z; vf8[3] = f0.w; vf8[4] = f1.x; vf8[5] = f1.y; vf8[6] = f1.z; vf8[7] = f1.w; }
    float lw[8];
#pragma unroll
    for (int k = 0; k < 8; ++k) lw[k] = -__expf(-softplus_f(-wp[k]) - 0.5f);
    float cs[8];
#pragma unroll
    for (int k = 0; k < 8; ++k) cs[k] = lw[k];
    chunk_cumsum8(cs, LWL, lane, w, c8);
    {
        float pk_[8], pa_[8], pr_[8];
        { const float* p0 = a.in[I_RW_K_K] + l * 512 + chb; const float* p1 = a.in[I_RW_K_A] + l * 512 + chb; const float* p2 = a.in[I_RW_R_K] + l * 512 + chb;
          const f32x4 a0 = *(const f32x4*)p0, a1 = *(const f32x4*)(p0 + 4), b0 = *(const f32x4*)p1, b1 = *(const f32x4*)(p1 + 4), c0 = *(const f32x4*)p2, c1 = *(const f32x4*)(p2 + 4);
          pk_[0] = a0.x; pk_[1] = a0.y; pk_[2] = a0.z; pk_[3] = a0.w; pk_[4] = a1.x; pk_[5] = a1.y; pk_[6] = a1.z; pk_[7] = a1.w;
          pa_[0] = b0.x; pa_[1] = b0.y; pa_[2] = b0.z; pa_[3] = b0.w; pa_[4] = b1.x; pa_[5] = b1.y; pa_[6] = b1.z; pa_[7] = b1.w;
          pr_[0] = c0.x; pr_[1] = c0.y; pr_[2] = c0.z; pr_[3] = c0.w; pr_[4] = c1.x; pr_[5] = c1.y; pr_[6] = c1.z; pr_[7] = c1.w; }
        float v[8], aa[8], kk[8], km[8];
        float ss = 0.f, bs = 0.f;
#pragma unroll
        for (int k = 0; k < 8; ++k) {
            v[k] = (l == 0) ? zv_[k] : zv_[k] + (vf8[k] - zv_[k]) * sigm(vres8[k]);
            aa[k] = sigm(ap[k]);
            kk[k] = zk_[k] * pk_[k]; ss += kk[k] * kk[k];
            km[k] = zk_[k] * (1.0f + (aa[k] - 1.0f) * pa_[k]); bs += zr_[k] * km[k] * pr_[k];
        }
        if (l == 0) { *(f32x4*)(vf + n * 512 + chb) = (f32x4){zv_[0], zv_[1], zv_[2], zv_[3]}; *(f32x4*)(vf + n * 512 + chb + 4) = (f32x4){zv_[4], zv_[5], zv_[6], zv_[7]}; }
        ss = red8(ss); bs = red8(bs);
        const float kinv = 1.0f / sqrtf(fmaxf(ss, 1e-24f));
        float cm[8], gcv[8];
        {
#pragma unroll
          for (int k = 0; k < 8; ++k) gcv[k] = 0.f;
#pragma unroll
          for (int ww = 0; ww < 8; ++ww) { const f32x4 g0 = *(const LAS f32x4*)(LWL + ww * 64 + c8), g1 = *(const LAS f32x4*)(LWL + ww * 64 + c8 + 4);
              gcv[0] += g0.x; gcv[1] += g0.y; gcv[2] += g0.z; gcv[3] += g0.w; gcv[4] += g1.x; gcv[5] += g1.y; gcv[6] += g1.z; gcv[7] += g1.w; } }
#pragma unroll
        for (int k = 0; k < 8; ++k) cm[k] = cs[k] - lw[k];
        float t_at[8], t_bt[8], t_kt[8], t_rt[8], t_bv[8];
        LAS bf16_t* KGTl = T1;
#pragma unroll
        for (int k = 0; k < 8; ++k) {
            const float G = __expf(cs[k]), Gm1 = __expf(cm[k]), iG = __expf(-cs[k]), GcG = __expf(gcv[k] - cs[k]);
            const float kkn = kk[k] * kinv;
            const float av = -kkn, bv = kkn * aa[k];
            t_at[k] = av * Gm1; t_bt[k] = bv * iG; t_kt[k] = km[k] * iG; t_rt[k] = zr_[k] * G; t_bv[k] = bs * v[k];
            AtT[(c8 + k) * RWP + j] = f2bf(t_at[k]);
            KtGT[(c8 + k) * RWP + j] = f2bf(km[k] * GcG);
            VmT[(c8 + k) * RWP + j] = f2bf(v[k]);
            KGTl[(c8 + k) * RWP + j] = f2bf(bv * GcG);
        }
        *(LAS v4u*)(At + j * RWP + c8) = pack8(t_at); *(LAS v4u*)(Bt + j * RWP + c8) = pack8(t_bt); *(LAS v4u*)(Kt + j * RWP + c8) = pack8(t_kt);
        const v4u rt8 = pack8(t_rt);
        *(LAS v4u*)(Rt + j * RWP + c8) = rt8; *(v4u*)(gQG + j * RWP + c8) = rt8;
        *(v4u*)(bvo + n * 512 + chb) = pack8(t_bv);
        if (j == 63) { *(f32x4*)(gDV + c8) = (f32x4){__expf(gcv[0]), __expf(gcv[1]), __expf(gcv[2]), __expf(gcv[3])}; *(f32x4*)(gDV + c8 + 4) = (f32x4){__expf(gcv[4]), __expf(gcv[5]), __expf(gcv[6]), __expf(gcv[7])}; }
    }
    __syncthreads();
    {
        for (int o = tid; o < RWT / 8; o += NTHR) ((v4u*)gKGT)[o] = ((const LAS v4u*)T1)[o];
        f32x4 z4 = {0.f, 0.f, 0.f, 0.f};
#pragma unroll 1
        for (int tt = 0; tt < 2; ++tt) {
            const int t = w + 8 * tt, mt = t >> 2, nt = t & 3;
            const int n = nt * 16 + (lane & 15), i0 = mt * 16 + (lane >> 4) * 4;
            f32x4 lab = mm64(At, Bt, mt, nt, lane, z4), lak = mm64(At, Kt, mt, nt, lane, z4), a1 = mm64(Rt, Bt, mt, nt, lane, z4), a2 = mm64(Rt, Kt, mt, nt, lane, z4);
            f32x4 tt0;
#pragma unroll
            for (int e = 0; e < 4; ++e) { const int i = i0 + e;
                if (n >= i) { lab[e] = 0.f; lak[e] = 0.f; }
                if (n > i) { a1[e] = 0.f; a2[e] = 0.f; }
                tt0[e] = lab[e] + (n == i ? 1.0f : 0.f); }
            st_rowmajor(X0, mt, nt, lane, lab); st_transposed(XT0, mt, nt, lane, lab);
            st_rowmajor(T0, mt, nt, lane, tt0);
            st_rowmajor(LAK, mt, nt, lane, lak);
            st_rowmajor(A2, mt, nt, lane, a2);
            gA1[(i0 + 0) * RWP + n] = f2bf(a1.x); gA1[(i0 + 1) * RWP + n] = f2bf(a1.y); gA1[(i0 + 2) * RWP + n] = f2bf(a1.z); gA1[(i0 + 3) * RWP + n] = f2bf(a1.w);
        }
    }
    __syncthreads();
    {
        f32x4 z4 = {0.f, 0.f, 0.f, 0.f};
#pragma unroll 1
        for (int tt = 0; tt < 2; ++tt) {
            const int t = w + 8 * tt, mt = t >> 2, nt = t & 3;
            const int n = nt * 16 + (lane & 15), i0 = mt * 16 + (lane >> 4) * 4;
            const f32x4 lv = mm64(LAK, VmT, mt, nt, lane, z4), o0 = mm64(A2, VmT, mt, nt, lane, z4), kv0 = mm64(KtGT, VmT, mt, nt, lane, z4);
            st_transposed((LAS bf16_t*)(F.lds + 131584), mt, nt, lane, lv);
            bf16_t* go = gVS + (size_t)nt * 3 * 1024 + 1024;
            const int r = lane & 15;
            go[(i0 + 0) * 16 + r] = f2bf(o0.x); go[(i0 + 1) * 16 + r] = f2bf(o0.y); go[(i0 + 2) * 16 + r] = f2bf(o0.z); go[(i0 + 3) * 16 + r] = f2bf(o0.w);
            go[1024 + (i0 + 0) * 16 + r] = f2bf(kv0.x); go[1024 + (i0 + 1) * 16 + r] = f2bf(kv0.y); go[1024 + (i0 + 2) * 16 + r] = f2bf(kv0.z); go[1024 + (i0 + 3) * 16 + r] = f2bf(kv0.w);
            (void)n;
        }
    }
    __syncthreads();
    {
        LAS bf16_t* Xc = X0; LAS bf16_t* XTc = XT0; LAS bf16_t* Tc = T0; LAS bf16_t* Xn = X1; LAS bf16_t* XTn = XT1; LAS bf16_t* Tn = T1;
        f32x4 z4 = {0.f, 0.f, 0.f, 0.f};
#pragma unroll 1
        for (int it = 0; it < 5; ++it) {
#pragma unroll 1
            for (int tt = 0; tt < 2; ++tt) { const int t = w + 8 * tt, mt = t >> 2, nt = t & 3;
                const f32x4 x2 = mm64(Xc, XTc, mt, nt, lane, z4);
                st_rowmajor(Xn, mt, nt, lane, x2); st_transposed(XTn, mt, nt, lane, x2); }
            __syncthreads();
#pragma unroll 1
            for (int tt = 0; tt < 2; ++tt) { const int t = w + 8 * tt, mt = t >> 2, nt = t & 3;
                const int n = nt * 16 + (lane & 15), i0 = mt * 16 + (lane >> 4) * 4;
                f32x4 tc; tc.x = bf2f(Tc[(i0 + 0) * RWP + n]); tc.y = bf2f(Tc[(i0 + 1) * RWP + n]); tc.z = bf2f(Tc[(i0 + 2) * RWP + n]); tc.w = bf2f(Tc[(i0 + 3) * RWP + n]);
                const f32x4 tn = mm64(Tc, XTn, mt, nt, lane, tc);
                st_rowmajor(Tn, mt, nt, lane, tn); }
            __syncthreads();
            LAS bf16_t* s0 = Xc; Xc = Xn; Xn = s0; s0 = XTc; XTc = XTn; XTn = s0; s0 = Tc; Tc = Tn; Tn = s0;
        }
        LAS bf16_t* LVTp = (LAS bf16_t*)(F.lds + 131584);
#pragma unroll 1
        for (int tt = 0; tt < 2; ++tt) { const int t = w + 8 * tt, mt = t >> 2, nt = t & 3;
            const int n = nt * 16 + (lane & 15), i0 = mt * 16 + (lane >> 4) * 4, r = lane & 15;
            const f32x4 wt = mm64(Tc, AtT, mt, nt, lane, z4), u0 = mm64(Tc, LVTp, mt, nt, lane, z4);
            gW[(i0 + 0) * RWP + n] = f2bf(wt.x); gW[(i0 + 1) * RWP + n] = f2bf(wt.y); gW[(i0 + 2) * RWP + n] = f2bf(wt.z); gW[(i0 + 3) * RWP + n] = f2bf(wt.w);
            bf16_t* gu = gVS + (size_t)nt * 3 * 1024;
            gu[(i0 + 0) * 16 + r] = f2bf(u0.x); gu[(i0 + 1) * 16 + r] = f2bf(u0.y); gu[(i0 + 2) * 16 + r] = f2bf(u0.z); gu[(i0 + 3) * 16 + r] = f2bf(u0.w); }
    }
    __syncthreads();
    (void)LVT;
}

__device__ __forceinline__ void rwkv_ps_task(const Args& a, Frame& F, int task) {
    const WsMap m = ws_map(NTOK);
    const int bh = task >> 2, vs = task & 3, b = bh >> 3, h = bh & 7;
    const int lane = F.lane, w = F.wave, tid = F.tid;
    LAS bf16_t* LB = (LAS bf16_t*)F.lds;
    LAS bf16_t* ST = LB + 4 * RWT; LAS bf16_t* VNT = ST + 16 * RWP;
    bf16_t* yo = (bf16_t*)(a.ws + m.rwy);
    const unsigned char* blob0 = a.ws + m.xn + (size_t)(bh * 64) * RWB_BYTES;
    const int r = lane & 15, i0w = (w & 3) * 16 + (lane >> 4) * 4;
    f32x4 Sacc = {0.f, 0.f, 0.f, 0.f};
    for (int i = tid; i < 16 * RWP / 2; i += NTHR) ((LAS unsigned*)ST)[i] = 0u;
    v4u pre[5];
    auto prefetch = [&](int c) {
        const v4u* g = (const v4u*)(blob0 + (size_t)c * RWB_BYTES);
#pragma unroll
        for (int k = 0; k < 5; ++k) { const int o = k * 512 + tid; pre[k] = (o < (int)(RWB_TILES / 16)) ? g[o] : (v4u){0u, 0u, 0u, 0u}; }
    };
    auto commit = [&]() {
#pragma unroll
        for (int k = 0; k < 5; ++k) { const int o = k * 512 + tid; if (o < (int)(RWB_TILES / 16)) ((LAS v4u*)LB)[o] = pre[k]; }
    };
    bf16_t nfr[4], nkv[4]; float ndv[4];
    auto prefrag = [&](int c) {
        const unsigned char* blob = blob0 + (size_t)c * RWB_BYTES;
        const bf16_t* gvs = (const bf16_t*)(blob + RWB_VS) + (size_t)vs * 3 * 1024;
        const bf16_t* src = gvs + (w < 4 ? 0 : 1024);
#pragma unroll
        for (int e = 0; e < 4; ++e) nfr[e] = src[(i0w + e) * 16 + r];
        if (w < 4) { const float* gd = (const float*)(blob + RWB_DVEC);
#pragma unroll
            for (int e = 0; e < 4; ++e) { ndv[e] = gd[i0w + e]; nkv[e] = gvs[2048 + (i0w + e) * 16 + r]; } }
        else {
#pragma unroll
            for (int e = 0; e < 4; ++e) { ndv[e] = 1.f; nkv[e] = 0; } }
    };
    prefetch(0); commit(); prefetch(1); prefrag(0);
    for (int c = 0; c < 64; ++c) {
        float fr[4], dv[4], kv0[4];
#pragma unroll
        for (int e = 0; e < 4; ++e) { fr[e] = bf2f(nfr[e]); dv[e] = ndv[e]; kv0[e] = bf2f(nkv[e]); }
        if (c + 1 < 64) prefrag(c + 1);
        __syncthreads();
        if (w < 4) {
            f32x4 vn = mm64(LB, ST, w, 0, lane, (f32x4){fr[0], fr[1], fr[2], fr[3]});
            st_transposed(VNT, w, 0, lane, vn);
        }
        __syncthreads();
        if (w < 4) {
            const f32x4 base = {dv[0] * Sacc.x + kv0[0], dv[1] * Sacc.y + kv0[1], dv[2] * Sacc.z + kv0[2], dv[3] * Sacc.w + kv0[3]};
            Sacc = mm64(LB + 2 * RWT, VNT, w, 0, lane, base);
        } else {
            f32x4 o = mm64(LB + RWT, ST, w - 4, 0, lane, (f32x4){fr[0], fr[1], fr[2], fr[3]});
            o = mm64(LB + 3 * RWT, VNT, w - 4, 0, lane, o);
            const size_t n = (size_t)b * TSEQ + c * 64 + i0w;
            bf16_t* yp = yo + n * 512 + h * 64 + vs * 16 + r;
            yp[0] = f2bf(o.x); yp[512] = f2bf(o.y); yp[1024] = f2bf(o.z); yp[1536] = f2bf(o.w);
        }
        __syncthreads();
        if (w < 4) st_transposed(ST, w, 0, lane, Sacc);
        if (c + 1 < 64) commit();
        if (c + 2 < 64) prefetch(c + 2);
    }
    __syncthreads();
}

constexpr int GP = 136;
constexpr size_t GB_BYTES = 26880;
template <int KD, int PA_, int PB_>
__device__ __forceinline__ f32x4 mmx(const LAS bf16_t* A, const LAS bf16_t* Bt, int mt, int nt, int lane, f32x4 acc) {
    const LAS bf16_t* ap = A + (mt * 16 + (lane & 15)) * PA_ + (lane >> 4) * 8;
    const LAS bf16_t* bp = Bt + (nt * 16 + (lane & 15)) * PB_ + (lane >> 4) * 8;
#pragma unroll
    for (int k0 = 0; k0 < KD; k0 += 32)
        acc = __builtin_amdgcn_mfma_f32_16x16x32_bf16(*(const LAS bf16x8*)(ap + k0), *(const LAS bf16x8*)(bp + k0), acc, 0, 0, 0);
    return acc;
}
__device__ __forceinline__ void gdn_pa_chunk(const Args& a, Frame& F, int ci) {
    const WsMap m = ws_map(NTOK);
    const int bh = ci >> 6, c = ci & 63, b = bh >> 2, h = bh & 3;
    const int lane = F.lane, w = F.wave, tid = F.tid;
    LAS bf16_t* KB = (LAS bf16_t*)F.lds; LAS bf16_t* KH = KB + 64 * GP; LAS bf16_t* QH = KH + 64 * GP;
    LAS bf16_t* KBEt = KB; LAS bf16_t* VbT = KB + 128 * RWP;
    LAS bf16_t* X0 = QH + 64 * GP; LAS bf16_t* XT0 = X0 + RWT; LAS bf16_t* T0 = XT0 + RWT; LAS bf16_t* X1 = T0 + RWT; LAS bf16_t* XT1 = X1 + RWT; LAS bf16_t* T1 = XT1 + RWT;
    LAS float* GC = (LAS float*)(T1 + RWT);
    LAS bf16_t* KGTl = (LAS bf16_t*)(GC + 64);
    bf16_t* gq = (bf16_t*)(a.ws + m.gq); bf16_t* gk = (bf16_t*)(a.ws + m.gk); bf16_t* gv = (bf16_t*)(a.ws + m.gv); const float* gsc = (const float*)(a.ws + m.gsc);
    unsigned char* blob = a.ws + m.gblob + (size_t)ci * GB_BYTES;
    bf16_t* gA1 = (bf16_t*)blob; bf16_t* gW = gA1 + RWT; float* gGC = (float*)(blob + RWT * 2 + 64 * GP * 2);
    const int j = tid >> 3, c16 = (tid & 7) * 16;
    const size_t n0 = (size_t)b * TSEQ + c * 64, n = n0 + j;
    const float be = gsc[n * 8 + h];
    v4u kw[2], qw[2], vw[2];
    {
        float kf[8];
#pragma unroll
        for (int hh = 0; hh < 2; ++hh) {
            kw[hh] = ld8(gk + n * 512 + h * 128 + c16 + hh * 8); qw[hh] = ld8(gq + n * 512 + h * 128 + c16 + hh * 8); vw[hh] = ld8(gv + n * 512 + h * 128 + c16 + hh * 8);
            *(LAS v4u*)(KH + j * GP + c16 + hh * 8) = kw[hh]; *(LAS v4u*)(QH + j * GP + c16 + hh * 8) = qw[hh];
            unpack8(kw[hh], kf);
#pragma unroll
            for (int k = 0; k < 8; ++k) kf[k] *= be;
            *(LAS v4u*)(KB + j * GP + c16 + hh * 8) = pack8(kf);
        }
        if (w == 0) {
            float g = gsc[(n0 + lane) * 8 + 4 + h];
#pragma unroll
            for (int o = 1; o < 64; o <<= 1) { const float t = __shfl_up(g, o); if (lane >= o) g += t; }
            GC[lane] = g; gGC[lane] = g;
        }
    }
    __syncthreads();
    {
        const f32x4 z4 = {0.f, 0.f, 0.f, 0.f};
#pragma unroll 1
        for (int tt = 0; tt < 2; ++tt) {
            const int t = w + 8 * tt, mt = t >> 2, nt = t & 3;
            const int nn = nt * 16 + (lane & 15), i0 = mt * 16 + (lane >> 4) * 4;
            f32x4 kk = mmx<128, GP, GP>(KB, KH, mt, nt, lane, z4), qk = mmx<128, GP, GP>(QH, KH, mt, nt, lane, z4);
            const float gj = GC[nn];
            f32x4 x, t0;
#pragma unroll
            for (int e = 0; e < 4; ++e) { const int i = i0 + e; const float d = __expf(fminf(GC[i] - gj, 0.f));
                x[e] = (nn < i) ? -kk[e] * d : 0.f; qk[e] = (nn <= i) ? qk[e] * d : 0.f; t0[e] = x[e] + (nn == i ? 1.0f : 0.f); }
            st_rowmajor(X0, mt, nt, lane, x); st_transposed(XT0, mt, nt, lane, x); st_rowmajor(T0, mt, nt, lane, t0);
            gA1[(i0 + 0) * RWP + nn] = f2bf(qk.x); gA1[(i0 + 1) * RWP + nn] = f2bf(qk.y); gA1[(i0 + 2) * RWP + nn] = f2bf(qk.z); gA1[(i0 + 3) * RWP + nn] = f2bf(qk.w);
        }
    }
    __syncthreads();
    {
        const float gj = GC[j], eg = __expf(gj), s_kbe = be * eg, s_kg = __expf(GC[63] - gj);
        float f[8], o8[8];
#pragma unroll
        for (int hh = 0; hh < 2; ++hh) {
            unpack8(kw[hh], f);
#pragma unroll
            for (int k = 0; k < 8; ++k) { KBEt[(c16 + hh * 8 + k) * RWP + j] = f2bf(f[k] * s_kbe); KGTl[(c16 + hh * 8 + k) * RWP + j] = f2bf(f[k] * s_kg); }
            unpack8(vw[hh], f);
#pragma unroll
            for (int k = 0; k < 8; ++k) VbT[(c16 + hh * 8 + k) * RWP + j] = f2bf(f[k] * be);
            unpack8(qw[hh], f);
#pragma unroll
            for (int k = 0; k < 8; ++k) o8[k] = f[k] * eg;
            *(v4u*)(gq + n * 512 + h * 128 + c16 + hh * 8) = pack8(o8);
        }
    }
    const f32x4 z4 = {0.f, 0.f, 0.f, 0.f};
    LAS bf16_t* Xc = X0; LAS bf16_t* XTc = XT0; LAS bf16_t* Tc = T0; LAS bf16_t* Xn = X1; LAS bf16_t* XTn = XT1; LAS bf16_t* Tn = T1;
#pragma unroll 1
    for (int it = 0; it < 5; ++it) {
#pragma unroll 1
        for (int tt = 0; tt < 2; ++tt) { const int t = w + 8 * tt, mt = t >> 2, nt = t & 3;
            const f32x4 x2 = mm64(Xc, XTc, mt, nt, lane, z4);
            st_rowmajor(Xn, mt, nt, lane, x2); st_transposed(XTn, mt, nt, lane, x2); }
        __syncthreads();
#pragma unroll 1
        for (int tt = 0; tt < 2; ++tt) { const int t = w + 8 * tt, mt = t >> 2, nt = t & 3;
            const int nn = nt * 16 + (lane & 15), i0 = mt * 16 + (lane >> 4) * 4;
            f32x4 tc; tc.x = bf2f(Tc[(i0 + 0) * RWP + nn]); tc.y = bf2f(Tc[(i0 + 1) * RWP + nn]); tc.z = bf2f(Tc[(i0 + 2) * RWP + nn]); tc.w = bf2f(Tc[(i0 + 3) * RWP + nn]);
            const f32x4 tn = mm64(Tc, XTn, mt, nt, lane, tc);
            st_rowmajor(Tn, mt, nt, lane, tn); }
        __syncthreads();
        LAS bf16_t* s0 = Xc; Xc = Xn; Xn = s0; s0 = XTc; XTc = XTn; XTn = s0; s0 = Tc; Tc = Tn; Tn = s0;
    }
    {
#pragma unroll 1
        for (int tt = 0; tt < 4; ++tt) { const int mt = w, nt = tt;
            const f32x4 dw = mm64(KBEt, Tc, mt, nt, lane, z4), du = mm64(VbT, Tc, mt, nt, lane, z4);
            const int i = nt * 16 + (lane & 15), c0 = mt * 16 + (lane >> 4) * 4;
            *(v2u*)(gW + i * GP + c0) = (v2u){pk2(dw.x, dw.y), pk2(dw.z, dw.w)};
            *(v2u*)(gv + (n0 + i) * 512 + h * 128 + c0) = (v2u){pk2(du.x, du.y), pk2(du.z, du.w)}; }
        for (int p = tid; p < 1024; p += NTHR) { const int k = p >> 3, j8 = (p & 7) * 8;
            *(v4u*)(gk + (n0 + (k >> 1)) * 512 + h * 128 + (k & 1) * 64 + j8) = *(const LAS v4u*)(KGTl + k * RWP + j8); }
    }
    __syncthreads();
}

__device__ __forceinline__ void gdn_ps_task(const Args& a, Frame& F, int task) {
    const WsMap m = ws_map(NTOK);
    const int bh = task >> 3, vs = task & 7, b = bh >> 2, h = bh & 3;
    const int lane = F.lane, w = F.wave, tid = F.tid;
    LAS bf16_t* A1 = (LAS bf16_t*)F.lds; LAS bf16_t* WT = A1 + RWT; LAS float* GC = (LAS float*)(WT + 64 * GP);
    LAS bf16_t* QG = (LAS bf16_t*)(GC + 64); LAS bf16_t* KGT = QG + 64 * GP; LAS bf16_t* ST = KGT + 128 * RWP;
    LAS bf16_t* VNT = ST + 16 * GP; LAS bf16_t* UU = VNT + 16 * RWP;
    const bf16_t* gq = (const bf16_t*)(a.ws + m.gq); const bf16_t* gk = (const bf16_t*)(a.ws + m.gk); const bf16_t* gv = (const bf16_t*)(a.ws + m.gv);
    bf16_t* go = (bf16_t*)(a.ws + m.gdno);
    const unsigned char* blob0 = a.ws + m.gblob + (size_t)(bh * 64) * GB_BYTES;
    const int r = lane & 15, kq4 = (lane >> 4) * 4;
    f32x4 Sacc = {0.f, 0.f, 0.f, 0.f};
    for (int i = tid; i < 16 * GP / 2; i += NTHR) ((LAS unsigned*)ST)[i] = 0u;
    v4u pb_[4], pq_[2], pk_[2], pu_;
    auto prefetch = [&](int c) {
        const size_t n0 = (size_t)b * TSEQ + c * 64;
        const v4u* g = (const v4u*)(blob0 + (size_t)c * GB_BYTES);
#pragma unroll
        for (int k = 0; k < 4; ++k) { const int o = k * 512 + tid; pb_[k] = (o < (int)(GB_BYTES / 16)) ? g[o] : (v4u){0u, 0u, 0u, 0u}; }
#pragma unroll
        for (int k = 0; k < 2; ++k) { const int p = k * 512 + tid;
            pq_[k] = ld8(gq + (n0 + (p >> 4)) * 512 + h * 128 + (p & 15) * 8);
            pk_[k] = ld8(gk + (n0 + (p >> 4)) * 512 + h * 128 + (p & 15) * 8); }
        if (tid < 128) pu_ = ld8(gv + (n0 + (tid >> 1)) * 512 + h * 128 + vs * 16 + (tid & 1) * 8);
    };
    prefetch(0);
    for (int c = 0; c < 64; ++c) {
#pragma unroll
        for (int k = 0; k < 4; ++k) { const int o = k * 512 + tid; if (o < (int)(GB_BYTES / 16)) ((LAS v4u*)A1)[o] = pb_[k]; }
#pragma unroll
        for (int k = 0; k < 2; ++k) { const int p = k * 512 + tid;
            *(LAS v4u*)(QG + (p >> 4) * GP + (p & 15) * 8) = pq_[k];
            const int kk = 2 * (p >> 4) + ((p & 15) >> 3), j8 = (p & 7) * 8;
            *(LAS v4u*)(KGT + kk * RWP + j8) = pk_[k]; }
        if (tid < 128) *(LAS v4u*)(UU + (tid >> 1) * 16 + (tid & 1) * 8) = pu_;
        __syncthreads();
        if (c + 1 < 64) prefetch(c + 1);
        const float glast = __expf(GC[63]);
        if (w < 4) {
            const int i0 = w * 16 + kq4;
            f32x4 vn = mmx<128, GP, GP>(WT, ST, w, 0, lane, (f32x4){0.f, 0.f, 0.f, 0.f});
            vn.x = bf2f(UU[(i0 + 0) * 16 + r]) - vn.x; vn.y = bf2f(UU[(i0 + 1) * 16 + r]) - vn.y; vn.z = bf2f(UU[(i0 + 2) * 16 + r]) - vn.z; vn.w = bf2f(UU[(i0 + 3) * 16 + r]) - vn.w;
            st_transposed(VNT, w, 0, lane, vn);
        }
        __syncthreads();
        {
            const f32x4 base = {Sacc.x * glast, Sacc.y * glast, Sacc.z * glast, Sacc.w * glast};
            Sacc = mm64(KGT, VNT, w, 0, lane, base);
            if (w < 4) {
                f32x4 o = mmx<128, GP, GP>(QG, ST, w, 0, lane, (f32x4){0.f, 0.f, 0.f, 0.f});
                o = mm64(A1, VNT, w, 0, lane, o);
                const size_t n = (size_t)b * TSEQ + c * 64 + w * 16 + kq4;
                bf16_t* op = go + n * 512 + h * 128 + vs * 16 + r;
                op[0] = f2bf(o.x); op[512] = f2bf(o.y); op[1024] = f2bf(o.z); op[1536] = f2bf(o.w);
            }
        }
        __syncthreads();
        { const int k0 = w * 16 + kq4;
          *(LAS v2u*)(ST + r * GP + k0) = (v2u){pk2(Sacc.x, Sacc.y), pk2(Sacc.z, Sacc.w)}; }
    }
    __syncthreads();
}

__device__ __forceinline__ void gla_pa_chunk(const Args& a, Frame& F, int ci) {
    const WsMap m = ws_map(NTOK);
    const int bh = ci >> 6, c = ci & 63, b = bh >> 2, h = bh & 3;
    const int lane = F.lane, w = F.wave, tid = F.tid;
    LAS bf16_t* KS2T = (LAS bf16_t*)F.lds; LAS bf16_t* VT = KS2T + RWT; LAS float* TMP = (LAS float*)(VT + 128 * RWP);
    const bf16_t* p16 = (const bf16_t*)(a.ws + m.p16); const bf16_t* ao = (const bf16_t*)(a.ws + m.auxo);
    bf16_t* gKV = (bf16_t*)(a.ws + m.glao) + (size_t)ci * 8192; float* gDV = (float*)(a.ws + m.gladv) + (size_t)ci * 64;
    const int j = tid >> 3, c8 = (tid & 7) * 8, v16 = (tid & 7) * 16;
    const size_t n = (size_t)b * TSEQ + c * 64 + j;
    float k8[8], la[8];
    unpack8(ld8(p16 + n * PLD + C_GLA + 256 + h * 64 + c8), k8); unpack8(ld8(ao + n * 1792 + 1536 + h * 64 + c8), la);
    const v4u v0 = ld8(p16 + n * PLD + C_GLA + 512 + h * 128 + v16), v1 = ld8(p16 + n * PLD + C_GLA + 512 + h * 128 + v16 + 8);
#pragma unroll
    for (int k = 0; k < 8; ++k) la[k] = -softplus_f(-la[k]) * (1.0f / 16.0f);
    chunk_cumsum8(la, TMP, lane, w, c8);
    float bl[8];
#pragma unroll
    for (int k = 0; k < 8; ++k) bl[k] = 0.f;
#pragma unroll
    for (int ww = 0; ww < 8; ++ww) { const f32x4 y0 = *(const LAS f32x4*)(TMP + ww * 64 + c8), y1 = *(const LAS f32x4*)(TMP + ww * 64 + c8 + 4);
        bl[0] += y0.x; bl[1] += y0.y; bl[2] += y0.z; bl[3] += y0.w; bl[4] += y1.x; bl[5] += y1.y; bl[6] += y1.z; bl[7] += y1.w; }
#pragma unroll
    for (int k = 0; k < 8; ++k) KS2T[(c8 + k) * RWP + j] = f2bf(k8[k] * __expf(bl[k] - la[k]));
    { const unsigned vw[8] = {v0.x, v0.y, v0.z, v0.w, v1.x, v1.y, v1.z, v1.w};
#pragma unroll
      for (int e = 0; e < 8; ++e) { VT[(v16 + 2 * e) * RWP + j] = (bf16_t)(vw[e] & 0xffffu); VT[(v16 + 2 * e + 1) * RWP + j] = (bf16_t)(vw[e] >> 16); } }
    if (j == 0) { *(f32x4*)(gDV + c8) = (f32x4){__expf(bl[0]), __expf(bl[1]), __expf(bl[2]), __expf(bl[3])}; *(f32x4*)(gDV + c8 + 4) = (f32x4){__expf(bl[4]), __expf(bl[5]), __expf(bl[6]), __expf(bl[7])}; }
    __syncthreads();
    {
        const f32x4 z4 = {0.f, 0.f, 0.f, 0.f};
#pragma unroll
        for (int tt = 0; tt < 4; ++tt) { const int mt = tt, nt = w;
            const f32x4 d = mm64(KS2T, VT, mt, nt, lane, z4);
            const int dv = nt * 16 + (lane & 15), k0 = mt * 16 + (lane >> 4) * 4;
            *(v2u*)(gKV + dv * 64 + k0) = (v2u){pk2(d.x, d.y), pk2(d.z, d.w)}; }
    }
    __syncthreads();
}
__device__ __forceinline__ void gla_sscan(const Args& a, Frame& F) {
    const WsMap m = ws_map(NTOK);
    const bf16_t* gKV = (const bf16_t*)(a.ws + m.glao); const float* gDV = (const float*)(a.ws + m.gladv); bf16_t* gS = (bf16_t*)(a.ws + m.glas);
    for (int it = F.vcu * NTHR + F.tid; it < 16 * 8192; it += F.G * NTHR) {
        const int bh = it >> 13, e = it & 8191, k = e & 63;
        float S = 0.f;
#pragma unroll 1
        for (int c0 = 0; c0 < 64; c0 += 16) {
            float kv[16], dv[16];
#pragma unroll
            for (int u = 0; u < 16; ++u) { const size_t ci = (size_t)bh * 64 + c0 + u; kv[u] = bf2f(gKV[ci * 8192 + e]); dv[u] = gDV[ci * 64 + k]; }
#pragma unroll
            for (int u = 0; u < 16; ++u) { const size_t ci = (size_t)bh * 64 + c0 + u; gS[ci * 8192 + e] = f2bf(S); S = S * dv[u] + kv[u]; }
        }
    }
}
__device__ __forceinline__ void gla_pb_chunk(const Args& a, Frame& F, int l, int ci) {
    const WsMap m = ws_map(NTOK);
    const int bh = ci >> 6, c = ci & 63, b = bh >> 2, h = bh & 3;
    const int lane = F.lane, w = F.wave, tid = F.tid;
    LAS bf16_t* QS = (LAS bf16_t*)F.lds; LAS bf16_t* KS = QS + RWT; LAS bf16_t* QG = KS + RWT; LAS bf16_t* PM = QG + RWT;
    LAS bf16_t* VT = PM + RWT; LAS bf16_t* ST = VT + 128 * RWP; LAS bf16_t* GG = ST + 128 * RWP;
    LAS float* TMP = (LAS float*)(GG + 64 * GP); LAS float* OSS = TMP + 512;
    const bf16_t* p16 = (const bf16_t*)(a.ws + m.p16); const bf16_t* ao = (const bf16_t*)(a.ws + m.auxo);
    const bf16_t* gS = (const bf16_t*)(a.ws + m.glas) + (size_t)ci * 8192; bf16_t* mix = (bf16_t*)(a.ws + m.mix16);
    const int j = tid >> 3, c8 = (tid & 7) * 8, v16 = (tid & 7) * 16;
    const size_t n = (size_t)b * TSEQ + c * 64 + j;
    float q8[8], k8[8], la[8];
    unpack8(ld8(p16 + n * PLD + C_GLA + h * 64 + c8), q8); unpack8(ld8(p16 + n * PLD + C_GLA + 256 + h * 64 + c8), k8); unpack8(ld8(ao + n * 1792 + 1536 + h * 64 + c8), la);
    const v4u v0 = ld8(p16 + n * PLD + C_GLA + 512 + h * 128 + v16), v1 = ld8(p16 + n * PLD + C_GLA + 512 + h * 128 + v16 + 8);
    const v4u g0 = ld8(p16 + n * PLD + C_GLA + 1024 + h * 128 + v16), g1 = ld8(p16 + n * PLD + C_GLA + 1024 + h * 128 + v16 + 8);
    const v4u s0 = ((const v4u*)gS)[tid], s1 = ((const v4u*)gS)[512 + tid];
#pragma unroll
    for (int k = 0; k < 8; ++k) la[k] = -softplus_f(-la[k]) * (1.0f / 16.0f);
    chunk_cumsum8(la, TMP, lane, w, c8);
    {
        float br[8], t0[8], t1[8], t2[8];
#pragma unroll
        for (int k = 0; k < 8; ++k) br[k] = 0.f;
#pragma unroll
        for (int ww = 0; ww < 4; ++ww) { const f32x4 y0 = *(const LAS f32x4*)(TMP + ww * 64 + c8), y1 = *(const LAS f32x4*)(TMP + ww * 64 + c8 + 4);
            br[0] += y0.x; br[1] += y0.y; br[2] += y0.z; br[3] += y0.w; br[4] += y1.x; br[5] += y1.y; br[6] += y1.z; br[7] += y1.w; }
#pragma unroll
        for (int k = 0; k < 8; ++k) { const float qq = q8[k] * 0.125f;
            t0[k] = qq * __expf(la[k] - br[k]); t1[k] = k8[k] * __expf(br[k] - la[k]); t2[k] = qq * __expf(la[k]); }
        *(LAS v4u*)(QS + j * RWP + c8) = pack8(t0); *(LAS v4u*)(KS + j * RWP + c8) = pack8(t1); *(LAS v4u*)(QG + j * RWP + c8) = pack8(t2);
        const unsigned vw[8] = {v0.x, v0.y, v0.z, v0.w, v1.x, v1.y, v1.z, v1.w};
#pragma unroll
        for (int e = 0; e < 8; ++e) { VT[(v16 + 2 * e) * RWP + j] = (bf16_t)(vw[e] & 0xffffu); VT[(v16 + 2 * e + 1) * RWP + j] = (bf16_t)(vw[e] >> 16); }
        *(LAS v4u*)(GG + j * GP + v16) = g0; *(LAS v4u*)(GG + j * GP + v16 + 8) = g1;
        { const int p0 = tid, p1 = 512 + tid;
          *(LAS v4u*)(ST + (p0 >> 3) * RWP + (p0 & 7) * 8) = s0; *(LAS v4u*)(ST + (p1 >> 3) * RWP + (p1 & 7) * 8) = s1; }
    }
    __syncthreads();
    {
        const f32x4 z4 = {0.f, 0.f, 0.f, 0.f};
#pragma unroll
        for (int tt = 0; tt < 2; ++tt) { const int t = w + 8 * tt, mtj = t >> 2, nti = t & 3;
            f32x4 s4 = mm64(KS, QS, mtj, nti, lane, z4);
            const int i = nti * 16 + (lane & 15), j0 = mtj * 16 + (lane >> 4) * 4;
#pragma unroll
            for (int e = 0; e < 4; ++e) if (j0 + e > i) s4[e] = 0.f;
            st_transposed(PM, mtj, nti, lane, s4); }
    }
    __syncthreads();
    {
        const int mt = w >> 1, ntb = (w & 1) * 4, r = lane & 15, i0 = mt * 16 + (lane >> 4) * 4;
        f32x4 o[4]; float ss[4] = {0.f, 0.f, 0.f, 0.f};
#pragma unroll
        for (int t = 0; t < 4; ++t) { o[t] = mm64(QG, ST, mt, ntb + t, lane, (f32x4){0.f, 0.f, 0.f, 0.f}); o[t] = mm64(PM, VT, mt, ntb + t, lane, o[t]);
            ss[0] += o[t].x * o[t].x; ss[1] += o[t].y * o[t].y; ss[2] += o[t].z * o[t].z; ss[3] += o[t].w * o[t].w; }
#pragma unroll
        for (int e = 0; e < 4; ++e) ss[e] = row16_sum(ss[e]);
        if (r == 0) {
#pragma unroll
            for (int e = 0; e < 4; ++e) OSS[(i0 + e) * 2 + (w & 1)] = ss[e]; }
        __syncthreads();
        float rs[4];
#pragma unroll
        for (int e = 0; e < 4; ++e) rs[e] = 1.0f / sqrtf((OSS[(i0 + e) * 2] + OSS[(i0 + e) * 2 + 1]) * (1.0f / 128.0f) + 1e-6f);
        const size_t nrow = (size_t)b * TSEQ + c * 64 + i0;
#pragma unroll
        for (int t = 0; t < 4; ++t) { const int dv = (ntb + t) * 16 + r; const float gn = a.in[I_GLA_NORM][l * 128 + dv];
            const float ov[4] = {o[t].x, o[t].y, o[t].z, o[t].w};
#pragma unroll
            for (int e = 0; e < 4; ++e) { const float g = bf2f(GG[(i0 + e) * GP + dv]);
                mix[(nrow + e) * DM + 512 + h * 128 + dv] = f2bf(ov[e] * rs[e] * gn * (g * sigm(g))); } }
    }
    __syncthreads();
}

__device__ __forceinline__ void lru_pass(const Args& a, Frame& F, int l, bool passB) {
    const WsMap m = ws_map(NTOK);
    const bf16_t* gt = (const bf16_t*)(a.ws + m.gates); const bf16_t* xc = (const bf16_t*)(a.ws + m.xc); const bf16_t* p16 = (const bf16_t*)(a.ws + m.p16);
    bf16_t* mix = (bf16_t*)(a.ws + m.mix16); float* lrs = (float*)(a.ws + m.lrs);
    for (int it = F.vcu * NTHR + F.tid; it < NBATCH * 64 * 512; it += F.G * NTHR) {
        const int ch = it & 511, bc = it >> 9, c = bc & 63;
        const float sp8 = 8.0f * softplus_f(-a.in[I_LRU_LAM][l * 512 + ch]);
        const size_t nb = (size_t)bc * 64;
        float hh = 0.f, ap = 1.f;
        if (passB) {
            for (int s0 = 0; s0 < c; s0 += 8) { f32x2 su[8];
#pragma unroll
                for (int u = 0; u < 8; ++u) su[u] = (s0 + u < c) ? *(const f32x2*)(lrs + ((size_t)(bc - c + s0 + u) * 512 + ch) * 2) : (f32x2){1.f, 0.f};
#pragma unroll
                for (int u = 0; u < 8; ++u) hh = su[u].x * hh + su[u].y; } }
#pragma unroll 1
        for (int t0 = 0; t0 < 64; t0 += 8) {
            bf16_t rr[8], ii[8], xx[8], yy[8];
#pragma unroll
            for (int u = 0; u < 8; ++u) { const size_t n = nb + t0 + u; rr[u] = gt[n * 1024 + ch]; ii[u] = gt[n * 1024 + 512 + ch]; xx[u] = xc[n * 512 + ch];
                yy[u] = passB ? p16[n * PLD + C_LRU + 512 + ch] : (bf16_t)0; }
#pragma unroll
            for (int u = 0; u < 8; ++u) { const size_t n = nb + t0 + u;
                const float la = -sp8 * sigm(bf2f(rr[u]));
                const float av = __expf(la);
                const float uu = bf2f(xx[u]) * sigm(bf2f(ii[u])) * sqrtf(fmaxf(1.0f - av * av, 0.0f));
                hh = av * hh + uu; ap *= av;
                if (passB) mix[n * DM + 1024 + ch] = f2bf(hh * gelu_fast(bf2f(yy[u]))); }
        }
        if (!passB) *(f32x2*)(lrs + ((size_t)bc * 512 + ch) * 2) = (f32x2){ap, hh};
    }
}

__device__ __forceinline__ void scan_phase(const Args& a, Frame& F, int l) {
    lru_pass(a, F, l, false);
    const int task = blockIdx.x;
    for (int q = 0; q < 8; ++q) rwkv_pa_chunk(a, F, l, task * 8 + q);
    for (int q = 0; q < 4; ++q) gdn_pa_chunk(a, F, task * 4 + q);
    for (int q = 0; q < 4; ++q) gla_pa_chunk(a, F, task * 4 + q);
    if (l == 0) tables_range(a, F, (size_t)2 * NEXP * DM / 32, (size_t)4 * NEXP * DM / 32, F.vcu, F.G);
}

__device__ __forceinline__ void post_phase(const Args& a, Frame& F, int l, const XcdBarrier& bar) {
    const WsMap m = ws_map(NTOK);
    if (blockIdx.x < 128) rwkv_ps_task(a, F, blockIdx.x); else gdn_ps_task(a, F, blockIdx.x - 128);
    gla_sscan(a, F);
    lru_pass(a, F, l, true);
    const bf16_t* p16 = (const bf16_t*)(a.ws + m.p16); const bf16_t* glao = (const bf16_t*)(a.ws + m.glao); const bf16_t* gdno = (const bf16_t*)(a.ws + m.gdno);
    const bf16_t* rwy = (const bf16_t*)(a.ws + m.rwy); const bf16_t* rwbv = (const bf16_t*)(a.ws + m.rwbv); const bf16_t* ao = (const bf16_t*)(a.ws + m.auxo);
    bf16_t* mix = (bf16_t*)(a.ws + m.mix16);
    const int lane = F.lane, col = lane * 8, hc = col & 127;
    float gg[8], gd[8], lw[8], lb[8];
    { const f32x4 x0 = *(const f32x4*)(a.in[I_GLA_NORM] + l * 128 + hc), x1 = *(const f32x4*)(a.in[I_GLA_NORM] + l * 128 + hc + 4);
      gg[0] = x0.x; gg[1] = x0.y; gg[2] = x0.z; gg[3] = x0.w; gg[4] = x1.x; gg[5] = x1.y; gg[6] = x1.z; gg[7] = x1.w;
      const f32x4 y0 = *(const f32x4*)(a.in[I_GDN_NORM] + l * 128 + hc), y1 = *(const f32x4*)(a.in[I_GDN_NORM] + l * 128 + hc + 4);
      gd[0] = y0.x; gd[1] = y0.y; gd[2] = y0.z; gd[3] = y0.w; gd[4] = y1.x; gd[5] = y1.y; gd[6] = y1.z; gd[7] = y1.w;
      const f32x4 w0 = *(const f32x4*)(a.in[I_RW_LN_W] + l * 512 + col), w1 = *(const f32x4*)(a.in[I_RW_LN_W] + l * 512 + col + 4);
      lw[0] = w0.x; lw[1] = w0.y; lw[2] = w0.z; lw[3] = w0.w; lw[4] = w1.x; lw[5] = w1.y; lw[6] = w1.z; lw[7] = w1.w;
      const f32x4 b0 = *(const f32x4*)(a.in[I_RW_LN_B] + l * 512 + col), b1 = *(const f32x4*)(a.in[I_RW_LN_B] + l * 512 + col + 4);
      lb[0] = b0.x; lb[1] = b0.y; lb[2] = b0.z; lb[3] = b0.w; lb[4] = b1.x; lb[5] = b1.y; lb[6] = b1.z; lb[7] = b1.w; }
    for (int pass = 1; pass < 2; ++pass) {
    if (pass == 1) xcd_barrier(bar);
    for (int q = 0; q < 4; ++q) gla_pb_chunk(a, F, l, blockIdx.x * 4 + q);
    for (int n = F.gw; n < NTOK; n += F.ngw) {
        if (pass == 1) {
            float y[8], bv[8], g[8];
            unpack8(ld8(rwy + (size_t)n * 512 + col), y); unpack8(ld8(rwbv + (size_t)n * 512 + col), bv); unpack8(ld8(ao + (size_t)n * 1792 + 1024 + col), g);
            float s = 0.f;
#pragma unroll
            for (int k = 0; k < 8; ++k) s += y[k];
            const float mean = red8(s) * (1.0f / 64.0f);
            float s2 = 0.f;
#pragma unroll
            for (int k = 0; k < 8; ++k) { y[k] -= mean; s2 += y[k] * y[k]; }
            const float rs = 1.0f / sqrtf(red8(s2) * (1.0f / 64.0f) + 64e-5f);
#pragma unroll
            for (int k = 0; k < 8; ++k) y[k] = (y[k] * rs * lw[k] + lb[k] + bv[k]) * g[k];
            *(v4u*)(mix + (size_t)n * DM + col) = pack8(y);
        }
        if (pass == 1)
#pragma unroll
        for (int which = 1; which < 2; ++which) {
            float o[8], g[8];
            unpack8(ld8((which ? gdno : glao) + (size_t)n * 512 + col), o);
            unpack8(ld8(p16 + (size_t)n * PLD + (which ? C_GDN + 1536 : C_GLA + 1024) + col), g);
            float ss = 0.f;
#pragma unroll
            for (int k = 0; k < 8; ++k) ss += o[k] * o[k];
            ss = row16_sum(ss);
            const float rs = 1.0f / sqrtf(ss * (1.0f / 128.0f) + 1e-6f);
#pragma unroll
            for (int k = 0; k < 8; ++k) o[k] = o[k] * rs * (which ? gd[k] : gg[k]) * (g[k] * sigm(g[k]));
            *(v4u*)(mix + (size_t)n * DM + (which ? 1536 : 512) + col) = pack8(o);
        }
    }
    }
}

__device__ __forceinline__ void norm2_phase(const Args& a, Frame& F, int l) {
    const WsMap m = ws_map(NTOK);
    const float* gain = a.in[I_NORM_FFN] + l * DM;
    f32x4 gv[8];
#pragma unroll
    for (int j = 0; j < 8; ++j) gv[j] = ((const f32x4*)gain)[64 * j + F.lane];
    for (int n = F.gw; n < NTOK; n += F.ngw) {
        const f32x4* xr = (const f32x4*)(a.out + (size_t)n * DM) + F.lane;
        f32x4 v[8]; float s = 0.f;
#pragma unroll
        for (int j = 0; j < 8; ++j) { v[j] = xr[64 * j]; s += (v[j].x * v[j].x + v[j].y * v[j].y) + (v[j].z * v[j].z + v[j].w * v[j].w); }
        const float rstd = 1.0f / sqrtf(wave_sum_u(s) * (1.0f / DM) + 1e-6f);
        v2u* o8 = (v2u*)((bf16_t*)(a.ws + m.hb) + (size_t)n * DM) + F.lane;
#pragma unroll
        for (int j = 0; j < 8; ++j) { v2u w; w.x = pk2(v[j].x * rstd * gv[j].x, v[j].y * rstd * gv[j].y); w.y = pk2(v[j].z * rstd * gv[j].z, v[j].w * rstd * gv[j].w); o8[64 * j] = w; }
    }
}

#define TK_CE(A, B) do { const float mx_ = fmaxf(A, B), mn_ = fminf(A, B); A = mx_; B = mn_; } while (0)
__device__ __forceinline__ void tk_sort16_desc(float (&x)[16]) {
#pragma unroll
    for (int k = 2; k <= 16; k <<= 1)
#pragma unroll
        for (int j = k >> 1; j > 0; j >>= 1)
#pragma unroll
            for (int i = 0; i < 16; ++i) { const int p = i ^ j;
                if (p > i) { if ((i & k) == 0) TK_CE(x[i], x[p]); else TK_CE(x[p], x[i]); } }
}
__device__ __forceinline__ void tk_merge16(float (&run)[16], const float (&g)[16]) {
#pragma unroll
    for (int i = 0; i < 16; ++i) run[i] = fmaxf(run[i], g[15 - i]);
#pragma unroll
    for (int j = 8; j > 0; j >>= 1)
#pragma unroll
        for (int i = 0; i < 16; ++i) { const int p = i ^ j; if (p > i) TK_CE(run[i], run[p]); }
}
__device__ __forceinline__ float tk_tag(float v, unsigned tag, unsigned mask) { return __builtin_bit_cast(float, (__builtin_bit_cast(unsigned, v) & ~mask) | tag); }
__device__ __forceinline__ void topk_phase(const Args& a, Frame& F) {
    const WsMap m = ws_map(NTOK);
    const float* sc = (const float*)(a.ws + m.sc);
    int* idx = (int*)(a.ws + m.idx); float* gate = (float*)(a.ws + m.gate);
    LAS float* LS = (LAS float*)F.lds;
    const int t = F.tid;
    for (int wv = F.gw; wv < (NTOK / 64) * 8; wv += F.ngw) {
        const int h = wv & 7, n = (wv >> 3) * 64 + F.lane;
        const float* sp = sc + (size_t)(h * 256) * NTOK + n;
        float s0[16], s1[16];
#pragma unroll
        for (int half = 0; half < 2; ++half) {
            float run[16];
#pragma unroll
            for (int j = 0; j < 16; ++j) run[j] = -3.0e38f;
#pragma unroll 1
            for (int g = 0; g < 8; ++g) {
                float x[16];
#pragma unroll
                for (int k = 0; k < 16; ++k) x[k] = tk_tag(sp[(size_t)(half * 128 + g * 16 + k) * NTOK], (unsigned)(g * 16 + k), 127u);
                tk_sort16_desc(x);
                tk_merge16(run, x);
            }
#pragma unroll
            for (int j = 0; j < 16; ++j) { if (half) s1[j] = run[j]; else s0[j] = run[j]; LS[(half * 16 + j) * 512 + t] = run[j]; }
        }
        float run[16];
#pragma unroll
        for (int j = 0; j < 16; ++j) run[j] = -3.0e38f;
        {
            float x[16]; int cnt = 0;
#pragma unroll
            for (int p = 0; p < 16; ++p)
#pragma unroll
                for (int q = 0; q < 16; ++q) if ((p + 1) * (q + 1) <= 16) {
                    x[cnt & 15] = tk_tag(s0[p] + s1[q], (unsigned)(p * 16 + q), 255u); ++cnt;
                    if ((cnt & 15) == 0) { tk_sort16_desc(x); tk_merge16(run, x); }
                }
#pragma unroll
            for (int k = 0; k < 16; ++k) if (k >= (cnt & 15)) x[k] = -3.0e38f;
            tk_sort16_desc(x); tk_merge16(run, x);
        }
        const float mx = run[0]; float den = 0.f; float e[16]; int ti[16];
#pragma unroll
        for (int j = 0; j < 16; ++j) {
            const unsigned tg = __builtin_bit_cast(unsigned, run[j]) & 255u; const int p = (int)(tg >> 4), q = (int)(tg & 15u);
            const unsigned k0 = __builtin_bit_cast(unsigned, LS[(0 * 16 + p) * 512 + t]) & 127u, k1 = __builtin_bit_cast(unsigned, LS[(1 * 16 + q) * 512 + t]) & 127u;
            ti[j] = (int)(k0 * 128u + k1);
            e[j] = __expf(run[j] - mx); den += e[j];
        }
        const float inv = 1.0f / den;
        const size_t it = (size_t)n * 8 + h;
        f32x4* go = (f32x4*)(gate + it * 16); v4u* io = (v4u*)(idx + it * 16);
#pragma unroll
        for (int j = 0; j < 4; ++j) { go[j] = (f32x4){e[4 * j] * inv, e[4 * j + 1] * inv, e[4 * j + 2] * inv, e[4 * j + 3] * inv};
            io[j] = (v4u){(unsigned)ti[4 * j], (unsigned)ti[4 * j + 1], (unsigned)ti[4 * j + 2], (unsigned)ti[4 * j + 3]}; }
    }
}

typedef float f32x2_t __attribute__((ext_vector_type(2)));
constexpr int PEER_R = 16;
__device__ __forceinline__ void peer_phase(const Args& a, Frame& F, int l) {
    const WsMap m = ws_map(NTOK);
    const unsigned char* TU = (const unsigned char*)(a.ws + m.tabu) + (size_t)l * 2 * NEXP * TROW;
    const unsigned char* TV = TU + (size_t)NEXP * TROW;
    const float* tsu = (const float*)(a.ws + m.tsc) + (size_t)l * 2 * NEXP; const float* tsv = tsu + NEXP;
    const int* idx = (const int*)(a.ws + m.idx); const float* gate = (const float*)(a.ws + m.gate);
    const int lane = F.lane;
    for (int n = F.gw; n < NTOK; n += F.ngw) {
        f32x2_t xf[16];
        { const v4u* hr = (const v4u*)((const bf16_t*)(a.ws + m.hb) + (size_t)n * DM + lane * 32);
#pragma unroll
          for (int q = 0; q < 4; ++q) { const v4u w = hr[q];
              xf[4 * q + 0] = (f32x2_t){bflo(w.x), bfhi(w.x)}; xf[4 * q + 1] = (f32x2_t){bflo(w.y), bfhi(w.y)}; xf[4 * q + 2] = (f32x2_t){bflo(w.z), bfhi(w.z)}; xf[4 * q + 3] = (f32x2_t){bflo(w.w), bfhi(w.w)}; } }
        const int e0 = idx[(size_t)n * 128 + lane], e1 = idx[(size_t)n * 128 + 64 + lane];
        const float g0 = gate[(size_t)n * 128 + lane] * tsv[e0], g1 = gate[(size_t)n * 128 + 64 + lane] * tsv[e1];
        const float su0 = tsu[e0], su1 = tsu[e1];
        float d0 = 0.f, d1 = 0.f;
#pragma unroll
        for (int half = 0; half < 2; ++half) {
            const int ev = half ? e1 : e0; float dd = 0.f;
            for (int j = 0; j < 64; j += PEER_R) {
                v4u u[PEER_R];
#pragma unroll
                for (int r = 0; r < PEER_R; ++r) { const int e = __builtin_amdgcn_readlane(ev, j + r); u[r] = *(const v4u*)(TU + (size_t)e * TROW + lane * 16); }
#pragma unroll
                for (int r = 0; r < PEER_R; ++r) {
                    f32x2_t a0 = {0.f, 0.f}, a1 = {0.f, 0.f};
#pragma unroll
                    for (int d = 0; d < 4; ++d) {
                        a0 = __builtin_elementwise_fma(__builtin_amdgcn_cvt_scalef32_pk_f32_fp4(u[r][d], 1.0f, 0), xf[4 * d + 0], a0);
                        a1 = __builtin_elementwise_fma(__builtin_amdgcn_cvt_scalef32_pk_f32_fp4(u[r][d], 1.0f, 1), xf[4 * d + 1], a1);
                        a0 = __builtin_elementwise_fma(__builtin_amdgcn_cvt_scalef32_pk_f32_fp4(u[r][d], 1.0f, 2), xf[4 * d + 2], a0);
                        a1 = __builtin_elementwise_fma(__builtin_amdgcn_cvt_scalef32_pk_f32_fp4(u[r][d], 1.0f, 3), xf[4 * d + 3], a1); }
                    a0 += a1;
                    const float t = wave_sum_u(a0.x + a0.y);
                    dd = (lane == j + r) ? t : dd;
                }
            }
            if (half) d1 = dd; else d0 = dd;
        }
        const float c0 = gelu_fast(d0 * su0) * g0, c1 = gelu_fast(d1 * su1) * g1;
        f32x2_t o2[16];
#pragma unroll
        for (int i = 0; i < 16; ++i) o2[i] = (f32x2_t){0.f, 0.f};
#pragma unroll
        for (int half = 0; half < 2; ++half) {
            const int ev = half ? e1 : e0; const float cv = half ? c1 : c0;
            for (int j = 0; j < 64; j += PEER_R) {
                v4u v[PEER_R]; float cj[PEER_R];
#pragma unroll
                for (int r = 0; r < PEER_R; ++r) { const int e = __builtin_amdgcn_readlane(ev, j + r); cj[r] = rdlane_f(cv, j + r); v[r] = *(const v4u*)(TV + (size_t)e * TROW + lane * 16); }
#pragma unroll
                for (int r = 0; r < PEER_R; ++r) { const f32x2_t c2 = {cj[r], cj[r]};
#pragma unroll
                    for (int d = 0; d < 4; ++d) {
                        o2[4 * d + 0] = __builtin_elementwise_fma(__builtin_amdgcn_cvt_scalef32_pk_f32_fp4(v[r][d], 1.0f, 0), c2, o2[4 * d + 0]);
                        o2[4 * d + 1] = __builtin_elementwise_fma(__builtin_amdgcn_cvt_scalef32_pk_f32_fp4(v[r][d], 1.0f, 1), c2, o2[4 * d + 1]);
                        o2[4 * d + 2] = __builtin_elementwise_fma(__builtin_amdgcn_cvt_scalef32_pk_f32_fp4(v[r][d], 1.0f, 2), c2, o2[4 * d + 2]);
                        o2[4 * d + 3] = __builtin_elementwise_fma(__builtin_amdgcn_cvt_scalef32_pk_f32_fp4(v[r][d], 1.0f, 3), c2, o2[4 * d + 3]); }
                }
            }
        }
        float o[32];
#pragma unroll
        for (int i = 0; i < 16; ++i) { o[2 * i] = o2[i].x; o[2 * i + 1] = o2[i].y; }
        float* xrow = a.out + (size_t)n * DM + lane * 32;
        float s = 0.f;
#pragma unroll
        for (int q = 0; q < 8; ++q) { const f32x4 x4 = *(const f32x4*)(xrow + 4 * q);
            o[4 * q] += x4.x; o[4 * q + 1] += x4.y; o[4 * q + 2] += x4.z; o[4 * q + 3] += x4.w;
            s += (o[4 * q] * o[4 * q] + o[4 * q + 1] * o[4 * q + 1]) + (o[4 * q + 2] * o[4 * q + 2] + o[4 * q + 3] * o[4 * q + 3]); }
        const float rstd = 1.0f / sqrtf(wave_sum_u(s) * (1.0f / DM) + 1e-6f);
        if (l + 1 < NL) {
            bf16_t* xo = (bf16_t*)(a.ws + m.xn) + (size_t)n * DM + lane * 32;
#pragma unroll
            for (int q = 0; q < 8; ++q) *(f32x4*)(xrow + 4 * q) = (f32x4){o[4 * q], o[4 * q + 1], o[4 * q + 2], o[4 * q + 3]};
#pragma unroll
            for (int q = 0; q < 4; ++q) { v4u w; w.x = pk2(o[8 * q] * rstd, o[8 * q + 1] * rstd); w.y = pk2(o[8 * q + 2] * rstd, o[8 * q + 3] * rstd); w.z = pk2(o[8 * q + 4] * rstd, o[8 * q + 5] * rstd); w.w = pk2(o[8 * q + 6] * rstd, o[8 * q + 7] * rstd);
                *(v4u*)(xo + 8 * q) = w; }
        } else {
            const float* gf = a.in[I_NORM_FINAL] + lane * 32;
#pragma unroll
            for (int q = 0; q < 8; ++q) { const f32x4 g4 = *(const f32x4*)(gf + 4 * q);
                *(f32x4*)(xrow + 4 * q) = (f32x4){o[4 * q] * rstd * g4.x, o[4 * q + 1] * rstd * g4.y, o[4 * q + 2] * rstd * g4.z, o[4 * q + 3] * rstd * g4.w}; }
        }
    }
}

#define IN(k) (lo <= (k) && (k) < hi)
#define SEAM(k) do { if (IN(k) && IN((k) + 1)) xcd_barrier(bar); } while (0)
template <int l>
__device__ __forceinline__ void layer_phases(const Args& a, Frame& F, const XcdBarrier& bar, const WsMap& m, int lo, int hi) {
    constexpr int pb = l * PH_PER_LAYER;
        if (IN(pb + PH_GEMM1)) {
            pg8::GemmX g{(const bf16_t*)(a.ws + m.xn), (const bf16_t*)(a.ws + m.w1t) + (size_t)l * PLD * DM, NTOK, PLD, DM, DM};
            pg8::StaticOrder S; S.init(NTOK, PLD, F.G, (int)blockIdx.x);
            pg8::EpiBf16 E{(bf16_t*)(a.ws + m.p16), PLD, nullptr};
            pg8::gemm_phase<pg8::EpiBf16, pg8::StaticOrder, true, true>(F.lds, g, S, E);
            SEAM(pb + PH_GEMM1);
        }
        if (IN(pb + PH_PREP)) { prep_phase(a, F, l); SEAM(pb + PH_PREP); }
        if (IN(pb + PH_AUX)) {
            const float* PP = (const float*)(a.ws + m.pp);
            { pg8::GemmX g{(const bf16_t*)(a.ws + m.auxA), (const bf16_t*)(a.ws + m.auxwt) + (size_t)l * 1792 * 384, NTOK, 1792, 384, 384};
              pg8::StaticOrder S; S.init(NTOK, 1792, F.G, (int)blockIdx.x);
              pg8::EpiBf16 E{(bf16_t*)(a.ws + m.auxo), 1792, PP + l * 1792};
              pg8::gemm_phase<pg8::EpiBf16, pg8::StaticOrder, true, true>(F.lds, g, S, E); }
            { pg8::GemmX g{(const bf16_t*)(a.ws + m.xc), (const bf16_t*)(a.ws + m.lruwt) + (size_t)l * 1024 * 512, NTOK, 1024, 512, 512};
              pg8::StaticOrder S; S.init(NTOK, 1024, F.G, (int)blockIdx.x);
              pg8::EpiBf16 E{(bf16_t*)(a.ws + m.gates), 1024, PP + 3584 + l * 1024};
              pg8::gemm_phase<pg8::EpiBf16, pg8::StaticOrder, true, true>(F.lds, g, S, E); }
            if (l > 0) {
              pg8::GemmX g{(const bf16_t*)(a.ws + m.zrkv) + 1024, (const bf16_t*)(a.ws + m.vreswt), NTOK, 512, 512, 1536};
              pg8::StaticOrder S; S.init(NTOK, 512, F.G, (int)blockIdx.x);
              pg8::EpiBf16 E{(bf16_t*)(a.ws + m.vres), 512, PP + 5632};
              pg8::gemm_phase<pg8::EpiBf16, pg8::StaticOrder, true, true>(F.lds, g, S, E); }
            SEAM(pb + PH_AUX);
        }
        if (IN(pb + PH_SCAN)) { scan_phase(a, F, l); SEAM(pb + PH_SCAN); }
        if (IN(pb + PH_POST)) { post_phase(a, F, l, bar); SEAM(pb + PH_POST); }
        if (IN(pb + PH_GEMM2)) {
            pg8::GemmX g{(const bf16_t*)(a.ws + m.mix16), (const bf16_t*)(a.ws + m.w2t) + (size_t)l * DM * DM, NTOK, DM, DM, DM};
            pg8::StaticOrder S; S.init(NTOK, DM, F.G, (int)blockIdx.x);
            pg8::EpiF32<true> E{a.out, DM};
            pg8::gemm_phase<pg8::EpiF32<true>, pg8::StaticOrder, true, true>(F.lds, g, S, E);
            SEAM(pb + PH_GEMM2);
        }
        if (IN(pb + PH_NORM2)) { norm2_phase(a, F, l); SEAM(pb + PH_NORM2); }
        if (IN(pb + PH_GEMM3)) {
            pg8::GemmX g{(const bf16_t*)(a.ws + m.wsct) + (size_t)l * DM * DM, (const bf16_t*)(a.ws + m.hb), DM, NTOK, DM, DM};
            pg8::StaticOrder S; S.init(DM, NTOK, F.G, (int)blockIdx.x);
            pg8::EpiF32<false> E{(float*)(a.ws + m.sc), NTOK};
            pg8::gemm_phase<pg8::EpiF32<false>, pg8::StaticOrder, true, true>(F.lds, g, S, E);
            SEAM(pb + PH_GEMM3);
        }
        if (IN(pb + PH_TOPK)) { topk_phase(a, F); SEAM(pb + PH_TOPK); }
        if (IN(pb + PH_PEER)) { peer_phase(a, F, l); SEAM(pb + PH_PEER); }
}

#undef IN
#undef SEAM
__global__ void __launch_bounds__(NTHR, 2) mega(Args a) {
    extern __shared__ __attribute__((aligned(16))) unsigned char lds_raw[];
    Frame F;
    F.lds = (LAS unsigned char*)lds_raw;
    F.tid = threadIdx.x; F.lane = F.tid & 63; F.wave = __builtin_amdgcn_readfirstlane(F.tid >> 6);
    F.G = gridDim.x; { const int bx = blockIdx.x; F.vcu = (F.G % 8 == 0) ? (bx % 8) * (F.G / 8) + bx / 8 : bx; }
    F.gw = F.vcu * NWAVES + F.wave; F.ngw = F.G * NWAVES;
    volatile LAS unsigned* MISC = (volatile LAS unsigned*)(F.lds + MISC_OFF);
    if (F.tid < 32) MISC[F.tid] = 0u;
    __syncthreads();
    const WsMap m = ws_map(NTOK);
    unsigned* ctl = (unsigned*)(a.ws + m.ctl);
    XcdBarrier bar; bar.bar = ctl + 4096 + a.li * XCD_BAR_WORDS; bar.x = 0; bar.st = nullptr;
    const int lo = a.ph_lo, hi = a.ph_hi;
    if (hi - lo > 1) bar = xcd_barrier_post(ctl + 4096 + a.li * XCD_BAR_WORDS, MISC + 8);
#define IN(k) (lo <= (k) && (k) < hi)
#define SEAM(k) do { if (IN(k) && IN((k) + 1)) xcd_barrier(bar); } while (0)
    if (IN(PH_P0)) { p0_prologue(a, F); tables_range(a, F, 0, (size_t)2 * NEXP * DM / 32, F.vcu, F.G); SEAM(PH_P0); }
    layer_phases<0>(a, F, bar, m, lo, hi);
    layer_phases<1>(a, F, bar, m, lo, hi);
#undef IN
#undef SEAM
}

template <int ST>
__global__ void __launch_bounds__(256) stage_kernel(Params P, int l) {
    const long n = stage_items(P, ST, l);
    for (long it = blockIdx.x * 256L + threadIdx.x; it < n; it += gridDim.x * 256L) run_item(P, ST, l, it);
}
template <int ST>
static void launch_stage(const Params& P, int l, hipStream_t stream) {
    const long n = stage_items(P, ST, l);
    if (n <= 0) return;
    long blocks = (n + 255) / 256;
    if (blocks > 8192) blocks = 8192;
    stage_kernel<ST><<<dim3((unsigned)blocks), dim3(256), 0, stream>>>(P, l);
}
#define LS(X) case X: launch_stage<X>(P, l, stream); break;
static void launch_any(int st, const Params& P, int l, hipStream_t stream) {
    switch (st) {
        LS(ST_COPYX) LS(ST_RSTD) LS(ST_NORM1) LS(ST_GEMM1) LS(ST_RW_A0) LS(ST_RW_A1) LS(ST_RW_A2) LS(ST_RW_A3) LS(ST_RW_KKN)
        LS(ST_RW_SCAN) LS(ST_RW_POST) LS(ST_GLA_B0) LS(ST_GLA_SCAN) LS(ST_GLA_POST) LS(ST_LRU_C0) LS(ST_LRU_C1) LS(ST_LRU_SCAN)
        LS(ST_GDN_D0) LS(ST_GDN_D1) LS(ST_GDN_SCAN) LS(ST_GDN_POST) LS(ST_GEMM2) LS(ST_RSTD2) LS(ST_NORM2) LS(ST_GEMM3)
        LS(ST_SCORES) LS(ST_TOPK1) LS(ST_TOPK2) LS(ST_PEER_U) LS(ST_PEER_V) LS(ST_FRSTD) LS(ST_FNORM)
    }
}

extern "C" void kernel_launch(void* const* d_in, const int* in_sizes, int n_in, void* d_out, int out_size, void* d_ws,
                              size_t ws_size, hipStream_t stream) {
    static int grid = 0;
    if (grid == 0) {
        int dev = 0, cus = 0;
        (void)hipGetDevice(&dev);
        (void)hipDeviceGetAttribute(&cus, hipDeviceAttributeMultiprocessorCount, dev);
        (void)hipFuncSetAttribute((const void*)mega, hipFuncAttributeMaxDynamicSharedMemorySize, LDS_BYTES);
        grid = cus > 0 ? cus : 256;
    }
    Params P;
    memset(&P, 0, sizeof(P));
    fill_inputs(P, d_in);
    P.B = 4; P.T = 4096; P.N = 16384; P.pad = 0;
    P.xcur = (float*)d_out;
    bind_ws(P, (char*)d_ws);
    Args a;
    memset(&a, 0, sizeof(a));
    for (int i = 0; i < 38; ++i) a.in[i] = (const float*)d_in[i];
    a.out = (float*)d_out; a.ws = (unsigned char*)d_ws;
    (void)hipMemsetAsync(d_ws, 0, 1u << 20, stream);
    int li = 0;
    auto run_mega = [&](int lo, int hi) { a.ph_lo = lo; a.ph_hi = hi; a.li = li++; hipLaunchKernelGGL(mega, dim3(grid), dim3(NTHR), LDS_BYTES, stream, a); };
    run_mega(PH_P0, PH_TOTAL);
}
#endif
```

```cpp
#ifndef HOST_EMU
#include <hip/hip_runtime.h>
#include <cstring>
#define HD __host__ __device__ __forceinline__
#else
#include <cmath>
#include <cstdio>
#include <cstdlib>
#include <cstring>
#define HD inline
#endif

constexpr int DM = 2048;
constexpr int NL = 2;
constexpr int INC = 6424;
constexpr int C_RW = 0;
constexpr int C_GLA = 1792;
constexpr int C_LRU = 3344;
constexpr int C_GDN = 4368;
constexpr int NEXP = 16384;

typedef unsigned short bf16_t;
constexpr int PLD = 6656;
HD float bf2f(bf16_t h) { unsigned u = (unsigned)h << 16; float f; memcpy(&f, &u, 4); return f; }
HD bf16_t f2bf(float f) { unsigned u; memcpy(&u, &f, 4); return (bf16_t)((u + 0x7fffu + ((u >> 16) & 1u)) >> 16); }

struct Params {
    const float *x, *norm_mix, *w_in, *w_out, *rw_mu, *rw_w0, *rw_w_up, *rw_a0, *rw_a_up, *rw_g_up, *rw_k_k, *rw_k_a,
        *rw_r_k, *rw_ln_w, *rw_ln_b, *rw_v0, *rw_v_down, *rw_v_up, *gla_a_up, *gla_a_bias, *gla_norm, *lru_conv_w,
        *lru_conv_b, *lru_w_r, *lru_b_r, *lru_w_i, *lru_b_i, *lru_lam, *gdn_conv_w, *gdn_a_log, *gdn_dt_bias, *gdn_norm,
        *norm_ffn, *peer_wq, *peer_sub_keys, *peer_u, *peer_v, *norm_final;
    float* xcur;
    bf16_t* xn;
    bf16_t* hb;
    bf16_t* mix16;
    bf16_t* p16;
    float* sc;
    float* qf;
    float* rstd;
    float* vfirst;
    float* scr;
    float* act;
    float* gate;
    int* idx;
    int B, T, N, pad;
};

HD float sigmoidf_(float x) { return 1.0f / (1.0f + expf(-x)); }
HD float softplusf_(float x) { return log1pf(expf(-fabsf(x))) + fmaxf(x, 0.0f); }
HD float siluf_(float x) { return x * sigmoidf_(x); }
HD float geluf_(float x) { return 0.5f * x * (1.0f + tanhf(0.7978845608028654f * (x + 0.044715f * x * x * x))); }

enum Stage {
    ST_COPYX = 0,
    ST_RSTD, ST_NORM1, ST_GEMM1,
    ST_RW_A0, ST_RW_A1, ST_RW_A2, ST_RW_A3, ST_RW_KKN, ST_RW_SCAN, ST_RW_POST,
    ST_GLA_B0, ST_GLA_SCAN, ST_GLA_POST,
    ST_LRU_C0, ST_LRU_C1, ST_LRU_SCAN,
    ST_GDN_D0, ST_GDN_D1, ST_GDN_SCAN, ST_GDN_POST,
    ST_GEMM2, ST_RSTD2, ST_NORM2, ST_GEMM3, ST_SCORES, ST_TOPK1, ST_TOPK2, ST_PEER_U, ST_PEER_V,
    ST_FRSTD, ST_FNORM,
    ST_COUNT
};

constexpr long SO_ZS = 0, SO_R = 256, SO_DEC = 768, SO_KM = 1280, SO_KK = 1792, SO_A = 2304, SO_G = 2816, SO_V = 3328,
               SO_Y = 3840, SO_VD = 4352, SO_KKINV = 4384;
constexpr long SO_ALPHA = 0, SO_GO = 256;
constexpr long SO_XC = 0, SO_LA = 512, SO_LU = 1024;
constexpr long SO_QKV = 0, SO_GS = 1536, SO_DO = 1552;
constexpr long SCR_PER_TOK = 4400;
constexpr long SO_TS = 0, SO_TI = 256;

HD long stage_items(const Params& P, int st, int l) {
    const long N = P.N;
    switch (st) {
        case ST_COPYX: return N * DM;
        case ST_RSTD: case ST_RSTD2: case ST_FRSTD: return N;
        case ST_NORM1: case ST_NORM2: case ST_FNORM: return N * DM;
        case ST_GEMM1: return (N / 4) * (INC / 4);
        case ST_RW_A0: return N * 256;
        case ST_RW_A1: return N * 512;
        case ST_RW_A2: return l > 0 ? N * 32 : 0;
        case ST_RW_A3: return l > 0 ? N * 512 : 0;
        case ST_RW_KKN: return N * 8;
        case ST_RW_SCAN: return (long)P.B * 512;
        case ST_RW_POST: return N * 8;
        case ST_GLA_B0: return N * 256;
        case ST_GLA_SCAN: return (long)P.B * 512;
        case ST_GLA_POST: return N * 4;
        case ST_LRU_C0: return N * 512;
        case ST_LRU_C1: return N * 512;
        case ST_LRU_SCAN: return (long)P.B * 512;
        case ST_GDN_D0: return N * 1536;
        case ST_GDN_D1: return N * 4;
        case ST_GDN_SCAN: return (long)P.B * 512;
        case ST_GDN_POST: return N * 4;
        case ST_GEMM2: case ST_GEMM3: return (N / 4) * (DM / 4);
        case ST_SCORES: return N * 2048;
        case ST_TOPK1: return N * 16;
        case ST_TOPK2: return N * 8;
        case ST_PEER_U: return N * 128;
        case ST_PEER_V: return N * DM;
    }
    return 0;
}

HD void gemm_item(const bf16_t* A, const float* W, int ldw, const float* kscale, float* Cf, bf16_t* Ch, int ldc, int n4, long item, int mode) {
    const long r4 = item / n4;
    const int c4 = (int)(item % n4);
    const bf16_t* a0 = A + (r4 * 4) * (long)DM;
    const float* w = W + c4 * 4;
    float acc[4][4];
    for (int i = 0; i < 4; ++i)
        for (int j = 0; j < 4; ++j) acc[i][j] = 0.f;
    for (int k = 0; k < DM; ++k) {
        const float ks = kscale ? kscale[k] : 1.0f;
        const float w0 = w[(long)k * ldw + 0] * ks, w1 = w[(long)k * ldw + 1] * ks, w2 = w[(long)k * ldw + 2] * ks, w3 = w[(long)k * ldw + 3] * ks;
#pragma unroll
        for (int i = 0; i < 4; ++i) {
            const float a = bf2f(a0[(long)i * DM + k]);
            acc[i][0] += a * w0; acc[i][1] += a * w1; acc[i][2] += a * w2; acc[i][3] += a * w3;
        }
    }
#pragma unroll
    for (int i = 0; i < 4; ++i) {
        const long o = (r4 * 4 + i) * (long)ldc + c4 * 4;
#pragma unroll
        for (int j = 0; j < 4; ++j) {
            if (mode == 0) Ch[o + j] = f2bf(acc[i][j]);
            else if (mode == 1) Cf[o + j] += acc[i][j];
            else Cf[o + j] = acc[i][j];
        }
    }
}

#define PF(n, col) bf2f(P.p16[(long)(n) * PLD + (col)])
HD float rw_shift(const Params& P, int l, long n, int col) {
    const int t = (int)(n % P.T);
    const float cur = PF(n, C_RW + col);
    const float prev = t > 0 ? PF(n - 1, C_RW + col) : 0.f;
    return cur + (prev - cur) * P.rw_mu[l * 1792 + col];
}

HD void run_item(const Params& P, int st, int l, long it) {
    const long N = P.N;
    float* scr = P.scr;
    switch (st) {
        case ST_COPYX: P.xcur[it] = P.x[it]; break;
        case ST_RSTD: case ST_RSTD2: case ST_FRSTD: {
            const float* xr = P.xcur + it * DM;
            float s = 0.f;
            for (int d = 0; d < DM; ++d) s += xr[d] * xr[d];
            P.rstd[it] = 1.0f / sqrtf(s * (1.0f / DM) + 1e-6f);
        } break;
        case ST_NORM1: case ST_NORM2: case ST_FNORM: {
            const long n = it / DM; const int d = (int)(it % DM);
            if (st == ST_NORM1) P.xn[it] = f2bf(P.xcur[it] * P.rstd[n]);
            else if (st == ST_NORM2) P.hb[it] = f2bf(P.xcur[it] * P.rstd[n] * P.norm_ffn[l * DM + d]);
            else P.xcur[it] = P.xcur[it] * P.rstd[n] * P.norm_final[d];
        } break;
        case ST_GEMM1: gemm_item(P.xn, P.w_in + (long)l * DM * INC, INC, P.norm_mix + l * DM, nullptr, P.p16, PLD, INC / 4, it, 0); break;
        case ST_GEMM2: gemm_item(P.mix16, P.w_out + (long)l * DM * DM, DM, nullptr, P.xcur, nullptr, DM, DM / 4, it, 1); break;
        case ST_GEMM3: gemm_item(P.hb, P.peer_wq + (long)l * DM * DM, DM, nullptr, P.qf, nullptr, DM, DM / 4, it, 2); break;
        case ST_RW_A0: {
            const long n = it / 256; const int c = (int)(it % 256);
            const float z = rw_shift(P, l, n, 1536 + c);
            scr[N * SO_ZS + it] = c < 64 ? tanhf(z) : (c < 128 ? z : sigmoidf_(z));
        } break;
        case ST_RW_A1: {
            const long n = it / 512; const int j = (int)(it % 512);
            const float zr = rw_shift(P, l, n, j), zk = rw_shift(P, l, n, 512 + j), zv = rw_shift(P, l, n, 1024 + j);
            const float* zs = scr + N * SO_ZS + n * 256;
            float aw = P.rw_w0[l * 512 + j], aa = P.rw_a0[l * 512 + j], ag = 0.f;
            const float* wu = P.rw_w_up + (long)l * 64 * 512 + j;
            const float* au = P.rw_a_up + (long)l * 64 * 512 + j;
            const float* gu = P.rw_g_up + (long)l * 128 * 512 + j;
            for (int i = 0; i < 64; ++i) { aw += zs[i] * wu[i * 512]; aa += zs[64 + i] * au[i * 512]; }
            for (int i = 0; i < 128; ++i) ag += zs[128 + i] * gu[i * 512];
            const float w_raw = -softplusf_(-aw) - 0.5f;
            const float a = sigmoidf_(aa);
            scr[N * SO_R + it] = zr;
            scr[N * SO_DEC + it] = expf(-expf(w_raw));
            scr[N * SO_KM + it] = zk * (1.0f + (a - 1.0f) * P.rw_k_a[l * 512 + j]);
            scr[N * SO_KK + it] = zk * P.rw_k_k[l * 512 + j];
            scr[N * SO_A + it] = a;
            scr[N * SO_G + it] = ag;
            scr[N * SO_V + it] = zv;
            if (l == 0) P.vfirst[it] = zv;
        } break;
        case ST_RW_A2: {
            const long n = it / 32; const int i = (int)(it % 32);
            const float* v = scr + N * SO_V + n * 512;
            const float* vdn = P.rw_v_down + (long)(l - 1) * 512 * 32 + i;
            float s = 0.f;
            for (int j = 0; j < 512; ++j) s += v[j] * vdn[j * 32];
            scr[N * SO_VD + it] = s;
        } break;
        case ST_RW_A3: {
            const long n = it / 512; const int j = (int)(it % 512);
            const float* vd = scr + N * SO_VD + n * 32;
            const float* vup = P.rw_v_up + (long)(l - 1) * 32 * 512 + j;
            float s = P.rw_v0[(l - 1) * 512 + j];
            for (int i = 0; i < 32; ++i) s += vd[i] * vup[i * 512];
            const float v = scr[N * SO_V + it];
            scr[N * SO_V + it] = v + (P.vfirst[it] - v) * sigmoidf_(s);
        } break;
        case ST_RW_KKN: {
            const float* kk = scr + N * SO_KK + it * 64;
            float s = 0.f;
            for (int i = 0; i < 64; ++i) s += kk[i] * kk[i];
            scr[N * SO_KKINV + it] = 1.0f / sqrtf(fmaxf(s, 1e-24f));
        } break;
        case ST_RW_SCAN: {
            const int b = (int)(it / 512); const int h = (int)((it % 512) / 64); const int v = (int)(it % 64);
            float S[64];
#pragma unroll
            for (int i = 0; i < 64; ++i) S[i] = 0.f;
            for (int t = 0; t < P.T; ++t) {
                const long n = (long)b * P.T + t;
                const long base = n * 512 + h * 64;
                const float inv = scr[N * SO_KKINV + n * 8 + h];
                const float vv = scr[N * SO_V + base + v];
                const float* KK = scr + N * SO_KK + base;
                const float* DEC = scr + N * SO_DEC + base;
                const float* KM = scr + N * SO_KM + base;
                const float* AA = scr + N * SO_A + base;
                const float* RR = scr + N * SO_R + base;
                float sa = 0.f;
#pragma unroll
                for (int i = 0; i < 64; ++i) sa += S[i] * (-KK[i] * inv);
                float y = 0.f;
#pragma unroll
                for (int i = 0; i < 64; ++i) {
                    const float kk = KK[i] * inv;
                    S[i] = S[i] * DEC[i] + sa * (kk * AA[i]) + vv * KM[i];
                    y += S[i] * RR[i];
                }
                scr[N * SO_Y + base + v] = y;
            }
        } break;
        case ST_RW_POST: {
            const long n = it / 8; const int h = (int)(it % 8);
            const long base = n * 512 + h * 64;
            const float* Y = scr + N * SO_Y + base;
            const float* RR = scr + N * SO_R + base;
            const float* KM = scr + N * SO_KM + base;
            const float* V = scr + N * SO_V + base;
            const float* G = scr + N * SO_G + base;
            float mean = 0.f, bon = 0.f;
            for (int i = 0; i < 64; ++i) { mean += Y[i]; bon += RR[i] * KM[i] * P.rw_r_k[l * 512 + h * 64 + i]; }
            mean *= (1.0f / 64);
            float var = 0.f;
            for (int i = 0; i < 64; ++i) { const float d = Y[i] - mean; var += d * d; }
            const float rs = 1.0f / sqrtf(var * (1.0f / 64) + 64e-5f);
            for (int i = 0; i < 64; ++i) {
                const int c = h * 64 + i;
                const float yn = (Y[i] - mean) * rs * P.rw_ln_w[l * 512 + c] + P.rw_ln_b[l * 512 + c];
                P.mix16[n * DM + c] = f2bf((yn + bon * V[i]) * G[i]);
            }
        } break;
        case ST_GLA_B0: {
            const long n = it / 256; const int c = (int)(it % 256);
            float s = P.gla_a_bias[l * 256 + c];
            for (int i = 0; i < 16; ++i) s += PF(n, C_GLA + 1536 + i) * P.gla_a_up[(long)l * 16 * 256 + i * 256 + c];
            scr[N * SO_ALPHA + it] = expf(-softplusf_(-s) * (1.0f / 16.0f));
        } break;
        case ST_GLA_SCAN: {
            const int b = (int)(it / 512); const int h = (int)((it % 512) / 128); const int v = (int)(it % 128);
            float S[64];
#pragma unroll
            for (int i = 0; i < 64; ++i) S[i] = 0.f;
            for (int t = 0; t < P.T; ++t) {
                const long n = (long)b * P.T + t;
                const bf16_t* q = P.p16 + n * PLD + C_GLA + h * 64;
                const bf16_t* k = q + 256;
                const float vv = PF(n, C_GLA + 512 + h * 128 + v);
                const float* al = scr + N * SO_ALPHA + n * 256 + h * 64;
                float o = 0.f;
#pragma unroll
                for (int i = 0; i < 64; ++i) {
                    S[i] = S[i] * al[i] + bf2f(k[i]) * vv;
                    o += bf2f(q[i]) * S[i];
                }
                scr[N * SO_GO + n * 512 + h * 128 + v] = o * 0.125f;
            }
        } break;
        case ST_GLA_POST: {
            const long n = it / 4; const int h = (int)(it % 4);
            const float* o = scr + N * SO_GO + n * 512 + h * 128;
            float ms = 0.f;
            for (int i = 0; i < 128; ++i) ms += o[i] * o[i];
            const float rs = 1.0f / sqrtf(ms * (1.0f / 128) + 1e-6f);
            for (int i = 0; i < 128; ++i) {
                const float g = PF(n, C_GLA + 1024 + h * 128 + i);
                P.mix16[n * DM + 512 + h * 128 + i] = f2bf(o[i] * rs * P.gla_norm[l * 128 + i] * siluf_(g));
            }
        } break;
        case ST_LRU_C0: {
            const long n = it / 512; const int c = (int)(it % 512);
            const int t = (int)(n % P.T);
            float s = P.lru_conv_b[l * 512 + c];
            for (int j = 0; j < 4; ++j) {
                const int tt = t - 3 + j;
                if (tt >= 0) s += P.lru_conv_w[(long)l * 4 * 512 + j * 512 + c] * PF(n - 3 + j, C_LRU + c);
            }
            scr[N * SO_XC + it] = s;
        } break;
        case ST_LRU_C1: {
            const long n = it / 512; const int c = (int)(it % 512);
            const int blk = c / 64, j = c % 64;
            const float* xc = scr + N * SO_XC + n * 512 + blk * 64;
            const float* wr = P.lru_w_r + (long)l * 8 * 64 * 64 + (long)blk * 64 * 64 + j;
            const float* wi = P.lru_w_i + (long)l * 8 * 64 * 64 + (long)blk * 64 * 64 + j;
            float sr = P.lru_b_r[l * 512 + c], si = P.lru_b_i[l * 512 + c];
            for (int i = 0; i < 64; ++i) { sr += xc[i] * wr[i * 64]; si += xc[i] * wi[i * 64]; }
            const float r = sigmoidf_(sr), ig = sigmoidf_(si);
            const float log_a = -8.0f * r * softplusf_(-P.lru_lam[l * 512 + c]);
            scr[N * SO_LA + it] = expf(log_a);
            scr[N * SO_LU + it] = scr[N * SO_XC + it] * ig * sqrtf(-expm1f(2.0f * log_a));
        } break;
        case ST_LRU_SCAN: {
            const int b = (int)(it / 512); const int c = (int)(it % 512);
            float hst = 0.f;
            for (int t = 0; t < P.T; ++t) {
                const long n = (long)b * P.T + t;
                hst = scr[N * SO_LA + n * 512 + c] * hst + scr[N * SO_LU + n * 512 + c];
                P.mix16[n * DM + 1024 + c] = f2bf(hst * geluf_(PF(n, C_LRU + 512 + c)));
            }
        } break;
        case ST_GDN_D0: {
            const long n = it / 1536; const int c = (int)(it % 1536);
            const int t = (int)(n % P.T);
            float s = 0.f;
            for (int j = 0; j < 4; ++j) {
                const int tt = t - 3 + j;
                if (tt >= 0) s += P.gdn_conv_w[(long)l * 4 * 1536 + j * 1536 + c] * PF(n - 3 + j, C_GDN + c);
            }
            scr[N * SO_QKV + it] = siluf_(s);
        } break;
        case ST_GDN_D1: {
            const long n = it / 4; const int h = (int)(it % 4);
            const float* q = scr + N * SO_QKV + n * 1536 + h * 128;
            const float* k = q + 512;
            float qs = 0.f, ks = 0.f;
            for (int i = 0; i < 128; ++i) { qs += q[i] * q[i]; ks += k[i] * k[i]; }
            float* gs = scr + N * SO_GS + n * 16 + h * 4;
            gs[0] = (1.0f / sqrtf(qs + 1e-6f)) * 0.08838834764831845f;
            gs[1] = 1.0f / sqrtf(ks + 1e-6f);
            gs[2] = sigmoidf_(PF(n, C_GDN + 2048 + h));
            gs[3] = expf(-expf(P.gdn_a_log[l * 4 + h]) * softplusf_(PF(n, C_GDN + 2052 + h) + P.gdn_dt_bias[l * 4 + h]));
        } break;
        case ST_GDN_SCAN: {
            const int b = (int)(it / 512); const int h = (int)((it % 512) / 128); const int v = (int)(it % 128);
            float S[128];
#pragma unroll
            for (int i = 0; i < 128; ++i) S[i] = 0.f;
            for (int t = 0; t < P.T; ++t) {
                const long n = (long)b * P.T + t;
                const float* q = scr + N * SO_QKV + n * 1536 + h * 128;
                const float* k = q + 512;
                const float vv = scr[N * SO_QKV + n * 1536 + 1024 + h * 128 + v];
                const float* gs = scr + N * SO_GS + n * 16 + h * 4;
                const float qinv = gs[0], kinv = gs[1], beta = gs[2], eg = gs[3];
                float dk = 0.f;
#pragma unroll
                for (int i = 0; i < 128; ++i) dk += S[i] * k[i];
                const float u = beta * (vv - eg * kinv * dk) * kinv;
                float o = 0.f;
#pragma unroll
                for (int i = 0; i < 128; ++i) {
                    S[i] = S[i] * eg + u * k[i];
                    o += S[i] * q[i];
                }
                scr[N * SO_DO + n * 512 + h * 128 + v] = o * qinv;
            }
        } break;
        case ST_GDN_POST: {
            const long n = it / 4; const int h = (int)(it % 4);
            const float* o = scr + N * SO_DO + n * 512 + h * 128;
            float ms = 0.f;
            for (int i = 0; i < 128; ++i) ms += o[i] * o[i];
            const float rs = 1.0f / sqrtf(ms * (1.0f / 128) + 1e-6f);
            for (int i = 0; i < 128; ++i) {
                const float z = PF(n, C_GDN + 1536 + h * 128 + i);
                P.mix16[n * DM + 1536 + h * 128 + i] = f2bf(o[i] * rs * P.gdn_norm[l * 128 + i] * siluf_(z));
            }
        } break;
        case ST_SCORES: {
            const long n = it / 2048; const int c = (int)(it % 2048);
            const int hp = c / 128, key = c % 128;
            const float* q = P.qf + n * DM + hp * 128;
            const float* sk = P.peer_sub_keys + (long)l * 16 * 128 * 128 + ((long)hp * 128 + key) * 128;
            float s = 0.f;
            for (int d = 0; d < 128; ++d) s += q[d] * sk[d];
            P.sc[it] = s;
        } break;
        case ST_TOPK1: {
            const float* sc = P.sc + it * 128;
            float ts[16]; int ti[16];
#pragma unroll
            for (int j = 0; j < 16; ++j) { ts[j] = -3.0e38f; ti[j] = 0; }
            for (int i = 0; i < 128; ++i) {
                float xv = sc[i]; int xi = i;
                if (xv > ts[15]) {
#pragma unroll
                    for (int j = 0; j < 16; ++j) {
                        if (xv > ts[j]) { const float tv = ts[j]; const int tj = ti[j]; ts[j] = xv; ti[j] = xi; xv = tv; xi = tj; }
                    }
                }
            }
            float* TS = scr + N * SO_TS + it * 16;
            int* TI = (int*)(scr + N * SO_TI) + it * 16;
#pragma unroll
            for (int j = 0; j < 16; ++j) { TS[j] = ts[j]; TI[j] = ti[j]; }
        } break;
        case ST_TOPK2: {
            const float* s0 = scr + N * SO_TS + it * 32;
            const float* s1 = s0 + 16;
            const int* i0 = (const int*)(scr + N * SO_TI) + it * 32;
            const int* i1 = i0 + 16;
            float ts[16]; int ti[16];
#pragma unroll
            for (int j = 0; j < 16; ++j) { ts[j] = -3.0e38f; ti[j] = 0; }
            for (int a = 0; a < 16; ++a) {
                const int jmax = 16 / (a + 1);
                for (int b = 0; b < jmax; ++b) {
                    float xv = s0[a] + s1[b]; int xi = i0[a] * 128 + i1[b];
                    if (xv > ts[15]) {
#pragma unroll
                        for (int j = 0; j < 16; ++j) {
                            if (xv > ts[j]) { const float tv = ts[j]; const int tj = ti[j]; ts[j] = xv; ti[j] = xi; xv = tv; xi = tj; }
                        }
                    }
                }
            }
            const float mx = ts[0];
            float den = 0.f;
#pragma unroll
            for (int j = 0; j < 16; ++j) { ts[j] = expf(ts[j] - mx); den += ts[j]; }
            const float inv = 1.0f / den;
#pragma unroll
            for (int j = 0; j < 16; ++j) { P.gate[it * 16 + j] = ts[j] * inv; P.idx[it * 16 + j] = ti[j]; }
        } break;
        case ST_PEER_U: {
            const long n = it / 128;
            const int e = P.idx[it];
            const float* u = P.peer_u + ((long)l * NEXP + e) * DM;
            const bf16_t* hx = P.hb + n * DM;
            float s = 0.f;
            for (int d = 0; d < DM; ++d) s += bf2f(hx[d]) * u[d];
            P.act[it] = geluf_(s) * P.gate[it];
        } break;
        case ST_PEER_V: {
            const long n = it / DM; const int d = (int)(it % DM);
            const float* a = P.act + n * 128;
            const int* ix = P.idx + n * 128;
            float s = 0.f;
            for (int j = 0; j < 128; ++j) s += a[j] * P.peer_v[((long)l * NEXP + ix[j]) * DM + d];
            P.xcur[it] += s;
        } break;
    }
}


struct WsMap {
    size_t ctl, w1t, w2t, wsct, auxwt, lruwt, vreswt, pp, tabu, tabv, tsc, ssq, dpart, xn, hb, mix16, p16, sc, aux, vfirst, idx, gate, rstd, act, end;
    size_t auxA, zrkv, xc, auxo, gates, vres, glao, gdno, gq, gk, gv, gsc, rwy, rwbv, lrs, gblob, glas, gladv;
    size_t scr, qf;
};
HD WsMap ws_map(size_t N) {
    WsMap m{};
    size_t o = 0;
    auto take = [&](size_t bytes) { size_t r = o; o += (bytes + 4095) & ~(size_t)4095; return r; };
    m.ctl = take(1u << 20);
    m.w1t = take((size_t)NL * PLD * DM * 2);
    m.w2t = take((size_t)NL * DM * DM * 2);
    m.wsct = take((size_t)NL * DM * DM * 2);
    m.auxwt = take((size_t)NL * 1792 * 384 * 2);
    m.lruwt = take((size_t)NL * 1024 * 512 * 2);
    m.vreswt = take((size_t)512 * 512 * 2);
    m.pp = take(1u << 20);
    m.xn = take(N * DM * 2);
    m.hb = take(N * DM * 2);
    m.mix16 = take(N * DM * 2);
    m.p16 = take(N * PLD * 2);
    m.sc = m.p16;
    m.vfirst = take(N * 512 * 4);
    m.idx = take(N * 128 * 4);
    m.gate = take(N * 128 * 4);
    m.act = take(N * 128 * 4);
    m.rstd = take(N * 4);
    m.tabu = take((size_t)NL * 2 * NEXP * 1024);
    m.tabv = m.tabu + (size_t)NEXP * 1024;
    m.ssq = take(N * 8 * 4);
    m.dpart = m.p16;
    m.tsc = take((size_t)NL * 2 * NEXP * 4);
    m.aux = take(N * 5888 * 4);
    m.end = o;
    size_t a = m.aux;
    auto sub = [&](size_t bytes) { size_t r = a; a += (bytes + 4095) & ~(size_t)4095; return r; };
    m.auxA = sub(N * 384 * 2); m.zrkv = sub(N * 1536 * 2); m.xc = sub(N * 512 * 2); m.auxo = sub(N * 1792 * 2);
    m.gates = sub(N * 1024 * 2); m.vres = sub(N * 512 * 2); m.glao = sub(N * 512 * 2); m.gdno = sub(N * 512 * 2);
    m.gq = sub(N * 512 * 2); m.gk = sub(N * 512 * 2); m.gv = sub(N * 512 * 2); m.gsc = sub(N * 8 * 4); m.rwy = sub(N * 512 * 2); m.rwbv = sub(N * 512 * 2); m.lrs = sub(N / 64 * 512 * 2 * 4);
    m.gblob = sub(N / 64 * 4 * 26880);
    m.glas = sub(N / 64 * 4 * 8192 * 2); m.gladv = sub(N / 64 * 4 * 64 * 4);
    m.scr = m.tabu;
    m.qf = m.aux + N * 3584 * 4;
    return m;
}
static inline void bind_ws(Params& P, char* ws) {
    const WsMap m = ws_map((size_t)P.N);
    P.xn = (bf16_t*)(ws + m.xn); P.hb = (bf16_t*)(ws + m.hb); P.mix16 = (bf16_t*)(ws + m.mix16); P.p16 = (bf16_t*)(ws + m.p16);
    P.sc = (float*)(ws + m.sc); P.qf = (float*)(ws + m.qf); P.rstd = (float*)(ws + m.rstd); P.vfirst = (float*)(ws + m.vfirst);
    P.scr = (float*)(ws + m.scr); P.act = (float*)(ws + m.act); P.gate = (float*)(ws + m.gate); P.idx = (int*)(ws + m.idx);
}

struct Step { int st, l; };
static inline int build_schedule(Step* s) {
    int n = 0;
    s[n++] = {ST_COPYX, 0};
    for (int l = 0; l < NL; ++l) {
        static const int per_layer[] = {ST_RSTD, ST_NORM1, ST_GEMM1,
            ST_RW_A0, ST_RW_A1, ST_RW_A2, ST_RW_A3, ST_RW_KKN, ST_RW_SCAN, ST_RW_POST,
            ST_GLA_B0, ST_GLA_SCAN, ST_GLA_POST, ST_LRU_C0, ST_LRU_C1, ST_LRU_SCAN,
            ST_GDN_D0, ST_GDN_D1, ST_GDN_SCAN, ST_GDN_POST,
            ST_GEMM2, ST_RSTD2, ST_NORM2, ST_GEMM3, ST_SCORES, ST_TOPK1, ST_TOPK2, ST_PEER_U, ST_PEER_V};
        for (int i = 0; i < (int)(sizeof(per_layer) / sizeof(int)); ++i) s[n++] = {per_layer[i], l};
    }
    s[n++] = {ST_FRSTD, 0};
    s[n++] = {ST_FNORM, 0};
    return n;
}

static inline void fill_inputs(Params& P, void* const* d_in) {
    const float** dst = (const float**)&P;
    for (int i = 0; i < 38; ++i) dst[i] = (const float*)d_in[i];
}

#ifndef HOST_EMU
#define GAS __attribute__((address_space(1)))
#define LAS __attribute__((address_space(3)))
typedef unsigned v4u __attribute__((ext_vector_type(4)));
typedef unsigned v2u __attribute__((ext_vector_type(2)));
typedef float f32x4 __attribute__((ext_vector_type(4)));
typedef float f32x2 __attribute__((ext_vector_type(2)));
typedef short bf16x8 __attribute__((ext_vector_type(8)));
constexpr int NWAVES = 8, NTHR = 512;
constexpr int RING_BYTES = 131072, MISC_OFF = RING_BYTES + 320, LDS_BYTES = 147456;
constexpr int NTOK = 16384, TSEQ = 4096, NBATCH = 4;

__device__ __forceinline__ unsigned pk2(float lo, float hi) { return (unsigned)f2bf(lo) | ((unsigned)f2bf(hi) << 16); }
__device__ __forceinline__ float bflo(unsigned u) { return __builtin_bit_cast(float, u << 16); }
__device__ __forceinline__ float bfhi(unsigned u) { return __builtin_bit_cast(float, u & 0xffff0000u); }
__device__ __forceinline__ float wave_sum(float v) {
#pragma unroll
    for (int o = 1; o < 64; o <<= 1) v += __shfl_xor(v, o);
    return v;
}
#define LDS_WAIT() asm volatile("s_waitcnt lgkmcnt(0)" ::: "memory")
#define VM_WAIT() asm volatile("s_waitcnt vmcnt(0)" ::: "memory")

namespace pg8 {
#define PG8_LAS __attribute__((address_space(3)))
constexpr int BM = 256, BK = 64, HALF = 128, HTB = HALF * BK * 2, STAGE_BYTES = 8 * HTB, NXCD = 8, WGM = 8;
__host__ __device__ __forceinline__ int lds_byte(int r, int c) { const int st = (r >> 4) * 2 + (c >> 5), rr = r & 15, cc = c & 31, ob = rr * 64 + cc * 2; return st * 1024 + (ob ^ (((ob >> 9) & 1) << 5)); }
__host__ __device__ __forceinline__ void stage_rc(int b, int& R, int& C) { const int st = b / 1024, sb = b % 1024, swz = sb ^ (((sb >> 9) & 1) << 5); R = (st >> 1) * 16 + swz / 64; C = (st & 1) * 32 + (swz % 64) / 2; }
__host__ __device__ __forceinline__ int perm32(int rho) { const int n = rho >> 4, i = rho & 15; return 8 * (i >> 2) + 4 * n + (i & 3); }
struct Unit { int pm, pn; };
struct GemmX { const bf16_t* A; const bf16_t* Bt; int M, N, K, lda; };
struct StaticOrder {
    int nM, nN, nwg, G, c;
    __host__ __device__ void init(int M, int N, int G_, int c_) { nM = M / BM; nN = N / BM; nwg = nM * nN; G = G_; c = c_; }
    __host__ __device__ bool next(int i, Unit& u) const {
        const long L = (long)i * G + c; if (L >= nwg) return false;
        int wgid = (int)L; { const int q = nwg / NXCD, r = nwg % NXCD, xcd = wgid % NXCD, off = wgid / NXCD; wgid = (xcd < r ? xcd * (q + 1) : r * (q + 1) + (xcd - r) * q) + off; }
        const int nig = WGM * nN, gid = wgid / nig, fm = gid * WGM, gsz = (nM - fm) < WGM ? (nM - fm) : WGM;
        u.pm = fm + ((wgid % nig) % gsz); u.pn = (wgid % nig) / gsz; return true;
    }
    __device__ __forceinline__ void a_ready(const Unit&) const {}
    __device__ __forceinline__ void done(const Unit&) const {}
};
__device__ __forceinline__ unsigned cvt_pk_bf16(float lo, float hi) { unsigned r; asm volatile("v_cvt_pk_bf16_f32 %0, %1, %2" : "=v"(r) : "v"(lo), "v"(hi)); return r; }
template <bool ACCUM> struct EpiF32 {
    static constexpr bool PERM = false, AFTER_DRAIN = false;
    float* C; int ldc;
    __device__ __forceinline__ void operator()(const f32x4 (&acc)[2][2][4][2], const Unit& u, int wr, int wc, int fr, int fq) const {
        const int row0 = u.pm * BM + wr * 64 + fr, col0 = u.pn * BM + wc * 32 + 4 * fq;
#pragma unroll
        for (int ai = 0; ai < 2; ++ai)
#pragma unroll
            for (int m = 0; m < 4; ++m) { float* rowp = C + (size_t)(row0 + ai * HALF + m * 16) * ldc + col0;
#pragma unroll
                for (int bj = 0; bj < 2; ++bj)
#pragma unroll
                    for (int n = 0; n < 2; ++n) { f32x4* p = (f32x4*)(rowp + bj * HALF + n * 16);
                        if (ACCUM) *p = *p + acc[ai][bj][m][n]; else *p = acc[ai][bj][m][n]; } }
    }
};
struct EpiBf16 {
    static constexpr bool PERM = true, AFTER_DRAIN = false;
    bf16_t* O; int ldc; const float* bias; const float* ssq = nullptr;
    __device__ __forceinline__ void operator()(const f32x4 (&acc)[2][2][4][2], const Unit& u, int wr, int wc, int fr, int fq) const {
        const int row0 = u.pm * BM + wr * 64 + fr; const int col0 = u.pn * BM + wc * 32 + 8 * fq;
        float rs[2][4];
#pragma unroll
        for (int ai = 0; ai < 2; ++ai)
#pragma unroll
            for (int m = 0; m < 4; ++m) { rs[ai][m] = 1.0f;
                if (ssq) { const f32x4* sp = (const f32x4*)(ssq + (size_t)(row0 + ai * HALF + m * 16) * 8); const f32x4 s0 = sp[0], s1 = sp[1];
                    rs[ai][m] = 1.0f / sqrtf((((s0.x + s0.y) + (s0.z + s0.w)) + ((s1.x + s1.y) + (s1.z + s1.w))) * (1.0f / 2048.0f) + 1e-6f); } }
        f32x4 bv[2][2];
#pragma unroll
        for (int bj = 0; bj < 2; ++bj)
#pragma unroll
            for (int n = 0; n < 2; ++n) bv[bj][n] = bias ? *(const f32x4*)(bias + col0 + bj * HALF + 4 * n) : (f32x4){0.f, 0.f, 0.f, 0.f};
#pragma unroll
        for (int ai = 0; ai < 2; ++ai)
#pragma unroll
            for (int m = 0; m < 4; ++m) { bf16_t* rowp = O + (size_t)(row0 + ai * HALF + m * 16) * ldc + col0;
#pragma unroll
                for (int bj = 0; bj < 2; ++bj) { const f32x4 v0 = acc[ai][bj][m][0] * rs[ai][m] + bv[bj][0], v1 = acc[ai][bj][m][1] * rs[ai][m] + bv[bj][1];
                    v4u w; w.x = cvt_pk_bf16(v0[0], v0[1]); w.y = cvt_pk_bf16(v0[2], v0[3]); w.z = cvt_pk_bf16(v1[0], v1[1]); w.w = cvt_pk_bf16(v1[2], v1[3]);
                    *(v4u*)(rowp + bj * HALF) = w; } }
    }
};
template <class Epi, class Sched, bool ALIGN_EPI = false, bool SP2 = false>
__device__ __forceinline__ void gemm_phase(PG8_LAS unsigned char* lds, const GemmX g, const Sched& S, const Epi& E) {
    const int tid = threadIdx.x, wid = __builtin_amdgcn_readfirstlane(tid >> 6), lane = tid & 63, wr = wid >> 2, wc = wid & 3, fr = lane & 15, fq = lane >> 4;
    const int K = g.K, nt = K / BK;
    unsigned voffA[2], voffB[2];
#pragma unroll
    for (int i = 0; i < 2; ++i) { int R, C; stage_rc(tid * 16 + i * 8192, R, C); const int Rb = Epi::PERM ? ((R & ~31) + perm32(R & 31)) : R;
        voffA[i] = (unsigned)(R * g.lda + C) * 2u; voffB[i] = (unsigned)(Rb * K + C) * 2u; }
    const size_t kstep = (size_t)(BK * 2);
    const size_t hstep = (size_t)HALF * K * 2;
    const size_t tstep = 2 * hstep;
    const size_t hstepA = (size_t)HALF * g.lda * 2, tstepA = 2 * hstepA;
    const unsigned ldsw = (unsigned)wid * 1024u;
    const int aoff = lds_byte(wr * 64 + fr, fq * 8), boff = lds_byte(wc * 32 + fr, fq * 8);
#define PG8_SA(b, h) (((b) * 2 + (h)) * HTB)
#define PG8_SB(b, h) ((4 + (b) * 2 + (h)) * HTB)
#define PG8_STAGE(bufoff, gbase, voff) do { _Pragma("unroll") for (int _i = 0; _i < 2; ++_i) \
        __builtin_amdgcn_global_load_lds((const unsigned*)((const char*)(gbase) + (voff)[_i]), (PG8_LAS unsigned*)(lds + (bufoff) + ldsw + _i * 8192), 16, 0, 0); } while (0)
#define PG8_LDA(dst, b, h) do { _Pragma("unroll") for (int m = 0; m < 4; ++m) _Pragma("unroll") for (int k = 0; k < 2; ++k) dst[m][k] = *(const PG8_LAS bf16x8*)(lds + PG8_SA(b, h) + aoff + m * 2048 + k * 1024); } while (0)
#define PG8_LDB(dst, b, h) do { _Pragma("unroll") for (int n = 0; n < 2; ++n) _Pragma("unroll") for (int k = 0; k < 2; ++k) dst[n][k] = *(const PG8_LAS bf16x8*)(lds + PG8_SB(b, h) + boff + n * 2048 + k * 1024); } while (0)
#define PG8_MMA(ai, bj, At, Bt) do { __builtin_amdgcn_s_setprio(1); _Pragma("unroll") for (int m = 0; m < 4; ++m) _Pragma("unroll") for (int n = 0; n < 2; ++n) _Pragma("unroll") for (int k = 0; k < 2; ++k) \
        acc[ai][bj][m][n] = __builtin_amdgcn_mfma_f32_16x16x32_bf16(Bt[n][k], At[m][k], acc[ai][bj][m][n], 0, 0, 0); __builtin_amdgcn_s_setprio(0); } while (0)
#define PG8_WAIT_V(n) asm volatile("s_waitcnt vmcnt(" #n ")" ::: "memory")
#define PG8_WAIT_L(n) asm volatile("s_waitcnt lgkmcnt(" #n ")" ::: "memory")
#define PG8_BAR __builtin_amdgcn_s_barrier()
#define PG8_SCHED __builtin_amdgcn_sched_barrier(0)
    Unit cur, nxt; int ui = 0;
    if (!S.next(0, cur)) return;
    f32x4 acc[2][2][4][2];
#pragma unroll
    for (int a = 0; a < 2; ++a)
#pragma unroll
        for (int b = 0; b < 2; ++b)
#pragma unroll
            for (int m = 0; m < 4; ++m)
#pragma unroll
                for (int n = 0; n < 2; ++n) acc[a][b][m][n] = (f32x4){0.f, 0.f, 0.f, 0.f};
    bf16x8 At[4][2], B0[2][2], B1[2][2];
    const char* cA = (const char*)g.A + (size_t)cur.pm * tstepA; const char* cB = (const char*)g.Bt + (size_t)cur.pn * tstep;
    S.a_ready(cur);
    if constexpr (SP2) {
        PG8_STAGE(PG8_SB(0, 0), cB, voffB); PG8_STAGE(PG8_SB(0, 1), cB + hstep, voffB); PG8_STAGE(PG8_SA(0, 0), cA, voffA); PG8_STAGE(PG8_SA(0, 1), cA + hstepA, voffA);
        if (wr == 1) PG8_BAR;
        PG8_WAIT_V(2); PG8_BAR;
        PG8_STAGE(PG8_SB(1, 0), cB + kstep, voffB); PG8_STAGE(PG8_SA(1, 0), cA + kstep, voffA); PG8_STAGE(PG8_SB(1, 1), cB + hstep + kstep, voffB);
        PG8_WAIT_V(6); PG8_BAR;
    } else {
        PG8_STAGE(PG8_SB(0, 0), cB, voffB); PG8_STAGE(PG8_SA(0, 0), cA, voffA); PG8_STAGE(PG8_SB(0, 1), cB + hstep, voffB); PG8_STAGE(PG8_SA(0, 1), cA + hstepA, voffA);
        if (wr == 1) PG8_BAR;
        PG8_WAIT_V(4); PG8_BAR;
        PG8_STAGE(PG8_SB(1, 0), cB + kstep, voffB); PG8_STAGE(PG8_SA(1, 0), cA + kstep, voffA); PG8_STAGE(PG8_SB(1, 1), cB + hstep + kstep, voffB);
        PG8_WAIT_V(6); PG8_BAR;
    }
    for (;;) {
        const bool has_next = S.next(ui + 1, nxt);
        const char* nA = has_next ? (const char*)g.A + (size_t)nxt.pm * tstepA : cA; const char* nB = has_next ? (const char*)g.Bt + (size_t)nxt.pn * tstep : cB;
        for (int t = 0; t < nt; t += 2) {
            const bool last = (t == nt - 2);
            const char* a1 = cA + (size_t)(t + 1) * kstep;
            const char* a2 = last ? nA : cA + (size_t)(t + 2) * kstep; const char* b2 = last ? nB : cB + (size_t)(t + 2) * kstep;
            const char* a3 = a2 + kstep; const char* b3 = b2 + kstep;
            if (last && has_next) S.a_ready(nxt);
            if constexpr (SP2) {
            PG8_LDB(B0, 0, 0); PG8_LDB(B1, 0, 1); PG8_SCHED; PG8_LDA(At, 0, 0); PG8_STAGE(PG8_SA(1, 1), a1 + hstepA, voffA);
            PG8_WAIT_V(8); PG8_WAIT_L(0); PG8_BAR; PG8_MMA(0, 0, At, B0); PG8_MMA(0, 1, At, B1); PG8_BAR; PG8_SCHED;
            PG8_LDA(At, 0, 1); PG8_STAGE(PG8_SB(0, 0), b2, voffB); PG8_STAGE(PG8_SB(0, 1), b2 + hstep, voffB); PG8_STAGE(PG8_SA(0, 0), a2, voffA);
            PG8_WAIT_V(8); PG8_WAIT_L(0); PG8_BAR; PG8_MMA(1, 0, At, B0); PG8_MMA(1, 1, At, B1); PG8_BAR; PG8_SCHED;
            PG8_LDB(B0, 1, 0); PG8_LDB(B1, 1, 1); PG8_SCHED; PG8_LDA(At, 1, 0); PG8_STAGE(PG8_SA(0, 1), a2 + hstepA, voffA);
            PG8_WAIT_V(8); PG8_WAIT_L(0); PG8_BAR; PG8_MMA(0, 0, At, B0); PG8_MMA(0, 1, At, B1); PG8_BAR; PG8_SCHED;
            PG8_LDA(At, 1, 1); PG8_STAGE(PG8_SB(1, 0), b3, voffB); PG8_STAGE(PG8_SB(1, 1), b3 + hstep, voffB); PG8_STAGE(PG8_SA(1, 0), a3, voffA);
            PG8_WAIT_V(8); PG8_WAIT_L(0); PG8_BAR; PG8_MMA(1, 0, At, B0); PG8_MMA(1, 1, At, B1); PG8_BAR; PG8_SCHED;
            } else {
            PG8_LDB(B0, 0, 0); PG8_SCHED; PG8_LDA(At, 0, 0); PG8_STAGE(PG8_SA(1, 1), a1 + hstepA, voffA);
            PG8_WAIT_L(8); PG8_BAR; PG8_WAIT_L(0); PG8_MMA(0, 0, At, B0); PG8_BAR; PG8_SCHED;
            PG8_LDB(B1, 0, 1); PG8_STAGE(PG8_SB(0, 0), b2, voffB);
            PG8_BAR; PG8_WAIT_L(0); PG8_MMA(0, 1, At, B1); PG8_BAR;
            PG8_LDA(At, 0, 1); PG8_STAGE(PG8_SA(0, 0), a2, voffA);
            PG8_BAR; PG8_WAIT_L(0); PG8_MMA(1, 0, At, B0); PG8_BAR; PG8_SCHED;
            PG8_STAGE(PG8_SB(0, 1), b2 + hstep, voffB);
            PG8_WAIT_V(6); PG8_BAR; PG8_MMA(1, 1, At, B1); PG8_BAR;
            PG8_LDB(B0, 1, 0); PG8_SCHED; PG8_LDA(At, 1, 0); PG8_STAGE(PG8_SA(0, 1), a2 + hstepA, voffA);
            PG8_WAIT_L(8); PG8_BAR; PG8_WAIT_L(0); PG8_MMA(0, 0, At, B0); PG8_BAR; PG8_SCHED;
            PG8_LDB(B1, 1, 1); PG8_STAGE(PG8_SB(1, 0), b3, voffB);
            PG8_BAR; PG8_WAIT_L(0); PG8_MMA(0, 1, At, B1); PG8_BAR;
            PG8_LDA(At, 1, 1); PG8_STAGE(PG8_SA(1, 0), a3, voffA);
            PG8_BAR; PG8_WAIT_L(0); PG8_MMA(1, 0, At, B0); PG8_BAR; PG8_SCHED;
            PG8_STAGE(PG8_SB(1, 1), b3 + hstep, voffB);
            PG8_WAIT_V(6); PG8_BAR; PG8_MMA(1, 1, At, B1); PG8_BAR;
            }
        }
        if constexpr (ALIGN_EPI) { if (wr == 0) PG8_BAR; }
        if constexpr (!Epi::AFTER_DRAIN) { E(acc, cur, wr, wc, fr, fq); S.done(cur); }
        if (!has_next) break;
#pragma unroll
        for (int a = 0; a < 2; ++a)
#pragma unroll
            for (int b = 0; b < 2; ++b)
#pragma unroll
                for (int m = 0; m < 4; ++m)
#pragma unroll
                    for (int n = 0; n < 2; ++n) acc[a][b][m][n] = (f32x4){0.f, 0.f, 0.f, 0.f};
        cur = nxt; cA = nA; cB = nB; ++ui;
        if constexpr (ALIGN_EPI) { if (wr == 1) PG8_BAR; }
    }
    PG8_WAIT_V(0);
    if constexpr (!ALIGN_EPI) { if (wr == 0) PG8_BAR; }
    PG8_BAR;
    if constexpr (Epi::AFTER_DRAIN) { E.fused(acc, cur, wr, wc, fr, fq, lds, wid, lane); S.done(cur); }
#undef PG8_SA
#undef PG8_SB
#undef PG8_STAGE
#undef PG8_LDA
#undef PG8_LDB
#undef PG8_MMA
#undef PG8_WAIT_V
#undef PG8_WAIT_L
#undef PG8_BAR
#undef PG8_SCHED
}
}

#define XB_TMO      128
#define XB_XCNT(j)  (256  + 64 * (j))
#define XB_XSUB(j)  (1280 + 64 * (j))
#define XB_XGEN(j)  (2304 + 64 * (j))
#define XB_TOP      3328
#define XB_TOPGEN   3392
#define XCD_BAR_WORDS 3456
#define XB_SPIN_CAP (1u << 20)
__device__ __forceinline__ unsigned xb_ld(unsigned* p) { return __hip_atomic_load(p, __ATOMIC_RELAXED, __HIP_MEMORY_SCOPE_AGENT); }
__device__ __forceinline__ unsigned xb_add(unsigned* p, unsigned v) { return __hip_atomic_fetch_add(p, v, __ATOMIC_RELAXED, __HIP_MEMORY_SCOPE_AGENT); }
__device__ __forceinline__ unsigned xb_xcc_id() { return (unsigned)__builtin_amdgcn_s_getreg((3 << 11) | 20) & 0xFu; }
#define XB_SPIN(cond, bar) do { unsigned _sp = 0; while (cond) { __builtin_amdgcn_s_sleep(1); \
    if ((++_sp & 255u) == 0u) { if (xb_ld(&(bar)[XB_TMO])) break; if (_sp > XB_SPIN_CAP) { atomicAdd(&(bar)[XB_TMO], 1u); break; } } } } while (0)
struct XcdBarrier { unsigned* bar; unsigned x; volatile LAS unsigned* st; };
__device__ __forceinline__ XcdBarrier xcd_barrier_post(unsigned* bar, volatile LAS unsigned* st) {
    XcdBarrier b; b.bar = bar; b.x = xb_xcc_id(); b.st = st;
    if (threadIdx.x == 0) (void)xb_add(&bar[XB_XCNT(b.x)], 1u);
    return b;
}
__device__ __forceinline__ void xcd_barrier_complete(unsigned* bar, unsigned x, unsigned& nloc, unsigned& nx) {
    const unsigned G = gridDim.x * gridDim.y * gridDim.z;
    unsigned sum, cnt, mine, sp = 0u;
    for (;;) {
        sum = 0u; cnt = 0u; mine = 0u;
#pragma unroll
        for (unsigned j = 0; j < 16; ++j) { const unsigned c = xb_ld(&bar[XB_XCNT(j)]); sum += c; cnt += (c > 0u) ? 1u : 0u; mine = (j == x) ? c : mine; }
        if (sum == G) break;
        __builtin_amdgcn_s_sleep(1);
        if ((++sp & 255u) == 0u) { if (xb_ld(&bar[XB_TMO])) break; if (sp > XB_SPIN_CAP) { atomicAdd(&bar[XB_TMO], 1u); break; } }
    }
    nloc = mine > 0u ? mine : 1u; nx = cnt > 0u ? cnt : 1u;
}
__device__ __forceinline__ void xcd_barrier(const XcdBarrier& b) {
    asm volatile("s_waitcnt vmcnt(0)" ::: "memory");
    __syncthreads();
    if (threadIdx.x == 0) {
        unsigned* bar = b.bar;
        __builtin_amdgcn_s_waitcnt(0);
        unsigned nloc = b.st[0], nx = b.st[1];
        if (nloc == 0u) { xcd_barrier_complete(bar, b.x, nloc, nx); b.st[0] = nloc; b.st[1] = nx; }
        const unsigned old = xb_add(&bar[XB_XSUB(b.x)], 1u);
        const unsigned gen = old / nloc;
        if (old + 1u == (gen + 1u) * nloc) {
            __builtin_amdgcn_fence(__ATOMIC_RELEASE, "agent");
            asm volatile("s_waitcnt vmcnt(0)" ::: "memory");
            const unsigned og = xb_add(&bar[XB_TOP], 1u);
            const unsigned tg = og / nx;
            if (og + 1u == (tg + 1u) * nx) xb_add(&bar[XB_TOPGEN], 1u);
            else XB_SPIN(xb_ld(&bar[XB_TOPGEN]) == tg, bar);
            __builtin_amdgcn_fence(__ATOMIC_ACQUIRE, "agent");
            xb_add(&bar[XB_XGEN(b.x)], 1u);
            asm volatile("s_waitcnt vmcnt(0)" ::: "memory");
        } else {
            XB_SPIN(xb_ld(&bar[XB_XGEN(b.x)]) == gen, bar);
            __builtin_amdgcn_fence(__ATOMIC_ACQUIRE, "agent");
            asm volatile("s_waitcnt vmcnt(0)" ::: "memory");
        }
    }
    __syncthreads();
}

struct Args { const float* in[38]; float* out; unsigned char* ws; int ph_lo, ph_hi, li, pad; };
enum InputId { I_X = 0, I_NORM_MIX, I_W_IN, I_W_OUT, I_RW_MU, I_RW_W0, I_RW_W_UP, I_RW_A0, I_RW_A_UP, I_RW_G_UP, I_RW_K_K, I_RW_K_A, I_RW_R_K,
    I_RW_LN_W, I_RW_LN_B, I_RW_V0, I_RW_V_DOWN, I_RW_V_UP, I_GLA_A_UP, I_GLA_A_BIAS, I_GLA_NORM, I_LRU_CONV_W, I_LRU_CONV_B, I_LRU_W_R,
    I_LRU_B_R, I_LRU_W_I, I_LRU_B_I, I_LRU_LAM, I_GDN_CONV_W, I_GDN_A_LOG, I_GDN_DT_BIAS, I_GDN_NORM, I_NORM_FFN, I_PEER_WQ, I_PEER_SK,
    I_PEER_U, I_PEER_V, I_NORM_FINAL };
enum { PH_P0 = 0, PH_GEMM1 = 1, PH_PREP = 2, PH_AUX = 3, PH_SCAN = 4, PH_POST = 5, PH_GEMM2 = 6, PH_NORM2 = 7, PH_GEMM3 = 8, PH_TOPK = 9, PH_PEERU = 10, PH_PEERC = 11, PH_PEERV = 12, PH_PER_LAYER = 12, PH_FNORM = 25, PH_TOTAL = 26 };

struct Frame {
    LAS unsigned char* lds;
    int tid, lane, wave, vcu, G;
    int gw, ngw;
};

__device__ __forceinline__ void p0_transpose_item(const float* W, int K, int N, const float* kscale, bf16_t* WT, LAS float* scr, int item, int nblk, int lane) {
    const int kb = item / nblk, nb = item % nblk, k0 = 64 * kb, n0 = 32 * nb;
    const int kr = lane >> 3, n4 = (lane & 7) * 4;
    f32x4 v[8];
#pragma unroll
    for (int i = 0; i < 8; ++i) { const int kk = kr + 8 * i;
        v[i] = (n0 + n4 < N) ? *(const f32x4*)(W + (size_t)(k0 + kk) * N + n0 + n4) : (f32x4){0.f, 0.f, 0.f, 0.f}; }
#pragma unroll
    for (int i = 0; i < 8; ++i) { const int kk = kr + 8 * i; const float s = kscale ? kscale[k0 + kk] : 1.0f;
        scr[kk * 33 + n4 + 0] = v[i].x * s; scr[kk * 33 + n4 + 1] = v[i].y * s; scr[kk * 33 + n4 + 2] = v[i].z * s; scr[kk * 33 + n4 + 3] = v[i].w * s; }
    LDS_WAIT(); asm volatile("" ::: "memory");
    const int c = lane & 7;
#pragma unroll
    for (int j = 0; j < 4; ++j) { const int n = (lane >> 3) + 8 * j; const LAS float* s = scr + (8 * c) * 33 + n;
        v4u o; o.x = pk2(s[0 * 33], s[1 * 33]); o.y = pk2(s[2 * 33], s[3 * 33]); o.z = pk2(s[4 * 33], s[5 * 33]); o.w = pk2(s[6 * 33], s[7 * 33]);
        *(v4u*)(WT + (size_t)(n0 + n) * K + k0 + 8 * c) = o; }
    LDS_WAIT(); asm volatile("" ::: "memory");
}

__device__ __forceinline__ void p0_prologue(const Args& a, Frame& F) {
    const WsMap m = ws_map(NTOK);
    unsigned char* ws = a.ws;
    LAS float* scr = (LAS float*)(F.lds + F.wave * 16384);
    const int gw = F.gw, NGW = F.ngw, lane = F.lane;
    for (int n = gw; n < NTOK; n += NGW) {
        const f32x4* xr = (const f32x4*)(a.in[I_X] + (size_t)n * DM) + lane;
        f32x4 v[8]; float s = 0.f;
#pragma unroll
        for (int j = 0; j < 8; ++j) { v[j] = xr[64 * j]; s += (v[j].x * v[j].x + v[j].y * v[j].y) + (v[j].z * v[j].z + v[j].w * v[j].w); }
        const float rstd = 1.0f / sqrtf(wave_sum(s) * (1.0f / DM) + 1e-6f);
        f32x4* xo = (f32x4*)(a.out + (size_t)n * DM) + lane;
        v2u* o8 = (v2u*)((bf16_t*)(ws + m.xn) + (size_t)n * DM) + lane;
#pragma unroll
        for (int j = 0; j < 8; ++j) { xo[64 * j] = v[j]; v2u w; w.x = pk2(v[j].x * rstd, v[j].y * rstd); w.y = pk2(v[j].z * rstd, v[j].w * rstd); o8[64 * j] = w; }
    }
    {
        constexpr int I1 = (DM / 64) * (PLD / 32), I2 = (DM / 64) * (DM / 32);
        for (int it = gw; it < NL * (I1 + I2); it += NGW) {
            const int l = it / (I1 + I2); int r = it % (I1 + I2);
            if (r < I1) p0_transpose_item(a.in[I_W_IN] + (size_t)l * DM * INC, DM, INC, a.in[I_NORM_MIX] + l * DM, (bf16_t*)(ws + m.w1t) + (size_t)l * PLD * DM, scr, r, PLD / 32, lane);
            else p0_transpose_item(a.in[I_W_OUT] + (size_t)l * DM * DM, DM, DM, nullptr, (bf16_t*)(ws + m.w2t) + (size_t)l * DM * DM, scr, r - I1, DM / 32, lane);
        }
    }
    for (int it = gw; it < NL * 16 * 64; it += NGW) {
        const int l = it / 1024, hp = (it % 1024) / 64, kb = it % 64;
        const int dh = lane & 1, kk = kb * 32 + (lane >> 1);
        const float* wq = a.in[I_PEER_WQ] + (size_t)l * DM * DM + (size_t)kk * DM + hp * 128 + dh * 64;
        const float* sk = a.in[I_PEER_SK] + ((size_t)l * 16 + hp) * 128 * 128;
        f32x4 q[16];
#pragma unroll
        for (int d = 0; d < 16; ++d) q[d] = *(const f32x4*)(wq + 4 * d);
        bf16_t* o = (bf16_t*)(ws + m.wsct) + (size_t)l * DM * DM + (size_t)(hp * 128) * DM + kk;
        f32x4 stg[8];
#pragma unroll
        for (int i = 0; i < 8; ++i) stg[i] = ((const f32x4*)sk)[i * 64 + lane];
#pragma unroll 1
        for (int kc = 0; kc < 8; ++kc) {
#pragma unroll
            for (int i = 0; i < 8; ++i) ((LAS f32x4*)scr)[i * 64 + lane] = stg[i];
            if (kc + 1 < 8) {
#pragma unroll
                for (int i = 0; i < 8; ++i) stg[i] = ((const f32x4*)(sk + (kc + 1) * 2048))[i * 64 + lane]; }
            LDS_WAIT(); asm volatile("" ::: "memory");
#pragma unroll 2
            for (int key = 0; key < 16; ++key) {
                const LAS f32x4* s4 = (const LAS f32x4*)(scr + key * 128 + dh * 64);
                float acc = 0.f;
#pragma unroll
                for (int d = 0; d < 16; ++d) { const f32x4 sv = s4[d]; acc += (q[d].x * sv.x + q[d].y * sv.y) + (q[d].z * sv.z + q[d].w * sv.w); }
                acc += __shfl_xor(acc, 1);
                if (dh == 0) o[(size_t)(kc * 16 + key) * DM] = f2bf(acc);
            }
            LDS_WAIT(); asm volatile("" ::: "memory");
        }
    }
    {
        const int gt = F.vcu * NTHR + F.tid, GT = F.G * NTHR;
        bf16_t* AW = (bf16_t*)(ws + m.auxwt); bf16_t* LW = (bf16_t*)(ws + m.lruwt); bf16_t* VW = (bf16_t*)(ws + m.vreswt); float* PP = (float*)(ws + m.pp);
        for (int it = gt; it < NL * 1792 * 384; it += GT) {
            const int l = it / (1792 * 384), r = it % (1792 * 384), n = r / 384, k = r % 384;
            float v = 0.f;
            if (n < 512) { if (k < 64) v = a.in[I_RW_W_UP][(size_t)l * 64 * 512 + k * 512 + n]; }
            else if (n < 1024) { if (k >= 64 && k < 128) v = a.in[I_RW_A_UP][(size_t)l * 64 * 512 + (k - 64) * 512 + (n - 512)]; }
            else if (n < 1536) { if (k >= 128 && k < 256) v = a.in[I_RW_G_UP][(size_t)l * 128 * 512 + (k - 128) * 512 + (n - 1024)]; }
            else { if (k >= 256 && k < 272) v = a.in[I_GLA_A_UP][(size_t)l * 16 * 256 + (k - 256) * 256 + (n - 1536)]; }
            AW[it] = f2bf(v);
        }
        for (int it = gt; it < NL * 1024 * 512; it += GT) {
            const int l = it / (1024 * 512), r = it % (1024 * 512), n = r / 512, k = r % 512;
            const int nn = n & 511, blk = nn >> 6, j = nn & 63;
            float v = 0.f;
            if ((k >> 6) == blk) v = (n < 512 ? a.in[I_LRU_W_R] : a.in[I_LRU_W_I])[(size_t)l * 8 * 64 * 64 + (size_t)blk * 4096 + (k & 63) * 64 + j];
            LW[it] = f2bf(v);
        }
        for (int it = gt; it < 512 * 512; it += GT) {
            const int n = it / 512, k = it % 512;
            float s = 0.f;
            for (int i = 0; i < 32; ++i) s += a.in[I_RW_V_DOWN][k * 32 + i] * a.in[I_RW_V_UP][i * 512 + n];
            VW[it] = f2bf(s);
        }
        for (int it = gt; it < 6144; it += GT) {
            float v = 0.f;
            if (it < 3584) { const int l = it / 1792, c = it % 1792;
                v = c < 512 ? a.in[I_RW_W0][l * 512 + c] : (c < 1024 ? a.in[I_RW_A0][l * 512 + c - 512] : (c < 1536 ? 0.f : a.in[I_GLA_A_BIAS][l * 256 + c - 1536])); }
            else if (it < 5632) { const int l = (it - 3584) / 1024, c = (it - 3584) % 1024; v = c < 512 ? a.in[I_LRU_B_R][l * 512 + c] : a.in[I_LRU_B_I][l * 512 + c - 512]; }
            else v = a.in[I_RW_V0][it - 5632];
            PP[it] = v;
        }
    }
}

__device__ __forceinline__ unsigned pk4_fp8(float a, float b, float c, float d) {
    int w = 0;
    w = __builtin_amdgcn_cvt_pk_fp8_f32(__builtin_fmaxf(__builtin_fminf(a, 448.f), -448.f), __builtin_fmaxf(__builtin_fminf(b, 448.f), -448.f), w, false);
    w = __builtin_amdgcn_cvt_pk_fp8_f32(__builtin_fmaxf(__builtin_fminf(c, 448.f), -448.f), __builtin_fmaxf(__builtin_fminf(d, 448.f), -448.f), w, true);
    return (unsigned)w;
}
constexpr size_t TSL = 128;
constexpr float TSTEP = 0.3352f;

template <int CTRL> __device__ __forceinline__ float dpp_f(float v) { return __builtin_bit_cast(float, __builtin_amdgcn_update_dpp(0, __builtin_bit_cast(int, v), CTRL, 0xF, 0xF, true)); }
__device__ __forceinline__ float rdlane_f(float v, int l) { return __builtin_bit_cast(float, __builtin_amdgcn_readlane(__builtin_bit_cast(int, v), l)); }
__device__ __forceinline__ float row16_sum(float v) {
    v += dpp_f<0xB1>(v); v += dpp_f<0x4E>(v); v += dpp_f<0x141>(v); v += dpp_f<0x140>(v); return v;
}
__device__ __forceinline__ float wave_sum_u(float v) {
    v = row16_sum(v);
    return (rdlane_f(v, 0) + rdlane_f(v, 16)) + (rdlane_f(v, 32) + rdlane_f(v, 48));
}
typedef __bf16 bf16x2_t __attribute__((ext_vector_type(2)));
__device__ __forceinline__ float dot2bf(unsigned w, unsigned x, float acc) { return __builtin_amdgcn_fdot2_f32_bf16(__builtin_bit_cast(bf16x2_t, w), __builtin_bit_cast(bf16x2_t, x), acc, false); }
__device__ __forceinline__ void tables_range(const Args& a, Frame& F, size_t it0, size_t it1, int sub, int nsub) {
    const WsMap m = ws_map(NTOK);
    const size_t per = (size_t)NEXP * DM / 32;
    const size_t stride = (size_t)nsub * NTHR;
    float* tsc = (float*)(a.ws + m.tsc);
    for (size_t base = it0 + (size_t)sub * NTHR + F.tid; base < it1; base += 2 * stride) {
        f32x4 v[2][8];
#pragma unroll
        for (int u = 0; u < 2; ++u) { const size_t it = base + u * stride;
            if (it < it1) { const int tb = (int)(it / per); const size_t r = it % per;
                const f32x4* srcp = (const f32x4*)(((tb & 1) ? a.in[I_PEER_V] : a.in[I_PEER_U]) + (size_t)(tb >> 1) * NEXP * DM + r * 32);
#pragma unroll
                for (int q = 0; q < 8; ++q) v[u][q] = __builtin_nontemporal_load(srcp + q); } }
#pragma unroll
        for (int u = 0; u < 2; ++u) { const size_t it = base + u * stride;
            if (it < it1) { const int tb = (int)(it / per); const size_t r = it % per;
                float ss = 0.f;
#pragma unroll
                for (int q = 0; q < 8; ++q) ss += (v[u][q].x * v[u][q].x + v[u][q].y * v[u][q].y) + (v[u][q].z * v[u][q].z + v[u][q].w * v[u][q].w);
                const float rms = sqrtf(wave_sum_u(ss) * (1.0f / DM));
                float step = rms * TSTEP; const float inv = rms > 0.f ? 1.0f / step : 0.f;
                v4u w;
                if (tb & 1) {
                    const float sc = rms > 0.f ? 2.05f / rms : 0.f; step = rms * (1.0f / 2.05f);
#pragma unroll
                    for (int d = 0; d < 4; ++d) { unsigned p = 0;
                        p = __builtin_amdgcn_cvt_scalef32_pk_fp4_f32(p, __builtin_fmaxf(__builtin_fminf(v[u][2 * d].x * sc, 6.f), -6.f), __builtin_fmaxf(__builtin_fminf(v[u][2 * d].y * sc, 6.f), -6.f), 1.0f, 0);
                        p = __builtin_amdgcn_cvt_scalef32_pk_fp4_f32(p, __builtin_fmaxf(__builtin_fminf(v[u][2 * d].z * sc, 6.f), -6.f), __builtin_fmaxf(__builtin_fminf(v[u][2 * d].w * sc, 6.f), -6.f), 1.0f, 1);
                        p = __builtin_amdgcn_cvt_scalef32_pk_fp4_f32(p, __builtin_fmaxf(__builtin_fminf(v[u][2 * d + 1].x * sc, 6.f), -6.f), __builtin_fmaxf(__builtin_fminf(v[u][2 * d + 1].y * sc, 6.f), -6.f), 1.0f, 2);
                        p = __builtin_amdgcn_cvt_scalef32_pk_fp4_f32(p, __builtin_fmaxf(__builtin_fminf(v[u][2 * d + 1].z * sc, 6.f), -6.f), __builtin_fmaxf(__builtin_fminf(v[u][2 * d + 1].w * sc, 6.f), -6.f), 1.0f, 3);
                        w[d] = p; }
                } else
#pragma unroll
                for (int d = 0; d < 4; ++d) {
                    const f32x4 lo = v[u][2 * d], hi = v[u][2 * d + 1]; unsigned p = 0;
#pragma unroll
                    for (int b = 0; b < 4; ++b) {
                        const int cl = (int)__builtin_fminf(__builtin_fmaxf(__builtin_floorf(lo[b] * inv), -8.0f), 7.0f);
                        const int ch = (int)__builtin_fminf(__builtin_fmaxf(__builtin_floorf(hi[b] * inv), -8.0f), 7.0f);
                        p |= (((unsigned)cl & 15u) << (4 * b)) | (((unsigned)ch & 15u) << (16 + 4 * b)); }
                    w[d] = p; }
                *(v4u*)((unsigned char*)(a.ws + m.tabu) + (((size_t)tb * 8 + (r & 63) / 8) * NEXP + (r >> 6)) * TSL + (r & 7) * 16) = w;
                if (F.lane == 0) tsc[(size_t)tb * NEXP + (r >> 6)] = step; } }
    }
}

__device__ __forceinline__ float gelu_fast(float x) {
    const float u = 1.5957691216057308f * (x + 0.044715f * x * x * x);
    return x / (1.0f + __expf(-u));
}


__device__ __forceinline__ float sigm(float x) { return 1.0f / (1.0f + __expf(-x)); }
__device__ __forceinline__ float softplus_f(float x) { return __logf(1.0f + __expf(-fabsf(x))) + fmaxf(x, 0.0f); }
__device__ __forceinline__ float tanh_f(float x) { return 1.0f - 2.0f / (1.0f + __expf(2.0f * x)); }
__device__ __forceinline__ float red8(float v) { v += dpp_f<0xB1>(v); v += dpp_f<0x4E>(v); v += dpp_f<0x141>(v); return v; }
__device__ __forceinline__ v4u ld8(const bf16_t* p) { return *(const v4u*)p; }
__device__ __forceinline__ void unpack8(const v4u w, float (&f)[8]) { f[0] = bflo(w.x); f[1] = bfhi(w.x); f[2] = bflo(w.y); f[3] = bfhi(w.y); f[4] = bflo(w.z); f[5] = bfhi(w.z); f[6] = bflo(w.w); f[7] = bfhi(w.w); }
__device__ __forceinline__ v4u pack8(const float (&f)[8]) { v4u w; w.x = pk2(f[0], f[1]); w.y = pk2(f[2], f[3]); w.z = pk2(f[4], f[5]); w.w = pk2(f[6], f[7]); return w; }

__device__ __forceinline__ void prep_phase(const Args& a, Frame& F, int l) {
    const WsMap m = ws_map(NTOK);
    const bf16_t* p16 = (const bf16_t*)(a.ws + m.p16);
    bf16_t* zrkv = (bf16_t*)(a.ws + m.zrkv); bf16_t* auxA = (bf16_t*)(a.ws + m.auxA); bf16_t* xc = (bf16_t*)(a.ws + m.xc);
    const float* mu = a.in[I_RW_MU] + l * 1792;
#pragma unroll 4
    for (size_t it = (size_t)F.vcu * NTHR + F.tid; it < (size_t)NTOK * 224; it += (size_t)F.G * NTHR) {
        const int n = (int)(it / 224), j = (int)(it % 224), t = n % TSEQ;
        const int col = j * 8;
        float cur[8], prv[8], z[8];
        unpack8(ld8(p16 + (size_t)n * PLD + col), cur);
        unpack8(ld8(p16 + (size_t)(t > 0 ? n - 1 : n) * PLD + col), prv);
        const f32x4 m0 = *(const f32x4*)(mu + col), m1 = *(const f32x4*)(mu + col + 4);
        const float mm[8] = {m0.x, m0.y, m0.z, m0.w, m1.x, m1.y, m1.z, m1.w};
#pragma unroll
        for (int k = 0; k < 8; ++k) z[k] = cur[k] + ((t > 0 ? prv[k] : 0.f) - cur[k]) * mm[k];
        if (col < 1536) *(v4u*)(zrkv + (size_t)n * 1536 + col) = pack8(z);
        else {
            const int c = col - 1536;
#pragma unroll
            for (int k = 0; k < 8; ++k) z[k] = c < 64 ? tanh_f(z[k]) : (c < 128 ? z[k] : sigm(z[k]));
            *(v4u*)(auxA + (size_t)n * 384 + c) = pack8(z);
        }
    }
    for (size_t it = (size_t)F.vcu * NTHR + F.tid; it < (size_t)NTOK * 16; it += (size_t)F.G * NTHR) {
        const int n = (int)(it / 16), c = 256 + (int)(it % 16) * 8;
        v4u w = (v4u){0u, 0u, 0u, 0u};
        if (c < 272) w = ld8(p16 + (size_t)n * PLD + C_GLA + 1536 + (c - 256));
        *(v4u*)(auxA + (size_t)n * 384 + c) = w;
    }
#pragma unroll 2
    for (size_t it = (size_t)F.vcu * NTHR + F.tid; it < (size_t)NTOK * 64; it += (size_t)F.G * NTHR) {
        const int n = (int)(it / 64), c = (int)(it % 64) * 8, t = n % TSEQ;
        float acc[8];
        { const f32x4 b0 = *(const f32x4*)(a.in[I_LRU_CONV_B] + l * 512 + c), b1 = *(const f32x4*)(a.in[I_LRU_CONV_B] + l * 512 + c + 4);
          acc[0] = b0.x; acc[1] = b0.y; acc[2] = b0.z; acc[3] = b0.w; acc[4] = b1.x; acc[5] = b1.y; acc[6] = b1.z; acc[7] = b1.w; }
        v4u raw[4];
#pragma unroll
        for (int jj = 0; jj < 4; ++jj) raw[jj] = ld8(p16 + (size_t)(t - 3 + jj >= 0 ? n - 3 + jj : n) * PLD + C_LRU + c);
#pragma unroll
        for (int jj = 0; jj < 4; ++jj) {
            float xv[8]; unpack8(raw[jj], xv);
            const float ok = (t - 3 + jj >= 0) ? 1.0f : 0.0f;
            const float* cw = a.in[I_LRU_CONV_W] + (size_t)l * 4 * 512 + jj * 512 + c;
            const f32x4 w0 = *(const f32x4*)cw * ok, w1 = *(const f32x4*)(cw + 4) * ok;
            acc[0] += w0.x * xv[0]; acc[1] += w0.y * xv[1]; acc[2] += w0.z * xv[2]; acc[3] += w0.w * xv[3];
            acc[4] += w1.x * xv[4]; acc[5] += w1.y * xv[5]; acc[6] += w1.z * xv[6]; acc[7] += w1.w * xv[7];
        }
        *(v4u*)(xc + (size_t)n * 512 + c) = pack8(acc);
    }
    {
        bf16_t* gq = (bf16_t*)(a.ws + m.gq); bf16_t* gk = (bf16_t*)(a.ws + m.gk); bf16_t* gv = (bf16_t*)(a.ws + m.gv); float* gsc = (float*)(a.ws + m.gsc);
        const float* cw = a.in[I_GDN_CONV_W] + (size_t)l * 4 * 1536;
        const int lane = F.lane;
        for (int n = F.gw; n < NTOK; n += F.ngw) {
            const int t = n % TSEQ;
#pragma unroll
            for (int part = 0; part < 3; ++part) {
                const int cb = part * 512 + lane * 8;
                float acc[8];
#pragma unroll
                for (int k = 0; k < 8; ++k) acc[k] = 0.f;
#pragma unroll
                for (int jj = 0; jj < 4; ++jj) {
                    if (t - 3 + jj >= 0) {
                        float xv[8]; unpack8(ld8(p16 + (size_t)(n - 3 + jj) * PLD + C_GDN + cb), xv);
                        const f32x4 w0 = *(const f32x4*)(cw + jj * 1536 + cb), w1 = *(const f32x4*)(cw + jj * 1536 + cb + 4);
                        acc[0] += w0.x * xv[0]; acc[1] += w0.y * xv[1]; acc[2] += w0.z * xv[2]; acc[3] += w0.w * xv[3];
                        acc[4] += w1.x * xv[4]; acc[5] += w1.y * xv[5]; acc[6] += w1.z * xv[6]; acc[7] += w1.w * xv[7];
                    }
                }
                float ss = 0.f;
#pragma unroll
                for (int k = 0; k < 8; ++k) { acc[k] = acc[k] * sigm(acc[k]); ss += acc[k] * acc[k]; }
                if (part < 2) {
                    ss = row16_sum(ss);
                    const float inv = (1.0f / sqrtf(ss + 1e-6f)) * (part == 0 ? 0.08838834764831845f : 1.0f);
#pragma unroll
                    for (int k = 0; k < 8; ++k) acc[k] *= inv;
                }
                *(v4u*)((part == 0 ? gq : (part == 1 ? gk : gv)) + (size_t)n * 512 + lane * 8) = pack8(acc);
            }
            if (lane < 4) {
                gsc[(size_t)n * 8 + lane] = sigm(bf2f(p16[(size_t)n * PLD + C_GDN + 2048 + lane]));
                gsc[(size_t)n * 8 + 4 + lane] = -__expf(a.in[I_GDN_A_LOG][l * 4 + lane]) * softplus_f(bf2f(p16[(size_t)n * PLD + C_GDN + 2052 + lane]) + a.in[I_GDN_DT_BIAS][l * 4 + lane]);
            }
        }
    }
}

__device__ __forceinline__ float swz16(float v) { return __builtin_bit_cast(float, __builtin_amdgcn_ds_swizzle(__builtin_bit_cast(int, v), 0x401F)); }
__device__ __forceinline__ float red32(float v) { v = row16_sum(v); return v + swz16(v); }

__device__ __forceinline__ void rwkv_task(const Args& a, Frame& F, int l, int task) {
    const WsMap m = ws_map(NTOK);
    const int b = task >> 4, h = (task >> 1) & 7, hf = task & 1;
    LAS float* LR = (LAS float*)F.lds; LAS float* LW = LR + 2048; LAS float* LK = LW + 2048; LAS float* LA = LK + 2048; LAS float* LB = LA + 2048;
    LAS float* LV = LB + 2048; LAS float* LY = LV + 1024;
    const int lane = F.lane, w = F.wave, tid = F.tid;
    const int ch = h * 64 + lane;
    const bool mine = (lane >> 5) == hf;
    const float kk_ = a.in[I_RW_K_K][l * 512 + ch], ka_ = a.in[I_RW_K_A][l * 512 + ch], rk_ = a.in[I_RW_R_K][l * 512 + ch];
    const bf16_t* zr = (const bf16_t*)(a.ws + m.zrkv); const bf16_t* ao = (const bf16_t*)(a.ws + m.auxo); const bf16_t* vr = (const bf16_t*)(a.ws + m.vres);
    float* vf = (float*)(a.ws + m.vfirst); bf16_t* yo = (bf16_t*)(a.ws + m.rwy); bf16_t* bvo = (bf16_t*)(a.ws + m.rwbv);
    float S0 = 0.f, S1 = 0.f, S2 = 0.f, S3 = 0.f;
    const int row = tid >> 4, ks = tid & 15;
    float in_[4][7];
    auto load_chunk = [&](int c) {
#pragma unroll
        for (int q = 0; q < 4; ++q) { const size_t n = (size_t)b * TSEQ + c * 32 + w + 8 * q;
            in_[q][0] = bf2f(zr[n * 1536 + ch]); in_[q][1] = bf2f(zr[n * 1536 + 512 + ch]); in_[q][2] = bf2f(zr[n * 1536 + 1024 + ch]);
            in_[q][3] = bf2f(ao[n * 1792 + ch]); in_[q][4] = bf2f(ao[n * 1792 + 512 + ch]);
            if (l > 0) { in_[q][5] = bf2f(vr[n * 512 + ch]); in_[q][6] = vf[n * 512 + ch]; } else { in_[q][5] = 0.f; in_[q][6] = 0.f; } }
    };
    load_chunk(0);
    for (int c = 0; c < TSEQ / 32; ++c) {
#pragma unroll
        for (int q = 0; q < 4; ++q) {
            const int tl = w + 8 * q; const size_t n = (size_t)b * TSEQ + c * 32 + tl;
            const float zr_ = in_[q][0], zk_ = in_[q][1], zv_ = in_[q][2], wp = in_[q][3], ap = in_[q][4];
            float v = zv_;
            if (l == 0) { if (mine) vf[n * 512 + ch] = zv_; } else v = zv_ + (in_[q][6] - zv_) * sigm(in_[q][5]);
            const float w_raw = -softplus_f(-wp) - 0.5f, dec = __expf(-__expf(w_raw));
            const float aa = sigm(ap);
            const float kkraw = zk_ * kk_;
            const float ss = wave_sum_u(kkraw * kkraw);
            const float kk = kkraw * (1.0f / sqrtf(fmaxf(ss, 1e-24f)));
            const float km = zk_ * (1.0f + (aa - 1.0f) * ka_);
            const float bon = wave_sum_u(zr_ * km * rk_);
            LR[tl * 64 + lane] = zr_; LW[tl * 64 + lane] = dec; LK[tl * 64 + lane] = km; LA[tl * 64 + lane] = -kk; LB[tl * 64 + lane] = kk * aa;
            if (mine) { LV[tl * 32 + (lane & 31)] = v; bvo[n * 512 + ch] = f2bf(bon * v); }
        }
        __syncthreads();
        if (c + 1 < TSEQ / 32) load_chunk(c + 1);
        float keep0 = 0.f, keep1 = 0.f;
#pragma unroll 4
        for (int tl = 0; tl < 32; ++tl) {
            const int o = tl * 64 + ks * 4;
            const f32x4 a4 = *(const LAS f32x4*)(LA + o), w4 = *(const LAS f32x4*)(LW + o), b4 = *(const LAS f32x4*)(LB + o), k4 = *(const LAS f32x4*)(LK + o), r4 = *(const LAS f32x4*)(LR + o);
            const float vv = LV[tl * 32 + row];
            const float sa = row16_sum((S0 * a4.x + S1 * a4.y) + (S2 * a4.z + S3 * a4.w));
            S0 = S0 * w4.x + (sa * b4.x + vv * k4.x); S1 = S1 * w4.y + (sa * b4.y + vv * k4.y); S2 = S2 * w4.z + (sa * b4.z + vv * k4.z); S3 = S3 * w4.w + (sa * b4.w + vv * k4.w);
            const float y = row16_sum((S0 * r4.x + S1 * r4.y) + (S2 * r4.z + S3 * r4.w));
            keep0 = (ks == tl) ? y : keep0; keep1 = (ks + 16 == tl) ? y : keep1;
        }
        LY[ks * 32 + row] = keep0; LY[(16 + ks) * 32 + row] = keep1;
        __syncthreads();
        { const int tl = tid >> 4, r2 = (tid & 15) * 2; const size_t n = (size_t)b * TSEQ + c * 32 + tl;
          *(unsigned*)(yo + n * 512 + h * 64 + hf * 32 + r2) = pk2(LY[tl * 32 + r2], LY[tl * 32 + r2 + 1]); }
    }
}


__device__ __forceinline__ void chunk_cumsum8(float (&x)[8], LAS float* tmp, int lane, int w, int c8) {
#pragma unroll
    for (int d = 8; d < 64; d <<= 1) {
#pragma unroll
        for (int k = 0; k < 8; ++k) { const float t = __shfl_up(x[k], d); if (lane >= d) x[k] += t; }
    }
    if (lane >= 56) { *(LAS f32x4*)(tmp + w * 64 + c8) = (f32x4){x[0], x[1], x[2], x[3]}; *(LAS f32x4*)(tmp + w * 64 + c8 + 4) = (f32x4){x[4], x[5], x[6], x[7]}; }
    __syncthreads();
    for (int ww = 0; ww < w; ++ww) { const f32x4 a0 = *(const LAS f32x4*)(tmp + ww * 64 + c8), a1 = *(const LAS f32x4*)(tmp + ww * 64 + c8 + 4);
        x[0] += a0.x; x[1] += a0.y; x[2] += a0.z; x[3] += a0.w; x[4] += a1.x; x[5] += a1.y; x[6] += a1.z; x[7] += a1.w; }
}

constexpr int RWP = 72;
constexpr int RWT = 64 * RWP;
constexpr size_t RWB_TILES = 4 * RWT * 2;
constexpr size_t RWB_DVEC = RWB_TILES;
constexpr size_t RWB_VS = RWB_DVEC + 256;
constexpr size_t RWB_BYTES = RWB_VS + 4 * 3 * 64 * 16 * 2;

__device__ __forceinline__ f32x4 mm64(const LAS bf16_t* A, const LAS bf16_t* Bt, int mt, int nt, int lane, f32x4 acc) {
    const LAS bf16_t* ap = A + (mt * 16 + (lane & 15)) * RWP + (lane >> 4) * 8;
    const LAS bf16_t* bp = Bt + (nt * 16 + (lane & 15)) * RWP + (lane >> 4) * 8;
#pragma unroll
    for (int k0 = 0; k0 < 64; k0 += 32)
        acc = __builtin_amdgcn_mfma_f32_16x16x32_bf16(*(const LAS bf16x8*)(ap + k0), *(const LAS bf16x8*)(bp + k0), acc, 0, 0, 0);
    return acc;
}
__device__ __forceinline__ void st_rowmajor(LAS bf16_t* T, int mt, int nt, int lane, const f32x4 v) {
    const int n = nt * 16 + (lane & 15), i0 = mt * 16 + (lane >> 4) * 4;
    T[(i0 + 0) * RWP + n] = f2bf(v.x); T[(i0 + 1) * RWP + n] = f2bf(v.y); T[(i0 + 2) * RWP + n] = f2bf(v.z); T[(i0 + 3) * RWP + n] = f2bf(v.w);
}
__device__ __forceinline__ void st_transposed(LAS bf16_t* T, int mt, int nt, int lane, const f32x4 v) {
    const int n = nt * 16 + (lane & 15), i0 = mt * 16 + (lane >> 4) * 4;
    *(LAS v2u*)(T + n * RWP + i0) = (v2u){pk2(v.x, v.y), pk2(v.z, v.w)};
}

__device__ __forceinline__ void rwkv_pa_chunk(const Args& a, Frame& F, int l, int ci) {
    const WsMap m = ws_map(NTOK);
    const int bh = ci >> 6, c = ci & 63, b = bh >> 3, h = bh & 7;
    const int lane = F.lane, w = F.wave, tid = F.tid;
    const int ch = h * 64 + lane;
    LAS bf16_t* At = (LAS bf16_t*)F.lds; LAS bf16_t* AtT = At + RWT; LAS bf16_t* Bt = AtT + RWT; LAS bf16_t* Kt = Bt + RWT; LAS bf16_t* KtGT = Kt + RWT;
    LAS bf16_t* Rt = KtGT + RWT; LAS bf16_t* VmT = Rt + RWT; LAS bf16_t* LAK = VmT + RWT;
    LAS bf16_t* X0 = LAK + RWT; LAS bf16_t* XT0 = X0 + RWT; LAS bf16_t* T0 = XT0 + RWT; LAS bf16_t* X1 = T0 + RWT; LAS bf16_t* XT1 = X1 + RWT; LAS bf16_t* T1 = XT1 + RWT;
    LAS float* LWL = (LAS float*)X0;
    LAS bf16_t* A2 = X1;
    LAS bf16_t* LVT = XT1;
    const bf16_t* zr = (const bf16_t*)(a.ws + m.zrkv); const bf16_t* ao = (const bf16_t*)(a.ws + m.auxo); const bf16_t* vr = (const bf16_t*)(a.ws + m.vres);
    float* vf = (float*)(a.ws + m.vfirst); bf16_t* bvo = (bf16_t*)(a.ws + m.rwbv);
    unsigned char* blob = a.ws + m.xn + (size_t)ci * RWB_BYTES;
    bf16_t* gW = (bf16_t*)blob; bf16_t* gQG = gW + RWT; bf16_t* gKGT = gQG + RWT; bf16_t* gA1 = gKGT + RWT;
    float* gDV = (float*)(blob + RWB_DVEC); bf16_t* gVS = (bf16_t*)(blob + RWB_VS);
    const int j = tid >> 3, c8 = (tid & 7) * 8, chb = h * 64 + c8;
    const size_t n = (size_t)b * TSEQ + c * 64 + j;
    float zr_[8], zk_[8], zv_[8], wp[8], ap[8];
    unpack8(ld8(zr + n * 1536 + chb), zr_); unpack8(ld8(zr + n * 1536 + 512 + chb), zk_); unpack8(ld8(zr + n * 1536 + 1024 + chb), zv_);
    unpack8(ld8(ao + n * 1792 + chb), wp); unpack8(ld8(ao + n * 1792 + 512 + chb), ap);
    float vres8[8], vf8[8];
    if (l > 0) { unpack8(ld8(vr + n * 512 + chb), vres8); const f32x4 f0 = *(const f32x4*)(vf + n * 512 + chb), f1 = *(const f32x4*)(vf + n * 512 + chb + 4);
        vf8[0] = f0.x; vf8[1] = f0.y; vf8[2] = f0.z; vf8[3] = f0.w; vf8[4] = f1.x; vf8[5] = f1.y; vf8[6] = f1.z; vf8[7] = f1.w; }
    float lw[8];
#pragma unroll
    for (int k = 0; k < 8; ++k) lw[k] = -__expf(-softplus_f(-wp[k]) - 0.5f);
    float cs[8];
#pragma unroll
    for (int k = 0; k < 8; ++k) cs[k] = lw[k];
    chunk_cumsum8(cs, LWL, lane, w, c8);
    {
        float pk_[8], pa_[8], pr_[8];
        { const float* p0 = a.in[I_RW_K_K] + l * 512 + chb; const float* p1 = a.in[I_RW_K_A] + l * 512 + chb; const float* p2 = a.in[I_RW_R_K] + l * 512 + chb;
          const f32x4 a0 = *(const f32x4*)p0, a1 = *(const f32x4*)(p0 + 4), b0 = *(const f32x4*)p1, b1 = *(const f32x4*)(p1 + 4), c0 = *(const f32x4*)p2, c1 = *(const f32x4*)(p2 + 4);
          pk_[0] = a0.x; pk_[1] = a0.y; pk_[2] = a0.z; pk_[3] = a0.w; pk_[4] = a1.x; pk_[5] = a1.y; pk_[6] = a1.z; pk_[7] = a1.w;
          pa_[0] = b0.x; pa_[1] = b0.y; pa_[2] = b0.z; pa_[3] = b0.w; pa_[4] = b1.x; pa_[5] = b1.y; pa_[6] = b1.z; pa_[7] = b1.w;
          pr_[0] = c0.x; pr_[1] = c0.y; pr_[2] = c0.z; pr_[3] = c0.w; pr_[4] = c1.x; pr_[5] = c1.y; pr_[6] = c1.z; pr_[7] = c1.w; }
        float v[8], aa[8], kk[8], km[8];
        float ss = 0.f, bs = 0.f;
#pragma unroll
        for (int k = 0; k < 8; ++k) {
            v[k] = (l == 0) ? zv_[k] : zv_[k] + (vf8[k] - zv_[k]) * sigm(vres8[k]);
            aa[k] = sigm(ap[k]);
            kk[k] = zk_[k] * pk_[k]; ss += kk[k] * kk[k];
            km[k] = zk_[k] * (1.0f + (aa[k] - 1.0f) * pa_[k]); bs += zr_[k] * km[k] * pr_[k];
        }
        if (l == 0) { *(f32x4*)(vf + n * 512 + chb) = (f32x4){zv_[0], zv_[1], zv_[2], zv_[3]}; *(f32x4*)(vf + n * 512 + chb + 4) = (f32x4){zv_[4], zv_[5], zv_[6], zv_[7]}; }
        ss = red8(ss); bs = red8(bs);
        const float kinv = 1.0f / sqrtf(fmaxf(ss, 1e-24f));
        float cm[8], gcv[8];
        {
#pragma unroll
          for (int k = 0; k < 8; ++k) gcv[k] = 0.f;
#pragma unroll
          for (int ww = 0; ww < 8; ++ww) { const f32x4 g0 = *(const LAS f32x4*)(LWL + ww * 64 + c8), g1 = *(const LAS f32x4*)(LWL + ww * 64 + c8 + 4);
              gcv[0] += g0.x; gcv[1] += g0.y; gcv[2] += g0.z; gcv[3] += g0.w; gcv[4] += g1.x; gcv[5] += g1.y; gcv[6] += g1.z; gcv[7] += g1.w; } }
#pragma unroll
        for (int k = 0; k < 8; ++k) cm[k] = cs[k] - lw[k];
        float t_at[8], t_bt[8], t_kt[8], t_rt[8], t_bv[8];
        LAS bf16_t* KGTl = T1;
#pragma unroll
        for (int k = 0; k < 8; ++k) {
            const float G = __expf(cs[k]), Gm1 = __expf(cm[k]), iG = __expf(-cs[k]), GcG = __expf(gcv[k] - cs[k]);
            const float kkn = kk[k] * kinv;
            const float av = -kkn, bv = kkn * aa[k];
            t_at[k] = av * Gm1; t_bt[k] = bv * iG; t_kt[k] = km[k] * iG; t_rt[k] = zr_[k] * G; t_bv[k] = bs * v[k];
            AtT[(c8 + k) * RWP + j] = f2bf(t_at[k]);
            KtGT[(c8 + k) * RWP + j] = f2bf(km[k] * GcG);
            VmT[(c8 + k) * RWP + j] = f2bf(v[k]);
            KGTl[(c8 + k) * RWP + j] = f2bf(bv * GcG);
        }
        *(LAS v4u*)(At + j * RWP + c8) = pack8(t_at); *(LAS v4u*)(Bt + j * RWP + c8) = pack8(t_bt); *(LAS v4u*)(Kt + j * RWP + c8) = pack8(t_kt);
        const v4u rt8 = pack8(t_rt);
        *(LAS v4u*)(Rt + j * RWP + c8) = rt8; *(v4u*)(gQG + j * RWP + c8) = rt8;
        *(v4u*)(bvo + n * 512 + chb) = pack8(t_bv);
        if (j == 63) { *(f32x4*)(gDV + c8) = (f32x4){__expf(gcv[0]), __expf(gcv[1]), __expf(gcv[2]), __expf(gcv[3])}; *(f32x4*)(gDV + c8 + 4) = (f32x4){__expf(gcv[4]), __expf(gcv[5]), __expf(gcv[6]), __expf(gcv[7])}; }
    }
    __syncthreads();
    {
        for (int o = tid; o < RWT / 8; o += NTHR) ((v4u*)gKGT)[o] = ((const LAS v4u*)T1)[o];
        f32x4 z4 = {0.f, 0.f, 0.f, 0.f};
#pragma unroll 1
        for (int tt = 0; tt < 2; ++tt) {
            const int t = w + 8 * tt, mt = t >> 2, nt = t & 3;
            const int n = nt * 16 + (lane & 15), i0 = mt * 16 + (lane >> 4) * 4;
            f32x4 lab = mm64(At, Bt, mt, nt, lane, z4), lak = mm64(At, Kt, mt, nt, lane, z4), a1 = mm64(Rt, Bt, mt, nt, lane, z4), a2 = mm64(Rt, Kt, mt, nt, lane, z4);
            f32x4 tt0;
#pragma unroll
            for (int e = 0; e < 4; ++e) { const int i = i0 + e;
                if (n >= i) { lab[e] = 0.f; lak[e] = 0.f; }
                if (n > i) { a1[e] = 0.f; a2[e] = 0.f; }
                tt0[e] = lab[e] + (n == i ? 1.0f : 0.f); }
            st_rowmajor(X0, mt, nt, lane, lab); st_transposed(XT0, mt, nt, lane, lab);
            st_rowmajor(T0, mt, nt, lane, tt0);
            st_rowmajor(LAK, mt, nt, lane, lak);
            st_rowmajor(A2, mt, nt, lane, a2);
            gA1[(i0 + 0) * RWP + n] = f2bf(a1.x); gA1[(i0 + 1) * RWP + n] = f2bf(a1.y); gA1[(i0 + 2) * RWP + n] = f2bf(a1.z); gA1[(i0 + 3) * RWP + n] = f2bf(a1.w);
        }
    }
    __syncthreads();
    {
        f32x4 z4 = {0.f, 0.f, 0.f, 0.f};
#pragma unroll 1
        for (int tt = 0; tt < 2; ++tt) {
            const int t = w + 8 * tt, mt = t >> 2, nt = t & 3;
            const int n = nt * 16 + (lane & 15), i0 = mt * 16 + (lane >> 4) * 4;
            const f32x4 lv = mm64(LAK, VmT, mt, nt, lane, z4), o0 = mm64(A2, VmT, mt, nt, lane, z4), kv0 = mm64(KtGT, VmT, mt, nt, lane, z4);
            st_transposed((LAS bf16_t*)(F.lds + 131584), mt, nt, lane, lv);
            bf16_t* go = gVS + (size_t)nt * 3 * 1024 + 1024;
            const int r = lane & 15;
            go[(i0 + 0) * 16 + r] = f2bf(o0.x); go[(i0 + 1) * 16 + r] = f2bf(o0.y); go[(i0 + 2) * 16 + r] = f2bf(o0.z); go[(i0 + 3) * 16 + r] = f2bf(o0.w);
            go[1024 + (i0 + 0) * 16 + r] = f2bf(kv0.x); go[1024 + (i0 + 1) * 16 + r] = f2bf(kv0.y); go[1024 + (i0 + 2) * 16 + r] = f2bf(kv0.z); go[1024 + (i0 + 3) * 16 + r] = f2bf(kv0.w);
            (void)n;
        }
    }
    __syncthreads();
    {
        LAS bf16_t* Xc = X0; LAS bf16_t* XTc = XT0; LAS bf16_t* Tc = T0; LAS bf16_t* Xn = X1; LAS bf16_t* XTn = XT1; LAS bf16_t* Tn = T1;
        f32x4 z4 = {0.f, 0.f, 0.f, 0.f};
#pragma unroll 1
        for (int it = 0; it < 5; ++it) {
#pragma unroll 1
            for (int tt = 0; tt < 2; ++tt) { const int t = w + 8 * tt, mt = t >> 2, nt = t & 3;
                const f32x4 x2 = mm64(Xc, XTc, mt, nt, lane, z4);
                st_rowmajor(Xn, mt, nt, lane, x2); st_transposed(XTn, mt, nt, lane, x2); }
            __syncthreads();
#pragma unroll 1
            for (int tt = 0; tt < 2; ++tt) { const int t = w + 8 * tt, mt = t >> 2, nt = t & 3;
                const int n = nt * 16 + (lane & 15), i0 = mt * 16 + (lane >> 4) * 4;
                f32x4 tc; tc.x = bf2f(Tc[(i0 + 0) * RWP + n]); tc.y = bf2f(Tc[(i0 + 1) * RWP + n]); tc.z = bf2f(Tc[(i0 + 2) * RWP + n]); tc.w = bf2f(Tc[(i0 + 3) * RWP + n]);
                const f32x4 tn = mm64(Tc, XTn, mt, nt, lane, tc);
                st_rowmajor(Tn, mt, nt, lane, tn); }
            __syncthreads();
            LAS bf16_t* s0 = Xc; Xc = Xn; Xn = s0; s0 = XTc; XTc = XTn; XTn = s0; s0 = Tc; Tc = Tn; Tn = s0;
        }
        LAS bf16_t* LVTp = (LAS bf16_t*)(F.lds + 131584);
#pragma unroll 1
        for (int tt = 0; tt < 2; ++tt) { const int t = w + 8 * tt, mt = t >> 2, nt = t & 3;
            const int n = nt * 16 + (lane & 15), i0 = mt * 16 + (lane >> 4) * 4, r = lane & 15;
            const f32x4 wt = mm64(Tc, AtT, mt, nt, lane, z4), u0 = mm64(Tc, LVTp, mt, nt, lane, z4);
            gW[(i0 + 0) * RWP + n] = f2bf(wt.x); gW[(i0 + 1) * RWP + n] = f2bf(wt.y); gW[(i0 + 2) * RWP + n] = f2bf(wt.z); gW[(i0 + 3) * RWP + n] = f2bf(wt.w);
            bf16_t* gu = gVS + (size_t)nt * 3 * 1024;
            gu[(i0 + 0) * 16 + r] = f2bf(u0.x); gu[(i0 + 1) * 16 + r] = f2bf(u0.y); gu[(i0 + 2) * 16 + r] = f2bf(u0.z); gu[(i0 + 3) * 16 + r] = f2bf(u0.w); }
    }
    __syncthreads();
    (void)LVT;
}

__device__ __forceinline__ void rwkv_ps_task(const Args& a, Frame& F, int task) {
    const WsMap m = ws_map(NTOK);
    const int bh = task >> 2, vs = task & 3, b = bh >> 3, h = bh & 7;
    const int lane = F.lane, w = F.wave, tid = F.tid;
    LAS bf16_t* LB = (LAS bf16_t*)F.lds;
    LAS bf16_t* ST = LB + 4 * RWT; LAS bf16_t* VNT = ST + 16 * RWP;
    bf16_t* yo = (bf16_t*)(a.ws + m.rwy);
    const unsigned char* blob0 = a.ws + m.xn + (size_t)(bh * 64) * RWB_BYTES;
    const int r = lane & 15, i0w = (w & 3) * 16 + (lane >> 4) * 4;
    f32x4 Sacc = {0.f, 0.f, 0.f, 0.f};
    for (int i = tid; i < 16 * RWP / 2; i += NTHR) ((LAS unsigned*)ST)[i] = 0u;
    v4u pre[5];
    auto prefetch = [&](int c) {
        const v4u* g = (const v4u*)(blob0 + (size_t)c * RWB_BYTES);
#pragma unroll
        for (int k = 0; k < 5; ++k) { const int o = k * 512 + tid; pre[k] = (o < (int)(RWB_TILES / 16)) ? g[o] : (v4u){0u, 0u, 0u, 0u}; }
    };
    auto commit = [&]() {
#pragma unroll
        for (int k = 0; k < 5; ++k) { const int o = k * 512 + tid; if (o < (int)(RWB_TILES / 16)) ((LAS v4u*)LB)[o] = pre[k]; }
    };
    bf16_t nfr[4], nkv[4]; float ndv[4];
    auto prefrag = [&](int c) {
        const unsigned char* blob = blob0 + (size_t)c * RWB_BYTES;
        const bf16_t* gvs = (const bf16_t*)(blob + RWB_VS) + (size_t)vs * 3 * 1024;
        const bf16_t* src = gvs + (w < 4 ? 0 : 1024);
#pragma unroll
        for (int e = 0; e < 4; ++e) nfr[e] = src[(i0w + e) * 16 + r];
        if (w < 4) { const float* gd = (const float*)(blob + RWB_DVEC);
#pragma unroll
            for (int e = 0; e < 4; ++e) { ndv[e] = gd[i0w + e]; nkv[e] = gvs[2048 + (i0w + e) * 16 + r]; } }
        else {
#pragma unroll
            for (int e = 0; e < 4; ++e) { ndv[e] = 1.f; nkv[e] = 0; } }
    };
    prefetch(0); commit(); prefetch(1); prefrag(0);
    for (int c = 0; c < 64; ++c) {
        float fr[4], dv[4], kv0[4];
#pragma unroll
        for (int e = 0; e < 4; ++e) { fr[e] = bf2f(nfr[e]); dv[e] = ndv[e]; kv0[e] = bf2f(nkv[e]); }
        if (c + 1 < 64) prefrag(c + 1);
        __syncthreads();
        if (w < 4) {
            f32x4 vn = mm64(LB, ST, w, 0, lane, (f32x4){fr[0], fr[1], fr[2], fr[3]});
            st_transposed(VNT, w, 0, lane, vn);
        }
        __syncthreads();
        if (w < 4) {
            const f32x4 base = {dv[0] * Sacc.x + kv0[0], dv[1] * Sacc.y + kv0[1], dv[2] * Sacc.z + kv0[2], dv[3] * Sacc.w + kv0[3]};
            Sacc = mm64(LB + 2 * RWT, VNT, w, 0, lane, base);
        } else {
            f32x4 o = mm64(LB + RWT, ST, w - 4, 0, lane, (f32x4){fr[0], fr[1], fr[2], fr[3]});
            o = mm64(LB + 3 * RWT, VNT, w - 4, 0, lane, o);
            const size_t n = (size_t)b * TSEQ + c * 64 + i0w;
            bf16_t* yp = yo + n * 512 + h * 64 + vs * 16 + r;
            yp[0] = f2bf(o.x); yp[512] = f2bf(o.y); yp[1024] = f2bf(o.z); yp[1536] = f2bf(o.w);
        }
        __syncthreads();
        if (w < 4) st_transposed(ST, w, 0, lane, Sacc);
        if (c + 1 < 64) commit();
        if (c + 2 < 64) prefetch(c + 2);
    }
    __syncthreads();
}

constexpr int GP = 136;
constexpr size_t GB_BYTES = 26880;
template <int KD, int PA_, int PB_>
__device__ __forceinline__ f32x4 mmx(const LAS bf16_t* A, const LAS bf16_t* Bt, int mt, int nt, int lane, f32x4 acc) {
    const LAS bf16_t* ap = A + (mt * 16 + (lane & 15)) * PA_ + (lane >> 4) * 8;
    const LAS bf16_t* bp = Bt + (nt * 16 + (lane & 15)) * PB_ + (lane >> 4) * 8;
#pragma unroll
    for (int k0 = 0; k0 < KD; k0 += 32)
        acc = __builtin_amdgcn_mfma_f32_16x16x32_bf16(*(const LAS bf16x8*)(ap + k0), *(const LAS bf16x8*)(bp + k0), acc, 0, 0, 0);
    return acc;
}
__device__ __forceinline__ void gdn_pa_chunk(const Args& a, Frame& F, int ci) {
    const WsMap m = ws_map(NTOK);
    const int bh = ci >> 6, c = ci & 63, b = bh >> 2, h = bh & 3;
    const int lane = F.lane, w = F.wave, tid = F.tid;
    LAS bf16_t* KB = (LAS bf16_t*)F.lds; LAS bf16_t* KH = KB + 64 * GP; LAS bf16_t* QH = KH + 64 * GP;
    LAS bf16_t* KBEt = KB; LAS bf16_t* VbT = KB + 128 * RWP;
    LAS bf16_t* X0 = QH + 64 * GP; LAS bf16_t* XT0 = X0 + RWT; LAS bf16_t* T0 = XT0 + RWT; LAS bf16_t* X1 = T0 + RWT; LAS bf16_t* XT1 = X1 + RWT; LAS bf16_t* T1 = XT1 + RWT;
    LAS float* GC = (LAS float*)(T1 + RWT);
    LAS bf16_t* KGTl = (LAS bf16_t*)(GC + 64);
    bf16_t* gq = (bf16_t*)(a.ws + m.gq); bf16_t* gk = (bf16_t*)(a.ws + m.gk); bf16_t* gv = (bf16_t*)(a.ws + m.gv); const float* gsc = (const float*)(a.ws + m.gsc);
    unsigned char* blob = a.ws + m.gblob + (size_t)ci * GB_BYTES;
    bf16_t* gA1 = (bf16_t*)blob; bf16_t* gW = gA1 + RWT; float* gGC = (float*)(blob + RWT * 2 + 64 * GP * 2);
    const int j = tid >> 3, c16 = (tid & 7) * 16;
    const size_t n0 = (size_t)b * TSEQ + c * 64, n = n0 + j;
    const float be = gsc[n * 8 + h];
    v4u kw[2], qw[2], vw[2];
    {
        float kf[8];
#pragma unroll
        for (int hh = 0; hh < 2; ++hh) {
            kw[hh] = ld8(gk + n * 512 + h * 128 + c16 + hh * 8); qw[hh] = ld8(gq + n * 512 + h * 128 + c16 + hh * 8); vw[hh] = ld8(gv + n * 512 + h * 128 + c16 + hh * 8);
            *(LAS v4u*)(KH + j * GP + c16 + hh * 8) = kw[hh]; *(LAS v4u*)(QH + j * GP + c16 + hh * 8) = qw[hh];
            unpack8(kw[hh], kf);
#pragma unroll
            for (int k = 0; k < 8; ++k) kf[k] *= be;
            *(LAS v4u*)(KB + j * GP + c16 + hh * 8) = pack8(kf);
        }
        if (w == 0) {
            float g = gsc[(n0 + lane) * 8 + 4 + h];
#pragma unroll
            for (int o = 1; o < 64; o <<= 1) { const float t = __shfl_up(g, o); if (lane >= o) g += t; }
            GC[lane] = g; gGC[lane] = g;
        }
    }
    __syncthreads();
    {
        const f32x4 z4 = {0.f, 0.f, 0.f, 0.f};
#pragma unroll 1
        for (int tt = 0; tt < 2; ++tt) {
            const int t = w + 8 * tt, mt = t >> 2, nt = t & 3;
            const int nn = nt * 16 + (lane & 15), i0 = mt * 16 + (lane >> 4) * 4;
            f32x4 kk = mmx<128, GP, GP>(KB, KH, mt, nt, lane, z4), qk = mmx<128, GP, GP>(QH, KH, mt, nt, lane, z4);
            const float gj = GC[nn];
            f32x4 x, t0;
#pragma unroll
            for (int e = 0; e < 4; ++e) { const int i = i0 + e; const float d = __expf(fminf(GC[i] - gj, 0.f));
                x[e] = (nn < i) ? -kk[e] * d : 0.f; qk[e] = (nn <= i) ? qk[e] * d : 0.f; t0[e] = x[e] + (nn == i ? 1.0f : 0.f); }
            st_rowmajor(X0, mt, nt, lane, x); st_transposed(XT0, mt, nt, lane, x); st_rowmajor(T0, mt, nt, lane, t0);
            gA1[(i0 + 0) * RWP + nn] = f2bf(qk.x); gA1[(i0 + 1) * RWP + nn] = f2bf(qk.y); gA1[(i0 + 2) * RWP + nn] = f2bf(qk.z); gA1[(i0 + 3) * RWP + nn] = f2bf(qk.w);
        }
    }
    __syncthreads();
    {
        const float gj = GC[j], eg = __expf(gj), s_kbe = be * eg, s_kg = __expf(GC[63] - gj);
        float f[8], o8[8];
#pragma unroll
        for (int hh = 0; hh < 2; ++hh) {
            unpack8(kw[hh], f);
#pragma unroll
            for (int k = 0; k < 8; ++k) { KBEt[(c16 + hh * 8 + k) * RWP + j] = f2bf(f[k] * s_kbe); KGTl[(c16 + hh * 8 + k) * RWP + j] = f2bf(f[k] * s_kg); }
            unpack8(vw[hh], f);
#pragma unroll
            for (int k = 0; k < 8; ++k) VbT[(c16 + hh * 8 + k) * RWP + j] = f2bf(f[k] * be);
            unpack8(qw[hh], f);
#pragma unroll
            for (int k = 0; k < 8; ++k) o8[k] = f[k] * eg;
            *(v4u*)(gq + n * 512 + h * 128 + c16 + hh * 8) = pack8(o8);
        }
    }
    const f32x4 z4 = {0.f, 0.f, 0.f, 0.f};
    LAS bf16_t* Xc = X0; LAS bf16_t* XTc = XT0; LAS bf16_t* Tc = T0; LAS bf16_t* Xn = X1; LAS bf16_t* XTn = XT1; LAS bf16_t* Tn = T1;
#pragma unroll 1
    for (int it = 0; it < 5; ++it) {
#pragma unroll 1
        for (int tt = 0; tt < 2; ++tt) { const int t = w + 8 * tt, mt = t >> 2, nt = t & 3;
            const f32x4 x2 = mm64(Xc, XTc, mt, nt, lane, z4);
            st_rowmajor(Xn, mt, nt, lane, x2); st_transposed(XTn, mt, nt, lane, x2); }
        __syncthreads();
#pragma unroll 1
        for (int tt = 0; tt < 2; ++tt) { const int t = w + 8 * tt, mt = t >> 2, nt = t & 3;
            const int nn = nt * 16 + (lane & 15), i0 = mt * 16 + (lane >> 4) * 4;
            f32x4 tc; tc.x = bf2f(Tc[(i0 + 0) * RWP + nn]); tc.y = bf2f(Tc[(i0 + 1) * RWP + nn]); tc.z = bf2f(Tc[(i0 + 2) * RWP + nn]); tc.w = bf2f(Tc[(i0 + 3) * RWP + nn]);
            const f32x4 tn = mm64(Tc, XTn, mt, nt, lane, tc);
            st_rowmajor(Tn, mt, nt, lane, tn); }
        __syncthreads();
        LAS bf16_t* s0 = Xc; Xc = Xn; Xn = s0; s0 = XTc; XTc = XTn; XTn = s0; s0 = Tc; Tc = Tn; Tn = s0;
    }
    {
#pragma unroll 1
        for (int tt = 0; tt < 4; ++tt) { const int mt = w, nt = tt;
            const f32x4 dw = mm64(KBEt, Tc, mt, nt, lane, z4), du = mm64(VbT, Tc, mt, nt, lane, z4);
            const int i = nt * 16 + (lane & 15), c0 = mt * 16 + (lane >> 4) * 4;
            *(v2u*)(gW + i * GP + c0) = (v2u){pk2(dw.x, dw.y), pk2(dw.z, dw.w)};
            *(v2u*)(gv + (n0 + i) * 512 + h * 128 + c0) = (v2u){pk2(du.x, du.y), pk2(du.z, du.w)}; }
        for (int p = tid; p < 1024; p += NTHR) { const int k = p >> 3, j8 = (p & 7) * 8;
            *(v4u*)(gk + (n0 + (k >> 1)) * 512 + h * 128 + (k & 1) * 64 + j8) = *(const LAS v4u*)(KGTl + k * RWP + j8); }
    }
    __syncthreads();
}

__device__ __forceinline__ void gdn_ps_task(const Args& a, Frame& F, int task) {
    const WsMap m = ws_map(NTOK);
    const int bh = task >> 3, vs = task & 7, b = bh >> 2, h = bh & 3;
    const int lane = F.lane, w = F.wave, tid = F.tid;
    LAS bf16_t* A1 = (LAS bf16_t*)F.lds; LAS bf16_t* WT = A1 + RWT; LAS float* GC = (LAS float*)(WT + 64 * GP);
    LAS bf16_t* QG = (LAS bf16_t*)(GC + 64); LAS bf16_t* KGT = QG + 64 * GP; LAS bf16_t* ST = KGT + 128 * RWP;
    LAS bf16_t* VNT = ST + 16 * GP; LAS bf16_t* UU = VNT + 16 * RWP;
    const bf16_t* gq = (const bf16_t*)(a.ws + m.gq); const bf16_t* gk = (const bf16_t*)(a.ws + m.gk); const bf16_t* gv = (const bf16_t*)(a.ws + m.gv);
    bf16_t* go = (bf16_t*)(a.ws + m.gdno);
    const unsigned char* blob0 = a.ws + m.gblob + (size_t)(bh * 64) * GB_BYTES;
    const int r = lane & 15, kq4 = (lane >> 4) * 4;
    f32x4 Sacc = {0.f, 0.f, 0.f, 0.f};
    for (int i = tid; i < 16 * GP / 2; i += NTHR) ((LAS unsigned*)ST)[i] = 0u;
    v4u pb_[4], pq_[2], pk_[2], pu_;
    auto prefetch = [&](int c) {
        const size_t n0 = (size_t)b * TSEQ + c * 64;
        const v4u* g = (const v4u*)(blob0 + (size_t)c * GB_BYTES);
#pragma unroll
        for (int k = 0; k < 4; ++k) { const int o = k * 512 + tid; pb_[k] = (o < (int)(GB_BYTES / 16)) ? g[o] : (v4u){0u, 0u, 0u, 0u}; }
#pragma unroll
        for (int k = 0; k < 2; ++k) { const int p = k * 512 + tid;
            pq_[k] = ld8(gq + (n0 + (p >> 4)) * 512 + h * 128 + (p & 15) * 8);
            pk_[k] = ld8(gk + (n0 + (p >> 4)) * 512 + h * 128 + (p & 15) * 8); }
        if (tid < 128) pu_ = ld8(gv + (n0 + (tid >> 1)) * 512 + h * 128 + vs * 16 + (tid & 1) * 8);
    };
    prefetch(0);
    for (int c = 0; c < 64; ++c) {
#pragma unroll
        for (int k = 0; k < 4; ++k) { const int o = k * 512 + tid; if (o < (int)(GB_BYTES / 16)) ((LAS v4u*)A1)[o] = pb_[k]; }
#pragma unroll
        for (int k = 0; k < 2; ++k) { const int p = k * 512 + tid;
            *(LAS v4u*)(QG + (p >> 4) * GP + (p & 15) * 8) = pq_[k];
            const int kk = 2 * (p >> 4) + ((p & 15) >> 3), j8 = (p & 7) * 8;
            *(LAS v4u*)(KGT + kk * RWP + j8) = pk_[k]; }
        if (tid < 128) *(LAS v4u*)(UU + (tid >> 1) * 16 + (tid & 1) * 8) = pu_;
        __syncthreads();
        if (c + 1 < 64) prefetch(c + 1);
        const float glast = __expf(GC[63]);
        if (w < 4) {
            const int i0 = w * 16 + kq4;
            f32x4 vn = mmx<128, GP, GP>(WT, ST, w, 0, lane, (f32x4){0.f, 0.f, 0.f, 0.f});
            vn.x = bf2f(UU[(i0 + 0) * 16 + r]) - vn.x; vn.y = bf2f(UU[(i0 + 1) * 16 + r]) - vn.y; vn.z = bf2f(UU[(i0 + 2) * 16 + r]) - vn.z; vn.w = bf2f(UU[(i0 + 3) * 16 + r]) - vn.w;
            st_transposed(VNT, w, 0, lane, vn);
        }
        __syncthreads();
        {
            const f32x4 base = {Sacc.x * glast, Sacc.y * glast, Sacc.z * glast, Sacc.w * glast};
            Sacc = mm64(KGT, VNT, w, 0, lane, base);
            if (w < 4) {
                f32x4 o = mmx<128, GP, GP>(QG, ST, w, 0, lane, (f32x4){0.f, 0.f, 0.f, 0.f});
                o = mm64(A1, VNT, w, 0, lane, o);
                const size_t n = (size_t)b * TSEQ + c * 64 + w * 16 + kq4;
                bf16_t* op = go + n * 512 + h * 128 + vs * 16 + r;
                op[0] = f2bf(o.x); op[512] = f2bf(o.y); op[1024] = f2bf(o.z); op[1536] = f2bf(o.w);
            }
        }
        __syncthreads();
        { const int k0 = w * 16 + kq4;
          *(LAS v2u*)(ST + r * GP + k0) = (v2u){pk2(Sacc.x, Sacc.y), pk2(Sacc.z, Sacc.w)}; }
    }
    __syncthreads();
}

__device__ __forceinline__ void gla_pa_chunk(const Args& a, Frame& F, int ci) {
    const WsMap m = ws_map(NTOK);
    const int bh = ci >> 6, c = ci & 63, b = bh >> 2, h = bh & 3;
    const int lane = F.lane, w = F.wave, tid = F.tid;
    LAS bf16_t* KS2T = (LAS bf16_t*)F.lds; LAS bf16_t* VT = KS2T + RWT; LAS float* TMP = (LAS float*)(VT + 128 * RWP);
    const bf16_t* p16 = (const bf16_t*)(a.ws + m.p16); const bf16_t* ao = (const bf16_t*)(a.ws + m.auxo);
    bf16_t* gKV = (bf16_t*)(a.ws + m.glao) + (size_t)ci * 8192; float* gDV = (float*)(a.ws + m.gladv) + (size_t)ci * 64;
    const int j = tid >> 3, c8 = (tid & 7) * 8, v16 = (tid & 7) * 16;
    const size_t n = (size_t)b * TSEQ + c * 64 + j;
    float k8[8], la[8];
    unpack8(ld8(p16 + n * PLD + C_GLA + 256 + h * 64 + c8), k8); unpack8(ld8(ao + n * 1792 + 1536 + h * 64 + c8), la);
    const v4u v0 = ld8(p16 + n * PLD + C_GLA + 512 + h * 128 + v16), v1 = ld8(p16 + n * PLD + C_GLA + 512 + h * 128 + v16 + 8);
#pragma unroll
    for (int k = 0; k < 8; ++k) la[k] = -softplus_f(-la[k]) * (1.0f / 16.0f);
    chunk_cumsum8(la, TMP, lane, w, c8);
    float bl[8];
#pragma unroll
    for (int k = 0; k < 8; ++k) bl[k] = 0.f;
#pragma unroll
    for (int ww = 0; ww < 8; ++ww) { const f32x4 y0 = *(const LAS f32x4*)(TMP + ww * 64 + c8), y1 = *(const LAS f32x4*)(TMP + ww * 64 + c8 + 4);
        bl[0] += y0.x; bl[1] += y0.y; bl[2] += y0.z; bl[3] += y0.w; bl[4] += y1.x; bl[5] += y1.y; bl[6] += y1.z; bl[7] += y1.w; }
#pragma unroll
    for (int k = 0; k < 8; ++k) KS2T[(c8 + k) * RWP + j] = f2bf(k8[k] * __expf(bl[k] - la[k]));
    { const unsigned vw[8] = {v0.x, v0.y, v0.z, v0.w, v1.x, v1.y, v1.z, v1.w};
#pragma unroll
      for (int e = 0; e < 8; ++e) { VT[(v16 + 2 * e) * RWP + j] = (bf16_t)(vw[e] & 0xffffu); VT[(v16 + 2 * e + 1) * RWP + j] = (bf16_t)(vw[e] >> 16); } }
    if (j == 0) { *(f32x4*)(gDV + c8) = (f32x4){__expf(bl[0]), __expf(bl[1]), __expf(bl[2]), __expf(bl[3])}; *(f32x4*)(gDV + c8 + 4) = (f32x4){__expf(bl[4]), __expf(bl[5]), __expf(bl[6]), __expf(bl[7])}; }
    __syncthreads();
    {
        const f32x4 z4 = {0.f, 0.f, 0.f, 0.f};
#pragma unroll
        for (int tt = 0; tt < 4; ++tt) { const int mt = tt, nt = w;
            const f32x4 d = mm64(KS2T, VT, mt, nt, lane, z4);
            const int dv = nt * 16 + (lane & 15), k0 = mt * 16 + (lane >> 4) * 4;
            *(v2u*)(gKV + dv * 64 + k0) = (v2u){pk2(d.x, d.y), pk2(d.z, d.w)}; }
    }
    __syncthreads();
}
__device__ __forceinline__ void gla_sscan(const Args& a, Frame& F) {
    const WsMap m = ws_map(NTOK);
    const bf16_t* gKV = (const bf16_t*)(a.ws + m.glao); const float* gDV = (const float*)(a.ws + m.gladv); bf16_t* gS = (bf16_t*)(a.ws + m.glas);
    for (int it = F.vcu * NTHR + F.tid; it < 16 * 8192; it += F.G * NTHR) {
        const int bh = it >> 13, e = it & 8191, k = e & 63;
        float S = 0.f;
#pragma unroll 1
        for (int c0 = 0; c0 < 64; c0 += 16) {
            float kv[16], dv[16];
#pragma unroll
            for (int u = 0; u < 16; ++u) { const size_t ci = (size_t)bh * 64 + c0 + u; kv[u] = bf2f(gKV[ci * 8192 + e]); dv[u] = gDV[ci * 64 + k]; }
#pragma unroll
            for (int u = 0; u < 16; ++u) { const size_t ci = (size_t)bh * 64 + c0 + u; gS[ci * 8192 + e] = f2bf(S); S = S * dv[u] + kv[u]; }
        }
    }
}
__device__ __forceinline__ void gla_pb_chunk(const Args& a, Frame& F, int l, int ci) {
    const WsMap m = ws_map(NTOK);
    const int bh = ci >> 6, c = ci & 63, b = bh >> 2, h = bh & 3;
    const int lane = F.lane, w = F.wave, tid = F.tid;
    LAS bf16_t* QS = (LAS bf16_t*)F.lds; LAS bf16_t* KS = QS + RWT; LAS bf16_t* QG = KS + RWT; LAS bf16_t* PM = QG + RWT;
    LAS bf16_t* VT = PM + RWT; LAS bf16_t* ST = VT + 128 * RWP; LAS bf16_t* GG = ST + 128 * RWP;
    LAS float* TMP = (LAS float*)(GG + 64 * GP); LAS float* OSS = TMP + 512;
    const bf16_t* p16 = (const bf16_t*)(a.ws + m.p16); const bf16_t* ao = (const bf16_t*)(a.ws + m.auxo);
    const bf16_t* gS = (const bf16_t*)(a.ws + m.glas) + (size_t)ci * 8192; bf16_t* mix = (bf16_t*)(a.ws + m.mix16);
    const int j = tid >> 3, c8 = (tid & 7) * 8, v16 = (tid & 7) * 16;
    const size_t n = (size_t)b * TSEQ + c * 64 + j;
    float q8[8], k8[8], la[8];
    unpack8(ld8(p16 + n * PLD + C_GLA + h * 64 + c8), q8); unpack8(ld8(p16 + n * PLD + C_GLA + 256 + h * 64 + c8), k8); unpack8(ld8(ao + n * 1792 + 1536 + h * 64 + c8), la);
    const v4u v0 = ld8(p16 + n * PLD + C_GLA + 512 + h * 128 + v16), v1 = ld8(p16 + n * PLD + C_GLA + 512 + h * 128 + v16 + 8);
    const v4u g0 = ld8(p16 + n * PLD + C_GLA + 1024 + h * 128 + v16), g1 = ld8(p16 + n * PLD + C_GLA + 1024 + h * 128 + v16 + 8);
    const v4u s0 = ((const v4u*)gS)[tid], s1 = ((const v4u*)gS)[512 + tid];
#pragma unroll
    for (int k = 0; k < 8; ++k) la[k] = -softplus_f(-la[k]) * (1.0f / 16.0f);
    chunk_cumsum8(la, TMP, lane, w, c8);
    {
        float br[8], t0[8], t1[8], t2[8];
#pragma unroll
        for (int k = 0; k < 8; ++k) br[k] = 0.f;
#pragma unroll
        for (int ww = 0; ww < 4; ++ww) { const f32x4 y0 = *(const LAS f32x4*)(TMP + ww * 64 + c8), y1 = *(const LAS f32x4*)(TMP + ww * 64 + c8 + 4);
            br[0] += y0.x; br[1] += y0.y; br[2] += y0.z; br[3] += y0.w; br[4] += y1.x; br[5] += y1.y; br[6] += y1.z; br[7] += y1.w; }
#pragma unroll
        for (int k = 0; k < 8; ++k) { const float qq = q8[k] * 0.125f;
            t0[k] = qq * __expf(la[k] - br[k]); t1[k] = k8[k] * __expf(br[k] - la[k]); t2[k] = qq * __expf(la[k]); }
        *(LAS v4u*)(QS + j * RWP + c8) = pack8(t0); *(LAS v4u*)(KS + j * RWP + c8) = pack8(t1); *(LAS v4u*)(QG + j * RWP + c8) = pack8(t2);
        const unsigned vw[8] = {v0.x, v0.y, v0.z, v0.w, v1.x, v1.y, v1.z, v1.w};
#pragma unroll
        for (int e = 0; e < 8; ++e) { VT[(v16 + 2 * e) * RWP + j] = (bf16_t)(vw[e] & 0xffffu); VT[(v16 + 2 * e + 1) * RWP + j] = (bf16_t)(vw[e] >> 16); }
        *(LAS v4u*)(GG + j * GP + v16) = g0; *(LAS v4u*)(GG + j * GP + v16 + 8) = g1;
        { const int p0 = tid, p1 = 512 + tid;
          *(LAS v4u*)(ST + (p0 >> 3) * RWP + (p0 & 7) * 8) = s0; *(LAS v4u*)(ST + (p1 >> 3) * RWP + (p1 & 7) * 8) = s1; }
    }
    __syncthreads();
    {
        const f32x4 z4 = {0.f, 0.f, 0.f, 0.f};
#pragma unroll
        for (int tt = 0; tt < 2; ++tt) { const int t = w + 8 * tt, mtj = t >> 2, nti = t & 3;
            f32x4 s4 = mm64(KS, QS, mtj, nti, lane, z4);
            const int i = nti * 16 + (lane & 15), j0 = mtj * 16 + (lane >> 4) * 4;
#pragma unroll
            for (int e = 0; e < 4; ++e) if (j0 + e > i) s4[e] = 0.f;
            st_transposed(PM, mtj, nti, lane, s4); }
    }
    __syncthreads();
    {
        const int mt = w >> 1, ntb = (w & 1) * 4, r = lane & 15, i0 = mt * 16 + (lane >> 4) * 4;
        f32x4 o[4]; float ss[4] = {0.f, 0.f, 0.f, 0.f};
#pragma unroll
        for (int t = 0; t < 4; ++t) { o[t] = mm64(QG, ST, mt, ntb + t, lane, (f32x4){0.f, 0.f, 0.f, 0.f}); o[t] = mm64(PM, VT, mt, ntb + t, lane, o[t]);
            ss[0] += o[t].x * o[t].x; ss[1] += o[t].y * o[t].y; ss[2] += o[t].z * o[t].z; ss[3] += o[t].w * o[t].w; }
#pragma unroll
        for (int e = 0; e < 4; ++e) ss[e] = row16_sum(ss[e]);
        if (r == 0) {
#pragma unroll
            for (int e = 0; e < 4; ++e) OSS[(i0 + e) * 2 + (w & 1)] = ss[e]; }
        __syncthreads();
        float rs[4];
#pragma unroll
        for (int e = 0; e < 4; ++e) rs[e] = 1.0f / sqrtf((OSS[(i0 + e) * 2] + OSS[(i0 + e) * 2 + 1]) * (1.0f / 128.0f) + 1e-6f);
        const size_t nrow = (size_t)b * TSEQ + c * 64 + i0;
#pragma unroll
        for (int t = 0; t < 4; ++t) { const int dv = (ntb + t) * 16 + r; const float gn = a.in[I_GLA_NORM][l * 128 + dv];
            const float ov[4] = {o[t].x, o[t].y, o[t].z, o[t].w};
#pragma unroll
            for (int e = 0; e < 4; ++e) { const float g = bf2f(GG[(i0 + e) * GP + dv]);
                mix[(nrow + e) * DM + 512 + h * 128 + dv] = f2bf(ov[e] * rs[e] * gn * (g * sigm(g))); } }
    }
    __syncthreads();
}

__device__ __forceinline__ void lru_pass(const Args& a, Frame& F, int l, bool passB) {
    const WsMap m = ws_map(NTOK);
    const bf16_t* gt = (const bf16_t*)(a.ws + m.gates); const bf16_t* xc = (const bf16_t*)(a.ws + m.xc); const bf16_t* p16 = (const bf16_t*)(a.ws + m.p16);
    bf16_t* mix = (bf16_t*)(a.ws + m.mix16); float* lrs = (float*)(a.ws + m.lrs);
    for (int it = F.vcu * NTHR + F.tid; it < NBATCH * 64 * 512; it += F.G * NTHR) {
        const int ch = it & 511, bc = it >> 9, c = bc & 63;
        const float sp8 = 8.0f * softplus_f(-a.in[I_LRU_LAM][l * 512 + ch]);
        const size_t nb = (size_t)bc * 64;
        float hh = 0.f, ap = 1.f;
        if (passB) {
            for (int s0 = 0; s0 < c; s0 += 8) { f32x2 su[8];
#pragma unroll
                for (int u = 0; u < 8; ++u) su[u] = (s0 + u < c) ? *(const f32x2*)(lrs + ((size_t)(bc - c + s0 + u) * 512 + ch) * 2) : (f32x2){1.f, 0.f};
#pragma unroll
                for (int u = 0; u < 8; ++u) hh = su[u].x * hh + su[u].y; } }
#pragma unroll 1
        for (int t0 = 0; t0 < 64; t0 += 8) {
            bf16_t rr[8], ii[8], xx[8], yy[8];
#pragma unroll
            for (int u = 0; u < 8; ++u) { const size_t n = nb + t0 + u; rr[u] = gt[n * 1024 + ch]; ii[u] = gt[n * 1024 + 512 + ch]; xx[u] = xc[n * 512 + ch];
                yy[u] = passB ? p16[n * PLD + C_LRU + 512 + ch] : (bf16_t)0; }
#pragma unroll
            for (int u = 0; u < 8; ++u) { const size_t n = nb + t0 + u;
                const float la = -sp8 * sigm(bf2f(rr[u]));
                const float av = __expf(la);
                const float uu = bf2f(xx[u]) * sigm(bf2f(ii[u])) * sqrtf(fmaxf(1.0f - av * av, 0.0f));
                hh = av * hh + uu; ap *= av;
                if (passB) mix[n * DM + 1024 + ch] = f2bf(hh * gelu_fast(bf2f(yy[u]))); }
        }
        if (!passB) *(f32x2*)(lrs + ((size_t)bc * 512 + ch) * 2) = (f32x2){ap, hh};
    }
}

__device__ __forceinline__ void scan_phase(const Args& a, Frame& F, int l) {
    lru_pass(a, F, l, false);
    const int task = blockIdx.x;
    for (int q = 0; q < 8; ++q) rwkv_pa_chunk(a, F, l, task * 8 + q);
    for (int q = 0; q < 4; ++q) gdn_pa_chunk(a, F, task * 4 + q);
    for (int q = 0; q < 4; ++q) gla_pa_chunk(a, F, task * 4 + q);
    if (l == 0) tables_range(a, F, (size_t)2 * NEXP * DM / 32, (size_t)4 * NEXP * DM / 32, F.vcu, F.G);
}

__device__ __forceinline__ void post_phase(const Args& a, Frame& F, int l, const XcdBarrier& bar) {
    const WsMap m = ws_map(NTOK);
    if (blockIdx.x < 128) rwkv_ps_task(a, F, blockIdx.x); else gdn_ps_task(a, F, blockIdx.x - 128);
    gla_sscan(a, F);
    lru_pass(a, F, l, true);
    const bf16_t* p16 = (const bf16_t*)(a.ws + m.p16); const bf16_t* glao = (const bf16_t*)(a.ws + m.glao); const bf16_t* gdno = (const bf16_t*)(a.ws + m.gdno);
    const bf16_t* rwy = (const bf16_t*)(a.ws + m.rwy); const bf16_t* rwbv = (const bf16_t*)(a.ws + m.rwbv); const bf16_t* ao = (const bf16_t*)(a.ws + m.auxo);
    bf16_t* mix = (bf16_t*)(a.ws + m.mix16);
    const int lane = F.lane, col = lane * 8, hc = col & 127;
    float gg[8], gd[8], lw[8], lb[8];
    { const f32x4 x0 = *(const f32x4*)(a.in[I_GLA_NORM] + l * 128 + hc), x1 = *(const f32x4*)(a.in[I_GLA_NORM] + l * 128 + hc + 4);
      gg[0] = x0.x; gg[1] = x0.y; gg[2] = x0.z; gg[3] = x0.w; gg[4] = x1.x; gg[5] = x1.y; gg[6] = x1.z; gg[7] = x1.w;
      const f32x4 y0 = *(const f32x4*)(a.in[I_GDN_NORM] + l * 128 + hc), y1 = *(const f32x4*)(a.in[I_GDN_NORM] + l * 128 + hc + 4);
      gd[0] = y0.x; gd[1] = y0.y; gd[2] = y0.z; gd[3] = y0.w; gd[4] = y1.x; gd[5] = y1.y; gd[6] = y1.z; gd[7] = y1.w;
      const f32x4 w0 = *(const f32x4*)(a.in[I_RW_LN_W] + l * 512 + col), w1 = *(const f32x4*)(a.in[I_RW_LN_W] + l * 512 + col + 4);
      lw[0] = w0.x; lw[1] = w0.y; lw[2] = w0.z; lw[3] = w0.w; lw[4] = w1.x; lw[5] = w1.y; lw[6] = w1.z; lw[7] = w1.w;
      const f32x4 b0 = *(const f32x4*)(a.in[I_RW_LN_B] + l * 512 + col), b1 = *(const f32x4*)(a.in[I_RW_LN_B] + l * 512 + col + 4);
      lb[0] = b0.x; lb[1] = b0.y; lb[2] = b0.z; lb[3] = b0.w; lb[4] = b1.x; lb[5] = b1.y; lb[6] = b1.z; lb[7] = b1.w; }
    for (int pass = 1; pass < 2; ++pass) {
    if (pass == 1) xcd_barrier(bar);
    for (int q = 0; q < 4; ++q) gla_pb_chunk(a, F, l, blockIdx.x * 4 + q);
    for (int n = F.gw; n < NTOK; n += F.ngw) {
        if (pass == 1) {
            float y[8], bv[8], g[8];
            unpack8(ld8(rwy + (size_t)n * 512 + col), y); unpack8(ld8(rwbv + (size_t)n * 512 + col), bv); unpack8(ld8(ao + (size_t)n * 1792 + 1024 + col), g);
            float s = 0.f;
#pragma unroll
            for (int k = 0; k < 8; ++k) s += y[k];
            const float mean = red8(s) * (1.0f / 64.0f);
            float s2 = 0.f;
#pragma unroll
            for (int k = 0; k < 8; ++k) { y[k] -= mean; s2 += y[k] * y[k]; }
            const float rs = 1.0f / sqrtf(red8(s2) * (1.0f / 64.0f) + 64e-5f);
#pragma unroll
            for (int k = 0; k < 8; ++k) y[k] = (y[k] * rs * lw[k] + lb[k] + bv[k]) * g[k];
            *(v4u*)(mix + (size_t)n * DM + col) = pack8(y);
        }
        if (pass == 1)
#pragma unroll
        for (int which = 1; which < 2; ++which) {
            float o[8], g[8];
            unpack8(ld8((which ? gdno : glao) + (size_t)n * 512 + col), o);
            unpack8(ld8(p16 + (size_t)n * PLD + (which ? C_GDN + 1536 : C_GLA + 1024) + col), g);
            float ss = 0.f;
#pragma unroll
            for (int k = 0; k < 8; ++k) ss += o[k] * o[k];
            ss = row16_sum(ss);
            const float rs = 1.0f / sqrtf(ss * (1.0f / 128.0f) + 1e-6f);
#pragma unroll
            for (int k = 0; k < 8; ++k) o[k] = o[k] * rs * (which ? gd[k] : gg[k]) * (g[k] * sigm(g[k]));
            *(v4u*)(mix + (size_t)n * DM + (which ? 1536 : 512) + col) = pack8(o);
        }
    }
    }
}

__device__ __forceinline__ void norm2_phase(const Args& a, Frame& F, int l) {
    const WsMap m = ws_map(NTOK);
    const float* gain = a.in[I_NORM_FFN] + l * DM;
    f32x4 gv[8];
#pragma unroll
    for (int j = 0; j < 8; ++j) gv[j] = ((const f32x4*)gain)[64 * j + F.lane];
    for (int n = F.gw; n < NTOK; n += F.ngw) {
        const f32x4* xr = (const f32x4*)(a.out + (size_t)n * DM) + F.lane;
        f32x4 v[8]; float s = 0.f;
#pragma unroll
        for (int j = 0; j < 8; ++j) { v[j] = xr[64 * j]; s += (v[j].x * v[j].x + v[j].y * v[j].y) + (v[j].z * v[j].z + v[j].w * v[j].w); }
        const float rstd = 1.0f / sqrtf(wave_sum_u(s) * (1.0f / DM) + 1e-6f);
        v2u* o8 = (v2u*)((bf16_t*)(a.ws + m.hb) + (size_t)n * DM) + F.lane;
        unsigned char* hq = a.ws + m.mix16 + (size_t)n * 2304;
#pragma unroll
        for (int j = 0; j < 8; ++j) {
            const float y0 = v[j].x * rstd * gv[j].x, y1 = v[j].y * rstd * gv[j].y, y2 = v[j].z * rstd * gv[j].z, y3 = v[j].w * rstd * gv[j].w;
            v2u w; w.x = pk2(y0, y1); w.y = pk2(y2, y3); o8[64 * j] = w;
            float am = __builtin_fmaxf(__builtin_fmaxf(__builtin_fabsf(y0), __builtin_fabsf(y1)), __builtin_fmaxf(__builtin_fabsf(y2), __builtin_fabsf(y3)));
            am = __builtin_fmaxf(am, dpp_f<0xB1>(am)); am = __builtin_fmaxf(am, dpp_f<0x4E>(am)); am = __builtin_fmaxf(am, dpp_f<0x141>(am)); am = __builtin_fmaxf(am, 1e-20f);
            const float xinv = 119.0f / am;
            const int q0 = (int)__builtin_rintf(y0 * xinv), q1 = (int)__builtin_rintf(y1 * xinv), q2 = (int)__builtin_rintf(y2 * xinv), q3 = (int)__builtin_rintf(y3 * xinv);
            const int h0 = (q0 + 8) >> 4, h1 = (q1 + 8) >> 4, h2 = (q2 + 8) >> 4, h3 = (q3 + 8) >> 4;
            const unsigned ph = ((unsigned)h0 & 15u) | (((unsigned)h1 & 15u) << 4) | (((unsigned)h2 & 15u) << 8) | (((unsigned)h3 & 15u) << 12);
            const unsigned pl = ((unsigned)(q0 - 16 * h0) & 15u) | (((unsigned)(q1 - 16 * h1) & 15u) << 4) | (((unsigned)(q2 - 16 * h2) & 15u) << 8) | (((unsigned)(q3 - 16 * h3) & 15u) << 12);
            *(unsigned short*)(hq + 128 * j + 2 * F.lane) = (unsigned short)ph;
            *(unsigned short*)(hq + 1024 + 128 * j + 2 * F.lane) = (unsigned short)pl;
            if ((F.lane & 7) == 0) *(float*)(hq + 2048 + 32 * j + 4 * (F.lane >> 3)) = am * (1.0f / 119.0f);
        }
    }
}

#define TK_CE(A, B) do { const float mx_ = fmaxf(A, B), mn_ = fminf(A, B); A = mx_; B = mn_; } while (0)
__device__ __forceinline__ void tk_sort16_desc(float (&x)[16]) {
#pragma unroll
    for (int k = 2; k <= 16; k <<= 1)
#pragma unroll
        for (int j = k >> 1; j > 0; j >>= 1)
#pragma unroll
            for (int i = 0; i < 16; ++i) { const int p = i ^ j;
                if (p > i) { if ((i & k) == 0) TK_CE(x[i], x[p]); else TK_CE(x[p], x[i]); } }
}
__device__ __forceinline__ void tk_merge16(float (&run)[16], const float (&g)[16]) {
#pragma unroll
    for (int i = 0; i < 16; ++i) run[i] = fmaxf(run[i], g[15 - i]);
#pragma unroll
    for (int j = 8; j > 0; j >>= 1)
#pragma unroll
        for (int i = 0; i < 16; ++i) { const int p = i ^ j; if (p > i) TK_CE(run[i], run[p]); }
}
__device__ __forceinline__ float tk_tag(float v, unsigned tag, unsigned mask) { return __builtin_bit_cast(float, (__builtin_bit_cast(unsigned, v) & ~mask) | tag); }
__device__ __forceinline__ void topk_phase(const Args& a, Frame& F, int l) {
    const WsMap m = ws_map(NTOK);
    const float* tsu = (const float*)(a.ws + m.tsc) + (size_t)l * 2 * NEXP; const float* tsv = tsu + NEXP; float* sug = (float*)(a.ws + m.act);
    const float* sc = (const float*)(a.ws + m.sc);
    int* idx = (int*)(a.ws + m.idx); float* gate = (float*)(a.ws + m.gate);
    LAS float* LS = (LAS float*)F.lds;
    const int t = F.tid;
    for (int wv = F.gw; wv < (NTOK / 64) * 8; wv += F.ngw) {
        const int h = wv & 7, n = (wv >> 3) * 64 + F.lane;
        const float* sp = sc + (size_t)(h * 256) * NTOK + n;
        float s0[16], s1[16];
#pragma unroll
        for (int half = 0; half < 2; ++half) {
            float run[16];
#pragma unroll
            for (int j = 0; j < 16; ++j) run[j] = -3.0e38f;
#pragma unroll 1
            for (int g = 0; g < 8; ++g) {
                float x[16];
#pragma unroll
                for (int k = 0; k < 16; ++k) x[k] = tk_tag(sp[(size_t)(half * 128 + g * 16 + k) * NTOK], (unsigned)(g * 16 + k), 127u);
                tk_sort16_desc(x);
                tk_merge16(run, x);
            }
#pragma unroll
            for (int j = 0; j < 16; ++j) { if (half) s1[j] = run[j]; else s0[j] = run[j]; LS[(half * 16 + j) * 512 + t] = run[j]; }
        }
        float run[16];
#pragma unroll
        for (int j = 0; j < 16; ++j) run[j] = -3.0e38f;
        {
            float x[16]; int cnt = 0;
#pragma unroll
            for (int p = 0; p < 16; ++p)
#pragma unroll
                for (int q = 0; q < 16; ++q) if ((p + 1) * (q + 1) <= 16) {
                    x[cnt & 15] = tk_tag(s0[p] + s1[q], (unsigned)(p * 16 + q), 255u); ++cnt;
                    if ((cnt & 15) == 0) { tk_sort16_desc(x); tk_merge16(run, x); }
                }
#pragma unroll
            for (int k = 0; k < 16; ++k) if (k >= (cnt & 15)) x[k] = -3.0e38f;
            tk_sort16_desc(x); tk_merge16(run, x);
        }
        const float mx = run[0]; float den = 0.f; float e[16]; int ti[16];
#pragma unroll
        for (int j = 0; j < 16; ++j) {
            const unsigned tg = __builtin_bit_cast(unsigned, run[j]) & 255u; const int p = (int)(tg >> 4), q = (int)(tg & 15u);
            const unsigned k0 = __builtin_bit_cast(unsigned, LS[(0 * 16 + p) * 512 + t]) & 127u, k1 = __builtin_bit_cast(unsigned, LS[(1 * 16 + q) * 512 + t]) & 127u;
            ti[j] = (int)(k0 * 128u + k1);
            e[j] = __expf(run[j] - mx); den += e[j];
        }
        const float inv = 1.0f / den;
        const size_t it = (size_t)n * 8 + h;
        float su[16];
#pragma unroll
        for (int j = 0; j < 16; ++j) { su[j] = tsu[ti[j]]; e[j] *= tsv[ti[j]]; }
        f32x4* go = (f32x4*)(gate + it * 16); v4u* io = (v4u*)(idx + it * 16); f32x4* so = (f32x4*)(sug + it * 16);
#pragma unroll
        for (int j = 0; j < 4; ++j) { go[j] = (f32x4){e[4 * j] * inv, e[4 * j + 1] * inv, e[4 * j + 2] * inv, e[4 * j + 3] * inv};
            so[j] = (f32x4){su[4 * j], su[4 * j + 1], su[4 * j + 2], su[4 * j + 3]};
            io[j] = (v4u){(unsigned)ti[4 * j], (unsigned)ti[4 * j + 1], (unsigned)ti[4 * j + 2], (unsigned)ti[4 * j + 3]}; }
    }
}

typedef float f32x2_t __attribute__((ext_vector_type(2)));
typedef int v4i __attribute__((ext_vector_type(4)));
struct PeerSplit { int ng, g, nwg, w0; };
__device__ __forceinline__ PeerSplit peer_split(const Frame& F) {
    PeerSplit p; p.ng = F.G < 8 ? F.G : 8; p.g = (int)blockIdx.x % p.ng; p.nwg = (F.G - p.g + p.ng - 1) / p.ng; p.w0 = ((int)blockIdx.x / p.ng) * NWAVES + F.wave; return p;
}
__device__ __forceinline__ float xl32(float v, int lane) { return __builtin_bit_cast(float, __builtin_amdgcn_ds_bpermute((lane ^ 32) << 2, __builtin_bit_cast(int, v))); }
constexpr int PU_CH = 8, PV_CH = 4;
constexpr int PU_WB = 12288, PV_WB = 8320;
__device__ __forceinline__ void fmac(float& acc, float x, float y) { asm("v_fmac_f32 %0, %1, %2" : "+v"(acc) : "v"(x), "v"(y)); }
template <int B> __device__ __forceinline__ float code_f(unsigned w) { return __builtin_bit_cast(float, __builtin_amdgcn_perm(w, 0x3Fu, 0x00040C0Cu + ((unsigned)B << 16))); }
__device__ __forceinline__ void lds_ld16(const LAS unsigned char* p, int (&e)[16]) {
#pragma unroll
    for (int k = 0; k < 4; ++k) { const v4u t = ((const LAS v4u*)p)[k]; e[4 * k] = (int)t.x; e[4 * k + 1] = (int)t.y; e[4 * k + 2] = (int)t.z; e[4 * k + 3] = (int)t.w; }
}
__device__ __forceinline__ void peer_u_phase(const Args& a, Frame& F, int l) {
    const WsMap m = ws_map(NTOK);
    const PeerSplit ps = peer_split(F);
    const int lane = F.lane, r = lane >> 3, q = lane & 7;
    const int* idx = (const int*)(a.ws + m.idx);
    float* dpart = (float*)(a.ws + m.dpart);
    const int stride = ps.nwg * NWAVES;
    if (ps.w0 >= NTOK) return;
    const int nt = (NTOK - 1 - ps.w0) / stride + 1;
    LAS unsigned char* wb = F.lds + F.wave * PU_WB;
    for (int s = ps.g; s < 8; s += ps.ng) {
        const unsigned char* TU = (const unsigned char*)(a.ws + m.tabu) + ((size_t)(l * 2) * 8 + s) * NEXP * TSL + q * 16;
        const unsigned char* hqs = a.ws + m.mix16 + 128 * s;
#pragma unroll 1
        for (int tb = 0; tb < nt; tb += PU_CH) {
            const int cnt = nt - tb < PU_CH ? nt - tb : PU_CH;
#pragma unroll
            for (int k = 0; k < PU_CH / 2; ++k) {
                const int j = 2 * k + (lane >> 5); const int n = ps.w0 + (tb + (j < cnt ? j : cnt - 1)) * stride;
                const v4u ev = *(const v4u*)(idx + (size_t)n * 128 + (lane & 31) * 4);
                *(LAS v4u*)(wb + j * 512 + (lane & 31) * 16) = ev; }
            { const int j = lane >> 3; const unsigned char* hn = hqs + (size_t)(ps.w0 + (tb + (j < cnt ? j : cnt - 1)) * stride) * 2304;
              const v4u xh = *(const v4u*)(hn + 16 * q), xl = *(const v4u*)(hn + 1024 + 16 * q); const float sc = *(const float*)(hn + 2048 - 96 * s + 4 * q);
              *(LAS v4u*)(wb + 4096 + lane * 16) = xh; *(LAS v4u*)(wb + 5120 + lane * 16) = xl; *(LAS float*)(wb + 6144 + lane * 4) = sc; }
            int ec[16]; v4u row[8];
            lds_ld16(wb + r * 64, ec);
#pragma unroll
            for (int i = 0; i < 8; ++i) row[i] = *(const v4u*)(TU + (size_t)ec[i] * TSL);
#pragma unroll 1
            for (int j = 0; j < cnt; ++j) {
                int en[16];
                lds_ld16(wb + (j + 1 < cnt ? j + 1 : j) * 512 + r * 64, en);
                const v4u xh = *(const LAS v4u*)(wb + 4096 + j * 128 + q * 16), xl = *(const LAS v4u*)(wb + 5120 + j * 128 + q * 16);
                const float xscale = *(const LAS float*)(wb + 6144 + j * 32 + q * 4);
                int sh = 0, sl = 0;
#pragma unroll
                for (int d = 0; d < 4; ++d) { sh = __builtin_amdgcn_sdot8((int)xh[d], 0x11111111, sh, false); sl = __builtin_amdgcn_sdot8((int)xl[d], 0x11111111, sl, false); }
                const float xoff = 0.5f * (float)(16 * sh + sl);
                float k0 = 0.f, k1 = 0.f;
#pragma unroll
                for (int hf = 0; hf < 2; ++hf)
#pragma unroll
                for (int i = 0; i < 8; ++i) {
                    int ia = 0, ib = 0;
#pragma unroll
                    for (int d = 0; d < 4; ++d) { ia = __builtin_amdgcn_sdot8((int)row[i][d], (int)xh[d], ia, false); ib = __builtin_amdgcn_sdot8((int)row[i][d], (int)xl[d], ib, false); }
                    row[i] = *(const v4u*)(TU + (size_t)(hf ? en[i] : ec[8 + i]) * TSL);
                    __builtin_amdgcn_sched_barrier(0);
                    const float tt = red8(((float)(16 * ia + ib) + xoff) * xscale);
                    const int ri = 8 * hf + i;
                    if (ri & 1) k1 = (q == (ri >> 1)) ? tt : k1; else k0 = (q == (ri >> 1)) ? tt : k0;
                }
                ((LAS f32x2_t*)(wb + 8192))[j * 64 + lane] = (f32x2_t){k0, k1};
#pragma unroll
                for (int i = 0; i < 16; ++i) ec[i] = en[i];
            }
#pragma unroll 1
            for (int j = 0; j < cnt; ++j) *(f32x2_t*)(dpart + ((size_t)s * NTOK + (ps.w0 + (tb + j) * stride)) * 128 + 16 * r + 2 * q) = ((LAS f32x2_t*)(wb + 8192))[j * 64 + lane];
            __builtin_amdgcn_s_waitcnt(0);
        }
    }
}
__device__ __forceinline__ void peer_c_phase(const Args& a, Frame& F) {
    const WsMap m = ws_map(NTOK);
    float* gate = (float*)(a.ws + m.gate); const float* sug = (const float*)(a.ws + m.act); const float* dpart = (const float*)(a.ws + m.dpart);
    for (int n = F.gw; n < NTOK; n += F.ngw) {
        const size_t j0 = (size_t)n * 128 + 2 * F.lane;
        f32x2_t dp[8];
#pragma unroll
        for (int sp = 0; sp < 8; ++sp) dp[sp] = *(const f32x2_t*)(dpart + (size_t)sp * NTOK * 128 + j0);
        const f32x2_t gt = *(const f32x2_t*)(gate + j0), su = *(const f32x2_t*)(sug + j0);
        const f32x2_t d = ((dp[0] + dp[1]) + (dp[2] + dp[3])) + ((dp[4] + dp[5]) + (dp[6] + dp[7]));
        *(f32x2_t*)(gate + j0) = (f32x2_t){gelu_fast(d.x * su.x) * gt.x, gelu_fast(d.y * su.y) * gt.y};
    }
}
__device__ __forceinline__ void peer_v_phase(const Args& a, Frame& F, int l) {
    const WsMap m = ws_map(NTOK);
    const PeerSplit ps = peer_split(F);
    const int lane = F.lane, r = lane >> 3, q = lane & 7;
    const int* idx = (const int*)(a.ws + m.idx); const float* coef = (const float*)(a.ws + m.gate);
    float* ssq = (float*)(a.ws + m.ssq);
    const bool b3 = (lane & 8) != 0, b4 = (lane & 16) != 0, b5 = (lane & 32) != 0;
    const int c0 = (b3 ? 16 : 0) + (b4 ? 8 : 0) + (b5 ? 4 : 0);
    const int stride = ps.nwg * NWAVES;
    if (ps.w0 >= NTOK) return;
    const int nt = (NTOK - 1 - ps.w0) / stride + 1;
    LAS unsigned char* wb = F.lds + F.wave * PV_WB;
    for (int s = ps.g; s < 8; s += ps.ng) {
        const unsigned char* TV = (const unsigned char*)(a.ws + m.tabu) + ((size_t)(l * 2 + 1) * 8 + s) * NEXP * TSL + q * 16;
#pragma unroll 1
        for (int tb = 0; tb < nt; tb += PV_CH) {
            const int cnt = nt - tb < PV_CH ? nt - tb : PV_CH;
#pragma unroll
            for (int k = 0; k < PV_CH / 2; ++k) {
                const int j = 2 * k + (lane >> 5); const int n = ps.w0 + (tb + (j < cnt ? j : cnt - 1)) * stride;
                const v4u ev = *(const v4u*)(idx + (size_t)n * 128 + (lane & 31) * 4);
                const v4u cv = *(const v4u*)(coef + (size_t)n * 128 + (lane & 31) * 4);
                *(LAS v4u*)(wb + j * 512 + (lane & 31) * 16) = ev;
                *(LAS v4u*)(wb + 2048 + j * 512 + (lane & 31) * 16) = cv; }
#pragma unroll
            for (int j = 0; j < PV_CH; ++j) { const int n = ps.w0 + (tb + (j < cnt ? j : cnt - 1)) * stride;
                *(LAS f32x4*)(wb + 4096 + j * 1024 + lane * 16) = *(const f32x4*)(a.out + (size_t)n * DM + 256 * s + lane * 4); }
            int ec[16]; v4u row[8];
            lds_ld16(wb + r * 64, ec);
#pragma unroll
            for (int i = 0; i < 8; ++i) row[i] = *(const v4u*)(TV + (size_t)ec[i] * TSL);
#pragma unroll 1
            for (int j = 0; j < cnt; ++j) {
                int en[16];
                lds_ld16(wb + (j + 1 < cnt ? j + 1 : j) * 512 + r * 64, en);
                float ci[16];
#pragma unroll
                for (int k = 0; k < 4; ++k) { const f32x4 t = ((const LAS f32x4*)(wb + 2048 + j * 512 + r * 64))[k]; ci[4 * k] = t.x; ci[4 * k + 1] = t.y; ci[4 * k + 2] = t.z; ci[4 * k + 3] = t.w; }
                const f32x4 x4 = *(const LAS f32x4*)(wb + 4096 + j * 1024 + (32 * q + c0) * 4);
                f32x2_t o2[16];
#pragma unroll
                for (int i = 0; i < 16; ++i) o2[i] = (f32x2_t){0.f, 0.f};
#pragma unroll
                for (int hf = 0; hf < 2; ++hf)
#pragma unroll
                for (int i = 0; i < 8; ++i) {
                    const f32x2_t c2 = {ci[8 * hf + i], ci[8 * hf + i]};
#pragma unroll
                    for (int d = 0; d < 4; ++d) {
                        o2[4 * d + 0] = __builtin_elementwise_fma(__builtin_amdgcn_cvt_scalef32_pk_f32_fp4(row[i][d], 1.0f, 0), c2, o2[4 * d + 0]);
                        o2[4 * d + 1] = __builtin_elementwise_fma(__builtin_amdgcn_cvt_scalef32_pk_f32_fp4(row[i][d], 1.0f, 1), c2, o2[4 * d + 1]);
                        o2[4 * d + 2] = __builtin_elementwise_fma(__builtin_amdgcn_cvt_scalef32_pk_f32_fp4(row[i][d], 1.0f, 2), c2, o2[4 * d + 2]);
                        o2[4 * d + 3] = __builtin_elementwise_fma(__builtin_amdgcn_cvt_scalef32_pk_f32_fp4(row[i][d], 1.0f, 3), c2, o2[4 * d + 3]); }
                    row[i] = *(const v4u*)(TV + (size_t)(hf ? en[i] : ec[8 + i]) * TSL);
                    __builtin_amdgcn_sched_barrier(0);
                }
                float h[16];
#pragma unroll
                for (int p = 0; p < 8; ++p) {
                    const float kx = b3 ? o2[p + 8].x : o2[p].x, sx = b3 ? o2[p].x : o2[p + 8].x, ky = b3 ? o2[p + 8].y : o2[p].y, sy = b3 ? o2[p].y : o2[p + 8].y;
                    h[2 * p] = kx + dpp_f<0x128>(sx); h[2 * p + 1] = ky + dpp_f<0x128>(sy); }
                float h2[8];
#pragma unroll
                for (int p = 0; p < 8; ++p) { const float kk = b4 ? h[p + 8] : h[p], ss = b4 ? h[p] : h[p + 8]; h2[p] = kk + swz16(ss); }
                float h3[4];
#pragma unroll
                for (int p = 0; p < 4; ++p) { const float kk = b5 ? h2[p + 4] : h2[p], ss = b5 ? h2[p] : h2[p + 4]; h3[p] = kk + xl32(ss, lane); }
                const f32x4 o = {x4.x + h3[0], x4.y + h3[1], x4.z + h3[2], x4.w + h3[3]};
                *(LAS f32x4*)(wb + 4096 + j * 1024 + (32 * q + c0) * 4) = o;
                const float tot = wave_sum_u((o.x * o.x + o.y * o.y) + (o.z * o.z + o.w * o.w));
                if (lane == 0) ((LAS float*)(wb + 8192))[j] = tot;
#pragma unroll
                for (int i = 0; i < 16; ++i) ec[i] = en[i];
            }
#pragma unroll 1
            for (int j = 0; j < cnt; ++j) { const int n = ps.w0 + (tb + j) * stride; const size_t off = (size_t)n * DM + 256 * s + lane * 4;
                const f32x4 o = *(const LAS f32x4*)(wb + 4096 + j * 1024 + lane * 16);
                *(f32x4*)(a.out + off) = o;
                if (l + 1 < NL) { v2u w; w.x = pk2(o.x, o.y); w.y = pk2(o.z, o.w); *(v2u*)((bf16_t*)(a.ws + m.xn) + off) = w; }
                if (lane == 0) ssq[(size_t)n * 8 + s] = ((const LAS float*)(wb + 8192))[j]; }
            __builtin_amdgcn_s_waitcnt(0);
        }
    }
}
__device__ __forceinline__ void fnorm_phase(const Args& a, Frame& F) {
    const WsMap m = ws_map(NTOK);
    const float* ssq = (const float*)(a.ws + m.ssq);
    const int lane = F.lane;
    for (int n = F.gw; n < NTOK; n += F.ngw) {
        const f32x4 s0 = *(const f32x4*)(ssq + (size_t)n * 8), s1 = *(const f32x4*)(ssq + (size_t)n * 8 + 4);
        const float rstd = 1.0f / sqrtf((((s0.x + s0.y) + (s0.z + s0.w)) + ((s1.x + s1.y) + (s1.z + s1.w))) * (1.0f / DM) + 1e-6f);
        float* xrow = a.out + (size_t)n * DM;
        const float* gf = a.in[I_NORM_FINAL];
        f32x4 v[8];
#pragma unroll
        for (int k = 0; k < 8; ++k) v[k] = *(const f32x4*)(xrow + 256 * k + 4 * lane);
#pragma unroll
        for (int k = 0; k < 8; ++k) { const f32x4 g4 = *(const f32x4*)(gf + 256 * k + 4 * lane);
            *(f32x4*)(xrow + 256 * k + 4 * lane) = (f32x4){v[k].x * rstd * g4.x, v[k].y * rstd * g4.y, v[k].z * rstd * g4.z, v[k].w * rstd * g4.w}; }
    }
}

#define IN(k) (lo <= (k) && (k) < hi)
#define SEAM(k) do { if (IN(k) && IN((k) + 1)) xcd_barrier(bar); } while (0)
template <int l>
__device__ __forceinline__ void layer_phases(const Args& a, Frame& F, const XcdBarrier& bar, const WsMap& m, int lo, int hi) {
    constexpr int pb = l * PH_PER_LAYER;
        if (IN(pb + PH_GEMM1)) {
            pg8::GemmX g{(const bf16_t*)(a.ws + m.xn), (const bf16_t*)(a.ws + m.w1t) + (size_t)l * PLD * DM, NTOK, PLD, DM, DM};
            pg8::StaticOrder S; S.init(NTOK, PLD, F.G, (int)blockIdx.x);
            pg8::EpiBf16 E{(bf16_t*)(a.ws + m.p16), PLD, nullptr, l > 0 ? (const float*)(a.ws + m.ssq) : nullptr};
            pg8::gemm_phase<pg8::EpiBf16, pg8::StaticOrder, true, true>(F.lds, g, S, E);
            SEAM(pb + PH_GEMM1);
        }
        if (IN(pb + PH_PREP)) { prep_phase(a, F, l); SEAM(pb + PH_PREP); }
        if (IN(pb + PH_AUX)) {
            const float* PP = (const float*)(a.ws + m.pp);
            { pg8::GemmX g{(const bf16_t*)(a.ws + m.auxA), (const bf16_t*)(a.ws + m.auxwt) + (size_t)l * 1792 * 384, NTOK, 1792, 384, 384};
              pg8::StaticOrder S; S.init(NTOK, 1792, F.G, (int)blockIdx.x);
              pg8::EpiBf16 E{(bf16_t*)(a.ws + m.auxo), 1792, PP + l * 1792};
              pg8::gemm_phase<pg8::EpiBf16, pg8::StaticOrder, true, true>(F.lds, g, S, E); }
            { pg8::GemmX g{(const bf16_t*)(a.ws + m.xc), (const bf16_t*)(a.ws + m.lruwt) + (size_t)l * 1024 * 512, NTOK, 1024, 512, 512};
              pg8::StaticOrder S; S.init(NTOK, 1024, F.G, (int)blockIdx.x);
              pg8::EpiBf16 E{(bf16_t*)(a.ws + m.gates), 1024, PP + 3584 + l * 1024};
              pg8::gemm_phase<pg8::EpiBf16, pg8::StaticOrder, true, true>(F.lds, g, S, E); }
            if (l > 0) {
              pg8::GemmX g{(const bf16_t*)(a.ws + m.zrkv) + 1024, (const bf16_t*)(a.ws + m.vreswt), NTOK, 512, 512, 1536};
              pg8::StaticOrder S; S.init(NTOK, 512, F.G, (int)blockIdx.x);
              pg8::EpiBf16 E{(bf16_t*)(a.ws + m.vres), 512, PP + 5632};
              pg8::gemm_phase<pg8::EpiBf16, pg8::StaticOrder, true, true>(F.lds, g, S, E); }
            SEAM(pb + PH_AUX);
        }
        if (IN(pb + PH_SCAN)) { scan_phase(a, F, l); SEAM(pb + PH_SCAN); }
        if (IN(pb + PH_POST)) { post_phase(a, F, l, bar); SEAM(pb + PH_POST); }
        if (IN(pb + PH_GEMM2)) {
            pg8::GemmX g{(const bf16_t*)(a.ws + m.mix16), (const bf16_t*)(a.ws + m.w2t) + (size_t)l * DM * DM, NTOK, DM, DM, DM};
            pg8::StaticOrder S; S.init(NTOK, DM, F.G, (int)blockIdx.x);
            pg8::EpiF32<true> E{a.out, DM};
            pg8::gemm_phase<pg8::EpiF32<true>, pg8::StaticOrder, true, true>(F.lds, g, S, E);
            SEAM(pb + PH_GEMM2);
        }
        if (IN(pb + PH_NORM2)) { norm2_phase(a, F, l); SEAM(pb + PH_NORM2); }
        if (IN(pb + PH_GEMM3)) {
            pg8::GemmX g{(const bf16_t*)(a.ws + m.wsct) + (size_t)l * DM * DM, (const bf16_t*)(a.ws + m.hb), DM, NTOK, DM, DM};
            pg8::StaticOrder S; S.init(DM, NTOK, F.G, (int)blockIdx.x);
            pg8::EpiF32<false> E{(float*)(a.ws + m.sc), NTOK};
            pg8::gemm_phase<pg8::EpiF32<false>, pg8::StaticOrder, true, true>(F.lds, g, S, E);
            SEAM(pb + PH_GEMM3);
        }
        if (IN(pb + PH_TOPK)) { topk_phase(a, F, l); SEAM(pb + PH_TOPK); }
        if (IN(pb + PH_PEERU)) { peer_u_phase(a, F, l); SEAM(pb + PH_PEERU); }
        if (IN(pb + PH_PEERC)) { peer_c_phase(a, F); SEAM(pb + PH_PEERC); }
        if (IN(pb + PH_PEERV)) { peer_v_phase(a, F, l); SEAM(pb + PH_PEERV); }
}

#undef IN
#undef SEAM
__global__ void __launch_bounds__(NTHR, 2) mega(Args a) {
    extern __shared__ __attribute__((aligned(16))) unsigned char lds_raw[];
    Frame F;
    F.lds = (LAS unsigned char*)lds_raw;
    F.tid = threadIdx.x; F.lane = F.tid & 63; F.wave = __builtin_amdgcn_readfirstlane(F.tid >> 6);
    F.G = gridDim.x; { const int bx = blockIdx.x; F.vcu = (F.G % 8 == 0) ? (bx % 8) * (F.G / 8) + bx / 8 : bx; }
    F.gw = F.vcu * NWAVES + F.wave; F.ngw = F.G * NWAVES;
    volatile LAS unsigned* MISC = (volatile LAS unsigned*)(F.lds + MISC_OFF);
    if (F.tid < 32) MISC[F.tid] = 0u;
    __syncthreads();
    const WsMap m = ws_map(NTOK);
    unsigned* ctl = (unsigned*)(a.ws + m.ctl);
    XcdBarrier bar; bar.bar = ctl + 4096 + a.li * XCD_BAR_WORDS; bar.x = 0; bar.st = nullptr;
    const int lo = a.ph_lo, hi = a.ph_hi;
    if (hi - lo > 1) bar = xcd_barrier_post(ctl + 4096 + a.li * XCD_BAR_WORDS, MISC + 8);
#define IN(k) (lo <= (k) && (k) < hi)
#define SEAM(k) do { if (IN(k) && IN((k) + 1)) xcd_barrier(bar); } while (0)
    if (IN(PH_P0)) { p0_prologue(a, F); tables_range(a, F, 0, (size_t)2 * NEXP * DM / 32, F.vcu, F.G); SEAM(PH_P0); }
    layer_phases<0>(a, F, bar, m, lo, hi);
    layer_phases<1>(a, F, bar, m, lo, hi);
    if (IN(PH_FNORM)) fnorm_phase(a, F);
#undef IN
#undef SEAM
}

template <int ST>
__global__ void __launch_bounds__(256) stage_kernel(Params P, int l) {
    const long n = stage_items(P, ST, l);
    for (long it = blockIdx.x * 256L + threadIdx.x; it < n; it += gridDim.x * 256L) run_item(P, ST, l, it);
}
template <int ST>
static void launch_stage(const Params& P, int l, hipStream_t stream) {
    const long n = stage_items(P, ST, l);
    if (n <= 0) return;
    long blocks = (n + 255) / 256;
    if (blocks > 8192) blocks = 8192;
    stage_kernel<ST><<<dim3((unsigned)blocks), dim3(256), 0, stream>>>(P, l);
}
#define LS(X) case X: launch_stage<X>(P, l, stream); break;
static void launch_any(int st, const Params& P, int l, hipStream_t stream) {
    switch (st) {
        LS(ST_COPYX) LS(ST_RSTD) LS(ST_NORM1) LS(ST_GEMM1) LS(ST_RW_A0) LS(ST_RW_A1) LS(ST_RW_A2) LS(ST_RW_A3) LS(ST_RW_KKN)
        LS(ST_RW_SCAN) LS(ST_RW_POST) LS(ST_GLA_B0) LS(ST_GLA_SCAN) LS(ST_GLA_POST) LS(ST_LRU_C0) LS(ST_LRU_C1) LS(ST_LRU_SCAN)
        LS(ST_GDN_D0) LS(ST_GDN_D1) LS(ST_GDN_SCAN) LS(ST_GDN_POST) LS(ST_GEMM2) LS(ST_RSTD2) LS(ST_NORM2) LS(ST_GEMM3)
        LS(ST_SCORES) LS(ST_TOPK1) LS(ST_TOPK2) LS(ST_PEER_U) LS(ST_PEER_V) LS(ST_FRSTD) LS(ST_FNORM)
    }
}

extern "C" void kernel_launch(void* const* d_in, const int* in_sizes, int n_in, void* d_out, int out_size, void* d_ws,
                              size_t ws_size, hipStream_t stream) {
    static int grid = 0;
    if (grid == 0) {
        int dev = 0, cus = 0;
        (void)hipGetDevice(&dev);
        (void)hipDeviceGetAttribute(&cus, hipDeviceAttributeMultiprocessorCount, dev);
        (void)hipFuncSetAttribute((const void*)mega, hipFuncAttributeMaxDynamicSharedMemorySize, LDS_BYTES);
        grid = cus > 0 ? cus : 256;
    }
    Params P;
    memset(&P, 0, sizeof(P));
    fill_inputs(P, d_in);
    P.B = 4; P.T = 4096; P.N = 16384; P.pad = 0;
    P.xcur = (float*)d_out;
    bind_ws(P, (char*)d_ws);
    Args a;
    memset(&a, 0, sizeof(a));
    for (int i = 0; i < 38; ++i) a.in[i] = (const float*)d_in[i];
    a.out = (float*)d_out; a.ws = (unsigned char*)d_ws;
    (void)hipMemsetAsync(d_ws, 0, 1u << 20, stream);
    int li = 0;
    auto run_mega = [&](int lo, int hi) { a.ph_lo = lo; a.ph_hi = hi; a.li = li++; hipLaunchKernelGGL(mega, dim3(grid), dim3(NTHR), LDS_BYTES, stream, a); };
    run_mega(PH_P0, PH_TOTAL);
}
#endif
```

```cpp
#ifndef HOST_EMU
#include <hip/hip_runtime.h>
#include <cstring>
#define HD __host__ __device__ __forceinline__
#else
#include <cmath>
#include <cstdio>
#include <cstdlib>
#include <cstring>
#define HD inline
#endif

constexpr int DM = 2048;
constexpr int NL = 2;
constexpr int INC = 6424;
constexpr int C_RW = 0;
constexpr int C_GLA = 1792;
constexpr int C_LRU = 3344;
constexpr int C_GDN = 4368;
constexpr int NEXP = 16384;

typedef unsigned short bf16_t;
constexpr int PLD = 6656;
HD float bf2f(bf16_t h) { unsigned u = (unsigned)h << 16; float f; memcpy(&f, &u, 4); return f; }
HD bf16_t f2bf(float f) { unsigned u; memcpy(&u, &f, 4); return (bf16_t)((u + 0x7fffu + ((u >> 16) & 1u)) >> 16); }

struct Params {
    const float *x, *norm_mix, *w_in, *w_out, *rw_mu, *rw_w0, *rw_w_up, *rw_a0, *rw_a_up, *rw_g_up, *rw_k_k, *rw_k_a,
        *rw_r_k, *rw_ln_w, *rw_ln_b, *rw_v0, *rw_v_down, *rw_v_up, *gla_a_up, *gla_a_bias, *gla_norm, *lru_conv_w,
        *lru_conv_b, *lru_w_r, *lru_b_r, *lru_w_i, *lru_b_i, *lru_lam, *gdn_conv_w, *gdn_a_log, *gdn_dt_bias, *gdn_norm,
        *norm_ffn, *peer_wq, *peer_sub_keys, *peer_u, *peer_v, *norm_final;
    float* xcur;
    bf16_t* xn;
    bf16_t* hb;
    bf16_t* mix16;
    bf16_t* p16;
    float* sc;
    float* qf;
    float* rstd;
    float* vfirst;
    float* scr;
    float* act;
    float* gate;
    int* idx;
    int B, T, N, pad;
};

HD float sigmoidf_(float x) { return 1.0f / (1.0f + expf(-x)); }
HD float softplusf_(float x) { return log1pf(expf(-fabsf(x))) + fmaxf(x, 0.0f); }
HD float siluf_(float x) { return x * sigmoidf_(x); }
HD float geluf_(float x) { return 0.5f * x * (1.0f + tanhf(0.7978845608028654f * (x + 0.044715f * x * x * x))); }

enum Stage {
    ST_COPYX = 0,
    ST_RSTD, ST_NORM1, ST_GEMM1,
    ST_RW_A0, ST_RW_A1, ST_RW_A2, ST_RW_A3, ST_RW_KKN, ST_RW_SCAN, ST_RW_POST,
    ST_GLA_B0, ST_GLA_SCAN, ST_GLA_POST,
    ST_LRU_C0, ST_LRU_C1, ST_LRU_SCAN,
    ST_GDN_D0, ST_GDN_D1, ST_GDN_SCAN, ST_GDN_POST,
    ST_GEMM2, ST_RSTD2, ST_NORM2, ST_GEMM3, ST_SCORES, ST_TOPK1, ST_TOPK2, ST_PEER_U, ST_PEER_V,
    ST_FRSTD, ST_FNORM,
    ST_COUNT
};

constexpr long SO_ZS = 0, SO_R = 256, SO_DEC = 768, SO_KM = 1280, SO_KK = 1792, SO_A = 2304, SO_G = 2816, SO_V = 3328,
               SO_Y = 3840, SO_VD = 4352, SO_KKINV = 4384;
constexpr long SO_ALPHA = 0, SO_GO = 256;
constexpr long SO_XC = 0, SO_LA = 512, SO_LU = 1024;
constexpr long SO_QKV = 0, SO_GS = 1536, SO_DO = 1552;
constexpr long SCR_PER_TOK = 4400;
constexpr long SO_TS = 0, SO_TI = 256;

HD long stage_items(const Params& P, int st, int l) {
    const long N = P.N;
    switch (st) {
        case ST_COPYX: return N * DM;
        case ST_RSTD: case ST_RSTD2: case ST_FRSTD: return N;
        case ST_NORM1: case ST_NORM2: case ST_FNORM: return N * DM;
        case ST_GEMM1: return (N / 4) * (INC / 4);
        case ST_RW_A0: return N * 256;
        case ST_RW_A1: return N * 512;
        case ST_RW_A2: return l > 0 ? N * 32 : 0;
        case ST_RW_A3: return l > 0 ? N * 512 : 0;
        case ST_RW_KKN: return N * 8;
        case ST_RW_SCAN: return (long)P.B * 512;
        case ST_RW_POST: return N * 8;
        case ST_GLA_B0: return N * 256;
        case ST_GLA_SCAN: return (long)P.B * 512;
        case ST_GLA_POST: return N * 4;
        case ST_LRU_C0: return N * 512;
        case ST_LRU_C1: return N * 512;
        case ST_LRU_SCAN: return (long)P.B * 512;
        case ST_GDN_D0: return N * 1536;
        case ST_GDN_D1: return N * 4;
        case ST_GDN_SCAN: return (long)P.B * 512;
        case ST_GDN_POST: return N * 4;
        case ST_GEMM2: case ST_GEMM3: return (N / 4) * (DM / 4);
        case ST_SCORES: return N * 2048;
        case ST_TOPK1: return N * 16;
        case ST_TOPK2: return N * 8;
        case ST_PEER_U: return N * 128;
        case ST_PEER_V: return N * DM;
    }
    return 0;
}

HD void gemm_item(const bf16_t* A, const float* W, int ldw, const float* kscale, float* Cf, bf16_t* Ch, int ldc, int n4, long item, int mode) {
    const long r4 = item / n4;
    const int c4 = (int)(item % n4);
    const bf16_t* a0 = A + (r4 * 4) * (long)DM;
    const float* w = W + c4 * 4;
    float acc[4][4];
    for (int i = 0; i < 4; ++i)
        for (int j = 0; j < 4; ++j) acc[i][j] = 0.f;
    for (int k = 0; k < DM; ++k) {
        const float ks = kscale ? kscale[k] : 1.0f;
        const float w0 = w[(long)k * ldw + 0] * ks, w1 = w[(long)k * ldw + 1] * ks, w2 = w[(long)k * ldw + 2] * ks, w3 = w[(long)k * ldw + 3] * ks;
#pragma unroll
        for (int i = 0; i < 4; ++i) {
            const float a = bf2f(a0[(long)i * DM + k]);
            acc[i][0] += a * w0; acc[i][1] += a * w1; acc[i][2] += a * w2; acc[i][3] += a * w3;
        }
    }
#pragma unroll
    for (int i = 0; i < 4; ++i) {
        const long o = (r4 * 4 + i) * (long)ldc + c4 * 4;
#pragma unroll
        for (int j = 0; j < 4; ++j) {
            if (mode == 0) Ch[o + j] = f2bf(acc[i][j]);
            else if (mode == 1) Cf[o + j] += acc[i][j];
            else Cf[o + j] = acc[i][j];
        }
    }
}

#define PF(n, col) bf2f(P.p16[(long)(n) * PLD + (col)])
HD float rw_shift(const Params& P, int l, long n, int col) {
    const int t = (int)(n % P.T);
    const float cur = PF(n, C_RW + col);
    const float prev = t > 0 ? PF(n - 1, C_RW + col) : 0.f;
    return cur + (prev - cur) * P.rw_mu[l * 1792 + col];
}

HD void run_item(const Params& P, int st, int l, long it) {
    const long N = P.N;
    float* scr = P.scr;
    switch (st) {
        case ST_COPYX: P.xcur[it] = P.x[it]; break;
        case ST_RSTD: case ST_RSTD2: case ST_FRSTD: {
            const float* xr = P.xcur + it * DM;
            float s = 0.f;
            for (int d = 0; d < DM; ++d) s += xr[d] * xr[d];
            P.rstd[it] = 1.0f / sqrtf(s * (1.0f / DM) + 1e-6f);
        } break;
        case ST_NORM1: case ST_NORM2: case ST_FNORM: {
            const long n = it / DM; const int d = (int)(it % DM);
            if (st == ST_NORM1) P.xn[it] = f2bf(P.xcur[it] * P.rstd[n]);
            else if (st == ST_NORM2) P.hb[it] = f2bf(P.xcur[it] * P.rstd[n] * P.norm_ffn[l * DM + d]);
            else P.xcur[it] = P.xcur[it] * P.rstd[n] * P.norm_final[d];
        } break;
        case ST_GEMM1: gemm_item(P.xn, P.w_in + (long)l * DM * INC, INC, P.norm_mix + l * DM, nullptr, P.p16, PLD, INC / 4, it, 0); break;
        case ST_GEMM2: gemm_item(P.mix16, P.w_out + (long)l * DM * DM, DM, nullptr, P.xcur, nullptr, DM, DM / 4, it, 1); break;
        case ST_GEMM3: gemm_item(P.hb, P.peer_wq + (long)l * DM * DM, DM, nullptr, P.qf, nullptr, DM, DM / 4, it, 2); break;
        case ST_RW_A0: {
            const long n = it / 256; const int c = (int)(it % 256);
            const float z = rw_shift(P, l, n, 1536 + c);
            scr[N * SO_ZS + it] = c < 64 ? tanhf(z) : (c < 128 ? z : sigmoidf_(z));
        } break;
        case ST_RW_A1: {
            const long n = it / 512; const int j = (int)(it % 512);
            const float zr = rw_shift(P, l, n, j), zk = rw_shift(P, l, n, 512 + j), zv = rw_shift(P, l, n, 1024 + j);
            const float* zs = scr + N * SO_ZS + n * 256;
            float aw = P.rw_w0[l * 512 + j], aa = P.rw_a0[l * 512 + j], ag = 0.f;
            const float* wu = P.rw_w_up + (long)l * 64 * 512 + j;
            const float* au = P.rw_a_up + (long)l * 64 * 512 + j;
            const float* gu = P.rw_g_up + (long)l * 128 * 512 + j;
            for (int i = 0; i < 64; ++i) { aw += zs[i] * wu[i * 512]; aa += zs[64 + i] * au[i * 512]; }
            for (int i = 0; i < 128; ++i) ag += zs[128 + i] * gu[i * 512];
            const float w_raw = -softplusf_(-aw) - 0.5f;
            const float a = sigmoidf_(aa);
            scr[N * SO_R + it] = zr;
            scr[N * SO_DEC + it] = expf(-expf(w_raw));
            scr[N * SO_KM + it] = zk * (1.0f + (a - 1.0f) * P.rw_k_a[l * 512 + j]);
            scr[N * SO_KK + it] = zk * P.rw_k_k[l * 512 + j];
            scr[N * SO_A + it] = a;
            scr[N * SO_G + it] = ag;
            scr[N * SO_V + it] = zv;
            if (l == 0) P.vfirst[it] = zv;
        } break;
        case ST_RW_A2: {
            const long n = it / 32; const int i = (int)(it % 32);
            const float* v = scr + N * SO_V + n * 512;
            const float* vdn = P.rw_v_down + (long)(l - 1) * 512 * 32 + i;
            float s = 0.f;
            for (int j = 0; j < 512; ++j) s += v[j] * vdn[j * 32];
            scr[N * SO_VD + it] = s;
        } break;
        case ST_RW_A3: {
            const long n = it / 512; const int j = (int)(it % 512);
            const float* vd = scr + N * SO_VD + n * 32;
            const float* vup = P.rw_v_up + (long)(l - 1) * 32 * 512 + j;
            float s = P.rw_v0[(l - 1) * 512 + j];
            for (int i = 0; i < 32; ++i) s += vd[i] * vup[i * 512];
            const float v = scr[N * SO_V + it];
            scr[N * SO_V + it] = v + (P.vfirst[it] - v) * sigmoidf_(s);
        } break;
        case ST_RW_KKN: {
            const float* kk = scr + N * SO_KK + it * 64;
            float s = 0.f;
            for (int i = 0; i < 64; ++i) s += kk[i] * kk[i];
            scr[N * SO_KKINV + it] = 1.0f / sqrtf(fmaxf(s, 1e-24f));
        } break;
        case ST_RW_SCAN: {
            const int b = (int)(it / 512); const int h = (int)((it % 512) / 64); const int v = (int)(it % 64);
            float S[64];
#pragma unroll
            for (int i = 0; i < 64; ++i) S[i] = 0.f;
            for (int t = 0; t < P.T; ++t) {
                const long n = (long)b * P.T + t;
                const long base = n * 512 + h * 64;
                const float inv = scr[N * SO_KKINV + n * 8 + h];
                const float vv = scr[N * SO_V + base + v];
                const float* KK = scr + N * SO_KK + base;
                const float* DEC = scr + N * SO_DEC + base;
                const float* KM = scr + N * SO_KM + base;
                const float* AA = scr + N * SO_A + base;
                const float* RR = scr + N * SO_R + base;
                float sa = 0.f;
#pragma unroll
                for (int i = 0; i < 64; ++i) sa += S[i] * (-KK[i] * inv);
                float y = 0.f;
#pragma unroll
                for (int i = 0; i < 64; ++i) {
                    const float kk = KK[i] * inv;
                    S[i] = S[i] * DEC[i] + sa * (kk * AA[i]) + vv * KM[i];
                    y += S[i] * RR[i];
                }
                scr[N * SO_Y + base + v] = y;
            }
        } break;
        case ST_RW_POST: {
            const long n = it / 8; const int h = (int)(it % 8);
            const long base = n * 512 + h * 64;
            const float* Y = scr + N * SO_Y + base;
            const float* RR = scr + N * SO_R + base;
            const float* KM = scr + N * SO_KM + base;
            const float* V = scr + N * SO_V + base;
            const float* G = scr + N * SO_G + base;
            float mean = 0.f, bon = 0.f;
            for (int i = 0; i < 64; ++i) { mean += Y[i]; bon += RR[i] * KM[i] * P.rw_r_k[l * 512 + h * 64 + i]; }
            mean *= (1.0f / 64);
            float var = 0.f;
            for (int i = 0; i < 64; ++i) { const float d = Y[i] - mean; var += d * d; }
            const float rs = 1.0f / sqrtf(var * (1.0f / 64) + 64e-5f);
            for (int i = 0; i < 64; ++i) {
                const int c = h * 64 + i;
                const float yn = (Y[i] - mean) * rs * P.rw_ln_w[l * 512 + c] + P.rw_ln_b[l * 512 + c];
                P.mix16[n * DM + c] = f2bf((yn + bon * V[i]) * G[i]);
            }
        } break;
        case ST_GLA_B0: {
            const long n = it / 256; const int c = (int)(it % 256);
            float s = P.gla_a_bias[l * 256 + c];
            for (int i = 0; i < 16; ++i) s += PF(n, C_GLA + 1536 + i) * P.gla_a_up[(long)l * 16 * 256 + i * 256 + c];
            scr[N * SO_ALPHA + it] = expf(-softplusf_(-s) * (1.0f / 16.0f));
        } break;
        case ST_GLA_SCAN: {
            const int b = (int)(it / 512); const int h = (int)((it % 512) / 128); const int v = (int)(it % 128);
            float S[64];
#pragma unroll
            for (int i = 0; i < 64; ++i) S[i] = 0.f;
            for (int t = 0; t < P.T; ++t) {
                const long n = (long)b * P.T + t;
                const bf16_t* q = P.p16 + n * PLD + C_GLA + h * 64;
                const bf16_t* k = q + 256;
                const float vv = PF(n, C_GLA + 512 + h * 128 + v);
                const float* al = scr + N * SO_ALPHA + n * 256 + h * 64;
                float o = 0.f;
#pragma unroll
                for (int i = 0; i < 64; ++i) {
                    S[i] = S[i] * al[i] + bf2f(k[i]) * vv;
                    o += bf2f(q[i]) * S[i];
                }
                scr[N * SO_GO + n * 512 + h * 128 + v] = o * 0.125f;
            }
        } break;
        case ST_GLA_POST: {
            const long n = it / 4; const int h = (int)(it % 4);
            const float* o = scr + N * SO_GO + n * 512 + h * 128;
            float ms = 0.f;
            for (int i = 0; i < 128; ++i) ms += o[i] * o[i];
            const float rs = 1.0f / sqrtf(ms * (1.0f / 128) + 1e-6f);
            for (int i = 0; i < 128; ++i) {
                const float g = PF(n, C_GLA + 1024 + h * 128 + i);
                P.mix16[n * DM + 512 + h * 128 + i] = f2bf(o[i] * rs * P.gla_norm[l * 128 + i] * siluf_(g));
            }
        } break;
        case ST_LRU_C0: {
            const long n = it / 512; const int c = (int)(it % 512);
            const int t = (int)(n % P.T);
            float s = P.lru_conv_b[l * 512 + c];
            for (int j = 0; j < 4; ++j) {
                const int tt = t - 3 + j;
                if (tt >= 0) s += P.lru_conv_w[(long)l * 4 * 512 + j * 512 + c] * PF(n - 3 + j, C_LRU + c);
            }
            scr[N * SO_XC + it] = s;
        } break;
        case ST_LRU_C1: {
            const long n = it / 512; const int c = (int)(it % 512);
            const int blk = c / 64, j = c % 64;
            const float* xc = scr + N * SO_XC + n * 512 + blk * 64;
            const float* wr = P.lru_w_r + (long)l * 8 * 64 * 64 + (long)blk * 64 * 64 + j;
            const float* wi = P.lru_w_i + (long)l * 8 * 64 * 64 + (long)blk * 64 * 64 + j;
            float sr = P.lru_b_r[l * 512 + c], si = P.lru_b_i[l * 512 + c];
            for (int i = 0; i < 64; ++i) { sr += xc[i] * wr[i * 64]; si += xc[i] * wi[i * 64]; }
            const float r = sigmoidf_(sr), ig = sigmoidf_(si);
            const float log_a = -8.0f * r * softplusf_(-P.lru_lam[l * 512 + c]);
            scr[N * SO_LA + it] = expf(log_a);
            scr[N * SO_LU + it] = scr[N * SO_XC + it] * ig * sqrtf(-expm1f(2.0f * log_a));
        } break;
        case ST_LRU_SCAN: {
            const int b = (int)(it / 512); const int c = (int)(it % 512);
            float hst = 0.f;
            for (int t = 0; t < P.T; ++t) {
                const long n = (long)b * P.T + t;
                hst = scr[N * SO_LA + n * 512 + c] * hst + scr[N * SO_LU + n * 512 + c];
                P.mix16[n * DM + 1024 + c] = f2bf(hst * geluf_(PF(n, C_LRU + 512 + c)));
            }
        } break;
        case ST_GDN_D0: {
            const long n = it / 1536; const int c = (int)(it % 1536);
            const int t = (int)(n % P.T);
            float s = 0.f;
            for (int j = 0; j < 4; ++j) {
                const int tt = t - 3 + j;
                if (tt >= 0) s += P.gdn_conv_w[(long)l * 4 * 1536 + j * 1536 + c] * PF(n - 3 + j, C_GDN + c);
            }
            scr[N * SO_QKV + it] = siluf_(s);
        } break;
        case ST_GDN_D1: {
            const long n = it / 4; const int h = (int)(it % 4);
            const float* q = scr + N * SO_QKV + n * 1536 + h * 128;
            const float* k = q + 512;
            float qs = 0.f, ks = 0.f;
            for (int i = 0; i < 128; ++i) { qs += q[i] * q[i]; ks += k[i] * k[i]; }
            float* gs = scr + N * SO_GS + n * 16 + h * 4;
            gs[0] = (1.0f / sqrtf(qs + 1e-6f)) * 0.08838834764831845f;
            gs[1] = 1.0f / sqrtf(ks + 1e-6f);
            gs[2] = sigmoidf_(PF(n, C_GDN + 2048 + h));
            gs[3] = expf(-expf(P.gdn_a_log[l * 4 + h]) * softplusf_(PF(n, C_GDN + 2052 + h) + P.gdn_dt_bias[l * 4 + h]));
        } break;
        case ST_GDN_SCAN: {
            const int b = (int)(it / 512); const int h = (int)((it % 512) / 128); const int v = (int)(it % 128);
            float S[128];
#pragma unroll
            for (int i = 0; i < 128; ++i) S[i] = 0.f;
            for (int t = 0; t < P.T; ++t) {
                const long n = (long)b * P.T + t;
                const float* q = scr + N * SO_QKV + n * 1536 + h * 128;
                const float* k = q + 512;
                const float vv = scr[N * SO_QKV + n * 1536 + 1024 + h * 128 + v];
                const float* gs = scr + N * SO_GS + n * 16 + h * 4;
                const float qinv = gs[0], kinv = gs[1], beta = gs[2], eg = gs[3];
                float dk = 0.f;
#pragma unroll
                for (int i = 0; i < 128; ++i) dk += S[i] * k[i];
                const float u = beta * (vv - eg * kinv * dk) * kinv;
                float o = 0.f;
#pragma unroll
                for (int i = 0; i < 128; ++i) {
                    S[i] = S[i] * eg + u * k[i];
                    o += S[i] * q[i];
                }
                scr[N * SO_DO + n * 512 + h * 128 + v] = o * qinv;
            }
        } break;
        case ST_GDN_POST: {
            const long n = it / 4; const int h = (int)(it % 4);
            const float* o = scr + N * SO_DO + n * 512 + h * 128;
            float ms = 0.f;
            for (int i = 0; i < 128; ++i) ms += o[i] * o[i];
            const float rs = 1.0f / sqrtf(ms * (1.0f / 128) + 1e-6f);
            for (int i = 0; i < 128; ++i) {
                const float z = PF(n, C_GDN + 1536 + h * 128 + i);
                P.mix16[n * DM + 1536 + h * 128 + i] = f2bf(o[i] * rs * P.gdn_norm[l * 128 + i] * siluf_(z));
            }
        } break;
        case ST_SCORES: {
            const long n = it / 2048; const int c = (int)(it % 2048);
            const int hp = c / 128, key = c % 128;
            const float* q = P.qf + n * DM + hp * 128;
            const float* sk = P.peer_sub_keys + (long)l * 16 * 128 * 128 + ((long)hp * 128 + key) * 128;
            float s = 0.f;
            for (int d = 0; d < 128; ++d) s += q[d] * sk[d];
            P.sc[it] = s;
        } break;
        case ST_TOPK1: {
            const float* sc = P.sc + it * 128;
            float ts[16]; int ti[16];
#pragma unroll
            for (int j = 0; j < 16; ++j) { ts[j] = -3.0e38f; ti[j] = 0; }
            for (int i = 0; i < 128; ++i) {
                float xv = sc[i]; int xi = i;
                if (xv > ts[15]) {
#pragma unroll
                    for (int j = 0; j < 16; ++j) {
                        if (xv > ts[j]) { const float tv = ts[j]; const int tj = ti[j]; ts[j] = xv; ti[j] = xi; xv = tv; xi = tj; }
                    }
                }
            }
            float* TS = scr + N * SO_TS + it * 16;
            int* TI = (int*)(scr + N * SO_TI) + it * 16;
#pragma unroll
            for (int j = 0; j < 16; ++j) { TS[j] = ts[j]; TI[j] = ti[j]; }
        } break;
        case ST_TOPK2: {
            const float* s0 = scr + N * SO_TS + it * 32;
            const float* s1 = s0 + 16;
            const int* i0 = (const int*)(scr + N * SO_TI) + it * 32;
            const int* i1 = i0 + 16;
            float ts[16]; int ti[16];
#pragma unroll
            for (int j = 0; j < 16; ++j) { ts[j] = -3.0e38f; ti[j] = 0; }
            for (int a = 0; a < 16; ++a) {
                const int jmax = 16 / (a + 1);
                for (int b = 0; b < jmax; ++b) {
                    float xv = s0[a] + s1[b]; int xi = i0[a] * 128 + i1[b];
                    if (xv > ts[15]) {
#pragma unroll
                        for (int j = 0; j < 16; ++j) {
                            if (xv > ts[j]) { const float tv = ts[j]; const int tj = ti[j]; ts[j] = xv; ti[j] = xi; xv = tv; xi = tj; }
                        }
                    }
                }
            }
            const float mx = ts[0];
            float den = 0.f;
#pragma unroll
            for (int j = 0; j < 16; ++j) { ts[j] = expf(ts[j] - mx); den += ts[j]; }
            const float inv = 1.0f / den;
#pragma unroll
            for (int j = 0; j < 16; ++j) { P.gate[it * 16 + j] = ts[j] * inv; P.idx[it * 16 + j] = ti[j]; }
        } break;
        case ST_PEER_U: {
            const long n = it / 128;
            const int e = P.idx[it];
            const float* u = P.peer_u + ((long)l * NEXP + e) * DM;
            const bf16_t* hx = P.hb + n * DM;
            float s = 0.f;
            for (int d = 0; d < DM; ++d) s += bf2f(hx[d]) * u[d];
            P.act[it] = geluf_(s) * P.gate[it];
        } break;
        case ST_PEER_V: {
            const long n = it / DM; const int d = (int)(it % DM);
            const float* a = P.act + n * 128;
            const int* ix = P.idx + n * 128;
            float s = 0.f;
            for (int j = 0; j < 128; ++j) s += a[j] * P.peer_v[((long)l * NEXP + ix[j]) * DM + d];
            P.xcur[it] += s;
        } break;
    }
}


struct WsMap {
    size_t ctl, w1t, w2t, wsct, auxwt, lruwt, vreswt, pp, tabu, tabv, tsc, ssq, dpart, xn, hb, mix16, p16, sc, aux, vfirst, idx, gate, rstd, act, end;
    size_t auxA, zrkv, xc, auxo, gates, vres, glao, gdno, gq, gk, gv, gsc, rwy, rwbv, lrs, gblob, glas, gladv;
    size_t scr, qf;
};
HD WsMap ws_map(size_t N) {
    WsMap m{};
    size_t o = 0;
    auto take = [&](size_t bytes) { size_t r = o; o += (bytes + 4095) & ~(size_t)4095; return r; };
    m.ctl = take(1u << 20);
    m.w1t = take((size_t)NL * PLD * DM * 2);
    m.w2t = take((size_t)NL * DM * DM * 2);
    m.wsct = take((size_t)NL * DM * DM * 2);
    m.auxwt = take((size_t)NL * 1792 * 384 * 2);
    m.lruwt = take((size_t)NL * 1024 * 512 * 2);
    m.vreswt = take((size_t)512 * 512 * 2);
    m.pp = take(1u << 20);
    m.xn = take(N * DM * 2);
    m.hb = take(N * DM * 2);
    m.mix16 = take(N * DM * 2);
    m.p16 = take(N * PLD * 2);
    m.sc = m.p16;
    m.vfirst = take(N * 512 * 4);
    m.idx = take(N * 128 * 4);
    m.gate = take(N * 128 * 4);
    m.act = take(N * 128 * 4);
    m.rstd = take(N * 4);
    m.tabu = take((size_t)NL * 2 * NEXP * 1024);
    m.tabv = m.tabu + (size_t)NEXP * 1024;
    m.ssq = take(N * 8 * 4);
    m.dpart = m.p16;
    m.tsc = take((size_t)NL * 2 * NEXP * 4);
    m.aux = take(N * 5888 * 4);
    m.end = o;
    size_t a = m.aux;
    auto sub = [&](size_t bytes) { size_t r = a; a += (bytes + 4095) & ~(size_t)4095; return r; };
    m.auxA = sub(N * 384 * 2); m.zrkv = sub(N * 1536 * 2); m.xc = sub(N * 512 * 2); m.auxo = sub(N * 1792 * 2);
    m.gates = sub(N * 1024 * 2); m.vres = sub(N * 512 * 2); m.glao = sub(N * 512 * 2); m.gdno = sub(N * 512 * 2);
    m.gq = sub(N * 512 * 2); m.gk = sub(N * 512 * 2); m.gv = sub(N * 512 * 2); m.gsc = sub(N * 8 * 4); m.rwy = sub(N * 512 * 2); m.rwbv = sub(N * 512 * 2); m.lrs = sub(N / 64 * 512 * 2 * 4);
    m.gblob = sub(N / 64 * 4 * 26880);
    m.glas = sub(N / 64 * 4 * 8192 * 2); m.gladv = sub(N / 64 * 4 * 64 * 4);
    m.scr = m.tabu;
    m.qf = m.aux + N * 3584 * 4;
    return m;
}
static inline void bind_ws(Params& P, char* ws) {
    const WsMap m = ws_map((size_t)P.N);
    P.xn = (bf16_t*)(ws + m.xn); P.hb = (bf16_t*)(ws + m.hb); P.mix16 = (bf16_t*)(ws + m.mix16); P.p16 = (bf16_t*)(ws + m.p16);
    P.sc = (float*)(ws + m.sc); P.qf = (float*)(ws + m.qf); P.rstd = (float*)(ws + m.rstd); P.vfirst = (float*)(ws + m.vfirst);
    P.scr = (float*)(ws + m.scr); P.act = (float*)(ws + m.act); P.gate = (float*)(ws + m.gate); P.idx = (int*)(ws + m.idx);
}

struct Step { int st, l; };
static inline int build_schedule(Step* s) {
    int n = 0;
    s[n++] = {ST_COPYX, 0};
    for (int l = 0; l < NL; ++l) {
        static const int per_layer[] = {ST_RSTD, ST_NORM1, ST_GEMM1,
            ST_RW_A0, ST_RW_A1, ST_RW_A2, ST_RW_A3, ST_RW_KKN, ST_RW_SCAN, ST_RW_POST,
            ST_GLA_B0, ST_GLA_SCAN, ST_GLA_POST, ST_LRU_C0, ST_LRU_C1, ST_LRU_SCAN,
            ST_GDN_D0, ST_GDN_D1, ST_GDN_SCAN, ST_GDN_POST,
            ST_GEMM2, ST_RSTD2, ST_NORM2, ST_GEMM3, ST_SCORES, ST_TOPK1, ST_TOPK2, ST_PEER_U, ST_PEER_V};
        for (int i = 0; i < (int)(sizeof(per_layer) / sizeof(int)); ++i) s[n++] = {per_layer[i], l};
    }
    s[n++] = {ST_FRSTD, 0};
    s[n++] = {ST_FNORM, 0};
    return n;
}

static inline void fill_inputs(Params& P, void* const* d_in) {
    const float** dst = (const float**)&P;
    for (int i = 0; i < 38; ++i) dst[i] = (const float*)d_in[i];
}

#ifndef HOST_EMU
#define GAS __attribute__((address_space(1)))
#define LAS __attribute__((address_space(3)))
typedef unsigned v4u __attribute__((ext_vector_type(4)));
typedef unsigned v2u __attribute__((ext_vector_type(2)));
typedef float f32x4 __attribute__((ext_vector_type(4)));
typedef float f32x2 __attribute__((ext_vector_type(2)));
typedef short bf16x8 __attribute__((ext_vector_type(8)));
constexpr int NWAVES = 8, NTHR = 512;
constexpr int RING_BYTES = 131072, MISC_OFF = RING_BYTES + 320, LDS_BYTES = 147456;
constexpr int NTOK = 16384, TSEQ = 4096, NBATCH = 4;

__device__ __forceinline__ unsigned pk2(float lo, float hi) { return (unsigned)f2bf(lo) | ((unsigned)f2bf(hi) << 16); }
__device__ __forceinline__ float bflo(unsigned u) { return __builtin_bit_cast(float, u << 16); }
__device__ __forceinline__ float bfhi(unsigned u) { return __builtin_bit_cast(float, u & 0xffff0000u); }
__device__ __forceinline__ float wave_sum(float v) {
#pragma unroll
    for (int o = 1; o < 64; o <<= 1) v += __shfl_xor(v, o);
    return v;
}
#define LDS_WAIT() asm volatile("s_waitcnt lgkmcnt(0)" ::: "memory")
#define VM_WAIT() asm volatile("s_waitcnt vmcnt(0)" ::: "memory")

namespace pg8 {
#define PG8_LAS __attribute__((address_space(3)))
constexpr int BM = 256, BK = 64, HALF = 128, HTB = HALF * BK * 2, STAGE_BYTES = 8 * HTB, NXCD = 8, WGM = 8;
__host__ __device__ __forceinline__ int lds_byte(int r, int c) { const int st = (r >> 4) * 2 + (c >> 5), rr = r & 15, cc = c & 31, ob = rr * 64 + cc * 2; return st * 1024 + (ob ^ (((ob >> 9) & 1) << 5)); }
__host__ __device__ __forceinline__ void stage_rc(int b, int& R, int& C) { const int st = b / 1024, sb = b % 1024, swz = sb ^ (((sb >> 9) & 1) << 5); R = (st >> 1) * 16 + swz / 64; C = (st & 1) * 32 + (swz % 64) / 2; }
__host__ __device__ __forceinline__ int perm32(int rho) { const int n = rho >> 4, i = rho & 15; return 8 * (i >> 2) + 4 * n + (i & 3); }
struct Unit { int pm, pn; };
struct GemmX { const bf16_t* A; const bf16_t* Bt; int M, N, K, lda; };
struct StaticOrder {
    int nM, nN, nwg, G, c;
    __host__ __device__ void init(int M, int N, int G_, int c_) { nM = M / BM; nN = N / BM; nwg = nM * nN; G = G_; c = c_; }
    __host__ __device__ bool next(int i, Unit& u) const {
        const long L = (long)i * G + c; if (L >= nwg) return false;
        int wgid = (int)L; { const int q = nwg / NXCD, r = nwg % NXCD, xcd = wgid % NXCD, off = wgid / NXCD; wgid = (xcd < r ? xcd * (q + 1) : r * (q + 1) + (xcd - r) * q) + off; }
        const int nig = WGM * nN, gid = wgid / nig, fm = gid * WGM, gsz = (nM - fm) < WGM ? (nM - fm) : WGM;
        u.pm = fm + ((wgid % nig) % gsz); u.pn = (wgid % nig) / gsz; return true;
    }
    __device__ __forceinline__ void a_ready(const Unit&) const {}
    __device__ __forceinline__ void done(const Unit&) const {}
};
__device__ __forceinline__ unsigned cvt_pk_bf16(float lo, float hi) { unsigned r; asm volatile("v_cvt_pk_bf16_f32 %0, %1, %2" : "=v"(r) : "v"(lo), "v"(hi)); return r; }
template <bool ACCUM> struct EpiF32 {
    static constexpr bool PERM = false, AFTER_DRAIN = false;
    float* C; int ldc;
    __device__ __forceinline__ void operator()(const f32x4 (&acc)[2][2][4][2], const Unit& u, int wr, int wc, int fr, int fq) const {
        const int row0 = u.pm * BM + wr * 64 + fr, col0 = u.pn * BM + wc * 32 + 4 * fq;
#pragma unroll
        for (int ai = 0; ai < 2; ++ai)
#pragma unroll
            for (int m = 0; m < 4; ++m) { float* rowp = C + (size_t)(row0 + ai * HALF + m * 16) * ldc + col0;
#pragma unroll
                for (int bj = 0; bj < 2; ++bj)
#pragma unroll
                    for (int n = 0; n < 2; ++n) { f32x4* p = (f32x4*)(rowp + bj * HALF + n * 16);
                        if (ACCUM) *p = *p + acc[ai][bj][m][n]; else *p = acc[ai][bj][m][n]; } }
    }
};
struct EpiBf16 {
    static constexpr bool PERM = true, AFTER_DRAIN = false;
    bf16_t* O; int ldc; const float* bias; const float* ssq = nullptr;
    __device__ __forceinline__ void operator()(const f32x4 (&acc)[2][2][4][2], const Unit& u, int wr, int wc, int fr, int fq) const {
        const int row0 = u.pm * BM + wr * 64 + fr; const int col0 = u.pn * BM + wc * 32 + 8 * fq;
        float rs[2][4];
#pragma unroll
        for (int ai = 0; ai < 2; ++ai)
#pragma unroll
            for (int m = 0; m < 4; ++m) { rs[ai][m] = 1.0f;
                if (ssq) { const f32x4* sp = (const f32x4*)(ssq + (size_t)(row0 + ai * HALF + m * 16) * 8); const f32x4 s0 = sp[0], s1 = sp[1];
                    rs[ai][m] = 1.0f / sqrtf((((s0.x + s0.y) + (s0.z + s0.w)) + ((s1.x + s1.y) + (s1.z + s1.w))) * (1.0f / 2048.0f) + 1e-6f); } }
        f32x4 bv[2][2];
#pragma unroll
        for (int bj = 0; bj < 2; ++bj)
#pragma unroll
            for (int n = 0; n < 2; ++n) bv[bj][n] = bias ? *(const f32x4*)(bias + col0 + bj * HALF + 4 * n) : (f32x4){0.f, 0.f, 0.f, 0.f};
#pragma unroll
        for (int ai = 0; ai < 2; ++ai)
#pragma unroll
            for (int m = 0; m < 4; ++m) { bf16_t* rowp = O + (size_t)(row0 + ai * HALF + m * 16) * ldc + col0;
#pragma unroll
                for (int bj = 0; bj < 2; ++bj) { const f32x4 v0 = acc[ai][bj][m][0] * rs[ai][m] + bv[bj][0], v1 = acc[ai][bj][m][1] * rs[ai][m] + bv[bj][1];
                    v4u w; w.x = cvt_pk_bf16(v0[0], v0[1]); w.y = cvt_pk_bf16(v0[2], v0[3]); w.z = cvt_pk_bf16(v1[0], v1[1]); w.w = cvt_pk_bf16(v1[2], v1[3]);
                    *(v4u*)(rowp + bj * HALF) = w; } }
    }
};
template <class Epi, class Sched, bool ALIGN_EPI = false, bool SP2 = false>
__device__ __forceinline__ void gemm_phase(PG8_LAS unsigned char* lds, const GemmX g, const Sched& S, const Epi& E) {
    const int tid = threadIdx.x, wid = __builtin_amdgcn_readfirstlane(tid >> 6), lane = tid & 63, wr = wid >> 2, wc = wid & 3, fr = lane & 15, fq = lane >> 4;
    const int K = g.K, nt = K / BK;
    unsigned voffA[2], voffB[2];
#pragma unroll
    for (int i = 0; i < 2; ++i) { int R, C; stage_rc(tid * 16 + i * 8192, R, C); const int Rb = Epi::PERM ? ((R & ~31) + perm32(R & 31)) : R;
        voffA[i] = (unsigned)(R * g.lda + C) * 2u; voffB[i] = (unsigned)(Rb * K + C) * 2u; }
    const size_t kstep = (size_t)(BK * 2);
    const size_t hstep = (size_t)HALF * K * 2;
    const size_t tstep = 2 * hstep;
    const size_t hstepA = (size_t)HALF * g.lda * 2, tstepA = 2 * hstepA;
    const unsigned ldsw = (unsigned)wid * 1024u;
    const int aoff = lds_byte(wr * 64 + fr, fq * 8), boff = lds_byte(wc * 32 + fr, fq * 8);
#define PG8_SA(b, h) (((b) * 2 + (h)) * HTB)
#define PG8_SB(b, h) ((4 + (b) * 2 + (h)) * HTB)
#define PG8_STAGE(bufoff, gbase, voff) do { _Pragma("unroll") for (int _i = 0; _i < 2; ++_i) \
        __builtin_amdgcn_global_load_lds((const unsigned*)((const char*)(gbase) + (voff)[_i]), (PG8_LAS unsigned*)(lds + (bufoff) + ldsw + _i * 8192), 16, 0, 0); } while (0)
#define PG8_LDA(dst, b, h) do { _Pragma("unroll") for (int m = 0; m < 4; ++m) _Pragma("unroll") for (int k = 0; k < 2; ++k) dst[m][k] = *(const PG8_LAS bf16x8*)(lds + PG8_SA(b, h) + aoff + m * 2048 + k * 1024); } while (0)
#define PG8_LDB(dst, b, h) do { _Pragma("unroll") for (int n = 0; n < 2; ++n) _Pragma("unroll") for (int k = 0; k < 2; ++k) dst[n][k] = *(const PG8_LAS bf16x8*)(lds + PG8_SB(b, h) + boff + n * 2048 + k * 1024); } while (0)
#define PG8_MMA(ai, bj, At, Bt) do { __builtin_amdgcn_s_setprio(1); _Pragma("unroll") for (int m = 0; m < 4; ++m) _Pragma("unroll") for (int n = 0; n < 2; ++n) _Pragma("unroll") for (int k = 0; k < 2; ++k) \
        acc[ai][bj][m][n] = __builtin_amdgcn_mfma_f32_16x16x32_bf16(Bt[n][k], At[m][k], acc[ai][bj][m][n], 0, 0, 0); __builtin_amdgcn_s_setprio(0); } while (0)
#define PG8_WAIT_V(n) asm volatile("s_waitcnt vmcnt(" #n ")" ::: "memory")
#define PG8_WAIT_L(n) asm volatile("s_waitcnt lgkmcnt(" #n ")" ::: "memory")
#define PG8_BAR __builtin_amdgcn_s_barrier()
#define PG8_SCHED __builtin_amdgcn_sched_barrier(0)
    Unit cur, nxt; int ui = 0;
    if (!S.next(0, cur)) return;
    f32x4 acc[2][2][4][2];
#pragma unroll
    for (int a = 0; a < 2; ++a)
#pragma unroll
        for (int b = 0; b < 2; ++b)
#pragma unroll
            for (int m = 0; m < 4; ++m)
#pragma unroll
                for (int n = 0; n < 2; ++n) acc[a][b][m][n] = (f32x4){0.f, 0.f, 0.f, 0.f};
    bf16x8 At[4][2], B0[2][2], B1[2][2];
    const char* cA = (const char*)g.A + (size_t)cur.pm * tstepA; const char* cB = (const char*)g.Bt + (size_t)cur.pn * tstep;
    S.a_ready(cur);
    if constexpr (SP2) {
        PG8_STAGE(PG8_SB(0, 0), cB, voffB); PG8_STAGE(PG8_SB(0, 1), cB + hstep, voffB); PG8_STAGE(PG8_SA(0, 0), cA, voffA); PG8_STAGE(PG8_SA(0, 1), cA + hstepA, voffA);
        if (wr == 1) PG8_BAR;
        PG8_WAIT_V(2); PG8_BAR;
        PG8_STAGE(PG8_SB(1, 0), cB + kstep, voffB); PG8_STAGE(PG8_SA(1, 0), cA + kstep, voffA); PG8_STAGE(PG8_SB(1, 1), cB + hstep + kstep, voffB);
        PG8_WAIT_V(6); PG8_BAR;
    } else {
        PG8_STAGE(PG8_SB(0, 0), cB, voffB); PG8_STAGE(PG8_SA(0, 0), cA, voffA); PG8_STAGE(PG8_SB(0, 1), cB + hstep, voffB); PG8_STAGE(PG8_SA(0, 1), cA + hstepA, voffA);
        if (wr == 1) PG8_BAR;
        PG8_WAIT_V(4); PG8_BAR;
        PG8_STAGE(PG8_SB(1, 0), cB + kstep, voffB); PG8_STAGE(PG8_SA(1, 0), cA + kstep, voffA); PG8_STAGE(PG8_SB(1, 1), cB + hstep + kstep, voffB);
        PG8_WAIT_V(6); PG8_BAR;
    }
    for (;;) {
        const bool has_next = S.next(ui + 1, nxt);
        const char* nA = has_next ? (const char*)g.A + (size_t)nxt.pm * tstepA : cA; const char* nB = has_next ? (const char*)g.Bt + (size_t)nxt.pn * tstep : cB;
        for (int t = 0; t < nt; t += 2) {
            const bool last = (t == nt - 2);
            const char* a1 = cA + (size_t)(t + 1) * kstep;
            const char* a2 = last ? nA : cA + (size_t)(t + 2) * kstep; const char* b2 = last ? nB : cB + (size_t)(t + 2) * kstep;
            const char* a3 = a2 + kstep; const char* b3 = b2 + kstep;
            if (last && has_next) S.a_ready(nxt);
            if constexpr (SP2) {
            PG8_LDB(B0, 0, 0); PG8_LDB(B1, 0, 1); PG8_SCHED; PG8_LDA(At, 0, 0); PG8_STAGE(PG8_SA(1, 1), a1 + hstepA, voffA);
            PG8_WAIT_V(8); PG8_WAIT_L(0); PG8_BAR; PG8_MMA(0, 0, At, B0); PG8_MMA(0, 1, At, B1); PG8_BAR; PG8_SCHED;
            PG8_LDA(At, 0, 1); PG8_STAGE(PG8_SB(0, 0), b2, voffB); PG8_STAGE(PG8_SB(0, 1), b2 + hstep, voffB); PG8_STAGE(PG8_SA(0, 0), a2, voffA);
            PG8_WAIT_V(8); PG8_WAIT_L(0); PG8_BAR; PG8_MMA(1, 0, At, B0); PG8_MMA(1, 1, At, B1); PG8_BAR; PG8_SCHED;
            PG8_LDB(B0, 1, 0); PG8_LDB(B1, 1, 1); PG8_SCHED; PG8_LDA(At, 1, 0); PG8_STAGE(PG8_SA(0, 1), a2 + hstepA, voffA);
            PG8_WAIT_V(8); PG8_WAIT_L(0); PG8_BAR; PG8_MMA(0, 0, At, B0); PG8_MMA(0, 1, At, B1); PG8_BAR; PG8_SCHED;
            PG8_LDA(At, 1, 1); PG8_STAGE(PG8_SB(1, 0), b3, voffB); PG8_STAGE(PG8_SB(1, 1), b3 + hstep, voffB); PG8_STAGE(PG8_SA(1, 0), a3, voffA);
            PG8_WAIT_V(8); PG8_WAIT_L(0); PG8_BAR; PG8_MMA(1, 0, At, B0); PG8_MMA(1, 1, At, B1); PG8_BAR; PG8_SCHED;
            } else {
            PG8_LDB(B0, 0, 0); PG8_SCHED; PG8_LDA(At, 0, 0); PG8_STAGE(PG8_SA(1, 1), a1 + hstepA, voffA);
            PG8_WAIT_L(8); PG8_BAR; PG8_WAIT_L(0); PG8_MMA(0, 0, At, B0); PG8_BAR; PG8_SCHED;
            PG8_LDB(B1, 0, 1); PG8_STAGE(PG8_SB(0, 0), b2, voffB);
            PG8_BAR; PG8_WAIT_L(0); PG8_MMA(0, 1, At, B1); PG8_BAR;
            PG8_LDA(At, 0, 1); PG8_STAGE(PG8_SA(0, 0), a2, voffA);
            PG8_BAR; PG8_WAIT_L(0); PG8_MMA(1, 0, At, B0); PG8_BAR; PG8_SCHED;
            PG8_STAGE(PG8_SB(0, 1), b2 + hstep, voffB);
            PG8_WAIT_V(6); PG8_BAR; PG8_MMA(1, 1, At, B1); PG8_BAR;
            PG8_LDB(B0, 1, 0); PG8_SCHED; PG8_LDA(At, 1, 0); PG8_STAGE(PG8_SA(0, 1), a2 + hstepA, voffA);
            PG8_WAIT_L(8); PG8_BAR; PG8_WAIT_L(0); PG8_MMA(0, 0, At, B0); PG8_BAR; PG8_SCHED;
            PG8_LDB(B1, 1, 1); PG8_STAGE(PG8_SB(1, 0), b3, voffB);
            PG8_BAR; PG8_WAIT_L(0); PG8_MMA(0, 1, At, B1); PG8_BAR;
            PG8_LDA(At, 1, 1); PG8_STAGE(PG8_SA(1, 0), a3, voffA);
            PG8_BAR; PG8_WAIT_L(0); PG8_MMA(1, 0, At, B0); PG8_BAR; PG8_SCHED;
            PG8_STAGE(PG8_SB(1, 1), b3 + hstep, voffB);
            PG8_WAIT_V(6); PG8_BAR; PG8_MMA(1, 1, At, B1); PG8_BAR;
            }
        }
        if constexpr (ALIGN_EPI) { if (wr == 0) PG8_BAR; }
        if constexpr (!Epi::AFTER_DRAIN) { E(acc, cur, wr, wc, fr, fq); S.done(cur); }
        if (!has_next) break;
#pragma unroll
        for (int a = 0; a < 2; ++a)
#pragma unroll
            for (int b = 0; b < 2; ++b)
#pragma unroll
                for (int m = 0; m < 4; ++m)
#pragma unroll
                    for (int n = 0; n < 2; ++n) acc[a][b][m][n] = (f32x4){0.f, 0.f, 0.f, 0.f};
        cur = nxt; cA = nA; cB = nB; ++ui;
        if constexpr (ALIGN_EPI) { if (wr == 1) PG8_BAR; }
    }
    PG8_WAIT_V(0);
    if constexpr (!ALIGN_EPI) { if (wr == 0) PG8_BAR; }
    PG8_BAR;
    if constexpr (Epi::AFTER_DRAIN) { E.fused(acc, cur, wr, wc, fr, fq, lds, wid, lane); S.done(cur); }
#undef PG8_SA
#undef PG8_SB
#undef PG8_STAGE
#undef PG8_LDA
#undef PG8_LDB
#undef PG8_MMA
#undef PG8_WAIT_V
#undef PG8_WAIT_L
#undef PG8_BAR
#undef PG8_SCHED
}
}

#define XB_TMO      128
#define XB_XCNT(j)  (256  + 64 * (j))
#define XB_XSUB(j)  (1280 + 64 * (j))
#define XB_XGEN(j)  (2304 + 64 * (j))
#define XB_TOP      3328
#define XB_TOPGEN   3392
#define XCD_BAR_WORDS 3456
#define XB_SPIN_CAP (1u << 20)
__device__ __forceinline__ unsigned xb_ld(unsigned* p) { return __hip_atomic_load(p, __ATOMIC_RELAXED, __HIP_MEMORY_SCOPE_AGENT); }
__device__ __forceinline__ unsigned xb_add(unsigned* p, unsigned v) { return __hip_atomic_fetch_add(p, v, __ATOMIC_RELAXED, __HIP_MEMORY_SCOPE_AGENT); }
__device__ __forceinline__ unsigned xb_xcc_id() { return (unsigned)__builtin_amdgcn_s_getreg((3 << 11) | 20) & 0xFu; }
#define XB_SPIN(cond, bar) do { unsigned _sp = 0; while (cond) { __builtin_amdgcn_s_sleep(1); \
    if ((++_sp & 255u) == 0u) { if (xb_ld(&(bar)[XB_TMO])) break; if (_sp > XB_SPIN_CAP) { atomicAdd(&(bar)[XB_TMO], 1u); break; } } } } while (0)
struct XcdBarrier { unsigned* bar; unsigned x; volatile LAS unsigned* st; };
__device__ __forceinline__ XcdBarrier xcd_barrier_post(unsigned* bar, volatile LAS unsigned* st) {
    XcdBarrier b; b.bar = bar; b.x = xb_xcc_id(); b.st = st;
    if (threadIdx.x == 0) (void)xb_add(&bar[XB_XCNT(b.x)], 1u);
    return b;
}
__device__ __forceinline__ void xcd_barrier_complete(unsigned* bar, unsigned x, unsigned& nloc, unsigned& nx) {
    const unsigned G = gridDim.x * gridDim.y * gridDim.z;
    unsigned sum, cnt, mine, sp = 0u;
    for (;;) {
        sum = 0u; cnt = 0u; mine = 0u;
#pragma unroll
        for (unsigned j = 0; j < 16; ++j) { const unsigned c = xb_ld(&bar[XB_XCNT(j)]); sum += c; cnt += (c > 0u) ? 1u : 0u; mine = (j == x) ? c : mine; }
        if (sum == G) break;
        __builtin_amdgcn_s_sleep(1);
        if ((++sp & 255u) == 0u) { if (xb_ld(&bar[XB_TMO])) break; if (sp > XB_SPIN_CAP) { atomicAdd(&bar[XB_TMO], 1u); break; } }
    }
    nloc = mine > 0u ? mine : 1u; nx = cnt > 0u ? cnt : 1u;
}
__device__ __forceinline__ void xcd_barrier(const XcdBarrier& b) {
    asm volatile("s_waitcnt vmcnt(0)" ::: "memory");
    __syncthreads();
    if (threadIdx.x == 0) {
        unsigned* bar = b.bar;
        __builtin_amdgcn_s_waitcnt(0);
        unsigned nloc = b.st[0], nx = b.st[1];
        if (nloc == 0u) { xcd_barrier_complete(bar, b.x, nloc, nx); b.st[0] = nloc; b.st[1] = nx; }
        const unsigned old = xb_add(&bar[XB_XSUB(b.x)], 1u);
        const unsigned gen = old / nloc;
        if (old + 1u == (gen + 1u) * nloc) {
            __builtin_amdgcn_fence(__ATOMIC_RELEASE, "agent");
            asm volatile("s_waitcnt vmcnt(0)" ::: "memory");
            const unsigned og = xb_add(&bar[XB_TOP], 1u);
            const unsigned tg = og / nx;
            if (og + 1u == (tg + 1u) * nx) xb_add(&bar[XB_TOPGEN], 1u);
            else XB_SPIN(xb_ld(&bar[XB_TOPGEN]) == tg, bar);
            __builtin_amdgcn_fence(__ATOMIC_ACQUIRE, "agent");
            xb_add(&bar[XB_XGEN(b.x)], 1u);
            asm volatile("s_waitcnt vmcnt(0)" ::: "memory");
        } else {
            XB_SPIN(xb_ld(&bar[XB_XGEN(b.x)]) == gen, bar);
            __builtin_amdgcn_fence(__ATOMIC_ACQUIRE, "agent");
            asm volatile("s_waitcnt vmcnt(0)" ::: "memory");
        }
    }
    __syncthreads();
}

struct Args { const float* in[38]; float* out; unsigned char* ws; int ph_lo, ph_hi, li, pad; };
enum InputId { I_X = 0, I_NORM_MIX, I_W_IN, I_W_OUT, I_RW_MU, I_RW_W0, I_RW_W_UP, I_RW_A0, I_RW_A_UP, I_RW_G_UP, I_RW_K_K, I_RW_K_A, I_RW_R_K,
    I_RW_LN_W, I_RW_LN_B, I_RW_V0, I_RW_V_DOWN, I_RW_V_UP, I_GLA_A_UP, I_GLA_A_BIAS, I_GLA_NORM, I_LRU_CONV_W, I_LRU_CONV_B, I_LRU_W_R,
    I_LRU_B_R, I_LRU_W_I, I_LRU_B_I, I_LRU_LAM, I_GDN_CONV_W, I_GDN_A_LOG, I_GDN_DT_BIAS, I_GDN_NORM, I_NORM_FFN, I_PEER_WQ, I_PEER_SK,
    I_PEER_U, I_PEER_V, I_NORM_FINAL };
enum { PH_P0 = 0, PH_GEMM1 = 1, PH_PREP = 2, PH_AUX = 3, PH_SCAN = 4, PH_POST = 5, PH_GEMM2 = 6, PH_NORM2 = 7, PH_GEMM3 = 8, PH_TOPK = 9, PH_PEERU = 10, PH_PEERC = 11, PH_PEERV = 12, PH_PER_LAYER = 12, PH_FNORM = 25, PH_TOTAL = 26 };

struct Frame {
    LAS unsigned char* lds;
    int tid, lane, wave, vcu, G;
    int gw, ngw;
};

__device__ __forceinline__ void p0_transpose_item(const float* W, int K, int N, const float* kscale, bf16_t* WT, LAS float* scr, int item, int nblk, int lane) {
    const int kb = item / nblk, nb = item % nblk, k0 = 64 * kb, n0 = 32 * nb;
    const int kr = lane >> 3, n4 = (lane & 7) * 4;
    f32x4 v[8];
#pragma unroll
    for (int i = 0; i < 8; ++i) { const int kk = kr + 8 * i;
        v[i] = (n0 + n4 < N) ? *(const f32x4*)(W + (size_t)(k0 + kk) * N + n0 + n4) : (f32x4){0.f, 0.f, 0.f, 0.f}; }
#pragma unroll
    for (int i = 0; i < 8; ++i) { const int kk = kr + 8 * i; const float s = kscale ? kscale[k0 + kk] : 1.0f;
        scr[kk * 33 + n4 + 0] = v[i].x * s; scr[kk * 33 + n4 + 1] = v[i].y * s; scr[kk * 33 + n4 + 2] = v[i].z * s; scr[kk * 33 + n4 + 3] = v[i].w * s; }
    LDS_WAIT(); asm volatile("" ::: "memory");
    const int c = lane & 7;
#pragma unroll
    for (int j = 0; j < 4; ++j) { const int n = (lane >> 3) + 8 * j; const LAS float* s = scr + (8 * c) * 33 + n;
        v4u o; o.x = pk2(s[0 * 33], s[1 * 33]); o.y = pk2(s[2 * 33], s[3 * 33]); o.z = pk2(s[4 * 33], s[5 * 33]); o.w = pk2(s[6 * 33], s[7 * 33]);
        *(v4u*)(WT + (size_t)(n0 + n) * K + k0 + 8 * c) = o; }
    LDS_WAIT(); asm volatile("" ::: "memory");
}

__device__ __forceinline__ void p0_prologue(const Args& a, Frame& F) {
    const WsMap m = ws_map(NTOK);
    unsigned char* ws = a.ws;
    LAS float* scr = (LAS float*)(F.lds + F.wave * 16384);
    const int gw = F.gw, NGW = F.ngw, lane = F.lane;
    for (int n = gw; n < NTOK; n += NGW) {
        const f32x4* xr = (const f32x4*)(a.in[I_X] + (size_t)n * DM) + lane;
        f32x4 v[8]; float s = 0.f;
#pragma unroll
        for (int j = 0; j < 8; ++j) { v[j] = xr[64 * j]; s += (v[j].x * v[j].x + v[j].y * v[j].y) + (v[j].z * v[j].z + v[j].w * v[j].w); }
        const float rstd = 1.0f / sqrtf(wave_sum(s) * (1.0f / DM) + 1e-6f);
        f32x4* xo = (f32x4*)(a.out + (size_t)n * DM) + lane;
        v2u* o8 = (v2u*)((bf16_t*)(ws + m.xn) + (size_t)n * DM) + lane;
#pragma unroll
        for (int j = 0; j < 8; ++j) { xo[64 * j] = v[j]; v2u w; w.x = pk2(v[j].x * rstd, v[j].y * rstd); w.y = pk2(v[j].z * rstd, v[j].w * rstd); o8[64 * j] = w; }
    }
    {
        constexpr int I1 = (DM / 64) * (PLD / 32), I2 = (DM / 64) * (DM / 32);
        for (int it = gw; it < NL * (I1 + I2); it += NGW) {
            const int l = it / (I1 + I2); int r = it % (I1 + I2);
            if (r < I1) p0_transpose_item(a.in[I_W_IN] + (size_t)l * DM * INC, DM, INC, a.in[I_NORM_MIX] + l * DM, (bf16_t*)(ws + m.w1t) + (size_t)l * PLD * DM, scr, r, PLD / 32, lane);
            else p0_transpose_item(a.in[I_W_OUT] + (size_t)l * DM * DM, DM, DM, nullptr, (bf16_t*)(ws + m.w2t) + (size_t)l * DM * DM, scr, r - I1, DM / 32, lane);
        }
    }
    for (int it = gw; it < NL * 16 * 64; it += NGW) {
        const int l = it / 1024, hp = (it % 1024) / 64, kb = it % 64;
        const int dh = lane & 1, kk = kb * 32 + (lane >> 1);
        const float* wq = a.in[I_PEER_WQ] + (size_t)l * DM * DM + (size_t)kk * DM + hp * 128 + dh * 64;
        const float* sk = a.in[I_PEER_SK] + ((size_t)l * 16 + hp) * 128 * 128;
        f32x4 q[16];
#pragma unroll
        for (int d = 0; d < 16; ++d) q[d] = *(const f32x4*)(wq + 4 * d);
        bf16_t* o = (bf16_t*)(ws + m.wsct) + (size_t)l * DM * DM + (size_t)(hp * 128) * DM + kk;
        f32x4 stg[8];
#pragma unroll
        for (int i = 0; i < 8; ++i) stg[i] = ((const f32x4*)sk)[i * 64 + lane];
#pragma unroll 1
        for (int kc = 0; kc < 8; ++kc) {
#pragma unroll
            for (int i = 0; i < 8; ++i) ((LAS f32x4*)scr)[i * 64 + lane] = stg[i];
            if (kc + 1 < 8) {
#pragma unroll
                for (int i = 0; i < 8; ++i) stg[i] = ((const f32x4*)(sk + (kc + 1) * 2048))[i * 64 + lane]; }
            LDS_WAIT(); asm volatile("" ::: "memory");
#pragma unroll 2
            for (int key = 0; key < 16; ++key) {
                const LAS f32x4* s4 = (const LAS f32x4*)(scr + key * 128 + dh * 64);
                float acc = 0.f;
#pragma unroll
                for (int d = 0; d < 16; ++d) { const f32x4 sv = s4[d]; acc += (q[d].x * sv.x + q[d].y * sv.y) + (q[d].z * sv.z + q[d].w * sv.w); }
                acc += __shfl_xor(acc, 1);
                if (dh == 0) o[(size_t)(kc * 16 + key) * DM] = f2bf(acc);
            }
            LDS_WAIT(); asm volatile("" ::: "memory");
        }
    }
    {
        const int gt = F.vcu * NTHR + F.tid, GT = F.G * NTHR;
        bf16_t* AW = (bf16_t*)(ws + m.auxwt); bf16_t* LW = (bf16_t*)(ws + m.lruwt); bf16_t* VW = (bf16_t*)(ws + m.vreswt); float* PP = (float*)(ws + m.pp);
        for (int it = gt; it < NL * 1792 * 384; it += GT) {
            const int l = it / (1792 * 384), r = it % (1792 * 384), n = r / 384, k = r % 384;
            float v = 0.f;
            if (n < 512) { if (k < 64) v = a.in[I_RW_W_UP][(size_t)l * 64 * 512 + k * 512 + n]; }
            else if (n < 1024) { if (k >= 64 && k < 128) v = a.in[I_RW_A_UP][(size_t)l * 64 * 512 + (k - 64) * 512 + (n - 512)]; }
            else if (n < 1536) { if (k >= 128 && k < 256) v = a.in[I_RW_G_UP][(size_t)l * 128 * 512 + (k - 128) * 512 + (n - 1024)]; }
            else { if (k >= 256 && k < 272) v = a.in[I_GLA_A_UP][(size_t)l * 16 * 256 + (k - 256) * 256 + (n - 1536)]; }
            AW[it] = f2bf(v);
        }
        for (int it = gt; it < NL * 1024 * 512; it += GT) {
            const int l = it / (1024 * 512), r = it % (1024 * 512), n = r / 512, k = r % 512;
            const int nn = n & 511, blk = nn >> 6, j = nn & 63;
            float v = 0.f;
            if ((k >> 6) == blk) v = (n < 512 ? a.in[I_LRU_W_R] : a.in[I_LRU_W_I])[(size_t)l * 8 * 64 * 64 + (size_t)blk * 4096 + (k & 63) * 64 + j];
            LW[it] = f2bf(v);
        }
        for (int it = gt; it < 512 * 512; it += GT) {
            const int n = it / 512, k = it % 512;
            float s = 0.f;
            for (int i = 0; i < 32; ++i) s += a.in[I_RW_V_DOWN][k * 32 + i] * a.in[I_RW_V_UP][i * 512 + n];
            VW[it] = f2bf(s);
        }
        for (int it = gt; it < 6144; it += GT) {
            float v = 0.f;
            if (it < 3584) { const int l = it / 1792, c = it % 1792;
                v = c < 512 ? a.in[I_RW_W0][l * 512 + c] : (c < 1024 ? a.in[I_RW_A0][l * 512 + c - 512] : (c < 1536 ? 0.f : a.in[I_GLA_A_BIAS][l * 256 + c - 1536])); }
            else if (it < 5632) { const int l = (it - 3584) / 1024, c = (it - 3584) % 1024; v = c < 512 ? a.in[I_LRU_B_R][l * 512 + c] : a.in[I_LRU_B_I][l * 512 + c - 512]; }
            else v = a.in[I_RW_V0][it - 5632];
            PP[it] = v;
        }
    }
}

__device__ __forceinline__ unsigned pk4_fp8(float a, float b, float c, float d) {
    int w = 0;
    w = __builtin_amdgcn_cvt_pk_fp8_f32(__builtin_fmaxf(__builtin_fminf(a, 448.f), -448.f), __builtin_fmaxf(__builtin_fminf(b, 448.f), -448.f), w, false);
    w = __builtin_amdgcn_cvt_pk_fp8_f32(__builtin_fmaxf(__builtin_fminf(c, 448.f), -448.f), __builtin_fmaxf(__builtin_fminf(d, 448.f), -448.f), w, true);
    return (unsigned)w;
}
constexpr size_t TSL = 128;
constexpr float TSTEP = 0.3352f;

template <int CTRL> __device__ __forceinline__ float dpp_f(float v) { return __builtin_bit_cast(float, __builtin_amdgcn_update_dpp(0, __builtin_bit_cast(int, v), CTRL, 0xF, 0xF, true)); }
__device__ __forceinline__ float rdlane_f(float v, int l) { return __builtin_bit_cast(float, __builtin_amdgcn_readlane(__builtin_bit_cast(int, v), l)); }
__device__ __forceinline__ float row16_sum(float v) {
    v += dpp_f<0xB1>(v); v += dpp_f<0x4E>(v); v += dpp_f<0x141>(v); v += dpp_f<0x140>(v); return v;
}
__device__ __forceinline__ float wave_sum_u(float v) {
    v = row16_sum(v);
    return (rdlane_f(v, 0) + rdlane_f(v, 16)) + (rdlane_f(v, 32) + rdlane_f(v, 48));
}
typedef __bf16 bf16x2_t __attribute__((ext_vector_type(2)));
__device__ __forceinline__ float dot2bf(unsigned w, unsigned x, float acc) { return __builtin_amdgcn_fdot2_f32_bf16(__builtin_bit_cast(bf16x2_t, w), __builtin_bit_cast(bf16x2_t, x), acc, false); }
__device__ __forceinline__ void tables_range(const Args& a, Frame& F, size_t it0, size_t it1, int sub, int nsub) {
    const WsMap m = ws_map(NTOK);
    const size_t per = (size_t)NEXP * DM / 32;
    const size_t stride = (size_t)nsub * NTHR;
    float* tsc = (float*)(a.ws + m.tsc);
    for (size_t base = it0 + (size_t)sub * NTHR + F.tid; base < it1; base += 2 * stride) {
        f32x4 v[2][8];
#pragma unroll
        for (int u = 0; u < 2; ++u) { const size_t it = base + u * stride;
            if (it < it1) { const int tb = (int)(it / per); const size_t r = it % per;
                const f32x4* srcp = (const f32x4*)(((tb & 1) ? a.in[I_PEER_V] : a.in[I_PEER_U]) + (size_t)(tb >> 1) * NEXP * DM + r * 32);
#pragma unroll
                for (int q = 0; q < 8; ++q) v[u][q] = __builtin_nontemporal_load(srcp + q); } }
#pragma unroll
        for (int u = 0; u < 2; ++u) { const size_t it = base + u * stride;
            if (it < it1) { const int tb = (int)(it / per); const size_t r = it % per;
                float ss = 0.f;
#pragma unroll
                for (int q = 0; q < 8; ++q) ss += (v[u][q].x * v[u][q].x + v[u][q].y * v[u][q].y) + (v[u][q].z * v[u][q].z + v[u][q].w * v[u][q].w);
                const float rms = sqrtf(wave_sum_u(ss) * (1.0f / DM));
                float step = rms * TSTEP; const float inv = rms > 0.f ? 1.0f / step : 0.f;
                v4u w;
                if (tb & 1) {
                    const float sc = rms > 0.f ? 2.05f / rms : 0.f; step = rms * (1.0f / 2.05f);
#pragma unroll
                    for (int d = 0; d < 4; ++d) { unsigned p = 0;
                        p = __builtin_amdgcn_cvt_scalef32_pk_fp4_f32(p, __builtin_fmaxf(__builtin_fminf(v[u][2 * d].x * sc, 6.f), -6.f), __builtin_fmaxf(__builtin_fminf(v[u][2 * d].y * sc, 6.f), -6.f), 1.0f, 0);
                        p = __builtin_amdgcn_cvt_scalef32_pk_fp4_f32(p, __builtin_fmaxf(__builtin_fminf(v[u][2 * d].z * sc, 6.f), -6.f), __builtin_fmaxf(__builtin_fminf(v[u][2 * d].w * sc, 6.f), -6.f), 1.0f, 1);
                        p = __builtin_amdgcn_cvt_scalef32_pk_fp4_f32(p, __builtin_fmaxf(__builtin_fminf(v[u][2 * d + 1].x * sc, 6.f), -6.f), __builtin_fmaxf(__builtin_fminf(v[u][2 * d + 1].y * sc, 6.f), -6.f), 1.0f, 2);
                        p = __builtin_amdgcn_cvt_scalef32_pk_fp4_f32(p, __builtin_fmaxf(__builtin_fminf(v[u][2 * d + 1].z * sc, 6.f), -6.f), __builtin_fmaxf(__builtin_fminf(v[u][2 * d + 1].w * sc, 6.f), -6.f), 1.0f, 3);
                        w[d] = p; }
                } else
#pragma unroll
                for (int d = 0; d < 4; ++d) {
                    const f32x4 lo = v[u][2 * d], hi = v[u][2 * d + 1]; unsigned p = 0;
#pragma unroll
                    for (int b = 0; b < 4; ++b) {
                        const int cl = (int)__builtin_fminf(__builtin_fmaxf(__builtin_floorf(lo[b] * inv), -8.0f), 7.0f);
                        const int ch = (int)__builtin_fminf(__builtin_fmaxf(__builtin_floorf(hi[b] * inv), -8.0f), 7.0f);
                        p |= (((unsigned)cl & 15u) << (4 * b)) | (((unsigned)ch & 15u) << (16 + 4 * b)); }
                    w[d] = p; }
                *(v4u*)((unsigned char*)(a.ws + m.tabu) + (((size_t)tb * 8 + (r & 63) / 8) * NEXP + (r >> 6)) * TSL + (r & 7) * 16) = w;
                if (F.lane == 0) tsc[(size_t)tb * NEXP + (r >> 6)] = step; } }
    }
}

__device__ __forceinline__ float gelu_fast(float x) {
    const float u = 1.5957691216057308f * (x + 0.044715f * x * x * x);
    return x / (1.0f + __expf(-u));
}


__device__ __forceinline__ float sigm(float x) { return 1.0f / (1.0f + __expf(-x)); }
__device__ __forceinline__ float softplus_f(float x) { return __logf(1.0f + __expf(-fabsf(x))) + fmaxf(x, 0.0f); }
__device__ __forceinline__ float tanh_f(float x) { return 1.0f - 2.0f / (1.0f + __expf(2.0f * x)); }
__device__ __forceinline__ float red8(float v) { v += dpp_f<0xB1>(v); v += dpp_f<0x4E>(v); v += dpp_f<0x141>(v); return v; }
__device__ __forceinline__ v4u ld8(const bf16_t* p) { return *(const v4u*)p; }
__device__ __forceinline__ void unpack8(const v4u w, float (&f)[8]) { f[0] = bflo(w.x); f[1] = bfhi(w.x); f[2] = bflo(w.y); f[3] = bfhi(w.y); f[4] = bflo(w.z); f[5] = bfhi(w.z); f[6] = bflo(w.w); f[7] = bfhi(w.w); }
__device__ __forceinline__ v4u pack8(const float (&f)[8]) { v4u w; w.x = pk2(f[0], f[1]); w.y = pk2(f[2], f[3]); w.z = pk2(f[4], f[5]); w.w = pk2(f[6], f[7]); return w; }

__device__ __forceinline__ void prep_phase(const Args& a, Frame& F, int l) {
    const WsMap m = ws_map(NTOK);
    const bf16_t* p16 = (const bf16_t*)(a.ws + m.p16);
    bf16_t* zrkv = (bf16_t*)(a.ws + m.zrkv); bf16_t* auxA = (bf16_t*)(a.ws + m.auxA); bf16_t* xc = (bf16_t*)(a.ws + m.xc);
    const float* mu = a.in[I_RW_MU] + l * 1792;
#pragma unroll 4
    for (size_t it = (size_t)F.vcu * NTHR + F.tid; it < (size_t)NTOK * 224; it += (size_t)F.G * NTHR) {
        const int n = (int)(it / 224), j = (int)(it % 224), t = n % TSEQ;
        const int col = j * 8;
        float cur[8], prv[8], z[8];
        unpack8(ld8(p16 + (size_t)n * PLD + col), cur);
        unpack8(ld8(p16 + (size_t)(t > 0 ? n - 1 : n) * PLD + col), prv);
        const f32x4 m0 = *(const f32x4*)(mu + col), m1 = *(const f32x4*)(mu + col + 4);
        const float mm[8] = {m0.x, m0.y, m0.z, m0.w, m1.x, m1.y, m1.z, m1.w};
#pragma unroll
        for (int k = 0; k < 8; ++k) z[k] = cur[k] + ((t > 0 ? prv[k] : 0.f) - cur[k]) * mm[k];
        if (col < 1536) *(v4u*)(zrkv + (size_t)n * 1536 + col) = pack8(z);
        else {
            const int c = col - 1536;
#pragma unroll
            for (int k = 0; k < 8; ++k) z[k] = c < 64 ? tanh_f(z[k]) : (c < 128 ? z[k] : sigm(z[k]));
            *(v4u*)(auxA + (size_t)n * 384 + c) = pack8(z);
        }
    }
    for (size_t it = (size_t)F.vcu * NTHR + F.tid; it < (size_t)NTOK * 16; it += (size_t)F.G * NTHR) {
        const int n = (int)(it / 16), c = 256 + (int)(it % 16) * 8;
        v4u w = (v4u){0u, 0u, 0u, 0u};
        if (c < 272) w = ld8(p16 + (size_t)n * PLD + C_GLA + 1536 + (c - 256));
        *(v4u*)(auxA + (size_t)n * 384 + c) = w;
    }
#pragma unroll 2
    for (size_t it = (size_t)F.vcu * NTHR + F.tid; it < (size_t)NTOK * 64; it += (size_t)F.G * NTHR) {
        const int n = (int)(it / 64), c = (int)(it % 64) * 8, t = n % TSEQ;
        float acc[8];
        { const f32x4 b0 = *(const f32x4*)(a.in[I_LRU_CONV_B] + l * 512 + c), b1 = *(const f32x4*)(a.in[I_LRU_CONV_B] + l * 512 + c + 4);
          acc[0] = b0.x; acc[1] = b0.y; acc[2] = b0.z; acc[3] = b0.w; acc[4] = b1.x; acc[5] = b1.y; acc[6] = b1.z; acc[7] = b1.w; }
        v4u raw[4];
#pragma unroll
        for (int jj = 0; jj < 4; ++jj) raw[jj] = ld8(p16 + (size_t)(t - 3 + jj >= 0 ? n - 3 + jj : n) * PLD + C_LRU + c);
#pragma unroll
        for (int jj = 0; jj < 4; ++jj) {
            float xv[8]; unpack8(raw[jj], xv);
            const float ok = (t - 3 + jj >= 0) ? 1.0f : 0.0f;
            const float* cw = a.in[I_LRU_CONV_W] + (size_t)l * 4 * 512 + jj * 512 + c;
            const f32x4 w0 = *(const f32x4*)cw * ok, w1 = *(const f32x4*)(cw + 4) * ok;
            acc[0] += w0.x * xv[0]; acc[1] += w0.y * xv[1]; acc[2] += w0.z * xv[2]; acc[3] += w0.w * xv[3];
            acc[4] += w1.x * xv[4]; acc[5] += w1.y * xv[5]; acc[6] += w1.z * xv[6]; acc[7] += w1.w * xv[7];
        }
        *(v4u*)(xc + (size_t)n * 512 + c) = pack8(acc);
    }
    {
        bf16_t* gq = (bf16_t*)(a.ws + m.gq); bf16_t* gk = (bf16_t*)(a.ws + m.gk); bf16_t* gv = (bf16_t*)(a.ws + m.gv); float* gsc = (float*)(a.ws + m.gsc);
        const float* cw = a.in[I_GDN_CONV_W] + (size_t)l * 4 * 1536;
        const int lane = F.lane;
        for (int n = F.gw; n < NTOK; n += F.ngw) {
            const int t = n % TSEQ;
#pragma unroll
            for (int part = 0; part < 3; ++part) {
                const int cb = part * 512 + lane * 8;
                float acc[8];
#pragma unroll
                for (int k = 0; k < 8; ++k) acc[k] = 0.f;
#pragma unroll
                for (int jj = 0; jj < 4; ++jj) {
                    if (t - 3 + jj >= 0) {
                        float xv[8]; unpack8(ld8(p16 + (size_t)(n - 3 + jj) * PLD + C_GDN + cb), xv);
                        const f32x4 w0 = *(const f32x4*)(cw + jj * 1536 + cb), w1 = *(const f32x4*)(cw + jj * 1536 + cb + 4);
                        acc[0] += w0.x * xv[0]; acc[1] += w0.y * xv[1]; acc[2] += w0.z * xv[2]; acc[3] += w0.w * xv[3];
                        acc[4] += w1.x * xv[4]; acc[5] += w1.y * xv[5]; acc[6] += w1.z * xv[6]; acc[7] += w1.w * xv[7];
                    }
                }
                float ss = 0.f;
#pragma unroll
                for (int k = 0; k < 8; ++k) { acc[k] = acc[k] * sigm(acc[k]); ss += acc[k] * acc[k]; }
                if (part < 2) {
                    ss = row16_sum(ss);
                    const float inv = (1.0f / sqrtf(ss + 1e-6f)) * (part == 0 ? 0.08838834764831845f : 1.0f);
#pragma unroll
                    for (int k = 0; k < 8; ++k) acc[k] *= inv;
                }
                *(v4u*)((part == 0 ? gq : (part == 1 ? gk : gv)) + (size_t)n * 512 + lane * 8) = pack8(acc);
            }
            if (lane < 4) {
                gsc[(size_t)n * 8 + lane] = sigm(bf2f(p16[(size_t)n * PLD + C_GDN + 2048 + lane]));
                gsc[(size_t)n * 8 + 4 + lane] = -__expf(a.in[I_GDN_A_LOG][l * 4 + lane]) * softplus_f(bf2f(p16[(size_t)n * PLD + C_GDN + 2052 + lane]) + a.in[I_GDN_DT_BIAS][l * 4 + lane]);
            }
        }
    }
}

__device__ __forceinline__ float swz16(float v) { return __builtin_bit_cast(float, __builtin_amdgcn_ds_swizzle(__builtin_bit_cast(int, v), 0x401F)); }
__device__ __forceinline__ float red32(float v) { v = row16_sum(v); return v + swz16(v); }

__device__ __forceinline__ void rwkv_task(const Args& a, Frame& F, int l, int task) {
    const WsMap m = ws_map(NTOK);
    const int b = task >> 4, h = (task >> 1) & 7, hf = task & 1;
    LAS float* LR = (LAS float*)F.lds; LAS float* LW = LR + 2048; LAS float* LK = LW + 2048; LAS float* LA = LK + 2048; LAS float* LB = LA + 2048;
    LAS float* LV = LB + 2048; LAS float* LY = LV + 1024;
    const int lane = F.lane, w = F.wave, tid = F.tid;
    const int ch = h * 64 + lane;
    const bool mine = (lane >> 5) == hf;
    const float kk_ = a.in[I_RW_K_K][l * 512 + ch], ka_ = a.in[I_RW_K_A][l * 512 + ch], rk_ = a.in[I_RW_R_K][l * 512 + ch];
    const bf16_t* zr = (const bf16_t*)(a.ws + m.zrkv); const bf16_t* ao = (const bf16_t*)(a.ws + m.auxo); const bf16_t* vr = (const bf16_t*)(a.ws + m.vres);
    float* vf = (float*)(a.ws + m.vfirst); bf16_t* yo = (bf16_t*)(a.ws + m.rwy); bf16_t* bvo = (bf16_t*)(a.ws + m.rwbv);
    float S0 = 0.f, S1 = 0.f, S2 = 0.f, S3 = 0.f;
    const int row = tid >> 4, ks = tid & 15;
    float in_[4][7];
    auto load_chunk = [&](int c) {
#pragma unroll
        for (int q = 0; q < 4; ++q) { const size_t n = (size_t)b * TSEQ + c * 32 + w + 8 * q;
            in_[q][0] = bf2f(zr[n * 1536 + ch]); in_[q][1] = bf2f(zr[n * 1536 + 512 + ch]); in_[q][2] = bf2f(zr[n * 1536 + 1024 + ch]);
            in_[q][3] = bf2f(ao[n * 1792 + ch]); in_[q][4] = bf2f(ao[n * 1792 + 512 + ch]);
            if (l > 0) { in_[q][5] = bf2f(vr[n * 512 + ch]); in_[q][6] = vf[n * 512 + ch]; } else { in_[q][5] = 0.f; in_[q][6] = 0.f; } }
    };
    load_chunk(0);
    for (int c = 0; c < TSEQ / 32; ++c) {
#pragma unroll
        for (int q = 0; q < 4; ++q) {
            const int tl = w + 8 * q; const size_t n = (size_t)b * TSEQ + c * 32 + tl;
            const float zr_ = in_[q][0], zk_ = in_[q][1], zv_ = in_[q][2], wp = in_[q][3], ap = in_[q][4];
            float v = zv_;
            if (l == 0) { if (mine) vf[n * 512 + ch] = zv_; } else v = zv_ + (in_[q][6] - zv_) * sigm(in_[q][5]);
            const float w_raw = -softplus_f(-wp) - 0.5f, dec = __expf(-__expf(w_raw));
            const float aa = sigm(ap);
            const float kkraw = zk_ * kk_;
            const float ss = wave_sum_u(kkraw * kkraw);
            const float kk = kkraw * (1.0f / sqrtf(fmaxf(ss, 1e-24f)));
            const float km = zk_ * (1.0f + (aa - 1.0f) * ka_);
            const float bon = wave_sum_u(zr_ * km * rk_);
            LR[tl * 64 + lane] = zr_; LW[tl * 64 + lane] = dec; LK[tl * 64 + lane] = km; LA[tl * 64 + lane] = -kk; LB[tl * 64 + lane] = kk * aa;
            if (mine) { LV[tl * 32 + (lane & 31)] = v; bvo[n * 512 + ch] = f2bf(bon * v); }
        }
        __syncthreads();
        if (c + 1 < TSEQ / 32) load_chunk(c + 1);
        float keep0 = 0.f, keep1 = 0.f;
#pragma unroll 4
        for (int tl = 0; tl < 32; ++tl) {
            const int o = tl * 64 + ks * 4;
            const f32x4 a4 = *(const LAS f32x4*)(LA + o), w4 = *(const LAS f32x4*)(LW + o), b4 = *(const LAS f32x4*)(LB + o), k4 = *(const LAS f32x4*)(LK + o), r4 = *(const LAS f32x4*)(LR + o);
            const float vv = LV[tl * 32 + row];
            const float sa = row16_sum((S0 * a4.x + S1 * a4.y) + (S2 * a4.z + S3 * a4.w));
            S0 = S0 * w4.x + (sa * b4.x + vv * k4.x); S1 = S1 * w4.y + (sa * b4.y + vv * k4.y); S2 = S2 * w4.z + (sa * b4.z + vv * k4.z); S3 = S3 * w4.w + (sa * b4.w + vv * k4.w);
            const float y = row16_sum((S0 * r4.x + S1 * r4.y) + (S2 * r4.z + S3 * r4.w));
            keep0 = (ks == tl) ? y : keep0; keep1 = (ks + 16 == tl) ? y : keep1;
        }
        LY[ks * 32 + row] = keep0; LY[(16 + ks) * 32 + row] = keep1;
        __syncthreads();
        { const int tl = tid >> 4, r2 = (tid & 15) * 2; const size_t n = (size_t)b * TSEQ + c * 32 + tl;
          *(unsigned*)(yo + n * 512 + h * 64 + hf * 32 + r2) = pk2(LY[tl * 32 + r2], LY[tl * 32 + r2 + 1]); }
    }
}


__device__ __forceinline__ void chunk_cumsum8(float (&x)[8], LAS float* tmp, int lane, int w, int c8) {
#pragma unroll
    for (int d = 8; d < 64; d <<= 1) {
#pragma unroll
        for (int k = 0; k < 8; ++k) { const float t = __shfl_up(x[k], d); if (lane >= d) x[k] += t; }
    }
    if (lane >= 56) { *(LAS f32x4*)(tmp + w * 64 + c8) = (f32x4){x[0], x[1], x[2], x[3]}; *(LAS f32x4*)(tmp + w * 64 + c8 + 4) = (f32x4){x[4], x[5], x[6], x[7]}; }
    __syncthreads();
    for (int ww = 0; ww < w; ++ww) { const f32x4 a0 = *(const LAS f32x4*)(tmp + ww * 64 + c8), a1 = *(const LAS f32x4*)(tmp + ww * 64 + c8 + 4);
        x[0] += a0.x; x[1] += a0.y; x[2] += a0.z; x[3] += a0.w; x[4] += a1.x; x[5] += a1.y; x[6] += a1.z; x[7] += a1.w; }
}

constexpr int RWP = 72;
constexpr int RWT = 64 * RWP;
constexpr size_t RWB_TILES = 4 * RWT * 2;
constexpr size_t RWB_DVEC = RWB_TILES;
constexpr size_t RWB_VS = RWB_DVEC + 256;
constexpr size_t RWB_BYTES = RWB_VS + 4 * 3 * 64 * 16 * 2;

__device__ __forceinline__ f32x4 mm64(const LAS bf16_t* A, const LAS bf16_t* Bt, int mt, int nt, int lane, f32x4 acc) {
    const LAS bf16_t* ap = A + (mt * 16 + (lane & 15)) * RWP + (lane >> 4) * 8;
    const LAS bf16_t* bp = Bt + (nt * 16 + (lane & 15)) * RWP + (lane >> 4) * 8;
#pragma unroll
    for (int k0 = 0; k0 < 64; k0 += 32)
        acc = __builtin_amdgcn_mfma_f32_16x16x32_bf16(*(const LAS bf16x8*)(ap + k0), *(const LAS bf16x8*)(bp + k0), acc, 0, 0, 0);
    return acc;
}
__device__ __forceinline__ void st_rowmajor(LAS bf16_t* T, int mt, int nt, int lane, const f32x4 v) {
    const int n = nt * 16 + (lane & 15), i0 = mt * 16 + (lane >> 4) * 4;
    T[(i0 + 0) * RWP + n] = f2bf(v.x); T[(i0 + 1) * RWP + n] = f2bf(v.y); T[(i0 + 2) * RWP + n] = f2bf(v.z); T[(i0 + 3) * RWP + n] = f2bf(v.w);
}
__device__ __forceinline__ void st_transposed(LAS bf16_t* T, int mt, int nt, int lane, const f32x4 v) {
    const int n = nt * 16 + (lane & 15), i0 = mt * 16 + (lane >> 4) * 4;
    *(LAS v2u*)(T + n * RWP + i0) = (v2u){pk2(v.x, v.y), pk2(v.z, v.w)};
}

__device__ __forceinline__ void rwkv_pa_chunk(const Args& a, Frame& F, int l, int ci) {
    const WsMap m = ws_map(NTOK);
    const int bh = ci >> 6, c = ci & 63, b = bh >> 3, h = bh & 7;
    const int lane = F.lane, w = F.wave, tid = F.tid;
    const int ch = h * 64 + lane;
    LAS bf16_t* At = (LAS bf16_t*)F.lds; LAS bf16_t* AtT = At + RWT; LAS bf16_t* Bt = AtT + RWT; LAS bf16_t* Kt = Bt + RWT; LAS bf16_t* KtGT = Kt + RWT;
    LAS bf16_t* Rt = KtGT + RWT; LAS bf16_t* VmT = Rt + RWT; LAS bf16_t* LAK = VmT + RWT;
    LAS bf16_t* X0 = LAK + RWT; LAS bf16_t* XT0 = X0 + RWT; LAS bf16_t* T0 = XT0 + RWT; LAS bf16_t* X1 = T0 + RWT; LAS bf16_t* XT1 = X1 + RWT; LAS bf16_t* T1 = XT1 + RWT;
    LAS float* LWL = (LAS float*)X0;
    LAS bf16_t* A2 = X1;
    LAS bf16_t* LVT = XT1;
    const bf16_t* zr = (const bf16_t*)(a.ws + m.zrkv); const bf16_t* ao = (const bf16_t*)(a.ws + m.auxo); const bf16_t* vr = (const bf16_t*)(a.ws + m.vres);
    float* vf = (float*)(a.ws + m.vfirst); bf16_t* bvo = (bf16_t*)(a.ws + m.rwbv);
    unsigned char* blob = a.ws + m.xn + (size_t)ci * RWB_BYTES;
    bf16_t* gW = (bf16_t*)blob; bf16_t* gQG = gW + RWT; bf16_t* gKGT = gQG + RWT; bf16_t* gA1 = gKGT + RWT;
    float* gDV = (float*)(blob + RWB_DVEC); bf16_t* gVS = (bf16_t*)(blob + RWB_VS);
    const int j = tid >> 3, c8 = (tid & 7) * 8, chb = h * 64 + c8;
    const size_t n = (size_t)b * TSEQ + c * 64 + j;
    float zr_[8], zk_[8], zv_[8], wp[8], ap[8];
    unpack8(ld8(zr + n * 1536 + chb), zr_); unpack8(ld8(zr + n * 1536 + 512 + chb), zk_); unpack8(ld8(zr + n * 1536 + 1024 + chb), zv_);
    unpack8(ld8(ao + n * 1792 + chb), wp); unpack8(ld8(ao + n * 1792 + 512 + chb), ap);
    float vres8[8], vf8[8];
    if (l > 0) { unpack8(ld8(vr + n * 512 + chb), vres8); const f32x4 f0 = *(const f32x4*)(vf + n * 512 + chb), f1 = *(const f32x4*)(vf + n * 512 + chb + 4);
        vf8[0] = f0.x; vf8[1] = f0.y; vf8[2] = f0.z; vf8[3] = f0.w; vf8[4] = f1.x; vf8[5] = f1.y; vf8[6] = f1.z; vf8[7] = f1.w; }
    float lw[8];
#pragma unroll
    for (int k = 0; k < 8; ++k) lw[k] = -__expf(-softplus_f(-wp[k]) - 0.5f);
    float cs[8];
#pragma unroll
    for (int k = 0; k < 8; ++k) cs[k] = lw[k];
    chunk_cumsum8(cs, LWL, lane, w, c8);
    {
        float pk_[8], pa_[8], pr_[8];
        { const float* p0 = a.in[I_RW_K_K] + l * 512 + chb; const float* p1 = a.in[I_RW_K_A] + l * 512 + chb; const float* p2 = a.in[I_RW_R_K] + l * 512 + chb;
          const f32x4 a0 = *(const f32x4*)p0, a1 = *(const f32x4*)(p0 + 4), b0 = *(const f32x4*)p1, b1 = *(const f32x4*)(p1 + 4), c0 = *(const f32x4*)p2, c1 = *(const f32x4*)(p2 + 4);
          pk_[0] = a0.x; pk_[1] = a0.y; pk_[2] = a0.z; pk_[3] = a0.w; pk_[4] = a1.x; pk_[5] = a1.y; pk_[6] = a1.z; pk_[7] = a1.w;
          pa_[0] = b0.x; pa_[1] = b0.y; pa_[2] = b0.z; pa_[3] = b0.w; pa_[4] = b1.x; pa_[5] = b1.y; pa_[6] = b1.z; pa_[7] = b1.w;
          pr_[0] = c0.x; pr_[1] = c0.y; pr_[2] = c0.z; pr_[3] = c0.w; pr_[4] = c1.x; pr_[5] = c1.y; pr_[6] = c1.z; pr_[7] = c1.w; }
        float v[8], aa[8], kk[8], km[8];
        float ss = 0.f, bs = 0.f;
#pragma unroll
        for (int k = 0; k < 8; ++k) {
            v[k] = (l == 0) ? zv_[k] : zv_[k] + (vf8[k] - zv_[k]) * sigm(vres8[k]);
            aa[k] = sigm(ap[k]);
            kk[k] = zk_[k] * pk_[k]; ss += kk[k] * kk[k];
            km[k] = zk_[k] * (1.0f + (aa[k] - 1.0f) * pa_[k]); bs += zr_[k] * km[k] * pr_[k];
        }
        if (l == 0) { *(f32x4*)(vf + n * 512 + chb) = (f32x4){zv_[0], zv_[1], zv_[2], zv_[3]}; *(f32x4*)(vf + n * 512 + chb + 4) = (f32x4){zv_[4], zv_[5], zv_[6], zv_[7]}; }
        ss = red8(ss); bs = red8(bs);
        const float kinv = 1.0f / sqrtf(fmaxf(ss, 1e-24f));
        float cm[8], gcv[8];
        {
#pragma unroll
          for (int k = 0; k < 8; ++k) gcv[k] = 0.f;
#pragma unroll
          for (int ww = 0; ww < 8; ++ww) { const f32x4 g0 = *(const LAS f32x4*)(LWL + ww * 64 + c8), g1 = *(const LAS f32x4*)(LWL + ww * 64 + c8 + 4);
              gcv[0] += g0.x; gcv[1] += g0.y; gcv[2] += g0.z; gcv[3] += g0.w; gcv[4] += g1.x; gcv[5] += g1.y; gcv[6] += g1.z; gcv[7] += g1.w; } }
#pragma unroll
        for (int k = 0; k < 8; ++k) cm[k] = cs[k] - lw[k];
        float t_at[8], t_bt[8], t_kt[8], t_rt[8], t_bv[8];
        LAS bf16_t* KGTl = T1;
#pragma unroll
        for (int k = 0; k < 8; ++k) {
            const float G = __expf(cs[k]), Gm1 = __expf(cm[k]), iG = __expf(-cs[k]), GcG = __expf(gcv[k] - cs[k]);
            const float kkn = kk[k] * kinv;
            const float av = -kkn, bv = kkn * aa[k];
            t_at[k] = av * Gm1; t_bt[k] = bv * iG; t_kt[k] = km[k] * iG; t_rt[k] = zr_[k] * G; t_bv[k] = bs * v[k];
            AtT[(c8 + k) * RWP + j] = f2bf(t_at[k]);
            KtGT[(c8 + k) * RWP + j] = f2bf(km[k] * GcG);
            VmT[(c8 + k) * RWP + j] = f2bf(v[k]);
            KGTl[(c8 + k) * RWP + j] = f2bf(bv * GcG);
        }
        *(LAS v4u*)(At + j * RWP + c8) = pack8(t_at); *(LAS v4u*)(Bt + j * RWP + c8) = pack8(t_bt); *(LAS v4u*)(Kt + j * RWP + c8) = pack8(t_kt);
        const v4u rt8 = pack8(t_rt);
        *(LAS v4u*)(Rt + j * RWP + c8) = rt8; *(v4u*)(gQG + j * RWP + c8) = rt8;
        *(v4u*)(bvo + n * 512 + chb) = pack8(t_bv);
        if (j == 63) { *(f32x4*)(gDV + c8) = (f32x4){__expf(gcv[0]), __expf(gcv[1]), __expf(gcv[2]), __expf(gcv[3])}; *(f32x4*)(gDV + c8 + 4) = (f32x4){__expf(gcv[4]), __expf(gcv[5]), __expf(gcv[6]), __expf(gcv[7])}; }
    }
    __syncthreads();
    {
        for (int o = tid; o < RWT / 8; o += NTHR) ((v4u*)gKGT)[o] = ((const LAS v4u*)T1)[o];
        f32x4 z4 = {0.f, 0.f, 0.f, 0.f};
#pragma unroll 1
        for (int tt = 0; tt < 2; ++tt) {
            const int t = w + 8 * tt, mt = t >> 2, nt = t & 3;
            const int n = nt * 16 + (lane & 15), i0 = mt * 16 + (lane >> 4) * 4;
            f32x4 lab = mm64(At, Bt, mt, nt, lane, z4), lak = mm64(At, Kt, mt, nt, lane, z4), a1 = mm64(Rt, Bt, mt, nt, lane, z4), a2 = mm64(Rt, Kt, mt, nt, lane, z4);
            f32x4 tt0;
#pragma unroll
            for (int e = 0; e < 4; ++e) { const int i = i0 + e;
                if (n >= i) { lab[e] = 0.f; lak[e] = 0.f; }
                if (n > i) { a1[e] = 0.f; a2[e] = 0.f; }
                tt0[e] = lab[e] + (n == i ? 1.0f : 0.f); }
            st_rowmajor(X0, mt, nt, lane, lab); st_transposed(XT0, mt, nt, lane, lab);
            st_rowmajor(T0, mt, nt, lane, tt0);
            st_rowmajor(LAK, mt, nt, lane, lak);
            st_rowmajor(A2, mt, nt, lane, a2);
            gA1[(i0 + 0) * RWP + n] = f2bf(a1.x); gA1[(i0 + 1) * RWP + n] = f2bf(a1.y); gA1[(i0 + 2) * RWP + n] = f2bf(a1.z); gA1[(i0 + 3) * RWP + n] = f2bf(a1.w);
        }
    }
    __syncthreads();
    {
        f32x4 z4 = {0.f, 0.f, 0.f, 0.f};
#pragma unroll 1
        for (int tt = 0; tt < 2; ++tt) {
            const int t = w + 8 * tt, mt = t >> 2, nt = t & 3;
            const int n = nt * 16 + (lane & 15), i0 = mt * 16 + (lane >> 4) * 4;
            const f32x4 lv = mm64(LAK, VmT, mt, nt, lane, z4), o0 = mm64(A2, VmT, mt, nt, lane, z4), kv0 = mm64(KtGT, VmT, mt, nt, lane, z4);
            st_transposed((LAS bf16_t*)(F.lds + 131584), mt, nt, lane, lv);
            bf16_t* go = gVS + (size_t)nt * 3 * 1024 + 1024;
            const int r = lane & 15;
            go[(i0 + 0) * 16 + r] = f2bf(o0.x); go[(i0 + 1) * 16 + r] = f2bf(o0.y); go[(i0 + 2) * 16 + r] = f2bf(o0.z); go[(i0 + 3) * 16 + r] = f2bf(o0.w);
            go[1024 + (i0 + 0) * 16 + r] = f2bf(kv0.x); go[1024 + (i0 + 1) * 16 + r] = f2bf(kv0.y); go[1024 + (i0 + 2) * 16 + r] = f2bf(kv0.z); go[1024 + (i0 + 3) * 16 + r] = f2bf(kv0.w);
            (void)n;
        }
    }
    __syncthreads();
    {
        LAS bf16_t* Xc = X0; LAS bf16_t* XTc = XT0; LAS bf16_t* Tc = T0; LAS bf16_t* Xn = X1; LAS bf16_t* XTn = XT1; LAS bf16_t* Tn = T1;
        f32x4 z4 = {0.f, 0.f, 0.f, 0.f};
#pragma unroll 1
        for (int it = 0; it < 5; ++it) {
#pragma unroll 1
            for (int tt = 0; tt < 2; ++tt) { const int t = w + 8 * tt, mt = t >> 2, nt = t & 3;
                const f32x4 x2 = mm64(Xc, XTc, mt, nt, lane, z4);
                st_rowmajor(Xn, mt, nt, lane, x2); st_transposed(XTn, mt, nt, lane, x2); }
            __syncthreads();
#pragma unroll 1
            for (int tt = 0; tt < 2; ++tt) { const int t = w + 8 * tt, mt = t >> 2, nt = t & 3;
                const int n = nt * 16 + (lane & 15), i0 = mt * 16 + (lane >> 4) * 4;
                f32x4 tc; tc.x = bf2f(Tc[(i0 + 0) * RWP + n]); tc.y = bf2f(Tc[(i0 + 1) * RWP + n]); tc.z = bf2f(Tc[(i0 + 2) * RWP + n]); tc.w = bf2f(Tc[(i0 + 3) * RWP + n]);
                const f32x4 tn = mm64(Tc, XTn, mt, nt, lane, tc);
                st_rowmajor(Tn, mt, nt, lane, tn); }
            __syncthreads();
            LAS bf16_t* s0 = Xc; Xc = Xn; Xn = s0; s0 = XTc; XTc = XTn; XTn = s0; s0 = Tc; Tc = Tn; Tn = s0;
        }
        LAS bf16_t* LVTp = (LAS bf16_t*)(F.lds + 131584);
#pragma unroll 1
        for (int tt = 0; tt < 2; ++tt) { const int t = w + 8 * tt, mt = t >> 2, nt = t & 3;
            const int n = nt * 16 + (lane & 15), i0 = mt * 16 + (lane >> 4) * 4, r = lane & 15;
            const f32x4 wt = mm64(Tc, AtT, mt, nt, lane, z4), u0 = mm64(Tc, LVTp, mt, nt, lane, z4);
            gW[(i0 + 0) * RWP + n] = f2bf(wt.x); gW[(i0 + 1) * RWP + n] = f2bf(wt.y); gW[(i0 + 2) * RWP + n] = f2bf(wt.z); gW[(i0 + 3) * RWP + n] = f2bf(wt.w);
            bf16_t* gu = gVS + (size_t)nt * 3 * 1024;
            gu[(i0 + 0) * 16 + r] = f2bf(u0.x); gu[(i0 + 1) * 16 + r] = f2bf(u0.y); gu[(i0 + 2) * 16 + r] = f2bf(u0.z); gu[(i0 + 3) * 16 + r] = f2bf(u0.w); }
    }
    __syncthreads();
    (void)LVT;
}

__device__ __forceinline__ void rwkv_ps_task(const Args& a, Frame& F, int task) {
    const WsMap m = ws_map(NTOK);
    const int bh = task >> 2, vs = task & 3, b = bh >> 3, h = bh & 7;
    const int lane = F.lane, w = F.wave, tid = F.tid;
    LAS bf16_t* LB = (LAS bf16_t*)F.lds;
    LAS bf16_t* ST = LB + 4 * RWT; LAS bf16_t* VNT = ST + 16 * RWP;
    bf16_t* yo = (bf16_t*)(a.ws + m.rwy);
    const unsigned char* blob0 = a.ws + m.xn + (size_t)(bh * 64) * RWB_BYTES;
    const int r = lane & 15, i0w = (w & 3) * 16 + (lane >> 4) * 4;
    f32x4 Sacc = {0.f, 0.f, 0.f, 0.f};
    for (int i = tid; i < 16 * RWP / 2; i += NTHR) ((LAS unsigned*)ST)[i] = 0u;
    v4u pre[5];
    auto prefetch = [&](int c) {
        const v4u* g = (const v4u*)(blob0 + (size_t)c * RWB_BYTES);
#pragma unroll
        for (int k = 0; k < 5; ++k) { const int o = k * 512 + tid; pre[k] = (o < (int)(RWB_TILES / 16)) ? g[o] : (v4u){0u, 0u, 0u, 0u}; }
    };
    auto commit = [&]() {
#pragma unroll
        for (int k = 0; k < 5; ++k) { const int o = k * 512 + tid; if (o < (int)(RWB_TILES / 16)) ((LAS v4u*)LB)[o] = pre[k]; }
    };
    bf16_t nfr[4], nkv[4]; float ndv[4];
    auto prefrag = [&](int c) {
        const unsigned char* blob = blob0 + (size_t)c * RWB_BYTES;
        const bf16_t* gvs = (const bf16_t*)(blob + RWB_VS) + (size_t)vs * 3 * 1024;
        const bf16_t* src = gvs + (w < 4 ? 0 : 1024);
#pragma unroll
        for (int e = 0; e < 4; ++e) nfr[e] = src[(i0w + e) * 16 + r];
        if (w < 4) { const float* gd = (const float*)(blob + RWB_DVEC);
#pragma unroll
            for (int e = 0; e < 4; ++e) { ndv[e] = gd[i0w + e]; nkv[e] = gvs[2048 + (i0w + e) * 16 + r]; } }
        else {
#pragma unroll
            for (int e = 0; e < 4; ++e) { ndv[e] = 1.f; nkv[e] = 0; } }
    };
    prefetch(0); commit(); prefetch(1); prefrag(0);
    for (int c = 0; c < 64; ++c) {
        float fr[4], dv[4], kv0[4];
#pragma unroll
        for (int e = 0; e < 4; ++e) { fr[e] = bf2f(nfr[e]); dv[e] = ndv[e]; kv0[e] = bf2f(nkv[e]); }
        if (c + 1 < 64) prefrag(c + 1);
        __syncthreads();
        if (w < 4) {
            f32x4 vn = mm64(LB, ST, w, 0, lane, (f32x4){fr[0], fr[1], fr[2], fr[3]});
            st_transposed(VNT, w, 0, lane, vn);
        }
        __syncthreads();
        if (w < 4) {
            const f32x4 base = {dv[0] * Sacc.x + kv0[0], dv[1] * Sacc.y + kv0[1], dv[2] * Sacc.z + kv0[2], dv[3] * Sacc.w + kv0[3]};
            Sacc = mm64(LB + 2 * RWT, VNT, w, 0, lane, base);
        } else {
            f32x4 o = mm64(LB + RWT, ST, w - 4, 0, lane, (f32x4){fr[0], fr[1], fr[2], fr[3]});
            o = mm64(LB + 3 * RWT, VNT, w - 4, 0, lane, o);
            const size_t n = (size_t)b * TSEQ + c * 64 + i0w;
            bf16_t* yp = yo + n * 512 + h * 64 + vs * 16 + r;
            yp[0] = f2bf(o.x); yp[512] = f2bf(o.y); yp[1024] = f2bf(o.z); yp[1536] = f2bf(o.w);
        }
        __syncthreads();
        if (w < 4) st_transposed(ST, w, 0, lane, Sacc);
        if (c + 1 < 64) commit();
        if (c + 2 < 64) prefetch(c + 2);
    }
    __syncthreads();
}

constexpr int GP = 136;
constexpr size_t GB_BYTES = 26880;
template <int KD, int PA_, int PB_>
__device__ __forceinline__ f32x4 mmx(const LAS bf16_t* A, const LAS bf16_t* Bt, int mt, int nt, int lane, f32x4 acc) {
    const LAS bf16_t* ap = A + (mt * 16 + (lane & 15)) * PA_ + (lane >> 4) * 8;
    const LAS bf16_t* bp = Bt + (nt * 16 + (lane & 15)) * PB_ + (lane >> 4) * 8;
#pragma unroll
    for (int k0 = 0; k0 < KD; k0 += 32)
        acc = __builtin_amdgcn_mfma_f32_16x16x32_bf16(*(const LAS bf16x8*)(ap + k0), *(const LAS bf16x8*)(bp + k0), acc, 0, 0, 0);
    return acc;
}
__device__ __forceinline__ void gdn_pa_chunk(const Args& a, Frame& F, int ci) {
    const WsMap m = ws_map(NTOK);
    const int bh = ci >> 6, c = ci & 63, b = bh >> 2, h = bh & 3;
    const int lane = F.lane, w = F.wave, tid = F.tid;
    LAS bf16_t* KB = (LAS bf16_t*)F.lds; LAS bf16_t* KH = KB + 64 * GP; LAS bf16_t* QH = KH + 64 * GP;
    LAS bf16_t* KBEt = KB; LAS bf16_t* VbT = KB + 128 * RWP;
    LAS bf16_t* X0 = QH + 64 * GP; LAS bf16_t* XT0 = X0 + RWT; LAS bf16_t* T0 = XT0 + RWT; LAS bf16_t* X1 = T0 + RWT; LAS bf16_t* XT1 = X1 + RWT; LAS bf16_t* T1 = XT1 + RWT;
    LAS float* GC = (LAS float*)(T1 + RWT);
    LAS bf16_t* KGTl = (LAS bf16_t*)(GC + 64);
    bf16_t* gq = (bf16_t*)(a.ws + m.gq); bf16_t* gk = (bf16_t*)(a.ws + m.gk); bf16_t* gv = (bf16_t*)(a.ws + m.gv); const float* gsc = (const float*)(a.ws + m.gsc);
    unsigned char* blob = a.ws + m.gblob + (size_t)ci * GB_BYTES;
    bf16_t* gA1 = (bf16_t*)blob; bf16_t* gW = gA1 + RWT; float* gGC = (float*)(blob + RWT * 2 + 64 * GP * 2);
    const int j = tid >> 3, c16 = (tid & 7) * 16;
    const size_t n0 = (size_t)b * TSEQ + c * 64, n = n0 + j;
    const float be = gsc[n * 8 + h];
    v4u kw[2], qw[2], vw[2];
    {
        float kf[8];
#pragma unroll
        for (int hh = 0; hh < 2; ++hh) {
            kw[hh] = ld8(gk + n * 512 + h * 128 + c16 + hh * 8); qw[hh] = ld8(gq + n * 512 + h * 128 + c16 + hh * 8); vw[hh] = ld8(gv + n * 512 + h * 128 + c16 + hh * 8);
            *(LAS v4u*)(KH + j * GP + c16 + hh * 8) = kw[hh]; *(LAS v4u*)(QH + j * GP + c16 + hh * 8) = qw[hh];
            unpack8(kw[hh], kf);
#pragma unroll
            for (int k = 0; k < 8; ++k) kf[k] *= be;
            *(LAS v4u*)(KB + j * GP + c16 + hh * 8) = pack8(kf);
        }
        if (w == 0) {
            float g = gsc[(n0 + lane) * 8 + 4 + h];
#pragma unroll
            for (int o = 1; o < 64; o <<= 1) { const float t = __shfl_up(g, o); if (lane >= o) g += t; }
            GC[lane] = g; gGC[lane] = g;
        }
    }
    __syncthreads();
    {
        const f32x4 z4 = {0.f, 0.f, 0.f, 0.f};
#pragma unroll 1
        for (int tt = 0; tt < 2; ++tt) {
            const int t = w + 8 * tt, mt = t >> 2, nt = t & 3;
            const int nn = nt * 16 + (lane & 15), i0 = mt * 16 + (lane >> 4) * 4;
            f32x4 kk = mmx<128, GP, GP>(KB, KH, mt, nt, lane, z4), qk = mmx<128, GP, GP>(QH, KH, mt, nt, lane, z4);
            const float gj = GC[nn];
            f32x4 x, t0;
#pragma unroll
            for (int e = 0; e < 4; ++e) { const int i = i0 + e; const float d = __expf(fminf(GC[i] - gj, 0.f));
                x[e] = (nn < i) ? -kk[e] * d : 0.f; qk[e] = (nn <= i) ? qk[e] * d : 0.f; t0[e] = x[e] + (nn == i ? 1.0f : 0.f); }
            st_rowmajor(X0, mt, nt, lane, x); st_transposed(XT0, mt, nt, lane, x); st_rowmajor(T0, mt, nt, lane, t0);
            gA1[(i0 + 0) * RWP + nn] = f2bf(qk.x); gA1[(i0 + 1) * RWP + nn] = f2bf(qk.y); gA1[(i0 + 2) * RWP + nn] = f2bf(qk.z); gA1[(i0 + 3) * RWP + nn] = f2bf(qk.w);
        }
    }
    __syncthreads();
    {
        const float gj = GC[j], eg = __expf(gj), s_kbe = be * eg, s_kg = __expf(GC[63] - gj);
        float f[8], o8[8];
#pragma unroll
        for (int hh = 0; hh < 2; ++hh) {
            unpack8(kw[hh], f);
#pragma unroll
            for (int k = 0; k < 8; ++k) { KBEt[(c16 + hh * 8 + k) * RWP + j] = f2bf(f[k] * s_kbe); KGTl[(c16 + hh * 8 + k) * RWP + j] = f2bf(f[k] * s_kg); }
            unpack8(vw[hh], f);
#pragma unroll
            for (int k = 0; k < 8; ++k) VbT[(c16 + hh * 8 + k) * RWP + j] = f2bf(f[k] * be);
            unpack8(qw[hh], f);
#pragma unroll
            for (int k = 0; k < 8; ++k) o8[k] = f[k] * eg;
            *(v4u*)(gq + n * 512 + h * 128 + c16 + hh * 8) = pack8(o8);
        }
    }
    const f32x4 z4 = {0.f, 0.f, 0.f, 0.f};
    LAS bf16_t* Xc = X0; LAS bf16_t* XTc = XT0; LAS bf16_t* Tc = T0; LAS bf16_t* Xn = X1; LAS bf16_t* XTn = XT1; LAS bf16_t* Tn = T1;
#pragma unroll 1
    for (int it = 0; it < 5; ++it) {
#pragma unroll 1
        for (int tt = 0; tt < 2; ++tt) { const int t = w + 8 * tt, mt = t >> 2, nt = t & 3;
            const f32x4 x2 = mm64(Xc, XTc, mt, nt, lane, z4);
            st_rowmajor(Xn, mt, nt, lane, x2); st_transposed(XTn, mt, nt, lane, x2); }
        __syncthreads();
#pragma unroll 1
        for (int tt = 0; tt < 2; ++tt) { const int t = w + 8 * tt, mt = t >> 2, nt = t & 3;
            const int nn = nt * 16 + (lane & 15), i0 = mt * 16 + (lane >> 4) * 4;
            f32x4 tc; tc.x = bf2f(Tc[(i0 + 0) * RWP + nn]); tc.y = bf2f(Tc[(i0 + 1) * RWP + nn]); tc.z = bf2f(Tc[(i0 + 2) * RWP + nn]); tc.w = bf2f(Tc[(i0 + 3) * RWP + nn]);
            const f32x4 tn = mm64(Tc, XTn, mt, nt, lane, tc);
            st_rowmajor(Tn, mt, nt, lane, tn); }
        __syncthreads();
        LAS bf16_t* s0 = Xc; Xc = Xn; Xn = s0; s0 = XTc; XTc = XTn; XTn = s0; s0 = Tc; Tc = Tn; Tn = s0;
    }
    {
#pragma unroll 1
        for (int tt = 0; tt < 4; ++tt) { const int mt = w, nt = tt;
            const f32x4 dw = mm64(KBEt, Tc, mt, nt, lane, z4), du = mm64(VbT, Tc, mt, nt, lane, z4);
            const int i = nt * 16 + (lane & 15), c0 = mt * 16 + (lane >> 4) * 4;
            *(v2u*)(gW + i * GP + c0) = (v2u){pk2(dw.x, dw.y), pk2(dw.z, dw.w)};
            *(v2u*)(gv + (n0 + i) * 512 + h * 128 + c0) = (v2u){pk2(du.x, du.y), pk2(du.z, du.w)}; }
        for (int p = tid; p < 1024; p += NTHR) { const int k = p >> 3, j8 = (p & 7) * 8;
            *(v4u*)(gk + (n0 + (k >> 1)) * 512 + h * 128 + (k & 1) * 64 + j8) = *(const LAS v4u*)(KGTl + k * RWP + j8); }
    }
    __syncthreads();
}

__device__ __forceinline__ void gdn_ps_task(const Args& a, Frame& F, int task) {
    const WsMap m = ws_map(NTOK);
    const int bh = task >> 3, vs = task & 7, b = bh >> 2, h = bh & 3;
    const int lane = F.lane, w = F.wave, tid = F.tid;
    LAS bf16_t* A1 = (LAS bf16_t*)F.lds; LAS bf16_t* WT = A1 + RWT; LAS float* GC = (LAS float*)(WT + 64 * GP);
    LAS bf16_t* QG = (LAS bf16_t*)(GC + 64); LAS bf16_t* KGT = QG + 64 * GP; LAS bf16_t* ST = KGT + 128 * RWP;
    LAS bf16_t* VNT = ST + 16 * GP; LAS bf16_t* UU = VNT + 16 * RWP;
    const bf16_t* gq = (const bf16_t*)(a.ws + m.gq); const bf16_t* gk = (const bf16_t*)(a.ws + m.gk); const bf16_t* gv = (const bf16_t*)(a.ws + m.gv);
    bf16_t* go = (bf16_t*)(a.ws + m.gdno);
    const unsigned char* blob0 = a.ws + m.gblob + (size_t)(bh * 64) * GB_BYTES;
    const int r = lane & 15, kq4 = (lane >> 4) * 4;
    f32x4 Sacc = {0.f, 0.f, 0.f, 0.f};
    for (int i = tid; i < 16 * GP / 2; i += NTHR) ((LAS unsigned*)ST)[i] = 0u;
    v4u pb_[4], pq_[2], pk_[2], pu_;
    auto prefetch = [&](int c) {
        const size_t n0 = (size_t)b * TSEQ + c * 64;
        const v4u* g = (const v4u*)(blob0 + (size_t)c * GB_BYTES);
#pragma unroll
        for (int k = 0; k < 4; ++k) { const int o = k * 512 + tid; pb_[k] = (o < (int)(GB_BYTES / 16)) ? g[o] : (v4u){0u, 0u, 0u, 0u}; }
#pragma unroll
        for (int k = 0; k < 2; ++k) { const int p = k * 512 + tid;
            pq_[k] = ld8(gq + (n0 + (p >> 4)) * 512 + h * 128 + (p & 15) * 8);
            pk_[k] = ld8(gk + (n0 + (p >> 4)) * 512 + h * 128 + (p & 15) * 8); }
        if (tid < 128) pu_ = ld8(gv + (n0 + (tid >> 1)) * 512 + h * 128 + vs * 16 + (tid & 1) * 8);
    };
    prefetch(0);
    for (int c = 0; c < 64; ++c) {
#pragma unroll
        for (int k = 0; k < 4; ++k) { const int o = k * 512 + tid; if (o < (int)(GB_BYTES / 16)) ((LAS v4u*)A1)[o] = pb_[k]; }
#pragma unroll
        for (int k = 0; k < 2; ++k) { const int p = k * 512 + tid;
            *(LAS v4u*)(QG + (p >> 4) * GP + (p & 15) * 8) = pq_[k];
            const int kk = 2 * (p >> 4) + ((p & 15) >> 3), j8 = (p & 7) * 8;
            *(LAS v4u*)(KGT + kk * RWP + j8) = pk_[k]; }
        if (tid < 128) *(LAS v4u*)(UU + (tid >> 1) * 16 + (tid & 1) * 8) = pu_;
        __syncthreads();
        if (c + 1 < 64) prefetch(c + 1);
        const float glast = __expf(GC[63]);
        if (w < 4) {
            const int i0 = w * 16 + kq4;
            f32x4 vn = mmx<128, GP, GP>(WT, ST, w, 0, lane, (f32x4){0.f, 0.f, 0.f, 0.f});
            vn.x = bf2f(UU[(i0 + 0) * 16 + r]) - vn.x; vn.y = bf2f(UU[(i0 + 1) * 16 + r]) - vn.y; vn.z = bf2f(UU[(i0 + 2) * 16 + r]) - vn.z; vn.w = bf2f(UU[(i0 + 3) * 16 + r]) - vn.w;
            st_transposed(VNT, w, 0, lane, vn);
        }
        __syncthreads();
        {
            const f32x4 base = {Sacc.x * glast, Sacc.y * glast, Sacc.z * glast, Sacc.w * glast};
            Sacc = mm64(KGT, VNT, w, 0, lane, base);
            if (w < 4) {
                f32x4 o = mmx<128, GP, GP>(QG, ST, w, 0, lane, (f32x4){0.f, 0.f, 0.f, 0.f});
                o = mm64(A1, VNT, w, 0, lane, o);
                const size_t n = (size_t)b * TSEQ + c * 64 + w * 16 + kq4;
                bf16_t* op = go + n * 512 + h * 128 + vs * 16 + r;
                op[0] = f2bf(o.x); op[512] = f2bf(o.y); op[1024] = f2bf(o.z); op[1536] = f2bf(o.w);
            }
        }
        __syncthreads();
        { const int k0 = w * 16 + kq4;
          *(LAS v2u*)(ST + r * GP + k0) = (v2u){pk2(Sacc.x, Sacc.y), pk2(Sacc.z, Sacc.w)}; }
    }
    __syncthreads();
}

__device__ __forceinline__ void gla_pa_chunk(const Args& a, Frame& F, int ci) {
    const WsMap m = ws_map(NTOK);
    const int bh = ci >> 6, c = ci & 63, b = bh >> 2, h = bh & 3;
    const int lane = F.lane, w = F.wave, tid = F.tid;
    LAS bf16_t* KS2T = (LAS bf16_t*)F.lds; LAS bf16_t* VT = KS2T + RWT; LAS float* TMP = (LAS float*)(VT + 128 * RWP);
    const bf16_t* p16 = (const bf16_t*)(a.ws + m.p16); const bf16_t* ao = (const bf16_t*)(a.ws + m.auxo);
    bf16_t* gKV = (bf16_t*)(a.ws + m.glao) + (size_t)ci * 8192; float* gDV = (float*)(a.ws + m.gladv) + (size_t)ci * 64;
    const int j = tid >> 3, c8 = (tid & 7) * 8, v16 = (tid & 7) * 16;
    const size_t n = (size_t)b * TSEQ + c * 64 + j;
    float k8[8], la[8];
    unpack8(ld8(p16 + n * PLD + C_GLA + 256 + h * 64 + c8), k8); unpack8(ld8(ao + n * 1792 + 1536 + h * 64 + c8), la);
    const v4u v0 = ld8(p16 + n * PLD + C_GLA + 512 + h * 128 + v16), v1 = ld8(p16 + n * PLD + C_GLA + 512 + h * 128 + v16 + 8);
#pragma unroll
    for (int k = 0; k < 8; ++k) la[k] = -softplus_f(-la[k]) * (1.0f / 16.0f);
    chunk_cumsum8(la, TMP, lane, w, c8);
    float bl[8];
#pragma unroll
    for (int k = 0; k < 8; ++k) bl[k] = 0.f;
#pragma unroll
    for (int ww = 0; ww < 8; ++ww) { const f32x4 y0 = *(const LAS f32x4*)(TMP + ww * 64 + c8), y1 = *(const LAS f32x4*)(TMP + ww * 64 + c8 + 4);
        bl[0] += y0.x; bl[1] += y0.y; bl[2] += y0.z; bl[3] += y0.w; bl[4] += y1.x; bl[5] += y1.y; bl[6] += y1.z; bl[7] += y1.w; }
#pragma unroll
    for (int k = 0; k < 8; ++k) KS2T[(c8 + k) * RWP + j] = f2bf(k8[k] * __expf(bl[k] - la[k]));
    { const unsigned vw[8] = {v0.x, v0.y, v0.z, v0.w, v1.x, v1.y, v1.z, v1.w};
#pragma unroll
      for (int e = 0; e < 8; ++e) { VT[(v16 + 2 * e) * RWP + j] = (bf16_t)(vw[e] & 0xffffu); VT[(v16 + 2 * e + 1) * RWP + j] = (bf16_t)(vw[e] >> 16); } }
    if (j == 0) { *(f32x4*)(gDV + c8) = (f32x4){__expf(bl[0]), __expf(bl[1]), __expf(bl[2]), __expf(bl[3])}; *(f32x4*)(gDV + c8 + 4) = (f32x4){__expf(bl[4]), __expf(bl[5]), __expf(bl[6]), __expf(bl[7])}; }
    __syncthreads();
    {
        const f32x4 z4 = {0.f, 0.f, 0.f, 0.f};
#pragma unroll
        for (int tt = 0; tt < 4; ++tt) { const int mt = tt, nt = w;
            const f32x4 d = mm64(KS2T, VT, mt, nt, lane, z4);
            const int dv = nt * 16 + (lane & 15), k0 = mt * 16 + (lane >> 4) * 4;
            *(v2u*)(gKV + dv * 64 + k0) = (v2u){pk2(d.x, d.y), pk2(d.z, d.w)}; }
    }
    __syncthreads();
}
__device__ __forceinline__ void gla_sscan(const Args& a, Frame& F) {
    const WsMap m = ws_map(NTOK);
    const bf16_t* gKV = (const bf16_t*)(a.ws + m.glao); const float* gDV = (const float*)(a.ws + m.gladv); bf16_t* gS = (bf16_t*)(a.ws + m.glas);
    for (int it = F.vcu * NTHR + F.tid; it < 16 * 8192; it += F.G * NTHR) {
        const int bh = it >> 13, e = it & 8191, k = e & 63;
        float S = 0.f;
#pragma unroll 1
        for (int c0 = 0; c0 < 64; c0 += 16) {
            float kv[16], dv[16];
#pragma unroll
            for (int u = 0; u < 16; ++u) { const size_t ci = (size_t)bh * 64 + c0 + u; kv[u] = bf2f(gKV[ci * 8192 + e]); dv[u] = gDV[ci * 64 + k]; }
#pragma unroll
            for (int u = 0; u < 16; ++u) { const size_t ci = (size_t)bh * 64 + c0 + u; gS[ci * 8192 + e] = f2bf(S); S = S * dv[u] + kv[u]; }
        }
    }
}
__device__ __forceinline__ void gla_pb_chunk(const Args& a, Frame& F, int l, int ci) {
    const WsMap m = ws_map(NTOK);
    const int bh = ci >> 6, c = ci & 63, b = bh >> 2, h = bh & 3;
    const int lane = F.lane, w = F.wave, tid = F.tid;
    LAS bf16_t* QS = (LAS bf16_t*)F.lds; LAS bf16_t* KS = QS + RWT; LAS bf16_t* QG = KS + RWT; LAS bf16_t* PM = QG + RWT;
    LAS bf16_t* VT = PM + RWT; LAS bf16_t* ST = VT + 128 * RWP; LAS bf16_t* GG = ST + 128 * RWP;
    LAS float* TMP = (LAS float*)(GG + 64 * GP); LAS float* OSS = TMP + 512;
    const bf16_t* p16 = (const bf16_t*)(a.ws + m.p16); const bf16_t* ao = (const bf16_t*)(a.ws + m.auxo);
    const bf16_t* gS = (const bf16_t*)(a.ws + m.glas) + (size_t)ci * 8192; bf16_t* mix = (bf16_t*)(a.ws + m.mix16);
    const int j = tid >> 3, c8 = (tid & 7) * 8, v16 = (tid & 7) * 16;
    const size_t n = (size_t)b * TSEQ + c * 64 + j;
    float q8[8], k8[8], la[8];
    unpack8(ld8(p16 + n * PLD + C_GLA + h * 64 + c8), q8); unpack8(ld8(p16 + n * PLD + C_GLA + 256 + h * 64 + c8), k8); unpack8(ld8(ao + n * 1792 + 1536 + h * 64 + c8), la);
    const v4u v0 = ld8(p16 + n * PLD + C_GLA + 512 + h * 128 + v16), v1 = ld8(p16 + n * PLD + C_GLA + 512 + h * 128 + v16 + 8);
    const v4u g0 = ld8(p16 + n * PLD + C_GLA + 1024 + h * 128 + v16), g1 = ld8(p16 + n * PLD + C_GLA + 1024 + h * 128 + v16 + 8);
    const v4u s0 = ((const v4u*)gS)[tid], s1 = ((const v4u*)gS)[512 + tid];
#pragma unroll
    for (int k = 0; k < 8; ++k) la[k] = -softplus_f(-la[k]) * (1.0f / 16.0f);
    chunk_cumsum8(la, TMP, lane, w, c8);
    {
        float br[8], t0[8], t1[8], t2[8];
#pragma unroll
        for (int k = 0; k < 8; ++k) br[k] = 0.f;
#pragma unroll
        for (int ww = 0; ww < 4; ++ww) { const f32x4 y0 = *(const LAS f32x4*)(TMP + ww * 64 + c8), y1 = *(const LAS f32x4*)(TMP + ww * 64 + c8 + 4);
            br[0] += y0.x; br[1] += y0.y; br[2] += y0.z; br[3] += y0.w; br[4] += y1.x; br[5] += y1.y; br[6] += y1.z; br[7] += y1.w; }
#pragma unroll
        for (int k = 0; k < 8; ++k) { const float qq = q8[k] * 0.125f;
            t0[k] = qq * __expf(la[k] - br[k]); t1[k] = k8[k] * __expf(br[k] - la[k]); t2[k] = qq * __expf(la[k]); }
        *(LAS v4u*)(QS + j * RWP + c8) = pack8(t0); *(LAS v4u*)(KS + j * RWP + c8) = pack8(t1); *(LAS v4u*)(QG + j * RWP + c8) = pack8(t2);
        const unsigned vw[8] = {v0.x, v0.y, v0.z, v0.w, v1.x, v1.y, v1.z, v1.w};
#pragma unroll
        for (int e = 0; e < 8; ++e) { VT[(v16 + 2 * e) * RWP + j] = (bf16_t)(vw[e] & 0xffffu); VT[(v16 + 2 * e + 1) * RWP + j] = (bf16_t)(vw[e] >> 16); }
        *(LAS v4u*)(GG + j * GP + v16) = g0; *(LAS v4u*)(GG + j * GP + v16 + 8) = g1;
        { const int p0 = tid, p1 = 512 + tid;
          *(LAS v4u*)(ST + (p0 >> 3) * RWP + (p0 & 7) * 8) = s0; *(LAS v4u*)(ST + (p1 >> 3) * RWP + (p1 & 7) * 8) = s1; }
    }
    __syncthreads();
    {
        const f32x4 z4 = {0.f, 0.f, 0.f, 0.f};
#pragma unroll
        for (int tt = 0; tt < 2; ++tt) { const int t = w + 8 * tt, mtj = t >> 2, nti = t & 3;
            f32x4 s4 = mm64(KS, QS, mtj, nti, lane, z4);
            const int i = nti * 16 + (lane & 15), j0 = mtj * 16 + (lane >> 4) * 4;
#pragma unroll
            for (int e = 0; e < 4; ++e) if (j0 + e > i) s4[e] = 0.f;
            st_transposed(PM, mtj, nti, lane, s4); }
    }
    __syncthreads();
    {
        const int mt = w >> 1, ntb = (w & 1) * 4, r = lane & 15, i0 = mt * 16 + (lane >> 4) * 4;
        f32x4 o[4]; float ss[4] = {0.f, 0.f, 0.f, 0.f};
#pragma unroll
        for (int t = 0; t < 4; ++t) { o[t] = mm64(QG, ST, mt, ntb + t, lane, (f32x4){0.f, 0.f, 0.f, 0.f}); o[t] = mm64(PM, VT, mt, ntb + t, lane, o[t]);
            ss[0] += o[t].x * o[t].x; ss[1] += o[t].y * o[t].y; ss[2] += o[t].z * o[t].z; ss[3] += o[t].w * o[t].w; }
#pragma unroll
        for (int e = 0; e < 4; ++e) ss[e] = row16_sum(ss[e]);
        if (r == 0) {
#pragma unroll
            for (int e = 0; e < 4; ++e) OSS[(i0 + e) * 2 + (w & 1)] = ss[e]; }
        __syncthreads();
        float rs[4];
#pragma unroll
        for (int e = 0; e < 4; ++e) rs[e] = 1.0f / sqrtf((OSS[(i0 + e) * 2] + OSS[(i0 + e) * 2 + 1]) * (1.0f / 128.0f) + 1e-6f);
        const size_t nrow = (size_t)b * TSEQ + c * 64 + i0;
#pragma unroll
        for (int t = 0; t < 4; ++t) { const int dv = (ntb + t) * 16 + r; const float gn = a.in[I_GLA_NORM][l * 128 + dv];
            const float ov[4] = {o[t].x, o[t].y, o[t].z, o[t].w};
#pragma unroll
            for (int e = 0; e < 4; ++e) { const float g = bf2f(GG[(i0 + e) * GP + dv]);
                mix[(nrow + e) * DM + 512 + h * 128 + dv] = f2bf(ov[e] * rs[e] * gn * (g * sigm(g))); } }
    }
    __syncthreads();
}

__device__ __forceinline__ void lru_pass(const Args& a, Frame& F, int l, bool passB) {
    const WsMap m = ws_map(NTOK);
    const bf16_t* gt = (const bf16_t*)(a.ws + m.gates); const bf16_t* xc = (const bf16_t*)(a.ws + m.xc); const bf16_t* p16 = (const bf16_t*)(a.ws + m.p16);
    bf16_t* mix = (bf16_t*)(a.ws + m.mix16); float* lrs = (float*)(a.ws + m.lrs);
    for (int it = F.vcu * NTHR + F.tid; it < NBATCH * 64 * 512; it += F.G * NTHR) {
        const int ch = it & 511, bc = it >> 9, c = bc & 63;
        const float sp8 = 8.0f * softplus_f(-a.in[I_LRU_LAM][l * 512 + ch]);
        const size_t nb = (size_t)bc * 64;
        float hh = 0.f, ap = 1.f;
        if (passB) {
            for (int s0 = 0; s0 < c; s0 += 8) { f32x2 su[8];
#pragma unroll
                for (int u = 0; u < 8; ++u) su[u] = (s0 + u < c) ? *(const f32x2*)(lrs + ((size_t)(bc - c + s0 + u) * 512 + ch) * 2) : (f32x2){1.f, 0.f};
#pragma unroll
                for (int u = 0; u < 8; ++u) hh = su[u].x * hh + su[u].y; } }
#pragma unroll 1
        for (int t0 = 0; t0 < 64; t0 += 8) {
            bf16_t rr[8], ii[8], xx[8], yy[8];
#pragma unroll
            for (int u = 0; u < 8; ++u) { const size_t n = nb + t0 + u; rr[u] = gt[n * 1024 + ch]; ii[u] = gt[n * 1024 + 512 + ch]; xx[u] = xc[n * 512 + ch];
                yy[u] = passB ? p16[n * PLD + C_LRU + 512 + ch] : (bf16_t)0; }
#pragma unroll
            for (int u = 0; u < 8; ++u) { const size_t n = nb + t0 + u;
                const float la = -sp8 * sigm(bf2f(rr[u]));
                const float av = __expf(la);
                const float uu = bf2f(xx[u]) * sigm(bf2f(ii[u])) * sqrtf(fmaxf(1.0f - av * av, 0.0f));
                hh = av * hh + uu; ap *= av;
                if (passB) mix[n * DM + 1024 + ch] = f2bf(hh * gelu_fast(bf2f(yy[u]))); }
        }
        if (!passB) *(f32x2*)(lrs + ((size_t)bc * 512 + ch) * 2) = (f32x2){ap, hh};
    }
}

__device__ __forceinline__ void scan_phase(const Args& a, Frame& F, int l) {
    lru_pass(a, F, l, false);
    const int task = blockIdx.x;
    for (int q = 0; q < 8; ++q) rwkv_pa_chunk(a, F, l, task * 8 + q);
    for (int q = 0; q < 4; ++q) gdn_pa_chunk(a, F, task * 4 + q);
    for (int q = 0; q < 4; ++q) gla_pa_chunk(a, F, task * 4 + q);
    if (l == 0) tables_range(a, F, (size_t)2 * NEXP * DM / 32, (size_t)4 * NEXP * DM / 32, F.vcu, F.G);
}

__device__ __forceinline__ void post_phase(const Args& a, Frame& F, int l, const XcdBarrier& bar) {
    const WsMap m = ws_map(NTOK);
    if (blockIdx.x < 128) rwkv_ps_task(a, F, blockIdx.x); else gdn_ps_task(a, F, blockIdx.x - 128);
    gla_sscan(a, F);
    lru_pass(a, F, l, true);
    const bf16_t* p16 = (const bf16_t*)(a.ws + m.p16); const bf16_t* glao = (const bf16_t*)(a.ws + m.glao); const bf16_t* gdno = (const bf16_t*)(a.ws + m.gdno);
    const bf16_t* rwy = (const bf16_t*)(a.ws + m.rwy); const bf16_t* rwbv = (const bf16_t*)(a.ws + m.rwbv); const bf16_t* ao = (const bf16_t*)(a.ws + m.auxo);
    bf16_t* mix = (bf16_t*)(a.ws + m.mix16);
    const int lane = F.lane, col = lane * 8, hc = col & 127;
    float gg[8], gd[8], lw[8], lb[8];
    { const f32x4 x0 = *(const f32x4*)(a.in[I_GLA_NORM] + l * 128 + hc), x1 = *(const f32x4*)(a.in[I_GLA_NORM] + l * 128 + hc + 4);
      gg[0] = x0.x; gg[1] = x0.y; gg[2] = x0.z; gg[3] = x0.w; gg[4] = x1.x; gg[5] = x1.y; gg[6] = x1.z; gg[7] = x1.w;
      const f32x4 y0 = *(const f32x4*)(a.in[I_GDN_NORM] + l * 128 + hc), y1 = *(const f32x4*)(a.in[I_GDN_NORM] + l * 128 + hc + 4);
      gd[0] = y0.x; gd[1] = y0.y; gd[2] = y0.z; gd[3] = y0.w; gd[4] = y1.x; gd[5] = y1.y; gd[6] = y1.z; gd[7] = y1.w;
      const f32x4 w0 = *(const f32x4*)(a.in[I_RW_LN_W] + l * 512 + col), w1 = *(const f32x4*)(a.in[I_RW_LN_W] + l * 512 + col + 4);
      lw[0] = w0.x; lw[1] = w0.y; lw[2] = w0.z; lw[3] = w0.w; lw[4] = w1.x; lw[5] = w1.y; lw[6] = w1.z; lw[7] = w1.w;
      const f32x4 b0 = *(const f32x4*)(a.in[I_RW_LN_B] + l * 512 + col), b1 = *(const f32x4*)(a.in[I_RW_LN_B] + l * 512 + col + 4);
      lb[0] = b0.x; lb[1] = b0.y; lb[2] = b0.z; lb[3] = b0.w; lb[4] = b1.x; lb[5] = b1.y; lb[6] = b1.z; lb[7] = b1.w; }
    for (int pass = 1; pass < 2; ++pass) {
    if (pass == 1) xcd_barrier(bar);
    for (int q = 0; q < 4; ++q) gla_pb_chunk(a, F, l, blockIdx.x * 4 + q);
    for (int n = F.gw; n < NTOK; n += F.ngw) {
        if (pass == 1) {
            float y[8], bv[8], g[8];
            unpack8(ld8(rwy + (size_t)n * 512 + col), y); unpack8(ld8(rwbv + (size_t)n * 512 + col), bv); unpack8(ld8(ao + (size_t)n * 1792 + 1024 + col), g);
            float s = 0.f;
#pragma unroll
            for (int k = 0; k < 8; ++k) s += y[k];
            const float mean = red8(s) * (1.0f / 64.0f);
            float s2 = 0.f;
#pragma unroll
            for (int k = 0; k < 8; ++k) { y[k] -= mean; s2 += y[k] * y[k]; }
            const float rs = 1.0f / sqrtf(red8(s2) * (1.0f / 64.0f) + 64e-5f);
#pragma unroll
            for (int k = 0; k < 8; ++k) y[k] = (y[k] * rs * lw[k] + lb[k] + bv[k]) * g[k];
            *(v4u*)(mix + (size_t)n * DM + col) = pack8(y);
        }
        if (pass == 1)
#pragma unroll
        for (int which = 1; which < 2; ++which) {
            float o[8], g[8];
            unpack8(ld8((which ? gdno : glao) + (size_t)n * 512 + col), o);
            unpack8(ld8(p16 + (size_t)n * PLD + (which ? C_GDN + 1536 : C_GLA + 1024) + col), g);
            float ss = 0.f;
#pragma unroll
            for (int k = 0; k < 8; ++k) ss += o[k] * o[k];
            ss = row16_sum(ss);
            const float rs = 1.0f / sqrtf(ss * (1.0f / 128.0f) + 1e-6f);
#pragma unroll
            for (int k = 0; k < 8; ++k) o[k] = o[k] * rs * (which ? gd[k] : gg[k]) * (g[k] * sigm(g[k]));
            *(v4u*)(mix + (size_t)n * DM + (which ? 1536 : 512) + col) = pack8(o);
        }
    }
    }
}

__device__ __forceinline__ void norm2_phase(const Args& a, Frame& F, int l) {
    const WsMap m = ws_map(NTOK);
    const float* gain = a.in[I_NORM_FFN] + l * DM;
    f32x4 gv[8];
#pragma unroll
    for (int j = 0; j < 8; ++j) gv[j] = ((const f32x4*)gain)[64 * j + F.lane];
    for (int n = F.gw; n < NTOK; n += F.ngw) {
        const f32x4* xr = (const f32x4*)(a.out + (size_t)n * DM) + F.lane;
        f32x4 v[8]; float s = 0.f;
#pragma unroll
        for (int j = 0; j < 8; ++j) { v[j] = xr[64 * j]; s += (v[j].x * v[j].x + v[j].y * v[j].y) + (v[j].z * v[j].z + v[j].w * v[j].w); }
        const float rstd = 1.0f / sqrtf(wave_sum_u(s) * (1.0f / DM) + 1e-6f);
        v2u* o8 = (v2u*)((bf16_t*)(a.ws + m.hb) + (size_t)n * DM) + F.lane;
        unsigned char* hq = a.ws + m.mix16 + (size_t)n * 2304;
#pragma unroll
        for (int j = 0; j < 8; ++j) {
            const float y0 = v[j].x * rstd * gv[j].x, y1 = v[j].y * rstd * gv[j].y, y2 = v[j].z * rstd * gv[j].z, y3 = v[j].w * rstd * gv[j].w;
            v2u w; w.x = pk2(y0, y1); w.y = pk2(y2, y3); o8[64 * j] = w;
            float am = __builtin_fmaxf(__builtin_fmaxf(__builtin_fabsf(y0), __builtin_fabsf(y1)), __builtin_fmaxf(__builtin_fabsf(y2), __builtin_fabsf(y3)));
            am = __builtin_fmaxf(am, dpp_f<0xB1>(am)); am = __builtin_fmaxf(am, dpp_f<0x4E>(am)); am = __builtin_fmaxf(am, dpp_f<0x141>(am)); am = __builtin_fmaxf(am, 1e-20f);
            const float xinv = 119.0f / am;
            const int q0 = (int)__builtin_rintf(y0 * xinv), q1 = (int)__builtin_rintf(y1 * xinv), q2 = (int)__builtin_rintf(y2 * xinv), q3 = (int)__builtin_rintf(y3 * xinv);
            const int h0 = (q0 + 8) >> 4, h1 = (q1 + 8) >> 4, h2 = (q2 + 8) >> 4, h3 = (q3 + 8) >> 4;
            const unsigned ph = ((unsigned)h0 & 15u) | (((unsigned)h1 & 15u) << 4) | (((unsigned)h2 & 15u) << 8) | (((unsigned)h3 & 15u) << 12);
            const unsigned pl = ((unsigned)(q0 - 16 * h0) & 15u) | (((unsigned)(q1 - 16 * h1) & 15u) << 4) | (((unsigned)(q2 - 16 * h2) & 15u) << 8) | (((unsigned)(q3 - 16 * h3) & 15u) << 12);
            *(unsigned short*)(hq + 128 * j + 2 * F.lane) = (unsigned short)ph;
            *(unsigned short*)(hq + 1024 + 128 * j + 2 * F.lane) = (unsigned short)pl;
            if ((F.lane & 7) == 0) *(float*)(hq + 2048 + 32 * j + 4 * (F.lane >> 3)) = am * (1.0f / 119.0f);
        }
    }
}

#define TK_CE(A, B) do { const float mx_ = fmaxf(A, B), mn_ = fminf(A, B); A = mx_; B = mn_; } while (0)
__device__ __forceinline__ void tk_sort16_desc(float (&x)[16]) {
#pragma unroll
    for (int k = 2; k <= 16; k <<= 1)
#pragma unroll
        for (int j = k >> 1; j > 0; j >>= 1)
#pragma unroll
            for (int i = 0; i < 16; ++i) { const int p = i ^ j;
                if (p > i) { if ((i & k) == 0) TK_CE(x[i], x[p]); else TK_CE(x[p], x[i]); } }
}
__device__ __forceinline__ void tk_merge16(float (&run)[16], const float (&g)[16]) {
#pragma unroll
    for (int i = 0; i < 16; ++i) run[i] = fmaxf(run[i], g[15 - i]);
#pragma unroll
    for (int j = 8; j > 0; j >>= 1)
#pragma unroll
        for (int i = 0; i < 16; ++i) { const int p = i ^ j; if (p > i) TK_CE(run[i], run[p]); }
}
__device__ __forceinline__ float tk_tag(float v, unsigned tag, unsigned mask) { return __builtin_bit_cast(float, (__builtin_bit_cast(unsigned, v) & ~mask) | tag); }
__device__ __forceinline__ void topk_phase(const Args& a, Frame& F, int l) {
    const WsMap m = ws_map(NTOK);
    const float* tsu = (const float*)(a.ws + m.tsc) + (size_t)l * 2 * NEXP; const float* tsv = tsu + NEXP; float* sug = (float*)(a.ws + m.act);
    const float* sc = (const float*)(a.ws + m.sc);
    int* idx = (int*)(a.ws + m.idx); float* gate = (float*)(a.ws + m.gate);
    LAS float* LS = (LAS float*)F.lds;
    const int t = F.tid;
    for (int wv = F.gw; wv < (NTOK / 64) * 8; wv += F.ngw) {
        const int h = wv & 7, n = (wv >> 3) * 64 + F.lane;
        const float* sp = sc + (size_t)(h * 256) * NTOK + n;
        float s0[16], s1[16];
#pragma unroll
        for (int half = 0; half < 2; ++half) {
            float run[16];
#pragma unroll
            for (int j = 0; j < 16; ++j) run[j] = -3.0e38f;
#pragma unroll 1
            for (int g = 0; g < 8; ++g) {
                float x[16];
#pragma unroll
                for (int k = 0; k < 16; ++k) x[k] = tk_tag(sp[(size_t)(half * 128 + g * 16 + k) * NTOK], (unsigned)(g * 16 + k), 127u);
                tk_sort16_desc(x);
                tk_merge16(run, x);
            }
#pragma unroll
            for (int j = 0; j < 16; ++j) { if (half) s1[j] = run[j]; else s0[j] = run[j]; LS[(half * 16 + j) * 512 + t] = run[j]; }
        }
        float run[16];
#pragma unroll
        for (int j = 0; j < 16; ++j) run[j] = -3.0e38f;
        {
            float x[16]; int cnt = 0;
#pragma unroll
            for (int p = 0; p < 16; ++p)
#pragma unroll
                for (int q = 0; q < 16; ++q) if ((p + 1) * (q + 1) <= 16) {
                    x[cnt & 15] = tk_tag(s0[p] + s1[q], (unsigned)(p * 16 + q), 255u); ++cnt;
                    if ((cnt & 15) == 0) { tk_sort16_desc(x); tk_merge16(run, x); }
                }
#pragma unroll
            for (int k = 0; k < 16; ++k) if (k >= (cnt & 15)) x[k] = -3.0e38f;
            tk_sort16_desc(x); tk_merge16(run, x);
        }
        const float mx = run[0]; float den = 0.f; float e[16]; int ti[16];
#pragma unroll
        for (int j = 0; j < 16; ++j) {
            const unsigned tg = __builtin_bit_cast(unsigned, run[j]) & 255u; const int p = (int)(tg >> 4), q = (int)(tg & 15u);
            const unsigned k0 = __builtin_bit_cast(unsigned, LS[(0 * 16 + p) * 512 + t]) & 127u, k1 = __builtin_bit_cast(unsigned, LS[(1 * 16 + q) * 512 + t]) & 127u;
            ti[j] = (int)(k0 * 128u + k1);
            e[j] = __expf(run[j] - mx); den += e[j];
        }
        const float inv = 1.0f / den;
        const size_t it = (size_t)n * 8 + h;
        float su[16];
#pragma unroll
        for (int j = 0; j < 16; ++j) { su[j] = tsu[ti[j]]; e[j] *= tsv[ti[j]]; }
        f32x4* go = (f32x4*)(gate + it * 16); v4u* io = (v4u*)(idx + it * 16); f32x4* so = (f32x4*)(sug + it * 16);
#pragma unroll
        for (int j = 0; j < 4; ++j) { go[j] = (f32x4){e[4 * j] * inv, e[4 * j + 1] * inv, e[4 * j + 2] * inv, e[4 * j + 3] * inv};
            so[j] = (f32x4){su[4 * j], su[4 * j + 1], su[4 * j + 2], su[4 * j + 3]};
            io[j] = (v4u){(unsigned)ti[4 * j], (unsigned)ti[4 * j + 1], (unsigned)ti[4 * j + 2], (unsigned)ti[4 * j + 3]}; }
    }
}

typedef float f32x2_t __attribute__((ext_vector_type(2)));
typedef int v4i __attribute__((ext_vector_type(4)));
struct PeerSplit { int ng, g, nwg, w0; };
__device__ __forceinline__ PeerSplit peer_split(const Frame& F) {
    PeerSplit p; p.ng = F.G < 8 ? F.G : 8; p.g = (int)blockIdx.x % p.ng; p.nwg = (F.G - p.g + p.ng - 1) / p.ng; p.w0 = ((int)blockIdx.x / p.ng) * NWAVES + F.wave; return p;
}
__device__ __forceinline__ float xl32(float v, int lane) { return __builtin_bit_cast(float, __builtin_amdgcn_ds_bpermute((lane ^ 32) << 2, __builtin_bit_cast(int, v))); }
constexpr int PU_CH = 12, PV_CH = 6;
constexpr int PU_E = 0, PU_XH = PU_CH * 512, PU_XL = PU_XH + PU_CH * 128, PU_SC = PU_XL + PU_CH * 128, PU_O = PU_SC + PU_CH * 32, PU_WB = PU_O + PU_CH * 512;
constexpr int PV_E = 0, PV_C = PV_CH * 512, PV_X = 2 * PV_CH * 512, PV_SQ = PV_X + PV_CH * 1024, PV_WB = PV_SQ + 64;
static_assert(8 * PU_WB <= 131072 && 8 * PV_WB <= 131072 && PU_WB % 64 == 0 && PV_WB % 64 == 0, "PEER staging must fit the LDS ring area");
__device__ __forceinline__ void fmac(float& acc, float x, float y) { asm("v_fmac_f32 %0, %1, %2" : "+v"(acc) : "v"(x), "v"(y)); }
template <int B> __device__ __forceinline__ float code_f(unsigned w) { return __builtin_bit_cast(float, __builtin_amdgcn_perm(w, 0x3Fu, 0x00040C0Cu + ((unsigned)B << 16))); }
__device__ __forceinline__ float swz4(float v) { return __builtin_bit_cast(float, __builtin_amdgcn_ds_swizzle(__builtin_bit_cast(int, v), 0x101F)); }
__device__ __forceinline__ void lds_ld16(const LAS unsigned char* p, int (&e)[16]) {
#pragma unroll
    for (int k = 0; k < 4; ++k) { const v4u t = ((const LAS v4u*)p)[k]; e[4 * k] = (int)t.x; e[4 * k + 1] = (int)t.y; e[4 * k + 2] = (int)t.z; e[4 * k + 3] = (int)t.w; }
}
__device__ __forceinline__ void peer_u_phase(const Args& a, Frame& F, int l) {
    const WsMap m = ws_map(NTOK);
    const PeerSplit ps = peer_split(F);
    const int lane = F.lane, r = lane >> 3, q = lane & 7;
    const int* idx = (const int*)(a.ws + m.idx);
    float* dpart = (float*)(a.ws + m.dpart);
    const bool q0b = (lane & 1) != 0, q1b = (lane & 2) != 0, q2b = (lane & 4) != 0;
    const int qrow = (q0b ? 8 : 0) + (q1b ? 4 : 0) + (q2b ? 2 : 0);
    const int stride = ps.nwg * NWAVES;
    if (ps.w0 >= NTOK) return;
    const int nt = (NTOK - 1 - ps.w0) / stride + 1;
    LAS unsigned char* wb = F.lds + F.wave * PU_WB;
    for (int s = ps.g; s < 8; s += ps.ng) {
        const unsigned char* TU = (const unsigned char*)(a.ws + m.tabu) + ((size_t)(l * 2) * 8 + s) * NEXP * TSL; const unsigned q16 = (unsigned)q * 16u;
        const unsigned char* hqs = a.ws + m.mix16 + 128 * s;
        v4u se[PU_CH / 2], sxh[2], sxl[2]; float ssc[2];
        auto stage_load = [&](int tb) {
            const int cnt = nt - tb < PU_CH ? nt - tb : PU_CH;
#pragma unroll
            for (int k = 0; k < PU_CH / 2; ++k) { const int j = 2 * k + (lane >> 5);
                se[k] = *(const v4u*)(idx + (size_t)(ps.w0 + (tb + (j < cnt ? j : cnt - 1)) * stride) * 128 + (lane & 31) * 4); }
#pragma unroll
            for (int k = 0; k < 2; ++k) { const int j = 8 * k + r;
                const unsigned char* hn = hqs + (size_t)(ps.w0 + (tb + (j < cnt ? j : cnt - 1)) * stride) * 2304;
                sxh[k] = *(const v4u*)(hn + 16 * q); sxl[k] = *(const v4u*)(hn + 1024 + 16 * q); ssc[k] = *(const float*)(hn + 2048 - 96 * s + 4 * q); }
        };
        stage_load(0);
#pragma unroll 1
        for (int tb = 0; tb < nt; tb += PU_CH) {
            const int cnt = nt - tb < PU_CH ? nt - tb : PU_CH;
#pragma unroll
            for (int k = 0; k < PU_CH / 2; ++k) *(LAS v4u*)(wb + PU_E + (2 * k + (lane >> 5)) * 512 + (lane & 31) * 16) = se[k];
#pragma unroll
            for (int k = 0; k < 2; ++k) if (8 * k + r < PU_CH) { const int j = 8 * k + r;
                *(LAS v4u*)(wb + PU_XH + j * 128 + q * 16) = sxh[k]; *(LAS v4u*)(wb + PU_XL + j * 128 + q * 16) = sxl[k]; *(LAS float*)(wb + PU_SC + j * 32 + q * 4) = ssc[k]; }
            int ec[16]; v4u row[8];
            lds_ld16(wb + PU_E + r * 64, ec);
#pragma unroll
            for (int i = 0; i < 8; ++i) row[i] = *(const v4u*)(TU + (((unsigned)ec[i] << 7) | q16));
#pragma unroll 1
            for (int j = 0; j < cnt; ++j) {
                int en[16];
                lds_ld16(wb + PU_E + (j + 1 < cnt ? j + 1 : j) * 512 + r * 64, en);
                const v4u xh = *(const LAS v4u*)(wb + PU_XH + j * 128 + q * 16), xl = *(const LAS v4u*)(wb + PU_XL + j * 128 + q * 16);
                const float xscale = *(const LAS float*)(wb + PU_SC + j * 32 + q * 4);
                int sh = 0, sl = 0;
#pragma unroll
                for (int d = 0; d < 4; ++d) { sh = __builtin_amdgcn_sdot8((int)xh[d], 0x11111111, sh, false); sl = __builtin_amdgcn_sdot8((int)xl[d], 0x11111111, sl, false); }
                const float xoff = 0.5f * (float)(16 * sh + sl);
                float tp[16];
#pragma unroll
                for (int hf = 0; hf < 2; ++hf)
#pragma unroll
                for (int i = 0; i < 8; ++i) {
                    int ia = 0, ib = 0;
#pragma unroll
                    for (int d = 0; d < 4; ++d) { ia = __builtin_amdgcn_sdot8((int)row[i][d], (int)xh[d], ia, false); ib = __builtin_amdgcn_sdot8((int)row[i][d], (int)xl[d], ib, false); }
                    row[i] = *(const v4u*)(TU + (((unsigned)(hf ? en[i] : ec[8 + i]) << 7) | q16));
                    __builtin_amdgcn_sched_barrier(0);
                    tp[8 * hf + i] = ((float)(16 * ia + ib) + xoff) * xscale;
                }
                float ta[8], tb2[4];
#pragma unroll
                for (int p = 0; p < 8; ++p) { const float kk = q0b ? tp[p + 8] : tp[p], ss = q0b ? tp[p] : tp[p + 8]; ta[p] = kk + dpp_f<0xB1>(ss); }
#pragma unroll
                for (int p = 0; p < 4; ++p) { const float kk = q1b ? ta[p + 4] : ta[p], ss = q1b ? ta[p] : ta[p + 4]; tb2[p] = kk + dpp_f<0x4E>(ss); }
                const float k0 = (q2b ? tb2[2] : tb2[0]) + swz4(q2b ? tb2[0] : tb2[2]), k1 = (q2b ? tb2[3] : tb2[1]) + swz4(q2b ? tb2[1] : tb2[3]);
                ((LAS f32x2_t*)(wb + PU_O))[j * 64 + lane] = (f32x2_t){k0, k1};
#pragma unroll
                for (int i = 0; i < 16; ++i) ec[i] = en[i];
            }
            if (tb + PU_CH < nt) stage_load(tb + PU_CH);
#pragma unroll 1
            for (int j = 0; j < cnt; ++j) *(f32x2_t*)(dpart + ((size_t)s * NTOK + (ps.w0 + (tb + j) * stride)) * 128 + 16 * r + qrow) = ((LAS f32x2_t*)(wb + PU_O))[j * 64 + lane];
            __builtin_amdgcn_s_waitcnt(0);
        }
    }
}
typedef _Float16 h2_t __attribute__((ext_vector_type(2)));
__device__ __forceinline__ float coef_pack(float c) { const _Float16 h = (_Float16)(c * 256.0f); return __builtin_bit_cast(float, (h2_t){h, h}); }
__device__ __forceinline__ void peer_c_phase(const Args& a, Frame& F) {
    const WsMap m = ws_map(NTOK);
    float* gate = (float*)(a.ws + m.gate); const float* sug = (const float*)(a.ws + m.act); const float* dpart = (const float*)(a.ws + m.dpart);
    for (int n = F.gw; n < NTOK; n += F.ngw) {
        const size_t j0 = (size_t)n * 128 + 2 * F.lane;
        f32x2_t dp[8];
#pragma unroll
        for (int sp = 0; sp < 8; ++sp) dp[sp] = *(const f32x2_t*)(dpart + (size_t)sp * NTOK * 128 + j0);
        const f32x2_t gt = *(const f32x2_t*)(gate + j0), su = *(const f32x2_t*)(sug + j0);
        const f32x2_t d = ((dp[0] + dp[1]) + (dp[2] + dp[3])) + ((dp[4] + dp[5]) + (dp[6] + dp[7]));
        *(f32x2_t*)(gate + j0) = (f32x2_t){coef_pack(gelu_fast(d.x * su.x) * gt.x), coef_pack(gelu_fast(d.y * su.y) * gt.y)};
    }
}
__device__ __forceinline__ void peer_v_phase(const Args& a, Frame& F, int l) {
    const WsMap m = ws_map(NTOK);
    const PeerSplit ps = peer_split(F);
    const int lane = F.lane, r = lane >> 3, q = lane & 7;
    const int* idx = (const int*)(a.ws + m.idx); const float* coef = (const float*)(a.ws + m.gate);
    float* ssq = (float*)(a.ws + m.ssq);
    const bool b3 = (lane & 8) != 0, b4 = (lane & 16) != 0, b5 = (lane & 32) != 0;
    const int c0 = (b3 ? 16 : 0) + (b4 ? 8 : 0) + (b5 ? 4 : 0);
    const int stride = ps.nwg * NWAVES;
    if (ps.w0 >= NTOK) return;
    const int nt = (NTOK - 1 - ps.w0) / stride + 1;
    LAS unsigned char* wb = F.lds + F.wave * PV_WB;
    for (int s = ps.g; s < 8; s += ps.ng) {
        const unsigned char* TV = (const unsigned char*)(a.ws + m.tabu) + ((size_t)(l * 2 + 1) * 8 + s) * NEXP * TSL; const unsigned q16 = (unsigned)q * 16u;
        v4u se[PV_CH / 2], sc[PV_CH / 2]; f32x4 sx[PV_CH];
        auto stage_load = [&](int tb) {
            const int cnt = nt - tb < PV_CH ? nt - tb : PV_CH;
#pragma unroll
            for (int k = 0; k < PV_CH / 2; ++k) { const int j = 2 * k + (lane >> 5); const size_t n = (size_t)(ps.w0 + (tb + (j < cnt ? j : cnt - 1)) * stride);
                se[k] = *(const v4u*)(idx + n * 128 + (lane & 31) * 4); sc[k] = *(const v4u*)(coef + n * 128 + (lane & 31) * 4); }
#pragma unroll
            for (int j = 0; j < PV_CH; ++j) sx[j] = *(const f32x4*)(a.out + (size_t)(ps.w0 + (tb + (j < cnt ? j : cnt - 1)) * stride) * DM + 256 * s + lane * 4);
        };
        stage_load(0);
#pragma unroll 1
        for (int tb = 0; tb < nt; tb += PV_CH) {
            const int cnt = nt - tb < PV_CH ? nt - tb : PV_CH;
#pragma unroll
            for (int k = 0; k < PV_CH / 2; ++k) { *(LAS v4u*)(wb + PV_E + (2 * k + (lane >> 5)) * 512 + (lane & 31) * 16) = se[k]; *(LAS v4u*)(wb + PV_C + (2 * k + (lane >> 5)) * 512 + (lane & 31) * 16) = sc[k]; }
#pragma unroll
            for (int j = 0; j < PV_CH; ++j) *(LAS f32x4*)(wb + PV_X + j * 1024 + lane * 16) = sx[j];
            int ec[16]; v4u row[8];
            lds_ld16(wb + PV_E + r * 64, ec);
#pragma unroll
            for (int i = 0; i < 8; ++i) row[i] = *(const v4u*)(TV + (((unsigned)ec[i] << 7) | q16));
#pragma unroll 1
            for (int j = 0; j < cnt; ++j) {
                int en[16];
                lds_ld16(wb + PV_E + (j + 1 < cnt ? j + 1 : j) * 512 + r * 64, en);
                float ci[16];
#pragma unroll
                for (int k = 0; k < 4; ++k) { const f32x4 t = ((const LAS f32x4*)(wb + PV_C + j * 512 + r * 64))[k]; ci[4 * k] = t.x; ci[4 * k + 1] = t.y; ci[4 * k + 2] = t.z; ci[4 * k + 3] = t.w; }
                const f32x4 x4 = *(const LAS f32x4*)(wb + PV_X + j * 1024 + (32 * q + c0) * 4);
                h2_t oh[16];
#pragma unroll
                for (int i = 0; i < 16; ++i) oh[i] = (h2_t){(_Float16)0.f, (_Float16)0.f};
#pragma unroll
                for (int hf = 0; hf < 2; ++hf)
#pragma unroll
                for (int i = 0; i < 8; ++i) {
                    const h2_t c2 = __builtin_bit_cast(h2_t, ci[8 * hf + i]);
#pragma unroll
                    for (int d = 0; d < 4; ++d) {
                        oh[4 * d + 0] = __builtin_elementwise_fma(__builtin_bit_cast(h2_t, __builtin_amdgcn_cvt_scalef32_pk_f16_fp4(row[i][d], 1.0f, 0)), c2, oh[4 * d + 0]);
                        oh[4 * d + 1] = __builtin_elementwise_fma(__builtin_bit_cast(h2_t, __builtin_amdgcn_cvt_scalef32_pk_f16_fp4(row[i][d], 1.0f, 1)), c2, oh[4 * d + 1]);
                        oh[4 * d + 2] = __builtin_elementwise_fma(__builtin_bit_cast(h2_t, __builtin_amdgcn_cvt_scalef32_pk_f16_fp4(row[i][d], 1.0f, 2)), c2, oh[4 * d + 2]);
                        oh[4 * d + 3] = __builtin_elementwise_fma(__builtin_bit_cast(h2_t, __builtin_amdgcn_cvt_scalef32_pk_f16_fp4(row[i][d], 1.0f, 3)), c2, oh[4 * d + 3]); }
                    row[i] = *(const v4u*)(TV + (((unsigned)(hf ? en[i] : ec[8 + i]) << 7) | q16));
                    __builtin_amdgcn_sched_barrier(0);
                }
                h2_t ha[8], hb[4], hc[2];
#pragma unroll
                for (int p = 0; p < 8; ++p) { const h2_t kk = b3 ? oh[p + 8] : oh[p], ss = b3 ? oh[p] : oh[p + 8];
                    ha[p] = kk + __builtin_bit_cast(h2_t, dpp_f<0x128>(__builtin_bit_cast(float, ss))); }
#pragma unroll
                for (int p = 0; p < 4; ++p) { const h2_t kk = b4 ? ha[p + 4] : ha[p], ss = b4 ? ha[p] : ha[p + 4];
                    hb[p] = kk + __builtin_bit_cast(h2_t, swz16(__builtin_bit_cast(float, ss))); }
#pragma unroll
                for (int p = 0; p < 2; ++p) { const h2_t kk = b5 ? hb[p + 2] : hb[p], ss = b5 ? hb[p] : hb[p + 2];
                    hc[p] = kk + __builtin_bit_cast(h2_t, xl32(__builtin_bit_cast(float, ss), lane)); }
                const float h3[4] = {(float)hc[0].x, (float)hc[0].y, (float)hc[1].x, (float)hc[1].y};
                const f32x4 o = {x4.x + h3[0] * (1.0f / 256.0f), x4.y + h3[1] * (1.0f / 256.0f), x4.z + h3[2] * (1.0f / 256.0f), x4.w + h3[3] * (1.0f / 256.0f)};
                *(LAS f32x4*)(wb + PV_X + j * 1024 + (32 * q + c0) * 4) = o;
                const float tot = wave_sum_u((o.x * o.x + o.y * o.y) + (o.z * o.z + o.w * o.w));
                if (lane == 0) ((LAS float*)(wb + PV_SQ))[j] = tot;
#pragma unroll
                for (int i = 0; i < 16; ++i) ec[i] = en[i];
            }
            if (tb + PV_CH < nt) stage_load(tb + PV_CH);
#pragma unroll 1
            for (int j = 0; j < cnt; ++j) { const int n = ps.w0 + (tb + j) * stride; const size_t off = (size_t)n * DM + 256 * s + lane * 4;
                const f32x4 o = *(const LAS f32x4*)(wb + PV_X + j * 1024 + lane * 16);
                *(f32x4*)(a.out + off) = o;
                if (l + 1 < NL) { v2u w; w.x = pk2(o.x, o.y); w.y = pk2(o.z, o.w); *(v2u*)((bf16_t*)(a.ws + m.xn) + off) = w; }
                if (lane == 0) ssq[(size_t)n * 8 + s] = ((const LAS float*)(wb + PV_SQ))[j]; }
            __builtin_amdgcn_s_waitcnt(0);
        }
    }
}
__device__ __forceinline__ void fnorm_phase(const Args& a, Frame& F) {
    const WsMap m = ws_map(NTOK);
    const float* ssq = (const float*)(a.ws + m.ssq);
    const int lane = F.lane;
    for (int n = F.gw; n < NTOK; n += F.ngw) {
        const f32x4 s0 = *(const f32x4*)(ssq + (size_t)n * 8), s1 = *(const f32x4*)(ssq + (size_t)n * 8 + 4);
        const float rstd = 1.0f / sqrtf((((s0.x + s0.y) + (s0.z + s0.w)) + ((s1.x + s1.y) + (s1.z + s1.w))) * (1.0f / DM) + 1e-6f);
        float* xrow = a.out + (size_t)n * DM;
        const float* gf = a.in[I_NORM_FINAL];
        f32x4 v[8];
#pragma unroll
        for (int k = 0; k < 8; ++k) v[k] = *(const f32x4*)(xrow + 256 * k + 4 * lane);
#pragma unroll
        for (int k = 0; k < 8; ++k) { const f32x4 g4 = *(const f32x4*)(gf + 256 * k + 4 * lane);
            *(f32x4*)(xrow + 256 * k + 4 * lane) = (f32x4){v[k].x * rstd * g4.x, v[k].y * rstd * g4.y, v[k].z * rstd * g4.z, v[k].w * rstd * g4.w}; }
    }
}

#define IN(k) (lo <= (k) && (k) < hi)
#define SEAM(k) do { if (IN(k) && IN((k) + 1)) xcd_barrier(bar); } while (0)
template <int l>
__device__ __forceinline__ void layer_phases(const Args& a, Frame& F, const XcdBarrier& bar, const WsMap& m, int lo, int hi) {
    constexpr int pb = l * PH_PER_LAYER;
        if (IN(pb + PH_GEMM1)) {
            pg8::GemmX g{(const bf16_t*)(a.ws + m.xn), (const bf16_t*)(a.ws + m.w1t) + (size_t)l * PLD * DM, NTOK, PLD, DM, DM};
            pg8::StaticOrder S; S.init(NTOK, PLD, F.G, (int)blockIdx.x);
            pg8::EpiBf16 E{(bf16_t*)(a.ws + m.p16), PLD, nullptr, l > 0 ? (const float*)(a.ws + m.ssq) : nullptr};
            pg8::gemm_phase<pg8::EpiBf16, pg8::StaticOrder, true, true>(F.lds, g, S, E);
            SEAM(pb + PH_GEMM1);
        }
        if (IN(pb + PH_PREP)) { prep_phase(a, F, l); SEAM(pb + PH_PREP); }
        if (IN(pb + PH_AUX)) {
            const float* PP = (const float*)(a.ws + m.pp);
            { pg8::GemmX g{(const bf16_t*)(a.ws + m.auxA), (const bf16_t*)(a.ws + m.auxwt) + (size_t)l * 1792 * 384, NTOK, 1792, 384, 384};
              pg8::StaticOrder S; S.init(NTOK, 1792, F.G, (int)blockIdx.x);
              pg8::EpiBf16 E{(bf16_t*)(a.ws + m.auxo), 1792, PP + l * 1792};
              pg8::gemm_phase<pg8::EpiBf16, pg8::StaticOrder, true, true>(F.lds, g, S, E); }
            { pg8::GemmX g{(const bf16_t*)(a.ws + m.xc), (const bf16_t*)(a.ws + m.lruwt) + (size_t)l * 1024 * 512, NTOK, 1024, 512, 512};
              pg8::StaticOrder S; S.init(NTOK, 1024, F.G, (int)blockIdx.x);
              pg8::EpiBf16 E{(bf16_t*)(a.ws + m.gates), 1024, PP + 3584 + l * 1024};
              pg8::gemm_phase<pg8::EpiBf16, pg8::StaticOrder, true, true>(F.lds, g, S, E); }
            if (l > 0) {
              pg8::GemmX g{(const bf16_t*)(a.ws + m.zrkv) + 1024, (const bf16_t*)(a.ws + m.vreswt), NTOK, 512, 512, 1536};
              pg8::StaticOrder S; S.init(NTOK, 512, F.G, (int)blockIdx.x);
              pg8::EpiBf16 E{(bf16_t*)(a.ws + m.vres), 512, PP + 5632};
              pg8::gemm_phase<pg8::EpiBf16, pg8::StaticOrder, true, true>(F.lds, g, S, E); }
            SEAM(pb + PH_AUX);
        }
        if (IN(pb + PH_SCAN)) { scan_phase(a, F, l); SEAM(pb + PH_SCAN); }
        if (IN(pb + PH_POST)) { post_phase(a, F, l, bar); SEAM(pb + PH_POST); }
        if (IN(pb + PH_GEMM2)) {
            pg8::GemmX g{(const bf16_t*)(a.ws + m.mix16), (const bf16_t*)(a.ws + m.w2t) + (size_t)l * DM * DM, NTOK, DM, DM, DM};
            pg8::StaticOrder S; S.init(NTOK, DM, F.G, (int)blockIdx.x);
            pg8::EpiF32<true> E{a.out, DM};
            pg8::gemm_phase<pg8::EpiF32<true>, pg8::StaticOrder, true, true>(F.lds, g, S, E);
            SEAM(pb + PH_GEMM2);
        }
        if (IN(pb + PH_NORM2)) { norm2_phase(a, F, l); SEAM(pb + PH_NORM2); }
        if (IN(pb + PH_GEMM3)) {
            pg8::GemmX g{(const bf16_t*)(a.ws + m.wsct) + (size_t)l * DM * DM, (const bf16_t*)(a.ws + m.hb), DM, NTOK, DM, DM};
            pg8::StaticOrder S; S.init(DM, NTOK, F.G, (int)blockIdx.x);
            pg8::EpiF32<false> E{(float*)(a.ws + m.sc), NTOK};
            pg8::gemm_phase<pg8::EpiF32<false>, pg8::StaticOrder, true, true>(F.lds, g, S, E);
            SEAM(pb + PH_GEMM3);
        }
        if (IN(pb + PH_TOPK)) { topk_phase(a, F, l); SEAM(pb + PH_TOPK); }
        if (IN(pb + PH_PEERU)) { peer_u_phase(a, F, l); SEAM(pb + PH_PEERU); }
        if (IN(pb + PH_PEERC)) { peer_c_phase(a, F); SEAM(pb + PH_PEERC); }
        if (IN(pb + PH_PEERV)) { peer_v_phase(a, F, l); SEAM(pb + PH_PEERV); }
}

#undef IN
#undef SEAM
__global__ void __launch_bounds__(NTHR, 2) mega(Args a) {
    extern __shared__ __attribute__((aligned(16))) unsigned char lds_raw[];
    Frame F;
    F.lds = (LAS unsigned char*)lds_raw;
    F.tid = threadIdx.x; F.lane = F.tid & 63; F.wave = __builtin_amdgcn_readfirstlane(F.tid >> 6);
    F.G = gridDim.x; { const int bx = blockIdx.x; F.vcu = (F.G % 8 == 0) ? (bx % 8) * (F.G / 8) + bx / 8 : bx; }
    F.gw = F.vcu * NWAVES + F.wave; F.ngw = F.G * NWAVES;
    volatile LAS unsigned* MISC = (volatile LAS unsigned*)(F.lds + MISC_OFF);
    if (F.tid < 32) MISC[F.tid] = 0u;
    __syncthreads();
    const WsMap m = ws_map(NTOK);
    unsigned* ctl = (unsigned*)(a.ws + m.ctl);
    XcdBarrier bar; bar.bar = ctl + 4096 + a.li * XCD_BAR_WORDS; bar.x = 0; bar.st = nullptr;
    const int lo = a.ph_lo, hi = a.ph_hi;
    if (hi - lo > 1) bar = xcd_barrier_post(ctl + 4096 + a.li * XCD_BAR_WORDS, MISC + 8);
#define IN(k) (lo <= (k) && (k) < hi)
#define SEAM(k) do { if (IN(k) && IN((k) + 1)) xcd_barrier(bar); } while (0)
    if (IN(PH_P0)) { p0_prologue(a, F); tables_range(a, F, 0, (size_t)2 * NEXP * DM / 32, F.vcu, F.G); SEAM(PH_P0); }
    layer_phases<0>(a, F, bar, m, lo, hi);
    layer_phases<1>(a, F, bar, m, lo, hi);
    if (IN(PH_FNORM)) fnorm_phase(a, F);
#undef IN
#undef SEAM
}

template <int ST>
__global__ void __launch_bounds__(256) stage_kernel(Params P, int l) {
    const long n = stage_items(P, ST, l);
    for (long it = blockIdx.x * 256L + threadIdx.x; it < n; it += gridDim.x * 256L) run_item(P, ST, l, it);
}
template <int ST>
static void launch_stage(const Params& P, int l, hipStream_t stream) {
    const long n = stage_items(P, ST, l);
    if (n <= 0) return;
    long blocks = (n + 255) / 256;
    if (blocks > 8192) blocks = 8192;
    stage_kernel<ST><<<dim3((unsigned)blocks), dim3(256), 0, stream>>>(P, l);
}
#define LS(X) case X: launch_stage<X>(P, l, stream); break;
static void launch_any(int st, const Params& P, int l, hipStream_t stream) {
    switch (st) {
        LS(ST_COPYX) LS(ST_RSTD) LS(ST_NORM1) LS(ST_GEMM1) LS(ST_RW_A0) LS(ST_RW_A1) LS(ST_RW_A2) LS(ST_RW_A3) LS(ST_RW_KKN)
        LS(ST_RW_SCAN) LS(ST_RW_POST) LS(ST_GLA_B0) LS(ST_GLA_SCAN) LS(ST_GLA_POST) LS(ST_LRU_C0) LS(ST_LRU_C1) LS(ST_LRU_SCAN)
        LS(ST_GDN_D0) LS(ST_GDN_D1) LS(ST_GDN_SCAN) LS(ST_GDN_POST) LS(ST_GEMM2) LS(ST_RSTD2) LS(ST_NORM2) LS(ST_GEMM3)
        LS(ST_SCORES) LS(ST_TOPK1) LS(ST_TOPK2) LS(ST_PEER_U) LS(ST_PEER_V) LS(ST_FRSTD) LS(ST_FNORM)
    }
}

extern "C" void kernel_launch(void* const* d_in, const int* in_sizes, int n_in, void* d_out, int out_size, void* d_ws,
                              size_t ws_size, hipStream_t stream) {
    static int grid = 0;
    if (grid == 0) {
        int dev = 0, cus = 0;
        (void)hipGetDevice(&dev);
        (void)hipDeviceGetAttribute(&cus, hipDeviceAttributeMultiprocessorCount, dev);
        (void)hipFuncSetAttribute((const void*)mega, hipFuncAttributeMaxDynamicSharedMemorySize, LDS_BYTES);
        grid = cus > 0 ? cus : 256;
    }
    Params P;
    memset(&P, 0, sizeof(P));
    fill_inputs(P, d_in);
    P.B = 4; P.T = 4096; P.N = 16384; P.pad = 0;
    P.xcur = (float*)d_out;
    bind_ws(P, (char*)d_ws);
    Args a;
    memset(&a, 0, sizeof(a));
    for (int i = 0; i < 38; ++i) a.in[i] = (const float*)d_in[i];
    a.out = (float*)d_out; a.ws = (unsigned char*)d_ws;
    (void)hipMemsetAsync(d_ws, 0, 1u << 20, stream);
    int li = 0;
    auto run_mega = [&](int lo, int hi) { a.ph_lo = lo; a.ph_hi = hi; a.li = li++; hipLaunchKernelGGL(mega, dim3(grid), dim3(NTHR), LDS_BYTES, stream, a); };
    run_mega(PH_P0, PH_TOTAL);
}
#endif
```

```cpp
#ifndef HOST_EMU
#include <hip/hip_runtime.h>
#include <cstring>
#define HD __host__ __device__ __forceinline__
#else
#include <cmath>
#include <cstdio>
#include <cstdlib>
#include <cstring>
#define HD inline
#endif

constexpr int DM = 2048;
constexpr int NL = 2;
constexpr int INC = 6424;
constexpr int C_RW = 0;
constexpr int C_GLA = 1792;
constexpr int C_LRU = 3344;
constexpr int C_GDN = 4368;
constexpr int NEXP = 16384;

typedef unsigned short bf16_t;
constexpr int PLD = 6656;
HD float bf2f(bf16_t h) { unsigned u = (unsigned)h << 16; float f; memcpy(&f, &u, 4); return f; }
HD bf16_t f2bf(float f) { unsigned u; memcpy(&u, &f, 4); return (bf16_t)((u + 0x7fffu + ((u >> 16) & 1u)) >> 16); }

struct Params {
    const float *x, *norm_mix, *w_in, *w_out, *rw_mu, *rw_w0, *rw_w_up, *rw_a0, *rw_a_up, *rw_g_up, *rw_k_k, *rw_k_a,
        *rw_r_k, *rw_ln_w, *rw_ln_b, *rw_v0, *rw_v_down, *rw_v_up, *gla_a_up, *gla_a_bias, *gla_norm, *lru_conv_w,
        *lru_conv_b, *lru_w_r, *lru_b_r, *lru_w_i, *lru_b_i, *lru_lam, *gdn_conv_w, *gdn_a_log, *gdn_dt_bias, *gdn_norm,
        *norm_ffn, *peer_wq, *peer_sub_keys, *peer_u, *peer_v, *norm_final;
    float* xcur;
    bf16_t* xn;
    bf16_t* hb;
    bf16_t* mix16;
    bf16_t* p16;
    float* sc;
    float* qf;
    float* rstd;
    float* vfirst;
    float* scr;
    float* act;
    float* gate;
    int* idx;
    int B, T, N, pad;
};

HD float sigmoidf_(float x) { return 1.0f / (1.0f + expf(-x)); }
HD float softplusf_(float x) { return log1pf(expf(-fabsf(x))) + fmaxf(x, 0.0f); }
HD float siluf_(float x) { return x * sigmoidf_(x); }
HD float geluf_(float x) { return 0.5f * x * (1.0f + tanhf(0.7978845608028654f * (x + 0.044715f * x * x * x))); }

enum Stage {
    ST_COPYX = 0,
    ST_RSTD, ST_NORM1, ST_GEMM1,
    ST_RW_A0, ST_RW_A1, ST_RW_A2, ST_RW_A3, ST_RW_KKN, ST_RW_SCAN, ST_RW_POST,
    ST_GLA_B0, ST_GLA_SCAN, ST_GLA_POST,
    ST_LRU_C0, ST_LRU_C1, ST_LRU_SCAN,
    ST_GDN_D0, ST_GDN_D1, ST_GDN_SCAN, ST_GDN_POST,
    ST_GEMM2, ST_RSTD2, ST_NORM2, ST_GEMM3, ST_SCORES, ST_TOPK1, ST_TOPK2, ST_PEER_U, ST_PEER_V,
    ST_FRSTD, ST_FNORM,
    ST_COUNT
};

constexpr long SO_ZS = 0, SO_R = 256, SO_DEC = 768, SO_KM = 1280, SO_KK = 1792, SO_A = 2304, SO_G = 2816, SO_V = 3328,
               SO_Y = 3840, SO_VD = 4352, SO_KKINV = 4384;
constexpr long SO_ALPHA = 0, SO_GO = 256;
constexpr long SO_XC = 0, SO_LA = 512, SO_LU = 1024;
constexpr long SO_QKV = 0, SO_GS = 1536, SO_DO = 1552;
constexpr long SCR_PER_TOK = 4400;
constexpr long SO_TS = 0, SO_TI = 256;

HD long stage_items(const Params& P, int st, int l) {
    const long N = P.N;
    switch (st) {
        case ST_COPYX: return N * DM;
        case ST_RSTD: case ST_RSTD2: case ST_FRSTD: return N;
        case ST_NORM1: case ST_NORM2: case ST_FNORM: return N * DM;
        case ST_GEMM1: return (N / 4) * (INC / 4);
        case ST_RW_A0: return N * 256;
        case ST_RW_A1: return N * 512;
        case ST_RW_A2: return l > 0 ? N * 32 : 0;
        case ST_RW_A3: return l > 0 ? N * 512 : 0;
        case ST_RW_KKN: return N * 8;
        case ST_RW_SCAN: return (long)P.B * 512;
        case ST_RW_POST: return N * 8;
        case ST_GLA_B0: return N * 256;
        case ST_GLA_SCAN: return (long)P.B * 512;
        case ST_GLA_POST: return N * 4;
        case ST_LRU_C0: return N * 512;
        case ST_LRU_C1: return N * 512;
        case ST_LRU_SCAN: return (long)P.B * 512;
        case ST_GDN_D0: return N * 1536;
        case ST_GDN_D1: return N * 4;
        case ST_GDN_SCAN: return (long)P.B * 512;
        case ST_GDN_POST: return N * 4;
        case ST_GEMM2: case ST_GEMM3: return (N / 4) * (DM / 4);
        case ST_SCORES: return N * 2048;
        case ST_TOPK1: return N * 16;
        case ST_TOPK2: return N * 8;
        case ST_PEER_U: return N * 128;
        case ST_PEER_V: return N * DM;
    }
    return 0;
}

HD void gemm_item(const bf16_t* A, const float* W, int ldw, const float* kscale, float* Cf, bf16_t* Ch, int ldc, int n4, long item, int mode) {
    const long r4 = item / n4;
    const int c4 = (int)(item % n4);
    const bf16_t* a0 = A + (r4 * 4) * (long)DM;
    const float* w = W + c4 * 4;
    float acc[4][4];
    for (int i = 0; i < 4; ++i)
        for (int j = 0; j < 4; ++j) acc[i][j] = 0.f;
    for (int k = 0; k < DM; ++k) {
        const float ks = kscale ? kscale[k] : 1.0f;
        const float w0 = w[(long)k * ldw + 0] * ks, w1 = w[(long)k * ldw + 1] * ks, w2 = w[(long)k * ldw + 2] * ks, w3 = w[(long)k * ldw + 3] * ks;
#pragma unroll
        for (int i = 0; i < 4; ++i) {
            const float a = bf2f(a0[(long)i * DM + k]);
            acc[i][0] += a * w0; acc[i][1] += a * w1; acc[i][2] += a * w2; acc[i][3] += a * w3;
        }
    }
#pragma unroll
    for (int i = 0; i < 4; ++i) {
        const long o = (r4 * 4 + i) * (long)ldc + c4 * 4;
#pragma unroll
        for (int j = 0; j < 4; ++j) {
            if (mode == 0) Ch[o + j] = f2bf(acc[i][j]);
            else if (mode == 1) Cf[o + j] += acc[i][j];
            else Cf[o + j] = acc[i][j];
        }
    }
}

#define PF(n, col) bf2f(P.p16[(long)(n) * PLD + (col)])
HD float rw_shift(const Params& P, int l, long n, int col) {
    const int t = (int)(n % P.T);
    const float cur = PF(n, C_RW + col);
    const float prev = t > 0 ? PF(n - 1, C_RW + col) : 0.f;
    return cur + (prev - cur) * P.rw_mu[l * 1792 + col];
}

HD void run_item(const Params& P, int st, int l, long it) {
    const long N = P.N;
    float* scr = P.scr;
    switch (st) {
        case ST_COPYX: P.xcur[it] = P.x[it]; break;
        case ST_RSTD: case ST_RSTD2: case ST_FRSTD: {
            const float* xr = P.xcur + it * DM;
            float s = 0.f;
            for (int d = 0; d < DM; ++d) s += xr[d] * xr[d];
            P.rstd[it] = 1.0f / sqrtf(s * (1.0f / DM) + 1e-6f);
        } break;
        case ST_NORM1: case ST_NORM2: case ST_FNORM: {
            const long n = it / DM; const int d = (int)(it % DM);
            if (st == ST_NORM1) P.xn[it] = f2bf(P.xcur[it] * P.rstd[n]);
            else if (st == ST_NORM2) P.hb[it] = f2bf(P.xcur[it] * P.rstd[n] * P.norm_ffn[l * DM + d]);
            else P.xcur[it] = P.xcur[it] * P.rstd[n] * P.norm_final[d];
        } break;
        case ST_GEMM1: gemm_item(P.xn, P.w_in + (long)l * DM * INC, INC, P.norm_mix + l * DM, nullptr, P.p16, PLD, INC / 4, it, 0); break;
        case ST_GEMM2: gemm_item(P.mix16, P.w_out + (long)l * DM * DM, DM, nullptr, P.xcur, nullptr, DM, DM / 4, it, 1); break;
        case ST_GEMM3: gemm_item(P.hb, P.peer_wq + (long)l * DM * DM, DM, nullptr, P.qf, nullptr, DM, DM / 4, it, 2); break;
        case ST_RW_A0: {
            const long n = it / 256; const int c = (int)(it % 256);
            const float z = rw_shift(P, l, n, 1536 + c);
            scr[N * SO_ZS + it] = c < 64 ? tanhf(z) : (c < 128 ? z : sigmoidf_(z));
        } break;
        case ST_RW_A1: {
            const long n = it / 512; const int j = (int)(it % 512);
            const float zr = rw_shift(P, l, n, j), zk = rw_shift(P, l, n, 512 + j), zv = rw_shift(P, l, n, 1024 + j);
            const float* zs = scr + N * SO_ZS + n * 256;
            float aw = P.rw_w0[l * 512 + j], aa = P.rw_a0[l * 512 + j], ag = 0.f;
            const float* wu = P.rw_w_up + (long)l * 64 * 512 + j;
            const float* au = P.rw_a_up + (long)l * 64 * 512 + j;
            const float* gu = P.rw_g_up + (long)l * 128 * 512 + j;
            for (int i = 0; i < 64; ++i) { aw += zs[i] * wu[i * 512]; aa += zs[64 + i] * au[i * 512]; }
            for (int i = 0; i < 128; ++i) ag += zs[128 + i] * gu[i * 512];
            const float w_raw = -softplusf_(-aw) - 0.5f;
            const float a = sigmoidf_(aa);
            scr[N * SO_R + it] = zr;
            scr[N * SO_DEC + it] = expf(-expf(w_raw));
            scr[N * SO_KM + it] = zk * (1.0f + (a - 1.0f) * P.rw_k_a[l * 512 + j]);
            scr[N * SO_KK + it] = zk * P.rw_k_k[l * 512 + j];
            scr[N * SO_A + it] = a;
            scr[N * SO_G + it] = ag;
            scr[N * SO_V + it] = zv;
            if (l == 0) P.vfirst[it] = zv;
        } break;
        case ST_RW_A2: {
            const long n = it / 32; const int i = (int)(it % 32);
            const float* v = scr + N * SO_V + n * 512;
            const float* vdn = P.rw_v_down + (long)(l - 1) * 512 * 32 + i;
            float s = 0.f;
            for (int j = 0; j < 512; ++j) s += v[j] * vdn[j * 32];
            scr[N * SO_VD + it] = s;
        } break;
        case ST_RW_A3: {
            const long n = it / 512; const int j = (int)(it % 512);
            const float* vd = scr + N * SO_VD + n * 32;
            const float* vup = P.rw_v_up + (long)(l - 1) * 32 * 512 + j;
            float s = P.rw_v0[(l - 1) * 512 + j];
            for (int i = 0; i < 32; ++i) s += vd[i] * vup[i * 512];
            const float v = scr[N * SO_V + it];
            scr[N * SO_V + it] = v + (P.vfirst[it] - v) * sigmoidf_(s);
        } break;
        case ST_RW_KKN: {
            const float* kk = scr + N * SO_KK + it * 64;
            float s = 0.f;
            for (int i = 0; i < 64; ++i) s += kk[i] * kk[i];
            scr[N * SO_KKINV + it] = 1.0f / sqrtf(fmaxf(s, 1e-24f));
        } break;
        case ST_RW_SCAN: {
            const int b = (int)(it / 512); const int h = (int)((it % 512) / 64); const int v = (int)(it % 64);
            float S[64];
#pragma unroll
            for (int i = 0; i < 64; ++i) S[i] = 0.f;
            for (int t = 0; t < P.T; ++t) {
                const long n = (long)b * P.T + t;
                const long base = n * 512 + h * 64;
                const float inv = scr[N * SO_KKINV + n * 8 + h];
                const float vv = scr[N * SO_V + base + v];
                const float* KK = scr + N * SO_KK + base;
                const float* DEC = scr + N * SO_DEC + base;
                const float* KM = scr + N * SO_KM + base;
                const float* AA = scr + N * SO_A + base;
                const float* RR = scr + N * SO_R + base;
                float sa = 0.f;
#pragma unroll
                for (int i = 0; i < 64; ++i) sa += S[i] * (-KK[i] * inv);
                float y = 0.f;
#pragma unroll
                for (int i = 0; i < 64; ++i) {
                    const float kk = KK[i] * inv;
                    S[i] = S[i] * DEC[i] + sa * (kk * AA[i]) + vv * KM[i];
                    y += S[i] * RR[i];
                }
                scr[N * SO_Y + base + v] = y;
            }
        } break;
        case ST_RW_POST: {
            const long n = it / 8; const int h = (int)(it % 8);
            const long base = n * 512 + h * 64;
            const float* Y = scr + N * SO_Y + base;
            const float* RR = scr + N * SO_R + base;
            const float* KM = scr + N * SO_KM + base;
            const float* V = scr + N * SO_V + base;
            const float* G = scr + N * SO_G + base;
            float mean = 0.f, bon = 0.f;
            for (int i = 0; i < 64; ++i) { mean += Y[i]; bon += RR[i] * KM[i] * P.rw_r_k[l * 512 + h * 64 + i]; }
            mean *= (1.0f / 64);
            float var = 0.f;
            for (int i = 0; i < 64; ++i) { const float d = Y[i] - mean; var += d * d; }
            const float rs = 1.0f / sqrtf(var * (1.0f / 64) + 64e-5f);
            for (int i = 0; i < 64; ++i) {
                const int c = h * 64 + i;
                const float yn = (Y[i] - mean) * rs * P.rw_ln_w[l * 512 + c] + P.rw_ln_b[l * 512 + c];
                P.mix16[n * DM + c] = f2bf((yn + bon * V[i]) * G[i]);
            }
        } break;
        case ST_GLA_B0: {
            const long n = it / 256; const int c = (int)(it % 256);
            float s = P.gla_a_bias[l * 256 + c];
            for (int i = 0; i < 16; ++i) s += PF(n, C_GLA + 1536 + i) * P.gla_a_up[(long)l * 16 * 256 + i * 256 + c];
            scr[N * SO_ALPHA + it] = expf(-softplusf_(-s) * (1.0f / 16.0f));
        } break;
        case ST_GLA_SCAN: {
            const int b = (int)(it / 512); const int h = (int)((it % 512) / 128); const int v = (int)(it % 128);
            float S[64];
#pragma unroll
            for (int i = 0; i < 64; ++i) S[i] = 0.f;
            for (int t = 0; t < P.T; ++t) {
                const long n = (long)b * P.T + t;
                const bf16_t* q = P.p16 + n * PLD + C_GLA + h * 64;
                const bf16_t* k = q + 256;
                const float vv = PF(n, C_GLA + 512 + h * 128 + v);
                const float* al = scr + N * SO_ALPHA + n * 256 + h * 64;
                float o = 0.f;
#pragma unroll
                for (int i = 0; i < 64; ++i) {
                    S[i] = S[i] * al[i] + bf2f(k[i]) * vv;
                    o += bf2f(q[i]) * S[i];
                }
                scr[N * SO_GO + n * 512 + h * 128 + v] = o * 0.125f;
            }
        } break;
        case ST_GLA_POST: {
            const long n = it / 4; const int h = (int)(it % 4);
            const float* o = scr + N * SO_GO + n * 512 + h * 128;
            float ms = 0.f;
            for (int i = 0; i < 128; ++i) ms += o[i] * o[i];
            const float rs = 1.0f / sqrtf(ms * (1.0f / 128) + 1e-6f);
            for (int i = 0; i < 128; ++i) {
                const float g = PF(n, C_GLA + 1024 + h * 128 + i);
                P.mix16[n * DM + 512 + h * 128 + i] = f2bf(o[i] * rs * P.gla_norm[l * 128 + i] * siluf_(g));
            }
        } break;
        case ST_LRU_C0: {
            const long n = it / 512; const int c = (int)(it % 512);
            const int t = (int)(n % P.T);
            float s = P.lru_conv_b[l * 512 + c];
            for (int j = 0; j < 4; ++j) {
                const int tt = t - 3 + j;
                if (tt >= 0) s += P.lru_conv_w[(long)l * 4 * 512 + j * 512 + c] * PF(n - 3 + j, C_LRU + c);
            }
            scr[N * SO_XC + it] = s;
        } break;
        case ST_LRU_C1: {
            const long n = it / 512; const int c = (int)(it % 512);
            const int blk = c / 64, j = c % 64;
            const float* xc = scr + N * SO_XC + n * 512 + blk * 64;
            const float* wr = P.lru_w_r + (long)l * 8 * 64 * 64 + (long)blk * 64 * 64 + j;
            const float* wi = P.lru_w_i + (long)l * 8 * 64 * 64 + (long)blk * 64 * 64 + j;
            float sr = P.lru_b_r[l * 512 + c], si = P.lru_b_i[l * 512 + c];
            for (int i = 0; i < 64; ++i) { sr += xc[i] * wr[i * 64]; si += xc[i] * wi[i * 64]; }
            const float r = sigmoidf_(sr), ig = sigmoidf_(si);
            const float log_a = -8.0f * r * softplusf_(-P.lru_lam[l * 512 + c]);
            scr[N * SO_LA + it] = expf(log_a);
            scr[N * SO_LU + it] = scr[N * SO_XC + it] * ig * sqrtf(-expm1f(2.0f * log_a));
        } break;
        case ST_LRU_SCAN: {
            const int b = (int)(it / 512); const int c = (int)(it % 512);
            float hst = 0.f;
            for (int t = 0; t < P.T; ++t) {
                const long n = (long)b * P.T + t;
                hst = scr[N * SO_LA + n * 512 + c] * hst + scr[N * SO_LU + n * 512 + c];
                P.mix16[n * DM + 1024 + c] = f2bf(hst * geluf_(PF(n, C_LRU + 512 + c)));
            }
        } break;
        case ST_GDN_D0: {
            const long n = it / 1536; const int c = (int)(it % 1536);
            const int t = (int)(n % P.T);
            float s = 0.f;
            for (int j = 0; j < 4; ++j) {
                const int tt = t - 3 + j;
                if (tt >= 0) s += P.gdn_conv_w[(long)l * 4 * 1536 + j * 1536 + c] * PF(n - 3 + j, C_GDN + c);
            }
            scr[N * SO_QKV + it] = siluf_(s);
        } break;
        case ST_GDN_D1: {
            const long n = it / 4; const int h = (int)(it % 4);
            const float* q = scr + N * SO_QKV + n * 1536 + h * 128;
            const float* k = q + 512;
            float qs = 0.f, ks = 0.f;
            for (int i = 0; i < 128; ++i) { qs += q[i] * q[i]; ks += k[i] * k[i]; }
            float* gs = scr + N * SO_GS + n * 16 + h * 4;
            gs[0] = (1.0f / sqrtf(qs + 1e-6f)) * 0.08838834764831845f;
            gs[1] = 1.0f / sqrtf(ks + 1e-6f);
            gs[2] = sigmoidf_(PF(n, C_GDN + 2048 + h));
            gs[3] = expf(-expf(P.gdn_a_log[l * 4 + h]) * softplusf_(PF(n, C_GDN + 2052 + h) + P.gdn_dt_bias[l * 4 + h]));
        } break;
        case ST_GDN_SCAN: {
            const int b = (int)(it / 512); const int h = (int)((it % 512) / 128); const int v = (int)(it % 128);
            float S[128];
#pragma unroll
            for (int i = 0; i < 128; ++i) S[i] = 0.f;
            for (int t = 0; t < P.T; ++t) {
                const long n = (long)b * P.T + t;
                const float* q = scr + N * SO_QKV + n * 1536 + h * 128;
                const float* k = q + 512;
                const float vv = scr[N * SO_QKV + n * 1536 + 1024 + h * 128 + v];
                const float* gs = scr + N * SO_GS + n * 16 + h * 4;
                const float qinv = gs[0], kinv = gs[1], beta = gs[2], eg = gs[3];
                float dk = 0.f;
#pragma unroll
                for (int i = 0; i < 128; ++i) dk += S[i] * k[i];
                const float u = beta * (vv - eg * kinv * dk) * kinv;
                float o = 0.f;
#pragma unroll
                for (int i = 0; i < 128; ++i) {
                    S[i] = S[i] * eg + u * k[i];
                    o += S[i] * q[i];
                }
                scr[N * SO_DO + n * 512 + h * 128 + v] = o * qinv;
            }
        } break;
        case ST_GDN_POST: {
            const long n = it / 4; const int h = (int)(it % 4);
            const float* o = scr + N * SO_DO + n * 512 + h * 128;
            float ms = 0.f;
            for (int i = 0; i < 128; ++i) ms += o[i] * o[i];
            const float rs = 1.0f / sqrtf(ms * (1.0f / 128) + 1e-6f);
            for (int i = 0; i < 128; ++i) {
                const float z = PF(n, C_GDN + 1536 + h * 128 + i);
                P.mix16[n * DM + 1536 + h * 128 + i] = f2bf(o[i] * rs * P.gdn_norm[l * 128 + i] * siluf_(z));
            }
        } break;
        case ST_SCORES: {
            const long n = it / 2048; const int c = (int)(it % 2048);
            const int hp = c / 128, key = c % 128;
            const float* q = P.qf + n * DM + hp * 128;
            const float* sk = P.peer_sub_keys + (long)l * 16 * 128 * 128 + ((long)hp * 128 + key) * 128;
            float s = 0.f;
            for (int d = 0; d < 128; ++d) s += q[d] * sk[d];
            P.sc[it] = s;
        } break;
        case ST_TOPK1: {
            const float* sc = P.sc + it * 128;
            float ts[16]; int ti[16];
#pragma unroll
            for (int j = 0; j < 16; ++j) { ts[j] = -3.0e38f; ti[j] = 0; }
            for (int i = 0; i < 128; ++i) {
                float xv = sc[i]; int xi = i;
                if (xv > ts[15]) {
#pragma unroll
                    for (int j = 0; j < 16; ++j) {
                        if (xv > ts[j]) { const float tv = ts[j]; const int tj = ti[j]; ts[j] = xv; ti[j] = xi; xv = tv; xi = tj; }
                    }
                }
            }
            float* TS = scr + N * SO_TS + it * 16;
            int* TI = (int*)(scr + N * SO_TI) + it * 16;
#pragma unroll
            for (int j = 0; j < 16; ++j) { TS[j] = ts[j]; TI[j] = ti[j]; }
        } break;
        case ST_TOPK2: {
            const float* s0 = scr + N * SO_TS + it * 32;
            const float* s1 = s0 + 16;
            const int* i0 = (const int*)(scr + N * SO_TI) + it * 32;
            const int* i1 = i0 + 16;
            float ts[16]; int ti[16];
#pragma unroll
            for (int j = 0; j < 16; ++j) { ts[j] = -3.0e38f; ti[j] = 0; }
            for (int a = 0; a < 16; ++a) {
                const int jmax = 16 / (a + 1);
                for (int b = 0; b < jmax; ++b) {
                    float xv = s0[a] + s1[b]; int xi = i0[a] * 128 + i1[b];
                    if (xv > ts[15]) {
#pragma unroll
                        for (int j = 0; j < 16; ++j) {
                            if (xv > ts[j]) { const float tv = ts[j]; const int tj = ti[j]; ts[j] = xv; ti[j] = xi; xv = tv; xi = tj; }
                        }
                    }
                }
            }
            const float mx = ts[0];
            float den = 0.f;
#pragma unroll
            for (int j = 0; j < 16; ++j) { ts[j] = expf(ts[j] - mx); den += ts[j]; }
            const float inv = 1.0f / den;
#pragma unroll
            for (int j = 0; j < 16; ++j) { P.gate[it * 16 + j] = ts[j] * inv; P.idx[it * 16 + j] = ti[j]; }
        } break;
        case ST_PEER_U: {
            const long n = it / 128;
            const int e = P.idx[it];
            const float* u = P.peer_u + ((long)l * NEXP + e) * DM;
            const bf16_t* hx = P.hb + n * DM;
            float s = 0.f;
            for (int d = 0; d < DM; ++d) s += bf2f(hx[d]) * u[d];
            P.act[it] = geluf_(s) * P.gate[it];
        } break;
        case ST_PEER_V: {
            const long n = it / DM; const int d = (int)(it % DM);
            const float* a = P.act + n * 128;
            const int* ix = P.idx + n * 128;
            float s = 0.f;
            for (int j = 0; j < 128; ++j) s += a[j] * P.peer_v[((long)l * NEXP + ix[j]) * DM + d];
            P.xcur[it] += s;
        } break;
    }
}


struct WsMap {
    size_t ctl, w1t, w2t, wsct, auxwt, lruwt, vreswt, pp, tabu, tabv, tsc, ssq, dpart, xn, hb, mix16, p16, sc, aux, vfirst, idx, gate, rstd, act, end;
    size_t auxA, zrkv, xc, auxo, gates, vres, glao, gdno, gq, gk, gv, gsc, rwy, rwbv, lrs, gblob, glas, gladv;
    size_t scr, qf;
};
HD WsMap ws_map(size_t N) {
    WsMap m{};
    size_t o = 0;
    auto take = [&](size_t bytes) { size_t r = o; o += (bytes + 4095) & ~(size_t)4095; return r; };
    m.ctl = take(1u << 20);
    m.w1t = take((size_t)NL * PLD * DM * 2);
    m.w2t = take((size_t)NL * DM * DM * 2);
    m.wsct = take((size_t)NL * DM * DM * 2);
    m.auxwt = take((size_t)NL * 1792 * 384 * 2);
    m.lruwt = take((size_t)NL * 1024 * 512 * 2);
    m.vreswt = take((size_t)512 * 512 * 2);
    m.pp = take(1u << 20);
    m.xn = take(N * DM * 2);
    m.hb = take(N * DM * 2);
    m.mix16 = take(N * DM * 2);
    m.p16 = take(N * PLD * 2);
    m.sc = m.p16;
    m.vfirst = take(N * 512 * 4);
    m.idx = take(N * 128 * 4);
    m.gate = take(N * 128 * 4);
    m.act = take(N * 128 * 4);
    m.rstd = take(N * 4);
    m.tabu = take((size_t)NL * 2 * NEXP * 1024);
    m.tabv = m.tabu + (size_t)NEXP * 1024;
    m.ssq = take(N * 8 * 4);
    m.dpart = m.p16;
    m.tsc = take((size_t)NL * 2 * NEXP * 4);
    m.aux = take(N * 5888 * 4);
    m.end = o;
    size_t a = m.aux;
    auto sub = [&](size_t bytes) { size_t r = a; a += (bytes + 4095) & ~(size_t)4095; return r; };
    m.auxA = sub(N * 384 * 2); m.zrkv = sub(N * 1536 * 2); m.xc = sub(N * 512 * 2); m.auxo = sub(N * 1792 * 2);
    m.gates = sub(N * 1024 * 2); m.vres = sub(N * 512 * 2); m.glao = sub(N * 512 * 2); m.gdno = sub(N * 512 * 2);
    m.gq = sub(N * 512 * 2); m.gk = sub(N * 512 * 2); m.gv = sub(N * 512 * 2); m.gsc = sub(N * 8 * 4); m.rwy = sub(N * 512 * 2); m.rwbv = sub(N * 512 * 2); m.lrs = sub(N / 64 * 512 * 2 * 4);
    m.gblob = sub(N / 64 * 4 * 26880);
    m.glas = sub(N / 64 * 4 * 8192 * 2); m.gladv = sub(N / 64 * 4 * 64 * 4);
    m.scr = m.tabu;
    m.qf = m.aux + N * 3584 * 4;
    return m;
}
static inline void bind_ws(Params& P, char* ws) {
    const WsMap m = ws_map((size_t)P.N);
    P.xn = (bf16_t*)(ws + m.xn); P.hb = (bf16_t*)(ws + m.hb); P.mix16 = (bf16_t*)(ws + m.mix16); P.p16 = (bf16_t*)(ws + m.p16);
    P.sc = (float*)(ws + m.sc); P.qf = (float*)(ws + m.qf); P.rstd = (float*)(ws + m.rstd); P.vfirst = (float*)(ws + m.vfirst);
    P.scr = (float*)(ws + m.scr); P.act = (float*)(ws + m.act); P.gate = (float*)(ws + m.gate); P.idx = (int*)(ws + m.idx);
}

struct Step { int st, l; };
static inline int build_schedule(Step* s) {
    int n = 0;
    s[n++] = {ST_COPYX, 0};
    for (int l = 0; l < NL; ++l) {
        static const int per_layer[] = {ST_RSTD, ST_NORM1, ST_GEMM1,
            ST_RW_A0, ST_RW_A1, ST_RW_A2, ST_RW_A3, ST_RW_KKN, ST_RW_SCAN, ST_RW_POST,
            ST_GLA_B0, ST_GLA_SCAN, ST_GLA_POST, ST_LRU_C0, ST_LRU_C1, ST_LRU_SCAN,
            ST_GDN_D0, ST_GDN_D1, ST_GDN_SCAN, ST_GDN_POST,
            ST_GEMM2, ST_RSTD2, ST_NORM2, ST_GEMM3, ST_SCORES, ST_TOPK1, ST_TOPK2, ST_PEER_U, ST_PEER_V};
        for (int i = 0; i < (int)(sizeof(per_layer) / sizeof(int)); ++i) s[n++] = {per_layer[i], l};
    }
    s[n++] = {ST_FRSTD, 0};
    s[n++] = {ST_FNORM, 0};
    return n;
}

static inline void fill_inputs(Params& P, void* const* d_in) {
    const float** dst = (const float**)&P;
    for (int i = 0; i < 38; ++i) dst[i] = (const float*)d_in[i];
}

#ifndef HOST_EMU
#define GAS __attribute__((address_space(1)))
#define LAS __attribute__((address_space(3)))
typedef unsigned v4u __attribute__((ext_vector_type(4)));
typedef unsigned v2u __attribute__((ext_vector_type(2)));
typedef float f32x4 __attribute__((ext_vector_type(4)));
typedef float f32x2 __attribute__((ext_vector_type(2)));
typedef short bf16x8 __attribute__((ext_vector_type(8)));
constexpr int NWAVES = 8, NTHR = 512;
constexpr int RING_BYTES = 131072, MISC_OFF = RING_BYTES + 320, LDS_BYTES = 147456;
constexpr int NTOK = 16384, TSEQ = 4096, NBATCH = 4;

__device__ __forceinline__ unsigned pk2(float lo, float hi) { return (unsigned)f2bf(lo) | ((unsigned)f2bf(hi) << 16); }
__device__ __forceinline__ float bflo(unsigned u) { return __builtin_bit_cast(float, u << 16); }
__device__ __forceinline__ float bfhi(unsigned u) { return __builtin_bit_cast(float, u & 0xffff0000u); }
__device__ __forceinline__ float wave_sum(float v) {
#pragma unroll
    for (int o = 1; o < 64; o <<= 1) v += __shfl_xor(v, o);
    return v;
}
#define LDS_WAIT() asm volatile("s_waitcnt lgkmcnt(0)" ::: "memory")
#define VM_WAIT() asm volatile("s_waitcnt vmcnt(0)" ::: "memory")

namespace pg8 {
#define PG8_LAS __attribute__((address_space(3)))
constexpr int BM = 256, BK = 64, HALF = 128, HTB = HALF * BK * 2, STAGE_BYTES = 8 * HTB, NXCD = 8, WGM = 8;
__host__ __device__ __forceinline__ int lds_byte(int r, int c) { const int st = (r >> 4) * 2 + (c >> 5), rr = r & 15, cc = c & 31, ob = rr * 64 + cc * 2; return st * 1024 + (ob ^ (((ob >> 9) & 1) << 5)); }
__host__ __device__ __forceinline__ void stage_rc(int b, int& R, int& C) { const int st = b / 1024, sb = b % 1024, swz = sb ^ (((sb >> 9) & 1) << 5); R = (st >> 1) * 16 + swz / 64; C = (st & 1) * 32 + (swz % 64) / 2; }
__host__ __device__ __forceinline__ int perm32(int rho) { const int n = rho >> 4, i = rho & 15; return 8 * (i >> 2) + 4 * n + (i & 3); }
struct Unit { int pm, pn; };
struct GemmX { const bf16_t* A; const bf16_t* Bt; int M, N, K, lda; };
struct StaticOrder {
    int nM, nN, nwg, G, c;
    __host__ __device__ void init(int M, int N, int G_, int c_) { nM = M / BM; nN = N / BM; nwg = nM * nN; G = G_; c = c_; }
    __host__ __device__ bool next(int i, Unit& u) const {
        const long L = (long)i * G + c; if (L >= nwg) return false;
        int wgid = (int)L; { const int q = nwg / NXCD, r = nwg % NXCD, xcd = wgid % NXCD, off = wgid / NXCD; wgid = (xcd < r ? xcd * (q + 1) : r * (q + 1) + (xcd - r) * q) + off; }
        const int nig = WGM * nN, gid = wgid / nig, fm = gid * WGM, gsz = (nM - fm) < WGM ? (nM - fm) : WGM;
        u.pm = fm + ((wgid % nig) % gsz); u.pn = (wgid % nig) / gsz; return true;
    }
    __device__ __forceinline__ void a_ready(const Unit&) const {}
    __device__ __forceinline__ void done(const Unit&) const {}
};
__device__ __forceinline__ unsigned cvt_pk_bf16(float lo, float hi) { unsigned r; asm volatile("v_cvt_pk_bf16_f32 %0, %1, %2" : "=v"(r) : "v"(lo), "v"(hi)); return r; }
template <bool ACCUM> struct EpiF32 {
    static constexpr bool PERM = false, AFTER_DRAIN = false;
    float* C; int ldc;
    __device__ __forceinline__ void operator()(const f32x4 (&acc)[2][2][4][2], const Unit& u, int wr, int wc, int fr, int fq) const {
        const int row0 = u.pm * BM + wr * 64 + fr, col0 = u.pn * BM + wc * 32 + 4 * fq;
#pragma unroll
        for (int ai = 0; ai < 2; ++ai)
#pragma unroll
            for (int m = 0; m < 4; ++m) { float* rowp = C + (size_t)(row0 + ai * HALF + m * 16) * ldc + col0;
#pragma unroll
                for (int bj = 0; bj < 2; ++bj)
#pragma unroll
                    for (int n = 0; n < 2; ++n) { f32x4* p = (f32x4*)(rowp + bj * HALF + n * 16);
                        if (ACCUM) *p = *p + acc[ai][bj][m][n]; else *p = acc[ai][bj][m][n]; } }
    }
};
struct EpiBf16 {
    static constexpr bool PERM = true, AFTER_DRAIN = false;
    bf16_t* O; int ldc; const float* bias; const float* ssq = nullptr;
    __device__ __forceinline__ void operator()(const f32x4 (&acc)[2][2][4][2], const Unit& u, int wr, int wc, int fr, int fq) const {
        const int row0 = u.pm * BM + wr * 64 + fr; const int col0 = u.pn * BM + wc * 32 + 8 * fq;
        float rs[2][4];
#pragma unroll
        for (int ai = 0; ai < 2; ++ai)
#pragma unroll
            for (int m = 0; m < 4; ++m) { rs[ai][m] = 1.0f;
                if (ssq) { const f32x4* sp = (const f32x4*)(ssq + (size_t)(row0 + ai * HALF + m * 16) * 8); const f32x4 s0 = sp[0], s1 = sp[1];
                    rs[ai][m] = 1.0f / sqrtf((((s0.x + s0.y) + (s0.z + s0.w)) + ((s1.x + s1.y) + (s1.z + s1.w))) * (1.0f / 2048.0f) + 1e-6f); } }
        f32x4 bv[2][2];
#pragma unroll
        for (int bj = 0; bj < 2; ++bj)
#pragma unroll
            for (int n = 0; n < 2; ++n) bv[bj][n] = bias ? *(const f32x4*)(bias + col0 + bj * HALF + 4 * n) : (f32x4){0.f, 0.f, 0.f, 0.f};
#pragma unroll
        for (int ai = 0; ai < 2; ++ai)
#pragma unroll
            for (int m = 0; m < 4; ++m) { bf16_t* rowp = O + (size_t)(row0 + ai * HALF + m * 16) * ldc + col0;
#pragma unroll
                for (int bj = 0; bj < 2; ++bj) { const f32x4 v0 = acc[ai][bj][m][0] * rs[ai][m] + bv[bj][0], v1 = acc[ai][bj][m][1] * rs[ai][m] + bv[bj][1];
                    v4u w; w.x = cvt_pk_bf16(v0[0], v0[1]); w.y = cvt_pk_bf16(v0[2], v0[3]); w.z = cvt_pk_bf16(v1[0], v1[1]); w.w = cvt_pk_bf16(v1[2], v1[3]);
                    *(v4u*)(rowp + bj * HALF) = w; } }
    }
};
template <class Epi, class Sched, bool ALIGN_EPI = false, bool SP2 = false>
__device__ __forceinline__ void gemm_phase(PG8_LAS unsigned char* lds, const GemmX g, const Sched& S, const Epi& E) {
    const int tid = threadIdx.x, wid = __builtin_amdgcn_readfirstlane(tid >> 6), lane = tid & 63, wr = wid >> 2, wc = wid & 3, fr = lane & 15, fq = lane >> 4;
    const int K = g.K, nt = K / BK;
    unsigned voffA[2], voffB[2];
#pragma unroll
    for (int i = 0; i < 2; ++i) { int R, C; stage_rc(tid * 16 + i * 8192, R, C); const int Rb = Epi::PERM ? ((R & ~31) + perm32(R & 31)) : R;
        voffA[i] = (unsigned)(R * g.lda + C) * 2u; voffB[i] = (unsigned)(Rb * K + C) * 2u; }
    const size_t kstep = (size_t)(BK * 2);
    const size_t hstep = (size_t)HALF * K * 2;
    const size_t tstep = 2 * hstep;
    const size_t hstepA = (size_t)HALF * g.lda * 2, tstepA = 2 * hstepA;
    const unsigned ldsw = (unsigned)wid * 1024u;
    const int aoff = lds_byte(wr * 64 + fr, fq * 8), boff = lds_byte(wc * 32 + fr, fq * 8);
#define PG8_SA(b, h) (((b) * 2 + (h)) * HTB)
#define PG8_SB(b, h) ((4 + (b) * 2 + (h)) * HTB)
#define PG8_STAGE(bufoff, gbase, voff) do { _Pragma("unroll") for (int _i = 0; _i < 2; ++_i) \
        __builtin_amdgcn_global_load_lds((const unsigned*)((const char*)(gbase) + (voff)[_i]), (PG8_LAS unsigned*)(lds + (bufoff) + ldsw + _i * 8192), 16, 0, 0); } while (0)
#define PG8_LDA(dst, b, h) do { _Pragma("unroll") for (int m = 0; m < 4; ++m) _Pragma("unroll") for (int k = 0; k < 2; ++k) dst[m][k] = *(const PG8_LAS bf16x8*)(lds + PG8_SA(b, h) + aoff + m * 2048 + k * 1024); } while (0)
#define PG8_LDB(dst, b, h) do { _Pragma("unroll") for (int n = 0; n < 2; ++n) _Pragma("unroll") for (int k = 0; k < 2; ++k) dst[n][k] = *(const PG8_LAS bf16x8*)(lds + PG8_SB(b, h) + boff + n * 2048 + k * 1024); } while (0)
#define PG8_MMA(ai, bj, At, Bt) do { __builtin_amdgcn_s_setprio(1); _Pragma("unroll") for (int m = 0; m < 4; ++m) _Pragma("unroll") for (int n = 0; n < 2; ++n) _Pragma("unroll") for (int k = 0; k < 2; ++k) \
        acc[ai][bj][m][n] = __builtin_amdgcn_mfma_f32_16x16x32_bf16(Bt[n][k], At[m][k], acc[ai][bj][m][n], 0, 0, 0); __builtin_amdgcn_s_setprio(0); } while (0)
#define PG8_WAIT_V(n) asm volatile("s_waitcnt vmcnt(" #n ")" ::: "memory")
#define PG8_WAIT_L(n) asm volatile("s_waitcnt lgkmcnt(" #n ")" ::: "memory")
#define PG8_BAR __builtin_amdgcn_s_barrier()
#define PG8_SCHED __builtin_amdgcn_sched_barrier(0)
    Unit cur, nxt; int ui = 0;
    if (!S.next(0, cur)) return;
    f32x4 acc[2][2][4][2];
#pragma unroll
    for (int a = 0; a < 2; ++a)
#pragma unroll
        for (int b = 0; b < 2; ++b)
#pragma unroll
            for (int m = 0; m < 4; ++m)
#pragma unroll
                for (int n = 0; n < 2; ++n) acc[a][b][m][n] = (f32x4){0.f, 0.f, 0.f, 0.f};
    bf16x8 At[4][2], B0[2][2], B1[2][2];
    const char* cA = (const char*)g.A + (size_t)cur.pm * tstepA; const char* cB = (const char*)g.Bt + (size_t)cur.pn * tstep;
    S.a_ready(cur);
    if constexpr (SP2) {
        PG8_STAGE(PG8_SB(0, 0), cB, voffB); PG8_STAGE(PG8_SB(0, 1), cB + hstep, voffB); PG8_STAGE(PG8_SA(0, 0), cA, voffA); PG8_STAGE(PG8_SA(0, 1), cA + hstepA, voffA);
        if (wr == 1) PG8_BAR;
        PG8_WAIT_V(2); PG8_BAR;
        PG8_STAGE(PG8_SB(1, 0), cB + kstep, voffB); PG8_STAGE(PG8_SA(1, 0), cA + kstep, voffA); PG8_STAGE(PG8_SB(1, 1), cB + hstep + kstep, voffB);
        PG8_WAIT_V(6); PG8_BAR;
    } else {
        PG8_STAGE(PG8_SB(0, 0), cB, voffB); PG8_STAGE(PG8_SA(0, 0), cA, voffA); PG8_STAGE(PG8_SB(0, 1), cB + hstep, voffB); PG8_STAGE(PG8_SA(0, 1), cA + hstepA, voffA);
        if (wr == 1) PG8_BAR;
        PG8_WAIT_V(4); PG8_BAR;
        PG8_STAGE(PG8_SB(1, 0), cB + kstep, voffB); PG8_STAGE(PG8_SA(1, 0), cA + kstep, voffA); PG8_STAGE(PG8_SB(1, 1), cB + hstep + kstep, voffB);
        PG8_WAIT_V(6); PG8_BAR;
    }
    for (;;) {
        const bool has_next = S.next(ui + 1, nxt);
        const char* nA = has_next ? (const char*)g.A + (size_t)nxt.pm * tstepA : cA; const char* nB = has_next ? (const char*)g.Bt + (size_t)nxt.pn * tstep : cB;
        for (int t = 0; t < nt; t += 2) {
            const bool last = (t == nt - 2);
            const char* a1 = cA + (size_t)(t + 1) * kstep;
            const char* a2 = last ? nA : cA + (size_t)(t + 2) * kstep; const char* b2 = last ? nB : cB + (size_t)(t + 2) * kstep;
            const char* a3 = a2 + kstep; const char* b3 = b2 + kstep;
            if (last && has_next) S.a_ready(nxt);
            if constexpr (SP2) {
            PG8_LDB(B0, 0, 0); PG8_LDB(B1, 0, 1); PG8_SCHED; PG8_LDA(At, 0, 0); PG8_STAGE(PG8_SA(1, 1), a1 + hstepA, voffA);
            PG8_WAIT_V(8); PG8_WAIT_L(0); PG8_BAR; PG8_MMA(0, 0, At, B0); PG8_MMA(0, 1, At, B1); PG8_BAR; PG8_SCHED;
            PG8_LDA(At, 0, 1); PG8_STAGE(PG8_SB(0, 0), b2, voffB); PG8_STAGE(PG8_SB(0, 1), b2 + hstep, voffB); PG8_STAGE(PG8_SA(0, 0), a2, voffA);
            PG8_WAIT_V(8); PG8_WAIT_L(0); PG8_BAR; PG8_MMA(1, 0, At, B0); PG8_MMA(1, 1, At, B1); PG8_BAR; PG8_SCHED;
            PG8_LDB(B0, 1, 0); PG8_LDB(B1, 1, 1); PG8_SCHED; PG8_LDA(At, 1, 0); PG8_STAGE(PG8_SA(0, 1), a2 + hstepA, voffA);
            PG8_WAIT_V(8); PG8_WAIT_L(0); PG8_BAR; PG8_MMA(0, 0, At, B0); PG8_MMA(0, 1, At, B1); PG8_BAR; PG8_SCHED;
            PG8_LDA(At, 1, 1); PG8_STAGE(PG8_SB(1, 0), b3, voffB); PG8_STAGE(PG8_SB(1, 1), b3 + hstep, voffB); PG8_STAGE(PG8_SA(1, 0), a3, voffA);
            PG8_WAIT_V(8); PG8_WAIT_L(0); PG8_BAR; PG8_MMA(1, 0, At, B0); PG8_MMA(1, 1, At, B1); PG8_BAR; PG8_SCHED;
            } else {
            PG8_LDB(B0, 0, 0); PG8_SCHED; PG8_LDA(At, 0, 0); PG8_STAGE(PG8_SA(1, 1), a1 + hstepA, voffA);
            PG8_WAIT_L(8); PG8_BAR; PG8_WAIT_L(0); PG8_MMA(0, 0, At, B0); PG8_BAR; PG8_SCHED;
            PG8_LDB(B1, 0, 1); PG8_STAGE(PG8_SB(0, 0), b2, voffB);
            PG8_BAR; PG8_WAIT_L(0); PG8_MMA(0, 1, At, B1); PG8_BAR;
            PG8_LDA(At, 0, 1); PG8_STAGE(PG8_SA(0, 0), a2, voffA);
            PG8_BAR; PG8_WAIT_L(0); PG8_MMA(1, 0, At, B0); PG8_BAR; PG8_SCHED;
            PG8_STAGE(PG8_SB(0, 1), b2 + hstep, voffB);
            PG8_WAIT_V(6); PG8_BAR; PG8_MMA(1, 1, At, B1); PG8_BAR;
            PG8_LDB(B0, 1, 0); PG8_SCHED; PG8_LDA(At, 1, 0); PG8_STAGE(PG8_SA(0, 1), a2 + hstepA, voffA);
            PG8_WAIT_L(8); PG8_BAR; PG8_WAIT_L(0); PG8_MMA(0, 0, At, B0); PG8_BAR; PG8_SCHED;
            PG8_LDB(B1, 1, 1); PG8_STAGE(PG8_SB(1, 0), b3, voffB);
            PG8_BAR; PG8_WAIT_L(0); PG8_MMA(0, 1, At, B1); PG8_BAR;
            PG8_LDA(At, 1, 1); PG8_STAGE(PG8_SA(1, 0), a3, voffA);
            PG8_BAR; PG8_WAIT_L(0); PG8_MMA(1, 0, At, B0); PG8_BAR; PG8_SCHED;
            PG8_STAGE(PG8_SB(1, 1), b3 + hstep, voffB);
            PG8_WAIT_V(6); PG8_BAR; PG8_MMA(1, 1, At, B1); PG8_BAR;
            }
        }
        if constexpr (ALIGN_EPI) { if (wr == 0) PG8_BAR; }
        if constexpr (!Epi::AFTER_DRAIN) { E(acc, cur, wr, wc, fr, fq); S.done(cur); }
        if (!has_next) break;
#pragma unroll
        for (int a = 0; a < 2; ++a)
#pragma unroll
            for (int b = 0; b < 2; ++b)
#pragma unroll
                for (int m = 0; m < 4; ++m)
#pragma unroll
                    for (int n = 0; n < 2; ++n) acc[a][b][m][n] = (f32x4){0.f, 0.f, 0.f, 0.f};
        cur = nxt; cA = nA; cB = nB; ++ui;
        if constexpr (ALIGN_EPI) { if (wr == 1) PG8_BAR; }
    }
    PG8_WAIT_V(0);
    if constexpr (!ALIGN_EPI) { if (wr == 0) PG8_BAR; }
    PG8_BAR;
    if constexpr (Epi::AFTER_DRAIN) { E.fused(acc, cur, wr, wc, fr, fq, lds, wid, lane); S.done(cur); }
#undef PG8_SA
#undef PG8_SB
#undef PG8_STAGE
#undef PG8_LDA
#undef PG8_LDB
#undef PG8_MMA
#undef PG8_WAIT_V
#undef PG8_WAIT_L
#undef PG8_BAR
#undef PG8_SCHED
}
}

#define XB_TMO      128
#define XB_XCNT(j)  (256  + 64 * (j))
#define XB_XSUB(j)  (1280 + 64 * (j))
#define XB_XGEN(j)  (2304 + 64 * (j))
#define XB_TOP      3328
#define XB_TOPGEN   3392
#define XCD_BAR_WORDS 3456
#define XB_SPIN_CAP (1u << 20)
__device__ __forceinline__ unsigned xb_ld(unsigned* p) { return __hip_atomic_load(p, __ATOMIC_RELAXED, __HIP_MEMORY_SCOPE_AGENT); }
__device__ __forceinline__ unsigned xb_add(unsigned* p, unsigned v) { return __hip_atomic_fetch_add(p, v, __ATOMIC_RELAXED, __HIP_MEMORY_SCOPE_AGENT); }
__device__ __forceinline__ unsigned xb_xcc_id() { return (unsigned)__builtin_amdgcn_s_getreg((3 << 11) | 20) & 0xFu; }
#define XB_SPIN(cond, bar) do { unsigned _sp = 0; while (cond) { __builtin_amdgcn_s_sleep(1); \
    if ((++_sp & 255u) == 0u) { if (xb_ld(&(bar)[XB_TMO])) break; if (_sp > XB_SPIN_CAP) { atomicAdd(&(bar)[XB_TMO], 1u); break; } } } } while (0)
struct XcdBarrier { unsigned* bar; unsigned x; volatile LAS unsigned* st; };
__device__ __forceinline__ XcdBarrier xcd_barrier_post(unsigned* bar, volatile LAS unsigned* st) {
    XcdBarrier b; b.bar = bar; b.x = xb_xcc_id(); b.st = st;
    if (threadIdx.x == 0) (void)xb_add(&bar[XB_XCNT(b.x)], 1u);
    return b;
}
__device__ __forceinline__ void xcd_barrier_complete(unsigned* bar, unsigned x, unsigned& nloc, unsigned& nx) {
    const unsigned G = gridDim.x * gridDim.y * gridDim.z;
    unsigned sum, cnt, mine, sp = 0u;
    for (;;) {
        sum = 0u; cnt = 0u; mine = 0u;
#pragma unroll
        for (unsigned j = 0; j < 16; ++j) { const unsigned c = xb_ld(&bar[XB_XCNT(j)]); sum += c; cnt += (c > 0u) ? 1u : 0u; mine = (j == x) ? c : mine; }
        if (sum == G) break;
        __builtin_amdgcn_s_sleep(1);
        if ((++sp & 255u) == 0u) { if (xb_ld(&bar[XB_TMO])) break; if (sp > XB_SPIN_CAP) { atomicAdd(&bar[XB_TMO], 1u); break; } }
    }
    nloc = mine > 0u ? mine : 1u; nx = cnt > 0u ? cnt : 1u;
}
__device__ __forceinline__ void xcd_barrier(const XcdBarrier& b) {
    asm volatile("s_waitcnt vmcnt(0)" ::: "memory");
    __syncthreads();
    if (threadIdx.x == 0) {
        unsigned* bar = b.bar;
        __builtin_amdgcn_s_waitcnt(0);
        unsigned nloc = b.st[0], nx = b.st[1];
        if (nloc == 0u) { xcd_barrier_complete(bar, b.x, nloc, nx); b.st[0] = nloc; b.st[1] = nx; }
        const unsigned old = xb_add(&bar[XB_XSUB(b.x)], 1u);
        const unsigned gen = old / nloc;
        if (old + 1u == (gen + 1u) * nloc) {
            __builtin_amdgcn_fence(__ATOMIC_RELEASE, "agent");
            asm volatile("s_waitcnt vmcnt(0)" ::: "memory");
            const unsigned og = xb_add(&bar[XB_TOP], 1u);
            const unsigned tg = og / nx;
            if (og + 1u == (tg + 1u) * nx) xb_add(&bar[XB_TOPGEN], 1u);
            else XB_SPIN(xb_ld(&bar[XB_TOPGEN]) == tg, bar);
            __builtin_amdgcn_fence(__ATOMIC_ACQUIRE, "agent");
            xb_add(&bar[XB_XGEN(b.x)], 1u);
            asm volatile("s_waitcnt vmcnt(0)" ::: "memory");
        } else {
            XB_SPIN(xb_ld(&bar[XB_XGEN(b.x)]) == gen, bar);
            __builtin_amdgcn_fence(__ATOMIC_ACQUIRE, "agent");
            asm volatile("s_waitcnt vmcnt(0)" ::: "memory");
        }
    }
    __syncthreads();
}

struct Args { const float* in[38]; float* out; unsigned char* ws; int ph_lo, ph_hi, li, pad; };
enum InputId { I_X = 0, I_NORM_MIX, I_W_IN, I_W_OUT, I_RW_MU, I_RW_W0, I_RW_W_UP, I_RW_A0, I_RW_A_UP, I_RW_G_UP, I_RW_K_K, I_RW_K_A, I_RW_R_K,
    I_RW_LN_W, I_RW_LN_B, I_RW_V0, I_RW_V_DOWN, I_RW_V_UP, I_GLA_A_UP, I_GLA_A_BIAS, I_GLA_NORM, I_LRU_CONV_W, I_LRU_CONV_B, I_LRU_W_R,
    I_LRU_B_R, I_LRU_W_I, I_LRU_B_I, I_LRU_LAM, I_GDN_CONV_W, I_GDN_A_LOG, I_GDN_DT_BIAS, I_GDN_NORM, I_NORM_FFN, I_PEER_WQ, I_PEER_SK,
    I_PEER_U, I_PEER_V, I_NORM_FINAL };
enum { PH_P0 = 0, PH_GEMM1 = 1, PH_PREP = 2, PH_AUX = 3, PH_SCAN = 4, PH_POST = 5, PH_GEMM2 = 6, PH_NORM2 = 7, PH_GEMM3 = 8, PH_TOPK = 9, PH_PEERU = 10, PH_PEERC = 11, PH_PEERV = 12, PH_PER_LAYER = 12, PH_FNORM = 25, PH_TOTAL = 26 };

struct Frame {
    LAS unsigned char* lds;
    int tid, lane, wave, vcu, G;
    int gw, ngw;
};

__device__ __forceinline__ void p0_transpose_item(const float* W, int K, int N, const float* kscale, bf16_t* WT, LAS float* scr, int item, int nblk, int lane) {
    const int kb = item / nblk, nb = item % nblk, k0 = 64 * kb, n0 = 32 * nb;
    const int kr = lane >> 3, n4 = (lane & 7) * 4;
    f32x4 v[8];
#pragma unroll
    for (int i = 0; i < 8; ++i) { const int kk = kr + 8 * i;
        v[i] = (n0 + n4 < N) ? *(const f32x4*)(W + (size_t)(k0 + kk) * N + n0 + n4) : (f32x4){0.f, 0.f, 0.f, 0.f}; }
#pragma unroll
    for (int i = 0; i < 8; ++i) { const int kk = kr + 8 * i; const float s = kscale ? kscale[k0 + kk] : 1.0f;
        scr[kk * 33 + n4 + 0] = v[i].x * s; scr[kk * 33 + n4 + 1] = v[i].y * s; scr[kk * 33 + n4 + 2] = v[i].z * s; scr[kk * 33 + n4 + 3] = v[i].w * s; }
    LDS_WAIT(); asm volatile("" ::: "memory");
    const int c = lane & 7;
#pragma unroll
    for (int j = 0; j < 4; ++j) { const int n = (lane >> 3) + 8 * j; const LAS float* s = scr + (8 * c) * 33 + n;
        v4u o; o.x = pk2(s[0 * 33], s[1 * 33]); o.y = pk2(s[2 * 33], s[3 * 33]); o.z = pk2(s[4 * 33], s[5 * 33]); o.w = pk2(s[6 * 33], s[7 * 33]);
        *(v4u*)(WT + (size_t)(n0 + n) * K + k0 + 8 * c) = o; }
    LDS_WAIT(); asm volatile("" ::: "memory");
}

__device__ __forceinline__ void p0_prologue(const Args& a, Frame& F) {
    const WsMap m = ws_map(NTOK);
    unsigned char* ws = a.ws;
    LAS float* scr = (LAS float*)(F.lds + F.wave * 16384);
    const int gw = F.gw, NGW = F.ngw, lane = F.lane;
    for (int n = gw; n < NTOK; n += NGW) {
        const f32x4* xr = (const f32x4*)(a.in[I_X] + (size_t)n * DM) + lane;
        f32x4 v[8]; float s = 0.f;
#pragma unroll
        for (int j = 0; j < 8; ++j) { v[j] = xr[64 * j]; s += (v[j].x * v[j].x + v[j].y * v[j].y) + (v[j].z * v[j].z + v[j].w * v[j].w); }
        const float rstd = 1.0f / sqrtf(wave_sum(s) * (1.0f / DM) + 1e-6f);
        f32x4* xo = (f32x4*)(a.out + (size_t)n * DM) + lane;
        v2u* o8 = (v2u*)((bf16_t*)(ws + m.xn) + (size_t)n * DM) + lane;
#pragma unroll
        for (int j = 0; j < 8; ++j) { xo[64 * j] = v[j]; v2u w; w.x = pk2(v[j].x * rstd, v[j].y * rstd); w.y = pk2(v[j].z * rstd, v[j].w * rstd); o8[64 * j] = w; }
    }
    {
        constexpr int I1 = (DM / 64) * (PLD / 32), I2 = (DM / 64) * (DM / 32);
        for (int it = gw; it < NL * (I1 + I2); it += NGW) {
            const int l = it / (I1 + I2); int r = it % (I1 + I2);
            if (r < I1) p0_transpose_item(a.in[I_W_IN] + (size_t)l * DM * INC, DM, INC, a.in[I_NORM_MIX] + l * DM, (bf16_t*)(ws + m.w1t) + (size_t)l * PLD * DM, scr, r, PLD / 32, lane);
            else p0_transpose_item(a.in[I_W_OUT] + (size_t)l * DM * DM, DM, DM, nullptr, (bf16_t*)(ws + m.w2t) + (size_t)l * DM * DM, scr, r - I1, DM / 32, lane);
        }
    }
    for (int it = gw; it < NL * 16 * 64; it += NGW) {
        const int l = it / 1024, hp = (it % 1024) / 64, kb = it % 64;
        const int dh = lane & 1, kk = kb * 32 + (lane >> 1);
        const float* wq = a.in[I_PEER_WQ] + (size_t)l * DM * DM + (size_t)kk * DM + hp * 128 + dh * 64;
        const float* sk = a.in[I_PEER_SK] + ((size_t)l * 16 + hp) * 128 * 128;
        f32x4 q[16];
#pragma unroll
        for (int d = 0; d < 16; ++d) q[d] = *(const f32x4*)(wq + 4 * d);
        bf16_t* o = (bf16_t*)(ws + m.wsct) + (size_t)l * DM * DM + (size_t)(hp * 128) * DM + kk;
        f32x4 stg[8];
#pragma unroll
        for (int i = 0; i < 8; ++i) stg[i] = ((const f32x4*)sk)[i * 64 + lane];
#pragma unroll 1
        for (int kc = 0; kc < 8; ++kc) {
#pragma unroll
            for (int i = 0; i < 8; ++i) ((LAS f32x4*)scr)[i * 64 + lane] = stg[i];
            if (kc + 1 < 8) {
#pragma unroll
                for (int i = 0; i < 8; ++i) stg[i] = ((const f32x4*)(sk + (kc + 1) * 2048))[i * 64 + lane]; }
            LDS_WAIT(); asm volatile("" ::: "memory");
#pragma unroll 2
            for (int key = 0; key < 16; ++key) {
                const LAS f32x4* s4 = (const LAS f32x4*)(scr + key * 128 + dh * 64);
                float acc = 0.f;
#pragma unroll
                for (int d = 0; d < 16; ++d) { const f32x4 sv = s4[d]; acc += (q[d].x * sv.x + q[d].y * sv.y) + (q[d].z * sv.z + q[d].w * sv.w); }
                acc += __shfl_xor(acc, 1);
                if (dh == 0) o[(size_t)(kc * 16 + key) * DM] = f2bf(acc);
            }
            LDS_WAIT(); asm volatile("" ::: "memory");
        }
    }
    {
        const int gt = F.vcu * NTHR + F.tid, GT = F.G * NTHR;
        bf16_t* AW = (bf16_t*)(ws + m.auxwt); bf16_t* LW = (bf16_t*)(ws + m.lruwt); bf16_t* VW = (bf16_t*)(ws + m.vreswt); float* PP = (float*)(ws + m.pp);
        for (int it = gt; it < NL * 1792 * 384; it += GT) {
            const int l = it / (1792 * 384), r = it % (1792 * 384), n = r / 384, k = r % 384;
            float v = 0.f;
            if (n < 512) { if (k < 64) v = a.in[I_RW_W_UP][(size_t)l * 64 * 512 + k * 512 + n]; }
            else if (n < 1024) { if (k >= 64 && k < 128) v = a.in[I_RW_A_UP][(size_t)l * 64 * 512 + (k - 64) * 512 + (n - 512)]; }
            else if (n < 1536) { if (k >= 128 && k < 256) v = a.in[I_RW_G_UP][(size_t)l * 128 * 512 + (k - 128) * 512 + (n - 1024)]; }
            else { if (k >= 256 && k < 272) v = a.in[I_GLA_A_UP][(size_t)l * 16 * 256 + (k - 256) * 256 + (n - 1536)]; }
            AW[it] = f2bf(v);
        }
        for (int it = gt; it < NL * 1024 * 512; it += GT) {
            const int l = it / (1024 * 512), r = it % (1024 * 512), n = r / 512, k = r % 512;
            const int nn = n & 511, blk = nn >> 6, j = nn & 63;
            float v = 0.f;
            if ((k >> 6) == blk) v = (n < 512 ? a.in[I_LRU_W_R] : a.in[I_LRU_W_I])[(size_t)l * 8 * 64 * 64 + (size_t)blk * 4096 + (k & 63) * 64 + j];
            LW[it] = f2bf(v);
        }
        for (int it = gt; it < 512 * 512; it += GT) {
            const int n = it / 512, k = it % 512;
            float s = 0.f;
            for (int i = 0; i < 32; ++i) s += a.in[I_RW_V_DOWN][k * 32 + i] * a.in[I_RW_V_UP][i * 512 + n];
            VW[it] = f2bf(s);
        }
        for (int it = gt; it < 6144; it += GT) {
            float v = 0.f;
            if (it < 3584) { const int l = it / 1792, c = it % 1792;
                v = c < 512 ? a.in[I_RW_W0][l * 512 + c] : (c < 1024 ? a.in[I_RW_A0][l * 512 + c - 512] : (c < 1536 ? 0.f : a.in[I_GLA_A_BIAS][l * 256 + c - 1536])); }
            else if (it < 5632) { const int l = (it - 3584) / 1024, c = (it - 3584) % 1024; v = c < 512 ? a.in[I_LRU_B_R][l * 512 + c] : a.in[I_LRU_B_I][l * 512 + c - 512]; }
            else v = a.in[I_RW_V0][it - 5632];
            PP[it] = v;
        }
    }
}

__device__ __forceinline__ unsigned pk4_fp8(float a, float b, float c, float d) {
    int w = 0;
    w = __builtin_amdgcn_cvt_pk_fp8_f32(__builtin_fmaxf(__builtin_fminf(a, 448.f), -448.f), __builtin_fmaxf(__builtin_fminf(b, 448.f), -448.f), w, false);
    w = __builtin_amdgcn_cvt_pk_fp8_f32(__builtin_fmaxf(__builtin_fminf(c, 448.f), -448.f), __builtin_fmaxf(__builtin_fminf(d, 448.f), -448.f), w, true);
    return (unsigned)w;
}
constexpr size_t TSL = 128;
constexpr float TSTEP = 0.3352f;

template <int CTRL> __device__ __forceinline__ float dpp_f(float v) { return __builtin_bit_cast(float, __builtin_amdgcn_update_dpp(0, __builtin_bit_cast(int, v), CTRL, 0xF, 0xF, true)); }
__device__ __forceinline__ float rdlane_f(float v, int l) { return __builtin_bit_cast(float, __builtin_amdgcn_readlane(__builtin_bit_cast(int, v), l)); }
__device__ __forceinline__ float row16_sum(float v) {
    v += dpp_f<0xB1>(v); v += dpp_f<0x4E>(v); v += dpp_f<0x141>(v); v += dpp_f<0x140>(v); return v;
}
__device__ __forceinline__ float wave_sum_u(float v) {
    v = row16_sum(v);
    return (rdlane_f(v, 0) + rdlane_f(v, 16)) + (rdlane_f(v, 32) + rdlane_f(v, 48));
}
typedef __bf16 bf16x2_t __attribute__((ext_vector_type(2)));
__device__ __forceinline__ float dot2bf(unsigned w, unsigned x, float acc) { return __builtin_amdgcn_fdot2_f32_bf16(__builtin_bit_cast(bf16x2_t, w), __builtin_bit_cast(bf16x2_t, x), acc, false); }
__device__ __forceinline__ void tables_range(const Args& a, Frame& F, size_t it0, size_t it1, int sub, int nsub) {
    const WsMap m = ws_map(NTOK);
    const size_t per = (size_t)NEXP * DM / 32;
    const size_t stride = (size_t)nsub * NTHR;
    float* tsc = (float*)(a.ws + m.tsc);
    for (size_t base = it0 + (size_t)sub * NTHR + F.tid; base < it1; base += 2 * stride) {
        f32x4 v[2][8];
#pragma unroll
        for (int u = 0; u < 2; ++u) { const size_t it = base + u * stride;
            if (it < it1) { const int tb = (int)(it / per); const size_t r = it % per;
                const f32x4* srcp = (const f32x4*)(((tb & 1) ? a.in[I_PEER_V] : a.in[I_PEER_U]) + (size_t)(tb >> 1) * NEXP * DM + r * 32);
#pragma unroll
                for (int q = 0; q < 8; ++q) v[u][q] = __builtin_nontemporal_load(srcp + q); } }
#pragma unroll
        for (int u = 0; u < 2; ++u) { const size_t it = base + u * stride;
            if (it < it1) { const int tb = (int)(it / per); const size_t r = it % per;
                float ss = 0.f;
#pragma unroll
                for (int q = 0; q < 8; ++q) ss += (v[u][q].x * v[u][q].x + v[u][q].y * v[u][q].y) + (v[u][q].z * v[u][q].z + v[u][q].w * v[u][q].w);
                const float rms = sqrtf(wave_sum_u(ss) * (1.0f / DM));
                float step = rms * TSTEP; const float inv = rms > 0.f ? 1.0f / step : 0.f;
                v4u w;
                if (tb & 1) {
                    const float sc = rms > 0.f ? 2.05f / rms : 0.f; step = rms * (1.0f / 2.05f);
#pragma unroll
                    for (int d = 0; d < 4; ++d) { unsigned p = 0;
                        p = __builtin_amdgcn_cvt_scalef32_pk_fp4_f32(p, __builtin_fmaxf(__builtin_fminf(v[u][2 * d].x * sc, 6.f), -6.f), __builtin_fmaxf(__builtin_fminf(v[u][2 * d].y * sc, 6.f), -6.f), 1.0f, 0);
                        p = __builtin_amdgcn_cvt_scalef32_pk_fp4_f32(p, __builtin_fmaxf(__builtin_fminf(v[u][2 * d].z * sc, 6.f), -6.f), __builtin_fmaxf(__builtin_fminf(v[u][2 * d].w * sc, 6.f), -6.f), 1.0f, 1);
                        p = __builtin_amdgcn_cvt_scalef32_pk_fp4_f32(p, __builtin_fmaxf(__builtin_fminf(v[u][2 * d + 1].x * sc, 6.f), -6.f), __builtin_fmaxf(__builtin_fminf(v[u][2 * d + 1].y * sc, 6.f), -6.f), 1.0f, 2);
                        p = __builtin_amdgcn_cvt_scalef32_pk_fp4_f32(p, __builtin_fmaxf(__builtin_fminf(v[u][2 * d + 1].z * sc, 6.f), -6.f), __builtin_fmaxf(__builtin_fminf(v[u][2 * d + 1].w * sc, 6.f), -6.f), 1.0f, 3);
                        w[d] = p; }
                } else
#pragma unroll
                for (int d = 0; d < 4; ++d) {
                    const f32x4 lo = v[u][2 * d], hi = v[u][2 * d + 1]; unsigned p = 0;
#pragma unroll
                    for (int b = 0; b < 4; ++b) {
                        const int cl = (int)__builtin_fminf(__builtin_fmaxf(__builtin_floorf(lo[b] * inv), -8.0f), 7.0f);
                        const int ch = (int)__builtin_fminf(__builtin_fmaxf(__builtin_floorf(hi[b] * inv), -8.0f), 7.0f);
                        p |= (((unsigned)cl & 15u) << (4 * b)) | (((unsigned)ch & 15u) << (16 + 4 * b)); }
                    w[d] = p; }
                *(v4u*)((unsigned char*)(a.ws + m.tabu) + (((size_t)tb * 8 + (r & 63) / 8) * NEXP + (r >> 6)) * TSL + (r & 7) * 16) = w;
                if (F.lane == 0) tsc[(size_t)tb * NEXP + (r >> 6)] = step; } }
    }
}

__device__ __forceinline__ float gelu_fast(float x) {
    const float u = 1.5957691216057308f * (x + 0.044715f * x * x * x);
    return x / (1.0f + __expf(-u));
}


__device__ __forceinline__ float sigm(float x) { return 1.0f / (1.0f + __expf(-x)); }
__device__ __forceinline__ float softplus_f(float x) { return __logf(1.0f + __expf(-fabsf(x))) + fmaxf(x, 0.0f); }
__device__ __forceinline__ float tanh_f(float x) { return 1.0f - 2.0f / (1.0f + __expf(2.0f * x)); }
__device__ __forceinline__ float red8(float v) { v += dpp_f<0xB1>(v); v += dpp_f<0x4E>(v); v += dpp_f<0x141>(v); return v; }
__device__ __forceinline__ v4u ld8(const bf16_t* p) { return *(const v4u*)p; }
__device__ __forceinline__ void unpack8(const v4u w, float (&f)[8]) { f[0] = bflo(w.x); f[1] = bfhi(w.x); f[2] = bflo(w.y); f[3] = bfhi(w.y); f[4] = bflo(w.z); f[5] = bfhi(w.z); f[6] = bflo(w.w); f[7] = bfhi(w.w); }
__device__ __forceinline__ v4u pack8(const float (&f)[8]) { v4u w; w.x = pk2(f[0], f[1]); w.y = pk2(f[2], f[3]); w.z = pk2(f[4], f[5]); w.w = pk2(f[6], f[7]); return w; }

__device__ __forceinline__ void prep_phase(const Args& a, Frame& F, int l) {
    const WsMap m = ws_map(NTOK);
    const bf16_t* p16 = (const bf16_t*)(a.ws + m.p16);
    bf16_t* zrkv = (bf16_t*)(a.ws + m.zrkv); bf16_t* auxA = (bf16_t*)(a.ws + m.auxA); bf16_t* xc = (bf16_t*)(a.ws + m.xc);
    const float* mu = a.in[I_RW_MU] + l * 1792;
#pragma unroll 4
    for (size_t it = (size_t)F.vcu * NTHR + F.tid; it < (size_t)NTOK * 224; it += (size_t)F.G * NTHR) {
        const int n = (int)(it / 224), j = (int)(it % 224), t = n % TSEQ;
        const int col = j * 8;
        float cur[8], prv[8], z[8];
        unpack8(ld8(p16 + (size_t)n * PLD + col), cur);
        unpack8(ld8(p16 + (size_t)(t > 0 ? n - 1 : n) * PLD + col), prv);
        const f32x4 m0 = *(const f32x4*)(mu + col), m1 = *(const f32x4*)(mu + col + 4);
        const float mm[8] = {m0.x, m0.y, m0.z, m0.w, m1.x, m1.y, m1.z, m1.w};
#pragma unroll
        for (int k = 0; k < 8; ++k) z[k] = cur[k] + ((t > 0 ? prv[k] : 0.f) - cur[k]) * mm[k];
        if (col < 1536) *(v4u*)(zrkv + (size_t)n * 1536 + col) = pack8(z);
        else {
            const int c = col - 1536;
#pragma unroll
            for (int k = 0; k < 8; ++k) z[k] = c < 64 ? tanh_f(z[k]) : (c < 128 ? z[k] : sigm(z[k]));
            *(v4u*)(auxA + (size_t)n * 384 + c) = pack8(z);
        }
    }
    for (size_t it = (size_t)F.vcu * NTHR + F.tid; it < (size_t)NTOK * 16; it += (size_t)F.G * NTHR) {
        const int n = (int)(it / 16), c = 256 + (int)(it % 16) * 8;
        v4u w = (v4u){0u, 0u, 0u, 0u};
        if (c < 272) w = ld8(p16 + (size_t)n * PLD + C_GLA + 1536 + (c - 256));
        *(v4u*)(auxA + (size_t)n * 384 + c) = w;
    }
#pragma unroll 2
    for (size_t it = (size_t)F.vcu * NTHR + F.tid; it < (size_t)NTOK * 64; it += (size_t)F.G * NTHR) {
        const int n = (int)(it / 64), c = (int)(it % 64) * 8, t = n % TSEQ;
        float acc[8];
        { const f32x4 b0 = *(const f32x4*)(a.in[I_LRU_CONV_B] + l * 512 + c), b1 = *(const f32x4*)(a.in[I_LRU_CONV_B] + l * 512 + c + 4);
          acc[0] = b0.x; acc[1] = b0.y; acc[2] = b0.z; acc[3] = b0.w; acc[4] = b1.x; acc[5] = b1.y; acc[6] = b1.z; acc[7] = b1.w; }
        v4u raw[4];
#pragma unroll
        for (int jj = 0; jj < 4; ++jj) raw[jj] = ld8(p16 + (size_t)(t - 3 + jj >= 0 ? n - 3 + jj : n) * PLD + C_LRU + c);
#pragma unroll
        for (int jj = 0; jj < 4; ++jj) {
            float xv[8]; unpack8(raw[jj], xv);
            const float ok = (t - 3 + jj >= 0) ? 1.0f : 0.0f;
            const float* cw = a.in[I_LRU_CONV_W] + (size_t)l * 4 * 512 + jj * 512 + c;
            const f32x4 w0 = *(const f32x4*)cw * ok, w1 = *(const f32x4*)(cw + 4) * ok;
            acc[0] += w0.x * xv[0]; acc[1] += w0.y * xv[1]; acc[2] += w0.z * xv[2]; acc[3] += w0.w * xv[3];
            acc[4] += w1.x * xv[4]; acc[5] += w1.y * xv[5]; acc[6] += w1.z * xv[6]; acc[7] += w1.w * xv[7];
        }
        *(v4u*)(xc + (size_t)n * 512 + c) = pack8(acc);
    }
    {
        bf16_t* gq = (bf16_t*)(a.ws + m.gq); bf16_t* gk = (bf16_t*)(a.ws + m.gk); bf16_t* gv = (bf16_t*)(a.ws + m.gv); float* gsc = (float*)(a.ws + m.gsc);
        const float* cw = a.in[I_GDN_CONV_W] + (size_t)l * 4 * 1536;
        const int lane = F.lane;
        for (int n = F.gw; n < NTOK; n += F.ngw) {
            const int t = n % TSEQ;
#pragma unroll
            for (int part = 0; part < 3; ++part) {
                const int cb = part * 512 + lane * 8;
                float acc[8];
#pragma unroll
                for (int k = 0; k < 8; ++k) acc[k] = 0.f;
#pragma unroll
                for (int jj = 0; jj < 4; ++jj) {
                    if (t - 3 + jj >= 0) {
                        float xv[8]; unpack8(ld8(p16 + (size_t)(n - 3 + jj) * PLD + C_GDN + cb), xv);
                        const f32x4 w0 = *(const f32x4*)(cw + jj * 1536 + cb), w1 = *(const f32x4*)(cw + jj * 1536 + cb + 4);
                        acc[0] += w0.x * xv[0]; acc[1] += w0.y * xv[1]; acc[2] += w0.z * xv[2]; acc[3] += w0.w * xv[3];
                        acc[4] += w1.x * xv[4]; acc[5] += w1.y * xv[5]; acc[6] += w1.z * xv[6]; acc[7] += w1.w * xv[7];
                    }
                }
                float ss = 0.f;
#pragma unroll
                for (int k = 0; k < 8; ++k) { acc[k] = acc[k] * sigm(acc[k]); ss += acc[k] * acc[k]; }
                if (part < 2) {
                    ss = row16_sum(ss);
                    const float inv = (1.0f / sqrtf(ss + 1e-6f)) * (part == 0 ? 0.08838834764831845f : 1.0f);
#pragma unroll
                    for (int k = 0; k < 8; ++k) acc[k] *= inv;
                }
                *(v4u*)((part == 0 ? gq : (part == 1 ? gk : gv)) + (size_t)n * 512 + lane * 8) = pack8(acc);
            }
            if (lane < 4) {
                gsc[(size_t)n * 8 + lane] = sigm(bf2f(p16[(size_t)n * PLD + C_GDN + 2048 + lane]));
                gsc[(size_t)n * 8 + 4 + lane] = -__expf(a.in[I_GDN_A_LOG][l * 4 + lane]) * softplus_f(bf2f(p16[(size_t)n * PLD + C_GDN + 2052 + lane]) + a.in[I_GDN_DT_BIAS][l * 4 + lane]);
            }
        }
    }
}

__device__ __forceinline__ float swz16(float v) { return __builtin_bit_cast(float, __builtin_amdgcn_ds_swizzle(__builtin_bit_cast(int, v), 0x401F)); }
__device__ __forceinline__ float red32(float v) { v = row16_sum(v); return v + swz16(v); }

__device__ __forceinline__ void rwkv_task(const Args& a, Frame& F, int l, int task) {
    const WsMap m = ws_map(NTOK);
    const int b = task >> 4, h = (task >> 1) & 7, hf = task & 1;
    LAS float* LR = (LAS float*)F.lds; LAS float* LW = LR + 2048; LAS float* LK = LW + 2048; LAS float* LA = LK + 2048; LAS float* LB = LA + 2048;
    LAS float* LV = LB + 2048; LAS float* LY = LV + 1024;
    const int lane = F.lane, w = F.wave, tid = F.tid;
    const int ch = h * 64 + lane;
    const bool mine = (lane >> 5) == hf;
    const float kk_ = a.in[I_RW_K_K][l * 512 + ch], ka_ = a.in[I_RW_K_A][l * 512 + ch], rk_ = a.in[I_RW_R_K][l * 512 + ch];
    const bf16_t* zr = (const bf16_t*)(a.ws + m.zrkv); const bf16_t* ao = (const bf16_t*)(a.ws + m.auxo); const bf16_t* vr = (const bf16_t*)(a.ws + m.vres);
    float* vf = (float*)(a.ws + m.vfirst); bf16_t* yo = (bf16_t*)(a.ws + m.rwy); bf16_t* bvo = (bf16_t*)(a.ws + m.rwbv);
    float S0 = 0.f, S1 = 0.f, S2 = 0.f, S3 = 0.f;
    const int row = tid >> 4, ks = tid & 15;
    float in_[4][7];
    auto load_chunk = [&](int c) {
#pragma unroll
        for (int q = 0; q < 4; ++q) { const size_t n = (size_t)b * TSEQ + c * 32 + w + 8 * q;
            in_[q][0] = bf2f(zr[n * 1536 + ch]); in_[q][1] = bf2f(zr[n * 1536 + 512 + ch]); in_[q][2] = bf2f(zr[n * 1536 + 1024 + ch]);
            in_[q][3] = bf2f(ao[n * 1792 + ch]); in_[q][4] = bf2f(ao[n * 1792 + 512 + ch]);
            if (l > 0) { in_[q][5] = bf2f(vr[n * 512 + ch]); in_[q][6] = vf[n * 512 + ch]; } else { in_[q][5] = 0.f; in_[q][6] = 0.f; } }
    };
    load_chunk(0);
    for (int c = 0; c < TSEQ / 32; ++c) {
#pragma unroll
        for (int q = 0; q < 4; ++q) {
            const int tl = w + 8 * q; const size_t n = (size_t)b * TSEQ + c * 32 + tl;
            const float zr_ = in_[q][0], zk_ = in_[q][1], zv_ = in_[q][2], wp = in_[q][3], ap = in_[q][4];
            float v = zv_;
            if (l == 0) { if (mine) vf[n * 512 + ch] = zv_; } else v = zv_ + (in_[q][6] - zv_) * sigm(in_[q][5]);
            const float w_raw = -softplus_f(-wp) - 0.5f, dec = __expf(-__expf(w_raw));
            const float aa = sigm(ap);
            const float kkraw = zk_ * kk_;
            const float ss = wave_sum_u(kkraw * kkraw);
            const float kk = kkraw * (1.0f / sqrtf(fmaxf(ss, 1e-24f)));
            const float km = zk_ * (1.0f + (aa - 1.0f) * ka_);
            const float bon = wave_sum_u(zr_ * km * rk_);
            LR[tl * 64 + lane] = zr_; LW[tl * 64 + lane] = dec; LK[tl * 64 + lane] = km; LA[tl * 64 + lane] = -kk; LB[tl * 64 + lane] = kk * aa;
            if (mine) { LV[tl * 32 + (lane & 31)] = v; bvo[n * 512 + ch] = f2bf(bon * v); }
        }
        __syncthreads();
        if (c + 1 < TSEQ / 32) load_chunk(c + 1);
        float keep0 = 0.f, keep1 = 0.f;
#pragma unroll 4
        for (int tl = 0; tl < 32; ++tl) {
            const int o = tl * 64 + ks * 4;
            const f32x4 a4 = *(const LAS f32x4*)(LA + o), w4 = *(const LAS f32x4*)(LW + o), b4 = *(const LAS f32x4*)(LB + o), k4 = *(const LAS f32x4*)(LK + o), r4 = *(const LAS f32x4*)(LR + o);
            const float vv = LV[tl * 32 + row];
            const float sa = row16_sum((S0 * a4.x + S1 * a4.y) + (S2 * a4.z + S3 * a4.w));
            S0 = S0 * w4.x + (sa * b4.x + vv * k4.x); S1 = S1 * w4.y + (sa * b4.y + vv * k4.y); S2 = S2 * w4.z + (sa * b4.z + vv * k4.z); S3 = S3 * w4.w + (sa * b4.w + vv * k4.w);
            const float y = row16_sum((S0 * r4.x + S1 * r4.y) + (S2 * r4.z + S3 * r4.w));
            keep0 = (ks == tl) ? y : keep0; keep1 = (ks + 16 == tl) ? y : keep1;
        }
        LY[ks * 32 + row] = keep0; LY[(16 + ks) * 32 + row] = keep1;
        __syncthreads();
        { const int tl = tid >> 4, r2 = (tid & 15) * 2; const size_t n = (size_t)b * TSEQ + c * 32 + tl;
          *(unsigned*)(yo + n * 512 + h * 64 + hf * 32 + r2) = pk2(LY[tl * 32 + r2], LY[tl * 32 + r2 + 1]); }
    }
}


__device__ __forceinline__ void chunk_cumsum8(float (&x)[8], LAS float* tmp, int lane, int w, int c8) {
#pragma unroll
    for (int d = 8; d < 64; d <<= 1) {
#pragma unroll
        for (int k = 0; k < 8; ++k) { const float t = __shfl_up(x[k], d); if (lane >= d) x[k] += t; }
    }
    if (lane >= 56) { *(LAS f32x4*)(tmp + w * 64 + c8) = (f32x4){x[0], x[1], x[2], x[3]}; *(LAS f32x4*)(tmp + w * 64 + c8 + 4) = (f32x4){x[4], x[5], x[6], x[7]}; }
    __syncthreads();
    for (int ww = 0; ww < w; ++ww) { const f32x4 a0 = *(const LAS f32x4*)(tmp + ww * 64 + c8), a1 = *(const LAS f32x4*)(tmp + ww * 64 + c8 + 4);
        x[0] += a0.x; x[1] += a0.y; x[2] += a0.z; x[3] += a0.w; x[4] += a1.x; x[5] += a1.y; x[6] += a1.z; x[7] += a1.w; }
}

constexpr int RWP = 72;
constexpr int RWT = 64 * RWP;
constexpr size_t RWB_TILES = 4 * RWT * 2;
constexpr size_t RWB_DVEC = RWB_TILES;
constexpr size_t RWB_VS = RWB_DVEC + 256;
constexpr size_t RWB_BYTES = RWB_VS + 4 * 3 * 64 * 16 * 2;

__device__ __forceinline__ f32x4 mm64(const LAS bf16_t* A, const LAS bf16_t* Bt, int mt, int nt, int lane, f32x4 acc) {
    const LAS bf16_t* ap = A + (mt * 16 + (lane & 15)) * RWP + (lane >> 4) * 8;
    const LAS bf16_t* bp = Bt + (nt * 16 + (lane & 15)) * RWP + (lane >> 4) * 8;
#pragma unroll
    for (int k0 = 0; k0 < 64; k0 += 32)
        acc = __builtin_amdgcn_mfma_f32_16x16x32_bf16(*(const LAS bf16x8*)(ap + k0), *(const LAS bf16x8*)(bp + k0), acc, 0, 0, 0);
    return acc;
}
__device__ __forceinline__ void st_rowmajor(LAS bf16_t* T, int mt, int nt, int lane, const f32x4 v) {
    const int n = nt * 16 + (lane & 15), i0 = mt * 16 + (lane >> 4) * 4;
    T[(i0 + 0) * RWP + n] = f2bf(v.x); T[(i0 + 1) * RWP + n] = f2bf(v.y); T[(i0 + 2) * RWP + n] = f2bf(v.z); T[(i0 + 3) * RWP + n] = f2bf(v.w);
}
__device__ __forceinline__ void st_transposed(LAS bf16_t* T, int mt, int nt, int lane, const f32x4 v) {
    const int n = nt * 16 + (lane & 15), i0 = mt * 16 + (lane >> 4) * 4;
    *(LAS v2u*)(T + n * RWP + i0) = (v2u){pk2(v.x, v.y), pk2(v.z, v.w)};
}

__device__ __forceinline__ void rwkv_pa_chunk(const Args& a, Frame& F, int l, int ci) {
    const WsMap m = ws_map(NTOK);
    const int bh = ci >> 6, c = ci & 63, b = bh >> 3, h = bh & 7;
    const int lane = F.lane, w = F.wave, tid = F.tid;
    const int ch = h * 64 + lane;
    LAS bf16_t* At = (LAS bf16_t*)F.lds; LAS bf16_t* AtT = At + RWT; LAS bf16_t* Bt = AtT + RWT; LAS bf16_t* Kt = Bt + RWT; LAS bf16_t* KtGT = Kt + RWT;
    LAS bf16_t* Rt = KtGT + RWT; LAS bf16_t* VmT = Rt + RWT; LAS bf16_t* LAK = VmT + RWT;
    LAS bf16_t* X0 = LAK + RWT; LAS bf16_t* XT0 = X0 + RWT; LAS bf16_t* T0 = XT0 + RWT; LAS bf16_t* X1 = T0 + RWT; LAS bf16_t* XT1 = X1 + RWT; LAS bf16_t* T1 = XT1 + RWT;
    LAS float* LWL = (LAS float*)X0;
    LAS bf16_t* A2 = X1;
    LAS bf16_t* LVT = XT1;
    const bf16_t* zr = (const bf16_t*)(a.ws + m.zrkv); const bf16_t* ao = (const bf16_t*)(a.ws + m.auxo); const bf16_t* vr = (const bf16_t*)(a.ws + m.vres);
    float* vf = (float*)(a.ws + m.vfirst); bf16_t* bvo = (bf16_t*)(a.ws + m.rwbv);
    unsigned char* blob = a.ws + m.xn + (size_t)ci * RWB_BYTES;
    bf16_t* gW = (bf16_t*)blob; bf16_t* gQG = gW + RWT; bf16_t* gKGT = gQG + RWT; bf16_t* gA1 = gKGT + RWT;
    float* gDV = (float*)(blob + RWB_DVEC); bf16_t* gVS = (bf16_t*)(blob + RWB_VS);
    const int j = tid >> 3, c8 = (tid & 7) * 8, chb = h * 64 + c8;
    const size_t n = (size_t)b * TSEQ + c * 64 + j;
    float zr_[8], zk_[8], zv_[8], wp[8], ap[8];
    unpack8(ld8(zr + n * 1536 + chb), zr_); unpack8(ld8(zr + n * 1536 + 512 + chb), zk_); unpack8(ld8(zr + n * 1536 + 1024 + chb), zv_);
    unpack8(ld8(ao + n * 1792 + chb), wp); unpack8(ld8(ao + n * 1792 + 512 + chb), ap);
    float vres8[8], vf8[8];
    if (l > 0) { unpack8(ld8(vr + n * 512 + chb), vres8); const f32x4 f0 = *(const f32x4*)(vf + n * 512 + chb), f1 = *(const f32x4*)(vf + n * 512 + chb + 4);
        vf8[0] = f0.x; vf8[1] = f0.y; vf8[2] = f0.z; vf8[3] = f0.w; vf8[4] = f1.x; vf8[5] = f1.y; vf8[6] = f1.z; vf8[7] = f1.w; }
    float lw[8];
#pragma unroll
    for (int k = 0; k < 8; ++k) lw[k] = -__expf(-softplus_f(-wp[k]) - 0.5f);
    float cs[8];
#pragma unroll
    for (int k = 0; k < 8; ++k) cs[k] = lw[k];
    chunk_cumsum8(cs, LWL, lane, w, c8);
    {
        float pk_[8], pa_[8], pr_[8];
        { const float* p0 = a.in[I_RW_K_K] + l * 512 + chb; const float* p1 = a.in[I_RW_K_A] + l * 512 + chb; const float* p2 = a.in[I_RW_R_K] + l * 512 + chb;
          const f32x4 a0 = *(const f32x4*)p0, a1 = *(const f32x4*)(p0 + 4), b0 = *(const f32x4*)p1, b1 = *(const f32x4*)(p1 + 4), c0 = *(const f32x4*)p2, c1 = *(const f32x4*)(p2 + 4);
          pk_[0] = a0.x; pk_[1] = a0.y; pk_[2] = a0.z; pk_[3] = a0.w; pk_[4] = a1.x; pk_[5] = a1.y; pk_[6] = a1.z; pk_[7] = a1.w;
          pa_[0] = b0.x; pa_[1] = b0.y; pa_[2] = b0.z; pa_[3] = b0.w; pa_[4] = b1.x; pa_[5] = b1.y; pa_[6] = b1.z; pa_[7] = b1.w;
          pr_[0] = c0.x; pr_[1] = c0.y; pr_[2] = c0.z; pr_[3] = c0.w; pr_[4] = c1.x; pr_[5] = c1.y; pr_[6] = c1.z; pr_[7] = c1.w; }
        float v[8], aa[8], kk[8], km[8];
        float ss = 0.f, bs = 0.f;
#pragma unroll
        for (int k = 0; k < 8; ++k) {
            v[k] = (l == 0) ? zv_[k] : zv_[k] + (vf8[k] - zv_[k]) * sigm(vres8[k]);
            aa[k] = sigm(ap[k]);
            kk[k] = zk_[k] * pk_[k]; ss += kk[k] * kk[k];
            km[k] = zk_[k] * (1.0f + (aa[k] - 1.0f) * pa_[k]); bs += zr_[k] * km[k] * pr_[k];
        }
        if (l == 0) { *(f32x4*)(vf + n * 512 + chb) = (f32x4){zv_[0], zv_[1], zv_[2], zv_[3]}; *(f32x4*)(vf + n * 512 + chb + 4) = (f32x4){zv_[4], zv_[5], zv_[6], zv_[7]}; }
        ss = red8(ss); bs = red8(bs);
        const float kinv = 1.0f / sqrtf(fmaxf(ss, 1e-24f));
        float cm[8], gcv[8];
        {
#pragma unroll
          for (int k = 0; k < 8; ++k) gcv[k] = 0.f;
#pragma unroll
          for (int ww = 0; ww < 8; ++ww) { const f32x4 g0 = *(const LAS f32x4*)(LWL + ww * 64 + c8), g1 = *(const LAS f32x4*)(LWL + ww * 64 + c8 + 4);
              gcv[0] += g0.x; gcv[1] += g0.y; gcv[2] += g0.z; gcv[3] += g0.w; gcv[4] += g1.x; gcv[5] += g1.y; gcv[6] += g1.z; gcv[7] += g1.w; } }
#pragma unroll
        for (int k = 0; k < 8; ++k) cm[k] = cs[k] - lw[k];
        float t_at[8], t_bt[8], t_kt[8], t_rt[8], t_bv[8];
        LAS bf16_t* KGTl = T1;
#pragma unroll
        for (int k = 0; k < 8; ++k) {
            const float G = __expf(cs[k]), Gm1 = __expf(cm[k]), iG = __expf(-cs[k]), GcG = __expf(gcv[k] - cs[k]);
            const float kkn = kk[k] * kinv;
            const float av = -kkn, bv = kkn * aa[k];
            t_at[k] = av * Gm1; t_bt[k] = bv * iG; t_kt[k] = km[k] * iG; t_rt[k] = zr_[k] * G; t_bv[k] = bs * v[k];
            AtT[(c8 + k) * RWP + j] = f2bf(t_at[k]);
            KtGT[(c8 + k) * RWP + j] = f2bf(km[k] * GcG);
            VmT[(c8 + k) * RWP + j] = f2bf(v[k]);
            KGTl[(c8 + k) * RWP + j] = f2bf(bv * GcG);
        }
        *(LAS v4u*)(At + j * RWP + c8) = pack8(t_at); *(LAS v4u*)(Bt + j * RWP + c8) = pack8(t_bt); *(LAS v4u*)(Kt + j * RWP + c8) = pack8(t_kt);
        const v4u rt8 = pack8(t_rt);
        *(LAS v4u*)(Rt + j * RWP + c8) = rt8; *(v4u*)(gQG + j * RWP + c8) = rt8;
        *(v4u*)(bvo + n * 512 + chb) = pack8(t_bv);
        if (j == 63) { *(f32x4*)(gDV + c8) = (f32x4){__expf(gcv[0]), __expf(gcv[1]), __expf(gcv[2]), __expf(gcv[3])}; *(f32x4*)(gDV + c8 + 4) = (f32x4){__expf(gcv[4]), __expf(gcv[5]), __expf(gcv[6]), __expf(gcv[7])}; }
    }
    __syncthreads();
    {
        for (int o = tid; o < RWT / 8; o += NTHR) ((v4u*)gKGT)[o] = ((const LAS v4u*)T1)[o];
        f32x4 z4 = {0.f, 0.f, 0.f, 0.f};
#pragma unroll 1
        for (int tt = 0; tt < 2; ++tt) {
            const int t = w + 8 * tt, mt = t >> 2, nt = t & 3;
            const int n = nt * 16 + (lane & 15), i0 = mt * 16 + (lane >> 4) * 4;
            f32x4 lab = mm64(At, Bt, mt, nt, lane, z4), lak = mm64(At, Kt, mt, nt, lane, z4), a1 = mm64(Rt, Bt, mt, nt, lane, z4), a2 = mm64(Rt, Kt, mt, nt, lane, z4);
            f32x4 tt0;
#pragma unroll
            for (int e = 0; e < 4; ++e) { const int i = i0 + e;
                if (n >= i) { lab[e] = 0.f; lak[e] = 0.f; }
                if (n > i) { a1[e] = 0.f; a2[e] = 0.f; }
                tt0[e] = lab[e] + (n == i ? 1.0f : 0.f); }
            st_rowmajor(X0, mt, nt, lane, lab); st_transposed(XT0, mt, nt, lane, lab);
            st_rowmajor(T0, mt, nt, lane, tt0);
            st_rowmajor(LAK, mt, nt, lane, lak);
            st_rowmajor(A2, mt, nt, lane, a2);
            gA1[(i0 + 0) * RWP + n] = f2bf(a1.x); gA1[(i0 + 1) * RWP + n] = f2bf(a1.y); gA1[(i0 + 2) * RWP + n] = f2bf(a1.z); gA1[(i0 + 3) * RWP + n] = f2bf(a1.w);
        }
    }
    __syncthreads();
    {
        f32x4 z4 = {0.f, 0.f, 0.f, 0.f};
#pragma unroll 1
        for (int tt = 0; tt < 2; ++tt) {
            const int t = w + 8 * tt, mt = t >> 2, nt = t & 3;
            const int n = nt * 16 + (lane & 15), i0 = mt * 16 + (lane >> 4) * 4;
            const f32x4 lv = mm64(LAK, VmT, mt, nt, lane, z4), o0 = mm64(A2, VmT, mt, nt, lane, z4), kv0 = mm64(KtGT, VmT, mt, nt, lane, z4);
            st_transposed((LAS bf16_t*)(F.lds + 131584), mt, nt, lane, lv);
            bf16_t* go = gVS + (size_t)nt * 3 * 1024 + 1024;
            const int r = lane & 15;
            go[(i0 + 0) * 16 + r] = f2bf(o0.x); go[(i0 + 1) * 16 + r] = f2bf(o0.y); go[(i0 + 2) * 16 + r] = f2bf(o0.z); go[(i0 + 3) * 16 + r] = f2bf(o0.w);
            go[1024 + (i0 + 0) * 16 + r] = f2bf(kv0.x); go[1024 + (i0 + 1) * 16 + r] = f2bf(kv0.y); go[1024 + (i0 + 2) * 16 + r] = f2bf(kv0.z); go[1024 + (i0 + 3) * 16 + r] = f2bf(kv0.w);
            (void)n;
        }
    }
    __syncthreads();
    {
        LAS bf16_t* Xc = X0; LAS bf16_t* XTc = XT0; LAS bf16_t* Tc = T0; LAS bf16_t* Xn = X1; LAS bf16_t* XTn = XT1; LAS bf16_t* Tn = T1;
        f32x4 z4 = {0.f, 0.f, 0.f, 0.f};
#pragma unroll 1
        for (int it = 0; it < 5; ++it) {
#pragma unroll 1
            for (int tt = 0; tt < 2; ++tt) { const int t = w + 8 * tt, mt = t >> 2, nt = t & 3;
                const f32x4 x2 = mm64(Xc, XTc, mt, nt, lane, z4);
                st_rowmajor(Xn, mt, nt, lane, x2); st_transposed(XTn, mt, nt, lane, x2); }
            __syncthreads();
#pragma unroll 1
            for (int tt = 0; tt < 2; ++tt) { const int t = w + 8 * tt, mt = t >> 2, nt = t & 3;
                const int n = nt * 16 + (lane & 15), i0 = mt * 16 + (lane >> 4) * 4;
                f32x4 tc; tc.x = bf2f(Tc[(i0 + 0) * RWP + n]); tc.y = bf2f(Tc[(i0 + 1) * RWP + n]); tc.z = bf2f(Tc[(i0 + 2) * RWP + n]); tc.w = bf2f(Tc[(i0 + 3) * RWP + n]);
                const f32x4 tn = mm64(Tc, XTn, mt, nt, lane, tc);
                st_rowmajor(Tn, mt, nt, lane, tn); }
            __syncthreads();
            LAS bf16_t* s0 = Xc; Xc = Xn; Xn = s0; s0 = XTc; XTc = XTn; XTn = s0; s0 = Tc; Tc = Tn; Tn = s0;
        }
        LAS bf16_t* LVTp = (LAS bf16_t*)(F.lds + 131584);
#pragma unroll 1
        for (int tt = 0; tt < 2; ++tt) { const int t = w + 8 * tt, mt = t >> 2, nt = t & 3;
            const int n = nt * 16 + (lane & 15), i0 = mt * 16 + (lane >> 4) * 4, r = lane & 15;
            const f32x4 wt = mm64(Tc, AtT, mt, nt, lane, z4), u0 = mm64(Tc, LVTp, mt, nt, lane, z4);
            gW[(i0 + 0) * RWP + n] = f2bf(wt.x); gW[(i0 + 1) * RWP + n] = f2bf(wt.y); gW[(i0 + 2) * RWP + n] = f2bf(wt.z); gW[(i0 + 3) * RWP + n] = f2bf(wt.w);
            bf16_t* gu = gVS + (size_t)nt * 3 * 1024;
            gu[(i0 + 0) * 16 + r] = f2bf(u0.x); gu[(i0 + 1) * 16 + r] = f2bf(u0.y); gu[(i0 + 2) * 16 + r] = f2bf(u0.z); gu[(i0 + 3) * 16 + r] = f2bf(u0.w); }
    }
    __syncthreads();
    (void)LVT;
}

__device__ __forceinline__ void rwkv_ps_task(const Args& a, Frame& F, int task) {
    const WsMap m = ws_map(NTOK);
    const int bh = task >> 2, vs = task & 3, b = bh >> 3, h = bh & 7;
    const int lane = F.lane, w = F.wave, tid = F.tid;
    LAS bf16_t* LB = (LAS bf16_t*)F.lds;
    LAS bf16_t* ST = LB + 4 * RWT; LAS bf16_t* VNT = ST + 16 * RWP;
    bf16_t* yo = (bf16_t*)(a.ws + m.rwy);
    const unsigned char* blob0 = a.ws + m.xn + (size_t)(bh * 64) * RWB_BYTES;
    const int r = lane & 15, i0w = (w & 3) * 16 + (lane >> 4) * 4;
    f32x4 Sacc = {0.f, 0.f, 0.f, 0.f};
    for (int i = tid; i < 16 * RWP / 2; i += NTHR) ((LAS unsigned*)ST)[i] = 0u;
    v4u pre[5];
    auto prefetch = [&](int c) {
        const v4u* g = (const v4u*)(blob0 + (size_t)c * RWB_BYTES);
#pragma unroll
        for (int k = 0; k < 5; ++k) { const int o = k * 512 + tid; pre[k] = (o < (int)(RWB_TILES / 16)) ? g[o] : (v4u){0u, 0u, 0u, 0u}; }
    };
    auto commit = [&]() {
#pragma unroll
        for (int k = 0; k < 5; ++k) { const int o = k * 512 + tid; if (o < (int)(RWB_TILES / 16)) ((LAS v4u*)LB)[o] = pre[k]; }
    };
    bf16_t nfr[4], nkv[4]; float ndv[4];
    auto prefrag = [&](int c) {
        const unsigned char* blob = blob0 + (size_t)c * RWB_BYTES;
        const bf16_t* gvs = (const bf16_t*)(blob + RWB_VS) + (size_t)vs * 3 * 1024;
        const bf16_t* src = gvs + (w < 4 ? 0 : 1024);
#pragma unroll
        for (int e = 0; e < 4; ++e) nfr[e] = src[(i0w + e) * 16 + r];
        if (w < 4) { const float* gd = (const float*)(blob + RWB_DVEC);
#pragma unroll
            for (int e = 0; e < 4; ++e) { ndv[e] = gd[i0w + e]; nkv[e] = gvs[2048 + (i0w + e) * 16 + r]; } }
        else {
#pragma unroll
            for (int e = 0; e < 4; ++e) { ndv[e] = 1.f; nkv[e] = 0; } }
    };
    prefetch(0); commit(); prefetch(1); prefrag(0);
    for (int c = 0; c < 64; ++c) {
        float fr[4], dv[4], kv0[4];
#pragma unroll
        for (int e = 0; e < 4; ++e) { fr[e] = bf2f(nfr[e]); dv[e] = ndv[e]; kv0[e] = bf2f(nkv[e]); }
        if (c + 1 < 64) prefrag(c + 1);
        __syncthreads();
        if (w < 4) {
            f32x4 vn = mm64(LB, ST, w, 0, lane, (f32x4){fr[0], fr[1], fr[2], fr[3]});
            st_transposed(VNT, w, 0, lane, vn);
        }
        __syncthreads();
        if (w < 4) {
            const f32x4 base = {dv[0] * Sacc.x + kv0[0], dv[1] * Sacc.y + kv0[1], dv[2] * Sacc.z + kv0[2], dv[3] * Sacc.w + kv0[3]};
            Sacc = mm64(LB + 2 * RWT, VNT, w, 0, lane, base);
        } else {
            f32x4 o = mm64(LB + RWT, ST, w - 4, 0, lane, (f32x4){fr[0], fr[1], fr[2], fr[3]});
            o = mm64(LB + 3 * RWT, VNT, w - 4, 0, lane, o);
            const size_t n = (size_t)b * TSEQ + c * 64 + i0w;
            bf16_t* yp = yo + n * 512 + h * 64 + vs * 16 + r;
            yp[0] = f2bf(o.x); yp[512] = f2bf(o.y); yp[1024] = f2bf(o.z); yp[1536] = f2bf(o.w);
        }
        __syncthreads();
        if (w < 4) st_transposed(ST, w, 0, lane, Sacc);
        if (c + 1 < 64) commit();
        if (c + 2 < 64) prefetch(c + 2);
    }
    __syncthreads();
}

constexpr int GP = 136;
constexpr size_t GB_BYTES = 26880;
template <int KD, int PA_, int PB_>
__device__ __forceinline__ f32x4 mmx(const LAS bf16_t* A, const LAS bf16_t* Bt, int mt, int nt, int lane, f32x4 acc) {
    const LAS bf16_t* ap = A + (mt * 16 + (lane & 15)) * PA_ + (lane >> 4) * 8;
    const LAS bf16_t* bp = Bt + (nt * 16 + (lane & 15)) * PB_ + (lane >> 4) * 8;
#pragma unroll
    for (int k0 = 0; k0 < KD; k0 += 32)
        acc = __builtin_amdgcn_mfma_f32_16x16x32_bf16(*(const LAS bf16x8*)(ap + k0), *(const LAS bf16x8*)(bp + k0), acc, 0, 0, 0);
    return acc;
}
__device__ __forceinline__ void gdn_pa_chunk(const Args& a, Frame& F, int ci) {
    const WsMap m = ws_map(NTOK);
    const int bh = ci >> 6, c = ci & 63, b = bh >> 2, h = bh & 3;
    const int lane = F.lane, w = F.wave, tid = F.tid;
    LAS bf16_t* KB = (LAS bf16_t*)F.lds; LAS bf16_t* KH = KB + 64 * GP; LAS bf16_t* QH = KH + 64 * GP;
    LAS bf16_t* KBEt = KB; LAS bf16_t* VbT = KB + 128 * RWP;
    LAS bf16_t* X0 = QH + 64 * GP; LAS bf16_t* XT0 = X0 + RWT; LAS bf16_t* T0 = XT0 + RWT; LAS bf16_t* X1 = T0 + RWT; LAS bf16_t* XT1 = X1 + RWT; LAS bf16_t* T1 = XT1 + RWT;
    LAS float* GC = (LAS float*)(T1 + RWT);
    LAS bf16_t* KGTl = (LAS bf16_t*)(GC + 64);
    bf16_t* gq = (bf16_t*)(a.ws + m.gq); bf16_t* gk = (bf16_t*)(a.ws + m.gk); bf16_t* gv = (bf16_t*)(a.ws + m.gv); const float* gsc = (const float*)(a.ws + m.gsc);
    unsigned char* blob = a.ws + m.gblob + (size_t)ci * GB_BYTES;
    bf16_t* gA1 = (bf16_t*)blob; bf16_t* gW = gA1 + RWT; float* gGC = (float*)(blob + RWT * 2 + 64 * GP * 2);
    const int j = tid >> 3, c16 = (tid & 7) * 16;
    const size_t n0 = (size_t)b * TSEQ + c * 64, n = n0 + j;
    const float be = gsc[n * 8 + h];
    v4u kw[2], qw[2], vw[2];
    {
        float kf[8];
#pragma unroll
        for (int hh = 0; hh < 2; ++hh) {
            kw[hh] = ld8(gk + n * 512 + h * 128 + c16 + hh * 8); qw[hh] = ld8(gq + n * 512 + h * 128 + c16 + hh * 8); vw[hh] = ld8(gv + n * 512 + h * 128 + c16 + hh * 8);
            *(LAS v4u*)(KH + j * GP + c16 + hh * 8) = kw[hh]; *(LAS v4u*)(QH + j * GP + c16 + hh * 8) = qw[hh];
            unpack8(kw[hh], kf);
#pragma unroll
            for (int k = 0; k < 8; ++k) kf[k] *= be;
            *(LAS v4u*)(KB + j * GP + c16 + hh * 8) = pack8(kf);
        }
        if (w == 0) {
            float g = gsc[(n0 + lane) * 8 + 4 + h];
#pragma unroll
            for (int o = 1; o < 64; o <<= 1) { const float t = __shfl_up(g, o); if (lane >= o) g += t; }
            GC[lane] = g; gGC[lane] = g;
        }
    }
    __syncthreads();
    {
        const f32x4 z4 = {0.f, 0.f, 0.f, 0.f};
#pragma unroll 1
        for (int tt = 0; tt < 2; ++tt) {
            const int t = w + 8 * tt, mt = t >> 2, nt = t & 3;
            const int nn = nt * 16 + (lane & 15), i0 = mt * 16 + (lane >> 4) * 4;
            f32x4 kk = mmx<128, GP, GP>(KB, KH, mt, nt, lane, z4), qk = mmx<128, GP, GP>(QH, KH, mt, nt, lane, z4);
            const float gj = GC[nn];
            f32x4 x, t0;
#pragma unroll
            for (int e = 0; e < 4; ++e) { const int i = i0 + e; const float d = __expf(fminf(GC[i] - gj, 0.f));
                x[e] = (nn < i) ? -kk[e] * d : 0.f; qk[e] = (nn <= i) ? qk[e] * d : 0.f; t0[e] = x[e] + (nn == i ? 1.0f : 0.f); }
            st_rowmajor(X0, mt, nt, lane, x); st_transposed(XT0, mt, nt, lane, x); st_rowmajor(T0, mt, nt, lane, t0);
            gA1[(i0 + 0) * RWP + nn] = f2bf(qk.x); gA1[(i0 + 1) * RWP + nn] = f2bf(qk.y); gA1[(i0 + 2) * RWP + nn] = f2bf(qk.z); gA1[(i0 + 3) * RWP + nn] = f2bf(qk.w);
        }
    }
    __syncthreads();
    {
        const float gj = GC[j], eg = __expf(gj), s_kbe = be * eg, s_kg = __expf(GC[63] - gj);
        float f[8], o8[8];
#pragma unroll
        for (int hh = 0; hh < 2; ++hh) {
            unpack8(kw[hh], f);
#pragma unroll
            for (int k = 0; k < 8; ++k) { KBEt[(c16 + hh * 8 + k) * RWP + j] = f2bf(f[k] * s_kbe); KGTl[(c16 + hh * 8 + k) * RWP + j] = f2bf(f[k] * s_kg); }
            unpack8(vw[hh], f);
#pragma unroll
            for (int k = 0; k < 8; ++k) VbT[(c16 + hh * 8 + k) * RWP + j] = f2bf(f[k] * be);
            unpack8(qw[hh], f);
#pragma unroll
            for (int k = 0; k < 8; ++k) o8[k] = f[k] * eg;
            *(v4u*)(gq + n * 512 + h * 128 + c16 + hh * 8) = pack8(o8);
        }
    }
    const f32x4 z4 = {0.f, 0.f, 0.f, 0.f};
    LAS bf16_t* Xc = X0; LAS bf16_t* XTc = XT0; LAS bf16_t* Tc = T0; LAS bf16_t* Xn = X1; LAS bf16_t* XTn = XT1; LAS bf16_t* Tn = T1;
#pragma unroll 1
    for (int it = 0; it < 5; ++it) {
#pragma unroll 1
        for (int tt = 0; tt < 2; ++tt) { const int t = w + 8 * tt, mt = t >> 2, nt = t & 3;
            const f32x4 x2 = mm64(Xc, XTc, mt, nt, lane, z4);
            st_rowmajor(Xn, mt, nt, lane, x2); st_transposed(XTn, mt, nt, lane, x2); }
        __syncthreads();
#pragma unroll 1
        for (int tt = 0; tt < 2; ++tt) { const int t = w + 8 * tt, mt = t >> 2, nt = t & 3;
            const int nn = nt * 16 + (lane & 15), i0 = mt * 16 + (lane >> 4) * 4;
            f32x4 tc; tc.x = bf2f(Tc[(i0 + 0) * RWP + nn]); tc.y = bf2f(Tc[(i0 + 1) * RWP + nn]); tc.z = bf2f(Tc[(i0 + 2) * RWP + nn]); tc.w = bf2f(Tc[(i0 + 3) * RWP + nn]);
            const f32x4 tn = mm64(Tc, XTn, mt, nt, lane, tc);
            st_rowmajor(Tn, mt, nt, lane, tn); }
        __syncthreads();
        LAS bf16_t* s0 = Xc; Xc = Xn; Xn = s0; s0 = XTc; XTc = XTn; XTn = s0; s0 = Tc; Tc = Tn; Tn = s0;
    }
    {
#pragma unroll 1
        for (int tt = 0; tt < 4; ++tt) { const int mt = w, nt = tt;
            const f32x4 dw = mm64(KBEt, Tc, mt, nt, lane, z4), du = mm64(VbT, Tc, mt, nt, lane, z4);
            const int i = nt * 16 + (lane & 15), c0 = mt * 16 + (lane >> 4) * 4;
            *(v2u*)(gW + i * GP + c0) = (v2u){pk2(dw.x, dw.y), pk2(dw.z, dw.w)};
            *(v2u*)(gv + (n0 + i) * 512 + h * 128 + c0) = (v2u){pk2(du.x, du.y), pk2(du.z, du.w)}; }
        for (int p = tid; p < 1024; p += NTHR) { const int k = p >> 3, j8 = (p & 7) * 8;
            *(v4u*)(gk + (n0 + (k >> 1)) * 512 + h * 128 + (k & 1) * 64 + j8) = *(const LAS v4u*)(KGTl + k * RWP + j8); }
    }
    __syncthreads();
}

__device__ __forceinline__ void gdn_ps_task(const Args& a, Frame& F, int task) {
    const WsMap m = ws_map(NTOK);
    const int bh = task >> 3, vs = task & 7, b = bh >> 2, h = bh & 3;
    const int lane = F.lane, w = F.wave, tid = F.tid;
    LAS bf16_t* A1 = (LAS bf16_t*)F.lds; LAS bf16_t* WT = A1 + RWT; LAS float* GC = (LAS float*)(WT + 64 * GP);
    LAS bf16_t* QG = (LAS bf16_t*)(GC + 64); LAS bf16_t* KGT = QG + 64 * GP; LAS bf16_t* ST = KGT + 128 * RWP;
    LAS bf16_t* VNT = ST + 16 * GP; LAS bf16_t* UU = VNT + 16 * RWP;
    const bf16_t* gq = (const bf16_t*)(a.ws + m.gq); const bf16_t* gk = (const bf16_t*)(a.ws + m.gk); const bf16_t* gv = (const bf16_t*)(a.ws + m.gv);
    bf16_t* go = (bf16_t*)(a.ws + m.gdno);
    const unsigned char* blob0 = a.ws + m.gblob + (size_t)(bh * 64) * GB_BYTES;
    const int r = lane & 15, kq4 = (lane >> 4) * 4;
    f32x4 Sacc = {0.f, 0.f, 0.f, 0.f};
    for (int i = tid; i < 16 * GP / 2; i += NTHR) ((LAS unsigned*)ST)[i] = 0u;
    v4u pb_[4], pq_[2], pk_[2], pu_;
    auto prefetch = [&](int c) {
        const size_t n0 = (size_t)b * TSEQ + c * 64;
        const v4u* g = (const v4u*)(blob0 + (size_t)c * GB_BYTES);
#pragma unroll
        for (int k = 0; k < 4; ++k) { const int o = k * 512 + tid; pb_[k] = (o < (int)(GB_BYTES / 16)) ? g[o] : (v4u){0u, 0u, 0u, 0u}; }
#pragma unroll
        for (int k = 0; k < 2; ++k) { const int p = k * 512 + tid;
            pq_[k] = ld8(gq + (n0 + (p >> 4)) * 512 + h * 128 + (p & 15) * 8);
            pk_[k] = ld8(gk + (n0 + (p >> 4)) * 512 + h * 128 + (p & 15) * 8); }
        if (tid < 128) pu_ = ld8(gv + (n0 + (tid >> 1)) * 512 + h * 128 + vs * 16 + (tid & 1) * 8);
    };
    prefetch(0);
    for (int c = 0; c < 64; ++c) {
#pragma unroll
        for (int k = 0; k < 4; ++k) { const int o = k * 512 + tid; if (o < (int)(GB_BYTES / 16)) ((LAS v4u*)A1)[o] = pb_[k]; }
#pragma unroll
        for (int k = 0; k < 2; ++k) { const int p = k * 512 + tid;
            *(LAS v4u*)(QG + (p >> 4) * GP + (p & 15) * 8) = pq_[k];
            const int kk = 2 * (p >> 4) + ((p & 15) >> 3), j8 = (p & 7) * 8;
            *(LAS v4u*)(KGT + kk * RWP + j8) = pk_[k]; }
        if (tid < 128) *(LAS v4u*)(UU + (tid >> 1) * 16 + (tid & 1) * 8) = pu_;
        __syncthreads();
        if (c + 1 < 64) prefetch(c + 1);
        const float glast = __expf(GC[63]);
        if (w < 4) {
            const int i0 = w * 16 + kq4;
            f32x4 vn = mmx<128, GP, GP>(WT, ST, w, 0, lane, (f32x4){0.f, 0.f, 0.f, 0.f});
            vn.x = bf2f(UU[(i0 + 0) * 16 + r]) - vn.x; vn.y = bf2f(UU[(i0 + 1) * 16 + r]) - vn.y; vn.z = bf2f(UU[(i0 + 2) * 16 + r]) - vn.z; vn.w = bf2f(UU[(i0 + 3) * 16 + r]) - vn.w;
            st_transposed(VNT, w, 0, lane, vn);
        }
        __syncthreads();
        {
            const f32x4 base = {Sacc.x * glast, Sacc.y * glast, Sacc.z * glast, Sacc.w * glast};
            Sacc = mm64(KGT, VNT, w, 0, lane, base);
            if (w < 4) {
                f32x4 o = mmx<128, GP, GP>(QG, ST, w, 0, lane, (f32x4){0.f, 0.f, 0.f, 0.f});
                o = mm64(A1, VNT, w, 0, lane, o);
                const size_t n = (size_t)b * TSEQ + c * 64 + w * 16 + kq4;
                bf16_t* op = go + n * 512 + h * 128 + vs * 16 + r;
                op[0] = f2bf(o.x); op[512] = f2bf(o.y); op[1024] = f2bf(o.z); op[1536] = f2bf(o.w);
            }
        }
        __syncthreads();
        { const int k0 = w * 16 + kq4;
          *(LAS v2u*)(ST + r * GP + k0) = (v2u){pk2(Sacc.x, Sacc.y), pk2(Sacc.z, Sacc.w)}; }
    }
    __syncthreads();
}

__device__ __forceinline__ void gla_pa_chunk(const Args& a, Frame& F, int ci) {
    const WsMap m = ws_map(NTOK);
    const int bh = ci >> 6, c = ci & 63, b = bh >> 2, h = bh & 3;
    const int lane = F.lane, w = F.wave, tid = F.tid;
    LAS bf16_t* KS2T = (LAS bf16_t*)F.lds; LAS bf16_t* VT = KS2T + RWT; LAS float* TMP = (LAS float*)(VT + 128 * RWP);
    const bf16_t* p16 = (const bf16_t*)(a.ws + m.p16); const bf16_t* ao = (const bf16_t*)(a.ws + m.auxo);
    bf16_t* gKV = (bf16_t*)(a.ws + m.glao) + (size_t)ci * 8192; float* gDV = (float*)(a.ws + m.gladv) + (size_t)ci * 64;
    const int j = tid >> 3, c8 = (tid & 7) * 8, v16 = (tid & 7) * 16;
    const size_t n = (size_t)b * TSEQ + c * 64 + j;
    float k8[8], la[8];
    unpack8(ld8(p16 + n * PLD + C_GLA + 256 + h * 64 + c8), k8); unpack8(ld8(ao + n * 1792 + 1536 + h * 64 + c8), la);
    const v4u v0 = ld8(p16 + n * PLD + C_GLA + 512 + h * 128 + v16), v1 = ld8(p16 + n * PLD + C_GLA + 512 + h * 128 + v16 + 8);
#pragma unroll
    for (int k = 0; k < 8; ++k) la[k] = -softplus_f(-la[k]) * (1.0f / 16.0f);
    chunk_cumsum8(la, TMP, lane, w, c8);
    float bl[8];
#pragma unroll
    for (int k = 0; k < 8; ++k) bl[k] = 0.f;
#pragma unroll
    for (int ww = 0; ww < 8; ++ww) { const f32x4 y0 = *(const LAS f32x4*)(TMP + ww * 64 + c8), y1 = *(const LAS f32x4*)(TMP + ww * 64 + c8 + 4);
        bl[0] += y0.x; bl[1] += y0.y; bl[2] += y0.z; bl[3] += y0.w; bl[4] += y1.x; bl[5] += y1.y; bl[6] += y1.z; bl[7] += y1.w; }
#pragma unroll
    for (int k = 0; k < 8; ++k) KS2T[(c8 + k) * RWP + j] = f2bf(k8[k] * __expf(bl[k] - la[k]));
    { const unsigned vw[8] = {v0.x, v0.y, v0.z, v0.w, v1.x, v1.y, v1.z, v1.w};
#pragma unroll
      for (int e = 0; e < 8; ++e) { VT[(v16 + 2 * e) * RWP + j] = (bf16_t)(vw[e] & 0xffffu); VT[(v16 + 2 * e + 1) * RWP + j] = (bf16_t)(vw[e] >> 16); } }
    if (j == 0) { *(f32x4*)(gDV + c8) = (f32x4){__expf(bl[0]), __expf(bl[1]), __expf(bl[2]), __expf(bl[3])}; *(f32x4*)(gDV + c8 + 4) = (f32x4){__expf(bl[4]), __expf(bl[5]), __expf(bl[6]), __expf(bl[7])}; }
    __syncthreads();
    {
        const f32x4 z4 = {0.f, 0.f, 0.f, 0.f};
#pragma unroll
        for (int tt = 0; tt < 4; ++tt) { const int mt = tt, nt = w;
            const f32x4 d = mm64(KS2T, VT, mt, nt, lane, z4);
            const int dv = nt * 16 + (lane & 15), k0 = mt * 16 + (lane >> 4) * 4;
            *(v2u*)(gKV + dv * 64 + k0) = (v2u){pk2(d.x, d.y), pk2(d.z, d.w)}; }
    }
    __syncthreads();
}
__device__ __forceinline__ void gla_sscan(const Args& a, Frame& F) {
    const WsMap m = ws_map(NTOK);
    const bf16_t* gKV = (const bf16_t*)(a.ws + m.glao); const float* gDV = (const float*)(a.ws + m.gladv); bf16_t* gS = (bf16_t*)(a.ws + m.glas);
    for (int it = F.vcu * NTHR + F.tid; it < 16 * 8192; it += F.G * NTHR) {
        const int bh = it >> 13, e = it & 8191, k = e & 63;
        float S = 0.f;
        bf16_t kn[16]; float dn[16];
#pragma unroll
        for (int u = 0; u < 16; ++u) { const size_t ci = (size_t)bh * 64 + u; kn[u] = gKV[ci * 8192 + e]; dn[u] = gDV[ci * 64 + k]; }
#pragma unroll 1
        for (int c0 = 0; c0 < 64; c0 += 16) {
            float kv[16], dv[16];
#pragma unroll
            for (int u = 0; u < 16; ++u) { kv[u] = bf2f(kn[u]); dv[u] = dn[u]; }
            if (c0 + 16 < 64) {
#pragma unroll
                for (int u = 0; u < 16; ++u) { const size_t ci = (size_t)bh * 64 + c0 + 16 + u; kn[u] = gKV[ci * 8192 + e]; dn[u] = gDV[ci * 64 + k]; } }
#pragma unroll
            for (int u = 0; u < 16; ++u) { const size_t ci = (size_t)bh * 64 + c0 + u; gS[ci * 8192 + e] = f2bf(S); S = S * dv[u] + kv[u]; }
        }
    }
}
__device__ __forceinline__ void gla_pb_chunk(const Args& a, Frame& F, int l, int ci) {
    const WsMap m = ws_map(NTOK);
    const int bh = ci >> 6, c = ci & 63, b = bh >> 2, h = bh & 3;
    const int lane = F.lane, w = F.wave, tid = F.tid;
    LAS bf16_t* QS = (LAS bf16_t*)F.lds; LAS bf16_t* KS = QS + RWT; LAS bf16_t* QG = KS + RWT; LAS bf16_t* PM = QG + RWT;
    LAS bf16_t* VT = PM + RWT; LAS bf16_t* ST = VT + 128 * RWP; LAS bf16_t* GG = ST + 128 * RWP;
    LAS float* TMP = (LAS float*)(GG + 64 * GP); LAS float* OSS = TMP + 512;
    const bf16_t* p16 = (const bf16_t*)(a.ws + m.p16); const bf16_t* ao = (const bf16_t*)(a.ws + m.auxo);
    const bf16_t* gS = (const bf16_t*)(a.ws + m.glas) + (size_t)ci * 8192; bf16_t* mix = (bf16_t*)(a.ws + m.mix16);
    const int j = tid >> 3, c8 = (tid & 7) * 8, v16 = (tid & 7) * 16;
    const size_t n = (size_t)b * TSEQ + c * 64 + j;
    float q8[8], k8[8], la[8];
    unpack8(ld8(p16 + n * PLD + C_GLA + h * 64 + c8), q8); unpack8(ld8(p16 + n * PLD + C_GLA + 256 + h * 64 + c8), k8); unpack8(ld8(ao + n * 1792 + 1536 + h * 64 + c8), la);
    const v4u v0 = ld8(p16 + n * PLD + C_GLA + 512 + h * 128 + v16), v1 = ld8(p16 + n * PLD + C_GLA + 512 + h * 128 + v16 + 8);
    const v4u g0 = ld8(p16 + n * PLD + C_GLA + 1024 + h * 128 + v16), g1 = ld8(p16 + n * PLD + C_GLA + 1024 + h * 128 + v16 + 8);
    const v4u s0 = ((const v4u*)gS)[tid], s1 = ((const v4u*)gS)[512 + tid];
#pragma unroll
    for (int k = 0; k < 8; ++k) la[k] = -softplus_f(-la[k]) * (1.0f / 16.0f);
    chunk_cumsum8(la, TMP, lane, w, c8);
    {
        float br[8], t0[8], t1[8], t2[8];
#pragma unroll
        for (int k = 0; k < 8; ++k) br[k] = 0.f;
#pragma unroll
        for (int ww = 0; ww < 4; ++ww) { const f32x4 y0 = *(const LAS f32x4*)(TMP + ww * 64 + c8), y1 = *(const LAS f32x4*)(TMP + ww * 64 + c8 + 4);
            br[0] += y0.x; br[1] += y0.y; br[2] += y0.z; br[3] += y0.w; br[4] += y1.x; br[5] += y1.y; br[6] += y1.z; br[7] += y1.w; }
#pragma unroll
        for (int k = 0; k < 8; ++k) { const float qq = q8[k] * 0.125f;
            t0[k] = qq * __expf(la[k] - br[k]); t1[k] = k8[k] * __expf(br[k] - la[k]); t2[k] = qq * __expf(la[k]); }
        *(LAS v4u*)(QS + j * RWP + c8) = pack8(t0); *(LAS v4u*)(KS + j * RWP + c8) = pack8(t1); *(LAS v4u*)(QG + j * RWP + c8) = pack8(t2);
        const unsigned vw[8] = {v0.x, v0.y, v0.z, v0.w, v1.x, v1.y, v1.z, v1.w};
#pragma unroll
        for (int e = 0; e < 8; ++e) { VT[(v16 + 2 * e) * RWP + j] = (bf16_t)(vw[e] & 0xffffu); VT[(v16 + 2 * e + 1) * RWP + j] = (bf16_t)(vw[e] >> 16); }
        *(LAS v4u*)(GG + j * GP + v16) = g0; *(LAS v4u*)(GG + j * GP + v16 + 8) = g1;
        { const int p0 = tid, p1 = 512 + tid;
          *(LAS v4u*)(ST + (p0 >> 3) * RWP + (p0 & 7) * 8) = s0; *(LAS v4u*)(ST + (p1 >> 3) * RWP + (p1 & 7) * 8) = s1; }
    }
    __syncthreads();
    {
        const f32x4 z4 = {0.f, 0.f, 0.f, 0.f};
#pragma unroll
        for (int tt = 0; tt < 2; ++tt) { const int t = w + 8 * tt, mtj = t >> 2, nti = t & 3;
            f32x4 s4 = mm64(KS, QS, mtj, nti, lane, z4);
            const int i = nti * 16 + (lane & 15), j0 = mtj * 16 + (lane >> 4) * 4;
#pragma unroll
            for (int e = 0; e < 4; ++e) if (j0 + e > i) s4[e] = 0.f;
            st_transposed(PM, mtj, nti, lane, s4); }
    }
    __syncthreads();
    {
        const int mt = w >> 1, ntb = (w & 1) * 4, r = lane & 15, i0 = mt * 16 + (lane >> 4) * 4;
        f32x4 o[4]; float ss[4] = {0.f, 0.f, 0.f, 0.f};
#pragma unroll
        for (int t = 0; t < 4; ++t) { o[t] = mm64(QG, ST, mt, ntb + t, lane, (f32x4){0.f, 0.f, 0.f, 0.f}); o[t] = mm64(PM, VT, mt, ntb + t, lane, o[t]);
            ss[0] += o[t].x * o[t].x; ss[1] += o[t].y * o[t].y; ss[2] += o[t].z * o[t].z; ss[3] += o[t].w * o[t].w; }
#pragma unroll
        for (int e = 0; e < 4; ++e) ss[e] = row16_sum(ss[e]);
        if (r == 0) {
#pragma unroll
            for (int e = 0; e < 4; ++e) OSS[(i0 + e) * 2 + (w & 1)] = ss[e]; }
        __syncthreads();
        float rs[4];
#pragma unroll
        for (int e = 0; e < 4; ++e) rs[e] = 1.0f / sqrtf((OSS[(i0 + e) * 2] + OSS[(i0 + e) * 2 + 1]) * (1.0f / 128.0f) + 1e-6f);
        const size_t nrow = (size_t)b * TSEQ + c * 64 + i0;
#pragma unroll
        for (int t = 0; t < 4; ++t) { const int dv = (ntb + t) * 16 + r; const float gn = a.in[I_GLA_NORM][l * 128 + dv];
            const float ov[4] = {o[t].x, o[t].y, o[t].z, o[t].w};
#pragma unroll
            for (int e = 0; e < 4; ++e) { const float g = bf2f(GG[(i0 + e) * GP + dv]);
                mix[(nrow + e) * DM + 512 + h * 128 + dv] = f2bf(ov[e] * rs[e] * gn * (g * sigm(g))); } }
    }
    __syncthreads();
}

__device__ __forceinline__ void lru_pass(const Args& a, Frame& F, int l, bool passB) {
    const WsMap m = ws_map(NTOK);
    const bf16_t* gt = (const bf16_t*)(a.ws + m.gates); const bf16_t* xc = (const bf16_t*)(a.ws + m.xc); const bf16_t* p16 = (const bf16_t*)(a.ws + m.p16);
    bf16_t* mix = (bf16_t*)(a.ws + m.mix16); float* lrs = (float*)(a.ws + m.lrs);
    for (int it = F.vcu * NTHR + F.tid; it < NBATCH * 64 * 512; it += F.G * NTHR) {
        const int ch = it & 511, bc = it >> 9, c = bc & 63;
        const float sp8 = 8.0f * softplus_f(-a.in[I_LRU_LAM][l * 512 + ch]);
        const size_t nb = (size_t)bc * 64;
        float hh = 0.f, ap = 1.f;
        if (passB) {
            f32x2 sn[8];
#pragma unroll
            for (int u = 0; u < 8; ++u) sn[u] = (u < c) ? *(const f32x2*)(lrs + ((size_t)(bc - c + u) * 512 + ch) * 2) : (f32x2){1.f, 0.f};
            for (int s0 = 0; s0 < c; s0 += 8) { f32x2 su[8];
#pragma unroll
                for (int u = 0; u < 8; ++u) su[u] = sn[u];
                if (s0 + 8 < c) {
#pragma unroll
                    for (int u = 0; u < 8; ++u) sn[u] = (s0 + 8 + u < c) ? *(const f32x2*)(lrs + ((size_t)(bc - c + s0 + 8 + u) * 512 + ch) * 2) : (f32x2){1.f, 0.f}; }
#pragma unroll
                for (int u = 0; u < 8; ++u) hh = su[u].x * hh + su[u].y; } }
        bf16_t rn[8], in_[8], xn_[8], yn[8];
#pragma unroll
        for (int u = 0; u < 8; ++u) { const size_t n = nb + u; rn[u] = gt[n * 1024 + ch]; in_[u] = gt[n * 1024 + 512 + ch]; xn_[u] = xc[n * 512 + ch];
            yn[u] = passB ? p16[n * PLD + C_LRU + 512 + ch] : (bf16_t)0; }
#pragma unroll 1
        for (int t0 = 0; t0 < 64; t0 += 8) {
            bf16_t rr[8], ii[8], xx[8], yy[8];
#pragma unroll
            for (int u = 0; u < 8; ++u) { rr[u] = rn[u]; ii[u] = in_[u]; xx[u] = xn_[u]; yy[u] = yn[u]; }
            if (t0 + 8 < 64) {
#pragma unroll
                for (int u = 0; u < 8; ++u) { const size_t n = nb + t0 + 8 + u; rn[u] = gt[n * 1024 + ch]; in_[u] = gt[n * 1024 + 512 + ch]; xn_[u] = xc[n * 512 + ch];
                    yn[u] = passB ? p16[n * PLD + C_LRU + 512 + ch] : (bf16_t)0; } }
#pragma unroll
            for (int u = 0; u < 8; ++u) { const size_t n = nb + t0 + u;
                const float la = -sp8 * sigm(bf2f(rr[u]));
                const float av = __expf(la);
                const float uu = bf2f(xx[u]) * sigm(bf2f(ii[u])) * sqrtf(fmaxf(1.0f - av * av, 0.0f));
                hh = av * hh + uu; ap *= av;
                if (passB) mix[n * DM + 1024 + ch] = f2bf(hh * gelu_fast(bf2f(yy[u]))); }
        }
        if (!passB) *(f32x2*)(lrs + ((size_t)bc * 512 + ch) * 2) = (f32x2){ap, hh};
    }
}

__device__ __forceinline__ void scan_phase(const Args& a, Frame& F, int l) {
    lru_pass(a, F, l, false);
    const int task = blockIdx.x;
    for (int q = 0; q < 8; ++q) rwkv_pa_chunk(a, F, l, task * 8 + q);
    for (int q = 0; q < 4; ++q) gdn_pa_chunk(a, F, task * 4 + q);
    for (int q = 0; q < 4; ++q) gla_pa_chunk(a, F, task * 4 + q);
    if (l == 0) tables_range(a, F, (size_t)2 * NEXP * DM / 32, (size_t)4 * NEXP * DM / 32, F.vcu, F.G);
}

__device__ __forceinline__ void post_phase(const Args& a, Frame& F, int l, const XcdBarrier& bar) {
    const WsMap m = ws_map(NTOK);
    if (blockIdx.x < 128) rwkv_ps_task(a, F, blockIdx.x); else gdn_ps_task(a, F, blockIdx.x - 128);
    gla_sscan(a, F);
    lru_pass(a, F, l, true);
    const bf16_t* p16 = (const bf16_t*)(a.ws + m.p16); const bf16_t* glao = (const bf16_t*)(a.ws + m.glao); const bf16_t* gdno = (const bf16_t*)(a.ws + m.gdno);
    const bf16_t* rwy = (const bf16_t*)(a.ws + m.rwy); const bf16_t* rwbv = (const bf16_t*)(a.ws + m.rwbv); const bf16_t* ao = (const bf16_t*)(a.ws + m.auxo);
    bf16_t* mix = (bf16_t*)(a.ws + m.mix16);
    const int lane = F.lane, col = lane * 8, hc = col & 127;
    float gg[8], gd[8], lw[8], lb[8];
    { const f32x4 x0 = *(const f32x4*)(a.in[I_GLA_NORM] + l * 128 + hc), x1 = *(const f32x4*)(a.in[I_GLA_NORM] + l * 128 + hc + 4);
      gg[0] = x0.x; gg[1] = x0.y; gg[2] = x0.z; gg[3] = x0.w; gg[4] = x1.x; gg[5] = x1.y; gg[6] = x1.z; gg[7] = x1.w;
      const f32x4 y0 = *(const f32x4*)(a.in[I_GDN_NORM] + l * 128 + hc), y1 = *(const f32x4*)(a.in[I_GDN_NORM] + l * 128 + hc + 4);
      gd[0] = y0.x; gd[1] = y0.y; gd[2] = y0.z; gd[3] = y0.w; gd[4] = y1.x; gd[5] = y1.y; gd[6] = y1.z; gd[7] = y1.w;
      const f32x4 w0 = *(const f32x4*)(a.in[I_RW_LN_W] + l * 512 + col), w1 = *(const f32x4*)(a.in[I_RW_LN_W] + l * 512 + col + 4);
      lw[0] = w0.x; lw[1] = w0.y; lw[2] = w0.z; lw[3] = w0.w; lw[4] = w1.x; lw[5] = w1.y; lw[6] = w1.z; lw[7] = w1.w;
      const f32x4 b0 = *(const f32x4*)(a.in[I_RW_LN_B] + l * 512 + col), b1 = *(const f32x4*)(a.in[I_RW_LN_B] + l * 512 + col + 4);
      lb[0] = b0.x; lb[1] = b0.y; lb[2] = b0.z; lb[3] = b0.w; lb[4] = b1.x; lb[5] = b1.y; lb[6] = b1.z; lb[7] = b1.w; }
    for (int pass = 1; pass < 2; ++pass) {
    if (pass == 1) xcd_barrier(bar);
    for (int q = 0; q < 4; ++q) gla_pb_chunk(a, F, l, blockIdx.x * 4 + q);
    for (int n = F.gw; n < NTOK; n += F.ngw) {
        if (pass == 1) {
            float y[8], bv[8], g[8];
            unpack8(ld8(rwy + (size_t)n * 512 + col), y); unpack8(ld8(rwbv + (size_t)n * 512 + col), bv); unpack8(ld8(ao + (size_t)n * 1792 + 1024 + col), g);
            float s = 0.f;
#pragma unroll
            for (int k = 0; k < 8; ++k) s += y[k];
            const float mean = red8(s) * (1.0f / 64.0f);
            float s2 = 0.f;
#pragma unroll
            for (int k = 0; k < 8; ++k) { y[k] -= mean; s2 += y[k] * y[k]; }
            const float rs = 1.0f / sqrtf(red8(s2) * (1.0f / 64.0f) + 64e-5f);
#pragma unroll
            for (int k = 0; k < 8; ++k) y[k] = (y[k] * rs * lw[k] + lb[k] + bv[k]) * g[k];
            *(v4u*)(mix + (size_t)n * DM + col) = pack8(y);
        }
        if (pass == 1)
#pragma unroll
        for (int which = 1; which < 2; ++which) {
            float o[8], g[8];
            unpack8(ld8((which ? gdno : glao) + (size_t)n * 512 + col), o);
            unpack8(ld8(p16 + (size_t)n * PLD + (which ? C_GDN + 1536 : C_GLA + 1024) + col), g);
            float ss = 0.f;
#pragma unroll
            for (int k = 0; k < 8; ++k) ss += o[k] * o[k];
            ss = row16_sum(ss);
            const float rs = 1.0f / sqrtf(ss * (1.0f / 128.0f) + 1e-6f);
#pragma unroll
            for (int k = 0; k < 8; ++k) o[k] = o[k] * rs * (which ? gd[k] : gg[k]) * (g[k] * sigm(g[k]));
            *(v4u*)(mix + (size_t)n * DM + (which ? 1536 : 512) + col) = pack8(o);
        }
    }
    }
}

__device__ __forceinline__ void norm2_phase(const Args& a, Frame& F, int l) {
    const WsMap m = ws_map(NTOK);
    const float* gain = a.in[I_NORM_FFN] + l * DM;
    f32x4 gv[8];
#pragma unroll
    for (int j = 0; j < 8; ++j) gv[j] = ((const f32x4*)gain)[64 * j + F.lane];
    for (int n = F.gw; n < NTOK; n += F.ngw) {
        const f32x4* xr = (const f32x4*)(a.out + (size_t)n * DM) + F.lane;
        f32x4 v[8]; float s = 0.f;
#pragma unroll
        for (int j = 0; j < 8; ++j) { v[j] = xr[64 * j]; s += (v[j].x * v[j].x + v[j].y * v[j].y) + (v[j].z * v[j].z + v[j].w * v[j].w); }
        const float rstd = 1.0f / sqrtf(wave_sum_u(s) * (1.0f / DM) + 1e-6f);
        v2u* o8 = (v2u*)((bf16_t*)(a.ws + m.hb) + (size_t)n * DM) + F.lane;
        unsigned char* hq = a.ws + m.mix16 + (size_t)n * 2304;
#pragma unroll
        for (int j = 0; j < 8; ++j) {
            const float y0 = v[j].x * rstd * gv[j].x, y1 = v[j].y * rstd * gv[j].y, y2 = v[j].z * rstd * gv[j].z, y3 = v[j].w * rstd * gv[j].w;
            v2u w; w.x = pk2(y0, y1); w.y = pk2(y2, y3); o8[64 * j] = w;
            float am = __builtin_fmaxf(__builtin_fmaxf(__builtin_fabsf(y0), __builtin_fabsf(y1)), __builtin_fmaxf(__builtin_fabsf(y2), __builtin_fabsf(y3)));
            am = __builtin_fmaxf(am, dpp_f<0xB1>(am)); am = __builtin_fmaxf(am, dpp_f<0x4E>(am)); am = __builtin_fmaxf(am, dpp_f<0x141>(am)); am = __builtin_fmaxf(am, 1e-20f);
            const float xinv = 119.0f / am;
            const int q0 = (int)__builtin_rintf(y0 * xinv), q1 = (int)__builtin_rintf(y1 * xinv), q2 = (int)__builtin_rintf(y2 * xinv), q3 = (int)__builtin_rintf(y3 * xinv);
            const int h0 = (q0 + 8) >> 4, h1 = (q1 + 8) >> 4, h2 = (q2 + 8) >> 4, h3 = (q3 + 8) >> 4;
            const unsigned ph = ((unsigned)h0 & 15u) | (((unsigned)h1 & 15u) << 4) | (((unsigned)h2 & 15u) << 8) | (((unsigned)h3 & 15u) << 12);
            const unsigned pl = ((unsigned)(q0 - 16 * h0) & 15u) | (((unsigned)(q1 - 16 * h1) & 15u) << 4) | (((unsigned)(q2 - 16 * h2) & 15u) << 8) | (((unsigned)(q3 - 16 * h3) & 15u) << 12);
            *(unsigned short*)(hq + 128 * j + 2 * F.lane) = (unsigned short)ph;
            *(unsigned short*)(hq + 1024 + 128 * j + 2 * F.lane) = (unsigned short)pl;
            if ((F.lane & 7) == 0) *(float*)(hq + 2048 + 32 * j + 4 * (F.lane >> 3)) = am * (1.0f / 119.0f);
        }
    }
}

#define TK_CE(A, B) do { const float mx_ = fmaxf(A, B), mn_ = fminf(A, B); A = mx_; B = mn_; } while (0)
__device__ __forceinline__ void tk_sort16_desc(float (&x)[16]) {
#pragma unroll
    for (int k = 2; k <= 16; k <<= 1)
#pragma unroll
        for (int j = k >> 1; j > 0; j >>= 1)
#pragma unroll
            for (int i = 0; i < 16; ++i) { const int p = i ^ j;
                if (p > i) { if ((i & k) == 0) TK_CE(x[i], x[p]); else TK_CE(x[p], x[i]); } }
}
__device__ __forceinline__ void tk_merge16(float (&run)[16], const float (&g)[16]) {
#pragma unroll
    for (int i = 0; i < 16; ++i) run[i] = fmaxf(run[i], g[15 - i]);
#pragma unroll
    for (int j = 8; j > 0; j >>= 1)
#pragma unroll
        for (int i = 0; i < 16; ++i) { const int p = i ^ j; if (p > i) TK_CE(run[i], run[p]); }
}
__device__ __forceinline__ float tk_tag(float v, unsigned tag, unsigned mask) { return __builtin_bit_cast(float, (__builtin_bit_cast(unsigned, v) & ~mask) | tag); }
__device__ __forceinline__ void topk_phase(const Args& a, Frame& F, int l) {
    const WsMap m = ws_map(NTOK);
    const float* tsu = (const float*)(a.ws + m.tsc) + (size_t)l * 2 * NEXP; const float* tsv = tsu + NEXP; float* sug = (float*)(a.ws + m.act);
    const float* sc = (const float*)(a.ws + m.sc);
    int* idx = (int*)(a.ws + m.idx); float* gate = (float*)(a.ws + m.gate);
    LAS float* LS = (LAS float*)F.lds;
    const int t = F.tid;
    for (int wv = F.gw; wv < (NTOK / 64) * 8; wv += F.ngw) {
        const int h = wv & 7, n = (wv >> 3) * 64 + F.lane;
        const float* sp = sc + (size_t)(h * 256) * NTOK + n;
        float s0[16], s1[16];
#pragma unroll
        for (int half = 0; half < 2; ++half) {
            float run[16];
#pragma unroll
            for (int j = 0; j < 16; ++j) run[j] = -3.0e38f;
#pragma unroll 1
            for (int g = 0; g < 8; ++g) {
                float x[16];
#pragma unroll
                for (int k = 0; k < 16; ++k) x[k] = tk_tag(sp[(size_t)(half * 128 + g * 16 + k) * NTOK], (unsigned)(g * 16 + k), 127u);
                tk_sort16_desc(x);
                tk_merge16(run, x);
            }
#pragma unroll
            for (int j = 0; j < 16; ++j) { if (half) s1[j] = run[j]; else s0[j] = run[j]; LS[(half * 16 + j) * 512 + t] = run[j]; }
        }
        float run[16];
#pragma unroll
        for (int j = 0; j < 16; ++j) run[j] = -3.0e38f;
        {
            float x[16]; int cnt = 0;
#pragma unroll
            for (int p = 0; p < 16; ++p)
#pragma unroll
                for (int q = 0; q < 16; ++q) if ((p + 1) * (q + 1) <= 16) {
                    x[cnt & 15] = tk_tag(s0[p] + s1[q], (unsigned)(p * 16 + q), 255u); ++cnt;
                    if ((cnt & 15) == 0) { tk_sort16_desc(x); tk_merge16(run, x); }
                }
#pragma unroll
            for (int k = 0; k < 16; ++k) if (k >= (cnt & 15)) x[k] = -3.0e38f;
            tk_sort16_desc(x); tk_merge16(run, x);
        }
        const float mx = run[0]; float den = 0.f; float e[16]; int ti[16];
#pragma unroll
        for (int j = 0; j < 16; ++j) {
            const unsigned tg = __builtin_bit_cast(unsigned, run[j]) & 255u; const int p = (int)(tg >> 4), q = (int)(tg & 15u);
            const unsigned k0 = __builtin_bit_cast(unsigned, LS[(0 * 16 + p) * 512 + t]) & 127u, k1 = __builtin_bit_cast(unsigned, LS[(1 * 16 + q) * 512 + t]) & 127u;
            ti[j] = (int)(k0 * 128u + k1);
            e[j] = __expf(run[j] - mx); den += e[j];
        }
        const float inv = 1.0f / den;
        const size_t it = (size_t)n * 8 + h;
        float su[16];
#pragma unroll
        for (int j = 0; j < 16; ++j) { su[j] = tsu[ti[j]]; e[j] *= tsv[ti[j]]; }
        f32x4* go = (f32x4*)(gate + it * 16); v4u* io = (v4u*)(idx + it * 16); f32x4* so = (f32x4*)(sug + it * 16);
#pragma unroll
        for (int j = 0; j < 4; ++j) { go[j] = (f32x4){e[4 * j] * inv, e[4 * j + 1] * inv, e[4 * j + 2] * inv, e[4 * j + 3] * inv};
            so[j] = (f32x4){su[4 * j], su[4 * j + 1], su[4 * j + 2], su[4 * j + 3]};
            io[j] = (v4u){(unsigned)ti[4 * j], (unsigned)ti[4 * j + 1], (unsigned)ti[4 * j + 2], (unsigned)ti[4 * j + 3]}; }
    }
}

typedef float f32x2_t __attribute__((ext_vector_type(2)));
typedef int v4i __attribute__((ext_vector_type(4)));
struct PeerSplit { int ng, g, nwg, w0; };
__device__ __forceinline__ PeerSplit peer_split(const Frame& F) {
    PeerSplit p; p.ng = F.G < 8 ? F.G : 8; p.g = (int)blockIdx.x % p.ng; p.nwg = (F.G - p.g + p.ng - 1) / p.ng; p.w0 = ((int)blockIdx.x / p.ng) * NWAVES + F.wave; return p;
}
__device__ __forceinline__ float xl32(float v, int lane) { return __builtin_bit_cast(float, __builtin_amdgcn_ds_bpermute((lane ^ 32) << 2, __builtin_bit_cast(int, v))); }
constexpr int PU_CH = 12, PV_CH = 6;
constexpr int PU_E = 0, PU_XH = PU_CH * 512, PU_XL = PU_XH + PU_CH * 128, PU_SC = PU_XL + PU_CH * 128, PU_O = PU_SC + PU_CH * 32, PU_WB = PU_O + PU_CH * 512;
constexpr int PV_E = 0, PV_C = PV_CH * 512, PV_X = 2 * PV_CH * 512, PV_SQ = PV_X + PV_CH * 1024, PV_WB = PV_SQ + 64;
static_assert(8 * PU_WB <= 131072 && 8 * PV_WB <= 131072 && PU_WB % 64 == 0 && PV_WB % 64 == 0, "PEER staging must fit the LDS ring area");
__device__ __forceinline__ void fmac(float& acc, float x, float y) { asm("v_fmac_f32 %0, %1, %2" : "+v"(acc) : "v"(x), "v"(y)); }
template <int B> __device__ __forceinline__ float code_f(unsigned w) { return __builtin_bit_cast(float, __builtin_amdgcn_perm(w, 0x3Fu, 0x00040C0Cu + ((unsigned)B << 16))); }
__device__ __forceinline__ float swz4(float v) { return __builtin_bit_cast(float, __builtin_amdgcn_ds_swizzle(__builtin_bit_cast(int, v), 0x101F)); }
__device__ __forceinline__ void lds_ld16(const LAS unsigned char* p, int (&e)[16]) {
#pragma unroll
    for (int k = 0; k < 4; ++k) { const v4u t = ((const LAS v4u*)p)[k]; e[4 * k] = (int)t.x; e[4 * k + 1] = (int)t.y; e[4 * k + 2] = (int)t.z; e[4 * k + 3] = (int)t.w; }
}
__device__ __forceinline__ void peer_u_phase(const Args& a, Frame& F, int l) {
    const WsMap m = ws_map(NTOK);
    const PeerSplit ps = peer_split(F);
    const int lane = F.lane, r = lane >> 3, q = lane & 7;
    const int* idx = (const int*)(a.ws + m.idx);
    float* dpart = (float*)(a.ws + m.dpart);
    const bool q0b = (lane & 1) != 0, q1b = (lane & 2) != 0, q2b = (lane & 4) != 0;
    const int qrow = (q0b ? 8 : 0) + (q1b ? 4 : 0) + (q2b ? 2 : 0);
    const int stride = ps.nwg * NWAVES;
    if (ps.w0 >= NTOK) return;
    const int nt = (NTOK - 1 - ps.w0) / stride + 1;
    LAS unsigned char* wb = F.lds + F.wave * PU_WB;
    for (int s = ps.g; s < 8; s += ps.ng) {
        const unsigned char* TU = (const unsigned char*)(a.ws + m.tabu) + ((size_t)(l * 2) * 8 + s) * NEXP * TSL; const unsigned q16 = (unsigned)q * 16u;
        const unsigned char* hqs = a.ws + m.mix16 + 128 * s;
        v4u se[PU_CH / 2], sxh[2], sxl[2]; float ssc[2];
        auto stage_load = [&](int tb) {
            const int cnt = nt - tb < PU_CH ? nt - tb : PU_CH;
#pragma unroll
            for (int k = 0; k < PU_CH / 2; ++k) { const int j = 2 * k + (lane >> 5);
                se[k] = *(const v4u*)(idx + (size_t)(ps.w0 + (tb + (j < cnt ? j : cnt - 1)) * stride) * 128 + (lane & 31) * 4); }
#pragma unroll
            for (int k = 0; k < 2; ++k) { const int j = 8 * k + r;
                const unsigned char* hn = hqs + (size_t)(ps.w0 + (tb + (j < cnt ? j : cnt - 1)) * stride) * 2304;
                sxh[k] = *(const v4u*)(hn + 16 * q); sxl[k] = *(const v4u*)(hn + 1024 + 16 * q); ssc[k] = *(const float*)(hn + 2048 - 96 * s + 4 * q); }
        };
        stage_load(0);
#pragma unroll 1
        for (int tb = 0; tb < nt; tb += PU_CH) {
            const int cnt = nt - tb < PU_CH ? nt - tb : PU_CH;
#pragma unroll
            for (int k = 0; k < PU_CH / 2; ++k) *(LAS v4u*)(wb + PU_E + (2 * k + (lane >> 5)) * 512 + (lane & 31) * 16) = se[k];
#pragma unroll
            for (int k = 0; k < 2; ++k) if (8 * k + r < PU_CH) { const int j = 8 * k + r;
                *(LAS v4u*)(wb + PU_XH + j * 128 + q * 16) = sxh[k]; *(LAS v4u*)(wb + PU_XL + j * 128 + q * 16) = sxl[k]; *(LAS float*)(wb + PU_SC + j * 32 + q * 4) = ssc[k]; }
            int ec[16]; v4u row[8];
            lds_ld16(wb + PU_E + r * 64, ec);
#pragma unroll
            for (int i = 0; i < 8; ++i) row[i] = *(const v4u*)(TU + (((unsigned)ec[i] << 7) | q16));
#pragma unroll 1
            for (int j = 0; j < cnt; ++j) {
                int en[16];
                lds_ld16(wb + PU_E + (j + 1 < cnt ? j + 1 : j) * 512 + r * 64, en);
                const v4u xh = *(const LAS v4u*)(wb + PU_XH + j * 128 + q * 16), xl = *(const LAS v4u*)(wb + PU_XL + j * 128 + q * 16);
                const float xscale = *(const LAS float*)(wb + PU_SC + j * 32 + q * 4);
                int sh = 0, sl = 0;
#pragma unroll
                for (int d = 0; d < 4; ++d) { sh = __builtin_amdgcn_sdot8((int)xh[d], 0x11111111, sh, false); sl = __builtin_amdgcn_sdot8((int)xl[d], 0x11111111, sl, false); }
                const float xoff = 0.5f * (float)(16 * sh + sl);
                float tp[16];
#pragma unroll
                for (int hf = 0; hf < 2; ++hf)
#pragma unroll
                for (int i = 0; i < 8; ++i) {
                    int ia = 0, ib = 0;
#pragma unroll
                    for (int d = 0; d < 4; ++d) { ia = __builtin_amdgcn_sdot8((int)row[i][d], (int)xh[d], ia, false); ib = __builtin_amdgcn_sdot8((int)row[i][d], (int)xl[d], ib, false); }
                    row[i] = *(const v4u*)(TU + (((unsigned)(hf ? en[i] : ec[8 + i]) << 7) | q16));
                    __builtin_amdgcn_sched_barrier(0);
                    tp[8 * hf + i] = ((float)(16 * ia + ib) + xoff) * xscale;
                }
                float ta[8], tb2[4];
#pragma unroll
                for (int p = 0; p < 8; ++p) { const float kk = q0b ? tp[p + 8] : tp[p], ss = q0b ? tp[p] : tp[p + 8]; ta[p] = kk + dpp_f<0xB1>(ss); }
#pragma unroll
                for (int p = 0; p < 4; ++p) { const float kk = q1b ? ta[p + 4] : ta[p], ss = q1b ? ta[p] : ta[p + 4]; tb2[p] = kk + dpp_f<0x4E>(ss); }
                const float k0 = (q2b ? tb2[2] : tb2[0]) + swz4(q2b ? tb2[0] : tb2[2]), k1 = (q2b ? tb2[3] : tb2[1]) + swz4(q2b ? tb2[1] : tb2[3]);
                ((LAS f32x2_t*)(wb + PU_O))[j * 64 + lane] = (f32x2_t){k0, k1};
#pragma unroll
                for (int i = 0; i < 16; ++i) ec[i] = en[i];
            }
            if (tb + PU_CH < nt) stage_load(tb + PU_CH);
#pragma unroll 1
            for (int j = 0; j < cnt; ++j) *(f32x2_t*)(dpart + ((size_t)s * NTOK + (ps.w0 + (tb + j) * stride)) * 128 + 16 * r + qrow) = ((LAS f32x2_t*)(wb + PU_O))[j * 64 + lane];
            __builtin_amdgcn_s_waitcnt(0);
        }
    }
}
typedef _Float16 h2_t __attribute__((ext_vector_type(2)));
__device__ __forceinline__ float coef_pack(float c) { const _Float16 h = (_Float16)(c * 256.0f); return __builtin_bit_cast(float, (h2_t){h, h}); }
__device__ __forceinline__ void peer_c_phase(const Args& a, Frame& F) {
    const WsMap m = ws_map(NTOK);
    float* gate = (float*)(a.ws + m.gate); const float* sug = (const float*)(a.ws + m.act); const float* dpart = (const float*)(a.ws + m.dpart);
    for (int n = F.gw; n < NTOK; n += F.ngw) {
        const size_t j0 = (size_t)n * 128 + 2 * F.lane;
        f32x2_t dp[8];
#pragma unroll
        for (int sp = 0; sp < 8; ++sp) dp[sp] = *(const f32x2_t*)(dpart + (size_t)sp * NTOK * 128 + j0);
        const f32x2_t gt = *(const f32x2_t*)(gate + j0), su = *(const f32x2_t*)(sug + j0);
        const f32x2_t d = ((dp[0] + dp[1]) + (dp[2] + dp[3])) + ((dp[4] + dp[5]) + (dp[6] + dp[7]));
        *(f32x2_t*)(gate + j0) = (f32x2_t){coef_pack(gelu_fast(d.x * su.x) * gt.x), coef_pack(gelu_fast(d.y * su.y) * gt.y)};
    }
}
__device__ __forceinline__ void peer_v_phase(const Args& a, Frame& F, int l) {
    const WsMap m = ws_map(NTOK);
    const PeerSplit ps = peer_split(F);
    const int lane = F.lane, r = lane >> 3, q = lane & 7;
    const int* idx = (const int*)(a.ws + m.idx); const float* coef = (const float*)(a.ws + m.gate);
    float* ssq = (float*)(a.ws + m.ssq);
    const bool b3 = (lane & 8) != 0, b4 = (lane & 16) != 0, b5 = (lane & 32) != 0;
    const int c0 = (b3 ? 16 : 0) + (b4 ? 8 : 0) + (b5 ? 4 : 0);
    const int stride = ps.nwg * NWAVES;
    if (ps.w0 >= NTOK) return;
    const int nt = (NTOK - 1 - ps.w0) / stride + 1;
    LAS unsigned char* wb = F.lds + F.wave * PV_WB;
    for (int s = ps.g; s < 8; s += ps.ng) {
        const unsigned char* TV = (const unsigned char*)(a.ws + m.tabu) + ((size_t)(l * 2 + 1) * 8 + s) * NEXP * TSL; const unsigned q16 = (unsigned)q * 16u;
        v4u se[PV_CH / 2], sc[PV_CH / 2]; f32x4 sx[PV_CH];
        auto stage_load = [&](int tb) {
            const int cnt = nt - tb < PV_CH ? nt - tb : PV_CH;
#pragma unroll
            for (int k = 0; k < PV_CH / 2; ++k) { const int j = 2 * k + (lane >> 5); const size_t n = (size_t)(ps.w0 + (tb + (j < cnt ? j : cnt - 1)) * stride);
                se[k] = *(const v4u*)(idx + n * 128 + (lane & 31) * 4); sc[k] = *(const v4u*)(coef + n * 128 + (lane & 31) * 4); }
#pragma unroll
            for (int j = 0; j < PV_CH; ++j) sx[j] = *(const f32x4*)(a.out + (size_t)(ps.w0 + (tb + (j < cnt ? j : cnt - 1)) * stride) * DM + 256 * s + lane * 4);
        };
        stage_load(0);
#pragma unroll 1
        for (int tb = 0; tb < nt; tb += PV_CH) {
            const int cnt = nt - tb < PV_CH ? nt - tb : PV_CH;
#pragma unroll
            for (int k = 0; k < PV_CH / 2; ++k) { *(LAS v4u*)(wb + PV_E + (2 * k + (lane >> 5)) * 512 + (lane & 31) * 16) = se[k]; *(LAS v4u*)(wb + PV_C + (2 * k + (lane >> 5)) * 512 + (lane & 31) * 16) = sc[k]; }
#pragma unroll
            for (int j = 0; j < PV_CH; ++j) *(LAS f32x4*)(wb + PV_X + j * 1024 + lane * 16) = sx[j];
            int ec[16]; v4u row[8];
            lds_ld16(wb + PV_E + r * 64, ec);
#pragma unroll
            for (int i = 0; i < 8; ++i) row[i] = *(const v4u*)(TV + (((unsigned)ec[i] << 7) | q16));
#pragma unroll 1
            for (int j = 0; j < cnt; ++j) {
                int en[16];
                lds_ld16(wb + PV_E + (j + 1 < cnt ? j + 1 : j) * 512 + r * 64, en);
                float ci[16];
#pragma unroll
                for (int k = 0; k < 4; ++k) { const f32x4 t = ((const LAS f32x4*)(wb + PV_C + j * 512 + r * 64))[k]; ci[4 * k] = t.x; ci[4 * k + 1] = t.y; ci[4 * k + 2] = t.z; ci[4 * k + 3] = t.w; }
                const f32x4 x4 = *(const LAS f32x4*)(wb + PV_X + j * 1024 + (32 * q + c0) * 4);
                h2_t oh[16];
#pragma unroll
                for (int i = 0; i < 16; ++i) oh[i] = (h2_t){(_Float16)0.f, (_Float16)0.f};
#pragma unroll
                for (int hf = 0; hf < 2; ++hf)
#pragma unroll
                for (int i = 0; i < 8; ++i) {
                    const h2_t c2 = __builtin_bit_cast(h2_t, ci[8 * hf + i]);
#pragma unroll
                    for (int d = 0; d < 4; ++d) {
                        oh[4 * d + 0] = __builtin_elementwise_fma(__builtin_bit_cast(h2_t, __builtin_amdgcn_cvt_scalef32_pk_f16_fp4(row[i][d], 1.0f, 0)), c2, oh[4 * d + 0]);
                        oh[4 * d + 1] = __builtin_elementwise_fma(__builtin_bit_cast(h2_t, __builtin_amdgcn_cvt_scalef32_pk_f16_fp4(row[i][d], 1.0f, 1)), c2, oh[4 * d + 1]);
                        oh[4 * d + 2] = __builtin_elementwise_fma(__builtin_bit_cast(h2_t, __builtin_amdgcn_cvt_scalef32_pk_f16_fp4(row[i][d], 1.0f, 2)), c2, oh[4 * d + 2]);
                        oh[4 * d + 3] = __builtin_elementwise_fma(__builtin_bit_cast(h2_t, __builtin_amdgcn_cvt_scalef32_pk_f16_fp4(row[i][d], 1.0f, 3)), c2, oh[4 * d + 3]); }
                    row[i] = *(const v4u*)(TV + (((unsigned)(hf ? en[i] : ec[8 + i]) << 7) | q16));
                    __builtin_amdgcn_sched_barrier(0);
                }
                h2_t ha[8], hb[4], hc[2];
#pragma unroll
                for (int p = 0; p < 8; ++p) { const h2_t kk = b3 ? oh[p + 8] : oh[p], ss = b3 ? oh[p] : oh[p + 8];
                    ha[p] = kk + __builtin_bit_cast(h2_t, dpp_f<0x128>(__builtin_bit_cast(float, ss))); }
#pragma unroll
                for (int p = 0; p < 4; ++p) { const h2_t kk = b4 ? ha[p + 4] : ha[p], ss = b4 ? ha[p] : ha[p + 4];
                    hb[p] = kk + __builtin_bit_cast(h2_t, swz16(__builtin_bit_cast(float, ss))); }
#pragma unroll
                for (int p = 0; p < 2; ++p) { const h2_t kk = b5 ? hb[p + 2] : hb[p], ss = b5 ? hb[p] : hb[p + 2];
                    hc[p] = kk + __builtin_bit_cast(h2_t, xl32(__builtin_bit_cast(float, ss), lane)); }
                const float h3[4] = {(float)hc[0].x, (float)hc[0].y, (float)hc[1].x, (float)hc[1].y};
                const f32x4 o = {x4.x + h3[0] * (1.0f / 256.0f), x4.y + h3[1] * (1.0f / 256.0f), x4.z + h3[2] * (1.0f / 256.0f), x4.w + h3[3] * (1.0f / 256.0f)};
                *(LAS f32x4*)(wb + PV_X + j * 1024 + (32 * q + c0) * 4) = o;
                const float tot = wave_sum_u((o.x * o.x + o.y * o.y) + (o.z * o.z + o.w * o.w));
                if (lane == 0) ((LAS float*)(wb + PV_SQ))[j] = tot;
#pragma unroll
                for (int i = 0; i < 16; ++i) ec[i] = en[i];
            }
            if (tb + PV_CH < nt) stage_load(tb + PV_CH);
#pragma unroll 1
            for (int j = 0; j < cnt; ++j) { const int n = ps.w0 + (tb + j) * stride; const size_t off = (size_t)n * DM + 256 * s + lane * 4;
                const f32x4 o = *(const LAS f32x4*)(wb + PV_X + j * 1024 + lane * 16);
                *(f32x4*)(a.out + off) = o;
                if (l + 1 < NL) { v2u w; w.x = pk2(o.x, o.y); w.y = pk2(o.z, o.w); *(v2u*)((bf16_t*)(a.ws + m.xn) + off) = w; }
                if (lane == 0) ssq[(size_t)n * 8 + s] = ((const LAS float*)(wb + PV_SQ))[j]; }
            __builtin_amdgcn_s_waitcnt(0);
        }
    }
}
__device__ __forceinline__ void fnorm_phase(const Args& a, Frame& F) {
    const WsMap m = ws_map(NTOK);
    const float* ssq = (const float*)(a.ws + m.ssq);
    const int lane = F.lane;
    for (int n = F.gw; n < NTOK; n += F.ngw) {
        const f32x4 s0 = *(const f32x4*)(ssq + (size_t)n * 8), s1 = *(const f32x4*)(ssq + (size_t)n * 8 + 4);
        const float rstd = 1.0f / sqrtf((((s0.x + s0.y) + (s0.z + s0.w)) + ((s1.x + s1.y) + (s1.z + s1.w))) * (1.0f / DM) + 1e-6f);
        float* xrow = a.out + (size_t)n * DM;
        const float* gf = a.in[I_NORM_FINAL];
        f32x4 v[8];
#pragma unroll
        for (int k = 0; k < 8; ++k) v[k] = *(const f32x4*)(xrow + 256 * k + 4 * lane);
#pragma unroll
        for (int k = 0; k < 8; ++k) { const f32x4 g4 = *(const f32x4*)(gf + 256 * k + 4 * lane);
            *(f32x4*)(xrow + 256 * k + 4 * lane) = (f32x4){v[k].x * rstd * g4.x, v[k].y * rstd * g4.y, v[k].z * rstd * g4.z, v[k].w * rstd * g4.w}; }
    }
}

#define IN(k) (lo <= (k) && (k) < hi)
#define SEAM(k) do { if (IN(k) && IN((k) + 1)) xcd_barrier(bar); } while (0)
template <int l>
__device__ __forceinline__ void layer_phases(const Args& a, Frame& F, const XcdBarrier& bar, const WsMap& m, int lo, int hi) {
    constexpr int pb = l * PH_PER_LAYER;
        if (IN(pb + PH_GEMM1)) {
            pg8::GemmX g{(const bf16_t*)(a.ws + m.xn), (const bf16_t*)(a.ws + m.w1t) + (size_t)l * PLD * DM, NTOK, PLD, DM, DM};
            pg8::StaticOrder S; S.init(NTOK, PLD, F.G, (int)blockIdx.x);
            pg8::EpiBf16 E{(bf16_t*)(a.ws + m.p16), PLD, nullptr, l > 0 ? (const float*)(a.ws + m.ssq) : nullptr};
            pg8::gemm_phase<pg8::EpiBf16, pg8::StaticOrder, true, true>(F.lds, g, S, E);
            SEAM(pb + PH_GEMM1);
        }
        if (IN(pb + PH_PREP)) { prep_phase(a, F, l); SEAM(pb + PH_PREP); }
        if (IN(pb + PH_AUX)) {
            const float* PP = (const float*)(a.ws + m.pp);
            { pg8::GemmX g{(const bf16_t*)(a.ws + m.auxA), (const bf16_t*)(a.ws + m.auxwt) + (size_t)l * 1792 * 384, NTOK, 1792, 384, 384};
              pg8::StaticOrder S; S.init(NTOK, 1792, F.G, (int)blockIdx.x);
              pg8::EpiBf16 E{(bf16_t*)(a.ws + m.auxo), 1792, PP + l * 1792};
              pg8::gemm_phase<pg8::EpiBf16, pg8::StaticOrder, true, true>(F.lds, g, S, E); }
            { pg8::GemmX g{(const bf16_t*)(a.ws + m.xc), (const bf16_t*)(a.ws + m.lruwt) + (size_t)l * 1024 * 512, NTOK, 1024, 512, 512};
              pg8::StaticOrder S; S.init(NTOK, 1024, F.G, (int)blockIdx.x);
              pg8::EpiBf16 E{(bf16_t*)(a.ws + m.gates), 1024, PP + 3584 + l * 1024};
              pg8::gemm_phase<pg8::EpiBf16, pg8::StaticOrder, true, true>(F.lds, g, S, E); }
            if (l > 0) {
              pg8::GemmX g{(const bf16_t*)(a.ws + m.zrkv) + 1024, (const bf16_t*)(a.ws + m.vreswt), NTOK, 512, 512, 1536};
              pg8::StaticOrder S; S.init(NTOK, 512, F.G, (int)blockIdx.x);
              pg8::EpiBf16 E{(bf16_t*)(a.ws + m.vres), 512, PP + 5632};
              pg8::gemm_phase<pg8::EpiBf16, pg8::StaticOrder, true, true>(F.lds, g, S, E); }
            SEAM(pb + PH_AUX);
        }
        if (IN(pb + PH_SCAN)) { scan_phase(a, F, l); SEAM(pb + PH_SCAN); }
        if (IN(pb + PH_POST)) { post_phase(a, F, l, bar); SEAM(pb + PH_POST); }
        if (IN(pb + PH_GEMM2)) {
            pg8::GemmX g{(const bf16_t*)(a.ws + m.mix16), (const bf16_t*)(a.ws + m.w2t) + (size_t)l * DM * DM, NTOK, DM, DM, DM};
            pg8::StaticOrder S; S.init(NTOK, DM, F.G, (int)blockIdx.x);
            pg8::EpiF32<true> E{a.out, DM};
            pg8::gemm_phase<pg8::EpiF32<true>, pg8::StaticOrder, true, true>(F.lds, g, S, E);
            SEAM(pb + PH_GEMM2);
        }
        if (IN(pb + PH_NORM2)) { norm2_phase(a, F, l); SEAM(pb + PH_NORM2); }
        if (IN(pb + PH_GEMM3)) {
            pg8::GemmX g{(const bf16_t*)(a.ws + m.wsct) + (size_t)l * DM * DM, (const bf16_t*)(a.ws + m.hb), DM, NTOK, DM, DM};
            pg8::StaticOrder S; S.init(DM, NTOK, F.G, (int)blockIdx.x);
            pg8::EpiF32<false> E{(float*)(a.ws + m.sc), NTOK};
            pg8::gemm_phase<pg8::EpiF32<false>, pg8::StaticOrder, true, true>(F.lds, g, S, E);
            SEAM(pb + PH_GEMM3);
        }
        if (IN(pb + PH_TOPK)) { topk_phase(a, F, l); SEAM(pb + PH_TOPK); }
        if (IN(pb + PH_PEERU)) { peer_u_phase(a, F, l); SEAM(pb + PH_PEERU); }
        if (IN(pb + PH_PEERC)) { peer_c_phase(a, F); SEAM(pb + PH_PEERC); }
        if (IN(pb + PH_PEERV)) { peer_v_phase(a, F, l); SEAM(pb + PH_PEERV); }
}

#undef IN
#undef SEAM
__global__ void __launch_bounds__(NTHR, 2) mega(Args a) {
    extern __shared__ __attribute__((aligned(16))) unsigned char lds_raw[];
    Frame F;
    F.lds = (LAS unsigned char*)lds_raw;
    F.tid = threadIdx.x; F.lane = F.tid & 63; F.wave = __builtin_amdgcn_readfirstlane(F.tid >> 6);
    F.G = gridDim.x; { const int bx = blockIdx.x; F.vcu = (F.G % 8 == 0) ? (bx % 8) * (F.G / 8) + bx / 8 : bx; }
    F.gw = F.vcu * NWAVES + F.wave; F.ngw = F.G * NWAVES;
    volatile LAS unsigned* MISC = (volatile LAS unsigned*)(F.lds + MISC_OFF);
    if (F.tid < 32) MISC[F.tid] = 0u;
    __syncthreads();
    const WsMap m = ws_map(NTOK);
    unsigned* ctl = (unsigned*)(a.ws + m.ctl);
    XcdBarrier bar; bar.bar = ctl + 4096 + a.li * XCD_BAR_WORDS; bar.x = 0; bar.st = nullptr;
    const int lo = a.ph_lo, hi = a.ph_hi;
    if (hi - lo > 1) bar = xcd_barrier_post(ctl + 4096 + a.li * XCD_BAR_WORDS, MISC + 8);
#define IN(k) (lo <= (k) && (k) < hi)
#define SEAM(k) do { if (IN(k) && IN((k) + 1)) xcd_barrier(bar); } while (0)
    if (IN(PH_P0)) { p0_prologue(a, F); tables_range(a, F, 0, (size_t)2 * NEXP * DM / 32, F.vcu, F.G); SEAM(PH_P0); }
    layer_phases<0>(a, F, bar, m, lo, hi);
    layer_phases<1>(a, F, bar, m, lo, hi);
    if (IN(PH_FNORM)) fnorm_phase(a, F);
#undef IN
#undef SEAM
}

template <int ST>
__global__ void __launch_bounds__(256) stage_kernel(Params P, int l) {
    const long n = stage_items(P, ST, l);
    for (long it = blockIdx.x * 256L + threadIdx.x; it < n; it += gridDim.x * 256L) run_item(P, ST, l, it);
}
template <int ST>
static void launch_stage(const Params& P, int l, hipStream_t stream) {
    const long n = stage_items(P, ST, l);
    if (n <= 0) return;
    long blocks = (n + 255) / 256;
    if (blocks > 8192) blocks = 8192;
    stage_kernel<ST><<<dim3((unsigned)blocks), dim3(256), 0, stream>>>(P, l);
}
#define LS(X) case X: launch_stage<X>(P, l, stream); break;
static void launch_any(int st, const Params& P, int l, hipStream_t stream) {
    switch (st) {
        LS(ST_COPYX) LS(ST_RSTD) LS(ST_NORM1) LS(ST_GEMM1) LS(ST_RW_A0) LS(ST_RW_A1) LS(ST_RW_A2) LS(ST_RW_A3) LS(ST_RW_KKN)
        LS(ST_RW_SCAN) LS(ST_RW_POST) LS(ST_GLA_B0) LS(ST_GLA_SCAN) LS(ST_GLA_POST) LS(ST_LRU_C0) LS(ST_LRU_C1) LS(ST_LRU_SCAN)
        LS(ST_GDN_D0) LS(ST_GDN_D1) LS(ST_GDN_SCAN) LS(ST_GDN_POST) LS(ST_GEMM2) LS(ST_RSTD2) LS(ST_NORM2) LS(ST_GEMM3)
        LS(ST_SCORES) LS(ST_TOPK1) LS(ST_TOPK2) LS(ST_PEER_U) LS(ST_PEER_V) LS(ST_FRSTD) LS(ST_FNORM)
    }
}

extern "C" void kernel_launch(void* const* d_in, const int* in_sizes, int n_in, void* d_out, int out_size, void* d_ws,
                              size_t ws_size, hipStream_t stream) {
    static int grid = 0;
    if (grid == 0) {
        int dev = 0, cus = 0;
        (void)hipGetDevice(&dev);
        (void)hipDeviceGetAttribute(&cus, hipDeviceAttributeMultiprocessorCount, dev);
        (void)hipFuncSetAttribute((const void*)mega, hipFuncAttributeMaxDynamicSharedMemorySize, LDS_BYTES);
        grid = cus > 0 ? cus : 256;
    }
    Params P;
    memset(&P, 0, sizeof(P));
    fill_inputs(P, d_in);
    P.B = 4; P.T = 4096; P.N = 16384; P.pad = 0;
    P.xcur = (float*)d_out;
    bind_ws(P, (char*)d_ws);
    Args a;
    memset(&a, 0, sizeof(a));
    for (int i = 0; i < 38; ++i) a.in[i] = (const float*)d_in[i];
    a.out = (float*)d_out; a.ws = (unsigned char*)d_ws;
    (void)hipMemsetAsync(d_ws, 0, 1u << 20, stream);
    int li = 0;
    auto run_mega = [&](int lo, int hi) { a.ph_lo = lo; a.ph_hi = hi; a.li = li++; hipLaunchKernelGGL(mega, dim3(grid), dim3(NTHR), LDS_BYTES, stream, a); };
    run_mega(PH_P0, PH_TOTAL);
}
#endif
```

```cpp
#ifndef HOST_EMU
#include <hip/hip_runtime.h>
#include <cstring>
#define HD __host__ __device__ __forceinline__
#else
#include <cmath>
#include <cstdio>
#include <cstdlib>
#include <cstring>
#define HD inline
#endif

constexpr int DM = 2048;
constexpr int NL = 2;
constexpr int INC = 6424;
constexpr int C_RW = 0;
constexpr int C_GLA = 1792;
constexpr int C_LRU = 3344;
constexpr int C_GDN = 4368;
constexpr int NEXP = 16384;

typedef unsigned short bf16_t;
constexpr int PLD = 6656;
HD float bf2f(bf16_t h) { unsigned u = (unsigned)h << 16; float f; memcpy(&f, &u, 4); return f; }
HD bf16_t f2bf(float f) { unsigned u; memcpy(&u, &f, 4); return (bf16_t)((u + 0x7fffu + ((u >> 16) & 1u)) >> 16); }

struct Params {
    const float *x, *norm_mix, *w_in, *w_out, *rw_mu, *rw_w0, *rw_w_up, *rw_a0, *rw_a_up, *rw_g_up, *rw_k_k, *rw_k_a,
        *rw_r_k, *rw_ln_w, *rw_ln_b, *rw_v0, *rw_v_down, *rw_v_up, *gla_a_up, *gla_a_bias, *gla_norm, *lru_conv_w,
        *lru_conv_b, *lru_w_r, *lru_b_r, *lru_w_i, *lru_b_i, *lru_lam, *gdn_conv_w, *gdn_a_log, *gdn_dt_bias, *gdn_norm,
        *norm_ffn, *peer_wq, *peer_sub_keys, *peer_u, *peer_v, *norm_final;
    float* xcur;
    bf16_t* xn;
    bf16_t* hb;
    bf16_t* mix16;
    bf16_t* p16;
    float* sc;
    float* qf;
    float* rstd;
    float* vfirst;
    float* scr;
    float* act;
    float* gate;
    int* idx;
    int B, T, N, pad;
};

HD float sigmoidf_(float x) { return 1.0f / (1.0f + expf(-x)); }
HD float softplusf_(float x) { return log1pf(expf(-fabsf(x))) + fmaxf(x, 0.0f); }
HD float siluf_(float x) { return x * sigmoidf_(x); }
HD float geluf_(float x) { return 0.5f * x * (1.0f + tanhf(0.7978845608028654f * (x + 0.044715f * x * x * x))); }

enum Stage {
    ST_COPYX = 0,
    ST_RSTD, ST_NORM1, ST_GEMM1,
    ST_RW_A0, ST_RW_A1, ST_RW_A2, ST_RW_A3, ST_RW_KKN, ST_RW_SCAN, ST_RW_POST,
    ST_GLA_B0, ST_GLA_SCAN, ST_GLA_POST,
    ST_LRU_C0, ST_LRU_C1, ST_LRU_SCAN,
    ST_GDN_D0, ST_GDN_D1, ST_GDN_SCAN, ST_GDN_POST,
    ST_GEMM2, ST_RSTD2, ST_NORM2, ST_GEMM3, ST_SCORES, ST_TOPK1, ST_TOPK2, ST_PEER_U, ST_PEER_V,
    ST_FRSTD, ST_FNORM,
    ST_COUNT
};

constexpr long SO_ZS = 0, SO_R = 256, SO_DEC = 768, SO_KM = 1280, SO_KK = 1792, SO_A = 2304, SO_G = 2816, SO_V = 3328,
               SO_Y = 3840, SO_VD = 4352, SO_KKINV = 4384;
constexpr long SO_ALPHA = 0, SO_GO = 256;
constexpr long SO_XC = 0, SO_LA = 512, SO_LU = 1024;
constexpr long SO_QKV = 0, SO_GS = 1536, SO_DO = 1552;
constexpr long SCR_PER_TOK = 4400;
constexpr long SO_TS = 0, SO_TI = 256;

HD long stage_items(const Params& P, int st, int l) {
    const long N = P.N;
    switch (st) {
        case ST_COPYX: return N * DM;
        case ST_RSTD: case ST_RSTD2: case ST_FRSTD: return N;
        case ST_NORM1: case ST_NORM2: case ST_FNORM: return N * DM;
        case ST_GEMM1: return (N / 4) * (INC / 4);
        case ST_RW_A0: return N * 256;
        case ST_RW_A1: return N * 512;
        case ST_RW_A2: return l > 0 ? N * 32 : 0;
        case ST_RW_A3: return l > 0 ? N * 512 : 0;
        case ST_RW_KKN: return N * 8;
        case ST_RW_SCAN: return (long)P.B * 512;
        case ST_RW_POST: return N * 8;
        case ST_GLA_B0: return N * 256;
        case ST_GLA_SCAN: return (long)P.B * 512;
        case ST_GLA_POST: return N * 4;
        case ST_LRU_C0: return N * 512;
        case ST_LRU_C1: return N * 512;
        case ST_LRU_SCAN: return (long)P.B * 512;
        case ST_GDN_D0: return N * 1536;
        case ST_GDN_D1: return N * 4;
        case ST_GDN_SCAN: return (long)P.B * 512;
        case ST_GDN_POST: return N * 4;
        case ST_GEMM2: case ST_GEMM3: return (N / 4) * (DM / 4);
        case ST_SCORES: return N * 2048;
        case ST_TOPK1: return N * 16;
        case ST_TOPK2: return N * 8;
        case ST_PEER_U: return N * 128;
        case ST_PEER_V: return N * DM;
    }
    return 0;
}

HD void gemm_item(const bf16_t* A, const float* W, int ldw, const float* kscale, float* Cf, bf16_t* Ch, int ldc, int n4, long item, int mode) {
    const long r4 = item / n4;
    const int c4 = (int)(item % n4);
    const bf16_t* a0 = A + (r4 * 4) * (long)DM;
    const float* w = W + c4 * 4;
    float acc[4][4];
    for (int i = 0; i < 4; ++i)
        for (int j = 0; j < 4; ++j) acc[i][j] = 0.f;
    for (int k = 0; k < DM; ++k) {
        const float ks = kscale ? kscale[k] : 1.0f;
        const float w0 = w[(long)k * ldw + 0] * ks, w1 = w[(long)k * ldw + 1] * ks, w2 = w[(long)k * ldw + 2] * ks, w3 = w[(long)k * ldw + 3] * ks;
#pragma unroll
        for (int i = 0; i < 4; ++i) {
            const float a = bf2f(a0[(long)i * DM + k]);
            acc[i][0] += a * w0; acc[i][1] += a * w1; acc[i][2] += a * w2; acc[i][3] += a * w3;
        }
    }
#pragma unroll
    for (int i = 0; i < 4; ++i) {
        const long o = (r4 * 4 + i) * (long)ldc + c4 * 4;
#pragma unroll
        for (int j = 0; j < 4; ++j) {
            if (mode == 0) Ch[o + j] = f2bf(acc[i][j]);
            else if (mode == 1) Cf[o + j] += acc[i][j];
            else Cf[o + j] = acc[i][j];
        }
    }
}

#define PF(n, col) bf2f(P.p16[(long)(n) * PLD + (col)])
HD float rw_shift(const Params& P, int l, long n, int col) {
    const int t = (int)(n % P.T);
    const float cur = PF(n, C_RW + col);
    const float prev = t > 0 ? PF(n - 1, C_RW + col) : 0.f;
    return cur + (prev - cur) * P.rw_mu[l * 1792 + col];
}

HD void run_item(const Params& P, int st, int l, long it) {
    const long N = P.N;
    float* scr = P.scr;
    switch (st) {
        case ST_COPYX: P.xcur[it] = P.x[it]; break;
        case ST_RSTD: case ST_RSTD2: case ST_FRSTD: {
            const float* xr = P.xcur + it * DM;
            float s = 0.f;
            for (int d = 0; d < DM; ++d) s += xr[d] * xr[d];
            P.rstd[it] = 1.0f / sqrtf(s * (1.0f / DM) + 1e-6f);
        } break;
        case ST_NORM1: case ST_NORM2: case ST_FNORM: {
            const long n = it / DM; const int d = (int)(it % DM);
            if (st == ST_NORM1) P.xn[it] = f2bf(P.xcur[it] * P.rstd[n]);
            else if (st == ST_NORM2) P.hb[it] = f2bf(P.xcur[it] * P.rstd[n] * P.norm_ffn[l * DM + d]);
            else P.xcur[it] = P.xcur[it] * P.rstd[n] * P.norm_final[d];
        } break;
        case ST_GEMM1: gemm_item(P.xn, P.w_in + (long)l * DM * INC, INC, P.norm_mix + l * DM, nullptr, P.p16, PLD, INC / 4, it, 0); break;
        case ST_GEMM2: gemm_item(P.mix16, P.w_out + (long)l * DM * DM, DM, nullptr, P.xcur, nullptr, DM, DM / 4, it, 1); break;
        case ST_GEMM3: gemm_item(P.hb, P.peer_wq + (long)l * DM * DM, DM, nullptr, P.qf, nullptr, DM, DM / 4, it, 2); break;
        case ST_RW_A0: {
            const long n = it / 256; const int c = (int)(it % 256);
            const float z = rw_shift(P, l, n, 1536 + c);
            scr[N * SO_ZS + it] = c < 64 ? tanhf(z) : (c < 128 ? z : sigmoidf_(z));
        } break;
        case ST_RW_A1: {
            const long n = it / 512; const int j = (int)(it % 512);
            const float zr = rw_shift(P, l, n, j), zk = rw_shift(P, l, n, 512 + j), zv = rw_shift(P, l, n, 1024 + j);
            const float* zs = scr + N * SO_ZS + n * 256;
            float aw = P.rw_w0[l * 512 + j], aa = P.rw_a0[l * 512 + j], ag = 0.f;
            const float* wu = P.rw_w_up + (long)l * 64 * 512 + j;
            const float* au = P.rw_a_up + (long)l * 64 * 512 + j;
            const float* gu = P.rw_g_up + (long)l * 128 * 512 + j;
            for (int i = 0; i < 64; ++i) { aw += zs[i] * wu[i * 512]; aa += zs[64 + i] * au[i * 512]; }
            for (int i = 0; i < 128; ++i) ag += zs[128 + i] * gu[i * 512];
            const float w_raw = -softplusf_(-aw) - 0.5f;
            const float a = sigmoidf_(aa);
            scr[N * SO_R + it] = zr;
            scr[N * SO_DEC + it] = expf(-expf(w_raw));
            scr[N * SO_KM + it] = zk * (1.0f + (a - 1.0f) * P.rw_k_a[l * 512 + j]);
            scr[N * SO_KK + it] = zk * P.rw_k_k[l * 512 + j];
            scr[N * SO_A + it] = a;
            scr[N * SO_G + it] = ag;
            scr[N * SO_V + it] = zv;
            if (l == 0) P.vfirst[it] = zv;
        } break;
        case ST_RW_A2: {
            const long n = it / 32; const int i = (int)(it % 32);
            const float* v = scr + N * SO_V + n * 512;
            const float* vdn = P.rw_v_down + (long)(l - 1) * 512 * 32 + i;
            float s = 0.f;
            for (int j = 0; j < 512; ++j) s += v[j] * vdn[j * 32];
            scr[N * SO_VD + it] = s;
        } break;
        case ST_RW_A3: {
            const long n = it / 512; const int j = (int)(it % 512);
            const float* vd = scr + N * SO_VD + n * 32;
            const float* vup = P.rw_v_up + (long)(l - 1) * 32 * 512 + j;
            float s = P.rw_v0[(l - 1) * 512 + j];
            for (int i = 0; i < 32; ++i) s += vd[i] * vup[i * 512];
            const float v = scr[N * SO_V + it];
            scr[N * SO_V + it] = v + (P.vfirst[it] - v) * sigmoidf_(s);
        } break;
        case ST_RW_KKN: {
            const float* kk = scr + N * SO_KK + it * 64;
            float s = 0.f;
            for (int i = 0; i < 64; ++i) s += kk[i] * kk[i];
            scr[N * SO_KKINV + it] = 1.0f / sqrtf(fmaxf(s, 1e-24f));
        } break;
        case ST_RW_SCAN: {
            const int b = (int)(it / 512); const int h = (int)((it % 512) / 64); const int v = (int)(it % 64);
            float S[64];
#pragma unroll
            for (int i = 0; i < 64; ++i) S[i] = 0.f;
            for (int t = 0; t < P.T; ++t) {
                const long n = (long)b * P.T + t;
                const long base = n * 512 + h * 64;
                const float inv = scr[N * SO_KKINV + n * 8 + h];
                const float vv = scr[N * SO_V + base + v];
                const float* KK = scr + N * SO_KK + base;
                const float* DEC = scr + N * SO_DEC + base;
                const float* KM = scr + N * SO_KM + base;
                const float* AA = scr + N * SO_A + base;
                const float* RR = scr + N * SO_R + base;
                float sa = 0.f;
#pragma unroll
                for (int i = 0; i < 64; ++i) sa += S[i] * (-KK[i] * inv);
                float y = 0.f;
#pragma unroll
                for (int i = 0; i < 64; ++i) {
                    const float kk = KK[i] * inv;
                    S[i] = S[i] * DEC[i] + sa * (kk * AA[i]) + vv * KM[i];
                    y += S[i] * RR[i];
                }
                scr[N * SO_Y + base + v] = y;
            }
        } break;
        case ST_RW_POST: {
            const long n = it / 8; const int h = (int)(it % 8);
            const long base = n * 512 + h * 64;
            const float* Y = scr + N * SO_Y + base;
            const float* RR = scr + N * SO_R + base;
            const float* KM = scr + N * SO_KM + base;
            const float* V = scr + N * SO_V + base;
            const float* G = scr + N * SO_G + base;
            float mean = 0.f, bon = 0.f;
            for (int i = 0; i < 64; ++i) { mean += Y[i]; bon += RR[i] * KM[i] * P.rw_r_k[l * 512 + h * 64 + i]; }
            mean *= (1.0f / 64);
            float var = 0.f;
            for (int i = 0; i < 64; ++i) { const float d = Y[i] - mean; var += d * d; }
            const float rs = 1.0f / sqrtf(var * (1.0f / 64) + 64e-5f);
            for (int i = 0; i < 64; ++i) {
                const int c = h * 64 + i;
                const float yn = (Y[i] - mean) * rs * P.rw_ln_w[l * 512 + c] + P.rw_ln_b[l * 512 + c];
                P.mix16[n * DM + c] = f2bf((yn + bon * V[i]) * G[i]);
            }
        } break;
        case ST_GLA_B0: {
            const long n = it / 256; const int c = (int)(it % 256);
            float s = P.gla_a_bias[l * 256 + c];
            for (int i = 0; i < 16; ++i) s += PF(n, C_GLA + 1536 + i) * P.gla_a_up[(long)l * 16 * 256 + i * 256 + c];
            scr[N * SO_ALPHA + it] = expf(-softplusf_(-s) * (1.0f / 16.0f));
        } break;
        case ST_GLA_SCAN: {
            const int b = (int)(it / 512); const int h = (int)((it % 512) / 128); const int v = (int)(it % 128);
            float S[64];
#pragma unroll
            for (int i = 0; i < 64; ++i) S[i] = 0.f;
            for (int t = 0; t < P.T; ++t) {
                const long n = (long)b * P.T + t;
                const bf16_t* q = P.p16 + n * PLD + C_GLA + h * 64;
                const bf16_t* k = q + 256;
                const float vv = PF(n, C_GLA + 512 + h * 128 + v);
                const float* al = scr + N * SO_ALPHA + n * 256 + h * 64;
                float o = 0.f;
#pragma unroll
                for (int i = 0; i < 64; ++i) {
                    S[i] = S[i] * al[i] + bf2f(k[i]) * vv;
                    o += bf2f(q[i]) * S[i];
                }
                scr[N * SO_GO + n * 512 + h * 128 + v] = o * 0.125f;
            }
        } break;
        case ST_GLA_POST: {
            const long n = it / 4; const int h = (int)(it % 4);
            const float* o = scr + N * SO_GO + n * 512 + h * 128;
            float ms = 0.f;
            for (int i = 0; i < 128; ++i) ms += o[i] * o[i];
            const float rs = 1.0f / sqrtf(ms * (1.0f / 128) + 1e-6f);
            for (int i = 0; i < 128; ++i) {
                const float g = PF(n, C_GLA + 1024 + h * 128 + i);
                P.mix16[n * DM + 512 + h * 128 + i] = f2bf(o[i] * rs * P.gla_norm[l * 128 + i] * siluf_(g));
            }
        } break;
        case ST_LRU_C0: {
            const long n = it / 512; const int c = (int)(it % 512);
            const int t = (int)(n % P.T);
            float s = P.lru_conv_b[l * 512 + c];
            for (int j = 0; j < 4; ++j) {
                const int tt = t - 3 + j;
                if (tt >= 0) s += P.lru_conv_w[(long)l * 4 * 512 + j * 512 + c] * PF(n - 3 + j, C_LRU + c);
            }
            scr[N * SO_XC + it] = s;
        } break;
        case ST_LRU_C1: {
            const long n = it / 512; const int c = (int)(it % 512);
            const int blk = c / 64, j = c % 64;
            const float* xc = scr + N * SO_XC + n * 512 + blk * 64;
            const float* wr = P.lru_w_r + (long)l * 8 * 64 * 64 + (long)blk * 64 * 64 + j;
            const float* wi = P.lru_w_i + (long)l * 8 * 64 * 64 + (long)blk * 64 * 64 + j;
            float sr = P.lru_b_r[l * 512 + c], si = P.lru_b_i[l * 512 + c];
            for (int i = 0; i < 64; ++i) { sr += xc[i] * wr[i * 64]; si += xc[i] * wi[i * 64]; }
            const float r = sigmoidf_(sr), ig = sigmoidf_(si);
            const float log_a = -8.0f * r * softplusf_(-P.lru_lam[l * 512 + c]);
            scr[N * SO_LA + it] = expf(log_a);
            scr[N * SO_LU + it] = scr[N * SO_XC + it] * ig * sqrtf(-expm1f(2.0f * log_a));
        } break;
        case ST_LRU_SCAN: {
            const int b = (int)(it / 512); const int c = (int)(it % 512);
            float hst = 0.f;
            for (int t = 0; t < P.T; ++t) {
                const long n = (long)b * P.T + t;
                hst = scr[N * SO_LA + n * 512 + c] * hst + scr[N * SO_LU + n * 512 + c];
                P.mix16[n * DM + 1024 + c] = f2bf(hst * geluf_(PF(n, C_LRU + 512 + c)));
            }
        } break;
        case ST_GDN_D0: {
            const long n = it / 1536; const int c = (int)(it % 1536);
            const int t = (int)(n % P.T);
            float s = 0.f;
            for (int j = 0; j < 4; ++j) {
                const int tt = t - 3 + j;
                if (tt >= 0) s += P.gdn_conv_w[(long)l * 4 * 1536 + j * 1536 + c] * PF(n - 3 + j, C_GDN + c);
            }
            scr[N * SO_QKV + it] = siluf_(s);
        } break;
        case ST_GDN_D1: {
            const long n = it / 4; const int h = (int)(it % 4);
            const float* q = scr + N * SO_QKV + n * 1536 + h * 128;
            const float* k = q + 512;
            float qs = 0.f, ks = 0.f;
            for (int i = 0; i < 128; ++i) { qs += q[i] * q[i]; ks += k[i] * k[i]; }
            float* gs = scr + N * SO_GS + n * 16 + h * 4;
            gs[0] = (1.0f / sqrtf(qs + 1e-6f)) * 0.08838834764831845f;
            gs[1] = 1.0f / sqrtf(ks + 1e-6f);
            gs[2] = sigmoidf_(PF(n, C_GDN + 2048 + h));
            gs[3] = expf(-expf(P.gdn_a_log[l * 4 + h]) * softplusf_(PF(n, C_GDN + 2052 + h) + P.gdn_dt_bias[l * 4 + h]));
        } break;
        case ST_GDN_SCAN: {
            const int b = (int)(it / 512); const int h = (int)((it % 512) / 128); const int v = (int)(it % 128);
            float S[128];
#pragma unroll
            for (int i = 0; i < 128; ++i) S[i] = 0.f;
            for (int t = 0; t < P.T; ++t) {
                const long n = (long)b * P.T + t;
                const float* q = scr + N * SO_QKV + n * 1536 + h * 128;
                const float* k = q + 512;
                const float vv = scr[N * SO_QKV + n * 1536 + 1024 + h * 128 + v];
                const float* gs = scr + N * SO_GS + n * 16 + h * 4;
                const float qinv = gs[0], kinv = gs[1], beta = gs[2], eg = gs[3];
                float dk = 0.f;
#pragma unroll
                for (int i = 0; i < 128; ++i) dk += S[i] * k[i];
                const float u = beta * (vv - eg * kinv * dk) * kinv;
                float o = 0.f;
#pragma unroll
                for (int i = 0; i < 128; ++i) {
                    S[i] = S[i] * eg + u * k[i];
                    o += S[i] * q[i];
                }
                scr[N * SO_DO + n * 512 + h * 128 + v] = o * qinv;
            }
        } break;
        case ST_GDN_POST: {
            const long n = it / 4; const int h = (int)(it % 4);
            const float* o = scr + N * SO_DO + n * 512 + h * 128;
            float ms = 0.f;
            for (int i = 0; i < 128; ++i) ms += o[i] * o[i];
            const float rs = 1.0f / sqrtf(ms * (1.0f / 128) + 1e-6f);
            for (int i = 0; i < 128; ++i) {
                const float z = PF(n, C_GDN + 1536 + h * 128 + i);
                P.mix16[n * DM + 1536 + h * 128 + i] = f2bf(o[i] * rs * P.gdn_norm[l * 128 + i] * siluf_(z));
            }
        } break;
        case ST_SCORES: {
            const long n = it / 2048; const int c = (int)(it % 2048);
            const int hp = c / 128, key = c % 128;
            const float* q = P.qf + n * DM + hp * 128;
            const float* sk = P.peer_sub_keys + (long)l * 16 * 128 * 128 + ((long)hp * 128 + key) * 128;
            float s = 0.f;
            for (int d = 0; d < 128; ++d) s += q[d] * sk[d];
            P.sc[it] = s;
        } break;
        case ST_TOPK1: {
            const float* sc = P.sc + it * 128;
            float ts[16]; int ti[16];
#pragma unroll
            for (int j = 0; j < 16; ++j) { ts[j] = -3.0e38f; ti[j] = 0; }
            for (int i = 0; i < 128; ++i) {
                float xv = sc[i]; int xi = i;
                if (xv > ts[15]) {
#pragma unroll
                    for (int j = 0; j < 16; ++j) {
                        if (xv > ts[j]) { const float tv = ts[j]; const int tj = ti[j]; ts[j] = xv; ti[j] = xi; xv = tv; xi = tj; }
                    }
                }
            }
            float* TS = scr + N * SO_TS + it * 16;
            int* TI = (int*)(scr + N * SO_TI) + it * 16;
#pragma unroll
            for (int j = 0; j < 16; ++j) { TS[j] = ts[j]; TI[j] = ti[j]; }
        } break;
        case ST_TOPK2: {
            const float* s0 = scr + N * SO_TS + it * 32;
            const float* s1 = s0 + 16;
            const int* i0 = (const int*)(scr + N * SO_TI) + it * 32;
            const int* i1 = i0 + 16;
            float ts[16]; int ti[16];
#pragma unroll
            for (int j = 0; j < 16; ++j) { ts[j] = -3.0e38f; ti[j] = 0; }
            for (int a = 0; a < 16; ++a) {
                const int jmax = 16 / (a + 1);
                for (int b = 0; b < jmax; ++b) {
                    float xv = s0[a] + s1[b]; int xi = i0[a] * 128 + i1[b];
                    if (xv > ts[15]) {
#pragma unroll
                        for (int j = 0; j < 16; ++j) {
                            if (xv > ts[j]) { const float tv = ts[j]; const int tj = ti[j]; ts[j] = xv; ti[j] = xi; xv = tv; xi = tj; }
                        }
                    }
                }
            }
            const float mx = ts[0];
            float den = 0.f;
#pragma unroll
            for (int j = 0; j < 16; ++j) { ts[j] = expf(ts[j] - mx); den += ts[j]; }
            const float inv = 1.0f / den;
#pragma unroll
            for (int j = 0; j < 16; ++j) { P.gate[it * 16 + j] = ts[j] * inv; P.idx[it * 16 + j] = ti[j]; }
        } break;
        case ST_PEER_U: {
            const long n = it / 128;
            const int e = P.idx[it];
            const float* u = P.peer_u + ((long)l * NEXP + e) * DM;
            const bf16_t* hx = P.hb + n * DM;
            float s = 0.f;
            for (int d = 0; d < DM; ++d) s += bf2f(hx[d]) * u[d];
            P.act[it] = geluf_(s) * P.gate[it];
        } break;
        case ST_PEER_V: {
            const long n = it / DM; const int d = (int)(it % DM);
            const float* a = P.act + n * 128;
            const int* ix = P.idx + n * 128;
            float s = 0.f;
            for (int j = 0; j < 128; ++j) s += a[j] * P.peer_v[((long)l * NEXP + ix[j]) * DM + d];
            P.xcur[it] += s;
        } break;
    }
}


struct WsMap {
    size_t ctl, w1t, w2t, wsct, auxwt, lruwt, vreswt, pp, tabu, tabv, tsc, ssq, dpart, xn, hb, mix16, p16, sc, aux, vfirst, idx, gate, rstd, act, end;
    size_t auxA, zrkv, xc, auxo, gates, vres, glao, gdno, gq, gk, gv, gsc, rwy, rwbv, lrs, gblob, glas, gladv;
    size_t scr, qf;
};
HD WsMap ws_map(size_t N) {
    WsMap m{};
    size_t o = 0;
    auto take = [&](size_t bytes) { size_t r = o; o += (bytes + 4095) & ~(size_t)4095; return r; };
    m.ctl = take(1u << 20);
    m.w1t = take((size_t)NL * PLD * DM * 2);
    m.w2t = take((size_t)NL * DM * DM * 2);
    m.wsct = take((size_t)NL * DM * DM * 2);
    m.auxwt = take((size_t)NL * 1792 * 384 * 2);
    m.lruwt = take((size_t)NL * 1024 * 512 * 2);
    m.vreswt = take((size_t)512 * 512 * 2);
    m.pp = take(1u << 20);
    m.xn = take(N * DM * 2);
    m.hb = take(N * DM * 2);
    m.mix16 = take(N * DM * 2);
    m.p16 = take(N * PLD * 2);
    m.sc = m.p16;
    m.vfirst = take(N * 512 * 4);
    m.idx = take(N * 128 * 4);
    m.gate = take(N * 128 * 4);
    m.act = take(N * 128 * 4);
    m.rstd = take(N * 4);
    m.tabu = take((size_t)NL * 2 * NEXP * 1024);
    m.tabv = m.tabu + (size_t)NEXP * 1024;
    m.ssq = take(N * 8 * 4);
    m.dpart = m.p16;
    m.tsc = take((size_t)NL * 2 * NEXP * 4);
    m.aux = take(N * 5888 * 4);
    m.end = o;
    size_t a = m.aux;
    auto sub = [&](size_t bytes) { size_t r = a; a += (bytes + 4095) & ~(size_t)4095; return r; };
    m.auxA = sub(N * 384 * 2); m.zrkv = sub(N * 1536 * 2); m.xc = sub(N * 512 * 2); m.auxo = sub(N * 1792 * 2);
    m.gates = sub(N * 1024 * 2); m.vres = sub(N * 512 * 2); m.glao = sub(N * 512 * 2); m.gdno = sub(N * 512 * 2);
    m.gq = sub(N * 512 * 2); m.gk = sub(N * 512 * 2); m.gv = sub(N * 512 * 2); m.gsc = sub(N * 8 * 4); m.rwy = sub(N * 512 * 2); m.rwbv = sub(N * 512 * 2); m.lrs = sub(N / 64 * 512 * 2 * 4);
    m.gblob = sub(N / 64 * 4 * 26880);
    m.glas = sub(N / 64 * 4 * 8192 * 2); m.gladv = sub(N / 64 * 4 * 64 * 4);
    m.scr = m.tabu;
    m.qf = m.aux + N * 3584 * 4;
    return m;
}
static inline void bind_ws(Params& P, char* ws) {
    const WsMap m = ws_map((size_t)P.N);
    P.xn = (bf16_t*)(ws + m.xn); P.hb = (bf16_t*)(ws + m.hb); P.mix16 = (bf16_t*)(ws + m.mix16); P.p16 = (bf16_t*)(ws + m.p16);
    P.sc = (float*)(ws + m.sc); P.qf = (float*)(ws + m.qf); P.rstd = (float*)(ws + m.rstd); P.vfirst = (float*)(ws + m.vfirst);
    P.scr = (float*)(ws + m.scr); P.act = (float*)(ws + m.act); P.gate = (float*)(ws + m.gate); P.idx = (int*)(ws + m.idx);
}

struct Step { int st, l; };
static inline int build_schedule(Step* s) {
    int n = 0;
    s[n++] = {ST_COPYX, 0};
    for (int l = 0; l < NL; ++l) {
        static const int per_layer[] = {ST_RSTD, ST_NORM1, ST_GEMM1,
            ST_RW_A0, ST_RW_A1, ST_RW_A2, ST_RW_A3, ST_RW_KKN, ST_RW_SCAN, ST_RW_POST,
            ST_GLA_B0, ST_GLA_SCAN, ST_GLA_POST, ST_LRU_C0, ST_LRU_C1, ST_LRU_SCAN,
            ST_GDN_D0, ST_GDN_D1, ST_GDN_SCAN, ST_GDN_POST,
            ST_GEMM2, ST_RSTD2, ST_NORM2, ST_GEMM3, ST_SCORES, ST_TOPK1, ST_TOPK2, ST_PEER_U, ST_PEER_V};
        for (int i = 0; i < (int)(sizeof(per_layer) / sizeof(int)); ++i) s[n++] = {per_layer[i], l};
    }
    s[n++] = {ST_FRSTD, 0};
    s[n++] = {ST_FNORM, 0};
    return n;
}

static inline void fill_inputs(Params& P, void* const* d_in) {
    const float** dst = (const float**)&P;
    for (int i = 0; i < 38; ++i) dst[i] = (const float*)d_in[i];
}

#ifndef HOST_EMU
#define GAS __attribute__((address_space(1)))
#define LAS __attribute__((address_space(3)))
typedef unsigned v4u __attribute__((ext_vector_type(4)));
typedef unsigned v2u __attribute__((ext_vector_type(2)));
typedef float f32x4 __attribute__((ext_vector_type(4)));
typedef float f32x2 __attribute__((ext_vector_type(2)));
typedef short bf16x8 __attribute__((ext_vector_type(8)));
constexpr int NWAVES = 8, NTHR = 512;
constexpr int RING_BYTES = 131072, MISC_OFF = RING_BYTES + 320, LDS_BYTES = 147456;
constexpr int NTOK = 16384, TSEQ = 4096, NBATCH = 4;

__device__ __forceinline__ unsigned pk2(float lo, float hi) { return (unsigned)f2bf(lo) | ((unsigned)f2bf(hi) << 16); }
__device__ __forceinline__ float bflo(unsigned u) { return __builtin_bit_cast(float, u << 16); }
__device__ __forceinline__ float bfhi(unsigned u) { return __builtin_bit_cast(float, u & 0xffff0000u); }
__device__ __forceinline__ float wave_sum(float v) {
#pragma unroll
    for (int o = 1; o < 64; o <<= 1) v += __shfl_xor(v, o);
    return v;
}
#define LDS_WAIT() asm volatile("s_waitcnt lgkmcnt(0)" ::: "memory")
#define VM_WAIT() asm volatile("s_waitcnt vmcnt(0)" ::: "memory")

namespace pg8 {
#define PG8_LAS __attribute__((address_space(3)))
constexpr int BM = 256, BK = 64, HALF = 128, HTB = HALF * BK * 2, STAGE_BYTES = 8 * HTB, NXCD = 8, WGM = 8;
__host__ __device__ __forceinline__ int lds_byte(int r, int c) { const int st = (r >> 4) * 2 + (c >> 5), rr = r & 15, cc = c & 31, ob = rr * 64 + cc * 2; return st * 1024 + (ob ^ (((ob >> 9) & 1) << 5)); }
__host__ __device__ __forceinline__ void stage_rc(int b, int& R, int& C) { const int st = b / 1024, sb = b % 1024, swz = sb ^ (((sb >> 9) & 1) << 5); R = (st >> 1) * 16 + swz / 64; C = (st & 1) * 32 + (swz % 64) / 2; }
__host__ __device__ __forceinline__ int perm32(int rho) { const int n = rho >> 4, i = rho & 15; return 8 * (i >> 2) + 4 * n + (i & 3); }
struct Unit { int pm, pn; };
struct GemmX { const bf16_t* A; const bf16_t* Bt; int M, N, K, lda; };
struct StaticOrder {
    int nM, nN, nwg, G, c;
    __host__ __device__ void init(int M, int N, int G_, int c_) { nM = M / BM; nN = N / BM; nwg = nM * nN; G = G_; c = c_; }
    __host__ __device__ bool next(int i, Unit& u) const {
        const long L = (long)i * G + c; if (L >= nwg) return false;
        int wgid = (int)L; { const int q = nwg / NXCD, r = nwg % NXCD, xcd = wgid % NXCD, off = wgid / NXCD; wgid = (xcd < r ? xcd * (q + 1) : r * (q + 1) + (xcd - r) * q) + off; }
        const int nig = WGM * nN, gid = wgid / nig, fm = gid * WGM, gsz = (nM - fm) < WGM ? (nM - fm) : WGM;
        u.pm = fm + ((wgid % nig) % gsz); u.pn = (wgid % nig) / gsz; return true;
    }
    __device__ __forceinline__ void a_ready(const Unit&) const {}
    __device__ __forceinline__ void done(const Unit&) const {}
};
__device__ __forceinline__ unsigned cvt_pk_bf16(float lo, float hi) { unsigned r; asm volatile("v_cvt_pk_bf16_f32 %0, %1, %2" : "=v"(r) : "v"(lo), "v"(hi)); return r; }
template <bool ACCUM> struct EpiF32 {
    static constexpr bool PERM = false, AFTER_DRAIN = false;
    float* C; int ldc;
    __device__ __forceinline__ void operator()(const f32x4 (&acc)[2][2][4][2], const Unit& u, int wr, int wc, int fr, int fq) const {
        const int row0 = u.pm * BM + wr * 64 + fr, col0 = u.pn * BM + wc * 32 + 4 * fq;
#pragma unroll
        for (int ai = 0; ai < 2; ++ai)
#pragma unroll
            for (int m = 0; m < 4; ++m) { float* rowp = C + (size_t)(row0 + ai * HALF + m * 16) * ldc + col0;
#pragma unroll
                for (int bj = 0; bj < 2; ++bj)
#pragma unroll
                    for (int n = 0; n < 2; ++n) { f32x4* p = (f32x4*)(rowp + bj * HALF + n * 16);
                        if (ACCUM) *p = *p + acc[ai][bj][m][n]; else *p = acc[ai][bj][m][n]; } }
    }
};
struct EpiBf16 {
    static constexpr bool PERM = true, AFTER_DRAIN = false;
    bf16_t* O; int ldc; const float* bias; const float* ssq = nullptr;
    __device__ __forceinline__ void operator()(const f32x4 (&acc)[2][2][4][2], const Unit& u, int wr, int wc, int fr, int fq) const {
        const int row0 = u.pm * BM + wr * 64 + fr; const int col0 = u.pn * BM + wc * 32 + 8 * fq;
        float rs[2][4];
#pragma unroll
        for (int ai = 0; ai < 2; ++ai)
#pragma unroll
            for (int m = 0; m < 4; ++m) { rs[ai][m] = 1.0f;
                if (ssq) { const f32x4* sp = (const f32x4*)(ssq + (size_t)(row0 + ai * HALF + m * 16) * 8); const f32x4 s0 = sp[0], s1 = sp[1];
                    rs[ai][m] = 1.0f / sqrtf((((s0.x + s0.y) + (s0.z + s0.w)) + ((s1.x + s1.y) + (s1.z + s1.w))) * (1.0f / 2048.0f) + 1e-6f); } }
        f32x4 bv[2][2];
#pragma unroll
        for (int bj = 0; bj < 2; ++bj)
#pragma unroll
            for (int n = 0; n < 2; ++n) bv[bj][n] = bias ? *(const f32x4*)(bias + col0 + bj * HALF + 4 * n) : (f32x4){0.f, 0.f, 0.f, 0.f};
#pragma unroll
        for (int ai = 0; ai < 2; ++ai)
#pragma unroll
            for (int m = 0; m < 4; ++m) { bf16_t* rowp = O + (size_t)(row0 + ai * HALF + m * 16) * ldc + col0;
#pragma unroll
                for (int bj = 0; bj < 2; ++bj) { const f32x4 v0 = acc[ai][bj][m][0] * rs[ai][m] + bv[bj][0], v1 = acc[ai][bj][m][1] * rs[ai][m] + bv[bj][1];
                    v4u w; w.x = cvt_pk_bf16(v0[0], v0[1]); w.y = cvt_pk_bf16(v0[2], v0[3]); w.z = cvt_pk_bf16(v1[0], v1[1]); w.w = cvt_pk_bf16(v1[2], v1[3]);
                    *(v4u*)(rowp + bj * HALF) = w; } }
    }
};
template <class Epi, class Sched, bool ALIGN_EPI = false, bool SP2 = false>
__device__ __forceinline__ void gemm_phase(PG8_LAS unsigned char* lds, const GemmX g, const Sched& S, const Epi& E) {
    const int tid = threadIdx.x, wid = __builtin_amdgcn_readfirstlane(tid >> 6), lane = tid & 63, wr = wid >> 2, wc = wid & 3, fr = lane & 15, fq = lane >> 4;
    const int K = g.K, nt = K / BK;
    unsigned voffA[2], voffB[2];
#pragma unroll
    for (int i = 0; i < 2; ++i) { int R, C; stage_rc(tid * 16 + i * 8192, R, C); const int Rb = Epi::PERM ? ((R & ~31) + perm32(R & 31)) : R;
        voffA[i] = (unsigned)(R * g.lda + C) * 2u; voffB[i] = (unsigned)(Rb * K + C) * 2u; }
    const size_t kstep = (size_t)(BK * 2);
    const size_t hstep = (size_t)HALF * K * 2;
    const size_t tstep = 2 * hstep;
    const size_t hstepA = (size_t)HALF * g.lda * 2, tstepA = 2 * hstepA;
    const unsigned ldsw = (unsigned)wid * 1024u;
    const int aoff = lds_byte(wr * 64 + fr, fq * 8), boff = lds_byte(wc * 32 + fr, fq * 8);
#define PG8_SA(b, h) (((b) * 2 + (h)) * HTB)
#define PG8_SB(b, h) ((4 + (b) * 2 + (h)) * HTB)
#define PG8_STAGE(bufoff, gbase, voff) do { _Pragma("unroll") for (int _i = 0; _i < 2; ++_i) \
        __builtin_amdgcn_global_load_lds((const unsigned*)((const char*)(gbase) + (voff)[_i]), (PG8_LAS unsigned*)(lds + (bufoff) + ldsw + _i * 8192), 16, 0, 0); } while (0)
#define PG8_LDA(dst, b, h) do { _Pragma("unroll") for (int m = 0; m < 4; ++m) _Pragma("unroll") for (int k = 0; k < 2; ++k) dst[m][k] = *(const PG8_LAS bf16x8*)(lds + PG8_SA(b, h) + aoff + m * 2048 + k * 1024); } while (0)
#define PG8_LDB(dst, b, h) do { _Pragma("unroll") for (int n = 0; n < 2; ++n) _Pragma("unroll") for (int k = 0; k < 2; ++k) dst[n][k] = *(const PG8_LAS bf16x8*)(lds + PG8_SB(b, h) + boff + n * 2048 + k * 1024); } while (0)
#define PG8_MMA(ai, bj, At, Bt) do { __builtin_amdgcn_s_setprio(1); _Pragma("unroll") for (int m = 0; m < 4; ++m) _Pragma("unroll") for (int n = 0; n < 2; ++n) _Pragma("unroll") for (int k = 0; k < 2; ++k) \
        acc[ai][bj][m][n] = __builtin_amdgcn_mfma_f32_16x16x32_bf16(Bt[n][k], At[m][k], acc[ai][bj][m][n], 0, 0, 0); __builtin_amdgcn_s_setprio(0); } while (0)
#define PG8_WAIT_V(n) asm volatile("s_waitcnt vmcnt(" #n ")" ::: "memory")
#define PG8_WAIT_L(n) asm volatile("s_waitcnt lgkmcnt(" #n ")" ::: "memory")
#define PG8_BAR __builtin_amdgcn_s_barrier()
#define PG8_SCHED __builtin_amdgcn_sched_barrier(0)
    Unit cur, nxt; int ui = 0;
    if (!S.next(0, cur)) return;
    f32x4 acc[2][2][4][2];
#pragma unroll
    for (int a = 0; a < 2; ++a)
#pragma unroll
        for (int b = 0; b < 2; ++b)
#pragma unroll
            for (int m = 0; m < 4; ++m)
#pragma unroll
                for (int n = 0; n < 2; ++n) acc[a][b][m][n] = (f32x4){0.f, 0.f, 0.f, 0.f};
    bf16x8 At[4][2], B0[2][2], B1[2][2];
    const char* cA = (const char*)g.A + (size_t)cur.pm * tstepA; const char* cB = (const char*)g.Bt + (size_t)cur.pn * tstep;
    S.a_ready(cur);
    if constexpr (SP2) {
        PG8_STAGE(PG8_SB(0, 0), cB, voffB); PG8_STAGE(PG8_SB(0, 1), cB + hstep, voffB); PG8_STAGE(PG8_SA(0, 0), cA, voffA); PG8_STAGE(PG8_SA(0, 1), cA + hstepA, voffA);
        if (wr == 1) PG8_BAR;
        PG8_WAIT_V(2); PG8_BAR;
        PG8_STAGE(PG8_SB(1, 0), cB + kstep, voffB); PG8_STAGE(PG8_SA(1, 0), cA + kstep, voffA); PG8_STAGE(PG8_SB(1, 1), cB + hstep + kstep, voffB);
        PG8_WAIT_V(6); PG8_BAR;
    } else {
        PG8_STAGE(PG8_SB(0, 0), cB, voffB); PG8_STAGE(PG8_SA(0, 0), cA, voffA); PG8_STAGE(PG8_SB(0, 1), cB + hstep, voffB); PG8_STAGE(PG8_SA(0, 1), cA + hstepA, voffA);
        if (wr == 1) PG8_BAR;
        PG8_WAIT_V(4); PG8_BAR;
        PG8_STAGE(PG8_SB(1, 0), cB + kstep, voffB); PG8_STAGE(PG8_SA(1, 0), cA + kstep, voffA); PG8_STAGE(PG8_SB(1, 1), cB + hstep + kstep, voffB);
        PG8_WAIT_V(6); PG8_BAR;
    }
    for (;;) {
        const bool has_next = S.next(ui + 1, nxt);
        const char* nA = has_next ? (const char*)g.A + (size_t)nxt.pm * tstepA : cA; const char* nB = has_next ? (const char*)g.Bt + (size_t)nxt.pn * tstep : cB;
        for (int t = 0; t < nt; t += 2) {
            const bool last = (t == nt - 2);
            const char* a1 = cA + (size_t)(t + 1) * kstep;
            const char* a2 = last ? nA : cA + (size_t)(t + 2) * kstep; const char* b2 = last ? nB : cB + (size_t)(t + 2) * kstep;
            const char* a3 = a2 + kstep; const char* b3 = b2 + kstep;
            if (last && has_next) S.a_ready(nxt);
            if constexpr (SP2) {
            PG8_LDB(B0, 0, 0); PG8_LDB(B1, 0, 1); PG8_SCHED; PG8_LDA(At, 0, 0); PG8_STAGE(PG8_SA(1, 1), a1 + hstepA, voffA);
            PG8_WAIT_V(8); PG8_WAIT_L(0); PG8_BAR; PG8_MMA(0, 0, At, B0); PG8_MMA(0, 1, At, B1); PG8_BAR; PG8_SCHED;
            PG8_LDA(At, 0, 1); PG8_STAGE(PG8_SB(0, 0), b2, voffB); PG8_STAGE(PG8_SB(0, 1), b2 + hstep, voffB); PG8_STAGE(PG8_SA(0, 0), a2, voffA);
            PG8_WAIT_V(8); PG8_WAIT_L(0); PG8_BAR; PG8_MMA(1, 0, At, B0); PG8_MMA(1, 1, At, B1); PG8_BAR; PG8_SCHED;
            PG8_LDB(B0, 1, 0); PG8_LDB(B1, 1, 1); PG8_SCHED; PG8_LDA(At, 1, 0); PG8_STAGE(PG8_SA(0, 1), a2 + hstepA, voffA);
            PG8_WAIT_V(8); PG8_WAIT_L(0); PG8_BAR; PG8_MMA(0, 0, At, B0); PG8_MMA(0, 1, At, B1); PG8_BAR; PG8_SCHED;
            PG8_LDA(At, 1, 1); PG8_STAGE(PG8_SB(1, 0), b3, voffB); PG8_STAGE(PG8_SB(1, 1), b3 + hstep, voffB); PG8_STAGE(PG8_SA(1, 0), a3, voffA);
            PG8_WAIT_V(8); PG8_WAIT_L(0); PG8_BAR; PG8_MMA(1, 0, At, B0); PG8_MMA(1, 1, At, B1); PG8_BAR; PG8_SCHED;
            } else {
            PG8_LDB(B0, 0, 0); PG8_SCHED; PG8_LDA(At, 0, 0); PG8_STAGE(PG8_SA(1, 1), a1 + hstepA, voffA);
            PG8_WAIT_L(8); PG8_BAR; PG8_WAIT_L(0); PG8_MMA(0, 0, At, B0); PG8_BAR; PG8_SCHED;
            PG8_LDB(B1, 0, 1); PG8_STAGE(PG8_SB(0, 0), b2, voffB);
            PG8_BAR; PG8_WAIT_L(0); PG8_MMA(0, 1, At, B1); PG8_BAR;
            PG8_LDA(At, 0, 1); PG8_STAGE(PG8_SA(0, 0), a2, voffA);
            PG8_BAR; PG8_WAIT_L(0); PG8_MMA(1, 0, At, B0); PG8_BAR; PG8_SCHED;
            PG8_STAGE(PG8_SB(0, 1), b2 + hstep, voffB);
            PG8_WAIT_V(6); PG8_BAR; PG8_MMA(1, 1, At, B1); PG8_BAR;
            PG8_LDB(B0, 1, 0); PG8_SCHED; PG8_LDA(At, 1, 0); PG8_STAGE(PG8_SA(0, 1), a2 + hstepA, voffA);
            PG8_WAIT_L(8); PG8_BAR; PG8_WAIT_L(0); PG8_MMA(0, 0, At, B0); PG8_BAR; PG8_SCHED;
            PG8_LDB(B1, 1, 1); PG8_STAGE(PG8_SB(1, 0), b3, voffB);
            PG8_BAR; PG8_WAIT_L(0); PG8_MMA(0, 1, At, B1); PG8_BAR;
            PG8_LDA(At, 1, 1); PG8_STAGE(PG8_SA(1, 0), a3, voffA);
            PG8_BAR; PG8_WAIT_L(0); PG8_MMA(1, 0, At, B0); PG8_BAR; PG8_SCHED;
            PG8_STAGE(PG8_SB(1, 1), b3 + hstep, voffB);
            PG8_WAIT_V(6); PG8_BAR; PG8_MMA(1, 1, At, B1); PG8_BAR;
            }
        }
        if constexpr (ALIGN_EPI) { if (wr == 0) PG8_BAR; }
        if constexpr (!Epi::AFTER_DRAIN) { E(acc, cur, wr, wc, fr, fq); S.done(cur); }
        if (!has_next) break;
#pragma unroll
        for (int a = 0; a < 2; ++a)
#pragma unroll
            for (int b = 0; b < 2; ++b)
#pragma unroll
                for (int m = 0; m < 4; ++m)
#pragma unroll
                    for (int n = 0; n < 2; ++n) acc[a][b][m][n] = (f32x4){0.f, 0.f, 0.f, 0.f};
        cur = nxt; cA = nA; cB = nB; ++ui;
        if constexpr (ALIGN_EPI) { if (wr == 1) PG8_BAR; }
    }
    PG8_WAIT_V(0);
    if constexpr (!ALIGN_EPI) { if (wr == 0) PG8_BAR; }
    PG8_BAR;
    if constexpr (Epi::AFTER_DRAIN) { E.fused(acc, cur, wr, wc, fr, fq, lds, wid, lane); S.done(cur); }
#undef PG8_SA
#undef PG8_SB
#undef PG8_STAGE
#undef PG8_LDA
#undef PG8_LDB
#undef PG8_MMA
#undef PG8_WAIT_V
#undef PG8_WAIT_L
#undef PG8_BAR
#undef PG8_SCHED
}
}

#define XB_TMO      128
#define XB_XCNT(j)  (256  + 64 * (j))
#define XB_XSUB(j)  (1280 + 64 * (j))
#define XB_XGEN(j)  (2304 + 64 * (j))
#define XB_TOP      3328
#define XB_TOPGEN   3392
#define XCD_BAR_WORDS 3456
#define XB_SPIN_CAP (1u << 20)
__device__ __forceinline__ unsigned xb_ld(unsigned* p) { return __hip_atomic_load(p, __ATOMIC_RELAXED, __HIP_MEMORY_SCOPE_AGENT); }
__device__ __forceinline__ unsigned xb_add(unsigned* p, unsigned v) { return __hip_atomic_fetch_add(p, v, __ATOMIC_RELAXED, __HIP_MEMORY_SCOPE_AGENT); }
__device__ __forceinline__ unsigned xb_xcc_id() { return (unsigned)__builtin_amdgcn_s_getreg((3 << 11) | 20) & 0xFu; }
#define XB_SPIN(cond, bar) do { unsigned _sp = 0; while (cond) { __builtin_amdgcn_s_sleep(1); \
    if ((++_sp & 255u) == 0u) { if (xb_ld(&(bar)[XB_TMO])) break; if (_sp > XB_SPIN_CAP) { atomicAdd(&(bar)[XB_TMO], 1u); break; } } } } while (0)
struct XcdBarrier { unsigned* bar; unsigned x; volatile LAS unsigned* st; };
__device__ __forceinline__ XcdBarrier xcd_barrier_post(unsigned* bar, volatile LAS unsigned* st) {
    XcdBarrier b; b.bar = bar; b.x = xb_xcc_id(); b.st = st;
    if (threadIdx.x == 0) (void)xb_add(&bar[XB_XCNT(b.x)], 1u);
    return b;
}
__device__ __forceinline__ void xcd_barrier_complete(unsigned* bar, unsigned x, unsigned& nloc, unsigned& nx) {
    const unsigned G = gridDim.x * gridDim.y * gridDim.z;
    unsigned sum, cnt, mine, sp = 0u;
    for (;;) {
        sum = 0u; cnt = 0u; mine = 0u;
#pragma unroll
        for (unsigned j = 0; j < 16; ++j) { const unsigned c = xb_ld(&bar[XB_XCNT(j)]); sum += c; cnt += (c > 0u) ? 1u : 0u; mine = (j == x) ? c : mine; }
        if (sum == G) break;
        __builtin_amdgcn_s_sleep(1);
        if ((++sp & 255u) == 0u) { if (xb_ld(&bar[XB_TMO])) break; if (sp > XB_SPIN_CAP) { atomicAdd(&bar[XB_TMO], 1u); break; } }
    }
    nloc = mine > 0u ? mine : 1u; nx = cnt > 0u ? cnt : 1u;
}
__device__ __forceinline__ void xcd_barrier(const XcdBarrier& b) {
    asm volatile("s_waitcnt vmcnt(0)" ::: "memory");
    __syncthreads();
    if (threadIdx.x == 0) {
        unsigned* bar = b.bar;
        __builtin_amdgcn_s_waitcnt(0);
        unsigned nloc = b.st[0], nx = b.st[1];
        if (nloc == 0u) { xcd_barrier_complete(bar, b.x, nloc, nx); b.st[0] = nloc; b.st[1] = nx; }
        const unsigned old = xb_add(&bar[XB_XSUB(b.x)], 1u);
        const unsigned gen = old / nloc;
        if (old + 1u == (gen + 1u) * nloc) {
            __builtin_amdgcn_fence(__ATOMIC_RELEASE, "agent");
            asm volatile("s_waitcnt vmcnt(0)" ::: "memory");
            const unsigned og = xb_add(&bar[XB_TOP], 1u);
            const unsigned tg = og / nx;
            if (og + 1u == (tg + 1u) * nx) xb_add(&bar[XB_TOPGEN], 1u);
            else XB_SPIN(xb_ld(&bar[XB_TOPGEN]) == tg, bar);
            __builtin_amdgcn_fence(__ATOMIC_ACQUIRE, "agent");
            xb_add(&bar[XB_XGEN(b.x)], 1u);
            asm volatile("s_waitcnt vmcnt(0)" ::: "memory");
        } else {
            XB_SPIN(xb_ld(&bar[XB_XGEN(b.x)]) == gen, bar);
            __builtin_amdgcn_fence(__ATOMIC_ACQUIRE, "agent");
            asm volatile("s_waitcnt vmcnt(0)" ::: "memory");
        }
    }
    __syncthreads();
}

struct Args { const float* in[38]; float* out; unsigned char* ws; int ph_lo, ph_hi, li, pad; };
enum InputId { I_X = 0, I_NORM_MIX, I_W_IN, I_W_OUT, I_RW_MU, I_RW_W0, I_RW_W_UP, I_RW_A0, I_RW_A_UP, I_RW_G_UP, I_RW_K_K, I_RW_K_A, I_RW_R_K,
    I_RW_LN_W, I_RW_LN_B, I_RW_V0, I_RW_V_DOWN, I_RW_V_UP, I_GLA_A_UP, I_GLA_A_BIAS, I_GLA_NORM, I_LRU_CONV_W, I_LRU_CONV_B, I_LRU_W_R,
    I_LRU_B_R, I_LRU_W_I, I_LRU_B_I, I_LRU_LAM, I_GDN_CONV_W, I_GDN_A_LOG, I_GDN_DT_BIAS, I_GDN_NORM, I_NORM_FFN, I_PEER_WQ, I_PEER_SK,
    I_PEER_U, I_PEER_V, I_NORM_FINAL };
enum { PH_P0 = 0, PH_GEMM1 = 1, PH_PREP = 2, PH_AUX = 3, PH_SCAN = 4, PH_POST = 5, PH_GEMM2 = 6, PH_NORM2 = 7, PH_GEMM3 = 8, PH_TOPK = 9, PH_PEERU = 10, PH_PEERC = 11, PH_PEERV = 12, PH_PER_LAYER = 12, PH_FNORM = 25, PH_TOTAL = 26 };

struct Frame {
    LAS unsigned char* lds;
    int tid, lane, wave, vcu, G;
    int gw, ngw;
};

__device__ __forceinline__ void p0_transpose_item(const float* W, int K, int N, const float* kscale, bf16_t* WT, LAS float* scr, int item, int nblk, int lane) {
    const int kb = item / nblk, nb = item % nblk, k0 = 64 * kb, n0 = 32 * nb;
    const int kr = lane >> 3, n4 = (lane & 7) * 4;
    f32x4 v[8];
#pragma unroll
    for (int i = 0; i < 8; ++i) { const int kk = kr + 8 * i;
        v[i] = (n0 + n4 < N) ? *(const f32x4*)(W + (size_t)(k0 + kk) * N + n0 + n4) : (f32x4){0.f, 0.f, 0.f, 0.f}; }
#pragma unroll
    for (int i = 0; i < 8; ++i) { const int kk = kr + 8 * i; const float s = kscale ? kscale[k0 + kk] : 1.0f;
        scr[kk * 33 + n4 + 0] = v[i].x * s; scr[kk * 33 + n4 + 1] = v[i].y * s; scr[kk * 33 + n4 + 2] = v[i].z * s; scr[kk * 33 + n4 + 3] = v[i].w * s; }
    LDS_WAIT(); asm volatile("" ::: "memory");
    const int c = lane & 7;
#pragma unroll
    for (int j = 0; j < 4; ++j) { const int n = (lane >> 3) + 8 * j; const LAS float* s = scr + (8 * c) * 33 + n;
        v4u o; o.x = pk2(s[0 * 33], s[1 * 33]); o.y = pk2(s[2 * 33], s[3 * 33]); o.z = pk2(s[4 * 33], s[5 * 33]); o.w = pk2(s[6 * 33], s[7 * 33]);
        *(v4u*)(WT + (size_t)(n0 + n) * K + k0 + 8 * c) = o; }
    LDS_WAIT(); asm volatile("" ::: "memory");
}

__device__ __forceinline__ void p0_prologue(const Args& a, Frame& F) {
    const WsMap m = ws_map(NTOK);
    unsigned char* ws = a.ws;
    LAS float* scr = (LAS float*)(F.lds + F.wave * 16384);
    const int gw = F.gw, NGW = F.ngw, lane = F.lane;
    for (int n = gw; n < NTOK; n += NGW) {
        const f32x4* xr = (const f32x4*)(a.in[I_X] + (size_t)n * DM) + lane;
        f32x4 v[8]; float s = 0.f;
#pragma unroll
        for (int j = 0; j < 8; ++j) { v[j] = xr[64 * j]; s += (v[j].x * v[j].x + v[j].y * v[j].y) + (v[j].z * v[j].z + v[j].w * v[j].w); }
        const float rstd = 1.0f / sqrtf(wave_sum(s) * (1.0f / DM) + 1e-6f);
        f32x4* xo = (f32x4*)(a.out + (size_t)n * DM) + lane;
        v2u* o8 = (v2u*)((bf16_t*)(ws + m.xn) + (size_t)n * DM) + lane;
#pragma unroll
        for (int j = 0; j < 8; ++j) { xo[64 * j] = v[j]; v2u w; w.x = pk2(v[j].x * rstd, v[j].y * rstd); w.y = pk2(v[j].z * rstd, v[j].w * rstd); o8[64 * j] = w; }
    }
    {
        constexpr int I1 = (DM / 64) * (PLD / 32), I2 = (DM / 64) * (DM / 32);
        for (int it = gw; it < NL * (I1 + I2); it += NGW) {
            const int l = it / (I1 + I2); int r = it % (I1 + I2);
            if (r < I1) p0_transpose_item(a.in[I_W_IN] + (size_t)l * DM * INC, DM, INC, a.in[I_NORM_MIX] + l * DM, (bf16_t*)(ws + m.w1t) + (size_t)l * PLD * DM, scr, r, PLD / 32, lane);
            else p0_transpose_item(a.in[I_W_OUT] + (size_t)l * DM * DM, DM, DM, nullptr, (bf16_t*)(ws + m.w2t) + (size_t)l * DM * DM, scr, r - I1, DM / 32, lane);
        }
    }
    for (int it = gw; it < NL * 16 * 64; it += NGW) {
        const int l = it / 1024, hp = (it % 1024) / 64, kb = it % 64;
        const int dh = lane & 1, kk = kb * 32 + (lane >> 1);
        const float* wq = a.in[I_PEER_WQ] + (size_t)l * DM * DM + (size_t)kk * DM + hp * 128 + dh * 64;
        const float* sk = a.in[I_PEER_SK] + ((size_t)l * 16 + hp) * 128 * 128;
        f32x4 q[16];
#pragma unroll
        for (int d = 0; d < 16; ++d) q[d] = *(const f32x4*)(wq + 4 * d);
        bf16_t* o = (bf16_t*)(ws + m.wsct) + (size_t)l * DM * DM + (size_t)(hp * 128) * DM + kk;
        f32x4 stg[8];
#pragma unroll
        for (int i = 0; i < 8; ++i) stg[i] = ((const f32x4*)sk)[i * 64 + lane];
#pragma unroll 1
        for (int kc = 0; kc < 8; ++kc) {
#pragma unroll
            for (int i = 0; i < 8; ++i) ((LAS f32x4*)scr)[i * 64 + lane] = stg[i];
            if (kc + 1 < 8) {
#pragma unroll
                for (int i = 0; i < 8; ++i) stg[i] = ((const f32x4*)(sk + (kc + 1) * 2048))[i * 64 + lane]; }
            LDS_WAIT(); asm volatile("" ::: "memory");
#pragma unroll 2
            for (int key = 0; key < 16; ++key) {
                const LAS f32x4* s4 = (const LAS f32x4*)(scr + key * 128 + dh * 64);
                float acc = 0.f;
#pragma unroll
                for (int d = 0; d < 16; ++d) { const f32x4 sv = s4[d]; acc += (q[d].x * sv.x + q[d].y * sv.y) + (q[d].z * sv.z + q[d].w * sv.w); }
                acc += __shfl_xor(acc, 1);
                if (dh == 0) o[(size_t)(kc * 16 + key) * DM] = f2bf(acc);
            }
            LDS_WAIT(); asm volatile("" ::: "memory");
        }
    }
    {
        const int gt = F.vcu * NTHR + F.tid, GT = F.G * NTHR;
        bf16_t* AW = (bf16_t*)(ws + m.auxwt); bf16_t* LW = (bf16_t*)(ws + m.lruwt); bf16_t* VW = (bf16_t*)(ws + m.vreswt); float* PP = (float*)(ws + m.pp);
        for (int it = gt; it < NL * 1792 * 384; it += GT) {
            const int l = it / (1792 * 384), r = it % (1792 * 384), n = r / 384, k = r % 384;
            float v = 0.f;
            if (n < 512) { if (k < 64) v = a.in[I_RW_W_UP][(size_t)l * 64 * 512 + k * 512 + n]; }
            else if (n < 1024) { if (k >= 64 && k < 128) v = a.in[I_RW_A_UP][(size_t)l * 64 * 512 + (k - 64) * 512 + (n - 512)]; }
            else if (n < 1536) { if (k >= 128 && k < 256) v = a.in[I_RW_G_UP][(size_t)l * 128 * 512 + (k - 128) * 512 + (n - 1024)]; }
            else { if (k >= 256 && k < 272) v = a.in[I_GLA_A_UP][(size_t)l * 16 * 256 + (k - 256) * 256 + (n - 1536)]; }
            AW[it] = f2bf(v);
        }
        for (int it = gt; it < NL * 1024 * 512; it += GT) {
            const int l = it / (1024 * 512), r = it % (1024 * 512), n = r / 512, k = r % 512;
            const int nn = n & 511, blk = nn >> 6, j = nn & 63;
            float v = 0.f;
            if ((k >> 6) == blk) v = (n < 512 ? a.in[I_LRU_W_R] : a.in[I_LRU_W_I])[(size_t)l * 8 * 64 * 64 + (size_t)blk * 4096 + (k & 63) * 64 + j];
            LW[it] = f2bf(v);
        }
        for (int it = gt; it < 512 * 512; it += GT) {
            const int n = it / 512, k = it % 512;
            float s = 0.f;
            for (int i = 0; i < 32; ++i) s += a.in[I_RW_V_DOWN][k * 32 + i] * a.in[I_RW_V_UP][i * 512 + n];
            VW[it] = f2bf(s);
        }
        for (int it = gt; it < 6144; it += GT) {
            float v = 0.f;
            if (it < 3584) { const int l = it / 1792, c = it % 1792;
                v = c < 512 ? a.in[I_RW_W0][l * 512 + c] : (c < 1024 ? a.in[I_RW_A0][l * 512 + c - 512] : (c < 1536 ? 0.f : a.in[I_GLA_A_BIAS][l * 256 + c - 1536])); }
            else if (it < 5632) { const int l = (it - 3584) / 1024, c = (it - 3584) % 1024; v = c < 512 ? a.in[I_LRU_B_R][l * 512 + c] : a.in[I_LRU_B_I][l * 512 + c - 512]; }
            else v = a.in[I_RW_V0][it - 5632];
            PP[it] = v;
        }
    }
}

__device__ __forceinline__ unsigned pk4_fp8(float a, float b, float c, float d) {
    int w = 0;
    w = __builtin_amdgcn_cvt_pk_fp8_f32(__builtin_fmaxf(__builtin_fminf(a, 448.f), -448.f), __builtin_fmaxf(__builtin_fminf(b, 448.f), -448.f), w, false);
    w = __builtin_amdgcn_cvt_pk_fp8_f32(__builtin_fmaxf(__builtin_fminf(c, 448.f), -448.f), __builtin_fmaxf(__builtin_fminf(d, 448.f), -448.f), w, true);
    return (unsigned)w;
}
constexpr size_t TSL = 128;
constexpr float TSTEP = 0.3352f;

template <int CTRL> __device__ __forceinline__ float dpp_f(float v) { return __builtin_bit_cast(float, __builtin_amdgcn_update_dpp(0, __builtin_bit_cast(int, v), CTRL, 0xF, 0xF, true)); }
__device__ __forceinline__ float rdlane_f(float v, int l) { return __builtin_bit_cast(float, __builtin_amdgcn_readlane(__builtin_bit_cast(int, v), l)); }
__device__ __forceinline__ float row16_sum(float v) {
    v += dpp_f<0xB1>(v); v += dpp_f<0x4E>(v); v += dpp_f<0x141>(v); v += dpp_f<0x140>(v); return v;
}
__device__ __forceinline__ float wave_sum_u(float v) {
    v = row16_sum(v);
    return (rdlane_f(v, 0) + rdlane_f(v, 16)) + (rdlane_f(v, 32) + rdlane_f(v, 48));
}
typedef __bf16 bf16x2_t __attribute__((ext_vector_type(2)));
__device__ __forceinline__ float dot2bf(unsigned w, unsigned x, float acc) { return __builtin_amdgcn_fdot2_f32_bf16(__builtin_bit_cast(bf16x2_t, w), __builtin_bit_cast(bf16x2_t, x), acc, false); }
__device__ __forceinline__ void tables_range(const Args& a, Frame& F, size_t it0, size_t it1, int sub, int nsub) {
    const WsMap m = ws_map(NTOK);
    const size_t per = (size_t)NEXP * DM / 32;
    const size_t stride = (size_t)nsub * NTHR;
    float* tsc = (float*)(a.ws + m.tsc);
    for (size_t base = it0 + (size_t)sub * NTHR + F.tid; base < it1; base += 2 * stride) {
        f32x4 v[2][8];
#pragma unroll
        for (int u = 0; u < 2; ++u) { const size_t it = base + u * stride;
            if (it < it1) { const int tb = (int)(it / per); const size_t r = it % per;
                const f32x4* srcp = (const f32x4*)(((tb & 1) ? a.in[I_PEER_V] : a.in[I_PEER_U]) + (size_t)(tb >> 1) * NEXP * DM + r * 32);
#pragma unroll
                for (int q = 0; q < 8; ++q) v[u][q] = __builtin_nontemporal_load(srcp + q); } }
#pragma unroll
        for (int u = 0; u < 2; ++u) { const size_t it = base + u * stride;
            if (it < it1) { const int tb = (int)(it / per); const size_t r = it % per;
                float ss = 0.f;
#pragma unroll
                for (int q = 0; q < 8; ++q) ss += (v[u][q].x * v[u][q].x + v[u][q].y * v[u][q].y) + (v[u][q].z * v[u][q].z + v[u][q].w * v[u][q].w);
                const float rms = sqrtf(wave_sum_u(ss) * (1.0f / DM));
                float step = rms * TSTEP; const float inv = rms > 0.f ? 1.0f / step : 0.f;
                v4u w;
                if (tb & 1) {
                    const float sc = rms > 0.f ? 2.05f / rms : 0.f; step = rms * (1.0f / 2.05f);
#pragma unroll
                    for (int d = 0; d < 4; ++d) { unsigned p = 0;
                        p = __builtin_amdgcn_cvt_scalef32_pk_fp4_f32(p, __builtin_fmaxf(__builtin_fminf(v[u][2 * d].x * sc, 6.f), -6.f), __builtin_fmaxf(__builtin_fminf(v[u][2 * d].y * sc, 6.f), -6.f), 1.0f, 0);
                        p = __builtin_amdgcn_cvt_scalef32_pk_fp4_f32(p, __builtin_fmaxf(__builtin_fminf(v[u][2 * d].z * sc, 6.f), -6.f), __builtin_fmaxf(__builtin_fminf(v[u][2 * d].w * sc, 6.f), -6.f), 1.0f, 1);
                        p = __builtin_amdgcn_cvt_scalef32_pk_fp4_f32(p, __builtin_fmaxf(__builtin_fminf(v[u][2 * d + 1].x * sc, 6.f), -6.f), __builtin_fmaxf(__builtin_fminf(v[u][2 * d + 1].y * sc, 6.f), -6.f), 1.0f, 2);
                        p = __builtin_amdgcn_cvt_scalef32_pk_fp4_f32(p, __builtin_fmaxf(__builtin_fminf(v[u][2 * d + 1].z * sc, 6.f), -6.f), __builtin_fmaxf(__builtin_fminf(v[u][2 * d + 1].w * sc, 6.f), -6.f), 1.0f, 3);
                        w[d] = p; }
                } else
#pragma unroll
                for (int d = 0; d < 4; ++d) {
                    const f32x4 lo = v[u][2 * d], hi = v[u][2 * d + 1]; unsigned p = 0;
#pragma unroll
                    for (int b = 0; b < 4; ++b) {
                        const int cl = (int)__builtin_fminf(__builtin_fmaxf(__builtin_floorf(lo[b] * inv), -8.0f), 7.0f);
                        const int ch = (int)__builtin_fminf(__builtin_fmaxf(__builtin_floorf(hi[b] * inv), -8.0f), 7.0f);
                        p |= (((unsigned)cl & 15u) << (4 * b)) | (((unsigned)ch & 15u) << (16 + 4 * b)); }
                    w[d] = p; }
                *(v4u*)((unsigned char*)(a.ws + m.tabu) + (((size_t)tb * 8 + (r & 63) / 8) * NEXP + (r >> 6)) * TSL + (r & 7) * 16) = w;
                if (F.lane == 0) tsc[(size_t)tb * NEXP + (r >> 6)] = step; } }
    }
}

__device__ __forceinline__ float gelu_fast(float x) {
    const float u = 1.5957691216057308f * (x + 0.044715f * x * x * x);
    return x / (1.0f + __expf(-u));
}


__device__ __forceinline__ float sigm(float x) { return 1.0f / (1.0f + __expf(-x)); }
__device__ __forceinline__ float softplus_f(float x) { return __logf(1.0f + __expf(-fabsf(x))) + fmaxf(x, 0.0f); }
__device__ __forceinline__ float tanh_f(float x) { return 1.0f - 2.0f / (1.0f + __expf(2.0f * x)); }
__device__ __forceinline__ float red8(float v) { v += dpp_f<0xB1>(v); v += dpp_f<0x4E>(v); v += dpp_f<0x141>(v); return v; }
__device__ __forceinline__ v4u ld8(const bf16_t* p) { return *(const v4u*)p; }
__device__ __forceinline__ void unpack8(const v4u w, float (&f)[8]) { f[0] = bflo(w.x); f[1] = bfhi(w.x); f[2] = bflo(w.y); f[3] = bfhi(w.y); f[4] = bflo(w.z); f[5] = bfhi(w.z); f[6] = bflo(w.w); f[7] = bfhi(w.w); }
__device__ __forceinline__ v4u pack8(const float (&f)[8]) { v4u w; w.x = pk2(f[0], f[1]); w.y = pk2(f[2], f[3]); w.z = pk2(f[4], f[5]); w.w = pk2(f[6], f[7]); return w; }

__device__ __forceinline__ void prep_phase(const Args& a, Frame& F, int l) {
    const WsMap m = ws_map(NTOK);
    const bf16_t* p16 = (const bf16_t*)(a.ws + m.p16);
    bf16_t* zrkv = (bf16_t*)(a.ws + m.zrkv); bf16_t* auxA = (bf16_t*)(a.ws + m.auxA); bf16_t* xc = (bf16_t*)(a.ws + m.xc);
    const float* mu = a.in[I_RW_MU] + l * 1792;
#pragma unroll 4
    for (size_t it = (size_t)F.vcu * NTHR + F.tid; it < (size_t)NTOK * 224; it += (size_t)F.G * NTHR) {
        const int n = (int)(it / 224), j = (int)(it % 224), t = n % TSEQ;
        const int col = j * 8;
        float cur[8], prv[8], z[8];
        unpack8(ld8(p16 + (size_t)n * PLD + col), cur);
        unpack8(ld8(p16 + (size_t)(t > 0 ? n - 1 : n) * PLD + col), prv);
        const f32x4 m0 = *(const f32x4*)(mu + col), m1 = *(const f32x4*)(mu + col + 4);
        const float mm[8] = {m0.x, m0.y, m0.z, m0.w, m1.x, m1.y, m1.z, m1.w};
#pragma unroll
        for (int k = 0; k < 8; ++k) z[k] = cur[k] + ((t > 0 ? prv[k] : 0.f) - cur[k]) * mm[k];
        if (col < 1536) *(v4u*)(zrkv + (size_t)n * 1536 + col) = pack8(z);
        else {
            const int c = col - 1536;
#pragma unroll
            for (int k = 0; k < 8; ++k) z[k] = c < 64 ? tanh_f(z[k]) : (c < 128 ? z[k] : sigm(z[k]));
            *(v4u*)(auxA + (size_t)n * 384 + c) = pack8(z);
        }
    }
    for (size_t it = (size_t)F.vcu * NTHR + F.tid; it < (size_t)NTOK * 16; it += (size_t)F.G * NTHR) {
        const int n = (int)(it / 16), c = 256 + (int)(it % 16) * 8;
        v4u w = (v4u){0u, 0u, 0u, 0u};
        if (c < 272) w = ld8(p16 + (size_t)n * PLD + C_GLA + 1536 + (c - 256));
        *(v4u*)(auxA + (size_t)n * 384 + c) = w;
    }
#pragma unroll 2
    for (size_t it = (size_t)F.vcu * NTHR + F.tid; it < (size_t)NTOK * 64; it += (size_t)F.G * NTHR) {
        const int n = (int)(it / 64), c = (int)(it % 64) * 8, t = n % TSEQ;
        float acc[8];
        { const f32x4 b0 = *(const f32x4*)(a.in[I_LRU_CONV_B] + l * 512 + c), b1 = *(const f32x4*)(a.in[I_LRU_CONV_B] + l * 512 + c + 4);
          acc[0] = b0.x; acc[1] = b0.y; acc[2] = b0.z; acc[3] = b0.w; acc[4] = b1.x; acc[5] = b1.y; acc[6] = b1.z; acc[7] = b1.w; }
        v4u raw[4];
#pragma unroll
        for (int jj = 0; jj < 4; ++jj) raw[jj] = ld8(p16 + (size_t)(t - 3 + jj >= 0 ? n - 3 + jj : n) * PLD + C_LRU + c);
#pragma unroll
        for (int jj = 0; jj < 4; ++jj) {
            float xv[8]; unpack8(raw[jj], xv);
            const float ok = (t - 3 + jj >= 0) ? 1.0f : 0.0f;
            const float* cw = a.in[I_LRU_CONV_W] + (size_t)l * 4 * 512 + jj * 512 + c;
            const f32x4 w0 = *(const f32x4*)cw * ok, w1 = *(const f32x4*)(cw + 4) * ok;
            acc[0] += w0.x * xv[0]; acc[1] += w0.y * xv[1]; acc[2] += w0.z * xv[2]; acc[3] += w0.w * xv[3];
            acc[4] += w1.x * xv[4]; acc[5] += w1.y * xv[5]; acc[6] += w1.z * xv[6]; acc[7] += w1.w * xv[7];
        }
        *(v4u*)(xc + (size_t)n * 512 + c) = pack8(acc);
    }
    {
        bf16_t* gq = (bf16_t*)(a.ws + m.gq); bf16_t* gk = (bf16_t*)(a.ws + m.gk); bf16_t* gv = (bf16_t*)(a.ws + m.gv); float* gsc = (float*)(a.ws + m.gsc);
        const float* cw = a.in[I_GDN_CONV_W] + (size_t)l * 4 * 1536;
        const int lane = F.lane;
        for (int n = F.gw; n < NTOK; n += F.ngw) {
            const int t = n % TSEQ;
#pragma unroll
            for (int part = 0; part < 3; ++part) {
                const int cb = part * 512 + lane * 8;
                float acc[8];
#pragma unroll
                for (int k = 0; k < 8; ++k) acc[k] = 0.f;
#pragma unroll
                for (int jj = 0; jj < 4; ++jj) {
                    if (t - 3 + jj >= 0) {
                        float xv[8]; unpack8(ld8(p16 + (size_t)(n - 3 + jj) * PLD + C_GDN + cb), xv);
                        const f32x4 w0 = *(const f32x4*)(cw + jj * 1536 + cb), w1 = *(const f32x4*)(cw + jj * 1536 + cb + 4);
                        acc[0] += w0.x * xv[0]; acc[1] += w0.y * xv[1]; acc[2] += w0.z * xv[2]; acc[3] += w0.w * xv[3];
                        acc[4] += w1.x * xv[4]; acc[5] += w1.y * xv[5]; acc[6] += w1.z * xv[6]; acc[7] += w1.w * xv[7];
                    }
                }
                float ss = 0.f;
#pragma unroll
                for (int k = 0; k < 8; ++k) { acc[k] = acc[k] * sigm(acc[k]); ss += acc[k] * acc[k]; }
                if (part < 2) {
                    ss = row16_sum(ss);
                    const float inv = (1.0f / sqrtf(ss + 1e-6f)) * (part == 0 ? 0.08838834764831845f : 1.0f);
#pragma unroll
                    for (int k = 0; k < 8; ++k) acc[k] *= inv;
                }
                *(v4u*)((part == 0 ? gq : (part == 1 ? gk : gv)) + (size_t)n * 512 + lane * 8) = pack8(acc);
            }
            if (lane < 4) {
                gsc[(size_t)n * 8 + lane] = sigm(bf2f(p16[(size_t)n * PLD + C_GDN + 2048 + lane]));
                gsc[(size_t)n * 8 + 4 + lane] = -__expf(a.in[I_GDN_A_LOG][l * 4 + lane]) * softplus_f(bf2f(p16[(size_t)n * PLD + C_GDN + 2052 + lane]) + a.in[I_GDN_DT_BIAS][l * 4 + lane]);
            }
        }
    }
}

__device__ __forceinline__ float swz16(float v) { return __builtin_bit_cast(float, __builtin_amdgcn_ds_swizzle(__builtin_bit_cast(int, v), 0x401F)); }
__device__ __forceinline__ float red32(float v) { v = row16_sum(v); return v + swz16(v); }

__device__ __forceinline__ void rwkv_task(const Args& a, Frame& F, int l, int task) {
    const WsMap m = ws_map(NTOK);
    const int b = task >> 4, h = (task >> 1) & 7, hf = task & 1;
    LAS float* LR = (LAS float*)F.lds; LAS float* LW = LR + 2048; LAS float* LK = LW + 2048; LAS float* LA = LK + 2048; LAS float* LB = LA + 2048;
    LAS float* LV = LB + 2048; LAS float* LY = LV + 1024;
    const int lane = F.lane, w = F.wave, tid = F.tid;
    const int ch = h * 64 + lane;
    const bool mine = (lane >> 5) == hf;
    const float kk_ = a.in[I_RW_K_K][l * 512 + ch], ka_ = a.in[I_RW_K_A][l * 512 + ch], rk_ = a.in[I_RW_R_K][l * 512 + ch];
    const bf16_t* zr = (const bf16_t*)(a.ws + m.zrkv); const bf16_t* ao = (const bf16_t*)(a.ws + m.auxo); const bf16_t* vr = (const bf16_t*)(a.ws + m.vres);
    float* vf = (float*)(a.ws + m.vfirst); bf16_t* yo = (bf16_t*)(a.ws + m.rwy); bf16_t* bvo = (bf16_t*)(a.ws + m.rwbv);
    float S0 = 0.f, S1 = 0.f, S2 = 0.f, S3 = 0.f;
    const int row = tid >> 4, ks = tid & 15;
    float in_[4][7];
    auto load_chunk = [&](int c) {
#pragma unroll
        for (int q = 0; q < 4; ++q) { const size_t n = (size_t)b * TSEQ + c * 32 + w + 8 * q;
            in_[q][0] = bf2f(zr[n * 1536 + ch]); in_[q][1] = bf2f(zr[n * 1536 + 512 + ch]); in_[q][2] = bf2f(zr[n * 1536 + 1024 + ch]);
            in_[q][3] = bf2f(ao[n * 1792 + ch]); in_[q][4] = bf2f(ao[n * 1792 + 512 + ch]);
            if (l > 0) { in_[q][5] = bf2f(vr[n * 512 + ch]); in_[q][6] = vf[n * 512 + ch]; } else { in_[q][5] = 0.f; in_[q][6] = 0.f; } }
    };
    load_chunk(0);
    for (int c = 0; c < TSEQ / 32; ++c) {
#pragma unroll
        for (int q = 0; q < 4; ++q) {
            const int tl = w + 8 * q; const size_t n = (size_t)b * TSEQ + c * 32 + tl;
            const float zr_ = in_[q][0], zk_ = in_[q][1], zv_ = in_[q][2], wp = in_[q][3], ap = in_[q][4];
            float v = zv_;
            if (l == 0) { if (mine) vf[n * 512 + ch] = zv_; } else v = zv_ + (in_[q][6] - zv_) * sigm(in_[q][5]);
            const float w_raw = -softplus_f(-wp) - 0.5f, dec = __expf(-__expf(w_raw));
            const float aa = sigm(ap);
            const float kkraw = zk_ * kk_;
            const float ss = wave_sum_u(kkraw * kkraw);
            const float kk = kkraw * (1.0f / sqrtf(fmaxf(ss, 1e-24f)));
            const float km = zk_ * (1.0f + (aa - 1.0f) * ka_);
            const float bon = wave_sum_u(zr_ * km * rk_);
            LR[tl * 64 + lane] = zr_; LW[tl * 64 + lane] = dec; LK[tl * 64 + lane] = km; LA[tl * 64 + lane] = -kk; LB[tl * 64 + lane] = kk * aa;
            if (mine) { LV[tl * 32 + (lane & 31)] = v; bvo[n * 512 + ch] = f2bf(bon * v); }
        }
        __syncthreads();
        if (c + 1 < TSEQ / 32) load_chunk(c + 1);
        float keep0 = 0.f, keep1 = 0.f;
#pragma unroll 4
        for (int tl = 0; tl < 32; ++tl) {
            const int o = tl * 64 + ks * 4;
            const f32x4 a4 = *(const LAS f32x4*)(LA + o), w4 = *(const LAS f32x4*)(LW + o), b4 = *(const LAS f32x4*)(LB + o), k4 = *(const LAS f32x4*)(LK + o), r4 = *(const LAS f32x4*)(LR + o);
            const float vv = LV[tl * 32 + row];
            const float sa = row16_sum((S0 * a4.x + S1 * a4.y) + (S2 * a4.z + S3 * a4.w));
            S0 = S0 * w4.x + (sa * b4.x + vv * k4.x); S1 = S1 * w4.y + (sa * b4.y + vv * k4.y); S2 = S2 * w4.z + (sa * b4.z + vv * k4.z); S3 = S3 * w4.w + (sa * b4.w + vv * k4.w);
            const float y = row16_sum((S0 * r4.x + S1 * r4.y) + (S2 * r4.z + S3 * r4.w));
            keep0 = (ks == tl) ? y : keep0; keep1 = (ks + 16 == tl) ? y : keep1;
        }
        LY[ks * 32 + row] = keep0; LY[(16 + ks) * 32 + row] = keep1;
        __syncthreads();
        { const int tl = tid >> 4, r2 = (tid & 15) * 2; const size_t n = (size_t)b * TSEQ + c * 32 + tl;
          *(unsigned*)(yo + n * 512 + h * 64 + hf * 32 + r2) = pk2(LY[tl * 32 + r2], LY[tl * 32 + r2 + 1]); }
    }
}


__device__ __forceinline__ void chunk_cumsum8(float (&x)[8], LAS float* tmp, int lane, int w, int c8) {
#pragma unroll
    for (int d = 8; d < 64; d <<= 1) {
#pragma unroll
        for (int k = 0; k < 8; ++k) { const float t = __shfl_up(x[k], d); if (lane >= d) x[k] += t; }
    }
    if (lane >= 56) { *(LAS f32x4*)(tmp + w * 64 + c8) = (f32x4){x[0], x[1], x[2], x[3]}; *(LAS f32x4*)(tmp + w * 64 + c8 + 4) = (f32x4){x[4], x[5], x[6], x[7]}; }
    __syncthreads();
    for (int ww = 0; ww < w; ++ww) { const f32x4 a0 = *(const LAS f32x4*)(tmp + ww * 64 + c8), a1 = *(const LAS f32x4*)(tmp + ww * 64 + c8 + 4);
        x[0] += a0.x; x[1] += a0.y; x[2] += a0.z; x[3] += a0.w; x[4] += a1.x; x[5] += a1.y; x[6] += a1.z; x[7] += a1.w; }
}

constexpr int RWP = 72;
constexpr int RWT = 64 * RWP;
constexpr size_t RWB_TILES = 4 * RWT * 2;
constexpr size_t RWB_DVEC = RWB_TILES;
constexpr size_t RWB_VS = RWB_DVEC + 256;
constexpr size_t RWB_BYTES = RWB_VS + 4 * 3 * 64 * 16 * 2;

__device__ __forceinline__ f32x4 mm64(const LAS bf16_t* A, const LAS bf16_t* Bt, int mt, int nt, int lane, f32x4 acc) {
    const LAS bf16_t* ap = A + (mt * 16 + (lane & 15)) * RWP + (lane >> 4) * 8;
    const LAS bf16_t* bp = Bt + (nt * 16 + (lane & 15)) * RWP + (lane >> 4) * 8;
#pragma unroll
    for (int k0 = 0; k0 < 64; k0 += 32)
        acc = __builtin_amdgcn_mfma_f32_16x16x32_bf16(*(const LAS bf16x8*)(ap + k0), *(const LAS bf16x8*)(bp + k0), acc, 0, 0, 0);
    return acc;
}
__device__ __forceinline__ void st_rowmajor(LAS bf16_t* T, int mt, int nt, int lane, const f32x4 v) {
    const int n = nt * 16 + (lane & 15), i0 = mt * 16 + (lane >> 4) * 4;
    T[(i0 + 0) * RWP + n] = f2bf(v.x); T[(i0 + 1) * RWP + n] = f2bf(v.y); T[(i0 + 2) * RWP + n] = f2bf(v.z); T[(i0 + 3) * RWP + n] = f2bf(v.w);
}
__device__ __forceinline__ void st_transposed(LAS bf16_t* T, int mt, int nt, int lane, const f32x4 v) {
    const int n = nt * 16 + (lane & 15), i0 = mt * 16 + (lane >> 4) * 4;
    *(LAS v2u*)(T + n * RWP + i0) = (v2u){pk2(v.x, v.y), pk2(v.z, v.w)};
}

__device__ __forceinline__ void rwkv_pa_chunk(const Args& a, Frame& F, int l, int ci) {
    const WsMap m = ws_map(NTOK);
    const int bh = ci >> 6, c = ci & 63, b = bh >> 3, h = bh & 7;
    const int lane = F.lane, w = F.wave, tid = F.tid;
    const int ch = h * 64 + lane;
    LAS bf16_t* At = (LAS bf16_t*)F.lds; LAS bf16_t* AtT = At + RWT; LAS bf16_t* Bt = AtT + RWT; LAS bf16_t* Kt = Bt + RWT; LAS bf16_t* KtGT = Kt + RWT;
    LAS bf16_t* Rt = KtGT + RWT; LAS bf16_t* VmT = Rt + RWT; LAS bf16_t* LAK = VmT + RWT;
    LAS bf16_t* X0 = LAK + RWT; LAS bf16_t* XT0 = X0 + RWT; LAS bf16_t* T0 = XT0 + RWT; LAS bf16_t* X1 = T0 + RWT; LAS bf16_t* XT1 = X1 + RWT; LAS bf16_t* T1 = XT1 + RWT;
    LAS float* LWL = (LAS float*)X0;
    LAS bf16_t* A2 = X1;
    LAS bf16_t* LVT = XT1;
    const bf16_t* zr = (const bf16_t*)(a.ws + m.zrkv); const bf16_t* ao = (const bf16_t*)(a.ws + m.auxo); const bf16_t* vr = (const bf16_t*)(a.ws + m.vres);
    float* vf = (float*)(a.ws + m.vfirst); bf16_t* bvo = (bf16_t*)(a.ws + m.rwbv);
    unsigned char* blob = a.ws + m.xn + (size_t)ci * RWB_BYTES;
    bf16_t* gW = (bf16_t*)blob; bf16_t* gQG = gW + RWT; bf16_t* gKGT = gQG + RWT; bf16_t* gA1 = gKGT + RWT;
    float* gDV = (float*)(blob + RWB_DVEC); bf16_t* gVS = (bf16_t*)(blob + RWB_VS);
    const int j = tid >> 3, c8 = (tid & 7) * 8, chb = h * 64 + c8;
    const size_t n = (size_t)b * TSEQ + c * 64 + j;
    float zr_[8], zk_[8], zv_[8], wp[8], ap[8];
    unpack8(ld8(zr + n * 1536 + chb), zr_); unpack8(ld8(zr + n * 1536 + 512 + chb), zk_); unpack8(ld8(zr + n * 1536 + 1024 + chb), zv_);
    unpack8(ld8(ao + n * 1792 + chb), wp); unpack8(ld8(ao + n * 1792 + 512 + chb), ap);
    float vres8[8], vf8[8];
    if (l > 0) { unpack8(ld8(vr + n * 512 + chb), vres8); const f32x4 f0 = *(const f32x4*)(vf + n * 512 + chb), f1 = *(const f32x4*)(vf + n * 512 + chb + 4);
        vf8[0] = f0.x; vf8[1] = f0.y; vf8[2] = f0.z; vf8[3] = f0.w; vf8[4] = f1.x; vf8[5] = f1.y; vf8[6] = f1.z; vf8[7] = f1.w; }
    float lw[8];
#pragma unroll
    for (int k = 0; k < 8; ++k) lw[k] = -__expf(-softplus_f(-wp[k]) - 0.5f);
    float cs[8];
#pragma unroll
    for (int k = 0; k < 8; ++k) cs[k] = lw[k];
    chunk_cumsum8(cs, LWL, lane, w, c8);
    {
        float pk_[8], pa_[8], pr_[8];
        { const float* p0 = a.in[I_RW_K_K] + l * 512 + chb; const float* p1 = a.in[I_RW_K_A] + l * 512 + chb; const float* p2 = a.in[I_RW_R_K] + l * 512 + chb;
          const f32x4 a0 = *(const f32x4*)p0, a1 = *(const f32x4*)(p0 + 4), b0 = *(const f32x4*)p1, b1 = *(const f32x4*)(p1 + 4), c0 = *(const f32x4*)p2, c1 = *(const f32x4*)(p2 + 4);
          pk_[0] = a0.x; pk_[1] = a0.y; pk_[2] = a0.z; pk_[3] = a0.w; pk_[4] = a1.x; pk_[5] = a1.y; pk_[6] = a1.z; pk_[7] = a1.w;
          pa_[0] = b0.x; pa_[1] = b0.y; pa_[2] = b0.z; pa_[3] = b0.w; pa_[4] = b1.x; pa_[5] = b1.y; pa_[6] = b1.z; pa_[7] = b1.w;
          pr_[0] = c0.x; pr_[1] = c0.y; pr_[2] = c0.z; pr_[3] = c0.w; pr_[4] = c1.x; pr_[5] = c1.y; pr_[6] = c1.z; pr_[7] = c1.w; }
        float v[8], aa[8], kk[8], km[8];
        float ss = 0.f, bs = 0.f;
#pragma unroll
        for (int k = 0; k < 8; ++k) {
            v[k] = (l == 0) ? zv_[k] : zv_[k] + (vf8[k] - zv_[k]) * sigm(vres8[k]);
            aa[k] = sigm(ap[k]);
            kk[k] = zk_[k] * pk_[k]; ss += kk[k] * kk[k];
            km[k] = zk_[k] * (1.0f + (aa[k] - 1.0f) * pa_[k]); bs += zr_[k] * km[k] * pr_[k];
        }
        if (l == 0) { *(f32x4*)(vf + n * 512 + chb) = (f32x4){zv_[0], zv_[1], zv_[2], zv_[3]}; *(f32x4*)(vf + n * 512 + chb + 4) = (f32x4){zv_[4], zv_[5], zv_[6], zv_[7]}; }
        ss = red8(ss); bs = red8(bs);
        const float kinv = 1.0f / sqrtf(fmaxf(ss, 1e-24f));
        float cm[8], gcv[8];
        {
#pragma unroll
          for (int k = 0; k < 8; ++k) gcv[k] = 0.f;
#pragma unroll
          for (int ww = 0; ww < 8; ++ww) { const f32x4 g0 = *(const LAS f32x4*)(LWL + ww * 64 + c8), g1 = *(const LAS f32x4*)(LWL + ww * 64 + c8 + 4);
              gcv[0] += g0.x; gcv[1] += g0.y; gcv[2] += g0.z; gcv[3] += g0.w; gcv[4] += g1.x; gcv[5] += g1.y; gcv[6] += g1.z; gcv[7] += g1.w; } }
#pragma unroll
        for (int k = 0; k < 8; ++k) cm[k] = cs[k] - lw[k];
        float t_at[8], t_bt[8], t_kt[8], t_rt[8], t_bv[8];
        LAS bf16_t* KGTl = T1;
#pragma unroll
        for (int k = 0; k < 8; ++k) {
            const float G = __expf(cs[k]), Gm1 = __expf(cm[k]), iG = __expf(-cs[k]), GcG = __expf(gcv[k] - cs[k]);
            const float kkn = kk[k] * kinv;
            const float av = -kkn, bv = kkn * aa[k];
            t_at[k] = av * Gm1; t_bt[k] = bv * iG; t_kt[k] = km[k] * iG; t_rt[k] = zr_[k] * G; t_bv[k] = bs * v[k];
            AtT[(c8 + k) * RWP + j] = f2bf(t_at[k]);
            KtGT[(c8 + k) * RWP + j] = f2bf(km[k] * GcG);
            VmT[(c8 + k) * RWP + j] = f2bf(v[k]);
            KGTl[(c8 + k) * RWP + j] = f2bf(bv * GcG);
        }
        *(LAS v4u*)(At + j * RWP + c8) = pack8(t_at); *(LAS v4u*)(Bt + j * RWP + c8) = pack8(t_bt); *(LAS v4u*)(Kt + j * RWP + c8) = pack8(t_kt);
        const v4u rt8 = pack8(t_rt);
        *(LAS v4u*)(Rt + j * RWP + c8) = rt8; *(v4u*)(gQG + j * RWP + c8) = rt8;
        *(v4u*)(bvo + n * 512 + chb) = pack8(t_bv);
        if (j == 63) { *(f32x4*)(gDV + c8) = (f32x4){__expf(gcv[0]), __expf(gcv[1]), __expf(gcv[2]), __expf(gcv[3])}; *(f32x4*)(gDV + c8 + 4) = (f32x4){__expf(gcv[4]), __expf(gcv[5]), __expf(gcv[6]), __expf(gcv[7])}; }
    }
    __syncthreads();
    {
        for (int o = tid; o < RWT / 8; o += NTHR) ((v4u*)gKGT)[o] = ((const LAS v4u*)T1)[o];
        f32x4 z4 = {0.f, 0.f, 0.f, 0.f};
#pragma unroll 1
        for (int tt = 0; tt < 2; ++tt) {
            const int t = w + 8 * tt, mt = t >> 2, nt = t & 3;
            const int n = nt * 16 + (lane & 15), i0 = mt * 16 + (lane >> 4) * 4;
            f32x4 lab = mm64(At, Bt, mt, nt, lane, z4), lak = mm64(At, Kt, mt, nt, lane, z4), a1 = mm64(Rt, Bt, mt, nt, lane, z4), a2 = mm64(Rt, Kt, mt, nt, lane, z4);
            f32x4 tt0;
#pragma unroll
            for (int e = 0; e < 4; ++e) { const int i = i0 + e;
                if (n >= i) { lab[e] = 0.f; lak[e] = 0.f; }
                if (n > i) { a1[e] = 0.f; a2[e] = 0.f; }
                tt0[e] = lab[e] + (n == i ? 1.0f : 0.f); }
            st_rowmajor(X0, mt, nt, lane, lab); st_transposed(XT0, mt, nt, lane, lab);
            st_rowmajor(T0, mt, nt, lane, tt0);
            st_rowmajor(LAK, mt, nt, lane, lak);
            st_rowmajor(A2, mt, nt, lane, a2);
            gA1[(i0 + 0) * RWP + n] = f2bf(a1.x); gA1[(i0 + 1) * RWP + n] = f2bf(a1.y); gA1[(i0 + 2) * RWP + n] = f2bf(a1.z); gA1[(i0 + 3) * RWP + n] = f2bf(a1.w);
        }
    }
    __syncthreads();
    {
        f32x4 z4 = {0.f, 0.f, 0.f, 0.f};
#pragma unroll 1
        for (int tt = 0; tt < 2; ++tt) {
            const int t = w + 8 * tt, mt = t >> 2, nt = t & 3;
            const int n = nt * 16 + (lane & 15), i0 = mt * 16 + (lane >> 4) * 4;
            const f32x4 lv = mm64(LAK, VmT, mt, nt, lane, z4), o0 = mm64(A2, VmT, mt, nt, lane, z4), kv0 = mm64(KtGT, VmT, mt, nt, lane, z4);
            st_transposed((LAS bf16_t*)(F.lds + 131584), mt, nt, lane, lv);
            bf16_t* go = gVS + (size_t)nt * 3 * 1024 + 1024;
            const int r = lane & 15;
            go[(i0 + 0) * 16 + r] = f2bf(o0.x); go[(i0 + 1) * 16 + r] = f2bf(o0.y); go[(i0 + 2) * 16 + r] = f2bf(o0.z); go[(i0 + 3) * 16 + r] = f2bf(o0.w);
            go[1024 + (i0 + 0) * 16 + r] = f2bf(kv0.x); go[1024 + (i0 + 1) * 16 + r] = f2bf(kv0.y); go[1024 + (i0 + 2) * 16 + r] = f2bf(kv0.z); go[1024 + (i0 + 3) * 16 + r] = f2bf(kv0.w);
            (void)n;
        }
    }
    __syncthreads();
    {
        LAS bf16_t* Xc = X0; LAS bf16_t* XTc = XT0; LAS bf16_t* Tc = T0; LAS bf16_t* Xn = X1; LAS bf16_t* XTn = XT1; LAS bf16_t* Tn = T1;
        f32x4 z4 = {0.f, 0.f, 0.f, 0.f};
#pragma unroll 1
        for (int it = 0; it < 5; ++it) {
#pragma unroll 1
            for (int tt = 0; tt < 2; ++tt) { const int t = w + 8 * tt, mt = t >> 2, nt = t & 3;
                const f32x4 x2 = mm64(Xc, XTc, mt, nt, lane, z4);
                st_rowmajor(Xn, mt, nt, lane, x2); st_transposed(XTn, mt, nt, lane, x2); }
            __syncthreads();
#pragma unroll 1
            for (int tt = 0; tt < 2; ++tt) { const int t = w + 8 * tt, mt = t >> 2, nt = t & 3;
                const int n = nt * 16 + (lane & 15), i0 = mt * 16 + (lane >> 4) * 4;
                f32x4 tc; tc.x = bf2f(Tc[(i0 + 0) * RWP + n]); tc.y = bf2f(Tc[(i0 + 1) * RWP + n]); tc.z = bf2f(Tc[(i0 + 2) * RWP + n]); tc.w = bf2f(Tc[(i0 + 3) * RWP + n]);
                const f32x4 tn = mm64(Tc, XTn, mt, nt, lane, tc);
                st_rowmajor(Tn, mt, nt, lane, tn); }
            __syncthreads();
            LAS bf16_t* s0 = Xc; Xc = Xn; Xn = s0; s0 = XTc; XTc = XTn; XTn = s0; s0 = Tc; Tc = Tn; Tn = s0;
        }
        LAS bf16_t* LVTp = (LAS bf16_t*)(F.lds + 131584);
#pragma unroll 1
        for (int tt = 0; tt < 2; ++tt) { const int t = w + 8 * tt, mt = t >> 2, nt = t & 3;
            const int n = nt * 16 + (lane & 15), i0 = mt * 16 + (lane >> 4) * 4, r = lane & 15;
            const f32x4 wt = mm64(Tc, AtT, mt, nt, lane, z4), u0 = mm64(Tc, LVTp, mt, nt, lane, z4);
            gW[(i0 + 0) * RWP + n] = f2bf(wt.x); gW[(i0 + 1) * RWP + n] = f2bf(wt.y); gW[(i0 + 2) * RWP + n] = f2bf(wt.z); gW[(i0 + 3) * RWP + n] = f2bf(wt.w);
            bf16_t* gu = gVS + (size_t)nt * 3 * 1024;
            gu[(i0 + 0) * 16 + r] = f2bf(u0.x); gu[(i0 + 1) * 16 + r] = f2bf(u0.y); gu[(i0 + 2) * 16 + r] = f2bf(u0.z); gu[(i0 + 3) * 16 + r] = f2bf(u0.w); }
    }
    __syncthreads();
    (void)LVT;
}

__device__ __forceinline__ void rwkv_ps_task(const Args& a, Frame& F, int task) {
    const WsMap m = ws_map(NTOK);
    const int bh = task >> 2, vs = task & 3, b = bh >> 3, h = bh & 7;
    const int lane = F.lane, w = F.wave, tid = F.tid;
    LAS bf16_t* LB = (LAS bf16_t*)F.lds;
    LAS bf16_t* ST = LB + 4 * RWT; LAS bf16_t* VNT = ST + 16 * RWP;
    bf16_t* yo = (bf16_t*)(a.ws + m.rwy);
    const unsigned char* blob0 = a.ws + m.xn + (size_t)(bh * 64) * RWB_BYTES;
    const int r = lane & 15, i0w = (w & 3) * 16 + (lane >> 4) * 4;
    f32x4 Sacc = {0.f, 0.f, 0.f, 0.f};
    for (int i = tid; i < 16 * RWP / 2; i += NTHR) ((LAS unsigned*)ST)[i] = 0u;
    v4u pre[5];
    auto prefetch = [&](int c) {
        const v4u* g = (const v4u*)(blob0 + (size_t)c * RWB_BYTES);
#pragma unroll
        for (int k = 0; k < 5; ++k) { const int o = k * 512 + tid; pre[k] = (o < (int)(RWB_TILES / 16)) ? g[o] : (v4u){0u, 0u, 0u, 0u}; }
    };
    auto commit = [&]() {
#pragma unroll
        for (int k = 0; k < 5; ++k) { const int o = k * 512 + tid; if (o < (int)(RWB_TILES / 16)) ((LAS v4u*)LB)[o] = pre[k]; }
    };
    bf16_t nfr[4], nkv[4]; float ndv[4];
    auto prefrag = [&](int c) {
        const unsigned char* blob = blob0 + (size_t)c * RWB_BYTES;
        const bf16_t* gvs = (const bf16_t*)(blob + RWB_VS) + (size_t)vs * 3 * 1024;
        const bf16_t* src = gvs + (w < 4 ? 0 : 1024);
#pragma unroll
        for (int e = 0; e < 4; ++e) nfr[e] = src[(i0w + e) * 16 + r];
        if (w < 4) { const float* gd = (const float*)(blob + RWB_DVEC);
#pragma unroll
            for (int e = 0; e < 4; ++e) { ndv[e] = gd[i0w + e]; nkv[e] = gvs[2048 + (i0w + e) * 16 + r]; } }
        else {
#pragma unroll
            for (int e = 0; e < 4; ++e) { ndv[e] = 1.f; nkv[e] = 0; } }
    };
    prefetch(0); commit(); prefetch(1); prefrag(0);
    for (int c = 0; c < 64; ++c) {
        float fr[4], dv[4], kv0[4];
#pragma unroll
        for (int e = 0; e < 4; ++e) { fr[e] = bf2f(nfr[e]); dv[e] = ndv[e]; kv0[e] = bf2f(nkv[e]); }
        if (c + 1 < 64) prefrag(c + 1);
        __syncthreads();
        if (w < 4) {
            f32x4 vn = mm64(LB, ST, w, 0, lane, (f32x4){fr[0], fr[1], fr[2], fr[3]});
            st_transposed(VNT, w, 0, lane, vn);
        }
        __syncthreads();
        if (w < 4) {
            const f32x4 base = {dv[0] * Sacc.x + kv0[0], dv[1] * Sacc.y + kv0[1], dv[2] * Sacc.z + kv0[2], dv[3] * Sacc.w + kv0[3]};
            Sacc = mm64(LB + 2 * RWT, VNT, w, 0, lane, base);
        } else {
            f32x4 o = mm64(LB + RWT, ST, w - 4, 0, lane, (f32x4){fr[0], fr[1], fr[2], fr[3]});
            o = mm64(LB + 3 * RWT, VNT, w - 4, 0, lane, o);
            const size_t n = (size_t)b * TSEQ + c * 64 + i0w;
            bf16_t* yp = yo + n * 512 + h * 64 + vs * 16 + r;
            yp[0] = f2bf(o.x); yp[512] = f2bf(o.y); yp[1024] = f2bf(o.z); yp[1536] = f2bf(o.w);
        }
        __syncthreads();
        if (w < 4) st_transposed(ST, w, 0, lane, Sacc);
        if (c + 1 < 64) commit();
        if (c + 2 < 64) prefetch(c + 2);
    }
    __syncthreads();
}

constexpr int GP = 136;
constexpr size_t GB_BYTES = 26880;
template <int KD, int PA_, int PB_>
__device__ __forceinline__ f32x4 mmx(const LAS bf16_t* A, const LAS bf16_t* Bt, int mt, int nt, int lane, f32x4 acc) {
    const LAS bf16_t* ap = A + (mt * 16 + (lane & 15)) * PA_ + (lane >> 4) * 8;
    const LAS bf16_t* bp = Bt + (nt * 16 + (lane & 15)) * PB_ + (lane >> 4) * 8;
#pragma unroll
    for (int k0 = 0; k0 < KD; k0 += 32)
        acc = __builtin_amdgcn_mfma_f32_16x16x32_bf16(*(const LAS bf16x8*)(ap + k0), *(const LAS bf16x8*)(bp + k0), acc, 0, 0, 0);
    return acc;
}
__device__ __forceinline__ void gdn_pa_chunk(const Args& a, Frame& F, int ci) {
    const WsMap m = ws_map(NTOK);
    const int bh = ci >> 6, c = ci & 63, b = bh >> 2, h = bh & 3;
    const int lane = F.lane, w = F.wave, tid = F.tid;
    LAS bf16_t* KB = (LAS bf16_t*)F.lds; LAS bf16_t* KH = KB + 64 * GP; LAS bf16_t* QH = KH + 64 * GP;
    LAS bf16_t* KBEt = KB; LAS bf16_t* VbT = KB + 128 * RWP;
    LAS bf16_t* X0 = QH + 64 * GP; LAS bf16_t* XT0 = X0 + RWT; LAS bf16_t* T0 = XT0 + RWT; LAS bf16_t* X1 = T0 + RWT; LAS bf16_t* XT1 = X1 + RWT; LAS bf16_t* T1 = XT1 + RWT;
    LAS float* GC = (LAS float*)(T1 + RWT);
    LAS bf16_t* KGTl = (LAS bf16_t*)(GC + 64);
    bf16_t* gq = (bf16_t*)(a.ws + m.gq); bf16_t* gk = (bf16_t*)(a.ws + m.gk); bf16_t* gv = (bf16_t*)(a.ws + m.gv); const float* gsc = (const float*)(a.ws + m.gsc);
    unsigned char* blob = a.ws + m.gblob + (size_t)ci * GB_BYTES;
    bf16_t* gA1 = (bf16_t*)blob; bf16_t* gW = gA1 + RWT; float* gGC = (float*)(blob + RWT * 2 + 64 * GP * 2);
    const int j = tid >> 3, c16 = (tid & 7) * 16;
    const size_t n0 = (size_t)b * TSEQ + c * 64, n = n0 + j;
    const float be = gsc[n * 8 + h];
    v4u kw[2], qw[2], vw[2];
    {
        float kf[8];
#pragma unroll
        for (int hh = 0; hh < 2; ++hh) {
            kw[hh] = ld8(gk + n * 512 + h * 128 + c16 + hh * 8); qw[hh] = ld8(gq + n * 512 + h * 128 + c16 + hh * 8); vw[hh] = ld8(gv + n * 512 + h * 128 + c16 + hh * 8);
            *(LAS v4u*)(KH + j * GP + c16 + hh * 8) = kw[hh]; *(LAS v4u*)(QH + j * GP + c16 + hh * 8) = qw[hh];
            unpack8(kw[hh], kf);
#pragma unroll
            for (int k = 0; k < 8; ++k) kf[k] *= be;
            *(LAS v4u*)(KB + j * GP + c16 + hh * 8) = pack8(kf);
        }
        if (w == 0) {
            float g = gsc[(n0 + lane) * 8 + 4 + h];
#pragma unroll
            for (int o = 1; o < 64; o <<= 1) { const float t = __shfl_up(g, o); if (lane >= o) g += t; }
            GC[lane] = g; gGC[lane] = g;
        }
    }
    __syncthreads();
    {
        const f32x4 z4 = {0.f, 0.f, 0.f, 0.f};
#pragma unroll 1
        for (int tt = 0; tt < 2; ++tt) {
            const int t = w + 8 * tt, mt = t >> 2, nt = t & 3;
            const int nn = nt * 16 + (lane & 15), i0 = mt * 16 + (lane >> 4) * 4;
            f32x4 kk = mmx<128, GP, GP>(KB, KH, mt, nt, lane, z4), qk = mmx<128, GP, GP>(QH, KH, mt, nt, lane, z4);
            const float gj = GC[nn];
            f32x4 x, t0;
#pragma unroll
            for (int e = 0; e < 4; ++e) { const int i = i0 + e; const float d = __expf(fminf(GC[i] - gj, 0.f));
                x[e] = (nn < i) ? -kk[e] * d : 0.f; qk[e] = (nn <= i) ? qk[e] * d : 0.f; t0[e] = x[e] + (nn == i ? 1.0f : 0.f); }
            st_rowmajor(X0, mt, nt, lane, x); st_transposed(XT0, mt, nt, lane, x); st_rowmajor(T0, mt, nt, lane, t0);
            gA1[(i0 + 0) * RWP + nn] = f2bf(qk.x); gA1[(i0 + 1) * RWP + nn] = f2bf(qk.y); gA1[(i0 + 2) * RWP + nn] = f2bf(qk.z); gA1[(i0 + 3) * RWP + nn] = f2bf(qk.w);
        }
    }
    __syncthreads();
    {
        const float gj = GC[j], eg = __expf(gj), s_kbe = be * eg, s_kg = __expf(GC[63] - gj);
        float f[8], o8[8];
#pragma unroll
        for (int hh = 0; hh < 2; ++hh) {
            unpack8(kw[hh], f);
#pragma unroll
            for (int k = 0; k < 8; ++k) { KBEt[(c16 + hh * 8 + k) * RWP + j] = f2bf(f[k] * s_kbe); KGTl[(c16 + hh * 8 + k) * RWP + j] = f2bf(f[k] * s_kg); }
            unpack8(vw[hh], f);
#pragma unroll
            for (int k = 0; k < 8; ++k) VbT[(c16 + hh * 8 + k) * RWP + j] = f2bf(f[k] * be);
            unpack8(qw[hh], f);
#pragma unroll
            for (int k = 0; k < 8; ++k) o8[k] = f[k] * eg;
            *(v4u*)(gq + n * 512 + h * 128 + c16 + hh * 8) = pack8(o8);
        }
    }
    const f32x4 z4 = {0.f, 0.f, 0.f, 0.f};
    LAS bf16_t* Xc = X0; LAS bf16_t* XTc = XT0; LAS bf16_t* Tc = T0; LAS bf16_t* Xn = X1; LAS bf16_t* XTn = XT1; LAS bf16_t* Tn = T1;
#pragma unroll 1
    for (int it = 0; it < 5; ++it) {
#pragma unroll 1
        for (int tt = 0; tt < 2; ++tt) { const int t = w + 8 * tt, mt = t >> 2, nt = t & 3;
            const f32x4 x2 = mm64(Xc, XTc, mt, nt, lane, z4);
            st_rowmajor(Xn, mt, nt, lane, x2); st_transposed(XTn, mt, nt, lane, x2); }
        __syncthreads();
#pragma unroll 1
        for (int tt = 0; tt < 2; ++tt) { const int t = w + 8 * tt, mt = t >> 2, nt = t & 3;
            const int nn = nt * 16 + (lane & 15), i0 = mt * 16 + (lane >> 4) * 4;
            f32x4 tc; tc.x = bf2f(Tc[(i0 + 0) * RWP + nn]); tc.y = bf2f(Tc[(i0 + 1) * RWP + nn]); tc.z = bf2f(Tc[(i0 + 2) * RWP + nn]); tc.w = bf2f(Tc[(i0 + 3) * RWP + nn]);
            const f32x4 tn = mm64(Tc, XTn, mt, nt, lane, tc);
            st_rowmajor(Tn, mt, nt, lane, tn); }
        __syncthreads();
        LAS bf16_t* s0 = Xc; Xc = Xn; Xn = s0; s0 = XTc; XTc = XTn; XTn = s0; s0 = Tc; Tc = Tn; Tn = s0;
    }
    {
#pragma unroll 1
        for (int tt = 0; tt < 4; ++tt) { const int mt = w, nt = tt;
            const f32x4 dw = mm64(KBEt, Tc, mt, nt, lane, z4), du = mm64(VbT, Tc, mt, nt, lane, z4);
            const int i = nt * 16 + (lane & 15), c0 = mt * 16 + (lane >> 4) * 4;
            *(v2u*)(gW + i * GP + c0) = (v2u){pk2(dw.x, dw.y), pk2(dw.z, dw.w)};
            *(v2u*)(gv + (n0 + i) * 512 + h * 128 + c0) = (v2u){pk2(du.x, du.y), pk2(du.z, du.w)}; }
        for (int p = tid; p < 1024; p += NTHR) { const int k = p >> 3, j8 = (p & 7) * 8;
            *(v4u*)(gk + (n0 + (k >> 1)) * 512 + h * 128 + (k & 1) * 64 + j8) = *(const LAS v4u*)(KGTl + k * RWP + j8); }
    }
    __syncthreads();
}

__device__ __forceinline__ void gdn_ps_task(const Args& a, Frame& F, int task) {
    const WsMap m = ws_map(NTOK);
    const int bh = task >> 3, vs = task & 7, b = bh >> 2, h = bh & 3;
    const int lane = F.lane, w = F.wave, tid = F.tid;
    LAS bf16_t* A1 = (LAS bf16_t*)F.lds; LAS bf16_t* WT = A1 + RWT; LAS float* GC = (LAS float*)(WT + 64 * GP);
    LAS bf16_t* QG = (LAS bf16_t*)(GC + 64); LAS bf16_t* KGT = QG + 64 * GP; LAS bf16_t* ST = KGT + 128 * RWP;
    LAS bf16_t* VNT = ST + 16 * GP; LAS bf16_t* UU = VNT + 16 * RWP;
    const bf16_t* gq = (const bf16_t*)(a.ws + m.gq); const bf16_t* gk = (const bf16_t*)(a.ws + m.gk); const bf16_t* gv = (const bf16_t*)(a.ws + m.gv);
    bf16_t* go = (bf16_t*)(a.ws + m.gdno);
    const unsigned char* blob0 = a.ws + m.gblob + (size_t)(bh * 64) * GB_BYTES;
    const int r = lane & 15, kq4 = (lane >> 4) * 4;
    f32x4 Sacc = {0.f, 0.f, 0.f, 0.f};
    for (int i = tid; i < 16 * GP / 2; i += NTHR) ((LAS unsigned*)ST)[i] = 0u;
    v4u pb_[4], pq_[2], pk_[2], pu_;
    auto prefetch = [&](int c) {
        const size_t n0 = (size_t)b * TSEQ + c * 64;
        const v4u* g = (const v4u*)(blob0 + (size_t)c * GB_BYTES);
#pragma unroll
        for (int k = 0; k < 4; ++k) { const int o = k * 512 + tid; pb_[k] = (o < (int)(GB_BYTES / 16)) ? g[o] : (v4u){0u, 0u, 0u, 0u}; }
#pragma unroll
        for (int k = 0; k < 2; ++k) { const int p = k * 512 + tid;
            pq_[k] = ld8(gq + (n0 + (p >> 4)) * 512 + h * 128 + (p & 15) * 8);
            pk_[k] = ld8(gk + (n0 + (p >> 4)) * 512 + h * 128 + (p & 15) * 8); }
        if (tid < 128) pu_ = ld8(gv + (n0 + (tid >> 1)) * 512 + h * 128 + vs * 16 + (tid & 1) * 8);
    };
    prefetch(0);
    for (int c = 0; c < 64; ++c) {
#pragma unroll
        for (int k = 0; k < 4; ++k) { const int o = k * 512 + tid; if (o < (int)(GB_BYTES / 16)) ((LAS v4u*)A1)[o] = pb_[k]; }
#pragma unroll
        for (int k = 0; k < 2; ++k) { const int p = k * 512 + tid;
            *(LAS v4u*)(QG + (p >> 4) * GP + (p & 15) * 8) = pq_[k];
            const int kk = 2 * (p >> 4) + ((p & 15) >> 3), j8 = (p & 7) * 8;
            *(LAS v4u*)(KGT + kk * RWP + j8) = pk_[k]; }
        if (tid < 128) *(LAS v4u*)(UU + (tid >> 1) * 16 + (tid & 1) * 8) = pu_;
        __syncthreads();
        if (c + 1 < 64) prefetch(c + 1);
        const float glast = __expf(GC[63]);
        if (w < 4) {
            const int i0 = w * 16 + kq4;
            f32x4 vn = mmx<128, GP, GP>(WT, ST, w, 0, lane, (f32x4){0.f, 0.f, 0.f, 0.f});
            vn.x = bf2f(UU[(i0 + 0) * 16 + r]) - vn.x; vn.y = bf2f(UU[(i0 + 1) * 16 + r]) - vn.y; vn.z = bf2f(UU[(i0 + 2) * 16 + r]) - vn.z; vn.w = bf2f(UU[(i0 + 3) * 16 + r]) - vn.w;
            st_transposed(VNT, w, 0, lane, vn);
        }
        __syncthreads();
        {
            const f32x4 base = {Sacc.x * glast, Sacc.y * glast, Sacc.z * glast, Sacc.w * glast};
            Sacc = mm64(KGT, VNT, w, 0, lane, base);
            if (w < 4) {
                f32x4 o = mmx<128, GP, GP>(QG, ST, w, 0, lane, (f32x4){0.f, 0.f, 0.f, 0.f});
                o = mm64(A1, VNT, w, 0, lane, o);
                const size_t n = (size_t)b * TSEQ + c * 64 + w * 16 + kq4;
                bf16_t* op = go + n * 512 + h * 128 + vs * 16 + r;
                op[0] = f2bf(o.x); op[512] = f2bf(o.y); op[1024] = f2bf(o.z); op[1536] = f2bf(o.w);
            }
        }
        __syncthreads();
        { const int k0 = w * 16 + kq4;
          *(LAS v2u*)(ST + r * GP + k0) = (v2u){pk2(Sacc.x, Sacc.y), pk2(Sacc.z, Sacc.w)}; }
    }
    __syncthreads();
}

__device__ __forceinline__ void gla_pa_chunk(const Args& a, Frame& F, int ci) {
    const WsMap m = ws_map(NTOK);
    const int bh = ci >> 6, c = ci & 63, b = bh >> 2, h = bh & 3;
    const int lane = F.lane, w = F.wave, tid = F.tid;
    LAS bf16_t* KS2T = (LAS bf16_t*)F.lds; LAS bf16_t* VT = KS2T + RWT; LAS float* TMP = (LAS float*)(VT + 128 * RWP);
    const bf16_t* p16 = (const bf16_t*)(a.ws + m.p16); const bf16_t* ao = (const bf16_t*)(a.ws + m.auxo);
    bf16_t* gKV = (bf16_t*)(a.ws + m.glao) + (size_t)ci * 8192; float* gDV = (float*)(a.ws + m.gladv) + (size_t)ci * 64;
    const int j = tid >> 3, c8 = (tid & 7) * 8, v16 = (tid & 7) * 16;
    const size_t n = (size_t)b * TSEQ + c * 64 + j;
    float k8[8], la[8];
    unpack8(ld8(p16 + n * PLD + C_GLA + 256 + h * 64 + c8), k8); unpack8(ld8(ao + n * 1792 + 1536 + h * 64 + c8), la);
    const v4u v0 = ld8(p16 + n * PLD + C_GLA + 512 + h * 128 + v16), v1 = ld8(p16 + n * PLD + C_GLA + 512 + h * 128 + v16 + 8);
#pragma unroll
    for (int k = 0; k < 8; ++k) la[k] = -softplus_f(-la[k]) * (1.0f / 16.0f);
    chunk_cumsum8(la, TMP, lane, w, c8);
    float bl[8];
#pragma unroll
    for (int k = 0; k < 8; ++k) bl[k] = 0.f;
#pragma unroll
    for (int ww = 0; ww < 8; ++ww) { const f32x4 y0 = *(const LAS f32x4*)(TMP + ww * 64 + c8), y1 = *(const LAS f32x4*)(TMP + ww * 64 + c8 + 4);
        bl[0] += y0.x; bl[1] += y0.y; bl[2] += y0.z; bl[3] += y0.w; bl[4] += y1.x; bl[5] += y1.y; bl[6] += y1.z; bl[7] += y1.w; }
#pragma unroll
    for (int k = 0; k < 8; ++k) KS2T[(c8 + k) * RWP + j] = f2bf(k8[k] * __expf(bl[k] - la[k]));
    { const unsigned vw[8] = {v0.x, v0.y, v0.z, v0.w, v1.x, v1.y, v1.z, v1.w};
#pragma unroll
      for (int e = 0; e < 8; ++e) { VT[(v16 + 2 * e) * RWP + j] = (bf16_t)(vw[e] & 0xffffu); VT[(v16 + 2 * e + 1) * RWP + j] = (bf16_t)(vw[e] >> 16); } }
    if (j == 0) { *(f32x4*)(gDV + c8) = (f32x4){__expf(bl[0]), __expf(bl[1]), __expf(bl[2]), __expf(bl[3])}; *(f32x4*)(gDV + c8 + 4) = (f32x4){__expf(bl[4]), __expf(bl[5]), __expf(bl[6]), __expf(bl[7])}; }
    __syncthreads();
    {
        const f32x4 z4 = {0.f, 0.f, 0.f, 0.f};
#pragma unroll
        for (int tt = 0; tt < 4; ++tt) { const int mt = tt, nt = w;
            const f32x4 d = mm64(KS2T, VT, mt, nt, lane, z4);
            const int dv = nt * 16 + (lane & 15), k0 = mt * 16 + (lane >> 4) * 4;
            *(v2u*)(gKV + dv * 64 + k0) = (v2u){pk2(d.x, d.y), pk2(d.z, d.w)}; }
    }
    __syncthreads();
}
__device__ __forceinline__ void gla_sscan(const Args& a, Frame& F) {
    const WsMap m = ws_map(NTOK);
    const bf16_t* gKV = (const bf16_t*)(a.ws + m.glao); const float* gDV = (const float*)(a.ws + m.gladv); bf16_t* gS = (bf16_t*)(a.ws + m.glas);
    for (int it = F.vcu * NTHR + F.tid; it < 16 * 8192; it += F.G * NTHR) {
        const int bh = it >> 13, e = it & 8191, k = e & 63;
        float S = 0.f;
        bf16_t kn[16]; float dn[16];
#pragma unroll
        for (int u = 0; u < 16; ++u) { const size_t ci = (size_t)bh * 64 + u; kn[u] = gKV[ci * 8192 + e]; dn[u] = gDV[ci * 64 + k]; }
#pragma unroll 1
        for (int c0 = 0; c0 < 64; c0 += 16) {
            float kv[16], dv[16];
#pragma unroll
            for (int u = 0; u < 16; ++u) { kv[u] = bf2f(kn[u]); dv[u] = dn[u]; }
            if (c0 + 16 < 64) {
#pragma unroll
                for (int u = 0; u < 16; ++u) { const size_t ci = (size_t)bh * 64 + c0 + 16 + u; kn[u] = gKV[ci * 8192 + e]; dn[u] = gDV[ci * 64 + k]; } }
#pragma unroll
            for (int u = 0; u < 16; ++u) { const size_t ci = (size_t)bh * 64 + c0 + u; gS[ci * 8192 + e] = f2bf(S); S = S * dv[u] + kv[u]; }
        }
    }
}
__device__ __forceinline__ void gla_pb_chunk(const Args& a, Frame& F, int l, int ci) {
    const WsMap m = ws_map(NTOK);
    const int bh = ci >> 6, c = ci & 63, b = bh >> 2, h = bh & 3;
    const int lane = F.lane, w = F.wave, tid = F.tid;
    LAS bf16_t* QS = (LAS bf16_t*)F.lds; LAS bf16_t* KS = QS + RWT; LAS bf16_t* QG = KS + RWT; LAS bf16_t* PM = QG + RWT;
    LAS bf16_t* VT = PM + RWT; LAS bf16_t* ST = VT + 128 * RWP; LAS bf16_t* GG = ST + 128 * RWP;
    LAS float* TMP = (LAS float*)(GG + 64 * GP); LAS float* OSS = TMP + 512;
    const bf16_t* p16 = (const bf16_t*)(a.ws + m.p16); const bf16_t* ao = (const bf16_t*)(a.ws + m.auxo);
    const bf16_t* gS = (const bf16_t*)(a.ws + m.glas) + (size_t)ci * 8192; bf16_t* mix = (bf16_t*)(a.ws + m.mix16);
    const int j = tid >> 3, c8 = (tid & 7) * 8, v16 = (tid & 7) * 16;
    const size_t n = (size_t)b * TSEQ + c * 64 + j;
    float q8[8], k8[8], la[8];
    unpack8(ld8(p16 + n * PLD + C_GLA + h * 64 + c8), q8); unpack8(ld8(p16 + n * PLD + C_GLA + 256 + h * 64 + c8), k8); unpack8(ld8(ao + n * 1792 + 1536 + h * 64 + c8), la);
    const v4u v0 = ld8(p16 + n * PLD + C_GLA + 512 + h * 128 + v16), v1 = ld8(p16 + n * PLD + C_GLA + 512 + h * 128 + v16 + 8);
    const v4u g0 = ld8(p16 + n * PLD + C_GLA + 1024 + h * 128 + v16), g1 = ld8(p16 + n * PLD + C_GLA + 1024 + h * 128 + v16 + 8);
    const v4u s0 = ((const v4u*)gS)[tid], s1 = ((const v4u*)gS)[512 + tid];
#pragma unroll
    for (int k = 0; k < 8; ++k) la[k] = -softplus_f(-la[k]) * (1.0f / 16.0f);
    chunk_cumsum8(la, TMP, lane, w, c8);
    {
        float br[8], t0[8], t1[8], t2[8];
#pragma unroll
        for (int k = 0; k < 8; ++k) br[k] = 0.f;
#pragma unroll
        for (int ww = 0; ww < 4; ++ww) { const f32x4 y0 = *(const LAS f32x4*)(TMP + ww * 64 + c8), y1 = *(const LAS f32x4*)(TMP + ww * 64 + c8 + 4);
            br[0] += y0.x; br[1] += y0.y; br[2] += y0.z; br[3] += y0.w; br[4] += y1.x; br[5] += y1.y; br[6] += y1.z; br[7] += y1.w; }
#pragma unroll
        for (int k = 0; k < 8; ++k) { const float qq = q8[k] * 0.125f;
            t0[k] = qq * __expf(la[k] - br[k]); t1[k] = k8[k] * __expf(br[k] - la[k]); t2[k] = qq * __expf(la[k]); }
        *(LAS v4u*)(QS + j * RWP + c8) = pack8(t0); *(LAS v4u*)(KS + j * RWP + c8) = pack8(t1); *(LAS v4u*)(QG + j * RWP + c8) = pack8(t2);
        const unsigned vw[8] = {v0.x, v0.y, v0.z, v0.w, v1.x, v1.y, v1.z, v1.w};
#pragma unroll
        for (int e = 0; e < 8; ++e) { VT[(v16 + 2 * e) * RWP + j] = (bf16_t)(vw[e] & 0xffffu); VT[(v16 + 2 * e + 1) * RWP + j] = (bf16_t)(vw[e] >> 16); }
        *(LAS v4u*)(GG + j * GP + v16) = g0; *(LAS v4u*)(GG + j * GP + v16 + 8) = g1;
        { const int p0 = tid, p1 = 512 + tid;
          *(LAS v4u*)(ST + (p0 >> 3) * RWP + (p0 & 7) * 8) = s0; *(LAS v4u*)(ST + (p1 >> 3) * RWP + (p1 & 7) * 8) = s1; }
    }
    __syncthreads();
    {
        const f32x4 z4 = {0.f, 0.f, 0.f, 0.f};
#pragma unroll
        for (int tt = 0; tt < 2; ++tt) { const int t = w + 8 * tt, mtj = t >> 2, nti = t & 3;
            f32x4 s4 = mm64(KS, QS, mtj, nti, lane, z4);
            const int i = nti * 16 + (lane & 15), j0 = mtj * 16 + (lane >> 4) * 4;
#pragma unroll
            for (int e = 0; e < 4; ++e) if (j0 + e > i) s4[e] = 0.f;
            st_transposed(PM, mtj, nti, lane, s4); }
    }
    __syncthreads();
    {
        const int mt = w >> 1, ntb = (w & 1) * 4, r = lane & 15, i0 = mt * 16 + (lane >> 4) * 4;
        f32x4 o[4]; float ss[4] = {0.f, 0.f, 0.f, 0.f};
#pragma unroll
        for (int t = 0; t < 4; ++t) { o[t] = mm64(QG, ST, mt, ntb + t, lane, (f32x4){0.f, 0.f, 0.f, 0.f}); o[t] = mm64(PM, VT, mt, ntb + t, lane, o[t]);
            ss[0] += o[t].x * o[t].x; ss[1] += o[t].y * o[t].y; ss[2] += o[t].z * o[t].z; ss[3] += o[t].w * o[t].w; }
#pragma unroll
        for (int e = 0; e < 4; ++e) ss[e] = row16_sum(ss[e]);
        if (r == 0) {
#pragma unroll
            for (int e = 0; e < 4; ++e) OSS[(i0 + e) * 2 + (w & 1)] = ss[e]; }
        __syncthreads();
        float rs[4];
#pragma unroll
        for (int e = 0; e < 4; ++e) rs[e] = 1.0f / sqrtf((OSS[(i0 + e) * 2] + OSS[(i0 + e) * 2 + 1]) * (1.0f / 128.0f) + 1e-6f);
        const size_t nrow = (size_t)b * TSEQ + c * 64 + i0;
#pragma unroll
        for (int t = 0; t < 4; ++t) { const int dv = (ntb + t) * 16 + r; const float gn = a.in[I_GLA_NORM][l * 128 + dv];
            const float ov[4] = {o[t].x, o[t].y, o[t].z, o[t].w};
#pragma unroll
            for (int e = 0; e < 4; ++e) { const float g = bf2f(GG[(i0 + e) * GP + dv]);
                mix[(nrow + e) * DM + 512 + h * 128 + dv] = f2bf(ov[e] * rs[e] * gn * (g * sigm(g))); } }
    }
    __syncthreads();
}

__device__ __forceinline__ void lru_pass(const Args& a, Frame& F, int l, bool passB) {
    const WsMap m = ws_map(NTOK);
    const bf16_t* gt = (const bf16_t*)(a.ws + m.gates); const bf16_t* xc = (const bf16_t*)(a.ws + m.xc); const bf16_t* p16 = (const bf16_t*)(a.ws + m.p16);
    bf16_t* mix = (bf16_t*)(a.ws + m.mix16); float* lrs = (float*)(a.ws + m.lrs);
    for (int it = F.vcu * NTHR + F.tid; it < NBATCH * 64 * 512; it += F.G * NTHR) {
        const int ch = it & 511, bc = it >> 9, c = bc & 63;
        const float sp8 = 8.0f * softplus_f(-a.in[I_LRU_LAM][l * 512 + ch]);
        const size_t nb = (size_t)bc * 64;
        float hh = 0.f, ap = 1.f;
        if (passB) {
            f32x2 sn[8];
#pragma unroll
            for (int u = 0; u < 8; ++u) sn[u] = (u < c) ? *(const f32x2*)(lrs + ((size_t)(bc - c + u) * 512 + ch) * 2) : (f32x2){1.f, 0.f};
            for (int s0 = 0; s0 < c; s0 += 8) { f32x2 su[8];
#pragma unroll
                for (int u = 0; u < 8; ++u) su[u] = sn[u];
                if (s0 + 8 < c) {
#pragma unroll
                    for (int u = 0; u < 8; ++u) sn[u] = (s0 + 8 + u < c) ? *(const f32x2*)(lrs + ((size_t)(bc - c + s0 + 8 + u) * 512 + ch) * 2) : (f32x2){1.f, 0.f}; }
#pragma unroll
                for (int u = 0; u < 8; ++u) hh = su[u].x * hh + su[u].y; } }
        bf16_t rn[8], in_[8], xn_[8], yn[8];
#pragma unroll
        for (int u = 0; u < 8; ++u) { const size_t n = nb + u; rn[u] = gt[n * 1024 + ch]; in_[u] = gt[n * 1024 + 512 + ch]; xn_[u] = xc[n * 512 + ch];
            yn[u] = passB ? p16[n * PLD + C_LRU + 512 + ch] : (bf16_t)0; }
#pragma unroll 1
        for (int t0 = 0; t0 < 64; t0 += 8) {
            bf16_t rr[8], ii[8], xx[8], yy[8];
#pragma unroll
            for (int u = 0; u < 8; ++u) { rr[u] = rn[u]; ii[u] = in_[u]; xx[u] = xn_[u]; yy[u] = yn[u]; }
            if (t0 + 8 < 64) {
#pragma unroll
                for (int u = 0; u < 8; ++u) { const size_t n = nb + t0 + 8 + u; rn[u] = gt[n * 1024 + ch]; in_[u] = gt[n * 1024 + 512 + ch]; xn_[u] = xc[n * 512 + ch];
                    yn[u] = passB ? p16[n * PLD + C_LRU + 512 + ch] : (bf16_t)0; } }
#pragma unroll
            for (int u = 0; u < 8; ++u) { const size_t n = nb + t0 + u;
                const float la = -sp8 * sigm(bf2f(rr[u]));
                const float av = __expf(la);
                const float uu = bf2f(xx[u]) * sigm(bf2f(ii[u])) * sqrtf(fmaxf(1.0f - av * av, 0.0f));
                hh = av * hh + uu; ap *= av;
                if (passB) mix[n * DM + 1024 + ch] = f2bf(hh * gelu_fast(bf2f(yy[u]))); }
        }
        if (!passB) *(f32x2*)(lrs + ((size_t)bc * 512 + ch) * 2) = (f32x2){ap, hh};
    }
}

__device__ __forceinline__ void scan_phase(const Args& a, Frame& F, int l) {
    lru_pass(a, F, l, false);
    const int task = blockIdx.x;
    for (int q = 0; q < 8; ++q) rwkv_pa_chunk(a, F, l, task * 8 + q);
    for (int q = 0; q < 4; ++q) gdn_pa_chunk(a, F, task * 4 + q);
    for (int q = 0; q < 4; ++q) gla_pa_chunk(a, F, task * 4 + q);
    if (l == 0) tables_range(a, F, (size_t)2 * NEXP * DM / 32, (size_t)4 * NEXP * DM / 32, F.vcu, F.G);
}

__device__ __forceinline__ void post_phase(const Args& a, Frame& F, int l, const XcdBarrier& bar) {
    const WsMap m = ws_map(NTOK);
    if (blockIdx.x < 128) rwkv_ps_task(a, F, blockIdx.x); else gdn_ps_task(a, F, blockIdx.x - 128);
    gla_sscan(a, F);
    lru_pass(a, F, l, true);
    const bf16_t* p16 = (const bf16_t*)(a.ws + m.p16); const bf16_t* glao = (const bf16_t*)(a.ws + m.glao); const bf16_t* gdno = (const bf16_t*)(a.ws + m.gdno);
    const bf16_t* rwy = (const bf16_t*)(a.ws + m.rwy); const bf16_t* rwbv = (const bf16_t*)(a.ws + m.rwbv); const bf16_t* ao = (const bf16_t*)(a.ws + m.auxo);
    bf16_t* mix = (bf16_t*)(a.ws + m.mix16);
    const int lane = F.lane, col = lane * 8, hc = col & 127;
    float gg[8], gd[8], lw[8], lb[8];
    { const f32x4 x0 = *(const f32x4*)(a.in[I_GLA_NORM] + l * 128 + hc), x1 = *(const f32x4*)(a.in[I_GLA_NORM] + l * 128 + hc + 4);
      gg[0] = x0.x; gg[1] = x0.y; gg[2] = x0.z; gg[3] = x0.w; gg[4] = x1.x; gg[5] = x1.y; gg[6] = x1.z; gg[7] = x1.w;
      const f32x4 y0 = *(const f32x4*)(a.in[I_GDN_NORM] + l * 128 + hc), y1 = *(const f32x4*)(a.in[I_GDN_NORM] + l * 128 + hc + 4);
      gd[0] = y0.x; gd[1] = y0.y; gd[2] = y0.z; gd[3] = y0.w; gd[4] = y1.x; gd[5] = y1.y; gd[6] = y1.z; gd[7] = y1.w;
      const f32x4 w0 = *(const f32x4*)(a.in[I_RW_LN_W] + l * 512 + col), w1 = *(const f32x4*)(a.in[I_RW_LN_W] + l * 512 + col + 4);
      lw[0] = w0.x; lw[1] = w0.y; lw[2] = w0.z; lw[3] = w0.w; lw[4] = w1.x; lw[5] = w1.y; lw[6] = w1.z; lw[7] = w1.w;
      const f32x4 b0 = *(const f32x4*)(a.in[I_RW_LN_B] + l * 512 + col), b1 = *(const f32x4*)(a.in[I_RW_LN_B] + l * 512 + col + 4);
      lb[0] = b0.x; lb[1] = b0.y; lb[2] = b0.z; lb[3] = b0.w; lb[4] = b1.x; lb[5] = b1.y; lb[6] = b1.z; lb[7] = b1.w; }
    for (int pass = 1; pass < 2; ++pass) {
    if (pass == 1) xcd_barrier(bar);
    for (int q = 0; q < 4; ++q) gla_pb_chunk(a, F, l, blockIdx.x * 4 + q);
    v4u nx[5];
    if (F.gw < NTOK) { const size_t n = (size_t)F.gw; nx[0] = ld8(rwy + n * 512 + col); nx[1] = ld8(rwbv + n * 512 + col); nx[2] = ld8(ao + n * 1792 + 1024 + col);
        nx[3] = ld8(gdno + n * 512 + col); nx[4] = ld8(p16 + n * PLD + C_GDN + 1536 + col); }
    for (int n = F.gw; n < NTOK; n += F.ngw) {
        v4u cu[5];
#pragma unroll
        for (int k = 0; k < 5; ++k) cu[k] = nx[k];
        if (n + F.ngw < NTOK) { const size_t n1 = (size_t)(n + F.ngw); nx[0] = ld8(rwy + n1 * 512 + col); nx[1] = ld8(rwbv + n1 * 512 + col); nx[2] = ld8(ao + n1 * 1792 + 1024 + col);
            nx[3] = ld8(gdno + n1 * 512 + col); nx[4] = ld8(p16 + n1 * PLD + C_GDN + 1536 + col); }
        if (pass == 1) {
            float y[8], bv[8], g[8];
            unpack8(cu[0], y); unpack8(cu[1], bv); unpack8(cu[2], g);
            float s = 0.f;
#pragma unroll
            for (int k = 0; k < 8; ++k) s += y[k];
            const float mean = red8(s) * (1.0f / 64.0f);
            float s2 = 0.f;
#pragma unroll
            for (int k = 0; k < 8; ++k) { y[k] -= mean; s2 += y[k] * y[k]; }
            const float rs = 1.0f / sqrtf(red8(s2) * (1.0f / 64.0f) + 64e-5f);
#pragma unroll
            for (int k = 0; k < 8; ++k) y[k] = (y[k] * rs * lw[k] + lb[k] + bv[k]) * g[k];
            *(v4u*)(mix + (size_t)n * DM + col) = pack8(y);
        }
        if (pass == 1)
#pragma unroll
        for (int which = 1; which < 2; ++which) {
            float o[8], g[8];
            unpack8(cu[3], o);
            unpack8(cu[4], g);
            float ss = 0.f;
#pragma unroll
            for (int k = 0; k < 8; ++k) ss += o[k] * o[k];
            ss = row16_sum(ss);
            const float rs = 1.0f / sqrtf(ss * (1.0f / 128.0f) + 1e-6f);
#pragma unroll
            for (int k = 0; k < 8; ++k) o[k] = o[k] * rs * (which ? gd[k] : gg[k]) * (g[k] * sigm(g[k]));
            *(v4u*)(mix + (size_t)n * DM + (which ? 1536 : 512) + col) = pack8(o);
        }
    }
    }
}

__device__ __forceinline__ void norm2_phase(const Args& a, Frame& F, int l) {
    const WsMap m = ws_map(NTOK);
    const float* gain = a.in[I_NORM_FFN] + l * DM;
    f32x4 gv[8];
#pragma unroll
    for (int j = 0; j < 8; ++j) gv[j] = ((const f32x4*)gain)[64 * j + F.lane];
    for (int n = F.gw; n < NTOK; n += F.ngw) {
        const f32x4* xr = (const f32x4*)(a.out + (size_t)n * DM) + F.lane;
        f32x4 v[8]; float s = 0.f;
#pragma unroll
        for (int j = 0; j < 8; ++j) { v[j] = xr[64 * j]; s += (v[j].x * v[j].x + v[j].y * v[j].y) + (v[j].z * v[j].z + v[j].w * v[j].w); }
        const float rstd = 1.0f / sqrtf(wave_sum_u(s) * (1.0f / DM) + 1e-6f);
        v2u* o8 = (v2u*)((bf16_t*)(a.ws + m.hb) + (size_t)n * DM) + F.lane;
        unsigned char* hq = a.ws + m.mix16 + (size_t)n * 2304;
#pragma unroll
        for (int j = 0; j < 8; ++j) {
            const float y0 = v[j].x * rstd * gv[j].x, y1 = v[j].y * rstd * gv[j].y, y2 = v[j].z * rstd * gv[j].z, y3 = v[j].w * rstd * gv[j].w;
            v2u w; w.x = pk2(y0, y1); w.y = pk2(y2, y3); o8[64 * j] = w;
            float am = __builtin_fmaxf(__builtin_fmaxf(__builtin_fabsf(y0), __builtin_fabsf(y1)), __builtin_fmaxf(__builtin_fabsf(y2), __builtin_fabsf(y3)));
            am = __builtin_fmaxf(am, dpp_f<0xB1>(am)); am = __builtin_fmaxf(am, dpp_f<0x4E>(am)); am = __builtin_fmaxf(am, dpp_f<0x141>(am)); am = __builtin_fmaxf(am, 1e-20f);
            const float xinv = 119.0f / am;
            const int q0 = (int)__builtin_rintf(y0 * xinv), q1 = (int)__builtin_rintf(y1 * xinv), q2 = (int)__builtin_rintf(y2 * xinv), q3 = (int)__builtin_rintf(y3 * xinv);
            const int h0 = (q0 + 8) >> 4, h1 = (q1 + 8) >> 4, h2 = (q2 + 8) >> 4, h3 = (q3 + 8) >> 4;
            const unsigned ph = ((unsigned)h0 & 15u) | (((unsigned)h1 & 15u) << 4) | (((unsigned)h2 & 15u) << 8) | (((unsigned)h3 & 15u) << 12);
            const unsigned pl = ((unsigned)(q0 - 16 * h0) & 15u) | (((unsigned)(q1 - 16 * h1) & 15u) << 4) | (((unsigned)(q2 - 16 * h2) & 15u) << 8) | (((unsigned)(q3 - 16 * h3) & 15u) << 12);
            *(unsigned short*)(hq + 128 * j + 2 * F.lane) = (unsigned short)ph;
            *(unsigned short*)(hq + 1024 + 128 * j + 2 * F.lane) = (unsigned short)pl;
            if ((F.lane & 7) == 0) *(float*)(hq + 2048 + 32 * j + 4 * (F.lane >> 3)) = am * (1.0f / 119.0f);
        }
    }
}

#define TK_CE(A, B) do { const float mx_ = fmaxf(A, B), mn_ = fminf(A, B); A = mx_; B = mn_; } while (0)
__device__ __forceinline__ void tk_sort16_desc(float (&x)[16]) {
#pragma unroll
    for (int k = 2; k <= 16; k <<= 1)
#pragma unroll
        for (int j = k >> 1; j > 0; j >>= 1)
#pragma unroll
            for (int i = 0; i < 16; ++i) { const int p = i ^ j;
                if (p > i) { if ((i & k) == 0) TK_CE(x[i], x[p]); else TK_CE(x[p], x[i]); } }
}
__device__ __forceinline__ void tk_merge16(float (&run)[16], const float (&g)[16]) {
#pragma unroll
    for (int i = 0; i < 16; ++i) run[i] = fmaxf(run[i], g[15 - i]);
#pragma unroll
    for (int j = 8; j > 0; j >>= 1)
#pragma unroll
        for (int i = 0; i < 16; ++i) { const int p = i ^ j; if (p > i) TK_CE(run[i], run[p]); }
}
__device__ __forceinline__ float tk_tag(float v, unsigned tag, unsigned mask) { return __builtin_bit_cast(float, (__builtin_bit_cast(unsigned, v) & ~mask) | tag); }
__device__ __forceinline__ void topk_phase(const Args& a, Frame& F, int l) {
    const WsMap m = ws_map(NTOK);
    const float* tsu = (const float*)(a.ws + m.tsc) + (size_t)l * 2 * NEXP; const float* tsv = tsu + NEXP; float* sug = (float*)(a.ws + m.act);
    const float* sc = (const float*)(a.ws + m.sc);
    int* idx = (int*)(a.ws + m.idx); float* gate = (float*)(a.ws + m.gate);
    LAS float* LS = (LAS float*)F.lds;
    const int t = F.tid;
    for (int wv = F.gw; wv < (NTOK / 64) * 8; wv += F.ngw) {
        const int h = wv & 7, n = (wv >> 3) * 64 + F.lane;
        const float* sp = sc + (size_t)(h * 256) * NTOK + n;
        float s0[16], s1[16];
#pragma unroll
        for (int half = 0; half < 2; ++half) {
            float run[16];
#pragma unroll
            for (int j = 0; j < 16; ++j) run[j] = -3.0e38f;
            float xn[16];
#pragma unroll
            for (int k = 0; k < 16; ++k) xn[k] = sp[(size_t)(half * 128 + k) * NTOK];
#pragma unroll 1
            for (int g = 0; g < 8; ++g) {
                float x[16];
#pragma unroll
                for (int k = 0; k < 16; ++k) x[k] = tk_tag(xn[k], (unsigned)(g * 16 + k), 127u);
                if (g + 1 < 8) {
#pragma unroll
                    for (int k = 0; k < 16; ++k) xn[k] = sp[(size_t)(half * 128 + (g + 1) * 16 + k) * NTOK]; }
                tk_sort16_desc(x);
                tk_merge16(run, x);
            }
#pragma unroll
            for (int j = 0; j < 16; ++j) { if (half) s1[j] = run[j]; else s0[j] = run[j]; LS[(half * 16 + j) * 512 + t] = run[j]; }
        }
        float run[16];
#pragma unroll
        for (int j = 0; j < 16; ++j) run[j] = -3.0e38f;
        {
            float x[16]; int cnt = 0;
#pragma unroll
            for (int p = 0; p < 16; ++p)
#pragma unroll
                for (int q = 0; q < 16; ++q) if ((p + 1) * (q + 1) <= 16) {
                    x[cnt & 15] = tk_tag(s0[p] + s1[q], (unsigned)(p * 16 + q), 255u); ++cnt;
                    if ((cnt & 15) == 0) { tk_sort16_desc(x); tk_merge16(run, x); }
                }
#pragma unroll
            for (int k = 0; k < 16; ++k) if (k >= (cnt & 15)) x[k] = -3.0e38f;
            tk_sort16_desc(x); tk_merge16(run, x);
        }
        const float mx = run[0]; float den = 0.f; float e[16]; int ti[16];
#pragma unroll
        for (int j = 0; j < 16; ++j) {
            const unsigned tg = __builtin_bit_cast(unsigned, run[j]) & 255u; const int p = (int)(tg >> 4), q = (int)(tg & 15u);
            const unsigned k0 = __builtin_bit_cast(unsigned, LS[(0 * 16 + p) * 512 + t]) & 127u, k1 = __builtin_bit_cast(unsigned, LS[(1 * 16 + q) * 512 + t]) & 127u;
            ti[j] = (int)(k0 * 128u + k1);
            e[j] = __expf(run[j] - mx); den += e[j];
        }
        const float inv = 1.0f / den;
        const size_t it = (size_t)n * 8 + h;
        float su[16];
#pragma unroll
        for (int j = 0; j < 16; ++j) { su[j] = tsu[ti[j]]; e[j] *= tsv[ti[j]]; }
        f32x4* go = (f32x4*)(gate + it * 16); v4u* io = (v4u*)(idx + it * 16); f32x4* so = (f32x4*)(sug + it * 16);
#pragma unroll
        for (int j = 0; j < 4; ++j) { go[j] = (f32x4){e[4 * j] * inv, e[4 * j + 1] * inv, e[4 * j + 2] * inv, e[4 * j + 3] * inv};
            so[j] = (f32x4){su[4 * j], su[4 * j + 1], su[4 * j + 2], su[4 * j + 3]};
            io[j] = (v4u){(unsigned)ti[4 * j], (unsigned)ti[4 * j + 1], (unsigned)ti[4 * j + 2], (unsigned)ti[4 * j + 3]}; }
    }
}

typedef float f32x2_t __attribute__((ext_vector_type(2)));
typedef int v4i __attribute__((ext_vector_type(4)));
struct PeerSplit { int ng, g, nwg, w0; };
__device__ __forceinline__ PeerSplit peer_split(const Frame& F) {
    PeerSplit p; p.ng = F.G < 8 ? F.G : 8; p.g = (int)blockIdx.x % p.ng; p.nwg = (F.G - p.g + p.ng - 1) / p.ng; p.w0 = ((int)blockIdx.x / p.ng) * NWAVES + F.wave; return p;
}
__device__ __forceinline__ float xl32(float v, int lane) { return __builtin_bit_cast(float, __builtin_amdgcn_ds_bpermute((lane ^ 32) << 2, __builtin_bit_cast(int, v))); }
constexpr int PU_CH = 12, PV_CH = 6;
constexpr int PU_E = 0, PU_XH = PU_CH * 512, PU_XL = PU_XH + PU_CH * 128, PU_SC = PU_XL + PU_CH * 128, PU_O = PU_SC + PU_CH * 32, PU_WB = PU_O + PU_CH * 512;
constexpr int PV_E = 0, PV_C = PV_CH * 512, PV_X = 2 * PV_CH * 512, PV_SQ = PV_X + PV_CH * 1024, PV_WB = PV_SQ + 64;
static_assert(8 * PU_WB <= 131072 && 8 * PV_WB <= 131072 && PU_WB % 64 == 0 && PV_WB % 64 == 0, "PEER staging must fit the LDS ring area");
__device__ __forceinline__ void fmac(float& acc, float x, float y) { asm("v_fmac_f32 %0, %1, %2" : "+v"(acc) : "v"(x), "v"(y)); }
template <int B> __device__ __forceinline__ float code_f(unsigned w) { return __builtin_bit_cast(float, __builtin_amdgcn_perm(w, 0x3Fu, 0x00040C0Cu + ((unsigned)B << 16))); }
__device__ __forceinline__ float swz4(float v) { return __builtin_bit_cast(float, __builtin_amdgcn_ds_swizzle(__builtin_bit_cast(int, v), 0x101F)); }
__device__ __forceinline__ void lds_ld16(const LAS unsigned char* p, int (&e)[16]) {
#pragma unroll
    for (int k = 0; k < 4; ++k) { const v4u t = ((const LAS v4u*)p)[k]; e[4 * k] = (int)t.x; e[4 * k + 1] = (int)t.y; e[4 * k + 2] = (int)t.z; e[4 * k + 3] = (int)t.w; }
}
__device__ __forceinline__ void peer_u_phase(const Args& a, Frame& F, int l) {
    const WsMap m = ws_map(NTOK);
    const PeerSplit ps = peer_split(F);
    const int lane = F.lane, r = lane >> 3, q = lane & 7;
    const int* idx = (const int*)(a.ws + m.idx);
    float* dpart = (float*)(a.ws + m.dpart);
    const bool q0b = (lane & 1) != 0, q1b = (lane & 2) != 0, q2b = (lane & 4) != 0;
    const int qrow = (q0b ? 8 : 0) + (q1b ? 4 : 0) + (q2b ? 2 : 0);
    const int stride = ps.nwg * NWAVES;
    if (ps.w0 >= NTOK) return;
    const int nt = (NTOK - 1 - ps.w0) / stride + 1;
    LAS unsigned char* wb = F.lds + F.wave * PU_WB;
    for (int s = ps.g; s < 8; s += ps.ng) {
        const unsigned char* TU = (const unsigned char*)(a.ws + m.tabu) + ((size_t)(l * 2) * 8 + s) * NEXP * TSL; const unsigned q16 = (unsigned)q * 16u;
        const unsigned char* hqs = a.ws + m.mix16 + 128 * s;
        v4u se[PU_CH / 2], sxh[2], sxl[2]; float ssc[2];
        auto stage_load = [&](int tb) {
            const int cnt = nt - tb < PU_CH ? nt - tb : PU_CH;
#pragma unroll
            for (int k = 0; k < PU_CH / 2; ++k) { const int j = 2 * k + (lane >> 5);
                se[k] = *(const v4u*)(idx + (size_t)(ps.w0 + (tb + (j < cnt ? j : cnt - 1)) * stride) * 128 + (lane & 31) * 4); }
#pragma unroll
            for (int k = 0; k < 2; ++k) { const int j = 8 * k + r;
                const unsigned char* hn = hqs + (size_t)(ps.w0 + (tb + (j < cnt ? j : cnt - 1)) * stride) * 2304;
                sxh[k] = *(const v4u*)(hn + 16 * q); sxl[k] = *(const v4u*)(hn + 1024 + 16 * q); ssc[k] = *(const float*)(hn + 2048 - 96 * s + 4 * q); }
        };
        stage_load(0);
#pragma unroll 1
        for (int tb = 0; tb < nt; tb += PU_CH) {
            const int cnt = nt - tb < PU_CH ? nt - tb : PU_CH;
#pragma unroll
            for (int k = 0; k < PU_CH / 2; ++k) *(LAS v4u*)(wb + PU_E + (2 * k + (lane >> 5)) * 512 + (lane & 31) * 16) = se[k];
#pragma unroll
            for (int k = 0; k < 2; ++k) if (8 * k + r < PU_CH) { const int j = 8 * k + r;
                *(LAS v4u*)(wb + PU_XH + j * 128 + q * 16) = sxh[k]; *(LAS v4u*)(wb + PU_XL + j * 128 + q * 16) = sxl[k]; *(LAS float*)(wb + PU_SC + j * 32 + q * 4) = ssc[k]; }
            int ec[16]; v4u row[8];
            lds_ld16(wb + PU_E + r * 64, ec);
#pragma unroll
            for (int i = 0; i < 8; ++i) row[i] = *(const v4u*)(TU + (((unsigned)ec[i] << 7) | q16));
#pragma unroll 1
            for (int j = 0; j < cnt; ++j) {
                int en[16];
                lds_ld16(wb + PU_E + (j + 1 < cnt ? j + 1 : j) * 512 + r * 64, en);
                const v4u xh = *(const LAS v4u*)(wb + PU_XH + j * 128 + q * 16), xl = *(const LAS v4u*)(wb + PU_XL + j * 128 + q * 16);
                const float xscale = *(const LAS float*)(wb + PU_SC + j * 32 + q * 4);
                int sh = 0, sl = 0;
#pragma unroll
                for (int d = 0; d < 4; ++d) { sh = __builtin_amdgcn_sdot8((int)xh[d], 0x11111111, sh, false); sl = __builtin_amdgcn_sdot8((int)xl[d], 0x11111111, sl, false); }
                const float xoff = 0.5f * (float)(16 * sh + sl);
                float tp[16];
#pragma unroll
                for (int hf = 0; hf < 2; ++hf)
#pragma unroll
                for (int i = 0; i < 8; ++i) {
                    int ia = 0, ib = 0;
#pragma unroll
                    for (int d = 0; d < 4; ++d) { ia = __builtin_amdgcn_sdot8((int)row[i][d], (int)xh[d], ia, false); ib = __builtin_amdgcn_sdot8((int)row[i][d], (int)xl[d], ib, false); }
                    row[i] = *(const v4u*)(TU + (((unsigned)(hf ? en[i] : ec[8 + i]) << 7) | q16));
                    __builtin_amdgcn_sched_barrier(0);
                    tp[8 * hf + i] = ((float)(16 * ia + ib) + xoff) * xscale;
                }
                float ta[8], tb2[4];
#pragma unroll
                for (int p = 0; p < 8; ++p) { const float kk = q0b ? tp[p + 8] : tp[p], ss = q0b ? tp[p] : tp[p + 8]; ta[p] = kk + dpp_f<0xB1>(ss); }
#pragma unroll
                for (int p = 0; p < 4; ++p) { const float kk = q1b ? ta[p + 4] : ta[p], ss = q1b ? ta[p] : ta[p + 4]; tb2[p] = kk + dpp_f<0x4E>(ss); }
                const float k0 = (q2b ? tb2[2] : tb2[0]) + swz4(q2b ? tb2[0] : tb2[2]), k1 = (q2b ? tb2[3] : tb2[1]) + swz4(q2b ? tb2[1] : tb2[3]);
                ((LAS f32x2_t*)(wb + PU_O))[j * 64 + lane] = (f32x2_t){k0, k1};
#pragma unroll
                for (int i = 0; i < 16; ++i) ec[i] = en[i];
            }
            if (tb + PU_CH < nt) stage_load(tb + PU_CH);
#pragma unroll 1
            for (int j = 0; j < cnt; ++j) *(f32x2_t*)(dpart + ((size_t)s * NTOK + (ps.w0 + (tb + j) * stride)) * 128 + 16 * r + qrow) = ((LAS f32x2_t*)(wb + PU_O))[j * 64 + lane];
            __builtin_amdgcn_s_waitcnt(0);
        }
    }
}
typedef _Float16 h2_t __attribute__((ext_vector_type(2)));
__device__ __forceinline__ float coef_pack(float c) { const _Float16 h = (_Float16)(c * 256.0f); return __builtin_bit_cast(float, (h2_t){h, h}); }
__device__ __forceinline__ void peer_c_phase(const Args& a, Frame& F) {
    const WsMap m = ws_map(NTOK);
    float* gate = (float*)(a.ws + m.gate); const float* sug = (const float*)(a.ws + m.act); const float* dpart = (const float*)(a.ws + m.dpart);
    for (int n = F.gw; n < NTOK; n += F.ngw) {
        const size_t j0 = (size_t)n * 128 + 2 * F.lane;
        f32x2_t dp[8];
#pragma unroll
        for (int sp = 0; sp < 8; ++sp) dp[sp] = *(const f32x2_t*)(dpart + (size_t)sp * NTOK * 128 + j0);
        const f32x2_t gt = *(const f32x2_t*)(gate + j0), su = *(const f32x2_t*)(sug + j0);
        const f32x2_t d = ((dp[0] + dp[1]) + (dp[2] + dp[3])) + ((dp[4] + dp[5]) + (dp[6] + dp[7]));
        *(f32x2_t*)(gate + j0) = (f32x2_t){coef_pack(gelu_fast(d.x * su.x) * gt.x), coef_pack(gelu_fast(d.y * su.y) * gt.y)};
    }
}
__device__ __forceinline__ void peer_v_phase(const Args& a, Frame& F, int l) {
    const WsMap m = ws_map(NTOK);
    const PeerSplit ps = peer_split(F);
    const int lane = F.lane, r = lane >> 3, q = lane & 7;
    const int* idx = (const int*)(a.ws + m.idx); const float* coef = (const float*)(a.ws + m.gate);
    float* ssq = (float*)(a.ws + m.ssq);
    const bool b3 = (lane & 8) != 0, b4 = (lane & 16) != 0, b5 = (lane & 32) != 0;
    const int c0 = (b3 ? 16 : 0) + (b4 ? 8 : 0) + (b5 ? 4 : 0);
    const int stride = ps.nwg * NWAVES;
    if (ps.w0 >= NTOK) return;
    const int nt = (NTOK - 1 - ps.w0) / stride + 1;
    LAS unsigned char* wb = F.lds + F.wave * PV_WB;
    for (int s = ps.g; s < 8; s += ps.ng) {
        const unsigned char* TV = (const unsigned char*)(a.ws + m.tabu) + ((size_t)(l * 2 + 1) * 8 + s) * NEXP * TSL; const unsigned q16 = (unsigned)q * 16u;
        v4u se[PV_CH / 2], sc[PV_CH / 2]; f32x4 sx[PV_CH];
        auto stage_load = [&](int tb) {
            const int cnt = nt - tb < PV_CH ? nt - tb : PV_CH;
#pragma unroll
            for (int k = 0; k < PV_CH / 2; ++k) { const int j = 2 * k + (lane >> 5); const size_t n = (size_t)(ps.w0 + (tb + (j < cnt ? j : cnt - 1)) * stride);
                se[k] = *(const v4u*)(idx + n * 128 + (lane & 31) * 4); sc[k] = *(const v4u*)(coef + n * 128 + (lane & 31) * 4); }
#pragma unroll
            for (int j = 0; j < PV_CH; ++j) sx[j] = *(const f32x4*)(a.out + (size_t)(ps.w0 + (tb + (j < cnt ? j : cnt - 1)) * stride) * DM + 256 * s + lane * 4);
        };
        stage_load(0);
#pragma unroll 1
        for (int tb = 0; tb < nt; tb += PV_CH) {
            const int cnt = nt - tb < PV_CH ? nt - tb : PV_CH;
#pragma unroll
            for (int k = 0; k < PV_CH / 2; ++k) { *(LAS v4u*)(wb + PV_E + (2 * k + (lane >> 5)) * 512 + (lane & 31) * 16) = se[k]; *(LAS v4u*)(wb + PV_C + (2 * k + (lane >> 5)) * 512 + (lane & 31) * 16) = sc[k]; }
#pragma unroll
            for (int j = 0; j < PV_CH; ++j) *(LAS f32x4*)(wb + PV_X + j * 1024 + lane * 16) = sx[j];
            int ec[16]; v4u row[8];
            lds_ld16(wb + PV_E + r * 64, ec);
#pragma unroll
            for (int i = 0; i < 8; ++i) row[i] = *(const v4u*)(TV + (((unsigned)ec[i] << 7) | q16));
#pragma unroll 1
            for (int j = 0; j < cnt; ++j) {
                int en[16];
                lds_ld16(wb + PV_E + (j + 1 < cnt ? j + 1 : j) * 512 + r * 64, en);
                float ci[16];
#pragma unroll
                for (int k = 0; k < 4; ++k) { const f32x4 t = ((const LAS f32x4*)(wb + PV_C + j * 512 + r * 64))[k]; ci[4 * k] = t.x; ci[4 * k + 1] = t.y; ci[4 * k + 2] = t.z; ci[4 * k + 3] = t.w; }
                const f32x4 x4 = *(const LAS f32x4*)(wb + PV_X + j * 1024 + (32 * q + c0) * 4);
                h2_t oh[16];
#pragma unroll
                for (int i = 0; i < 16; ++i) oh[i] = (h2_t){(_Float16)0.f, (_Float16)0.f};
#pragma unroll
                for (int hf = 0; hf < 2; ++hf)
#pragma unroll
                for (int i = 0; i < 8; ++i) {
                    const h2_t c2 = __builtin_bit_cast(h2_t, ci[8 * hf + i]);
#pragma unroll
                    for (int d = 0; d < 4; ++d) {
                        oh[4 * d + 0] = __builtin_elementwise_fma(__builtin_bit_cast(h2_t, __builtin_amdgcn_cvt_scalef32_pk_f16_fp4(row[i][d], 1.0f, 0)), c2, oh[4 * d + 0]);
                        oh[4 * d + 1] = __builtin_elementwise_fma(__builtin_bit_cast(h2_t, __builtin_amdgcn_cvt_scalef32_pk_f16_fp4(row[i][d], 1.0f, 1)), c2, oh[4 * d + 1]);
                        oh[4 * d + 2] = __builtin_elementwise_fma(__builtin_bit_cast(h2_t, __builtin_amdgcn_cvt_scalef32_pk_f16_fp4(row[i][d], 1.0f, 2)), c2, oh[4 * d + 2]);
                        oh[4 * d + 3] = __builtin_elementwise_fma(__builtin_bit_cast(h2_t, __builtin_amdgcn_cvt_scalef32_pk_f16_fp4(row[i][d], 1.0f, 3)), c2, oh[4 * d + 3]); }
                    row[i] = *(const v4u*)(TV + (((unsigned)(hf ? en[i] : ec[8 + i]) << 7) | q16));
                    __builtin_amdgcn_sched_barrier(0);
                }
                h2_t ha[8], hb[4], hc[2];
#pragma unroll
                for (int p = 0; p < 8; ++p) { const h2_t kk = b3 ? oh[p + 8] : oh[p], ss = b3 ? oh[p] : oh[p + 8];
                    ha[p] = kk + __builtin_bit_cast(h2_t, dpp_f<0x128>(__builtin_bit_cast(float, ss))); }
#pragma unroll
                for (int p = 0; p < 4; ++p) { const h2_t kk = b4 ? ha[p + 4] : ha[p], ss = b4 ? ha[p] : ha[p + 4];
                    hb[p] = kk + __builtin_bit_cast(h2_t, swz16(__builtin_bit_cast(float, ss))); }
#pragma unroll
                for (int p = 0; p < 2; ++p) { const h2_t kk = b5 ? hb[p + 2] : hb[p], ss = b5 ? hb[p] : hb[p + 2];
                    hc[p] = kk + __builtin_bit_cast(h2_t, xl32(__builtin_bit_cast(float, ss), lane)); }
                const float h3[4] = {(float)hc[0].x, (float)hc[0].y, (float)hc[1].x, (float)hc[1].y};
                const f32x4 o = {x4.x + h3[0] * (1.0f / 256.0f), x4.y + h3[1] * (1.0f / 256.0f), x4.z + h3[2] * (1.0f / 256.0f), x4.w + h3[3] * (1.0f / 256.0f)};
                *(LAS f32x4*)(wb + PV_X + j * 1024 + (32 * q + c0) * 4) = o;
                const float tot = wave_sum_u((o.x * o.x + o.y * o.y) + (o.z * o.z + o.w * o.w));
                if (lane == 0) ((LAS float*)(wb + PV_SQ))[j] = tot;
#pragma unroll
                for (int i = 0; i < 16; ++i) ec[i] = en[i];
            }
            if (tb + PV_CH < nt) stage_load(tb + PV_CH);
#pragma unroll 1
            for (int j = 0; j < cnt; ++j) { const int n = ps.w0 + (tb + j) * stride; const size_t off = (size_t)n * DM + 256 * s + lane * 4;
                const f32x4 o = *(const LAS f32x4*)(wb + PV_X + j * 1024 + lane * 16);
                *(f32x4*)(a.out + off) = o;
                if (l + 1 < NL) { v2u w; w.x = pk2(o.x, o.y); w.y = pk2(o.z, o.w); *(v2u*)((bf16_t*)(a.ws + m.xn) + off) = w; }
                if (lane == 0) ssq[(size_t)n * 8 + s] = ((const LAS float*)(wb + PV_SQ))[j]; }
            __builtin_amdgcn_s_waitcnt(0);
        }
    }
}
__device__ __forceinline__ void fnorm_phase(const Args& a, Frame& F) {
    const WsMap m = ws_map(NTOK);
    const float* ssq = (const float*)(a.ws + m.ssq);
    const int lane = F.lane;
    for (int n = F.gw; n < NTOK; n += F.ngw) {
        const f32x4 s0 = *(const f32x4*)(ssq + (size_t)n * 8), s1 = *(const f32x4*)(ssq + (size_t)n * 8 + 4);
        const float rstd = 1.0f / sqrtf((((s0.x + s0.y) + (s0.z + s0.w)) + ((s1.x + s1.y) + (s1.z + s1.w))) * (1.0f / DM) + 1e-6f);
        float* xrow = a.out + (size_t)n * DM;
        const float* gf = a.in[I_NORM_FINAL];
        f32x4 v[8];
#pragma unroll
        for (int k = 0; k < 8; ++k) v[k] = *(const f32x4*)(xrow + 256 * k + 4 * lane);
#pragma unroll
        for (int k = 0; k < 8; ++k) { const f32x4 g4 = *(const f32x4*)(gf + 256 * k + 4 * lane);
            *(f32x4*)(xrow + 256 * k + 4 * lane) = (f32x4){v[k].x * rstd * g4.x, v[k].y * rstd * g4.y, v[k].z * rstd * g4.z, v[k].w * rstd * g4.w}; }
    }
}

#define IN(k) (lo <= (k) && (k) < hi)
#define SEAM(k) do { if (IN(k) && IN((k) + 1)) xcd_barrier(bar); } while (0)
template <int l>
__device__ __forceinline__ void layer_phases(const Args& a, Frame& F, const XcdBarrier& bar, const WsMap& m, int lo, int hi) {
    constexpr int pb = l * PH_PER_LAYER;
        if (IN(pb + PH_GEMM1)) {
            pg8::GemmX g{(const bf16_t*)(a.ws + m.xn), (const bf16_t*)(a.ws + m.w1t) + (size_t)l * PLD * DM, NTOK, PLD, DM, DM};
            pg8::StaticOrder S; S.init(NTOK, PLD, F.G, (int)blockIdx.x);
            pg8::EpiBf16 E{(bf16_t*)(a.ws + m.p16), PLD, nullptr, l > 0 ? (const float*)(a.ws + m.ssq) : nullptr};
            pg8::gemm_phase<pg8::EpiBf16, pg8::StaticOrder, true, true>(F.lds, g, S, E);
            SEAM(pb + PH_GEMM1);
        }
        if (IN(pb + PH_PREP)) { prep_phase(a, F, l); SEAM(pb + PH_PREP); }
        if (IN(pb + PH_AUX)) {
            const float* PP = (const float*)(a.ws + m.pp);
            { pg8::GemmX g{(const bf16_t*)(a.ws + m.auxA), (const bf16_t*)(a.ws + m.auxwt) + (size_t)l * 1792 * 384, NTOK, 1792, 384, 384};
              pg8::StaticOrder S; S.init(NTOK, 1792, F.G, (int)blockIdx.x);
              pg8::EpiBf16 E{(bf16_t*)(a.ws + m.auxo), 1792, PP + l * 1792};
              pg8::gemm_phase<pg8::EpiBf16, pg8::StaticOrder, true, true>(F.lds, g, S, E); }
            { pg8::GemmX g{(const bf16_t*)(a.ws + m.xc), (const bf16_t*)(a.ws + m.lruwt) + (size_t)l * 1024 * 512, NTOK, 1024, 512, 512};
              pg8::StaticOrder S; S.init(NTOK, 1024, F.G, (int)blockIdx.x);
              pg8::EpiBf16 E{(bf16_t*)(a.ws + m.gates), 1024, PP + 3584 + l * 1024};
              pg8::gemm_phase<pg8::EpiBf16, pg8::StaticOrder, true, true>(F.lds, g, S, E); }
            if (l > 0) {
              pg8::GemmX g{(const bf16_t*)(a.ws + m.zrkv) + 1024, (const bf16_t*)(a.ws + m.vreswt), NTOK, 512, 512, 1536};
              pg8::StaticOrder S; S.init(NTOK, 512, F.G, (int)blockIdx.x);
              pg8::EpiBf16 E{(bf16_t*)(a.ws + m.vres), 512, PP + 5632};
              pg8::gemm_phase<pg8::EpiBf16, pg8::StaticOrder, true, true>(F.lds, g, S, E); }
            SEAM(pb + PH_AUX);
        }
        if (IN(pb + PH_SCAN)) { scan_phase(a, F, l); SEAM(pb + PH_SCAN); }
        if (IN(pb + PH_POST)) { post_phase(a, F, l, bar); SEAM(pb + PH_POST); }
        if (IN(pb + PH_GEMM2)) {
            pg8::GemmX g{(const bf16_t*)(a.ws + m.mix16), (const bf16_t*)(a.ws + m.w2t) + (size_t)l * DM * DM, NTOK, DM, DM, DM};
            pg8::StaticOrder S; S.init(NTOK, DM, F.G, (int)blockIdx.x);
            pg8::EpiF32<true> E{a.out, DM};
            pg8::gemm_phase<pg8::EpiF32<true>, pg8::StaticOrder, true, true>(F.lds, g, S, E);
            SEAM(pb + PH_GEMM2);
        }
        if (IN(pb + PH_NORM2)) { norm2_phase(a, F, l); SEAM(pb + PH_NORM2); }
        if (IN(pb + PH_GEMM3)) {
            pg8::GemmX g{(const bf16_t*)(a.ws + m.wsct) + (size_t)l * DM * DM, (const bf16_t*)(a.ws + m.hb), DM, NTOK, DM, DM};
            pg8::StaticOrder S; S.init(DM, NTOK, F.G, (int)blockIdx.x);
            pg8::EpiF32<false> E{(float*)(a.ws + m.sc), NTOK};
            pg8::gemm_phase<pg8::EpiF32<false>, pg8::StaticOrder, true, true>(F.lds, g, S, E);
            SEAM(pb + PH_GEMM3);
        }
        if (IN(pb + PH_TOPK)) { topk_phase(a, F, l); SEAM(pb + PH_TOPK); }
        if (IN(pb + PH_PEERU)) { peer_u_phase(a, F, l); SEAM(pb + PH_PEERU); }
        if (IN(pb + PH_PEERC)) { peer_c_phase(a, F); SEAM(pb + PH_PEERC); }
        if (IN(pb + PH_PEERV)) { peer_v_phase(a, F, l); SEAM(pb + PH_PEERV); }
}

#undef IN
#undef SEAM
__global__ void __launch_bounds__(NTHR, 2) mega(Args a) {
    extern __shared__ __attribute__((aligned(16))) unsigned char lds_raw[];
    Frame F;
    F.lds = (LAS unsigned char*)lds_raw;
    F.tid = threadIdx.x; F.lane = F.tid & 63; F.wave = __builtin_amdgcn_readfirstlane(F.tid >> 6);
    F.G = gridDim.x; { const int bx = blockIdx.x; F.vcu = (F.G % 8 == 0) ? (bx % 8) * (F.G / 8) + bx / 8 : bx; }
    F.gw = F.vcu * NWAVES + F.wave; F.ngw = F.G * NWAVES;
    volatile LAS unsigned* MISC = (volatile LAS unsigned*)(F.lds + MISC_OFF);
    if (F.tid < 32) MISC[F.tid] = 0u;
    __syncthreads();
    const WsMap m = ws_map(NTOK);
    unsigned* ctl = (unsigned*)(a.ws + m.ctl);
    XcdBarrier bar; bar.bar = ctl + 4096 + a.li * XCD_BAR_WORDS; bar.x = 0; bar.st = nullptr;
    const int lo = a.ph_lo, hi = a.ph_hi;
    if (hi - lo > 1) bar = xcd_barrier_post(ctl + 4096 + a.li * XCD_BAR_WORDS, MISC + 8);
#define IN(k) (lo <= (k) && (k) < hi)
#define SEAM(k) do { if (IN(k) && IN((k) + 1)) xcd_barrier(bar); } while (0)
    if (IN(PH_P0)) { p0_prologue(a, F); tables_range(a, F, 0, (size_t)2 * NEXP * DM / 32, F.vcu, F.G); SEAM(PH_P0); }
    layer_phases<0>(a, F, bar, m, lo, hi);
    layer_phases<1>(a, F, bar, m, lo, hi);
    if (IN(PH_FNORM)) fnorm_phase(a, F);
#undef IN
#undef SEAM
}

template <int ST>
__global__ void __launch_bounds__(256) stage_kernel(Params P, int l) {
    const long n = stage_items(P, ST, l);
    for (long it = blockIdx.x * 256L + threadIdx.x; it < n; it += gridDim.x * 256L) run_item(P, ST, l, it);
}
template <int ST>
static void launch_stage(const Params& P, int l, hipStream_t stream) {
    const long n = stage_items(P, ST, l);
    if (n <= 0) return;
    long blocks = (n + 255) / 256;
    if (blocks > 8192) blocks = 8192;
    stage_kernel<ST><<<dim3((unsigned)blocks), dim3(256), 0, stream>>>(P, l);
}
#define LS(X) case X: launch_stage<X>(P, l, stream); break;
static void launch_any(int st, const Params& P, int l, hipStream_t stream) {
    switch (st) {
        LS(ST_COPYX) LS(ST_RSTD) LS(ST_NORM1) LS(ST_GEMM1) LS(ST_RW_A0) LS(ST_RW_A1) LS(ST_RW_A2) LS(ST_RW_A3) LS(ST_RW_KKN)
        LS(ST_RW_SCAN) LS(ST_RW_POST) LS(ST_GLA_B0) LS(ST_GLA_SCAN) LS(ST_GLA_POST) LS(ST_LRU_C0) LS(ST_LRU_C1) LS(ST_LRU_SCAN)
        LS(ST_GDN_D0) LS(ST_GDN_D1) LS(ST_GDN_SCAN) LS(ST_GDN_POST) LS(ST_GEMM2) LS(ST_RSTD2) LS(ST_NORM2) LS(ST_GEMM3)
        LS(ST_SCORES) LS(ST_TOPK1) LS(ST_TOPK2) LS(ST_PEER_U) LS(ST_PEER_V) LS(ST_FRSTD) LS(ST_FNORM)
    }
}

extern "C" void kernel_launch(void* const* d_in, const int* in_sizes, int n_in, void* d_out, int out_size, void* d_ws,
                              size_t ws_size, hipStream_t stream) {
    static int grid = 0;
    if (grid == 0) {
        int dev = 0, cus = 0;
        (void)hipGetDevice(&dev);
        (void)hipDeviceGetAttribute(&cus, hipDeviceAttributeMultiprocessorCount, dev);
        (void)hipFuncSetAttribute((const void*)mega, hipFuncAttributeMaxDynamicSharedMemorySize, LDS_BYTES);
        grid = cus > 0 ? cus : 256;
    }
    Params P;
    memset(&P, 0, sizeof(P));
    fill_inputs(P, d_in);
    P.B = 4; P.T = 4096; P.N = 16384; P.pad = 0;
    P.xcur = (float*)d_out;
    bind_ws(P, (char*)d_ws);
    Args a;
    memset(&a, 0, sizeof(a));
    for (int i = 0; i < 38; ++i) a.in[i] = (const float*)d_in[i];
    a.out = (float*)d_out; a.ws = (unsigned char*)d_ws;
    (void)hipMemsetAsync(d_ws, 0, 1u << 20, stream);
    int li = 0;
    auto run_mega = [&](int lo, int hi) { a.ph_lo = lo; a.ph_hi = hi; a.li = li++; hipLaunchKernelGGL(mega, dim3(grid), dim3(NTHR), LDS_BYTES, stream, a); };
    run_mega(PH_P0, PH_TOTAL);
}
#endif
```

```cpp
#ifndef HOST_EMU
#include <hip/hip_runtime.h>
#include <cstring>
#define HD __host__ __device__ __forceinline__
#else
#include <cmath>
#include <cstdio>
#include <cstdlib>
#include <cstring>
#define HD inline
#endif

constexpr int DM = 2048;
constexpr int NL = 2;
constexpr int INC = 6424;
constexpr int C_RW = 0;
constexpr int C_GLA = 1792;
constexpr int C_LRU = 3344;
constexpr int C_GDN = 4368;
constexpr int NEXP = 16384;

typedef unsigned short bf16_t;
constexpr int PLD = 6656;
HD float bf2f(bf16_t h) { unsigned u = (unsigned)h << 16; float f; memcpy(&f, &u, 4); return f; }
HD bf16_t f2bf(float f) { unsigned u; memcpy(&u, &f, 4); return (bf16_t)((u + 0x7fffu + ((u >> 16) & 1u)) >> 16); }

struct Params {
    const float *x, *norm_mix, *w_in, *w_out, *rw_mu, *rw_w0, *rw_w_up, *rw_a0, *rw_a_up, *rw_g_up, *rw_k_k, *rw_k_a,
        *rw_r_k, *rw_ln_w, *rw_ln_b, *rw_v0, *rw_v_down, *rw_v_up, *gla_a_up, *gla_a_bias, *gla_norm, *lru_conv_w,
        *lru_conv_b, *lru_w_r, *lru_b_r, *lru_w_i, *lru_b_i, *lru_lam, *gdn_conv_w, *gdn_a_log, *gdn_dt_bias, *gdn_norm,
        *norm_ffn, *peer_wq, *peer_sub_keys, *peer_u, *peer_v, *norm_final;
    float* xcur;
    bf16_t* xn;
    bf16_t* hb;
    bf16_t* mix16;
    bf16_t* p16;
    float* sc;
    float* qf;
    float* rstd;
    float* vfirst;
    float* scr;
    float* act;
    float* gate;
    int* idx;
    int B, T, N, pad;
};

HD float sigmoidf_(float x) { return 1.0f / (1.0f + expf(-x)); }
HD float softplusf_(float x) { return log1pf(expf(-fabsf(x))) + fmaxf(x, 0.0f); }
HD float siluf_(float x) { return x * sigmoidf_(x); }
HD float geluf_(float x) { return 0.5f * x * (1.0f + tanhf(0.7978845608028654f * (x + 0.044715f * x * x * x))); }

enum Stage {
    ST_COPYX = 0,
    ST_RSTD, ST_NORM1, ST_GEMM1,
    ST_RW_A0, ST_RW_A1, ST_RW_A2, ST_RW_A3, ST_RW_KKN, ST_RW_SCAN, ST_RW_POST,
    ST_GLA_B0, ST_GLA_SCAN, ST_GLA_POST,
    ST_LRU_C0, ST_LRU_C1, ST_LRU_SCAN,
    ST_GDN_D0, ST_GDN_D1, ST_GDN_SCAN, ST_GDN_POST,
    ST_GEMM2, ST_RSTD2, ST_NORM2, ST_GEMM3, ST_SCORES, ST_TOPK1, ST_TOPK2, ST_PEER_U, ST_PEER_V,
    ST_FRSTD, ST_FNORM,
    ST_COUNT
};

constexpr long SO_ZS = 0, SO_R = 256, SO_DEC = 768, SO_KM = 1280, SO_KK = 1792, SO_A = 2304, SO_G = 2816, SO_V = 3328,
               SO_Y = 3840, SO_VD = 4352, SO_KKINV = 4384;
constexpr long SO_ALPHA = 0, SO_GO = 256;
constexpr long SO_XC = 0, SO_LA = 512, SO_LU = 1024;
constexpr long SO_QKV = 0, SO_GS = 1536, SO_DO = 1552;
constexpr long SCR_PER_TOK = 4400;
constexpr long SO_TS = 0, SO_TI = 256;

HD long stage_items(const Params& P, int st, int l) {
    const long N = P.N;
    switch (st) {
        case ST_COPYX: return N * DM;
        case ST_RSTD: case ST_RSTD2: case ST_FRSTD: return N;
        case ST_NORM1: case ST_NORM2: case ST_FNORM: return N * DM;
        case ST_GEMM1: return (N / 4) * (INC / 4);
        case ST_RW_A0: return N * 256;
        case ST_RW_A1: return N * 512;
        case ST_RW_A2: return l > 0 ? N * 32 : 0;
        case ST_RW_A3: return l > 0 ? N * 512 : 0;
        case ST_RW_KKN: return N * 8;
        case ST_RW_SCAN: return (long)P.B * 512;
        case ST_RW_POST: return N * 8;
        case ST_GLA_B0: return N * 256;
        case ST_GLA_SCAN: return (long)P.B * 512;
        case ST_GLA_POST: return N * 4;
        case ST_LRU_C0: return N * 512;
        case ST_LRU_C1: return N * 512;
        case ST_LRU_SCAN: return (long)P.B * 512;
        case ST_GDN_D0: return N * 1536;
        case ST_GDN_D1: return N * 4;
        case ST_GDN_SCAN: return (long)P.B * 512;
        case ST_GDN_POST: return N * 4;
        case ST_GEMM2: case ST_GEMM3: return (N / 4) * (DM / 4);
        case ST_SCORES: return N * 2048;
        case ST_TOPK1: return N * 16;
        case ST_TOPK2: return N * 8;
        case ST_PEER_U: return N * 128;
        case ST_PEER_V: return N * DM;
    }
    return 0;
}

HD void gemm_item(const bf16_t* A, const float* W, int ldw, const float* kscale, float* Cf, bf16_t* Ch, int ldc, int n4, long item, int mode) {
    const long r4 = item / n4;
    const int c4 = (int)(item % n4);
    const bf16_t* a0 = A + (r4 * 4) * (long)DM;
    const float* w = W + c4 * 4;
    float acc[4][4];
    for (int i = 0; i < 4; ++i)
        for (int j = 0; j < 4; ++j) acc[i][j] = 0.f;
    for (int k = 0; k < DM; ++k) {
        const float ks = kscale ? kscale[k] : 1.0f;
        const float w0 = w[(long)k * ldw + 0] * ks, w1 = w[(long)k * ldw + 1] * ks, w2 = w[(long)k * ldw + 2] * ks, w3 = w[(long)k * ldw + 3] * ks;
#pragma unroll
        for (int i = 0; i < 4; ++i) {
            const float a = bf2f(a0[(long)i * DM + k]);
            acc[i][0] += a * w0; acc[i][1] += a * w1; acc[i][2] += a * w2; acc[i][3] += a * w3;
        }
    }
#pragma unroll
    for (int i = 0; i < 4; ++i) {
        const long o = (r4 * 4 + i) * (long)ldc + c4 * 4;
#pragma unroll
        for (int j = 0; j < 4; ++j) {
            if (mode == 0) Ch[o + j] = f2bf(acc[i][j]);
            else if (mode == 1) Cf[o + j] += acc[i][j];
            else Cf[o + j] = acc[i][j];
        }
    }
}

#define PF(n, col) bf2f(P.p16[(long)(n) * PLD + (col)])
HD float rw_shift(const Params& P, int l, long n, int col) {
    const int t = (int)(n % P.T);
    const float cur = PF(n, C_RW + col);
    const float prev = t > 0 ? PF(n - 1, C_RW + col) : 0.f;
    return cur + (prev - cur) * P.rw_mu[l * 1792 + col];
}

HD void run_item(const Params& P, int st, int l, long it) {
    const long N = P.N;
    float* scr = P.scr;
    switch (st) {
        case ST_COPYX: P.xcur[it] = P.x[it]; break;
        case ST_RSTD: case ST_RSTD2: case ST_FRSTD: {
            const float* xr = P.xcur + it * DM;
            float s = 0.f;
            for (int d = 0; d < DM; ++d) s += xr[d] * xr[d];
            P.rstd[it] = 1.0f / sqrtf(s * (1.0f / DM) + 1e-6f);
        } break;
        case ST_NORM1: case ST_NORM2: case ST_FNORM: {
            const long n = it / DM; const int d = (int)(it % DM);
            if (st == ST_NORM1) P.xn[it] = f2bf(P.xcur[it] * P.rstd[n]);
            else if (st == ST_NORM2) P.hb[it] = f2bf(P.xcur[it] * P.rstd[n] * P.norm_ffn[l * DM + d]);
            else P.xcur[it] = P.xcur[it] * P.rstd[n] * P.norm_final[d];
        } break;
        case ST_GEMM1: gemm_item(P.xn, P.w_in + (long)l * DM * INC, INC, P.norm_mix + l * DM, nullptr, P.p16, PLD, INC / 4, it, 0); break;
        case ST_GEMM2: gemm_item(P.mix16, P.w_out + (long)l * DM * DM, DM, nullptr, P.xcur, nullptr, DM, DM / 4, it, 1); break;
        case ST_GEMM3: gemm_item(P.hb, P.peer_wq + (long)l * DM * DM, DM, nullptr, P.qf, nullptr, DM, DM / 4, it, 2); break;
        case ST_RW_A0: {
            const long n = it / 256; const int c = (int)(it % 256);
            const float z = rw_shift(P, l, n, 1536 + c);
            scr[N * SO_ZS + it] = c < 64 ? tanhf(z) : (c < 128 ? z : sigmoidf_(z));
        } break;
        case ST_RW_A1: {
            const long n = it / 512; const int j = (int)(it % 512);
            const float zr = rw_shift(P, l, n, j), zk = rw_shift(P, l, n, 512 + j), zv = rw_shift(P, l, n, 1024 + j);
            const float* zs = scr + N * SO_ZS + n * 256;
            float aw = P.rw_w0[l * 512 + j], aa = P.rw_a0[l * 512 + j], ag = 0.f;
            const float* wu = P.rw_w_up + (long)l * 64 * 512 + j;
            const float* au = P.rw_a_up + (long)l * 64 * 512 + j;
            const float* gu = P.rw_g_up + (long)l * 128 * 512 + j;
            for (int i = 0; i < 64; ++i) { aw += zs[i] * wu[i * 512]; aa += zs[64 + i] * au[i * 512]; }
            for (int i = 0; i < 128; ++i) ag += zs[128 + i] * gu[i * 512];
            const float w_raw = -softplusf_(-aw) - 0.5f;
            const float a = sigmoidf_(aa);
            scr[N * SO_R + it] = zr;
            scr[N * SO_DEC + it] = expf(-expf(w_raw));
            scr[N * SO_KM + it] = zk * (1.0f + (a - 1.0f) * P.rw_k_a[l * 512 + j]);
            scr[N * SO_KK + it] = zk * P.rw_k_k[l * 512 + j];
            scr[N * SO_A + it] = a;
            scr[N * SO_G + it] = ag;
            scr[N * SO_V + it] = zv;
            if (l == 0) P.vfirst[it] = zv;
        } break;
        case ST_RW_A2: {
            const long n = it / 32; const int i = (int)(it % 32);
            const float* v = scr + N * SO_V + n * 512;
            const float* vdn = P.rw_v_down + (long)(l - 1) * 512 * 32 + i;
            float s = 0.f;
            for (int j = 0; j < 512; ++j) s += v[j] * vdn[j * 32];
            scr[N * SO_VD + it] = s;
        } break;
        case ST_RW_A3: {
            const long n = it / 512; const int j = (int)(it % 512);
            const float* vd = scr + N * SO_VD + n * 32;
            const float* vup = P.rw_v_up + (long)(l - 1) * 32 * 512 + j;
            float s = P.rw_v0[(l - 1) * 512 + j];
            for (int i = 0; i < 32; ++i) s += vd[i] * vup[i * 512];
            const float v = scr[N * SO_V + it];
            scr[N * SO_V + it] = v + (P.vfirst[it] - v) * sigmoidf_(s);
        } break;
        case ST_RW_KKN: {
            const float* kk = scr + N * SO_KK + it * 64;
            float s = 0.f;
            for (int i = 0; i < 64; ++i) s += kk[i] * kk[i];
            scr[N * SO_KKINV + it] = 1.0f / sqrtf(fmaxf(s, 1e-24f));
        } break;
        case ST_RW_SCAN: {
            const int b = (int)(it / 512); const int h = (int)((it % 512) / 64); const int v = (int)(it % 64);
            float S[64];
#pragma unroll
            for (int i = 0; i < 64; ++i) S[i] = 0.f;
            for (int t = 0; t < P.T; ++t) {
                const long n = (long)b * P.T + t;
                const long base = n * 512 + h * 64;
                const float inv = scr[N * SO_KKINV + n * 8 + h];
                const float vv = scr[N * SO_V + base + v];
                const float* KK = scr + N * SO_KK + base;
                const float* DEC = scr + N * SO_DEC + base;
                const float* KM = scr + N * SO_KM + base;
                const float* AA = scr + N * SO_A + base;
                const float* RR = scr + N * SO_R + base;
                float sa = 0.f;
#pragma unroll
                for (int i = 0; i < 64; ++i) sa += S[i] * (-KK[i] * inv);
                float y = 0.f;
#pragma unroll
                for (int i = 0; i < 64; ++i) {
                    const float kk = KK[i] * inv;
                    S[i] = S[i] * DEC[i] + sa * (kk * AA[i]) + vv * KM[i];
                    y += S[i] * RR[i];
                }
                scr[N * SO_Y + base + v] = y;
            }
        } break;
        case ST_RW_POST: {
            const long n = it / 8; const int h = (int)(it % 8);
            const long base = n * 512 + h * 64;
            const float* Y = scr + N * SO_Y + base;
            const float* RR = scr + N * SO_R + base;
            const float* KM = scr + N * SO_KM + base;
            const float* V = scr + N * SO_V + base;
            const float* G = scr + N * SO_G + base;
            float mean = 0.f, bon = 0.f;
            for (int i = 0; i < 64; ++i) { mean += Y[i]; bon += RR[i] * KM[i] * P.rw_r_k[l * 512 + h * 64 + i]; }
            mean *= (1.0f / 64);
            float var = 0.f;
            for (int i = 0; i < 64; ++i) { const float d = Y[i] - mean; var += d * d; }
            const float rs = 1.0f / sqrtf(var * (1.0f / 64) + 64e-5f);
            for (int i = 0; i < 64; ++i) {
                const int c = h * 64 + i;
                const float yn = (Y[i] - mean) * rs * P.rw_ln_w[l * 512 + c] + P.rw_ln_b[l * 512 + c];
                P.mix16[n * DM + c] = f2bf((yn + bon * V[i]) * G[i]);
            }
        } break;
        case ST_GLA_B0: {
            const long n = it / 256; const int c = (int)(it % 256);
            float s = P.gla_a_bias[l * 256 + c];
            for (int i = 0; i < 16; ++i) s += PF(n, C_GLA + 1536 + i) * P.gla_a_up[(long)l * 16 * 256 + i * 256 + c];
            scr[N * SO_ALPHA + it] = expf(-softplusf_(-s) * (1.0f / 16.0f));
        } break;
        case ST_GLA_SCAN: {
            const int b = (int)(it / 512); const int h = (int)((it % 512) / 128); const int v = (int)(it % 128);
            float S[64];
#pragma unroll
            for (int i = 0; i < 64; ++i) S[i] = 0.f;
            for (int t = 0; t < P.T; ++t) {
                const long n = (long)b * P.T + t;
                const bf16_t* q = P.p16 + n * PLD + C_GLA + h * 64;
                const bf16_t* k = q + 256;
                const float vv = PF(n, C_GLA + 512 + h * 128 + v);
                const float* al = scr + N * SO_ALPHA + n * 256 + h * 64;
                float o = 0.f;
#pragma unroll
                for (int i = 0; i < 64; ++i) {
                    S[i] = S[i] * al[i] + bf2f(k[i]) * vv;
                    o += bf2f(q[i]) * S[i];
                }
                scr[N * SO_GO + n * 512 + h * 128 + v] = o * 0.125f;
            }
        } break;
        case ST_GLA_POST: {
            const long n = it / 4; const int h = (int)(it % 4);
            const float* o = scr + N * SO_GO + n * 512 + h * 128;
            float ms = 0.f;
            for (int i = 0; i < 128; ++i) ms += o[i] * o[i];
            const float rs = 1.0f / sqrtf(ms * (1.0f / 128) + 1e-6f);
            for (int i = 0; i < 128; ++i) {
                const float g = PF(n, C_GLA + 1024 + h * 128 + i);
                P.mix16[n * DM + 512 + h * 128 + i] = f2bf(o[i] * rs * P.gla_norm[l * 128 + i] * siluf_(g));
            }
        } break;
        case ST_LRU_C0: {
            const long n = it / 512; const int c = (int)(it % 512);
            const int t = (int)(n % P.T);
            float s = P.lru_conv_b[l * 512 + c];
            for (int j = 0; j < 4; ++j) {
                const int tt = t - 3 + j;
                if (tt >= 0) s += P.lru_conv_w[(long)l * 4 * 512 + j * 512 + c] * PF(n - 3 + j, C_LRU + c);
            }
            scr[N * SO_XC + it] = s;
        } break;
        case ST_LRU_C1: {
            const long n = it / 512; const int c = (int)(it % 512);
            const int blk = c / 64, j = c % 64;
            const float* xc = scr + N * SO_XC + n * 512 + blk * 64;
            const float* wr = P.lru_w_r + (long)l * 8 * 64 * 64 + (long)blk * 64 * 64 + j;
            const float* wi = P.lru_w_i + (long)l * 8 * 64 * 64 + (long)blk * 64 * 64 + j;
            float sr = P.lru_b_r[l * 512 + c], si = P.lru_b_i[l * 512 + c];
            for (int i = 0; i < 64; ++i) { sr += xc[i] * wr[i * 64]; si += xc[i] * wi[i * 64]; }
            const float r = sigmoidf_(sr), ig = sigmoidf_(si);
            const float log_a = -8.0f * r * softplusf_(-P.lru_lam[l * 512 + c]);
            scr[N * SO_LA + it] = expf(log_a);
            scr[N * SO_LU + it] = scr[N * SO_XC + it] * ig * sqrtf(-expm1f(2.0f * log_a));
        } break;
        case ST_LRU_SCAN: {
            const int b = (int)(it / 512); const int c = (int)(it % 512);
            float hst = 0.f;
            for (int t = 0; t < P.T; ++t) {
                const long n = (long)b * P.T + t;
                hst = scr[N * SO_LA + n * 512 + c] * hst + scr[N * SO_LU + n * 512 + c];
                P.mix16[n * DM + 1024 + c] = f2bf(hst * geluf_(PF(n, C_LRU + 512 + c)));
            }
        } break;
        case ST_GDN_D0: {
            const long n = it / 1536; const int c = (int)(it % 1536);
            const int t = (int)(n % P.T);
            float s = 0.f;
            for (int j = 0; j < 4; ++j) {
                const int tt = t - 3 + j;
                if (tt >= 0) s += P.gdn_conv_w[(long)l * 4 * 1536 + j * 1536 + c] * PF(n - 3 + j, C_GDN + c);
            }
            scr[N * SO_QKV + it] = siluf_(s);
        } break;
        case ST_GDN_D1: {
            const long n = it / 4; const int h = (int)(it % 4);
            const float* q = scr + N * SO_QKV + n * 1536 + h * 128;
            const float* k = q + 512;
            float qs = 0.f, ks = 0.f;
            for (int i = 0; i < 128; ++i) { qs += q[i] * q[i]; ks += k[i] * k[i]; }
            float* gs = scr + N * SO_GS + n * 16 + h * 4;
            gs[0] = (1.0f / sqrtf(qs + 1e-6f)) * 0.08838834764831845f;
            gs[1] = 1.0f / sqrtf(ks + 1e-6f);
            gs[2] = sigmoidf_(PF(n, C_GDN + 2048 + h));
            gs[3] = expf(-expf(P.gdn_a_log[l * 4 + h]) * softplusf_(PF(n, C_GDN + 2052 + h) + P.gdn_dt_bias[l * 4 + h]));
        } break;
        case ST_GDN_SCAN: {
            const int b = (int)(it / 512); const int h = (int)((it % 512) / 128); const int v = (int)(it % 128);
            float S[128];
#pragma unroll
            for (int i = 0; i < 128; ++i) S[i] = 0.f;
            for (int t = 0; t < P.T; ++t) {
                const long n = (long)b * P.T + t;
                const float* q = scr + N * SO_QKV + n * 1536 + h * 128;
                const float* k = q + 512;
                const float vv = scr[N * SO_QKV + n * 1536 + 1024 + h * 128 + v];
                const float* gs = scr + N * SO_GS + n * 16 + h * 4;
                const float qinv = gs[0], kinv = gs[1], beta = gs[2], eg = gs[3];
                float dk = 0.f;
#pragma unroll
                for (int i = 0; i < 128; ++i) dk += S[i] * k[i];
                const float u = beta * (vv - eg * kinv * dk) * kinv;
                float o = 0.f;
#pragma unroll
                for (int i = 0; i < 128; ++i) {
                    S[i] = S[i] * eg + u * k[i];
                    o += S[i] * q[i];
                }
                scr[N * SO_DO + n * 512 + h * 128 + v] = o * qinv;
            }
        } break;
        case ST_GDN_POST: {
            const long n = it / 4; const int h = (int)(it % 4);
            const float* o = scr + N * SO_DO + n * 512 + h * 128;
            float ms = 0.f;
            for (int i = 0; i < 128; ++i) ms += o[i] * o[i];
            const float rs = 1.0f / sqrtf(ms * (1.0f / 128) + 1e-6f);
            for (int i = 0; i < 128; ++i) {
                const float z = PF(n, C_GDN + 1536 + h * 128 + i);
                P.mix16[n * DM + 1536 + h * 128 + i] = f2bf(o[i] * rs * P.gdn_norm[l * 128 + i] * siluf_(z));
            }
        } break;
        case ST_SCORES: {
            const long n = it / 2048; const int c = (int)(it % 2048);
            const int hp = c / 128, key = c % 128;
            const float* q = P.qf + n * DM + hp * 128;
            const float* sk = P.peer_sub_keys + (long)l * 16 * 128 * 128 + ((long)hp * 128 + key) * 128;
            float s = 0.f;
            for (int d = 0; d < 128; ++d) s += q[d] * sk[d];
            P.sc[it] = s;
        } break;
        case ST_TOPK1: {
            const float* sc = P.sc + it * 128;
            float ts[16]; int ti[16];
#pragma unroll
            for (int j = 0; j < 16; ++j) { ts[j] = -3.0e38f; ti[j] = 0; }
            for (int i = 0; i < 128; ++i) {
                float xv = sc[i]; int xi = i;
                if (xv > ts[15]) {
#pragma unroll
                    for (int j = 0; j < 16; ++j) {
                        if (xv > ts[j]) { const float tv = ts[j]; const int tj = ti[j]; ts[j] = xv; ti[j] = xi; xv = tv; xi = tj; }
                    }
                }
            }
            float* TS = scr + N * SO_TS + it * 16;
            int* TI = (int*)(scr + N * SO_TI) + it * 16;
#pragma unroll
            for (int j = 0; j < 16; ++j) { TS[j] = ts[j]; TI[j] = ti[j]; }
        } break;
        case ST_TOPK2: {
            const float* s0 = scr + N * SO_TS + it * 32;
            const float* s1 = s0 + 16;
            const int* i0 = (const int*)(scr + N * SO_TI) + it * 32;
            const int* i1 = i0 + 16;
            float ts[16]; int ti[16];
#pragma unroll
            for (int j = 0; j < 16; ++j) { ts[j] = -3.0e38f; ti[j] = 0; }
            for (int a = 0; a < 16; ++a) {
                const int jmax = 16 / (a + 1);
                for (int b = 0; b < jmax; ++b) {
                    float xv = s0[a] + s1[b]; int xi = i0[a] * 128 + i1[b];
                    if (xv > ts[15]) {
#pragma unroll
                        for (int j = 0; j < 16; ++j) {
                            if (xv > ts[j]) { const float tv = ts[j]; const int tj = ti[j]; ts[j] = xv; ti[j] = xi; xv = tv; xi = tj; }
                        }
                    }
                }
            }
            const float mx = ts[0];
            float den = 0.f;
#pragma unroll
            for (int j = 0; j < 16; ++j) { ts[j] = expf(ts[j] - mx); den += ts[j]; }
            const float inv = 1.0f / den;
#pragma unroll
            for (int j = 0; j < 16; ++j) { P.gate[it * 16 + j] = ts[j] * inv; P.idx[it * 16 + j] = ti[j]; }
        } break;
        case ST_PEER_U: {
            const long n = it / 128;
            const int e = P.idx[it];
            const float* u = P.peer_u + ((long)l * NEXP + e) * DM;
            const bf16_t* hx = P.hb + n * DM;
            float s = 0.f;
            for (int d = 0; d < DM; ++d) s += bf2f(hx[d]) * u[d];
            P.act[it] = geluf_(s) * P.gate[it];
        } break;
        case ST_PEER_V: {
            const long n = it / DM; const int d = (int)(it % DM);
            const float* a = P.act + n * 128;
            const int* ix = P.idx + n * 128;
            float s = 0.f;
            for (int j = 0; j < 128; ++j) s += a[j] * P.peer_v[((long)l * NEXP + ix[j]) * DM + d];
            P.xcur[it] += s;
        } break;
    }
}


struct WsMap {
    size_t ctl, w1t, w2t, wsct, auxwt, lruwt, vreswt, pp, tabu, tabv, tsc, ssq, dpart, xn, hb, mix16, p16, sc, aux, vfirst, idx, gate, rstd, act, end;
    size_t auxA, zrkv, xc, auxo, gates, vres, glao, gdno, gq, gk, gv, gsc, rwy, rwbv, lrs, gblob, glas, gladv;
    size_t scr, qf;
};
HD WsMap ws_map(size_t N) {
    WsMap m{};
    size_t o = 0;
    auto take = [&](size_t bytes) { size_t r = o; o += (bytes + 4095) & ~(size_t)4095; return r; };
    m.ctl = take(1u << 20);
    m.w1t = take((size_t)NL * PLD * DM * 2);
    m.w2t = take((size_t)NL * DM * DM * 2);
    m.wsct = take((size_t)NL * DM * DM * 2);
    m.auxwt = take((size_t)NL * 1792 * 384 * 2);
    m.lruwt = take((size_t)NL * 1024 * 512 * 2);
    m.vreswt = take((size_t)512 * 512 * 2);
    m.pp = take(1u << 20);
    m.xn = take(N * DM * 2);
    m.hb = take(N * DM * 2);
    m.mix16 = take(N * DM * 2);
    m.p16 = take(N * PLD * 2);
    m.sc = m.p16;
    m.vfirst = take(N * 512 * 4);
    m.idx = take(N * 128 * 4);
    m.gate = take(N * 128 * 4);
    m.act = take(N * 128 * 4);
    m.rstd = take(N * 4);
    m.tabu = take((size_t)NL * 2 * NEXP * 1024);
    m.tabv = m.tabu + (size_t)NEXP * 1024;
    m.ssq = take(N * 8 * 4);
    m.dpart = m.p16;
    m.tsc = take((size_t)NL * 2 * NEXP * 4);
    m.aux = take(N * 5888 * 4);
    m.end = o;
    size_t a = m.aux;
    auto sub = [&](size_t bytes) { size_t r = a; a += (bytes + 4095) & ~(size_t)4095; return r; };
    m.auxA = sub(N * 384 * 2); m.zrkv = sub(N * 1536 * 2); m.xc = sub(N * 512 * 2); m.auxo = sub(N * 1792 * 2);
    m.gates = sub(N * 1024 * 2); m.vres = sub(N * 512 * 2); m.glao = sub(N * 512 * 2); m.gdno = sub(N * 512 * 2);
    m.gq = sub(N * 512 * 2); m.gk = sub(N * 512 * 2); m.gv = sub(N * 512 * 2); m.gsc = sub(N * 8 * 4); m.rwy = sub(N * 512 * 2); m.rwbv = sub(N * 512 * 2); m.lrs = sub(N / 64 * 512 * 2 * 4);
    m.gblob = sub(N / 64 * 4 * 26880);
    m.glas = sub(N / 64 * 4 * 8192 * 2); m.gladv = sub(N / 64 * 4 * 64 * 4);
    m.scr = m.tabu;
    m.qf = m.aux + N * 3584 * 4;
    return m;
}
static inline void bind_ws(Params& P, char* ws) {
    const WsMap m = ws_map((size_t)P.N);
    P.xn = (bf16_t*)(ws + m.xn); P.hb = (bf16_t*)(ws + m.hb); P.mix16 = (bf16_t*)(ws + m.mix16); P.p16 = (bf16_t*)(ws + m.p16);
    P.sc = (float*)(ws + m.sc); P.qf = (float*)(ws + m.qf); P.rstd = (float*)(ws + m.rstd); P.vfirst = (float*)(ws + m.vfirst);
    P.scr = (float*)(ws + m.scr); P.act = (float*)(ws + m.act); P.gate = (float*)(ws + m.gate); P.idx = (int*)(ws + m.idx);
}

struct Step { int st, l; };
static inline int build_schedule(Step* s) {
    int n = 0;
    s[n++] = {ST_COPYX, 0};
    for (int l = 0; l < NL; ++l) {
        static const int per_layer[] = {ST_RSTD, ST_NORM1, ST_GEMM1,
            ST_RW_A0, ST_RW_A1, ST_RW_A2, ST_RW_A3, ST_RW_KKN, ST_RW_SCAN, ST_RW_POST,
            ST_GLA_B0, ST_GLA_SCAN, ST_GLA_POST, ST_LRU_C0, ST_LRU_C1, ST_LRU_SCAN,
            ST_GDN_D0, ST_GDN_D1, ST_GDN_SCAN, ST_GDN_POST,
            ST_GEMM2, ST_RSTD2, ST_NORM2, ST_GEMM3, ST_SCORES, ST_TOPK1, ST_TOPK2, ST_PEER_U, ST_PEER_V};
        for (int i = 0; i < (int)(sizeof(per_layer) / sizeof(int)); ++i) s[n++] = {per_layer[i], l};
    }
    s[n++] = {ST_FRSTD, 0};
    s[n++] = {ST_FNORM, 0};
    return n;
}

static inline void fill_inputs(Params& P, void* const* d_in) {
    const float** dst = (const float**)&P;
    for (int i = 0; i < 38; ++i) dst[i] = (const float*)d_in[i];
}

#ifndef HOST_EMU
#define GAS __attribute__((address_space(1)))
#define LAS __attribute__((address_space(3)))
typedef unsigned v4u __attribute__((ext_vector_type(4)));
typedef unsigned v2u __attribute__((ext_vector_type(2)));
typedef float f32x4 __attribute__((ext_vector_type(4)));
typedef float f32x2 __attribute__((ext_vector_type(2)));
typedef short bf16x8 __attribute__((ext_vector_type(8)));
constexpr int NWAVES = 8, NTHR = 512;
constexpr int RING_BYTES = 131072, MISC_OFF = RING_BYTES + 320, LDS_BYTES = 147456;
constexpr int NTOK = 16384, TSEQ = 4096, NBATCH = 4;

__device__ __forceinline__ unsigned pk2(float lo, float hi) { return (unsigned)f2bf(lo) | ((unsigned)f2bf(hi) << 16); }
__device__ __forceinline__ float bflo(unsigned u) { return __builtin_bit_cast(float, u << 16); }
__device__ __forceinline__ float bfhi(unsigned u) { return __builtin_bit_cast(float, u & 0xffff0000u); }
__device__ __forceinline__ float wave_sum(float v) {
#pragma unroll
    for (int o = 1; o < 64; o <<= 1) v += __shfl_xor(v, o);
    return v;
}
#define LDS_WAIT() asm volatile("s_waitcnt lgkmcnt(0)" ::: "memory")
#define VM_WAIT() asm volatile("s_waitcnt vmcnt(0)" ::: "memory")

namespace pg8 {
#define PG8_LAS __attribute__((address_space(3)))
constexpr int BM = 256, BK = 64, HALF = 128, HTB = HALF * BK * 2, STAGE_BYTES = 8 * HTB, NXCD = 8, WGM = 8;
__host__ __device__ __forceinline__ int lds_byte(int r, int c) { const int st = (r >> 4) * 2 + (c >> 5), rr = r & 15, cc = c & 31, ob = rr * 64 + cc * 2; return st * 1024 + (ob ^ (((ob >> 9) & 1) << 5)); }
__host__ __device__ __forceinline__ void stage_rc(int b, int& R, int& C) { const int st = b / 1024, sb = b % 1024, swz = sb ^ (((sb >> 9) & 1) << 5); R = (st >> 1) * 16 + swz / 64; C = (st & 1) * 32 + (swz % 64) / 2; }
__host__ __device__ __forceinline__ int perm32(int rho) { const int n = rho >> 4, i = rho & 15; return 8 * (i >> 2) + 4 * n + (i & 3); }
struct Unit { int pm, pn; };
struct GemmX { const bf16_t* A; const bf16_t* Bt; int M, N, K, lda; };
struct StaticOrder {
    int nM, nN, nwg, G, c;
    __host__ __device__ void init(int M, int N, int G_, int c_) { nM = M / BM; nN = N / BM; nwg = nM * nN; G = G_; c = c_; }
    __host__ __device__ bool next(int i, Unit& u) const {
        const long L = (long)i * G + c; if (L >= nwg) return false;
        int wgid = (int)L; { const int q = nwg / NXCD, r = nwg % NXCD, xcd = wgid % NXCD, off = wgid / NXCD; wgid = (xcd < r ? xcd * (q + 1) : r * (q + 1) + (xcd - r) * q) + off; }
        const int nig = WGM * nN, gid = wgid / nig, fm = gid * WGM, gsz = (nM - fm) < WGM ? (nM - fm) : WGM;
        u.pm = fm + ((wgid % nig) % gsz); u.pn = (wgid % nig) / gsz; return true;
    }
    __device__ __forceinline__ void a_ready(const Unit&) const {}
    __device__ __forceinline__ void done(const Unit&) const {}
};
__device__ __forceinline__ unsigned cvt_pk_bf16(float lo, float hi) { unsigned r; asm volatile("v_cvt_pk_bf16_f32 %0, %1, %2" : "=v"(r) : "v"(lo), "v"(hi)); return r; }
template <bool ACCUM> struct EpiF32 {
    static constexpr bool PERM = false, AFTER_DRAIN = false;
    float* C; int ldc; const float* S = nullptr; const bf16_t* S16 = nullptr; bf16_t* O16 = nullptr;
    __device__ __forceinline__ void operator()(const f32x4 (&acc)[2][2][4][2], const Unit& u, int wr, int wc, int fr, int fq) const {
        const int row0 = u.pm * BM + wr * 64 + fr, col0 = u.pn * BM + wc * 32 + 4 * fq;
        const float* src = S ? S : C;
#pragma unroll
        for (int ai = 0; ai < 2; ++ai)
#pragma unroll
            for (int m = 0; m < 4; ++m) { const size_t ro = (size_t)(row0 + ai * HALF + m * 16) * ldc + col0;
#pragma unroll
                for (int bj = 0; bj < 2; ++bj)
#pragma unroll
                    for (int n = 0; n < 2; ++n) { f32x4* p = (f32x4*)(C + ro + bj * HALF + n * 16);
                        if (ACCUM) { f32x4 s4;
                            if (S16) { const v2u w = *(const v2u*)(S16 + ro + bj * HALF + n * 16); s4 = (f32x4){__builtin_bit_cast(float, w.x << 16), __builtin_bit_cast(float, w.x & 0xffff0000u), __builtin_bit_cast(float, w.y << 16), __builtin_bit_cast(float, w.y & 0xffff0000u)}; }
                            else s4 = *(const f32x4*)(src + ro + bj * HALF + n * 16);
                            const f32x4 r4 = s4 + acc[ai][bj][m][n];
                            if (O16) { v2u w; w.x = cvt_pk_bf16(r4[0], r4[1]); w.y = cvt_pk_bf16(r4[2], r4[3]); *(v2u*)(O16 + ro + bj * HALF + n * 16) = w; }
                            else *p = r4; }
                        else *p = acc[ai][bj][m][n]; } }
    }
};
struct EpiBf16 {
    static constexpr bool PERM = true, AFTER_DRAIN = false;
    bf16_t* O; int ldc; const float* bias; const float* ssq = nullptr;
    __device__ __forceinline__ void operator()(const f32x4 (&acc)[2][2][4][2], const Unit& u, int wr, int wc, int fr, int fq) const {
        const int row0 = u.pm * BM + wr * 64 + fr; const int col0 = u.pn * BM + wc * 32 + 8 * fq;
        float rs[2][4];
#pragma unroll
        for (int ai = 0; ai < 2; ++ai)
#pragma unroll
            for (int m = 0; m < 4; ++m) { rs[ai][m] = 1.0f;
                if (ssq) { const f32x4* sp = (const f32x4*)(ssq + (size_t)(row0 + ai * HALF + m * 16) * 8); const f32x4 s0 = sp[0], s1 = sp[1];
                    rs[ai][m] = 1.0f / sqrtf((((s0.x + s0.y) + (s0.z + s0.w)) + ((s1.x + s1.y) + (s1.z + s1.w))) * (1.0f / 2048.0f) + 1e-6f); } }
        f32x4 bv[2][2];
#pragma unroll
        for (int bj = 0; bj < 2; ++bj)
#pragma unroll
            for (int n = 0; n < 2; ++n) bv[bj][n] = bias ? *(const f32x4*)(bias + col0 + bj * HALF + 4 * n) : (f32x4){0.f, 0.f, 0.f, 0.f};
#pragma unroll
        for (int ai = 0; ai < 2; ++ai)
#pragma unroll
            for (int m = 0; m < 4; ++m) { bf16_t* rowp = O + (size_t)(row0 + ai * HALF + m * 16) * ldc + col0;
#pragma unroll
                for (int bj = 0; bj < 2; ++bj) { const f32x4 v0 = acc[ai][bj][m][0] * rs[ai][m] + bv[bj][0], v1 = acc[ai][bj][m][1] * rs[ai][m] + bv[bj][1];
                    v4u w; w.x = cvt_pk_bf16(v0[0], v0[1]); w.y = cvt_pk_bf16(v0[2], v0[3]); w.z = cvt_pk_bf16(v1[0], v1[1]); w.w = cvt_pk_bf16(v1[2], v1[3]);
                    *(v4u*)(rowp + bj * HALF) = w; } }
    }
};
struct EpiResBf16 {
    static constexpr bool PERM = true, AFTER_DRAIN = false;
    bf16_t* O; int ldc; const bf16_t* S;
    __device__ __forceinline__ void operator()(const f32x4 (&acc)[2][2][4][2], const Unit& u, int wr, int wc, int fr, int fq) const {
        const int row0 = u.pm * BM + wr * 64 + fr; const int col0 = u.pn * BM + wc * 32 + 8 * fq;
#pragma unroll
        for (int ai = 0; ai < 2; ++ai)
#pragma unroll
            for (int m = 0; m < 4; ++m) { const size_t ro = (size_t)(row0 + ai * HALF + m * 16) * ldc + col0;
#pragma unroll
                for (int bj = 0; bj < 2; ++bj) { const v4u s = *(const v4u*)(S + ro + bj * HALF);
                    const f32x4 v0 = acc[ai][bj][m][0] + (f32x4){bflo(s.x), bfhi(s.x), bflo(s.y), bfhi(s.y)}, v1 = acc[ai][bj][m][1] + (f32x4){bflo(s.z), bfhi(s.z), bflo(s.w), bfhi(s.w)};
                    v4u w; w.x = cvt_pk_bf16(v0[0], v0[1]); w.y = cvt_pk_bf16(v0[2], v0[3]); w.z = cvt_pk_bf16(v1[0], v1[1]); w.w = cvt_pk_bf16(v1[2], v1[3]);
                    *(v4u*)(O + ro + bj * HALF) = w; } }
    }
};
template <class Epi, class Sched, bool ALIGN_EPI = false, bool SP2 = false>
__device__ __forceinline__ void gemm_phase(PG8_LAS unsigned char* lds, const GemmX g, const Sched& S, const Epi& E) {
    const int tid = threadIdx.x, wid = __builtin_amdgcn_readfirstlane(tid >> 6), lane = tid & 63, wr = wid >> 2, wc = wid & 3, fr = lane & 15, fq = lane >> 4;
    const int K = g.K, nt = K / BK;
    unsigned voffA[2], voffB[2];
#pragma unroll
    for (int i = 0; i < 2; ++i) { int R, C; stage_rc(tid * 16 + i * 8192, R, C); const int Rb = Epi::PERM ? ((R & ~31) + perm32(R & 31)) : R;
        voffA[i] = (unsigned)(R * g.lda + C) * 2u; voffB[i] = (unsigned)(Rb * K + C) * 2u; }
    const size_t kstep = (size_t)(BK * 2);
    const size_t hstep = (size_t)HALF * K * 2;
    const size_t tstep = 2 * hstep;
    const size_t hstepA = (size_t)HALF * g.lda * 2, tstepA = 2 * hstepA;
    const unsigned ldsw = (unsigned)wid * 1024u;
    const int aoff = lds_byte(wr * 64 + fr, fq * 8), boff = lds_byte(wc * 32 + fr, fq * 8);
#define PG8_SA(b, h) (((b) * 2 + (h)) * HTB)
#define PG8_SB(b, h) ((4 + (b) * 2 + (h)) * HTB)
#define PG8_STAGE(bufoff, gbase, voff) do { _Pragma("unroll") for (int _i = 0; _i < 2; ++_i) \
        __builtin_amdgcn_global_load_lds((const unsigned*)((const char*)(gbase) + (voff)[_i]), (PG8_LAS unsigned*)(lds + (bufoff) + ldsw + _i * 8192), 16, 0, 0); } while (0)
#define PG8_LDA(dst, b, h) do { _Pragma("unroll") for (int m = 0; m < 4; ++m) _Pragma("unroll") for (int k = 0; k < 2; ++k) dst[m][k] = *(const PG8_LAS bf16x8*)(lds + PG8_SA(b, h) + aoff + m * 2048 + k * 1024); } while (0)
#define PG8_LDB(dst, b, h) do { _Pragma("unroll") for (int n = 0; n < 2; ++n) _Pragma("unroll") for (int k = 0; k < 2; ++k) dst[n][k] = *(const PG8_LAS bf16x8*)(lds + PG8_SB(b, h) + boff + n * 2048 + k * 1024); } while (0)
#define PG8_MMA(ai, bj, At, Bt) do { __builtin_amdgcn_s_setprio(1); _Pragma("unroll") for (int m = 0; m < 4; ++m) _Pragma("unroll") for (int n = 0; n < 2; ++n) _Pragma("unroll") for (int k = 0; k < 2; ++k) \
        acc[ai][bj][m][n] = __builtin_amdgcn_mfma_f32_16x16x32_bf16(Bt[n][k], At[m][k], acc[ai][bj][m][n], 0, 0, 0); __builtin_amdgcn_s_setprio(0); } while (0)
#define PG8_WAIT_V(n) asm volatile("s_waitcnt vmcnt(" #n ")" ::: "memory")
#define PG8_WAIT_L(n) asm volatile("s_waitcnt lgkmcnt(" #n ")" ::: "memory")
#define PG8_BAR __builtin_amdgcn_s_barrier()
#define PG8_SCHED __builtin_amdgcn_sched_barrier(0)
    Unit cur, nxt; int ui = 0;
    if (!S.next(0, cur)) return;
    f32x4 acc[2][2][4][2];
#pragma unroll
    for (int a = 0; a < 2; ++a)
#pragma unroll
        for (int b = 0; b < 2; ++b)
#pragma unroll
            for (int m = 0; m < 4; ++m)
#pragma unroll
                for (int n = 0; n < 2; ++n) acc[a][b][m][n] = (f32x4){0.f, 0.f, 0.f, 0.f};
    bf16x8 At[4][2], B0[2][2], B1[2][2];
    const char* cA = (const char*)g.A + (size_t)cur.pm * tstepA; const char* cB = (const char*)g.Bt + (size_t)cur.pn * tstep;
    S.a_ready(cur);
    if constexpr (SP2) {
        PG8_STAGE(PG8_SB(0, 0), cB, voffB); PG8_STAGE(PG8_SB(0, 1), cB + hstep, voffB); PG8_STAGE(PG8_SA(0, 0), cA, voffA); PG8_STAGE(PG8_SA(0, 1), cA + hstepA, voffA);
        if (wr == 1) PG8_BAR;
        PG8_WAIT_V(2); PG8_BAR;
        PG8_STAGE(PG8_SB(1, 0), cB + kstep, voffB); PG8_STAGE(PG8_SA(1, 0), cA + kstep, voffA); PG8_STAGE(PG8_SB(1, 1), cB + hstep + kstep, voffB);
        PG8_WAIT_V(6); PG8_BAR;
    } else {
        PG8_STAGE(PG8_SB(0, 0), cB, voffB); PG8_STAGE(PG8_SA(0, 0), cA, voffA); PG8_STAGE(PG8_SB(0, 1), cB + hstep, voffB); PG8_STAGE(PG8_SA(0, 1), cA + hstepA, voffA);
        if (wr == 1) PG8_BAR;
        PG8_WAIT_V(4); PG8_BAR;
        PG8_STAGE(PG8_SB(1, 0), cB + kstep, voffB); PG8_STAGE(PG8_SA(1, 0), cA + kstep, voffA); PG8_STAGE(PG8_SB(1, 1), cB + hstep + kstep, voffB);
        PG8_WAIT_V(6); PG8_BAR;
    }
    for (;;) {
        const bool has_next = S.next(ui + 1, nxt);
        const char* nA = has_next ? (const char*)g.A + (size_t)nxt.pm * tstepA : cA; const char* nB = has_next ? (const char*)g.Bt + (size_t)nxt.pn * tstep : cB;
        for (int t = 0; t < nt; t += 2) {
            const bool last = (t == nt - 2);
            const char* a1 = cA + (size_t)(t + 1) * kstep;
            const char* a2 = last ? nA : cA + (size_t)(t + 2) * kstep; const char* b2 = last ? nB : cB + (size_t)(t + 2) * kstep;
            const char* a3 = a2 + kstep; const char* b3 = b2 + kstep;
            if (last && has_next) S.a_ready(nxt);
            if constexpr (SP2) {
            PG8_LDB(B0, 0, 0); PG8_LDB(B1, 0, 1); PG8_SCHED; PG8_LDA(At, 0, 0); PG8_STAGE(PG8_SA(1, 1), a1 + hstepA, voffA);
            PG8_WAIT_V(8); PG8_WAIT_L(0); PG8_BAR; PG8_MMA(0, 0, At, B0); PG8_MMA(0, 1, At, B1); PG8_BAR; PG8_SCHED;
            PG8_LDA(At, 0, 1); PG8_STAGE(PG8_SB(0, 0), b2, voffB); PG8_STAGE(PG8_SB(0, 1), b2 + hstep, voffB); PG8_STAGE(PG8_SA(0, 0), a2, voffA);
            PG8_WAIT_V(8); PG8_WAIT_L(0); PG8_BAR; PG8_MMA(1, 0, At, B0); PG8_MMA(1, 1, At, B1); PG8_BAR; PG8_SCHED;
            PG8_LDB(B0, 1, 0); PG8_LDB(B1, 1, 1); PG8_SCHED; PG8_LDA(At, 1, 0); PG8_STAGE(PG8_SA(0, 1), a2 + hstepA, voffA);
            PG8_WAIT_V(8); PG8_WAIT_L(0); PG8_BAR; PG8_MMA(0, 0, At, B0); PG8_MMA(0, 1, At, B1); PG8_BAR; PG8_SCHED;
            PG8_LDA(At, 1, 1); PG8_STAGE(PG8_SB(1, 0), b3, voffB); PG8_STAGE(PG8_SB(1, 1), b3 + hstep, voffB); PG8_STAGE(PG8_SA(1, 0), a3, voffA);
            PG8_WAIT_V(8); PG8_WAIT_L(0); PG8_BAR; PG8_MMA(1, 0, At, B0); PG8_MMA(1, 1, At, B1); PG8_BAR; PG8_SCHED;
            } else {
            PG8_LDB(B0, 0, 0); PG8_SCHED; PG8_LDA(At, 0, 0); PG8_STAGE(PG8_SA(1, 1), a1 + hstepA, voffA);
            PG8_WAIT_L(8); PG8_BAR; PG8_WAIT_L(0); PG8_MMA(0, 0, At, B0); PG8_BAR; PG8_SCHED;
            PG8_LDB(B1, 0, 1); PG8_STAGE(PG8_SB(0, 0), b2, voffB);
            PG8_BAR; PG8_WAIT_L(0); PG8_MMA(0, 1, At, B1); PG8_BAR;
            PG8_LDA(At, 0, 1); PG8_STAGE(PG8_SA(0, 0), a2, voffA);
            PG8_BAR; PG8_WAIT_L(0); PG8_MMA(1, 0, At, B0); PG8_BAR; PG8_SCHED;
            PG8_STAGE(PG8_SB(0, 1), b2 + hstep, voffB);
            PG8_WAIT_V(6); PG8_BAR; PG8_MMA(1, 1, At, B1); PG8_BAR;
            PG8_LDB(B0, 1, 0); PG8_SCHED; PG8_LDA(At, 1, 0); PG8_STAGE(PG8_SA(0, 1), a2 + hstepA, voffA);
            PG8_WAIT_L(8); PG8_BAR; PG8_WAIT_L(0); PG8_MMA(0, 0, At, B0); PG8_BAR; PG8_SCHED;
            PG8_LDB(B1, 1, 1); PG8_STAGE(PG8_SB(1, 0), b3, voffB);
            PG8_BAR; PG8_WAIT_L(0); PG8_MMA(0, 1, At, B1); PG8_BAR;
            PG8_LDA(At, 1, 1); PG8_STAGE(PG8_SA(1, 0), a3, voffA);
            PG8_BAR; PG8_WAIT_L(0); PG8_MMA(1, 0, At, B0); PG8_BAR; PG8_SCHED;
            PG8_STAGE(PG8_SB(1, 1), b3 + hstep, voffB);
            PG8_WAIT_V(6); PG8_BAR; PG8_MMA(1, 1, At, B1); PG8_BAR;
            }
        }
        if constexpr (ALIGN_EPI) { if (wr == 0) PG8_BAR; }
        if constexpr (!Epi::AFTER_DRAIN) { E(acc, cur, wr, wc, fr, fq); S.done(cur); }
        if (!has_next) break;
#pragma unroll
        for (int a = 0; a < 2; ++a)
#pragma unroll
            for (int b = 0; b < 2; ++b)
#pragma unroll
                for (int m = 0; m < 4; ++m)
#pragma unroll
                    for (int n = 0; n < 2; ++n) acc[a][b][m][n] = (f32x4){0.f, 0.f, 0.f, 0.f};
        cur = nxt; cA = nA; cB = nB; ++ui;
        if constexpr (ALIGN_EPI) { if (wr == 1) PG8_BAR; }
    }
    PG8_WAIT_V(0);
    if constexpr (!ALIGN_EPI) { if (wr == 0) PG8_BAR; }
    PG8_BAR;
    if constexpr (Epi::AFTER_DRAIN) { E.fused(acc, cur, wr, wc, fr, fq, lds, wid, lane); S.done(cur); }
#undef PG8_SA
#undef PG8_SB
#undef PG8_STAGE
#undef PG8_LDA
#undef PG8_LDB
#undef PG8_MMA
#undef PG8_WAIT_V
#undef PG8_WAIT_L
#undef PG8_BAR
#undef PG8_SCHED
}
}

#define XB_TMO      128
#define XB_XCNT(j)  (256  + 64 * (j))
#define XB_XSUB(j)  (1280 + 64 * (j))
#define XB_XGEN(j)  (2304 + 64 * (j))
#define XB_TOP      3328
#define XB_TOPGEN   3392
#define XCD_BAR_WORDS 3456
#define XB_SPIN_CAP (1u << 20)
__device__ __forceinline__ unsigned xb_ld(unsigned* p) { return __hip_atomic_load(p, __ATOMIC_RELAXED, __HIP_MEMORY_SCOPE_AGENT); }
__device__ __forceinline__ unsigned xb_add(unsigned* p, unsigned v) { return __hip_atomic_fetch_add(p, v, __ATOMIC_RELAXED, __HIP_MEMORY_SCOPE_AGENT); }
__device__ __forceinline__ unsigned xb_xcc_id() { return (unsigned)__builtin_amdgcn_s_getreg((3 << 11) | 20) & 0xFu; }
#define XB_SPIN(cond, bar) do { unsigned _sp = 0; while (cond) { __builtin_amdgcn_s_sleep(1); \
    if ((++_sp & 255u) == 0u) { if (xb_ld(&(bar)[XB_TMO])) break; if (_sp > XB_SPIN_CAP) { atomicAdd(&(bar)[XB_TMO], 1u); break; } } } } while (0)
struct XcdBarrier { unsigned* bar; unsigned x; volatile LAS unsigned* st; };
__device__ __forceinline__ XcdBarrier xcd_barrier_post(unsigned* bar, volatile LAS unsigned* st) {
    XcdBarrier b; b.bar = bar; b.x = xb_xcc_id(); b.st = st;
    if (threadIdx.x == 0) (void)xb_add(&bar[XB_XCNT(b.x)], 1u);
    return b;
}
__device__ __forceinline__ void xcd_barrier_complete(unsigned* bar, unsigned x, unsigned& nloc, unsigned& nx) {
    const unsigned G = gridDim.x * gridDim.y * gridDim.z;
    unsigned sum, cnt, mine, sp = 0u;
    for (;;) {
        sum = 0u; cnt = 0u; mine = 0u;
#pragma unroll
        for (unsigned j = 0; j < 16; ++j) { const unsigned c = xb_ld(&bar[XB_XCNT(j)]); sum += c; cnt += (c > 0u) ? 1u : 0u; mine = (j == x) ? c : mine; }
        if (sum == G) break;
        __builtin_amdgcn_s_sleep(1);
        if ((++sp & 255u) == 0u) { if (xb_ld(&bar[XB_TMO])) break; if (sp > XB_SPIN_CAP) { atomicAdd(&bar[XB_TMO], 1u); break; } }
    }
    nloc = mine > 0u ? mine : 1u; nx = cnt > 0u ? cnt : 1u;
}
__device__ __forceinline__ void xcd_barrier(const XcdBarrier& b) {
    asm volatile("s_waitcnt vmcnt(0)" ::: "memory");
    __syncthreads();
    if (threadIdx.x == 0) {
        unsigned* bar = b.bar;
        __builtin_amdgcn_s_waitcnt(0);
        unsigned nloc = b.st[0], nx = b.st[1];
        if (nloc == 0u) { xcd_barrier_complete(bar, b.x, nloc, nx); b.st[0] = nloc; b.st[1] = nx; }
        const unsigned old = xb_add(&bar[XB_XSUB(b.x)], 1u);
        const unsigned gen = old / nloc;
        if (old + 1u == (gen + 1u) * nloc) {
            __builtin_amdgcn_fence(__ATOMIC_RELEASE, "agent");
            asm volatile("s_waitcnt vmcnt(0)" ::: "memory");
            const unsigned og = xb_add(&bar[XB_TOP], 1u);
            const unsigned tg = og / nx;
            if (og + 1u == (tg + 1u) * nx) xb_add(&bar[XB_TOPGEN], 1u);
            else XB_SPIN(xb_ld(&bar[XB_TOPGEN]) == tg, bar);
            __builtin_amdgcn_fence(__ATOMIC_ACQUIRE, "agent");
            xb_add(&bar[XB_XGEN(b.x)], 1u);
            asm volatile("s_waitcnt vmcnt(0)" ::: "memory");
        } else {
            XB_SPIN(xb_ld(&bar[XB_XGEN(b.x)]) == gen, bar);
            __builtin_amdgcn_fence(__ATOMIC_ACQUIRE, "agent");
            asm volatile("s_waitcnt vmcnt(0)" ::: "memory");
        }
    }
    __syncthreads();
}

struct Args { const float* in[38]; float* out; unsigned char* ws; int ph_lo, ph_hi, li, pad; };
enum InputId { I_X = 0, I_NORM_MIX, I_W_IN, I_W_OUT, I_RW_MU, I_RW_W0, I_RW_W_UP, I_RW_A0, I_RW_A_UP, I_RW_G_UP, I_RW_K_K, I_RW_K_A, I_RW_R_K,
    I_RW_LN_W, I_RW_LN_B, I_RW_V0, I_RW_V_DOWN, I_RW_V_UP, I_GLA_A_UP, I_GLA_A_BIAS, I_GLA_NORM, I_LRU_CONV_W, I_LRU_CONV_B, I_LRU_W_R,
    I_LRU_B_R, I_LRU_W_I, I_LRU_B_I, I_LRU_LAM, I_GDN_CONV_W, I_GDN_A_LOG, I_GDN_DT_BIAS, I_GDN_NORM, I_NORM_FFN, I_PEER_WQ, I_PEER_SK,
    I_PEER_U, I_PEER_V, I_NORM_FINAL };
enum { PH_P0 = 0, PH_GEMM1 = 1, PH_PREP = 2, PH_AUX = 3, PH_SCAN = 4, PH_POST = 5, PH_GEMM2 = 6, PH_NORM2 = 7, PH_GEMM3 = 8, PH_TOPK = 9, PH_PEERU = 10, PH_PEERC = 11, PH_PEERV = 12, PH_PER_LAYER = 12, PH_FNORM = 25, PH_TOTAL = 26 };

struct Frame {
    LAS unsigned char* lds;
    int tid, lane, wave, vcu, G;
    int gw, ngw;
};

__device__ __forceinline__ void p0_transpose_load(const float* W, int N, int item, int nblk, int lane, f32x4 (&v)[8]) {
    const int kb = item / nblk, nb = item % nblk, k0 = 64 * kb, n0 = 32 * nb;
    const int kr = lane >> 3, n4 = (lane & 7) * 4;
#pragma unroll
    for (int i = 0; i < 8; ++i) { const int kk = kr + 8 * i;
        v[i] = (n0 + n4 < N) ? *(const f32x4*)(W + (size_t)(k0 + kk) * N + n0 + n4) : (f32x4){0.f, 0.f, 0.f, 0.f}; }
}
__device__ __forceinline__ void p0_transpose_finish(int K, const float* kscale, bf16_t* WT, LAS float* scr, int item, int nblk, int lane, const f32x4 (&v)[8]) {
    const int kb = item / nblk, nb = item % nblk, k0 = 64 * kb, n0 = 32 * nb;
    const int kr = lane >> 3, n4 = (lane & 7) * 4;
#pragma unroll
    for (int i = 0; i < 8; ++i) { const int kk = kr + 8 * i; const float s = kscale ? kscale[k0 + kk] : 1.0f;
        scr[kk * 33 + n4 + 0] = v[i].x * s; scr[kk * 33 + n4 + 1] = v[i].y * s; scr[kk * 33 + n4 + 2] = v[i].z * s; scr[kk * 33 + n4 + 3] = v[i].w * s; }
    LDS_WAIT(); asm volatile("" ::: "memory");
    const int c = lane & 7;
#pragma unroll
    for (int j = 0; j < 4; ++j) { const int n = (lane >> 3) + 8 * j; const LAS float* s = scr + (8 * c) * 33 + n;
        v4u o; o.x = pk2(s[0 * 33], s[1 * 33]); o.y = pk2(s[2 * 33], s[3 * 33]); o.z = pk2(s[4 * 33], s[5 * 33]); o.w = pk2(s[6 * 33], s[7 * 33]);
        *(v4u*)(WT + (size_t)(n0 + n) * K + k0 + 8 * c) = o; }
    LDS_WAIT(); asm volatile("" ::: "memory");
}

__device__ __forceinline__ v4u p0_pack8(const float (&f)[8]) { v4u w; w.x = pk2(f[0], f[1]); w.y = pk2(f[2], f[3]); w.z = pk2(f[4], f[5]); w.w = pk2(f[6], f[7]); return w; }
__device__ __forceinline__ void p0_prologue(const Args& a, Frame& F) {
    const WsMap m = ws_map(NTOK);
    unsigned char* ws = a.ws;
    LAS float* scr = (LAS float*)(F.lds + F.wave * 16384);
    const int gw = F.gw, NGW = F.ngw, lane = F.lane;
    for (int n = gw; n < NTOK; n += 2 * NGW) {
        f32x4 v[2][8]; float s[2] = {0.f, 0.f};
#pragma unroll
        for (int u = 0; u < 2; ++u) { const int nn = n + u * NGW; if (nn < NTOK) { const f32x4* xr = (const f32x4*)(a.in[I_X] + (size_t)nn * DM) + lane;
#pragma unroll
            for (int j = 0; j < 8; ++j) v[u][j] = __builtin_nontemporal_load(xr + 64 * j); } }
#pragma unroll
        for (int u = 0; u < 2; ++u) { const int nn = n + u * NGW; if (nn < NTOK) {
#pragma unroll
            for (int j = 0; j < 8; ++j) s[u] += (v[u][j].x * v[u][j].x + v[u][j].y * v[u][j].y) + (v[u][j].z * v[u][j].z + v[u][j].w * v[u][j].w);
            const float st = wave_sum(s[u]);
            if (lane < 8) ((float*)(ws + m.ssq))[(size_t)nn * 8 + lane] = lane == 0 ? st : 0.f;
            v2u* o8 = (v2u*)((bf16_t*)(ws + m.xn) + (size_t)nn * DM) + lane;
#pragma unroll
            for (int j = 0; j < 8; ++j) { v2u w; w.x = pk2(v[u][j].x, v[u][j].y); w.y = pk2(v[u][j].z, v[u][j].w); o8[64 * j] = w; } } }
    }
    {
        constexpr int I1 = (DM / 64) * (PLD / 32), I2 = (DM / 64) * (DM / 32);
        auto tl = [&](int it, f32x4 (&v)[8]) { const int l = it / (I1 + I2), r = it % (I1 + I2);
            if (r < I1) p0_transpose_load(a.in[I_W_IN] + (size_t)l * DM * INC, INC, r, PLD / 32, lane, v);
            else p0_transpose_load(a.in[I_W_OUT] + (size_t)l * DM * DM, DM, r - I1, DM / 32, lane, v); };
        auto tf = [&](int it, const f32x4 (&v)[8]) { const int l = it / (I1 + I2), r = it % (I1 + I2);
            if (r < I1) p0_transpose_finish(DM, a.in[I_NORM_MIX] + l * DM, (bf16_t*)(ws + m.w1t) + (size_t)l * PLD * DM, scr, r, PLD / 32, lane, v);
            else p0_transpose_finish(DM, nullptr, (bf16_t*)(ws + m.w2t) + (size_t)l * DM * DM, scr, r - I1, DM / 32, lane, v); };
        constexpr int NIT = NL * (I1 + I2);
        f32x4 va[8], vb[8];
        if (gw < NIT) tl(gw, va);
#pragma unroll 1
        for (int it = gw; it < NIT; it += 2 * NGW) {
            if (it + NGW < NIT) tl(it + NGW, vb);
            tf(it, va);
            if (it + NGW < NIT) { if (it + 2 * NGW < NIT) tl(it + 2 * NGW, va); tf(it + NGW, vb); }
        }
    }
    for (int it = gw; it < NL * 16 * 128; it += NGW) {
        const int l = it >> 11, hp = (it >> 7) & 15, n0 = (it & 127) * 16;
        const float* wq = a.in[I_PEER_WQ] + (size_t)l * DM * DM + (size_t)(n0 + (lane & 15)) * DM + hp * 128 + (lane >> 4) * 8;
        const float* sk = a.in[I_PEER_SK] + ((size_t)l * 16 + hp) * 128 * 128 + (size_t)(lane & 15) * 128 + (lane >> 4) * 8;
        bf16x8 bfr[4];
#pragma unroll
        for (int ks = 0; ks < 4; ++ks) { const f32x4 x0 = *(const f32x4*)(wq + 32 * ks), x1 = *(const f32x4*)(wq + 32 * ks + 4);
            const float t[8] = {x0.x, x0.y, x0.z, x0.w, x1.x, x1.y, x1.z, x1.w}; bfr[ks] = __builtin_bit_cast(bf16x8, p0_pack8(t)); }
        bf16_t* o = (bf16_t*)(ws + m.wsct) + (size_t)l * DM * DM + (size_t)(hp * 128 + (lane >> 4) * 4) * DM + n0 + (lane & 15);
#pragma unroll 2
        for (int mt = 0; mt < 8; ++mt) {
            f32x4 s0[4], s1[4];
#pragma unroll
            for (int ks = 0; ks < 4; ++ks) { s0[ks] = *(const f32x4*)(sk + (size_t)mt * 16 * 128 + 32 * ks); s1[ks] = *(const f32x4*)(sk + (size_t)mt * 16 * 128 + 32 * ks + 4); }
            f32x4 acc = {0.f, 0.f, 0.f, 0.f};
#pragma unroll
            for (int ks = 0; ks < 4; ++ks) { const float t[8] = {s0[ks].x, s0[ks].y, s0[ks].z, s0[ks].w, s1[ks].x, s1[ks].y, s1[ks].z, s1[ks].w};
                acc = __builtin_amdgcn_mfma_f32_16x16x32_bf16(__builtin_bit_cast(bf16x8, p0_pack8(t)), bfr[ks], acc, 0, 0, 0); }
            bf16_t* op = o + (size_t)(mt * 16) * DM;
            op[0] = f2bf(acc.x); op[DM] = f2bf(acc.y); op[2 * DM] = f2bf(acc.z); op[3 * DM] = f2bf(acc.w);
        }
    }
    {
        const int gt = F.vcu * NTHR + F.tid, GT = F.G * NTHR;
        bf16_t* AW = (bf16_t*)(ws + m.auxwt); bf16_t* LW = (bf16_t*)(ws + m.lruwt); bf16_t* VW = (bf16_t*)(ws + m.vreswt); float* PP = (float*)(ws + m.pp);
        for (int it = gt; it < NL * 1792 * 384; it += GT) {
            const int l = it / (1792 * 384), r = it % (1792 * 384), n = r / 384, k = r % 384;
            float v = 0.f;
            if (n < 512) { if (k < 64) v = a.in[I_RW_W_UP][(size_t)l * 64 * 512 + k * 512 + n]; }
            else if (n < 1024) { if (k >= 64 && k < 128) v = a.in[I_RW_A_UP][(size_t)l * 64 * 512 + (k - 64) * 512 + (n - 512)]; }
            else if (n < 1536) { if (k >= 128 && k < 256) v = a.in[I_RW_G_UP][(size_t)l * 128 * 512 + (k - 128) * 512 + (n - 1024)]; }
            else { if (k >= 256 && k < 272) v = a.in[I_GLA_A_UP][(size_t)l * 16 * 256 + (k - 256) * 256 + (n - 1536)]; }
            AW[it] = f2bf(v);
        }
        for (int it = gt; it < NL * 1024 * 512; it += GT) {
            const int l = it / (1024 * 512), r = it % (1024 * 512), n = r / 512, k = r % 512;
            const int nn = n & 511, blk = nn >> 6, j = nn & 63;
            float v = 0.f;
            if ((k >> 6) == blk) v = (n < 512 ? a.in[I_LRU_W_R] : a.in[I_LRU_W_I])[(size_t)l * 8 * 64 * 64 + (size_t)blk * 4096 + (k & 63) * 64 + j];
            LW[it] = f2bf(v);
        }
        for (int it = gt; it < 512 * 512; it += GT) {
            const int n = it / 512, k = it % 512;
            float s = 0.f;
            for (int i = 0; i < 32; ++i) s += a.in[I_RW_V_DOWN][k * 32 + i] * a.in[I_RW_V_UP][i * 512 + n];
            VW[it] = f2bf(s);
        }
        for (int it = gt; it < 6144; it += GT) {
            float v = 0.f;
            if (it < 3584) { const int l = it / 1792, c = it % 1792;
                v = c < 512 ? a.in[I_RW_W0][l * 512 + c] : (c < 1024 ? a.in[I_RW_A0][l * 512 + c - 512] : (c < 1536 ? 0.f : a.in[I_GLA_A_BIAS][l * 256 + c - 1536])); }
            else if (it < 5632) { const int l = (it - 3584) / 1024, c = (it - 3584) % 1024; v = c < 512 ? a.in[I_LRU_B_R][l * 512 + c] : a.in[I_LRU_B_I][l * 512 + c - 512]; }
            else v = a.in[I_RW_V0][it - 5632];
            PP[it] = v;
        }
    }
}

__device__ __forceinline__ unsigned pk4_fp8(float a, float b, float c, float d) {
    int w = 0;
    w = __builtin_amdgcn_cvt_pk_fp8_f32(__builtin_fmaxf(__builtin_fminf(a, 448.f), -448.f), __builtin_fmaxf(__builtin_fminf(b, 448.f), -448.f), w, false);
    w = __builtin_amdgcn_cvt_pk_fp8_f32(__builtin_fmaxf(__builtin_fminf(c, 448.f), -448.f), __builtin_fmaxf(__builtin_fminf(d, 448.f), -448.f), w, true);
    return (unsigned)w;
}
constexpr size_t TSL = 128;
constexpr float TSTEP = 0.3352f;

template <int CTRL> __device__ __forceinline__ float dpp_f(float v) { return __builtin_bit_cast(float, __builtin_amdgcn_update_dpp(0, __builtin_bit_cast(int, v), CTRL, 0xF, 0xF, true)); }
__device__ __forceinline__ float rdlane_f(float v, int l) { return __builtin_bit_cast(float, __builtin_amdgcn_readlane(__builtin_bit_cast(int, v), l)); }
__device__ __forceinline__ float row16_sum(float v) {
    v += dpp_f<0xB1>(v); v += dpp_f<0x4E>(v); v += dpp_f<0x141>(v); v += dpp_f<0x140>(v); return v;
}
__device__ __forceinline__ float wave_sum_u(float v) {
    v = row16_sum(v);
    return (rdlane_f(v, 0) + rdlane_f(v, 16)) + (rdlane_f(v, 32) + rdlane_f(v, 48));
}
typedef __bf16 bf16x2_t __attribute__((ext_vector_type(2)));
__device__ __forceinline__ float dot2bf(unsigned w, unsigned x, float acc) { return __builtin_amdgcn_fdot2_f32_bf16(__builtin_bit_cast(bf16x2_t, w), __builtin_bit_cast(bf16x2_t, x), acc, false); }
__device__ __forceinline__ void tables_range(const Args& a, Frame& F, size_t it0, size_t it1, int sub, int nsub) {
    const WsMap m = ws_map(NTOK);
    const size_t r0 = it0 >> 6, r1 = it1 >> 6;
    const size_t wstride = (size_t)nsub * NWAVES;
    float* tsc = (float*)(a.ws + m.tsc);
    const int lane = F.lane;
    for (size_t base = r0 + (size_t)sub * NWAVES + F.wave; base < r1; base += 2 * wstride) {
        f32x4 v[2][8];
#pragma unroll
        for (int u = 0; u < 2; ++u) { const size_t row = base + u * wstride;
            if (row < r1) { const int tb = (int)(row / NEXP); const size_t e = row % NEXP;
                const f32x4* srcp = (const f32x4*)(((tb & 1) ? a.in[I_PEER_V] : a.in[I_PEER_U]) + (size_t)(tb >> 1) * NEXP * DM + e * DM) + lane;
#pragma unroll
                for (int q = 0; q < 8; ++q) v[u][q] = __builtin_nontemporal_load(srcp + 64 * q); } }
#pragma unroll
        for (int u = 0; u < 2; ++u) { const size_t row = base + u * wstride;
            if (row < r1) { const int tb = (int)(row / NEXP); const size_t e = row % NEXP;
                float ss = 0.f;
#pragma unroll
                for (int q = 0; q < 8; ++q) ss += (v[u][q].x * v[u][q].x + v[u][q].y * v[u][q].y) + (v[u][q].z * v[u][q].z + v[u][q].w * v[u][q].w);
                const float rms = sqrtf(wave_sum_u(ss) * (1.0f / DM));
                float step = rms * TSTEP; const float inv = rms > 0.f ? 1.0f / step : 0.f;
                unsigned char* dst = (unsigned char*)(a.ws + m.tabu) + ((size_t)tb * 8 * NEXP + e) * TSL + 2 * lane;
                if (tb & 1) {
                    const float sc = rms > 0.f ? 2.05f / rms : 0.f; step = rms * (1.0f / 2.05f);
#pragma unroll
                    for (int q = 0; q < 8; ++q) { unsigned p = 0;
                        p = __builtin_amdgcn_cvt_scalef32_pk_fp4_f32(p, __builtin_fmaxf(__builtin_fminf(v[u][q].x * sc, 6.f), -6.f), __builtin_fmaxf(__builtin_fminf(v[u][q].y * sc, 6.f), -6.f), 1.0f, 0);
                        p = __builtin_amdgcn_cvt_scalef32_pk_fp4_f32(p, __builtin_fmaxf(__builtin_fminf(v[u][q].z * sc, 6.f), -6.f), __builtin_fmaxf(__builtin_fminf(v[u][q].w * sc, 6.f), -6.f), 1.0f, 1);
                        *(unsigned short*)(dst + (size_t)q * NEXP * TSL) = (unsigned short)p; }
                } else {
#pragma unroll
                    for (int q = 0; q < 8; ++q) { const f32x4 x = v[u][q]; unsigned p = 0;
#pragma unroll
                        for (int b = 0; b < 4; ++b) { const int c = (int)__builtin_fminf(__builtin_fmaxf(__builtin_floorf(x[b] * inv), -8.0f), 7.0f); p |= ((unsigned)c & 15u) << (4 * b); }
                        *(unsigned short*)(dst + (size_t)q * NEXP * TSL) = (unsigned short)p; }
                }
                if (lane == 0) tsc[((size_t)(tb >> 1) * NEXP + e) * 2 + (tb & 1)] = step; } }
    }
}

__device__ __forceinline__ float gelu_fast(float x) {
    const float u = 1.5957691216057308f * (x + 0.044715f * x * x * x);
    return x / (1.0f + __expf(-u));
}


__device__ __forceinline__ float sigm(float x) { return 1.0f / (1.0f + __expf(-x)); }
__device__ __forceinline__ float softplus_f(float x) { return __logf(1.0f + __expf(-fabsf(x))) + fmaxf(x, 0.0f); }
__device__ __forceinline__ float tanh_f(float x) { return 1.0f - 2.0f / (1.0f + __expf(2.0f * x)); }
__device__ __forceinline__ float red8(float v) { v += dpp_f<0xB1>(v); v += dpp_f<0x4E>(v); v += dpp_f<0x141>(v); return v; }
__device__ __forceinline__ v4u ld8(const bf16_t* p) { return *(const v4u*)p; }
__device__ __forceinline__ void unpack8(const v4u w, float (&f)[8]) { f[0] = bflo(w.x); f[1] = bfhi(w.x); f[2] = bflo(w.y); f[3] = bfhi(w.y); f[4] = bflo(w.z); f[5] = bfhi(w.z); f[6] = bflo(w.w); f[7] = bfhi(w.w); }
__device__ __forceinline__ v4u pack8(const float (&f)[8]) { v4u w; w.x = pk2(f[0], f[1]); w.y = pk2(f[2], f[3]); w.z = pk2(f[4], f[5]); w.w = pk2(f[6], f[7]); return w; }

__device__ __forceinline__ void prep_phase(const Args& a, Frame& F, int l) {
    const WsMap m = ws_map(NTOK);
    const bf16_t* p16 = (const bf16_t*)(a.ws + m.p16);
    bf16_t* zrkv = (bf16_t*)(a.ws + m.zrkv); bf16_t* auxA = (bf16_t*)(a.ws + m.auxA); bf16_t* xc = (bf16_t*)(a.ws + m.xc);
    const float* mu = a.in[I_RW_MU] + l * 1792;
    for (size_t it = (size_t)F.vcu * NTHR + F.tid; it < (size_t)(NTOK / 8) * 224; it += (size_t)F.G * NTHR) {
        const int n0 = (int)(it / 224) * 8, j = (int)(it % 224), t0 = n0 % TSEQ;
        const int col = j * 8;
        v4u rw[9];
#pragma unroll
        for (int k = 0; k < 9; ++k) rw[k] = ld8(p16 + (size_t)(n0 - 1 + k + ((k == 0 && t0 == 0) ? 1 : 0)) * PLD + col);
        const f32x4 m0 = *(const f32x4*)(mu + col), m1 = *(const f32x4*)(mu + col + 4);
        const float mm[8] = {m0.x, m0.y, m0.z, m0.w, m1.x, m1.y, m1.z, m1.w};
#pragma unroll
        for (int u = 0; u < 8; ++u) {
            const int n = n0 + u; const bool first = (u == 0 && t0 == 0);
            float cur[8], prv[8], z[8];
            unpack8(rw[u + 1], cur); unpack8(rw[u], prv);
#pragma unroll
            for (int k = 0; k < 8; ++k) z[k] = cur[k] + ((first ? 0.f : prv[k]) - cur[k]) * mm[k];
            if (col < 1536) *(v4u*)(zrkv + (size_t)n * 1536 + col) = pack8(z);
            else {
                const int c = col - 1536;
#pragma unroll
                for (int k = 0; k < 8; ++k) z[k] = c < 64 ? tanh_f(z[k]) : (c < 128 ? z[k] : sigm(z[k]));
                *(v4u*)(auxA + (size_t)n * 384 + c) = pack8(z);
            }
        }
    }
    for (size_t it = (size_t)F.vcu * NTHR + F.tid; it < (size_t)NTOK * 16; it += (size_t)F.G * NTHR) {
        const int n = (int)(it / 16), c = 256 + (int)(it % 16) * 8;
        v4u w = (v4u){0u, 0u, 0u, 0u};
        if (c < 272) w = ld8(p16 + (size_t)n * PLD + C_GLA + 1536 + (c - 256));
        *(v4u*)(auxA + (size_t)n * 384 + c) = w;
    }
    for (size_t it = (size_t)F.vcu * NTHR + F.tid; it < (size_t)(NTOK / 8) * 64; it += (size_t)F.G * NTHR) {
        const int n0 = (int)(it / 64) * 8, c = (int)(it % 64) * 8, t0 = n0 % TSEQ;
        v4u rw[11];
#pragma unroll
        for (int k = 0; k < 11; ++k) rw[k] = (t0 - 3 + k >= 0) ? ld8(p16 + (size_t)(n0 - 3 + k) * PLD + C_LRU + c) : (v4u){0u, 0u, 0u, 0u};
        f32x4 w0[4], w1[4];
#pragma unroll
        for (int jj = 0; jj < 4; ++jj) { const float* cw = a.in[I_LRU_CONV_W] + (size_t)l * 4 * 512 + jj * 512 + c; w0[jj] = *(const f32x4*)cw; w1[jj] = *(const f32x4*)(cw + 4); }
        const f32x4 b0 = *(const f32x4*)(a.in[I_LRU_CONV_B] + l * 512 + c), b1 = *(const f32x4*)(a.in[I_LRU_CONV_B] + l * 512 + c + 4);
#pragma unroll
        for (int u = 0; u < 8; ++u) {
            float acc[8] = {b0.x, b0.y, b0.z, b0.w, b1.x, b1.y, b1.z, b1.w};
#pragma unroll
            for (int jj = 0; jj < 4; ++jj) {
                float xv[8]; unpack8(rw[u + jj], xv);
                acc[0] += w0[jj].x * xv[0]; acc[1] += w0[jj].y * xv[1]; acc[2] += w0[jj].z * xv[2]; acc[3] += w0[jj].w * xv[3];
                acc[4] += w1[jj].x * xv[4]; acc[5] += w1[jj].y * xv[5]; acc[6] += w1[jj].z * xv[6]; acc[7] += w1[jj].w * xv[7];
            }
            *(v4u*)(xc + (size_t)(n0 + u) * 512 + c) = pack8(acc);
        }
    }
    {
        bf16_t* gq = (bf16_t*)(a.ws + m.gq); bf16_t* gk = (bf16_t*)(a.ws + m.gk); bf16_t* gv = (bf16_t*)(a.ws + m.gv); float* gsc = (float*)(a.ws + m.gsc);
        const float* cw = a.in[I_GDN_CONV_W] + (size_t)l * 4 * 1536;
        const int lane = F.lane;
        for (int n0 = F.gw * 8; n0 < NTOK; n0 += F.ngw * 8) {
            const int t0 = n0 % TSEQ;
#pragma unroll
            for (int part = 0; part < 3; ++part) {
                const int cb = part * 512 + lane * 8;
                v4u rw[11];
#pragma unroll
                for (int k = 0; k < 11; ++k) rw[k] = (t0 - 3 + k >= 0) ? ld8(p16 + (size_t)(n0 - 3 + k) * PLD + C_GDN + cb) : (v4u){0u, 0u, 0u, 0u};
                f32x4 w0[4], w1[4];
#pragma unroll
                for (int jj = 0; jj < 4; ++jj) { w0[jj] = *(const f32x4*)(cw + jj * 1536 + cb); w1[jj] = *(const f32x4*)(cw + jj * 1536 + cb + 4); }
#pragma unroll
                for (int u = 0; u < 8; ++u) {
                    float acc[8];
#pragma unroll
                    for (int k = 0; k < 8; ++k) acc[k] = 0.f;
#pragma unroll
                    for (int jj = 0; jj < 4; ++jj) {
                        float xv[8]; unpack8(rw[u + jj], xv);
                        acc[0] += w0[jj].x * xv[0]; acc[1] += w0[jj].y * xv[1]; acc[2] += w0[jj].z * xv[2]; acc[3] += w0[jj].w * xv[3];
                        acc[4] += w1[jj].x * xv[4]; acc[5] += w1[jj].y * xv[5]; acc[6] += w1[jj].z * xv[6]; acc[7] += w1[jj].w * xv[7];
                    }
                    float ss = 0.f;
#pragma unroll
                    for (int k = 0; k < 8; ++k) { acc[k] = acc[k] * sigm(acc[k]); ss += acc[k] * acc[k]; }
                    if (part < 2) {
                        ss = row16_sum(ss);
                        const float inv = (1.0f / sqrtf(ss + 1e-6f)) * (part == 0 ? 0.08838834764831845f : 1.0f);
#pragma unroll
                        for (int k = 0; k < 8; ++k) acc[k] *= inv;
                    }
                    *(v4u*)((part == 0 ? gq : (part == 1 ? gk : gv)) + (size_t)(n0 + u) * 512 + lane * 8) = pack8(acc);
                }
            }
            { const int u = lane >> 3, k = lane & 7; const size_t n = (size_t)(n0 + u);
              const float pv = bf2f(p16[n * PLD + C_GDN + 2048 + k]);
              gsc[n * 8 + k] = k < 4 ? sigm(pv) : -__expf(a.in[I_GDN_A_LOG][l * 4 + (k & 3)]) * softplus_f(pv + a.in[I_GDN_DT_BIAS][l * 4 + (k & 3)]); }
        }
    }
}

__device__ __forceinline__ float swz16(float v) { return __builtin_bit_cast(float, __builtin_amdgcn_ds_swizzle(__builtin_bit_cast(int, v), 0x401F)); }
__device__ __forceinline__ float red32(float v) { v = row16_sum(v); return v + swz16(v); }

__device__ __forceinline__ void rwkv_task(const Args& a, Frame& F, int l, int task) {
    const WsMap m = ws_map(NTOK);
    const int b = task >> 4, h = (task >> 1) & 7, hf = task & 1;
    LAS float* LR = (LAS float*)F.lds; LAS float* LW = LR + 2048; LAS float* LK = LW + 2048; LAS float* LA = LK + 2048; LAS float* LB = LA + 2048;
    LAS float* LV = LB + 2048; LAS float* LY = LV + 1024;
    const int lane = F.lane, w = F.wave, tid = F.tid;
    const int ch = h * 64 + lane;
    const bool mine = (lane >> 5) == hf;
    const float kk_ = a.in[I_RW_K_K][l * 512 + ch], ka_ = a.in[I_RW_K_A][l * 512 + ch], rk_ = a.in[I_RW_R_K][l * 512 + ch];
    const bf16_t* zr = (const bf16_t*)(a.ws + m.zrkv); const bf16_t* ao = (const bf16_t*)(a.ws + m.auxo); const bf16_t* vr = (const bf16_t*)(a.ws + m.vres);
    bf16_t* vf = (bf16_t*)(a.ws + m.vfirst); bf16_t* yo = (bf16_t*)(a.ws + m.rwy); bf16_t* bvo = (bf16_t*)(a.ws + m.rwbv);
    float S0 = 0.f, S1 = 0.f, S2 = 0.f, S3 = 0.f;
    const int row = tid >> 4, ks = tid & 15;
    float in_[4][7];
    auto load_chunk = [&](int c) {
#pragma unroll
        for (int q = 0; q < 4; ++q) { const size_t n = (size_t)b * TSEQ + c * 32 + w + 8 * q;
            in_[q][0] = bf2f(zr[n * 1536 + ch]); in_[q][1] = bf2f(zr[n * 1536 + 512 + ch]); in_[q][2] = bf2f(zr[n * 1536 + 1024 + ch]);
            in_[q][3] = bf2f(ao[n * 1792 + ch]); in_[q][4] = bf2f(ao[n * 1792 + 512 + ch]);
            if (l > 0) { in_[q][5] = bf2f(vr[n * 512 + ch]); in_[q][6] = bf2f(vf[n * 512 + ch]); } else { in_[q][5] = 0.f; in_[q][6] = 0.f; } }
    };
    load_chunk(0);
    for (int c = 0; c < TSEQ / 32; ++c) {
#pragma unroll
        for (int q = 0; q < 4; ++q) {
            const int tl = w + 8 * q; const size_t n = (size_t)b * TSEQ + c * 32 + tl;
            const float zr_ = in_[q][0], zk_ = in_[q][1], zv_ = in_[q][2], wp = in_[q][3], ap = in_[q][4];
            float v = zv_;
            if (l == 0) { if (mine) vf[n * 512 + ch] = f2bf(zv_); } else v = zv_ + (in_[q][6] - zv_) * sigm(in_[q][5]);
            const float w_raw = -softplus_f(-wp) - 0.5f, dec = __expf(-__expf(w_raw));
            const float aa = sigm(ap);
            const float kkraw = zk_ * kk_;
            const float ss = wave_sum_u(kkraw * kkraw);
            const float kk = kkraw * (1.0f / sqrtf(fmaxf(ss, 1e-24f)));
            const float km = zk_ * (1.0f + (aa - 1.0f) * ka_);
            const float bon = wave_sum_u(zr_ * km * rk_);
            LR[tl * 64 + lane] = zr_; LW[tl * 64 + lane] = dec; LK[tl * 64 + lane] = km; LA[tl * 64 + lane] = -kk; LB[tl * 64 + lane] = kk * aa;
            if (mine) { LV[tl * 32 + (lane & 31)] = v; bvo[n * 512 + ch] = f2bf(bon * v); }
        }
        __syncthreads();
        if (c + 1 < TSEQ / 32) load_chunk(c + 1);
        float keep0 = 0.f, keep1 = 0.f;
#pragma unroll 4
        for (int tl = 0; tl < 32; ++tl) {
            const int o = tl * 64 + ks * 4;
            const f32x4 a4 = *(const LAS f32x4*)(LA + o), w4 = *(const LAS f32x4*)(LW + o), b4 = *(const LAS f32x4*)(LB + o), k4 = *(const LAS f32x4*)(LK + o), r4 = *(const LAS f32x4*)(LR + o);
            const float vv = LV[tl * 32 + row];
            const float sa = row16_sum((S0 * a4.x + S1 * a4.y) + (S2 * a4.z + S3 * a4.w));
            S0 = S0 * w4.x + (sa * b4.x + vv * k4.x); S1 = S1 * w4.y + (sa * b4.y + vv * k4.y); S2 = S2 * w4.z + (sa * b4.z + vv * k4.z); S3 = S3 * w4.w + (sa * b4.w + vv * k4.w);
            const float y = row16_sum((S0 * r4.x + S1 * r4.y) + (S2 * r4.z + S3 * r4.w));
            keep0 = (ks == tl) ? y : keep0; keep1 = (ks + 16 == tl) ? y : keep1;
        }
        LY[ks * 32 + row] = keep0; LY[(16 + ks) * 32 + row] = keep1;
        __syncthreads();
        { const int tl = tid >> 4, r2 = (tid & 15) * 2; const size_t n = (size_t)b * TSEQ + c * 32 + tl;
          *(unsigned*)(yo + n * 512 + h * 64 + hf * 32 + r2) = pk2(LY[tl * 32 + r2], LY[tl * 32 + r2 + 1]); }
    }
}


__device__ __forceinline__ void chunk_cumsum8(float (&x)[8], LAS float* tmp, int lane, int w, int c8) {
#pragma unroll
    for (int d = 8; d < 64; d <<= 1) {
#pragma unroll
        for (int k = 0; k < 8; ++k) { const float t = __shfl_up(x[k], d); if (lane >= d) x[k] += t; }
    }
    if (lane >= 56) { *(LAS f32x4*)(tmp + w * 64 + c8) = (f32x4){x[0], x[1], x[2], x[3]}; *(LAS f32x4*)(tmp + w * 64 + c8 + 4) = (f32x4){x[4], x[5], x[6], x[7]}; }
    __syncthreads();
    for (int ww = 0; ww < w; ++ww) { const f32x4 a0 = *(const LAS f32x4*)(tmp + ww * 64 + c8), a1 = *(const LAS f32x4*)(tmp + ww * 64 + c8 + 4);
        x[0] += a0.x; x[1] += a0.y; x[2] += a0.z; x[3] += a0.w; x[4] += a1.x; x[5] += a1.y; x[6] += a1.z; x[7] += a1.w; }
}

constexpr int RWP = 72;
constexpr int RWT = 64 * RWP;
constexpr size_t RWB_TILES = 4 * RWT * 2;
constexpr size_t RWB_DVEC = RWB_TILES;
constexpr size_t RWB_VS = RWB_DVEC + 256;
constexpr size_t RWB_BYTES = RWB_VS + 4 * 3 * 64 * 16 * 2;

__device__ __forceinline__ f32x4 mm64(const LAS bf16_t* A, const LAS bf16_t* Bt, int mt, int nt, int lane, f32x4 acc) {
    const LAS bf16_t* ap = A + (mt * 16 + (lane & 15)) * RWP + (lane >> 4) * 8;
    const LAS bf16_t* bp = Bt + (nt * 16 + (lane & 15)) * RWP + (lane >> 4) * 8;
#pragma unroll
    for (int k0 = 0; k0 < 64; k0 += 32)
        acc = __builtin_amdgcn_mfma_f32_16x16x32_bf16(*(const LAS bf16x8*)(ap + k0), *(const LAS bf16x8*)(bp + k0), acc, 0, 0, 0);
    return acc;
}
__device__ __forceinline__ void st_rowmajor(LAS bf16_t* T, int mt, int nt, int lane, const f32x4 v) {
    const int n = nt * 16 + (lane & 15), i0 = mt * 16 + (lane >> 4) * 4;
    T[(i0 + 0) * RWP + n] = f2bf(v.x); T[(i0 + 1) * RWP + n] = f2bf(v.y); T[(i0 + 2) * RWP + n] = f2bf(v.z); T[(i0 + 3) * RWP + n] = f2bf(v.w);
}
__device__ __forceinline__ void st_transposed(LAS bf16_t* T, int mt, int nt, int lane, const f32x4 v) {
    const int n = nt * 16 + (lane & 15), i0 = mt * 16 + (lane >> 4) * 4;
    *(LAS v2u*)(T + n * RWP + i0) = (v2u){pk2(v.x, v.y), pk2(v.z, v.w)};
}

__device__ __forceinline__ void rwkv_pa_chunk(const Args& a, Frame& F, int l, int ci) {
    const WsMap m = ws_map(NTOK);
    const int bh = ci >> 6, c = ci & 63, b = bh >> 3, h = bh & 7;
    const int lane = F.lane, w = F.wave, tid = F.tid;
    const int ch = h * 64 + lane;
    LAS bf16_t* At = (LAS bf16_t*)F.lds; LAS bf16_t* AtT = At + RWT; LAS bf16_t* Bt = AtT + RWT; LAS bf16_t* Kt = Bt + RWT; LAS bf16_t* KtGT = Kt + RWT;
    LAS bf16_t* Rt = KtGT + RWT; LAS bf16_t* VmT = Rt + RWT; LAS bf16_t* LAK = VmT + RWT;
    LAS bf16_t* X0 = LAK + RWT; LAS bf16_t* XT0 = X0 + RWT; LAS bf16_t* T0 = XT0 + RWT; LAS bf16_t* X1 = T0 + RWT; LAS bf16_t* XT1 = X1 + RWT; LAS bf16_t* T1 = XT1 + RWT;
    LAS float* LWL = (LAS float*)X0;
    LAS bf16_t* A2 = X1;
    LAS bf16_t* LVT = XT1;
    const bf16_t* zr = (const bf16_t*)(a.ws + m.zrkv); const bf16_t* ao = (const bf16_t*)(a.ws + m.auxo); const bf16_t* vr = (const bf16_t*)(a.ws + m.vres);
    bf16_t* vf = (bf16_t*)(a.ws + m.vfirst); bf16_t* bvo = (bf16_t*)(a.ws + m.rwbv);
    unsigned char* blob = (unsigned char*)a.out + (size_t)ci * RWB_BYTES;
    bf16_t* gW = (bf16_t*)blob; bf16_t* gQG = gW + RWT; bf16_t* gKGT = gQG + RWT; bf16_t* gA1 = gKGT + RWT;
    float* gDV = (float*)(blob + RWB_DVEC); bf16_t* gVS = (bf16_t*)(blob + RWB_VS);
    const int j = tid >> 3, c8 = (tid & 7) * 8, chb = h * 64 + c8;
    const size_t n = (size_t)b * TSEQ + c * 64 + j;
    float zr_[8], zk_[8], zv_[8], wp[8], ap[8];
    unpack8(ld8(zr + n * 1536 + chb), zr_); unpack8(ld8(zr + n * 1536 + 512 + chb), zk_); unpack8(ld8(zr + n * 1536 + 1024 + chb), zv_);
    unpack8(ld8(ao + n * 1792 + chb), wp); unpack8(ld8(ao + n * 1792 + 512 + chb), ap);
    float vres8[8], vf8[8];
    if (l > 0) { unpack8(ld8(vr + n * 512 + chb), vres8); unpack8(ld8(vf + n * 512 + chb), vf8); }
    float lw[8];
#pragma unroll
    for (int k = 0; k < 8; ++k) lw[k] = -__expf(-softplus_f(-wp[k]) - 0.5f);
    float cs[8];
#pragma unroll
    for (int k = 0; k < 8; ++k) cs[k] = lw[k];
    chunk_cumsum8(cs, LWL, lane, w, c8);
    {
        float pk_[8], pa_[8], pr_[8];
        { const float* p0 = a.in[I_RW_K_K] + l * 512 + chb; const float* p1 = a.in[I_RW_K_A] + l * 512 + chb; const float* p2 = a.in[I_RW_R_K] + l * 512 + chb;
          const f32x4 a0 = *(const f32x4*)p0, a1 = *(const f32x4*)(p0 + 4), b0 = *(const f32x4*)p1, b1 = *(const f32x4*)(p1 + 4), c0 = *(const f32x4*)p2, c1 = *(const f32x4*)(p2 + 4);
          pk_[0] = a0.x; pk_[1] = a0.y; pk_[2] = a0.z; pk_[3] = a0.w; pk_[4] = a1.x; pk_[5] = a1.y; pk_[6] = a1.z; pk_[7] = a1.w;
          pa_[0] = b0.x; pa_[1] = b0.y; pa_[2] = b0.z; pa_[3] = b0.w; pa_[4] = b1.x; pa_[5] = b1.y; pa_[6] = b1.z; pa_[7] = b1.w;
          pr_[0] = c0.x; pr_[1] = c0.y; pr_[2] = c0.z; pr_[3] = c0.w; pr_[4] = c1.x; pr_[5] = c1.y; pr_[6] = c1.z; pr_[7] = c1.w; }
        float v[8], aa[8], kk[8], km[8];
        float ss = 0.f, bs = 0.f;
#pragma unroll
        for (int k = 0; k < 8; ++k) {
            v[k] = (l == 0) ? zv_[k] : zv_[k] + (vf8[k] - zv_[k]) * sigm(vres8[k]);
            aa[k] = sigm(ap[k]);
            kk[k] = zk_[k] * pk_[k]; ss += kk[k] * kk[k];
            km[k] = zk_[k] * (1.0f + (aa[k] - 1.0f) * pa_[k]); bs += zr_[k] * km[k] * pr_[k];
        }
        if (l == 0) *(v4u*)(vf + n * 512 + chb) = p0_pack8(zv_);
        ss = red8(ss); bs = red8(bs);
        const float kinv = 1.0f / sqrtf(fmaxf(ss, 1e-24f));
        float cm[8], gcv[8];
        {
#pragma unroll
          for (int k = 0; k < 8; ++k) gcv[k] = 0.f;
#pragma unroll
          for (int ww = 0; ww < 8; ++ww) { const f32x4 g0 = *(const LAS f32x4*)(LWL + ww * 64 + c8), g1 = *(const LAS f32x4*)(LWL + ww * 64 + c8 + 4);
              gcv[0] += g0.x; gcv[1] += g0.y; gcv[2] += g0.z; gcv[3] += g0.w; gcv[4] += g1.x; gcv[5] += g1.y; gcv[6] += g1.z; gcv[7] += g1.w; } }
#pragma unroll
        for (int k = 0; k < 8; ++k) cm[k] = cs[k] - lw[k];
        float t_at[8], t_bt[8], t_kt[8], t_rt[8], t_bv[8];
        LAS bf16_t* KGTl = T1;
#pragma unroll
        for (int k = 0; k < 8; ++k) {
            const float G = __expf(cs[k]), Gm1 = __expf(cm[k]), iG = __expf(-cs[k]), GcG = __expf(gcv[k] - cs[k]);
            const float kkn = kk[k] * kinv;
            const float av = -kkn, bv = kkn * aa[k];
            t_at[k] = av * Gm1; t_bt[k] = bv * iG; t_kt[k] = km[k] * iG; t_rt[k] = zr_[k] * G; t_bv[k] = bs * v[k];
            AtT[(c8 + k) * RWP + j] = f2bf(t_at[k]);
            KtGT[(c8 + k) * RWP + j] = f2bf(km[k] * GcG);
            VmT[(c8 + k) * RWP + j] = f2bf(v[k]);
            KGTl[(c8 + k) * RWP + j] = f2bf(bv * GcG);
        }
        *(LAS v4u*)(At + j * RWP + c8) = pack8(t_at); *(LAS v4u*)(Bt + j * RWP + c8) = pack8(t_bt); *(LAS v4u*)(Kt + j * RWP + c8) = pack8(t_kt);
        const v4u rt8 = pack8(t_rt);
        *(LAS v4u*)(Rt + j * RWP + c8) = rt8; *(v4u*)(gQG + j * RWP + c8) = rt8;
        *(v4u*)(bvo + n * 512 + chb) = pack8(t_bv);
        if (j == 63) { *(f32x4*)(gDV + c8) = (f32x4){__expf(gcv[0]), __expf(gcv[1]), __expf(gcv[2]), __expf(gcv[3])}; *(f32x4*)(gDV + c8 + 4) = (f32x4){__expf(gcv[4]), __expf(gcv[5]), __expf(gcv[6]), __expf(gcv[7])}; }
    }
    __syncthreads();
    {
        for (int o = tid; o < RWT / 8; o += NTHR) ((v4u*)gKGT)[o] = ((const LAS v4u*)T1)[o];
        f32x4 z4 = {0.f, 0.f, 0.f, 0.f};
#pragma unroll 1
        for (int tt = 0; tt < 2; ++tt) {
            const int t = w + 8 * tt, mt = t >> 2, nt = t & 3;
            const int n = nt * 16 + (lane & 15), i0 = mt * 16 + (lane >> 4) * 4;
            f32x4 lab = mm64(At, Bt, mt, nt, lane, z4), lak = mm64(At, Kt, mt, nt, lane, z4), a1 = mm64(Rt, Bt, mt, nt, lane, z4), a2 = mm64(Rt, Kt, mt, nt, lane, z4);
            f32x4 tt0;
#pragma unroll
            for (int e = 0; e < 4; ++e) { const int i = i0 + e;
                if (n >= i) { lab[e] = 0.f; lak[e] = 0.f; }
                if (n > i) { a1[e] = 0.f; a2[e] = 0.f; }
                tt0[e] = lab[e] + (n == i ? 1.0f : 0.f); }
            st_rowmajor(X0, mt, nt, lane, lab); st_transposed(XT0, mt, nt, lane, lab);
            st_rowmajor(T0, mt, nt, lane, tt0);
            st_rowmajor(LAK, mt, nt, lane, lak);
            st_rowmajor(A2, mt, nt, lane, a2);
            gA1[(i0 + 0) * RWP + n] = f2bf(a1.x); gA1[(i0 + 1) * RWP + n] = f2bf(a1.y); gA1[(i0 + 2) * RWP + n] = f2bf(a1.z); gA1[(i0 + 3) * RWP + n] = f2bf(a1.w);
        }
    }
    __syncthreads();
    {
        f32x4 z4 = {0.f, 0.f, 0.f, 0.f};
#pragma unroll 1
        for (int tt = 0; tt < 2; ++tt) {
            const int t = w + 8 * tt, mt = t >> 2, nt = t & 3;
            const int n = nt * 16 + (lane & 15), i0 = mt * 16 + (lane >> 4) * 4;
            const f32x4 lv = mm64(LAK, VmT, mt, nt, lane, z4), o0 = mm64(A2, VmT, mt, nt, lane, z4), kv0 = mm64(KtGT, VmT, mt, nt, lane, z4);
            st_transposed((LAS bf16_t*)(F.lds + 131584), mt, nt, lane, lv);
            bf16_t* go = gVS + (size_t)nt * 3 * 1024 + 1024;
            const int r = lane & 15;
            go[(i0 + 0) * 16 + r] = f2bf(o0.x); go[(i0 + 1) * 16 + r] = f2bf(o0.y); go[(i0 + 2) * 16 + r] = f2bf(o0.z); go[(i0 + 3) * 16 + r] = f2bf(o0.w);
            go[1024 + (i0 + 0) * 16 + r] = f2bf(kv0.x); go[1024 + (i0 + 1) * 16 + r] = f2bf(kv0.y); go[1024 + (i0 + 2) * 16 + r] = f2bf(kv0.z); go[1024 + (i0 + 3) * 16 + r] = f2bf(kv0.w);
            (void)n;
        }
    }
    __syncthreads();
    {
        LAS bf16_t* Xc = X0; LAS bf16_t* XTc = XT0; LAS bf16_t* Tc = T0; LAS bf16_t* Xn = X1; LAS bf16_t* XTn = XT1; LAS bf16_t* Tn = T1;
        f32x4 z4 = {0.f, 0.f, 0.f, 0.f};
#pragma unroll 1
        for (int it = 0; it < 5; ++it) {
#pragma unroll 1
            for (int tt = 0; tt < 2; ++tt) { const int t = w + 8 * tt, mt = t >> 2, nt = t & 3;
                const f32x4 x2 = mm64(Xc, XTc, mt, nt, lane, z4);
                st_rowmajor(Xn, mt, nt, lane, x2); st_transposed(XTn, mt, nt, lane, x2); }
            __syncthreads();
#pragma unroll 1
            for (int tt = 0; tt < 2; ++tt) { const int t = w + 8 * tt, mt = t >> 2, nt = t & 3;
                const int n = nt * 16 + (lane & 15), i0 = mt * 16 + (lane >> 4) * 4;
                f32x4 tc; tc.x = bf2f(Tc[(i0 + 0) * RWP + n]); tc.y = bf2f(Tc[(i0 + 1) * RWP + n]); tc.z = bf2f(Tc[(i0 + 2) * RWP + n]); tc.w = bf2f(Tc[(i0 + 3) * RWP + n]);
                const f32x4 tn = mm64(Tc, XTn, mt, nt, lane, tc);
                st_rowmajor(Tn, mt, nt, lane, tn); }
            __syncthreads();
            LAS bf16_t* s0 = Xc; Xc = Xn; Xn = s0; s0 = XTc; XTc = XTn; XTn = s0; s0 = Tc; Tc = Tn; Tn = s0;
        }
        LAS bf16_t* LVTp = (LAS bf16_t*)(F.lds + 131584);
#pragma unroll 1
        for (int tt = 0; tt < 2; ++tt) { const int t = w + 8 * tt, mt = t >> 2, nt = t & 3;
            const int n = nt * 16 + (lane & 15), i0 = mt * 16 + (lane >> 4) * 4, r = lane & 15;
            const f32x4 wt = mm64(Tc, AtT, mt, nt, lane, z4), u0 = mm64(Tc, LVTp, mt, nt, lane, z4);
            gW[(i0 + 0) * RWP + n] = f2bf(wt.x); gW[(i0 + 1) * RWP + n] = f2bf(wt.y); gW[(i0 + 2) * RWP + n] = f2bf(wt.z); gW[(i0 + 3) * RWP + n] = f2bf(wt.w);
            bf16_t* gu = gVS + (size_t)nt * 3 * 1024;
            gu[(i0 + 0) * 16 + r] = f2bf(u0.x); gu[(i0 + 1) * 16 + r] = f2bf(u0.y); gu[(i0 + 2) * 16 + r] = f2bf(u0.z); gu[(i0 + 3) * 16 + r] = f2bf(u0.w); }
    }
    __syncthreads();
    (void)LVT;
}

__device__ __forceinline__ void rwkv_ps_task(const Args& a, Frame& F, int task) {
    const WsMap m = ws_map(NTOK);
    const int bh = task >> 2, vs = task & 3, b = bh >> 3, h = bh & 7;
    const int lane = F.lane, w = F.wave, tid = F.tid;
    LAS bf16_t* LB0 = (LAS bf16_t*)F.lds;
    LAS bf16_t* ST0 = LB0 + 8 * RWT; LAS bf16_t* VNT = ST0 + 2 * 16 * RWP;
    bf16_t* yo = (bf16_t*)(a.ws + m.rwy);
    const unsigned char* blob0 = (const unsigned char*)a.out + (size_t)(bh * 64) * RWB_BYTES;
    const int r = lane & 15, i0w = (w & 3) * 16 + (lane >> 4) * 4;
    f32x4 Sacc = {0.f, 0.f, 0.f, 0.f};
    for (int i = tid; i < 16 * RWP / 2; i += NTHR) ((LAS unsigned*)ST0)[i] = 0u;
    v4u pre[5];
    auto prefetch = [&](int c) {
        const v4u* g = (const v4u*)(blob0 + (size_t)c * RWB_BYTES);
#pragma unroll
        for (int k = 0; k < 5; ++k) { const int o = k * 512 + tid; pre[k] = (o < (int)(RWB_TILES / 16)) ? g[o] : (v4u){0u, 0u, 0u, 0u}; }
    };
    auto commit = [&](int p) {
#pragma unroll
        for (int k = 0; k < 5; ++k) { const int o = k * 512 + tid; if (o < (int)(RWB_TILES / 16)) ((LAS v4u*)(LB0 + p * 4 * RWT))[o] = pre[k]; }
    };
    bf16_t nfr[4], nkv[4]; float ndv[4];
    auto prefrag = [&](int c) {
        const unsigned char* blob = blob0 + (size_t)c * RWB_BYTES;
        const bf16_t* gvs = (const bf16_t*)(blob + RWB_VS) + (size_t)vs * 3 * 1024;
        const bf16_t* src = gvs + (w < 4 ? 0 : 1024);
#pragma unroll
        for (int e = 0; e < 4; ++e) nfr[e] = src[(i0w + e) * 16 + r];
        if (w < 4) { const float* gd = (const float*)(blob + RWB_DVEC);
#pragma unroll
            for (int e = 0; e < 4; ++e) { ndv[e] = gd[i0w + e]; nkv[e] = gvs[2048 + (i0w + e) * 16 + r]; } }
        else {
#pragma unroll
            for (int e = 0; e < 4; ++e) { ndv[e] = 1.f; nkv[e] = 0; } }
    };
    prefetch(0); commit(0); prefetch(1); prefrag(0);
    for (int c = 0; c < 64; ++c) {
        float fr[4], dv[4], kv0[4];
#pragma unroll
        for (int e = 0; e < 4; ++e) { fr[e] = bf2f(nfr[e]); dv[e] = ndv[e]; kv0[e] = bf2f(nkv[e]); }
        if (c + 1 < 64) prefrag(c + 1);
        const int p = c & 1;
        LAS bf16_t* LB = LB0 + p * 4 * RWT; LAS bf16_t* ST = ST0 + p * 16 * RWP; LAS bf16_t* STN = ST0 + (1 - p) * 16 * RWP;
        __syncthreads();
        if (c + 1 < 64) commit(1 - p);
        if (c + 2 < 64) prefetch(c + 2);
        if (w < 4) {
            f32x4 vn = mm64(LB, ST, w, 0, lane, (f32x4){fr[0], fr[1], fr[2], fr[3]});
            st_transposed(VNT, w, 0, lane, vn);
        }
        __syncthreads();
        if (w < 4) {
            const f32x4 base = {dv[0] * Sacc.x + kv0[0], dv[1] * Sacc.y + kv0[1], dv[2] * Sacc.z + kv0[2], dv[3] * Sacc.w + kv0[3]};
            Sacc = mm64(LB + 2 * RWT, VNT, w, 0, lane, base);
            st_transposed(STN, w, 0, lane, Sacc);
        } else {
            f32x4 o = mm64(LB + RWT, ST, w - 4, 0, lane, (f32x4){fr[0], fr[1], fr[2], fr[3]});
            o = mm64(LB + 3 * RWT, VNT, w - 4, 0, lane, o);
            const size_t n = (size_t)b * TSEQ + c * 64 + i0w;
            bf16_t* yp = yo + n * 512 + h * 64 + vs * 16 + r;
            yp[0] = f2bf(o.x); yp[512] = f2bf(o.y); yp[1024] = f2bf(o.z); yp[1536] = f2bf(o.w);
        }
    }
    __syncthreads();
}

constexpr int GP = 136;
constexpr size_t GB_BYTES = 26880;
template <int KD, int PA_, int PB_>
__device__ __forceinline__ f32x4 mmx(const LAS bf16_t* A, const LAS bf16_t* Bt, int mt, int nt, int lane, f32x4 acc) {
    const LAS bf16_t* ap = A + (mt * 16 + (lane & 15)) * PA_ + (lane >> 4) * 8;
    const LAS bf16_t* bp = Bt + (nt * 16 + (lane & 15)) * PB_ + (lane >> 4) * 8;
#pragma unroll
    for (int k0 = 0; k0 < KD; k0 += 32)
        acc = __builtin_amdgcn_mfma_f32_16x16x32_bf16(*(const LAS bf16x8*)(ap + k0), *(const LAS bf16x8*)(bp + k0), acc, 0, 0, 0);
    return acc;
}
__device__ __forceinline__ void gdn_pa_chunk(const Args& a, Frame& F, int ci) {
    const WsMap m = ws_map(NTOK);
    const int bh = ci >> 6, c = ci & 63, b = bh >> 2, h = bh & 3;
    const int lane = F.lane, w = F.wave, tid = F.tid;
    LAS bf16_t* KB = (LAS bf16_t*)F.lds; LAS bf16_t* KH = KB + 64 * GP; LAS bf16_t* QH = KH + 64 * GP;
    LAS bf16_t* KBEt = KB; LAS bf16_t* VbT = KB + 128 * RWP;
    LAS bf16_t* X0 = QH + 64 * GP; LAS bf16_t* XT0 = X0 + RWT; LAS bf16_t* T0 = XT0 + RWT; LAS bf16_t* X1 = T0 + RWT; LAS bf16_t* XT1 = X1 + RWT; LAS bf16_t* T1 = XT1 + RWT;
    LAS float* GC = (LAS float*)(T1 + RWT);
    LAS bf16_t* KGTl = (LAS bf16_t*)(GC + 64);
    bf16_t* gq = (bf16_t*)(a.ws + m.gq); bf16_t* gk = (bf16_t*)(a.ws + m.gk); bf16_t* gv = (bf16_t*)(a.ws + m.gv); const float* gsc = (const float*)(a.ws + m.gsc);
    unsigned char* blob = a.ws + m.gblob + (size_t)ci * GB_BYTES;
    bf16_t* gA1 = (bf16_t*)blob; bf16_t* gW = gA1 + RWT; float* gGC = (float*)(blob + RWT * 2 + 64 * GP * 2);
    const int j = tid >> 3, c16 = (tid & 7) * 16;
    const size_t n0 = (size_t)b * TSEQ + c * 64, n = n0 + j;
    const float be = gsc[n * 8 + h];
    v4u kw[2], qw[2], vw[2];
    {
        float kf[8];
#pragma unroll
        for (int hh = 0; hh < 2; ++hh) {
            kw[hh] = ld8(gk + n * 512 + h * 128 + c16 + hh * 8); qw[hh] = ld8(gq + n * 512 + h * 128 + c16 + hh * 8); vw[hh] = ld8(gv + n * 512 + h * 128 + c16 + hh * 8);
            *(LAS v4u*)(KH + j * GP + c16 + hh * 8) = kw[hh]; *(LAS v4u*)(QH + j * GP + c16 + hh * 8) = qw[hh];
            unpack8(kw[hh], kf);
#pragma unroll
            for (int k = 0; k < 8; ++k) kf[k] *= be;
            *(LAS v4u*)(KB + j * GP + c16 + hh * 8) = pack8(kf);
        }
        if (w == 0) {
            float g = gsc[(n0 + lane) * 8 + 4 + h];
#pragma unroll
            for (int o = 1; o < 64; o <<= 1) { const float t = __shfl_up(g, o); if (lane >= o) g += t; }
            GC[lane] = g; gGC[lane] = g;
        }
    }
    __syncthreads();
    {
        const f32x4 z4 = {0.f, 0.f, 0.f, 0.f};
#pragma unroll 1
        for (int tt = 0; tt < 2; ++tt) {
            const int t = w + 8 * tt, mt = t >> 2, nt = t & 3;
            const int nn = nt * 16 + (lane & 15), i0 = mt * 16 + (lane >> 4) * 4;
            f32x4 kk = mmx<128, GP, GP>(KB, KH, mt, nt, lane, z4), qk = mmx<128, GP, GP>(QH, KH, mt, nt, lane, z4);
            const float gj = GC[nn];
            f32x4 x, t0;
#pragma unroll
            for (int e = 0; e < 4; ++e) { const int i = i0 + e; const float d = __expf(fminf(GC[i] - gj, 0.f));
                x[e] = (nn < i) ? -kk[e] * d : 0.f; qk[e] = (nn <= i) ? qk[e] * d : 0.f; t0[e] = x[e] + (nn == i ? 1.0f : 0.f); }
            st_rowmajor(X0, mt, nt, lane, x); st_transposed(XT0, mt, nt, lane, x); st_rowmajor(T0, mt, nt, lane, t0);
            gA1[(i0 + 0) * RWP + nn] = f2bf(qk.x); gA1[(i0 + 1) * RWP + nn] = f2bf(qk.y); gA1[(i0 + 2) * RWP + nn] = f2bf(qk.z); gA1[(i0 + 3) * RWP + nn] = f2bf(qk.w);
        }
    }
    __syncthreads();
    {
        const float gj = GC[j], eg = __expf(gj), s_kbe = be * eg, s_kg = __expf(GC[63] - gj);
        float f[8], o8[8];
#pragma unroll
        for (int hh = 0; hh < 2; ++hh) {
            unpack8(kw[hh], f);
#pragma unroll
            for (int k = 0; k < 8; ++k) { KBEt[(c16 + hh * 8 + k) * RWP + j] = f2bf(f[k] * s_kbe); KGTl[(c16 + hh * 8 + k) * RWP + j] = f2bf(f[k] * s_kg); }
            unpack8(vw[hh], f);
#pragma unroll
            for (int k = 0; k < 8; ++k) VbT[(c16 + hh * 8 + k) * RWP + j] = f2bf(f[k] * be);
            unpack8(qw[hh], f);
#pragma unroll
            for (int k = 0; k < 8; ++k) o8[k] = f[k] * eg;
            *(v4u*)(gq + n * 512 + h * 128 + c16 + hh * 8) = pack8(o8);
        }
    }
    const f32x4 z4 = {0.f, 0.f, 0.f, 0.f};
    LAS bf16_t* Xc = X0; LAS bf16_t* XTc = XT0; LAS bf16_t* Tc = T0; LAS bf16_t* Xn = X1; LAS bf16_t* XTn = XT1; LAS bf16_t* Tn = T1;
#pragma unroll 1
    for (int it = 0; it < 5; ++it) {
#pragma unroll 1
        for (int tt = 0; tt < 2; ++tt) { const int t = w + 8 * tt, mt = t >> 2, nt = t & 3;
            const f32x4 x2 = mm64(Xc, XTc, mt, nt, lane, z4);
            st_rowmajor(Xn, mt, nt, lane, x2); st_transposed(XTn, mt, nt, lane, x2); }
        __syncthreads();
#pragma unroll 1
        for (int tt = 0; tt < 2; ++tt) { const int t = w + 8 * tt, mt = t >> 2, nt = t & 3;
            const int nn = nt * 16 + (lane & 15), i0 = mt * 16 + (lane >> 4) * 4;
            f32x4 tc; tc.x = bf2f(Tc[(i0 + 0) * RWP + nn]); tc.y = bf2f(Tc[(i0 + 1) * RWP + nn]); tc.z = bf2f(Tc[(i0 + 2) * RWP + nn]); tc.w = bf2f(Tc[(i0 + 3) * RWP + nn]);
            const f32x4 tn = mm64(Tc, XTn, mt, nt, lane, tc);
            st_rowmajor(Tn, mt, nt, lane, tn); }
        __syncthreads();
        LAS bf16_t* s0 = Xc; Xc = Xn; Xn = s0; s0 = XTc; XTc = XTn; XTn = s0; s0 = Tc; Tc = Tn; Tn = s0;
    }
    {
#pragma unroll 1
        for (int tt = 0; tt < 4; ++tt) { const int mt = w, nt = tt;
            const f32x4 dw = mm64(KBEt, Tc, mt, nt, lane, z4), du = mm64(VbT, Tc, mt, nt, lane, z4);
            const int i = nt * 16 + (lane & 15), c0 = mt * 16 + (lane >> 4) * 4;
            *(v2u*)(gW + i * GP + c0) = (v2u){pk2(dw.x, dw.y), pk2(dw.z, dw.w)};
            *(v2u*)(gv + (n0 + i) * 512 + h * 128 + c0) = (v2u){pk2(du.x, du.y), pk2(du.z, du.w)}; }
        for (int p = tid; p < 1024; p += NTHR) { const int k = p >> 3, j8 = (p & 7) * 8;
            *(v4u*)(gk + (n0 + (k >> 1)) * 512 + h * 128 + (k & 1) * 64 + j8) = *(const LAS v4u*)(KGTl + k * RWP + j8); }
    }
    __syncthreads();
}

struct GdnPsRegs { v4u pb[4], pq[2], pk[2], pu; };
__device__ __forceinline__ void gdn_ps_task(const Args& a, Frame& F, int task) {
    const WsMap m = ws_map(NTOK);
    const int bh = task >> 3, vs = task & 7, b = bh >> 2, h = bh & 3;
    const int lane = F.lane, w = F.wave, tid = F.tid;
    constexpr int OB = RWT + 64 * GP + 128 * RWP + 128;
    LAS bf16_t* OT = (LAS bf16_t*)F.lds;
    LAS bf16_t* WT = OT + 2 * OB; LAS bf16_t* UU = WT + 64 * GP; LAS bf16_t* STB = UU + 64 * 16; LAS bf16_t* VNT = STB + 2 * 16 * GP;
    const bf16_t* gq = (const bf16_t*)(a.ws + m.gq); const bf16_t* gk = (const bf16_t*)(a.ws + m.gk); const bf16_t* gv = (const bf16_t*)(a.ws + m.gv);
    bf16_t* go = (bf16_t*)(a.ws + m.gdno);
    const unsigned char* blob0 = a.ws + m.gblob + (size_t)(bh * 64) * GB_BYTES;
    const int r = lane & 15, kq4 = (lane >> 4) * 4;
    f32x4 Sacc = {0.f, 0.f, 0.f, 0.f};
    for (int i = tid; i < 16 * GP / 2; i += NTHR) ((LAS unsigned*)STB)[i] = 0u;
    auto prefetch = [&](int c, GdnPsRegs& R) {
        const size_t n0 = (size_t)b * TSEQ + c * 64;
        const v4u* g = (const v4u*)(blob0 + (size_t)c * GB_BYTES);
#pragma unroll
        for (int k = 0; k < 4; ++k) { const int o = k * 512 + tid; R.pb[k] = (o < (int)(GB_BYTES / 16)) ? g[o] : (v4u){0u, 0u, 0u, 0u}; }
#pragma unroll
        for (int k = 0; k < 2; ++k) { const int p = k * 512 + tid;
            R.pq[k] = ld8(gq + (n0 + (p >> 4)) * 512 + h * 128 + (p & 15) * 8);
            R.pk[k] = ld8(gk + (n0 + (p >> 4)) * 512 + h * 128 + (p & 15) * 8); }
        if (tid < 128) R.pu = ld8(gv + (n0 + (tid >> 1)) * 512 + h * 128 + vs * 16 + (tid & 1) * 8);
    };
    auto put_o = [&](const GdnPsRegs& R, int p) {
        LAS bf16_t* ob = OT + p * OB;
#pragma unroll
        for (int k = 0; k < 4; ++k) { const int o = k * 512 + tid;
            if (o < 576) ((LAS v4u*)ob)[o] = R.pb[k];
            else if (o >= 1664 && o < 1680) ((LAS v4u*)(ob + RWT + 64 * GP + 128 * RWP))[o - 1664] = R.pb[k]; }
#pragma unroll
        for (int k = 0; k < 2; ++k) { const int pp = k * 512 + tid;
            *(LAS v4u*)(ob + RWT + (pp >> 4) * GP + (pp & 15) * 8) = R.pq[k];
            const int kk = 2 * (pp >> 4) + ((pp & 15) >> 3), j8 = (pp & 7) * 8;
            *(LAS v4u*)(ob + RWT + 64 * GP + kk * RWP + j8) = R.pk[k]; }
    };
    auto put_w = [&](const GdnPsRegs& R) {
#pragma unroll
        for (int k = 0; k < 4; ++k) { const int o = k * 512 + tid; if (o >= 576 && o < 1664) ((LAS v4u*)WT)[o - 576] = R.pb[k]; }
        if (tid < 128) *(LAS v4u*)(UU + (tid >> 1) * 16 + (tid & 1) * 8) = R.pu;
    };
    auto step = [&](int c, GdnPsRegs& Rfree, const GdnPsRegs& Rnext) {
        const int p = c & 1;
        LAS bf16_t* A1 = OT + p * OB; LAS bf16_t* QG = A1 + RWT; LAS bf16_t* KGT = QG + 64 * GP; const LAS float* GC = (const LAS float*)(KGT + 128 * RWP);
        LAS bf16_t* ST = STB + p * 16 * GP; LAS bf16_t* STN = STB + (1 - p) * 16 * GP;
        __syncthreads();
        if (c + 2 < 64) prefetch(c + 2, Rfree);
        if (c + 1 < 64) put_o(Rnext, 1 - p);
        if (w < 4) {
            const int i0 = w * 16 + kq4;
            f32x4 vn = mmx<128, GP, GP>(WT, ST, w, 0, lane, (f32x4){0.f, 0.f, 0.f, 0.f});
            vn.x = bf2f(UU[(i0 + 0) * 16 + r]) - vn.x; vn.y = bf2f(UU[(i0 + 1) * 16 + r]) - vn.y; vn.z = bf2f(UU[(i0 + 2) * 16 + r]) - vn.z; vn.w = bf2f(UU[(i0 + 3) * 16 + r]) - vn.w;
            st_transposed(VNT, w, 0, lane, vn);
        }
        __syncthreads();
        if (c + 1 < 64) put_w(Rnext);
        {
            const float glast = __expf(GC[63]);
            const f32x4 base = {Sacc.x * glast, Sacc.y * glast, Sacc.z * glast, Sacc.w * glast};
            Sacc = mm64(KGT, VNT, w, 0, lane, base);
            if (w < 4) {
                f32x4 o = mmx<128, GP, GP>(QG, ST, w, 0, lane, (f32x4){0.f, 0.f, 0.f, 0.f});
                o = mm64(A1, VNT, w, 0, lane, o);
                const size_t n = (size_t)b * TSEQ + c * 64 + w * 16 + kq4;
                bf16_t* op = go + n * 512 + h * 128 + vs * 16 + r;
                op[0] = f2bf(o.x); op[512] = f2bf(o.y); op[1024] = f2bf(o.z); op[1536] = f2bf(o.w);
            }
            const int k0 = w * 16 + kq4;
            *(LAS v2u*)(STN + r * GP + k0) = (v2u){pk2(Sacc.x, Sacc.y), pk2(Sacc.z, Sacc.w)};
        }
    };
    GdnPsRegs R0, R1;
    prefetch(0, R0); prefetch(1, R1);
    put_o(R0, 0); put_w(R0);
#pragma unroll 1
    for (int c = 0; c < 64; c += 2) { step(c, R0, R1); step(c + 1, R1, R0); }
    __syncthreads();
}

__device__ __forceinline__ void gla_pa_chunk(const Args& a, Frame& F, int ci) {
    const WsMap m = ws_map(NTOK);
    const int bh = ci >> 6, c = ci & 63, b = bh >> 2, h = bh & 3;
    const int lane = F.lane, w = F.wave, tid = F.tid;
    LAS bf16_t* KS2T = (LAS bf16_t*)F.lds; LAS bf16_t* VT = KS2T + RWT; LAS float* TMP = (LAS float*)(VT + 128 * RWP);
    const bf16_t* p16 = (const bf16_t*)(a.ws + m.p16); const bf16_t* ao = (const bf16_t*)(a.ws + m.auxo);
    bf16_t* gKV = (bf16_t*)(a.ws + m.glao) + (size_t)ci * 8192; float* gDV = (float*)(a.ws + m.gladv) + (size_t)ci * 64;
    const int j = tid >> 3, c8 = (tid & 7) * 8, v16 = (tid & 7) * 16;
    const size_t n = (size_t)b * TSEQ + c * 64 + j;
    float k8[8], la[8];
    unpack8(ld8(p16 + n * PLD + C_GLA + 256 + h * 64 + c8), k8); unpack8(ld8(ao + n * 1792 + 1536 + h * 64 + c8), la);
    const v4u v0 = ld8(p16 + n * PLD + C_GLA + 512 + h * 128 + v16), v1 = ld8(p16 + n * PLD + C_GLA + 512 + h * 128 + v16 + 8);
#pragma unroll
    for (int k = 0; k < 8; ++k) la[k] = -softplus_f(-la[k]) * (1.0f / 16.0f);
    chunk_cumsum8(la, TMP, lane, w, c8);
    float bl[8];
#pragma unroll
    for (int k = 0; k < 8; ++k) bl[k] = 0.f;
#pragma unroll
    for (int ww = 0; ww < 8; ++ww) { const f32x4 y0 = *(const LAS f32x4*)(TMP + ww * 64 + c8), y1 = *(const LAS f32x4*)(TMP + ww * 64 + c8 + 4);
        bl[0] += y0.x; bl[1] += y0.y; bl[2] += y0.z; bl[3] += y0.w; bl[4] += y1.x; bl[5] += y1.y; bl[6] += y1.z; bl[7] += y1.w; }
#pragma unroll
    for (int k = 0; k < 8; ++k) KS2T[(c8 + k) * RWP + j] = f2bf(k8[k] * __expf(bl[k] - la[k]));
    { const unsigned vw[8] = {v0.x, v0.y, v0.z, v0.w, v1.x, v1.y, v1.z, v1.w};
#pragma unroll
      for (int e = 0; e < 8; ++e) { VT[(v16 + 2 * e) * RWP + j] = (bf16_t)(vw[e] & 0xffffu); VT[(v16 + 2 * e + 1) * RWP + j] = (bf16_t)(vw[e] >> 16); } }
    if (j == 0) { *(f32x4*)(gDV + c8) = (f32x4){__expf(bl[0]), __expf(bl[1]), __expf(bl[2]), __expf(bl[3])}; *(f32x4*)(gDV + c8 + 4) = (f32x4){__expf(bl[4]), __expf(bl[5]), __expf(bl[6]), __expf(bl[7])}; }
    __syncthreads();
    {
        const f32x4 z4 = {0.f, 0.f, 0.f, 0.f};
#pragma unroll
        for (int tt = 0; tt < 4; ++tt) { const int mt = tt, nt = w;
            const f32x4 d = mm64(KS2T, VT, mt, nt, lane, z4);
            const int dv = nt * 16 + (lane & 15), k0 = mt * 16 + (lane >> 4) * 4;
            *(v2u*)(gKV + dv * 64 + k0) = (v2u){pk2(d.x, d.y), pk2(d.z, d.w)}; }
    }
    __syncthreads();
}
__device__ __forceinline__ void gla_sscan(const Args& a, Frame& F) {
    const WsMap m = ws_map(NTOK);
    const bf16_t* gKV = (const bf16_t*)(a.ws + m.glao); const float* gDV = (const float*)(a.ws + m.gladv); bf16_t* gS = (bf16_t*)(a.ws + m.glas);
    for (int it = F.vcu * NTHR + F.tid; it < 16 * 8192; it += F.G * NTHR) {
        const int bh = it >> 13, e = it & 8191, k = e & 63;
        float S = 0.f;
        bf16_t kn[16]; float dn[16];
#pragma unroll
        for (int u = 0; u < 16; ++u) { const size_t ci = (size_t)bh * 64 + u; kn[u] = gKV[ci * 8192 + e]; dn[u] = gDV[ci * 64 + k]; }
#pragma unroll 1
        for (int c0 = 0; c0 < 64; c0 += 16) {
            float kv[16], dv[16];
#pragma unroll
            for (int u = 0; u < 16; ++u) { kv[u] = bf2f(kn[u]); dv[u] = dn[u]; }
            if (c0 + 16 < 64) {
#pragma unroll
                for (int u = 0; u < 16; ++u) { const size_t ci = (size_t)bh * 64 + c0 + 16 + u; kn[u] = gKV[ci * 8192 + e]; dn[u] = gDV[ci * 64 + k]; } }
#pragma unroll
            for (int u = 0; u < 16; ++u) { const size_t ci = (size_t)bh * 64 + c0 + u; gS[ci * 8192 + e] = f2bf(S); S = S * dv[u] + kv[u]; }
        }
    }
}
__device__ __forceinline__ void gla_pb_chunk(const Args& a, Frame& F, int l, int ci) {
    const WsMap m = ws_map(NTOK);
    const int bh = ci >> 6, c = ci & 63, b = bh >> 2, h = bh & 3;
    const int lane = F.lane, w = F.wave, tid = F.tid;
    LAS bf16_t* QS = (LAS bf16_t*)F.lds; LAS bf16_t* KS = QS + RWT; LAS bf16_t* QG = KS + RWT; LAS bf16_t* PM = QG + RWT;
    LAS bf16_t* VT = PM + RWT; LAS bf16_t* ST = VT + 128 * RWP; LAS bf16_t* GG = ST + 128 * RWP;
    LAS float* TMP = (LAS float*)(GG + 64 * GP); LAS float* OSS = TMP + 512;
    const bf16_t* p16 = (const bf16_t*)(a.ws + m.p16); const bf16_t* ao = (const bf16_t*)(a.ws + m.auxo);
    const bf16_t* gS = (const bf16_t*)(a.ws + m.glas) + (size_t)ci * 8192; bf16_t* mix = (bf16_t*)(a.ws + m.mix16);
    const int j = tid >> 3, c8 = (tid & 7) * 8, v16 = (tid & 7) * 16;
    const size_t n = (size_t)b * TSEQ + c * 64 + j;
    float q8[8], k8[8], la[8];
    unpack8(ld8(p16 + n * PLD + C_GLA + h * 64 + c8), q8); unpack8(ld8(p16 + n * PLD + C_GLA + 256 + h * 64 + c8), k8); unpack8(ld8(ao + n * 1792 + 1536 + h * 64 + c8), la);
    const v4u v0 = ld8(p16 + n * PLD + C_GLA + 512 + h * 128 + v16), v1 = ld8(p16 + n * PLD + C_GLA + 512 + h * 128 + v16 + 8);
    const v4u g0 = ld8(p16 + n * PLD + C_GLA + 1024 + h * 128 + v16), g1 = ld8(p16 + n * PLD + C_GLA + 1024 + h * 128 + v16 + 8);
    const v4u s0 = ((const v4u*)gS)[tid], s1 = ((const v4u*)gS)[512 + tid];
#pragma unroll
    for (int k = 0; k < 8; ++k) la[k] = -softplus_f(-la[k]) * (1.0f / 16.0f);
    chunk_cumsum8(la, TMP, lane, w, c8);
    {
        float br[8], t0[8], t1[8], t2[8];
#pragma unroll
        for (int k = 0; k < 8; ++k) br[k] = 0.f;
#pragma unroll
        for (int ww = 0; ww < 4; ++ww) { const f32x4 y0 = *(const LAS f32x4*)(TMP + ww * 64 + c8), y1 = *(const LAS f32x4*)(TMP + ww * 64 + c8 + 4);
            br[0] += y0.x; br[1] += y0.y; br[2] += y0.z; br[3] += y0.w; br[4] += y1.x; br[5] += y1.y; br[6] += y1.z; br[7] += y1.w; }
#pragma unroll
        for (int k = 0; k < 8; ++k) { const float qq = q8[k] * 0.125f;
            t0[k] = qq * __expf(la[k] - br[k]); t1[k] = k8[k] * __expf(br[k] - la[k]); t2[k] = qq * __expf(la[k]); }
        *(LAS v4u*)(QS + j * RWP + c8) = pack8(t0); *(LAS v4u*)(KS + j * RWP + c8) = pack8(t1); *(LAS v4u*)(QG + j * RWP + c8) = pack8(t2);
        const unsigned vw[8] = {v0.x, v0.y, v0.z, v0.w, v1.x, v1.y, v1.z, v1.w};
#pragma unroll
        for (int e = 0; e < 8; ++e) { VT[(v16 + 2 * e) * RWP + j] = (bf16_t)(vw[e] & 0xffffu); VT[(v16 + 2 * e + 1) * RWP + j] = (bf16_t)(vw[e] >> 16); }
        *(LAS v4u*)(GG + j * GP + v16) = g0; *(LAS v4u*)(GG + j * GP + v16 + 8) = g1;
        { const int p0 = tid, p1 = 512 + tid;
          *(LAS v4u*)(ST + (p0 >> 3) * RWP + (p0 & 7) * 8) = s0; *(LAS v4u*)(ST + (p1 >> 3) * RWP + (p1 & 7) * 8) = s1; }
    }
    __syncthreads();
    {
        const f32x4 z4 = {0.f, 0.f, 0.f, 0.f};
#pragma unroll
        for (int tt = 0; tt < 2; ++tt) { const int t = w + 8 * tt, mtj = t >> 2, nti = t & 3;
            f32x4 s4 = mm64(KS, QS, mtj, nti, lane, z4);
            const int i = nti * 16 + (lane & 15), j0 = mtj * 16 + (lane >> 4) * 4;
#pragma unroll
            for (int e = 0; e < 4; ++e) if (j0 + e > i) s4[e] = 0.f;
            st_transposed(PM, mtj, nti, lane, s4); }
    }
    __syncthreads();
    {
        const int mt = w >> 1, ntb = (w & 1) * 4, r = lane & 15, i0 = mt * 16 + (lane >> 4) * 4;
        f32x4 o[4]; float ss[4] = {0.f, 0.f, 0.f, 0.f};
#pragma unroll
        for (int t = 0; t < 4; ++t) { o[t] = mm64(QG, ST, mt, ntb + t, lane, (f32x4){0.f, 0.f, 0.f, 0.f}); o[t] = mm64(PM, VT, mt, ntb + t, lane, o[t]);
            ss[0] += o[t].x * o[t].x; ss[1] += o[t].y * o[t].y; ss[2] += o[t].z * o[t].z; ss[3] += o[t].w * o[t].w; }
#pragma unroll
        for (int e = 0; e < 4; ++e) ss[e] = row16_sum(ss[e]);
        if (r == 0) {
#pragma unroll
            for (int e = 0; e < 4; ++e) OSS[(i0 + e) * 2 + (w & 1)] = ss[e]; }
        __syncthreads();
        float rs[4];
#pragma unroll
        for (int e = 0; e < 4; ++e) rs[e] = 1.0f / sqrtf((OSS[(i0 + e) * 2] + OSS[(i0 + e) * 2 + 1]) * (1.0f / 128.0f) + 1e-6f);
        const size_t nrow = (size_t)b * TSEQ + c * 64 + i0;
#pragma unroll
        for (int t = 0; t < 4; ++t) { const int dv = (ntb + t) * 16 + r; const float gn = a.in[I_GLA_NORM][l * 128 + dv];
            const float ov[4] = {o[t].x, o[t].y, o[t].z, o[t].w};
#pragma unroll
            for (int e = 0; e < 4; ++e) { const float g = bf2f(GG[(i0 + e) * GP + dv]);
                mix[(nrow + e) * DM + 512 + h * 128 + dv] = f2bf(ov[e] * rs[e] * gn * (g * sigm(g))); } }
    }
    __syncthreads();
}

__device__ __forceinline__ void lru_pass(const Args& a, Frame& F, int l, bool passB) {
    const WsMap m = ws_map(NTOK);
    const bf16_t* gt = (const bf16_t*)(a.ws + m.gates); const bf16_t* xc = (const bf16_t*)(a.ws + m.xc); const bf16_t* p16 = (const bf16_t*)(a.ws + m.p16);
    bf16_t* mix = (bf16_t*)(a.ws + m.mix16); float* lrs = (float*)(a.ws + m.lrs);
    for (int it = F.vcu * NTHR + F.tid; it < NBATCH * 64 * 512; it += F.G * NTHR) {
        const int ch = it & 511, bc = it >> 9, c = bc & 63;
        const float sp8 = 8.0f * softplus_f(-a.in[I_LRU_LAM][l * 512 + ch]);
        const size_t nb = (size_t)bc * 64;
        float hh = 0.f, ap = 1.f;
        if (passB) {
            f32x2 sn[8];
#pragma unroll
            for (int u = 0; u < 8; ++u) sn[u] = (u < c) ? *(const f32x2*)(lrs + ((size_t)(bc - c + u) * 512 + ch) * 2) : (f32x2){1.f, 0.f};
            for (int s0 = 0; s0 < c; s0 += 8) { f32x2 su[8];
#pragma unroll
                for (int u = 0; u < 8; ++u) su[u] = sn[u];
                if (s0 + 8 < c) {
#pragma unroll
                    for (int u = 0; u < 8; ++u) sn[u] = (s0 + 8 + u < c) ? *(const f32x2*)(lrs + ((size_t)(bc - c + s0 + 8 + u) * 512 + ch) * 2) : (f32x2){1.f, 0.f}; }
#pragma unroll
                for (int u = 0; u < 8; ++u) hh = su[u].x * hh + su[u].y; } }
        bf16_t rn[8], in_[8], xn_[8], yn[8];
#pragma unroll
        for (int u = 0; u < 8; ++u) { const size_t n = nb + u; rn[u] = gt[n * 1024 + ch]; in_[u] = gt[n * 1024 + 512 + ch]; xn_[u] = xc[n * 512 + ch];
            yn[u] = passB ? p16[n * PLD + C_LRU + 512 + ch] : (bf16_t)0; }
#pragma unroll 1
        for (int t0 = 0; t0 < 64; t0 += 8) {
            bf16_t rr[8], ii[8], xx[8], yy[8];
#pragma unroll
            for (int u = 0; u < 8; ++u) { rr[u] = rn[u]; ii[u] = in_[u]; xx[u] = xn_[u]; yy[u] = yn[u]; }
            if (t0 + 8 < 64) {
#pragma unroll
                for (int u = 0; u < 8; ++u) { const size_t n = nb + t0 + 8 + u; rn[u] = gt[n * 1024 + ch]; in_[u] = gt[n * 1024 + 512 + ch]; xn_[u] = xc[n * 512 + ch];
                    yn[u] = passB ? p16[n * PLD + C_LRU + 512 + ch] : (bf16_t)0; } }
#pragma unroll
            for (int u = 0; u < 8; ++u) { const size_t n = nb + t0 + u;
                const float la = -sp8 * sigm(bf2f(rr[u]));
                const float av = __expf(la);
                const float uu = bf2f(xx[u]) * sigm(bf2f(ii[u])) * sqrtf(fmaxf(1.0f - av * av, 0.0f));
                hh = av * hh + uu; ap *= av;
                if (passB) mix[n * DM + 1024 + ch] = f2bf(hh * gelu_fast(bf2f(yy[u]))); }
        }
        if (!passB) *(f32x2*)(lrs + ((size_t)bc * 512 + ch) * 2) = (f32x2){ap, hh};
    }
}

__device__ __forceinline__ void scan_phase(const Args& a, Frame& F, int l) {
    lru_pass(a, F, l, false);
    const int task = blockIdx.x;
    for (int q = 0; q < 8; ++q) rwkv_pa_chunk(a, F, l, task * 8 + q);
    for (int q = 0; q < 4; ++q) gdn_pa_chunk(a, F, task * 4 + q);
    for (int q = 0; q < 4; ++q) gla_pa_chunk(a, F, task * 4 + q);
    if (l == 0) tables_range(a, F, (size_t)2 * NEXP * DM / 32, (size_t)4 * NEXP * DM / 32, F.vcu, F.G);
}

__device__ __forceinline__ void post_phase(const Args& a, Frame& F, int l, const XcdBarrier& bar) {
    const WsMap m = ws_map(NTOK);
    if (blockIdx.x < 128) rwkv_ps_task(a, F, blockIdx.x); else gdn_ps_task(a, F, blockIdx.x - 128);
    gla_sscan(a, F);
    lru_pass(a, F, l, true);
    const bf16_t* p16 = (const bf16_t*)(a.ws + m.p16); const bf16_t* glao = (const bf16_t*)(a.ws + m.glao); const bf16_t* gdno = (const bf16_t*)(a.ws + m.gdno);
    const bf16_t* rwy = (const bf16_t*)(a.ws + m.rwy); const bf16_t* rwbv = (const bf16_t*)(a.ws + m.rwbv); const bf16_t* ao = (const bf16_t*)(a.ws + m.auxo);
    bf16_t* mix = (bf16_t*)(a.ws + m.mix16);
    const int lane = F.lane, col = lane * 8, hc = col & 127;
    float gg[8], gd[8], lw[8], lb[8];
    { const f32x4 x0 = *(const f32x4*)(a.in[I_GLA_NORM] + l * 128 + hc), x1 = *(const f32x4*)(a.in[I_GLA_NORM] + l * 128 + hc + 4);
      gg[0] = x0.x; gg[1] = x0.y; gg[2] = x0.z; gg[3] = x0.w; gg[4] = x1.x; gg[5] = x1.y; gg[6] = x1.z; gg[7] = x1.w;
      const f32x4 y0 = *(const f32x4*)(a.in[I_GDN_NORM] + l * 128 + hc), y1 = *(const f32x4*)(a.in[I_GDN_NORM] + l * 128 + hc + 4);
      gd[0] = y0.x; gd[1] = y0.y; gd[2] = y0.z; gd[3] = y0.w; gd[4] = y1.x; gd[5] = y1.y; gd[6] = y1.z; gd[7] = y1.w;
      const f32x4 w0 = *(const f32x4*)(a.in[I_RW_LN_W] + l * 512 + col), w1 = *(const f32x4*)(a.in[I_RW_LN_W] + l * 512 + col + 4);
      lw[0] = w0.x; lw[1] = w0.y; lw[2] = w0.z; lw[3] = w0.w; lw[4] = w1.x; lw[5] = w1.y; lw[6] = w1.z; lw[7] = w1.w;
      const f32x4 b0 = *(const f32x4*)(a.in[I_RW_LN_B] + l * 512 + col), b1 = *(const f32x4*)(a.in[I_RW_LN_B] + l * 512 + col + 4);
      lb[0] = b0.x; lb[1] = b0.y; lb[2] = b0.z; lb[3] = b0.w; lb[4] = b1.x; lb[5] = b1.y; lb[6] = b1.z; lb[7] = b1.w; }
    for (int pass = 1; pass < 2; ++pass) {
    if (pass == 1) xcd_barrier(bar);
    for (int q = 0; q < 4; ++q) gla_pb_chunk(a, F, l, blockIdx.x * 4 + q);
    v4u nx[5];
    if (F.gw < NTOK) { const size_t n = (size_t)F.gw; nx[0] = ld8(rwy + n * 512 + col); nx[1] = ld8(rwbv + n * 512 + col); nx[2] = ld8(ao + n * 1792 + 1024 + col);
        nx[3] = ld8(gdno + n * 512 + col); nx[4] = ld8(p16 + n * PLD + C_GDN + 1536 + col); }
    for (int n = F.gw; n < NTOK; n += F.ngw) {
        v4u cu[5];
#pragma unroll
        for (int k = 0; k < 5; ++k) cu[k] = nx[k];
        if (n + F.ngw < NTOK) { const size_t n1 = (size_t)(n + F.ngw); nx[0] = ld8(rwy + n1 * 512 + col); nx[1] = ld8(rwbv + n1 * 512 + col); nx[2] = ld8(ao + n1 * 1792 + 1024 + col);
            nx[3] = ld8(gdno + n1 * 512 + col); nx[4] = ld8(p16 + n1 * PLD + C_GDN + 1536 + col); }
        if (pass == 1) {
            float y[8], bv[8], g[8];
            unpack8(cu[0], y); unpack8(cu[1], bv); unpack8(cu[2], g);
            float s = 0.f;
#pragma unroll
            for (int k = 0; k < 8; ++k) s += y[k];
            const float mean = red8(s) * (1.0f / 64.0f);
            float s2 = 0.f;
#pragma unroll
            for (int k = 0; k < 8; ++k) { y[k] -= mean; s2 += y[k] * y[k]; }
            const float rs = 1.0f / sqrtf(red8(s2) * (1.0f / 64.0f) + 64e-5f);
#pragma unroll
            for (int k = 0; k < 8; ++k) y[k] = (y[k] * rs * lw[k] + lb[k] + bv[k]) * g[k];
            *(v4u*)(mix + (size_t)n * DM + col) = pack8(y);
        }
        if (pass == 1)
#pragma unroll
        for (int which = 1; which < 2; ++which) {
            float o[8], g[8];
            unpack8(cu[3], o);
            unpack8(cu[4], g);
            float ss = 0.f;
#pragma unroll
            for (int k = 0; k < 8; ++k) ss += o[k] * o[k];
            ss = row16_sum(ss);
            const float rs = 1.0f / sqrtf(ss * (1.0f / 128.0f) + 1e-6f);
#pragma unroll
            for (int k = 0; k < 8; ++k) o[k] = o[k] * rs * (which ? gd[k] : gg[k]) * (g[k] * sigm(g[k]));
            *(v4u*)(mix + (size_t)n * DM + (which ? 1536 : 512) + col) = pack8(o);
        }
    }
    }
}

__device__ __forceinline__ void norm2_phase(const Args& a, Frame& F, int l) {
    const WsMap m = ws_map(NTOK);
    const float* gain = a.in[I_NORM_FFN] + l * DM;
    f32x4 gv[8];
#pragma unroll
    for (int j = 0; j < 8; ++j) gv[j] = ((const f32x4*)gain)[64 * j + F.lane];
    for (int n = F.gw; n < NTOK; n += F.ngw) {
        const v2u* xr = (const v2u*)((const bf16_t*)a.out + (size_t)n * DM) + F.lane;
        f32x4 v[8]; float s = 0.f;
#pragma unroll
        for (int j = 0; j < 8; ++j) { const v2u w = xr[64 * j]; v[j] = (f32x4){bflo(w.x), bfhi(w.x), bflo(w.y), bfhi(w.y)}; s += (v[j].x * v[j].x + v[j].y * v[j].y) + (v[j].z * v[j].z + v[j].w * v[j].w); }
        const float rstd = 1.0f / sqrtf(wave_sum_u(s) * (1.0f / DM) + 1e-6f);
        v2u* o8 = (v2u*)((bf16_t*)(a.ws + m.hb) + (size_t)n * DM) + F.lane;
        unsigned char* hq = a.ws + m.mix16 + (size_t)n * 2304;
#pragma unroll
        for (int j = 0; j < 8; ++j) {
            const float y0 = v[j].x * rstd * gv[j].x, y1 = v[j].y * rstd * gv[j].y, y2 = v[j].z * rstd * gv[j].z, y3 = v[j].w * rstd * gv[j].w;
            v2u w; w.x = pk2(y0, y1); w.y = pk2(y2, y3); o8[64 * j] = w;
            float am = __builtin_fmaxf(__builtin_fmaxf(__builtin_fabsf(y0), __builtin_fabsf(y1)), __builtin_fmaxf(__builtin_fabsf(y2), __builtin_fabsf(y3)));
            am = __builtin_fmaxf(am, dpp_f<0xB1>(am)); am = __builtin_fmaxf(am, dpp_f<0x4E>(am)); am = __builtin_fmaxf(am, dpp_f<0x141>(am)); am = __builtin_fmaxf(am, 1e-20f);
            const float xinv = 119.0f / am;
            const int q0 = (int)__builtin_rintf(y0 * xinv), q1 = (int)__builtin_rintf(y1 * xinv), q2 = (int)__builtin_rintf(y2 * xinv), q3 = (int)__builtin_rintf(y3 * xinv);
            const int h0 = (q0 + 8) >> 4, h1 = (q1 + 8) >> 4, h2 = (q2 + 8) >> 4, h3 = (q3 + 8) >> 4;
            const unsigned ph = ((unsigned)h0 & 15u) | (((unsigned)h1 & 15u) << 4) | (((unsigned)h2 & 15u) << 8) | (((unsigned)h3 & 15u) << 12);
            const unsigned pl = ((unsigned)(q0 - 16 * h0) & 15u) | (((unsigned)(q1 - 16 * h1) & 15u) << 4) | (((unsigned)(q2 - 16 * h2) & 15u) << 8) | (((unsigned)(q3 - 16 * h3) & 15u) << 12);
            *(unsigned short*)(hq + 128 * j + 2 * F.lane) = (unsigned short)ph;
            *(unsigned short*)(hq + 1024 + 128 * j + 2 * F.lane) = (unsigned short)pl;
            if ((F.lane & 7) == 0) *(float*)(hq + 2048 + 32 * j + 4 * (F.lane >> 3)) = am * (1.0f / 119.0f);
        }
    }
}

#define TK_CE(A, B) do { const float mx_ = fmaxf(A, B), mn_ = fminf(A, B); A = mx_; B = mn_; } while (0)
__device__ __forceinline__ void tk_sort16_desc(float (&x)[16]) {
#pragma unroll
    for (int k = 2; k <= 16; k <<= 1)
#pragma unroll
        for (int j = k >> 1; j > 0; j >>= 1)
#pragma unroll
            for (int i = 0; i < 16; ++i) { const int p = i ^ j;
                if (p > i) { if ((i & k) == 0) TK_CE(x[i], x[p]); else TK_CE(x[p], x[i]); } }
}
__device__ __forceinline__ void tk_merge16(float (&run)[16], const float (&g)[16]) {
#pragma unroll
    for (int i = 0; i < 16; ++i) run[i] = fmaxf(run[i], g[15 - i]);
#pragma unroll
    for (int j = 8; j > 0; j >>= 1)
#pragma unroll
        for (int i = 0; i < 16; ++i) { const int p = i ^ j; if (p > i) TK_CE(run[i], run[p]); }
}
__device__ __forceinline__ float tk_tag(float v, unsigned tag, unsigned mask) { return __builtin_bit_cast(float, (__builtin_bit_cast(unsigned, v) & ~mask) | tag); }
__device__ __forceinline__ void topk_phase(const Args& a, Frame& F, int l) {
    const WsMap m = ws_map(NTOK);
    const f32x2* tsuv = (const f32x2*)(a.ws + m.tsc) + (size_t)l * NEXP; float* sug = (float*)(a.ws + m.act);
    const float* sc = (const float*)(a.ws + m.sc);
    int* idx = (int*)(a.ws + m.idx); float* gate = (float*)(a.ws + m.gate);
    LAS float* LS = (LAS float*)F.lds;
    const int t = F.tid;
    for (int wv = F.gw; wv < (NTOK / 64) * 8; wv += F.ngw) {
        const int h = wv & 7, n = (wv >> 3) * 64 + F.lane;
        const float* sp = sc + (size_t)(h * 256) * NTOK + n;
        float s0[16], s1[16];
#pragma unroll
        for (int half = 0; half < 2; ++half) {
            float run[16];
#pragma unroll
            for (int j = 0; j < 16; ++j) run[j] = -3.0e38f;
            float xn[16];
#pragma unroll
            for (int k = 0; k < 16; ++k) xn[k] = sp[(size_t)(half * 128 + k) * NTOK];
#pragma unroll 1
            for (int g = 0; g < 8; ++g) {
                float x[16];
#pragma unroll
                for (int k = 0; k < 16; ++k) x[k] = tk_tag(xn[k], (unsigned)(g * 16 + k), 127u);
                if (g + 1 < 8) {
#pragma unroll
                    for (int k = 0; k < 16; ++k) xn[k] = sp[(size_t)(half * 128 + (g + 1) * 16 + k) * NTOK]; }
                tk_sort16_desc(x);
                tk_merge16(run, x);
            }
#pragma unroll
            for (int j = 0; j < 16; ++j) { if (half) s1[j] = run[j]; else s0[j] = run[j]; LS[(half * 16 + j) * 512 + t] = run[j]; }
        }
        float run[16];
#pragma unroll
        for (int j = 0; j < 16; ++j) run[j] = -3.0e38f;
        {
            float x[16]; int cnt = 0;
#pragma unroll
            for (int p = 0; p < 16; ++p)
#pragma unroll
                for (int q = 0; q < 16; ++q) if ((p + 1) * (q + 1) <= 16) {
                    x[cnt & 15] = tk_tag(s0[p] + s1[q], (unsigned)(p * 16 + q), 255u); ++cnt;
                    if ((cnt & 15) == 0) { tk_sort16_desc(x); tk_merge16(run, x); }
                }
#pragma unroll
            for (int k = 0; k < 16; ++k) if (k >= (cnt & 15)) x[k] = -3.0e38f;
            tk_sort16_desc(x); tk_merge16(run, x);
        }
        const float mx = run[0]; float den = 0.f; float e[16]; int ti[16];
#pragma unroll
        for (int j = 0; j < 16; ++j) {
            const unsigned tg = __builtin_bit_cast(unsigned, run[j]) & 255u; const int p = (int)(tg >> 4), q = (int)(tg & 15u);
            const unsigned k0 = __builtin_bit_cast(unsigned, LS[(0 * 16 + p) * 512 + t]) & 127u, k1 = __builtin_bit_cast(unsigned, LS[(1 * 16 + q) * 512 + t]) & 127u;
            ti[j] = (int)(k0 * 128u + k1);
            e[j] = __expf(run[j] - mx); den += e[j];
        }
        const float inv = 1.0f / den;
        const size_t it = (size_t)n * 8 + h;
        float su[16];
#pragma unroll
        for (int j = 0; j < 16; ++j) { const f32x2 s2 = tsuv[ti[j]]; su[j] = s2.x; e[j] *= s2.y; }
        f32x4* go = (f32x4*)(gate + it * 16); v4u* io = (v4u*)(idx + it * 16); f32x4* so = (f32x4*)(sug + it * 16);
#pragma unroll
        for (int j = 0; j < 4; ++j) { go[j] = (f32x4){e[4 * j] * inv, e[4 * j + 1] * inv, e[4 * j + 2] * inv, e[4 * j + 3] * inv};
            so[j] = (f32x4){su[4 * j], su[4 * j + 1], su[4 * j + 2], su[4 * j + 3]};
            io[j] = (v4u){(unsigned)ti[4 * j], (unsigned)ti[4 * j + 1], (unsigned)ti[4 * j + 2], (unsigned)ti[4 * j + 3]}; }
    }
}

typedef float f32x2_t __attribute__((ext_vector_type(2)));
typedef int v4i __attribute__((ext_vector_type(4)));
struct PeerSplit { int ng, g, nwg, w0; };
__device__ __forceinline__ PeerSplit peer_split(const Frame& F) {
    PeerSplit p; p.ng = F.G < 8 ? F.G : 8; p.g = (int)blockIdx.x % p.ng; p.nwg = (F.G - p.g + p.ng - 1) / p.ng; p.w0 = ((int)blockIdx.x / p.ng) * NWAVES + F.wave; return p;
}
__device__ __forceinline__ float xl32(float v, int lane) { return __builtin_bit_cast(float, __builtin_amdgcn_ds_bpermute((lane ^ 32) << 2, __builtin_bit_cast(int, v))); }
constexpr int PU_CH = 12, PV_CH = 4;
constexpr int PU_E = 0, PU_XH = PU_CH * 512, PU_XL = PU_XH + PU_CH * 128, PU_SC = PU_XL + PU_CH * 128, PU_O = PU_SC + PU_CH * 32, PU_WB = PU_O + PU_CH * 512;
constexpr int PV_E = 0, PV_C = PV_CH * 512, PV_X = PV_C + PV_CH * 128, PV_SQ = PV_X + PV_CH * 1024, PV_WB = PV_SQ + 64;
constexpr int PV_TILE = 128 * 64, PV_WS = PV_WB + PV_TILE;
static_assert(8 * PU_WB <= 131072 && 8 * PV_WS <= 131072 && PU_WB % 64 == 0 && PV_WS % 64 == 0 && PV_WB % 16 == 0, "PEER staging must fit the LDS ring area");
__device__ __forceinline__ void fmac(float& acc, float x, float y) { asm("v_fmac_f32 %0, %1, %2" : "+v"(acc) : "v"(x), "v"(y)); }
template <int B> __device__ __forceinline__ float code_f(unsigned w) { return __builtin_bit_cast(float, __builtin_amdgcn_perm(w, 0x3Fu, 0x00040C0Cu + ((unsigned)B << 16))); }
__device__ __forceinline__ float swz4(float v) { return __builtin_bit_cast(float, __builtin_amdgcn_ds_swizzle(__builtin_bit_cast(int, v), 0x101F)); }
__device__ __forceinline__ void lds_ld16(const LAS unsigned char* p, int (&e)[16]) {
#pragma unroll
    for (int k = 0; k < 4; ++k) { const v4u t = ((const LAS v4u*)p)[k]; e[4 * k] = (int)t.x; e[4 * k + 1] = (int)t.y; e[4 * k + 2] = (int)t.z; e[4 * k + 3] = (int)t.w; }
}
__device__ __forceinline__ void peer_u_phase(const Args& a, Frame& F, int l) {
    const WsMap m = ws_map(NTOK);
    const PeerSplit ps = peer_split(F);
    const int lane = F.lane, r = lane >> 3, q = lane & 7;
    const int* idx = (const int*)(a.ws + m.idx);
    float* dpart = (float*)(a.ws + m.dpart);
    const bool q0b = (lane & 1) != 0, q1b = (lane & 2) != 0, q2b = (lane & 4) != 0;
    const int qrow = (q0b ? 8 : 0) + (q1b ? 4 : 0) + (q2b ? 2 : 0);
    const int stride = ps.nwg * NWAVES;
    if (ps.w0 >= NTOK) return;
    const int nt = (NTOK - 1 - ps.w0) / stride + 1;
    LAS unsigned char* wb = F.lds + F.wave * PU_WB;
    for (int s = ps.g; s < 8; s += ps.ng) {
        const unsigned char* TU = (const unsigned char*)(a.ws + m.tabu) + ((size_t)(l * 2) * 8 + s) * NEXP * TSL; const unsigned q16 = (unsigned)q * 16u;
        const unsigned char* hqs = a.ws + m.mix16 + 128 * s;
        v4u se[PU_CH / 2], sxh[2], sxl[2]; float ssc[2];
        auto stage_load = [&](int tb) {
            const int cnt = nt - tb < PU_CH ? nt - tb : PU_CH;
#pragma unroll
            for (int k = 0; k < PU_CH / 2; ++k) { const int j = 2 * k + (lane >> 5);
                se[k] = *(const v4u*)(idx + (size_t)(ps.w0 + (tb + (j < cnt ? j : cnt - 1)) * stride) * 128 + (lane & 31) * 4); }
#pragma unroll
            for (int k = 0; k < 2; ++k) { const int j = 8 * k + r;
                const unsigned char* hn = hqs + (size_t)(ps.w0 + (tb + (j < cnt ? j : cnt - 1)) * stride) * 2304;
                sxh[k] = *(const v4u*)(hn + 16 * q); sxl[k] = *(const v4u*)(hn + 1024 + 16 * q); ssc[k] = *(const float*)(hn + 2048 - 96 * s + 4 * q); }
        };
        stage_load(0);
#pragma unroll 1
        for (int tb = 0; tb < nt; tb += PU_CH) {
            const int cnt = nt - tb < PU_CH ? nt - tb : PU_CH;
#pragma unroll
            for (int k = 0; k < PU_CH / 2; ++k) *(LAS v4u*)(wb + PU_E + (2 * k + (lane >> 5)) * 512 + (lane & 31) * 16) = se[k];
#pragma unroll
            for (int k = 0; k < 2; ++k) if (8 * k + r < PU_CH) { const int j = 8 * k + r;
                *(LAS v4u*)(wb + PU_XH + j * 128 + q * 16) = sxh[k]; *(LAS v4u*)(wb + PU_XL + j * 128 + q * 16) = sxl[k]; *(LAS float*)(wb + PU_SC + j * 32 + q * 4) = ssc[k]; }
            int ec[16]; v4u row[8];
            lds_ld16(wb + PU_E + r * 64, ec);
#pragma unroll
            for (int i = 0; i < 8; ++i) row[i] = *(const v4u*)(TU + (((unsigned)ec[i] << 7) | q16));
#pragma unroll 1
            for (int j = 0; j < cnt; ++j) {
                int en[16];
                lds_ld16(wb + PU_E + (j + 1 < cnt ? j + 1 : j) * 512 + r * 64, en);
                const v4u xh = *(const LAS v4u*)(wb + PU_XH + j * 128 + q * 16), xl = *(const LAS v4u*)(wb + PU_XL + j * 128 + q * 16);
                const float xscale = *(const LAS float*)(wb + PU_SC + j * 32 + q * 4);
                int sh = 0, sl = 0;
#pragma unroll
                for (int d = 0; d < 4; ++d) { sh = __builtin_amdgcn_sdot8((int)xh[d], 0x11111111, sh, false); sl = __builtin_amdgcn_sdot8((int)xl[d], 0x11111111, sl, false); }
                const float xoff = 0.5f * (float)(16 * sh + sl);
                float tp[16];
#pragma unroll
                for (int hf = 0; hf < 2; ++hf)
#pragma unroll
                for (int i = 0; i < 8; ++i) {
                    int ia = 0, ib = 0;
#pragma unroll
                    for (int d = 0; d < 4; ++d) { ia = __builtin_amdgcn_sdot8((int)row[i][d], (int)xh[d], ia, false); ib = __builtin_amdgcn_sdot8((int)row[i][d], (int)xl[d], ib, false); }
                    row[i] = *(const v4u*)(TU + (((unsigned)(hf ? en[i] : ec[8 + i]) << 7) | q16));
                    __builtin_amdgcn_sched_barrier(0);
                    tp[8 * hf + i] = ((float)(16 * ia + ib) + xoff) * xscale;
                }
                float ta[8], tb2[4];
#pragma unroll
                for (int p = 0; p < 8; ++p) { const float kk = q0b ? tp[p + 8] : tp[p], ss = q0b ? tp[p] : tp[p + 8]; ta[p] = kk + dpp_f<0xB1>(ss); }
#pragma unroll
                for (int p = 0; p < 4; ++p) { const float kk = q1b ? ta[p + 4] : ta[p], ss = q1b ? ta[p] : ta[p + 4]; tb2[p] = kk + dpp_f<0x4E>(ss); }
                const float k0 = (q2b ? tb2[2] : tb2[0]) + swz4(q2b ? tb2[0] : tb2[2]), k1 = (q2b ? tb2[3] : tb2[1]) + swz4(q2b ? tb2[1] : tb2[3]);
                ((LAS f32x2_t*)(wb + PU_O))[j * 64 + lane] = (f32x2_t){k0, k1};
#pragma unroll
                for (int i = 0; i < 16; ++i) ec[i] = en[i];
            }
            if (tb + PU_CH < nt) stage_load(tb + PU_CH);
#pragma unroll 1
            for (int j = 0; j < cnt; ++j) { const f32x2_t o2 = ((LAS f32x2_t*)(wb + PU_O))[j * 64 + lane]; *(unsigned*)((bf16_t*)dpart + ((size_t)s * NTOK + (ps.w0 + (tb + j) * stride)) * 128 + 16 * r + qrow) = pk2(o2.x, o2.y); }
            __builtin_amdgcn_s_waitcnt(0);
        }
    }
}
typedef _Float16 h2_t __attribute__((ext_vector_type(2)));
__device__ __forceinline__ float coef_pack(float c) { const _Float16 h = (_Float16)(c * 256.0f); return __builtin_bit_cast(float, (h2_t){h, h}); }
__device__ __forceinline__ void peer_c_phase(const Args& a, Frame& F) {
    const WsMap m = ws_map(NTOK);
    float* gate = (float*)(a.ws + m.gate); const float* sug = (const float*)(a.ws + m.act); const float* dpart = (const float*)(a.ws + m.dpart);
    for (int n = F.gw; n < NTOK; n += 2 * F.ngw) {
        unsigned dpr[2][8]; f32x2_t gt[2], su[2];
#pragma unroll
        for (int u = 0; u < 2; ++u) { const int nn = n + u * F.ngw; if (nn < NTOK) { const size_t j0 = (size_t)nn * 128 + 2 * F.lane;
#pragma unroll
            for (int sp = 0; sp < 8; ++sp) dpr[u][sp] = *(const unsigned*)((const bf16_t*)dpart + (size_t)sp * NTOK * 128 + j0);
            gt[u] = *(const f32x2_t*)(gate + j0); su[u] = *(const f32x2_t*)(sug + j0); } }
#pragma unroll
        for (int u = 0; u < 2; ++u) { const int nn = n + u * F.ngw; if (nn < NTOK) { const size_t j0 = (size_t)nn * 128 + 2 * F.lane;
            f32x2_t dp[8];
#pragma unroll
            for (int sp = 0; sp < 8; ++sp) dp[sp] = (f32x2_t){bflo(dpr[u][sp]), bfhi(dpr[u][sp])};
            const f32x2_t d = ((dp[0] + dp[1]) + (dp[2] + dp[3])) + ((dp[4] + dp[5]) + (dp[6] + dp[7]));
            *(f32x2_t*)(gate + j0) = (f32x2_t){gelu_fast(d.x * su[u].x) * gt[u].x, gelu_fast(d.y * su[u].y) * gt[u].y}; } }
    }
}
typedef int v8i_t __attribute__((ext_vector_type(8)));
typedef int v2i_t __attribute__((ext_vector_type(2)));
__device__ __forceinline__ void peer_v_phase(const Args& a, Frame& F, int l) {
    const WsMap m = ws_map(NTOK);
    const PeerSplit ps = peer_split(F);
    const int lane = F.lane, r = lane >> 3, q = lane & 7;
    const int* idx = (const int*)(a.ws + m.idx); const float* coef = (const float*)(a.ws + m.gate);
    float* ssq = (float*)(a.ws + m.ssq);
    const int stride = ps.nwg * NWAVES;
    if (ps.w0 >= NTOK) return;
    const int nt = (NTOK - 1 - ps.w0) / stride + 1;
    LAS unsigned char* wb = F.lds + F.wave * PV_WS;
    LAS unsigned char* T = wb + PV_WB;
    const int g = lane >> 4, p = lane & 15;
    const LAS unsigned char* trb = T + (32 * g + p) * 64;
    const int sw0 = (p >> 2) ^ (4 * (g & 1)), sw1 = (4 + (p >> 2)) ^ (4 * (g & 1));
    const LAS unsigned char* trb1 = T + (32 * g + 16 + (p ^ 1)) * 64;
    constexpr int NS = (PV_CH + 1) / 2;
    for (int s = ps.g; s < 8; s += ps.ng) {
        const unsigned char* TV = (const unsigned char*)(a.ws + m.tabu) + ((size_t)(l * 2 + 1) * 8 + s) * NEXP * TSL; const unsigned q16 = (unsigned)q * 16u;
        v4u se[NS], sc[NS]; v2u sx[PV_CH];
        auto stage_load = [&](int tb) {
            const int cnt = nt - tb < PV_CH ? nt - tb : PV_CH;
#pragma unroll
            for (int k = 0; k < NS; ++k) { const int j = 2 * k + (lane >> 5); const size_t n = (size_t)(ps.w0 + (tb + (j < cnt ? j : cnt - 1)) * stride);
                se[k] = *(const v4u*)(idx + n * 128 + (lane & 31) * 4); sc[k] = *(const v4u*)(coef + n * 128 + (lane & 31) * 4); }
#pragma unroll
            for (int j = 0; j < PV_CH; ++j) sx[j] = *(const v2u*)((const bf16_t*)a.out + (size_t)(ps.w0 + (tb + (j < cnt ? j : cnt - 1)) * stride) * DM + 256 * s + lane * 4);
        };
        stage_load(0);
#pragma unroll 1
        for (int tb = 0; tb < nt; tb += PV_CH) {
            const int cnt = nt - tb < PV_CH ? nt - tb : PV_CH;
#pragma unroll
            for (int k = 0; k < NS; ++k) { const int j = 2 * k + (lane >> 5);
                if (j < PV_CH) { *(LAS v4u*)(wb + PV_E + j * 512 + (lane & 31) * 16) = se[k];
                    const f32x4 c4 = __builtin_bit_cast(f32x4, sc[k]); int w8 = 0;
                    w8 = __builtin_amdgcn_cvt_pk_fp8_f32(c4.x * 128.0f, c4.y * 128.0f, w8, false); w8 = __builtin_amdgcn_cvt_pk_fp8_f32(c4.z * 128.0f, c4.w * 128.0f, w8, true);
                    *(LAS int*)(wb + PV_C + j * 128 + (lane & 31) * 4) = w8; } }
#pragma unroll
            for (int j = 0; j < PV_CH; ++j) *(LAS f32x4*)(wb + PV_X + j * 1024 + lane * 16) = (f32x4){bflo(sx[j].x), bfhi(sx[j].x), bflo(sx[j].y), bfhi(sx[j].y)};
            v4u row[16];
            { int ec[16]; lds_ld16(wb + PV_E + r * 64, ec);
#pragma unroll
              for (int i = 0; i < 16; ++i) row[i] = *(const v4u*)(TV + (((unsigned)ec[i] << 7) | q16)); }
#pragma unroll 1
            for (int j = 0; j < cnt; ++j) {
                int en[16];
                lds_ld16(wb + PV_E + (j + 1 < cnt ? j + 1 : j) * 512 + r * 64, en);
                v8i_t afr;
                { const LAS unsigned char* c8 = wb + PV_C + j * 128 + 16 * g; const v4u lo = *(const LAS v4u*)c8, hi = *(const LAS v4u*)(c8 + 64);
                  const bool on = p == 0;
                  afr[0] = on ? (int)lo.x : 0; afr[1] = on ? (int)lo.y : 0; afr[2] = on ? (int)lo.z : 0; afr[3] = on ? (int)lo.w : 0;
                  afr[4] = on ? (int)hi.x : 0; afr[5] = on ? (int)hi.y : 0; afr[6] = on ? (int)hi.z : 0; afr[7] = on ? (int)hi.w : 0; }
                float tot = 0.f;
#pragma unroll
                for (int hc = 0; hc < 2; ++hc) {
#pragma unroll
                    for (int i = 0; i < 16; ++i) { const int sw = (4 * (r & 1) + (i >> 2)) ^ (2 * (r & 2));
                        *(LAS v2u*)(T + (16 * r + (i ^ (r & 1))) * 64 + ((q ^ sw) << 3)) = hc ? (v2u){row[i].z, row[i].w} : (v2u){row[i].x, row[i].y}; }
                    if (hc == 1) {
#pragma unroll
                        for (int i = 0; i < 16; ++i) row[i] = *(const v4u*)(TV + (((unsigned)en[i] << 7) | q16)); }
                    __builtin_amdgcn_sched_barrier(0);
                    f32x4 acc[8];
#pragma unroll
                    for (int qq = 0; qq < 8; ++qq) {
                        const v2i_t b0 = __builtin_amdgcn_ds_read_tr4_b64_v2i32((LAS v2i_t*)(trb + ((qq ^ sw0) << 3))), b1 = __builtin_amdgcn_ds_read_tr4_b64_v2i32((LAS v2i_t*)(trb1 + ((qq ^ sw1) << 3)));
                        const v8i_t bfr = {b0.x, b0.y, b1.x, b1.y, 0, 0, 0, 0};
                        acc[qq] = __builtin_amdgcn_mfma_scale_f32_16x16x128_f8f6f4(afr, bfr, (f32x4){0.f, 0.f, 0.f, 0.f}, 0, 4, 0, 127, 0, 127); }
                    __builtin_amdgcn_sched_barrier(0);
                    if (lane < 16) { LAS float* xs = (LAS float*)(wb + PV_X + j * 1024) + 16 * hc + lane;
#pragma unroll
                        for (int qq = 0; qq < 8; ++qq) { LAS float* xp = xs + 32 * qq; const float o = *xp + acc[qq].x * (1.0f / 128.0f); *xp = o; tot += o * o; } }
                }
                tot = wave_sum_u(tot);
                if (lane == 0) ((LAS float*)(wb + PV_SQ))[j] = tot;
            }
            if (tb + PV_CH < nt) stage_load(tb + PV_CH);
#pragma unroll 1
            for (int j = 0; j < cnt; ++j) { const int n = ps.w0 + (tb + j) * stride; const size_t off = (size_t)n * DM + 256 * s + lane * 4;
                const f32x4 o = *(const LAS f32x4*)(wb + PV_X + j * 1024 + lane * 16);
                { v2u w; w.x = pk2(o.x, o.y); w.y = pk2(o.z, o.w); *(v2u*)((bf16_t*)(a.ws + m.xn) + off) = w; }
                if (lane == 0) ssq[(size_t)n * 8 + s] = ((const LAS float*)(wb + PV_SQ))[j]; }
            __builtin_amdgcn_s_waitcnt(0);
        }
    }
}
__device__ __forceinline__ void fnorm_phase(const Args& a, Frame& F) {
    const WsMap m = ws_map(NTOK);
    const float* ssq = (const float*)(a.ws + m.ssq);
    const int lane = F.lane;
    f32x4 g4[8];
#pragma unroll
    for (int k = 0; k < 8; ++k) g4[k] = *(const f32x4*)(a.in[I_NORM_FINAL] + 256 * k + 4 * lane);
    for (int n = F.gw; n < NTOK; n += 2 * F.ngw) {
        f32x4 v[2][8]; float rstd[2];
#pragma unroll
        for (int u = 0; u < 2; ++u) { const int nn = n + u * F.ngw; if (nn < NTOK) {
            const f32x4 s0 = *(const f32x4*)(ssq + (size_t)nn * 8), s1 = *(const f32x4*)(ssq + (size_t)nn * 8 + 4);
            rstd[u] = 1.0f / sqrtf((((s0.x + s0.y) + (s0.z + s0.w)) + ((s1.x + s1.y) + (s1.z + s1.w))) * (1.0f / DM) + 1e-6f);
#pragma unroll
            for (int k = 0; k < 8; ++k) { const v2u w = *(const v2u*)((const bf16_t*)(a.ws + m.xn) + (size_t)nn * DM + 256 * k + 4 * lane); v[u][k] = (f32x4){bflo(w.x), bfhi(w.x), bflo(w.y), bfhi(w.y)}; } } }
#pragma unroll
        for (int u = 0; u < 2; ++u) { const int nn = n + u * F.ngw; if (nn < NTOK) {
#pragma unroll
            for (int k = 0; k < 8; ++k) *(f32x4*)(a.out + (size_t)nn * DM + 256 * k + 4 * lane) = (f32x4){v[u][k].x * rstd[u] * g4[k].x, v[u][k].y * rstd[u] * g4[k].y, v[u][k].z * rstd[u] * g4[k].z, v[u][k].w * rstd[u] * g4[k].w}; } }
    }
}

#define IN(k) (lo <= (k) && (k) < hi)
#define SEAM(k) do { if (IN(k) && IN((k) + 1)) xcd_barrier(bar); } while (0)
template <int l>
__device__ __forceinline__ void layer_phases(const Args& a, Frame& F, const XcdBarrier& bar, const WsMap& m, int lo, int hi) {
    constexpr int pb = l * PH_PER_LAYER;
        if (IN(pb + PH_GEMM1)) {
            pg8::GemmX g{(const bf16_t*)(a.ws + m.xn), (const bf16_t*)(a.ws + m.w1t) + (size_t)l * PLD * DM, NTOK, PLD, DM, DM};
            pg8::StaticOrder S; S.init(NTOK, PLD, F.G, (int)blockIdx.x);
            pg8::EpiBf16 E{(bf16_t*)(a.ws + m.p16), PLD, nullptr, (const float*)(a.ws + m.ssq)};
            pg8::gemm_phase<pg8::EpiBf16, pg8::StaticOrder, true, true>(F.lds, g, S, E);
            SEAM(pb + PH_GEMM1);
        }
        if (IN(pb + PH_PREP)) { prep_phase(a, F, l); SEAM(pb + PH_PREP); }
        if (IN(pb + PH_AUX)) {
            const float* PP = (const float*)(a.ws + m.pp);
            { pg8::GemmX g{(const bf16_t*)(a.ws + m.auxA), (const bf16_t*)(a.ws + m.auxwt) + (size_t)l * 1792 * 384, NTOK, 1792, 384, 384};
              pg8::StaticOrder S; S.init(NTOK, 1792, F.G, (int)blockIdx.x);
              pg8::EpiBf16 E{(bf16_t*)(a.ws + m.auxo), 1792, PP + l * 1792};
              pg8::gemm_phase<pg8::EpiBf16, pg8::StaticOrder, true, true>(F.lds, g, S, E); }
            { pg8::GemmX g{(const bf16_t*)(a.ws + m.xc), (const bf16_t*)(a.ws + m.lruwt) + (size_t)l * 1024 * 512, NTOK, 1024, 512, 512};
              pg8::StaticOrder S; S.init(NTOK, 1024, F.G, (int)blockIdx.x);
              pg8::EpiBf16 E{(bf16_t*)(a.ws + m.gates), 1024, PP + 3584 + l * 1024};
              pg8::gemm_phase<pg8::EpiBf16, pg8::StaticOrder, true, true>(F.lds, g, S, E); }
            if (l > 0) {
              pg8::GemmX g{(const bf16_t*)(a.ws + m.zrkv) + 1024, (const bf16_t*)(a.ws + m.vreswt), NTOK, 512, 512, 1536};
              pg8::StaticOrder S; S.init(NTOK, 512, F.G, (int)blockIdx.x);
              pg8::EpiBf16 E{(bf16_t*)(a.ws + m.vres), 512, PP + 5632};
              pg8::gemm_phase<pg8::EpiBf16, pg8::StaticOrder, true, true>(F.lds, g, S, E); }
            SEAM(pb + PH_AUX);
        }
        if (IN(pb + PH_SCAN)) { scan_phase(a, F, l); SEAM(pb + PH_SCAN); }
        if (IN(pb + PH_POST)) { post_phase(a, F, l, bar); SEAM(pb + PH_POST); }
        if (IN(pb + PH_GEMM2)) {
            pg8::GemmX g{(const bf16_t*)(a.ws + m.mix16), (const bf16_t*)(a.ws + m.w2t) + (size_t)l * DM * DM, NTOK, DM, DM, DM};
            pg8::StaticOrder S; S.init(NTOK, DM, F.G, (int)blockIdx.x);
            pg8::EpiResBf16 E{(bf16_t*)a.out, DM, (const bf16_t*)(a.ws + m.xn)};
            pg8::gemm_phase<pg8::EpiResBf16, pg8::StaticOrder, true, true>(F.lds, g, S, E);
            SEAM(pb + PH_GEMM2);
        }
        if (IN(pb + PH_NORM2)) { norm2_phase(a, F, l); SEAM(pb + PH_NORM2); }
        if (IN(pb + PH_GEMM3)) {
            pg8::GemmX g{(const bf16_t*)(a.ws + m.wsct) + (size_t)l * DM * DM, (const bf16_t*)(a.ws + m.hb), DM, NTOK, DM, DM};
            pg8::StaticOrder S; S.init(DM, NTOK, F.G, (int)blockIdx.x);
            pg8::EpiF32<false> E{(float*)(a.ws + m.sc), NTOK};
            pg8::gemm_phase<pg8::EpiF32<false>, pg8::StaticOrder, true, true>(F.lds, g, S, E);
            SEAM(pb + PH_GEMM3);
        }
        if (IN(pb + PH_TOPK)) { topk_phase(a, F, l); SEAM(pb + PH_TOPK); }
        if (IN(pb + PH_PEERU)) { peer_u_phase(a, F, l); SEAM(pb + PH_PEERU); }
        if (IN(pb + PH_PEERC)) { peer_c_phase(a, F); SEAM(pb + PH_PEERC); }
        if (IN(pb + PH_PEERV)) { peer_v_phase(a, F, l); SEAM(pb + PH_PEERV); }
}

#undef IN
#undef SEAM
__global__ void __launch_bounds__(NTHR, 2) mega(Args a) {
    extern __shared__ __attribute__((aligned(16))) unsigned char lds_raw[];
    Frame F;
    F.lds = (LAS unsigned char*)lds_raw;
    F.tid = threadIdx.x; F.lane = F.tid & 63; F.wave = __builtin_amdgcn_readfirstlane(F.tid >> 6);
    F.G = gridDim.x; { const int bx = blockIdx.x; F.vcu = (F.G % 8 == 0) ? (bx % 8) * (F.G / 8) + bx / 8 : bx; }
    F.gw = F.vcu * NWAVES + F.wave; F.ngw = F.G * NWAVES;
    volatile LAS unsigned* MISC = (volatile LAS unsigned*)(F.lds + MISC_OFF);
    if (F.tid < 32) MISC[F.tid] = 0u;
    __syncthreads();
    const WsMap m = ws_map(NTOK);
    unsigned* ctl = (unsigned*)(a.ws + m.ctl);
    XcdBarrier bar; bar.bar = ctl + 4096 + a.li * XCD_BAR_WORDS; bar.x = 0; bar.st = nullptr;
    const int lo = a.ph_lo, hi = a.ph_hi;
    if (hi - lo > 1) bar = xcd_barrier_post(ctl + 4096 + a.li * XCD_BAR_WORDS, MISC + 8);
#define IN(k) (lo <= (k) && (k) < hi)
#define SEAM(k) do { if (IN(k) && IN((k) + 1)) xcd_barrier(bar); } while (0)
    if (IN(PH_P0)) { p0_prologue(a, F); tables_range(a, F, 0, (size_t)2 * NEXP * DM / 32, F.vcu, F.G); SEAM(PH_P0); }
    layer_phases<0>(a, F, bar, m, lo, hi);
    layer_phases<1>(a, F, bar, m, lo, hi);
    if (IN(PH_FNORM)) fnorm_phase(a, F);
#undef IN
#undef SEAM
}

template <int ST>
__global__ void __launch_bounds__(256) stage_kernel(Params P, int l) {
    const long n = stage_items(P, ST, l);
    for (long it = blockIdx.x * 256L + threadIdx.x; it < n; it += gridDim.x * 256L) run_item(P, ST, l, it);
}
template <int ST>
static void launch_stage(const Params& P, int l, hipStream_t stream) {
    const long n = stage_items(P, ST, l);
    if (n <= 0) return;
    long blocks = (n + 255) / 256;
    if (blocks > 8192) blocks = 8192;
    stage_kernel<ST><<<dim3((unsigned)blocks), dim3(256), 0, stream>>>(P, l);
}
#define LS(X) case X: launch_stage<X>(P, l, stream); break;
static void launch_any(int st, const Params& P, int l, hipStream_t stream) {
    switch (st) {
        LS(ST_COPYX) LS(ST_RSTD) LS(ST_NORM1) LS(ST_GEMM1) LS(ST_RW_A0) LS(ST_RW_A1) LS(ST_RW_A2) LS(ST_RW_A3) LS(ST_RW_KKN)
        LS(ST_RW_SCAN) LS(ST_RW_POST) LS(ST_GLA_B0) LS(ST_GLA_SCAN) LS(ST_GLA_POST) LS(ST_LRU_C0) LS(ST_LRU_C1) LS(ST_LRU_SCAN)
        LS(ST_GDN_D0) LS(ST_GDN_D1) LS(ST_GDN_SCAN) LS(ST_GDN_POST) LS(ST_GEMM2) LS(ST_RSTD2) LS(ST_NORM2) LS(ST_GEMM3)
        LS(ST_SCORES) LS(ST_TOPK1) LS(ST_TOPK2) LS(ST_PEER_U) LS(ST_PEER_V) LS(ST_FRSTD) LS(ST_FNORM)
    }
}

extern "C" void kernel_launch(void* const* d_in, const int* in_sizes, int n_in, void* d_out, int out_size, void* d_ws,
                              size_t ws_size, hipStream_t stream) {
    static int grid = 0;
    if (grid == 0) {
        int dev = 0, cus = 0;
        (void)hipGetDevice(&dev);
        (void)hipDeviceGetAttribute(&cus, hipDeviceAttributeMultiprocessorCount, dev);
        (void)hipFuncSetAttribute((const void*)mega, hipFuncAttributeMaxDynamicSharedMemorySize, LDS_BYTES);
        grid = cus > 0 ? cus : 256;
    }
    Params P;
    memset(&P, 0, sizeof(P));
    fill_inputs(P, d_in);
    P.B = 4; P.T = 4096; P.N = 16384; P.pad = 0;
    P.xcur = (float*)d_out;
    bind_ws(P, (char*)d_ws);
    Args a;
    memset(&a, 0, sizeof(a));
    for (int i = 0; i < 38; ++i) a.in[i] = (const float*)d_in[i];
    a.out = (float*)d_out; a.ws = (unsigned char*)d_ws;
    (void)hipMemsetAsync(d_ws, 0, 32768, stream);
    int li = 0;
    auto run_mega = [&](int lo, int hi) { a.ph_lo = lo; a.ph_hi = hi; a.li = li++; hipLaunchKernelGGL(mega, dim3(grid), dim3(NTHR), LDS_BYTES, stream, a); };
    run_mega(PH_P0, PH_TOTAL);
}
#endif
```
